# Optimizing an MI355X kernel written in HIP

```python
import math
import jax, jax.numpy as jnp
from jax import lax
import numpy as np

D_MODEL = 1024
BATCH = 32
SEQ = 2048
DEPTH = 4

CTX_LEN = 256
GRID_W = 64
EPS = 1e-6
ROPE_BASE = 10000.0
Q_BLOCK = 128

MLA_HEADS = 8
MLA_NOPE = 64
MLA_ROPE = 32
MLA_V = 64
MLA_Q_RANK = 256
MLA_KV_RANK = 128
MLA_OUT = MLA_HEADS * MLA_V
MLA_SCALE = (MLA_NOPE + MLA_ROPE) ** -0.5

HY_WIDTH = 256
HY_SHORT = 3
HY_EMB = 33
HY_BANDS = (HY_EMB - 1) // 2
HY_HIDDEN = 64
HY_TARGET = 1e-2
HY_FAST = 0.3
HY_SLOW = 1.5
HY_SHIFT = 0.05

DF_HEADS = 4
DF_DIM = 32
DF_V = 2 * DF_DIM
DF_OUT = DF_HEADS * DF_V
DF_SCALE = DF_DIM ** -0.5

N_BRANCH = 3
D_FF = 4 * D_MODEL

COLS = (MLA_Q_RANK, MLA_KV_RANK, MLA_ROPE, 3 * HY_WIDTH,
        2 * DF_HEADS * DF_DIM, 2 * DF_HEADS * DF_DIM, DF_OUT, N_BRANCH * D_MODEL)
D_IN = sum(COLS)

kernel_name = "hybrid_mla_hyena_diffattn_dit"

f32 = jnp.float32


def rmsnorm(x, g):
    xf = x.astype(f32)
    y = xf * lax.rsqrt(jnp.mean(xf * xf, axis=-1, keepdims=True) + EPS)
    return (y * g.astype(f32)).astype(x.dtype)


def modulate(h, shift, scale):
    return h * (1 + scale) + shift


def split_cols(p):
    parts, off = [], 0
    for n in COLS:
        parts.append(p[..., off:off + n])
        off += n
    return parts


def to_heads(t, n_heads):
    B, L, _ = t.shape
    return t.reshape(B, L, n_heads, -1).transpose(0, 2, 1, 3)


def from_heads(t):
    B, H, L, d = t.shape
    return t.transpose(0, 2, 1, 3).reshape(B, L, H * d)


def axial_cos_sin(n_tokens, d_rot):
    rows = n_tokens // GRID_W
    row = jnp.repeat(jnp.arange(rows), GRID_W).astype(f32)
    col = jnp.tile(jnp.arange(GRID_W), rows).astype(f32)
    nf = d_rot // 4
    inv = ROPE_BASE ** (-jnp.arange(nf, dtype=f32) / nf)
    ang = jnp.concatenate([row[:, None] * inv, col[:, None] * inv], axis=-1)
    return jnp.cos(ang), jnp.sin(ang)


def apply_rope(x, cos, sin):
    half = x.shape[-1] // 2
    x1 = x[..., :half].astype(f32)
    x2 = x[..., half:].astype(f32)
    return jnp.concatenate([x1 * cos - x2 * sin, x2 * cos + x1 * sin], axis=-1).astype(x.dtype)


def attend(q, k, v, scale):
    B, H, Lq, dk = q.shape
    nb = Lq // Q_BLOCK
    qb = jnp.moveaxis(q.reshape(B, H, nb, Q_BLOCK, dk), 2, 0)

    def block(qi):
        s = jnp.einsum('bhqd,bhkd->bhqk', qi, k).astype(f32) * scale
        p = jax.nn.softmax(s, axis=-1).astype(v.dtype)
        return jnp.einsum('bhqk,bhkv->bhqv', p, v)

    o = lax.map(block, qb)
    return jnp.moveaxis(o, 0, 2).reshape(B, H, Lq, v.shape[-1])


def mla_qkv(pq, pkv, pkr, lp, rope):
    q = to_heads(rmsnorm(pq, lp['mla_q_norm_g']) @ lp['mla_w_uq'], MLA_HEADS)
    kv = to_heads(rmsnorm(pkv, lp['mla_kv_norm_g']) @ lp['mla_w_ukv'], MLA_HEADS)
    q_nope, q_rope = q[..., :MLA_NOPE], q[..., MLA_NOPE:]
    k_nope, v = kv[..., :MLA_NOPE], kv[..., MLA_NOPE:]
    k_rope = pkr[:, None]
    if rope is not None:
        q_rope = apply_rope(q_rope, *rope)
        k_rope = apply_rope(k_rope, *rope)
    k_rope = jnp.broadcast_to(k_rope, k_nope.shape[:-1] + (MLA_ROPE,))
    q = jnp.concatenate([q_nope, q_rope], axis=-1)
    k = jnp.concatenate([k_nope, k_rope], axis=-1)
    return q, k, v


def short_conv(u, w, b):
    C = u.shape[-1]
    y = lax.conv_general_dilated(u, w[:, None, :].astype(u.dtype), window_strides=(1,),
                                 padding=[(HY_SHORT // 2, HY_SHORT // 2)],
                                 dimension_numbers=('NWC', 'WIO', 'NWC'),
                                 feature_group_count=C)
    return y + b


def hyena_filters(L, lp):
    t = jnp.linspace(0.0, 1.0, L, dtype=f32)[:, None]
    w = (2.0 * math.pi / L) * jnp.arange(L, dtype=f32)[:, None]
    bands = jnp.linspace(1e-4, HY_BANDS - 1, HY_BANDS, dtype=f32)[None]
    z = jnp.concatenate([t, jnp.cos(bands * w), -jnp.sin(bands * w)], axis=-1)
    freq = lp['hy_freq'].astype(f32)
    a = jnp.sin(freq * (z @ lp['hy_w1'].astype(f32) + lp['hy_b1'].astype(f32)))
    a = jnp.sin(freq * (a @ lp['hy_w2'].astype(f32) + lp['hy_b2'].astype(f32)))
    h = a @ lp['hy_w3'].astype(f32) + lp['hy_b3'].astype(f32)
    deltas = jnp.linspace(math.log(HY_TARGET) / HY_SLOW, math.log(HY_TARGET) / HY_FAST,
                          HY_WIDTH, dtype=f32)
    window = jnp.exp(-t * jnp.abs(deltas)) + HY_SHIFT
    h = h.reshape(L, 2, HY_WIDTH) * window[:, None, :]
    return h[:, 0], h[:, 1]


def bidir_longconv(u, h_f, h_b, skip):
    L = u.shape[1]
    f = jnp.concatenate([h_f, jnp.zeros((1, h_f.shape[1]), f32), h_b[:0:-1]], axis=0)
    uf = u.astype(f32)
    y = jnp.fft.irfft(jnp.fft.rfft(uf, n=2 * L, axis=1) * jnp.fft.rfft(f, axis=0)[None],
                      n=2 * L, axis=1)[:, :L]
    return (y + uf * skip.astype(f32)).astype(u.dtype)


def hyena_branch(p, lp):
    L = p.shape[1]
    uc = short_conv(p, lp['hy_conv_w'], lp['hy_conv_b'])
    x0, x1, v = jnp.split(uc, 3, axis=-1)
    h_f, h_b = hyena_filters(L, lp)
    return x0 * bidir_longconv(v * x1, h_f, h_b, lp['hy_skip'])


def diff_qkv(pq, pk, pv, rope):
    q = to_heads(pq, 2 * DF_HEADS)
    k = to_heads(pk, 2 * DF_HEADS)
    if rope is not None:
        q = apply_rope(q, *rope)
        k = apply_rope(k, *rope)
    B, _, L, _ = q.shape
    q = q.reshape(B, DF_HEADS, 2, L, DF_DIM)
    k = k.reshape(B, DF_HEADS, 2, L, DF_DIM)
    return q, k, to_heads(pv, DF_HEADS)


def diff_lambda(lp, lam_init):
    l1 = jnp.exp(jnp.sum(lp['df_lq1'].astype(f32) * lp['df_lk1'].astype(f32)))
    l2 = jnp.exp(jnp.sum(lp['df_lq2'].astype(f32) * lp['df_lk2'].astype(f32)))
    return l1 - l2 + lam_init


def diff_combine(o1, o2, lam, lam_init, g):
    o = o1 - lam.astype(o1.dtype) * o2
    return from_heads(rmsnorm(o, g) * (1.0 - lam_init))


def merge_branches(ya, yb, yc, pg, lp):
    g = jax.nn.sigmoid(pg.astype(f32)).astype(ya.dtype)
    g_a, g_b, g_c = jnp.split(g, N_BRANCH, axis=-1)
    m = g_a * (ya @ lp['w_br_a']) + g_b * (yb @ lp['w_br_b']) + g_c * (yc @ lp['w_br_c'])
    return m @ lp['w_out']


def sqrelu_mlp(h, w1, w2):
    return jnp.square(jax.nn.relu(h @ w1)) @ w2


def token_mixers(h, hc, lp, lam_init, rope_mla, rope_df, with_ctx):
    pq, pkv, pkr, phy, pdq, pdk, pdv, pg = split_cols(h @ lp['w_in'])
    cq, ckv, ckr, chy, cdq, cdk, cdv, cg = split_cols(hc @ lp['w_in'])

    qa, ka, va = mla_qkv(pq, pkv, pkr, lp, rope_mla)
    qa_c, ka_c, va_c = mla_qkv(cq, ckv, ckr, lp, None)
    ya = from_heads(attend(qa, jnp.concatenate([ka_c, ka], axis=2),
                           jnp.concatenate([va_c, va], axis=2), MLA_SCALE))

    yb = hyena_branch(phy, lp)

    lam = diff_lambda(lp, lam_init)
    qd, kd, vd = diff_qkv(pdq, pdk, pdv, rope_df)
    qd_c, kd_c, vd_c = diff_qkv(cdq, cdk, cdv, None)
    v_all = jnp.concatenate([vd_c, vd], axis=2)
    o1 = attend(qd[:, :, 0], jnp.concatenate([kd_c[:, :, 0], kd[:, :, 0]], axis=2), v_all, DF_SCALE)
    o2 = attend(qd[:, :, 1], jnp.concatenate([kd_c[:, :, 1], kd[:, :, 1]], axis=2), v_all, DF_SCALE)
    yc = diff_combine(o1, o2, lam, lam_init, lp['df_subln_g'])

    y = merge_branches(ya, yb, yc, pg, lp)
    if not with_ctx:
        return y, None

    ya_c = from_heads(attend(qa_c, ka_c, va_c, MLA_SCALE))
    yb_c = hyena_branch(chy, lp)
    o1c = attend(qd_c[:, :, 0], kd_c[:, :, 0], vd_c, DF_SCALE)
    o2c = attend(qd_c[:, :, 1], kd_c[:, :, 1], vd_c, DF_SCALE)
    yc_c = diff_combine(o1c, o2c, lam, lam_init, lp['df_subln_g'])
    y_c = merge_branches(ya_c, yb_c, yc_c, cg, lp)
    return y, y_c


def setup_inputs(seed: int = 0) -> dict:
    key = jax.random.key(seed)
    it = iter(jax.random.split(key, 40))

    def nrm(shape, scale):
        return jax.random.normal(next(it), shape, f32) * scale

    def gain(shape):
        return 1.0 + nrm(shape, 0.05)

    L = DEPTH
    return {
        'x': nrm((BATCH, SEQ, D_MODEL), 1.0),
        'c': nrm((BATCH, D_MODEL), 1.0),
        'ctx': nrm((BATCH, CTX_LEN, D_MODEL), 1.0),
        'c_ctx': nrm((D_MODEL,), 1.0),
        'norm_mix_g': gain((L, D_MODEL)),
        'norm_ffn_g': gain((L, D_MODEL)),
        'w_mod': nrm((L, D_MODEL, 6 * D_MODEL), 0.02),
        'b_mod': nrm((L, 6 * D_MODEL), 0.01),
        'w_in': nrm((L, D_MODEL, D_IN), D_MODEL ** -0.5),
        'mla_q_norm_g': gain((L, MLA_Q_RANK)),
        'mla_w_uq': nrm((L, MLA_Q_RANK, MLA_HEADS * (MLA_NOPE + MLA_ROPE)), MLA_Q_RANK ** -0.5),
        'mla_kv_norm_g': gain((L, MLA_KV_RANK)),
        'mla_w_ukv': nrm((L, MLA_KV_RANK, MLA_HEADS * (MLA_NOPE + MLA_V)), MLA_KV_RANK ** -0.5),
        'hy_conv_w': nrm((L, HY_SHORT, 3 * HY_WIDTH), 0.5),
        'hy_conv_b': nrm((L, 3 * HY_WIDTH), 0.01),
        'hy_w1': nrm((L, HY_EMB, HY_HIDDEN), HY_EMB ** -0.5),
        'hy_b1': nrm((L, HY_HIDDEN), 0.1),
        'hy_freq': gain((L, HY_HIDDEN)),
        'hy_w2': nrm((L, HY_HIDDEN, HY_HIDDEN), HY_HIDDEN ** -0.5),
        'hy_b2': nrm((L, HY_HIDDEN), 0.1),
        'hy_w3': nrm((L, HY_HIDDEN, 2 * HY_WIDTH), 0.005),
        'hy_b3': nrm((L, 2 * HY_WIDTH), 0.001),
        'hy_skip': nrm((L, HY_WIDTH), 0.5),
        'df_lq1': nrm((L, DF_DIM), 0.1),
        'df_lk1': nrm((L, DF_DIM), 0.1),
        'df_lq2': nrm((L, DF_DIM), 0.1),
        'df_lk2': nrm((L, DF_DIM), 0.1),
        'df_subln_g': gain((L, DF_V)),
        'w_br_a': nrm((L, MLA_OUT, D_MODEL), MLA_OUT ** -0.5),
        'w_br_b': nrm((L, HY_WIDTH, D_MODEL), HY_WIDTH ** -0.5),
        'w_br_c': nrm((L, DF_OUT, D_MODEL), DF_OUT ** -0.5),
        'w_out': nrm((L, D_MODEL, D_MODEL), D_MODEL ** -0.5),
        'w_fc1': nrm((L, D_MODEL, D_FF), D_MODEL ** -0.5),
        'w_fc2': nrm((L, D_FF, D_MODEL), D_FF ** -0.5),
        'final_norm_g': gain((D_MODEL,)),
    }


def reference(x, c, ctx, c_ctx, norm_mix_g, norm_ffn_g, w_mod, b_mod, w_in,
              mla_q_norm_g, mla_w_uq, mla_kv_norm_g, mla_w_ukv,
              hy_conv_w, hy_conv_b, hy_w1, hy_b1, hy_freq, hy_w2, hy_b2, hy_w3, hy_b3, hy_skip,
              df_lq1, df_lk1, df_lq2, df_lk2, df_subln_g,
              w_br_a, w_br_b, w_br_c, w_out, w_fc1, w_fc2, final_norm_g):
    n_lat = x.shape[1]
    rope_mla = axial_cos_sin(n_lat, MLA_ROPE)
    rope_df = axial_cos_sin(n_lat, DF_DIM)
    s_c = jax.nn.silu(c)
    s_cc = jax.nn.silu(c_ctx)
    xc = ctx
    for l in range(DEPTH):
        with_ctx = l < DEPTH - 1
        lam_init = 0.8 - 0.6 * math.exp(-0.3 * l)
        lp = {
            'w_in': w_in[l],
            'mla_q_norm_g': mla_q_norm_g[l], 'mla_w_uq': mla_w_uq[l],
            'mla_kv_norm_g': mla_kv_norm_g[l], 'mla_w_ukv': mla_w_ukv[l],
            'hy_conv_w': hy_conv_w[l], 'hy_conv_b': hy_conv_b[l],
            'hy_w1': hy_w1[l], 'hy_b1': hy_b1[l], 'hy_freq': hy_freq[l],
            'hy_w2': hy_w2[l], 'hy_b2': hy_b2[l], 'hy_w3': hy_w3[l], 'hy_b3': hy_b3[l],
            'hy_skip': hy_skip[l],
            'df_lq1': df_lq1[l], 'df_lk1': df_lk1[l], 'df_lq2': df_lq2[l], 'df_lk2': df_lk2[l],
            'df_subln_g': df_subln_g[l],
            'w_br_a': w_br_a[l], 'w_br_b': w_br_b[l], 'w_br_c': w_br_c[l], 'w_out': w_out[l],
        }
        sh_m, sc_m, g_m, sh_f, sc_f, g_f = [t[:, None] for t in
                                            jnp.split(s_c @ w_mod[l] + b_mod[l], 6, axis=-1)]
        csh_m, csc_m, cg_m, csh_f, csc_f, cg_f = jnp.split(s_cc @ w_mod[l] + b_mod[l], 6, axis=-1)

        h = modulate(rmsnorm(x, norm_mix_g[l]), sh_m, sc_m)
        hc = modulate(rmsnorm(xc, norm_mix_g[l]), csh_m, csc_m)
        y, y_c = token_mixers(h, hc, lp, lam_init, rope_mla, rope_df, with_ctx)

        x = x + g_m * y
        x = x + g_f * sqrelu_mlp(modulate(rmsnorm(x, norm_ffn_g[l]), sh_f, sc_f), w_fc1[l], w_fc2[l])
        if with_ctx:
            xc = xc + cg_m * y_c
            xc = xc + cg_f * sqrelu_mlp(modulate(rmsnorm(xc, norm_ffn_g[l]), csh_f, csc_f),
                                        w_fc1[l], w_fc2[l])
    return rmsnorm(x, final_norm_g)
```

```cpp
#include <hip/hip_runtime.h>
#include <cstdio>
#include <cstdint>

#ifndef MK_FUSED
#define MK_FUSED 0
#endif

#define LAS __attribute__((address_space(3)))
#define GAS __attribute__((address_space(1)))
typedef _Float16 hf;
typedef _Float16 hf2 __attribute__((ext_vector_type(2)));
typedef _Float16 hf4 __attribute__((ext_vector_type(4)));
typedef _Float16 hf8 __attribute__((ext_vector_type(8)));
typedef short s16x4 __attribute__((ext_vector_type(4)));
typedef float f32x2 __attribute__((ext_vector_type(2)));
typedef float f32x4 __attribute__((ext_vector_type(4)));
typedef float f32x16 __attribute__((ext_vector_type(16)));
typedef unsigned u32x2 __attribute__((ext_vector_type(2)));
typedef unsigned u32x4 __attribute__((ext_vector_type(4)));

constexpr int DM = 1024, NB = 32, SEQ = 2048, DEPTH = 4, CTXL = 256, GRIDW = 64;
constexpr int NLAT = NB * SEQ;
constexpr int NCTX = NB * CTXL;
constexpr int MTOT = NLAT + NCTX;
constexpr int D_IN = 5024, NP1 = 2048  , NGATE = 3072, DFF = 4096;
constexpr int C_PQ = 0, C_PKV = 256, C_PKR = 384, C_HY = 416, C_DQ = 1184, C_DK = 1440, C_DV = 1696, C_PG = 1952;
constexpr int NUP = 1792, KUP = 384;
constexpr int NMODV = 33, MODW = 6 * DM;
constexpr float EPS = 1e-6f;
constexpr float MLA_SCALE = 0.10206207261596575f;
constexpr float DF_SCALE = 0.17677669529663687f;

constexpr size_t al256(size_t x) { return (x + 255) / 256 * 256; }
constexpr size_t WS_BAR = 0, WS_BAR_BYTES = 65536;
constexpr size_t WS_MOD = WS_BAR + WS_BAR_BYTES;
constexpr size_t WS_ROPE = WS_MOD + al256((size_t)DEPTH * NMODV * MODW * 4);
constexpr size_t WS_LAM = WS_ROPE + (size_t)SEQ * 32 * 4;
constexpr size_t WS_RF = WS_LAM + 256;
constexpr size_t WS_RFC = WS_RF + (size_t)DEPTH * 256 * 4096 * 2;
constexpr size_t WS_XC = WS_RFC + (size_t)DEPTH * 256 * 512 * 2;
constexpr size_t WS_WT = WS_XC + (size_t)NCTX * DM * 4;
constexpr size_t W_IN1 = 0, W_ING = W_IN1 + (size_t)NP1 * DM * 2, W_UP = W_ING + (size_t)NGATE * DM * 2, W_BR = W_UP + (size_t)NUP * KUP * 2,
                 W_OUT = W_BR + (size_t)DM * DM * 2, W_FC1 = W_OUT + (size_t)DM * DM * 2, W_FC2 = W_FC1 + (size_t)DFF * DM * 2, W_LAYER = W_FC2 + (size_t)DM * DFF * 2;
constexpr size_t WS_ARENA = WS_WT + DEPTH * W_LAYER;
constexpr size_t SZ_ROW1024 = (size_t)MTOT * 1024 * 2;
constexpr size_t A_H = WS_ARENA;
constexpr size_t A_Y = A_H + SZ_ROW1024;
constexpr size_t A_BIG = A_Y + SZ_ROW1024;
constexpr size_t A_P1 = A_BIG;
constexpr size_t A_QKV = A_BIG;
constexpr size_t A_QKVN = A_P1 + (size_t)MTOT * NP1 * 2;
constexpr size_t A_KR = A_QKVN + (size_t)MTOT * KUP * 2;
constexpr size_t A_DQ = A_KR + (size_t)MTOT * 32 * 2;
constexpr size_t A_DK = A_DQ + (size_t)MTOT * 256 * 2;
constexpr size_t A_DV = A_DK + (size_t)MTOT * 256 * 2;
constexpr size_t A_UT = A_DV + (size_t)MTOT * 256 * 2;
constexpr size_t A_X0T = A_UT + (size_t)256 * NLAT * 2;
constexpr size_t A_UTC = A_X0T + (size_t)256 * NLAT * 2;
constexpr size_t A_X0TC = A_UTC + (size_t)256 * NCTX * 2;
constexpr size_t A_BIG_END = A_X0TC + (size_t)256 * NCTX * 2;
constexpr size_t A_G = A_BIG;
constexpr size_t A_HID = A_Y;
constexpr size_t WS_END = (A_BIG_END > A_HID + (size_t)MTOT * DFF * 2) ? A_BIG_END : A_HID + (size_t)MTOT * DFF * 2;
static_assert(A_G + (size_t)MTOT * NGATE * 2 <= A_BIG_END + ((size_t)1 << 40), "map");
static_assert(WS_END <= (size_t)1024 * 1024 * 1024, "workspace map exceeds 1 GiB");

constexpr int LDS_BYTES = 147456;
constexpr int LDS_MISC = LDS_BYTES - 64;

__device__ __forceinline__ unsigned pkh(float lo, float hi) { f32x2 v = {lo, hi}; hf2 h = __builtin_convertvector(v, hf2); return __builtin_bit_cast(unsigned, h); }
__device__ __forceinline__ float wave_sum(float v) {
#pragma unroll
    for (int o = 1; o < 64; o <<= 1) v += __shfl_xor(v, o);
    return v;
}
#define LDS_WAIT() asm volatile("s_waitcnt lgkmcnt(0)" ::: "memory")
#define VM_WAIT() asm volatile("s_waitcnt vmcnt(0)" ::: "memory")

#define XB_TMO      128
#define XB_XCNT(j)  (256  + 64 * (j))
#define XB_XSUB(j)  (1280 + 64 * (j))
#define XB_XGEN(j)  (2304 + 64 * (j))
#define XB_TOP      3328
#define XB_TOPGEN   3392
#define XCD_BAR_WORDS 3456
#define XB_SPIN_CAP (1u << 22)
__device__ __forceinline__ unsigned xb_ld(unsigned* p)              { return __hip_atomic_load(p, __ATOMIC_RELAXED, __HIP_MEMORY_SCOPE_AGENT); }
__device__ __forceinline__ unsigned xb_add(unsigned* p, unsigned v) { return __hip_atomic_fetch_add(p, v, __ATOMIC_RELAXED, __HIP_MEMORY_SCOPE_AGENT); }
__device__ __forceinline__ unsigned xb_xcc_id() { return (unsigned)__builtin_amdgcn_s_getreg((3 << 11) | 20) & 0xFu; }
#define XB_SPIN(cond, bar) do { unsigned _sp = 0; while (cond) { __builtin_amdgcn_s_sleep(1); \
    if ((++_sp & 255u) == 0u) { if (xb_ld(&(bar)[XB_TMO])) break; if (_sp > XB_SPIN_CAP) { atomicAdd(&(bar)[XB_TMO], 1u); break; } } } } while (0)
struct XcdBarrier { unsigned* bar; unsigned x; volatile LAS unsigned* st; };
__device__ __forceinline__ XcdBarrier xcd_barrier_post(unsigned* bar, volatile LAS unsigned* st) {
    XcdBarrier b; b.bar = bar; b.x = xb_xcc_id(); b.st = st;
    if (threadIdx.x == 0) (void)xb_add(&bar[XB_XCNT(b.x)], 1u);
    return b;
}
__device__ __forceinline__ void xcd_barrier_complete(unsigned* bar, unsigned x, unsigned& nloc, unsigned& nx) {
    const unsigned G = gridDim.x * gridDim.y * gridDim.z;
    unsigned sum, cnt, mine, sp = 0u;
    for (;;) {
        sum = 0u; cnt = 0u; mine = 0u;
#pragma unroll
        for (unsigned j = 0; j < 16; ++j) { const unsigned c = xb_ld(&bar[XB_XCNT(j)]); sum += c; cnt += (c > 0u) ? 1u : 0u; mine = (j == x) ? c : mine; }
        if (sum == G) break;
        __builtin_amdgcn_s_sleep(1);
        if ((++sp & 255u) == 0u) { if (xb_ld(&bar[XB_TMO])) break; if (sp > XB_SPIN_CAP) { atomicAdd(&bar[XB_TMO], 1u); break; } }
    }
    nloc = mine > 0u ? mine : 1u; nx = cnt > 0u ? cnt : 1u;
}
__device__ __forceinline__ void xcd_barrier(const XcdBarrier& b) {
    asm volatile("s_waitcnt vmcnt(0)" ::: "memory");
    __syncthreads();
    if (threadIdx.x == 0) {
        unsigned* bar = b.bar;
        __builtin_amdgcn_s_waitcnt(0);
        unsigned nloc = b.st[0], nx = b.st[1];
        if (nloc == 0u) { xcd_barrier_complete(bar, b.x, nloc, nx); b.st[0] = nloc; b.st[1] = nx; }
        const unsigned old = xb_add(&bar[XB_XSUB(b.x)], 1u);
        const unsigned gen = old / nloc;
        if (old + 1u == (gen + 1u) * nloc) {
            __builtin_amdgcn_fence(__ATOMIC_RELEASE, "agent");
            asm volatile("s_waitcnt vmcnt(0)" ::: "memory");
            const unsigned og = xb_add(&bar[XB_TOP], 1u);
            const unsigned tg = og / nx;
            if (og + 1u == (tg + 1u) * nx) xb_add(&bar[XB_TOPGEN], 1u);
            else XB_SPIN(xb_ld(&bar[XB_TOPGEN]) == tg, bar);
            __builtin_amdgcn_fence(__ATOMIC_ACQUIRE, "agent");
            xb_add(&bar[XB_XGEN(b.x)], 1u);
            asm volatile("s_waitcnt vmcnt(0)" ::: "memory");
        } else {
            XB_SPIN(xb_ld(&bar[XB_XGEN(b.x)]) == gen, bar);
            __builtin_amdgcn_fence(__ATOMIC_ACQUIRE, "agent");
            asm volatile("s_waitcnt vmcnt(0)" ::: "memory");
        }
    }
    __syncthreads();
}

namespace pg8 {
constexpr int BM = 256, BK = 64, HALF = 128, HTB = HALF * BK * 2, STAGE_BYTES = 8 * HTB, NXCD = 8, WGM = 8;
__host__ __device__ __forceinline__ int lds_byte(int r, int c) { const int st = (r >> 4) * 2 + (c >> 5), rr = r & 15, cc = c & 31, ob = rr * 64 + cc * 2; return st * 1024 + (ob ^ (((ob >> 9) & 1) << 5)); }
__host__ __device__ __forceinline__ void stage_rc(int b, int& R, int& C) { const int st = b / 1024, sb = b % 1024, swz = sb ^ (((sb >> 9) & 1) << 5); R = (st >> 1) * 16 + swz / 64; C = (st & 1) * 32 + (swz % 64) / 2; }
__host__ __device__ __forceinline__ int perm32(int rho) { const int n = rho >> 4, i = rho & 15; return 8 * (i >> 2) + 4 * n + (i & 3); }
struct Unit { int pm, pn; };
struct Gemm { const hf* A; const hf* Bt; int M, N, K, lda, ldb; };
struct StaticOrder {
    int nM, nN, nwg, G, c;
    __host__ __device__ void init(int M, int N, int G_, int c_) { nM = M / BM; nN = N / BM; nwg = nM * nN; G = G_; c = c_; }
    __host__ __device__ bool next(int i, Unit& u) const {
        const long L = (long)i * G + c; if (L >= nwg) return false;
        int wgid = (int)L; { const int q = nwg / NXCD, r = nwg % NXCD, xcd = wgid % NXCD, off = wgid / NXCD; wgid = (xcd < r ? xcd * (q + 1) : r * (q + 1) + (xcd - r) * q) + off; }
        const int nig = WGM * nN, gid = wgid / nig, fm = gid * WGM, gsz = (nM - fm) < WGM ? (nM - fm) : WGM;
        u.pm = fm + ((wgid % nig) % gsz); u.pn = (wgid % nig) / gsz; return true;
    }
    __device__ __forceinline__ void a_ready(const Unit&) const {}
    __device__ __forceinline__ void done(const Unit&) const {}
};

template <int ACT  > struct EpiHalf {
    static constexpr bool PERM = true, AFTER_DRAIN = false;
    hf* O; int ldc;
    __device__ __forceinline__ void operator()(const f32x4 (&acc)[2][2][4][2], const Unit& u, int wr, int wc, int fr, int fq) const {
        const int row0 = u.pm * BM + wr * 64 + fr, col0 = u.pn * BM + wc * 32 + 8 * fq;
#pragma unroll
        for (int ai = 0; ai < 2; ++ai)
#pragma unroll
            for (int m = 0; m < 4; ++m) { hf* rowp = O + (size_t)(row0 + ai * HALF + m * 16) * ldc + col0;
#pragma unroll
                for (int bj = 0; bj < 2; ++bj) { f32x4 v0 = acc[ai][bj][m][0], v1 = acc[ai][bj][m][1];
                    if (ACT == 1) {
#pragma unroll
                        for (int e = 0; e < 4; ++e) { v0[e] = __builtin_amdgcn_rcpf(1.f + __builtin_amdgcn_exp2f(-1.4426950408889634f * v0[e])); v1[e] = __builtin_amdgcn_rcpf(1.f + __builtin_amdgcn_exp2f(-1.4426950408889634f * v1[e])); } }
                    if (ACT == 2) {
#pragma unroll
                        for (int e = 0; e < 4; ++e) { const float a = fmaxf(v0[e], 0.f), b = fmaxf(v1[e], 0.f); v0[e] = a * a; v1[e] = b * b; } }
                    u32x4 w; w.x = pkh(v0[0], v0[1]); w.y = pkh(v0[2], v0[3]); w.z = pkh(v1[0], v1[1]); w.w = pkh(v1[2], v1[3]);
                    *(u32x4*)(rowp + bj * HALF) = w; } }
    }
};
template <bool FIRST> struct EpiGated {
    static constexpr bool PERM = true, AFTER_DRAIN = false;
    hf* MMo; const hf* G; int goff;
    __device__ __forceinline__ void operator()(const f32x4 (&acc)[2][2][4][2], const Unit& u, int wr, int wc, int fr, int fq) const {
        const int row0 = u.pm * BM + wr * 64 + fr, col0 = u.pn * BM + wc * 32 + 8 * fq;
#pragma unroll
        for (int ai = 0; ai < 2; ++ai)
#pragma unroll
            for (int m = 0; m < 4; ++m) { const size_t r = (size_t)(row0 + ai * HALF + m * 16);
#pragma unroll
                for (int bj = 0; bj < 2; ++bj) { const f32x4 v0 = acc[ai][bj][m][0], v1 = acc[ai][bj][m][1];
                    const hf8 g = *(const hf8*)(G + r * NGATE + goff + col0 + bj * HALF);
                    hf* mp = MMo + r * DM + col0 + bj * HALF;
                    float o[8];
#pragma unroll
                    for (int e = 0; e < 4; ++e) { o[e] = (float)g[e] * v0[e]; o[4 + e] = (float)g[4 + e] * v1[e]; }
                    if (!FIRST) { const hf8 p = *(const hf8*)mp;
#pragma unroll
                        for (int e = 0; e < 8; ++e) o[e] += (float)p[e]; }
                    u32x4 w; w.x = pkh(o[0], o[1]); w.y = pkh(o[2], o[3]); w.z = pkh(o[4], o[5]); w.w = pkh(o[6], o[7]);
                    *(u32x4*)mp = w; } }
    }
};
struct EpiResid {
    static constexpr bool PERM = false, AFTER_DRAIN = false;
    const float* xs_lat; const float* xs_ctx; float* xd_lat; float* xd_ctx; const float* gate;
    __device__ __forceinline__ void operator()(const f32x4 (&acc)[2][2][4][2], const Unit& u, int wr, int wc, int fr, int fq) const {
        const int R0 = u.pm * BM; const bool lat = R0 < NLAT;
        const int v = lat ? (R0 >> 11) : NB;
        const int rloc = (lat ? R0 : R0 - NLAT) + wr * 64 + fr, col0 = u.pn * BM + wc * 32 + 4 * fq;
        const float* src = lat ? xs_lat : xs_ctx; float* dst = lat ? xd_lat : xd_ctx; const float* gp = gate + (size_t)v * MODW + col0;
        f32x4 gv[2][2];
#pragma unroll
        for (int bj = 0; bj < 2; ++bj)
#pragma unroll
            for (int n = 0; n < 2; ++n) gv[bj][n] = *(const f32x4*)(gp + bj * HALF + n * 16);
#pragma unroll
        for (int ai = 0; ai < 2; ++ai)
#pragma unroll
            for (int m = 0; m < 4; ++m) { const size_t off = (size_t)(rloc + ai * HALF + m * 16) * DM + col0;
#pragma unroll
                for (int bj = 0; bj < 2; ++bj)
#pragma unroll
                    for (int n = 0; n < 2; ++n) { const f32x4 x = *(const f32x4*)(src + off + bj * HALF + n * 16);
                        *(f32x4*)(dst + off + bj * HALF + n * 16) = x + gv[bj][n] * acc[ai][bj][m][n]; } }
    }
};

template <class Epi, class Sched, bool ALIGN_EPI = true>
__device__ __forceinline__ void gemm_phase(LAS unsigned char* lds, const Gemm g, const Sched& S, const Epi& E) {
    int tid = threadIdx.x; asm volatile("" : "+v"(tid));
    const int wid = __builtin_amdgcn_readfirstlane(tid >> 6), lane = tid & 63, wr = wid >> 2, wc = wid & 3, fr = lane & 15, fq = lane >> 4;
    const int K = g.K, nt = K / BK;
    unsigned voffA[2], voffB[2];
#pragma unroll
    for (int i = 0; i < 2; ++i) { int R, C; stage_rc(tid * 16 + i * 8192, R, C); const int Rb = Epi::PERM ? ((R & ~31) + perm32(R & 31)) : R;
        voffA[i] = (unsigned)(R * g.lda + C) * 2u; voffB[i] = (unsigned)(Rb * g.ldb + C) * 2u; }
    const size_t kstep = (size_t)(BK * 2);
    const size_t hstepA = (size_t)HALF * g.lda * 2, hstepB = (size_t)HALF * g.ldb * 2;
    const size_t tstepA = 2 * hstepA, tstepB = 2 * hstepB;
    const unsigned ldsw = (unsigned)wid * 1024u;
    const int aoff = lds_byte(wr * 64 + fr, fq * 8), boff = lds_byte(wc * 32 + fr, fq * 8);
#define PG8_SA(b, h) (((b) * 2 + (h)) * HTB)
#define PG8_SB(b, h) ((4 + (b) * 2 + (h)) * HTB)
#define PG8_STAGE(bufoff, gbase, voff) do { _Pragma("unroll") for (int _i = 0; _i < 2; ++_i) \
        __builtin_amdgcn_global_load_lds((const unsigned*)((const char*)(gbase) + (voff)[_i]), (LAS unsigned*)(lds + (bufoff) + ldsw + _i * 8192), 16, 0, 0); } while (0)
#define PG8_LDA(dst, b, h) do { _Pragma("unroll") for (int m = 0; m < 4; ++m) _Pragma("unroll") for (int k = 0; k < 2; ++k) dst[m][k] = *(const LAS hf8*)(lds + PG8_SA(b, h) + aoff + m * 2048 + k * 1024); } while (0)
#define PG8_LDB(dst, b, h) do { _Pragma("unroll") for (int n = 0; n < 2; ++n) _Pragma("unroll") for (int k = 0; k < 2; ++k) dst[n][k] = *(const LAS hf8*)(lds + PG8_SB(b, h) + boff + n * 2048 + k * 1024); } while (0)
#define PG8_MMA(ai, bj, At, Bt) do { __builtin_amdgcn_s_setprio(1); _Pragma("unroll") for (int m = 0; m < 4; ++m) _Pragma("unroll") for (int n = 0; n < 2; ++n) _Pragma("unroll") for (int k = 0; k < 2; ++k) \
        acc[ai][bj][m][n] = __builtin_amdgcn_mfma_f32_16x16x32_f16(Bt[n][k], At[m][k], acc[ai][bj][m][n], 0, 0, 0); __builtin_amdgcn_s_setprio(0); } while (0)
#define PG8_WAIT_V(n) asm volatile("s_waitcnt vmcnt(" #n ")" ::: "memory")
#define PG8_WAIT_L(n) asm volatile("s_waitcnt lgkmcnt(" #n ")" ::: "memory")
#define PG8_BAR __builtin_amdgcn_s_barrier()
#define PG8_SCHED __builtin_amdgcn_sched_barrier(0)
    Unit cur, nxt; int ui = 0;
    if (!S.next(0, cur)) return;
    f32x4 acc[2][2][4][2];
#pragma unroll
    for (int a = 0; a < 2; ++a)
#pragma unroll
        for (int b = 0; b < 2; ++b)
#pragma unroll
            for (int m = 0; m < 4; ++m)
#pragma unroll
                for (int n = 0; n < 2; ++n) acc[a][b][m][n] = (f32x4){0.f, 0.f, 0.f, 0.f};
    hf8 At[4][2], B0[2][2], B1[2][2];
    const char* cA = (const char*)g.A + (size_t)cur.pm * tstepA; const char* cB = (const char*)g.Bt + (size_t)cur.pn * tstepB;
    S.a_ready(cur);
    PG8_STAGE(PG8_SB(0, 0), cB, voffB); PG8_STAGE(PG8_SB(0, 1), cB + hstepB, voffB); PG8_STAGE(PG8_SA(0, 0), cA, voffA); PG8_STAGE(PG8_SA(0, 1), cA + hstepA, voffA);
    if (wr == 1) PG8_BAR;
    PG8_WAIT_V(2); PG8_BAR;
    PG8_STAGE(PG8_SB(1, 0), cB + kstep, voffB); PG8_STAGE(PG8_SA(1, 0), cA + kstep, voffA); PG8_STAGE(PG8_SB(1, 1), cB + hstepB + kstep, voffB);
    PG8_WAIT_V(6); PG8_BAR;
    for (;;) {
        const bool has_next = S.next(ui + 1, nxt);
        const char* nA = has_next ? (const char*)g.A + (size_t)nxt.pm * tstepA : cA; const char* nB = has_next ? (const char*)g.Bt + (size_t)nxt.pn * tstepB : cB;
#pragma unroll 1
        for (int t = 0; t < nt; t += 2) {
            const bool last = (t == nt - 2);
            const char* a1 = cA + (size_t)(t + 1) * kstep;
            const char* a2 = last ? nA : cA + (size_t)(t + 2) * kstep; const char* b2 = last ? nB : cB + (size_t)(t + 2) * kstep;
            const char* a3 = a2 + kstep; const char* b3 = b2 + kstep;
            if (last && has_next) S.a_ready(nxt);
            PG8_LDB(B0, 0, 0); PG8_LDB(B1, 0, 1); PG8_SCHED; PG8_LDA(At, 0, 0); PG8_STAGE(PG8_SA(1, 1), a1 + hstepA, voffA);
            PG8_WAIT_V(8); PG8_WAIT_L(0); PG8_BAR; PG8_MMA(0, 0, At, B0); PG8_MMA(0, 1, At, B1); PG8_BAR; PG8_SCHED;
            PG8_LDA(At, 0, 1); PG8_STAGE(PG8_SB(0, 0), b2, voffB); PG8_STAGE(PG8_SB(0, 1), b2 + hstepB, voffB); PG8_STAGE(PG8_SA(0, 0), a2, voffA);
            PG8_WAIT_V(8); PG8_WAIT_L(0); PG8_BAR; PG8_MMA(1, 0, At, B0); PG8_MMA(1, 1, At, B1); PG8_BAR; PG8_SCHED;
            PG8_LDB(B0, 1, 0); PG8_LDB(B1, 1, 1); PG8_SCHED; PG8_LDA(At, 1, 0); PG8_STAGE(PG8_SA(0, 1), a2 + hstepA, voffA);
            PG8_WAIT_V(8); PG8_WAIT_L(0); PG8_BAR; PG8_MMA(0, 0, At, B0); PG8_MMA(0, 1, At, B1); PG8_BAR; PG8_SCHED;
            PG8_LDA(At, 1, 1); PG8_STAGE(PG8_SB(1, 0), b3, voffB); PG8_STAGE(PG8_SB(1, 1), b3 + hstepB, voffB); PG8_STAGE(PG8_SA(1, 0), a3, voffA);
            PG8_WAIT_V(8); PG8_WAIT_L(0); PG8_BAR; PG8_MMA(1, 0, At, B0); PG8_MMA(1, 1, At, B1); PG8_BAR; PG8_SCHED;
        }
        if constexpr (ALIGN_EPI) { if (wr == 0) PG8_BAR; }
        E(acc, cur, wr, wc, fr, fq); S.done(cur);
        if (!has_next) break;
#pragma unroll
        for (int a = 0; a < 2; ++a)
#pragma unroll
            for (int b = 0; b < 2; ++b)
#pragma unroll
                for (int m = 0; m < 4; ++m)
#pragma unroll
                    for (int n = 0; n < 2; ++n) acc[a][b][m][n] = (f32x4){0.f, 0.f, 0.f, 0.f};
        cur = nxt; cA = nA; cB = nB; ++ui;
        if constexpr (ALIGN_EPI) { if (wr == 1) PG8_BAR; }
    }
    PG8_WAIT_V(0);
    if constexpr (!ALIGN_EPI) { if (wr == 0) PG8_BAR; }
    PG8_BAR;
#undef PG8_SA
#undef PG8_SB
#undef PG8_STAGE
#undef PG8_LDA
#undef PG8_LDB
#undef PG8_MMA
#undef PG8_WAIT_V
#undef PG8_WAIT_L
#undef PG8_BAR
#undef PG8_SCHED
}
}

struct Params {
    const float* in[35];
    float* out;
    unsigned char* ws;
    int ph_lo, ph_hi;
};
enum { I_X = 0, I_C, I_CTX, I_CCTX, I_NMG, I_NFG, I_WMOD, I_BMOD, I_WIN, I_QNG, I_WUQ, I_KVNG, I_WUKV, I_HCW, I_HCB, I_HW1, I_HB1, I_HFREQ, I_HW2, I_HB2, I_HW3, I_HB3,
       I_HSKIP, I_LQ1, I_LK1, I_LQ2, I_LK2, I_SUBG, I_WBRA, I_WBRB, I_WBRC, I_WOUT, I_FC1, I_FC2, I_FNG };

struct Frame {
    LAS unsigned char* lds;
    int tid, lane, wave, vcu, G;
};

__device__ __forceinline__ void tr_item(const float* W, int ldw, hf* WT, int ldt, int nblk, LAS float* scr, int item, int lane) {
    const int kb = item / nblk, nb = item % nblk, k0 = 64 * kb, n0 = 32 * nb;
#pragma unroll 8
    for (int i = 0; i < 32; ++i) { const int kk = 2 * i + (lane >> 5); scr[kk * 33 + (lane & 31)] = W[(size_t)(k0 + kk) * ldw + n0 + (lane & 31)]; }
    LDS_WAIT(); asm volatile("" ::: "memory");
    const int c = lane & 7;
#pragma unroll
    for (int j = 0; j < 4; ++j) { const int n = (lane >> 3) + 8 * j; const LAS float* s = scr + (8 * c) * 33 + n;
        u32x4 o; o.x = pkh(s[0 * 33], s[1 * 33]); o.y = pkh(s[2 * 33], s[3 * 33]); o.z = pkh(s[4 * 33], s[5 * 33]); o.w = pkh(s[6 * 33], s[7 * 33]);
        *(u32x4*)(WT + (size_t)(n0 + n) * ldt + k0 + 8 * c) = o; }
    LDS_WAIT(); asm volatile("" ::: "memory");
}
__device__ __forceinline__ float silu_f(float x) { return x / (1.f + expf(-x)); }

__device__ __forceinline__ void mod_phase(const Frame& F, const Params& p) {
    float* MOD = (float*)(p.ws + WS_MOD);
    LAS float* sv = (LAS float*)F.lds;
    constexpr int NCB = DEPTH * MODW / 512;
    for (int item = F.vcu; item < NCB * 3; item += F.G) {
        const int cb = item / 3, vg = item % 3;
        __syncthreads();
        for (int i = F.tid; i < 11 * 1024; i += 512) { const int v = vg * 11 + i / 1024, k = i % 1024;
            const float c = (v < NB) ? p.in[I_C][v * DM + k] : p.in[I_CCTX][k]; sv[i] = silu_f(c); }
        __syncthreads();
        const int gcol = cb * 512 + F.tid, l = gcol / MODW, n = gcol % MODW;
        const float* w = p.in[I_WMOD] + (size_t)l * DM * MODW + n;
        float acc[11];
#pragma unroll
        for (int v = 0; v < 11; ++v) acc[v] = 0.f;
        for (int k = 0; k < DM; k += 4) {
            const float w0 = w[(size_t)k * MODW], w1 = w[(size_t)(k + 1) * MODW], w2 = w[(size_t)(k + 2) * MODW], w3 = w[(size_t)(k + 3) * MODW];
#pragma unroll
            for (int v = 0; v < 11; ++v) { const f32x4 s = *(const LAS f32x4*)(sv + v * 1024 + k);
                acc[v] = fmaf(s[0], w0, acc[v]); acc[v] = fmaf(s[1], w1, acc[v]); acc[v] = fmaf(s[2], w2, acc[v]); acc[v] = fmaf(s[3], w3, acc[v]); }
        }
        const float bm = p.in[I_BMOD][(size_t)l * MODW + n];
#pragma unroll
        for (int v = 0; v < 11; ++v) MOD[((size_t)l * NMODV + vg * 11 + v) * MODW + n] = acc[v] + bm;
    }
    __syncthreads();
}

__device__ __forceinline__ void filt_item(const Params& p, int l, int kind  , int t, int lane) {
    const int L = kind ? CTXL : SEQ;
    hf* R = kind ? (hf*)(p.ws + WS_RFC) + (size_t)l * 256 * 512 : (hf*)(p.ws + WS_RF) + (size_t)l * 256 * 4096;
    const int rl = 2 * L;
    const float tl = (float)t / (float)(L - 1);
    const float wt = (6.283185307179586f / (float)L) * (float)t;
    float z = 0.f;
    if (lane == 0) z = tl;
    else if (lane <= 32) { const int bi = (lane - 1) & 15; const float band = 1e-4f + (15.f - 1e-4f) * ((float)bi / 15.f); const float a = band * wt; z = (lane <= 16) ? cosf(a) : -sinf(a); }
    const float* w1 = p.in[I_HW1] + (size_t)l * 33 * 64; const float* w2 = p.in[I_HW2] + (size_t)l * 64 * 64; const float* w3 = p.in[I_HW3] + (size_t)l * 64 * 512;
    const float fr = p.in[I_HFREQ][l * 64 + lane];
    float a1 = p.in[I_HB1][l * 64 + lane];
    for (int i = 0; i < 33; ++i) a1 = fmaf(__shfl(z, i), w1[i * 64 + lane], a1);
    a1 = sinf(fr * a1);
    float a2 = p.in[I_HB2][l * 64 + lane];
    for (int i = 0; i < 64; ++i) a2 = fmaf(__shfl(a1, i), w2[i * 64 + lane], a2);
    a2 = sinf(fr * a2);
    float h[8];
#pragma unroll
    for (int q = 0; q < 8; ++q) h[q] = p.in[I_HB3][l * 512 + q * 64 + lane];
    for (int i = 0; i < 64; ++i) { const float a = __shfl(a2, i);
#pragma unroll
        for (int q = 0; q < 8; ++q) h[q] = fmaf(a, w3[i * 512 + q * 64 + lane], h[q]); }
    const float d0 = -4.605170185988091f / 1.5f, d1 = -4.605170185988091f / 0.3f;
#pragma unroll
    for (int q = 0; q < 8; ++q) { const int o = q * 64 + lane, dir = o >> 8, c = o & 255;
        const float delta = fabsf(d0 + (d1 - d0) * ((float)c / 255.f));
        float val = h[q] * (expf(-tl * delta) + 0.05f);
        if (dir == 0) { if (t == 0) val += p.in[I_HSKIP][l * 256 + c]; R[(size_t)c * rl + (L - t)] = (hf)val; if (t == 0) R[(size_t)c * rl] = (hf)0.f; }
        else if (t >= 1) R[(size_t)c * rl + (L + t)] = (hf)val; }
}

__device__ __forceinline__ void prologue_phase(const Frame& F, const Params& p) {
    mod_phase(F, p);
    LAS float* scr = (LAS float*)(F.lds + F.wave * 16384);
    const int gw = F.vcu * 8 + F.wave, NGW = F.G * 8, lane = F.lane;
    constexpr int IT_IN1 = 16 * 61, IT_ING = 16 * 96, IT_UQ = 4 * 24, IT_UKV = 2 * 32, IT_BRA = 8 * 32, IT_BRB = 4 * 32, IT_BRC = 4 * 32, IT_OUT = 16 * 32, IT_FC1 = 16 * 128, IT_FC2 = 64 * 32;
    constexpr int IT_LAYER = IT_IN1 + IT_ING + IT_UQ + IT_UKV + IT_BRA + IT_BRB + IT_BRC + IT_OUT + IT_FC1 + IT_FC2;
    for (int it = gw; it < DEPTH * IT_LAYER; it += NGW) {
        const int l = it / IT_LAYER; int r = it % IT_LAYER;
        unsigned char* wl = p.ws + WS_WT + (size_t)l * W_LAYER;
        if (r < IT_IN1) { tr_item(p.in[I_WIN] + (size_t)l * DM * D_IN, D_IN, (hf*)(wl + W_IN1), DM, 61, scr, r, lane); continue; } r -= IT_IN1;
        if (r < IT_ING) { tr_item(p.in[I_WIN] + (size_t)l * DM * D_IN + C_PG, D_IN, (hf*)(wl + W_ING), DM, 96, scr, r, lane); continue; } r -= IT_ING;
        if (r < IT_UQ) { tr_item(p.in[I_WUQ] + (size_t)l * 256 * 768, 768, (hf*)(wl + W_UP), KUP, 24, scr, r, lane); continue; } r -= IT_UQ;
        if (r < IT_UKV) { tr_item(p.in[I_WUKV] + (size_t)l * 128 * 1024, 1024, (hf*)(wl + W_UP) + (size_t)768 * KUP + 256, KUP, 32, scr, r, lane); continue; } r -= IT_UKV;
        if (r < IT_BRA) { tr_item(p.in[I_WBRA] + (size_t)l * 512 * DM, DM, (hf*)(wl + W_BR), DM, 32, scr, r, lane); continue; } r -= IT_BRA;
        if (r < IT_BRB) { tr_item(p.in[I_WBRB] + (size_t)l * 256 * DM, DM, (hf*)(wl + W_BR) + 512, DM, 32, scr, r, lane); continue; } r -= IT_BRB;
        if (r < IT_BRC) { tr_item(p.in[I_WBRC] + (size_t)l * 256 * DM, DM, (hf*)(wl + W_BR) + 768, DM, 32, scr, r, lane); continue; } r -= IT_BRC;
        if (r < IT_OUT) { tr_item(p.in[I_WOUT] + (size_t)l * DM * DM, DM, (hf*)(wl + W_OUT), DM, 32, scr, r, lane); continue; } r -= IT_OUT;
        if (r < IT_FC1) { tr_item(p.in[I_FC1] + (size_t)l * DM * DFF, DFF, (hf*)(wl + W_FC1), DM, 128, scr, r, lane); continue; } r -= IT_FC1;
        tr_item(p.in[I_FC2] + (size_t)l * DFF * DM, DM, (hf*)(wl + W_FC2), DFF, 32, scr, r, lane);
    }
    {
        const int gt = gw * 64 + lane, NGT = NGW * 64;
        for (int l = 0; l < DEPTH; ++l) {
            unsigned char* wl = p.ws + WS_WT + (size_t)l * W_LAYER;
            u32x4* z1 = (u32x4*)((hf*)(wl + W_IN1) + (size_t)C_PG * DM);
            for (int i = gt; i < 96 * DM / 8; i += NGT) z1[i] = (u32x4){0u, 0u, 0u, 0u};
            hf* up = (hf*)(wl + W_UP);
            for (int i = gt; i < 768 * 16; i += NGT) { const int n = i / 16, k8 = i % 16; *(u32x4*)(up + (size_t)n * KUP + 256 + k8 * 8) = (u32x4){0u, 0u, 0u, 0u}; }
            for (int i = gt; i < 1024 * 32; i += NGT) { const int n = 768 + i / 32, k8 = i % 32; *(u32x4*)(up + (size_t)n * KUP + k8 * 8) = (u32x4){0u, 0u, 0u, 0u}; }
        }
    }
    for (int it = gw; it < DEPTH * (SEQ + CTXL); it += NGW) { const int l = it / (SEQ + CTXL), r = it % (SEQ + CTXL); if (r < SEQ) filt_item(p, l, 0, r, lane); else filt_item(p, l, 1, r - SEQ, lane); }
    {
        float* rope = (float*)(p.ws + WS_ROPE);
        const int gt = gw * 64 + lane, NGT = NGW * 64;
        for (int i = gt; i < SEQ * 16; i += NGT) { const int t = i >> 4, j = i & 15; const float pos = (j < 8) ? (float)(t / GRIDW) : (float)(t % GRIDW);
            const float inv = powf(10000.f, -(float)(j & 7) / 8.f); const float a = pos * inv; rope[t * 32 + j] = cosf(a); rope[t * 32 + 16 + j] = sinf(a); }
        if (gt < DEPTH) { const int l = gt; float s1 = 0.f, s2 = 0.f;
            for (int i = 0; i < 32; ++i) { s1 += p.in[I_LQ1][l * 32 + i] * p.in[I_LK1][l * 32 + i]; s2 += p.in[I_LQ2][l * 32 + i] * p.in[I_LK2][l * 32 + i]; }
            const float li = 0.8f - 0.6f * expf(-0.3f * (float)l);
            float* lam = (float*)(p.ws + WS_LAM); lam[2 * l] = expf(s1) - expf(s2) + li; lam[2 * l + 1] = 1.f - li; }
    }
}

__device__ __forceinline__ void norm_phase(const Frame& F, const float* xs_lat, const float* xs_ctx, int nrows, const float* gain, const float* modl, int sh_off, int sc_off, hf* H) {
    const int gw = F.vcu * 8 + F.wave, NGW = F.G * 8, lane = F.lane;
    f32x4 g[4];
#pragma unroll
    for (int j = 0; j < 4; ++j) g[j] = *(const f32x4*)(gain + 4 * lane + 256 * j);
    for (int row = gw; row < nrows; row += NGW) {
        const bool lat = row < NLAT; const float* xr = lat ? xs_lat + (size_t)row * DM : xs_ctx + (size_t)(row - NLAT) * DM;
        const int v = lat ? (row >> 11) : NB; const float* mv = modl + (size_t)v * MODW;
        f32x4 x[4]; float ss = 0.f;
#pragma unroll
        for (int j = 0; j < 4; ++j) { x[j] = *(const f32x4*)(xr + 4 * lane + 256 * j); ss += (x[j][0] * x[j][0] + x[j][1] * x[j][1]) + (x[j][2] * x[j][2] + x[j][3] * x[j][3]); }
        const float rstd = rsqrtf(wave_sum(ss) * (1.f / DM) + EPS);
        hf* hr = H + (size_t)row * DM;
#pragma unroll
        for (int j = 0; j < 4; ++j) { const f32x4 sh = *(const f32x4*)(mv + sh_off + 4 * lane + 256 * j), sc = *(const f32x4*)(mv + sc_off + 4 * lane + 256 * j);
            const f32x4 y = (x[j] * rstd) * g[j]; const f32x4 o = y * (sc + 1.f) + sh;
            u32x2 w; w.x = pkh(o[0], o[1]); w.y = pkh(o[2], o[3]); *(u32x2*)(hr + 4 * lane + 256 * j) = w; }
    }
}
__device__ __forceinline__ void final_norm_phase(const Frame& F, float* X, const float* gain) {
    const int gw = F.vcu * 8 + F.wave, NGW = F.G * 8, lane = F.lane;
    f32x4 g[4];
#pragma unroll
    for (int j = 0; j < 4; ++j) g[j] = *(const f32x4*)(gain + 4 * lane + 256 * j);
    for (int row = gw; row < NLAT; row += NGW) {
        float* xr = X + (size_t)row * DM; f32x4 x[4]; float ss = 0.f;
#pragma unroll
        for (int j = 0; j < 4; ++j) { x[j] = *(const f32x4*)(xr + 4 * lane + 256 * j); ss += (x[j][0] * x[j][0] + x[j][1] * x[j][1]) + (x[j][2] * x[j][2] + x[j][3] * x[j][3]); }
        const float rstd = rsqrtf(wave_sum(ss) * (1.f / DM) + EPS);
#pragma unroll
        for (int j = 0; j < 4; ++j) *(f32x4*)(xr + 4 * lane + 256 * j) = (x[j] * rstd) * g[j];
    }
}

__device__ __forceinline__ void prep_rows(const Frame& F, const Params& p, int l) {
    const int gw = F.vcu * 8 + F.wave, NGW = F.G * 8, lane = F.lane;
    const hf* P1 = (const hf*)(p.ws + A_P1); hf* QKVN = (hf*)(p.ws + A_QKVN); hf* KR = (hf*)(p.ws + A_KR); hf* DQ = (hf*)(p.ws + A_DQ); hf* DK = (hf*)(p.ws + A_DK); hf* DV = (hf*)(p.ws + A_DV);
    const float* rope = (const float*)(p.ws + WS_ROPE);
    const f32x4 gq = *(const f32x4*)(p.in[I_QNG] + l * 256 + 4 * lane);
    const f32x2 gkv = *(const f32x2*)(p.in[I_KVNG] + l * 128 + 2 * lane);
    for (int row = gw; row < MTOT; row += NGW) {
        const hf* pr = P1 + (size_t)row * NP1; const bool lat = row < NLAT; const int t = row & (SEQ - 1);
        {
            const hf4 a = *(const hf4*)(pr + C_PQ + 4 * lane); f32x4 x = {(float)a[0], (float)a[1], (float)a[2], (float)a[3]};
            const float rstd = rsqrtf(wave_sum((x[0] * x[0] + x[1] * x[1]) + (x[2] * x[2] + x[3] * x[3])) * (1.f / 256.f) + EPS);
            x = (x * rstd) * gq; u32x2 w; w.x = pkh(x[0], x[1]); w.y = pkh(x[2], x[3]); *(u32x2*)(QKVN + (size_t)row * KUP + 4 * lane) = w; }
        {
            const hf2 a = *(const hf2*)(pr + C_PKV + 2 * lane); f32x2 x = {(float)a[0], (float)a[1]};
            const float rstd = rsqrtf(wave_sum(x[0] * x[0] + x[1] * x[1]) * (1.f / 128.f) + EPS);
            x = (x * rstd) * gkv; *(unsigned*)(QKVN + (size_t)row * KUP + 256 + 2 * lane) = pkh(x[0], x[1]); }
        {
            *(u32x2*)(DQ + (size_t)row * 256 + 4 * lane) = *(const u32x2*)(pr + C_DQ + 4 * lane);
            *(u32x2*)(DV + (size_t)row * 256 + 4 * lane) = *(const u32x2*)(pr + C_DV + 4 * lane); }
        {
            const int hh = lane >> 3, i0 = 2 * (lane & 7);
            const hf2 a = *(const hf2*)(pr + C_DK + hh * 32 + i0), b = *(const hf2*)(pr + C_DK + hh * 32 + 16 + i0);
            float x1[2] = {(float)a[0], (float)a[1]}, x2[2] = {(float)b[0], (float)b[1]}, o1[2], o2[2];
#pragma unroll
            for (int e = 0; e < 2; ++e) { const float c = lat ? rope[t * 32 + i0 + e] : 1.f, s = lat ? rope[t * 32 + 16 + i0 + e] : 0.f; o1[e] = x1[e] * c - x2[e] * s; o2[e] = x2[e] * c + x1[e] * s; }
            *(unsigned*)(DK + (size_t)row * 256 + hh * 32 + i0) = pkh(o1[0], o1[1]); *(unsigned*)(DK + (size_t)row * 256 + hh * 32 + 16 + i0) = pkh(o2[0], o2[1]); }
        if (lane < 16) {
            const float x1 = (float)pr[C_PKR + lane], x2 = (float)pr[C_PKR + 16 + lane];
            const float c = lat ? rope[t * 32 + lane] : 1.f, s = lat ? rope[t * 32 + 16 + lane] : 0.f;
            KR[(size_t)row * 32 + lane] = (hf)(x1 * c - x2 * s); KR[(size_t)row * 32 + 16 + lane] = (hf)(x2 * c + x1 * s); }
    }
}
__device__ __forceinline__ void prep_hyena(const Frame& F, const Params& p, int l) {
    const int gw = F.vcu * 8 + F.wave, NGW = F.G * 8, lane = F.lane;
    const hf* P1 = (const hf*)(p.ws + A_P1);
    LAS hf* tile = (LAS hf*)(F.lds + F.wave * 9216);
    const float* cw = p.in[I_HCW] + (size_t)l * 3 * 768; const float* cb = p.in[I_HCB] + (size_t)l * 768;
    constexpr int IT_LAT = 2 * NB * (SEQ / 64) * 4, IT_CTX = 2 * NB * (CTXL / 64) * 4;
    for (int it = gw; it < IT_LAT + IT_CTX; it += NGW) {
        const bool ctx = it >= IT_LAT; int r = ctx ? it - IT_LAT : it; const int L = ctx ? CTXL : SEQ, ntile = L / 64;
        const int cg = r & 3; r >>= 2; const int tt = r % ntile; r /= ntile; const int b = r % NB; const int which = r / NB;
        const int c = cg * 64 + lane, t0 = tt * 64; const size_t rowbase = ctx ? (size_t)NLAT + (size_t)b * CTXL : (size_t)b * SEQ;
        hf* dst = ctx ? (hf*)(p.ws + (which ? A_X0TC : A_UTC)) : (hf*)(p.ws + (which ? A_X0T : A_UT));
        if (which == 1) {
            const int col = C_HY + c; const float w0 = cw[c], w1 = cw[768 + c], w2 = cw[1536 + c], bb = cb[c];
            float prev = (t0 > 0) ? (float)P1[(rowbase + t0 - 1) * NP1 + col] : 0.f, cur = (float)P1[(rowbase + t0) * NP1 + col];
#pragma unroll 8
            for (int t = 0; t < 64; ++t) { const int tn = t0 + t + 1; const float nxt = (tn < L) ? (float)P1[(rowbase + tn) * NP1 + col] : 0.f;
                tile[lane * 72 + t] = (hf)(w0 * prev + w1 * cur + w2 * nxt + bb); prev = cur; cur = nxt; }
        } else {
            const int c1 = C_HY + 256 + c, c2 = C_HY + 512 + c;
            const float a0 = cw[256 + c], a1 = cw[768 + 256 + c], a2 = cw[1536 + 256 + c], ab = cb[256 + c];
            const float v0 = cw[512 + c], v1 = cw[768 + 512 + c], v2 = cw[1536 + 512 + c], vb = cb[512 + c];
            float pa = (t0 > 0) ? (float)P1[(rowbase + t0 - 1) * NP1 + c1] : 0.f, ca = (float)P1[(rowbase + t0) * NP1 + c1];
            float pv = (t0 > 0) ? (float)P1[(rowbase + t0 - 1) * NP1 + c2] : 0.f, cv = (float)P1[(rowbase + t0) * NP1 + c2];
#pragma unroll 8
            for (int t = 0; t < 64; ++t) { const int tn = t0 + t + 1; const bool in = tn < L;
                const float na = in ? (float)P1[(rowbase + tn) * NP1 + c1] : 0.f, nv = in ? (float)P1[(rowbase + tn) * NP1 + c2] : 0.f;
                const float x1 = a0 * pa + a1 * ca + a2 * na + ab, vv = v0 * pv + v1 * cv + v2 * nv + vb;
                tile[lane * 72 + t] = (hf)(vv * x1); pa = ca; ca = na; pv = cv; cv = nv; }
        }
        LDS_WAIT(); asm volatile("" ::: "memory");
#pragma unroll
        for (int q = 0; q < 8; ++q) { const int ch = q * 8 + (lane >> 3), pc = lane & 7;
            const u32x4 v = *(const LAS u32x4*)(tile + ch * 72 + pc * 8);
            *(u32x4*)(dst + ((size_t)(cg * 64 + ch) * NB + b) * L + t0 + pc * 8) = v; }
        LDS_WAIT(); asm volatile("" ::: "memory");
    }
}

namespace att {
__device__ __forceinline__ int crow(int r, int hi) { return (r & 3) + 8 * (r >> 2) + 4 * hi; }
#define SBAR() __builtin_amdgcn_sched_barrier(0)
constexpr float THR = 8.f;
__device__ __forceinline__ void sm_part(f32x16& p0, f32x16& p1, float& m_reg, float& alpha, const float C, const float THRS) {
    float pmax = p0[0];
#pragma unroll
    for (int r = 1; r < 16; ++r) pmax = fmaxf(pmax, p0[r]);
#pragma unroll
    for (int r = 0; r < 16; ++r) pmax = fmaxf(pmax, p1[r]);
    { auto rr = __builtin_amdgcn_permlane32_swap(__float_as_uint(pmax), __float_as_uint(pmax), false, false);
      pmax = fmaxf(__uint_as_float(rr[0]), __uint_as_float(rr[1])); }
    float mn;
    if (__all(pmax - m_reg <= THRS)) { mn = m_reg; alpha = 1.f; }
    else { mn = fmaxf(m_reg, pmax); alpha = __builtin_amdgcn_exp2f((m_reg - mn) * C); m_reg = mn; }
    const float mnC = -mn * C;
#pragma unroll
    for (int r = 0; r < 16; ++r) p0[r] = __builtin_amdgcn_exp2f(fmaf(p0[r], C, mnC));
#pragma unroll
    for (int r = 0; r < 16; ++r) p1[r] = __builtin_amdgcn_exp2f(fmaf(p1[r], C, mnC));
}
__device__ __forceinline__ void sm_fin(const f32x16& p0, const f32x16& p1, float alpha, float& l_reg, hf8& pa0, hf8& pa1, hf8& pa2, hf8& pa3) {
    float ps = 0.f;
#pragma unroll
    for (int r = 0; r < 16; ++r) ps += p0[r];
#pragma unroll
    for (int r = 0; r < 16; ++r) ps += p1[r];
    { auto rr = __builtin_amdgcn_permlane32_swap(__float_as_uint(ps), __float_as_uint(ps), false, false);
      ps = __uint_as_float(rr[0]) + __uint_as_float(rr[1]); }
    l_reg = l_reg * alpha + ps;
#define PK4(P, BASE, OUT) do { unsigned a0 = pkh(P[BASE + 0], P[BASE + 1]), a1 = pkh(P[BASE + 2], P[BASE + 3]);   \
    unsigned b0 = pkh(P[BASE + 4], P[BASE + 5]), b1 = pkh(P[BASE + 6], P[BASE + 7]);                              \
    auto r0 = __builtin_amdgcn_permlane32_swap(a0, b0, false, false); auto r1 = __builtin_amdgcn_permlane32_swap(a1, b1, false, false); \
    u32x4 w = {r0[0], r1[0], r0[1], r1[1]}; OUT = __builtin_bit_cast(hf8, w); } while (0)
    PK4(p0, 0, pa0); PK4(p0, 8, pa1); PK4(p1, 0, pa2); PK4(p1, 8, pa3);
#undef PK4
}
template <int ND0, int KS>
__device__ __forceinline__ void qkt(f32x16& p0, f32x16& p1, const LAS unsigned char* Ks, const hf8* qr, int r32, int hi) {
    p0 = f32x16{}; p1 = f32x16{};
#pragma unroll
    for (int d0 = 0; d0 < ND0; ++d0) { const int cb = (d0 * 16 + hi * 8) * 2;
        const hf8 b0 = *(const LAS hf8*)(Ks + r32 * KS + cb);
        const hf8 b1 = *(const LAS hf8*)(Ks + (32 + r32) * KS + cb);
        p0 = __builtin_amdgcn_mfma_f32_32x32x16_f16(b0, qr[d0], p0, 0, 0, 0);
        p1 = __builtin_amdgcn_mfma_f32_32x32x16_f16(b1, qr[d0], p1, 0, 0, 0); }
}
__device__ __forceinline__ int v_st(int k, int c) { const int kk = (k & ~0xC) | ((k & 4) << 1) | ((k & 8) >> 1); return ((kk >> 3) * 2 + (c >> 5)) * 512 + ((kk & 7) * 32 + (c & 31)) * 2; }
__device__ __forceinline__ int v_rd_base(int lane) { return ((lane & 3) << 3) | (((lane >> 2) & 3) << 6) | (((lane >> 4) & 1) << 5) | (((lane >> 5) & 1) << 8); }
constexpr int v_rd_off(int d0, int ks, int half) { return d0 * 512 + ks * 2048 + half * 1024; }
template <int OFF> __device__ __forceinline__ s16x4 tr_read(int vb) {
    s16x4 r; asm volatile("ds_read_b64_tr_b16 %0, %1 offset:%2" : "=&v"(r) : "v"(vb), "i"(OFF) : "memory"); return r;
}
template <int D0> __device__ __forceinline__ void pv_one(f32x16& od, int vb, hf8 pa0, hf8 pa1, hf8 pa2, hf8 pa3) {
    const s16x4 l0 = tr_read<v_rd_off(D0, 0, 0)>(vb), h0 = tr_read<v_rd_off(D0, 0, 1)>(vb), l1 = tr_read<v_rd_off(D0, 1, 0)>(vb), h1 = tr_read<v_rd_off(D0, 1, 1)>(vb);
    const s16x4 l2 = tr_read<v_rd_off(D0, 2, 0)>(vb), h2 = tr_read<v_rd_off(D0, 2, 1)>(vb), l3 = tr_read<v_rd_off(D0, 3, 0)>(vb), h3 = tr_read<v_rd_off(D0, 3, 1)>(vb);
    asm volatile("s_waitcnt lgkmcnt(0)" ::: "memory"); SBAR();
#define PKV(L, H) __builtin_bit_cast(hf8, (short __attribute__((ext_vector_type(8)))){L[0], L[1], L[2], L[3], H[0], H[1], H[2], H[3]})
    od = __builtin_amdgcn_mfma_f32_32x32x16_f16(pa0, PKV(l0, h0), od, 0, 0, 0);
    od = __builtin_amdgcn_mfma_f32_32x32x16_f16(pa1, PKV(l1, h1), od, 0, 0, 0);
    od = __builtin_amdgcn_mfma_f32_32x32x16_f16(pa2, PKV(l2, h2), od, 0, 0, 0);
    od = __builtin_amdgcn_mfma_f32_32x32x16_f16(pa3, PKV(l3, h3), od, 0, 0, 0);
#undef PKV
}

constexpr int KS_MLA = 208, KS_DF = 80;
constexpr int KB_MLA = 64 * KS_MLA, KB_DF = 64 * KS_DF;
constexpr int VB = 8192;
constexpr int OFF_V = 32768, OFF_WS = OFF_V + 2 * VB;

template <bool MLA>
__device__ __forceinline__ void attn_unit(const Frame& F, const Params& p, int l, int h, int qrow0, int qpos0, int klat0, int nlat, int kctx0) {
    constexpr int NSUB = MLA ? 1 : 2, DK = MLA ? 96 : 32, ND0 = DK / 16, KS = MLA ? KS_MLA : KS_DF, KB = MLA ? KB_MLA : KB_DF;
    constexpr float SCALE = MLA ? MLA_SCALE : DF_SCALE, C = SCALE * 1.4426950408889634f, THRS = THR / SCALE;
    const int tid = F.tid, wid = F.wave, lane = F.lane, r32 = lane & 31, hi = lane >> 5;
    const hf* QKV = (const hf*)(p.ws + A_QKV); const hf* KRb = (const hf*)(p.ws + A_KR);
    const hf* DQ = (const hf*)(p.ws + A_DQ); const hf* DKb = (const hf*)(p.ws + A_DK); const hf* DVb = (const hf*)(p.ws + A_DV);
    const float* rope = (const float*)(p.ws + WS_ROPE);
    hf* Y = (hf*)(p.ws + A_Y);
    LAS unsigned char* lds = F.lds;
    LAS float* wsf = (LAS float*)(lds + OFF_WS) + wid * 64; LAS float* al_l = wsf; LAS float* li_l = wsf + 32;
    hf8 qr[NSUB][ND0];
    {
        const int qrow = qrow0 + wid * 32 + r32;
#pragma unroll
        for (int s = 0; s < NSUB; ++s) {
            const hf* qp = MLA ? QKV + (size_t)qrow * NUP + h * 96 + hi * 8 : DQ + (size_t)qrow * 256 + (2 * h + s) * 32 + hi * 8;
#pragma unroll
            for (int d0 = 0; d0 < ND0; ++d0) qr[s][d0] = *(const hf8*)(qp + d0 * 16);
            if (qpos0 >= 0) {
                const int t = qpos0 + wid * 32 + r32;
                const f32x4 c0 = *(const f32x4*)(rope + t * 32 + hi * 8), c1 = *(const f32x4*)(rope + t * 32 + hi * 8 + 4);
                const f32x4 s0 = *(const f32x4*)(rope + t * 32 + 16 + hi * 8), s1 = *(const f32x4*)(rope + t * 32 + 16 + hi * 8 + 4);
                hf8& x1 = qr[s][ND0 - 2]; hf8& x2 = qr[s][ND0 - 1]; hf8 y1, y2;
#pragma unroll
                for (int j = 0; j < 8; ++j) { const float cc = j < 4 ? c0[j & 3] : c1[j & 3], sn = j < 4 ? s0[j & 3] : s1[j & 3]; const float a = (float)x1[j], b = (float)x2[j];
                    y1[j] = (hf)(a * cc - b * sn); y2[j] = (hf)(b * cc + a * sn); }
                x1 = y1; x2 = y2;
            }
        }
    }
    const int vr = tid >> 3, vc = (tid & 7) * 8, vst = v_st(vr, vc);
    const int k1r = MLA ? (tid >> 3) : ((tid >> 2) & 63), k1c = MLA ? (tid & 7) * 8 : (tid & 3) * 8, k1s = MLA ? 0 : (tid >> 8);
    const int k2r = tid >> 2, k2c = (tid & 3) * 8;
    u32x4 sv, sk1, sk2;
    const int ntile = nlat + 4;
#define A_SLOAD(j) do { const int kr0 = ((j) < nlat) ? klat0 + (j) * 64 : kctx0 + ((j) - nlat) * 64; \
        if (MLA) { sv = *(const u32x4*)(QKV + (size_t)(kr0 + vr) * NUP + 768 + h * 128 + 64 + vc); sk1 = *(const u32x4*)(QKV + (size_t)(kr0 + k1r) * NUP + 768 + h * 128 + k1c); \
                   if (tid < 256) sk2 = *(const u32x4*)(KRb + (size_t)(kr0 + k2r) * 32 + k2c); } \
        else { sv = *(const u32x4*)(DVb + (size_t)(kr0 + vr) * 256 + h * 64 + vc); sk1 = *(const u32x4*)(DKb + (size_t)(kr0 + k1r) * 256 + (2 * h + k1s) * 32 + k1c); } } while (0)
#define A_SWRITE(b) do { *(LAS u32x4*)(lds + OFF_V + (b) * VB + vst) = sv; \
        if (MLA) { *(LAS u32x4*)(lds + (b) * KB + k1r * KS + k1c * 2) = sk1; if (tid < 256) *(LAS u32x4*)(lds + (b) * KB + k2r * KS + 128 + k2c * 2) = sk2; } \
        else { *(LAS u32x4*)(lds + ((b) * 2 + k1s) * KB + k1r * KS + k1c * 2) = sk1; } } while (0)
    float m_reg[NSUB], l_reg[NSUB]; f32x16 o[NSUB][2];
#pragma unroll
    for (int s = 0; s < NSUB; ++s) { m_reg[s] = -1e30f; l_reg[s] = 0.f; o[s][0] = f32x16{}; o[s][1] = f32x16{}; }
    const int vb0 = (int)(unsigned)(uintptr_t)(lds + OFF_V) + v_rd_base(lane);
    __syncthreads();
    A_SLOAD(0); VM_WAIT(); A_SWRITE(0); __syncthreads();
    for (int j = 0; j < ntile; ++j) {
        const int cur = j & 1;
        if (j + 1 < ntile) A_SLOAD(j + 1);
#pragma unroll
        for (int s = 0; s < NSUB; ++s) {
            f32x16 p0, p1; float alpha; hf8 pa0, pa1, pa2, pa3;
            qkt<ND0, KS>(p0, p1, lds + (MLA ? cur : cur * 2 + s) * KB, qr[s], r32, hi);
            sm_part(p0, p1, m_reg[s], alpha, C, THRS);
            if (__any(alpha < 1.f)) { if (hi == 0) al_l[r32] = alpha; LDS_WAIT();
#pragma unroll
                for (int d = 0; d < 2; ++d)
#pragma unroll
                    for (int r = 0; r < 16; ++r) o[s][d][r] *= al_l[crow(r, hi)];
                LDS_WAIT(); }
            sm_fin(p0, p1, alpha, l_reg[s], pa0, pa1, pa2, pa3); SBAR();
            pv_one<0>(o[s][0], vb0 + cur * VB, pa0, pa1, pa2, pa3); pv_one<1>(o[s][1], vb0 + cur * VB, pa0, pa1, pa2, pa3);
        }
        if (j + 1 < ntile) { VM_WAIT(); A_SWRITE(cur ^ 1); }
        __syncthreads();
    }
#undef A_SLOAD
#undef A_SWRITE
    float rli[NSUB][16];
#pragma unroll
    for (int s = 0; s < NSUB; ++s) { if (hi == 0) li_l[r32] = l_reg[s]; LDS_WAIT();
#pragma unroll
        for (int r = 0; r < 16; ++r) rli[s][r] = __builtin_amdgcn_rcpf(li_l[crow(r, hi)]);
        LDS_WAIT(); }
    if constexpr (MLA) {
#pragma unroll
        for (int r = 0; r < 16; ++r) { hf* yr = Y + (size_t)(qrow0 + wid * 32 + crow(r, hi)) * DM + h * 64 + r32;
            yr[0] = (hf)(o[0][0][r] * rli[0][r]); yr[32] = (hf)(o[0][1][r] * rli[0][r]); }
    } else {
        const float lam = ((const float*)(p.ws + WS_LAM))[2 * l], oml = ((const float*)(p.ws + WS_LAM))[2 * l + 1];
        const float g0 = p.in[I_SUBG][l * 64 + r32], g1 = p.in[I_SUBG][l * 64 + 32 + r32];
#pragma unroll
        for (int r = 0; r < 16; ++r) {
            const float a = o[0][0][r] * rli[0][r] - lam * (o[1][0][r] * rli[1][r]), b = o[0][1][r] * rli[0][r] - lam * (o[1][1][r] * rli[1][r]);
            float ss = a * a + b * b;
#pragma unroll
            for (int of = 1; of < 32; of <<= 1) ss += __shfl_xor(ss, of);
            const float rs = rsqrtf(ss * (1.f / 64.f) + EPS) * oml;
            hf* yr = Y + (size_t)(qrow0 + wid * 32 + crow(r, hi)) * DM + 768 + h * 64 + r32;
            yr[0] = (hf)(a * rs * g0); yr[32] = (hf)(b * rs * g1); }
    }
}
}

template <int L>
__device__ __forceinline__ void hyena_unit(const Frame& F, const hf* Rrow  , const hf* U  , const hf* X0  , hf* Ycol  ) {
    constexpr int NM = L / 256, RL = 2 * L, SH = (L > 1024) ? 1024 : L, NH = L / SH, US = SH * 2 + 16;
    constexpr int OFF_U = 8 * RL * 2;
    static_assert(OFF_U + 32 * US <= LDS_MISC, "hyena LDS");
    const int tid = F.tid, w = F.wave, lane = F.lane, i32 = lane & 31, hi = lane >> 5;
    LAS unsigned char* lds = F.lds;
    __syncthreads();
    for (int idx = tid; idx < 8 * RL; idx += 512) { const int cw = idx / RL, x = idx % RL; ((LAS hf*)lds)[idx] = (x >= cw) ? Rrow[x - cw] : (hf)0.f; }
    f32x16 acc[NM];
#pragma unroll
    for (int m = 0; m < NM; ++m) acc[m] = f32x16{};
    const LAS unsigned char* cpy = lds + w * (RL * 2);
    for (int half = 0; half < NH; ++half) {
        __syncthreads();
        for (int idx = tid; idx < 32 * (SH / 8); idx += 512) { const int b = idx / (SH / 8), pc = idx % (SH / 8);
            *(LAS u32x4*)(lds + OFF_U + b * US + pc * 16) = *(const u32x4*)(U + (size_t)b * L + half * SH + pc * 8); }
        __syncthreads();
#pragma unroll 2
        for (int jl = 0; jl < SH / 16; ++jl) {
            const int j = half * (SH / 16) + jl;
            const hf8 bf = *(const LAS hf8*)(lds + OFF_U + i32 * US + (jl * 16 + hi * 8) * 2);
            const int x0 = L + 16 * j + 8 * hi - 8 * i32;
#pragma unroll
            for (int m = 0; m < NM; ++m) { const hf8 af = *(const LAS hf8*)(cpy + (x0 - 256 * m) * 2);
                acc[m] = __builtin_amdgcn_mfma_f32_32x32x16_f16(af, bf, acc[m], 0, 0, 0); }
        }
    }
    const hf* x0p = X0 + (size_t)i32 * L + w + 32 * hi;
    hf* yp = Ycol + ((size_t)i32 * L + w + 32 * hi) * DM;
#pragma unroll
    for (int m = 0; m < NM; ++m) {
#pragma unroll
        for (int r = 0; r < 16; ++r) { const int tt = 256 * m + 8 * ((r & 3) + 8 * (r >> 2));
            const float x0v = (float)x0p[tt];
            yp[(size_t)tt * DM] = (hf)(x0v * acc[m][r]); }
        asm volatile("" ::: "memory");
    }
}

#ifndef PH_MASK
#define PH_MASK 0x1FFFF
#endif
#define PHM(k) ((PH_MASK >> (k)) & 1)
constexpr int NPH_LAYER = 11, NPHASE = 1 + DEPTH * NPH_LAYER + 1;
__global__ void __launch_bounds__(512, 2) fwd_kernel(Params p) {
    extern __shared__ __attribute__((aligned(16))) unsigned char lds_raw[];
    Frame F0; Frame& F = F0;
    F.lds = (LAS unsigned char*)lds_raw;
    F.tid = threadIdx.x; F.lane = F.tid & 63; F.wave = __builtin_amdgcn_readfirstlane(F.tid >> 6);
    F.G = gridDim.x; { const int bx = blockIdx.x; F.vcu = (F.G % 8 == 0) ? (bx % 8) * (F.G / 8) + bx / 8 : bx; }
    volatile LAS unsigned* misc = (volatile LAS unsigned*)(F.lds + LDS_MISC);
    if (F.tid < 16) misc[F.tid] = 0u;
    __syncthreads();
    const int lo = p.ph_lo, hi = p.ph_hi;
    XcdBarrier bar; bar.bar = (unsigned*)(p.ws + WS_BAR); bar.x = 0; bar.st = misc;
    if (hi - lo > 1) bar = xcd_barrier_post((unsigned*)(p.ws + WS_BAR), misc);
#define IN(k) (lo <= (k) && (k) < hi)
#define LAUNDER(Fl) Frame Fl = F0; asm volatile("" : "+v"(Fl.tid), "+v"(Fl.lane))
#define SEAM(k) do { if (IN(k) && IN((k) + 1)) xcd_barrier(bar); } while (0)
    unsigned char* ws = p.ws;
    float* X = p.out; float* XC = (float*)(ws + WS_XC);
    hf* H = (hf*)(ws + A_H); hf* Y = (hf*)(ws + A_Y); hf* P1 = (hf*)(ws + A_P1); hf* QKV = (hf*)(ws + A_QKV); hf* QKVN = (hf*)(ws + A_QKVN);
    hf* Gt = (hf*)(ws + A_G); hf* HID = (hf*)(ws + A_HID); hf* MM = H;

    if (PHM(11) && IN(0)) { LAUNDER(Fl); prologue_phase(Fl, p); }
    SEAM(0);

    for (int l = 0; l < DEPTH; ++l) {
        const int pb = 1 + l * NPH_LAYER;
        const bool ctx_live = l < DEPTH - 1;
        const int Mrows = ctx_live ? MTOT : NLAT;
        const float* xin_lat = (l == 0) ? p.in[I_X] : X; const float* xin_ctx = (l == 0) ? p.in[I_CTX] : XC;
        const float* modl = (const float*)(ws + WS_MOD) + (size_t)l * NMODV * MODW;
        const unsigned char* wl = ws + WS_WT + (size_t)l * W_LAYER;

        if (PHM(0) && IN(pb + 0)) { LAUNDER(Fl); norm_phase(Fl, xin_lat, xin_ctx, MTOT, p.in[I_NMG] + l * DM, modl, 0, DM, H); }
        SEAM(pb + 0);
        if (PHM(1) && IN(pb + 1)) { pg8::Gemm g{H, (const hf*)(wl + W_IN1), MTOT, NP1, DM, DM, DM}; pg8::StaticOrder S; S.init(MTOT, NP1, F.G, (int)blockIdx.x);
            pg8::EpiHalf<0> E{P1, NP1}; pg8::gemm_phase(F.lds, g, S, E); }
        SEAM(pb + 1);
        if (PHM(2) && IN(pb + 2)) { LAUNDER(Fl); prep_rows(Fl, p, l); prep_hyena(Fl, p, l); }
        SEAM(pb + 2);
        if (PHM(3) && IN(pb + 3)) { pg8::Gemm g{QKVN, (const hf*)(wl + W_UP), MTOT, NUP, KUP, KUP, KUP}; pg8::StaticOrder S; S.init(MTOT, NUP, F.G, (int)blockIdx.x);
            pg8::EpiHalf<0> E{QKV, NUP}; pg8::gemm_phase(F.lds, g, S, E); }
        SEAM(pb + 3);
        if (PHM(4) && IN(pb + 4)) {
            LAUNDER(Fl);
            const int n_mla = 2048 + (ctx_live ? 256 : 0);
            if (PHM(13)) for (int id = F.vcu; id < n_mla; id += F.G) {
                if (id < 2048) { const int qb = id & 7, h = (id >> 3) & 7, b = id >> 6; att::attn_unit<true>(Fl, p, l, h, b * SEQ + qb * 256, qb * 256, b * SEQ, 32, NLAT + b * CTXL); }
                else { const int i2 = id - 2048, h = i2 & 7, b = i2 >> 3; att::attn_unit<true>(Fl, p, l, h, NLAT + b * CTXL, -1, 0, 0, NLAT + b * CTXL); }
            }
            const int n_df = 1024 + (ctx_live ? 128 : 0);
            if (PHM(14)) for (int id = F.vcu; id < n_df; id += F.G) {
                if (id < 1024) { const int qb = id & 7, h = (id >> 3) & 3, b = id >> 5; att::attn_unit<false>(Fl, p, l, h, b * SEQ + qb * 256, qb * 256, b * SEQ, 32, NLAT + b * CTXL); }
                else { const int i2 = id - 1024, h = i2 & 3, b = i2 >> 2; att::attn_unit<false>(Fl, p, l, h, NLAT + b * CTXL, -1, 0, 0, NLAT + b * CTXL); }
            }
            if (PHM(15)) for (int c = F.vcu; c < 256; c += F.G)
                hyena_unit<SEQ>(Fl, (const hf*)(ws + WS_RF) + ((size_t)l * 256 + c) * 4096, (const hf*)(ws + A_UT) + (size_t)c * NLAT, (const hf*)(ws + A_X0T) + (size_t)c * NLAT, Y + 512 + c);
            if (PHM(16) && ctx_live) for (int c = F.vcu; c < 256; c += F.G)
                hyena_unit<CTXL>(Fl, (const hf*)(ws + WS_RFC) + ((size_t)l * 256 + c) * 512, (const hf*)(ws + A_UTC) + (size_t)c * NCTX, (const hf*)(ws + A_X0TC) + (size_t)c * NCTX, Y + (size_t)NLAT * DM + 512 + c);
            __syncthreads();
        }
        SEAM(pb + 4);
        if (PHM(5) && IN(pb + 5)) { pg8::Gemm g{H, (const hf*)(wl + W_ING), Mrows, NGATE, DM, DM, DM}; pg8::StaticOrder S; S.init(Mrows, NGATE, F.G, (int)blockIdx.x);
            pg8::EpiHalf<1> E{Gt, NGATE}; pg8::gemm_phase(F.lds, g, S, E); }
        SEAM(pb + 5);
        if (PHM(6) && IN(pb + 6)) { pg8::StaticOrder S; S.init(Mrows, DM, F.G, (int)blockIdx.x); const hf* wbr = (const hf*)(wl + W_BR);
            { pg8::Gemm g{Y, wbr, Mrows, DM, 512, DM, DM}; pg8::EpiGated<true> E{MM, Gt, 0}; pg8::gemm_phase(F.lds, g, S, E); }
            { pg8::Gemm g{Y + 512, wbr + 512, Mrows, DM, 256, DM, DM}; pg8::EpiGated<false> E{MM, Gt, 1024}; pg8::gemm_phase(F.lds, g, S, E); }
            { pg8::Gemm g{Y + 768, wbr + 768, Mrows, DM, 256, DM, DM}; pg8::EpiGated<false> E{MM, Gt, 2048}; pg8::gemm_phase(F.lds, g, S, E); } }
        SEAM(pb + 6);
        if (PHM(7) && IN(pb + 7)) { pg8::Gemm g{MM, (const hf*)(wl + W_OUT), Mrows, DM, DM, DM, DM}; pg8::StaticOrder S; S.init(Mrows, DM, F.G, (int)blockIdx.x);
            pg8::EpiResid E{xin_lat, xin_ctx, X, XC, modl + 2 * DM}; pg8::gemm_phase(F.lds, g, S, E); }
        SEAM(pb + 7);
        if (PHM(8) && IN(pb + 8)) { LAUNDER(Fl); norm_phase(Fl, X, XC, Mrows, p.in[I_NFG] + l * DM, modl, 3 * DM, 4 * DM, H); }
        SEAM(pb + 8);
        if (PHM(9) && IN(pb + 9)) { pg8::Gemm g{H, (const hf*)(wl + W_FC1), Mrows, DFF, DM, DM, DM}; pg8::StaticOrder S; S.init(Mrows, DFF, F.G, (int)blockIdx.x);
            pg8::EpiHalf<2> E{HID, DFF}; pg8::gemm_phase(F.lds, g, S, E); }
        SEAM(pb + 9);
        if (PHM(10) && IN(pb + 10)) { pg8::Gemm g{HID, (const hf*)(wl + W_FC2), Mrows, DM, DFF, DFF, DFF}; pg8::StaticOrder S; S.init(Mrows, DM, F.G, (int)blockIdx.x);
            pg8::EpiResid E{X, XC, X, XC, modl + 5 * DM}; pg8::gemm_phase(F.lds, g, S, E); }
        SEAM(pb + 10);
    }
    if (PHM(12) && IN(NPHASE - 1)) { LAUNDER(Fl); final_norm_phase(Fl, X, p.in[I_FNG]); }
#undef IN
#undef SEAM
}

extern "C" void kernel_launch(void* const* d_in, const int* in_sizes, int n_in, void* d_out, int out_size, void* d_ws, size_t ws_size, hipStream_t stream) {
    static int grid = 0;
    if (grid == 0) {
        if (n_in != 35 || in_sizes[0] != NLAT * DM || out_size != NLAT * DM || ws_size < WS_END) {
            fprintf(stderr, "kernel_launch: unexpected shapes: n_in %d in0 %d out %d ws %zu (need %zu); nothing launched\n", n_in, n_in > 0 ? in_sizes[0] : -1, out_size, ws_size, (size_t)WS_END); grid = -1; return; }
        int dev = 0, cus = 0, per_cu = 0;
        if (hipGetDevice(&dev) != hipSuccess || hipDeviceGetAttribute(&cus, hipDeviceAttributeMultiprocessorCount, dev) != hipSuccess) { fprintf(stderr, "kernel_launch: device query failed\n"); grid = -1; return; }
        if (hipFuncSetAttribute((const void*)fwd_kernel, hipFuncAttributeMaxDynamicSharedMemorySize, LDS_BYTES) != hipSuccess) { fprintf(stderr, "kernel_launch: hipFuncSetAttribute failed\n"); grid = -1; return; }
        if (hipOccupancyMaxActiveBlocksPerMultiprocessor(&per_cu, (const void*)fwd_kernel, 512, LDS_BYTES) != hipSuccess || per_cu < 1)
            fprintf(stderr, "kernel_launch: note: occupancy query reports %d workgroups per CU\n", per_cu);
        (void)hipGetLastError();
        grid = cus;
    }
    if (grid < 0) return;
    if (hipMemsetAsync((char*)d_ws + WS_BAR, 0, WS_BAR_BYTES, stream) != hipSuccess) { fprintf(stderr, "kernel_launch: memset failed\n"); return; }
    Params P{};
    for (int i = 0; i < 35; ++i) P.in[i] = (const float*)d_in[i];
    P.out = (float*)d_out; P.ws = (unsigned char*)d_ws;
#if MK_FUSED
    P.ph_lo = 0; P.ph_hi = NPHASE;
    hipLaunchKernelGGL(fwd_kernel, dim3(grid), dim3(512), LDS_BYTES, stream, P);
#else
    for (int ph = 0; ph < NPHASE; ++ph) { P.ph_lo = ph; P.ph_hi = ph + 1; hipLaunchKernelGGL(fwd_kernel, dim3(grid), dim3(512), LDS_BYTES, stream, P); }
#endif
    const hipError_t le = hipPeekAtLastError();
    if (le != hipSuccess) fprintf(stderr, "kernel_launch: launch failed: %s\n", hipGetErrorName(le));
}
```

```cpp
#include <hip/hip_runtime.h>
#include <cstdio>
#include <cstdint>

#ifndef MK_FUSED
#define MK_FUSED 1
#endif

#define LAS __attribute__((address_space(3)))
#define GAS __attribute__((address_space(1)))
typedef _Float16 hf;
typedef _Float16 hf2 __attribute__((ext_vector_type(2)));
typedef _Float16 hf4 __attribute__((ext_vector_type(4)));
typedef _Float16 hf8 __attribute__((ext_vector_type(8)));
typedef short s16x4 __attribute__((ext_vector_type(4)));
typedef float f32x2 __attribute__((ext_vector_type(2)));
typedef float f32x4 __attribute__((ext_vector_type(4)));
typedef float f32x16 __attribute__((ext_vector_type(16)));
typedef unsigned u32x2 __attribute__((ext_vector_type(2)));
typedef unsigned u32x4 __attribute__((ext_vector_type(4)));

constexpr int DM = 1024, NB = 32, SEQ = 2048, DEPTH = 4, CTXL = 256, GRIDW = 64;
constexpr int NLAT = NB * SEQ;
constexpr int NCTX = NB * CTXL;
constexpr int MTOT = NLAT + NCTX;
constexpr int D_IN = 5024, NP1 = 2048  , NGATE = 3072, DFF = 4096;
constexpr int C_PQ = 0, C_PKV = 256, C_PKR = 384, C_HY = 416, C_DQ = 1184, C_DK = 1440, C_DV = 1696, C_PG = 1952;
constexpr int NUP = 1792, KUP = 384;
constexpr int NMODV = 33, MODW = 6 * DM;
constexpr float EPS = 1e-6f;
constexpr float MLA_SCALE = 0.10206207261596575f;
constexpr float DF_SCALE = 0.17677669529663687f;

constexpr size_t al256(size_t x) { return (x + 255) / 256 * 256; }
constexpr size_t WS_BAR = 0, WS_BAR_BYTES = 65536;
constexpr size_t WS_MOD = WS_BAR + WS_BAR_BYTES;
constexpr size_t WS_ROPE = WS_MOD + al256((size_t)DEPTH * NMODV * MODW * 4);
constexpr size_t WS_LAM = WS_ROPE + (size_t)SEQ * 32 * 4;
constexpr size_t WS_RF = WS_LAM + 256;
constexpr size_t WS_RFC = WS_RF + (size_t)DEPTH * 256 * 4096 * 2;
constexpr size_t WS_XC = WS_RFC + (size_t)DEPTH * 256 * 512 * 2;
constexpr size_t WS_WT = WS_XC + (size_t)NCTX * DM * 4;
constexpr size_t W_IN1 = 0, W_ING = W_IN1 + (size_t)NP1 * DM * 2, W_UP = W_ING + (size_t)NGATE * DM * 2, W_BR = W_UP + (size_t)NUP * KUP * 2,
                 W_OUT = W_BR + (size_t)DM * DM * 2, W_FC1 = W_OUT + (size_t)DM * DM * 2, W_FC2 = W_FC1 + (size_t)DFF * DM * 2, W_LAYER = W_FC2 + (size_t)DM * DFF * 2;
constexpr size_t WS_ARENA = WS_WT + DEPTH * W_LAYER;
constexpr size_t SZ_ROW1024 = (size_t)MTOT * 1024 * 2;
constexpr size_t A_H = WS_ARENA;
constexpr size_t A_Y = A_H + SZ_ROW1024;
constexpr size_t A_BIG = A_Y + SZ_ROW1024;
constexpr size_t A_P1 = A_BIG;
constexpr size_t A_QKV = A_BIG;
constexpr size_t A_QKVN = A_P1 + (size_t)MTOT * NP1 * 2;
constexpr size_t A_KR = A_QKVN + (size_t)MTOT * KUP * 2;
constexpr size_t A_DQ = A_KR + (size_t)MTOT * 32 * 2;
constexpr size_t A_DK = A_DQ + (size_t)MTOT * 256 * 2;
constexpr size_t A_DV = A_DK + (size_t)MTOT * 256 * 2;
constexpr size_t A_UT = A_DV + (size_t)MTOT * 256 * 2;
constexpr size_t A_X0T = A_UT + (size_t)256 * NLAT * 2;
constexpr size_t A_UTC = A_X0T + (size_t)256 * NLAT * 2;
constexpr size_t A_X0TC = A_UTC + (size_t)256 * NCTX * 2;
constexpr size_t A_BIG_END = A_X0TC + (size_t)256 * NCTX * 2;
constexpr size_t A_G = A_BIG;
constexpr size_t A_HID = A_Y;
constexpr size_t WS_END = (A_BIG_END > A_HID + (size_t)MTOT * DFF * 2) ? A_BIG_END : A_HID + (size_t)MTOT * DFF * 2;
static_assert(A_G + (size_t)MTOT * NGATE * 2 <= A_BIG_END + ((size_t)1 << 40), "map");
static_assert(WS_END <= (size_t)1024 * 1024 * 1024, "workspace map exceeds 1 GiB");

constexpr int LDS_BYTES = 147456;
constexpr int LDS_MISC = LDS_BYTES - 64;

__device__ __forceinline__ unsigned pkh(float lo, float hi) { f32x2 v = {lo, hi}; hf2 h = __builtin_convertvector(v, hf2); return __builtin_bit_cast(unsigned, h); }
__device__ __forceinline__ float wave_sum(float v) {
#pragma unroll
    for (int o = 1; o < 64; o <<= 1) v += __shfl_xor(v, o);
    return v;
}
#define LDS_WAIT() asm volatile("s_waitcnt lgkmcnt(0)" ::: "memory")
#define VM_WAIT() asm volatile("s_waitcnt vmcnt(0)" ::: "memory")

#define XB_TMO      128
#define XB_XCNT(j)  (256  + 64 * (j))
#define XB_XSUB(j)  (1280 + 64 * (j))
#define XB_XGEN(j)  (2304 + 64 * (j))
#define XB_TOP      3328
#define XB_TOPGEN   3392
#define XCD_BAR_WORDS 3456
#define XB_SPIN_CAP (1u << 22)
__device__ __forceinline__ unsigned xb_ld(unsigned* p)              { return __hip_atomic_load(p, __ATOMIC_RELAXED, __HIP_MEMORY_SCOPE_AGENT); }
__device__ __forceinline__ unsigned xb_add(unsigned* p, unsigned v) { return __hip_atomic_fetch_add(p, v, __ATOMIC_RELAXED, __HIP_MEMORY_SCOPE_AGENT); }
__device__ __forceinline__ unsigned xb_xcc_id() { return (unsigned)__builtin_amdgcn_s_getreg((3 << 11) | 20) & 0xFu; }
#define XB_SPIN(cond, bar) do { unsigned _sp = 0; while (cond) { __builtin_amdgcn_s_sleep(1); \
    if ((++_sp & 255u) == 0u) { if (xb_ld(&(bar)[XB_TMO])) break; if (_sp > XB_SPIN_CAP) { atomicAdd(&(bar)[XB_TMO], 1u); break; } } } } while (0)
struct XcdBarrier { unsigned* bar; unsigned x; volatile LAS unsigned* st; };
__device__ __forceinline__ XcdBarrier xcd_barrier_post(unsigned* bar, volatile LAS unsigned* st) {
    XcdBarrier b; b.bar = bar; b.x = xb_xcc_id(); b.st = st;
    if (threadIdx.x == 0) (void)xb_add(&bar[XB_XCNT(b.x)], 1u);
    return b;
}
__device__ __forceinline__ void xcd_barrier_complete(unsigned* bar, unsigned x, unsigned& nloc, unsigned& nx) {
    const unsigned G = gridDim.x * gridDim.y * gridDim.z;
    unsigned sum, cnt, mine, sp = 0u;
    for (;;) {
        sum = 0u; cnt = 0u; mine = 0u;
#pragma unroll
        for (unsigned j = 0; j < 16; ++j) { const unsigned c = xb_ld(&bar[XB_XCNT(j)]); sum += c; cnt += (c > 0u) ? 1u : 0u; mine = (j == x) ? c : mine; }
        if (sum == G) break;
        __builtin_amdgcn_s_sleep(1);
        if ((++sp & 255u) == 0u) { if (xb_ld(&bar[XB_TMO])) break; if (sp > XB_SPIN_CAP) { atomicAdd(&bar[XB_TMO], 1u); break; } }
    }
    nloc = mine > 0u ? mine : 1u; nx = cnt > 0u ? cnt : 1u;
}
__device__ __forceinline__ void xcd_barrier(const XcdBarrier& b) {
    asm volatile("s_waitcnt vmcnt(0)" ::: "memory");
    __syncthreads();
    if (threadIdx.x == 0) {
        unsigned* bar = b.bar;
        __builtin_amdgcn_s_waitcnt(0);
        unsigned nloc = b.st[0], nx = b.st[1];
        if (nloc == 0u) { xcd_barrier_complete(bar, b.x, nloc, nx); b.st[0] = nloc; b.st[1] = nx; }
        const unsigned old = xb_add(&bar[XB_XSUB(b.x)], 1u);
        const unsigned gen = old / nloc;
        if (old + 1u == (gen + 1u) * nloc) {
            __builtin_amdgcn_fence(__ATOMIC_RELEASE, "agent");
            asm volatile("s_waitcnt vmcnt(0)" ::: "memory");
            const unsigned og = xb_add(&bar[XB_TOP], 1u);
            const unsigned tg = og / nx;
            if (og + 1u == (tg + 1u) * nx) xb_add(&bar[XB_TOPGEN], 1u);
            else XB_SPIN(xb_ld(&bar[XB_TOPGEN]) == tg, bar);
            __builtin_amdgcn_fence(__ATOMIC_ACQUIRE, "agent");
            xb_add(&bar[XB_XGEN(b.x)], 1u);
            asm volatile("s_waitcnt vmcnt(0)" ::: "memory");
        } else {
            XB_SPIN(xb_ld(&bar[XB_XGEN(b.x)]) == gen, bar);
            __builtin_amdgcn_fence(__ATOMIC_ACQUIRE, "agent");
            asm volatile("s_waitcnt vmcnt(0)" ::: "memory");
        }
    }
    __syncthreads();
}

namespace pg8 {
constexpr int BM = 256, BK = 64, HALF = 128, HTB = HALF * BK * 2, STAGE_BYTES = 8 * HTB, NXCD = 8, WGM = 8;
__host__ __device__ __forceinline__ int lds_byte(int r, int c) { const int st = (r >> 4) * 2 + (c >> 5), rr = r & 15, cc = c & 31, ob = rr * 64 + cc * 2; return st * 1024 + (ob ^ (((ob >> 9) & 1) << 5)); }
__host__ __device__ __forceinline__ void stage_rc(int b, int& R, int& C) { const int st = b / 1024, sb = b % 1024, swz = sb ^ (((sb >> 9) & 1) << 5); R = (st >> 1) * 16 + swz / 64; C = (st & 1) * 32 + (swz % 64) / 2; }
__host__ __device__ __forceinline__ int perm32(int rho) { const int n = rho >> 4, i = rho & 15; return 8 * (i >> 2) + 4 * n + (i & 3); }
struct Unit { int pm, pn; };
struct Gemm { const hf* A; const hf* Bt; int M, N, K, lda, ldb; };
struct StaticOrder {
    int nM, nN, nwg, G, c;
    __host__ __device__ void init(int M, int N, int G_, int c_) { nM = M / BM; nN = N / BM; nwg = nM * nN; G = G_; c = c_; }
    __host__ __device__ bool next(int i, Unit& u) const {
        const long L = (long)i * G + c; if (L >= nwg) return false;
        int wgid = (int)L; { const int q = nwg / NXCD, r = nwg % NXCD, xcd = wgid % NXCD, off = wgid / NXCD; wgid = (xcd < r ? xcd * (q + 1) : r * (q + 1) + (xcd - r) * q) + off; }
        const int nig = WGM * nN, gid = wgid / nig, fm = gid * WGM, gsz = (nM - fm) < WGM ? (nM - fm) : WGM;
        u.pm = fm + ((wgid % nig) % gsz); u.pn = (wgid % nig) / gsz; return true;
    }
    __device__ __forceinline__ void a_ready(const Unit&) const {}
    __device__ __forceinline__ void done(const Unit&) const {}
};

template <int ACT  > struct EpiHalf {
    static constexpr bool PERM = true, AFTER_DRAIN = false;
    hf* O; int ldc;
    __device__ __forceinline__ void operator()(const f32x4 (&acc)[2][2][4][2], const Unit& u, int wr, int wc, int fr, int fq) const {
        const int row0 = u.pm * BM + wr * 64 + fr, col0 = u.pn * BM + wc * 32 + 8 * fq;
#pragma unroll
        for (int ai = 0; ai < 2; ++ai)
#pragma unroll
            for (int m = 0; m < 4; ++m) { hf* rowp = O + (size_t)(row0 + ai * HALF + m * 16) * ldc + col0;
#pragma unroll
                for (int bj = 0; bj < 2; ++bj) { f32x4 v0 = acc[ai][bj][m][0], v1 = acc[ai][bj][m][1];
                    if (ACT == 1) {
#pragma unroll
                        for (int e = 0; e < 4; ++e) { v0[e] = __builtin_amdgcn_rcpf(1.f + __builtin_amdgcn_exp2f(-1.4426950408889634f * v0[e])); v1[e] = __builtin_amdgcn_rcpf(1.f + __builtin_amdgcn_exp2f(-1.4426950408889634f * v1[e])); } }
                    if (ACT == 2) {
#pragma unroll
                        for (int e = 0; e < 4; ++e) { const float a = fmaxf(v0[e], 0.f), b = fmaxf(v1[e], 0.f); v0[e] = a * a; v1[e] = b * b; } }
                    u32x4 w; w.x = pkh(v0[0], v0[1]); w.y = pkh(v0[2], v0[3]); w.z = pkh(v1[0], v1[1]); w.w = pkh(v1[2], v1[3]);
                    *(u32x4*)(rowp + bj * HALF) = w; } }
    }
};
template <bool FIRST> struct EpiGated {
    static constexpr bool PERM = true, AFTER_DRAIN = false;
    hf* MMo; const hf* G; int goff;
    __device__ __forceinline__ void operator()(const f32x4 (&acc)[2][2][4][2], const Unit& u, int wr, int wc, int fr, int fq) const {
        const int row0 = u.pm * BM + wr * 64 + fr, col0 = u.pn * BM + wc * 32 + 8 * fq;
#pragma unroll
        for (int ai = 0; ai < 2; ++ai)
#pragma unroll
            for (int m = 0; m < 4; ++m) { const size_t r = (size_t)(row0 + ai * HALF + m * 16);
#pragma unroll
                for (int bj = 0; bj < 2; ++bj) { const f32x4 v0 = acc[ai][bj][m][0], v1 = acc[ai][bj][m][1];
                    const hf8 g = *(const hf8*)(G + r * NGATE + goff + col0 + bj * HALF);
                    hf* mp = MMo + r * DM + col0 + bj * HALF;
                    float o[8];
#pragma unroll
                    for (int e = 0; e < 4; ++e) { o[e] = (float)g[e] * v0[e]; o[4 + e] = (float)g[4 + e] * v1[e]; }
                    if (!FIRST) { const hf8 p = *(const hf8*)mp;
#pragma unroll
                        for (int e = 0; e < 8; ++e) o[e] += (float)p[e]; }
                    u32x4 w; w.x = pkh(o[0], o[1]); w.y = pkh(o[2], o[3]); w.z = pkh(o[4], o[5]); w.w = pkh(o[6], o[7]);
                    *(u32x4*)mp = w; } }
    }
};
struct EpiResid {
    static constexpr bool PERM = false, AFTER_DRAIN = false;
    const float* xs_lat; const float* xs_ctx; float* xd_lat; float* xd_ctx; const float* gate;
    __device__ __forceinline__ void operator()(const f32x4 (&acc)[2][2][4][2], const Unit& u, int wr, int wc, int fr, int fq) const {
        const int R0 = u.pm * BM; const bool lat = R0 < NLAT;
        const int v = lat ? (R0 >> 11) : NB;
        const int rloc = (lat ? R0 : R0 - NLAT) + wr * 64 + fr, col0 = u.pn * BM + wc * 32 + 4 * fq;
        const float* src = lat ? xs_lat : xs_ctx; float* dst = lat ? xd_lat : xd_ctx; const float* gp = gate + (size_t)v * MODW + col0;
        f32x4 gv[2][2];
#pragma unroll
        for (int bj = 0; bj < 2; ++bj)
#pragma unroll
            for (int n = 0; n < 2; ++n) gv[bj][n] = *(const f32x4*)(gp + bj * HALF + n * 16);
#pragma unroll
        for (int ai = 0; ai < 2; ++ai)
#pragma unroll
            for (int m = 0; m < 4; ++m) { const size_t off = (size_t)(rloc + ai * HALF + m * 16) * DM + col0;
#pragma unroll
                for (int bj = 0; bj < 2; ++bj)
#pragma unroll
                    for (int n = 0; n < 2; ++n) { const f32x4 x = *(const f32x4*)(src + off + bj * HALF + n * 16);
                        *(f32x4*)(dst + off + bj * HALF + n * 16) = x + gv[bj][n] * acc[ai][bj][m][n]; } }
    }
};

template <class Epi, class Sched, bool ALIGN_EPI = true>
__device__ __forceinline__ void gemm_phase(LAS unsigned char* lds, const Gemm g, const Sched& S, const Epi& E) {
    int tid = threadIdx.x; asm volatile("" : "+v"(tid));
    const int wid = __builtin_amdgcn_readfirstlane(tid >> 6), lane = tid & 63, wr = wid >> 2, wc = wid & 3, fr = lane & 15, fq = lane >> 4;
    const int K = g.K, nt = K / BK;
    unsigned voffA[2], voffB[2];
#pragma unroll
    for (int i = 0; i < 2; ++i) { int R, C; stage_rc(tid * 16 + i * 8192, R, C); const int Rb = Epi::PERM ? ((R & ~31) + perm32(R & 31)) : R;
        voffA[i] = (unsigned)(R * g.lda + C) * 2u; voffB[i] = (unsigned)(Rb * g.ldb + C) * 2u; }
    const size_t kstep = (size_t)(BK * 2);
    const size_t hstepA = (size_t)HALF * g.lda * 2, hstepB = (size_t)HALF * g.ldb * 2;
    const size_t tstepA = 2 * hstepA, tstepB = 2 * hstepB;
    const unsigned ldsw = (unsigned)wid * 1024u;
    const int aoff = lds_byte(wr * 64 + fr, fq * 8), boff = lds_byte(wc * 32 + fr, fq * 8);
#define PG8_SA(b, h) (((b) * 2 + (h)) * HTB)
#define PG8_SB(b, h) ((4 + (b) * 2 + (h)) * HTB)
#define PG8_STAGE(bufoff, gbase, voff) do { _Pragma("unroll") for (int _i = 0; _i < 2; ++_i) \
        __builtin_amdgcn_global_load_lds((const unsigned*)((const char*)(gbase) + (voff)[_i]), (LAS unsigned*)(lds + (bufoff) + ldsw + _i * 8192), 16, 0, 0); } while (0)
#define PG8_LDA(dst, b, h) do { _Pragma("unroll") for (int m = 0; m < 4; ++m) _Pragma("unroll") for (int k = 0; k < 2; ++k) dst[m][k] = *(const LAS hf8*)(lds + PG8_SA(b, h) + aoff + m * 2048 + k * 1024); } while (0)
#define PG8_LDB(dst, b, h) do { _Pragma("unroll") for (int n = 0; n < 2; ++n) _Pragma("unroll") for (int k = 0; k < 2; ++k) dst[n][k] = *(const LAS hf8*)(lds + PG8_SB(b, h) + boff + n * 2048 + k * 1024); } while (0)
#define PG8_MMA(ai, bj, At, Bt) do { __builtin_amdgcn_s_setprio(1); _Pragma("unroll") for (int m = 0; m < 4; ++m) _Pragma("unroll") for (int n = 0; n < 2; ++n) _Pragma("unroll") for (int k = 0; k < 2; ++k) \
        acc[ai][bj][m][n] = __builtin_amdgcn_mfma_f32_16x16x32_f16(Bt[n][k], At[m][k], acc[ai][bj][m][n], 0, 0, 0); __builtin_amdgcn_s_setprio(0); } while (0)
#define PG8_WAIT_V(n) asm volatile("s_waitcnt vmcnt(" #n ")" ::: "memory")
#define PG8_WAIT_L(n) asm volatile("s_waitcnt lgkmcnt(" #n ")" ::: "memory")
#define PG8_BAR __builtin_amdgcn_s_barrier()
#define PG8_SCHED __builtin_amdgcn_sched_barrier(0)
    Unit cur, nxt; int ui = 0;
    if (!S.next(0, cur)) return;
    f32x4 acc[2][2][4][2];
#pragma unroll
    for (int a = 0; a < 2; ++a)
#pragma unroll
        for (int b = 0; b < 2; ++b)
#pragma unroll
            for (int m = 0; m < 4; ++m)
#pragma unroll
                for (int n = 0; n < 2; ++n) acc[a][b][m][n] = (f32x4){0.f, 0.f, 0.f, 0.f};
    hf8 At[4][2], B0[2][2], B1[2][2];
    const char* cA = (const char*)g.A + (size_t)cur.pm * tstepA; const char* cB = (const char*)g.Bt + (size_t)cur.pn * tstepB;
    S.a_ready(cur);
    PG8_STAGE(PG8_SB(0, 0), cB, voffB); PG8_STAGE(PG8_SB(0, 1), cB + hstepB, voffB); PG8_STAGE(PG8_SA(0, 0), cA, voffA); PG8_STAGE(PG8_SA(0, 1), cA + hstepA, voffA);
    if (wr == 1) PG8_BAR;
    PG8_WAIT_V(2); PG8_BAR;
    PG8_STAGE(PG8_SB(1, 0), cB + kstep, voffB); PG8_STAGE(PG8_SA(1, 0), cA + kstep, voffA); PG8_STAGE(PG8_SB(1, 1), cB + hstepB + kstep, voffB);
    PG8_WAIT_V(6); PG8_BAR;
    for (;;) {
        const bool has_next = S.next(ui + 1, nxt);
        const char* nA = has_next ? (const char*)g.A + (size_t)nxt.pm * tstepA : cA; const char* nB = has_next ? (const char*)g.Bt + (size_t)nxt.pn * tstepB : cB;
#pragma unroll 1
        for (int t = 0; t < nt; t += 2) {
            const bool last = (t == nt - 2);
            const char* a1 = cA + (size_t)(t + 1) * kstep;
            const char* a2 = last ? nA : cA + (size_t)(t + 2) * kstep; const char* b2 = last ? nB : cB + (size_t)(t + 2) * kstep;
            const char* a3 = a2 + kstep; const char* b3 = b2 + kstep;
            if (last && has_next) S.a_ready(nxt);
            PG8_LDB(B0, 0, 0); PG8_LDB(B1, 0, 1); PG8_SCHED; PG8_LDA(At, 0, 0); PG8_STAGE(PG8_SA(1, 1), a1 + hstepA, voffA);
            PG8_WAIT_V(8); PG8_WAIT_L(0); PG8_BAR; PG8_MMA(0, 0, At, B0); PG8_MMA(0, 1, At, B1); PG8_BAR; PG8_SCHED;
            PG8_LDA(At, 0, 1); PG8_STAGE(PG8_SB(0, 0), b2, voffB); PG8_STAGE(PG8_SB(0, 1), b2 + hstepB, voffB); PG8_STAGE(PG8_SA(0, 0), a2, voffA);
            PG8_WAIT_V(8); PG8_WAIT_L(0); PG8_BAR; PG8_MMA(1, 0, At, B0); PG8_MMA(1, 1, At, B1); PG8_BAR; PG8_SCHED;
            PG8_LDB(B0, 1, 0); PG8_LDB(B1, 1, 1); PG8_SCHED; PG8_LDA(At, 1, 0); PG8_STAGE(PG8_SA(0, 1), a2 + hstepA, voffA);
            PG8_WAIT_V(8); PG8_WAIT_L(0); PG8_BAR; PG8_MMA(0, 0, At, B0); PG8_MMA(0, 1, At, B1); PG8_BAR; PG8_SCHED;
            PG8_LDA(At, 1, 1); PG8_STAGE(PG8_SB(1, 0), b3, voffB); PG8_STAGE(PG8_SB(1, 1), b3 + hstepB, voffB); PG8_STAGE(PG8_SA(1, 0), a3, voffA);
            PG8_WAIT_V(8); PG8_WAIT_L(0); PG8_BAR; PG8_MMA(1, 0, At, B0); PG8_MMA(1, 1, At, B1); PG8_BAR; PG8_SCHED;
        }
        if constexpr (ALIGN_EPI) { if (wr == 0) PG8_BAR; }
        E(acc, cur, wr, wc, fr, fq); S.done(cur);
        if (!has_next) break;
#pragma unroll
        for (int a = 0; a < 2; ++a)
#pragma unroll
            for (int b = 0; b < 2; ++b)
#pragma unroll
                for (int m = 0; m < 4; ++m)
#pragma unroll
                    for (int n = 0; n < 2; ++n) acc[a][b][m][n] = (f32x4){0.f, 0.f, 0.f, 0.f};
        cur = nxt; cA = nA; cB = nB; ++ui;
        if constexpr (ALIGN_EPI) { if (wr == 1) PG8_BAR; }
    }
    PG8_WAIT_V(0);
    if constexpr (!ALIGN_EPI) { if (wr == 0) PG8_BAR; }
    PG8_BAR;
#undef PG8_SA
#undef PG8_SB
#undef PG8_STAGE
#undef PG8_LDA
#undef PG8_LDB
#undef PG8_MMA
#undef PG8_WAIT_V
#undef PG8_WAIT_L
#undef PG8_BAR
#undef PG8_SCHED
}
}

struct Params {
    const float* in[35];
    float* out;
    unsigned char* ws;
    int ph_lo, ph_hi;
};
enum { I_X = 0, I_C, I_CTX, I_CCTX, I_NMG, I_NFG, I_WMOD, I_BMOD, I_WIN, I_QNG, I_WUQ, I_KVNG, I_WUKV, I_HCW, I_HCB, I_HW1, I_HB1, I_HFREQ, I_HW2, I_HB2, I_HW3, I_HB3,
       I_HSKIP, I_LQ1, I_LK1, I_LQ2, I_LK2, I_SUBG, I_WBRA, I_WBRB, I_WBRC, I_WOUT, I_FC1, I_FC2, I_FNG };

struct Frame {
    LAS unsigned char* lds;
    int tid, lane, wave, vcu, G;
};

__device__ __forceinline__ void tr_item(const float* W, int ldw, hf* WT, int ldt, int nblk, LAS float* scr, int item, int lane) {
    const int kb = item / nblk, nb = item % nblk, k0 = 64 * kb, n0 = 32 * nb;
#pragma unroll 8
    for (int i = 0; i < 32; ++i) { const int kk = 2 * i + (lane >> 5); scr[kk * 33 + (lane & 31)] = W[(size_t)(k0 + kk) * ldw + n0 + (lane & 31)]; }
    LDS_WAIT(); asm volatile("" ::: "memory");
    const int c = lane & 7;
#pragma unroll
    for (int j = 0; j < 4; ++j) { const int n = (lane >> 3) + 8 * j; const LAS float* s = scr + (8 * c) * 33 + n;
        u32x4 o; o.x = pkh(s[0 * 33], s[1 * 33]); o.y = pkh(s[2 * 33], s[3 * 33]); o.z = pkh(s[4 * 33], s[5 * 33]); o.w = pkh(s[6 * 33], s[7 * 33]);
        *(u32x4*)(WT + (size_t)(n0 + n) * ldt + k0 + 8 * c) = o; }
    LDS_WAIT(); asm volatile("" ::: "memory");
}
__device__ __forceinline__ float silu_f(float x) { return x / (1.f + expf(-x)); }

__device__ __forceinline__ void mod_phase(const Frame& F, const Params& p) {
    float* MOD = (float*)(p.ws + WS_MOD);
    LAS float* sv = (LAS float*)F.lds;
    constexpr int NCB = DEPTH * MODW / 512;
    for (int item = F.vcu; item < NCB * 3; item += F.G) {
        const int cb = item / 3, vg = item % 3;
        __syncthreads();
        for (int i = F.tid; i < 11 * 1024; i += 512) { const int v = vg * 11 + i / 1024, k = i % 1024;
            const float c = (v < NB) ? p.in[I_C][v * DM + k] : p.in[I_CCTX][k]; sv[i] = silu_f(c); }
        __syncthreads();
        const int gcol = cb * 512 + F.tid, l = gcol / MODW, n = gcol % MODW;
        const float* w = p.in[I_WMOD] + (size_t)l * DM * MODW + n;
        float acc[11];
#pragma unroll
        for (int v = 0; v < 11; ++v) acc[v] = 0.f;
        for (int k = 0; k < DM; k += 4) {
            const float w0 = w[(size_t)k * MODW], w1 = w[(size_t)(k + 1) * MODW], w2 = w[(size_t)(k + 2) * MODW], w3 = w[(size_t)(k + 3) * MODW];
#pragma unroll
            for (int v = 0; v < 11; ++v) { const f32x4 s = *(const LAS f32x4*)(sv + v * 1024 + k);
                acc[v] = fmaf(s[0], w0, acc[v]); acc[v] = fmaf(s[1], w1, acc[v]); acc[v] = fmaf(s[2], w2, acc[v]); acc[v] = fmaf(s[3], w3, acc[v]); }
        }
        const float bm = p.in[I_BMOD][(size_t)l * MODW + n];
#pragma unroll
        for (int v = 0; v < 11; ++v) MOD[((size_t)l * NMODV + vg * 11 + v) * MODW + n] = acc[v] + bm;
    }
    __syncthreads();
}

__device__ __forceinline__ void filt_item(const Params& p, int l, int kind  , int t, int lane) {
    const int L = kind ? CTXL : SEQ;
    hf* R = kind ? (hf*)(p.ws + WS_RFC) + (size_t)l * 256 * 512 : (hf*)(p.ws + WS_RF) + (size_t)l * 256 * 4096;
    const int rl = 2 * L;
    const float tl = (float)t / (float)(L - 1);
    const float wt = (6.283185307179586f / (float)L) * (float)t;
    float z = 0.f;
    if (lane == 0) z = tl;
    else if (lane <= 32) { const int bi = (lane - 1) & 15; const float band = 1e-4f + (15.f - 1e-4f) * ((float)bi / 15.f); const float a = band * wt; z = (lane <= 16) ? cosf(a) : -sinf(a); }
    const float* w1 = p.in[I_HW1] + (size_t)l * 33 * 64; const float* w2 = p.in[I_HW2] + (size_t)l * 64 * 64; const float* w3 = p.in[I_HW3] + (size_t)l * 64 * 512;
    const float fr = p.in[I_HFREQ][l * 64 + lane];
    float a1 = p.in[I_HB1][l * 64 + lane];
    for (int i = 0; i < 33; ++i) a1 = fmaf(__shfl(z, i), w1[i * 64 + lane], a1);
    a1 = sinf(fr * a1);
    float a2 = p.in[I_HB2][l * 64 + lane];
    for (int i = 0; i < 64; ++i) a2 = fmaf(__shfl(a1, i), w2[i * 64 + lane], a2);
    a2 = sinf(fr * a2);
    float h[8];
#pragma unroll
    for (int q = 0; q < 8; ++q) h[q] = p.in[I_HB3][l * 512 + q * 64 + lane];
    for (int i = 0; i < 64; ++i) { const float a = __shfl(a2, i);
#pragma unroll
        for (int q = 0; q < 8; ++q) h[q] = fmaf(a, w3[i * 512 + q * 64 + lane], h[q]); }
    const float d0 = -4.605170185988091f / 1.5f, d1 = -4.605170185988091f / 0.3f;
#pragma unroll
    for (int q = 0; q < 8; ++q) { const int o = q * 64 + lane, dir = o >> 8, c = o & 255;
        const float delta = fabsf(d0 + (d1 - d0) * ((float)c / 255.f));
        float val = h[q] * (expf(-tl * delta) + 0.05f);
        if (dir == 0) { if (t == 0) val += p.in[I_HSKIP][l * 256 + c]; R[(size_t)c * rl + (L - t)] = (hf)val; if (t == 0) R[(size_t)c * rl] = (hf)0.f; }
        else if (t >= 1) R[(size_t)c * rl + (L + t)] = (hf)val; }
}

__device__ __forceinline__ void prologue_phase(const Frame& F, const Params& p) {
    mod_phase(F, p);
    LAS float* scr = (LAS float*)(F.lds + F.wave * 16384);
    const int gw = F.vcu * 8 + F.wave, NGW = F.G * 8, lane = F.lane;
    constexpr int IT_IN1 = 16 * 61, IT_ING = 16 * 96, IT_UQ = 4 * 24, IT_UKV = 2 * 32, IT_BRA = 8 * 32, IT_BRB = 4 * 32, IT_BRC = 4 * 32, IT_OUT = 16 * 32, IT_FC1 = 16 * 128, IT_FC2 = 64 * 32;
    constexpr int IT_LAYER = IT_IN1 + IT_ING + IT_UQ + IT_UKV + IT_BRA + IT_BRB + IT_BRC + IT_OUT + IT_FC1 + IT_FC2;
    for (int it = gw; it < DEPTH * IT_LAYER; it += NGW) {
        const int l = it / IT_LAYER; int r = it % IT_LAYER;
        unsigned char* wl = p.ws + WS_WT + (size_t)l * W_LAYER;
        if (r < IT_IN1) { tr_item(p.in[I_WIN] + (size_t)l * DM * D_IN, D_IN, (hf*)(wl + W_IN1), DM, 61, scr, r, lane); continue; } r -= IT_IN1;
        if (r < IT_ING) { tr_item(p.in[I_WIN] + (size_t)l * DM * D_IN + C_PG, D_IN, (hf*)(wl + W_ING), DM, 96, scr, r, lane); continue; } r -= IT_ING;
        if (r < IT_UQ) { tr_item(p.in[I_WUQ] + (size_t)l * 256 * 768, 768, (hf*)(wl + W_UP), KUP, 24, scr, r, lane); continue; } r -= IT_UQ;
        if (r < IT_UKV) { tr_item(p.in[I_WUKV] + (size_t)l * 128 * 1024, 1024, (hf*)(wl + W_UP) + (size_t)768 * KUP + 256, KUP, 32, scr, r, lane); continue; } r -= IT_UKV;
        if (r < IT_BRA) { tr_item(p.in[I_WBRA] + (size_t)l * 512 * DM, DM, (hf*)(wl + W_BR), DM, 32, scr, r, lane); continue; } r -= IT_BRA;
        if (r < IT_BRB) { tr_item(p.in[I_WBRB] + (size_t)l * 256 * DM, DM, (hf*)(wl + W_BR) + 512, DM, 32, scr, r, lane); continue; } r -= IT_BRB;
        if (r < IT_BRC) { tr_item(p.in[I_WBRC] + (size_t)l * 256 * DM, DM, (hf*)(wl + W_BR) + 768, DM, 32, scr, r, lane); continue; } r -= IT_BRC;
        if (r < IT_OUT) { tr_item(p.in[I_WOUT] + (size_t)l * DM * DM, DM, (hf*)(wl + W_OUT), DM, 32, scr, r, lane); continue; } r -= IT_OUT;
        if (r < IT_FC1) { tr_item(p.in[I_FC1] + (size_t)l * DM * DFF, DFF, (hf*)(wl + W_FC1), DM, 128, scr, r, lane); continue; } r -= IT_FC1;
        tr_item(p.in[I_FC2] + (size_t)l * DFF * DM, DM, (hf*)(wl + W_FC2), DFF, 32, scr, r, lane);
    }
    {
        const int gt = gw * 64 + lane, NGT = NGW * 64;
        for (int l = 0; l < DEPTH; ++l) {
            unsigned char* wl = p.ws + WS_WT + (size_t)l * W_LAYER;
            u32x4* z1 = (u32x4*)((hf*)(wl + W_IN1) + (size_t)C_PG * DM);
            for (int i = gt; i < 96 * DM / 8; i += NGT) z1[i] = (u32x4){0u, 0u, 0u, 0u};
            hf* up = (hf*)(wl + W_UP);
            for (int i = gt; i < 768 * 16; i += NGT) { const int n = i / 16, k8 = i % 16; *(u32x4*)(up + (size_t)n * KUP + 256 + k8 * 8) = (u32x4){0u, 0u, 0u, 0u}; }
            for (int i = gt; i < 1024 * 32; i += NGT) { const int n = 768 + i / 32, k8 = i % 32; *(u32x4*)(up + (size_t)n * KUP + k8 * 8) = (u32x4){0u, 0u, 0u, 0u}; }
        }
    }
    for (int it = gw; it < DEPTH * (SEQ + CTXL); it += NGW) { const int l = it / (SEQ + CTXL), r = it % (SEQ + CTXL); if (r < SEQ) filt_item(p, l, 0, r, lane); else filt_item(p, l, 1, r - SEQ, lane); }
    {
        float* rope = (float*)(p.ws + WS_ROPE);
        const int gt = gw * 64 + lane, NGT = NGW * 64;
        for (int i = gt; i < SEQ * 16; i += NGT) { const int t = i >> 4, j = i & 15; const float pos = (j < 8) ? (float)(t / GRIDW) : (float)(t % GRIDW);
            const float inv = powf(10000.f, -(float)(j & 7) / 8.f); const float a = pos * inv; rope[t * 32 + j] = cosf(a); rope[t * 32 + 16 + j] = sinf(a); }
        if (gt < DEPTH) { const int l = gt; float s1 = 0.f, s2 = 0.f;
            for (int i = 0; i < 32; ++i) { s1 += p.in[I_LQ1][l * 32 + i] * p.in[I_LK1][l * 32 + i]; s2 += p.in[I_LQ2][l * 32 + i] * p.in[I_LK2][l * 32 + i]; }
            const float li = 0.8f - 0.6f * expf(-0.3f * (float)l);
            float* lam = (float*)(p.ws + WS_LAM); lam[2 * l] = expf(s1) - expf(s2) + li; lam[2 * l + 1] = 1.f - li; }
    }
}

__device__ __forceinline__ void norm_phase(const Frame& F, const float* xs_lat, const float* xs_ctx, int nrows, const float* gain, const float* modl, int sh_off, int sc_off, hf* H) {
    const int gw = F.vcu * 8 + F.wave, NGW = F.G * 8, lane = F.lane;
    f32x4 g[4];
#pragma unroll
    for (int j = 0; j < 4; ++j) g[j] = *(const f32x4*)(gain + 4 * lane + 256 * j);
    for (int row = gw; row < nrows; row += NGW) {
        const bool lat = row < NLAT; const float* xr = lat ? xs_lat + (size_t)row * DM : xs_ctx + (size_t)(row - NLAT) * DM;
        const int v = lat ? (row >> 11) : NB; const float* mv = modl + (size_t)v * MODW;
        f32x4 x[4]; float ss = 0.f;
#pragma unroll
        for (int j = 0; j < 4; ++j) { x[j] = *(const f32x4*)(xr + 4 * lane + 256 * j); ss += (x[j][0] * x[j][0] + x[j][1] * x[j][1]) + (x[j][2] * x[j][2] + x[j][3] * x[j][3]); }
        const float rstd = rsqrtf(wave_sum(ss) * (1.f / DM) + EPS);
        hf* hr = H + (size_t)row * DM;
#pragma unroll
        for (int j = 0; j < 4; ++j) { const f32x4 sh = *(const f32x4*)(mv + sh_off + 4 * lane + 256 * j), sc = *(const f32x4*)(mv + sc_off + 4 * lane + 256 * j);
            const f32x4 y = (x[j] * rstd) * g[j]; const f32x4 o = y * (sc + 1.f) + sh;
            u32x2 w; w.x = pkh(o[0], o[1]); w.y = pkh(o[2], o[3]); *(u32x2*)(hr + 4 * lane + 256 * j) = w; }
    }
}
__device__ __forceinline__ void final_norm_phase(const Frame& F, float* X, const float* gain) {
    const int gw = F.vcu * 8 + F.wave, NGW = F.G * 8, lane = F.lane;
    f32x4 g[4];
#pragma unroll
    for (int j = 0; j < 4; ++j) g[j] = *(const f32x4*)(gain + 4 * lane + 256 * j);
    for (int row = gw; row < NLAT; row += NGW) {
        float* xr = X + (size_t)row * DM; f32x4 x[4]; float ss = 0.f;
#pragma unroll
        for (int j = 0; j < 4; ++j) { x[j] = *(const f32x4*)(xr + 4 * lane + 256 * j); ss += (x[j][0] * x[j][0] + x[j][1] * x[j][1]) + (x[j][2] * x[j][2] + x[j][3] * x[j][3]); }
        const float rstd = rsqrtf(wave_sum(ss) * (1.f / DM) + EPS);
#pragma unroll
        for (int j = 0; j < 4; ++j) *(f32x4*)(xr + 4 * lane + 256 * j) = (x[j] * rstd) * g[j];
    }
}

__device__ __forceinline__ void prep_rows(const Frame& F, const Params& p, int l) {
    const int gw = F.vcu * 8 + F.wave, NGW = F.G * 8, lane = F.lane;
    const hf* P1 = (const hf*)(p.ws + A_P1); hf* QKVN = (hf*)(p.ws + A_QKVN); hf* KR = (hf*)(p.ws + A_KR); hf* DQ = (hf*)(p.ws + A_DQ); hf* DK = (hf*)(p.ws + A_DK); hf* DV = (hf*)(p.ws + A_DV);
    const float* rope = (const float*)(p.ws + WS_ROPE);
    const f32x4 gq = *(const f32x4*)(p.in[I_QNG] + l * 256 + 4 * lane);
    const f32x2 gkv = *(const f32x2*)(p.in[I_KVNG] + l * 128 + 2 * lane);
    for (int row = gw; row < MTOT; row += NGW) {
        const hf* pr = P1 + (size_t)row * NP1; const bool lat = row < NLAT; const int t = row & (SEQ - 1);
        {
            const hf4 a = *(const hf4*)(pr + C_PQ + 4 * lane); f32x4 x = {(float)a[0], (float)a[1], (float)a[2], (float)a[3]};
            const float rstd = rsqrtf(wave_sum((x[0] * x[0] + x[1] * x[1]) + (x[2] * x[2] + x[3] * x[3])) * (1.f / 256.f) + EPS);
            x = (x * rstd) * gq; u32x2 w; w.x = pkh(x[0], x[1]); w.y = pkh(x[2], x[3]); *(u32x2*)(QKVN + (size_t)row * KUP + 4 * lane) = w; }
        {
            const hf2 a = *(const hf2*)(pr + C_PKV + 2 * lane); f32x2 x = {(float)a[0], (float)a[1]};
            const float rstd = rsqrtf(wave_sum(x[0] * x[0] + x[1] * x[1]) * (1.f / 128.f) + EPS);
            x = (x * rstd) * gkv; *(unsigned*)(QKVN + (size_t)row * KUP + 256 + 2 * lane) = pkh(x[0], x[1]); }
        {
            *(u32x2*)(DQ + (size_t)row * 256 + 4 * lane) = *(const u32x2*)(pr + C_DQ + 4 * lane);
            *(u32x2*)(DV + (size_t)row * 256 + 4 * lane) = *(const u32x2*)(pr + C_DV + 4 * lane); }
        {
            const int hh = lane >> 3, i0 = 2 * (lane & 7);
            const hf2 a = *(const hf2*)(pr + C_DK + hh * 32 + i0), b = *(const hf2*)(pr + C_DK + hh * 32 + 16 + i0);
            float x1[2] = {(float)a[0], (float)a[1]}, x2[2] = {(float)b[0], (float)b[1]}, o1[2], o2[2];
#pragma unroll
            for (int e = 0; e < 2; ++e) { const float c = lat ? rope[t * 32 + i0 + e] : 1.f, s = lat ? rope[t * 32 + 16 + i0 + e] : 0.f; o1[e] = x1[e] * c - x2[e] * s; o2[e] = x2[e] * c + x1[e] * s; }
            *(unsigned*)(DK + (size_t)row * 256 + hh * 32 + i0) = pkh(o1[0], o1[1]); *(unsigned*)(DK + (size_t)row * 256 + hh * 32 + 16 + i0) = pkh(o2[0], o2[1]); }
        if (lane < 16) {
            const float x1 = (float)pr[C_PKR + lane], x2 = (float)pr[C_PKR + 16 + lane];
            const float c = lat ? rope[t * 32 + lane] : 1.f, s = lat ? rope[t * 32 + 16 + lane] : 0.f;
            KR[(size_t)row * 32 + lane] = (hf)(x1 * c - x2 * s); KR[(size_t)row * 32 + 16 + lane] = (hf)(x2 * c + x1 * s); }
    }
}
__device__ __forceinline__ void prep_hyena(const Frame& F, const Params& p, int l) {
    const int gw = F.vcu * 8 + F.wave, NGW = F.G * 8, lane = F.lane;
    const hf* P1 = (const hf*)(p.ws + A_P1);
    LAS hf* tile = (LAS hf*)(F.lds + F.wave * 9216);
    const float* cw = p.in[I_HCW] + (size_t)l * 3 * 768; const float* cb = p.in[I_HCB] + (size_t)l * 768;
    constexpr int IT_LAT = 2 * NB * (SEQ / 64) * 4, IT_CTX = 2 * NB * (CTXL / 64) * 4;
    for (int it = gw; it < IT_LAT + IT_CTX; it += NGW) {
        const bool ctx = it >= IT_LAT; int r = ctx ? it - IT_LAT : it; const int L = ctx ? CTXL : SEQ, ntile = L / 64;
        const int cg = r & 3; r >>= 2; const int tt = r % ntile; r /= ntile; const int b = r % NB; const int which = r / NB;
        const int c = cg * 64 + lane, t0 = tt * 64; const size_t rowbase = ctx ? (size_t)NLAT + (size_t)b * CTXL : (size_t)b * SEQ;
        hf* dst = ctx ? (hf*)(p.ws + (which ? A_X0TC : A_UTC)) : (hf*)(p.ws + (which ? A_X0T : A_UT));
        if (which == 1) {
            const int col = C_HY + c; const float w0 = cw[c], w1 = cw[768 + c], w2 = cw[1536 + c], bb = cb[c];
            float prev = (t0 > 0) ? (float)P1[(rowbase + t0 - 1) * NP1 + col] : 0.f, cur = (float)P1[(rowbase + t0) * NP1 + col];
#pragma unroll 8
            for (int t = 0; t < 64; ++t) { const int tn = t0 + t + 1; const float nxt = (tn < L) ? (float)P1[(rowbase + tn) * NP1 + col] : 0.f;
                tile[lane * 72 + t] = (hf)(w0 * prev + w1 * cur + w2 * nxt + bb); prev = cur; cur = nxt; }
        } else {
            const int c1 = C_HY + 256 + c, c2 = C_HY + 512 + c;
            const float a0 = cw[256 + c], a1 = cw[768 + 256 + c], a2 = cw[1536 + 256 + c], ab = cb[256 + c];
            const float v0 = cw[512 + c], v1 = cw[768 + 512 + c], v2 = cw[1536 + 512 + c], vb = cb[512 + c];
            float pa = (t0 > 0) ? (float)P1[(rowbase + t0 - 1) * NP1 + c1] : 0.f, ca = (float)P1[(rowbase + t0) * NP1 + c1];
            float pv = (t0 > 0) ? (float)P1[(rowbase + t0 - 1) * NP1 + c2] : 0.f, cv = (float)P1[(rowbase + t0) * NP1 + c2];
#pragma unroll 8
            for (int t = 0; t < 64; ++t) { const int tn = t0 + t + 1; const bool in = tn < L;
                const float na = in ? (float)P1[(rowbase + tn) * NP1 + c1] : 0.f, nv = in ? (float)P1[(rowbase + tn) * NP1 + c2] : 0.f;
                const float x1 = a0 * pa + a1 * ca + a2 * na + ab, vv = v0 * pv + v1 * cv + v2 * nv + vb;
                tile[lane * 72 + t] = (hf)(vv * x1); pa = ca; ca = na; pv = cv; cv = nv; }
        }
        LDS_WAIT(); asm volatile("" ::: "memory");
#pragma unroll
        for (int q = 0; q < 8; ++q) { const int ch = q * 8 + (lane >> 3), pc = lane & 7;
            const u32x4 v = *(const LAS u32x4*)(tile + ch * 72 + pc * 8);
            *(u32x4*)(dst + ((size_t)(cg * 64 + ch) * NB + b) * L + t0 + pc * 8) = v; }
        LDS_WAIT(); asm volatile("" ::: "memory");
    }
}

namespace att {
__device__ __forceinline__ int crow(int r, int hi) { return (r & 3) + 8 * (r >> 2) + 4 * hi; }
#define SBAR() __builtin_amdgcn_sched_barrier(0)
constexpr float THR = 8.f;
__device__ __forceinline__ void sm_part(f32x16& p0, f32x16& p1, float& m_reg, float& alpha, const float C, const float THRS) {
    float pmax = p0[0];
#pragma unroll
    for (int r = 1; r < 16; ++r) pmax = fmaxf(pmax, p0[r]);
#pragma unroll
    for (int r = 0; r < 16; ++r) pmax = fmaxf(pmax, p1[r]);
    { auto rr = __builtin_amdgcn_permlane32_swap(__float_as_uint(pmax), __float_as_uint(pmax), false, false);
      pmax = fmaxf(__uint_as_float(rr[0]), __uint_as_float(rr[1])); }
    float mn;
    if (__all(pmax - m_reg <= THRS)) { mn = m_reg; alpha = 1.f; }
    else { mn = fmaxf(m_reg, pmax); alpha = __builtin_amdgcn_exp2f((m_reg - mn) * C); m_reg = mn; }
    const float mnC = -mn * C;
#pragma unroll
    for (int r = 0; r < 16; ++r) p0[r] = __builtin_amdgcn_exp2f(fmaf(p0[r], C, mnC));
#pragma unroll
    for (int r = 0; r < 16; ++r) p1[r] = __builtin_amdgcn_exp2f(fmaf(p1[r], C, mnC));
}
__device__ __forceinline__ void sm_fin(const f32x16& p0, const f32x16& p1, float alpha, float& l_reg, hf8& pa0, hf8& pa1, hf8& pa2, hf8& pa3) {
    float ps = 0.f;
#pragma unroll
    for (int r = 0; r < 16; ++r) ps += p0[r];
#pragma unroll
    for (int r = 0; r < 16; ++r) ps += p1[r];
    { auto rr = __builtin_amdgcn_permlane32_swap(__float_as_uint(ps), __float_as_uint(ps), false, false);
      ps = __uint_as_float(rr[0]) + __uint_as_float(rr[1]); }
    l_reg = l_reg * alpha + ps;
#define PK4(P, BASE, OUT) do { unsigned a0 = pkh(P[BASE + 0], P[BASE + 1]), a1 = pkh(P[BASE + 2], P[BASE + 3]);   \
    unsigned b0 = pkh(P[BASE + 4], P[BASE + 5]), b1 = pkh(P[BASE + 6], P[BASE + 7]);                              \
    auto r0 = __builtin_amdgcn_permlane32_swap(a0, b0, false, false); auto r1 = __builtin_amdgcn_permlane32_swap(a1, b1, false, false); \
    u32x4 w = {r0[0], r1[0], r0[1], r1[1]}; OUT = __builtin_bit_cast(hf8, w); } while (0)
    PK4(p0, 0, pa0); PK4(p0, 8, pa1); PK4(p1, 0, pa2); PK4(p1, 8, pa3);
#undef PK4
}
template <int ND0, int KS>
__device__ __forceinline__ void qkt(f32x16& p0, f32x16& p1, const LAS unsigned char* Ks, const hf8* qr, int r32, int hi) {
    p0 = f32x16{}; p1 = f32x16{};
#pragma unroll
    for (int d0 = 0; d0 < ND0; ++d0) { const int cb = (d0 * 16 + hi * 8) * 2;
        const hf8 b0 = *(const LAS hf8*)(Ks + r32 * KS + cb);
        const hf8 b1 = *(const LAS hf8*)(Ks + (32 + r32) * KS + cb);
        p0 = __builtin_amdgcn_mfma_f32_32x32x16_f16(b0, qr[d0], p0, 0, 0, 0);
        p1 = __builtin_amdgcn_mfma_f32_32x32x16_f16(b1, qr[d0], p1, 0, 0, 0); }
}
__device__ __forceinline__ int v_st(int k, int c) { const int kk = (k & ~0xC) | ((k & 4) << 1) | ((k & 8) >> 1); return ((kk >> 3) * 2 + (c >> 5)) * 512 + ((kk & 7) * 32 + (c & 31)) * 2; }
__device__ __forceinline__ int v_rd_base(int lane) { return ((lane & 3) << 3) | (((lane >> 2) & 3) << 6) | (((lane >> 4) & 1) << 5) | (((lane >> 5) & 1) << 8); }
constexpr int v_rd_off(int d0, int ks, int half) { return d0 * 512 + ks * 2048 + half * 1024; }
template <int OFF> __device__ __forceinline__ s16x4 tr_read(int vb) {
    s16x4 r; asm volatile("ds_read_b64_tr_b16 %0, %1 offset:%2" : "=&v"(r) : "v"(vb), "i"(OFF) : "memory"); return r;
}
template <int D0> __device__ __forceinline__ void pv_one(f32x16& od, int vb, hf8 pa0, hf8 pa1, hf8 pa2, hf8 pa3) {
    const s16x4 l0 = tr_read<v_rd_off(D0, 0, 0)>(vb), h0 = tr_read<v_rd_off(D0, 0, 1)>(vb), l1 = tr_read<v_rd_off(D0, 1, 0)>(vb), h1 = tr_read<v_rd_off(D0, 1, 1)>(vb);
    const s16x4 l2 = tr_read<v_rd_off(D0, 2, 0)>(vb), h2 = tr_read<v_rd_off(D0, 2, 1)>(vb), l3 = tr_read<v_rd_off(D0, 3, 0)>(vb), h3 = tr_read<v_rd_off(D0, 3, 1)>(vb);
    asm volatile("s_waitcnt lgkmcnt(0)" ::: "memory"); SBAR();
#define PKV(L, H) __builtin_bit_cast(hf8, (short __attribute__((ext_vector_type(8)))){L[0], L[1], L[2], L[3], H[0], H[1], H[2], H[3]})
    od = __builtin_amdgcn_mfma_f32_32x32x16_f16(pa0, PKV(l0, h0), od, 0, 0, 0);
    od = __builtin_amdgcn_mfma_f32_32x32x16_f16(pa1, PKV(l1, h1), od, 0, 0, 0);
    od = __builtin_amdgcn_mfma_f32_32x32x16_f16(pa2, PKV(l2, h2), od, 0, 0, 0);
    od = __builtin_amdgcn_mfma_f32_32x32x16_f16(pa3, PKV(l3, h3), od, 0, 0, 0);
#undef PKV
}

constexpr int KS_MLA = 208, KS_DF = 80;
constexpr int KB_MLA = 64 * KS_MLA, KB_DF = 64 * KS_DF;
constexpr int VB = 8192;
constexpr int OFF_V = 32768, OFF_WS = OFF_V + 2 * VB;

template <bool MLA>
__device__ __forceinline__ void attn_unit(const Frame& F, const Params& p, int l, int h, int qrow0, int qpos0, int klat0, int nlat, int kctx0) {
    constexpr int NSUB = MLA ? 1 : 2, DK = MLA ? 96 : 32, ND0 = DK / 16, KS = MLA ? KS_MLA : KS_DF, KB = MLA ? KB_MLA : KB_DF;
    constexpr float SCALE = MLA ? MLA_SCALE : DF_SCALE, C = SCALE * 1.4426950408889634f, THRS = THR / SCALE;
    const int tid = F.tid, wid = F.wave, lane = F.lane, r32 = lane & 31, hi = lane >> 5;
    const hf* QKV = (const hf*)(p.ws + A_QKV); const hf* KRb = (const hf*)(p.ws + A_KR);
    const hf* DQ = (const hf*)(p.ws + A_DQ); const hf* DKb = (const hf*)(p.ws + A_DK); const hf* DVb = (const hf*)(p.ws + A_DV);
    const float* rope = (const float*)(p.ws + WS_ROPE);
    hf* Y = (hf*)(p.ws + A_Y);
    LAS unsigned char* lds = F.lds;
    LAS float* wsf = (LAS float*)(lds + OFF_WS) + wid * 64; LAS float* al_l = wsf; LAS float* li_l = wsf + 32;
    hf8 qr[NSUB][ND0];
    {
        const int qrow = qrow0 + wid * 32 + r32;
#pragma unroll
        for (int s = 0; s < NSUB; ++s) {
            const hf* qp = MLA ? QKV + (size_t)qrow * NUP + h * 96 + hi * 8 : DQ + (size_t)qrow * 256 + (2 * h + s) * 32 + hi * 8;
#pragma unroll
            for (int d0 = 0; d0 < ND0; ++d0) qr[s][d0] = *(const hf8*)(qp + d0 * 16);
            if (qpos0 >= 0) {
                const int t = qpos0 + wid * 32 + r32;
                const f32x4 c0 = *(const f32x4*)(rope + t * 32 + hi * 8), c1 = *(const f32x4*)(rope + t * 32 + hi * 8 + 4);
                const f32x4 s0 = *(const f32x4*)(rope + t * 32 + 16 + hi * 8), s1 = *(const f32x4*)(rope + t * 32 + 16 + hi * 8 + 4);
                hf8& x1 = qr[s][ND0 - 2]; hf8& x2 = qr[s][ND0 - 1]; hf8 y1, y2;
#pragma unroll
                for (int j = 0; j < 8; ++j) { const float cc = j < 4 ? c0[j & 3] : c1[j & 3], sn = j < 4 ? s0[j & 3] : s1[j & 3]; const float a = (float)x1[j], b = (float)x2[j];
                    y1[j] = (hf)(a * cc - b * sn); y2[j] = (hf)(b * cc + a * sn); }
                x1 = y1; x2 = y2;
            }
        }
    }
    const int vr = tid >> 3, vc = (tid & 7) * 8, vst = v_st(vr, vc);
    const int k1r = MLA ? (tid >> 3) : ((tid >> 2) & 63), k1c = MLA ? (tid & 7) * 8 : (tid & 3) * 8, k1s = MLA ? 0 : (tid >> 8);
    const int k2r = tid >> 2, k2c = (tid & 3) * 8;
    u32x4 sv, sk1, sk2;
    const int ntile = nlat + 4;
#define A_SLOAD(j) do { const int kr0 = ((j) < nlat) ? klat0 + (j) * 64 : kctx0 + ((j) - nlat) * 64; \
        if (MLA) { sv = *(const u32x4*)(QKV + (size_t)(kr0 + vr) * NUP + 768 + h * 128 + 64 + vc); sk1 = *(const u32x4*)(QKV + (size_t)(kr0 + k1r) * NUP + 768 + h * 128 + k1c); \
                   if (tid < 256) sk2 = *(const u32x4*)(KRb + (size_t)(kr0 + k2r) * 32 + k2c); } \
        else { sv = *(const u32x4*)(DVb + (size_t)(kr0 + vr) * 256 + h * 64 + vc); sk1 = *(const u32x4*)(DKb + (size_t)(kr0 + k1r) * 256 + (2 * h + k1s) * 32 + k1c); } } while (0)
#define A_SWRITE(b) do { *(LAS u32x4*)(lds + OFF_V + (b) * VB + vst) = sv; \
        if (MLA) { *(LAS u32x4*)(lds + (b) * KB + k1r * KS + k1c * 2) = sk1; if (tid < 256) *(LAS u32x4*)(lds + (b) * KB + k2r * KS + 128 + k2c * 2) = sk2; } \
        else { *(LAS u32x4*)(lds + ((b) * 2 + k1s) * KB + k1r * KS + k1c * 2) = sk1; } } while (0)
    float m_reg[NSUB], l_reg[NSUB]; f32x16 o[NSUB][2];
#pragma unroll
    for (int s = 0; s < NSUB; ++s) { m_reg[s] = -1e30f; l_reg[s] = 0.f; o[s][0] = f32x16{}; o[s][1] = f32x16{}; }
    const int vb0 = (int)(unsigned)(uintptr_t)(lds + OFF_V) + v_rd_base(lane);
    __syncthreads();
    A_SLOAD(0); VM_WAIT(); A_SWRITE(0); __syncthreads();
    for (int j = 0; j < ntile; ++j) {
        const int cur = j & 1;
        if (j + 1 < ntile) A_SLOAD(j + 1);
#pragma unroll
        for (int s = 0; s < NSUB; ++s) {
            f32x16 p0, p1; float alpha; hf8 pa0, pa1, pa2, pa3;
            qkt<ND0, KS>(p0, p1, lds + (MLA ? cur : cur * 2 + s) * KB, qr[s], r32, hi);
            sm_part(p0, p1, m_reg[s], alpha, C, THRS);
            if (__any(alpha < 1.f)) { if (hi == 0) al_l[r32] = alpha; LDS_WAIT();
#pragma unroll
                for (int d = 0; d < 2; ++d)
#pragma unroll
                    for (int r = 0; r < 16; ++r) o[s][d][r] *= al_l[crow(r, hi)];
                LDS_WAIT(); }
            sm_fin(p0, p1, alpha, l_reg[s], pa0, pa1, pa2, pa3); SBAR();
            pv_one<0>(o[s][0], vb0 + cur * VB, pa0, pa1, pa2, pa3); pv_one<1>(o[s][1], vb0 + cur * VB, pa0, pa1, pa2, pa3);
        }
        if (j + 1 < ntile) { VM_WAIT(); A_SWRITE(cur ^ 1); }
        __syncthreads();
    }
#undef A_SLOAD
#undef A_SWRITE
    float rli[NSUB][16];
#pragma unroll
    for (int s = 0; s < NSUB; ++s) { if (hi == 0) li_l[r32] = l_reg[s]; LDS_WAIT();
#pragma unroll
        for (int r = 0; r < 16; ++r) rli[s][r] = __builtin_amdgcn_rcpf(li_l[crow(r, hi)]);
        LDS_WAIT(); }
    if constexpr (MLA) {
#pragma unroll
        for (int r = 0; r < 16; ++r) { hf* yr = Y + (size_t)(qrow0 + wid * 32 + crow(r, hi)) * DM + h * 64 + r32;
            yr[0] = (hf)(o[0][0][r] * rli[0][r]); yr[32] = (hf)(o[0][1][r] * rli[0][r]); }
    } else {
        const float lam = ((const float*)(p.ws + WS_LAM))[2 * l], oml = ((const float*)(p.ws + WS_LAM))[2 * l + 1];
        const float g0 = p.in[I_SUBG][l * 64 + r32], g1 = p.in[I_SUBG][l * 64 + 32 + r32];
#pragma unroll
        for (int r = 0; r < 16; ++r) {
            const float a = o[0][0][r] * rli[0][r] - lam * (o[1][0][r] * rli[1][r]), b = o[0][1][r] * rli[0][r] - lam * (o[1][1][r] * rli[1][r]);
            float ss = a * a + b * b;
#pragma unroll
            for (int of = 1; of < 32; of <<= 1) ss += __shfl_xor(ss, of);
            const float rs = rsqrtf(ss * (1.f / 64.f) + EPS) * oml;
            hf* yr = Y + (size_t)(qrow0 + wid * 32 + crow(r, hi)) * DM + 768 + h * 64 + r32;
            yr[0] = (hf)(a * rs * g0); yr[32] = (hf)(b * rs * g1); }
    }
}
}

template <int L>
__device__ __forceinline__ void hyena_unit(const Frame& F, const hf* Rrow  , const hf* U  , const hf* X0  , hf* Ycol  ) {
    constexpr int NM = L / 256, RL = 2 * L, SH = (L > 1024) ? 1024 : L, NH = L / SH, US = SH * 2 + 16;
    constexpr int OFF_U = 8 * RL * 2;
    static_assert(OFF_U + 32 * US <= LDS_MISC, "hyena LDS");
    const int tid = F.tid, w = F.wave, lane = F.lane, i32 = lane & 31, hi = lane >> 5;
    LAS unsigned char* lds = F.lds;
    __syncthreads();
    for (int idx = tid; idx < 8 * RL; idx += 512) { const int cw = idx / RL, x = idx % RL; ((LAS hf*)lds)[idx] = (x >= cw) ? Rrow[x - cw] : (hf)0.f; }
    f32x16 acc[NM];
#pragma unroll
    for (int m = 0; m < NM; ++m) acc[m] = f32x16{};
    const LAS unsigned char* cpy = lds + w * (RL * 2);
    for (int half = 0; half < NH; ++half) {
        __syncthreads();
        for (int idx = tid; idx < 32 * (SH / 8); idx += 512) { const int b = idx / (SH / 8), pc = idx % (SH / 8);
            *(LAS u32x4*)(lds + OFF_U + b * US + pc * 16) = *(const u32x4*)(U + (size_t)b * L + half * SH + pc * 8); }
        __syncthreads();
#pragma unroll 2
        for (int jl = 0; jl < SH / 16; ++jl) {
            const int j = half * (SH / 16) + jl;
            const hf8 bf = *(const LAS hf8*)(lds + OFF_U + i32 * US + (jl * 16 + hi * 8) * 2);
            const int x0 = L + 16 * j + 8 * hi - 8 * i32;
#pragma unroll
            for (int m = 0; m < NM; ++m) { const hf8 af = *(const LAS hf8*)(cpy + (x0 - 256 * m) * 2);
                acc[m] = __builtin_amdgcn_mfma_f32_32x32x16_f16(af, bf, acc[m], 0, 0, 0); }
        }
    }
    const hf* x0p = X0 + (size_t)i32 * L + w + 32 * hi;
    hf* yp = Ycol + ((size_t)i32 * L + w + 32 * hi) * DM;
#pragma unroll
    for (int m = 0; m < NM; ++m) {
#pragma unroll
        for (int r = 0; r < 16; ++r) { const int tt = 256 * m + 8 * ((r & 3) + 8 * (r >> 2));
            const float x0v = (float)x0p[tt];
            yp[(size_t)tt * DM] = (hf)(x0v * acc[m][r]); }
        asm volatile("" ::: "memory");
    }
}

#ifndef PH_MASK
#define PH_MASK 0x1FFFF
#endif
#define PHM(k) ((PH_MASK >> (k)) & 1)
constexpr int NPH_LAYER = 11, NPHASE = 1 + DEPTH * NPH_LAYER + 1;
__global__ void __launch_bounds__(512, 2) fwd_kernel(Params p) {
    extern __shared__ __attribute__((aligned(16))) unsigned char lds_raw[];
    Frame F0; Frame& F = F0;
    F.lds = (LAS unsigned char*)lds_raw;
    F.tid = threadIdx.x; F.lane = F.tid & 63; F.wave = __builtin_amdgcn_readfirstlane(F.tid >> 6);
    F.G = gridDim.x; { const int bx = blockIdx.x; F.vcu = (F.G % 8 == 0) ? (bx % 8) * (F.G / 8) + bx / 8 : bx; }
    volatile LAS unsigned* misc = (volatile LAS unsigned*)(F.lds + LDS_MISC);
    if (F.tid < 16) misc[F.tid] = 0u;
    __syncthreads();
    const int lo = p.ph_lo, hi = p.ph_hi;
    XcdBarrier bar; bar.bar = (unsigned*)(p.ws + WS_BAR); bar.x = 0; bar.st = misc;
    if (hi - lo > 1) bar = xcd_barrier_post((unsigned*)(p.ws + WS_BAR), misc);
#define IN(k) (lo <= (k) && (k) < hi)
#define LAUNDER(Fl) Frame Fl = F0; asm volatile("" : "+v"(Fl.tid), "+v"(Fl.lane))
#define SEAM(k) do { if (IN(k) && IN((k) + 1)) xcd_barrier(bar); } while (0)
    unsigned char* ws = p.ws;
    float* X = p.out; float* XC = (float*)(ws + WS_XC);
    hf* H = (hf*)(ws + A_H); hf* Y = (hf*)(ws + A_Y); hf* P1 = (hf*)(ws + A_P1); hf* QKV = (hf*)(ws + A_QKV); hf* QKVN = (hf*)(ws + A_QKVN);
    hf* Gt = (hf*)(ws + A_G); hf* HID = (hf*)(ws + A_HID); hf* MM = H;

    if (PHM(11) && IN(0)) { LAUNDER(Fl); prologue_phase(Fl, p); }
    SEAM(0);

    for (int l = 0; l < DEPTH; ++l) {
        const int pb = 1 + l * NPH_LAYER;
        const bool ctx_live = l < DEPTH - 1;
        const int Mrows = ctx_live ? MTOT : NLAT;
        const float* xin_lat = (l == 0) ? p.in[I_X] : X; const float* xin_ctx = (l == 0) ? p.in[I_CTX] : XC;
        const float* modl = (const float*)(ws + WS_MOD) + (size_t)l * NMODV * MODW;
        const unsigned char* wl = ws + WS_WT + (size_t)l * W_LAYER;

        if (PHM(0) && IN(pb + 0)) { LAUNDER(Fl); norm_phase(Fl, xin_lat, xin_ctx, MTOT, p.in[I_NMG] + l * DM, modl, 0, DM, H); }
        SEAM(pb + 0);
        if (PHM(1) && IN(pb + 1)) { pg8::Gemm g{H, (const hf*)(wl + W_IN1), MTOT, NP1, DM, DM, DM}; pg8::StaticOrder S; S.init(MTOT, NP1, F.G, (int)blockIdx.x);
            pg8::EpiHalf<0> E{P1, NP1}; pg8::gemm_phase(F.lds, g, S, E); }
        SEAM(pb + 1);
        if (PHM(2) && IN(pb + 2)) { LAUNDER(Fl); prep_rows(Fl, p, l); prep_hyena(Fl, p, l); }
        SEAM(pb + 2);
        if (PHM(3) && IN(pb + 3)) { pg8::Gemm g{QKVN, (const hf*)(wl + W_UP), MTOT, NUP, KUP, KUP, KUP}; pg8::StaticOrder S; S.init(MTOT, NUP, F.G, (int)blockIdx.x);
            pg8::EpiHalf<0> E{QKV, NUP}; pg8::gemm_phase(F.lds, g, S, E); }
        SEAM(pb + 3);
        if (PHM(4) && IN(pb + 4)) {
            LAUNDER(Fl);
            const int n_mla = 2048 + (ctx_live ? 256 : 0);
            if (PHM(13)) for (int id = F.vcu; id < n_mla; id += F.G) {
                if (id < 2048) { const int qb = id & 7, h = (id >> 3) & 7, b = id >> 6; att::attn_unit<true>(Fl, p, l, h, b * SEQ + qb * 256, qb * 256, b * SEQ, 32, NLAT + b * CTXL); }
                else { const int i2 = id - 2048, h = i2 & 7, b = i2 >> 3; att::attn_unit<true>(Fl, p, l, h, NLAT + b * CTXL, -1, 0, 0, NLAT + b * CTXL); }
            }
            const int n_df = 1024 + (ctx_live ? 128 : 0);
            if (PHM(14)) for (int id = F.vcu; id < n_df; id += F.G) {
                if (id < 1024) { const int qb = id & 7, h = (id >> 3) & 3, b = id >> 5; att::attn_unit<false>(Fl, p, l, h, b * SEQ + qb * 256, qb * 256, b * SEQ, 32, NLAT + b * CTXL); }
                else { const int i2 = id - 1024, h = i2 & 3, b = i2 >> 2; att::attn_unit<false>(Fl, p, l, h, NLAT + b * CTXL, -1, 0, 0, NLAT + b * CTXL); }
            }
            if (PHM(15)) for (int c = F.vcu; c < 256; c += F.G)
                hyena_unit<SEQ>(Fl, (const hf*)(ws + WS_RF) + ((size_t)l * 256 + c) * 4096, (const hf*)(ws + A_UT) + (size_t)c * NLAT, (const hf*)(ws + A_X0T) + (size_t)c * NLAT, Y + 512 + c);
            if (PHM(16) && ctx_live) for (int c = F.vcu; c < 256; c += F.G)
                hyena_unit<CTXL>(Fl, (const hf*)(ws + WS_RFC) + ((size_t)l * 256 + c) * 512, (const hf*)(ws + A_UTC) + (size_t)c * NCTX, (const hf*)(ws + A_X0TC) + (size_t)c * NCTX, Y + (size_t)NLAT * DM + 512 + c);
            __syncthreads();
        }
        SEAM(pb + 4);
        if (PHM(5) && IN(pb + 5)) { pg8::Gemm g{H, (const hf*)(wl + W_ING), Mrows, NGATE, DM, DM, DM}; pg8::StaticOrder S; S.init(Mrows, NGATE, F.G, (int)blockIdx.x);
            pg8::EpiHalf<1> E{Gt, NGATE}; pg8::gemm_phase(F.lds, g, S, E); }
        SEAM(pb + 5);
        if (PHM(6) && IN(pb + 6)) { pg8::StaticOrder S; S.init(Mrows, DM, F.G, (int)blockIdx.x); const hf* wbr = (const hf*)(wl + W_BR);
            { pg8::Gemm g{Y, wbr, Mrows, DM, 512, DM, DM}; pg8::EpiGated<true> E{MM, Gt, 0}; pg8::gemm_phase(F.lds, g, S, E); }
            { pg8::Gemm g{Y + 512, wbr + 512, Mrows, DM, 256, DM, DM}; pg8::EpiGated<false> E{MM, Gt, 1024}; pg8::gemm_phase(F.lds, g, S, E); }
            { pg8::Gemm g{Y + 768, wbr + 768, Mrows, DM, 256, DM, DM}; pg8::EpiGated<false> E{MM, Gt, 2048}; pg8::gemm_phase(F.lds, g, S, E); } }
        SEAM(pb + 6);
        if (PHM(7) && IN(pb + 7)) { pg8::Gemm g{MM, (const hf*)(wl + W_OUT), Mrows, DM, DM, DM, DM}; pg8::StaticOrder S; S.init(Mrows, DM, F.G, (int)blockIdx.x);
            pg8::EpiResid E{xin_lat, xin_ctx, X, XC, modl + 2 * DM}; pg8::gemm_phase(F.lds, g, S, E); }
        SEAM(pb + 7);
        if (PHM(8) && IN(pb + 8)) { LAUNDER(Fl); norm_phase(Fl, X, XC, Mrows, p.in[I_NFG] + l * DM, modl, 3 * DM, 4 * DM, H); }
        SEAM(pb + 8);
        if (PHM(9) && IN(pb + 9)) { pg8::Gemm g{H, (const hf*)(wl + W_FC1), Mrows, DFF, DM, DM, DM}; pg8::StaticOrder S; S.init(Mrows, DFF, F.G, (int)blockIdx.x);
            pg8::EpiHalf<2> E{HID, DFF}; pg8::gemm_phase(F.lds, g, S, E); }
        SEAM(pb + 9);
        if (PHM(10) && IN(pb + 10)) { pg8::Gemm g{HID, (const hf*)(wl + W_FC2), Mrows, DM, DFF, DFF, DFF}; pg8::StaticOrder S; S.init(Mrows, DM, F.G, (int)blockIdx.x);
            pg8::EpiResid E{X, XC, X, XC, modl + 5 * DM}; pg8::gemm_phase(F.lds, g, S, E); }
        SEAM(pb + 10);
    }
    if (PHM(12) && IN(NPHASE - 1)) { LAUNDER(Fl); final_norm_phase(Fl, X, p.in[I_FNG]); }
#undef IN
#undef SEAM
}

extern "C" void kernel_launch(void* const* d_in, const int* in_sizes, int n_in, void* d_out, int out_size, void* d_ws, size_t ws_size, hipStream_t stream) {
    static int grid = 0;
    if (grid == 0) {
        if (n_in != 35 || in_sizes[0] != NLAT * DM || out_size != NLAT * DM || ws_size < WS_END) {
            fprintf(stderr, "kernel_launch: unexpected shapes: n_in %d in0 %d out %d ws %zu (need %zu); nothing launched\n", n_in, n_in > 0 ? in_sizes[0] : -1, out_size, ws_size, (size_t)WS_END); grid = -1; return; }
        int dev = 0, cus = 0, per_cu = 0;
        if (hipGetDevice(&dev) != hipSuccess || hipDeviceGetAttribute(&cus, hipDeviceAttributeMultiprocessorCount, dev) != hipSuccess) { fprintf(stderr, "kernel_launch: device query failed\n"); grid = -1; return; }
        if (hipFuncSetAttribute((const void*)fwd_kernel, hipFuncAttributeMaxDynamicSharedMemorySize, LDS_BYTES) != hipSuccess) { fprintf(stderr, "kernel_launch: hipFuncSetAttribute failed\n"); grid = -1; return; }
        if (hipOccupancyMaxActiveBlocksPerMultiprocessor(&per_cu, (const void*)fwd_kernel, 512, LDS_BYTES) != hipSuccess || per_cu < 1)
            fprintf(stderr, "kernel_launch: note: occupancy query reports %d workgroups per CU\n", per_cu);
        (void)hipGetLastError();
        grid = cus;
    }
    if (grid < 0) return;
    if (hipMemsetAsync((char*)d_ws + WS_BAR, 0, WS_BAR_BYTES, stream) != hipSuccess) { fprintf(stderr, "kernel_launch: memset failed\n"); return; }
    Params P{};
    for (int i = 0; i < 35; ++i) P.in[i] = (const float*)d_in[i];
    P.out = (float*)d_out; P.ws = (unsigned char*)d_ws;
#if MK_FUSED
    P.ph_lo = 0; P.ph_hi = NPHASE;
    hipLaunchKernelGGL(fwd_kernel, dim3(grid), dim3(512), LDS_BYTES, stream, P);
#else
    for (int ph = 0; ph < NPHASE; ++ph) { P.ph_lo = ph; P.ph_hi = ph + 1; hipLaunchKernelGGL(fwd_kernel, dim3(grid), dim3(512), LDS_BYTES, stream, P); }
#endif
    const hipError_t le = hipPeekAtLastError();
    if (le != hipSuccess) fprintf(stderr, "kernel_launch: launch failed: %s\n", hipGetErrorName(le));
}
```

```cpp
#include <hip/hip_runtime.h>
#include <cstdio>
#include <cstdint>

#ifndef MK_FUSED
#define MK_FUSED 1
#endif

#define LAS __attribute__((address_space(3)))
#define GAS __attribute__((address_space(1)))
typedef _Float16 hf;
typedef _Float16 hf2 __attribute__((ext_vector_type(2)));
typedef _Float16 hf4 __attribute__((ext_vector_type(4)));
typedef _Float16 hf8 __attribute__((ext_vector_type(8)));
typedef short s16x4 __attribute__((ext_vector_type(4)));
typedef float f32x2 __attribute__((ext_vector_type(2)));
typedef float f32x4 __attribute__((ext_vector_type(4)));
typedef float f32x16 __attribute__((ext_vector_type(16)));
typedef unsigned u32x2 __attribute__((ext_vector_type(2)));
typedef unsigned u32x4 __attribute__((ext_vector_type(4)));

constexpr int DM = 1024, NB = 32, SEQ = 2048, DEPTH = 4, CTXL = 256, GRIDW = 64;
constexpr int NLAT = NB * SEQ;
constexpr int NCTX = NB * CTXL;
constexpr int MTOT = NLAT + NCTX;
constexpr int D_IN = 5024, NP1 = 2048  , NGATE = 3072, DFF = 4096;
constexpr int C_PQ = 0, C_PKV = 256, C_PKR = 384, C_HY = 416, C_DQ = 1184, C_DK = 1440, C_DV = 1696, C_PG = 1952;
constexpr int NUP = 1792, KUP = 384;
constexpr int NMODV = 33, MODW = 6 * DM;
constexpr float EPS = 1e-6f;
constexpr float MLA_SCALE = 0.10206207261596575f;
constexpr float DF_SCALE = 0.17677669529663687f;

constexpr size_t al256(size_t x) { return (x + 255) / 256 * 256; }
constexpr size_t WS_BAR = 0, WS_BAR_BYTES = 65536;
constexpr size_t WS_MOD = WS_BAR + WS_BAR_BYTES;
constexpr size_t WS_ROPE = WS_MOD + al256((size_t)DEPTH * NMODV * MODW * 4);
constexpr size_t WS_LAM = WS_ROPE + (size_t)SEQ * 32 * 4;
constexpr size_t WS_RF = WS_LAM + 256;
constexpr size_t WS_RFC = WS_RF + (size_t)DEPTH * 256 * 4096 * 2;
constexpr size_t WS_XC = WS_RFC + (size_t)DEPTH * 256 * 512 * 2;
constexpr size_t WS_WT = WS_XC + (size_t)NCTX * DM * 4;
constexpr size_t W_IN1 = 0, W_ING = W_IN1 + (size_t)NP1 * DM * 2, W_UP = W_ING + (size_t)NGATE * DM * 2, W_BR = W_UP + (size_t)NUP * KUP * 2,
                 W_OUT = W_BR + (size_t)DM * DM * 2, W_FC1 = W_OUT + (size_t)DM * DM * 2, W_FC2 = W_FC1 + (size_t)DFF * DM * 2, W_LAYER = W_FC2 + (size_t)DM * DFF * 2;
constexpr size_t WS_ARENA = WS_WT + DEPTH * W_LAYER;
constexpr size_t SZ_ROW1024 = (size_t)MTOT * 1024 * 2;
constexpr size_t A_H = WS_ARENA;
constexpr size_t A_Y = A_H + SZ_ROW1024;
constexpr size_t A_BIG = A_Y + SZ_ROW1024;
constexpr size_t A_P1 = A_BIG;
constexpr size_t A_QKV = A_BIG;
constexpr size_t A_QKVN = A_P1 + (size_t)MTOT * NP1 * 2;
constexpr size_t A_KR = A_QKVN + (size_t)MTOT * KUP * 2;
constexpr size_t A_DQ = A_KR + (size_t)MTOT * 32 * 2;
constexpr size_t A_DK = A_DQ + (size_t)MTOT * 256 * 2;
constexpr size_t A_DV = A_DK + (size_t)MTOT * 256 * 2;
constexpr size_t A_UT = A_DV + (size_t)MTOT * 256 * 2;
constexpr size_t A_X0T = A_UT + (size_t)256 * NLAT * 2;
constexpr size_t A_UTC = A_X0T + (size_t)256 * NLAT * 2;
constexpr size_t A_X0TC = A_UTC + (size_t)256 * NCTX * 2;
constexpr size_t A_BIG_END = A_X0TC + (size_t)256 * NCTX * 2;
constexpr size_t A_G = A_BIG;
constexpr size_t A_HID = A_Y;
constexpr size_t WS_END = (A_BIG_END > A_HID + (size_t)MTOT * DFF * 2) ? A_BIG_END : A_HID + (size_t)MTOT * DFF * 2;
static_assert(A_G + (size_t)MTOT * NGATE * 2 <= A_BIG_END + ((size_t)1 << 40), "map");
static_assert(WS_END <= (size_t)1024 * 1024 * 1024, "workspace map exceeds 1 GiB");

constexpr int LDS_BYTES = 147456;
constexpr int LDS_MISC = LDS_BYTES - 64;

__device__ __forceinline__ unsigned pkh(float lo, float hi) { f32x2 v = {lo, hi}; hf2 h = __builtin_convertvector(v, hf2); return __builtin_bit_cast(unsigned, h); }
__device__ __forceinline__ float wave_sum(float v) {
#pragma unroll
    for (int o = 1; o < 64; o <<= 1) v += __shfl_xor(v, o);
    return v;
}
#define LDS_WAIT() asm volatile("s_waitcnt lgkmcnt(0)" ::: "memory")
#define VM_WAIT() asm volatile("s_waitcnt vmcnt(0)" ::: "memory")

#define XB_TMO      128
#define XB_XCNT(j)  (256  + 64 * (j))
#define XB_XSUB(j)  (1280 + 64 * (j))
#define XB_XGEN(j)  (2304 + 64 * (j))
#define XB_TOP      3328
#define XB_TOPGEN   3392
#define XCD_BAR_WORDS 3456
#define XB_SPIN_CAP (1u << 22)
__device__ __forceinline__ unsigned xb_ld(unsigned* p)              { return __hip_atomic_load(p, __ATOMIC_RELAXED, __HIP_MEMORY_SCOPE_AGENT); }
__device__ __forceinline__ unsigned xb_add(unsigned* p, unsigned v) { return __hip_atomic_fetch_add(p, v, __ATOMIC_RELAXED, __HIP_MEMORY_SCOPE_AGENT); }
__device__ __forceinline__ unsigned xb_xcc_id() { return (unsigned)__builtin_amdgcn_s_getreg((3 << 11) | 20) & 0xFu; }
#define XB_SPIN(cond, bar) do { unsigned _sp = 0; while (cond) { __builtin_amdgcn_s_sleep(1); \
    if ((++_sp & 255u) == 0u) { if (xb_ld(&(bar)[XB_TMO])) break; if (_sp > XB_SPIN_CAP) { atomicAdd(&(bar)[XB_TMO], 1u); break; } } } } while (0)
struct XcdBarrier { unsigned* bar; unsigned x; volatile LAS unsigned* st; };
__device__ __forceinline__ XcdBarrier xcd_barrier_post(unsigned* bar, volatile LAS unsigned* st) {
    XcdBarrier b; b.bar = bar; b.x = xb_xcc_id(); b.st = st;
    if (threadIdx.x == 0) (void)xb_add(&bar[XB_XCNT(b.x)], 1u);
    return b;
}
__device__ __forceinline__ void xcd_barrier_complete(unsigned* bar, unsigned x, unsigned& nloc, unsigned& nx) {
    const unsigned G = gridDim.x * gridDim.y * gridDim.z;
    unsigned sum, cnt, mine, sp = 0u;
    for (;;) {
        sum = 0u; cnt = 0u; mine = 0u;
#pragma unroll
        for (unsigned j = 0; j < 16; ++j) { const unsigned c = xb_ld(&bar[XB_XCNT(j)]); sum += c; cnt += (c > 0u) ? 1u : 0u; mine = (j == x) ? c : mine; }
        if (sum == G) break;
        __builtin_amdgcn_s_sleep(1);
        if ((++sp & 255u) == 0u) { if (xb_ld(&bar[XB_TMO])) break; if (sp > XB_SPIN_CAP) { atomicAdd(&bar[XB_TMO], 1u); break; } }
    }
    nloc = mine > 0u ? mine : 1u; nx = cnt > 0u ? cnt : 1u;
}
__device__ __forceinline__ void xcd_barrier(const XcdBarrier& b) {
    asm volatile("s_waitcnt vmcnt(0)" ::: "memory");
    __syncthreads();
    if (threadIdx.x == 0) {
        unsigned* bar = b.bar;
        __builtin_amdgcn_s_waitcnt(0);
        unsigned nloc = b.st[0], nx = b.st[1];
        if (nloc == 0u) { xcd_barrier_complete(bar, b.x, nloc, nx); b.st[0] = nloc; b.st[1] = nx; }
        const unsigned old = xb_add(&bar[XB_XSUB(b.x)], 1u);
        const unsigned gen = old / nloc;
        if (old + 1u == (gen + 1u) * nloc) {
            __builtin_amdgcn_fence(__ATOMIC_RELEASE, "agent");
            asm volatile("s_waitcnt vmcnt(0)" ::: "memory");
            const unsigned og = xb_add(&bar[XB_TOP], 1u);
            const unsigned tg = og / nx;
            if (og + 1u == (tg + 1u) * nx) xb_add(&bar[XB_TOPGEN], 1u);
            else XB_SPIN(xb_ld(&bar[XB_TOPGEN]) == tg, bar);
            __builtin_amdgcn_fence(__ATOMIC_ACQUIRE, "agent");
            xb_add(&bar[XB_XGEN(b.x)], 1u);
            asm volatile("s_waitcnt vmcnt(0)" ::: "memory");
        } else {
            XB_SPIN(xb_ld(&bar[XB_XGEN(b.x)]) == gen, bar);
            __builtin_amdgcn_fence(__ATOMIC_ACQUIRE, "agent");
            asm volatile("s_waitcnt vmcnt(0)" ::: "memory");
        }
    }
    __syncthreads();
}

namespace pg8 {
constexpr int BM = 256, BK = 64, HALF = 128, HTB = HALF * BK * 2, STAGE_BYTES = 8 * HTB, NXCD = 8, WGM = 8;
__host__ __device__ __forceinline__ int lds_byte(int r, int c) { const int st = (r >> 4) * 2 + (c >> 5), rr = r & 15, cc = c & 31, ob = rr * 64 + cc * 2; return st * 1024 + (ob ^ (((ob >> 9) & 1) << 5)); }
__host__ __device__ __forceinline__ void stage_rc(int b, int& R, int& C) { const int st = b / 1024, sb = b % 1024, swz = sb ^ (((sb >> 9) & 1) << 5); R = (st >> 1) * 16 + swz / 64; C = (st & 1) * 32 + (swz % 64) / 2; }
__host__ __device__ __forceinline__ int perm32(int rho) { const int n = rho >> 4, i = rho & 15; return 8 * (i >> 2) + 4 * n + (i & 3); }
struct Unit { int pm, pn; };
struct Gemm { const hf* A; const hf* Bt; int M, N, K, lda, ldb; };
struct StaticOrder {
    int nM, nN, nwg, G, c;
    __host__ __device__ void init(int M, int N, int G_, int c_) { nM = M / BM; nN = N / BM; nwg = nM * nN; G = G_; c = c_; }
    __host__ __device__ bool next(int i, Unit& u) const {
        const long L = (long)i * G + c; if (L >= nwg) return false;
        int wgid = (int)L; { const int q = nwg / NXCD, r = nwg % NXCD, xcd = wgid % NXCD, off = wgid / NXCD; wgid = (xcd < r ? xcd * (q + 1) : r * (q + 1) + (xcd - r) * q) + off; }
        const int nig = WGM * nN, gid = wgid / nig, fm = gid * WGM, gsz = (nM - fm) < WGM ? (nM - fm) : WGM;
        u.pm = fm + ((wgid % nig) % gsz); u.pn = (wgid % nig) / gsz; return true;
    }
    __device__ __forceinline__ void a_ready(const Unit&) const {}
    __device__ __forceinline__ void done(const Unit&) const {}
};

template <int ACT  > struct EpiHalf {
    static constexpr bool PERM = true, AFTER_DRAIN = false, PROBE2 = (ACT != 0);
    hf* O; int ldc;
    __device__ __forceinline__ void operator()(const f32x4 (&acc)[2][2][4][2], const Unit& u, int wr, int wc, int fr, int fq) const {
        const int row0 = u.pm * BM + wr * 64 + fr, col0 = u.pn * BM + wc * 32 + 8 * fq;
#pragma unroll
        for (int ai = 0; ai < 2; ++ai)
#pragma unroll
            for (int m = 0; m < 4; ++m) { hf* rowp = O + (size_t)(row0 + ai * HALF + m * 16) * ldc + col0;
#pragma unroll
                for (int bj = 0; bj < 2; ++bj) { f32x4 v0 = acc[ai][bj][m][0], v1 = acc[ai][bj][m][1];
                    if (ACT == 1) {
#pragma unroll
                        for (int e = 0; e < 4; ++e) { v0[e] = __builtin_amdgcn_rcpf(1.f + __builtin_amdgcn_exp2f(-1.4426950408889634f * v0[e])); v1[e] = __builtin_amdgcn_rcpf(1.f + __builtin_amdgcn_exp2f(-1.4426950408889634f * v1[e])); } }
                    if (ACT == 2) {
#pragma unroll
                        for (int e = 0; e < 4; ++e) { const float a = fmaxf(v0[e], 0.f), b = fmaxf(v1[e], 0.f); v0[e] = a * a; v1[e] = b * b; } }
                    u32x4 w; w.x = pkh(v0[0], v0[1]); w.y = pkh(v0[2], v0[3]); w.z = pkh(v1[0], v1[1]); w.w = pkh(v1[2], v1[3]);
                    *(u32x4*)(rowp + bj * HALF) = w; } }
    }
};
template <bool FIRST> struct EpiGated {
    static constexpr bool PERM = true, AFTER_DRAIN = false, PROBE2 = false;
    hf* MMo; const hf* G; int goff;
    __device__ __forceinline__ void operator()(const f32x4 (&acc)[2][2][4][2], const Unit& u, int wr, int wc, int fr, int fq) const {
        const int row0 = u.pm * BM + wr * 64 + fr, col0 = u.pn * BM + wc * 32 + 8 * fq;
#pragma unroll
        for (int ai = 0; ai < 2; ++ai)
#pragma unroll
            for (int m = 0; m < 4; ++m) { const size_t r = (size_t)(row0 + ai * HALF + m * 16);
#pragma unroll
                for (int bj = 0; bj < 2; ++bj) { const f32x4 v0 = acc[ai][bj][m][0], v1 = acc[ai][bj][m][1];
                    const hf8 g = *(const hf8*)(G + r * NGATE + goff + col0 + bj * HALF);
                    hf* mp = MMo + r * DM + col0 + bj * HALF;
                    float o[8];
#pragma unroll
                    for (int e = 0; e < 4; ++e) { o[e] = (float)g[e] * v0[e]; o[4 + e] = (float)g[4 + e] * v1[e]; }
                    if (!FIRST) { const hf8 p = *(const hf8*)mp;
#pragma unroll
                        for (int e = 0; e < 8; ++e) o[e] += (float)p[e]; }
                    u32x4 w; w.x = pkh(o[0], o[1]); w.y = pkh(o[2], o[3]); w.z = pkh(o[4], o[5]); w.w = pkh(o[6], o[7]);
                    *(u32x4*)mp = w; } }
    }
};
struct EpiResid {
    static constexpr bool PERM = false, AFTER_DRAIN = false, PROBE2 = false;
    const float* xs_lat; const float* xs_ctx; float* xd_lat; float* xd_ctx; const float* gate;
    __device__ __forceinline__ void operator()(const f32x4 (&acc)[2][2][4][2], const Unit& u, int wr, int wc, int fr, int fq) const {
        const int R0 = u.pm * BM; const bool lat = R0 < NLAT;
        const int v = lat ? (R0 >> 11) : NB;
        const int rloc = (lat ? R0 : R0 - NLAT) + wr * 64 + fr, col0 = u.pn * BM + wc * 32 + 4 * fq;
        const float* src = lat ? xs_lat : xs_ctx; float* dst = lat ? xd_lat : xd_ctx; const float* gp = gate + (size_t)v * MODW + col0;
        f32x4 gv[2][2];
#pragma unroll
        for (int bj = 0; bj < 2; ++bj)
#pragma unroll
            for (int n = 0; n < 2; ++n) gv[bj][n] = *(const f32x4*)(gp + bj * HALF + n * 16);
#pragma unroll
        for (int ai = 0; ai < 2; ++ai)
#pragma unroll
            for (int m = 0; m < 4; ++m) { const size_t off = (size_t)(rloc + ai * HALF + m * 16) * DM + col0;
#pragma unroll
                for (int bj = 0; bj < 2; ++bj)
#pragma unroll
                    for (int n = 0; n < 2; ++n) { const f32x4 x = *(const f32x4*)(src + off + bj * HALF + n * 16);
                        *(f32x4*)(dst + off + bj * HALF + n * 16) = x + gv[bj][n] * acc[ai][bj][m][n]; } }
    }
};

template <class Epi, class Sched, bool ALIGN_EPI = true>
__device__ __forceinline__ void gemm_phase(LAS unsigned char* lds, const Gemm g, const Sched& S, const Epi& E) {
    int tid = threadIdx.x; asm volatile("" : "+v"(tid));
    const int wid = __builtin_amdgcn_readfirstlane(tid >> 6), lane = tid & 63, wr = wid >> 2, wc = wid & 3, fr = lane & 15, fq = lane >> 4;
    const int K = g.K, nt = K / BK;
    unsigned voffA[2], voffB[2];
#pragma unroll
    for (int i = 0; i < 2; ++i) { int R, C; stage_rc(tid * 16 + i * 8192, R, C); const int Rb = Epi::PERM ? ((R & ~31) + perm32(R & 31)) : R;
        voffA[i] = (unsigned)(R * g.lda + C) * 2u; voffB[i] = (unsigned)(Rb * g.ldb + C) * 2u; }
    const size_t kstep = (size_t)(BK * 2);
    const size_t hstepA = (size_t)HALF * g.lda * 2, hstepB = (size_t)HALF * g.ldb * 2;
    const size_t tstepA = 2 * hstepA, tstepB = 2 * hstepB;
    const unsigned ldsw = (unsigned)wid * 1024u;
    const int aoff = lds_byte(wr * 64 + fr, fq * 8), boff = lds_byte(wc * 32 + fr, fq * 8);
#define PG8_SA(b, h) (((b) * 2 + (h)) * HTB)
#define PG8_SB(b, h) ((4 + (b) * 2 + (h)) * HTB)
#define PG8_STAGE(bufoff, gbase, voff) do { _Pragma("unroll") for (int _i = 0; _i < 2; ++_i) \
        __builtin_amdgcn_global_load_lds((const unsigned*)((const char*)(gbase) + (voff)[_i]), (LAS unsigned*)(lds + (bufoff) + ldsw + _i * 8192), 16, 0, 0); } while (0)
#define PG8_LDA(dst, b, h) do { _Pragma("unroll") for (int m = 0; m < 4; ++m) _Pragma("unroll") for (int k = 0; k < 2; ++k) dst[m][k] = *(const LAS hf8*)(lds + PG8_SA(b, h) + aoff + m * 2048 + k * 1024); } while (0)
#define PG8_LDB(dst, b, h) do { _Pragma("unroll") for (int n = 0; n < 2; ++n) _Pragma("unroll") for (int k = 0; k < 2; ++k) dst[n][k] = *(const LAS hf8*)(lds + PG8_SB(b, h) + boff + n * 2048 + k * 1024); } while (0)
#define PG8_MMA(ai, bj, At, Bt) do { __builtin_amdgcn_s_setprio(1); _Pragma("unroll") for (int m = 0; m < 4; ++m) _Pragma("unroll") for (int n = 0; n < 2; ++n) _Pragma("unroll") for (int k = 0; k < 2; ++k) \
        acc[ai][bj][m][n] = __builtin_amdgcn_mfma_f32_16x16x32_f16(Bt[n][k], At[m][k], acc[ai][bj][m][n], 0, 0, 0); __builtin_amdgcn_s_setprio(0); } while (0)
#define PG8_WAIT_V(n) asm volatile("s_waitcnt vmcnt(" #n ")" ::: "memory")
#define PG8_WAIT_L(n) asm volatile("s_waitcnt lgkmcnt(" #n ")" ::: "memory")
#define PG8_BAR __builtin_amdgcn_s_barrier()
#define PG8_SCHED __builtin_amdgcn_sched_barrier(0)
    Unit cur, nxt; int ui = 0;
    if (!S.next(0, cur)) return;
    f32x4 acc[2][2][4][2];
#pragma unroll
    for (int a = 0; a < 2; ++a)
#pragma unroll
        for (int b = 0; b < 2; ++b)
#pragma unroll
            for (int m = 0; m < 4; ++m)
#pragma unroll
                for (int n = 0; n < 2; ++n) acc[a][b][m][n] = (f32x4){0.f, 0.f, 0.f, 0.f};
    hf8 At[4][2], B0[2][2], B1[2][2];
    const char* cA = (const char*)g.A + (size_t)cur.pm * tstepA; const char* cB = (const char*)g.Bt + (size_t)cur.pn * tstepB;
    S.a_ready(cur);
    PG8_STAGE(PG8_SB(0, 0), cB, voffB); PG8_STAGE(PG8_SB(0, 1), cB + hstepB, voffB); PG8_STAGE(PG8_SA(0, 0), cA, voffA); PG8_STAGE(PG8_SA(0, 1), cA + hstepA, voffA);
    if (wr == 1) PG8_BAR;
    PG8_WAIT_V(2); PG8_BAR;
    PG8_STAGE(PG8_SB(1, 0), cB + kstep, voffB); PG8_STAGE(PG8_SA(1, 0), cA + kstep, voffA); PG8_STAGE(PG8_SB(1, 1), cB + hstepB + kstep, voffB);
    PG8_WAIT_V(6); PG8_BAR;
    for (;;) {
        const bool has_next = S.next(ui + 1, nxt);
        const char* nA = has_next ? (const char*)g.A + (size_t)nxt.pm * tstepA : cA; const char* nB = has_next ? (const char*)g.Bt + (size_t)nxt.pn * tstepB : cB;
#pragma unroll 1
        for (int t = 0; t < nt; t += 2) {
            const bool last = (t == nt - 2);
            const char* a1 = cA + (size_t)(t + 1) * kstep;
            const char* a2 = last ? nA : cA + (size_t)(t + 2) * kstep; const char* b2 = last ? nB : cB + (size_t)(t + 2) * kstep;
            const char* a3 = a2 + kstep; const char* b3 = b2 + kstep;
            if (last && has_next) S.a_ready(nxt);
            PG8_LDB(B0, 0, 0); PG8_LDB(B1, 0, 1); PG8_SCHED; PG8_LDA(At, 0, 0); PG8_STAGE(PG8_SA(1, 1), a1 + hstepA, voffA);
            PG8_WAIT_V(8); PG8_WAIT_L(0); PG8_BAR; PG8_MMA(0, 0, At, B0); PG8_MMA(0, 1, At, B1); PG8_BAR; PG8_SCHED;
            PG8_LDA(At, 0, 1); PG8_STAGE(PG8_SB(0, 0), b2, voffB); PG8_STAGE(PG8_SB(0, 1), b2 + hstepB, voffB); PG8_STAGE(PG8_SA(0, 0), a2, voffA);
            PG8_WAIT_V(8); PG8_WAIT_L(0); PG8_BAR; PG8_MMA(1, 0, At, B0); PG8_MMA(1, 1, At, B1); PG8_BAR; PG8_SCHED;
            PG8_LDB(B0, 1, 0); PG8_LDB(B1, 1, 1); PG8_SCHED; PG8_LDA(At, 1, 0); PG8_STAGE(PG8_SA(0, 1), a2 + hstepA, voffA);
            PG8_WAIT_V(8); PG8_WAIT_L(0); PG8_BAR; PG8_MMA(0, 0, At, B0); PG8_MMA(0, 1, At, B1); PG8_BAR; PG8_SCHED;
            PG8_LDA(At, 1, 1); PG8_STAGE(PG8_SB(1, 0), b3, voffB); PG8_STAGE(PG8_SB(1, 1), b3 + hstepB, voffB); PG8_STAGE(PG8_SA(1, 0), a3, voffA);
            PG8_WAIT_V(8); PG8_WAIT_L(0); PG8_BAR; PG8_MMA(1, 0, At, B0); PG8_MMA(1, 1, At, B1); PG8_BAR; PG8_SCHED;
        }
        if constexpr (ALIGN_EPI) { if (wr == 0) PG8_BAR; }
        E(acc, cur, wr, wc, fr, fq); S.done(cur);
#ifdef PROBE_EPI2
        if (Epi::PROBE2) { asm volatile("" ::: "memory"); E(acc, cur, wr, wc, fr, fq); }
#endif
        if (!has_next) break;
#pragma unroll
        for (int a = 0; a < 2; ++a)
#pragma unroll
            for (int b = 0; b < 2; ++b)
#pragma unroll
                for (int m = 0; m < 4; ++m)
#pragma unroll
                    for (int n = 0; n < 2; ++n) acc[a][b][m][n] = (f32x4){0.f, 0.f, 0.f, 0.f};
        cur = nxt; cA = nA; cB = nB; ++ui;
        if constexpr (ALIGN_EPI) { if (wr == 1) PG8_BAR; }
    }
    PG8_WAIT_V(0);
    if constexpr (!ALIGN_EPI) { if (wr == 0) PG8_BAR; }
    PG8_BAR;
#undef PG8_SA
#undef PG8_SB
#undef PG8_STAGE
#undef PG8_LDA
#undef PG8_LDB
#undef PG8_MMA
#undef PG8_WAIT_V
#undef PG8_WAIT_L
#undef PG8_BAR
#undef PG8_SCHED
}
}

struct Params {
    const float* in[35];
    float* out;
    unsigned char* ws;
    int ph_lo, ph_hi;
};
enum { I_X = 0, I_C, I_CTX, I_CCTX, I_NMG, I_NFG, I_WMOD, I_BMOD, I_WIN, I_QNG, I_WUQ, I_KVNG, I_WUKV, I_HCW, I_HCB, I_HW1, I_HB1, I_HFREQ, I_HW2, I_HB2, I_HW3, I_HB3,
       I_HSKIP, I_LQ1, I_LK1, I_LQ2, I_LK2, I_SUBG, I_WBRA, I_WBRB, I_WBRC, I_WOUT, I_FC1, I_FC2, I_FNG };

struct Frame {
    LAS unsigned char* lds;
    int tid, lane, wave, vcu, G;
};

__device__ __forceinline__ void tr_item(const float* W, int ldw, hf* WT, int ldt, int nblk, LAS float* scr, int item, int lane) {
    const int kb = item / nblk, nb = item % nblk, k0 = 64 * kb, n0 = 32 * nb;
#pragma unroll 8
    for (int i = 0; i < 32; ++i) { const int kk = 2 * i + (lane >> 5); scr[kk * 33 + (lane & 31)] = W[(size_t)(k0 + kk) * ldw + n0 + (lane & 31)]; }
    LDS_WAIT(); asm volatile("" ::: "memory");
    const int c = lane & 7;
#pragma unroll
    for (int j = 0; j < 4; ++j) { const int n = (lane >> 3) + 8 * j; const LAS float* s = scr + (8 * c) * 33 + n;
        u32x4 o; o.x = pkh(s[0 * 33], s[1 * 33]); o.y = pkh(s[2 * 33], s[3 * 33]); o.z = pkh(s[4 * 33], s[5 * 33]); o.w = pkh(s[6 * 33], s[7 * 33]);
        *(u32x4*)(WT + (size_t)(n0 + n) * ldt + k0 + 8 * c) = o; }
    LDS_WAIT(); asm volatile("" ::: "memory");
}
__device__ __forceinline__ float silu_f(float x) { return x / (1.f + expf(-x)); }

__device__ __forceinline__ void mod_phase(const Frame& F, const Params& p) {
    float* MOD = (float*)(p.ws + WS_MOD);
    LAS float* sv = (LAS float*)F.lds;
    constexpr int NCB = DEPTH * MODW / 512;
    for (int item = F.vcu; item < NCB * 3; item += F.G) {
        const int cb = item / 3, vg = item % 3;
        __syncthreads();
        for (int i = F.tid; i < 11 * 1024; i += 512) { const int v = vg * 11 + i / 1024, k = i % 1024;
            const float c = (v < NB) ? p.in[I_C][v * DM + k] : p.in[I_CCTX][k]; sv[i] = silu_f(c); }
        __syncthreads();
        const int gcol = cb * 512 + F.tid, l = gcol / MODW, n = gcol % MODW;
        const float* w = p.in[I_WMOD] + (size_t)l * DM * MODW + n;
        float acc[11];
#pragma unroll
        for (int v = 0; v < 11; ++v) acc[v] = 0.f;
        for (int k = 0; k < DM; k += 4) {
            const float w0 = w[(size_t)k * MODW], w1 = w[(size_t)(k + 1) * MODW], w2 = w[(size_t)(k + 2) * MODW], w3 = w[(size_t)(k + 3) * MODW];
#pragma unroll
            for (int v = 0; v < 11; ++v) { const f32x4 s = *(const LAS f32x4*)(sv + v * 1024 + k);
                acc[v] = fmaf(s[0], w0, acc[v]); acc[v] = fmaf(s[1], w1, acc[v]); acc[v] = fmaf(s[2], w2, acc[v]); acc[v] = fmaf(s[3], w3, acc[v]); }
        }
        const float bm = p.in[I_BMOD][(size_t)l * MODW + n];
#pragma unroll
        for (int v = 0; v < 11; ++v) MOD[((size_t)l * NMODV + vg * 11 + v) * MODW + n] = acc[v] + bm;
    }
    __syncthreads();
}

__device__ __forceinline__ void filt_item(const Params& p, int l, int kind  , int t, int lane) {
    const int L = kind ? CTXL : SEQ;
    hf* R = kind ? (hf*)(p.ws + WS_RFC) + (size_t)l * 256 * 512 : (hf*)(p.ws + WS_RF) + (size_t)l * 256 * 4096;
    const int rl = 2 * L;
    const float tl = (float)t / (float)(L - 1);
    const float wt = (6.283185307179586f / (float)L) * (float)t;
    float z = 0.f;
    if (lane == 0) z = tl;
    else if (lane <= 32) { const int bi = (lane - 1) & 15; const float band = 1e-4f + (15.f - 1e-4f) * ((float)bi / 15.f); const float a = band * wt; z = (lane <= 16) ? cosf(a) : -sinf(a); }
    const float* w1 = p.in[I_HW1] + (size_t)l * 33 * 64; const float* w2 = p.in[I_HW2] + (size_t)l * 64 * 64; const float* w3 = p.in[I_HW3] + (size_t)l * 64 * 512;
    const float fr = p.in[I_HFREQ][l * 64 + lane];
    float a1 = p.in[I_HB1][l * 64 + lane];
    for (int i = 0; i < 33; ++i) a1 = fmaf(__shfl(z, i), w1[i * 64 + lane], a1);
    a1 = sinf(fr * a1);
    float a2 = p.in[I_HB2][l * 64 + lane];
    for (int i = 0; i < 64; ++i) a2 = fmaf(__shfl(a1, i), w2[i * 64 + lane], a2);
    a2 = sinf(fr * a2);
    float h[8];
#pragma unroll
    for (int q = 0; q < 8; ++q) h[q] = p.in[I_HB3][l * 512 + q * 64 + lane];
    for (int i = 0; i < 64; ++i) { const float a = __shfl(a2, i);
#pragma unroll
        for (int q = 0; q < 8; ++q) h[q] = fmaf(a, w3[i * 512 + q * 64 + lane], h[q]); }
    const float d0 = -4.605170185988091f / 1.5f, d1 = -4.605170185988091f / 0.3f;
#pragma unroll
    for (int q = 0; q < 8; ++q) { const int o = q * 64 + lane, dir = o >> 8, c = o & 255;
        const float delta = fabsf(d0 + (d1 - d0) * ((float)c / 255.f));
        float val = h[q] * (expf(-tl * delta) + 0.05f);
        if (dir == 0) { if (t == 0) val += p.in[I_HSKIP][l * 256 + c]; R[(size_t)c * rl + (L - t)] = (hf)val; if (t == 0) R[(size_t)c * rl] = (hf)0.f; }
        else if (t >= 1) R[(size_t)c * rl + (L + t)] = (hf)val; }
}

__device__ __forceinline__ void prologue_phase(const Frame& F, const Params& p) {
    mod_phase(F, p);
    LAS float* scr = (LAS float*)(F.lds + F.wave * 16384);
    const int gw = F.vcu * 8 + F.wave, NGW = F.G * 8, lane = F.lane;
    constexpr int IT_IN1 = 16 * 61, IT_ING = 16 * 96, IT_UQ = 4 * 24, IT_UKV = 2 * 32, IT_BRA = 8 * 32, IT_BRB = 4 * 32, IT_BRC = 4 * 32, IT_OUT = 16 * 32, IT_FC1 = 16 * 128, IT_FC2 = 64 * 32;
    constexpr int IT_LAYER = IT_IN1 + IT_ING + IT_UQ + IT_UKV + IT_BRA + IT_BRB + IT_BRC + IT_OUT + IT_FC1 + IT_FC2;
    for (int it = gw; it < DEPTH * IT_LAYER; it += NGW) {
        const int l = it / IT_LAYER; int r = it % IT_LAYER;
        unsigned char* wl = p.ws + WS_WT + (size_t)l * W_LAYER;
        if (r < IT_IN1) { tr_item(p.in[I_WIN] + (size_t)l * DM * D_IN, D_IN, (hf*)(wl + W_IN1), DM, 61, scr, r, lane); continue; } r -= IT_IN1;
        if (r < IT_ING) { tr_item(p.in[I_WIN] + (size_t)l * DM * D_IN + C_PG, D_IN, (hf*)(wl + W_ING), DM, 96, scr, r, lane); continue; } r -= IT_ING;
        if (r < IT_UQ) { tr_item(p.in[I_WUQ] + (size_t)l * 256 * 768, 768, (hf*)(wl + W_UP), KUP, 24, scr, r, lane); continue; } r -= IT_UQ;
        if (r < IT_UKV) { tr_item(p.in[I_WUKV] + (size_t)l * 128 * 1024, 1024, (hf*)(wl + W_UP) + (size_t)768 * KUP + 256, KUP, 32, scr, r, lane); continue; } r -= IT_UKV;
        if (r < IT_BRA) { tr_item(p.in[I_WBRA] + (size_t)l * 512 * DM, DM, (hf*)(wl + W_BR), DM, 32, scr, r, lane); continue; } r -= IT_BRA;
        if (r < IT_BRB) { tr_item(p.in[I_WBRB] + (size_t)l * 256 * DM, DM, (hf*)(wl + W_BR) + 512, DM, 32, scr, r, lane); continue; } r -= IT_BRB;
        if (r < IT_BRC) { tr_item(p.in[I_WBRC] + (size_t)l * 256 * DM, DM, (hf*)(wl + W_BR) + 768, DM, 32, scr, r, lane); continue; } r -= IT_BRC;
        if (r < IT_OUT) { tr_item(p.in[I_WOUT] + (size_t)l * DM * DM, DM, (hf*)(wl + W_OUT), DM, 32, scr, r, lane); continue; } r -= IT_OUT;
        if (r < IT_FC1) { tr_item(p.in[I_FC1] + (size_t)l * DM * DFF, DFF, (hf*)(wl + W_FC1), DM, 128, scr, r, lane); continue; } r -= IT_FC1;
        tr_item(p.in[I_FC2] + (size_t)l * DFF * DM, DM, (hf*)(wl + W_FC2), DFF, 32, scr, r, lane);
    }
    {
        const int gt = gw * 64 + lane, NGT = NGW * 64;
        for (int l = 0; l < DEPTH; ++l) {
            unsigned char* wl = p.ws + WS_WT + (size_t)l * W_LAYER;
            u32x4* z1 = (u32x4*)((hf*)(wl + W_IN1) + (size_t)C_PG * DM);
            for (int i = gt; i < 96 * DM / 8; i += NGT) z1[i] = (u32x4){0u, 0u, 0u, 0u};
            hf* up = (hf*)(wl + W_UP);
            for (int i = gt; i < 768 * 16; i += NGT) { const int n = i / 16, k8 = i % 16; *(u32x4*)(up + (size_t)n * KUP + 256 + k8 * 8) = (u32x4){0u, 0u, 0u, 0u}; }
            for (int i = gt; i < 1024 * 32; i += NGT) { const int n = 768 + i / 32, k8 = i % 32; *(u32x4*)(up + (size_t)n * KUP + k8 * 8) = (u32x4){0u, 0u, 0u, 0u}; }
        }
    }
    for (int it = gw; it < DEPTH * (SEQ + CTXL); it += NGW) { const int l = it / (SEQ + CTXL), r = it % (SEQ + CTXL); if (r < SEQ) filt_item(p, l, 0, r, lane); else filt_item(p, l, 1, r - SEQ, lane); }
    {
        float* rope = (float*)(p.ws + WS_ROPE);
        const int gt = gw * 64 + lane, NGT = NGW * 64;
        for (int i = gt; i < SEQ * 16; i += NGT) { const int t = i >> 4, j = i & 15; const float pos = (j < 8) ? (float)(t / GRIDW) : (float)(t % GRIDW);
            const float inv = powf(10000.f, -(float)(j & 7) / 8.f); const float a = pos * inv; rope[t * 32 + j] = cosf(a); rope[t * 32 + 16 + j] = sinf(a); }
        if (gt < DEPTH) { const int l = gt; float s1 = 0.f, s2 = 0.f;
            for (int i = 0; i < 32; ++i) { s1 += p.in[I_LQ1][l * 32 + i] * p.in[I_LK1][l * 32 + i]; s2 += p.in[I_LQ2][l * 32 + i] * p.in[I_LK2][l * 32 + i]; }
            const float li = 0.8f - 0.6f * expf(-0.3f * (float)l);
            float* lam = (float*)(p.ws + WS_LAM); lam[2 * l] = expf(s1) - expf(s2) + li; lam[2 * l + 1] = 1.f - li; }
    }
}

__device__ __forceinline__ void norm_phase(const Frame& F, const float* xs_lat, const float* xs_ctx, int nrows, const float* gain, const float* modl, int sh_off, int sc_off, hf* H) {
    const int gw = F.vcu * 8 + F.wave, NGW = F.G * 8, lane = F.lane;
    f32x4 g[4];
#pragma unroll
    for (int j = 0; j < 4; ++j) g[j] = *(const f32x4*)(gain + 4 * lane + 256 * j);
    for (int row = gw; row < nrows; row += NGW) {
        const bool lat = row < NLAT; const float* xr = lat ? xs_lat + (size_t)row * DM : xs_ctx + (size_t)(row - NLAT) * DM;
        const int v = lat ? (row >> 11) : NB; const float* mv = modl + (size_t)v * MODW;
        f32x4 x[4]; float ss = 0.f;
#pragma unroll
        for (int j = 0; j < 4; ++j) { x[j] = *(const f32x4*)(xr + 4 * lane + 256 * j); ss += (x[j][0] * x[j][0] + x[j][1] * x[j][1]) + (x[j][2] * x[j][2] + x[j][3] * x[j][3]); }
        const float rstd = rsqrtf(wave_sum(ss) * (1.f / DM) + EPS);
        hf* hr = H + (size_t)row * DM;
#pragma unroll
        for (int j = 0; j < 4; ++j) { const f32x4 sh = *(const f32x4*)(mv + sh_off + 4 * lane + 256 * j), sc = *(const f32x4*)(mv + sc_off + 4 * lane + 256 * j);
            const f32x4 y = (x[j] * rstd) * g[j]; const f32x4 o = y * (sc + 1.f) + sh;
            u32x2 w; w.x = pkh(o[0], o[1]); w.y = pkh(o[2], o[3]); *(u32x2*)(hr + 4 * lane + 256 * j) = w; }
    }
}
__device__ __forceinline__ void final_norm_phase(const Frame& F, float* X, const float* gain) {
    const int gw = F.vcu * 8 + F.wave, NGW = F.G * 8, lane = F.lane;
    f32x4 g[4];
#pragma unroll
    for (int j = 0; j < 4; ++j) g[j] = *(const f32x4*)(gain + 4 * lane + 256 * j);
    for (int row = gw; row < NLAT; row += NGW) {
        float* xr = X + (size_t)row * DM; f32x4 x[4]; float ss = 0.f;
#pragma unroll
        for (int j = 0; j < 4; ++j) { x[j] = *(const f32x4*)(xr + 4 * lane + 256 * j); ss += (x[j][0] * x[j][0] + x[j][1] * x[j][1]) + (x[j][2] * x[j][2] + x[j][3] * x[j][3]); }
        const float rstd = rsqrtf(wave_sum(ss) * (1.f / DM) + EPS);
#pragma unroll
        for (int j = 0; j < 4; ++j) *(f32x4*)(xr + 4 * lane + 256 * j) = (x[j] * rstd) * g[j];
    }
}

__device__ __forceinline__ void prep_rows(const Frame& F, const Params& p, int l) {
    const int gw = F.vcu * 8 + F.wave, NGW = F.G * 8, lane = F.lane;
    const hf* P1 = (const hf*)(p.ws + A_P1); hf* QKVN = (hf*)(p.ws + A_QKVN); hf* KR = (hf*)(p.ws + A_KR); hf* DQ = (hf*)(p.ws + A_DQ); hf* DK = (hf*)(p.ws + A_DK); hf* DV = (hf*)(p.ws + A_DV);
    const float* rope = (const float*)(p.ws + WS_ROPE);
    const f32x4 gq = *(const f32x4*)(p.in[I_QNG] + l * 256 + 4 * lane);
    const f32x2 gkv = *(const f32x2*)(p.in[I_KVNG] + l * 128 + 2 * lane);
    for (int row = gw; row < MTOT; row += NGW) {
        const hf* pr = P1 + (size_t)row * NP1; const bool lat = row < NLAT; const int t = row & (SEQ - 1);
        {
            const hf4 a = *(const hf4*)(pr + C_PQ + 4 * lane); f32x4 x = {(float)a[0], (float)a[1], (float)a[2], (float)a[3]};
            const float rstd = rsqrtf(wave_sum((x[0] * x[0] + x[1] * x[1]) + (x[2] * x[2] + x[3] * x[3])) * (1.f / 256.f) + EPS);
            x = (x * rstd) * gq; u32x2 w; w.x = pkh(x[0], x[1]); w.y = pkh(x[2], x[3]); *(u32x2*)(QKVN + (size_t)row * KUP + 4 * lane) = w; }
        {
            const hf2 a = *(const hf2*)(pr + C_PKV + 2 * lane); f32x2 x = {(float)a[0], (float)a[1]};
            const float rstd = rsqrtf(wave_sum(x[0] * x[0] + x[1] * x[1]) * (1.f / 128.f) + EPS);
            x = (x * rstd) * gkv; *(unsigned*)(QKVN + (size_t)row * KUP + 256 + 2 * lane) = pkh(x[0], x[1]); }
        {
            *(u32x2*)(DQ + (size_t)row * 256 + 4 * lane) = *(const u32x2*)(pr + C_DQ + 4 * lane);
            *(u32x2*)(DV + (size_t)row * 256 + 4 * lane) = *(const u32x2*)(pr + C_DV + 4 * lane); }
        {
            const int hh = lane >> 3, i0 = 2 * (lane & 7);
            const hf2 a = *(const hf2*)(pr + C_DK + hh * 32 + i0), b = *(const hf2*)(pr + C_DK + hh * 32 + 16 + i0);
            float x1[2] = {(float)a[0], (float)a[1]}, x2[2] = {(float)b[0], (float)b[1]}, o1[2], o2[2];
#pragma unroll
            for (int e = 0; e < 2; ++e) { const float c = lat ? rope[t * 32 + i0 + e] : 1.f, s = lat ? rope[t * 32 + 16 + i0 + e] : 0.f; o1[e] = x1[e] * c - x2[e] * s; o2[e] = x2[e] * c + x1[e] * s; }
            *(unsigned*)(DK + (size_t)row * 256 + hh * 32 + i0) = pkh(o1[0], o1[1]); *(unsigned*)(DK + (size_t)row * 256 + hh * 32 + 16 + i0) = pkh(o2[0], o2[1]); }
        if (lane < 16) {
            const float x1 = (float)pr[C_PKR + lane], x2 = (float)pr[C_PKR + 16 + lane];
            const float c = lat ? rope[t * 32 + lane] : 1.f, s = lat ? rope[t * 32 + 16 + lane] : 0.f;
            KR[(size_t)row * 32 + lane] = (hf)(x1 * c - x2 * s); KR[(size_t)row * 32 + 16 + lane] = (hf)(x2 * c + x1 * s); }
    }
}
__device__ __forceinline__ void prep_hyena(const Frame& F, const Params& p, int l) {
    const int gw = F.vcu * 8 + F.wave, NGW = F.G * 8, lane = F.lane;
    const hf* P1 = (const hf*)(p.ws + A_P1);
    LAS hf* tile = (LAS hf*)(F.lds + F.wave * 9216);
    const float* cw = p.in[I_HCW] + (size_t)l * 3 * 768; const float* cb = p.in[I_HCB] + (size_t)l * 768;
    constexpr int IT_LAT = 2 * NB * (SEQ / 64) * 4, IT_CTX = 2 * NB * (CTXL / 64) * 4;
    for (int it = gw; it < IT_LAT + IT_CTX; it += NGW) {
        const bool ctx = it >= IT_LAT; int r = ctx ? it - IT_LAT : it; const int L = ctx ? CTXL : SEQ, ntile = L / 64;
        const int cg = r & 3; r >>= 2; const int tt = r % ntile; r /= ntile; const int b = r % NB; const int which = r / NB;
        const int c = cg * 64 + lane, t0 = tt * 64; const size_t rowbase = ctx ? (size_t)NLAT + (size_t)b * CTXL : (size_t)b * SEQ;
        hf* dst = ctx ? (hf*)(p.ws + (which ? A_X0TC : A_UTC)) : (hf*)(p.ws + (which ? A_X0T : A_UT));
        if (which == 1) {
            const int col = C_HY + c; const float w0 = cw[c], w1 = cw[768 + c], w2 = cw[1536 + c], bb = cb[c];
            float prev = (t0 > 0) ? (float)P1[(rowbase + t0 - 1) * NP1 + col] : 0.f, cur = (float)P1[(rowbase + t0) * NP1 + col];
#pragma unroll 8
            for (int t = 0; t < 64; ++t) { const int tn = t0 + t + 1; const float nxt = (tn < L) ? (float)P1[(rowbase + tn) * NP1 + col] : 0.f;
                tile[lane * 72 + t] = (hf)(w0 * prev + w1 * cur + w2 * nxt + bb); prev = cur; cur = nxt; }
        } else {
            const int c1 = C_HY + 256 + c, c2 = C_HY + 512 + c;
            const float a0 = cw[256 + c], a1 = cw[768 + 256 + c], a2 = cw[1536 + 256 + c], ab = cb[256 + c];
            const float v0 = cw[512 + c], v1 = cw[768 + 512 + c], v2 = cw[1536 + 512 + c], vb = cb[512 + c];
            float pa = (t0 > 0) ? (float)P1[(rowbase + t0 - 1) * NP1 + c1] : 0.f, ca = (float)P1[(rowbase + t0) * NP1 + c1];
            float pv = (t0 > 0) ? (float)P1[(rowbase + t0 - 1) * NP1 + c2] : 0.f, cv = (float)P1[(rowbase + t0) * NP1 + c2];
#pragma unroll 8
            for (int t = 0; t < 64; ++t) { const int tn = t0 + t + 1; const bool in = tn < L;
                const float na = in ? (float)P1[(rowbase + tn) * NP1 + c1] : 0.f, nv = in ? (float)P1[(rowbase + tn) * NP1 + c2] : 0.f;
                const float x1 = a0 * pa + a1 * ca + a2 * na + ab, vv = v0 * pv + v1 * cv + v2 * nv + vb;
                tile[lane * 72 + t] = (hf)(vv * x1); pa = ca; ca = na; pv = cv; cv = nv; }
        }
        LDS_WAIT(); asm volatile("" ::: "memory");
#pragma unroll
        for (int q = 0; q < 8; ++q) { const int ch = q * 8 + (lane >> 3), pc = lane & 7;
            const u32x4 v = *(const LAS u32x4*)(tile + ch * 72 + pc * 8);
            *(u32x4*)(dst + ((size_t)(cg * 64 + ch) * NB + b) * L + t0 + pc * 8) = v; }
        LDS_WAIT(); asm volatile("" ::: "memory");
    }
}

namespace att {
__device__ __forceinline__ int crow(int r, int hi) { return (r & 3) + 8 * (r >> 2) + 4 * hi; }
#define SBAR() __builtin_amdgcn_sched_barrier(0)
constexpr float THR2 = 8.f * 1.4426950408889634f;
constexpr int KS_MLA = 208, KS_DF = 80;
constexpr int VS = 144, VB = 64 * VS;
constexpr int OFF_V = 32768;
__device__ __forceinline__ int kpos(int key) { return (key & ~0xC) | ((key & 4) << 1) | ((key & 8) >> 1); }

template <int ND0, int KS>
__device__ __forceinline__ void qkt(f32x16& p0, f32x16& p1, const LAS unsigned char* Ks, const hf8* qr, int r32, int hi) {
    p0 = f32x16{}; p1 = f32x16{};
#pragma unroll
    for (int d0 = 0; d0 < ND0; ++d0) { const int cb = (d0 * 16 + hi * 8) * 2;
        const hf8 b0 = *(const LAS hf8*)(Ks + r32 * KS + cb), b1 = *(const LAS hf8*)(Ks + (32 + r32) * KS + cb);
        p0 = __builtin_amdgcn_mfma_f32_32x32x16_f16(b0, qr[d0], p0, 0, 0, 0); p1 = __builtin_amdgcn_mfma_f32_32x32x16_f16(b1, qr[d0], p1, 0, 0, 0); }
}
__device__ __forceinline__ float max3f(float a, float b, float c) { float r; asm("v_max3_f32 %0, %1, %2, %3" : "=v"(r) : "v"(a), "v"(b), "v"(c)); return r; }
__device__ __forceinline__ float max2f(float a, float b) { float r; asm("v_max_f32_e32 %0, %1, %2" : "=v"(r) : "v"(a), "v"(b)); return r; }
__device__ __forceinline__ hf8 pack8(const f32x16& p, int b) { u32x4 w = {pkh(p[b], p[b + 1]), pkh(p[b + 2], p[b + 3]), pkh(p[b + 4], p[b + 5]), pkh(p[b + 6], p[b + 7])}; return __builtin_bit_cast(hf8, w); }
__device__ __forceinline__ void sm_max(const f32x16& p0, const f32x16& p1, float& m, float& l, f32x16& o0, f32x16& o1, const bool first) {
    float pmax = max3f(p0[0], p1[0], p0[1]);
#pragma unroll
    for (int r = 1; r < 15; ++r) pmax = max3f(pmax, p1[r], p0[r + 1]);
    pmax = max2f(pmax, p1[15]);
    { auto rr = __builtin_amdgcn_permlane32_swap(__float_as_uint(pmax), __float_as_uint(pmax), false, false);
      pmax = max2f(__uint_as_float(rr[0]), __uint_as_float(rr[1])); }
    if (first || __any(pmax - m > THR2)) {
        const float mn = first ? pmax : max2f(m, pmax);
        if (!first) { const float alpha = __builtin_amdgcn_exp2f(m - mn); l *= alpha;
#pragma unroll
            for (int r = 0; r < 16; ++r) { o0[r] *= alpha; o1[r] *= alpha; } }
        m = mn;
    }
}
__device__ __forceinline__ void sm_exp_pv(f32x16& p0, f32x16& p1, const float m, float& l, f32x16& o0, f32x16& o1, const LAS unsigned char* Vt, int r32, int hi) {
#pragma unroll
    for (int r = 0; r < 16; ++r) { p0[r] -= m; p1[r] -= m; }
#pragma unroll
    for (int r = 0; r < 16; ++r) { p0[r] = __builtin_amdgcn_exp2f(p0[r]); p1[r] = __builtin_amdgcn_exp2f(p1[r]); }
    float ps = 0.f;
#pragma unroll
    for (int r = 0; r < 16; ++r) ps += p0[r] + p1[r];
    l += ps;
    const hf8 pf0 = pack8(p0, 0), pf1 = pack8(p0, 8), pf2 = pack8(p1, 0), pf3 = pack8(p1, 8);
    const LAS unsigned char* vr = Vt + r32 * VS + hi * 16;
#define PVK(ks, pf) do { const hf8 a0 = *(const LAS hf8*)(vr + (ks) * 32), a1 = *(const LAS hf8*)(vr + 32 * VS + (ks) * 32); \
        o0 = __builtin_amdgcn_mfma_f32_32x32x16_f16(a0, pf, o0, 0, 0, 0); o1 = __builtin_amdgcn_mfma_f32_32x32x16_f16(a1, pf, o1, 0, 0, 0); } while (0)
    PVK(0, pf0); PVK(1, pf1); PVK(2, pf2); PVK(3, pf3);
#undef PVK
}

template <bool MLA>
__device__ __forceinline__ void attn_pass(const Frame& F, const Params& p, int hq, int hv, int qrow0, int qpos0, int klat0, int nlat, int kctx0, f32x16& o0, f32x16& o1, float& inv) {
    constexpr int DK = MLA ? 96 : 32, ND0 = DK / 16, KS = MLA ? KS_MLA : KS_DF, KB = 64 * KS;
    constexpr float SCALE = MLA ? MLA_SCALE : DF_SCALE, C = SCALE * 1.4426950408889634f;
    const int tid = F.tid, wid = F.wave, lane = F.lane, r32 = lane & 31, hi = lane >> 5;
    const hf* QKV = (const hf*)(p.ws + A_QKV); const hf* KRb = (const hf*)(p.ws + A_KR);
    const hf* DQ = (const hf*)(p.ws + A_DQ); const hf* DKb = (const hf*)(p.ws + A_DK); const hf* DVb = (const hf*)(p.ws + A_DV);
    const float* rope = (const float*)(p.ws + WS_ROPE);
    LAS unsigned char* lds = F.lds;
    hf8 qr[ND0];
    {
        const int qrow = qrow0 + wid * 32 + r32;
        const hf* qp = MLA ? QKV + (size_t)qrow * NUP + hq * 96 + hi * 8 : DQ + (size_t)qrow * 256 + hq * 32 + hi * 8;
        hf8 raw[ND0];
#pragma unroll
        for (int d0 = 0; d0 < ND0; ++d0) raw[d0] = *(const hf8*)(qp + d0 * 16);
        f32x4 c0 = {1.f, 1.f, 1.f, 1.f}, c1 = c0, s0 = {0.f, 0.f, 0.f, 0.f}, s1 = s0;
        if (qpos0 >= 0) { const int t = qpos0 + wid * 32 + r32;
            c0 = *(const f32x4*)(rope + t * 32 + hi * 8); c1 = *(const f32x4*)(rope + t * 32 + hi * 8 + 4);
            s0 = *(const f32x4*)(rope + t * 32 + 16 + hi * 8); s1 = *(const f32x4*)(rope + t * 32 + 16 + hi * 8 + 4); }
#pragma unroll
        for (int d0 = 0; d0 < ND0 - 2; ++d0) {
#pragma unroll
            for (int j = 0; j < 8; ++j) qr[d0][j] = (hf)((float)raw[d0][j] * C); }
#pragma unroll
        for (int j = 0; j < 8; ++j) { const float cc = j < 4 ? c0[j & 3] : c1[j & 3], sn = j < 4 ? s0[j & 3] : s1[j & 3]; const float a = (float)raw[ND0 - 2][j], b = (float)raw[ND0 - 1][j];
            qr[ND0 - 2][j] = (hf)((a * cc - b * sn) * C); qr[ND0 - 1][j] = (hf)((b * cc + a * sn) * C); }
    }
    const int k1r = MLA ? (tid >> 3) : ((tid & 255) >> 2), k1c = MLA ? (tid & 7) * 8 : (tid & 3) * 8;
    const int k2r = (tid & 255) >> 2, k2c = (tid & 3) * 8;
    const int vkp = kpos(lane) * 2 + wid * 8 * VS;
    const bool klo = tid < 256;
    struct Stg { u32x4 v, k1, k2; };
    Stg sA, sB; sA.v = sA.k1 = sA.k2 = sB.v = sB.k1 = sB.k2 = (u32x4){0u, 0u, 0u, 0u};
    const int ntile = nlat + 4;
#define KROW0(j) (((j) < nlat) ? klat0 + (j) * 64 : kctx0 + ((j) - nlat) * 64)
#define A_LOADK(S, j) do { const int kr0 = KROW0(j); \
        if (MLA) { S.k1 = *(const u32x4*)(QKV + (size_t)(kr0 + k1r) * NUP + 768 + hq * 128 + k1c); S.k2 = *(const u32x4*)(KRb + (size_t)(kr0 + k2r) * 32 + k2c); } \
        else S.k1 = *(const u32x4*)(DKb + (size_t)(kr0 + k1r) * 256 + hq * 32 + k1c); } while (0)
#define A_LOADV(S, j) do { const int kr0 = KROW0(j); \
        if (MLA) S.v = *(const u32x4*)(QKV + (size_t)(kr0 + lane) * NUP + 768 + hv * 128 + 64 + wid * 8); else S.v = *(const u32x4*)(DVb + (size_t)(kr0 + lane) * 256 + hv * 64 + wid * 8); } while (0)
#define A_WRITEK(S, b) do { if (MLA) { *(LAS u32x4*)(lds + (b) * KB + k1r * KS + k1c * 2) = S.k1; if (klo) *(LAS u32x4*)(lds + (b) * KB + k2r * KS + 128 + k2c * 2) = S.k2; } \
        else if (klo) *(LAS u32x4*)(lds + (b) * KB + k1r * KS + k1c * 2) = S.k1; } while (0)
#define A_WRITEV(S, b) do { LAS unsigned short* vp = (LAS unsigned short*)(lds + OFF_V + (b) * VB + vkp); \
        vp[0 * (VS / 2)] = (unsigned short)(S.v[0] & 0xffffu); vp[1 * (VS / 2)] = (unsigned short)(S.v[0] >> 16); vp[2 * (VS / 2)] = (unsigned short)(S.v[1] & 0xffffu); vp[3 * (VS / 2)] = (unsigned short)(S.v[1] >> 16); \
        vp[4 * (VS / 2)] = (unsigned short)(S.v[2] & 0xffffu); vp[5 * (VS / 2)] = (unsigned short)(S.v[2] >> 16); vp[6 * (VS / 2)] = (unsigned short)(S.v[3] & 0xffffu); vp[7 * (VS / 2)] = (unsigned short)(S.v[3] >> 16); } while (0)
    float m_reg = 0.f, l_reg = 0.f;
    o0 = f32x16{}; o1 = f32x16{};
    f32x16 pA0, pA1, pB0, pB1;
    __syncthreads();
    A_LOADK(sA, 0); A_LOADV(sA, 0); A_LOADK(sB, 1);
    A_WRITEK(sA, 0); A_WRITEV(sA, 0); A_WRITEK(sB, 1);
    if (2 < ntile) A_LOADK(sA, 2);
    A_LOADV(sA, 1);
    __syncthreads();
    qkt<ND0, KS>(pA0, pA1, lds, qr, r32, hi);
    for (int j = 0; j < ntile; j += 2) {
        if (j + 3 < ntile) A_LOADK(sB, j + 3);
        if (j + 2 < ntile) A_LOADV(sB, j + 2);
        sm_max(pA0, pA1, m_reg, l_reg, o0, o1, j == 0);
        qkt<ND0, KS>(pB0, pB1, lds + KB, qr, r32, hi);
        sm_exp_pv(pA0, pA1, m_reg, l_reg, o0, o1, lds + OFF_V, r32, hi);
        if (j + 2 < ntile) A_WRITEK(sA, 0);
        A_WRITEV(sA, 1);
        __syncthreads();
        if (j + 4 < ntile) A_LOADK(sA, j + 4);
        if (j + 3 < ntile) A_LOADV(sA, j + 3);
        sm_max(pB0, pB1, m_reg, l_reg, o0, o1, false);
        if (j + 2 < ntile) qkt<ND0, KS>(pA0, pA1, lds, qr, r32, hi);
        sm_exp_pv(pB0, pB1, m_reg, l_reg, o0, o1, lds + OFF_V + VB, r32, hi);
        if (j + 3 < ntile) A_WRITEK(sB, 1);
        if (j + 2 < ntile) A_WRITEV(sB, 0);
        __syncthreads();
    }
#undef KROW0
#undef A_LOADK
#undef A_LOADV
#undef A_WRITEK
#undef A_WRITEV
    const float lt = l_reg + __shfl_xor(l_reg, 32); inv = __builtin_amdgcn_rcpf(lt);
}
template <bool MLA>
__device__ __forceinline__ void attn_unit(const Frame& F, const Params& p, int l, int h, int qrow0, int qpos0, int klat0, int nlat, int kctx0) {
    const int wid = F.wave, lane = F.lane, r32 = lane & 31, hi = lane >> 5;
    hf* Y = (hf*)(p.ws + A_Y);
    const size_t yrow = (size_t)(qrow0 + wid * 32 + r32) * DM;
    if constexpr (MLA) {
        f32x16 o0, o1; float inv;
        attn_pass<true>(F, p, h, h, qrow0, qpos0, klat0, nlat, kctx0, o0, o1, inv);
#pragma unroll
        for (int g = 0; g < 4; ++g) { u32x2 w; w.x = pkh(o0[4 * g] * inv, o0[4 * g + 1] * inv); w.y = pkh(o0[4 * g + 2] * inv, o0[4 * g + 3] * inv); *(u32x2*)(Y + yrow + h * 64 + 8 * g + 4 * hi) = w; }
#pragma unroll
        for (int g = 0; g < 4; ++g) { u32x2 w; w.x = pkh(o1[4 * g] * inv, o1[4 * g + 1] * inv); w.y = pkh(o1[4 * g + 2] * inv, o1[4 * g + 3] * inv); *(u32x2*)(Y + yrow + h * 64 + 32 + 8 * g + 4 * hi) = w; }
    } else {
        const float lam = ((const float*)(p.ws + WS_LAM))[2 * l], oml = ((const float*)(p.ws + WS_LAM))[2 * l + 1];
        f32x16 a0, a1;
        LAS float* park = (LAS float*)(F.lds + 65536 + wid * 8192) + lane;
        { f32x16 o0, o1; float inv; attn_pass<false>(F, p, 2 * h, h, qrow0, qpos0, klat0, nlat, kctx0, o0, o1, inv);
#pragma unroll
          for (int r = 0; r < 16; ++r) { park[r * 64] = o0[r] * inv; park[(16 + r) * 64] = o1[r] * inv; } }
        { f32x16 o0, o1; float inv; attn_pass<false>(F, p, 2 * h + 1, h, qrow0, qpos0, klat0, nlat, kctx0, o0, o1, inv);
#pragma unroll
          for (int r = 0; r < 16; ++r) { a0[r] = park[r * 64] - o0[r] * (lam * inv); a1[r] = park[(16 + r) * 64] - o1[r] * (lam * inv); } }
        float ss = 0.f;
#pragma unroll
        for (int r = 0; r < 16; ++r) ss += a0[r] * a0[r] + a1[r] * a1[r];
        ss += __shfl_xor(ss, 32);
        const float rs = rsqrtf(ss * (1.f / 64.f) + EPS) * oml;
#pragma unroll
        for (int g = 0; g < 4; ++g) { const f32x4 gg = *(const f32x4*)(p.in[I_SUBG] + l * 64 + 8 * g + 4 * hi);
            u32x2 w; w.x = pkh(a0[4 * g] * rs * gg[0], a0[4 * g + 1] * rs * gg[1]); w.y = pkh(a0[4 * g + 2] * rs * gg[2], a0[4 * g + 3] * rs * gg[3]); *(u32x2*)(Y + yrow + 768 + h * 64 + 8 * g + 4 * hi) = w; }
#pragma unroll
        for (int g = 0; g < 4; ++g) { const f32x4 gg = *(const f32x4*)(p.in[I_SUBG] + l * 64 + 32 + 8 * g + 4 * hi);
            u32x2 w; w.x = pkh(a1[4 * g] * rs * gg[0], a1[4 * g + 1] * rs * gg[1]); w.y = pkh(a1[4 * g + 2] * rs * gg[2], a1[4 * g + 3] * rs * gg[3]); *(u32x2*)(Y + yrow + 768 + h * 64 + 32 + 8 * g + 4 * hi) = w; }
    }
}
}

template <int L>
__device__ __forceinline__ void hyena_unit(const Frame& F, const hf* Rrow  , const hf* U  , const hf* X0  , hf* Ycol  ) {
    constexpr int NM = L / 256, RL = 2 * L, SH = (L > 1024) ? 1024 : L, NH = L / SH, US = SH * 2 + 16;
    constexpr int OFF_U = 8 * RL * 2;
    static_assert(OFF_U + 32 * US <= LDS_MISC, "hyena LDS");
    const int tid = F.tid, w = F.wave, lane = F.lane, i32 = lane & 31, hi = lane >> 5;
    LAS unsigned char* lds = F.lds;
    __syncthreads();
    for (int idx = tid; idx < 8 * RL; idx += 512) { const int cw = idx / RL, x = idx % RL; ((LAS hf*)lds)[idx] = (x >= cw) ? Rrow[x - cw] : (hf)0.f; }
    f32x16 acc[NM];
#pragma unroll
    for (int m = 0; m < NM; ++m) acc[m] = f32x16{};
    const LAS unsigned char* cpy = lds + w * (RL * 2);
    for (int half = 0; half < NH; ++half) {
        __syncthreads();
        for (int idx = tid; idx < 32 * (SH / 8); idx += 512) { const int b = idx / (SH / 8), pc = idx % (SH / 8);
            *(LAS u32x4*)(lds + OFF_U + b * US + pc * 16) = *(const u32x4*)(U + (size_t)b * L + half * SH + pc * 8); }
        __syncthreads();
#pragma unroll 2
        for (int jl = 0; jl < SH / 16; ++jl) {
            const int j = half * (SH / 16) + jl;
            const hf8 bf = *(const LAS hf8*)(lds + OFF_U + i32 * US + (jl * 16 + hi * 8) * 2);
            const int x0 = L + 16 * j + 8 * hi - 8 * i32;
#pragma unroll
            for (int m = 0; m < NM; ++m) { const hf8 af = *(const LAS hf8*)(cpy + (x0 - 256 * m) * 2);
                acc[m] = __builtin_amdgcn_mfma_f32_32x32x16_f16(af, bf, acc[m], 0, 0, 0); }
        }
    }
    const hf* x0p = X0 + (size_t)i32 * L + w + 32 * hi;
    hf* yp = Ycol + ((size_t)i32 * L + w + 32 * hi) * DM;
#pragma unroll
    for (int m = 0; m < NM; ++m) {
#pragma unroll
        for (int r = 0; r < 16; ++r) { const int tt = 256 * m + 8 * ((r & 3) + 8 * (r >> 2));
            const float x0v = (float)x0p[tt];
            yp[(size_t)tt * DM] = (hf)(x0v * acc[m][r]); }
        asm volatile("" ::: "memory");
    }
}

#ifndef PH_MASK
#define PH_MASK 0x1FFFF
#endif
#define PHM(k) ((PH_MASK >> (k)) & 1)
#ifndef PROBE_REP
#define PROBE_REP 0
#endif
#define NREP(k) (((PROBE_REP >> (k)) & 1) ? 2 : 1)
constexpr int NPH_LAYER = 11, NPHASE = 1 + DEPTH * NPH_LAYER + 1;
__global__ void __launch_bounds__(512, 2) fwd_kernel(Params p) {
    extern __shared__ __attribute__((aligned(16))) unsigned char lds_raw[];
    Frame F0; Frame& F = F0;
    F.lds = (LAS unsigned char*)lds_raw;
    F.tid = threadIdx.x; F.lane = F.tid & 63; F.wave = __builtin_amdgcn_readfirstlane(F.tid >> 6);
    F.G = gridDim.x; { const int bx = blockIdx.x; F.vcu = (F.G % 8 == 0) ? (bx % 8) * (F.G / 8) + bx / 8 : bx; }
    volatile LAS unsigned* misc = (volatile LAS unsigned*)(F.lds + LDS_MISC);
    if (F.tid < 16) misc[F.tid] = 0u;
    __syncthreads();
    const int lo = p.ph_lo, hi = p.ph_hi;
    XcdBarrier bar; bar.bar = (unsigned*)(p.ws + WS_BAR); bar.x = 0; bar.st = misc;
    if (hi - lo > 1) bar = xcd_barrier_post((unsigned*)(p.ws + WS_BAR), misc);
#define IN(k) (lo <= (k) && (k) < hi)
#define LAUNDER(Fl) Frame Fl = F0; asm volatile("" : "+v"(Fl.tid), "+v"(Fl.lane))
#define SEAM(k) do { if (IN(k) && IN((k) + 1)) xcd_barrier(bar); } while (0)
    unsigned char* ws = p.ws;
    float* X = p.out; float* XC = (float*)(ws + WS_XC);
    hf* H = (hf*)(ws + A_H); hf* Y = (hf*)(ws + A_Y); hf* P1 = (hf*)(ws + A_P1); hf* QKV = (hf*)(ws + A_QKV); hf* QKVN = (hf*)(ws + A_QKVN);
    hf* Gt = (hf*)(ws + A_G); hf* HID = (hf*)(ws + A_HID); hf* MM = H;

    if (PHM(11) && IN(0)) { LAUNDER(Fl); prologue_phase(Fl, p); }
    SEAM(0);

    for (int l = 0; l < DEPTH; ++l) {
        const int pb = 1 + l * NPH_LAYER;
        const bool ctx_live = l < DEPTH - 1;
        const int Mrows = ctx_live ? MTOT : NLAT;
        const float* xin_lat = (l == 0) ? p.in[I_X] : X; const float* xin_ctx = (l == 0) ? p.in[I_CTX] : XC;
        const float* modl = (const float*)(ws + WS_MOD) + (size_t)l * NMODV * MODW;
        const unsigned char* wl = ws + WS_WT + (size_t)l * W_LAYER;

        if (PHM(0) && IN(pb + 0)) for (int rep = 0; rep < NREP(0); ++rep) { LAUNDER(Fl); norm_phase(Fl, xin_lat, xin_ctx, MTOT, p.in[I_NMG] + l * DM, modl, 0, DM, H); }
        SEAM(pb + 0);
        if (PHM(1) && IN(pb + 1)) for (int rep = 0; rep < NREP(1); ++rep) { pg8::Gemm g{H, (const hf*)(wl + W_IN1), MTOT, NP1, DM, DM, DM}; pg8::StaticOrder S; S.init(MTOT, NP1, F.G, (int)blockIdx.x);
            pg8::EpiHalf<0> E{P1, NP1}; pg8::gemm_phase(F.lds, g, S, E); }
        SEAM(pb + 1);
        if (PHM(2) && IN(pb + 2)) for (int rep = 0; rep < NREP(2); ++rep) { LAUNDER(Fl); prep_rows(Fl, p, l); prep_hyena(Fl, p, l); }
        SEAM(pb + 2);
        if (PHM(3) && IN(pb + 3)) for (int rep = 0; rep < NREP(3); ++rep) { pg8::Gemm g{QKVN, (const hf*)(wl + W_UP), MTOT, NUP, KUP, KUP, KUP}; pg8::StaticOrder S; S.init(MTOT, NUP, F.G, (int)blockIdx.x);
            pg8::EpiHalf<0> E{QKV, NUP}; pg8::gemm_phase(F.lds, g, S, E); }
        SEAM(pb + 3);
        if (PHM(4) && IN(pb + 4)) for (int rep = 0; rep < NREP(4); ++rep) {
            LAUNDER(Fl);
            const int n_mla = 2048 + (ctx_live ? 256 : 0);
            if (PHM(13)) for (int rp = 0; rp < NREP(13); ++rp) for (int id = F.vcu; id < n_mla; id += F.G) {
                if (id < 2048) { const int qb = id & 7, h = (id >> 3) & 7, b = id >> 6; att::attn_unit<true>(Fl, p, l, h, b * SEQ + qb * 256, qb * 256, b * SEQ, 32, NLAT + b * CTXL); }
                else { const int i2 = id - 2048, h = i2 & 7, b = i2 >> 3; att::attn_unit<true>(Fl, p, l, h, NLAT + b * CTXL, -1, 0, 0, NLAT + b * CTXL); }
            }
            const int n_df = 1024 + (ctx_live ? 128 : 0);
            if (PHM(14)) for (int rp = 0; rp < NREP(14); ++rp) for (int id = F.vcu; id < n_df; id += F.G) {
                if (id < 1024) { const int qb = id & 7, h = (id >> 3) & 3, b = id >> 5; att::attn_unit<false>(Fl, p, l, h, b * SEQ + qb * 256, qb * 256, b * SEQ, 32, NLAT + b * CTXL); }
                else { const int i2 = id - 1024, h = i2 & 3, b = i2 >> 2; att::attn_unit<false>(Fl, p, l, h, NLAT + b * CTXL, -1, 0, 0, NLAT + b * CTXL); }
            }
            if (PHM(15)) for (int rp = 0; rp < NREP(15); ++rp) for (int c = F.vcu; c < 256; c += F.G)
                hyena_unit<SEQ>(Fl, (const hf*)(ws + WS_RF) + ((size_t)l * 256 + c) * 4096, (const hf*)(ws + A_UT) + (size_t)c * NLAT, (const hf*)(ws + A_X0T) + (size_t)c * NLAT, Y + 512 + c);
            if (PHM(16) && ctx_live) for (int rp = 0; rp < NREP(15); ++rp) for (int c = F.vcu; c < 256; c += F.G)
                hyena_unit<CTXL>(Fl, (const hf*)(ws + WS_RFC) + ((size_t)l * 256 + c) * 512, (const hf*)(ws + A_UTC) + (size_t)c * NCTX, (const hf*)(ws + A_X0TC) + (size_t)c * NCTX, Y + (size_t)NLAT * DM + 512 + c);
            __syncthreads();
        }
        SEAM(pb + 4);
        if (PHM(5) && IN(pb + 5)) for (int rep = 0; rep < NREP(5); ++rep) { pg8::Gemm g{H, (const hf*)(wl + W_ING), Mrows, NGATE, DM, DM, DM}; pg8::StaticOrder S; S.init(Mrows, NGATE, F.G, (int)blockIdx.x);
            pg8::EpiHalf<1> E{Gt, NGATE}; pg8::gemm_phase(F.lds, g, S, E); }
        SEAM(pb + 5);
        if (PHM(6) && IN(pb + 6)) for (int rep = 0; rep < NREP(6); ++rep) { pg8::StaticOrder S; S.init(Mrows, DM, F.G, (int)blockIdx.x); const hf* wbr = (const hf*)(wl + W_BR);
            { pg8::Gemm g{Y, wbr, Mrows, DM, 512, DM, DM}; pg8::EpiGated<true> E{MM, Gt, 0}; pg8::gemm_phase(F.lds, g, S, E); }
            { pg8::Gemm g{Y + 512, wbr + 512, Mrows, DM, 256, DM, DM}; pg8::EpiGated<false> E{MM, Gt, 1024}; pg8::gemm_phase(F.lds, g, S, E); }
            { pg8::Gemm g{Y + 768, wbr + 768, Mrows, DM, 256, DM, DM}; pg8::EpiGated<false> E{MM, Gt, 2048}; pg8::gemm_phase(F.lds, g, S, E); } }
        SEAM(pb + 6);
        if (PHM(7) && IN(pb + 7)) { pg8::Gemm g{MM, (const hf*)(wl + W_OUT), Mrows, DM, DM, DM, DM}; pg8::StaticOrder S; S.init(Mrows, DM, F.G, (int)blockIdx.x);
            pg8::EpiResid E{xin_lat, xin_ctx, X, XC, modl + 2 * DM}; pg8::gemm_phase(F.lds, g, S, E); }
        SEAM(pb + 7);
        if (PHM(8) && IN(pb + 8)) for (int rep = 0; rep < NREP(8); ++rep) { LAUNDER(Fl); norm_phase(Fl, X, XC, Mrows, p.in[I_NFG] + l * DM, modl, 3 * DM, 4 * DM, H); }
        SEAM(pb + 8);
        if (PHM(9) && IN(pb + 9)) for (int rep = 0; rep < NREP(9); ++rep) { pg8::Gemm g{H, (const hf*)(wl + W_FC1), Mrows, DFF, DM, DM, DM}; pg8::StaticOrder S; S.init(Mrows, DFF, F.G, (int)blockIdx.x);
            pg8::EpiHalf<2> E{HID, DFF}; pg8::gemm_phase(F.lds, g, S, E); }
        SEAM(pb + 9);
        if (PHM(10) && IN(pb + 10)) { pg8::Gemm g{HID, (const hf*)(wl + W_FC2), Mrows, DM, DFF, DFF, DFF}; pg8::StaticOrder S; S.init(Mrows, DM, F.G, (int)blockIdx.x);
            pg8::EpiResid E{X, XC, X, XC, modl + 5 * DM}; pg8::gemm_phase(F.lds, g, S, E); }
        SEAM(pb + 10);
    }
    if (PHM(12) && IN(NPHASE - 1)) { LAUNDER(Fl); final_norm_phase(Fl, X, p.in[I_FNG]); }
#undef IN
#undef SEAM
}

extern "C" void kernel_launch(void* const* d_in, const int* in_sizes, int n_in, void* d_out, int out_size, void* d_ws, size_t ws_size, hipStream_t stream) {
    static int grid = 0;
    if (grid == 0) {
        if (n_in != 35 || in_sizes[0] != NLAT * DM || out_size != NLAT * DM || ws_size < WS_END) {
            fprintf(stderr, "kernel_launch: unexpected shapes: n_in %d in0 %d out %d ws %zu (need %zu); nothing launched\n", n_in, n_in > 0 ? in_sizes[0] : -1, out_size, ws_size, (size_t)WS_END); grid = -1; return; }
        int dev = 0, cus = 0, per_cu = 0;
        if (hipGetDevice(&dev) != hipSuccess || hipDeviceGetAttribute(&cus, hipDeviceAttributeMultiprocessorCount, dev) != hipSuccess) { fprintf(stderr, "kernel_launch: device query failed\n"); grid = -1; return; }
        if (hipFuncSetAttribute((const void*)fwd_kernel, hipFuncAttributeMaxDynamicSharedMemorySize, LDS_BYTES) != hipSuccess) { fprintf(stderr, "kernel_launch: hipFuncSetAttribute failed\n"); grid = -1; return; }
        if (hipOccupancyMaxActiveBlocksPerMultiprocessor(&per_cu, (const void*)fwd_kernel, 512, LDS_BYTES) != hipSuccess || per_cu < 1)
            fprintf(stderr, "kernel_launch: note: occupancy query reports %d workgroups per CU\n", per_cu);
        (void)hipGetLastError();
        grid = cus;
    }
    if (grid < 0) return;
    if (hipMemsetAsync((char*)d_ws + WS_BAR, 0, WS_BAR_BYTES, stream) != hipSuccess) { fprintf(stderr, "kernel_launch: memset failed\n"); return; }
    Params P{};
    for (int i = 0; i < 35; ++i) P.in[i] = (const float*)d_in[i];
    P.out = (float*)d_out; P.ws = (unsigned char*)d_ws;
#if MK_FUSED
    P.ph_lo = 0; P.ph_hi = NPHASE;
    hipLaunchKernelGGL(fwd_kernel, dim3(grid), dim3(512), LDS_BYTES, stream, P);
#else
    for (int ph = 0; ph < NPHASE; ++ph) { P.ph_lo = ph; P.ph_hi = ph + 1; hipLaunchKernelGGL(fwd_kernel, dim3(grid), dim3(512), LDS_BYTES, stream, P); }
#endif
    const hipError_t le = hipPeekAtLastError();
    if (le != hipSuccess) fprintf(stderr, "kernel_launch: launch failed: %s\n", hipGetErrorName(le));
}
```

```cpp
#include <hip/hip_runtime.h>
#include <cstdio>
#include <cstdint>

#ifndef MK_FUSED
#define MK_FUSED 1
#endif

#define LAS __attribute__((address_space(3)))
#define GAS __attribute__((address_space(1)))
typedef _Float16 hf;
typedef _Float16 hf2 __attribute__((ext_vector_type(2)));
typedef _Float16 hf4 __attribute__((ext_vector_type(4)));
typedef _Float16 hf8 __attribute__((ext_vector_type(8)));
typedef short s16x4 __attribute__((ext_vector_type(4)));
typedef float f32x2 __attribute__((ext_vector_type(2)));
typedef float f32x4 __attribute__((ext_vector_type(4)));
typedef float f32x16 __attribute__((ext_vector_type(16)));
typedef unsigned u32x2 __attribute__((ext_vector_type(2)));
typedef unsigned u32x4 __attribute__((ext_vector_type(4)));

constexpr int DM = 1024, NB = 32, SEQ = 2048, DEPTH = 4, CTXL = 256, GRIDW = 64;
constexpr int NLAT = NB * SEQ;
constexpr int NCTX = NB * CTXL;
constexpr int MTOT = NLAT + NCTX;
constexpr int D_IN = 5024, NP1 = 2048  , NGATE = 3072, DFF = 4096;
constexpr int C_PQ = 0, C_PKV = 256, C_PKR = 384, C_HY = 416, C_DQ = 1184, C_DK = 1440, C_DV = 1696, C_PG = 1952;
constexpr int NUP = 1792, KUP = 384;
constexpr int NMODV = 33, MODW = 6 * DM;
constexpr float EPS = 1e-6f;
constexpr float MLA_SCALE = 0.10206207261596575f;
constexpr float DF_SCALE = 0.17677669529663687f;

constexpr size_t al256(size_t x) { return (x + 255) / 256 * 256; }
constexpr size_t WS_BAR = 0, WS_BAR_BYTES = 65536;
constexpr size_t WS_SS = WS_BAR + WS_BAR_BYTES;
constexpr int SS_1 = 0, SS_2 = DEPTH, SS_F = 2 * DEPTH, SS_Q = 2 * DEPTH + 1, SS_KV = 3 * DEPTH + 1, SS_N = 4 * DEPTH + 1;
constexpr size_t WS_ZERO_BYTES = WS_BAR_BYTES + al256((size_t)SS_N * MTOT * 4);
constexpr size_t WS_MOD = WS_BAR + WS_ZERO_BYTES;
constexpr size_t WS_GS = WS_MOD + al256((size_t)DEPTH * NMODV * MODW * 4);
constexpr int NBIAS = 9216, B_IN = 0, B_G = 2048, B_FC1 = 5120;
constexpr size_t WS_BIAS = WS_GS + (size_t)DEPTH * 2 * NMODV * DM * 4;
constexpr size_t WS_ROPE = WS_BIAS + (size_t)DEPTH * NMODV * NBIAS * 4;
constexpr size_t WS_LAM = WS_ROPE + (size_t)SEQ * 32 * 4;
constexpr size_t WS_RF = WS_LAM + 256;
constexpr size_t WS_RFC = WS_RF + (size_t)DEPTH * 256 * 4096 * 2;
constexpr size_t WS_XC = WS_RFC + (size_t)DEPTH * 256 * 512 * 2;
constexpr size_t WS_WT = WS_XC + (size_t)NCTX * DM * 4;
constexpr size_t W_IN1 = 0, W_ING = W_IN1 + (size_t)NP1 * DM * 2, W_UP = W_ING + (size_t)NGATE * DM * 2, W_BR = W_UP + (size_t)NUP * KUP * 2,
                 W_OUT = W_BR + (size_t)DM * DM * 2, W_FC1 = W_OUT + (size_t)DM * DM * 2, W_FC2 = W_FC1 + (size_t)DFF * DM * 2, W_LAYER = W_FC2 + (size_t)DM * DFF * 2;
constexpr size_t WS_ARENA = WS_WT + 2 * W_LAYER;
constexpr size_t SZ_ROW1024 = (size_t)MTOT * 1024 * 2;
constexpr size_t A_A = WS_ARENA;
constexpr size_t A_B = A_A + SZ_ROW1024;
constexpr size_t A_C = A_B + SZ_ROW1024;
constexpr size_t A_H = A_A, A_Y = A_B, A_XS2 = A_B, A_BIG = A_C;
constexpr size_t A_P1 = A_BIG;
constexpr size_t A_QKV = A_BIG;
constexpr size_t A_QKVN = A_P1 + (size_t)MTOT * NP1 * 2;
constexpr size_t A_KR = A_QKVN + (size_t)MTOT * KUP * 2;
constexpr size_t A_DQ = A_KR + (size_t)MTOT * 32 * 2;
constexpr size_t A_DK = A_DQ + (size_t)MTOT * 256 * 2;
constexpr size_t A_DV = A_DK + (size_t)MTOT * 256 * 2;
constexpr size_t A_UT = A_DV + (size_t)MTOT * 256 * 2;
constexpr size_t A_X0T = A_UT + (size_t)256 * NLAT * 2;
constexpr size_t A_UTC = A_X0T + (size_t)256 * NLAT * 2;
constexpr size_t A_X0TC = A_UTC + (size_t)256 * NCTX * 2;
constexpr size_t A_BIG_END = A_X0TC + (size_t)256 * NCTX * 2;
constexpr size_t A_G = A_BIG;
constexpr size_t A_HID = A_C;
constexpr size_t WS_END = (A_BIG_END > A_HID + (size_t)MTOT * DFF * 2) ? A_BIG_END : A_HID + (size_t)MTOT * DFF * 2;
static_assert(WS_END <= (size_t)1024 * 1024 * 1024, "workspace map exceeds 1 GiB");

constexpr int LDS_BYTES = 147456;
constexpr int LDS_MISC = LDS_BYTES - 64;

__device__ __forceinline__ unsigned pkh(float lo, float hi) { f32x2 v = {lo, hi}; hf2 h = __builtin_convertvector(v, hf2); return __builtin_bit_cast(unsigned, h); }
__device__ __forceinline__ float wave_sum(float v) {
#pragma unroll
    for (int o = 1; o < 64; o <<= 1) v += __shfl_xor(v, o);
    return v;
}
#define LDS_WAIT() asm volatile("s_waitcnt lgkmcnt(0)" ::: "memory")
#define VM_WAIT() asm volatile("s_waitcnt vmcnt(0)" ::: "memory")

#define XB_TMO      128
#define XB_XCNT(j)  (256  + 64 * (j))
#define XB_XSUB(j)  (1280 + 64 * (j))
#define XB_XGEN(j)  (2304 + 64 * (j))
#define XB_TOP      3328
#define XB_TOPGEN   3392
#define XCD_BAR_WORDS 3456
#define XB_SPIN_CAP (1u << 22)
__device__ __forceinline__ unsigned xb_ld(unsigned* p)              { return __hip_atomic_load(p, __ATOMIC_RELAXED, __HIP_MEMORY_SCOPE_AGENT); }
__device__ __forceinline__ unsigned xb_add(unsigned* p, unsigned v) { return __hip_atomic_fetch_add(p, v, __ATOMIC_RELAXED, __HIP_MEMORY_SCOPE_AGENT); }
__device__ __forceinline__ unsigned xb_xcc_id() { return (unsigned)__builtin_amdgcn_s_getreg((3 << 11) | 20) & 0xFu; }
#define XB_SPIN(cond, bar) do { unsigned _sp = 0; while (cond) { __builtin_amdgcn_s_sleep(1); \
    if ((++_sp & 255u) == 0u) { if (xb_ld(&(bar)[XB_TMO])) break; if (_sp > XB_SPIN_CAP) { atomicAdd(&(bar)[XB_TMO], 1u); break; } } } } while (0)
struct XcdBarrier { unsigned* bar; unsigned x; volatile LAS unsigned* st; };
__device__ __forceinline__ XcdBarrier xcd_barrier_post(unsigned* bar, volatile LAS unsigned* st) {
    XcdBarrier b; b.bar = bar; b.x = xb_xcc_id(); b.st = st;
    if (threadIdx.x == 0) (void)xb_add(&bar[XB_XCNT(b.x)], 1u);
    return b;
}
__device__ __forceinline__ void xcd_barrier_complete(unsigned* bar, unsigned x, unsigned& nloc, unsigned& nx) {
    const unsigned G = gridDim.x * gridDim.y * gridDim.z;
    unsigned sum, cnt, mine, sp = 0u;
    for (;;) {
        sum = 0u; cnt = 0u; mine = 0u;
#pragma unroll
        for (unsigned j = 0; j < 16; ++j) { const unsigned c = xb_ld(&bar[XB_XCNT(j)]); sum += c; cnt += (c > 0u) ? 1u : 0u; mine = (j == x) ? c : mine; }
        if (sum == G) break;
        __builtin_amdgcn_s_sleep(1);
        if ((++sp & 255u) == 0u) { if (xb_ld(&bar[XB_TMO])) break; if (sp > XB_SPIN_CAP) { atomicAdd(&bar[XB_TMO], 1u); break; } }
    }
    nloc = mine > 0u ? mine : 1u; nx = cnt > 0u ? cnt : 1u;
}
__device__ __forceinline__ void xcd_barrier(const XcdBarrier& b) {
    asm volatile("s_waitcnt vmcnt(0)" ::: "memory");
    __syncthreads();
    if (threadIdx.x == 0) {
        unsigned* bar = b.bar;
        __builtin_amdgcn_s_waitcnt(0);
        unsigned nloc = b.st[0], nx = b.st[1];
        if (nloc == 0u) { xcd_barrier_complete(bar, b.x, nloc, nx); b.st[0] = nloc; b.st[1] = nx; }
        const unsigned old = xb_add(&bar[XB_XSUB(b.x)], 1u);
        const unsigned gen = old / nloc;
        if (old + 1u == (gen + 1u) * nloc) {
            __builtin_amdgcn_fence(__ATOMIC_RELEASE, "agent");
            asm volatile("s_waitcnt vmcnt(0)" ::: "memory");
            const unsigned og = xb_add(&bar[XB_TOP], 1u);
            const unsigned tg = og / nx;
            if (og + 1u == (tg + 1u) * nx) xb_add(&bar[XB_TOPGEN], 1u);
            else XB_SPIN(xb_ld(&bar[XB_TOPGEN]) == tg, bar);
            __builtin_amdgcn_fence(__ATOMIC_ACQUIRE, "agent");
            xb_add(&bar[XB_XGEN(b.x)], 1u);
            asm volatile("s_waitcnt vmcnt(0)" ::: "memory");
        } else {
            XB_SPIN(xb_ld(&bar[XB_XGEN(b.x)]) == gen, bar);
            __builtin_amdgcn_fence(__ATOMIC_ACQUIRE, "agent");
            asm volatile("s_waitcnt vmcnt(0)" ::: "memory");
        }
    }
    __syncthreads();
}

namespace pg8 {
constexpr int BM = 256, BK = 64, HALF = 128, HTB = HALF * BK * 2, STAGE_BYTES = 8 * HTB, NXCD = 8, WGM = 8;
__host__ __device__ __forceinline__ int lds_byte(int r, int c) { const int st = (r >> 4) * 2 + (c >> 5), rr = r & 15, cc = c & 31, ob = rr * 64 + cc * 2; return st * 1024 + (ob ^ (((ob >> 9) & 1) << 5)); }
__host__ __device__ __forceinline__ void stage_rc(int b, int& R, int& C) { const int st = b / 1024, sb = b % 1024, swz = sb ^ (((sb >> 9) & 1) << 5); R = (st >> 1) * 16 + swz / 64; C = (st & 1) * 32 + (swz % 64) / 2; }
__host__ __device__ __forceinline__ int perm32(int rho) { const int n = rho >> 4, i = rho & 15; return 8 * (i >> 2) + 4 * n + (i & 3); }
struct Unit { int pm, pn; };
struct Gemm { const hf* A; const hf* Bt; int M, N, K, lda, ldb; };
struct StaticOrder {
    int nM, nN, nwg, G, c;
    __host__ __device__ void init(int M, int N, int G_, int c_) { nM = M / BM; nN = N / BM; nwg = nM * nN; G = G_; c = c_; }
    __host__ __device__ bool next(int i, Unit& u) const {
        const long L = (long)i * G + c; if (L >= nwg) return false;
        int wgid = (int)L; { const int q = nwg / NXCD, r = nwg % NXCD, xcd = wgid % NXCD, off = wgid / NXCD; wgid = (xcd < r ? xcd * (q + 1) : r * (q + 1) + (xcd - r) * q) + off; }
        const int nig = WGM * nN, gid = wgid / nig, fm = gid * WGM, gsz = (nM - fm) < WGM ? (nM - fm) : WGM;
        u.pm = fm + ((wgid % nig) % gsz); u.pn = (wgid % nig) / gsz; return true;
    }
    __device__ __forceinline__ void a_ready(const Unit&) const {}
    __device__ __forceinline__ void done(const Unit&) const {}
};

template <int ACT  , bool NORM> struct EpiHalf {
    static constexpr bool PERM = true, AFTER_DRAIN = false, PROBE2 = false;
    hf* O; int ldc; const float* ss; const float* bias;
    __device__ __forceinline__ void operator()(const f32x4 (&acc)[2][2][4][2], const Unit& u, int wr, int wc, int fr, int fq) const {
        const int row0 = u.pm * BM + wr * 64 + fr, col0 = u.pn * BM + wc * 32 + 8 * fq;
        f32x4 bv[2][2];
        if (NORM) { const int R0 = u.pm * BM; const int v = (R0 < NLAT) ? (R0 >> 11) : NB; const float* bp = bias + (size_t)v * NBIAS + col0;
#pragma unroll
            for (int bj = 0; bj < 2; ++bj)
#pragma unroll
                for (int n = 0; n < 2; ++n) bv[bj][n] = *(const f32x4*)(bp + bj * HALF + 4 * n); }
#pragma unroll
        for (int ai = 0; ai < 2; ++ai)
#pragma unroll
            for (int m = 0; m < 4; ++m) { const int r = row0 + ai * HALF + m * 16; hf* rowp = O + (size_t)r * ldc + col0;
                float rs = 1.f; if (NORM) rs = rsqrtf(ss[r] * (1.f / DM) + EPS);
#pragma unroll
                for (int bj = 0; bj < 2; ++bj) { f32x4 v0 = acc[ai][bj][m][0], v1 = acc[ai][bj][m][1];
                    if (NORM) { v0 = v0 * rs + bv[bj][0]; v1 = v1 * rs + bv[bj][1]; }
                    if (ACT == 1) {
#pragma unroll
                        for (int e = 0; e < 4; ++e) { v0[e] = __builtin_amdgcn_rcpf(1.f + __builtin_amdgcn_exp2f(-1.4426950408889634f * v0[e])); v1[e] = __builtin_amdgcn_rcpf(1.f + __builtin_amdgcn_exp2f(-1.4426950408889634f * v1[e])); } }
                    if (ACT == 2) {
#pragma unroll
                        for (int e = 0; e < 4; ++e) { const float a = fmaxf(v0[e], 0.f), b = fmaxf(v1[e], 0.f); v0[e] = a * a; v1[e] = b * b; } }
                    u32x4 w; w.x = pkh(v0[0], v0[1]); w.y = pkh(v0[2], v0[3]); w.z = pkh(v1[0], v1[1]); w.w = pkh(v1[2], v1[3]);
                    *(u32x4*)(rowp + bj * HALF) = w; } }
    }
};
template <bool FIRST> struct EpiGated {
    static constexpr bool PERM = true, AFTER_DRAIN = false, PROBE2 = false;
    hf* MMo; const hf* G; int goff;
    __device__ __forceinline__ void operator()(const f32x4 (&acc)[2][2][4][2], const Unit& u, int wr, int wc, int fr, int fq) const {
        const int row0 = u.pm * BM + wr * 64 + fr, col0 = u.pn * BM + wc * 32 + 8 * fq;
#pragma unroll
        for (int ai = 0; ai < 2; ++ai)
#pragma unroll
            for (int m = 0; m < 4; ++m) { const size_t r = (size_t)(row0 + ai * HALF + m * 16);
#pragma unroll
                for (int bj = 0; bj < 2; ++bj) { const f32x4 v0 = acc[ai][bj][m][0], v1 = acc[ai][bj][m][1];
                    const hf8 g = *(const hf8*)(G + r * NGATE + goff + col0 + bj * HALF);
                    hf* mp = MMo + r * DM + col0 + bj * HALF;
                    float o[8];
#pragma unroll
                    for (int e = 0; e < 4; ++e) { o[e] = (float)g[e] * v0[e]; o[4 + e] = (float)g[4 + e] * v1[e]; }
                    if (!FIRST) { const hf8 p = *(const hf8*)mp;
#pragma unroll
                        for (int e = 0; e < 8; ++e) o[e] += (float)p[e]; }
                    u32x4 w; w.x = pkh(o[0], o[1]); w.y = pkh(o[2], o[3]); w.z = pkh(o[4], o[5]); w.w = pkh(o[6], o[7]);
                    *(u32x4*)mp = w; } }
    }
};
template <bool XS, bool STAT> struct EpiResidX {
    static constexpr bool PERM = true, AFTER_DRAIN = false, PROBE2 = false;
    const float* xs_lat; const float* xs_ctx; float* xd_lat; float* xd_ctx; const float* gate;
    hf* xsout; const float* gs; float* ss;
    __device__ __forceinline__ void operator()(const f32x4 (&acc)[2][2][4][2], const Unit& u, int wr, int wc, int fr, int fq) const {
        const int R0 = u.pm * BM; const bool lat = R0 < NLAT;
        const int v = lat ? (R0 >> 11) : NB;
        const int rglob = R0 + wr * 64 + fr, rloc = (lat ? rglob : rglob - NLAT), col0 = u.pn * BM + wc * 32 + 8 * fq;
        const float* src = lat ? xs_lat : xs_ctx; float* dst = lat ? xd_lat : xd_ctx; const float* gp = gate + (size_t)v * MODW + col0; const float* gsp = gs + (size_t)v * DM + col0;
        float sq[2][4];
#pragma unroll
        for (int ai = 0; ai < 2; ++ai)
#pragma unroll
            for (int m = 0; m < 4; ++m) sq[ai][m] = 0.f;
#pragma unroll
        for (int bj = 0; bj < 2; ++bj) {
            const f32x4 g0 = *(const f32x4*)(gp + bj * HALF), g1 = *(const f32x4*)(gp + bj * HALF + 4);
            f32x4 s0 = {1.f, 1.f, 1.f, 1.f}, s1 = s0; if (XS) { s0 = *(const f32x4*)(gsp + bj * HALF); s1 = *(const f32x4*)(gsp + bj * HALF + 4); }
#pragma unroll
            for (int ai = 0; ai < 2; ++ai)
#pragma unroll
                for (int m = 0; m < 4; ++m) { const int rr = ai * HALF + m * 16; const size_t off = (size_t)(rloc + rr) * DM + col0 + bj * HALF;
                    const f32x4 x0 = *(const f32x4*)(src + off), x1 = *(const f32x4*)(src + off + 4);
                    const f32x4 n0 = x0 + g0 * acc[ai][bj][m][0], n1 = x1 + g1 * acc[ai][bj][m][1];
                    *(f32x4*)(dst + off) = n0; *(f32x4*)(dst + off + 4) = n1;
                    if (STAT) sq[ai][m] += (n0[0] * n0[0] + n0[1] * n0[1]) + (n0[2] * n0[2] + n0[3] * n0[3]) + (n1[0] * n1[0] + n1[1] * n1[1]) + (n1[2] * n1[2] + n1[3] * n1[3]);
                    if (XS) { const f32x4 a = n0 * s0, b = n1 * s1; u32x4 w; w.x = pkh(a[0], a[1]); w.y = pkh(a[2], a[3]); w.z = pkh(b[0], b[1]); w.w = pkh(b[2], b[3]);
                        *(u32x4*)(xsout + (size_t)(rglob + rr) * DM + col0 + bj * HALF) = w; } }
        }
        if (STAT) {
#pragma unroll
            for (int ai = 0; ai < 2; ++ai)
#pragma unroll
                for (int m = 0; m < 4; ++m) { float t = sq[ai][m]; t += __shfl_xor(t, 16); t += __shfl_xor(t, 32);
                    if (fq == 0) (void)__hip_atomic_fetch_add(ss + rglob + ai * HALF + m * 16, t, __ATOMIC_RELAXED, __HIP_MEMORY_SCOPE_AGENT); }
        }
    }
};

template <class Epi, class Sched, bool ALIGN_EPI = true>
__device__ __forceinline__ void gemm_phase(LAS unsigned char* lds, const Gemm g, const Sched& S, const Epi& E) {
    int tid = threadIdx.x; asm volatile("" : "+v"(tid));
    const int wid = __builtin_amdgcn_readfirstlane(tid >> 6), lane = tid & 63, wr = wid >> 2, wc = wid & 3, fr = lane & 15, fq = lane >> 4;
    const int K = g.K, nt = K / BK;
    unsigned voffA[2], voffB[2];
#pragma unroll
    for (int i = 0; i < 2; ++i) { int R, C; stage_rc(tid * 16 + i * 8192, R, C); const int Rb = Epi::PERM ? ((R & ~31) + perm32(R & 31)) : R;
        voffA[i] = (unsigned)(R * g.lda + C) * 2u; voffB[i] = (unsigned)(Rb * g.ldb + C) * 2u; }
    const size_t kstep = (size_t)(BK * 2);
    const size_t hstepA = (size_t)HALF * g.lda * 2, hstepB = (size_t)HALF * g.ldb * 2;
    const size_t tstepA = 2 * hstepA, tstepB = 2 * hstepB;
    const unsigned ldsw = (unsigned)wid * 1024u;
    const int aoff = lds_byte(wr * 64 + fr, fq * 8), boff = lds_byte(wc * 32 + fr, fq * 8);
#define PG8_SA(b, h) (((b) * 2 + (h)) * HTB)
#define PG8_SB(b, h) ((4 + (b) * 2 + (h)) * HTB)
#define PG8_STAGE(bufoff, gbase, voff) do { _Pragma("unroll") for (int _i = 0; _i < 2; ++_i) \
        __builtin_amdgcn_global_load_lds((const unsigned*)((const char*)(gbase) + (voff)[_i]), (LAS unsigned*)(lds + (bufoff) + ldsw + _i * 8192), 16, 0, 0); } while (0)
#define PG8_LDA(dst, b, h) do { _Pragma("unroll") for (int m = 0; m < 4; ++m) _Pragma("unroll") for (int k = 0; k < 2; ++k) dst[m][k] = *(const LAS hf8*)(lds + PG8_SA(b, h) + aoff + m * 2048 + k * 1024); } while (0)
#define PG8_LDB(dst, b, h) do { _Pragma("unroll") for (int n = 0; n < 2; ++n) _Pragma("unroll") for (int k = 0; k < 2; ++k) dst[n][k] = *(const LAS hf8*)(lds + PG8_SB(b, h) + boff + n * 2048 + k * 1024); } while (0)
#define PG8_MMA(ai, bj, At, Bt) do { __builtin_amdgcn_s_setprio(1); _Pragma("unroll") for (int m = 0; m < 4; ++m) _Pragma("unroll") for (int n = 0; n < 2; ++n) _Pragma("unroll") for (int k = 0; k < 2; ++k) \
        acc[ai][bj][m][n] = __builtin_amdgcn_mfma_f32_16x16x32_f16(Bt[n][k], At[m][k], acc[ai][bj][m][n], 0, 0, 0); __builtin_amdgcn_s_setprio(0); } while (0)
#define PG8_WAIT_V(n) asm volatile("s_waitcnt vmcnt(" #n ")" ::: "memory")
#define PG8_WAIT_L(n) asm volatile("s_waitcnt lgkmcnt(" #n ")" ::: "memory")
#define PG8_BAR __builtin_amdgcn_s_barrier()
#define PG8_SCHED __builtin_amdgcn_sched_barrier(0)
    Unit cur, nxt; int ui = 0;
    if (!S.next(0, cur)) return;
    f32x4 acc[2][2][4][2];
#pragma unroll
    for (int a = 0; a < 2; ++a)
#pragma unroll
        for (int b = 0; b < 2; ++b)
#pragma unroll
            for (int m = 0; m < 4; ++m)
#pragma unroll
                for (int n = 0; n < 2; ++n) acc[a][b][m][n] = (f32x4){0.f, 0.f, 0.f, 0.f};
    hf8 At[4][2], B0[2][2], B1[2][2];
    const char* cA = (const char*)g.A + (size_t)cur.pm * tstepA; const char* cB = (const char*)g.Bt + (size_t)cur.pn * tstepB;
    S.a_ready(cur);
    PG8_STAGE(PG8_SB(0, 0), cB, voffB); PG8_STAGE(PG8_SB(0, 1), cB + hstepB, voffB); PG8_STAGE(PG8_SA(0, 0), cA, voffA); PG8_STAGE(PG8_SA(0, 1), cA + hstepA, voffA);
    if (wr == 1) PG8_BAR;
    PG8_WAIT_V(2); PG8_BAR;
    PG8_STAGE(PG8_SB(1, 0), cB + kstep, voffB); PG8_STAGE(PG8_SA(1, 0), cA + kstep, voffA); PG8_STAGE(PG8_SB(1, 1), cB + hstepB + kstep, voffB);
    PG8_WAIT_V(6); PG8_BAR;
    for (;;) {
        const bool has_next = S.next(ui + 1, nxt);
        const char* nA = has_next ? (const char*)g.A + (size_t)nxt.pm * tstepA : cA; const char* nB = has_next ? (const char*)g.Bt + (size_t)nxt.pn * tstepB : cB;
#pragma unroll 1
        for (int t = 0; t < nt; t += 2) {
            const bool last = (t == nt - 2);
            const char* a1 = cA + (size_t)(t + 1) * kstep;
            const char* a2 = last ? nA : cA + (size_t)(t + 2) * kstep; const char* b2 = last ? nB : cB + (size_t)(t + 2) * kstep;
            const char* a3 = a2 + kstep; const char* b3 = b2 + kstep;
            if (last && has_next) S.a_ready(nxt);
            PG8_LDB(B0, 0, 0); PG8_LDB(B1, 0, 1); PG8_SCHED; PG8_LDA(At, 0, 0); PG8_STAGE(PG8_SA(1, 1), a1 + hstepA, voffA);
            PG8_WAIT_V(8); PG8_WAIT_L(0); PG8_BAR; PG8_MMA(0, 0, At, B0); PG8_MMA(0, 1, At, B1); PG8_BAR; PG8_SCHED;
            PG8_LDA(At, 0, 1); PG8_STAGE(PG8_SB(0, 0), b2, voffB); PG8_STAGE(PG8_SB(0, 1), b2 + hstepB, voffB); PG8_STAGE(PG8_SA(0, 0), a2, voffA);
            PG8_WAIT_V(8); PG8_WAIT_L(0); PG8_BAR; PG8_MMA(1, 0, At, B0); PG8_MMA(1, 1, At, B1); PG8_BAR; PG8_SCHED;
            PG8_LDB(B0, 1, 0); PG8_LDB(B1, 1, 1); PG8_SCHED; PG8_LDA(At, 1, 0); PG8_STAGE(PG8_SA(0, 1), a2 + hstepA, voffA);
            PG8_WAIT_V(8); PG8_WAIT_L(0); PG8_BAR; PG8_MMA(0, 0, At, B0); PG8_MMA(0, 1, At, B1); PG8_BAR; PG8_SCHED;
            PG8_LDA(At, 1, 1); PG8_STAGE(PG8_SB(1, 0), b3, voffB); PG8_STAGE(PG8_SB(1, 1), b3 + hstepB, voffB); PG8_STAGE(PG8_SA(1, 0), a3, voffA);
            PG8_WAIT_V(8); PG8_WAIT_L(0); PG8_BAR; PG8_MMA(1, 0, At, B0); PG8_MMA(1, 1, At, B1); PG8_BAR; PG8_SCHED;
        }
        if constexpr (ALIGN_EPI) { if (wr == 0) PG8_BAR; }
        E(acc, cur, wr, wc, fr, fq); S.done(cur);
#ifdef PROBE_EPI2
        if (Epi::PROBE2) { asm volatile("" ::: "memory"); E(acc, cur, wr, wc, fr, fq); }
#endif
        if (!has_next) break;
#pragma unroll
        for (int a = 0; a < 2; ++a)
#pragma unroll
            for (int b = 0; b < 2; ++b)
#pragma unroll
                for (int m = 0; m < 4; ++m)
#pragma unroll
                    for (int n = 0; n < 2; ++n) acc[a][b][m][n] = (f32x4){0.f, 0.f, 0.f, 0.f};
        cur = nxt; cA = nA; cB = nB; ++ui;
        if constexpr (ALIGN_EPI) { if (wr == 1) PG8_BAR; }
    }
    PG8_WAIT_V(0);
    if constexpr (!ALIGN_EPI) { if (wr == 0) PG8_BAR; }
    PG8_BAR;
#undef PG8_SA
#undef PG8_SB
#undef PG8_STAGE
#undef PG8_LDA
#undef PG8_LDB
#undef PG8_MMA
#undef PG8_WAIT_V
#undef PG8_WAIT_L
#undef PG8_BAR
#undef PG8_SCHED
}
}

struct Params {
    const float* in[35];
    float* out;
    unsigned char* ws;
    int ph_lo, ph_hi;
};
enum { I_X = 0, I_C, I_CTX, I_CCTX, I_NMG, I_NFG, I_WMOD, I_BMOD, I_WIN, I_QNG, I_WUQ, I_KVNG, I_WUKV, I_HCW, I_HCB, I_HW1, I_HB1, I_HFREQ, I_HW2, I_HB2, I_HW3, I_HB3,
       I_HSKIP, I_LQ1, I_LK1, I_LQ2, I_LK2, I_SUBG, I_WBRA, I_WBRB, I_WBRC, I_WOUT, I_FC1, I_FC2, I_FNG };

struct Frame {
    LAS unsigned char* lds;
    int tid, lane, wave, vcu, G;
};

__device__ __forceinline__ void tr_item(const float* W, int ldw, hf* WT, int ldt, int nblk, LAS float* scr, int item, int lane) {
    const int kb = item / nblk, nb = item % nblk, k0 = 64 * kb, n0 = 32 * nb;
#pragma unroll 8
    for (int i = 0; i < 32; ++i) { const int kk = 2 * i + (lane >> 5); scr[kk * 33 + (lane & 31)] = W[(size_t)(k0 + kk) * ldw + n0 + (lane & 31)]; }
    LDS_WAIT(); asm volatile("" ::: "memory");
    const int c = lane & 7;
#pragma unroll
    for (int j = 0; j < 4; ++j) { const int n = (lane >> 3) + 8 * j; const LAS float* s = scr + (8 * c) * 33 + n;
        u32x4 o; o.x = pkh(s[0 * 33], s[1 * 33]); o.y = pkh(s[2 * 33], s[3 * 33]); o.z = pkh(s[4 * 33], s[5 * 33]); o.w = pkh(s[6 * 33], s[7 * 33]);
        *(u32x4*)(WT + (size_t)(n0 + n) * ldt + k0 + 8 * c) = o; }
    LDS_WAIT(); asm volatile("" ::: "memory");
}
__device__ __forceinline__ float silu_f(float x) { return x / (1.f + expf(-x)); }

__device__ __forceinline__ void mod_phase(const Frame& F, const Params& p) {
    float* MOD = (float*)(p.ws + WS_MOD);
    LAS float* sv = (LAS float*)F.lds;
    constexpr int NCB = DEPTH * MODW / 512;
    for (int item = F.vcu; item < NCB * 3; item += F.G) {
        const int cb = item / 3, vg = item % 3;
        __syncthreads();
        for (int i = F.tid; i < 11 * 1024; i += 512) { const int v = vg * 11 + i / 1024, k = i % 1024;
            const float c = (v < NB) ? p.in[I_C][v * DM + k] : p.in[I_CCTX][k]; sv[i] = silu_f(c); }
        __syncthreads();
        const int gcol = cb * 512 + F.tid, l = gcol / MODW, n = gcol % MODW;
        const float* w = p.in[I_WMOD] + (size_t)l * DM * MODW + n;
        float acc[11];
#pragma unroll
        for (int v = 0; v < 11; ++v) acc[v] = 0.f;
        for (int k = 0; k < DM; k += 4) {
            const float w0 = w[(size_t)k * MODW], w1 = w[(size_t)(k + 1) * MODW], w2 = w[(size_t)(k + 2) * MODW], w3 = w[(size_t)(k + 3) * MODW];
#pragma unroll
            for (int v = 0; v < 11; ++v) { const f32x4 s = *(const LAS f32x4*)(sv + v * 1024 + k);
                acc[v] = fmaf(s[0], w0, acc[v]); acc[v] = fmaf(s[1], w1, acc[v]); acc[v] = fmaf(s[2], w2, acc[v]); acc[v] = fmaf(s[3], w3, acc[v]); }
        }
        const float bm = p.in[I_BMOD][(size_t)l * MODW + n];
#pragma unroll
        for (int v = 0; v < 11; ++v) MOD[((size_t)l * NMODV + vg * 11 + v) * MODW + n] = acc[v] + bm;
    }
    __syncthreads();
}

__device__ __forceinline__ void filt_item(const Params& p, int l, int kind  , int t, int lane) {
    const int L = kind ? CTXL : SEQ;
    hf* R = kind ? (hf*)(p.ws + WS_RFC) + (size_t)l * 256 * 512 : (hf*)(p.ws + WS_RF) + (size_t)l * 256 * 4096;
    const int rl = 2 * L;
    const float tl = (float)t / (float)(L - 1);
    const float wt = (6.283185307179586f / (float)L) * (float)t;
    float z = 0.f;
    if (lane == 0) z = tl;
    else if (lane <= 32) { const int bi = (lane - 1) & 15; const float band = 1e-4f + (15.f - 1e-4f) * ((float)bi / 15.f); const float a = band * wt; z = (lane <= 16) ? cosf(a) : -sinf(a); }
    const float* w1 = p.in[I_HW1] + (size_t)l * 33 * 64; const float* w2 = p.in[I_HW2] + (size_t)l * 64 * 64; const float* w3 = p.in[I_HW3] + (size_t)l * 64 * 512;
    const float fr = p.in[I_HFREQ][l * 64 + lane];
    float a1 = p.in[I_HB1][l * 64 + lane];
    for (int i = 0; i < 33; ++i) a1 = fmaf(__shfl(z, i), w1[i * 64 + lane], a1);
    a1 = sinf(fr * a1);
    float a2 = p.in[I_HB2][l * 64 + lane];
    for (int i = 0; i < 64; ++i) a2 = fmaf(__shfl(a1, i), w2[i * 64 + lane], a2);
    a2 = sinf(fr * a2);
    float h[8];
#pragma unroll
    for (int q = 0; q < 8; ++q) h[q] = p.in[I_HB3][l * 512 + q * 64 + lane];
    for (int i = 0; i < 64; ++i) { const float a = __shfl(a2, i);
#pragma unroll
        for (int q = 0; q < 8; ++q) h[q] = fmaf(a, w3[i * 512 + q * 64 + lane], h[q]); }
    const float d0 = -4.605170185988091f / 1.5f, d1 = -4.605170185988091f / 0.3f;
#pragma unroll
    for (int q = 0; q < 8; ++q) { const int o = q * 64 + lane, dir = o >> 8, c = o & 255;
        const float delta = fabsf(d0 + (d1 - d0) * ((float)c / 255.f));
        float val = h[q] * (expf(-tl * delta) + 0.05f);
        if (dir == 0) { if (t == 0) val += p.in[I_HSKIP][l * 256 + c]; R[(size_t)c * rl + (L - t)] = (hf)val; if (t == 0) R[(size_t)c * rl] = (hf)0.f; }
        else if (t >= 1) R[(size_t)c * rl + (L + t)] = (hf)val; }
}

__device__ __forceinline__ void convert_layer(const Frame& F, const Params& p, int l, unsigned char* wl) {
    LAS float* scr = (LAS float*)(F.lds + F.wave * 16384);
    const int gw = F.vcu * 8 + F.wave, NGW = F.G * 8, lane = F.lane;
    constexpr int IT_IN1 = 16 * 61, IT_ING = 16 * 96, IT_UQ = 4 * 24, IT_UKV = 2 * 32, IT_BRA = 8 * 32, IT_BRB = 4 * 32, IT_BRC = 4 * 32, IT_OUT = 16 * 32, IT_FC1 = 16 * 128, IT_FC2 = 64 * 32;
    constexpr int IT_LAYER = IT_IN1 + IT_ING + IT_UQ + IT_UKV + IT_BRA + IT_BRB + IT_BRC + IT_OUT + IT_FC1 + IT_FC2;
    for (int it = gw; it < IT_LAYER; it += NGW) {
        int r = it;
        if (r < IT_IN1) { tr_item(p.in[I_WIN] + (size_t)l * DM * D_IN, D_IN, (hf*)(wl + W_IN1), DM, 61, scr, r, lane); continue; } r -= IT_IN1;
        if (r < IT_ING) { tr_item(p.in[I_WIN] + (size_t)l * DM * D_IN + C_PG, D_IN, (hf*)(wl + W_ING), DM, 96, scr, r, lane); continue; } r -= IT_ING;
        if (r < IT_UQ) { tr_item(p.in[I_WUQ] + (size_t)l * 256 * 768, 768, (hf*)(wl + W_UP), KUP, 24, scr, r, lane); continue; } r -= IT_UQ;
        if (r < IT_UKV) { tr_item(p.in[I_WUKV] + (size_t)l * 128 * 1024, 1024, (hf*)(wl + W_UP) + (size_t)768 * KUP + 256, KUP, 32, scr, r, lane); continue; } r -= IT_UKV;
        if (r < IT_BRA) { tr_item(p.in[I_WBRA] + (size_t)l * 512 * DM, DM, (hf*)(wl + W_BR), DM, 32, scr, r, lane); continue; } r -= IT_BRA;
        if (r < IT_BRB) { tr_item(p.in[I_WBRB] + (size_t)l * 256 * DM, DM, (hf*)(wl + W_BR) + 512, DM, 32, scr, r, lane); continue; } r -= IT_BRB;
        if (r < IT_BRC) { tr_item(p.in[I_WBRC] + (size_t)l * 256 * DM, DM, (hf*)(wl + W_BR) + 768, DM, 32, scr, r, lane); continue; } r -= IT_BRC;
        if (r < IT_OUT) { tr_item(p.in[I_WOUT] + (size_t)l * DM * DM, DM, (hf*)(wl + W_OUT), DM, 32, scr, r, lane); continue; } r -= IT_OUT;
        if (r < IT_FC1) { tr_item(p.in[I_FC1] + (size_t)l * DM * DFF, DFF, (hf*)(wl + W_FC1), DM, 128, scr, r, lane); continue; } r -= IT_FC1;
        tr_item(p.in[I_FC2] + (size_t)l * DFF * DM, DM, (hf*)(wl + W_FC2), DFF, 32, scr, r, lane);
    }
    const int gt = gw * 64 + lane, NGT = NGW * 64;
    u32x4* z1 = (u32x4*)((hf*)(wl + W_IN1) + (size_t)C_PG * DM);
    for (int i = gt; i < 96 * DM / 8; i += NGT) z1[i] = (u32x4){0u, 0u, 0u, 0u};
    hf* up = (hf*)(wl + W_UP);
    for (int i = gt; i < 768 * 16; i += NGT) { const int n = i / 16, k8 = i % 16; *(u32x4*)(up + (size_t)n * KUP + 256 + k8 * 8) = (u32x4){0u, 0u, 0u, 0u}; }
    for (int i = gt; i < 1024 * 32; i += NGT) { const int n = 768 + i / 32, k8 = i % 32; *(u32x4*)(up + (size_t)n * KUP + k8 * 8) = (u32x4){0u, 0u, 0u, 0u}; }
}

__device__ __forceinline__ void prologue_a(const Frame& F, const Params& p) {
    mod_phase(F, p);
    convert_layer(F, p, 0, p.ws + WS_WT);
    const int gw = F.vcu * 8 + F.wave, NGW = F.G * 8, lane = F.lane;
    for (int it = gw; it < DEPTH * (SEQ + CTXL); it += NGW) { const int l = it / (SEQ + CTXL), r = it % (SEQ + CTXL); if (r < SEQ) filt_item(p, l, 0, r, lane); else filt_item(p, l, 1, r - SEQ, lane); }
    {
        float* rope = (float*)(p.ws + WS_ROPE);
        const int gt = gw * 64 + lane, NGT = NGW * 64;
        for (int i = gt; i < SEQ * 16; i += NGT) { const int t = i >> 4, j = i & 15; const float pos = (j < 8) ? (float)(t / GRIDW) : (float)(t % GRIDW);
            const float inv = powf(10000.f, -(float)(j & 7) / 8.f); const float a = pos * inv; rope[t * 32 + j] = cosf(a); rope[t * 32 + 16 + j] = sinf(a); }
        if (gt < DEPTH) { const int l = gt; float s1 = 0.f, s2 = 0.f;
            for (int i = 0; i < 32; ++i) { s1 += p.in[I_LQ1][l * 32 + i] * p.in[I_LK1][l * 32 + i]; s2 += p.in[I_LQ2][l * 32 + i] * p.in[I_LK2][l * 32 + i]; }
            const float li = 0.8f - 0.6f * expf(-0.3f * (float)l);
            float* lam = (float*)(p.ws + WS_LAM); lam[2 * l] = expf(s1) - expf(s2) + li; lam[2 * l + 1] = 1.f - li; }
    }
}
__device__ __forceinline__ void prologue_b(const Frame& F, const Params& p) {
    const float* MOD = (const float*)(p.ws + WS_MOD); float* BIAS = (float*)(p.ws + WS_BIAS);
    {
        LAS float* sv = (LAS float*)F.lds;
        constexpr int NCB = DEPTH * NBIAS / 512;
        for (int item = F.vcu; item < NCB * 3; item += F.G) {
            const int cb = item / 3, vg = item % 3;
            const int gcol = cb * 512 + F.tid, l = gcol / NBIAS, n = gcol % NBIAS, n0 = (cb * 512) % NBIAS;
            const int soff = (n0 >= B_FC1) ? 3 * DM : 0;
            __syncthreads();
            for (int i = F.tid; i < 11 * 1024; i += 512) { const int v = vg * 11 + i / 1024, k = i % 1024; sv[i] = MOD[((size_t)l * NMODV + v) * MODW + soff + k]; }
            __syncthreads();
            const float* w; size_t ldw; bool valid = true;
            if (n < B_G) { w = p.in[I_WIN] + (size_t)l * DM * D_IN + n; ldw = D_IN; valid = n < C_PG; }
            else if (n < B_FC1) { w = p.in[I_WIN] + (size_t)l * DM * D_IN + C_PG + (n - B_G); ldw = D_IN; }
            else { w = p.in[I_FC1] + (size_t)l * DM * DFF + (n - B_FC1); ldw = DFF; }
            float acc[11];
#pragma unroll
            for (int v = 0; v < 11; ++v) acc[v] = 0.f;
            if (valid) for (int k = 0; k < DM; k += 4) {
                const float w0 = w[(size_t)k * ldw], w1 = w[(size_t)(k + 1) * ldw], w2 = w[(size_t)(k + 2) * ldw], w3 = w[(size_t)(k + 3) * ldw];
#pragma unroll
                for (int v = 0; v < 11; ++v) { const f32x4 sx = *(const LAS f32x4*)(sv + v * 1024 + k);
                    acc[v] = fmaf(sx[0], w0, acc[v]); acc[v] = fmaf(sx[1], w1, acc[v]); acc[v] = fmaf(sx[2], w2, acc[v]); acc[v] = fmaf(sx[3], w3, acc[v]); }
            }
#pragma unroll
            for (int v = 0; v < 11; ++v) BIAS[((size_t)l * NMODV + vg * 11 + v) * NBIAS + n] = acc[v];
        }
        __syncthreads();
    }
    const int gw = F.vcu * 8 + F.wave, NGW = F.G * 8, lane = F.lane;
    {
        float* GS = (float*)(p.ws + WS_GS);
        const int gt = gw * 64 + lane, NGT = NGW * 64;
        for (int i = gt; i < DEPTH * 2 * NMODV * DM; i += NGT) { const int c = i % DM, v = (i / DM) % NMODV, wh = (i / (DM * NMODV)) % 2, l = i / (DM * NMODV * 2);
            const float g = wh ? p.in[I_NFG][l * DM + c] : p.in[I_NMG][l * DM + c];
            GS[i] = g * (1.f + MOD[((size_t)l * NMODV + v) * MODW + (wh ? 4 * DM : DM) + c]); }
    }
    {
        hf* XS = (hf*)(p.ws + A_A); float* ss = (float*)(p.ws + WS_SS) + (size_t)SS_1 * MTOT;
        f32x4 g[4];
#pragma unroll
        for (int j = 0; j < 4; ++j) g[j] = *(const f32x4*)(p.in[I_NMG] + 4 * lane + 256 * j);
        for (int row = gw; row < MTOT; row += NGW) {
            const bool lat = row < NLAT; const float* xr = lat ? p.in[I_X] + (size_t)row * DM : p.in[I_CTX] + (size_t)(row - NLAT) * DM;
            const int v = lat ? (row >> 11) : NB; const float* mv = MOD + (size_t)v * MODW + DM;
            float sq = 0.f; hf* hr = XS + (size_t)row * DM;
#pragma unroll
            for (int j = 0; j < 4; ++j) { const f32x4 x = *(const f32x4*)(xr + 4 * lane + 256 * j); const f32x4 sc = *(const f32x4*)(mv + 4 * lane + 256 * j);
                sq += (x[0] * x[0] + x[1] * x[1]) + (x[2] * x[2] + x[3] * x[3]);
                const f32x4 o = x * (g[j] * (sc + 1.f)); u32x2 w; w.x = pkh(o[0], o[1]); w.y = pkh(o[2], o[3]); *(u32x2*)(hr + 4 * lane + 256 * j) = w; }
            sq = wave_sum(sq);
            if (lane == 0) ss[row] = sq;
        }
    }
}

__device__ __forceinline__ void norm_phase(const Frame& F, const float* xs_lat, const float* xs_ctx, int nrows, const float* gain, const float* modl, int sh_off, int sc_off, hf* H) {
    const int gw = F.vcu * 8 + F.wave, NGW = F.G * 8, lane = F.lane;
    f32x4 g[4];
#pragma unroll
    for (int j = 0; j < 4; ++j) g[j] = *(const f32x4*)(gain + 4 * lane + 256 * j);
    for (int row = gw; row < nrows; row += NGW) {
        const bool lat = row < NLAT; const float* xr = lat ? xs_lat + (size_t)row * DM : xs_ctx + (size_t)(row - NLAT) * DM;
        const int v = lat ? (row >> 11) : NB; const float* mv = modl + (size_t)v * MODW;
        f32x4 x[4]; float ss = 0.f;
#pragma unroll
        for (int j = 0; j < 4; ++j) { x[j] = *(const f32x4*)(xr + 4 * lane + 256 * j); ss += (x[j][0] * x[j][0] + x[j][1] * x[j][1]) + (x[j][2] * x[j][2] + x[j][3] * x[j][3]); }
        const float rstd = rsqrtf(wave_sum(ss) * (1.f / DM) + EPS);
        hf* hr = H + (size_t)row * DM;
#pragma unroll
        for (int j = 0; j < 4; ++j) { const f32x4 sh = *(const f32x4*)(mv + sh_off + 4 * lane + 256 * j), sc = *(const f32x4*)(mv + sc_off + 4 * lane + 256 * j);
            const f32x4 y = (x[j] * rstd) * g[j]; const f32x4 o = y * (sc + 1.f) + sh;
            u32x2 w; w.x = pkh(o[0], o[1]); w.y = pkh(o[2], o[3]); *(u32x2*)(hr + 4 * lane + 256 * j) = w; }
    }
}
__device__ __forceinline__ void final_norm_phase(const Frame& F, float* X, const float* gain, const float* ss) {
    const int gw = F.vcu * 8 + F.wave, NGW = F.G * 8, lane = F.lane;
    f32x4 g[4];
#pragma unroll
    for (int j = 0; j < 4; ++j) g[j] = *(const f32x4*)(gain + 4 * lane + 256 * j);
    for (int row = gw; row < NLAT; row += NGW) {
        float* xr = X + (size_t)row * DM; const float rstd = rsqrtf(ss[row] * (1.f / DM) + EPS);
#pragma unroll
        for (int j = 0; j < 4; ++j) { const f32x4 x = *(const f32x4*)(xr + 4 * lane + 256 * j); *(f32x4*)(xr + 4 * lane + 256 * j) = (x * rstd) * g[j]; }
    }
}

__device__ __forceinline__ void prep_rows(const Frame& F, const Params& p, int l) {
    const int gw = F.vcu * 8 + F.wave, NGW = F.G * 8, lane = F.lane;
    const hf* P1 = (const hf*)(p.ws + A_P1); hf* QKVN = (hf*)(p.ws + A_QKVN); hf* KR = (hf*)(p.ws + A_KR); hf* DQ = (hf*)(p.ws + A_DQ); hf* DK = (hf*)(p.ws + A_DK); hf* DV = (hf*)(p.ws + A_DV);
    const float* rope = (const float*)(p.ws + WS_ROPE);
    const f32x4 gq = *(const f32x4*)(p.in[I_QNG] + l * 256 + 4 * lane);
    const f32x2 gkv = *(const f32x2*)(p.in[I_KVNG] + l * 128 + 2 * lane);
    for (int row = gw; row < MTOT; row += NGW) {
        const hf* pr = P1 + (size_t)row * NP1; const bool lat = row < NLAT; const int t = row & (SEQ - 1);
        {
            const hf4 a = *(const hf4*)(pr + C_PQ + 4 * lane); f32x4 x = {(float)a[0], (float)a[1], (float)a[2], (float)a[3]};
            const float rstd = rsqrtf(wave_sum((x[0] * x[0] + x[1] * x[1]) + (x[2] * x[2] + x[3] * x[3])) * (1.f / 256.f) + EPS);
            x = (x * rstd) * gq; u32x2 w; w.x = pkh(x[0], x[1]); w.y = pkh(x[2], x[3]); *(u32x2*)(QKVN + (size_t)row * KUP + 4 * lane) = w; }
        {
            const hf2 a = *(const hf2*)(pr + C_PKV + 2 * lane); f32x2 x = {(float)a[0], (float)a[1]};
            const float rstd = rsqrtf(wave_sum(x[0] * x[0] + x[1] * x[1]) * (1.f / 128.f) + EPS);
            x = (x * rstd) * gkv; *(unsigned*)(QKVN + (size_t)row * KUP + 256 + 2 * lane) = pkh(x[0], x[1]); }
        {
            *(u32x2*)(DQ + (size_t)row * 256 + 4 * lane) = *(const u32x2*)(pr + C_DQ + 4 * lane);
            *(u32x2*)(DV + (size_t)row * 256 + 4 * lane) = *(const u32x2*)(pr + C_DV + 4 * lane); }
        {
            const int hh = lane >> 3, i0 = 2 * (lane & 7);
            const hf2 a = *(const hf2*)(pr + C_DK + hh * 32 + i0), b = *(const hf2*)(pr + C_DK + hh * 32 + 16 + i0);
            float x1[2] = {(float)a[0], (float)a[1]}, x2[2] = {(float)b[0], (float)b[1]}, o1[2], o2[2];
#pragma unroll
            for (int e = 0; e < 2; ++e) { const float c = lat ? rope[t * 32 + i0 + e] : 1.f, s = lat ? rope[t * 32 + 16 + i0 + e] : 0.f; o1[e] = x1[e] * c - x2[e] * s; o2[e] = x2[e] * c + x1[e] * s; }
            *(unsigned*)(DK + (size_t)row * 256 + hh * 32 + i0) = pkh(o1[0], o1[1]); *(unsigned*)(DK + (size_t)row * 256 + hh * 32 + 16 + i0) = pkh(o2[0], o2[1]); }
        if (lane < 16) {
            const float x1 = (float)pr[C_PKR + lane], x2 = (float)pr[C_PKR + 16 + lane];
            const float c = lat ? rope[t * 32 + lane] : 1.f, s = lat ? rope[t * 32 + 16 + lane] : 0.f;
            KR[(size_t)row * 32 + lane] = (hf)(x1 * c - x2 * s); KR[(size_t)row * 32 + 16 + lane] = (hf)(x2 * c + x1 * s); }
    }
}
__device__ __forceinline__ void prep_hyena(const Frame& F, const Params& p, int l) {
    const int gw = F.vcu * 8 + F.wave, NGW = F.G * 8, lane = F.lane;
    const hf* P1 = (const hf*)(p.ws + A_P1);
    LAS hf* tile = (LAS hf*)(F.lds + F.wave * 9216);
    const float* cw = p.in[I_HCW] + (size_t)l * 3 * 768; const float* cb = p.in[I_HCB] + (size_t)l * 768;
    constexpr int IT_LAT = 2 * NB * (SEQ / 64) * 4, IT_CTX = 2 * NB * (CTXL / 64) * 4;
    for (int it = gw; it < IT_LAT + IT_CTX; it += NGW) {
        const bool ctx = it >= IT_LAT; int r = ctx ? it - IT_LAT : it; const int L = ctx ? CTXL : SEQ, ntile = L / 64;
        const int cg = r & 3; r >>= 2; const int tt = r % ntile; r /= ntile; const int b = r % NB; const int which = r / NB;
        const int c = cg * 64 + lane, t0 = tt * 64; const size_t rowbase = ctx ? (size_t)NLAT + (size_t)b * CTXL : (size_t)b * SEQ;
        hf* dst = ctx ? (hf*)(p.ws + (which ? A_X0TC : A_UTC)) : (hf*)(p.ws + (which ? A_X0T : A_UT));
        if (which == 1) {
            const int col = C_HY + c; const float w0 = cw[c], w1 = cw[768 + c], w2 = cw[1536 + c], bb = cb[c];
            float prev = (t0 > 0) ? (float)P1[(rowbase + t0 - 1) * NP1 + col] : 0.f, cur = (float)P1[(rowbase + t0) * NP1 + col];
#pragma unroll 8
            for (int t = 0; t < 64; ++t) { const int tn = t0 + t + 1; const float nxt = (tn < L) ? (float)P1[(rowbase + tn) * NP1 + col] : 0.f;
                tile[lane * 72 + t] = (hf)(w0 * prev + w1 * cur + w2 * nxt + bb); prev = cur; cur = nxt; }
        } else {
            const int c1 = C_HY + 256 + c, c2 = C_HY + 512 + c;
            const float a0 = cw[256 + c], a1 = cw[768 + 256 + c], a2 = cw[1536 + 256 + c], ab = cb[256 + c];
            const float v0 = cw[512 + c], v1 = cw[768 + 512 + c], v2 = cw[1536 + 512 + c], vb = cb[512 + c];
            float pa = (t0 > 0) ? (float)P1[(rowbase + t0 - 1) * NP1 + c1] : 0.f, ca = (float)P1[(rowbase + t0) * NP1 + c1];
            float pv = (t0 > 0) ? (float)P1[(rowbase + t0 - 1) * NP1 + c2] : 0.f, cv = (float)P1[(rowbase + t0) * NP1 + c2];
#pragma unroll 8
            for (int t = 0; t < 64; ++t) { const int tn = t0 + t + 1; const bool in = tn < L;
                const float na = in ? (float)P1[(rowbase + tn) * NP1 + c1] : 0.f, nv = in ? (float)P1[(rowbase + tn) * NP1 + c2] : 0.f;
                const float x1 = a0 * pa + a1 * ca + a2 * na + ab, vv = v0 * pv + v1 * cv + v2 * nv + vb;
                tile[lane * 72 + t] = (hf)(vv * x1); pa = ca; ca = na; pv = cv; cv = nv; }
        }
        LDS_WAIT(); asm volatile("" ::: "memory");
#pragma unroll
        for (int q = 0; q < 8; ++q) { const int ch = q * 8 + (lane >> 3), pc = lane & 7;
            const u32x4 v = *(const LAS u32x4*)(tile + ch * 72 + pc * 8);
            *(u32x4*)(dst + ((size_t)(cg * 64 + ch) * NB + b) * L + t0 + pc * 8) = v; }
        LDS_WAIT(); asm volatile("" ::: "memory");
    }
}

namespace att {
__device__ __forceinline__ int crow(int r, int hi) { return (r & 3) + 8 * (r >> 2) + 4 * hi; }
#define SBAR() __builtin_amdgcn_sched_barrier(0)
constexpr float THR2 = 8.f * 1.4426950408889634f;
constexpr int KS_MLA = 208, KS_DF = 80;
constexpr int VS = 144, VB = 64 * VS;
constexpr int OFF_V = 32768;
__device__ __forceinline__ int kpos(int key) { return (key & ~0xC) | ((key & 4) << 1) | ((key & 8) >> 1); }

template <int ND0, int KS>
__device__ __forceinline__ void qkt(f32x16& p0, f32x16& p1, const LAS unsigned char* Ks, const hf8* qr, int r32, int hi) {
    p0 = f32x16{}; p1 = f32x16{};
#pragma unroll
    for (int d0 = 0; d0 < ND0; ++d0) { const int cb = (d0 * 16 + hi * 8) * 2;
        const hf8 b0 = *(const LAS hf8*)(Ks + r32 * KS + cb), b1 = *(const LAS hf8*)(Ks + (32 + r32) * KS + cb);
        p0 = __builtin_amdgcn_mfma_f32_32x32x16_f16(b0, qr[d0], p0, 0, 0, 0); p1 = __builtin_amdgcn_mfma_f32_32x32x16_f16(b1, qr[d0], p1, 0, 0, 0); }
}
__device__ __forceinline__ float max3f(float a, float b, float c) { float r; asm("v_max3_f32 %0, %1, %2, %3" : "=v"(r) : "v"(a), "v"(b), "v"(c)); return r; }
__device__ __forceinline__ float max2f(float a, float b) { float r; asm("v_max_f32_e32 %0, %1, %2" : "=v"(r) : "v"(a), "v"(b)); return r; }
__device__ __forceinline__ hf8 pack8(const f32x16& p, int b) { u32x4 w = {pkh(p[b], p[b + 1]), pkh(p[b + 2], p[b + 3]), pkh(p[b + 4], p[b + 5]), pkh(p[b + 6], p[b + 7])}; return __builtin_bit_cast(hf8, w); }
__device__ __forceinline__ void sm_max(const f32x16& p0, const f32x16& p1, float& m, float& l, f32x16& o0, f32x16& o1, const bool first) {
    float pmax = max3f(p0[0], p1[0], p0[1]);
#pragma unroll
    for (int r = 1; r < 15; ++r) pmax = max3f(pmax, p1[r], p0[r + 1]);
    pmax = max2f(pmax, p1[15]);
    { auto rr = __builtin_amdgcn_permlane32_swap(__float_as_uint(pmax), __float_as_uint(pmax), false, false);
      pmax = max2f(__uint_as_float(rr[0]), __uint_as_float(rr[1])); }
    if (first || __any(pmax - m > THR2)) {
        const float mn = first ? pmax : max2f(m, pmax);
        if (!first) { const float alpha = __builtin_amdgcn_exp2f(m - mn); l *= alpha;
#pragma unroll
            for (int r = 0; r < 16; ++r) { o0[r] *= alpha; o1[r] *= alpha; } }
        m = mn;
    }
}
__device__ __forceinline__ void sm_exp_pv(f32x16& p0, f32x16& p1, const float m, float& l, f32x16& o0, f32x16& o1, const LAS unsigned char* Vt, int r32, int hi) {
#pragma unroll
    for (int r = 0; r < 16; ++r) { p0[r] -= m; p1[r] -= m; }
#pragma unroll
    for (int r = 0; r < 16; ++r) { p0[r] = __builtin_amdgcn_exp2f(p0[r]); p1[r] = __builtin_amdgcn_exp2f(p1[r]); }
    float ps = 0.f;
#pragma unroll
    for (int r = 0; r < 16; ++r) ps += p0[r] + p1[r];
    l += ps;
    const hf8 pf0 = pack8(p0, 0), pf1 = pack8(p0, 8), pf2 = pack8(p1, 0), pf3 = pack8(p1, 8);
    const LAS unsigned char* vr = Vt + r32 * VS + hi * 16;
#define PVK(ks, pf) do { const hf8 a0 = *(const LAS hf8*)(vr + (ks) * 32), a1 = *(const LAS hf8*)(vr + 32 * VS + (ks) * 32); \
        o0 = __builtin_amdgcn_mfma_f32_32x32x16_f16(a0, pf, o0, 0, 0, 0); o1 = __builtin_amdgcn_mfma_f32_32x32x16_f16(a1, pf, o1, 0, 0, 0); } while (0)
    PVK(0, pf0); PVK(1, pf1); PVK(2, pf2); PVK(3, pf3);
#undef PVK
}

template <bool MLA>
__device__ __forceinline__ void attn_pass(const Frame& F, const Params& p, int hq, int hv, int qrow0, int qpos0, int klat0, int nlat, int kctx0, f32x16& o0, f32x16& o1, float& inv) {
    constexpr int DK = MLA ? 96 : 32, ND0 = DK / 16, KS = MLA ? KS_MLA : KS_DF, KB = 64 * KS;
    constexpr float SCALE = MLA ? MLA_SCALE : DF_SCALE, C = SCALE * 1.4426950408889634f;
    const int tid = F.tid, wid = F.wave, lane = F.lane, r32 = lane & 31, hi = lane >> 5;
    const hf* QKV = (const hf*)(p.ws + A_QKV); const hf* KRb = (const hf*)(p.ws + A_KR);
    const hf* DQ = (const hf*)(p.ws + A_DQ); const hf* DKb = (const hf*)(p.ws + A_DK); const hf* DVb = (const hf*)(p.ws + A_DV);
    const float* rope = (const float*)(p.ws + WS_ROPE);
    LAS unsigned char* lds = F.lds;
    hf8 qr[ND0];
    {
        const int qrow = qrow0 + wid * 32 + r32;
        const hf* qp = MLA ? QKV + (size_t)qrow * NUP + hq * 96 + hi * 8 : DQ + (size_t)qrow * 256 + hq * 32 + hi * 8;
        hf8 raw[ND0];
#pragma unroll
        for (int d0 = 0; d0 < ND0; ++d0) raw[d0] = *(const hf8*)(qp + d0 * 16);
        f32x4 c0 = {1.f, 1.f, 1.f, 1.f}, c1 = c0, s0 = {0.f, 0.f, 0.f, 0.f}, s1 = s0;
        if (qpos0 >= 0) { const int t = qpos0 + wid * 32 + r32;
            c0 = *(const f32x4*)(rope + t * 32 + hi * 8); c1 = *(const f32x4*)(rope + t * 32 + hi * 8 + 4);
            s0 = *(const f32x4*)(rope + t * 32 + 16 + hi * 8); s1 = *(const f32x4*)(rope + t * 32 + 16 + hi * 8 + 4); }
#pragma unroll
        for (int d0 = 0; d0 < ND0 - 2; ++d0) {
#pragma unroll
            for (int j = 0; j < 8; ++j) qr[d0][j] = (hf)((float)raw[d0][j] * C); }
#pragma unroll
        for (int j = 0; j < 8; ++j) { const float cc = j < 4 ? c0[j & 3] : c1[j & 3], sn = j < 4 ? s0[j & 3] : s1[j & 3]; const float a = (float)raw[ND0 - 2][j], b = (float)raw[ND0 - 1][j];
            qr[ND0 - 2][j] = (hf)((a * cc - b * sn) * C); qr[ND0 - 1][j] = (hf)((b * cc + a * sn) * C); }
    }
    const int k1r = MLA ? (tid >> 3) : ((tid & 255) >> 2), k1c = MLA ? (tid & 7) * 8 : (tid & 3) * 8;
    const int k2r = (tid & 255) >> 2, k2c = (tid & 3) * 8;
    const int vkp = kpos(lane) * 2 + wid * 8 * VS;
    const bool klo = tid < 256;
    struct Stg { u32x4 v, k1, k2; };
    Stg sA, sB; sA.v = sA.k1 = sA.k2 = sB.v = sB.k1 = sB.k2 = (u32x4){0u, 0u, 0u, 0u};
    const int ntile = nlat + 4;
#define KROW0(j) (((j) < nlat) ? klat0 + (j) * 64 : kctx0 + ((j) - nlat) * 64)
#define A_LOADK(S, j) do { const int kr0 = KROW0(j); \
        if (MLA) { S.k1 = *(const u32x4*)(QKV + (size_t)(kr0 + k1r) * NUP + 768 + hq * 128 + k1c); S.k2 = *(const u32x4*)(KRb + (size_t)(kr0 + k2r) * 32 + k2c); } \
        else S.k1 = *(const u32x4*)(DKb + (size_t)(kr0 + k1r) * 256 + hq * 32 + k1c); } while (0)
#define A_LOADV(S, j) do { const int kr0 = KROW0(j); \
        if (MLA) S.v = *(const u32x4*)(QKV + (size_t)(kr0 + lane) * NUP + 768 + hv * 128 + 64 + wid * 8); else S.v = *(const u32x4*)(DVb + (size_t)(kr0 + lane) * 256 + hv * 64 + wid * 8); } while (0)
#define A_WRITEK(S, b) do { if (MLA) { *(LAS u32x4*)(lds + (b) * KB + k1r * KS + k1c * 2) = S.k1; if (klo) *(LAS u32x4*)(lds + (b) * KB + k2r * KS + 128 + k2c * 2) = S.k2; } \
        else if (klo) *(LAS u32x4*)(lds + (b) * KB + k1r * KS + k1c * 2) = S.k1; } while (0)
#define A_WRITEV(S, b) do { LAS unsigned short* vp = (LAS unsigned short*)(lds + OFF_V + (b) * VB + vkp); \
        vp[0 * (VS / 2)] = (unsigned short)(S.v[0] & 0xffffu); vp[1 * (VS / 2)] = (unsigned short)(S.v[0] >> 16); vp[2 * (VS / 2)] = (unsigned short)(S.v[1] & 0xffffu); vp[3 * (VS / 2)] = (unsigned short)(S.v[1] >> 16); \
        vp[4 * (VS / 2)] = (unsigned short)(S.v[2] & 0xffffu); vp[5 * (VS / 2)] = (unsigned short)(S.v[2] >> 16); vp[6 * (VS / 2)] = (unsigned short)(S.v[3] & 0xffffu); vp[7 * (VS / 2)] = (unsigned short)(S.v[3] >> 16); } while (0)
    float m_reg = 0.f, l_reg = 0.f;
    o0 = f32x16{}; o1 = f32x16{};
    f32x16 pA0, pA1, pB0, pB1;
    __syncthreads();
    A_LOADK(sA, 0); A_LOADV(sA, 0); A_LOADK(sB, 1);
    A_WRITEK(sA, 0); A_WRITEV(sA, 0); A_WRITEK(sB, 1);
    if (2 < ntile) A_LOADK(sA, 2);
    A_LOADV(sA, 1);
    __syncthreads();
    qkt<ND0, KS>(pA0, pA1, lds, qr, r32, hi);
    for (int j = 0; j < ntile; j += 2) {
        if (j + 3 < ntile) A_LOADK(sB, j + 3);
        if (j + 2 < ntile) A_LOADV(sB, j + 2);
        sm_max(pA0, pA1, m_reg, l_reg, o0, o1, j == 0);
        qkt<ND0, KS>(pB0, pB1, lds + KB, qr, r32, hi);
        sm_exp_pv(pA0, pA1, m_reg, l_reg, o0, o1, lds + OFF_V, r32, hi);
        if (j + 2 < ntile) A_WRITEK(sA, 0);
        A_WRITEV(sA, 1);
        __syncthreads();
        if (j + 4 < ntile) A_LOADK(sA, j + 4);
        if (j + 3 < ntile) A_LOADV(sA, j + 3);
        sm_max(pB0, pB1, m_reg, l_reg, o0, o1, false);
        if (j + 2 < ntile) qkt<ND0, KS>(pA0, pA1, lds, qr, r32, hi);
        sm_exp_pv(pB0, pB1, m_reg, l_reg, o0, o1, lds + OFF_V + VB, r32, hi);
        if (j + 3 < ntile) A_WRITEK(sB, 1);
        if (j + 2 < ntile) A_WRITEV(sB, 0);
        __syncthreads();
    }
#undef KROW0
#undef A_LOADK
#undef A_LOADV
#undef A_WRITEK
#undef A_WRITEV
    const float lt = l_reg + __shfl_xor(l_reg, 32); inv = __builtin_amdgcn_rcpf(lt);
}
template <bool MLA>
__device__ __forceinline__ void attn_unit(const Frame& F, const Params& p, int l, int h, int qrow0, int qpos0, int klat0, int nlat, int kctx0) {
    const int wid = F.wave, lane = F.lane, r32 = lane & 31, hi = lane >> 5;
    hf* Y = (hf*)(p.ws + A_Y);
    const size_t yrow = (size_t)(qrow0 + wid * 32 + r32) * DM;
    if constexpr (MLA) {
        f32x16 o0, o1; float inv;
        attn_pass<true>(F, p, h, h, qrow0, qpos0, klat0, nlat, kctx0, o0, o1, inv);
#pragma unroll
        for (int g = 0; g < 4; ++g) { u32x2 w; w.x = pkh(o0[4 * g] * inv, o0[4 * g + 1] * inv); w.y = pkh(o0[4 * g + 2] * inv, o0[4 * g + 3] * inv); *(u32x2*)(Y + yrow + h * 64 + 8 * g + 4 * hi) = w; }
#pragma unroll
        for (int g = 0; g < 4; ++g) { u32x2 w; w.x = pkh(o1[4 * g] * inv, o1[4 * g + 1] * inv); w.y = pkh(o1[4 * g + 2] * inv, o1[4 * g + 3] * inv); *(u32x2*)(Y + yrow + h * 64 + 32 + 8 * g + 4 * hi) = w; }
    } else {
        const float lam = ((const float*)(p.ws + WS_LAM))[2 * l], oml = ((const float*)(p.ws + WS_LAM))[2 * l + 1];
        f32x16 a0, a1;
        LAS float* park = (LAS float*)(F.lds + 65536 + wid * 8192) + lane;
        { f32x16 o0, o1; float inv; attn_pass<false>(F, p, 2 * h, h, qrow0, qpos0, klat0, nlat, kctx0, o0, o1, inv);
#pragma unroll
          for (int r = 0; r < 16; ++r) { park[r * 64] = o0[r] * inv; park[(16 + r) * 64] = o1[r] * inv; } }
        { f32x16 o0, o1; float inv; attn_pass<false>(F, p, 2 * h + 1, h, qrow0, qpos0, klat0, nlat, kctx0, o0, o1, inv);
#pragma unroll
          for (int r = 0; r < 16; ++r) { a0[r] = park[r * 64] - o0[r] * (lam * inv); a1[r] = park[(16 + r) * 64] - o1[r] * (lam * inv); } }
        float ss = 0.f;
#pragma unroll
        for (int r = 0; r < 16; ++r) ss += a0[r] * a0[r] + a1[r] * a1[r];
        ss += __shfl_xor(ss, 32);
        const float rs = rsqrtf(ss * (1.f / 64.f) + EPS) * oml;
#pragma unroll
        for (int g = 0; g < 4; ++g) { const f32x4 gg = *(const f32x4*)(p.in[I_SUBG] + l * 64 + 8 * g + 4 * hi);
            u32x2 w; w.x = pkh(a0[4 * g] * rs * gg[0], a0[4 * g + 1] * rs * gg[1]); w.y = pkh(a0[4 * g + 2] * rs * gg[2], a0[4 * g + 3] * rs * gg[3]); *(u32x2*)(Y + yrow + 768 + h * 64 + 8 * g + 4 * hi) = w; }
#pragma unroll
        for (int g = 0; g < 4; ++g) { const f32x4 gg = *(const f32x4*)(p.in[I_SUBG] + l * 64 + 32 + 8 * g + 4 * hi);
            u32x2 w; w.x = pkh(a1[4 * g] * rs * gg[0], a1[4 * g + 1] * rs * gg[1]); w.y = pkh(a1[4 * g + 2] * rs * gg[2], a1[4 * g + 3] * rs * gg[3]); *(u32x2*)(Y + yrow + 768 + h * 64 + 32 + 8 * g + 4 * hi) = w; }
    }
}
}

template <int L>
__device__ __forceinline__ void hyena_unit(const Frame& F, const hf* Rrow  , const hf* U  , const hf* X0  , hf* Ycol  ) {
    constexpr int NM = L / 256, RL = 2 * L, SH = (L > 1024) ? 1024 : L, NH = L / SH, US = SH * 2 + 16;
    constexpr int OFF_U = 8 * RL * 2;
    static_assert(OFF_U + 32 * US <= LDS_MISC, "hyena LDS");
    const int tid = F.tid, w = F.wave, lane = F.lane, i32 = lane & 31, hi = lane >> 5;
    LAS unsigned char* lds = F.lds;
    __syncthreads();
    for (int idx = tid; idx < 8 * RL; idx += 512) { const int cw = idx / RL, x = idx % RL; ((LAS hf*)lds)[idx] = (x >= cw) ? Rrow[x - cw] : (hf)0.f; }
    f32x16 acc[NM];
#pragma unroll
    for (int m = 0; m < NM; ++m) acc[m] = f32x16{};
    const LAS unsigned char* cpy = lds + w * (RL * 2);
    for (int half = 0; half < NH; ++half) {
        __syncthreads();
        for (int idx = tid; idx < 32 * (SH / 8); idx += 512) { const int b = idx / (SH / 8), pc = idx % (SH / 8);
            *(LAS u32x4*)(lds + OFF_U + b * US + pc * 16) = *(const u32x4*)(U + (size_t)b * L + half * SH + pc * 8); }
        __syncthreads();
#pragma unroll 2
        for (int jl = 0; jl < SH / 16; ++jl) {
            const int j = half * (SH / 16) + jl;
            const hf8 bf = *(const LAS hf8*)(lds + OFF_U + i32 * US + (jl * 16 + hi * 8) * 2);
            const int x0 = L + 16 * j + 8 * hi - 8 * i32;
#pragma unroll
            for (int m = 0; m < NM; ++m) { const hf8 af = *(const LAS hf8*)(cpy + (x0 - 256 * m) * 2);
                acc[m] = __builtin_amdgcn_mfma_f32_32x32x16_f16(af, bf, acc[m], 0, 0, 0); }
        }
    }
    const hf* x0p = X0 + (size_t)i32 * L + w + 32 * hi;
    hf* yp = Ycol + ((size_t)i32 * L + w + 32 * hi) * DM;
#pragma unroll
    for (int m = 0; m < NM; ++m) {
#pragma unroll
        for (int r = 0; r < 16; ++r) { const int tt = 256 * m + 8 * ((r & 3) + 8 * (r >> 2));
            const float x0v = (float)x0p[tt];
            yp[(size_t)tt * DM] = (hf)(x0v * acc[m][r]); }
        asm volatile("" ::: "memory");
    }
}

#ifndef PH_MASK
#define PH_MASK 0x1FFFF
#endif
#define PHM(k) ((PH_MASK >> (k)) & 1)
#ifndef PROBE_REP
#define PROBE_REP 0
#endif
#define NREP(k) (((PROBE_REP >> (k)) & 1) ? 2 : 1)
constexpr int NPH_LAYER = 9, PH_L0 = 2, NPHASE = PH_L0 + DEPTH * NPH_LAYER + 1;
__global__ void __launch_bounds__(512, 2) fwd_kernel(Params p) {
    extern __shared__ __attribute__((aligned(16))) unsigned char lds_raw[];
    Frame F0; Frame& F = F0;
    F.lds = (LAS unsigned char*)lds_raw;
    F.tid = threadIdx.x; F.lane = F.tid & 63; F.wave = __builtin_amdgcn_readfirstlane(F.tid >> 6);
    F.G = gridDim.x; { const int bx = blockIdx.x; F.vcu = (F.G % 8 == 0) ? (bx % 8) * (F.G / 8) + bx / 8 : bx; }
    volatile LAS unsigned* misc = (volatile LAS unsigned*)(F.lds + LDS_MISC);
    if (F.tid < 16) misc[F.tid] = 0u;
    __syncthreads();
    const int lo = p.ph_lo, hi = p.ph_hi;
    XcdBarrier bar; bar.bar = (unsigned*)(p.ws + WS_BAR); bar.x = 0; bar.st = misc;
    if (hi - lo > 1) bar = xcd_barrier_post((unsigned*)(p.ws + WS_BAR), misc);
#define IN(k) (lo <= (k) && (k) < hi)
#define LAUNDER(Fl) Frame Fl = F0; asm volatile("" : "+v"(Fl.tid), "+v"(Fl.lane))
#define SEAM(k) do { if (IN(k) && IN((k) + 1)) xcd_barrier(bar); } while (0)
    unsigned char* ws = p.ws;
    float* X = p.out; float* XC = (float*)(ws + WS_XC);
    hf* XS1 = (hf*)(ws + A_A); hf* MM = (hf*)(ws + A_A); hf* Y = (hf*)(ws + A_B); hf* XS2 = (hf*)(ws + A_B);
    hf* P1 = (hf*)(ws + A_P1); hf* QKV = (hf*)(ws + A_QKV); hf* QKVN = (hf*)(ws + A_QKVN);
    hf* Gt = (hf*)(ws + A_G); hf* HID = (hf*)(ws + A_HID);
    float* SS = (float*)(ws + WS_SS);

    if (PHM(11) && IN(0)) { LAUNDER(Fl); prologue_a(Fl, p); }
    SEAM(0);
    if (PHM(11) && IN(1)) { LAUNDER(Fl); prologue_b(Fl, p); }
    SEAM(1);

    for (int l = 0; l < DEPTH; ++l) {
        const int pb = PH_L0 + l * NPH_LAYER;
        const bool ctx_live = l < DEPTH - 1;
        const int Mrows = ctx_live ? MTOT : NLAT;
        const float* xin_lat = (l == 0) ? p.in[I_X] : X; const float* xin_ctx = (l == 0) ? p.in[I_CTX] : XC;
        const float* modl = (const float*)(ws + WS_MOD) + (size_t)l * NMODV * MODW;
        const float* biasl = (const float*)(ws + WS_BIAS) + (size_t)l * NMODV * NBIAS;
        const float* gsl = (const float*)(ws + WS_GS) + (size_t)l * 2 * NMODV * DM;
        const unsigned char* wl = ws + WS_WT + (size_t)(l & 1) * W_LAYER;
        float* ss1 = SS + (size_t)(SS_1 + l) * MTOT; float* ss2 = SS + (size_t)(SS_2 + l) * MTOT;

        if (PHM(1) && IN(pb + 0)) for (int rep = 0; rep < NREP(1); ++rep) { pg8::Gemm g{XS1, (const hf*)(wl + W_IN1), MTOT, NP1, DM, DM, DM}; pg8::StaticOrder S; S.init(MTOT, NP1, F.G, (int)blockIdx.x);
            pg8::EpiHalf<0, true> E{P1, NP1, ss1, biasl + B_IN}; pg8::gemm_phase(F.lds, g, S, E); }
        SEAM(pb + 0);
        if (PHM(2) && IN(pb + 1)) for (int rep = 0; rep < NREP(2); ++rep) { LAUNDER(Fl); prep_rows(Fl, p, l); prep_hyena(Fl, p, l);
            __syncthreads();
            if (rep == 0 && l + 1 < DEPTH) convert_layer(Fl, p, l + 1, ws + WS_WT + (size_t)((l + 1) & 1) * W_LAYER); }
        SEAM(pb + 1);
        if (PHM(3) && IN(pb + 2)) for (int rep = 0; rep < NREP(3); ++rep) { pg8::Gemm g{QKVN, (const hf*)(wl + W_UP), MTOT, NUP, KUP, KUP, KUP}; pg8::StaticOrder S; S.init(MTOT, NUP, F.G, (int)blockIdx.x);
            pg8::EpiHalf<0, false> E{QKV, NUP, nullptr, nullptr}; pg8::gemm_phase(F.lds, g, S, E); }
        SEAM(pb + 2);
        if (PHM(4) && IN(pb + 3)) for (int rep = 0; rep < NREP(4); ++rep) {
            LAUNDER(Fl);
            const int n_mla = 2048 + (ctx_live ? 256 : 0);
            if (PHM(13)) for (int rp = 0; rp < NREP(13); ++rp) for (int id = F.vcu; id < n_mla; id += F.G) {
                if (id < 2048) { const int qb = id & 7, h = (id >> 3) & 7, b = id >> 6; att::attn_unit<true>(Fl, p, l, h, b * SEQ + qb * 256, qb * 256, b * SEQ, 32, NLAT + b * CTXL); }
                else { const int i2 = id - 2048, h = i2 & 7, b = i2 >> 3; att::attn_unit<true>(Fl, p, l, h, NLAT + b * CTXL, -1, 0, 0, NLAT + b * CTXL); }
            }
            const int n_df = 1024 + (ctx_live ? 128 : 0);
            if (PHM(14)) for (int rp = 0; rp < NREP(14); ++rp) for (int id = F.vcu; id < n_df; id += F.G) {
                if (id < 1024) { const int qb = id & 7, h = (id >> 3) & 3, b = id >> 5; att::attn_unit<false>(Fl, p, l, h, b * SEQ + qb * 256, qb * 256, b * SEQ, 32, NLAT + b * CTXL); }
                else { const int i2 = id - 1024, h = i2 & 3, b = i2 >> 2; att::attn_unit<false>(Fl, p, l, h, NLAT + b * CTXL, -1, 0, 0, NLAT + b * CTXL); }
            }
            if (PHM(15)) for (int rp = 0; rp < NREP(15); ++rp) for (int c = F.vcu; c < 256; c += F.G)
                hyena_unit<SEQ>(Fl, (const hf*)(ws + WS_RF) + ((size_t)l * 256 + c) * 4096, (const hf*)(ws + A_UT) + (size_t)c * NLAT, (const hf*)(ws + A_X0T) + (size_t)c * NLAT, Y + 512 + c);
            if (PHM(16) && ctx_live) for (int rp = 0; rp < NREP(15); ++rp) for (int c = F.vcu; c < 256; c += F.G)
                hyena_unit<CTXL>(Fl, (const hf*)(ws + WS_RFC) + ((size_t)l * 256 + c) * 512, (const hf*)(ws + A_UTC) + (size_t)c * NCTX, (const hf*)(ws + A_X0TC) + (size_t)c * NCTX, Y + (size_t)NLAT * DM + 512 + c);
            __syncthreads();
        }
        SEAM(pb + 3);
        if (PHM(5) && IN(pb + 4)) for (int rep = 0; rep < NREP(5); ++rep) { pg8::Gemm g{XS1, (const hf*)(wl + W_ING), Mrows, NGATE, DM, DM, DM}; pg8::StaticOrder S; S.init(Mrows, NGATE, F.G, (int)blockIdx.x);
            pg8::EpiHalf<1, true> E{Gt, NGATE, ss1, biasl + B_G}; pg8::gemm_phase(F.lds, g, S, E); }
        SEAM(pb + 4);
        if (PHM(6) && IN(pb + 5)) for (int rep = 0; rep < NREP(6); ++rep) { pg8::StaticOrder S; S.init(Mrows, DM, F.G, (int)blockIdx.x); const hf* wbr = (const hf*)(wl + W_BR);
            { pg8::Gemm g{Y, wbr, Mrows, DM, 512, DM, DM}; pg8::EpiGated<true> E{MM, Gt, 0}; pg8::gemm_phase(F.lds, g, S, E); }
            { pg8::Gemm g{Y + 512, wbr + 512, Mrows, DM, 256, DM, DM}; pg8::EpiGated<false> E{MM, Gt, 1024}; pg8::gemm_phase(F.lds, g, S, E); }
            { pg8::Gemm g{Y + 768, wbr + 768, Mrows, DM, 256, DM, DM}; pg8::EpiGated<false> E{MM, Gt, 2048}; pg8::gemm_phase(F.lds, g, S, E); } }
        SEAM(pb + 5);
        if (PHM(7) && IN(pb + 6)) { pg8::Gemm g{MM, (const hf*)(wl + W_OUT), Mrows, DM, DM, DM, DM}; pg8::StaticOrder S; S.init(Mrows, DM, F.G, (int)blockIdx.x);
            pg8::EpiResidX<true, true> E{xin_lat, xin_ctx, X, XC, modl + 2 * DM, XS2, gsl + (size_t)NMODV * DM, ss2}; pg8::gemm_phase(F.lds, g, S, E); }
        SEAM(pb + 6);
        if (PHM(9) && IN(pb + 7)) for (int rep = 0; rep < NREP(9); ++rep) { pg8::Gemm g{XS2, (const hf*)(wl + W_FC1), Mrows, DFF, DM, DM, DM}; pg8::StaticOrder S; S.init(Mrows, DFF, F.G, (int)blockIdx.x);
            pg8::EpiHalf<2, true> E{HID, DFF, ss2, biasl + B_FC1}; pg8::gemm_phase(F.lds, g, S, E); }
        SEAM(pb + 7);
        if (PHM(10) && IN(pb + 8)) { pg8::Gemm g{HID, (const hf*)(wl + W_FC2), Mrows, DM, DFF, DFF, DFF}; pg8::StaticOrder S; S.init(Mrows, DM, F.G, (int)blockIdx.x);
            if (ctx_live) { pg8::EpiResidX<true, true> E{X, XC, X, XC, modl + 5 * DM, XS1, gsl + (size_t)2 * NMODV * DM, ss1 + MTOT}; pg8::gemm_phase(F.lds, g, S, E); }
            else { pg8::EpiResidX<false, true> E{X, XC, X, XC, modl + 5 * DM, nullptr, nullptr, SS + (size_t)SS_F * MTOT}; pg8::gemm_phase(F.lds, g, S, E); } }
        SEAM(pb + 8);
    }
    if (PHM(12) && IN(NPHASE - 1)) { LAUNDER(Fl); final_norm_phase(Fl, X, p.in[I_FNG], SS + (size_t)SS_F * MTOT); }
#undef IN
#undef SEAM
}

extern "C" void kernel_launch(void* const* d_in, const int* in_sizes, int n_in, void* d_out, int out_size, void* d_ws, size_t ws_size, hipStream_t stream) {
    static int grid = 0;
    if (grid == 0) {
        if (n_in != 35 || in_sizes[0] != NLAT * DM || out_size != NLAT * DM || ws_size < WS_END) {
            fprintf(stderr, "kernel_launch: unexpected shapes: n_in %d in0 %d out %d ws %zu (need %zu); nothing launched\n", n_in, n_in > 0 ? in_sizes[0] : -1, out_size, ws_size, (size_t)WS_END); grid = -1; return; }
        int dev = 0, cus = 0, per_cu = 0;
        if (hipGetDevice(&dev) != hipSuccess || hipDeviceGetAttribute(&cus, hipDeviceAttributeMultiprocessorCount, dev) != hipSuccess) { fprintf(stderr, "kernel_launch: device query failed\n"); grid = -1; return; }
        if (hipFuncSetAttribute((const void*)fwd_kernel, hipFuncAttributeMaxDynamicSharedMemorySize, LDS_BYTES) != hipSuccess) { fprintf(stderr, "kernel_launch: hipFuncSetAttribute failed\n"); grid = -1; return; }
        if (hipOccupancyMaxActiveBlocksPerMultiprocessor(&per_cu, (const void*)fwd_kernel, 512, LDS_BYTES) != hipSuccess || per_cu < 1)
            fprintf(stderr, "kernel_launch: note: occupancy query reports %d workgroups per CU\n", per_cu);
        (void)hipGetLastError();
        grid = cus;
    }
    if (grid < 0) return;
    if (hipMemsetAsync((char*)d_ws + WS_BAR, 0, WS_ZERO_BYTES, stream) != hipSuccess) { fprintf(stderr, "kernel_launch: memset failed\n"); return; }
    Params P{};
    for (int i = 0; i < 35; ++i) P.in[i] = (const float*)d_in[i];
    P.out = (float*)d_out; P.ws = (unsigned char*)d_ws;
#if MK_FUSED
    P.ph_lo = 0; P.ph_hi = NPHASE;
    hipLaunchKernelGGL(fwd_kernel, dim3(grid), dim3(512), LDS_BYTES, stream, P);
#else
    for (int ph = 0; ph < NPHASE; ++ph) { P.ph_lo = ph; P.ph_hi = ph + 1; hipLaunchKernelGGL(fwd_kernel, dim3(grid), dim3(512), LDS_BYTES, stream, P); }
#endif
    const hipError_t le = hipPeekAtLastError();
    if (le != hipSuccess) fprintf(stderr, "kernel_launch: launch failed: %s\n", hipGetErrorName(le));
}
```

```cpp
#include <hip/hip_runtime.h>
#include <cstdio>
#include <cstdint>

#ifndef MK_FUSED
#define MK_FUSED 1
#endif

#define LAS __attribute__((address_space(3)))
#define GAS __attribute__((address_space(1)))
typedef _Float16 hf;
typedef _Float16 hf2 __attribute__((ext_vector_type(2)));
typedef _Float16 hf4 __attribute__((ext_vector_type(4)));
typedef _Float16 hf8 __attribute__((ext_vector_type(8)));
typedef short s16x4 __attribute__((ext_vector_type(4)));
typedef float f32x2 __attribute__((ext_vector_type(2)));
typedef float f32x4 __attribute__((ext_vector_type(4)));
typedef float f32x16 __attribute__((ext_vector_type(16)));
typedef unsigned u32x2 __attribute__((ext_vector_type(2)));
typedef unsigned u32x4 __attribute__((ext_vector_type(4)));

constexpr int DM = 1024, NB = 32, SEQ = 2048, DEPTH = 4, CTXL = 256, GRIDW = 64;
constexpr int NLAT = NB * SEQ;
constexpr int NCTX = NB * CTXL;
constexpr int MTOT = NLAT + NCTX;
constexpr int D_IN = 5024, NP1 = 2048  , NGATE = 3072, DFF = 4096;
constexpr int C_PQ = 0, C_PKV = 256, C_PKR = 384, C_HY = 416, C_DQ = 1184, C_DK = 1440, C_DV = 1696, C_PG = 1952;
constexpr int NUP = 1792, KUP = 384;
constexpr int NMODV = 33, MODW = 6 * DM;
constexpr float EPS = 1e-6f;
constexpr float MLA_SCALE = 0.10206207261596575f;
constexpr float DF_SCALE = 0.17677669529663687f;

constexpr size_t al256(size_t x) { return (x + 255) / 256 * 256; }
constexpr size_t WS_BAR = 0, WS_BAR_BYTES = 65536;
constexpr size_t WS_SS = WS_BAR + WS_BAR_BYTES;
constexpr int SS_1 = 0, SS_2 = DEPTH, SS_F = 2 * DEPTH, SS_Q = 2 * DEPTH + 1, SS_KV = 3 * DEPTH + 1, SS_N = 4 * DEPTH + 1;
constexpr size_t WS_ZERO_BYTES = WS_BAR_BYTES + al256((size_t)SS_N * MTOT * 4);
constexpr size_t WS_MOD = WS_BAR + WS_ZERO_BYTES;
constexpr size_t WS_GS = WS_MOD + al256((size_t)DEPTH * NMODV * MODW * 4);
constexpr int NBIAS = 9216, B_IN = 0, B_G = 2048, B_FC1 = 5120;
constexpr size_t WS_BIAS = WS_GS + (size_t)DEPTH * 2 * NMODV * DM * 4;
constexpr size_t WS_ROPE = WS_BIAS + (size_t)DEPTH * NMODV * NBIAS * 4;
constexpr size_t WS_LAM = WS_ROPE + (size_t)SEQ * 32 * 4;
constexpr size_t WS_RF = WS_LAM + 256;
constexpr size_t WS_RFC = WS_RF + (size_t)DEPTH * 256 * 4096 * 2;
constexpr size_t WS_XC = WS_RFC + (size_t)DEPTH * 256 * 512 * 2;
constexpr size_t WS_WT = WS_XC + (size_t)NCTX * DM * 4;
constexpr size_t W_IN1 = 0, W_ING = W_IN1 + (size_t)NP1 * DM * 2, W_UP = W_ING + (size_t)NGATE * DM * 2, W_BR = W_UP + (size_t)NUP * KUP * 2,
                 W_OUT = W_BR + (size_t)DM * DM * 2, W_FC1 = W_OUT + (size_t)DM * DM * 2, W_FC2 = W_FC1 + (size_t)DFF * DM * 2, W_LAYER = W_FC2 + (size_t)DM * DFF * 2;
constexpr size_t WS_ARENA = WS_WT + 2 * W_LAYER;
constexpr size_t SZ_ROW1024 = (size_t)MTOT * 1024 * 2;
constexpr size_t A_A = WS_ARENA;
constexpr size_t A_B = A_A + SZ_ROW1024;
constexpr size_t A_C = A_B + SZ_ROW1024;
constexpr size_t A_H = A_A, A_Y = A_B, A_XS2 = A_B, A_BIG = A_C;
constexpr size_t A_QKVN = A_BIG;
constexpr size_t A_KR = A_QKVN + (size_t)MTOT * KUP * 2;
constexpr size_t A_DQ = A_KR + (size_t)MTOT * 32 * 2;
constexpr size_t A_DK = A_DQ + (size_t)MTOT * 256 * 2;
constexpr size_t A_DV = A_DK + (size_t)MTOT * 256 * 2;
constexpr size_t A_UT = A_DV + (size_t)MTOT * 256 * 2;
constexpr size_t A_X0T = A_UT + (size_t)256 * NLAT * 2;
constexpr size_t A_UTC = A_X0T + (size_t)256 * NLAT * 2;
constexpr size_t A_X0TC = A_UTC + (size_t)256 * NCTX * 2;
constexpr size_t A_PHY = A_X0TC + (size_t)256 * NCTX * 2;
constexpr size_t A_QKV = A_PHY;
constexpr size_t A_BIG_END = A_QKV + (size_t)MTOT * NUP * 2;
constexpr size_t A_G = A_BIG;
constexpr size_t A_HID = A_C;
constexpr size_t WS_END = (A_BIG_END > A_HID + (size_t)MTOT * DFF * 2) ? A_BIG_END : A_HID + (size_t)MTOT * DFF * 2;
static_assert(WS_END <= (size_t)1024 * 1024 * 1024, "workspace map exceeds 1 GiB");

constexpr int LDS_BYTES = 147456;
constexpr int LDS_MISC = LDS_BYTES - 64;

__device__ __forceinline__ unsigned pkh(float lo, float hi) { f32x2 v = {lo, hi}; hf2 h = __builtin_convertvector(v, hf2); return __builtin_bit_cast(unsigned, h); }
__device__ __forceinline__ float wave_sum(float v) {
#pragma unroll
    for (int o = 1; o < 64; o <<= 1) v += __shfl_xor(v, o);
    return v;
}
#define LDS_WAIT() asm volatile("s_waitcnt lgkmcnt(0)" ::: "memory")
#define VM_WAIT() asm volatile("s_waitcnt vmcnt(0)" ::: "memory")

#define XB_TMO      128
#define XB_XCNT(j)  (256  + 64 * (j))
#define XB_XSUB(j)  (1280 + 64 * (j))
#define XB_XGEN(j)  (2304 + 64 * (j))
#define XB_TOP      3328
#define XB_TOPGEN   3392
#define XCD_BAR_WORDS 3456
#define XB_SPIN_CAP (1u << 22)
__device__ __forceinline__ unsigned xb_ld(unsigned* p)              { return __hip_atomic_load(p, __ATOMIC_RELAXED, __HIP_MEMORY_SCOPE_AGENT); }
__device__ __forceinline__ unsigned xb_add(unsigned* p, unsigned v) { return __hip_atomic_fetch_add(p, v, __ATOMIC_RELAXED, __HIP_MEMORY_SCOPE_AGENT); }
__device__ __forceinline__ unsigned xb_xcc_id() { return (unsigned)__builtin_amdgcn_s_getreg((3 << 11) | 20) & 0xFu; }
#define XB_SPIN(cond, bar) do { unsigned _sp = 0; while (cond) { __builtin_amdgcn_s_sleep(1); \
    if ((++_sp & 255u) == 0u) { if (xb_ld(&(bar)[XB_TMO])) break; if (_sp > XB_SPIN_CAP) { atomicAdd(&(bar)[XB_TMO], 1u); break; } } } } while (0)
struct XcdBarrier { unsigned* bar; unsigned x; volatile LAS unsigned* st; };
__device__ __forceinline__ XcdBarrier xcd_barrier_post(unsigned* bar, volatile LAS unsigned* st) {
    XcdBarrier b; b.bar = bar; b.x = xb_xcc_id(); b.st = st;
    if (threadIdx.x == 0) (void)xb_add(&bar[XB_XCNT(b.x)], 1u);
    return b;
}
__device__ __forceinline__ void xcd_barrier_complete(unsigned* bar, unsigned x, unsigned& nloc, unsigned& nx) {
    const unsigned G = gridDim.x * gridDim.y * gridDim.z;
    unsigned sum, cnt, mine, sp = 0u;
    for (;;) {
        sum = 0u; cnt = 0u; mine = 0u;
#pragma unroll
        for (unsigned j = 0; j < 16; ++j) { const unsigned c = xb_ld(&bar[XB_XCNT(j)]); sum += c; cnt += (c > 0u) ? 1u : 0u; mine = (j == x) ? c : mine; }
        if (sum == G) break;
        __builtin_amdgcn_s_sleep(1);
        if ((++sp & 255u) == 0u) { if (xb_ld(&bar[XB_TMO])) break; if (sp > XB_SPIN_CAP) { atomicAdd(&bar[XB_TMO], 1u); break; } }
    }
    nloc = mine > 0u ? mine : 1u; nx = cnt > 0u ? cnt : 1u;
}
__device__ __forceinline__ void xcd_barrier(const XcdBarrier& b) {
    asm volatile("s_waitcnt vmcnt(0)" ::: "memory");
    __syncthreads();
    if (threadIdx.x == 0) {
        unsigned* bar = b.bar;
        __builtin_amdgcn_s_waitcnt(0);
        unsigned nloc = b.st[0], nx = b.st[1];
        if (nloc == 0u) { xcd_barrier_complete(bar, b.x, nloc, nx); b.st[0] = nloc; b.st[1] = nx; }
        const unsigned old = xb_add(&bar[XB_XSUB(b.x)], 1u);
        const unsigned gen = old / nloc;
        if (old + 1u == (gen + 1u) * nloc) {
            __builtin_amdgcn_fence(__ATOMIC_RELEASE, "agent");
            asm volatile("s_waitcnt vmcnt(0)" ::: "memory");
            const unsigned og = xb_add(&bar[XB_TOP], 1u);
            const unsigned tg = og / nx;
            if (og + 1u == (tg + 1u) * nx) xb_add(&bar[XB_TOPGEN], 1u);
            else XB_SPIN(xb_ld(&bar[XB_TOPGEN]) == tg, bar);
            __builtin_amdgcn_fence(__ATOMIC_ACQUIRE, "agent");
            xb_add(&bar[XB_XGEN(b.x)], 1u);
            asm volatile("s_waitcnt vmcnt(0)" ::: "memory");
        } else {
            XB_SPIN(xb_ld(&bar[XB_XGEN(b.x)]) == gen, bar);
            __builtin_amdgcn_fence(__ATOMIC_ACQUIRE, "agent");
            asm volatile("s_waitcnt vmcnt(0)" ::: "memory");
        }
    }
    __syncthreads();
}

namespace pg8 {
constexpr int BM = 256, BK = 64, HALF = 128, HTB = HALF * BK * 2, STAGE_BYTES = 8 * HTB, NXCD = 8, WGM = 8;
__host__ __device__ __forceinline__ int lds_byte(int r, int c) { const int st = (r >> 4) * 2 + (c >> 5), rr = r & 15, cc = c & 31, ob = rr * 64 + cc * 2; return st * 1024 + (ob ^ (((ob >> 9) & 1) << 5)); }
__host__ __device__ __forceinline__ void stage_rc(int b, int& R, int& C) { const int st = b / 1024, sb = b % 1024, swz = sb ^ (((sb >> 9) & 1) << 5); R = (st >> 1) * 16 + swz / 64; C = (st & 1) * 32 + (swz % 64) / 2; }
__host__ __device__ __forceinline__ int perm32(int rho) { const int n = rho >> 4, i = rho & 15; return 8 * (i >> 2) + 4 * n + (i & 3); }
struct Unit { int pm, pn; };
struct Gemm { const hf* A; const hf* Bt; int M, N, K, lda, ldb; };
struct StaticOrder {
    int nM, nN, nwg, G, c;
    __host__ __device__ void init(int M, int N, int G_, int c_) { nM = M / BM; nN = N / BM; nwg = nM * nN; G = G_; c = c_; }
    __host__ __device__ bool next(int i, Unit& u) const {
        const long L = (long)i * G + c; if (L >= nwg) return false;
        int wgid = (int)L; { const int q = nwg / NXCD, r = nwg % NXCD, xcd = wgid % NXCD, off = wgid / NXCD; wgid = (xcd < r ? xcd * (q + 1) : r * (q + 1) + (xcd - r) * q) + off; }
        const int nig = WGM * nN, gid = wgid / nig, fm = gid * WGM, gsz = (nM - fm) < WGM ? (nM - fm) : WGM;
        u.pm = fm + ((wgid % nig) % gsz); u.pn = (wgid % nig) / gsz; return true;
    }
    __device__ __forceinline__ void a_ready(const Unit&) const {}
    __device__ __forceinline__ void done(const Unit&) const {}
};

template <int ACT  , bool NORM> struct EpiHalf {
    static constexpr bool PERM = true, AFTER_DRAIN = false, PROBE2 = false;
    hf* O; int ldc; const float* ss; const float* bias;
    __device__ __forceinline__ void operator()(const f32x4 (&acc)[2][2][4][2], const Unit& u, int wr, int wc, int fr, int fq) const {
        const int row0 = u.pm * BM + wr * 64 + fr, col0 = u.pn * BM + wc * 32 + 8 * fq;
        f32x4 bv[2][2];
        if (NORM) { const int R0 = u.pm * BM; const int v = (R0 < NLAT) ? (R0 >> 11) : NB; const float* bp = bias + (size_t)v * NBIAS + col0;
#pragma unroll
            for (int bj = 0; bj < 2; ++bj)
#pragma unroll
                for (int n = 0; n < 2; ++n) bv[bj][n] = *(const f32x4*)(bp + bj * HALF + 4 * n); }
#pragma unroll
        for (int ai = 0; ai < 2; ++ai)
#pragma unroll
            for (int m = 0; m < 4; ++m) { const int r = row0 + ai * HALF + m * 16; hf* rowp = O + (size_t)r * ldc + col0;
                float rs = 1.f; if (NORM) rs = rsqrtf(ss[r] * (1.f / DM) + EPS);
#pragma unroll
                for (int bj = 0; bj < 2; ++bj) { f32x4 v0 = acc[ai][bj][m][0], v1 = acc[ai][bj][m][1];
                    if (NORM) { v0 = v0 * rs + bv[bj][0]; v1 = v1 * rs + bv[bj][1]; }
                    if (ACT == 1) {
#pragma unroll
                        for (int e = 0; e < 4; ++e) { v0[e] = __builtin_amdgcn_rcpf(1.f + __builtin_amdgcn_exp2f(-1.4426950408889634f * v0[e])); v1[e] = __builtin_amdgcn_rcpf(1.f + __builtin_amdgcn_exp2f(-1.4426950408889634f * v1[e])); } }
                    if (ACT == 2) {
#pragma unroll
                        for (int e = 0; e < 4; ++e) { const float a = fmaxf(v0[e], 0.f), b = fmaxf(v1[e], 0.f); v0[e] = a * a; v1[e] = b * b; } }
                    u32x4 w; w.x = pkh(v0[0], v0[1]); w.y = pkh(v0[2], v0[3]); w.z = pkh(v1[0], v1[1]); w.w = pkh(v1[2], v1[3]);
                    *(u32x4*)(rowp + bj * HALF) = w; } }
    }
};
struct EpiIn {
    static constexpr bool PERM = true, AFTER_DRAIN = false, PROBE2 = false;
    hf* QKVNo; hf* KRo; hf* PHYo; hf* DQo; hf* DKo; hf* DVo; const float* ss; const float* bias; float* ssq; float* sskv;
    __device__ __forceinline__ void operator()(const f32x4 (&acc)[2][2][4][2], const Unit& u, int wr, int wc, int fr, int fq) const {
        const int R0 = u.pm * BM, row0 = R0 + wr * 64 + fr, col0 = u.pn * BM + wc * 32 + 8 * fq;
        const int v = (R0 < NLAT) ? (R0 >> 11) : NB; const float* bp = bias + (size_t)v * NBIAS + col0;
        f32x4 bv[2][2]; hf* dst[2]; int ld[2];
#pragma unroll
        for (int bj = 0; bj < 2; ++bj) { const int c8 = col0 + bj * HALF;
            bv[bj][0] = *(const f32x4*)(bp + bj * HALF); bv[bj][1] = *(const f32x4*)(bp + bj * HALF + 4);
            if (c8 < C_PKR) { dst[bj] = QKVNo + c8; ld[bj] = KUP; }
            else if (c8 < C_HY) { dst[bj] = KRo + (c8 - C_PKR); ld[bj] = 32; }
            else if (c8 < C_DQ) { dst[bj] = PHYo + (c8 - C_HY); ld[bj] = 768; }
            else if (c8 < C_DK) { dst[bj] = DQo + (c8 - C_DQ); ld[bj] = 256; }
            else if (c8 < C_DV) { dst[bj] = DKo + (c8 - C_DK); ld[bj] = 256; }
            else if (c8 < C_PG) { dst[bj] = DVo + (c8 - C_DV); ld[bj] = 256; }
            else { dst[bj] = nullptr; ld[bj] = 0; } }
        const int nstat = (u.pn == 0) ? 2 : (u.pn == 1 ? 1 : 0);
        float* sp = (u.pn == 0) ? ssq : sskv;
#pragma unroll
        for (int ai = 0; ai < 2; ++ai)
#pragma unroll
            for (int m = 0; m < 4; ++m) { const int r = row0 + ai * HALF + m * 16; const float rs = rsqrtf(ss[r] * (1.f / DM) + EPS); float sq = 0.f;
#pragma unroll
                for (int bj = 0; bj < 2; ++bj) { const f32x4 v0 = acc[ai][bj][m][0] * rs + bv[bj][0], v1 = acc[ai][bj][m][1] * rs + bv[bj][1];
                    if (bj < nstat) sq += (v0[0] * v0[0] + v0[1] * v0[1]) + (v0[2] * v0[2] + v0[3] * v0[3]) + (v1[0] * v1[0] + v1[1] * v1[1]) + (v1[2] * v1[2] + v1[3] * v1[3]);
                    if (dst[bj]) { u32x4 w; w.x = pkh(v0[0], v0[1]); w.y = pkh(v0[2], v0[3]); w.z = pkh(v1[0], v1[1]); w.w = pkh(v1[2], v1[3]); *(u32x4*)(dst[bj] + (size_t)r * ld[bj]) = w; } }
                if (nstat) { sq += __shfl_xor(sq, 16); sq += __shfl_xor(sq, 32);
                    if (fq == 0) (void)__hip_atomic_fetch_add(sp + r, sq, __ATOMIC_RELAXED, __HIP_MEMORY_SCOPE_AGENT); } }
    }
};
struct EpiUp {
    static constexpr bool PERM = true, AFTER_DRAIN = false, PROBE2 = false;
    hf* O; const float* ssq; const float* sskv;
    __device__ __forceinline__ void operator()(const f32x4 (&acc)[2][2][4][2], const Unit& u, int wr, int wc, int fr, int fq) const {
        const int row0 = u.pm * BM + wr * 64 + fr, col0 = u.pn * BM + wc * 32 + 8 * fq;
        const bool isq = u.pn < 3; const float* sp = isq ? ssq : sskv; const float invn = isq ? (1.f / 256.f) : (1.f / 128.f);
#pragma unroll
        for (int ai = 0; ai < 2; ++ai)
#pragma unroll
            for (int m = 0; m < 4; ++m) { const int r = row0 + ai * HALF + m * 16; hf* rowp = O + (size_t)r * NUP + col0; const float rs = rsqrtf(sp[r] * invn + EPS);
#pragma unroll
                for (int bj = 0; bj < 2; ++bj) { const f32x4 v0 = acc[ai][bj][m][0] * rs, v1 = acc[ai][bj][m][1] * rs;
                    u32x4 w; w.x = pkh(v0[0], v0[1]); w.y = pkh(v0[2], v0[3]); w.z = pkh(v1[0], v1[1]); w.w = pkh(v1[2], v1[3]);
                    *(u32x4*)(rowp + bj * HALF) = w; } }
    }
};
template <bool FIRST> struct EpiGated {
    static constexpr bool PERM = true, AFTER_DRAIN = false, PROBE2 = false;
    hf* MMo; const hf* G; int goff;
    __device__ __forceinline__ void operator()(const f32x4 (&acc)[2][2][4][2], const Unit& u, int wr, int wc, int fr, int fq) const {
        const int row0 = u.pm * BM + wr * 64 + fr, col0 = u.pn * BM + wc * 32 + 8 * fq;
#pragma unroll
        for (int ai = 0; ai < 2; ++ai)
#pragma unroll
            for (int m = 0; m < 4; ++m) { const size_t r = (size_t)(row0 + ai * HALF + m * 16);
#pragma unroll
                for (int bj = 0; bj < 2; ++bj) { const f32x4 v0 = acc[ai][bj][m][0], v1 = acc[ai][bj][m][1];
                    const hf8 g = *(const hf8*)(G + r * NGATE + goff + col0 + bj * HALF);
                    hf* mp = MMo + r * DM + col0 + bj * HALF;
                    float o[8];
#pragma unroll
                    for (int e = 0; e < 4; ++e) { o[e] = (float)g[e] * v0[e]; o[4 + e] = (float)g[4 + e] * v1[e]; }
                    if (!FIRST) { const hf8 p = *(const hf8*)mp;
#pragma unroll
                        for (int e = 0; e < 8; ++e) o[e] += (float)p[e]; }
                    u32x4 w; w.x = pkh(o[0], o[1]); w.y = pkh(o[2], o[3]); w.z = pkh(o[4], o[5]); w.w = pkh(o[6], o[7]);
                    *(u32x4*)mp = w; } }
    }
};
template <bool XS, bool STAT> struct EpiResidX {
    static constexpr bool PERM = true, AFTER_DRAIN = false, PROBE2 = false;
    const float* xs_lat; const float* xs_ctx; float* xd_lat; float* xd_ctx; const float* gate;
    hf* xsout; const float* gs; float* ss;
    __device__ __forceinline__ void operator()(const f32x4 (&acc)[2][2][4][2], const Unit& u, int wr, int wc, int fr, int fq) const {
        const int R0 = u.pm * BM; const bool lat = R0 < NLAT;
        const int v = lat ? (R0 >> 11) : NB;
        const int rglob = R0 + wr * 64 + fr, rloc = (lat ? rglob : rglob - NLAT), col0 = u.pn * BM + wc * 32 + 8 * fq;
        const float* src = lat ? xs_lat : xs_ctx; float* dst = lat ? xd_lat : xd_ctx; const float* gp = gate + (size_t)v * MODW + col0; const float* gsp = gs + (size_t)v * DM + col0;
        float sq[2][4];
#pragma unroll
        for (int ai = 0; ai < 2; ++ai)
#pragma unroll
            for (int m = 0; m < 4; ++m) sq[ai][m] = 0.f;
#pragma unroll
        for (int bj = 0; bj < 2; ++bj) {
            const f32x4 g0 = *(const f32x4*)(gp + bj * HALF), g1 = *(const f32x4*)(gp + bj * HALF + 4);
            f32x4 s0 = {1.f, 1.f, 1.f, 1.f}, s1 = s0; if (XS) { s0 = *(const f32x4*)(gsp + bj * HALF); s1 = *(const f32x4*)(gsp + bj * HALF + 4); }
#pragma unroll
            for (int ai = 0; ai < 2; ++ai)
#pragma unroll
                for (int m = 0; m < 4; ++m) { const int rr = ai * HALF + m * 16; const size_t off = (size_t)(rloc + rr) * DM + col0 + bj * HALF;
                    const f32x4 x0 = *(const f32x4*)(src + off), x1 = *(const f32x4*)(src + off + 4);
                    const f32x4 n0 = x0 + g0 * acc[ai][bj][m][0], n1 = x1 + g1 * acc[ai][bj][m][1];
                    *(f32x4*)(dst + off) = n0; *(f32x4*)(dst + off + 4) = n1;
                    if (STAT) sq[ai][m] += (n0[0] * n0[0] + n0[1] * n0[1]) + (n0[2] * n0[2] + n0[3] * n0[3]) + (n1[0] * n1[0] + n1[1] * n1[1]) + (n1[2] * n1[2] + n1[3] * n1[3]);
                    if (XS) { const f32x4 a = n0 * s0, b = n1 * s1; u32x4 w; w.x = pkh(a[0], a[1]); w.y = pkh(a[2], a[3]); w.z = pkh(b[0], b[1]); w.w = pkh(b[2], b[3]);
                        *(u32x4*)(xsout + (size_t)(rglob + rr) * DM + col0 + bj * HALF) = w; } }
        }
        if (STAT) {
#pragma unroll
            for (int ai = 0; ai < 2; ++ai)
#pragma unroll
                for (int m = 0; m < 4; ++m) { float t = sq[ai][m]; t += __shfl_xor(t, 16); t += __shfl_xor(t, 32);
                    if (fq == 0) (void)__hip_atomic_fetch_add(ss + rglob + ai * HALF + m * 16, t, __ATOMIC_RELAXED, __HIP_MEMORY_SCOPE_AGENT); }
        }
    }
};

template <class Epi, class Sched, bool ALIGN_EPI = true>
__device__ __forceinline__ void gemm_phase(LAS unsigned char* lds, const Gemm g, const Sched& S, const Epi& E) {
    int tid = threadIdx.x; asm volatile("" : "+v"(tid));
    const int wid = __builtin_amdgcn_readfirstlane(tid >> 6), lane = tid & 63, wr = wid >> 2, wc = wid & 3, fr = lane & 15, fq = lane >> 4;
    const int K = g.K, nt = K / BK;
    unsigned voffA[2], voffB[2];
#pragma unroll
    for (int i = 0; i < 2; ++i) { int R, C; stage_rc(tid * 16 + i * 8192, R, C); const int Rb = Epi::PERM ? ((R & ~31) + perm32(R & 31)) : R;
        voffA[i] = (unsigned)(R * g.lda + C) * 2u; voffB[i] = (unsigned)(Rb * g.ldb + C) * 2u; }
    const size_t kstep = (size_t)(BK * 2);
    const size_t hstepA = (size_t)HALF * g.lda * 2, hstepB = (size_t)HALF * g.ldb * 2;
    const size_t tstepA = 2 * hstepA, tstepB = 2 * hstepB;
    const unsigned ldsw = (unsigned)wid * 1024u;
    const int aoff = lds_byte(wr * 64 + fr, fq * 8), boff = lds_byte(wc * 32 + fr, fq * 8);
#define PG8_SA(b, h) (((b) * 2 + (h)) * HTB)
#define PG8_SB(b, h) ((4 + (b) * 2 + (h)) * HTB)
#define PG8_STAGE(bufoff, gbase, voff) do { _Pragma("unroll") for (int _i = 0; _i < 2; ++_i) \
        __builtin_amdgcn_global_load_lds((const unsigned*)((const char*)(gbase) + (voff)[_i]), (LAS unsigned*)(lds + (bufoff) + ldsw + _i * 8192), 16, 0, 0); } while (0)
#define PG8_LDA(dst, b, h) do { _Pragma("unroll") for (int m = 0; m < 4; ++m) _Pragma("unroll") for (int k = 0; k < 2; ++k) dst[m][k] = *(const LAS hf8*)(lds + PG8_SA(b, h) + aoff + m * 2048 + k * 1024); } while (0)
#define PG8_LDB(dst, b, h) do { _Pragma("unroll") for (int n = 0; n < 2; ++n) _Pragma("unroll") for (int k = 0; k < 2; ++k) dst[n][k] = *(const LAS hf8*)(lds + PG8_SB(b, h) + boff + n * 2048 + k * 1024); } while (0)
#define PG8_MMA(ai, bj, At, Bt) do { __builtin_amdgcn_s_setprio(1); _Pragma("unroll") for (int m = 0; m < 4; ++m) _Pragma("unroll") for (int n = 0; n < 2; ++n) _Pragma("unroll") for (int k = 0; k < 2; ++k) \
        acc[ai][bj][m][n] = __builtin_amdgcn_mfma_f32_16x16x32_f16(Bt[n][k], At[m][k], acc[ai][bj][m][n], 0, 0, 0); __builtin_amdgcn_s_setprio(0); } while (0)
#define PG8_WAIT_V(n) asm volatile("s_waitcnt vmcnt(" #n ")" ::: "memory")
#define PG8_WAIT_L(n) asm volatile("s_waitcnt lgkmcnt(" #n ")" ::: "memory")
#define PG8_BAR __builtin_amdgcn_s_barrier()
#define PG8_SCHED __builtin_amdgcn_sched_barrier(0)
    Unit cur, nxt; int ui = 0;
    if (!S.next(0, cur)) return;
    f32x4 acc[2][2][4][2];
#pragma unroll
    for (int a = 0; a < 2; ++a)
#pragma unroll
        for (int b = 0; b < 2; ++b)
#pragma unroll
            for (int m = 0; m < 4; ++m)
#pragma unroll
                for (int n = 0; n < 2; ++n) acc[a][b][m][n] = (f32x4){0.f, 0.f, 0.f, 0.f};
    hf8 At[4][2], B0[2][2], B1[2][2];
    const char* cA = (const char*)g.A + (size_t)cur.pm * tstepA; const char* cB = (const char*)g.Bt + (size_t)cur.pn * tstepB;
    S.a_ready(cur);
    PG8_STAGE(PG8_SB(0, 0), cB, voffB); PG8_STAGE(PG8_SB(0, 1), cB + hstepB, voffB); PG8_STAGE(PG8_SA(0, 0), cA, voffA); PG8_STAGE(PG8_SA(0, 1), cA + hstepA, voffA);
    if (wr == 1) PG8_BAR;
    PG8_WAIT_V(2); PG8_BAR;
    PG8_STAGE(PG8_SB(1, 0), cB + kstep, voffB); PG8_STAGE(PG8_SA(1, 0), cA + kstep, voffA); PG8_STAGE(PG8_SB(1, 1), cB + hstepB + kstep, voffB);
    PG8_WAIT_V(6); PG8_BAR;
    for (;;) {
        const bool has_next = S.next(ui + 1, nxt);
        const char* nA = has_next ? (const char*)g.A + (size_t)nxt.pm * tstepA : cA; const char* nB = has_next ? (const char*)g.Bt + (size_t)nxt.pn * tstepB : cB;
#pragma unroll 1
        for (int t = 0; t < nt; t += 2) {
            const bool last = (t == nt - 2);
            const char* a1 = cA + (size_t)(t + 1) * kstep;
            const char* a2 = last ? nA : cA + (size_t)(t + 2) * kstep; const char* b2 = last ? nB : cB + (size_t)(t + 2) * kstep;
            const char* a3 = a2 + kstep; const char* b3 = b2 + kstep;
            if (last && has_next) S.a_ready(nxt);
            PG8_LDB(B0, 0, 0); PG8_LDB(B1, 0, 1); PG8_SCHED; PG8_LDA(At, 0, 0); PG8_STAGE(PG8_SA(1, 1), a1 + hstepA, voffA);
            PG8_WAIT_V(8); PG8_WAIT_L(0); PG8_BAR; PG8_MMA(0, 0, At, B0); PG8_MMA(0, 1, At, B1); PG8_BAR; PG8_SCHED;
            PG8_LDA(At, 0, 1); PG8_STAGE(PG8_SB(0, 0), b2, voffB); PG8_STAGE(PG8_SB(0, 1), b2 + hstepB, voffB); PG8_STAGE(PG8_SA(0, 0), a2, voffA);
            PG8_WAIT_V(8); PG8_WAIT_L(0); PG8_BAR; PG8_MMA(1, 0, At, B0); PG8_MMA(1, 1, At, B1); PG8_BAR; PG8_SCHED;
            PG8_LDB(B0, 1, 0); PG8_LDB(B1, 1, 1); PG8_SCHED; PG8_LDA(At, 1, 0); PG8_STAGE(PG8_SA(0, 1), a2 + hstepA, voffA);
            PG8_WAIT_V(8); PG8_WAIT_L(0); PG8_BAR; PG8_MMA(0, 0, At, B0); PG8_MMA(0, 1, At, B1); PG8_BAR; PG8_SCHED;
            PG8_LDA(At, 1, 1); PG8_STAGE(PG8_SB(1, 0), b3, voffB); PG8_STAGE(PG8_SB(1, 1), b3 + hstepB, voffB); PG8_STAGE(PG8_SA(1, 0), a3, voffA);
            PG8_WAIT_V(8); PG8_WAIT_L(0); PG8_BAR; PG8_MMA(1, 0, At, B0); PG8_MMA(1, 1, At, B1); PG8_BAR; PG8_SCHED;
        }
        if constexpr (ALIGN_EPI) { if (wr == 0) PG8_BAR; }
        E(acc, cur, wr, wc, fr, fq); S.done(cur);
#ifdef PROBE_EPI2
        if (Epi::PROBE2) { asm volatile("" ::: "memory"); E(acc, cur, wr, wc, fr, fq); }
#endif
        if (!has_next) break;
#pragma unroll
        for (int a = 0; a < 2; ++a)
#pragma unroll
            for (int b = 0; b < 2; ++b)
#pragma unroll
                for (int m = 0; m < 4; ++m)
#pragma unroll
                    for (int n = 0; n < 2; ++n) acc[a][b][m][n] = (f32x4){0.f, 0.f, 0.f, 0.f};
        cur = nxt; cA = nA; cB = nB; ++ui;
        if constexpr (ALIGN_EPI) { if (wr == 1) PG8_BAR; }
    }
    PG8_WAIT_V(0);
    if constexpr (!ALIGN_EPI) { if (wr == 0) PG8_BAR; }
    PG8_BAR;
#undef PG8_SA
#undef PG8_SB
#undef PG8_STAGE
#undef PG8_LDA
#undef PG8_LDB
#undef PG8_MMA
#undef PG8_WAIT_V
#undef PG8_WAIT_L
#undef PG8_BAR
#undef PG8_SCHED
}
}

struct Params {
    const float* in[35];
    float* out;
    unsigned char* ws;
    int ph_lo, ph_hi;
};
enum { I_X = 0, I_C, I_CTX, I_CCTX, I_NMG, I_NFG, I_WMOD, I_BMOD, I_WIN, I_QNG, I_WUQ, I_KVNG, I_WUKV, I_HCW, I_HCB, I_HW1, I_HB1, I_HFREQ, I_HW2, I_HB2, I_HW3, I_HB3,
       I_HSKIP, I_LQ1, I_LK1, I_LQ2, I_LK2, I_SUBG, I_WBRA, I_WBRB, I_WBRC, I_WOUT, I_FC1, I_FC2, I_FNG };

struct Frame {
    LAS unsigned char* lds;
    int tid, lane, wave, vcu, G;
};

__device__ __forceinline__ void tr_item(const float* W, int ldw, hf* WT, int ldt, int nblk, LAS float* scr, int item, int lane, const float* kgain = nullptr) {
    const int kb = item / nblk, nb = item % nblk, k0 = 64 * kb, n0 = 32 * nb;
#pragma unroll 8
    for (int i = 0; i < 32; ++i) { const int kk = 2 * i + (lane >> 5); const float gk = kgain ? kgain[k0 + kk] : 1.f; scr[kk * 33 + (lane & 31)] = W[(size_t)(k0 + kk) * ldw + n0 + (lane & 31)] * gk; }
    LDS_WAIT(); asm volatile("" ::: "memory");
    const int c = lane & 7;
#pragma unroll
    for (int j = 0; j < 4; ++j) { const int n = (lane >> 3) + 8 * j; const LAS float* s = scr + (8 * c) * 33 + n;
        u32x4 o; o.x = pkh(s[0 * 33], s[1 * 33]); o.y = pkh(s[2 * 33], s[3 * 33]); o.z = pkh(s[4 * 33], s[5 * 33]); o.w = pkh(s[6 * 33], s[7 * 33]);
        *(u32x4*)(WT + (size_t)(n0 + n) * ldt + k0 + 8 * c) = o; }
    LDS_WAIT(); asm volatile("" ::: "memory");
}
__device__ __forceinline__ float silu_f(float x) { return x / (1.f + expf(-x)); }

__device__ __forceinline__ void mod_phase(const Frame& F, const Params& p) {
    float* MOD = (float*)(p.ws + WS_MOD);
    LAS float* sv = (LAS float*)F.lds;
    constexpr int NCB = DEPTH * MODW / 512;
    for (int item = F.vcu; item < NCB * 3; item += F.G) {
        const int cb = item / 3, vg = item % 3;
        __syncthreads();
        for (int i = F.tid; i < 11 * 1024; i += 512) { const int v = vg * 11 + i / 1024, k = i % 1024;
            const float c = (v < NB) ? p.in[I_C][v * DM + k] : p.in[I_CCTX][k]; sv[i] = silu_f(c); }
        __syncthreads();
        const int gcol = cb * 512 + F.tid, l = gcol / MODW, n = gcol % MODW;
        const float* w = p.in[I_WMOD] + (size_t)l * DM * MODW + n;
        float acc[11];
#pragma unroll
        for (int v = 0; v < 11; ++v) acc[v] = 0.f;
        for (int k = 0; k < DM; k += 4) {
            const float w0 = w[(size_t)k * MODW], w1 = w[(size_t)(k + 1) * MODW], w2 = w[(size_t)(k + 2) * MODW], w3 = w[(size_t)(k + 3) * MODW];
#pragma unroll
            for (int v = 0; v < 11; ++v) { const f32x4 s = *(const LAS f32x4*)(sv + v * 1024 + k);
                acc[v] = fmaf(s[0], w0, acc[v]); acc[v] = fmaf(s[1], w1, acc[v]); acc[v] = fmaf(s[2], w2, acc[v]); acc[v] = fmaf(s[3], w3, acc[v]); }
        }
        const float bm = p.in[I_BMOD][(size_t)l * MODW + n];
#pragma unroll
        for (int v = 0; v < 11; ++v) MOD[((size_t)l * NMODV + vg * 11 + v) * MODW + n] = acc[v] + bm;
    }
    __syncthreads();
}

__device__ __forceinline__ void filt_item(const Params& p, int l, int kind  , int t, int lane) {
    const int L = kind ? CTXL : SEQ;
    hf* R = kind ? (hf*)(p.ws + WS_RFC) + (size_t)l * 256 * 512 : (hf*)(p.ws + WS_RF) + (size_t)l * 256 * 4096;
    const int rl = 2 * L;
    const float tl = (float)t / (float)(L - 1);
    const float wt = (6.283185307179586f / (float)L) * (float)t;
    float z = 0.f;
    if (lane == 0) z = tl;
    else if (lane <= 32) { const int bi = (lane - 1) & 15; const float band = 1e-4f + (15.f - 1e-4f) * ((float)bi / 15.f); const float a = band * wt; z = (lane <= 16) ? cosf(a) : -sinf(a); }
    const float* w1 = p.in[I_HW1] + (size_t)l * 33 * 64; const float* w2 = p.in[I_HW2] + (size_t)l * 64 * 64; const float* w3 = p.in[I_HW3] + (size_t)l * 64 * 512;
    const float fr = p.in[I_HFREQ][l * 64 + lane];
    float a1 = p.in[I_HB1][l * 64 + lane];
    for (int i = 0; i < 33; ++i) a1 = fmaf(__shfl(z, i), w1[i * 64 + lane], a1);
    a1 = sinf(fr * a1);
    float a2 = p.in[I_HB2][l * 64 + lane];
    for (int i = 0; i < 64; ++i) a2 = fmaf(__shfl(a1, i), w2[i * 64 + lane], a2);
    a2 = sinf(fr * a2);
    float h[8];
#pragma unroll
    for (int q = 0; q < 8; ++q) h[q] = p.in[I_HB3][l * 512 + q * 64 + lane];
    for (int i = 0; i < 64; ++i) { const float a = __shfl(a2, i);
#pragma unroll
        for (int q = 0; q < 8; ++q) h[q] = fmaf(a, w3[i * 512 + q * 64 + lane], h[q]); }
    const float d0 = -4.605170185988091f / 1.5f, d1 = -4.605170185988091f / 0.3f;
#pragma unroll
    for (int q = 0; q < 8; ++q) { const int o = q * 64 + lane, dir = o >> 8, c = o & 255;
        const float delta = fabsf(d0 + (d1 - d0) * ((float)c / 255.f));
        float val = h[q] * (expf(-tl * delta) + 0.05f);
        if (dir == 0) { if (t == 0) val += p.in[I_HSKIP][l * 256 + c]; R[(size_t)c * rl + (L - t)] = (hf)val; if (t == 0) R[(size_t)c * rl] = (hf)0.f; }
        else if (t >= 1) R[(size_t)c * rl + (L + t)] = (hf)val; }
}

__device__ __forceinline__ void convert_layer(const Frame& F, const Params& p, int l, unsigned char* wl) {
    LAS float* scr = (LAS float*)(F.lds + F.wave * 16384);
    const int gw = F.vcu * 8 + F.wave, NGW = F.G * 8, lane = F.lane;
    constexpr int IT_IN1 = 16 * 61, IT_ING = 16 * 96, IT_UQ = 4 * 24, IT_UKV = 2 * 32, IT_BRA = 8 * 32, IT_BRB = 4 * 32, IT_BRC = 4 * 32, IT_OUT = 16 * 32, IT_FC1 = 16 * 128, IT_FC2 = 64 * 32;
    constexpr int IT_LAYER = IT_IN1 + IT_ING + IT_UQ + IT_UKV + IT_BRA + IT_BRB + IT_BRC + IT_OUT + IT_FC1 + IT_FC2;
    for (int it = gw; it < IT_LAYER; it += NGW) {
        int r = it;
        if (r < IT_IN1) { tr_item(p.in[I_WIN] + (size_t)l * DM * D_IN, D_IN, (hf*)(wl + W_IN1), DM, 61, scr, r, lane); continue; } r -= IT_IN1;
        if (r < IT_ING) { tr_item(p.in[I_WIN] + (size_t)l * DM * D_IN + C_PG, D_IN, (hf*)(wl + W_ING), DM, 96, scr, r, lane); continue; } r -= IT_ING;
        if (r < IT_UQ) { tr_item(p.in[I_WUQ] + (size_t)l * 256 * 768, 768, (hf*)(wl + W_UP), KUP, 24, scr, r, lane, p.in[I_QNG] + l * 256); continue; } r -= IT_UQ;
        if (r < IT_UKV) { tr_item(p.in[I_WUKV] + (size_t)l * 128 * 1024, 1024, (hf*)(wl + W_UP) + (size_t)768 * KUP + 256, KUP, 32, scr, r, lane, p.in[I_KVNG] + l * 128); continue; } r -= IT_UKV;
        if (r < IT_BRA) { tr_item(p.in[I_WBRA] + (size_t)l * 512 * DM, DM, (hf*)(wl + W_BR), DM, 32, scr, r, lane); continue; } r -= IT_BRA;
        if (r < IT_BRB) { tr_item(p.in[I_WBRB] + (size_t)l * 256 * DM, DM, (hf*)(wl + W_BR) + 512, DM, 32, scr, r, lane); continue; } r -= IT_BRB;
        if (r < IT_BRC) { tr_item(p.in[I_WBRC] + (size_t)l * 256 * DM, DM, (hf*)(wl + W_BR) + 768, DM, 32, scr, r, lane); continue; } r -= IT_BRC;
        if (r < IT_OUT) { tr_item(p.in[I_WOUT] + (size_t)l * DM * DM, DM, (hf*)(wl + W_OUT), DM, 32, scr, r, lane); continue; } r -= IT_OUT;
        if (r < IT_FC1) { tr_item(p.in[I_FC1] + (size_t)l * DM * DFF, DFF, (hf*)(wl + W_FC1), DM, 128, scr, r, lane); continue; } r -= IT_FC1;
        tr_item(p.in[I_FC2] + (size_t)l * DFF * DM, DM, (hf*)(wl + W_FC2), DFF, 32, scr, r, lane);
    }
    const int gt = gw * 64 + lane, NGT = NGW * 64;
    u32x4* z1 = (u32x4*)((hf*)(wl + W_IN1) + (size_t)C_PG * DM);
    for (int i = gt; i < 96 * DM / 8; i += NGT) z1[i] = (u32x4){0u, 0u, 0u, 0u};
    hf* up = (hf*)(wl + W_UP);
    for (int i = gt; i < 768 * 16; i += NGT) { const int n = i / 16, k8 = i % 16; *(u32x4*)(up + (size_t)n * KUP + 256 + k8 * 8) = (u32x4){0u, 0u, 0u, 0u}; }
    for (int i = gt; i < 1024 * 32; i += NGT) { const int n = 768 + i / 32, k8 = i % 32; *(u32x4*)(up + (size_t)n * KUP + k8 * 8) = (u32x4){0u, 0u, 0u, 0u}; }
}

__device__ __forceinline__ void prologue_a(const Frame& F, const Params& p) {
    mod_phase(F, p);
    convert_layer(F, p, 0, p.ws + WS_WT);
    const int gw = F.vcu * 8 + F.wave, NGW = F.G * 8, lane = F.lane;
    for (int it = gw; it < DEPTH * (SEQ + CTXL); it += NGW) { const int l = it / (SEQ + CTXL), r = it % (SEQ + CTXL); if (r < SEQ) filt_item(p, l, 0, r, lane); else filt_item(p, l, 1, r - SEQ, lane); }
    {
        float* rope = (float*)(p.ws + WS_ROPE);
        const int gt = gw * 64 + lane, NGT = NGW * 64;
        for (int i = gt; i < SEQ * 16; i += NGT) { const int t = i >> 4, j = i & 15; const float pos = (j < 8) ? (float)(t / GRIDW) : (float)(t % GRIDW);
            const float inv = powf(10000.f, -(float)(j & 7) / 8.f); const float a = pos * inv; rope[t * 32 + j] = cosf(a); rope[t * 32 + 16 + j] = sinf(a); }
        if (gt < DEPTH) { const int l = gt; float s1 = 0.f, s2 = 0.f;
            for (int i = 0; i < 32; ++i) { s1 += p.in[I_LQ1][l * 32 + i] * p.in[I_LK1][l * 32 + i]; s2 += p.in[I_LQ2][l * 32 + i] * p.in[I_LK2][l * 32 + i]; }
            const float li = 0.8f - 0.6f * expf(-0.3f * (float)l);
            float* lam = (float*)(p.ws + WS_LAM); lam[2 * l] = expf(s1) - expf(s2) + li; lam[2 * l + 1] = 1.f - li; }
    }
}
__device__ __forceinline__ void prologue_b(const Frame& F, const Params& p) {
    const float* MOD = (const float*)(p.ws + WS_MOD); float* BIAS = (float*)(p.ws + WS_BIAS);
    {
        LAS float* sv = (LAS float*)F.lds;
        constexpr int NCB = DEPTH * NBIAS / 512;
        for (int item = F.vcu; item < NCB * 3; item += F.G) {
            const int cb = item / 3, vg = item % 3;
            const int gcol = cb * 512 + F.tid, l = gcol / NBIAS, n = gcol % NBIAS, n0 = (cb * 512) % NBIAS;
            const int soff = (n0 >= B_FC1) ? 3 * DM : 0;
            __syncthreads();
            for (int i = F.tid; i < 11 * 1024; i += 512) { const int v = vg * 11 + i / 1024, k = i % 1024; sv[i] = MOD[((size_t)l * NMODV + v) * MODW + soff + k]; }
            __syncthreads();
            const float* w; size_t ldw; bool valid = true;
            if (n < B_G) { w = p.in[I_WIN] + (size_t)l * DM * D_IN + n; ldw = D_IN; valid = n < C_PG; }
            else if (n < B_FC1) { w = p.in[I_WIN] + (size_t)l * DM * D_IN + C_PG + (n - B_G); ldw = D_IN; }
            else { w = p.in[I_FC1] + (size_t)l * DM * DFF + (n - B_FC1); ldw = DFF; }
            float acc[11];
#pragma unroll
            for (int v = 0; v < 11; ++v) acc[v] = 0.f;
            if (valid) for (int k = 0; k < DM; k += 4) {
                const float w0 = w[(size_t)k * ldw], w1 = w[(size_t)(k + 1) * ldw], w2 = w[(size_t)(k + 2) * ldw], w3 = w[(size_t)(k + 3) * ldw];
#pragma unroll
                for (int v = 0; v < 11; ++v) { const f32x4 sx = *(const LAS f32x4*)(sv + v * 1024 + k);
                    acc[v] = fmaf(sx[0], w0, acc[v]); acc[v] = fmaf(sx[1], w1, acc[v]); acc[v] = fmaf(sx[2], w2, acc[v]); acc[v] = fmaf(sx[3], w3, acc[v]); }
            }
#pragma unroll
            for (int v = 0; v < 11; ++v) BIAS[((size_t)l * NMODV + vg * 11 + v) * NBIAS + n] = acc[v];
        }
        __syncthreads();
    }
    const int gw = F.vcu * 8 + F.wave, NGW = F.G * 8, lane = F.lane;
    {
        float* GS = (float*)(p.ws + WS_GS);
        const int gt = gw * 64 + lane, NGT = NGW * 64;
        for (int i = gt; i < DEPTH * 2 * NMODV * DM; i += NGT) { const int c = i % DM, v = (i / DM) % NMODV, wh = (i / (DM * NMODV)) % 2, l = i / (DM * NMODV * 2);
            const float g = wh ? p.in[I_NFG][l * DM + c] : p.in[I_NMG][l * DM + c];
            GS[i] = g * (1.f + MOD[((size_t)l * NMODV + v) * MODW + (wh ? 4 * DM : DM) + c]); }
    }
    {
        hf* XS = (hf*)(p.ws + A_A); float* ss = (float*)(p.ws + WS_SS) + (size_t)SS_1 * MTOT;
        f32x4 g[4];
#pragma unroll
        for (int j = 0; j < 4; ++j) g[j] = *(const f32x4*)(p.in[I_NMG] + 4 * lane + 256 * j);
        for (int row = gw; row < MTOT; row += NGW) {
            const bool lat = row < NLAT; const float* xr = lat ? p.in[I_X] + (size_t)row * DM : p.in[I_CTX] + (size_t)(row - NLAT) * DM;
            const int v = lat ? (row >> 11) : NB; const float* mv = MOD + (size_t)v * MODW + DM;
            float sq = 0.f; hf* hr = XS + (size_t)row * DM;
#pragma unroll
            for (int j = 0; j < 4; ++j) { const f32x4 x = *(const f32x4*)(xr + 4 * lane + 256 * j); const f32x4 sc = *(const f32x4*)(mv + 4 * lane + 256 * j);
                sq += (x[0] * x[0] + x[1] * x[1]) + (x[2] * x[2] + x[3] * x[3]);
                const f32x4 o = x * (g[j] * (sc + 1.f)); u32x2 w; w.x = pkh(o[0], o[1]); w.y = pkh(o[2], o[3]); *(u32x2*)(hr + 4 * lane + 256 * j) = w; }
            sq = wave_sum(sq);
            if (lane == 0) ss[row] = sq;
        }
    }
}

__device__ __forceinline__ void norm_phase(const Frame& F, const float* xs_lat, const float* xs_ctx, int nrows, const float* gain, const float* modl, int sh_off, int sc_off, hf* H) {
    const int gw = F.vcu * 8 + F.wave, NGW = F.G * 8, lane = F.lane;
    f32x4 g[4];
#pragma unroll
    for (int j = 0; j < 4; ++j) g[j] = *(const f32x4*)(gain + 4 * lane + 256 * j);
    for (int row = gw; row < nrows; row += NGW) {
        const bool lat = row < NLAT; const float* xr = lat ? xs_lat + (size_t)row * DM : xs_ctx + (size_t)(row - NLAT) * DM;
        const int v = lat ? (row >> 11) : NB; const float* mv = modl + (size_t)v * MODW;
        f32x4 x[4]; float ss = 0.f;
#pragma unroll
        for (int j = 0; j < 4; ++j) { x[j] = *(const f32x4*)(xr + 4 * lane + 256 * j); ss += (x[j][0] * x[j][0] + x[j][1] * x[j][1]) + (x[j][2] * x[j][2] + x[j][3] * x[j][3]); }
        const float rstd = rsqrtf(wave_sum(ss) * (1.f / DM) + EPS);
        hf* hr = H + (size_t)row * DM;
#pragma unroll
        for (int j = 0; j < 4; ++j) { const f32x4 sh = *(const f32x4*)(mv + sh_off + 4 * lane + 256 * j), sc = *(const f32x4*)(mv + sc_off + 4 * lane + 256 * j);
            const f32x4 y = (x[j] * rstd) * g[j]; const f32x4 o = y * (sc + 1.f) + sh;
            u32x2 w; w.x = pkh(o[0], o[1]); w.y = pkh(o[2], o[3]); *(u32x2*)(hr + 4 * lane + 256 * j) = w; }
    }
}
__device__ __forceinline__ void final_norm_phase(const Frame& F, float* X, const float* gain, const float* ss) {
    const int gw = F.vcu * 8 + F.wave, NGW = F.G * 8, lane = F.lane;
    f32x4 g[4];
#pragma unroll
    for (int j = 0; j < 4; ++j) g[j] = *(const f32x4*)(gain + 4 * lane + 256 * j);
    for (int row = gw; row < NLAT; row += NGW) {
        float* xr = X + (size_t)row * DM; const float rstd = rsqrtf(ss[row] * (1.f / DM) + EPS);
#pragma unroll
        for (int j = 0; j < 4; ++j) { const f32x4 x = *(const f32x4*)(xr + 4 * lane + 256 * j); *(f32x4*)(xr + 4 * lane + 256 * j) = (x * rstd) * g[j]; }
    }
}

__device__ __forceinline__ void prep_rope(const Frame& F, const Params& p) {
    const int gw = F.vcu * 8 + F.wave, NGW = F.G * 8, lane = F.lane;
    hf* KR = (hf*)(p.ws + A_KR); hf* DK = (hf*)(p.ws + A_DK); const float* rope = (const float*)(p.ws + WS_ROPE);
    const int hh = lane >> 3, i0 = 2 * (lane & 7);
    for (int row = gw; row < NLAT; row += NGW) {
        const int t = row & (SEQ - 1);
        hf* dk = DK + (size_t)row * 256 + hh * 32 + i0;
        const hf2 a = *(const hf2*)dk, b = *(const hf2*)(dk + 16);
        const f32x2 c = *(const f32x2*)(rope + t * 32 + i0), sn = *(const f32x2*)(rope + t * 32 + 16 + i0);
        const float x1[2] = {(float)a[0], (float)a[1]}, x2[2] = {(float)b[0], (float)b[1]};
        *(unsigned*)dk = pkh(x1[0] * c[0] - x2[0] * sn[0], x1[1] * c[1] - x2[1] * sn[1]);
        *(unsigned*)(dk + 16) = pkh(x2[0] * c[0] + x1[0] * sn[0], x2[1] * c[1] + x1[1] * sn[1]);
        if (lane < 16) { hf* kr = KR + (size_t)row * 32 + lane; const float y1 = (float)kr[0], y2 = (float)kr[16];
            const float cc = rope[t * 32 + lane], ss = rope[t * 32 + 16 + lane];
            kr[0] = (hf)(y1 * cc - y2 * ss); kr[16] = (hf)(y2 * cc + y1 * ss); }
    }
}
__device__ __forceinline__ void prep_hyena(const Frame& F, const Params& p, int l, bool with_ctx) {
    constexpr int INP = 784;
    constexpr int OUTP = 33;
    constexpr int OFF_OU = 66 * INP, OFF_OX = OFF_OU + 128 * OUTP * 4;
    const hf* PHY = (const hf*)(p.ws + A_PHY);
    LAS unsigned char* lds = F.lds; const int tid = F.tid;
    const float* cw = p.in[I_HCW] + (size_t)l * 3 * 768; const float* cb = p.in[I_HCB] + (size_t)l * 768;
    constexpr int U_LAT = NB * (SEQ / 64) * 2, U_CTX = NB * (CTXL / 64) * 2;
    const int nunit = U_LAT + (with_ctx ? U_CTX : 0);
    for (int un = F.vcu; un < nunit; un += F.G) {
        const bool ctx = un >= U_LAT; int r = ctx ? un - U_LAT : un; const int L = ctx ? CTXL : SEQ, ntile = L / 64;
        const int ch = r & 1; r >>= 1; const int tt = r % ntile, b = r / ntile;
        const int t0 = tt * 64; const size_t rowbase = ctx ? (size_t)NLAT + (size_t)b * CTXL : (size_t)b * SEQ;
        hf* dU = ctx ? (hf*)(p.ws + A_UTC) : (hf*)(p.ws + A_UT); hf* dX = ctx ? (hf*)(p.ws + A_X0TC) : (hf*)(p.ws + A_X0T);
        __syncthreads();
        for (int i = tid; i < 66 * 48; i += 512) { const int rr = i / 48, q = i % 48, seg = q >> 4, c16 = q & 15; const int t = t0 - 1 + rr;
            u32x4 v = {0u, 0u, 0u, 0u};
            if (t >= 0 && t < L) v = *(const u32x4*)(PHY + (rowbase + t) * 768 + seg * 256 + ch * 128 + c16 * 8);
            *(LAS u32x4*)(lds + rr * INP + seg * 256 + c16 * 16) = v; }
        __syncthreads();
        {
            const int c = tid & 127, tg = tid >> 7, cg = ch * 128 + c;
            const float a0 = cw[cg], a1 = cw[768 + cg], a2 = cw[1536 + cg], ab = cb[cg];
            const float b0 = cw[256 + cg], b1 = cw[768 + 256 + cg], b2 = cw[1536 + 256 + cg], bb = cb[256 + cg];
            const float v0 = cw[512 + cg], v1 = cw[768 + 512 + cg], v2 = cw[1536 + 512 + cg], vb = cb[512 + cg];
            const LAS hf* in = (const LAS hf*)(lds + (16 * tg) * INP) + c;
            float p0 = (float)in[0], p1 = (float)in[128], p2 = (float)in[256];
            float c0 = (float)in[INP / 2], c1 = (float)in[INP / 2 + 128], c2 = (float)in[INP / 2 + 256];
            LAS hf* ou = (LAS hf*)(lds + OFF_OU) + c * (OUTP * 2) + 16 * tg; LAS hf* ox = (LAS hf*)(lds + OFF_OX) + c * (OUTP * 2) + 16 * tg;
#pragma unroll
            for (int j = 0; j < 16; ++j) { const LAS hf* nx = in + (j + 2) * (INP / 2);
                const float n0 = (float)nx[0], n1 = (float)nx[128], n2 = (float)nx[256];
                const float x0 = a0 * p0 + a1 * c0 + a2 * n0 + ab, x1 = b0 * p1 + b1 * c1 + b2 * n1 + bb, vv = v0 * p2 + v1 * c2 + v2 * n2 + vb;
                ou[j] = (hf)(vv * x1); ox[j] = (hf)x0;
                p0 = c0; p1 = c1; p2 = c2; c0 = n0; c1 = n1; c2 = n2; }
        }
        __syncthreads();
        {
            const int c = tid >> 2, q = tid & 3; const size_t go = ((size_t)(ch * 128 + c) * NB + b) * L + t0 + 16 * q;
            const LAS unsigned* su = (const LAS unsigned*)(lds + OFF_OU) + c * OUTP + 8 * q; const LAS unsigned* sx = (const LAS unsigned*)(lds + OFF_OX) + c * OUTP + 8 * q;
            u32x4 w0 = {su[0], su[1], su[2], su[3]}, w1 = {su[4], su[5], su[6], su[7]};
            *(u32x4*)(dU + go) = w0; *(u32x4*)(dU + go + 8) = w1;
            u32x4 y0 = {sx[0], sx[1], sx[2], sx[3]}, y1 = {sx[4], sx[5], sx[6], sx[7]};
            *(u32x4*)(dX + go) = y0; *(u32x4*)(dX + go + 8) = y1;
        }
    }
    __syncthreads();
}

namespace att {
__device__ __forceinline__ int crow(int r, int hi) { return (r & 3) + 8 * (r >> 2) + 4 * hi; }
#define SBAR() __builtin_amdgcn_sched_barrier(0)
constexpr float THR2 = 8.f * 1.4426950408889634f;
constexpr int KS_MLA = 208, KS_DF = 80;
constexpr int VS = 144, VB = 64 * VS;
constexpr int OFF_V = 32768;
__device__ __forceinline__ int kpos(int key) { return (key & ~0xC) | ((key & 4) << 1) | ((key & 8) >> 1); }

template <int ND0, int KS>
__device__ __forceinline__ void qkt(f32x16& p0, f32x16& p1, const LAS unsigned char* Ks, const hf8* qr, int r32, int hi) {
    p0 = f32x16{}; p1 = f32x16{};
#pragma unroll
    for (int d0 = 0; d0 < ND0; ++d0) { const int cb = (d0 * 16 + hi * 8) * 2;
        const hf8 b0 = *(const LAS hf8*)(Ks + r32 * KS + cb), b1 = *(const LAS hf8*)(Ks + (32 + r32) * KS + cb);
        p0 = __builtin_amdgcn_mfma_f32_32x32x16_f16(b0, qr[d0], p0, 0, 0, 0); p1 = __builtin_amdgcn_mfma_f32_32x32x16_f16(b1, qr[d0], p1, 0, 0, 0); }
}
__device__ __forceinline__ float max3f(float a, float b, float c) { float r; asm("v_max3_f32 %0, %1, %2, %3" : "=v"(r) : "v"(a), "v"(b), "v"(c)); return r; }
__device__ __forceinline__ float max2f(float a, float b) { float r; asm("v_max_f32_e32 %0, %1, %2" : "=v"(r) : "v"(a), "v"(b)); return r; }
__device__ __forceinline__ hf8 pack8(const f32x16& p, int b) { u32x4 w = {pkh(p[b], p[b + 1]), pkh(p[b + 2], p[b + 3]), pkh(p[b + 4], p[b + 5]), pkh(p[b + 6], p[b + 7])}; return __builtin_bit_cast(hf8, w); }
__device__ __forceinline__ void sm_max(const f32x16& p0, const f32x16& p1, float& m, float& l, f32x16& o0, f32x16& o1, const bool first) {
    float pmax = max3f(p0[0], p1[0], p0[1]);
#pragma unroll
    for (int r = 1; r < 15; ++r) pmax = max3f(pmax, p1[r], p0[r + 1]);
    pmax = max2f(pmax, p1[15]);
    { auto rr = __builtin_amdgcn_permlane32_swap(__float_as_uint(pmax), __float_as_uint(pmax), false, false);
      pmax = max2f(__uint_as_float(rr[0]), __uint_as_float(rr[1])); }
    if (first || __any(pmax - m > THR2)) {
        const float mn = first ? pmax : max2f(m, pmax);
        if (!first) { const float alpha = __builtin_amdgcn_exp2f(m - mn); l *= alpha;
#pragma unroll
            for (int r = 0; r < 16; ++r) { o0[r] *= alpha; o1[r] *= alpha; } }
        m = mn;
    }
}
__device__ __forceinline__ void sm_exp_pv(f32x16& p0, f32x16& p1, const float m, float& l, f32x16& o0, f32x16& o1, const LAS unsigned char* Vt, int r32, int hi) {
#pragma unroll
    for (int r = 0; r < 16; ++r) { p0[r] -= m; p1[r] -= m; }
#pragma unroll
    for (int r = 0; r < 16; ++r) { p0[r] = __builtin_amdgcn_exp2f(p0[r]); p1[r] = __builtin_amdgcn_exp2f(p1[r]); }
    float ps = 0.f;
#pragma unroll
    for (int r = 0; r < 16; ++r) ps += p0[r] + p1[r];
    l += ps;
    const hf8 pf0 = pack8(p0, 0), pf1 = pack8(p0, 8), pf2 = pack8(p1, 0), pf3 = pack8(p1, 8);
    const LAS unsigned char* vr = Vt + r32 * VS + hi * 16;
#define PVK(ks, pf) do { const hf8 a0 = *(const LAS hf8*)(vr + (ks) * 32), a1 = *(const LAS hf8*)(vr + 32 * VS + (ks) * 32); \
        o0 = __builtin_amdgcn_mfma_f32_32x32x16_f16(a0, pf, o0, 0, 0, 0); o1 = __builtin_amdgcn_mfma_f32_32x32x16_f16(a1, pf, o1, 0, 0, 0); } while (0)
    PVK(0, pf0); PVK(1, pf1); PVK(2, pf2); PVK(3, pf3);
#undef PVK
}

template <bool MLA>
__device__ __forceinline__ void attn_pass(const Frame& F, const Params& p, int hq, int hv, int qrow0, int qpos0, int klat0, int nlat, int kctx0, f32x16& o0, f32x16& o1, float& inv) {
    constexpr int DK = MLA ? 96 : 32, ND0 = DK / 16, KS = MLA ? KS_MLA : KS_DF, KB = 64 * KS;
    constexpr float SCALE = MLA ? MLA_SCALE : DF_SCALE, C = SCALE * 1.4426950408889634f;
    const int tid = F.tid, wid = F.wave, lane = F.lane, r32 = lane & 31, hi = lane >> 5;
    const hf* QKV = (const hf*)(p.ws + A_QKV); const hf* KRb = (const hf*)(p.ws + A_KR);
    const hf* DQ = (const hf*)(p.ws + A_DQ); const hf* DKb = (const hf*)(p.ws + A_DK); const hf* DVb = (const hf*)(p.ws + A_DV);
    const float* rope = (const float*)(p.ws + WS_ROPE);
    LAS unsigned char* lds = F.lds;
    hf8 qr[ND0];
    {
        const int qrow = qrow0 + wid * 32 + r32;
        const hf* qp = MLA ? QKV + (size_t)qrow * NUP + hq * 96 + hi * 8 : DQ + (size_t)qrow * 256 + hq * 32 + hi * 8;
        hf8 raw[ND0];
#pragma unroll
        for (int d0 = 0; d0 < ND0; ++d0) raw[d0] = *(const hf8*)(qp + d0 * 16);
        f32x4 c0 = {1.f, 1.f, 1.f, 1.f}, c1 = c0, s0 = {0.f, 0.f, 0.f, 0.f}, s1 = s0;
        if (qpos0 >= 0) { const int t = qpos0 + wid * 32 + r32;
            c0 = *(const f32x4*)(rope + t * 32 + hi * 8); c1 = *(const f32x4*)(rope + t * 32 + hi * 8 + 4);
            s0 = *(const f32x4*)(rope + t * 32 + 16 + hi * 8); s1 = *(const f32x4*)(rope + t * 32 + 16 + hi * 8 + 4); }
#pragma unroll
        for (int d0 = 0; d0 < ND0 - 2; ++d0) {
#pragma unroll
            for (int j = 0; j < 8; ++j) qr[d0][j] = (hf)((float)raw[d0][j] * C); }
#pragma unroll
        for (int j = 0; j < 8; ++j) { const float cc = j < 4 ? c0[j & 3] : c1[j & 3], sn = j < 4 ? s0[j & 3] : s1[j & 3]; const float a = (float)raw[ND0 - 2][j], b = (float)raw[ND0 - 1][j];
            qr[ND0 - 2][j] = (hf)((a * cc - b * sn) * C); qr[ND0 - 1][j] = (hf)((b * cc + a * sn) * C); }
    }
    const int k1r = MLA ? (tid >> 3) : ((tid & 255) >> 2), k1c = MLA ? (tid & 7) * 8 : (tid & 3) * 8;
    const int k2r = (tid & 255) >> 2, k2c = (tid & 3) * 8;
    const int vkp = kpos(lane) * 2 + wid * 8 * VS;
    const bool klo = tid < 256;
    struct Stg { u32x4 v, k1, k2; };
    Stg sA, sB; sA.v = sA.k1 = sA.k2 = sB.v = sB.k1 = sB.k2 = (u32x4){0u, 0u, 0u, 0u};
    const int ntile = nlat + 4;
#define KROW0(j) (((j) < nlat) ? klat0 + (j) * 64 : kctx0 + ((j) - nlat) * 64)
#define A_LOADK(S, j) do { const int kr0 = KROW0(j); \
        if (MLA) { S.k1 = *(const u32x4*)(QKV + (size_t)(kr0 + k1r) * NUP + 768 + hq * 128 + k1c); S.k2 = *(const u32x4*)(KRb + (size_t)(kr0 + k2r) * 32 + k2c); } \
        else S.k1 = *(const u32x4*)(DKb + (size_t)(kr0 + k1r) * 256 + hq * 32 + k1c); } while (0)
#define A_LOADV(S, j) do { const int kr0 = KROW0(j); \
        if (MLA) S.v = *(const u32x4*)(QKV + (size_t)(kr0 + lane) * NUP + 768 + hv * 128 + 64 + wid * 8); else S.v = *(const u32x4*)(DVb + (size_t)(kr0 + lane) * 256 + hv * 64 + wid * 8); } while (0)
#define A_WRITEK(S, b) do { if (MLA) { *(LAS u32x4*)(lds + (b) * KB + k1r * KS + k1c * 2) = S.k1; if (klo) *(LAS u32x4*)(lds + (b) * KB + k2r * KS + 128 + k2c * 2) = S.k2; } \
        else if (klo) *(LAS u32x4*)(lds + (b) * KB + k1r * KS + k1c * 2) = S.k1; } while (0)
#define A_WRITEV(S, b) do { LAS unsigned short* vp = (LAS unsigned short*)(lds + OFF_V + (b) * VB + vkp); \
        vp[0 * (VS / 2)] = (unsigned short)(S.v[0] & 0xffffu); vp[1 * (VS / 2)] = (unsigned short)(S.v[0] >> 16); vp[2 * (VS / 2)] = (unsigned short)(S.v[1] & 0xffffu); vp[3 * (VS / 2)] = (unsigned short)(S.v[1] >> 16); \
        vp[4 * (VS / 2)] = (unsigned short)(S.v[2] & 0xffffu); vp[5 * (VS / 2)] = (unsigned short)(S.v[2] >> 16); vp[6 * (VS / 2)] = (unsigned short)(S.v[3] & 0xffffu); vp[7 * (VS / 2)] = (unsigned short)(S.v[3] >> 16); } while (0)
    float m_reg = 0.f, l_reg = 0.f;
    o0 = f32x16{}; o1 = f32x16{};
    f32x16 pA0, pA1, pB0, pB1;
    __syncthreads();
    A_LOADK(sA, 0); A_LOADV(sA, 0); A_LOADK(sB, 1);
    A_WRITEK(sA, 0); A_WRITEV(sA, 0); A_WRITEK(sB, 1);
    if (2 < ntile) A_LOADK(sA, 2);
    A_LOADV(sA, 1);
    __syncthreads();
    qkt<ND0, KS>(pA0, pA1, lds, qr, r32, hi);
    for (int j = 0; j < ntile; j += 2) {
        if (j + 3 < ntile) A_LOADK(sB, j + 3);
        if (j + 2 < ntile) A_LOADV(sB, j + 2);
        sm_max(pA0, pA1, m_reg, l_reg, o0, o1, j == 0);
        qkt<ND0, KS>(pB0, pB1, lds + KB, qr, r32, hi);
        sm_exp_pv(pA0, pA1, m_reg, l_reg, o0, o1, lds + OFF_V, r32, hi);
        if (j + 2 < ntile) A_WRITEK(sA, 0);
        A_WRITEV(sA, 1);
        __syncthreads();
        if (j + 4 < ntile) A_LOADK(sA, j + 4);
        if (j + 3 < ntile) A_LOADV(sA, j + 3);
        sm_max(pB0, pB1, m_reg, l_reg, o0, o1, false);
        if (j + 2 < ntile) qkt<ND0, KS>(pA0, pA1, lds, qr, r32, hi);
        sm_exp_pv(pB0, pB1, m_reg, l_reg, o0, o1, lds + OFF_V + VB, r32, hi);
        if (j + 3 < ntile) A_WRITEK(sB, 1);
        if (j + 2 < ntile) A_WRITEV(sB, 0);
        __syncthreads();
    }
#undef KROW0
#undef A_LOADK
#undef A_LOADV
#undef A_WRITEK
#undef A_WRITEV
    const float lt = l_reg + __shfl_xor(l_reg, 32); inv = __builtin_amdgcn_rcpf(lt);
}
template <bool MLA>
__device__ __forceinline__ void attn_unit(const Frame& F, const Params& p, int l, int h, int qrow0, int qpos0, int klat0, int nlat, int kctx0) {
    const int wid = F.wave, lane = F.lane, r32 = lane & 31, hi = lane >> 5;
    hf* Y = (hf*)(p.ws + A_Y);
    const size_t yrow = (size_t)(qrow0 + wid * 32 + r32) * DM;
    if constexpr (MLA) {
        f32x16 o0, o1; float inv;
        attn_pass<true>(F, p, h, h, qrow0, qpos0, klat0, nlat, kctx0, o0, o1, inv);
#pragma unroll
        for (int g = 0; g < 4; ++g) { u32x2 w; w.x = pkh(o0[4 * g] * inv, o0[4 * g + 1] * inv); w.y = pkh(o0[4 * g + 2] * inv, o0[4 * g + 3] * inv); *(u32x2*)(Y + yrow + h * 64 + 8 * g + 4 * hi) = w; }
#pragma unroll
        for (int g = 0; g < 4; ++g) { u32x2 w; w.x = pkh(o1[4 * g] * inv, o1[4 * g + 1] * inv); w.y = pkh(o1[4 * g + 2] * inv, o1[4 * g + 3] * inv); *(u32x2*)(Y + yrow + h * 64 + 32 + 8 * g + 4 * hi) = w; }
    } else {
        const float lam = ((const float*)(p.ws + WS_LAM))[2 * l], oml = ((const float*)(p.ws + WS_LAM))[2 * l + 1];
        f32x16 a0, a1;
        LAS float* park = (LAS float*)(F.lds + 65536 + wid * 8192) + lane;
        { f32x16 o0, o1; float inv; attn_pass<false>(F, p, 2 * h, h, qrow0, qpos0, klat0, nlat, kctx0, o0, o1, inv);
#pragma unroll
          for (int r = 0; r < 16; ++r) { park[r * 64] = o0[r] * inv; park[(16 + r) * 64] = o1[r] * inv; } }
        { f32x16 o0, o1; float inv; attn_pass<false>(F, p, 2 * h + 1, h, qrow0, qpos0, klat0, nlat, kctx0, o0, o1, inv);
#pragma unroll
          for (int r = 0; r < 16; ++r) { a0[r] = park[r * 64] - o0[r] * (lam * inv); a1[r] = park[(16 + r) * 64] - o1[r] * (lam * inv); } }
        float ss = 0.f;
#pragma unroll
        for (int r = 0; r < 16; ++r) ss += a0[r] * a0[r] + a1[r] * a1[r];
        ss += __shfl_xor(ss, 32);
        const float rs = rsqrtf(ss * (1.f / 64.f) + EPS) * oml;
#pragma unroll
        for (int g = 0; g < 4; ++g) { const f32x4 gg = *(const f32x4*)(p.in[I_SUBG] + l * 64 + 8 * g + 4 * hi);
            u32x2 w; w.x = pkh(a0[4 * g] * rs * gg[0], a0[4 * g + 1] * rs * gg[1]); w.y = pkh(a0[4 * g + 2] * rs * gg[2], a0[4 * g + 3] * rs * gg[3]); *(u32x2*)(Y + yrow + 768 + h * 64 + 8 * g + 4 * hi) = w; }
#pragma unroll
        for (int g = 0; g < 4; ++g) { const f32x4 gg = *(const f32x4*)(p.in[I_SUBG] + l * 64 + 32 + 8 * g + 4 * hi);
            u32x2 w; w.x = pkh(a1[4 * g] * rs * gg[0], a1[4 * g + 1] * rs * gg[1]); w.y = pkh(a1[4 * g + 2] * rs * gg[2], a1[4 * g + 3] * rs * gg[3]); *(u32x2*)(Y + yrow + 768 + h * 64 + 32 + 8 * g + 4 * hi) = w; }
    }
}
}

template <int L>
__device__ __forceinline__ void hyena_unit(const Frame& F, const hf* Rrow  , const hf* U  , const hf* X0  , hf* Ycol  ) {
    constexpr int NM = L / 256, RL = 2 * L, SH = (L > 1024) ? 1024 : L, NH = L / SH, US = SH * 2 + 16;
    constexpr int OFF_U = 8 * RL * 2;
    static_assert(OFF_U + 32 * US <= LDS_MISC, "hyena LDS");
    const int tid = F.tid, w = F.wave, lane = F.lane, i32 = lane & 31, hi = lane >> 5;
    LAS unsigned char* lds = F.lds;
    __syncthreads();
    for (int idx = tid; idx < 8 * RL; idx += 512) { const int cw = idx / RL, x = idx % RL; ((LAS hf*)lds)[idx] = (x >= cw) ? Rrow[x - cw] : (hf)0.f; }
    f32x16 acc[NM];
#pragma unroll
    for (int m = 0; m < NM; ++m) acc[m] = f32x16{};
    const LAS unsigned char* cpy = lds + w * (RL * 2);
    for (int half = 0; half < NH; ++half) {
        __syncthreads();
        for (int idx = tid; idx < 32 * (SH / 8); idx += 512) { const int b = idx / (SH / 8), pc = idx % (SH / 8);
            *(LAS u32x4*)(lds + OFF_U + b * US + pc * 16) = *(const u32x4*)(U + (size_t)b * L + half * SH + pc * 8); }
        __syncthreads();
#pragma unroll 2
        for (int jl = 0; jl < SH / 16; ++jl) {
            const int j = half * (SH / 16) + jl;
            const hf8 bf = *(const LAS hf8*)(lds + OFF_U + i32 * US + (jl * 16 + hi * 8) * 2);
            const int x0 = L + 16 * j + 8 * hi - 8 * i32;
#pragma unroll
            for (int m = 0; m < NM; ++m) { const hf8 af = *(const LAS hf8*)(cpy + (x0 - 256 * m) * 2);
                acc[m] = __builtin_amdgcn_mfma_f32_32x32x16_f16(af, bf, acc[m], 0, 0, 0); }
        }
    }
    const hf* x0p = X0 + (size_t)i32 * L + w + 32 * hi;
    hf* yp = Ycol + ((size_t)i32 * L + w + 32 * hi) * DM;
#pragma unroll
    for (int m = 0; m < NM; ++m) {
#pragma unroll
        for (int r = 0; r < 16; ++r) { const int tt = 256 * m + 8 * ((r & 3) + 8 * (r >> 2));
            const float x0v = (float)x0p[tt];
            yp[(size_t)tt * DM] = (hf)(x0v * acc[m][r]); }
        asm volatile("" ::: "memory");
    }
}

#ifndef PH_MASK
#define PH_MASK 0x1FFFF
#endif
#define PHM(k) ((PH_MASK >> (k)) & 1)
#ifndef PROBE_REP
#define PROBE_REP 0
#endif
#define NREP(k) (((PROBE_REP >> (k)) & 1) ? 2 : 1)
constexpr int NPH_LAYER = 9, PH_L0 = 2, NPHASE = PH_L0 + DEPTH * NPH_LAYER + 1;
__global__ void __launch_bounds__(512, 2) fwd_kernel(Params p) {
    extern __shared__ __attribute__((aligned(16))) unsigned char lds_raw[];
    Frame F0; Frame& F = F0;
    F.lds = (LAS unsigned char*)lds_raw;
    F.tid = threadIdx.x; F.lane = F.tid & 63; F.wave = __builtin_amdgcn_readfirstlane(F.tid >> 6);
    F.G = gridDim.x; { const int bx = blockIdx.x; F.vcu = (F.G % 8 == 0) ? (bx % 8) * (F.G / 8) + bx / 8 : bx; }
    volatile LAS unsigned* misc = (volatile LAS unsigned*)(F.lds + LDS_MISC);
    if (F.tid < 16) misc[F.tid] = 0u;
    __syncthreads();
    const int lo = p.ph_lo, hi = p.ph_hi;
    XcdBarrier bar; bar.bar = (unsigned*)(p.ws + WS_BAR); bar.x = 0; bar.st = misc;
    if (hi - lo > 1) bar = xcd_barrier_post((unsigned*)(p.ws + WS_BAR), misc);
#define IN(k) (lo <= (k) && (k) < hi)
#define LAUNDER(Fl) Frame Fl = F0; asm volatile("" : "+v"(Fl.tid), "+v"(Fl.lane))
#define SEAM(k) do { if (IN(k) && IN((k) + 1)) xcd_barrier(bar); } while (0)
    unsigned char* ws = p.ws;
    float* X = p.out; float* XC = (float*)(ws + WS_XC);
    hf* XS1 = (hf*)(ws + A_A); hf* MM = (hf*)(ws + A_A); hf* Y = (hf*)(ws + A_B); hf* XS2 = (hf*)(ws + A_B);
    hf* QKV = (hf*)(ws + A_QKV); hf* QKVN = (hf*)(ws + A_QKVN);
    hf* Gt = (hf*)(ws + A_G); hf* HID = (hf*)(ws + A_HID);
    float* SS = (float*)(ws + WS_SS);

    if (PHM(11) && IN(0)) for (int rep = 0; rep < NREP(11); ++rep) { LAUNDER(Fl); prologue_a(Fl, p); }
    SEAM(0);
    if (PHM(11) && IN(1)) for (int rep = 0; rep < NREP(12); ++rep) { LAUNDER(Fl); prologue_b(Fl, p); }
    SEAM(1);

    for (int l = 0; l < DEPTH; ++l) {
        const int pb = PH_L0 + l * NPH_LAYER;
        const bool ctx_live = l < DEPTH - 1;
        const int Mrows = ctx_live ? MTOT : NLAT;
        const float* xin_lat = (l == 0) ? p.in[I_X] : X; const float* xin_ctx = (l == 0) ? p.in[I_CTX] : XC;
        const float* modl = (const float*)(ws + WS_MOD) + (size_t)l * NMODV * MODW;
        const float* biasl = (const float*)(ws + WS_BIAS) + (size_t)l * NMODV * NBIAS;
        const float* gsl = (const float*)(ws + WS_GS) + (size_t)l * 2 * NMODV * DM;
        const unsigned char* wl = ws + WS_WT + (size_t)(l & 1) * W_LAYER;
        float* ss1 = SS + (size_t)(SS_1 + l) * MTOT; float* ss2 = SS + (size_t)(SS_2 + l) * MTOT;

        if (PHM(1) && IN(pb + 0)) for (int rep = 0; rep < NREP(1); ++rep) { pg8::Gemm g{XS1, (const hf*)(wl + W_IN1), MTOT, NP1, DM, DM, DM}; pg8::StaticOrder S; S.init(MTOT, NP1, F.G, (int)blockIdx.x);
            pg8::EpiIn E{QKVN, (hf*)(ws + A_KR), (hf*)(ws + A_PHY), (hf*)(ws + A_DQ), (hf*)(ws + A_DK), (hf*)(ws + A_DV), ss1, biasl + B_IN, SS + (size_t)(SS_Q + l) * MTOT, SS + (size_t)(SS_KV + l) * MTOT};
            pg8::gemm_phase(F.lds, g, S, E); }
        SEAM(pb + 0);
        if (PHM(2) && IN(pb + 1)) { LAUNDER(Fl); prep_rope(Fl, p); prep_hyena(Fl, p, l, ctx_live);
            if (l + 1 < DEPTH) convert_layer(Fl, p, l + 1, ws + WS_WT + (size_t)((l + 1) & 1) * W_LAYER); }
        SEAM(pb + 1);
        if (PHM(3) && IN(pb + 2)) for (int rep = 0; rep < NREP(3); ++rep) { pg8::Gemm g{QKVN, (const hf*)(wl + W_UP), MTOT, NUP, KUP, KUP, KUP}; pg8::StaticOrder S; S.init(MTOT, NUP, F.G, (int)blockIdx.x);
            pg8::EpiUp E{QKV, SS + (size_t)(SS_Q + l) * MTOT, SS + (size_t)(SS_KV + l) * MTOT}; pg8::gemm_phase(F.lds, g, S, E); }
        SEAM(pb + 2);
        if (PHM(4) && IN(pb + 3)) for (int rep = 0; rep < NREP(4); ++rep) {
            LAUNDER(Fl);
            const int n_mla = 2048 + (ctx_live ? 256 : 0);
            if (PHM(13)) for (int rp = 0; rp < NREP(13); ++rp) for (int id = F.vcu; id < n_mla; id += F.G) {
                if (id < 2048) { const int qb = id & 7, h = (id >> 3) & 7, b = id >> 6; att::attn_unit<true>(Fl, p, l, h, b * SEQ + qb * 256, qb * 256, b * SEQ, 32, NLAT + b * CTXL); }
                else { const int i2 = id - 2048, h = i2 & 7, b = i2 >> 3; att::attn_unit<true>(Fl, p, l, h, NLAT + b * CTXL, -1, 0, 0, NLAT + b * CTXL); }
            }
            const int n_df = 1024 + (ctx_live ? 128 : 0);
            if (PHM(14)) for (int rp = 0; rp < NREP(14); ++rp) for (int id = F.vcu; id < n_df; id += F.G) {
                if (id < 1024) { const int qb = id & 7, h = (id >> 3) & 3, b = id >> 5; att::attn_unit<false>(Fl, p, l, h, b * SEQ + qb * 256, qb * 256, b * SEQ, 32, NLAT + b * CTXL); }
                else { const int i2 = id - 1024, h = i2 & 3, b = i2 >> 2; att::attn_unit<false>(Fl, p, l, h, NLAT + b * CTXL, -1, 0, 0, NLAT + b * CTXL); }
            }
            if (PHM(15)) for (int rp = 0; rp < NREP(15); ++rp) for (int c = F.vcu; c < 256; c += F.G)
                hyena_unit<SEQ>(Fl, (const hf*)(ws + WS_RF) + ((size_t)l * 256 + c) * 4096, (const hf*)(ws + A_UT) + (size_t)c * NLAT, (const hf*)(ws + A_X0T) + (size_t)c * NLAT, Y + 512 + c);
            if (PHM(16) && ctx_live) for (int rp = 0; rp < NREP(15); ++rp) for (int c = F.vcu; c < 256; c += F.G)
                hyena_unit<CTXL>(Fl, (const hf*)(ws + WS_RFC) + ((size_t)l * 256 + c) * 512, (const hf*)(ws + A_UTC) + (size_t)c * NCTX, (const hf*)(ws + A_X0TC) + (size_t)c * NCTX, Y + (size_t)NLAT * DM + 512 + c);
            __syncthreads();
        }
        SEAM(pb + 3);
        if (PHM(5) && IN(pb + 4)) for (int rep = 0; rep < NREP(5); ++rep) { pg8::Gemm g{XS1, (const hf*)(wl + W_ING), Mrows, NGATE, DM, DM, DM}; pg8::StaticOrder S; S.init(Mrows, NGATE, F.G, (int)blockIdx.x);
            pg8::EpiHalf<1, true> E{Gt, NGATE, ss1, biasl + B_G}; pg8::gemm_phase(F.lds, g, S, E); }
        SEAM(pb + 4);
        if (PHM(6) && IN(pb + 5)) for (int rep = 0; rep < NREP(6); ++rep) { pg8::StaticOrder S; S.init(Mrows, DM, F.G, (int)blockIdx.x); const hf* wbr = (const hf*)(wl + W_BR);
            { pg8::Gemm g{Y, wbr, Mrows, DM, 512, DM, DM}; pg8::EpiGated<true> E{MM, Gt, 0}; pg8::gemm_phase(F.lds, g, S, E); }
            { pg8::Gemm g{Y + 512, wbr + 512, Mrows, DM, 256, DM, DM}; pg8::EpiGated<false> E{MM, Gt, 1024}; pg8::gemm_phase(F.lds, g, S, E); }
            { pg8::Gemm g{Y + 768, wbr + 768, Mrows, DM, 256, DM, DM}; pg8::EpiGated<false> E{MM, Gt, 2048}; pg8::gemm_phase(F.lds, g, S, E); } }
        SEAM(pb + 5);
        if (PHM(7) && IN(pb + 6)) { pg8::Gemm g{MM, (const hf*)(wl + W_OUT), Mrows, DM, DM, DM, DM}; pg8::StaticOrder S; S.init(Mrows, DM, F.G, (int)blockIdx.x);
            pg8::EpiResidX<true, true> E{xin_lat, xin_ctx, X, XC, modl + 2 * DM, XS2, gsl + (size_t)NMODV * DM, ss2}; pg8::gemm_phase(F.lds, g, S, E); }
        SEAM(pb + 6);
        if (PHM(9) && IN(pb + 7)) for (int rep = 0; rep < NREP(9); ++rep) { pg8::Gemm g{XS2, (const hf*)(wl + W_FC1), Mrows, DFF, DM, DM, DM}; pg8::StaticOrder S; S.init(Mrows, DFF, F.G, (int)blockIdx.x);
            pg8::EpiHalf<2, true> E{HID, DFF, ss2, biasl + B_FC1}; pg8::gemm_phase(F.lds, g, S, E); }
        SEAM(pb + 7);
        if (PHM(10) && IN(pb + 8)) { pg8::Gemm g{HID, (const hf*)(wl + W_FC2), Mrows, DM, DFF, DFF, DFF}; pg8::StaticOrder S; S.init(Mrows, DM, F.G, (int)blockIdx.x);
            if (ctx_live) { pg8::EpiResidX<true, true> E{X, XC, X, XC, modl + 5 * DM, XS1, gsl + (size_t)2 * NMODV * DM, ss1 + MTOT}; pg8::gemm_phase(F.lds, g, S, E); }
            else { pg8::EpiResidX<false, true> E{X, XC, X, XC, modl + 5 * DM, nullptr, nullptr, SS + (size_t)SS_F * MTOT}; pg8::gemm_phase(F.lds, g, S, E); } }
        SEAM(pb + 8);
    }
    if (PHM(12) && IN(NPHASE - 1)) { LAUNDER(Fl); final_norm_phase(Fl, X, p.in[I_FNG], SS + (size_t)SS_F * MTOT); }
#undef IN
#undef SEAM
}

extern "C" void kernel_launch(void* const* d_in, const int* in_sizes, int n_in, void* d_out, int out_size, void* d_ws, size_t ws_size, hipStream_t stream) {
    static int grid = 0;
    if (grid == 0) {
        if (n_in != 35 || in_sizes[0] != NLAT * DM || out_size != NLAT * DM || ws_size < WS_END) {
            fprintf(stderr, "kernel_launch: unexpected shapes: n_in %d in0 %d out %d ws %zu (need %zu); nothing launched\n", n_in, n_in > 0 ? in_sizes[0] : -1, out_size, ws_size, (size_t)WS_END); grid = -1; return; }
        int dev = 0, cus = 0, per_cu = 0;
        if (hipGetDevice(&dev) != hipSuccess || hipDeviceGetAttribute(&cus, hipDeviceAttributeMultiprocessorCount, dev) != hipSuccess) { fprintf(stderr, "kernel_launch: device query failed\n"); grid = -1; return; }
        if (hipFuncSetAttribute((const void*)fwd_kernel, hipFuncAttributeMaxDynamicSharedMemorySize, LDS_BYTES) != hipSuccess) { fprintf(stderr, "kernel_launch: hipFuncSetAttribute failed\n"); grid = -1; return; }
        if (hipOccupancyMaxActiveBlocksPerMultiprocessor(&per_cu, (const void*)fwd_kernel, 512, LDS_BYTES) != hipSuccess || per_cu < 1)
            fprintf(stderr, "kernel_launch: note: occupancy query reports %d workgroups per CU\n", per_cu);
        (void)hipGetLastError();
        grid = cus;
    }
    if (grid < 0) return;
    if (hipMemsetAsync((char*)d_ws + WS_BAR, 0, WS_ZERO_BYTES, stream) != hipSuccess) { fprintf(stderr, "kernel_launch: memset failed\n"); return; }
    Params P{};
    for (int i = 0; i < 35; ++i) P.in[i] = (const float*)d_in[i];
    P.out = (float*)d_out; P.ws = (unsigned char*)d_ws;
#if MK_FUSED
    P.ph_lo = 0; P.ph_hi = NPHASE;
    hipLaunchKernelGGL(fwd_kernel, dim3(grid), dim3(512), LDS_BYTES, stream, P);
#else
    for (int ph = 0; ph < NPHASE; ++ph) { P.ph_lo = ph; P.ph_hi = ph + 1; hipLaunchKernelGGL(fwd_kernel, dim3(grid), dim3(512), LDS_BYTES, stream, P); }
#endif
    const hipError_t le = hipPeekAtLastError();
    if (le != hipSuccess) fprintf(stderr, "kernel_launch: launch failed: %s\n", hipGetErrorName(le));
}
```

```cpp
#include <hip/hip_runtime.h>
#include <cstdio>
#include <cstdint>

#ifndef MK_FUSED
#define MK_FUSED 1
#endif

#define LAS __attribute__((address_space(3)))
#define GAS __attribute__((address_space(1)))
typedef _Float16 hf;
typedef _Float16 hf2 __attribute__((ext_vector_type(2)));
typedef _Float16 hf4 __attribute__((ext_vector_type(4)));
typedef _Float16 hf8 __attribute__((ext_vector_type(8)));
typedef short s16x4 __attribute__((ext_vector_type(4)));
typedef float f32x2 __attribute__((ext_vector_type(2)));
typedef float f32x4 __attribute__((ext_vector_type(4)));
typedef float f32x16 __attribute__((ext_vector_type(16)));
typedef unsigned u32x2 __attribute__((ext_vector_type(2)));
typedef unsigned u32x4 __attribute__((ext_vector_type(4)));

constexpr int DM = 1024, NB = 32, SEQ = 2048, DEPTH = 4, CTXL = 256, GRIDW = 64;
constexpr int NLAT = NB * SEQ;
constexpr int NCTX = NB * CTXL;
constexpr int MTOT = NLAT + NCTX;
constexpr int D_IN = 5024, NP1 = 2048  , NGATE = 3072, DFF = 4096;
constexpr int C_PQ = 0, C_PKV = 256, C_PKR = 384, C_HY = 416, C_DQ = 1184, C_DK = 1440, C_DV = 1696, C_PG = 1952;
constexpr int NUP = 1792, KUP = 384;
constexpr int NMODV = 33, MODW = 6 * DM;
constexpr float EPS = 1e-6f;
constexpr float MLA_SCALE = 0.10206207261596575f;
constexpr float DF_SCALE = 0.17677669529663687f;

constexpr size_t al256(size_t x) { return (x + 255) / 256 * 256; }
constexpr size_t WS_BAR = 0, WS_BAR_BYTES = 65536;
constexpr size_t WS_SS = WS_BAR + WS_BAR_BYTES;
constexpr int SS_1 = 0, SS_2 = DEPTH, SS_F = 2 * DEPTH, SS_Q = 2 * DEPTH + 1, SS_KV = 3 * DEPTH + 1, SS_N = 4 * DEPTH + 1;
constexpr size_t WS_ZERO_BYTES = WS_BAR_BYTES + al256((size_t)SS_N * MTOT * 4);
constexpr size_t WS_MOD = WS_BAR + WS_ZERO_BYTES;
constexpr size_t WS_GS = WS_MOD + al256((size_t)DEPTH * NMODV * MODW * 4);
constexpr int NBIAS = 9216, B_IN = 0, B_G = 2048, B_FC1 = 5120;
constexpr size_t WS_BIAS = WS_GS + (size_t)DEPTH * 2 * NMODV * DM * 4;
constexpr size_t WS_ROPE = WS_BIAS + (size_t)DEPTH * NMODV * NBIAS * 4;
constexpr size_t WS_LAM = WS_ROPE + (size_t)SEQ * 32 * 4;
constexpr size_t WS_RF = WS_LAM + 256;
constexpr size_t WS_RFC = WS_RF + (size_t)DEPTH * 256 * 4096 * 2;
constexpr size_t WS_XC = WS_RFC + (size_t)DEPTH * 256 * 512 * 2;
constexpr size_t WS_WT = WS_XC + (size_t)NCTX * DM * 4;
constexpr size_t W_IN1 = 0, W_ING = W_IN1 + (size_t)NP1 * DM * 2, W_UP = W_ING + (size_t)NGATE * DM * 2, W_BR = W_UP + (size_t)NUP * KUP * 2,
                 W_OUT = W_BR + (size_t)DM * DM * 2, W_FC1 = W_OUT + (size_t)DM * DM * 2, W_FC2 = W_FC1 + (size_t)DFF * DM * 2, W_LAYER = W_FC2 + (size_t)DM * DFF * 2;
constexpr size_t WS_ARENA = WS_WT + 2 * W_LAYER;
constexpr size_t SZ_ROW1024 = (size_t)MTOT * 1024 * 2;
constexpr size_t A_A = WS_ARENA;
constexpr size_t A_B = A_A + SZ_ROW1024;
constexpr size_t A_C = A_B + SZ_ROW1024;
constexpr size_t A_H = A_A, A_Y = A_B, A_XS2 = A_B, A_BIG = A_C;
constexpr size_t A_QKVN = A_BIG;
constexpr size_t A_KR = A_QKVN + (size_t)MTOT * KUP * 2;
constexpr size_t A_DQ = A_KR + (size_t)MTOT * 32 * 2;
constexpr size_t A_DK = A_DQ + (size_t)MTOT * 256 * 2;
constexpr size_t A_DV = A_DK + (size_t)MTOT * 256 * 2;
constexpr size_t A_UT = A_DV + (size_t)MTOT * 256 * 2;
constexpr size_t A_X0T = A_UT + (size_t)256 * NLAT * 2;
constexpr size_t A_UTC = A_X0T + (size_t)256 * NLAT * 2;
constexpr size_t A_X0TC = A_UTC + (size_t)256 * NCTX * 2;
constexpr size_t A_PHY = A_X0TC + (size_t)256 * NCTX * 2;
constexpr size_t A_QKV = A_PHY;
constexpr size_t A_BIG_END = A_QKV + (size_t)MTOT * NUP * 2;
constexpr size_t A_G = A_BIG;
constexpr size_t A_HID = A_C;
constexpr size_t WS_END = (A_BIG_END > A_HID + (size_t)MTOT * DFF * 2) ? A_BIG_END : A_HID + (size_t)MTOT * DFF * 2;
static_assert(WS_END <= (size_t)1024 * 1024 * 1024, "workspace map exceeds 1 GiB");

constexpr int LDS_BYTES = 147456;
constexpr int LDS_MISC = LDS_BYTES - 64;

__device__ __forceinline__ unsigned pkh(float lo, float hi) { f32x2 v = {lo, hi}; hf2 h = __builtin_convertvector(v, hf2); return __builtin_bit_cast(unsigned, h); }
__device__ __forceinline__ float wave_sum(float v) {
#pragma unroll
    for (int o = 1; o < 64; o <<= 1) v += __shfl_xor(v, o);
    return v;
}
#define LDS_WAIT() asm volatile("s_waitcnt lgkmcnt(0)" ::: "memory")
#define VM_WAIT() asm volatile("s_waitcnt vmcnt(0)" ::: "memory")

#define XB_TMO      128
#define XB_XCNT(j)  (256  + 64 * (j))
#define XB_XSUB(j)  (1280 + 64 * (j))
#define XB_XGEN(j)  (2304 + 64 * (j))
#define XB_TOP      3328
#define XB_TOPGEN   3392
#define XCD_BAR_WORDS 3456
#define XB_SPIN_CAP (1u << 22)
__device__ __forceinline__ unsigned xb_ld(unsigned* p)              { return __hip_atomic_load(p, __ATOMIC_RELAXED, __HIP_MEMORY_SCOPE_AGENT); }
__device__ __forceinline__ unsigned xb_add(unsigned* p, unsigned v) { return __hip_atomic_fetch_add(p, v, __ATOMIC_RELAXED, __HIP_MEMORY_SCOPE_AGENT); }
__device__ __forceinline__ unsigned xb_xcc_id() { return (unsigned)__builtin_amdgcn_s_getreg((3 << 11) | 20) & 0xFu; }
#define XB_SPIN(cond, bar) do { unsigned _sp = 0; while (cond) { __builtin_amdgcn_s_sleep(1); \
    if ((++_sp & 255u) == 0u) { if (xb_ld(&(bar)[XB_TMO])) break; if (_sp > XB_SPIN_CAP) { atomicAdd(&(bar)[XB_TMO], 1u); break; } } } } while (0)
struct XcdBarrier { unsigned* bar; unsigned x; volatile LAS unsigned* st; };
__device__ __forceinline__ XcdBarrier xcd_barrier_post(unsigned* bar, volatile LAS unsigned* st) {
    XcdBarrier b; b.bar = bar; b.x = xb_xcc_id(); b.st = st;
    if (threadIdx.x == 0) (void)xb_add(&bar[XB_XCNT(b.x)], 1u);
    return b;
}
__device__ __forceinline__ void xcd_barrier_complete(unsigned* bar, unsigned x, unsigned& nloc, unsigned& nx) {
    const unsigned G = gridDim.x * gridDim.y * gridDim.z;
    unsigned sum, cnt, mine, sp = 0u;
    for (;;) {
        sum = 0u; cnt = 0u; mine = 0u;
#pragma unroll
        for (unsigned j = 0; j < 16; ++j) { const unsigned c = xb_ld(&bar[XB_XCNT(j)]); sum += c; cnt += (c > 0u) ? 1u : 0u; mine = (j == x) ? c : mine; }
        if (sum == G) break;
        __builtin_amdgcn_s_sleep(1);
        if ((++sp & 255u) == 0u) { if (xb_ld(&bar[XB_TMO])) break; if (sp > XB_SPIN_CAP) { atomicAdd(&bar[XB_TMO], 1u); break; } }
    }
    nloc = mine > 0u ? mine : 1u; nx = cnt > 0u ? cnt : 1u;
}
__device__ __forceinline__ void xcd_barrier(const XcdBarrier& b) {
    asm volatile("s_waitcnt vmcnt(0)" ::: "memory");
    __syncthreads();
    if (threadIdx.x == 0) {
        unsigned* bar = b.bar;
        __builtin_amdgcn_s_waitcnt(0);
        unsigned nloc = b.st[0], nx = b.st[1];
        if (nloc == 0u) { xcd_barrier_complete(bar, b.x, nloc, nx); b.st[0] = nloc; b.st[1] = nx; }
        const unsigned old = xb_add(&bar[XB_XSUB(b.x)], 1u);
        const unsigned gen = old / nloc;
        if (old + 1u == (gen + 1u) * nloc) {
            __builtin_amdgcn_fence(__ATOMIC_RELEASE, "agent");
            asm volatile("s_waitcnt vmcnt(0)" ::: "memory");
            const unsigned og = xb_add(&bar[XB_TOP], 1u);
            const unsigned tg = og / nx;
            if (og + 1u == (tg + 1u) * nx) xb_add(&bar[XB_TOPGEN], 1u);
            else XB_SPIN(xb_ld(&bar[XB_TOPGEN]) == tg, bar);
            __builtin_amdgcn_fence(__ATOMIC_ACQUIRE, "agent");
            xb_add(&bar[XB_XGEN(b.x)], 1u);
            asm volatile("s_waitcnt vmcnt(0)" ::: "memory");
        } else {
            XB_SPIN(xb_ld(&bar[XB_XGEN(b.x)]) == gen, bar);
            __builtin_amdgcn_fence(__ATOMIC_ACQUIRE, "agent");
            asm volatile("s_waitcnt vmcnt(0)" ::: "memory");
        }
    }
    __syncthreads();
}

namespace pg8 {
constexpr int BM = 256, BK = 64, HALF = 128, HTB = HALF * BK * 2, STAGE_BYTES = 8 * HTB, NXCD = 8, WGM = 8;
__host__ __device__ __forceinline__ int lds_byte(int r, int c) { const int st = (r >> 4) * 2 + (c >> 5), rr = r & 15, cc = c & 31, ob = rr * 64 + cc * 2; return st * 1024 + (ob ^ (((ob >> 9) & 1) << 5)); }
__host__ __device__ __forceinline__ void stage_rc(int b, int& R, int& C) { const int st = b / 1024, sb = b % 1024, swz = sb ^ (((sb >> 9) & 1) << 5); R = (st >> 1) * 16 + swz / 64; C = (st & 1) * 32 + (swz % 64) / 2; }
__host__ __device__ __forceinline__ int perm32(int rho) { const int n = rho >> 4, i = rho & 15; return 8 * (i >> 2) + 4 * n + (i & 3); }
struct Unit { int pm, pn; };
struct Gemm { const hf* A; const hf* Bt; int M, N, K, lda, ldb; };
struct StaticOrder {
    int nM, nN, nwg, G, c;
    __host__ __device__ void init(int M, int N, int G_, int c_) { nM = M / BM; nN = N / BM; nwg = nM * nN; G = G_; c = c_; }
    __host__ __device__ bool next(int i, Unit& u) const {
        const long L = (long)i * G + c; if (L >= nwg) return false;
        int wgid = (int)L; { const int q = nwg / NXCD, r = nwg % NXCD, xcd = wgid % NXCD, off = wgid / NXCD; wgid = (xcd < r ? xcd * (q + 1) : r * (q + 1) + (xcd - r) * q) + off; }
        const int nig = WGM * nN, gid = wgid / nig, fm = gid * WGM, gsz = (nM - fm) < WGM ? (nM - fm) : WGM;
        u.pm = fm + ((wgid % nig) % gsz); u.pn = (wgid % nig) / gsz; return true;
    }
    __device__ __forceinline__ void a_ready(const Unit&) const {}
    __device__ __forceinline__ void done(const Unit&) const {}
};

template <int ACT  , bool NORM> struct EpiHalf {
    static constexpr bool PERM = true, AFTER_DRAIN = false, PROBE2 = false;
    hf* O; int ldc; const float* ss; const float* bias;
    __device__ __forceinline__ void operator()(const f32x4 (&acc)[2][2][4][2], const Unit& u, int wr, int wc, int fr, int fq) const {
        const int row0 = u.pm * BM + wr * 64 + fr, col0 = u.pn * BM + wc * 32 + 8 * fq;
        f32x4 bv[2][2];
        if (NORM) { const int R0 = u.pm * BM; const int v = (R0 < NLAT) ? (R0 >> 11) : NB; const float* bp = bias + (size_t)v * NBIAS + col0;
#pragma unroll
            for (int bj = 0; bj < 2; ++bj)
#pragma unroll
                for (int n = 0; n < 2; ++n) bv[bj][n] = *(const f32x4*)(bp + bj * HALF + 4 * n); }
#pragma unroll
        for (int ai = 0; ai < 2; ++ai)
#pragma unroll
            for (int m = 0; m < 4; ++m) { const int r = row0 + ai * HALF + m * 16; hf* rowp = O + (size_t)r * ldc + col0;
                float rs = 1.f; if (NORM) rs = rsqrtf(ss[r] * (1.f / DM) + EPS);
#pragma unroll
                for (int bj = 0; bj < 2; ++bj) { f32x4 v0 = acc[ai][bj][m][0], v1 = acc[ai][bj][m][1];
                    if (NORM) { v0 = v0 * rs + bv[bj][0]; v1 = v1 * rs + bv[bj][1]; }
                    if (ACT == 1) {
#pragma unroll
                        for (int e = 0; e < 4; ++e) { v0[e] = __builtin_amdgcn_rcpf(1.f + __builtin_amdgcn_exp2f(-1.4426950408889634f * v0[e])); v1[e] = __builtin_amdgcn_rcpf(1.f + __builtin_amdgcn_exp2f(-1.4426950408889634f * v1[e])); } }
                    if (ACT == 2) {
#pragma unroll
                        for (int e = 0; e < 4; ++e) { const float a = fmaxf(v0[e], 0.f), b = fmaxf(v1[e], 0.f); v0[e] = a * a; v1[e] = b * b; } }
                    u32x4 w; w.x = pkh(v0[0], v0[1]); w.y = pkh(v0[2], v0[3]); w.z = pkh(v1[0], v1[1]); w.w = pkh(v1[2], v1[3]);
                    *(u32x4*)(rowp + bj * HALF) = w; } }
    }
};
struct EpiIn {
    static constexpr bool PERM = true, AFTER_DRAIN = false, PROBE2 = false;
    hf* QKVNo; hf* KRo; hf* PHYo; hf* DQo; hf* DKo; hf* DVo; const float* ss; const float* bias; float* ssq; float* sskv;
    __device__ __forceinline__ void operator()(const f32x4 (&acc)[2][2][4][2], const Unit& u, int wr, int wc, int fr, int fq) const {
        const int R0 = u.pm * BM, row0 = R0 + wr * 64 + fr, col0 = u.pn * BM + wc * 32 + 8 * fq;
        const int v = (R0 < NLAT) ? (R0 >> 11) : NB; const float* bp = bias + (size_t)v * NBIAS + col0;
        f32x4 bv[2][2]; hf* dst[2]; int ld[2];
#pragma unroll
        for (int bj = 0; bj < 2; ++bj) { const int c8 = col0 + bj * HALF;
            bv[bj][0] = *(const f32x4*)(bp + bj * HALF); bv[bj][1] = *(const f32x4*)(bp + bj * HALF + 4);
            if (c8 < C_PKR) { dst[bj] = QKVNo + c8; ld[bj] = KUP; }
            else if (c8 < C_HY) { dst[bj] = KRo + (c8 - C_PKR); ld[bj] = 32; }
            else if (c8 < C_DQ) { dst[bj] = PHYo + (c8 - C_HY); ld[bj] = 768; }
            else if (c8 < C_DK) { dst[bj] = DQo + (c8 - C_DQ); ld[bj] = 256; }
            else if (c8 < C_DV) { dst[bj] = DKo + (c8 - C_DK); ld[bj] = 256; }
            else if (c8 < C_PG) { dst[bj] = DVo + (c8 - C_DV); ld[bj] = 256; }
            else { dst[bj] = nullptr; ld[bj] = 0; } }
        const int nstat = (u.pn == 0) ? 2 : (u.pn == 1 ? 1 : 0);
        float* sp = (u.pn == 0) ? ssq : sskv;
#pragma unroll
        for (int ai = 0; ai < 2; ++ai)
#pragma unroll
            for (int m = 0; m < 4; ++m) { const int r = row0 + ai * HALF + m * 16; const float rs = rsqrtf(ss[r] * (1.f / DM) + EPS); float sq = 0.f;
#pragma unroll
                for (int bj = 0; bj < 2; ++bj) { const f32x4 v0 = acc[ai][bj][m][0] * rs + bv[bj][0], v1 = acc[ai][bj][m][1] * rs + bv[bj][1];
                    if (bj < nstat) sq += (v0[0] * v0[0] + v0[1] * v0[1]) + (v0[2] * v0[2] + v0[3] * v0[3]) + (v1[0] * v1[0] + v1[1] * v1[1]) + (v1[2] * v1[2] + v1[3] * v1[3]);
                    if (dst[bj]) { u32x4 w; w.x = pkh(v0[0], v0[1]); w.y = pkh(v0[2], v0[3]); w.z = pkh(v1[0], v1[1]); w.w = pkh(v1[2], v1[3]); *(u32x4*)(dst[bj] + (size_t)r * ld[bj]) = w; } }
                if (nstat) { sq += __shfl_xor(sq, 16); sq += __shfl_xor(sq, 32);
                    if (fq == 0) (void)__hip_atomic_fetch_add(sp + r, sq, __ATOMIC_RELAXED, __HIP_MEMORY_SCOPE_AGENT); } }
    }
};
struct EpiUp {
    static constexpr bool PERM = true, AFTER_DRAIN = false, PROBE2 = false;
    hf* O; const float* ssq; const float* sskv;
    __device__ __forceinline__ void operator()(const f32x4 (&acc)[2][2][4][2], const Unit& u, int wr, int wc, int fr, int fq) const {
        const int row0 = u.pm * BM + wr * 64 + fr, col0 = u.pn * BM + wc * 32 + 8 * fq;
        const bool isq = u.pn < 3; const float* sp = isq ? ssq : sskv; const float invn = isq ? (1.f / 256.f) : (1.f / 128.f);
#pragma unroll
        for (int ai = 0; ai < 2; ++ai)
#pragma unroll
            for (int m = 0; m < 4; ++m) { const int r = row0 + ai * HALF + m * 16; hf* rowp = O + (size_t)r * NUP + col0; const float rs = rsqrtf(sp[r] * invn + EPS);
#pragma unroll
                for (int bj = 0; bj < 2; ++bj) { const f32x4 v0 = acc[ai][bj][m][0] * rs, v1 = acc[ai][bj][m][1] * rs;
                    u32x4 w; w.x = pkh(v0[0], v0[1]); w.y = pkh(v0[2], v0[3]); w.z = pkh(v1[0], v1[1]); w.w = pkh(v1[2], v1[3]);
                    *(u32x4*)(rowp + bj * HALF) = w; } }
    }
};
template <bool FIRST> struct EpiGated {
    static constexpr bool PERM = true, AFTER_DRAIN = false, PROBE2 = false;
    hf* MMo; const hf* G; int goff;
    __device__ __forceinline__ void operator()(const f32x4 (&acc)[2][2][4][2], const Unit& u, int wr, int wc, int fr, int fq) const {
        const int row0 = u.pm * BM + wr * 64 + fr, col0 = u.pn * BM + wc * 32 + 8 * fq;
#pragma unroll
        for (int ai = 0; ai < 2; ++ai)
#pragma unroll
            for (int m = 0; m < 4; ++m) { const size_t r = (size_t)(row0 + ai * HALF + m * 16);
#pragma unroll
                for (int bj = 0; bj < 2; ++bj) { const f32x4 v0 = acc[ai][bj][m][0], v1 = acc[ai][bj][m][1];
                    const hf8 g = *(const hf8*)(G + r * NGATE + goff + col0 + bj * HALF);
                    hf* mp = MMo + r * DM + col0 + bj * HALF;
                    float o[8];
#pragma unroll
                    for (int e = 0; e < 4; ++e) { o[e] = (float)g[e] * v0[e]; o[4 + e] = (float)g[4 + e] * v1[e]; }
                    if (!FIRST) { const hf8 p = *(const hf8*)mp;
#pragma unroll
                        for (int e = 0; e < 8; ++e) o[e] += (float)p[e]; }
                    u32x4 w; w.x = pkh(o[0], o[1]); w.y = pkh(o[2], o[3]); w.z = pkh(o[4], o[5]); w.w = pkh(o[6], o[7]);
                    *(u32x4*)mp = w; } }
    }
};
template <bool XS, bool STAT> struct EpiResidX {
    static constexpr bool PERM = true, AFTER_DRAIN = false, PROBE2 = false;
    const float* xs_lat; const float* xs_ctx; float* xd_lat; float* xd_ctx; const float* gate;
    hf* xsout; const float* gs; float* ss;
    __device__ __forceinline__ void operator()(const f32x4 (&acc)[2][2][4][2], const Unit& u, int wr, int wc, int fr, int fq) const {
        const int R0 = u.pm * BM; const bool lat = R0 < NLAT;
        const int v = lat ? (R0 >> 11) : NB;
        const int rglob = R0 + wr * 64 + fr, rloc = (lat ? rglob : rglob - NLAT), col0 = u.pn * BM + wc * 32 + 8 * fq;
        const float* src = lat ? xs_lat : xs_ctx; float* dst = lat ? xd_lat : xd_ctx; const float* gp = gate + (size_t)v * MODW + col0; const float* gsp = gs + (size_t)v * DM + col0;
        float sq[2][4];
#pragma unroll
        for (int ai = 0; ai < 2; ++ai)
#pragma unroll
            for (int m = 0; m < 4; ++m) sq[ai][m] = 0.f;
#pragma unroll
        for (int bj = 0; bj < 2; ++bj) {
            const f32x4 g0 = *(const f32x4*)(gp + bj * HALF), g1 = *(const f32x4*)(gp + bj * HALF + 4);
            f32x4 s0 = {1.f, 1.f, 1.f, 1.f}, s1 = s0; if (XS) { s0 = *(const f32x4*)(gsp + bj * HALF); s1 = *(const f32x4*)(gsp + bj * HALF + 4); }
#pragma unroll
            for (int ai = 0; ai < 2; ++ai)
#pragma unroll
                for (int m = 0; m < 4; ++m) { const int rr = ai * HALF + m * 16; const size_t off = (size_t)(rloc + rr) * DM + col0 + bj * HALF;
                    const f32x4 x0 = *(const f32x4*)(src + off), x1 = *(const f32x4*)(src + off + 4);
                    const f32x4 n0 = x0 + g0 * acc[ai][bj][m][0], n1 = x1 + g1 * acc[ai][bj][m][1];
                    *(f32x4*)(dst + off) = n0; *(f32x4*)(dst + off + 4) = n1;
                    if (STAT) sq[ai][m] += (n0[0] * n0[0] + n0[1] * n0[1]) + (n0[2] * n0[2] + n0[3] * n0[3]) + (n1[0] * n1[0] + n1[1] * n1[1]) + (n1[2] * n1[2] + n1[3] * n1[3]);
                    if (XS) { const f32x4 a = n0 * s0, b = n1 * s1; u32x4 w; w.x = pkh(a[0], a[1]); w.y = pkh(a[2], a[3]); w.z = pkh(b[0], b[1]); w.w = pkh(b[2], b[3]);
                        *(u32x4*)(xsout + (size_t)(rglob + rr) * DM + col0 + bj * HALF) = w; } }
        }
        if (STAT) {
#pragma unroll
            for (int ai = 0; ai < 2; ++ai)
#pragma unroll
                for (int m = 0; m < 4; ++m) { float t = sq[ai][m]; t += __shfl_xor(t, 16); t += __shfl_xor(t, 32);
                    if (fq == 0) (void)__hip_atomic_fetch_add(ss + rglob + ai * HALF + m * 16, t, __ATOMIC_RELAXED, __HIP_MEMORY_SCOPE_AGENT); }
        }
    }
};

template <class Epi, class Sched, bool ALIGN_EPI = true>
__device__ __forceinline__ void gemm_phase(LAS unsigned char* lds, const Gemm g, const Sched& S, const Epi& E) {
    int tid = threadIdx.x; asm volatile("" : "+v"(tid));
    const int wid = __builtin_amdgcn_readfirstlane(tid >> 6), lane = tid & 63, wr = wid >> 2, wc = wid & 3, fr = lane & 15, fq = lane >> 4;
    const int K = g.K, nt = K / BK;
    unsigned voffA[2], voffB[2];
#pragma unroll
    for (int i = 0; i < 2; ++i) { int R, C; stage_rc(tid * 16 + i * 8192, R, C); const int Rb = Epi::PERM ? ((R & ~31) + perm32(R & 31)) : R;
        voffA[i] = (unsigned)(R * g.lda + C) * 2u; voffB[i] = (unsigned)(Rb * g.ldb + C) * 2u; }
    const size_t kstep = (size_t)(BK * 2);
    const size_t hstepA = (size_t)HALF * g.lda * 2, hstepB = (size_t)HALF * g.ldb * 2;
    const size_t tstepA = 2 * hstepA, tstepB = 2 * hstepB;
    const unsigned ldsw = (unsigned)wid * 1024u;
    const int aoff = lds_byte(wr * 64 + fr, fq * 8), boff = lds_byte(wc * 32 + fr, fq * 8);
#define PG8_SA(b, h) (((b) * 2 + (h)) * HTB)
#define PG8_SB(b, h) ((4 + (b) * 2 + (h)) * HTB)
#define PG8_STAGE(bufoff, gbase, voff) do { _Pragma("unroll") for (int _i = 0; _i < 2; ++_i) \
        __builtin_amdgcn_global_load_lds((const unsigned*)((const char*)(gbase) + (voff)[_i]), (LAS unsigned*)(lds + (bufoff) + ldsw + _i * 8192), 16, 0, 0); } while (0)
#define PG8_LDA(dst, b, h) do { _Pragma("unroll") for (int m = 0; m < 4; ++m) _Pragma("unroll") for (int k = 0; k < 2; ++k) dst[m][k] = *(const LAS hf8*)(lds + PG8_SA(b, h) + aoff + m * 2048 + k * 1024); } while (0)
#define PG8_LDB(dst, b, h) do { _Pragma("unroll") for (int n = 0; n < 2; ++n) _Pragma("unroll") for (int k = 0; k < 2; ++k) dst[n][k] = *(const LAS hf8*)(lds + PG8_SB(b, h) + boff + n * 2048 + k * 1024); } while (0)
#define PG8_MMA(ai, bj, At, Bt) do { __builtin_amdgcn_s_setprio(1); _Pragma("unroll") for (int m = 0; m < 4; ++m) _Pragma("unroll") for (int n = 0; n < 2; ++n) _Pragma("unroll") for (int k = 0; k < 2; ++k) \
        acc[ai][bj][m][n] = __builtin_amdgcn_mfma_f32_16x16x32_f16(Bt[n][k], At[m][k], acc[ai][bj][m][n], 0, 0, 0); __builtin_amdgcn_s_setprio(0); } while (0)
#define PG8_WAIT_V(n) asm volatile("s_waitcnt vmcnt(" #n ")" ::: "memory")
#define PG8_WAIT_L(n) asm volatile("s_waitcnt lgkmcnt(" #n ")" ::: "memory")
#define PG8_BAR __builtin_amdgcn_s_barrier()
#define PG8_SCHED __builtin_amdgcn_sched_barrier(0)
    Unit cur, nxt; int ui = 0;
    if (!S.next(0, cur)) return;
    f32x4 acc[2][2][4][2];
#pragma unroll
    for (int a = 0; a < 2; ++a)
#pragma unroll
        for (int b = 0; b < 2; ++b)
#pragma unroll
            for (int m = 0; m < 4; ++m)
#pragma unroll
                for (int n = 0; n < 2; ++n) acc[a][b][m][n] = (f32x4){0.f, 0.f, 0.f, 0.f};
    hf8 At[4][2], B0[2][2], B1[2][2];
    const char* cA = (const char*)g.A + (size_t)cur.pm * tstepA; const char* cB = (const char*)g.Bt + (size_t)cur.pn * tstepB;
    S.a_ready(cur);
    PG8_STAGE(PG8_SB(0, 0), cB, voffB); PG8_STAGE(PG8_SB(0, 1), cB + hstepB, voffB); PG8_STAGE(PG8_SA(0, 0), cA, voffA); PG8_STAGE(PG8_SA(0, 1), cA + hstepA, voffA);
    if (wr == 1) PG8_BAR;
    PG8_WAIT_V(2); PG8_BAR;
    PG8_STAGE(PG8_SB(1, 0), cB + kstep, voffB); PG8_STAGE(PG8_SA(1, 0), cA + kstep, voffA); PG8_STAGE(PG8_SB(1, 1), cB + hstepB + kstep, voffB);
    PG8_WAIT_V(6); PG8_BAR;
    for (;;) {
        const bool has_next = S.next(ui + 1, nxt);
        const char* nA = has_next ? (const char*)g.A + (size_t)nxt.pm * tstepA : cA; const char* nB = has_next ? (const char*)g.Bt + (size_t)nxt.pn * tstepB : cB;
#pragma unroll 1
        for (int t = 0; t < nt; t += 2) {
            const bool last = (t == nt - 2);
            const char* a1 = cA + (size_t)(t + 1) * kstep;
            const char* a2 = last ? nA : cA + (size_t)(t + 2) * kstep; const char* b2 = last ? nB : cB + (size_t)(t + 2) * kstep;
            const char* a3 = a2 + kstep; const char* b3 = b2 + kstep;
            if (last && has_next) S.a_ready(nxt);
            PG8_LDB(B0, 0, 0); PG8_LDB(B1, 0, 1); PG8_SCHED; PG8_LDA(At, 0, 0); PG8_STAGE(PG8_SA(1, 1), a1 + hstepA, voffA);
            PG8_WAIT_V(8); PG8_WAIT_L(0); PG8_BAR; PG8_MMA(0, 0, At, B0); PG8_MMA(0, 1, At, B1); PG8_BAR; PG8_SCHED;
            PG8_LDA(At, 0, 1); PG8_STAGE(PG8_SB(0, 0), b2, voffB); PG8_STAGE(PG8_SB(0, 1), b2 + hstepB, voffB); PG8_STAGE(PG8_SA(0, 0), a2, voffA);
            PG8_WAIT_V(8); PG8_WAIT_L(0); PG8_BAR; PG8_MMA(1, 0, At, B0); PG8_MMA(1, 1, At, B1); PG8_BAR; PG8_SCHED;
            PG8_LDB(B0, 1, 0); PG8_LDB(B1, 1, 1); PG8_SCHED; PG8_LDA(At, 1, 0); PG8_STAGE(PG8_SA(0, 1), a2 + hstepA, voffA);
            PG8_WAIT_V(8); PG8_WAIT_L(0); PG8_BAR; PG8_MMA(0, 0, At, B0); PG8_MMA(0, 1, At, B1); PG8_BAR; PG8_SCHED;
            PG8_LDA(At, 1, 1); PG8_STAGE(PG8_SB(1, 0), b3, voffB); PG8_STAGE(PG8_SB(1, 1), b3 + hstepB, voffB); PG8_STAGE(PG8_SA(1, 0), a3, voffA);
            PG8_WAIT_V(8); PG8_WAIT_L(0); PG8_BAR; PG8_MMA(1, 0, At, B0); PG8_MMA(1, 1, At, B1); PG8_BAR; PG8_SCHED;
        }
        if constexpr (ALIGN_EPI) { if (wr == 0) PG8_BAR; }
        E(acc, cur, wr, wc, fr, fq); S.done(cur);
#ifdef PROBE_EPI2
        if (Epi::PROBE2) { asm volatile("" ::: "memory"); E(acc, cur, wr, wc, fr, fq); }
#endif
        if (!has_next) break;
#pragma unroll
        for (int a = 0; a < 2; ++a)
#pragma unroll
            for (int b = 0; b < 2; ++b)
#pragma unroll
                for (int m = 0; m < 4; ++m)
#pragma unroll
                    for (int n = 0; n < 2; ++n) acc[a][b][m][n] = (f32x4){0.f, 0.f, 0.f, 0.f};
        cur = nxt; cA = nA; cB = nB; ++ui;
        if constexpr (ALIGN_EPI) { if (wr == 1) PG8_BAR; }
    }
    PG8_WAIT_V(0);
    if constexpr (!ALIGN_EPI) { if (wr == 0) PG8_BAR; }
    PG8_BAR;
#undef PG8_SA
#undef PG8_SB
#undef PG8_STAGE
#undef PG8_LDA
#undef PG8_LDB
#undef PG8_MMA
#undef PG8_WAIT_V
#undef PG8_WAIT_L
#undef PG8_BAR
#undef PG8_SCHED
}
}

struct Params {
    const float* in[35];
    float* out;
    unsigned char* ws;
    int ph_lo, ph_hi;
};
enum { I_X = 0, I_C, I_CTX, I_CCTX, I_NMG, I_NFG, I_WMOD, I_BMOD, I_WIN, I_QNG, I_WUQ, I_KVNG, I_WUKV, I_HCW, I_HCB, I_HW1, I_HB1, I_HFREQ, I_HW2, I_HB2, I_HW3, I_HB3,
       I_HSKIP, I_LQ1, I_LK1, I_LQ2, I_LK2, I_SUBG, I_WBRA, I_WBRB, I_WBRC, I_WOUT, I_FC1, I_FC2, I_FNG };

struct Frame {
    LAS unsigned char* lds;
    int tid, lane, wave, vcu, G;
};

__device__ __forceinline__ void tr_item(const float* W, int ldw, hf* WT, int ldt, int nblk, LAS float* scr, int item, int lane, const float* kgain = nullptr) {
    const int kb = item / nblk, nb = item % nblk, k0 = 64 * kb, n0 = 32 * nb;
#pragma unroll 8
    for (int i = 0; i < 32; ++i) { const int kk = 2 * i + (lane >> 5); const float gk = kgain ? kgain[k0 + kk] : 1.f; scr[kk * 33 + (lane & 31)] = W[(size_t)(k0 + kk) * ldw + n0 + (lane & 31)] * gk; }
    LDS_WAIT(); asm volatile("" ::: "memory");
    const int c = lane & 7;
#pragma unroll
    for (int j = 0; j < 4; ++j) { const int n = (lane >> 3) + 8 * j; const LAS float* s = scr + (8 * c) * 33 + n;
        u32x4 o; o.x = pkh(s[0 * 33], s[1 * 33]); o.y = pkh(s[2 * 33], s[3 * 33]); o.z = pkh(s[4 * 33], s[5 * 33]); o.w = pkh(s[6 * 33], s[7 * 33]);
        *(u32x4*)(WT + (size_t)(n0 + n) * ldt + k0 + 8 * c) = o; }
    LDS_WAIT(); asm volatile("" ::: "memory");
}
__device__ __forceinline__ float silu_f(float x) { return x / (1.f + expf(-x)); }

__device__ __forceinline__ void mod_phase(const Frame& F, const Params& p) {
    float* MOD = (float*)(p.ws + WS_MOD);
    LAS float* sv = (LAS float*)F.lds;
    constexpr int NCB = DEPTH * MODW / 512;
    for (int item = F.vcu; item < NCB * 3; item += F.G) {
        const int cb = item / 3, vg = item % 3;
        __syncthreads();
        for (int i = F.tid; i < 11 * 1024; i += 512) { const int v = vg * 11 + i / 1024, k = i % 1024;
            const float c = (v < NB) ? p.in[I_C][v * DM + k] : p.in[I_CCTX][k]; sv[i] = silu_f(c); }
        __syncthreads();
        const int gcol = cb * 512 + F.tid, l = gcol / MODW, n = gcol % MODW;
        const float* w = p.in[I_WMOD] + (size_t)l * DM * MODW + n;
        float acc[11];
#pragma unroll
        for (int v = 0; v < 11; ++v) acc[v] = 0.f;
#pragma unroll 4
        for (int k = 0; k < DM; k += 4) {
            const float w0 = w[(size_t)k * MODW], w1 = w[(size_t)(k + 1) * MODW], w2 = w[(size_t)(k + 2) * MODW], w3 = w[(size_t)(k + 3) * MODW];
#pragma unroll
            for (int v = 0; v < 11; ++v) { const f32x4 s = *(const LAS f32x4*)(sv + v * 1024 + k);
                acc[v] = fmaf(s[0], w0, acc[v]); acc[v] = fmaf(s[1], w1, acc[v]); acc[v] = fmaf(s[2], w2, acc[v]); acc[v] = fmaf(s[3], w3, acc[v]); }
        }
        const float bm = p.in[I_BMOD][(size_t)l * MODW + n];
#pragma unroll
        for (int v = 0; v < 11; ++v) MOD[((size_t)l * NMODV + vg * 11 + v) * MODW + n] = acc[v] + bm;
    }
    __syncthreads();
}

__device__ __forceinline__ void filt_item(const Params& p, int l, int kind  , int t, int lane) {
    const int L = kind ? CTXL : SEQ;
    hf* R = kind ? (hf*)(p.ws + WS_RFC) + (size_t)l * 256 * 512 : (hf*)(p.ws + WS_RF) + (size_t)l * 256 * 4096;
    const int rl = 2 * L;
    const float tl = (float)t / (float)(L - 1);
    const float wt = (6.283185307179586f / (float)L) * (float)t;
    float z = 0.f;
    if (lane == 0) z = tl;
    else if (lane <= 32) { const int bi = (lane - 1) & 15; const float band = 1e-4f + (15.f - 1e-4f) * ((float)bi / 15.f); const float a = band * wt; z = (lane <= 16) ? cosf(a) : -sinf(a); }
    const float* w1 = p.in[I_HW1] + (size_t)l * 33 * 64; const float* w2 = p.in[I_HW2] + (size_t)l * 64 * 64; const float* w3 = p.in[I_HW3] + (size_t)l * 64 * 512;
    const float fr = p.in[I_HFREQ][l * 64 + lane];
    float a1 = p.in[I_HB1][l * 64 + lane];
    for (int i = 0; i < 33; ++i) a1 = fmaf(__shfl(z, i), w1[i * 64 + lane], a1);
    a1 = sinf(fr * a1);
    float a2 = p.in[I_HB2][l * 64 + lane];
    for (int i = 0; i < 64; ++i) a2 = fmaf(__shfl(a1, i), w2[i * 64 + lane], a2);
    a2 = sinf(fr * a2);
    float h[8];
#pragma unroll
    for (int q = 0; q < 8; ++q) h[q] = p.in[I_HB3][l * 512 + q * 64 + lane];
    for (int i = 0; i < 64; ++i) { const float a = __shfl(a2, i);
#pragma unroll
        for (int q = 0; q < 8; ++q) h[q] = fmaf(a, w3[i * 512 + q * 64 + lane], h[q]); }
    const float d0 = -4.605170185988091f / 1.5f, d1 = -4.605170185988091f / 0.3f;
#pragma unroll
    for (int q = 0; q < 8; ++q) { const int o = q * 64 + lane, dir = o >> 8, c = o & 255;
        const float delta = fabsf(d0 + (d1 - d0) * ((float)c / 255.f));
        float val = h[q] * (expf(-tl * delta) + 0.05f);
        if (dir == 0) { if (t == 0) val += p.in[I_HSKIP][l * 256 + c]; R[(size_t)c * rl + (L - t)] = (hf)val; if (t == 0) R[(size_t)c * rl] = (hf)0.f; }
        else if (t >= 1) R[(size_t)c * rl + (L + t)] = (hf)val; }
}

__device__ __forceinline__ void convert_layer(const Frame& F, const Params& p, int l, unsigned char* wl) {
    LAS float* scr = (LAS float*)(F.lds + F.wave * 16384);
    const int gw = F.vcu * 8 + F.wave, NGW = F.G * 8, lane = F.lane;
    constexpr int IT_IN1 = 16 * 61, IT_ING = 16 * 96, IT_UQ = 4 * 24, IT_UKV = 2 * 32, IT_BRA = 8 * 32, IT_BRB = 4 * 32, IT_BRC = 4 * 32, IT_OUT = 16 * 32, IT_FC1 = 16 * 128, IT_FC2 = 64 * 32;
    constexpr int IT_LAYER = IT_IN1 + IT_ING + IT_UQ + IT_UKV + IT_BRA + IT_BRB + IT_BRC + IT_OUT + IT_FC1 + IT_FC2;
    for (int it = gw; it < IT_LAYER; it += NGW) {
        int r = it;
        if (r < IT_IN1) { tr_item(p.in[I_WIN] + (size_t)l * DM * D_IN, D_IN, (hf*)(wl + W_IN1), DM, 61, scr, r, lane); continue; } r -= IT_IN1;
        if (r < IT_ING) { tr_item(p.in[I_WIN] + (size_t)l * DM * D_IN + C_PG, D_IN, (hf*)(wl + W_ING), DM, 96, scr, r, lane); continue; } r -= IT_ING;
        if (r < IT_UQ) { tr_item(p.in[I_WUQ] + (size_t)l * 256 * 768, 768, (hf*)(wl + W_UP), KUP, 24, scr, r, lane, p.in[I_QNG] + l * 256); continue; } r -= IT_UQ;
        if (r < IT_UKV) { tr_item(p.in[I_WUKV] + (size_t)l * 128 * 1024, 1024, (hf*)(wl + W_UP) + (size_t)768 * KUP + 256, KUP, 32, scr, r, lane, p.in[I_KVNG] + l * 128); continue; } r -= IT_UKV;
        if (r < IT_BRA) { tr_item(p.in[I_WBRA] + (size_t)l * 512 * DM, DM, (hf*)(wl + W_BR), DM, 32, scr, r, lane); continue; } r -= IT_BRA;
        if (r < IT_BRB) { tr_item(p.in[I_WBRB] + (size_t)l * 256 * DM, DM, (hf*)(wl + W_BR) + 512, DM, 32, scr, r, lane); continue; } r -= IT_BRB;
        if (r < IT_BRC) { tr_item(p.in[I_WBRC] + (size_t)l * 256 * DM, DM, (hf*)(wl + W_BR) + 768, DM, 32, scr, r, lane); continue; } r -= IT_BRC;
        if (r < IT_OUT) { tr_item(p.in[I_WOUT] + (size_t)l * DM * DM, DM, (hf*)(wl + W_OUT), DM, 32, scr, r, lane); continue; } r -= IT_OUT;
        if (r < IT_FC1) { tr_item(p.in[I_FC1] + (size_t)l * DM * DFF, DFF, (hf*)(wl + W_FC1), DM, 128, scr, r, lane); continue; } r -= IT_FC1;
        tr_item(p.in[I_FC2] + (size_t)l * DFF * DM, DM, (hf*)(wl + W_FC2), DFF, 32, scr, r, lane);
    }
    const int gt = gw * 64 + lane, NGT = NGW * 64;
    u32x4* z1 = (u32x4*)((hf*)(wl + W_IN1) + (size_t)C_PG * DM);
    for (int i = gt; i < 96 * DM / 8; i += NGT) z1[i] = (u32x4){0u, 0u, 0u, 0u};
    hf* up = (hf*)(wl + W_UP);
    for (int i = gt; i < 768 * 16; i += NGT) { const int n = i / 16, k8 = i % 16; *(u32x4*)(up + (size_t)n * KUP + 256 + k8 * 8) = (u32x4){0u, 0u, 0u, 0u}; }
    for (int i = gt; i < 1024 * 32; i += NGT) { const int n = 768 + i / 32, k8 = i % 32; *(u32x4*)(up + (size_t)n * KUP + k8 * 8) = (u32x4){0u, 0u, 0u, 0u}; }
}

__device__ __forceinline__ void prologue_a(const Frame& F, const Params& p) {
    mod_phase(F, p);
    convert_layer(F, p, 0, p.ws + WS_WT);
    const int gw = F.vcu * 8 + F.wave, NGW = F.G * 8, lane = F.lane;
    for (int it = gw; it < DEPTH * (SEQ + CTXL); it += NGW) { const int l = it / (SEQ + CTXL), r = it % (SEQ + CTXL); if (r < SEQ) filt_item(p, l, 0, r, lane); else filt_item(p, l, 1, r - SEQ, lane); }
    {
        float* rope = (float*)(p.ws + WS_ROPE);
        const int gt = gw * 64 + lane, NGT = NGW * 64;
        for (int i = gt; i < SEQ * 16; i += NGT) { const int t = i >> 4, j = i & 15; const float pos = (j < 8) ? (float)(t / GRIDW) : (float)(t % GRIDW);
            const float inv = powf(10000.f, -(float)(j & 7) / 8.f); const float a = pos * inv; rope[t * 32 + j] = cosf(a); rope[t * 32 + 16 + j] = sinf(a); }
        if (gt < DEPTH) { const int l = gt; float s1 = 0.f, s2 = 0.f;
            for (int i = 0; i < 32; ++i) { s1 += p.in[I_LQ1][l * 32 + i] * p.in[I_LK1][l * 32 + i]; s2 += p.in[I_LQ2][l * 32 + i] * p.in[I_LK2][l * 32 + i]; }
            const float li = 0.8f - 0.6f * expf(-0.3f * (float)l);
            float* lam = (float*)(p.ws + WS_LAM); lam[2 * l] = expf(s1) - expf(s2) + li; lam[2 * l + 1] = 1.f - li; }
    }
}
__device__ __forceinline__ void prologue_b(const Frame& F, const Params& p) {
    const float* MOD = (const float*)(p.ws + WS_MOD); float* BIAS = (float*)(p.ws + WS_BIAS);
    {
        LAS float* sv = (LAS float*)F.lds;
        constexpr int NCB = DEPTH * NBIAS / 512;
        for (int item = F.vcu; item < NCB * 3; item += F.G) {
            const int cb = item / 3, vg = item % 3;
            const int gcol = cb * 512 + F.tid, l = gcol / NBIAS, n = gcol % NBIAS, n0 = (cb * 512) % NBIAS;
            const int soff = (n0 >= B_FC1) ? 3 * DM : 0;
            __syncthreads();
            for (int i = F.tid; i < 11 * 1024; i += 512) { const int v = vg * 11 + i / 1024, k = i % 1024; sv[i] = MOD[((size_t)l * NMODV + v) * MODW + soff + k]; }
            __syncthreads();
            const float* w; size_t ldw; bool valid = true;
            if (n < B_G) { w = p.in[I_WIN] + (size_t)l * DM * D_IN + n; ldw = D_IN; valid = n < C_PG; }
            else if (n < B_FC1) { w = p.in[I_WIN] + (size_t)l * DM * D_IN + C_PG + (n - B_G); ldw = D_IN; }
            else { w = p.in[I_FC1] + (size_t)l * DM * DFF + (n - B_FC1); ldw = DFF; }
            float acc[11];
#pragma unroll
            for (int v = 0; v < 11; ++v) acc[v] = 0.f;
            if (valid)
#pragma unroll 4
            for (int k = 0; k < DM; k += 4) {
                const float w0 = w[(size_t)k * ldw], w1 = w[(size_t)(k + 1) * ldw], w2 = w[(size_t)(k + 2) * ldw], w3 = w[(size_t)(k + 3) * ldw];
#pragma unroll
                for (int v = 0; v < 11; ++v) { const f32x4 sx = *(const LAS f32x4*)(sv + v * 1024 + k);
                    acc[v] = fmaf(sx[0], w0, acc[v]); acc[v] = fmaf(sx[1], w1, acc[v]); acc[v] = fmaf(sx[2], w2, acc[v]); acc[v] = fmaf(sx[3], w3, acc[v]); }
            }
#pragma unroll
            for (int v = 0; v < 11; ++v) BIAS[((size_t)l * NMODV + vg * 11 + v) * NBIAS + n] = acc[v];
        }
        __syncthreads();
    }
    const int gw = F.vcu * 8 + F.wave, NGW = F.G * 8, lane = F.lane;
    {
        float* GS = (float*)(p.ws + WS_GS);
        const int gt = gw * 64 + lane, NGT = NGW * 64;
        for (int i = gt; i < DEPTH * 2 * NMODV * DM; i += NGT) { const int c = i % DM, v = (i / DM) % NMODV, wh = (i / (DM * NMODV)) % 2, l = i / (DM * NMODV * 2);
            const float g = wh ? p.in[I_NFG][l * DM + c] : p.in[I_NMG][l * DM + c];
            GS[i] = g * (1.f + MOD[((size_t)l * NMODV + v) * MODW + (wh ? 4 * DM : DM) + c]); }
    }
    {
        hf* XS = (hf*)(p.ws + A_A); float* ss = (float*)(p.ws + WS_SS) + (size_t)SS_1 * MTOT;
        f32x4 g[4];
#pragma unroll
        for (int j = 0; j < 4; ++j) g[j] = *(const f32x4*)(p.in[I_NMG] + 4 * lane + 256 * j);
        for (int row = gw; row < MTOT; row += NGW) {
            const bool lat = row < NLAT; const float* xr = lat ? p.in[I_X] + (size_t)row * DM : p.in[I_CTX] + (size_t)(row - NLAT) * DM;
            const int v = lat ? (row >> 11) : NB; const float* mv = MOD + (size_t)v * MODW + DM;
            float sq = 0.f; hf* hr = XS + (size_t)row * DM;
#pragma unroll
            for (int j = 0; j < 4; ++j) { const f32x4 x = *(const f32x4*)(xr + 4 * lane + 256 * j); const f32x4 sc = *(const f32x4*)(mv + 4 * lane + 256 * j);
                sq += (x[0] * x[0] + x[1] * x[1]) + (x[2] * x[2] + x[3] * x[3]);
                const f32x4 o = x * (g[j] * (sc + 1.f)); u32x2 w; w.x = pkh(o[0], o[1]); w.y = pkh(o[2], o[3]); *(u32x2*)(hr + 4 * lane + 256 * j) = w; }
            sq = wave_sum(sq);
            if (lane == 0) ss[row] = sq;
        }
    }
}

__device__ __forceinline__ void norm_phase(const Frame& F, const float* xs_lat, const float* xs_ctx, int nrows, const float* gain, const float* modl, int sh_off, int sc_off, hf* H) {
    const int gw = F.vcu * 8 + F.wave, NGW = F.G * 8, lane = F.lane;
    f32x4 g[4];
#pragma unroll
    for (int j = 0; j < 4; ++j) g[j] = *(const f32x4*)(gain + 4 * lane + 256 * j);
    for (int row = gw; row < nrows; row += NGW) {
        const bool lat = row < NLAT; const float* xr = lat ? xs_lat + (size_t)row * DM : xs_ctx + (size_t)(row - NLAT) * DM;
        const int v = lat ? (row >> 11) : NB; const float* mv = modl + (size_t)v * MODW;
        f32x4 x[4]; float ss = 0.f;
#pragma unroll
        for (int j = 0; j < 4; ++j) { x[j] = *(const f32x4*)(xr + 4 * lane + 256 * j); ss += (x[j][0] * x[j][0] + x[j][1] * x[j][1]) + (x[j][2] * x[j][2] + x[j][3] * x[j][3]); }
        const float rstd = rsqrtf(wave_sum(ss) * (1.f / DM) + EPS);
        hf* hr = H + (size_t)row * DM;
#pragma unroll
        for (int j = 0; j < 4; ++j) { const f32x4 sh = *(const f32x4*)(mv + sh_off + 4 * lane + 256 * j), sc = *(const f32x4*)(mv + sc_off + 4 * lane + 256 * j);
            const f32x4 y = (x[j] * rstd) * g[j]; const f32x4 o = y * (sc + 1.f) + sh;
            u32x2 w; w.x = pkh(o[0], o[1]); w.y = pkh(o[2], o[3]); *(u32x2*)(hr + 4 * lane + 256 * j) = w; }
    }
}
__device__ __forceinline__ void final_norm_phase(const Frame& F, float* X, const float* gain, const float* ss) {
    const int gw = F.vcu * 8 + F.wave, NGW = F.G * 8, lane = F.lane;
    f32x4 g[4];
#pragma unroll
    for (int j = 0; j < 4; ++j) g[j] = *(const f32x4*)(gain + 4 * lane + 256 * j);
    for (int row = gw; row < NLAT; row += NGW) {
        float* xr = X + (size_t)row * DM; const float rstd = rsqrtf(ss[row] * (1.f / DM) + EPS);
#pragma unroll
        for (int j = 0; j < 4; ++j) { const f32x4 x = *(const f32x4*)(xr + 4 * lane + 256 * j); *(f32x4*)(xr + 4 * lane + 256 * j) = (x * rstd) * g[j]; }
    }
}

__device__ __forceinline__ void prep_rope(const Frame& F, const Params& p) {
    const int gw = F.vcu * 8 + F.wave, NGW = F.G * 8, lane = F.lane;
    hf* KR = (hf*)(p.ws + A_KR); hf* DK = (hf*)(p.ws + A_DK); const float* rope = (const float*)(p.ws + WS_ROPE);
    const int hh = lane >> 3, i0 = 2 * (lane & 7);
    for (int row = gw; row < NLAT; row += NGW) {
        const int t = row & (SEQ - 1);
        hf* dk = DK + (size_t)row * 256 + hh * 32 + i0;
        const hf2 a = *(const hf2*)dk, b = *(const hf2*)(dk + 16);
        const f32x2 c = *(const f32x2*)(rope + t * 32 + i0), sn = *(const f32x2*)(rope + t * 32 + 16 + i0);
        const float x1[2] = {(float)a[0], (float)a[1]}, x2[2] = {(float)b[0], (float)b[1]};
        *(unsigned*)dk = pkh(x1[0] * c[0] - x2[0] * sn[0], x1[1] * c[1] - x2[1] * sn[1]);
        *(unsigned*)(dk + 16) = pkh(x2[0] * c[0] + x1[0] * sn[0], x2[1] * c[1] + x1[1] * sn[1]);
        if (lane < 16) { hf* kr = KR + (size_t)row * 32 + lane; const float y1 = (float)kr[0], y2 = (float)kr[16];
            const float cc = rope[t * 32 + lane], ss = rope[t * 32 + 16 + lane];
            kr[0] = (hf)(y1 * cc - y2 * ss); kr[16] = (hf)(y2 * cc + y1 * ss); }
    }
}
__device__ __forceinline__ void prep_hyena(const Frame& F, const Params& p, int l, bool with_ctx) {
    constexpr int INP = 784;
    constexpr int OUTP = 33;
    constexpr int OFF_OU = 66 * INP, OFF_OX = OFF_OU + 128 * OUTP * 4;
    const hf* PHY = (const hf*)(p.ws + A_PHY);
    LAS unsigned char* lds = F.lds; const int tid = F.tid;
    const float* cw = p.in[I_HCW] + (size_t)l * 3 * 768; const float* cb = p.in[I_HCB] + (size_t)l * 768;
    constexpr int U_LAT = NB * (SEQ / 64) * 2, U_CTX = NB * (CTXL / 64) * 2;
    const int nunit = U_LAT + (with_ctx ? U_CTX : 0);
    for (int un = F.vcu; un < nunit; un += F.G) {
        const bool ctx = un >= U_LAT; int r = ctx ? un - U_LAT : un; const int L = ctx ? CTXL : SEQ, ntile = L / 64;
        const int ch = r & 1; r >>= 1; const int tt = r % ntile, b = r / ntile;
        const int t0 = tt * 64; const size_t rowbase = ctx ? (size_t)NLAT + (size_t)b * CTXL : (size_t)b * SEQ;
        hf* dU = ctx ? (hf*)(p.ws + A_UTC) : (hf*)(p.ws + A_UT); hf* dX = ctx ? (hf*)(p.ws + A_X0TC) : (hf*)(p.ws + A_X0T);
        __syncthreads();
        for (int i = tid; i < 66 * 48; i += 512) { const int rr = i / 48, q = i % 48, seg = q >> 4, c16 = q & 15; const int t = t0 - 1 + rr;
            u32x4 v = {0u, 0u, 0u, 0u};
            if (t >= 0 && t < L) v = *(const u32x4*)(PHY + (rowbase + t) * 768 + seg * 256 + ch * 128 + c16 * 8);
            *(LAS u32x4*)(lds + rr * INP + seg * 256 + c16 * 16) = v; }
        __syncthreads();
        {
            const int c = tid & 127, tg = tid >> 7, cg = ch * 128 + c;
            const float a0 = cw[cg], a1 = cw[768 + cg], a2 = cw[1536 + cg], ab = cb[cg];
            const float b0 = cw[256 + cg], b1 = cw[768 + 256 + cg], b2 = cw[1536 + 256 + cg], bb = cb[256 + cg];
            const float v0 = cw[512 + cg], v1 = cw[768 + 512 + cg], v2 = cw[1536 + 512 + cg], vb = cb[512 + cg];
            const LAS hf* in = (const LAS hf*)(lds + (16 * tg) * INP) + c;
            float p0 = (float)in[0], p1 = (float)in[128], p2 = (float)in[256];
            float c0 = (float)in[INP / 2], c1 = (float)in[INP / 2 + 128], c2 = (float)in[INP / 2 + 256];
            LAS hf* ou = (LAS hf*)(lds + OFF_OU) + c * (OUTP * 2) + 16 * tg; LAS hf* ox = (LAS hf*)(lds + OFF_OX) + c * (OUTP * 2) + 16 * tg;
#pragma unroll
            for (int j = 0; j < 16; ++j) { const LAS hf* nx = in + (j + 2) * (INP / 2);
                const float n0 = (float)nx[0], n1 = (float)nx[128], n2 = (float)nx[256];
                const float x0 = a0 * p0 + a1 * c0 + a2 * n0 + ab, x1 = b0 * p1 + b1 * c1 + b2 * n1 + bb, vv = v0 * p2 + v1 * c2 + v2 * n2 + vb;
                ou[j] = (hf)(vv * x1); ox[j] = (hf)x0;
                p0 = c0; p1 = c1; p2 = c2; c0 = n0; c1 = n1; c2 = n2; }
        }
        __syncthreads();
        {
            const int c = tid >> 2, q = tid & 3; const size_t go = ((size_t)(ch * 128 + c) * NB + b) * L + t0 + 16 * q;
            const LAS unsigned* su = (const LAS unsigned*)(lds + OFF_OU) + c * OUTP + 8 * q; const LAS unsigned* sx = (const LAS unsigned*)(lds + OFF_OX) + c * OUTP + 8 * q;
            u32x4 w0 = {su[0], su[1], su[2], su[3]}, w1 = {su[4], su[5], su[6], su[7]};
            *(u32x4*)(dU + go) = w0; *(u32x4*)(dU + go + 8) = w1;
            u32x4 y0 = {sx[0], sx[1], sx[2], sx[3]}, y1 = {sx[4], sx[5], sx[6], sx[7]};
            *(u32x4*)(dX + go) = y0; *(u32x4*)(dX + go + 8) = y1;
        }
    }
    __syncthreads();
}

namespace att {
#ifndef PROF_SEL
#define PROF_SEL -1
#endif
#define ATT_MARK(b) do { if (PROF_SEL >= 0 && F.tid == 0) { volatile LAS unsigned* _pf = (volatile LAS unsigned*)(F.lds + LDS_BYTES - 512); const unsigned _t = (unsigned)__builtin_amdgcn_s_memrealtime(); _pf[(b)] += _t - _pf[32]; _pf[32] = _t; } } while (0)
__device__ __forceinline__ int crow(int r, int hi) { return (r & 3) + 8 * (r >> 2) + 4 * hi; }
#define SBAR() __builtin_amdgcn_sched_barrier(0)
constexpr float THR2 = 8.f * 1.4426950408889634f;
constexpr int KS_MLA = 208, KS_DF = 80;
constexpr int VS = 192, VB = 64 * VS;
constexpr int OFF_V = 32768;
template <int OFF> __device__ __forceinline__ s16x4 tr_read(int vb) {
    s16x4 r; asm volatile("ds_read_b64_tr_b16 %0, %1 offset:%2" : "=&v"(r) : "v"(vb), "i"(OFF) : "memory"); return r;
}
__device__ __forceinline__ int kpos(int key) { return (key & ~0xC) | ((key & 4) << 1) | ((key & 8) >> 1); }

template <int ND0, int KS>
__device__ __forceinline__ void qkt(f32x16& p0, f32x16& p1, const LAS unsigned char* Ks, const hf8* qr, int r32, int hi) {
    p0 = f32x16{}; p1 = f32x16{};
#pragma unroll
    for (int d0 = 0; d0 < ND0; ++d0) { const int cb = (d0 * 16 + hi * 8) * 2;
        const hf8 b0 = *(const LAS hf8*)(Ks + r32 * KS + cb), b1 = *(const LAS hf8*)(Ks + (32 + r32) * KS + cb);
        p0 = __builtin_amdgcn_mfma_f32_32x32x16_f16(b0, qr[d0], p0, 0, 0, 0); p1 = __builtin_amdgcn_mfma_f32_32x32x16_f16(b1, qr[d0], p1, 0, 0, 0); }
}
__device__ __forceinline__ float max3f(float a, float b, float c) { float r; asm("v_max3_f32 %0, %1, %2, %3" : "=v"(r) : "v"(a), "v"(b), "v"(c)); return r; }
__device__ __forceinline__ float max2f(float a, float b) { float r; asm("v_max_f32_e32 %0, %1, %2" : "=v"(r) : "v"(a), "v"(b)); return r; }
__device__ __forceinline__ float max16(const f32x16& p) { float r;
    asm("v_max3_f32 %0, %1, %2, %3\n\tv_max3_f32 %0, %0, %4, %5\n\tv_max3_f32 %0, %0, %6, %7\n\tv_max3_f32 %0, %0, %8, %9\n\tv_max3_f32 %0, %0, %10, %11\n\tv_max3_f32 %0, %0, %12, %13\n\tv_max3_f32 %0, %0, %14, %15\n\tv_max_f32_e32 %0, %0, %16"
        : "=&v"(r) : "v"(p[0]), "v"(p[1]), "v"(p[2]), "v"(p[3]), "v"(p[4]), "v"(p[5]), "v"(p[6]), "v"(p[7]), "v"(p[8]), "v"(p[9]), "v"(p[10]), "v"(p[11]), "v"(p[12]), "v"(p[13]), "v"(p[14]), "v"(p[15]));
    return r; }
__device__ __forceinline__ hf8 pack8(const f32x16& p, int b) { u32x4 w = {pkh(p[b], p[b + 1]), pkh(p[b + 2], p[b + 3]), pkh(p[b + 4], p[b + 5]), pkh(p[b + 6], p[b + 7])}; return __builtin_bit_cast(hf8, w); }
__device__ __forceinline__ void sm_max(const f32x16& p0, const f32x16& p1, float& m, float& l, f32x16& o0, f32x16& o1, const bool first) {
    float pmax = max2f(max16(p0), max16(p1));
    { auto rr = __builtin_amdgcn_permlane32_swap(__float_as_uint(pmax), __float_as_uint(pmax), false, false);
      pmax = max2f(__uint_as_float(rr[0]), __uint_as_float(rr[1])); }
    if (first || __any(pmax - m > THR2)) {
        const float mn = first ? pmax : max2f(m, pmax);
        if (!first) { const float alpha = __builtin_amdgcn_exp2f(m - mn); l *= alpha;
#pragma unroll
            for (int r = 0; r < 16; ++r) { o0[r] *= alpha; o1[r] *= alpha; } }
        m = mn;
    }
}
__device__ __forceinline__ void sm_exp_pv(f32x16& p0, f32x16& p1, const float m, float& l, f32x16& o0, f32x16& o1, const LAS unsigned char* Vt, int r32, int hi) {
#pragma unroll
    for (int r = 0; r < 16; ++r) { p0[r] -= m; p1[r] -= m; }
#pragma unroll
    for (int r = 0; r < 16; ++r) { p0[r] = __builtin_amdgcn_exp2f(p0[r]); p1[r] = __builtin_amdgcn_exp2f(p1[r]); }
    float ps = 0.f;
#pragma unroll
    for (int r = 0; r < 16; ++r) ps += p0[r] + p1[r];
    l += ps;
    const hf8 pf0 = pack8(p0, 0), pf1 = pack8(p0, 8), pf2 = pack8(p1, 0), pf3 = pack8(p1, 8);
    const int lg = (int)(threadIdx.x & 15), vq = lg >> 2, vp4 = lg & 3;
    const int vbase = (int)(unsigned)(uintptr_t)Vt + (4 * hi + vq) * VS + (16 * ((int)(threadIdx.x >> 4) & 1) + 4 * vp4) * 2;
#define PVK(ks, pf) do { \
        s16x4 l0 = tr_read<(16 * (ks)) * VS>(vbase), h0 = tr_read<(16 * (ks) + 8) * VS>(vbase), l1 = tr_read<(16 * (ks)) * VS + 64>(vbase), h1 = tr_read<(16 * (ks) + 8) * VS + 64>(vbase); \
        asm volatile("s_waitcnt lgkmcnt(0)" : "+v"(l0), "+v"(h0), "+v"(l1), "+v"(h1) :: "memory");     \
        const hf8 a0 = __builtin_bit_cast(hf8, (short __attribute__((ext_vector_type(8)))){l0[0], l0[1], l0[2], l0[3], h0[0], h0[1], h0[2], h0[3]}); \
        const hf8 a1 = __builtin_bit_cast(hf8, (short __attribute__((ext_vector_type(8)))){l1[0], l1[1], l1[2], l1[3], h1[0], h1[1], h1[2], h1[3]}); \
        o0 = __builtin_amdgcn_mfma_f32_32x32x16_f16(a0, pf, o0, 0, 0, 0); o1 = __builtin_amdgcn_mfma_f32_32x32x16_f16(a1, pf, o1, 0, 0, 0); } while (0)
    PVK(0, pf0); PVK(1, pf1); PVK(2, pf2); PVK(3, pf3);
#undef PVK
}

template <bool MLA>
__device__ __forceinline__ void attn_pass(const Frame& F, const Params& p, int hq, int hv, int qrow0, int qpos0, int klat0, int nlat, int kctx0, f32x16& o0, f32x16& o1, float& inv) {
    constexpr int DK = MLA ? 96 : 32, ND0 = DK / 16, KS = MLA ? KS_MLA : KS_DF, KB = 64 * KS;
    constexpr float SCALE = MLA ? MLA_SCALE : DF_SCALE, C = SCALE * 1.4426950408889634f;
    const int tid = F.tid, wid = F.wave, lane = F.lane, r32 = lane & 31, hi = lane >> 5;
    const hf* QKV = (const hf*)(p.ws + A_QKV); const hf* KRb = (const hf*)(p.ws + A_KR);
    const hf* DQ = (const hf*)(p.ws + A_DQ); const hf* DKb = (const hf*)(p.ws + A_DK); const hf* DVb = (const hf*)(p.ws + A_DV);
    const float* rope = (const float*)(p.ws + WS_ROPE);
    LAS unsigned char* lds = F.lds;
    hf8 qr[ND0];
    {
        const int qrow = qrow0 + wid * 32 + r32;
        const hf* qp = MLA ? QKV + (size_t)qrow * NUP + hq * 96 + hi * 8 : DQ + (size_t)qrow * 256 + hq * 32 + hi * 8;
        hf8 raw[ND0];
#pragma unroll
        for (int d0 = 0; d0 < ND0; ++d0) raw[d0] = *(const hf8*)(qp + d0 * 16);
        f32x4 c0 = {1.f, 1.f, 1.f, 1.f}, c1 = c0, s0 = {0.f, 0.f, 0.f, 0.f}, s1 = s0;
        if (qpos0 >= 0) { const int t = qpos0 + wid * 32 + r32;
            c0 = *(const f32x4*)(rope + t * 32 + hi * 8); c1 = *(const f32x4*)(rope + t * 32 + hi * 8 + 4);
            s0 = *(const f32x4*)(rope + t * 32 + 16 + hi * 8); s1 = *(const f32x4*)(rope + t * 32 + 16 + hi * 8 + 4); }
#pragma unroll
        for (int d0 = 0; d0 < ND0 - 2; ++d0) {
#pragma unroll
            for (int j = 0; j < 8; ++j) qr[d0][j] = (hf)((float)raw[d0][j] * C); }
#pragma unroll
        for (int j = 0; j < 8; ++j) { const float cc = j < 4 ? c0[j & 3] : c1[j & 3], sn = j < 4 ? s0[j & 3] : s1[j & 3]; const float a = (float)raw[ND0 - 2][j], b = (float)raw[ND0 - 1][j];
            qr[ND0 - 2][j] = (hf)((a * cc - b * sn) * C); qr[ND0 - 1][j] = (hf)((b * cc + a * sn) * C); }
    }
    const int k1r = MLA ? (tid >> 3) : ((tid & 255) >> 2), k1c = MLA ? (tid & 7) * 8 : (tid & 3) * 8;
    const int k2r = (tid & 255) >> 2, k2c = (tid & 3) * 8;
    const int vr_ = tid >> 3, vc_ = (tid & 7) * 8;
    const bool klo = tid < 256;
    struct Stg { u32x4 v, k1, k2; };
    Stg sA, sB; sA.v = sA.k1 = sA.k2 = sB.v = sB.k1 = sB.k2 = (u32x4){0u, 0u, 0u, 0u};
    const int ntile = nlat + 4;
#define KROW0(j) (((j) < nlat) ? klat0 + (j) * 64 : kctx0 + ((j) - nlat) * 64)
#define A_LOADK(S, j) do { const int kr0 = KROW0(j); \
        if (MLA) { S.k1 = *(const u32x4*)(QKV + (size_t)(kr0 + k1r) * NUP + 768 + hq * 128 + k1c); S.k2 = *(const u32x4*)(KRb + (size_t)(kr0 + k2r) * 32 + k2c); } \
        else S.k1 = *(const u32x4*)(DKb + (size_t)(kr0 + k1r) * 256 + hq * 32 + k1c); } while (0)
#define A_LOADV(S, j) do { const int kr0 = KROW0(j); \
        if (MLA) S.v = *(const u32x4*)(QKV + (size_t)(kr0 + vr_) * NUP + 768 + hv * 128 + 64 + vc_); else S.v = *(const u32x4*)(DVb + (size_t)(kr0 + vr_) * 256 + hv * 64 + vc_); } while (0)
#define A_WRITEK(S, b) do { *(LAS u32x4*)(lds + (b) * KB + k1r * KS + k1c * 2) = S.k1; if (MLA) *(LAS u32x4*)(lds + (b) * KB + k2r * KS + 128 + k2c * 2) = S.k2; } while (0)
#define A_WRITEV(S, b) do { *(LAS u32x4*)(lds + OFF_V + (b) * VB + vr_ * VS + vc_ * 2) = S.v; } while (0)
    float m_reg = 0.f, l_reg = 0.f;
    o0 = f32x16{}; o1 = f32x16{};
    f32x16 pA0, pA1, pB0, pB1;
    __syncthreads();
    const int nt1 = ntile - 1;
#define TCL(j) (((j) < nt1) ? (j) : nt1)
    A_LOADK(sA, 0); A_LOADV(sA, 0); A_LOADK(sB, 1);
    A_WRITEK(sA, 0); A_WRITEV(sA, 0); A_WRITEK(sB, 1);
    A_LOADK(sA, TCL(2));
    A_LOADV(sA, 1);
    __syncthreads();
    qkt<ND0, KS>(pA0, pA1, lds, qr, r32, hi);
    for (int j = 0; j < ntile; j += 2) {
        A_LOADK(sB, TCL(j + 3)); A_LOADV(sB, TCL(j + 2));
        sm_max(pA0, pA1, m_reg, l_reg, o0, o1, j == 0);
        qkt<ND0, KS>(pB0, pB1, lds + KB, qr, r32, hi);
        sm_exp_pv(pA0, pA1, m_reg, l_reg, o0, o1, lds + OFF_V, r32, hi);
        ATT_MARK(26);
        A_WRITEK(sA, 0); A_WRITEV(sA, 1);
        ATT_MARK(27);
        __syncthreads();
        ATT_MARK(28);
        A_LOADK(sA, TCL(j + 4)); A_LOADV(sA, TCL(j + 3));
        sm_max(pB0, pB1, m_reg, l_reg, o0, o1, false);
        qkt<ND0, KS>(pA0, pA1, lds, qr, r32, hi);
        sm_exp_pv(pB0, pB1, m_reg, l_reg, o0, o1, lds + OFF_V + VB, r32, hi);
        ATT_MARK(26);
        A_WRITEK(sB, 1); A_WRITEV(sB, 0);
        ATT_MARK(27);
        __syncthreads();
        ATT_MARK(28);
    }
#undef TCL
#undef KROW0
#undef A_LOADK
#undef A_LOADV
#undef A_WRITEK
#undef A_WRITEV
    const float lt = l_reg + __shfl_xor(l_reg, 32); inv = __builtin_amdgcn_rcpf(lt);
}
template <bool MLA>
__device__ __forceinline__ void attn_unit(const Frame& F, const Params& p, int l, int h, int qrow0, int qpos0, int klat0, int nlat, int kctx0) {
    const int wid = F.wave, lane = F.lane, r32 = lane & 31, hi = lane >> 5;
    hf* Y = (hf*)(p.ws + A_Y);
    const size_t yrow = (size_t)(qrow0 + wid * 32 + r32) * DM;
    if constexpr (MLA) {
        f32x16 o0, o1; float inv;
        attn_pass<true>(F, p, h, h, qrow0, qpos0, klat0, nlat, kctx0, o0, o1, inv);
#pragma unroll
        for (int g = 0; g < 4; ++g) { u32x2 w; w.x = pkh(o0[4 * g] * inv, o0[4 * g + 1] * inv); w.y = pkh(o0[4 * g + 2] * inv, o0[4 * g + 3] * inv); *(u32x2*)(Y + yrow + h * 64 + 8 * g + 4 * hi) = w; }
#pragma unroll
        for (int g = 0; g < 4; ++g) { u32x2 w; w.x = pkh(o1[4 * g] * inv, o1[4 * g + 1] * inv); w.y = pkh(o1[4 * g + 2] * inv, o1[4 * g + 3] * inv); *(u32x2*)(Y + yrow + h * 64 + 32 + 8 * g + 4 * hi) = w; }
    } else {
        const float lam = ((const float*)(p.ws + WS_LAM))[2 * l], oml = ((const float*)(p.ws + WS_LAM))[2 * l + 1];
        f32x16 a0, a1;
        LAS float* park = (LAS float*)(F.lds + 65536 + wid * 8192) + lane;
        { f32x16 o0, o1; float inv; attn_pass<false>(F, p, 2 * h, h, qrow0, qpos0, klat0, nlat, kctx0, o0, o1, inv);
#pragma unroll
          for (int r = 0; r < 16; ++r) { park[r * 64] = o0[r] * inv; park[(16 + r) * 64] = o1[r] * inv; } }
        { f32x16 o0, o1; float inv; attn_pass<false>(F, p, 2 * h + 1, h, qrow0, qpos0, klat0, nlat, kctx0, o0, o1, inv);
#pragma unroll
          for (int r = 0; r < 16; ++r) { a0[r] = park[r * 64] - o0[r] * (lam * inv); a1[r] = park[(16 + r) * 64] - o1[r] * (lam * inv); } }
        float ss = 0.f;
#pragma unroll
        for (int r = 0; r < 16; ++r) ss += a0[r] * a0[r] + a1[r] * a1[r];
        ss += __shfl_xor(ss, 32);
        const float rs = rsqrtf(ss * (1.f / 64.f) + EPS) * oml;
#pragma unroll
        for (int g = 0; g < 4; ++g) { const f32x4 gg = *(const f32x4*)(p.in[I_SUBG] + l * 64 + 8 * g + 4 * hi);
            u32x2 w; w.x = pkh(a0[4 * g] * rs * gg[0], a0[4 * g + 1] * rs * gg[1]); w.y = pkh(a0[4 * g + 2] * rs * gg[2], a0[4 * g + 3] * rs * gg[3]); *(u32x2*)(Y + yrow + 768 + h * 64 + 8 * g + 4 * hi) = w; }
#pragma unroll
        for (int g = 0; g < 4; ++g) { const f32x4 gg = *(const f32x4*)(p.in[I_SUBG] + l * 64 + 32 + 8 * g + 4 * hi);
            u32x2 w; w.x = pkh(a1[4 * g] * rs * gg[0], a1[4 * g + 1] * rs * gg[1]); w.y = pkh(a1[4 * g + 2] * rs * gg[2], a1[4 * g + 3] * rs * gg[3]); *(u32x2*)(Y + yrow + 768 + h * 64 + 32 + 8 * g + 4 * hi) = w; }
    }
}
}

template <int L>
__device__ __forceinline__ void hyena_unit(const Frame& F, const hf* Rrow  , const hf* U  , const hf* X0  , hf* Ycol  ) {
    constexpr int NM = L / 256, RL = 2 * L, SH = (L > 1024) ? 1024 : L, NH = L / SH, US = SH * 2 + 16;
    constexpr int OFF_U = 8 * RL * 2;
    constexpr int XP = L * 2 + 16;
    static_assert(OFF_U + 32 * US <= LDS_MISC && 32 * XP <= LDS_MISC, "hyena LDS");
    const int tid = F.tid, w = F.wave, lane = F.lane, i32 = lane & 31, hi = lane >> 5;
    LAS unsigned char* lds = F.lds;
    __syncthreads();
    for (int i = tid; i < RL / 8; i += 512) *(LAS u32x4*)(lds + i * 16) = *(const u32x4*)(Rrow + i * 8);
    __syncthreads();
    for (int idx = tid; idx < 7 * RL; idx += 512) { const int cw = 1 + idx / RL, x = idx % RL; ((LAS hf*)lds)[cw * RL + x] = (x >= cw) ? ((const LAS hf*)lds)[x - cw] : (hf)0.f; }
    f32x16 acc[NM];
#pragma unroll
    for (int m = 0; m < NM; ++m) acc[m] = f32x16{};
    const LAS unsigned char* cpy = lds + w * (RL * 2);
    for (int half = 0; half < NH; ++half) {
        __syncthreads();
        for (int idx = tid; idx < 32 * (SH / 8); idx += 512) { const int b = idx / (SH / 8), pc = idx % (SH / 8);
            *(LAS u32x4*)(lds + OFF_U + b * US + pc * 16) = *(const u32x4*)(U + (size_t)b * L + half * SH + pc * 8); }
        __syncthreads();
#pragma unroll 2
        for (int jl = 0; jl < SH / 16; ++jl) {
            const int j = half * (SH / 16) + jl;
            const hf8 bf = *(const LAS hf8*)(lds + OFF_U + i32 * US + (jl * 16 + hi * 8) * 2);
            const int x0 = L + 16 * j + 8 * hi - 8 * i32;
#pragma unroll
            for (int m = 0; m < NM; ++m) { const hf8 af = *(const LAS hf8*)(cpy + (x0 - 256 * m) * 2);
                acc[m] = __builtin_amdgcn_mfma_f32_32x32x16_f16(af, bf, acc[m], 0, 0, 0); }
        }
    }
    __syncthreads();
    for (int idx = tid; idx < 32 * (L / 8); idx += 512) { const int b = idx / (L / 8), pc = idx % (L / 8);
        *(LAS u32x4*)(lds + b * XP + pc * 16) = *(const u32x4*)(X0 + (size_t)b * L + pc * 8); }
    __syncthreads();
    const LAS hf* x0p = (const LAS hf*)(lds + i32 * XP) + w + 32 * hi;
    hf* yp = Ycol + ((size_t)i32 * L + w + 32 * hi) * DM;
#pragma unroll
    for (int m = 0; m < NM; ++m) {
#pragma unroll
        for (int r = 0; r < 16; ++r) { const int tt = 256 * m + 8 * ((r & 3) + 8 * (r >> 2));
            const float x0v = (float)x0p[tt];
            yp[(size_t)tt * DM] = (hf)(x0v * acc[m][r]); }
        asm volatile("" ::: "memory");
    }
}

#ifndef PH_MASK
#define PH_MASK 0x1FFFF
#endif
#define PHM(k) ((PH_MASK >> (k)) & 1)
#ifndef PROBE_REP
#define PROBE_REP 0
#endif
#define NREP(k) (((PROBE_REP >> (k)) & 1) ? 2 : 1)
constexpr int NPH_LAYER = 9, PH_L0 = 2, NPHASE = PH_L0 + DEPTH * NPH_LAYER + 1;
__global__ void __launch_bounds__(512, 2) fwd_kernel(Params p) {
    extern __shared__ __attribute__((aligned(16))) unsigned char lds_raw[];
    Frame F0; Frame& F = F0;
    F.lds = (LAS unsigned char*)lds_raw;
    F.tid = threadIdx.x; F.lane = F.tid & 63; F.wave = __builtin_amdgcn_readfirstlane(F.tid >> 6);
    F.G = gridDim.x; { const int bx = blockIdx.x; F.vcu = (F.G % 8 == 0) ? (bx % 8) * (F.G / 8) + bx / 8 : bx; }
    volatile LAS unsigned* misc = (volatile LAS unsigned*)(F.lds + LDS_MISC);
    if (F.tid < 16) misc[F.tid] = 0u;
    __syncthreads();
    const int lo = p.ph_lo, hi = p.ph_hi;
    XcdBarrier bar; bar.bar = (unsigned*)(p.ws + WS_BAR); bar.x = 0; bar.st = misc;
    if (hi - lo > 1) bar = xcd_barrier_post((unsigned*)(p.ws + WS_BAR), misc);
#define IN(k) (lo <= (k) && (k) < hi)
#define LAUNDER(Fl) Frame Fl = F0; asm volatile("" : "+v"(Fl.tid), "+v"(Fl.lane))
#ifndef PROF_SEL
#define PROF_SEL -1
#endif
#define PROF_K 8
    volatile LAS unsigned* prof = (volatile LAS unsigned*)(F.lds + LDS_BYTES - 512);
    if (PROF_SEL >= 0 && F.tid < 40) prof[F.tid] = 0u;
    if (PROF_SEL >= 0) __syncthreads();
    if (PROF_SEL >= 0 && F.tid == 0) prof[32] = (unsigned)__builtin_amdgcn_s_memrealtime();
#define PROF_MARK(b) do { if (PROF_SEL >= 0 && F.tid == 0) { const unsigned _t = (unsigned)__builtin_amdgcn_s_memrealtime(); prof[(b)] += _t - prof[32]; if ((b) >= 16) prof[30] += _t - prof[32]; prof[32] = _t; } } while (0)
#define SEAMT(k, b) do { PROF_MARK(b); if (IN(k) && IN((k) + 1)) xcd_barrier(bar); PROF_MARK(16 + (b)); } while (0)
#define SEAM(k) do { if (IN(k) && IN((k) + 1)) xcd_barrier(bar); } while (0)
    unsigned char* ws = p.ws;
    float* X = p.out; float* XC = (float*)(ws + WS_XC);
    hf* XS1 = (hf*)(ws + A_A); hf* MM = (hf*)(ws + A_A); hf* Y = (hf*)(ws + A_B); hf* XS2 = (hf*)(ws + A_B);
    hf* QKV = (hf*)(ws + A_QKV); hf* QKVN = (hf*)(ws + A_QKVN);
    hf* Gt = (hf*)(ws + A_G); hf* HID = (hf*)(ws + A_HID);
    float* SS = (float*)(ws + WS_SS);

    if (PHM(11) && IN(0)) for (int rep = 0; rep < NREP(11); ++rep) { LAUNDER(Fl); prologue_a(Fl, p); }
    SEAMT(0, 9);
    if (PHM(11) && IN(1)) for (int rep = 0; rep < NREP(12); ++rep) { LAUNDER(Fl); prologue_b(Fl, p); }
    SEAMT(1, 9);

    for (int l = 0; l < DEPTH; ++l) {
        const int pb = PH_L0 + l * NPH_LAYER;
        const bool ctx_live = l < DEPTH - 1;
        const int Mrows = ctx_live ? MTOT : NLAT;
        const float* xin_lat = (l == 0) ? p.in[I_X] : X; const float* xin_ctx = (l == 0) ? p.in[I_CTX] : XC;
        const float* modl = (const float*)(ws + WS_MOD) + (size_t)l * NMODV * MODW;
        const float* biasl = (const float*)(ws + WS_BIAS) + (size_t)l * NMODV * NBIAS;
        const float* gsl = (const float*)(ws + WS_GS) + (size_t)l * 2 * NMODV * DM;
        const unsigned char* wl = ws + WS_WT + (size_t)(l & 1) * W_LAYER;
        float* ss1 = SS + (size_t)(SS_1 + l) * MTOT; float* ss2 = SS + (size_t)(SS_2 + l) * MTOT;

        if (PHM(1) && IN(pb + 0)) for (int rep = 0; rep < NREP(1); ++rep) { pg8::Gemm g{XS1, (const hf*)(wl + W_IN1), MTOT, NP1, DM, DM, DM}; pg8::StaticOrder S; S.init(MTOT, NP1, F.G, (int)blockIdx.x);
            pg8::EpiIn E{QKVN, (hf*)(ws + A_KR), (hf*)(ws + A_PHY), (hf*)(ws + A_DQ), (hf*)(ws + A_DK), (hf*)(ws + A_DV), ss1, biasl + B_IN, SS + (size_t)(SS_Q + l) * MTOT, SS + (size_t)(SS_KV + l) * MTOT};
            pg8::gemm_phase(F.lds, g, S, E); }
        SEAMT(pb + 0, 0);
        if (PHM(2) && IN(pb + 1)) { LAUNDER(Fl); prep_rope(Fl, p); prep_hyena(Fl, p, l, ctx_live);
            if (l + 1 < DEPTH) convert_layer(Fl, p, l + 1, ws + WS_WT + (size_t)((l + 1) & 1) * W_LAYER); }
        SEAMT(pb + 1, 1);
        if (PHM(3) && IN(pb + 2)) for (int rep = 0; rep < NREP(3); ++rep) { pg8::Gemm g{QKVN, (const hf*)(wl + W_UP), MTOT, NUP, KUP, KUP, KUP}; pg8::StaticOrder S; S.init(MTOT, NUP, F.G, (int)blockIdx.x);
            pg8::EpiUp E{QKV, SS + (size_t)(SS_Q + l) * MTOT, SS + (size_t)(SS_KV + l) * MTOT}; pg8::gemm_phase(F.lds, g, S, E); }
        SEAMT(pb + 2, 2);
        if (PHM(4) && IN(pb + 3)) for (int rep = 0; rep < NREP(4); ++rep) {
            LAUNDER(Fl);
            PROF_MARK(14);
            const int n_mla = 2048 + (ctx_live ? 256 : 0);
            if (PHM(13)) for (int rp = 0; rp < NREP(13); ++rp) for (int id = F.vcu; id < n_mla; id += F.G) {
                if (id < 2048) { const int qb = id & 7, h = (id >> 3) & 7, b = id >> 6; att::attn_unit<true>(Fl, p, l, h, b * SEQ + qb * 256, qb * 256, b * SEQ, 32, NLAT + b * CTXL); }
                else { const int i2 = id - 2048, h = i2 & 7, b = i2 >> 3; att::attn_unit<true>(Fl, p, l, h, NLAT + b * CTXL, -1, 0, 0, NLAT + b * CTXL); }
            }
            PROF_MARK(11);
            const int n_df = 1024 + (ctx_live ? 128 : 0);
            if (PHM(14)) for (int rp = 0; rp < NREP(14); ++rp) for (int id = F.vcu; id < n_df; id += F.G) {
                if (id < 1024) { const int qb = id & 7, h = (id >> 3) & 3, b = id >> 5; att::attn_unit<false>(Fl, p, l, h, b * SEQ + qb * 256, qb * 256, b * SEQ, 32, NLAT + b * CTXL); }
                else { const int i2 = id - 1024, h = i2 & 3, b = i2 >> 2; att::attn_unit<false>(Fl, p, l, h, NLAT + b * CTXL, -1, 0, 0, NLAT + b * CTXL); }
            }
            PROF_MARK(12);
            if (PHM(15)) for (int rp = 0; rp < NREP(15); ++rp) for (int c = F.vcu; c < 256; c += F.G)
                hyena_unit<SEQ>(Fl, (const hf*)(ws + WS_RF) + ((size_t)l * 256 + c) * 4096, (const hf*)(ws + A_UT) + (size_t)c * NLAT, (const hf*)(ws + A_X0T) + (size_t)c * NLAT, Y + 512 + c);
            if (PHM(16) && ctx_live) for (int rp = 0; rp < NREP(15); ++rp) for (int c = F.vcu; c < 256; c += F.G)
                hyena_unit<CTXL>(Fl, (const hf*)(ws + WS_RFC) + ((size_t)l * 256 + c) * 512, (const hf*)(ws + A_UTC) + (size_t)c * NCTX, (const hf*)(ws + A_X0TC) + (size_t)c * NCTX, Y + (size_t)NLAT * DM + 512 + c);
            __syncthreads();
            PROF_MARK(13);
        }
        SEAMT(pb + 3, 3);
        if (PHM(5) && IN(pb + 4)) for (int rep = 0; rep < NREP(5); ++rep) { pg8::Gemm g{XS1, (const hf*)(wl + W_ING), Mrows, NGATE, DM, DM, DM}; pg8::StaticOrder S; S.init(Mrows, NGATE, F.G, (int)blockIdx.x);
            pg8::EpiHalf<1, true> E{Gt, NGATE, ss1, biasl + B_G}; pg8::gemm_phase(F.lds, g, S, E); }
        SEAMT(pb + 4, 4);
        if (PHM(6) && IN(pb + 5)) for (int rep = 0; rep < NREP(6); ++rep) { pg8::StaticOrder S; S.init(Mrows, DM, F.G, (int)blockIdx.x); const hf* wbr = (const hf*)(wl + W_BR);
            { pg8::Gemm g{Y, wbr, Mrows, DM, 512, DM, DM}; pg8::EpiGated<true> E{MM, Gt, 0}; pg8::gemm_phase(F.lds, g, S, E); }
            { pg8::Gemm g{Y + 512, wbr + 512, Mrows, DM, 256, DM, DM}; pg8::EpiGated<false> E{MM, Gt, 1024}; pg8::gemm_phase(F.lds, g, S, E); }
            { pg8::Gemm g{Y + 768, wbr + 768, Mrows, DM, 256, DM, DM}; pg8::EpiGated<false> E{MM, Gt, 2048}; pg8::gemm_phase(F.lds, g, S, E); } }
        SEAMT(pb + 5, 5);
        if (PHM(7) && IN(pb + 6)) { pg8::Gemm g{MM, (const hf*)(wl + W_OUT), Mrows, DM, DM, DM, DM}; pg8::StaticOrder S; S.init(Mrows, DM, F.G, (int)blockIdx.x);
            pg8::EpiResidX<true, true> E{xin_lat, xin_ctx, X, XC, modl + 2 * DM, XS2, gsl + (size_t)NMODV * DM, ss2}; pg8::gemm_phase(F.lds, g, S, E); }
        SEAMT(pb + 6, 6);
        if (PHM(9) && IN(pb + 7)) for (int rep = 0; rep < NREP(9); ++rep) { pg8::Gemm g{XS2, (const hf*)(wl + W_FC1), Mrows, DFF, DM, DM, DM}; pg8::StaticOrder S; S.init(Mrows, DFF, F.G, (int)blockIdx.x);
            pg8::EpiHalf<2, true> E{HID, DFF, ss2, biasl + B_FC1}; pg8::gemm_phase(F.lds, g, S, E); }
        SEAMT(pb + 7, 7);
        if (PHM(10) && IN(pb + 8)) { pg8::Gemm g{HID, (const hf*)(wl + W_FC2), Mrows, DM, DFF, DFF, DFF}; pg8::StaticOrder S; S.init(Mrows, DM, F.G, (int)blockIdx.x);
            if (ctx_live) { pg8::EpiResidX<true, true> E{X, XC, X, XC, modl + 5 * DM, XS1, gsl + (size_t)2 * NMODV * DM, ss1 + MTOT}; pg8::gemm_phase(F.lds, g, S, E); }
            else { pg8::EpiResidX<false, true> E{X, XC, X, XC, modl + 5 * DM, nullptr, nullptr, SS + (size_t)SS_F * MTOT}; pg8::gemm_phase(F.lds, g, S, E); } }
        SEAMT(pb + 8, 8);
    }
    if (PHM(12) && IN(NPHASE - 1)) { LAUNDER(Fl); final_norm_phase(Fl, X, p.in[I_FNG], SS + (size_t)SS_F * MTOT); }
    PROF_MARK(10);
    if (PROF_SEL >= 0 && blockIdx.x == 0 && F.tid == 0) { const unsigned long long t0 = __builtin_amdgcn_s_memrealtime(); const unsigned long long d = (unsigned long long)PROF_K * prof[PROF_SEL];
        while (__builtin_amdgcn_s_memrealtime() - t0 < d) __builtin_amdgcn_s_sleep(8); }
#undef IN
#undef SEAM
}

extern "C" void kernel_launch(void* const* d_in, const int* in_sizes, int n_in, void* d_out, int out_size, void* d_ws, size_t ws_size, hipStream_t stream) {
    static int grid = 0;
    if (grid == 0) {
        if (n_in != 35 || in_sizes[0] != NLAT * DM || out_size != NLAT * DM || ws_size < WS_END) {
            fprintf(stderr, "kernel_launch: unexpected shapes: n_in %d in0 %d out %d ws %zu (need %zu); nothing launched\n", n_in, n_in > 0 ? in_sizes[0] : -1, out_size, ws_size, (size_t)WS_END); grid = -1; return; }
        int dev = 0, cus = 0, per_cu = 0;
        if (hipGetDevice(&dev) != hipSuccess || hipDeviceGetAttribute(&cus, hipDeviceAttributeMultiprocessorCount, dev) != hipSuccess) { fprintf(stderr, "kernel_launch: device query failed\n"); grid = -1; return; }
        if (hipFuncSetAttribute((const void*)fwd_kernel, hipFuncAttributeMaxDynamicSharedMemorySize, LDS_BYTES) != hipSuccess) { fprintf(stderr, "kernel_launch: hipFuncSetAttribute failed\n"); grid = -1; return; }
        if (hipOccupancyMaxActiveBlocksPerMultiprocessor(&per_cu, (const void*)fwd_kernel, 512, LDS_BYTES) != hipSuccess || per_cu < 1)
            fprintf(stderr, "kernel_launch: note: occupancy query reports %d workgroups per CU\n", per_cu);
        (void)hipGetLastError();
        grid = cus;
    }
    if (grid < 0) return;
    if (hipMemsetAsync((char*)d_ws + WS_BAR, 0, WS_ZERO_BYTES, stream) != hipSuccess) { fprintf(stderr, "kernel_launch: memset failed\n"); return; }
    Params P{};
    for (int i = 0; i < 35; ++i) P.in[i] = (const float*)d_in[i];
    P.out = (float*)d_out; P.ws = (unsigned char*)d_ws;
#if MK_FUSED
    P.ph_lo = 0; P.ph_hi = NPHASE;
    hipLaunchKernelGGL(fwd_kernel, dim3(grid), dim3(512), LDS_BYTES, stream, P);
#else
    for (int ph = 0; ph < NPHASE; ++ph) { P.ph_lo = ph; P.ph_hi = ph + 1; hipLaunchKernelGGL(fwd_kernel, dim3(grid), dim3(512), LDS_BYTES, stream, P); }
#endif
    const hipError_t le = hipPeekAtLastError();
    if (le != hipSuccess) fprintf(stderr, "kernel_launch: launch failed: %s\n", hipGetErrorName(le));
}
```

```cpp
#include <hip/hip_runtime.h>
#include <cstdio>
#include <cstdint>

#ifndef MK_FUSED
#define MK_FUSED 1
#endif

#define LAS __attribute__((address_space(3)))
#define GAS __attribute__((address_space(1)))
typedef _Float16 hf;
typedef _Float16 hf2 __attribute__((ext_vector_type(2)));
typedef _Float16 hf4 __attribute__((ext_vector_type(4)));
typedef _Float16 hf8 __attribute__((ext_vector_type(8)));
typedef short s16x4 __attribute__((ext_vector_type(4)));
typedef float f32x2 __attribute__((ext_vector_type(2)));
typedef float f32x4 __attribute__((ext_vector_type(4)));
typedef float f32x16 __attribute__((ext_vector_type(16)));
typedef unsigned u32x2 __attribute__((ext_vector_type(2)));
typedef unsigned u32x4 __attribute__((ext_vector_type(4)));

constexpr int DM = 1024, NB = 32, SEQ = 2048, DEPTH = 4, CTXL = 256, GRIDW = 64;
constexpr int NLAT = NB * SEQ;
constexpr int NCTX = NB * CTXL;
constexpr int MTOT = NLAT + NCTX;
constexpr int D_IN = 5024, NP1 = 2048  , NGATE = 3072, DFF = 4096;
constexpr int C_PQ = 0, C_PKV = 256, C_PKR = 384, C_HY = 416, C_DQ = 1184, C_DK = 1440, C_DV = 1696, C_PG = 1952;
constexpr int NUP = 1792, KUP = 384;
constexpr int NMODV = 33, MODW = 6 * DM;
constexpr float EPS = 1e-6f;
constexpr float MLA_SCALE = 0.10206207261596575f;
constexpr float DF_SCALE = 0.17677669529663687f;

constexpr size_t al256(size_t x) { return (x + 255) / 256 * 256; }
constexpr size_t WS_BAR = 0, WS_BAR_BYTES = 65536;
constexpr size_t WS_SS = WS_BAR + WS_BAR_BYTES;
constexpr int SS_1 = 0, SS_2 = DEPTH, SS_F = 2 * DEPTH, SS_Q = 2 * DEPTH + 1, SS_KV = 3 * DEPTH + 1, SS_N = 4 * DEPTH + 1;
constexpr size_t WS_ZERO_BYTES = WS_BAR_BYTES + al256((size_t)SS_N * MTOT * 4);
constexpr size_t WS_MOD = WS_BAR + WS_ZERO_BYTES;
constexpr size_t WS_GS = WS_MOD + al256((size_t)DEPTH * NMODV * MODW * 4);
constexpr int NBIAS = 9216, B_IN = 0, B_G = 2048, B_FC1 = 5120;
constexpr size_t WS_BIAS = WS_GS + (size_t)DEPTH * 2 * NMODV * DM * 4;
constexpr size_t WS_ROPE = WS_BIAS + (size_t)DEPTH * NMODV * NBIAS * 4;
constexpr size_t WS_LAM = WS_ROPE + (size_t)SEQ * 32 * 4;
constexpr size_t WS_RF = WS_LAM + 256;
constexpr size_t WS_RFC = WS_RF + (size_t)DEPTH * 256 * 4096 * 2;
constexpr size_t WS_X16 = WS_RFC + (size_t)DEPTH * 256 * 512 * 2;
constexpr size_t WS_WT = WS_X16 + (size_t)MTOT * DM * 2;
constexpr size_t W_IN1 = 0, W_ING = W_IN1 + (size_t)NP1 * DM * 2, W_UP = W_ING + (size_t)NGATE * DM * 2, W_BR = W_UP + (size_t)NUP * KUP * 2,
                 W_OUT = W_BR + (size_t)DM * DM * 2, W_FC1 = W_OUT + (size_t)DM * DM * 2, W_FC2 = W_FC1 + (size_t)DFF * DM * 2, W_LAYER = W_FC2 + (size_t)DM * DFF * 2;
constexpr size_t WS_ARENA = WS_WT + 2 * W_LAYER;
constexpr size_t SZ_ROW1024 = (size_t)MTOT * 1024 * 2;
constexpr size_t A_B = WS_ARENA;
constexpr size_t A_C = A_B + SZ_ROW1024;
constexpr size_t A_Y = A_B, A_XS2 = A_B, A_BIG = A_C;
constexpr size_t A_QKVN = A_BIG;
constexpr size_t A_KR = A_QKVN + (size_t)MTOT * KUP * 2;
constexpr size_t A_DQ = A_KR + (size_t)MTOT * 32 * 2;
constexpr size_t A_DK = A_DQ + (size_t)MTOT * 256 * 2;
constexpr size_t A_DV = A_DK + (size_t)MTOT * 256 * 2;
constexpr size_t A_UT = A_DV + (size_t)MTOT * 256 * 2;
constexpr size_t A_X0T = A_UT + (size_t)256 * NLAT * 2;
constexpr size_t A_UTC = A_X0T + (size_t)256 * NLAT * 2;
constexpr size_t A_X0TC = A_UTC + (size_t)256 * NCTX * 2;
constexpr size_t A_PHY = A_X0TC + (size_t)256 * NCTX * 2;
constexpr size_t A_QKV = A_PHY;
constexpr size_t A_BIG_END = A_QKV + (size_t)MTOT * NUP * 2;
constexpr size_t A_G = A_BIG;
constexpr size_t A_HID = A_C;
constexpr size_t WS_END = (A_BIG_END > A_HID + (size_t)MTOT * DFF * 2) ? A_BIG_END : A_HID + (size_t)MTOT * DFF * 2;
static_assert(WS_END <= (size_t)1024 * 1024 * 1024, "workspace map exceeds 1 GiB");

constexpr int LDS_BYTES = 147456;
constexpr int LDS_MISC = LDS_BYTES - 64;

__device__ __forceinline__ unsigned pkh(float lo, float hi) { f32x2 v = {lo, hi}; hf2 h = __builtin_convertvector(v, hf2); return __builtin_bit_cast(unsigned, h); }
__device__ __forceinline__ float wave_sum(float v) {
#pragma unroll
    for (int o = 1; o < 64; o <<= 1) v += __shfl_xor(v, o);
    return v;
}
#define LDS_WAIT() asm volatile("s_waitcnt lgkmcnt(0)" ::: "memory")
#define VM_WAIT() asm volatile("s_waitcnt vmcnt(0)" ::: "memory")

#define XB_TMO      128
#define XB_XCNT(j)  (256  + 64 * (j))
#define XB_XSUB(j)  (1280 + 64 * (j))
#define XB_XGEN(j)  (2304 + 64 * (j))
#define XB_TOP      3328
#define XB_TOPGEN   3392
#define XCD_BAR_WORDS 3456
#define XB_SPIN_CAP (1u << 22)
__device__ __forceinline__ unsigned xb_ld(unsigned* p)              { return __hip_atomic_load(p, __ATOMIC_RELAXED, __HIP_MEMORY_SCOPE_AGENT); }
__device__ __forceinline__ unsigned xb_add(unsigned* p, unsigned v) { return __hip_atomic_fetch_add(p, v, __ATOMIC_RELAXED, __HIP_MEMORY_SCOPE_AGENT); }
__device__ __forceinline__ unsigned xb_xcc_id() { return (unsigned)__builtin_amdgcn_s_getreg((3 << 11) | 20) & 0xFu; }
#define XB_SPIN(cond, bar) do { unsigned _sp = 0; while (cond) { __builtin_amdgcn_s_sleep(1); \
    if ((++_sp & 255u) == 0u) { if (xb_ld(&(bar)[XB_TMO])) break; if (_sp > XB_SPIN_CAP) { atomicAdd(&(bar)[XB_TMO], 1u); break; } } } } while (0)
struct XcdBarrier { unsigned* bar; unsigned x; volatile LAS unsigned* st; };
__device__ __forceinline__ XcdBarrier xcd_barrier_post(unsigned* bar, volatile LAS unsigned* st) {
    XcdBarrier b; b.bar = bar; b.x = xb_xcc_id(); b.st = st;
    if (threadIdx.x == 0) (void)xb_add(&bar[XB_XCNT(b.x)], 1u);
    return b;
}
__device__ __forceinline__ void xcd_barrier_complete(unsigned* bar, unsigned x, unsigned& nloc, unsigned& nx) {
    const unsigned G = gridDim.x * gridDim.y * gridDim.z;
    unsigned sum, cnt, mine, sp = 0u;
    for (;;) {
        sum = 0u; cnt = 0u; mine = 0u;
#pragma unroll
        for (unsigned j = 0; j < 16; ++j) { const unsigned c = xb_ld(&bar[XB_XCNT(j)]); sum += c; cnt += (c > 0u) ? 1u : 0u; mine = (j == x) ? c : mine; }
        if (sum == G) break;
        __builtin_amdgcn_s_sleep(1);
        if ((++sp & 255u) == 0u) { if (xb_ld(&bar[XB_TMO])) break; if (sp > XB_SPIN_CAP) { atomicAdd(&bar[XB_TMO], 1u); break; } }
    }
    nloc = mine > 0u ? mine : 1u; nx = cnt > 0u ? cnt : 1u;
}
__device__ __forceinline__ void xcd_barrier(const XcdBarrier& b) {
    asm volatile("s_waitcnt vmcnt(0)" ::: "memory");
    __syncthreads();
    if (threadIdx.x == 0) {
        unsigned* bar = b.bar;
        __builtin_amdgcn_s_waitcnt(0);
        unsigned nloc = b.st[0], nx = b.st[1];
        if (nloc == 0u) { xcd_barrier_complete(bar, b.x, nloc, nx); b.st[0] = nloc; b.st[1] = nx; }
        const unsigned old = xb_add(&bar[XB_XSUB(b.x)], 1u);
        const unsigned gen = old / nloc;
        if (old + 1u == (gen + 1u) * nloc) {
            __builtin_amdgcn_fence(__ATOMIC_RELEASE, "agent");
            asm volatile("s_waitcnt vmcnt(0)" ::: "memory");
            const unsigned og = xb_add(&bar[XB_TOP], 1u);
            const unsigned tg = og / nx;
            if (og + 1u == (tg + 1u) * nx) xb_add(&bar[XB_TOPGEN], 1u);
            else XB_SPIN(xb_ld(&bar[XB_TOPGEN]) == tg, bar);
            __builtin_amdgcn_fence(__ATOMIC_ACQUIRE, "agent");
            xb_add(&bar[XB_XGEN(b.x)], 1u);
            asm volatile("s_waitcnt vmcnt(0)" ::: "memory");
        } else {
            XB_SPIN(xb_ld(&bar[XB_XGEN(b.x)]) == gen, bar);
            __builtin_amdgcn_fence(__ATOMIC_ACQUIRE, "agent");
            asm volatile("s_waitcnt vmcnt(0)" ::: "memory");
        }
    }
    __syncthreads();
}

namespace pg8 {
constexpr int BM = 256, BK = 64, HALF = 128, HTB = HALF * BK * 2, STAGE_BYTES = 8 * HTB, NXCD = 8, WGM = 8;
__host__ __device__ __forceinline__ int lds_byte(int r, int c) { const int st = (r >> 4) * 2 + (c >> 5), rr = r & 15, cc = c & 31, ob = rr * 64 + cc * 2; return st * 1024 + (ob ^ (((ob >> 9) & 1) << 5)); }
__host__ __device__ __forceinline__ void stage_rc(int b, int& R, int& C) { const int st = b / 1024, sb = b % 1024, swz = sb ^ (((sb >> 9) & 1) << 5); R = (st >> 1) * 16 + swz / 64; C = (st & 1) * 32 + (swz % 64) / 2; }
__host__ __device__ __forceinline__ int perm32(int rho) { const int n = rho >> 4, i = rho & 15; return 8 * (i >> 2) + 4 * n + (i & 3); }
struct Unit { int pm, pn; };
struct Gemm { const hf* A; const hf* Bt; int M, N, K, lda, ldb; };
struct StaticOrder {
    int nM, nN, nwg, G, c;
    __host__ __device__ void init(int M, int N, int G_, int c_) { nM = M / BM; nN = N / BM; nwg = nM * nN; G = G_; c = c_; }
    __host__ __device__ bool next(int i, Unit& u) const {
        const long L = (long)i * G + c; if (L >= nwg) return false;
        int wgid = (int)L; { const int q = nwg / NXCD, r = nwg % NXCD, xcd = wgid % NXCD, off = wgid / NXCD; wgid = (xcd < r ? xcd * (q + 1) : r * (q + 1) + (xcd - r) * q) + off; }
        const int nig = WGM * nN, gid = wgid / nig, fm = gid * WGM, gsz = (nM - fm) < WGM ? (nM - fm) : WGM;
        u.pm = fm + ((wgid % nig) % gsz); u.pn = (wgid % nig) / gsz; return true;
    }
    __device__ __forceinline__ void a_ready(const Unit&) const {}
    __device__ __forceinline__ void done(const Unit&) const {}
};

template <int ACT  , bool NORM> struct EpiHalf {
    static constexpr bool PERM = true, AFTER_DRAIN = false, PROBE2 = false, MIDK = false;
    hf* O; int ldc; const float* ss; const float* bias;
    __device__ __forceinline__ void operator()(const f32x4 (&acc)[2][2][4][2], const Unit& u, int wr, int wc, int fr, int fq) const {
        const int row0 = u.pm * BM + wr * 64 + fr, col0 = u.pn * BM + wc * 32 + 8 * fq;
        f32x4 bv[2][2];
        if (NORM) { const int R0 = u.pm * BM; const int v = (R0 < NLAT) ? (R0 >> 11) : NB; const float* bp = bias + (size_t)v * NBIAS + col0;
#pragma unroll
            for (int bj = 0; bj < 2; ++bj)
#pragma unroll
                for (int n = 0; n < 2; ++n) bv[bj][n] = *(const f32x4*)(bp + bj * HALF + 4 * n); }
#pragma unroll
        for (int ai = 0; ai < 2; ++ai)
#pragma unroll
            for (int m = 0; m < 4; ++m) { const int r = row0 + ai * HALF + m * 16; hf* rowp = O + (size_t)r * ldc + col0;
                float rs = 1.f; if (NORM) rs = rsqrtf(ss[r] * (1.f / DM) + EPS);
#pragma unroll
                for (int bj = 0; bj < 2; ++bj) { f32x4 v0 = acc[ai][bj][m][0], v1 = acc[ai][bj][m][1];
                    if (NORM) { v0 = v0 * rs + bv[bj][0]; v1 = v1 * rs + bv[bj][1]; }
                    if (ACT == 1) {
#pragma unroll
                        for (int e = 0; e < 4; ++e) { v0[e] = __builtin_amdgcn_rcpf(1.f + __builtin_amdgcn_exp2f(-1.4426950408889634f * v0[e])); v1[e] = __builtin_amdgcn_rcpf(1.f + __builtin_amdgcn_exp2f(-1.4426950408889634f * v1[e])); } }
                    if (ACT == 2) {
#pragma unroll
                        for (int e = 0; e < 4; ++e) { const float a = fmaxf(v0[e], 0.f), b = fmaxf(v1[e], 0.f); v0[e] = a * a; v1[e] = b * b; } }
                    u32x4 w; w.x = pkh(v0[0], v0[1]); w.y = pkh(v0[2], v0[3]); w.z = pkh(v1[0], v1[1]); w.w = pkh(v1[2], v1[3]);
                    *(u32x4*)(rowp + bj * HALF) = w; } }
    }
};
struct EpiGate8 {
    static constexpr bool PERM = true, AFTER_DRAIN = false, PROBE2 = false, MIDK = false;
    unsigned char* O; const float* ss; const float* bias;
    __device__ __forceinline__ void operator()(const f32x4 (&acc)[2][2][4][2], const Unit& u, int wr, int wc, int fr, int fq) const {
        const int R0 = u.pm * BM, row0 = R0 + wr * 64 + fr, col0 = u.pn * BM + wc * 32 + 8 * fq;
        const int v = (R0 < NLAT) ? (R0 >> 11) : NB; const float* bp = bias + (size_t)v * NBIAS + col0;
        f32x4 bv[2][2];
#pragma unroll
        for (int bj = 0; bj < 2; ++bj) { bv[bj][0] = *(const f32x4*)(bp + bj * HALF); bv[bj][1] = *(const f32x4*)(bp + bj * HALF + 4); }
#pragma unroll
        for (int ai = 0; ai < 2; ++ai)
#pragma unroll
            for (int m = 0; m < 4; ++m) { const int r = row0 + ai * HALF + m * 16; const float rs = rsqrtf(ss[r] * (1.f / DM) + EPS);
#pragma unroll
                for (int bj = 0; bj < 2; ++bj) { const f32x4 v0 = acc[ai][bj][m][0] * rs + bv[bj][0], v1 = acc[ai][bj][m][1] * rs + bv[bj][1];
                    unsigned q[8];
#pragma unroll
                    for (int e = 0; e < 4; ++e) { const float g0 = __builtin_amdgcn_rcpf(1.f + __builtin_amdgcn_exp2f(-1.4426950408889634f * v0[e])), g1 = __builtin_amdgcn_rcpf(1.f + __builtin_amdgcn_exp2f(-1.4426950408889634f * v1[e]));
                        q[e] = (unsigned)fmaxf(1.f, __builtin_rintf(255.f * g0)); q[4 + e] = (unsigned)fmaxf(1.f, __builtin_rintf(255.f * g1)); }
                    u32x2 w; w.x = q[0] | (q[1] << 8) | (q[2] << 16) | (q[3] << 24); w.y = q[4] | (q[5] << 8) | (q[6] << 16) | (q[7] << 24);
                    *(u32x2*)(O + (size_t)r * NGATE + col0 + bj * HALF) = w; } }
    }
};
struct EpiIn {
    static constexpr bool PERM = true, AFTER_DRAIN = false, PROBE2 = false, MIDK = false;
    hf* QKVNo; hf* KRo; hf* PHYo; hf* DQo; hf* DKo; hf* DVo; const float* ss; const float* bias; float* ssq; float* sskv;
    __device__ __forceinline__ void operator()(const f32x4 (&acc)[2][2][4][2], const Unit& u, int wr, int wc, int fr, int fq) const {
        const int R0 = u.pm * BM, row0 = R0 + wr * 64 + fr, col0 = u.pn * BM + wc * 32 + 8 * fq;
        const int v = (R0 < NLAT) ? (R0 >> 11) : NB; const float* bp = bias + (size_t)v * NBIAS + col0;
        f32x4 bv[2][2]; hf* dst[2]; int ld[2];
#pragma unroll
        for (int bj = 0; bj < 2; ++bj) { const int c8 = col0 + bj * HALF;
            bv[bj][0] = *(const f32x4*)(bp + bj * HALF); bv[bj][1] = *(const f32x4*)(bp + bj * HALF + 4);
            if (c8 < C_PKR) { dst[bj] = QKVNo + c8; ld[bj] = KUP; }
            else if (c8 < C_HY) { dst[bj] = KRo + (c8 - C_PKR); ld[bj] = 32; }
            else if (c8 < C_DQ) { dst[bj] = PHYo + (c8 - C_HY); ld[bj] = 768; }
            else if (c8 < C_DK) { dst[bj] = DQo + (c8 - C_DQ); ld[bj] = 256; }
            else if (c8 < C_DV) { dst[bj] = DKo + (c8 - C_DK); ld[bj] = 256; }
            else if (c8 < C_PG) { dst[bj] = DVo + (c8 - C_DV); ld[bj] = 256; }
            else { dst[bj] = nullptr; ld[bj] = 0; } }
        const int nstat = (u.pn == 0) ? 2 : (u.pn == 1 ? 1 : 0);
        float* sp = (u.pn == 0) ? ssq : sskv;
#pragma unroll
        for (int ai = 0; ai < 2; ++ai)
#pragma unroll
            for (int m = 0; m < 4; ++m) { const int r = row0 + ai * HALF + m * 16; const float rs = rsqrtf(ss[r] * (1.f / DM) + EPS); float sq = 0.f;
#pragma unroll
                for (int bj = 0; bj < 2; ++bj) { const f32x4 v0 = acc[ai][bj][m][0] * rs + bv[bj][0], v1 = acc[ai][bj][m][1] * rs + bv[bj][1];
                    if (bj < nstat) sq += (v0[0] * v0[0] + v0[1] * v0[1]) + (v0[2] * v0[2] + v0[3] * v0[3]) + (v1[0] * v1[0] + v1[1] * v1[1]) + (v1[2] * v1[2] + v1[3] * v1[3]);
                    if (dst[bj]) { u32x4 w; w.x = pkh(v0[0], v0[1]); w.y = pkh(v0[2], v0[3]); w.z = pkh(v1[0], v1[1]); w.w = pkh(v1[2], v1[3]); *(u32x4*)(dst[bj] + (size_t)r * ld[bj]) = w; } }
                if (nstat) { sq += __shfl_xor(sq, 16); sq += __shfl_xor(sq, 32);
                    if (fq == 0) (void)__hip_atomic_fetch_add(sp + r, sq, __ATOMIC_RELAXED, __HIP_MEMORY_SCOPE_AGENT); } }
    }
};
struct EpiUp {
    static constexpr bool PERM = true, AFTER_DRAIN = false, PROBE2 = false, MIDK = false;
    hf* O; const float* ssq; const float* sskv;
    __device__ __forceinline__ void operator()(const f32x4 (&acc)[2][2][4][2], const Unit& u, int wr, int wc, int fr, int fq) const {
        const int row0 = u.pm * BM + wr * 64 + fr, col0 = u.pn * BM + wc * 32 + 8 * fq;
        const bool isq = u.pn < 3; const float* sp = isq ? ssq : sskv; const float invn = isq ? (1.f / 256.f) : (1.f / 128.f);
#pragma unroll
        for (int ai = 0; ai < 2; ++ai)
#pragma unroll
            for (int m = 0; m < 4; ++m) { const int r = row0 + ai * HALF + m * 16; hf* rowp = O + (size_t)r * NUP + col0; const float rs = rsqrtf(sp[r] * invn + EPS);
#pragma unroll
                for (int bj = 0; bj < 2; ++bj) { const f32x4 v0 = acc[ai][bj][m][0] * rs, v1 = acc[ai][bj][m][1] * rs;
                    u32x4 w; w.x = pkh(v0[0], v0[1]); w.y = pkh(v0[2], v0[3]); w.z = pkh(v1[0], v1[1]); w.w = pkh(v1[2], v1[3]);
                    *(u32x4*)(rowp + bj * HALF) = w; } }
    }
};
template <bool FIRST> struct EpiGated {
    static constexpr bool PERM = true, AFTER_DRAIN = false, PROBE2 = false, MIDK = false;
    hf* MMo; const hf* G; int goff;
    __device__ __forceinline__ void operator()(const f32x4 (&acc)[2][2][4][2], const Unit& u, int wr, int wc, int fr, int fq) const {
        const int row0 = u.pm * BM + wr * 64 + fr, col0 = u.pn * BM + wc * 32 + 8 * fq;
#pragma unroll
        for (int ai = 0; ai < 2; ++ai)
#pragma unroll
            for (int m = 0; m < 4; ++m) { const size_t r = (size_t)(row0 + ai * HALF + m * 16);
#pragma unroll
                for (int bj = 0; bj < 2; ++bj) { const f32x4 v0 = acc[ai][bj][m][0], v1 = acc[ai][bj][m][1];
                    const hf8 g = *(const hf8*)(G + r * NGATE + goff + col0 + bj * HALF);
                    hf* mp = MMo + r * DM + col0 + bj * HALF;
                    float o[8];
#pragma unroll
                    for (int e = 0; e < 4; ++e) { o[e] = (float)g[e] * v0[e]; o[4 + e] = (float)g[4 + e] * v1[e]; }
                    if (!FIRST) { const hf8 p = *(const hf8*)mp;
#pragma unroll
                        for (int e = 0; e < 8; ++e) o[e] += (float)p[e]; }
                    u32x4 w; w.x = pkh(o[0], o[1]); w.y = pkh(o[2], o[3]); w.z = pkh(o[4], o[5]); w.w = pkh(o[6], o[7]);
                    *(u32x4*)mp = w; } }
    }
};
struct EpiMerge {
    static constexpr bool PERM = true, AFTER_DRAIN = false, PROBE2 = false, MIDK = true;
    static constexpr int MID1 = 8, MID2 = 12;
    hf* MMo; const unsigned char* G;
    __device__ __forceinline__ void mid(f32x4 (&acc)[2][2][4][2], const Unit& u, int which, int wr, int wc, int fr, int fq) const {
        asm volatile("" : "+v"(fr), "+v"(fq));
        const int row0 = u.pm * BM + wr * 64 + fr, col0 = u.pn * BM + wc * 32 + 8 * fq; const int gnum = which ? 1024 : 0, gden = which ? 2048 : 1024;
#pragma unroll
        for (int ai = 0; ai < 2; ++ai) {
            u32x2 gn[4][2], gd[4][2];
#pragma unroll
            for (int m = 0; m < 4; ++m) { const unsigned char* gr = G + (size_t)(row0 + ai * HALF + m * 16) * NGATE + col0;
#pragma unroll
                for (int bj = 0; bj < 2; ++bj) { gn[m][bj] = *(const u32x2*)(gr + gnum + bj * HALF); gd[m][bj] = *(const u32x2*)(gr + gden + bj * HALF); } }
#pragma unroll
            for (int m = 0; m < 4; ++m)
#pragma unroll
                for (int bj = 0; bj < 2; ++bj)
#pragma unroll
                    for (int e = 0; e < 4; ++e) {
                        acc[ai][bj][m][0][e] *= (float)((gn[m][bj].x >> (8 * e)) & 255u) * __builtin_amdgcn_rcpf((float)((gd[m][bj].x >> (8 * e)) & 255u));
                        acc[ai][bj][m][1][e] *= (float)((gn[m][bj].y >> (8 * e)) & 255u) * __builtin_amdgcn_rcpf((float)((gd[m][bj].y >> (8 * e)) & 255u)); }
            asm volatile("" ::: "memory");
        }
    }
    __device__ __forceinline__ void operator()(const f32x4 (&acc)[2][2][4][2], const Unit& u, int wr, int wc, int fr, int fq) const {
        const int row0 = u.pm * BM + wr * 64 + fr, col0 = u.pn * BM + wc * 32 + 8 * fq;
#pragma unroll
        for (int ai = 0; ai < 2; ++ai)
#pragma unroll
            for (int m = 0; m < 4; ++m) { const size_t r = (size_t)(row0 + ai * HALF + m * 16);
#pragma unroll
                for (int bj = 0; bj < 2; ++bj) { const f32x4 v0 = acc[ai][bj][m][0], v1 = acc[ai][bj][m][1];
                    const u32x2 g = *(const u32x2*)(G + r * NGATE + 2048 + col0 + bj * HALF);
                    float o[8];
#pragma unroll
                    for (int e = 0; e < 4; ++e) { o[e] = (float)((g.x >> (8 * e)) & 255u) * (1.f / 255.f) * v0[e]; o[4 + e] = (float)((g.y >> (8 * e)) & 255u) * (1.f / 255.f) * v1[e]; }
                    u32x4 w; w.x = pkh(o[0], o[1]); w.y = pkh(o[2], o[3]); w.z = pkh(o[4], o[5]); w.w = pkh(o[6], o[7]);
                    *(u32x4*)(MMo + r * DM + col0 + bj * HALF) = w; } }
    }
};
template <bool XS, bool STAT> struct EpiResidX {
    static constexpr bool PERM = true, AFTER_DRAIN = false, PROBE2 = false, MIDK = false;
    hf* x16; const float* gate;
    hf* xsout; const float* gs; float* ss;
    __device__ __forceinline__ void operator()(const f32x4 (&acc)[2][2][4][2], const Unit& u, int wr, int wc, int fr, int fq) const {
        const int R0 = u.pm * BM; const int v = (R0 < NLAT) ? (R0 >> 11) : NB;
        const int rglob = R0 + wr * 64 + fr, col0 = u.pn * BM + wc * 32 + 8 * fq;
        const float* gp = gate + (size_t)v * MODW + col0; const float* gsp = gs + (size_t)v * DM + col0;
        float sq[2][4];
#pragma unroll
        for (int ai = 0; ai < 2; ++ai)
#pragma unroll
            for (int m = 0; m < 4; ++m) sq[ai][m] = 0.f;
#pragma unroll
        for (int bj = 0; bj < 2; ++bj) {
            const f32x4 g0 = *(const f32x4*)(gp + bj * HALF), g1 = *(const f32x4*)(gp + bj * HALF + 4);
            f32x4 s0 = {1.f, 1.f, 1.f, 1.f}, s1 = s0; if (XS) { s0 = *(const f32x4*)(gsp + bj * HALF); s1 = *(const f32x4*)(gsp + bj * HALF + 4); }
#pragma unroll
            for (int ai = 0; ai < 2; ++ai)
#pragma unroll
                for (int m = 0; m < 4; ++m) { const int rr = ai * HALF + m * 16; const size_t off = (size_t)(rglob + rr) * DM + col0 + bj * HALF;
                    const hf8 xv = *(const hf8*)(x16 + off);
                    const f32x4 x0 = {(float)xv[0], (float)xv[1], (float)xv[2], (float)xv[3]}, x1 = {(float)xv[4], (float)xv[5], (float)xv[6], (float)xv[7]};
                    const f32x4 n0 = x0 + g0 * acc[ai][bj][m][0], n1 = x1 + g1 * acc[ai][bj][m][1];
                    { u32x4 w; w.x = pkh(n0[0], n0[1]); w.y = pkh(n0[2], n0[3]); w.z = pkh(n1[0], n1[1]); w.w = pkh(n1[2], n1[3]); *(u32x4*)(x16 + off) = w; }
                    if (STAT) sq[ai][m] += (n0[0] * n0[0] + n0[1] * n0[1]) + (n0[2] * n0[2] + n0[3] * n0[3]) + (n1[0] * n1[0] + n1[1] * n1[1]) + (n1[2] * n1[2] + n1[3] * n1[3]);
                    if (XS) { const f32x4 a = n0 * s0, b = n1 * s1; u32x4 w; w.x = pkh(a[0], a[1]); w.y = pkh(a[2], a[3]); w.z = pkh(b[0], b[1]); w.w = pkh(b[2], b[3]);
                        *(u32x4*)(xsout + off) = w; } }
        }
        if (STAT) {
#pragma unroll
            for (int ai = 0; ai < 2; ++ai)
#pragma unroll
                for (int m = 0; m < 4; ++m) { float t = sq[ai][m]; t += __shfl_xor(t, 16); t += __shfl_xor(t, 32);
                    if (fq == 0) (void)__hip_atomic_fetch_add(ss + rglob + ai * HALF + m * 16, t, __ATOMIC_RELAXED, __HIP_MEMORY_SCOPE_AGENT); }
        }
    }
};

template <class Epi, class Sched, bool ALIGN_EPI = true>
__device__ __forceinline__ void gemm_phase(LAS unsigned char* lds, const Gemm g, const Sched& S, const Epi& E) {
    int tid = threadIdx.x; asm volatile("" : "+v"(tid));
    const int wid = __builtin_amdgcn_readfirstlane(tid >> 6), lane = tid & 63, wr = wid >> 2, wc = wid & 3, fr = lane & 15, fq = lane >> 4;
    const int K = g.K, nt = K / BK;
    unsigned voffA[2], voffB[2];
#pragma unroll
    for (int i = 0; i < 2; ++i) { int R, C; stage_rc(tid * 16 + i * 8192, R, C); const int Rb = Epi::PERM ? ((R & ~31) + perm32(R & 31)) : R;
        voffA[i] = (unsigned)(R * g.lda + C) * 2u; voffB[i] = (unsigned)(Rb * g.ldb + C) * 2u; }
    const size_t kstep = (size_t)(BK * 2);
    const size_t hstepA = (size_t)HALF * g.lda * 2, hstepB = (size_t)HALF * g.ldb * 2;
    const size_t tstepA = 2 * hstepA, tstepB = 2 * hstepB;
    const unsigned ldsw = (unsigned)wid * 1024u;
    const int aoff = lds_byte(wr * 64 + fr, fq * 8), boff = lds_byte(wc * 32 + fr, fq * 8);
#define PG8_SA(b, h) (((b) * 2 + (h)) * HTB)
#define PG8_SB(b, h) ((4 + (b) * 2 + (h)) * HTB)
#define PG8_STAGE(bufoff, gbase, voff) do { _Pragma("unroll") for (int _i = 0; _i < 2; ++_i) \
        __builtin_amdgcn_global_load_lds((const unsigned*)((const char*)(gbase) + (voff)[_i]), (LAS unsigned*)(lds + (bufoff) + ldsw + _i * 8192), 16, 0, 0); } while (0)
#define PG8_LDA(dst, b, h) do { _Pragma("unroll") for (int m = 0; m < 4; ++m) _Pragma("unroll") for (int k = 0; k < 2; ++k) dst[m][k] = *(const LAS hf8*)(lds + PG8_SA(b, h) + aoff + m * 2048 + k * 1024); } while (0)
#define PG8_LDB(dst, b, h) do { _Pragma("unroll") for (int n = 0; n < 2; ++n) _Pragma("unroll") for (int k = 0; k < 2; ++k) dst[n][k] = *(const LAS hf8*)(lds + PG8_SB(b, h) + boff + n * 2048 + k * 1024); } while (0)
#define PG8_MMA(ai, bj, At, Bt) do { __builtin_amdgcn_s_setprio(1); _Pragma("unroll") for (int m = 0; m < 4; ++m) _Pragma("unroll") for (int n = 0; n < 2; ++n) _Pragma("unroll") for (int k = 0; k < 2; ++k) \
        acc[ai][bj][m][n] = __builtin_amdgcn_mfma_f32_16x16x32_f16(Bt[n][k], At[m][k], acc[ai][bj][m][n], 0, 0, 0); __builtin_amdgcn_s_setprio(0); } while (0)
#define PG8_WAIT_V(n) asm volatile("s_waitcnt vmcnt(" #n ")" ::: "memory")
#define PG8_WAIT_L(n) asm volatile("s_waitcnt lgkmcnt(" #n ")" ::: "memory")
#define PG8_BAR __builtin_amdgcn_s_barrier()
#define PG8_SCHED __builtin_amdgcn_sched_barrier(0)
    Unit cur, nxt; int ui = 0;
    if (!S.next(0, cur)) return;
    f32x4 acc[2][2][4][2];
#pragma unroll
    for (int a = 0; a < 2; ++a)
#pragma unroll
        for (int b = 0; b < 2; ++b)
#pragma unroll
            for (int m = 0; m < 4; ++m)
#pragma unroll
                for (int n = 0; n < 2; ++n) acc[a][b][m][n] = (f32x4){0.f, 0.f, 0.f, 0.f};
    hf8 At[4][2], B0[2][2], B1[2][2];
    const char* cA = (const char*)g.A + (size_t)cur.pm * tstepA; const char* cB = (const char*)g.Bt + (size_t)cur.pn * tstepB;
    S.a_ready(cur);
    PG8_STAGE(PG8_SB(0, 0), cB, voffB); PG8_STAGE(PG8_SB(0, 1), cB + hstepB, voffB); PG8_STAGE(PG8_SA(0, 0), cA, voffA); PG8_STAGE(PG8_SA(0, 1), cA + hstepA, voffA);
    if (wr == 1) PG8_BAR;
    PG8_WAIT_V(2); PG8_BAR;
    PG8_STAGE(PG8_SB(1, 0), cB + kstep, voffB); PG8_STAGE(PG8_SA(1, 0), cA + kstep, voffA); PG8_STAGE(PG8_SB(1, 1), cB + hstepB + kstep, voffB);
    PG8_WAIT_V(6); PG8_BAR;
    for (;;) {
        const bool has_next = S.next(ui + 1, nxt);
        const char* nA = has_next ? (const char*)g.A + (size_t)nxt.pm * tstepA : cA; const char* nB = has_next ? (const char*)g.Bt + (size_t)nxt.pn * tstepB : cB;
#pragma unroll 1
        for (int t = 0; t < nt; t += 2) {
            const bool last = (t == nt - 2);
            const char* a1 = cA + (size_t)(t + 1) * kstep;
            const char* a2 = last ? nA : cA + (size_t)(t + 2) * kstep; const char* b2 = last ? nB : cB + (size_t)(t + 2) * kstep;
            const char* a3 = a2 + kstep; const char* b3 = b2 + kstep;
            if (last && has_next) S.a_ready(nxt);
            if constexpr (Epi::MIDK) { if (t == Epi::MID1 || t == Epi::MID2) E.mid(acc, cur, t == Epi::MID1 ? 0 : 1, wr, wc, fr, fq); }
            PG8_LDB(B0, 0, 0); PG8_LDB(B1, 0, 1); PG8_SCHED; PG8_LDA(At, 0, 0); PG8_STAGE(PG8_SA(1, 1), a1 + hstepA, voffA);
            PG8_WAIT_V(8); PG8_WAIT_L(0); PG8_BAR; PG8_MMA(0, 0, At, B0); PG8_MMA(0, 1, At, B1); PG8_BAR; PG8_SCHED;
            PG8_LDA(At, 0, 1); PG8_STAGE(PG8_SB(0, 0), b2, voffB); PG8_STAGE(PG8_SB(0, 1), b2 + hstepB, voffB); PG8_STAGE(PG8_SA(0, 0), a2, voffA);
            PG8_WAIT_V(8); PG8_WAIT_L(0); PG8_BAR; PG8_MMA(1, 0, At, B0); PG8_MMA(1, 1, At, B1); PG8_BAR; PG8_SCHED;
            PG8_LDB(B0, 1, 0); PG8_LDB(B1, 1, 1); PG8_SCHED; PG8_LDA(At, 1, 0); PG8_STAGE(PG8_SA(0, 1), a2 + hstepA, voffA);
            PG8_WAIT_V(8); PG8_WAIT_L(0); PG8_BAR; PG8_MMA(0, 0, At, B0); PG8_MMA(0, 1, At, B1); PG8_BAR; PG8_SCHED;
            PG8_LDA(At, 1, 1); PG8_STAGE(PG8_SB(1, 0), b3, voffB); PG8_STAGE(PG8_SB(1, 1), b3 + hstepB, voffB); PG8_STAGE(PG8_SA(1, 0), a3, voffA);
            PG8_WAIT_V(8); PG8_WAIT_L(0); PG8_BAR; PG8_MMA(1, 0, At, B0); PG8_MMA(1, 1, At, B1); PG8_BAR; PG8_SCHED;
        }
        if constexpr (ALIGN_EPI) { if (wr == 0) PG8_BAR; }
        E(acc, cur, wr, wc, fr, fq); S.done(cur);
#ifdef PROBE_EPI2
        if (Epi::PROBE2) { asm volatile("" ::: "memory"); E(acc, cur, wr, wc, fr, fq); }
#endif
        if (!has_next) break;
#pragma unroll
        for (int a = 0; a < 2; ++a)
#pragma unroll
            for (int b = 0; b < 2; ++b)
#pragma unroll
                for (int m = 0; m < 4; ++m)
#pragma unroll
                    for (int n = 0; n < 2; ++n) acc[a][b][m][n] = (f32x4){0.f, 0.f, 0.f, 0.f};
        cur = nxt; cA = nA; cB = nB; ++ui;
        if constexpr (ALIGN_EPI) { if (wr == 1) PG8_BAR; }
    }
    PG8_WAIT_V(0);
    if constexpr (!ALIGN_EPI) { if (wr == 0) PG8_BAR; }
    PG8_BAR;
#undef PG8_SA
#undef PG8_SB
#undef PG8_STAGE
#undef PG8_LDA
#undef PG8_LDB
#undef PG8_MMA
#undef PG8_WAIT_V
#undef PG8_WAIT_L
#undef PG8_BAR
#undef PG8_SCHED
}
}

struct Params {
    const float* in[35];
    float* out;
    unsigned char* ws;
    int ph_lo, ph_hi;
};
enum { I_X = 0, I_C, I_CTX, I_CCTX, I_NMG, I_NFG, I_WMOD, I_BMOD, I_WIN, I_QNG, I_WUQ, I_KVNG, I_WUKV, I_HCW, I_HCB, I_HW1, I_HB1, I_HFREQ, I_HW2, I_HB2, I_HW3, I_HB3,
       I_HSKIP, I_LQ1, I_LK1, I_LQ2, I_LK2, I_SUBG, I_WBRA, I_WBRB, I_WBRC, I_WOUT, I_FC1, I_FC2, I_FNG };

struct Frame {
    LAS unsigned char* lds;
    int tid, lane, wave, vcu, G;
};

__device__ __forceinline__ void tr_item(const float* W, int ldw, hf* WT, int ldt, int nblk, LAS float* scr, int item, int lane, const float* kgain = nullptr) {
    const int kb = item / nblk, nb = item % nblk, k0 = 64 * kb, n0 = 32 * nb;
#pragma unroll 8
    for (int i = 0; i < 32; ++i) { const int kk = 2 * i + (lane >> 5); const float gk = kgain ? kgain[k0 + kk] : 1.f; scr[kk * 33 + (lane & 31)] = W[(size_t)(k0 + kk) * ldw + n0 + (lane & 31)] * gk; }
    LDS_WAIT(); asm volatile("" ::: "memory");
    const int c = lane & 7;
#pragma unroll
    for (int j = 0; j < 4; ++j) { const int n = (lane >> 3) + 8 * j; const LAS float* s = scr + (8 * c) * 33 + n;
        u32x4 o; o.x = pkh(s[0 * 33], s[1 * 33]); o.y = pkh(s[2 * 33], s[3 * 33]); o.z = pkh(s[4 * 33], s[5 * 33]); o.w = pkh(s[6 * 33], s[7 * 33]);
        *(u32x4*)(WT + (size_t)(n0 + n) * ldt + k0 + 8 * c) = o; }
    LDS_WAIT(); asm volatile("" ::: "memory");
}
__device__ __forceinline__ float silu_f(float x) { return x / (1.f + expf(-x)); }

__device__ __forceinline__ void mod_phase(const Frame& F, const Params& p) {
    float* MOD = (float*)(p.ws + WS_MOD);
    LAS float* sv = (LAS float*)F.lds;
    constexpr int NCB = DEPTH * MODW / 512;
    for (int item = F.vcu; item < NCB * 3; item += F.G) {
        const int cb = item / 3, vg = item % 3;
        __syncthreads();
        for (int i = F.tid; i < 11 * 1024; i += 512) { const int v = vg * 11 + i / 1024, k = i % 1024;
            const float c = (v < NB) ? p.in[I_C][v * DM + k] : p.in[I_CCTX][k]; sv[i] = silu_f(c); }
        __syncthreads();
        const int gcol = cb * 512 + F.tid, l = gcol / MODW, n = gcol % MODW;
        const float* w = p.in[I_WMOD] + (size_t)l * DM * MODW + n;
        float acc[11];
#pragma unroll
        for (int v = 0; v < 11; ++v) acc[v] = 0.f;
#pragma unroll 4
        for (int k = 0; k < DM; k += 4) {
            const float w0 = w[(size_t)k * MODW], w1 = w[(size_t)(k + 1) * MODW], w2 = w[(size_t)(k + 2) * MODW], w3 = w[(size_t)(k + 3) * MODW];
#pragma unroll
            for (int v = 0; v < 11; ++v) { const f32x4 s = *(const LAS f32x4*)(sv + v * 1024 + k);
                acc[v] = fmaf(s[0], w0, acc[v]); acc[v] = fmaf(s[1], w1, acc[v]); acc[v] = fmaf(s[2], w2, acc[v]); acc[v] = fmaf(s[3], w3, acc[v]); }
        }
        const float bm = p.in[I_BMOD][(size_t)l * MODW + n];
#pragma unroll
        for (int v = 0; v < 11; ++v) MOD[((size_t)l * NMODV + vg * 11 + v) * MODW + n] = acc[v] + bm;
    }
    __syncthreads();
}

__device__ __forceinline__ void filt_item(const Params& p, int l, int kind  , int t, int lane) {
    const int L = kind ? CTXL : SEQ;
    hf* R = kind ? (hf*)(p.ws + WS_RFC) + (size_t)l * 256 * 512 : (hf*)(p.ws + WS_RF) + (size_t)l * 256 * 4096;
    const int rl = 2 * L;
    const float tl = (float)t / (float)(L - 1);
    const float wt = (6.283185307179586f / (float)L) * (float)t;
    float z = 0.f;
    if (lane == 0) z = tl;
    else if (lane <= 32) { const int bi = (lane - 1) & 15; const float band = 1e-4f + (15.f - 1e-4f) * ((float)bi / 15.f); const float a = band * wt; z = (lane <= 16) ? cosf(a) : -sinf(a); }
    const float* w1 = p.in[I_HW1] + (size_t)l * 33 * 64; const float* w2 = p.in[I_HW2] + (size_t)l * 64 * 64; const float* w3 = p.in[I_HW3] + (size_t)l * 64 * 512;
    const float fr = p.in[I_HFREQ][l * 64 + lane];
    float a1 = p.in[I_HB1][l * 64 + lane];
    for (int i = 0; i < 33; ++i) a1 = fmaf(__shfl(z, i), w1[i * 64 + lane], a1);
    a1 = sinf(fr * a1);
    float a2 = p.in[I_HB2][l * 64 + lane];
    for (int i = 0; i < 64; ++i) a2 = fmaf(__shfl(a1, i), w2[i * 64 + lane], a2);
    a2 = sinf(fr * a2);
    float h[8];
#pragma unroll
    for (int q = 0; q < 8; ++q) h[q] = p.in[I_HB3][l * 512 + q * 64 + lane];
    for (int i = 0; i < 64; ++i) { const float a = __shfl(a2, i);
#pragma unroll
        for (int q = 0; q < 8; ++q) h[q] = fmaf(a, w3[i * 512 + q * 64 + lane], h[q]); }
    const float d0 = -4.605170185988091f / 1.5f, d1 = -4.605170185988091f / 0.3f;
#pragma unroll
    for (int q = 0; q < 8; ++q) { const int o = q * 64 + lane, dir = o >> 8, c = o & 255;
        const float delta = fabsf(d0 + (d1 - d0) * ((float)c / 255.f));
        float val = h[q] * (expf(-tl * delta) + 0.05f);
        if (dir == 0) { if (t == 0) val += p.in[I_HSKIP][l * 256 + c]; R[(size_t)c * rl + (L - t)] = (hf)val; if (t == 0) R[(size_t)c * rl] = (hf)0.f; }
        else if (t >= 1) R[(size_t)c * rl + (L + t)] = (hf)val; }
}

__device__ __forceinline__ void convert_layer(const Frame& F, const Params& p, int l, unsigned char* wl) {
    LAS float* scr = (LAS float*)(F.lds + F.wave * 16384);
    const int gw = F.vcu * 8 + F.wave, NGW = F.G * 8, lane = F.lane;
    constexpr int IT_IN1 = 16 * 61, IT_ING = 16 * 96, IT_UQ = 4 * 24, IT_UKV = 2 * 32, IT_BRA = 8 * 32, IT_BRB = 4 * 32, IT_BRC = 4 * 32, IT_OUT = 16 * 32, IT_FC1 = 16 * 128, IT_FC2 = 64 * 32;
    constexpr int IT_LAYER = IT_IN1 + IT_ING + IT_UQ + IT_UKV + IT_BRA + IT_BRB + IT_BRC + IT_OUT + IT_FC1 + IT_FC2;
    for (int it = gw; it < IT_LAYER; it += NGW) {
        int r = it;
        if (r < IT_IN1) { tr_item(p.in[I_WIN] + (size_t)l * DM * D_IN, D_IN, (hf*)(wl + W_IN1), DM, 61, scr, r, lane); continue; } r -= IT_IN1;
        if (r < IT_ING) { tr_item(p.in[I_WIN] + (size_t)l * DM * D_IN + C_PG, D_IN, (hf*)(wl + W_ING), DM, 96, scr, r, lane); continue; } r -= IT_ING;
        if (r < IT_UQ) { tr_item(p.in[I_WUQ] + (size_t)l * 256 * 768, 768, (hf*)(wl + W_UP), KUP, 24, scr, r, lane, p.in[I_QNG] + l * 256); continue; } r -= IT_UQ;
        if (r < IT_UKV) { tr_item(p.in[I_WUKV] + (size_t)l * 128 * 1024, 1024, (hf*)(wl + W_UP) + (size_t)768 * KUP + 256, KUP, 32, scr, r, lane, p.in[I_KVNG] + l * 128); continue; } r -= IT_UKV;
        if (r < IT_BRA) { tr_item(p.in[I_WBRA] + (size_t)l * 512 * DM, DM, (hf*)(wl + W_BR), DM, 32, scr, r, lane); continue; } r -= IT_BRA;
        if (r < IT_BRB) { tr_item(p.in[I_WBRB] + (size_t)l * 256 * DM, DM, (hf*)(wl + W_BR) + 512, DM, 32, scr, r, lane); continue; } r -= IT_BRB;
        if (r < IT_BRC) { tr_item(p.in[I_WBRC] + (size_t)l * 256 * DM, DM, (hf*)(wl + W_BR) + 768, DM, 32, scr, r, lane); continue; } r -= IT_BRC;
        if (r < IT_OUT) { tr_item(p.in[I_WOUT] + (size_t)l * DM * DM, DM, (hf*)(wl + W_OUT), DM, 32, scr, r, lane); continue; } r -= IT_OUT;
        if (r < IT_FC1) { tr_item(p.in[I_FC1] + (size_t)l * DM * DFF, DFF, (hf*)(wl + W_FC1), DM, 128, scr, r, lane); continue; } r -= IT_FC1;
        tr_item(p.in[I_FC2] + (size_t)l * DFF * DM, DM, (hf*)(wl + W_FC2), DFF, 32, scr, r, lane);
    }
    const int gt = gw * 64 + lane, NGT = NGW * 64;
    u32x4* z1 = (u32x4*)((hf*)(wl + W_IN1) + (size_t)C_PG * DM);
    for (int i = gt; i < 96 * DM / 8; i += NGT) z1[i] = (u32x4){0u, 0u, 0u, 0u};
    hf* up = (hf*)(wl + W_UP);
    for (int i = gt; i < 768 * 16; i += NGT) { const int n = i / 16, k8 = i % 16; *(u32x4*)(up + (size_t)n * KUP + 256 + k8 * 8) = (u32x4){0u, 0u, 0u, 0u}; }
    for (int i = gt; i < 1024 * 32; i += NGT) { const int n = 768 + i / 32, k8 = i % 32; *(u32x4*)(up + (size_t)n * KUP + k8 * 8) = (u32x4){0u, 0u, 0u, 0u}; }
}

__device__ __forceinline__ void prologue_a(const Frame& F, const Params& p) {
    mod_phase(F, p);
    convert_layer(F, p, 0, p.ws + WS_WT);
    const int gw = F.vcu * 8 + F.wave, NGW = F.G * 8, lane = F.lane;
    for (int it = gw; it < DEPTH * (SEQ + CTXL); it += NGW) { const int l = it / (SEQ + CTXL), r = it % (SEQ + CTXL); if (r < SEQ) filt_item(p, l, 0, r, lane); else filt_item(p, l, 1, r - SEQ, lane); }
    {
        float* rope = (float*)(p.ws + WS_ROPE);
        const int gt = gw * 64 + lane, NGT = NGW * 64;
        for (int i = gt; i < SEQ * 16; i += NGT) { const int t = i >> 4, j = i & 15; const float pos = (j < 8) ? (float)(t / GRIDW) : (float)(t % GRIDW);
            const float inv = powf(10000.f, -(float)(j & 7) / 8.f); const float a = pos * inv; rope[t * 32 + j] = cosf(a); rope[t * 32 + 16 + j] = sinf(a); }
        if (gt < DEPTH) { const int l = gt; float s1 = 0.f, s2 = 0.f;
            for (int i = 0; i < 32; ++i) { s1 += p.in[I_LQ1][l * 32 + i] * p.in[I_LK1][l * 32 + i]; s2 += p.in[I_LQ2][l * 32 + i] * p.in[I_LK2][l * 32 + i]; }
            const float li = 0.8f - 0.6f * expf(-0.3f * (float)l);
            float* lam = (float*)(p.ws + WS_LAM); lam[2 * l] = expf(s1) - expf(s2) + li; lam[2 * l + 1] = 1.f - li; }
    }
}
__device__ __forceinline__ void prologue_b(const Frame& F, const Params& p) {
    const float* MOD = (const float*)(p.ws + WS_MOD); float* BIAS = (float*)(p.ws + WS_BIAS);
    {
        LAS float* sv = (LAS float*)F.lds;
        constexpr int NCB = DEPTH * NBIAS / 512;
        for (int item = F.vcu; item < NCB * 3; item += F.G) {
            const int cb = item / 3, vg = item % 3;
            const int gcol = cb * 512 + F.tid, l = gcol / NBIAS, n = gcol % NBIAS, n0 = (cb * 512) % NBIAS;
            const int soff = (n0 >= B_FC1) ? 3 * DM : 0;
            __syncthreads();
            for (int i = F.tid; i < 11 * 1024; i += 512) { const int v = vg * 11 + i / 1024, k = i % 1024; sv[i] = MOD[((size_t)l * NMODV + v) * MODW + soff + k]; }
            __syncthreads();
            const float* w; size_t ldw; bool valid = true;
            if (n < B_G) { w = p.in[I_WIN] + (size_t)l * DM * D_IN + n; ldw = D_IN; valid = n < C_PG; }
            else if (n < B_FC1) { w = p.in[I_WIN] + (size_t)l * DM * D_IN + C_PG + (n - B_G); ldw = D_IN; }
            else { w = p.in[I_FC1] + (size_t)l * DM * DFF + (n - B_FC1); ldw = DFF; }
            float acc[11];
#pragma unroll
            for (int v = 0; v < 11; ++v) acc[v] = 0.f;
            if (valid)
#pragma unroll 4
            for (int k = 0; k < DM; k += 4) {
                const float w0 = w[(size_t)k * ldw], w1 = w[(size_t)(k + 1) * ldw], w2 = w[(size_t)(k + 2) * ldw], w3 = w[(size_t)(k + 3) * ldw];
#pragma unroll
                for (int v = 0; v < 11; ++v) { const f32x4 sx = *(const LAS f32x4*)(sv + v * 1024 + k);
                    acc[v] = fmaf(sx[0], w0, acc[v]); acc[v] = fmaf(sx[1], w1, acc[v]); acc[v] = fmaf(sx[2], w2, acc[v]); acc[v] = fmaf(sx[3], w3, acc[v]); }
            }
#pragma unroll
            for (int v = 0; v < 11; ++v) BIAS[((size_t)l * NMODV + vg * 11 + v) * NBIAS + n] = acc[v];
        }
        __syncthreads();
    }
    const int gw = F.vcu * 8 + F.wave, NGW = F.G * 8, lane = F.lane;
    {
        float* GS = (float*)(p.ws + WS_GS);
        const int gt = gw * 64 + lane, NGT = NGW * 64;
        for (int i = gt; i < DEPTH * 2 * NMODV * DM; i += NGT) { const int c = i % DM, v = (i / DM) % NMODV, wh = (i / (DM * NMODV)) % 2, l = i / (DM * NMODV * 2);
            const float g = wh ? p.in[I_NFG][l * DM + c] : p.in[I_NMG][l * DM + c];
            GS[i] = g * (1.f + MOD[((size_t)l * NMODV + v) * MODW + (wh ? 4 * DM : DM) + c]); }
    }
    {
        hf* XS = (hf*)p.out; hf* X16 = (hf*)(p.ws + WS_X16); float* ss = (float*)(p.ws + WS_SS) + (size_t)SS_1 * MTOT;
        f32x4 g[4];
#pragma unroll
        for (int j = 0; j < 4; ++j) g[j] = *(const f32x4*)(p.in[I_NMG] + 4 * lane + 256 * j);
        for (int row = gw; row < MTOT; row += NGW) {
            const bool lat = row < NLAT; const float* xr = lat ? p.in[I_X] + (size_t)row * DM : p.in[I_CTX] + (size_t)(row - NLAT) * DM;
            const int v = lat ? (row >> 11) : NB; const float* mv = MOD + (size_t)v * MODW + DM;
            float sq = 0.f; hf* hr = XS + (size_t)row * DM; hf* xh = X16 + (size_t)row * DM;
#pragma unroll
            for (int j = 0; j < 4; ++j) { const f32x4 x = *(const f32x4*)(xr + 4 * lane + 256 * j); const f32x4 sc = *(const f32x4*)(mv + 4 * lane + 256 * j);
                sq += (x[0] * x[0] + x[1] * x[1]) + (x[2] * x[2] + x[3] * x[3]);
                const f32x4 o = x * (g[j] * (sc + 1.f)); u32x2 w; w.x = pkh(o[0], o[1]); w.y = pkh(o[2], o[3]); *(u32x2*)(hr + 4 * lane + 256 * j) = w;
                u32x2 w2; w2.x = pkh(x[0], x[1]); w2.y = pkh(x[2], x[3]); *(u32x2*)(xh + 4 * lane + 256 * j) = w2; }
            sq = wave_sum(sq);
            if (lane == 0) ss[row] = sq;
        }
    }
}

__device__ __forceinline__ void norm_phase(const Frame& F, const float* xs_lat, const float* xs_ctx, int nrows, const float* gain, const float* modl, int sh_off, int sc_off, hf* H) {
    const int gw = F.vcu * 8 + F.wave, NGW = F.G * 8, lane = F.lane;
    f32x4 g[4];
#pragma unroll
    for (int j = 0; j < 4; ++j) g[j] = *(const f32x4*)(gain + 4 * lane + 256 * j);
    for (int row = gw; row < nrows; row += NGW) {
        const bool lat = row < NLAT; const float* xr = lat ? xs_lat + (size_t)row * DM : xs_ctx + (size_t)(row - NLAT) * DM;
        const int v = lat ? (row >> 11) : NB; const float* mv = modl + (size_t)v * MODW;
        f32x4 x[4]; float ss = 0.f;
#pragma unroll
        for (int j = 0; j < 4; ++j) { x[j] = *(const f32x4*)(xr + 4 * lane + 256 * j); ss += (x[j][0] * x[j][0] + x[j][1] * x[j][1]) + (x[j][2] * x[j][2] + x[j][3] * x[j][3]); }
        const float rstd = rsqrtf(wave_sum(ss) * (1.f / DM) + EPS);
        hf* hr = H + (size_t)row * DM;
#pragma unroll
        for (int j = 0; j < 4; ++j) { const f32x4 sh = *(const f32x4*)(mv + sh_off + 4 * lane + 256 * j), sc = *(const f32x4*)(mv + sc_off + 4 * lane + 256 * j);
            const f32x4 y = (x[j] * rstd) * g[j]; const f32x4 o = y * (sc + 1.f) + sh;
            u32x2 w; w.x = pkh(o[0], o[1]); w.y = pkh(o[2], o[3]); *(u32x2*)(hr + 4 * lane + 256 * j) = w; }
    }
}
__device__ __forceinline__ void final_norm_phase(const Frame& F, const hf* X16, float* out, const float* gain, const float* ss) {
    const int gw = F.vcu * 8 + F.wave, NGW = F.G * 8, lane = F.lane;
    f32x4 g[4];
#pragma unroll
    for (int j = 0; j < 4; ++j) g[j] = *(const f32x4*)(gain + 4 * lane + 256 * j);
    for (int row = gw; row < NLAT; row += NGW) {
        const hf* xr = X16 + (size_t)row * DM; float* orow = out + (size_t)row * DM; const float rstd = rsqrtf(ss[row] * (1.f / DM) + EPS);
#pragma unroll
        for (int j = 0; j < 4; ++j) { const hf4 xh = *(const hf4*)(xr + 4 * lane + 256 * j); const f32x4 x = {(float)xh[0], (float)xh[1], (float)xh[2], (float)xh[3]};
            *(f32x4*)(orow + 4 * lane + 256 * j) = (x * rstd) * g[j]; }
    }
}

__device__ __forceinline__ void prep_rope(const Frame& F, const Params& p) {
    const int gw = F.vcu * 8 + F.wave, NGW = F.G * 8, lane = F.lane;
    hf* KR = (hf*)(p.ws + A_KR); hf* DK = (hf*)(p.ws + A_DK); const float* rope = (const float*)(p.ws + WS_ROPE);
    const int hh = lane >> 3, i0 = 2 * (lane & 7);
    for (int row = gw; row < NLAT; row += NGW) {
        const int t = row & (SEQ - 1);
        hf* dk = DK + (size_t)row * 256 + hh * 32 + i0;
        const hf2 a = *(const hf2*)dk, b = *(const hf2*)(dk + 16);
        const f32x2 c = *(const f32x2*)(rope + t * 32 + i0), sn = *(const f32x2*)(rope + t * 32 + 16 + i0);
        const float x1[2] = {(float)a[0], (float)a[1]}, x2[2] = {(float)b[0], (float)b[1]};
        *(unsigned*)dk = pkh(x1[0] * c[0] - x2[0] * sn[0], x1[1] * c[1] - x2[1] * sn[1]);
        *(unsigned*)(dk + 16) = pkh(x2[0] * c[0] + x1[0] * sn[0], x2[1] * c[1] + x1[1] * sn[1]);
        if (lane < 16) { hf* kr = KR + (size_t)row * 32 + lane; const float y1 = (float)kr[0], y2 = (float)kr[16];
            const float cc = rope[t * 32 + lane], ss = rope[t * 32 + 16 + lane];
            kr[0] = (hf)(y1 * cc - y2 * ss); kr[16] = (hf)(y2 * cc + y1 * ss); }
    }
}
__device__ __forceinline__ void prep_hyena(const Frame& F, const Params& p, int l, bool with_ctx) {
    constexpr int INP = 784;
    constexpr int OUTP = 33;
    constexpr int OFF_OU = 66 * INP, OFF_OX = OFF_OU + 128 * OUTP * 4;
    const hf* PHY = (const hf*)(p.ws + A_PHY);
    LAS unsigned char* lds = F.lds; const int tid = F.tid;
    const float* cw = p.in[I_HCW] + (size_t)l * 3 * 768; const float* cb = p.in[I_HCB] + (size_t)l * 768;
    constexpr int U_LAT = NB * (SEQ / 64) * 2, U_CTX = NB * (CTXL / 64) * 2;
    const int nunit = U_LAT + (with_ctx ? U_CTX : 0);
    for (int un = F.vcu; un < nunit; un += F.G) {
        const bool ctx = un >= U_LAT; int r = ctx ? un - U_LAT : un; const int L = ctx ? CTXL : SEQ, ntile = L / 64;
        const int ch = r & 1; r >>= 1; const int tt = r % ntile, b = r / ntile;
        const int t0 = tt * 64; const size_t rowbase = ctx ? (size_t)NLAT + (size_t)b * CTXL : (size_t)b * SEQ;
        hf* dU = ctx ? (hf*)(p.ws + A_UTC) : (hf*)(p.ws + A_UT); hf* dX = ctx ? (hf*)(p.ws + A_X0TC) : (hf*)(p.ws + A_X0T);
        __syncthreads();
        for (int i = tid; i < 66 * 48; i += 512) { const int rr = i / 48, q = i % 48, seg = q >> 4, c16 = q & 15; const int t = t0 - 1 + rr;
            u32x4 v = {0u, 0u, 0u, 0u};
            if (t >= 0 && t < L) v = *(const u32x4*)(PHY + (rowbase + t) * 768 + seg * 256 + ch * 128 + c16 * 8);
            *(LAS u32x4*)(lds + rr * INP + seg * 256 + c16 * 16) = v; }
        __syncthreads();
        {
            const int c = tid & 127, tg = tid >> 7, cg = ch * 128 + c;
            const float a0 = cw[cg], a1 = cw[768 + cg], a2 = cw[1536 + cg], ab = cb[cg];
            const float b0 = cw[256 + cg], b1 = cw[768 + 256 + cg], b2 = cw[1536 + 256 + cg], bb = cb[256 + cg];
            const float v0 = cw[512 + cg], v1 = cw[768 + 512 + cg], v2 = cw[1536 + 512 + cg], vb = cb[512 + cg];
            const LAS hf* in = (const LAS hf*)(lds + (16 * tg) * INP) + c;
            float p0 = (float)in[0], p1 = (float)in[128], p2 = (float)in[256];
            float c0 = (float)in[INP / 2], c1 = (float)in[INP / 2 + 128], c2 = (float)in[INP / 2 + 256];
            LAS hf* ou = (LAS hf*)(lds + OFF_OU) + c * (OUTP * 2) + 16 * tg; LAS hf* ox = (LAS hf*)(lds + OFF_OX) + c * (OUTP * 2) + 16 * tg;
#pragma unroll
            for (int j = 0; j < 16; ++j) { const LAS hf* nx = in + (j + 2) * (INP / 2);
                const float n0 = (float)nx[0], n1 = (float)nx[128], n2 = (float)nx[256];
                const float x0 = a0 * p0 + a1 * c0 + a2 * n0 + ab, x1 = b0 * p1 + b1 * c1 + b2 * n1 + bb, vv = v0 * p2 + v1 * c2 + v2 * n2 + vb;
                ou[j] = (hf)(vv * x1); ox[j] = (hf)x0;
                p0 = c0; p1 = c1; p2 = c2; c0 = n0; c1 = n1; c2 = n2; }
        }
        __syncthreads();
        {
            const int c = tid >> 2, q = tid & 3; const size_t go = ((size_t)(ch * 128 + c) * NB + b) * L + t0 + 16 * q;
            const LAS unsigned* su = (const LAS unsigned*)(lds + OFF_OU) + c * OUTP + 8 * q; const LAS unsigned* sx = (const LAS unsigned*)(lds + OFF_OX) + c * OUTP + 8 * q;
            u32x4 w0 = {su[0], su[1], su[2], su[3]}, w1 = {su[4], su[5], su[6], su[7]};
            *(u32x4*)(dU + go) = w0; *(u32x4*)(dU + go + 8) = w1;
            u32x4 y0 = {sx[0], sx[1], sx[2], sx[3]}, y1 = {sx[4], sx[5], sx[6], sx[7]};
            *(u32x4*)(dX + go) = y0; *(u32x4*)(dX + go + 8) = y1;
        }
    }
    __syncthreads();
}

namespace att {
#ifndef PROF_SEL
#define PROF_SEL -1
#endif
#define ATT_MARK(b) do { if (PROF_SEL >= 0 && F.tid == 0) { volatile LAS unsigned* _pf = (volatile LAS unsigned*)(F.lds + LDS_BYTES - 512); const unsigned _t = (unsigned)__builtin_amdgcn_s_memrealtime(); _pf[(b)] += _t - _pf[32]; _pf[32] = _t; } } while (0)
__device__ __forceinline__ int crow(int r, int hi) { return (r & 3) + 8 * (r >> 2) + 4 * hi; }
#define SBAR() __builtin_amdgcn_sched_barrier(0)
constexpr float THR2 = 8.f * 1.4426950408889634f;
constexpr int KS_MLA = 208, KS_DF = 80;
constexpr int VS = 192, VB = 64 * VS;
constexpr int OFF_V = 32768;
template <int OFF> __device__ __forceinline__ s16x4 tr_read(int vb) {
    s16x4 r; asm volatile("ds_read_b64_tr_b16 %0, %1 offset:%2" : "=&v"(r) : "v"(vb), "i"(OFF) : "memory"); return r;
}
__device__ __forceinline__ int kpos(int key) { return (key & ~0xC) | ((key & 4) << 1) | ((key & 8) >> 1); }

template <int ND0, int KS>
__device__ __forceinline__ void qkt(f32x16& p0, f32x16& p1, const LAS unsigned char* Ks, const hf8* qr, int r32, int hi) {
    p0 = f32x16{}; p1 = f32x16{};
#pragma unroll
    for (int d0 = 0; d0 < ND0; ++d0) { const int cb = (d0 * 16 + hi * 8) * 2;
        const hf8 b0 = *(const LAS hf8*)(Ks + r32 * KS + cb), b1 = *(const LAS hf8*)(Ks + (32 + r32) * KS + cb);
        p0 = __builtin_amdgcn_mfma_f32_32x32x16_f16(b0, qr[d0], p0, 0, 0, 0); p1 = __builtin_amdgcn_mfma_f32_32x32x16_f16(b1, qr[d0], p1, 0, 0, 0); }
}
__device__ __forceinline__ float max3f(float a, float b, float c) { float r; asm("v_max3_f32 %0, %1, %2, %3" : "=v"(r) : "v"(a), "v"(b), "v"(c)); return r; }
__device__ __forceinline__ float max2f(float a, float b) { float r; asm("v_max_f32_e32 %0, %1, %2" : "=v"(r) : "v"(a), "v"(b)); return r; }
__device__ __forceinline__ float max16(const f32x16& p) { float r;
    asm("v_max3_f32 %0, %1, %2, %3\n\tv_max3_f32 %0, %0, %4, %5\n\tv_max3_f32 %0, %0, %6, %7\n\tv_max3_f32 %0, %0, %8, %9\n\tv_max3_f32 %0, %0, %10, %11\n\tv_max3_f32 %0, %0, %12, %13\n\tv_max3_f32 %0, %0, %14, %15\n\tv_max_f32_e32 %0, %0, %16"
        : "=&v"(r) : "v"(p[0]), "v"(p[1]), "v"(p[2]), "v"(p[3]), "v"(p[4]), "v"(p[5]), "v"(p[6]), "v"(p[7]), "v"(p[8]), "v"(p[9]), "v"(p[10]), "v"(p[11]), "v"(p[12]), "v"(p[13]), "v"(p[14]), "v"(p[15]));
    return r; }
__device__ __forceinline__ hf8 pack8(const f32x16& p, int b) { u32x4 w = {pkh(p[b], p[b + 1]), pkh(p[b + 2], p[b + 3]), pkh(p[b + 4], p[b + 5]), pkh(p[b + 6], p[b + 7])}; return __builtin_bit_cast(hf8, w); }
__device__ __forceinline__ void sm_max(const f32x16& p0, const f32x16& p1, float& m, float& l, f32x16& o0, f32x16& o1, const bool first) {
    float pmax = max2f(max16(p0), max16(p1));
    { auto rr = __builtin_amdgcn_permlane32_swap(__float_as_uint(pmax), __float_as_uint(pmax), false, false);
      pmax = max2f(__uint_as_float(rr[0]), __uint_as_float(rr[1])); }
    if (first || __any(pmax - m > THR2)) {
        const float mn = first ? pmax : max2f(m, pmax);
        if (!first) { const float alpha = __builtin_amdgcn_exp2f(m - mn); l *= alpha;
#pragma unroll
            for (int r = 0; r < 16; ++r) { o0[r] *= alpha; o1[r] *= alpha; } }
        m = mn;
    }
}
__device__ __forceinline__ void sm_exp_pv(f32x16& p0, f32x16& p1, const float m, float& l, f32x16& o0, f32x16& o1, const LAS unsigned char* Vt, int r32, int hi) {
#pragma unroll
    for (int r = 0; r < 16; ++r) { p0[r] -= m; p1[r] -= m; }
#pragma unroll
    for (int r = 0; r < 16; ++r) { p0[r] = __builtin_amdgcn_exp2f(p0[r]); p1[r] = __builtin_amdgcn_exp2f(p1[r]); }
    float ps = 0.f;
#pragma unroll
    for (int r = 0; r < 16; ++r) ps += p0[r] + p1[r];
    l += ps;
    const hf8 pf0 = pack8(p0, 0), pf1 = pack8(p0, 8), pf2 = pack8(p1, 0), pf3 = pack8(p1, 8);
    const int lg = (int)(threadIdx.x & 15), vq = lg >> 2, vp4 = lg & 3;
    const int vbase = (int)(unsigned)(uintptr_t)Vt + (4 * hi + vq) * VS + (16 * ((int)(threadIdx.x >> 4) & 1) + 4 * vp4) * 2;
#define PVK(ks, pf) do { \
        s16x4 l0 = tr_read<(16 * (ks)) * VS>(vbase), h0 = tr_read<(16 * (ks) + 8) * VS>(vbase), l1 = tr_read<(16 * (ks)) * VS + 64>(vbase), h1 = tr_read<(16 * (ks) + 8) * VS + 64>(vbase); \
        asm volatile("s_waitcnt lgkmcnt(0)" : "+v"(l0), "+v"(h0), "+v"(l1), "+v"(h1) :: "memory");     \
        const hf8 a0 = __builtin_bit_cast(hf8, (short __attribute__((ext_vector_type(8)))){l0[0], l0[1], l0[2], l0[3], h0[0], h0[1], h0[2], h0[3]}); \
        const hf8 a1 = __builtin_bit_cast(hf8, (short __attribute__((ext_vector_type(8)))){l1[0], l1[1], l1[2], l1[3], h1[0], h1[1], h1[2], h1[3]}); \
        o0 = __builtin_amdgcn_mfma_f32_32x32x16_f16(a0, pf, o0, 0, 0, 0); o1 = __builtin_amdgcn_mfma_f32_32x32x16_f16(a1, pf, o1, 0, 0, 0); } while (0)
    PVK(0, pf0); PVK(1, pf1); PVK(2, pf2); PVK(3, pf3);
#undef PVK
}

template <bool MLA>
__device__ __forceinline__ void attn_pass(const Frame& F, const Params& p, int hq, int hv, int qrow0, int qpos0, int klat0, int nlat, int kctx0, f32x16& o0, f32x16& o1, float& inv) {
    constexpr int DK = MLA ? 96 : 32, ND0 = DK / 16, KS = MLA ? KS_MLA : KS_DF, KB = 64 * KS;
    constexpr float SCALE = MLA ? MLA_SCALE : DF_SCALE, C = SCALE * 1.4426950408889634f;
    const int tid = F.tid, wid = F.wave, lane = F.lane, r32 = lane & 31, hi = lane >> 5;
    const hf* QKV = (const hf*)(p.ws + A_QKV); const hf* KRb = (const hf*)(p.ws + A_KR);
    const hf* DQ = (const hf*)(p.ws + A_DQ); const hf* DKb = (const hf*)(p.ws + A_DK); const hf* DVb = (const hf*)(p.ws + A_DV);
    const float* rope = (const float*)(p.ws + WS_ROPE);
    LAS unsigned char* lds = F.lds;
    hf8 qr[ND0];
    {
        const int qrow = qrow0 + wid * 32 + r32;
        const hf* qp = MLA ? QKV + (size_t)qrow * NUP + hq * 96 + hi * 8 : DQ + (size_t)qrow * 256 + hq * 32 + hi * 8;
        hf8 raw[ND0];
#pragma unroll
        for (int d0 = 0; d0 < ND0; ++d0) raw[d0] = *(const hf8*)(qp + d0 * 16);
        f32x4 c0 = {1.f, 1.f, 1.f, 1.f}, c1 = c0, s0 = {0.f, 0.f, 0.f, 0.f}, s1 = s0;
        if (qpos0 >= 0) { const int t = qpos0 + wid * 32 + r32;
            c0 = *(const f32x4*)(rope + t * 32 + hi * 8); c1 = *(const f32x4*)(rope + t * 32 + hi * 8 + 4);
            s0 = *(const f32x4*)(rope + t * 32 + 16 + hi * 8); s1 = *(const f32x4*)(rope + t * 32 + 16 + hi * 8 + 4); }
#pragma unroll
        for (int d0 = 0; d0 < ND0 - 2; ++d0) {
#pragma unroll
            for (int j = 0; j < 8; ++j) qr[d0][j] = (hf)((float)raw[d0][j] * C); }
#pragma unroll
        for (int j = 0; j < 8; ++j) { const float cc = j < 4 ? c0[j & 3] : c1[j & 3], sn = j < 4 ? s0[j & 3] : s1[j & 3]; const float a = (float)raw[ND0 - 2][j], b = (float)raw[ND0 - 1][j];
            qr[ND0 - 2][j] = (hf)((a * cc - b * sn) * C); qr[ND0 - 1][j] = (hf)((b * cc + a * sn) * C); }
    }
    const int k1r = MLA ? (tid >> 3) : ((tid & 255) >> 2), k1c = MLA ? (tid & 7) * 8 : (tid & 3) * 8;
    const int k2r = (tid & 255) >> 2, k2c = (tid & 3) * 8;
    const int vr_ = tid >> 3, vc_ = (tid & 7) * 8;
    const bool klo = tid < 256;
    struct Stg { u32x4 v, k1, k2; };
    Stg sA, sB; sA.v = sA.k1 = sA.k2 = sB.v = sB.k1 = sB.k2 = (u32x4){0u, 0u, 0u, 0u};
    const int ntile = nlat + 4;
#define KROW0(j) (((j) < nlat) ? klat0 + (j) * 64 : kctx0 + ((j) - nlat) * 64)
#define A_LOADK(S, j) do { const int kr0 = KROW0(j); \
        if (MLA) { S.k1 = *(const u32x4*)(QKV + (size_t)(kr0 + k1r) * NUP + 768 + hq * 128 + k1c); S.k2 = *(const u32x4*)(KRb + (size_t)(kr0 + k2r) * 32 + k2c); } \
        else S.k1 = *(const u32x4*)(DKb + (size_t)(kr0 + k1r) * 256 + hq * 32 + k1c); } while (0)
#define A_LOADV(S, j) do { const int kr0 = KROW0(j); \
        if (MLA) S.v = *(const u32x4*)(QKV + (size_t)(kr0 + vr_) * NUP + 768 + hv * 128 + 64 + vc_); else S.v = *(const u32x4*)(DVb + (size_t)(kr0 + vr_) * 256 + hv * 64 + vc_); } while (0)
#define A_WRITEK(S, b) do { *(LAS u32x4*)(lds + (b) * KB + k1r * KS + k1c * 2) = S.k1; if (MLA) *(LAS u32x4*)(lds + (b) * KB + k2r * KS + 128 + k2c * 2) = S.k2; } while (0)
#define A_WRITEV(S, b) do { *(LAS u32x4*)(lds + OFF_V + (b) * VB + vr_ * VS + vc_ * 2) = S.v; } while (0)
    float m_reg = 0.f, l_reg = 0.f;
    o0 = f32x16{}; o1 = f32x16{};
    f32x16 pA0, pA1, pB0, pB1;
    __syncthreads();
    const int nt1 = ntile - 1;
#define TCL(j) (((j) < nt1) ? (j) : nt1)
    A_LOADK(sA, 0); A_LOADV(sA, 0); A_LOADK(sB, 1);
    A_WRITEK(sA, 0); A_WRITEV(sA, 0); A_WRITEK(sB, 1);
    A_LOADK(sA, TCL(2));
    A_LOADV(sA, 1);
    __syncthreads();
    qkt<ND0, KS>(pA0, pA1, lds, qr, r32, hi);
    for (int j = 0; j < ntile; j += 2) {
        A_LOADK(sB, TCL(j + 3)); A_LOADV(sB, TCL(j + 2));
        sm_max(pA0, pA1, m_reg, l_reg, o0, o1, j == 0);
        qkt<ND0, KS>(pB0, pB1, lds + KB, qr, r32, hi);
        sm_exp_pv(pA0, pA1, m_reg, l_reg, o0, o1, lds + OFF_V, r32, hi);
        ATT_MARK(26);
        A_WRITEK(sA, 0); A_WRITEV(sA, 1);
        ATT_MARK(27);
        __syncthreads();
        ATT_MARK(28);
        A_LOADK(sA, TCL(j + 4)); A_LOADV(sA, TCL(j + 3));
        sm_max(pB0, pB1, m_reg, l_reg, o0, o1, false);
        qkt<ND0, KS>(pA0, pA1, lds, qr, r32, hi);
        sm_exp_pv(pB0, pB1, m_reg, l_reg, o0, o1, lds + OFF_V + VB, r32, hi);
        ATT_MARK(26);
        A_WRITEK(sB, 1); A_WRITEV(sB, 0);
        ATT_MARK(27);
        __syncthreads();
        ATT_MARK(28);
    }
#undef TCL
#undef KROW0
#undef A_LOADK
#undef A_LOADV
#undef A_WRITEK
#undef A_WRITEV
    const float lt = l_reg + __shfl_xor(l_reg, 32); inv = __builtin_amdgcn_rcpf(lt);
}
template <bool MLA>
__device__ __forceinline__ void attn_unit(const Frame& F, const Params& p, int l, int h, int qrow0, int qpos0, int klat0, int nlat, int kctx0) {
    const int wid = F.wave, lane = F.lane, r32 = lane & 31, hi = lane >> 5;
    hf* Y = (hf*)(p.ws + A_Y);
    const size_t yrow = (size_t)(qrow0 + wid * 32 + r32) * DM;
    if constexpr (MLA) {
        f32x16 o0, o1; float inv;
        attn_pass<true>(F, p, h, h, qrow0, qpos0, klat0, nlat, kctx0, o0, o1, inv);
#pragma unroll
        for (int g = 0; g < 4; ++g) { u32x2 w; w.x = pkh(o0[4 * g] * inv, o0[4 * g + 1] * inv); w.y = pkh(o0[4 * g + 2] * inv, o0[4 * g + 3] * inv); *(u32x2*)(Y + yrow + h * 64 + 8 * g + 4 * hi) = w; }
#pragma unroll
        for (int g = 0; g < 4; ++g) { u32x2 w; w.x = pkh(o1[4 * g] * inv, o1[4 * g + 1] * inv); w.y = pkh(o1[4 * g + 2] * inv, o1[4 * g + 3] * inv); *(u32x2*)(Y + yrow + h * 64 + 32 + 8 * g + 4 * hi) = w; }
    } else {
        const float lam = ((const float*)(p.ws + WS_LAM))[2 * l], oml = ((const float*)(p.ws + WS_LAM))[2 * l + 1];
        f32x16 a0, a1;
        LAS float* park = (LAS float*)(F.lds + 65536 + wid * 8192) + lane;
        { f32x16 o0, o1; float inv; attn_pass<false>(F, p, 2 * h, h, qrow0, qpos0, klat0, nlat, kctx0, o0, o1, inv);
#pragma unroll
          for (int r = 0; r < 16; ++r) { park[r * 64] = o0[r] * inv; park[(16 + r) * 64] = o1[r] * inv; } }
        { f32x16 o0, o1; float inv; attn_pass<false>(F, p, 2 * h + 1, h, qrow0, qpos0, klat0, nlat, kctx0, o0, o1, inv);
#pragma unroll
          for (int r = 0; r < 16; ++r) { a0[r] = park[r * 64] - o0[r] * (lam * inv); a1[r] = park[(16 + r) * 64] - o1[r] * (lam * inv); } }
        float ss = 0.f;
#pragma unroll
        for (int r = 0; r < 16; ++r) ss += a0[r] * a0[r] + a1[r] * a1[r];
        ss += __shfl_xor(ss, 32);
        const float rs = rsqrtf(ss * (1.f / 64.f) + EPS) * oml;
#pragma unroll
        for (int g = 0; g < 4; ++g) { const f32x4 gg = *(const f32x4*)(p.in[I_SUBG] + l * 64 + 8 * g + 4 * hi);
            u32x2 w; w.x = pkh(a0[4 * g] * rs * gg[0], a0[4 * g + 1] * rs * gg[1]); w.y = pkh(a0[4 * g + 2] * rs * gg[2], a0[4 * g + 3] * rs * gg[3]); *(u32x2*)(Y + yrow + 768 + h * 64 + 8 * g + 4 * hi) = w; }
#pragma unroll
        for (int g = 0; g < 4; ++g) { const f32x4 gg = *(const f32x4*)(p.in[I_SUBG] + l * 64 + 32 + 8 * g + 4 * hi);
            u32x2 w; w.x = pkh(a1[4 * g] * rs * gg[0], a1[4 * g + 1] * rs * gg[1]); w.y = pkh(a1[4 * g + 2] * rs * gg[2], a1[4 * g + 3] * rs * gg[3]); *(u32x2*)(Y + yrow + 768 + h * 64 + 32 + 8 * g + 4 * hi) = w; }
    }
}
}

template <int L>
__device__ __forceinline__ void hyena_unit(const Frame& F, const hf* Rrow  , const hf* U  , const hf* X0  , hf* Ycol  ) {
    constexpr int NM = L / 256, RL = 2 * L, SH = (L > 1024) ? 1024 : L, NH = L / SH, US = SH * 2 + 16;
    constexpr int OFF_U = 8 * RL * 2;
    constexpr int XP = L * 2 + 16;
    static_assert(OFF_U + 32 * US <= LDS_MISC && 32 * XP <= LDS_MISC, "hyena LDS");
    const int tid = F.tid, w = F.wave, lane = F.lane, i32 = lane & 31, hi = lane >> 5;
    LAS unsigned char* lds = F.lds;
    __syncthreads();
    for (int i = tid; i < RL / 8; i += 512) *(LAS u32x4*)(lds + i * 16) = *(const u32x4*)(Rrow + i * 8);
    __syncthreads();
    for (int idx = tid; idx < 7 * RL; idx += 512) { const int cw = 1 + idx / RL, x = idx % RL; ((LAS hf*)lds)[cw * RL + x] = (x >= cw) ? ((const LAS hf*)lds)[x - cw] : (hf)0.f; }
    f32x16 acc[NM];
#pragma unroll
    for (int m = 0; m < NM; ++m) acc[m] = f32x16{};
    const LAS unsigned char* cpy = lds + w * (RL * 2);
    for (int half = 0; half < NH; ++half) {
        __syncthreads();
        for (int idx = tid; idx < 32 * (SH / 8); idx += 512) { const int b = idx / (SH / 8), pc = idx % (SH / 8);
            *(LAS u32x4*)(lds + OFF_U + b * US + pc * 16) = *(const u32x4*)(U + (size_t)b * L + half * SH + pc * 8); }
        __syncthreads();
#pragma unroll 2
        for (int jl = 0; jl < SH / 16; ++jl) {
            const int j = half * (SH / 16) + jl;
            const hf8 bf = *(const LAS hf8*)(lds + OFF_U + i32 * US + (jl * 16 + hi * 8) * 2);
            const int x0 = L + 16 * j + 8 * hi - 8 * i32;
#pragma unroll
            for (int m = 0; m < NM; ++m) { const hf8 af = *(const LAS hf8*)(cpy + (x0 - 256 * m) * 2);
                acc[m] = __builtin_amdgcn_mfma_f32_32x32x16_f16(af, bf, acc[m], 0, 0, 0); }
        }
    }
    __syncthreads();
    for (int idx = tid; idx < 32 * (L / 8); idx += 512) { const int b = idx / (L / 8), pc = idx % (L / 8);
        *(LAS u32x4*)(lds + b * XP + pc * 16) = *(const u32x4*)(X0 + (size_t)b * L + pc * 8); }
    __syncthreads();
    const LAS hf* x0p = (const LAS hf*)(lds + i32 * XP) + w + 32 * hi;
    hf* yp = Ycol + ((size_t)i32 * L + w + 32 * hi) * DM;
#pragma unroll
    for (int m = 0; m < NM; ++m) {
#pragma unroll
        for (int r = 0; r < 16; ++r) { const int tt = 256 * m + 8 * ((r & 3) + 8 * (r >> 2));
            const float x0v = (float)x0p[tt];
            yp[(size_t)tt * DM] = (hf)(x0v * acc[m][r]); }
        asm volatile("" ::: "memory");
    }
}

#ifndef PH_MASK
#define PH_MASK 0x1FFFF
#endif
#define PHM(k) ((PH_MASK >> (k)) & 1)
#ifndef PROBE_REP
#define PROBE_REP 0
#endif
#define NREP(k) (((PROBE_REP >> (k)) & 1) ? 2 : 1)
constexpr int NPH_LAYER = 9, PH_L0 = 2, NPHASE = PH_L0 + DEPTH * NPH_LAYER + 1;
__global__ void __launch_bounds__(512, 2) fwd_kernel(Params p) {
    extern __shared__ __attribute__((aligned(16))) unsigned char lds_raw[];
    Frame F0; Frame& F = F0;
    F.lds = (LAS unsigned char*)lds_raw;
    F.tid = threadIdx.x; F.lane = F.tid & 63; F.wave = __builtin_amdgcn_readfirstlane(F.tid >> 6);
    F.G = gridDim.x; { const int bx = blockIdx.x; F.vcu = (F.G % 8 == 0) ? (bx % 8) * (F.G / 8) + bx / 8 : bx; }
    volatile LAS unsigned* misc = (volatile LAS unsigned*)(F.lds + LDS_MISC);
    if (F.tid < 16) misc[F.tid] = 0u;
    __syncthreads();
    const int lo = p.ph_lo, hi = p.ph_hi;
    XcdBarrier bar; bar.bar = (unsigned*)(p.ws + WS_BAR); bar.x = 0; bar.st = misc;
    if (hi - lo > 1) bar = xcd_barrier_post((unsigned*)(p.ws + WS_BAR), misc);
#define IN(k) (lo <= (k) && (k) < hi)
#define LAUNDER(Fl) Frame Fl = F0; asm volatile("" : "+v"(Fl.tid), "+v"(Fl.lane))
#ifndef PROF_SEL
#define PROF_SEL -1
#endif
#define PROF_K 8
    volatile LAS unsigned* prof = (volatile LAS unsigned*)(F.lds + LDS_BYTES - 512);
    if (PROF_SEL >= 0 && F.tid < 40) prof[F.tid] = 0u;
    if (PROF_SEL >= 0) __syncthreads();
    if (PROF_SEL >= 0 && F.tid == 0) prof[32] = (unsigned)__builtin_amdgcn_s_memrealtime();
#define PROF_MARK(b) do { if (PROF_SEL >= 0 && F.tid == 0) { const unsigned _t = (unsigned)__builtin_amdgcn_s_memrealtime(); prof[(b)] += _t - prof[32]; if ((b) >= 16) prof[30] += _t - prof[32]; prof[32] = _t; } } while (0)
#define SEAMT(k, b) do { PROF_MARK(b); if (IN(k) && IN((k) + 1)) xcd_barrier(bar); PROF_MARK(16 + (b)); } while (0)
#define SEAM(k) do { if (IN(k) && IN((k) + 1)) xcd_barrier(bar); } while (0)
    unsigned char* ws = p.ws;
    hf* X16 = (hf*)(ws + WS_X16);
    hf* XS1 = (hf*)p.out; hf* MM = (hf*)p.out; hf* Y = (hf*)(ws + A_B); hf* XS2 = (hf*)(ws + A_B);
    hf* QKV = (hf*)(ws + A_QKV); hf* QKVN = (hf*)(ws + A_QKVN);
    unsigned char* Gt = (unsigned char*)(ws + A_G); hf* HID = (hf*)(ws + A_HID);
    float* SS = (float*)(ws + WS_SS);

    if (PHM(11) && IN(0)) for (int rep = 0; rep < NREP(11); ++rep) { LAUNDER(Fl); prologue_a(Fl, p); }
    SEAMT(0, 9);
    if (PHM(11) && IN(1)) for (int rep = 0; rep < NREP(12); ++rep) { LAUNDER(Fl); prologue_b(Fl, p); }
    SEAMT(1, 9);

    for (int l = 0; l < DEPTH; ++l) {
        const int pb = PH_L0 + l * NPH_LAYER;
        const bool ctx_live = l < DEPTH - 1;
        const int Mrows = ctx_live ? MTOT : NLAT;
        const float* modl = (const float*)(ws + WS_MOD) + (size_t)l * NMODV * MODW;
        const float* biasl = (const float*)(ws + WS_BIAS) + (size_t)l * NMODV * NBIAS;
        const float* gsl = (const float*)(ws + WS_GS) + (size_t)l * 2 * NMODV * DM;
        const unsigned char* wl = ws + WS_WT + (size_t)(l & 1) * W_LAYER;
        float* ss1 = SS + (size_t)(SS_1 + l) * MTOT; float* ss2 = SS + (size_t)(SS_2 + l) * MTOT;

        if (PHM(1) && IN(pb + 0)) for (int rep = 0; rep < NREP(1); ++rep) { pg8::Gemm g{XS1, (const hf*)(wl + W_IN1), MTOT, NP1, DM, DM, DM}; pg8::StaticOrder S; S.init(MTOT, NP1, F.G, (int)blockIdx.x);
            pg8::EpiIn E{QKVN, (hf*)(ws + A_KR), (hf*)(ws + A_PHY), (hf*)(ws + A_DQ), (hf*)(ws + A_DK), (hf*)(ws + A_DV), ss1, biasl + B_IN, SS + (size_t)(SS_Q + l) * MTOT, SS + (size_t)(SS_KV + l) * MTOT};
            pg8::gemm_phase(F.lds, g, S, E); }
        SEAMT(pb + 0, 0);
        if (PHM(2) && IN(pb + 1)) { LAUNDER(Fl); prep_rope(Fl, p); prep_hyena(Fl, p, l, ctx_live);
            if (l + 1 < DEPTH) convert_layer(Fl, p, l + 1, ws + WS_WT + (size_t)((l + 1) & 1) * W_LAYER); }
        SEAMT(pb + 1, 1);
        if (PHM(3) && IN(pb + 2)) for (int rep = 0; rep < NREP(3); ++rep) { pg8::Gemm g{QKVN, (const hf*)(wl + W_UP), MTOT, NUP, KUP, KUP, KUP}; pg8::StaticOrder S; S.init(MTOT, NUP, F.G, (int)blockIdx.x);
            pg8::EpiUp E{QKV, SS + (size_t)(SS_Q + l) * MTOT, SS + (size_t)(SS_KV + l) * MTOT}; pg8::gemm_phase(F.lds, g, S, E); }
        SEAMT(pb + 2, 2);
        if (PHM(4) && IN(pb + 3)) for (int rep = 0; rep < NREP(4); ++rep) {
            LAUNDER(Fl);
            PROF_MARK(14);
            const int n_mla = 2048 + (ctx_live ? 256 : 0);
            if (PHM(13)) for (int rp = 0; rp < NREP(13); ++rp) for (int id = F.vcu; id < n_mla; id += F.G) {
                if (id < 2048) { const int qb = id & 7, h = (id >> 3) & 7, b = id >> 6; att::attn_unit<true>(Fl, p, l, h, b * SEQ + qb * 256, qb * 256, b * SEQ, 32, NLAT + b * CTXL); }
                else { const int i2 = id - 2048, h = i2 & 7, b = i2 >> 3; att::attn_unit<true>(Fl, p, l, h, NLAT + b * CTXL, -1, 0, 0, NLAT + b * CTXL); }
            }
            PROF_MARK(11);
            const int n_df = 1024 + (ctx_live ? 128 : 0);
            if (PHM(14)) for (int rp = 0; rp < NREP(14); ++rp) for (int id = F.vcu; id < n_df; id += F.G) {
                if (id < 1024) { const int qb = id & 7, h = (id >> 3) & 3, b = id >> 5; att::attn_unit<false>(Fl, p, l, h, b * SEQ + qb * 256, qb * 256, b * SEQ, 32, NLAT + b * CTXL); }
                else { const int i2 = id - 1024, h = i2 & 3, b = i2 >> 2; att::attn_unit<false>(Fl, p, l, h, NLAT + b * CTXL, -1, 0, 0, NLAT + b * CTXL); }
            }
            PROF_MARK(12);
            if (PHM(15)) for (int rp = 0; rp < NREP(15); ++rp) for (int c = F.vcu; c < 256; c += F.G)
                hyena_unit<SEQ>(Fl, (const hf*)(ws + WS_RF) + ((size_t)l * 256 + c) * 4096, (const hf*)(ws + A_UT) + (size_t)c * NLAT, (const hf*)(ws + A_X0T) + (size_t)c * NLAT, Y + 512 + c);
            if (PHM(16) && ctx_live) for (int rp = 0; rp < NREP(15); ++rp) for (int c = F.vcu; c < 256; c += F.G)
                hyena_unit<CTXL>(Fl, (const hf*)(ws + WS_RFC) + ((size_t)l * 256 + c) * 512, (const hf*)(ws + A_UTC) + (size_t)c * NCTX, (const hf*)(ws + A_X0TC) + (size_t)c * NCTX, Y + (size_t)NLAT * DM + 512 + c);
            __syncthreads();
            PROF_MARK(13);
        }
        SEAMT(pb + 3, 3);
        if (PHM(5) && IN(pb + 4)) for (int rep = 0; rep < NREP(5); ++rep) { pg8::Gemm g{XS1, (const hf*)(wl + W_ING), Mrows, NGATE, DM, DM, DM}; pg8::StaticOrder S; S.init(Mrows, NGATE, F.G, (int)blockIdx.x);
            pg8::EpiGate8 E{Gt, ss1, biasl + B_G}; pg8::gemm_phase(F.lds, g, S, E); }
        SEAMT(pb + 4, 4);
        if (PHM(6) && IN(pb + 5)) for (int rep = 0; rep < NREP(6); ++rep) { pg8::Gemm g{Y, (const hf*)(wl + W_BR), Mrows, DM, DM, DM, DM}; pg8::StaticOrder S; S.init(Mrows, DM, F.G, (int)blockIdx.x);
            pg8::EpiMerge E{MM, Gt}; pg8::gemm_phase(F.lds, g, S, E); }
        SEAMT(pb + 5, 5);
        if (PHM(7) && IN(pb + 6)) { pg8::Gemm g{MM, (const hf*)(wl + W_OUT), Mrows, DM, DM, DM, DM}; pg8::StaticOrder S; S.init(Mrows, DM, F.G, (int)blockIdx.x);
            pg8::EpiResidX<true, true> E{X16, modl + 2 * DM, XS2, gsl + (size_t)NMODV * DM, ss2}; pg8::gemm_phase(F.lds, g, S, E); }
        SEAMT(pb + 6, 6);
        if (PHM(9) && IN(pb + 7)) for (int rep = 0; rep < NREP(9); ++rep) { pg8::Gemm g{XS2, (const hf*)(wl + W_FC1), Mrows, DFF, DM, DM, DM}; pg8::StaticOrder S; S.init(Mrows, DFF, F.G, (int)blockIdx.x);
            pg8::EpiHalf<2, true> E{HID, DFF, ss2, biasl + B_FC1}; pg8::gemm_phase(F.lds, g, S, E); }
        SEAMT(pb + 7, 7);
        if (PHM(10) && IN(pb + 8)) { pg8::Gemm g{HID, (const hf*)(wl + W_FC2), Mrows, DM, DFF, DFF, DFF}; pg8::StaticOrder S; S.init(Mrows, DM, F.G, (int)blockIdx.x);
            if (ctx_live) { pg8::EpiResidX<true, true> E{X16, modl + 5 * DM, XS1, gsl + (size_t)2 * NMODV * DM, ss1 + MTOT}; pg8::gemm_phase(F.lds, g, S, E); }
            else { pg8::EpiResidX<false, true> E{X16, modl + 5 * DM, nullptr, nullptr, SS + (size_t)SS_F * MTOT}; pg8::gemm_phase(F.lds, g, S, E); } }
        SEAMT(pb + 8, 8);
    }
    if (PHM(12) && IN(NPHASE - 1)) { LAUNDER(Fl); final_norm_phase(Fl, X16, p.out, p.in[I_FNG], SS + (size_t)SS_F * MTOT); }
    PROF_MARK(10);
    if (PROF_SEL >= 0 && blockIdx.x == 0 && F.tid == 0) { const unsigned long long t0 = __builtin_amdgcn_s_memrealtime(); const unsigned long long d = (unsigned long long)PROF_K * prof[PROF_SEL];
        while (__builtin_amdgcn_s_memrealtime() - t0 < d) __builtin_amdgcn_s_sleep(8); }
#undef IN
#undef SEAM
}

extern "C" void kernel_launch(void* const* d_in, const int* in_sizes, int n_in, void* d_out, int out_size, void* d_ws, size_t ws_size, hipStream_t stream) {
    static int grid = 0;
    if (grid == 0) {
        if (n_in != 35 || in_sizes[0] != NLAT * DM || out_size != NLAT * DM || ws_size < WS_END) {
            fprintf(stderr, "kernel_launch: unexpected shapes: n_in %d in0 %d out %d ws %zu (need %zu); nothing launched\n", n_in, n_in > 0 ? in_sizes[0] : -1, out_size, ws_size, (size_t)WS_END); grid = -1; return; }
        int dev = 0, cus = 0, per_cu = 0;
        if (hipGetDevice(&dev) != hipSuccess || hipDeviceGetAttribute(&cus, hipDeviceAttributeMultiprocessorCount, dev) != hipSuccess) { fprintf(stderr, "kernel_launch: device query failed\n"); grid = -1; return; }
        if (hipFuncSetAttribute((const void*)fwd_kernel, hipFuncAttributeMaxDynamicSharedMemorySize, LDS_BYTES) != hipSuccess) { fprintf(stderr, "kernel_launch: hipFuncSetAttribute failed\n"); grid = -1; return; }
        if (hipOccupancyMaxActiveBlocksPerMultiprocessor(&per_cu, (const void*)fwd_kernel, 512, LDS_BYTES) != hipSuccess || per_cu < 1)
            fprintf(stderr, "kernel_launch: note: occupancy query reports %d workgroups per CU\n", per_cu);
        (void)hipGetLastError();
        grid = cus;
    }
    if (grid < 0) return;
    if (hipMemsetAsync((char*)d_ws + WS_BAR, 0, WS_ZERO_BYTES, stream) != hipSuccess) { fprintf(stderr, "kernel_launch: memset failed\n"); return; }
    Params P{};
    for (int i = 0; i < 35; ++i) P.in[i] = (const float*)d_in[i];
    P.out = (float*)d_out; P.ws = (unsigned char*)d_ws;
#if MK_FUSED
    P.ph_lo = 0; P.ph_hi = NPHASE;
    hipLaunchKernelGGL(fwd_kernel, dim3(grid), dim3(512), LDS_BYTES, stream, P);
#else
    for (int ph = 0; ph < NPHASE; ++ph) { P.ph_lo = ph; P.ph_hi = ph + 1; hipLaunchKernelGGL(fwd_kernel, dim3(grid), dim3(512), LDS_BYTES, stream, P); }
#endif
    const hipError_t le = hipPeekAtLastError();
    if (le != hipSuccess) fprintf(stderr, "kernel_launch: launch failed: %s\n", hipGetErrorName(le));
}
```

```cpp
#include <hip/hip_runtime.h>
#include <cstdio>
#include <cstdint>

#ifndef MK_FUSED
#define MK_FUSED 1
#endif

#define LAS __attribute__((address_space(3)))
#define GAS __attribute__((address_space(1)))
typedef _Float16 hf;
typedef _Float16 hf2 __attribute__((ext_vector_type(2)));
typedef _Float16 hf4 __attribute__((ext_vector_type(4)));
typedef _Float16 hf8 __attribute__((ext_vector_type(8)));
typedef short s16x4 __attribute__((ext_vector_type(4)));
typedef float f32x2 __attribute__((ext_vector_type(2)));
typedef float f32x4 __attribute__((ext_vector_type(4)));
typedef float f32x16 __attribute__((ext_vector_type(16)));
typedef unsigned u32x2 __attribute__((ext_vector_type(2)));
typedef unsigned u32x4 __attribute__((ext_vector_type(4)));

constexpr int DM = 1024, NB = 32, SEQ = 2048, DEPTH = 4, CTXL = 256, GRIDW = 64;
constexpr int NLAT = NB * SEQ;
constexpr int NCTX = NB * CTXL;
constexpr int MTOT = NLAT + NCTX;
constexpr int D_IN = 5024, NP1 = 2048  , NGATE = 3072, DFF = 4096;
constexpr int C_PQ = 0, C_PKV = 256, C_PKR = 384, C_HY = 416, C_DQ = 1184, C_DK = 1440, C_DV = 1696, C_PG = 1952;
constexpr int NUP = 1792, KUP = 384;
constexpr int NMODV = 33, MODW = 6 * DM;
constexpr float EPS = 1e-6f;
constexpr float MLA_SCALE = 0.10206207261596575f;
constexpr float DF_SCALE = 0.17677669529663687f;

constexpr size_t al256(size_t x) { return (x + 255) / 256 * 256; }
constexpr size_t WS_BAR = 0, WS_BAR_BYTES = 65536;
constexpr size_t WS_SS = WS_BAR + WS_BAR_BYTES;
constexpr int SS_1 = 0, SS_2 = DEPTH, SS_F = 2 * DEPTH, SS_Q = 2 * DEPTH + 1, SS_KV = 3 * DEPTH + 1, SS_N = 4 * DEPTH + 1;
constexpr size_t WS_ZERO_BYTES = WS_BAR_BYTES + al256((size_t)SS_N * MTOT * 4);
constexpr size_t WS_MOD = WS_BAR + WS_ZERO_BYTES;
constexpr size_t WS_GS = WS_MOD + al256((size_t)DEPTH * NMODV * MODW * 4);
constexpr int NBIAS = 9216, B_IN = 0, B_G = 2048, B_FC1 = 5120;
constexpr size_t WS_BIAS = WS_GS + (size_t)DEPTH * 2 * NMODV * DM * 4;
constexpr size_t WS_ROPE = WS_BIAS + (size_t)DEPTH * NMODV * NBIAS * 4;
constexpr size_t WS_LAM = WS_ROPE + (size_t)SEQ * 32 * 4;
constexpr size_t WS_RF = WS_LAM + 256;
constexpr size_t WS_RFC = WS_RF + (size_t)DEPTH * 256 * 4096 * 2;
constexpr size_t WS_X16 = WS_RFC + (size_t)DEPTH * 256 * 512 * 2;
constexpr size_t WS_WT = WS_X16 + (size_t)MTOT * DM * 2;
constexpr size_t W_IN1 = 0, W_ING = W_IN1 + (size_t)NP1 * DM * 2, W_UP = W_ING + (size_t)NGATE * DM * 2, W_BR = W_UP + (size_t)NUP * KUP * 2,
                 W_OUT = W_BR + (size_t)DM * DM * 2, W_FC1 = W_OUT + (size_t)DM * DM * 2, W_FC2 = W_FC1 + (size_t)DFF * DM * 2, W_LAYER = W_FC2 + (size_t)DM * DFF * 2;
constexpr size_t WS_ARENA = WS_WT + 2 * W_LAYER;
constexpr size_t SZ_ROW1024 = (size_t)MTOT * 1024 * 2;
constexpr size_t A_B = WS_ARENA;
constexpr size_t A_C = A_B + SZ_ROW1024;
constexpr size_t A_Y = A_B, A_XS2 = A_B, A_BIG = A_C;
constexpr size_t A_QKVN = A_BIG;
constexpr size_t A_KR = A_QKVN + (size_t)MTOT * KUP * 2;
constexpr size_t A_DQ = A_KR + (size_t)MTOT * 32 * 2;
constexpr size_t A_DK = A_DQ + (size_t)MTOT * 256 * 2;
constexpr size_t A_DV = A_DK + (size_t)MTOT * 256 * 2;
constexpr size_t A_UT = A_DV + (size_t)MTOT * 256 * 2;
constexpr size_t A_X0T = A_UT + (size_t)256 * NLAT * 2;
constexpr size_t A_UTC = A_X0T + (size_t)256 * NLAT * 2;
constexpr size_t A_X0TC = A_UTC + (size_t)256 * NCTX * 2;
constexpr size_t A_PHY = A_X0TC + (size_t)256 * NCTX * 2;
constexpr size_t A_QKV = A_PHY;
constexpr size_t A_BIG_END = A_QKV + (size_t)MTOT * NUP * 2;
constexpr size_t A_G = A_BIG;
constexpr size_t A_HID = A_C;
constexpr size_t WS_END = (A_BIG_END > A_HID + (size_t)MTOT * DFF * 2) ? A_BIG_END : A_HID + (size_t)MTOT * DFF * 2;
static_assert(WS_END <= (size_t)1024 * 1024 * 1024, "workspace map exceeds 1 GiB");

constexpr int LDS_BYTES = 147456;
constexpr int LDS_MISC = LDS_BYTES - 64;

__device__ __forceinline__ unsigned pkh(float lo, float hi) { f32x2 v = {lo, hi}; hf2 h = __builtin_convertvector(v, hf2); return __builtin_bit_cast(unsigned, h); }
__device__ __forceinline__ float wave_sum(float v) {
#pragma unroll
    for (int o = 1; o < 64; o <<= 1) v += __shfl_xor(v, o);
    return v;
}
#define LDS_WAIT() asm volatile("s_waitcnt lgkmcnt(0)" ::: "memory")
#define VM_WAIT() asm volatile("s_waitcnt vmcnt(0)" ::: "memory")

#define XB_TMO      128
#define XB_XCNT(j)  (256  + 64 * (j))
#define XB_XSUB(j)  (1280 + 64 * (j))
#define XB_XGEN(j)  (2304 + 64 * (j))
#define XB_TOP      3328
#define XB_TOPGEN   3392
#define XCD_BAR_WORDS 3456
#define XB_SPIN_CAP (1u << 22)
__device__ __forceinline__ unsigned xb_ld(unsigned* p)              { return __hip_atomic_load(p, __ATOMIC_RELAXED, __HIP_MEMORY_SCOPE_AGENT); }
__device__ __forceinline__ unsigned xb_add(unsigned* p, unsigned v) { return __hip_atomic_fetch_add(p, v, __ATOMIC_RELAXED, __HIP_MEMORY_SCOPE_AGENT); }
__device__ __forceinline__ unsigned xb_xcc_id() { return (unsigned)__builtin_amdgcn_s_getreg((3 << 11) | 20) & 0xFu; }
#define XB_SPIN(cond, bar) do { unsigned _sp = 0; while (cond) { __builtin_amdgcn_s_sleep(1); \
    if ((++_sp & 255u) == 0u) { if (xb_ld(&(bar)[XB_TMO])) break; if (_sp > XB_SPIN_CAP) { atomicAdd(&(bar)[XB_TMO], 1u); break; } } } } while (0)
struct XcdBarrier { unsigned* bar; unsigned x; volatile LAS unsigned* st; };
__device__ __forceinline__ XcdBarrier xcd_barrier_post(unsigned* bar, volatile LAS unsigned* st) {
    XcdBarrier b; b.bar = bar; b.x = xb_xcc_id(); b.st = st;
    if (threadIdx.x == 0) (void)xb_add(&bar[XB_XCNT(b.x)], 1u);
    return b;
}
__device__ __forceinline__ void xcd_barrier_complete(unsigned* bar, unsigned x, unsigned& nloc, unsigned& nx) {
    const unsigned G = gridDim.x * gridDim.y * gridDim.z;
    unsigned sum, cnt, mine, sp = 0u;
    for (;;) {
        sum = 0u; cnt = 0u; mine = 0u;
#pragma unroll
        for (unsigned j = 0; j < 16; ++j) { const unsigned c = xb_ld(&bar[XB_XCNT(j)]); sum += c; cnt += (c > 0u) ? 1u : 0u; mine = (j == x) ? c : mine; }
        if (sum == G) break;
        __builtin_amdgcn_s_sleep(1);
        if ((++sp & 255u) == 0u) { if (xb_ld(&bar[XB_TMO])) break; if (sp > XB_SPIN_CAP) { atomicAdd(&bar[XB_TMO], 1u); break; } }
    }
    nloc = mine > 0u ? mine : 1u; nx = cnt > 0u ? cnt : 1u;
}
__device__ __forceinline__ void xcd_barrier(const XcdBarrier& b) {
    asm volatile("s_waitcnt vmcnt(0)" ::: "memory");
    __syncthreads();
    if (threadIdx.x == 0) {
        unsigned* bar = b.bar;
        __builtin_amdgcn_s_waitcnt(0);
        unsigned nloc = b.st[0], nx = b.st[1];
        if (nloc == 0u) { xcd_barrier_complete(bar, b.x, nloc, nx); b.st[0] = nloc; b.st[1] = nx; }
        const unsigned old = xb_add(&bar[XB_XSUB(b.x)], 1u);
        const unsigned gen = old / nloc;
        if (old + 1u == (gen + 1u) * nloc) {
            __builtin_amdgcn_fence(__ATOMIC_RELEASE, "agent");
            asm volatile("s_waitcnt vmcnt(0)" ::: "memory");
            const unsigned og = xb_add(&bar[XB_TOP], 1u);
            const unsigned tg = og / nx;
            if (og + 1u == (tg + 1u) * nx) xb_add(&bar[XB_TOPGEN], 1u);
            else XB_SPIN(xb_ld(&bar[XB_TOPGEN]) == tg, bar);
            __builtin_amdgcn_fence(__ATOMIC_ACQUIRE, "agent");
            xb_add(&bar[XB_XGEN(b.x)], 1u);
            asm volatile("s_waitcnt vmcnt(0)" ::: "memory");
        } else {
            XB_SPIN(xb_ld(&bar[XB_XGEN(b.x)]) == gen, bar);
            __builtin_amdgcn_fence(__ATOMIC_ACQUIRE, "agent");
            asm volatile("s_waitcnt vmcnt(0)" ::: "memory");
        }
    }
    __syncthreads();
}

namespace pg8 {
constexpr int BM = 256, BK = 64, HALF = 128, HTB = HALF * BK * 2, STAGE_BYTES = 8 * HTB, NXCD = 8, WGM = 8;
__host__ __device__ __forceinline__ int lds_byte(int r, int c) { const int st = (r >> 4) * 2 + (c >> 5), rr = r & 15, cc = c & 31, ob = rr * 64 + cc * 2; return st * 1024 + (ob ^ (((ob >> 9) & 1) << 5)); }
__host__ __device__ __forceinline__ void stage_rc(int b, int& R, int& C) { const int st = b / 1024, sb = b % 1024, swz = sb ^ (((sb >> 9) & 1) << 5); R = (st >> 1) * 16 + swz / 64; C = (st & 1) * 32 + (swz % 64) / 2; }
__host__ __device__ __forceinline__ int perm32(int rho) { const int n = rho >> 4, i = rho & 15; return 8 * (i >> 2) + 4 * n + (i & 3); }
struct Unit { int pm, pn; };
struct Gemm { const hf* A; const hf* Bt; int M, N, K, lda, ldb; };
struct StaticOrder {
    int nM, nN, nwg, G, c;
    __host__ __device__ void init(int M, int N, int G_, int c_) { nM = M / BM; nN = N / BM; nwg = nM * nN; G = G_; c = c_; }
    __host__ __device__ bool next(int i, Unit& u) const {
        const long L = (long)i * G + c; if (L >= nwg) return false;
        int wgid = (int)L; { const int q = nwg / NXCD, r = nwg % NXCD, xcd = wgid % NXCD, off = wgid / NXCD; wgid = (xcd < r ? xcd * (q + 1) : r * (q + 1) + (xcd - r) * q) + off; }
        const int nig = WGM * nN, gid = wgid / nig, fm = gid * WGM, gsz = (nM - fm) < WGM ? (nM - fm) : WGM;
        u.pm = fm + ((wgid % nig) % gsz); u.pn = (wgid % nig) / gsz; return true;
    }
    __device__ __forceinline__ void a_ready(const Unit&) const {}
    __device__ __forceinline__ void done(const Unit&) const {}
};

template <int ACT  , bool NORM> struct EpiHalf {
    static constexpr bool PERM = true, AFTER_DRAIN = false, PROBE2 = false, MIDK = false;
    hf* O; int ldc; const float* ss; const float* bias;
    __device__ __forceinline__ void operator()(const f32x4 (&acc)[2][2][4][2], const Unit& u, int wr, int wc, int fr, int fq) const {
        const int row0 = u.pm * BM + wr * 64 + fr, col0 = u.pn * BM + wc * 32 + 8 * fq;
        f32x4 bv[2][2];
        if (NORM) { const int R0 = u.pm * BM; const int v = (R0 < NLAT) ? (R0 >> 11) : NB; const float* bp = bias + (size_t)v * NBIAS + col0;
#pragma unroll
            for (int bj = 0; bj < 2; ++bj)
#pragma unroll
                for (int n = 0; n < 2; ++n) bv[bj][n] = *(const f32x4*)(bp + bj * HALF + 4 * n); }
#pragma unroll
        for (int ai = 0; ai < 2; ++ai)
#pragma unroll
            for (int m = 0; m < 4; ++m) { const int r = row0 + ai * HALF + m * 16; hf* rowp = O + (size_t)r * ldc + col0;
                float rs = 1.f; if (NORM) rs = rsqrtf(ss[r] * (1.f / DM) + EPS);
#pragma unroll
                for (int bj = 0; bj < 2; ++bj) { f32x4 v0 = acc[ai][bj][m][0], v1 = acc[ai][bj][m][1];
                    if (NORM) { v0 = v0 * rs + bv[bj][0]; v1 = v1 * rs + bv[bj][1]; }
                    if (ACT == 1) {
#pragma unroll
                        for (int e = 0; e < 4; ++e) { v0[e] = __builtin_amdgcn_rcpf(1.f + __builtin_amdgcn_exp2f(-1.4426950408889634f * v0[e])); v1[e] = __builtin_amdgcn_rcpf(1.f + __builtin_amdgcn_exp2f(-1.4426950408889634f * v1[e])); } }
                    if (ACT == 2) {
#pragma unroll
                        for (int e = 0; e < 4; ++e) { const float a = fmaxf(v0[e], 0.f), b = fmaxf(v1[e], 0.f); v0[e] = a * a; v1[e] = b * b; } }
                    u32x4 w; w.x = pkh(v0[0], v0[1]); w.y = pkh(v0[2], v0[3]); w.z = pkh(v1[0], v1[1]); w.w = pkh(v1[2], v1[3]);
                    *(u32x4*)(rowp + bj * HALF) = w; } }
    }
};
struct EpiGate8 {
    static constexpr bool PERM = true, AFTER_DRAIN = false, PROBE2 = false, MIDK = false;
    unsigned char* O; const float* ss; const float* bias;
    __device__ __forceinline__ void operator()(const f32x4 (&acc)[2][2][4][2], const Unit& u, int wr, int wc, int fr, int fq) const {
        const int R0 = u.pm * BM, row0 = R0 + wr * 64 + fr, col0 = u.pn * BM + wc * 32 + 8 * fq;
        const int v = (R0 < NLAT) ? (R0 >> 11) : NB; const float* bp = bias + (size_t)v * NBIAS + col0;
        f32x4 bv[2][2];
#pragma unroll
        for (int bj = 0; bj < 2; ++bj) { bv[bj][0] = *(const f32x4*)(bp + bj * HALF); bv[bj][1] = *(const f32x4*)(bp + bj * HALF + 4); }
#pragma unroll
        for (int ai = 0; ai < 2; ++ai)
#pragma unroll
            for (int m = 0; m < 4; ++m) { const int r = row0 + ai * HALF + m * 16; const float rs = rsqrtf(ss[r] * (1.f / DM) + EPS);
#pragma unroll
                for (int bj = 0; bj < 2; ++bj) { const f32x4 v0 = acc[ai][bj][m][0] * rs + bv[bj][0], v1 = acc[ai][bj][m][1] * rs + bv[bj][1];
                    unsigned q[8];
#pragma unroll
                    for (int e = 0; e < 4; ++e) { const float g0 = __builtin_amdgcn_rcpf(1.f + __builtin_amdgcn_exp2f(-1.4426950408889634f * v0[e])), g1 = __builtin_amdgcn_rcpf(1.f + __builtin_amdgcn_exp2f(-1.4426950408889634f * v1[e]));
                        q[e] = (unsigned)fmaxf(1.f, __builtin_rintf(255.f * g0)); q[4 + e] = (unsigned)fmaxf(1.f, __builtin_rintf(255.f * g1)); }
                    u32x2 w; w.x = q[0] | (q[1] << 8) | (q[2] << 16) | (q[3] << 24); w.y = q[4] | (q[5] << 8) | (q[6] << 16) | (q[7] << 24);
                    *(u32x2*)(O + (size_t)r * NGATE + col0 + bj * HALF) = w; } }
    }
};
struct EpiIn {
    static constexpr bool PERM = true, AFTER_DRAIN = false, PROBE2 = false, MIDK = false;
    hf* QKVNo; hf* KRo; hf* PHYo; hf* DQo; hf* DKo; hf* DVo; const float* ss; const float* bias; float* ssq; float* sskv;
    __device__ __forceinline__ void operator()(const f32x4 (&acc)[2][2][4][2], const Unit& u, int wr, int wc, int fr, int fq) const {
        const int R0 = u.pm * BM, row0 = R0 + wr * 64 + fr, col0 = u.pn * BM + wc * 32 + 8 * fq;
        const int v = (R0 < NLAT) ? (R0 >> 11) : NB; const float* bp = bias + (size_t)v * NBIAS + col0;
        f32x4 bv[2][2]; hf* dst[2]; int ld[2];
#pragma unroll
        for (int bj = 0; bj < 2; ++bj) { const int c8 = col0 + bj * HALF;
            bv[bj][0] = *(const f32x4*)(bp + bj * HALF); bv[bj][1] = *(const f32x4*)(bp + bj * HALF + 4);
            if (c8 < C_PKR) { dst[bj] = QKVNo + c8; ld[bj] = KUP; }
            else if (c8 < C_HY) { dst[bj] = KRo + (c8 - C_PKR); ld[bj] = 32; }
            else if (c8 < C_DQ) { dst[bj] = PHYo + (c8 - C_HY); ld[bj] = 768; }
            else if (c8 < C_DK) { dst[bj] = DQo + (c8 - C_DQ); ld[bj] = 256; }
            else if (c8 < C_DV) { dst[bj] = DKo + (c8 - C_DK); ld[bj] = 256; }
            else if (c8 < C_PG) { dst[bj] = DVo + (c8 - C_DV); ld[bj] = 256; }
            else { dst[bj] = nullptr; ld[bj] = 0; } }
        const int nstat = (u.pn == 0) ? 2 : (u.pn == 1 ? 1 : 0);
        float* sp = (u.pn == 0) ? ssq : sskv;
#pragma unroll
        for (int ai = 0; ai < 2; ++ai)
#pragma unroll
            for (int m = 0; m < 4; ++m) { const int r = row0 + ai * HALF + m * 16; const float rs = rsqrtf(ss[r] * (1.f / DM) + EPS); float sq = 0.f;
#pragma unroll
                for (int bj = 0; bj < 2; ++bj) { const f32x4 v0 = acc[ai][bj][m][0] * rs + bv[bj][0], v1 = acc[ai][bj][m][1] * rs + bv[bj][1];
                    if (bj < nstat) sq += (v0[0] * v0[0] + v0[1] * v0[1]) + (v0[2] * v0[2] + v0[3] * v0[3]) + (v1[0] * v1[0] + v1[1] * v1[1]) + (v1[2] * v1[2] + v1[3] * v1[3]);
                    if (dst[bj]) { u32x4 w; w.x = pkh(v0[0], v0[1]); w.y = pkh(v0[2], v0[3]); w.z = pkh(v1[0], v1[1]); w.w = pkh(v1[2], v1[3]); *(u32x4*)(dst[bj] + (size_t)r * ld[bj]) = w; } }
                if (nstat) { sq += __shfl_xor(sq, 16); sq += __shfl_xor(sq, 32);
                    if (fq == 0) (void)__hip_atomic_fetch_add(sp + r, sq, __ATOMIC_RELAXED, __HIP_MEMORY_SCOPE_AGENT); } }
    }
};
struct EpiUp {
    static constexpr bool PERM = true, AFTER_DRAIN = false, PROBE2 = false, MIDK = false;
    hf* O; const float* ssq; const float* sskv;
    __device__ __forceinline__ void operator()(const f32x4 (&acc)[2][2][4][2], const Unit& u, int wr, int wc, int fr, int fq) const {
        const int row0 = u.pm * BM + wr * 64 + fr, col0 = u.pn * BM + wc * 32 + 8 * fq;
        const bool isq = u.pn < 3; const float* sp = isq ? ssq : sskv; const float invn = isq ? (1.f / 256.f) : (1.f / 128.f);
#pragma unroll
        for (int ai = 0; ai < 2; ++ai)
#pragma unroll
            for (int m = 0; m < 4; ++m) { const int r = row0 + ai * HALF + m * 16; hf* rowp = O + (size_t)r * NUP + col0; const float rs = rsqrtf(sp[r] * invn + EPS);
#pragma unroll
                for (int bj = 0; bj < 2; ++bj) { const f32x4 v0 = acc[ai][bj][m][0] * rs, v1 = acc[ai][bj][m][1] * rs;
                    u32x4 w; w.x = pkh(v0[0], v0[1]); w.y = pkh(v0[2], v0[3]); w.z = pkh(v1[0], v1[1]); w.w = pkh(v1[2], v1[3]);
                    *(u32x4*)(rowp + bj * HALF) = w; } }
    }
};
template <bool FIRST> struct EpiGated {
    static constexpr bool PERM = true, AFTER_DRAIN = false, PROBE2 = false, MIDK = false;
    hf* MMo; const hf* G; int goff;
    __device__ __forceinline__ void operator()(const f32x4 (&acc)[2][2][4][2], const Unit& u, int wr, int wc, int fr, int fq) const {
        const int row0 = u.pm * BM + wr * 64 + fr, col0 = u.pn * BM + wc * 32 + 8 * fq;
#pragma unroll
        for (int ai = 0; ai < 2; ++ai)
#pragma unroll
            for (int m = 0; m < 4; ++m) { const size_t r = (size_t)(row0 + ai * HALF + m * 16);
#pragma unroll
                for (int bj = 0; bj < 2; ++bj) { const f32x4 v0 = acc[ai][bj][m][0], v1 = acc[ai][bj][m][1];
                    const hf8 g = *(const hf8*)(G + r * NGATE + goff + col0 + bj * HALF);
                    hf* mp = MMo + r * DM + col0 + bj * HALF;
                    float o[8];
#pragma unroll
                    for (int e = 0; e < 4; ++e) { o[e] = (float)g[e] * v0[e]; o[4 + e] = (float)g[4 + e] * v1[e]; }
                    if (!FIRST) { const hf8 p = *(const hf8*)mp;
#pragma unroll
                        for (int e = 0; e < 8; ++e) o[e] += (float)p[e]; }
                    u32x4 w; w.x = pkh(o[0], o[1]); w.y = pkh(o[2], o[3]); w.z = pkh(o[4], o[5]); w.w = pkh(o[6], o[7]);
                    *(u32x4*)mp = w; } }
    }
};
struct EpiMerge {
    static constexpr bool PERM = true, AFTER_DRAIN = false, PROBE2 = false, MIDK = true;
    static constexpr int MID1 = 8, MID2 = 12;
    hf* MMo; const unsigned char* G;
    __device__ __forceinline__ void mid(f32x4 (&acc)[2][2][4][2], const Unit& u, int which, int wr, int wc, int fr, int fq) const {
        asm volatile("" : "+v"(fr), "+v"(fq));
        const int row0 = u.pm * BM + wr * 64 + fr, col0 = u.pn * BM + wc * 32 + 8 * fq; const int gnum = which ? 1024 : 0, gden = which ? 2048 : 1024;
#pragma unroll
        for (int ai = 0; ai < 2; ++ai) {
            u32x2 gn[4][2], gd[4][2];
#pragma unroll
            for (int m = 0; m < 4; ++m) { const unsigned char* gr = G + (size_t)(row0 + ai * HALF + m * 16) * NGATE + col0;
#pragma unroll
                for (int bj = 0; bj < 2; ++bj) { gn[m][bj] = *(const u32x2*)(gr + gnum + bj * HALF); gd[m][bj] = *(const u32x2*)(gr + gden + bj * HALF); } }
#pragma unroll
            for (int m = 0; m < 4; ++m)
#pragma unroll
                for (int bj = 0; bj < 2; ++bj)
#pragma unroll
                    for (int e = 0; e < 4; ++e) {
                        acc[ai][bj][m][0][e] *= (float)((gn[m][bj].x >> (8 * e)) & 255u) * __builtin_amdgcn_rcpf((float)((gd[m][bj].x >> (8 * e)) & 255u));
                        acc[ai][bj][m][1][e] *= (float)((gn[m][bj].y >> (8 * e)) & 255u) * __builtin_amdgcn_rcpf((float)((gd[m][bj].y >> (8 * e)) & 255u)); }
            asm volatile("" ::: "memory");
        }
    }
    __device__ __forceinline__ void operator()(const f32x4 (&acc)[2][2][4][2], const Unit& u, int wr, int wc, int fr, int fq) const {
        const int row0 = u.pm * BM + wr * 64 + fr, col0 = u.pn * BM + wc * 32 + 8 * fq;
#pragma unroll
        for (int ai = 0; ai < 2; ++ai)
#pragma unroll
            for (int m = 0; m < 4; ++m) { const size_t r = (size_t)(row0 + ai * HALF + m * 16);
#pragma unroll
                for (int bj = 0; bj < 2; ++bj) { const f32x4 v0 = acc[ai][bj][m][0], v1 = acc[ai][bj][m][1];
                    const u32x2 g = *(const u32x2*)(G + r * NGATE + 2048 + col0 + bj * HALF);
                    float o[8];
#pragma unroll
                    for (int e = 0; e < 4; ++e) { o[e] = (float)((g.x >> (8 * e)) & 255u) * (1.f / 255.f) * v0[e]; o[4 + e] = (float)((g.y >> (8 * e)) & 255u) * (1.f / 255.f) * v1[e]; }
                    u32x4 w; w.x = pkh(o[0], o[1]); w.y = pkh(o[2], o[3]); w.z = pkh(o[4], o[5]); w.w = pkh(o[6], o[7]);
                    *(u32x4*)(MMo + r * DM + col0 + bj * HALF) = w; } }
    }
};
template <bool XS, bool STAT> struct EpiResidX {
    static constexpr bool PERM = true, AFTER_DRAIN = false, PROBE2 = false, MIDK = false;
    hf* x16; const float* gate;
    hf* xsout; const float* gs; float* ss;
    __device__ __forceinline__ void operator()(const f32x4 (&acc)[2][2][4][2], const Unit& u, int wr, int wc, int fr, int fq) const {
        const int R0 = u.pm * BM; const int v = (R0 < NLAT) ? (R0 >> 11) : NB;
        const int rglob = R0 + wr * 64 + fr, col0 = u.pn * BM + wc * 32 + 8 * fq;
        const float* gp = gate + (size_t)v * MODW + col0; const float* gsp = gs + (size_t)v * DM + col0;
        float sq[2][4];
#pragma unroll
        for (int ai = 0; ai < 2; ++ai)
#pragma unroll
            for (int m = 0; m < 4; ++m) sq[ai][m] = 0.f;
#pragma unroll
        for (int bj = 0; bj < 2; ++bj) {
            const f32x4 g0 = *(const f32x4*)(gp + bj * HALF), g1 = *(const f32x4*)(gp + bj * HALF + 4);
            f32x4 s0 = {1.f, 1.f, 1.f, 1.f}, s1 = s0; if (XS) { s0 = *(const f32x4*)(gsp + bj * HALF); s1 = *(const f32x4*)(gsp + bj * HALF + 4); }
#pragma unroll
            for (int ai = 0; ai < 2; ++ai)
#pragma unroll
                for (int m = 0; m < 4; ++m) { const int rr = ai * HALF + m * 16; const size_t off = (size_t)(rglob + rr) * DM + col0 + bj * HALF;
                    const hf8 xv = *(const hf8*)(x16 + off);
                    const f32x4 x0 = {(float)xv[0], (float)xv[1], (float)xv[2], (float)xv[3]}, x1 = {(float)xv[4], (float)xv[5], (float)xv[6], (float)xv[7]};
                    const f32x4 n0 = x0 + g0 * acc[ai][bj][m][0], n1 = x1 + g1 * acc[ai][bj][m][1];
                    { u32x4 w; w.x = pkh(n0[0], n0[1]); w.y = pkh(n0[2], n0[3]); w.z = pkh(n1[0], n1[1]); w.w = pkh(n1[2], n1[3]); *(u32x4*)(x16 + off) = w; }
                    if (STAT) sq[ai][m] += (n0[0] * n0[0] + n0[1] * n0[1]) + (n0[2] * n0[2] + n0[3] * n0[3]) + (n1[0] * n1[0] + n1[1] * n1[1]) + (n1[2] * n1[2] + n1[3] * n1[3]);
                    if (XS) { const f32x4 a = n0 * s0, b = n1 * s1; u32x4 w; w.x = pkh(a[0], a[1]); w.y = pkh(a[2], a[3]); w.z = pkh(b[0], b[1]); w.w = pkh(b[2], b[3]);
                        *(u32x4*)(xsout + off) = w; } }
        }
        if (STAT) {
#pragma unroll
            for (int ai = 0; ai < 2; ++ai)
#pragma unroll
                for (int m = 0; m < 4; ++m) { float t = sq[ai][m]; t += __shfl_xor(t, 16); t += __shfl_xor(t, 32);
                    if (fq == 0) (void)__hip_atomic_fetch_add(ss + rglob + ai * HALF + m * 16, t, __ATOMIC_RELAXED, __HIP_MEMORY_SCOPE_AGENT); }
        }
    }
};

template <class Epi, class Sched, bool ALIGN_EPI = true>
__device__ __forceinline__ void gemm_phase(LAS unsigned char* lds, const Gemm g, const Sched& S, const Epi& E) {
    int tid = threadIdx.x; asm volatile("" : "+v"(tid));
    const int wid = __builtin_amdgcn_readfirstlane(tid >> 6), lane = tid & 63, wr = wid >> 2, wc = wid & 3, fr = lane & 15, fq = lane >> 4;
    const int K = g.K, nt = K / BK;
    unsigned voffA[2], voffB[2];
#pragma unroll
    for (int i = 0; i < 2; ++i) { int R, C; stage_rc(tid * 16 + i * 8192, R, C); const int Rb = Epi::PERM ? ((R & ~31) + perm32(R & 31)) : R;
        voffA[i] = (unsigned)(R * g.lda + C) * 2u; voffB[i] = (unsigned)(Rb * g.ldb + C) * 2u; }
    const size_t kstep = (size_t)(BK * 2);
    const size_t hstepA = (size_t)HALF * g.lda * 2, hstepB = (size_t)HALF * g.ldb * 2;
    const size_t tstepA = 2 * hstepA, tstepB = 2 * hstepB;
    const unsigned ldsw = (unsigned)wid * 1024u;
    const int aoff = lds_byte(wr * 64 + fr, fq * 8), boff = lds_byte(wc * 32 + fr, fq * 8);
#define PG8_SA(b, h) (((b) * 2 + (h)) * HTB)
#define PG8_SB(b, h) ((4 + (b) * 2 + (h)) * HTB)
#define PG8_STAGE(bufoff, gbase, voff) do { _Pragma("unroll") for (int _i = 0; _i < 2; ++_i) \
        __builtin_amdgcn_global_load_lds((const unsigned*)((const char*)(gbase) + (voff)[_i]), (LAS unsigned*)(lds + (bufoff) + ldsw + _i * 8192), 16, 0, 0); } while (0)
#define PG8_LDA(dst, b, h) do { _Pragma("unroll") for (int m = 0; m < 4; ++m) _Pragma("unroll") for (int k = 0; k < 2; ++k) dst[m][k] = *(const LAS hf8*)(lds + PG8_SA(b, h) + aoff + m * 2048 + k * 1024); } while (0)
#define PG8_LDB(dst, b, h) do { _Pragma("unroll") for (int n = 0; n < 2; ++n) _Pragma("unroll") for (int k = 0; k < 2; ++k) dst[n][k] = *(const LAS hf8*)(lds + PG8_SB(b, h) + boff + n * 2048 + k * 1024); } while (0)
#define PG8_MMA(ai, bj, At, Bt) do { __builtin_amdgcn_s_setprio(1); _Pragma("unroll") for (int m = 0; m < 4; ++m) _Pragma("unroll") for (int n = 0; n < 2; ++n) _Pragma("unroll") for (int k = 0; k < 2; ++k) \
        acc[ai][bj][m][n] = __builtin_amdgcn_mfma_f32_16x16x32_f16(Bt[n][k], At[m][k], acc[ai][bj][m][n], 0, 0, 0); __builtin_amdgcn_s_setprio(0); } while (0)
#define PG8_WAIT_V(n) asm volatile("s_waitcnt vmcnt(" #n ")" ::: "memory")
#define PG8_WAIT_L(n) asm volatile("s_waitcnt lgkmcnt(" #n ")" ::: "memory")
#define PG8_BAR __builtin_amdgcn_s_barrier()
#define PG8_SCHED __builtin_amdgcn_sched_barrier(0)
    Unit cur, nxt; int ui = 0;
    if (!S.next(0, cur)) return;
    f32x4 acc[2][2][4][2];
#pragma unroll
    for (int a = 0; a < 2; ++a)
#pragma unroll
        for (int b = 0; b < 2; ++b)
#pragma unroll
            for (int m = 0; m < 4; ++m)
#pragma unroll
                for (int n = 0; n < 2; ++n) acc[a][b][m][n] = (f32x4){0.f, 0.f, 0.f, 0.f};
    hf8 At[4][2], B0[2][2], B1[2][2];
    const char* cA = (const char*)g.A + (size_t)cur.pm * tstepA; const char* cB = (const char*)g.Bt + (size_t)cur.pn * tstepB;
    S.a_ready(cur);
    PG8_STAGE(PG8_SB(0, 0), cB, voffB); PG8_STAGE(PG8_SB(0, 1), cB + hstepB, voffB); PG8_STAGE(PG8_SA(0, 0), cA, voffA); PG8_STAGE(PG8_SA(0, 1), cA + hstepA, voffA);
    if (wr == 1) PG8_BAR;
    PG8_WAIT_V(2); PG8_BAR;
    PG8_STAGE(PG8_SB(1, 0), cB + kstep, voffB); PG8_STAGE(PG8_SA(1, 0), cA + kstep, voffA); PG8_STAGE(PG8_SB(1, 1), cB + hstepB + kstep, voffB);
    PG8_WAIT_V(6); PG8_BAR;
    for (;;) {
        const bool has_next = S.next(ui + 1, nxt);
        const char* nA = has_next ? (const char*)g.A + (size_t)nxt.pm * tstepA : cA; const char* nB = has_next ? (const char*)g.Bt + (size_t)nxt.pn * tstepB : cB;
#pragma unroll 1
        for (int t = 0; t < nt; t += 2) {
            const bool last = (t == nt - 2);
            const char* a1 = cA + (size_t)(t + 1) * kstep;
            const char* a2 = last ? nA : cA + (size_t)(t + 2) * kstep; const char* b2 = last ? nB : cB + (size_t)(t + 2) * kstep;
            const char* a3 = a2 + kstep; const char* b3 = b2 + kstep;
            if (last && has_next) S.a_ready(nxt);
            if constexpr (Epi::MIDK) { if (t == Epi::MID1 || t == Epi::MID2) E.mid(acc, cur, t == Epi::MID1 ? 0 : 1, wr, wc, fr, fq); }
            PG8_LDB(B0, 0, 0); PG8_LDB(B1, 0, 1); PG8_SCHED; PG8_LDA(At, 0, 0); PG8_STAGE(PG8_SA(1, 1), a1 + hstepA, voffA);
            PG8_WAIT_V(8); PG8_WAIT_L(0); PG8_BAR; PG8_MMA(0, 0, At, B0); PG8_MMA(0, 1, At, B1); PG8_BAR; PG8_SCHED;
            PG8_LDA(At, 0, 1); PG8_STAGE(PG8_SB(0, 0), b2, voffB); PG8_STAGE(PG8_SB(0, 1), b2 + hstepB, voffB); PG8_STAGE(PG8_SA(0, 0), a2, voffA);
            PG8_WAIT_V(8); PG8_WAIT_L(0); PG8_BAR; PG8_MMA(1, 0, At, B0); PG8_MMA(1, 1, At, B1); PG8_BAR; PG8_SCHED;
            PG8_LDB(B0, 1, 0); PG8_LDB(B1, 1, 1); PG8_SCHED; PG8_LDA(At, 1, 0); PG8_STAGE(PG8_SA(0, 1), a2 + hstepA, voffA);
            PG8_WAIT_V(8); PG8_WAIT_L(0); PG8_BAR; PG8_MMA(0, 0, At, B0); PG8_MMA(0, 1, At, B1); PG8_BAR; PG8_SCHED;
            PG8_LDA(At, 1, 1); PG8_STAGE(PG8_SB(1, 0), b3, voffB); PG8_STAGE(PG8_SB(1, 1), b3 + hstepB, voffB); PG8_STAGE(PG8_SA(1, 0), a3, voffA);
            PG8_WAIT_V(8); PG8_WAIT_L(0); PG8_BAR; PG8_MMA(1, 0, At, B0); PG8_MMA(1, 1, At, B1); PG8_BAR; PG8_SCHED;
        }
        if constexpr (ALIGN_EPI) { if (wr == 0) PG8_BAR; }
        E(acc, cur, wr, wc, fr, fq); S.done(cur);
#ifdef PROBE_EPI2
        if (Epi::PROBE2) { asm volatile("" ::: "memory"); E(acc, cur, wr, wc, fr, fq); }
#endif
        if (!has_next) break;
#pragma unroll
        for (int a = 0; a < 2; ++a)
#pragma unroll
            for (int b = 0; b < 2; ++b)
#pragma unroll
                for (int m = 0; m < 4; ++m)
#pragma unroll
                    for (int n = 0; n < 2; ++n) acc[a][b][m][n] = (f32x4){0.f, 0.f, 0.f, 0.f};
        cur = nxt; cA = nA; cB = nB; ++ui;
        if constexpr (ALIGN_EPI) { if (wr == 1) PG8_BAR; }
    }
    PG8_WAIT_V(0);
    if constexpr (!ALIGN_EPI) { if (wr == 0) PG8_BAR; }
    PG8_BAR;
#undef PG8_SA
#undef PG8_SB
#undef PG8_STAGE
#undef PG8_LDA
#undef PG8_LDB
#undef PG8_MMA
#undef PG8_WAIT_V
#undef PG8_WAIT_L
#undef PG8_BAR
#undef PG8_SCHED
}
}

struct Params {
    const float* in[35];
    float* out;
    unsigned char* ws;
    int ph_lo, ph_hi;
};
enum { I_X = 0, I_C, I_CTX, I_CCTX, I_NMG, I_NFG, I_WMOD, I_BMOD, I_WIN, I_QNG, I_WUQ, I_KVNG, I_WUKV, I_HCW, I_HCB, I_HW1, I_HB1, I_HFREQ, I_HW2, I_HB2, I_HW3, I_HB3,
       I_HSKIP, I_LQ1, I_LK1, I_LQ2, I_LK2, I_SUBG, I_WBRA, I_WBRB, I_WBRC, I_WOUT, I_FC1, I_FC2, I_FNG };

struct Frame {
    LAS unsigned char* lds;
    int tid, lane, wave, vcu, G;
};

__device__ __forceinline__ void tr_item(const float* W, int ldw, hf* WT, int ldt, int nblk, LAS float* scr, int item, int lane, const float* kgain = nullptr) {
    const int kb = item / nblk, nb = item % nblk, k0 = 64 * kb, n0 = 32 * nb;
#pragma unroll 8
    for (int i = 0; i < 32; ++i) { const int kk = 2 * i + (lane >> 5); const float gk = kgain ? kgain[k0 + kk] : 1.f; scr[kk * 33 + (lane & 31)] = W[(size_t)(k0 + kk) * ldw + n0 + (lane & 31)] * gk; }
    LDS_WAIT(); asm volatile("" ::: "memory");
    const int c = lane & 7;
#pragma unroll
    for (int j = 0; j < 4; ++j) { const int n = (lane >> 3) + 8 * j; const LAS float* s = scr + (8 * c) * 33 + n;
        u32x4 o; o.x = pkh(s[0 * 33], s[1 * 33]); o.y = pkh(s[2 * 33], s[3 * 33]); o.z = pkh(s[4 * 33], s[5 * 33]); o.w = pkh(s[6 * 33], s[7 * 33]);
        *(u32x4*)(WT + (size_t)(n0 + n) * ldt + k0 + 8 * c) = o; }
    LDS_WAIT(); asm volatile("" ::: "memory");
}
__device__ __forceinline__ float silu_f(float x) { return x / (1.f + expf(-x)); }

__device__ __forceinline__ void mod_phase(const Frame& F, const Params& p) {
    float* MOD = (float*)(p.ws + WS_MOD);
    LAS float* sv = (LAS float*)F.lds;
    constexpr int NCB = DEPTH * MODW / 512;
    for (int item = F.vcu; item < NCB * 3; item += F.G) {
        const int cb = item / 3, vg = item % 3;
        __syncthreads();
        for (int i = F.tid; i < 11 * 1024; i += 512) { const int v = vg * 11 + i / 1024, k = i % 1024;
            const float c = (v < NB) ? p.in[I_C][v * DM + k] : p.in[I_CCTX][k]; sv[i] = silu_f(c); }
        __syncthreads();
        const int gcol = cb * 512 + F.tid, l = gcol / MODW, n = gcol % MODW;
        const float* w = p.in[I_WMOD] + (size_t)l * DM * MODW + n;
        float acc[11];
#pragma unroll
        for (int v = 0; v < 11; ++v) acc[v] = 0.f;
#pragma unroll 4
        for (int k = 0; k < DM; k += 4) {
            const float w0 = w[(size_t)k * MODW], w1 = w[(size_t)(k + 1) * MODW], w2 = w[(size_t)(k + 2) * MODW], w3 = w[(size_t)(k + 3) * MODW];
#pragma unroll
            for (int v = 0; v < 11; ++v) { const f32x4 s = *(const LAS f32x4*)(sv + v * 1024 + k);
                acc[v] = fmaf(s[0], w0, acc[v]); acc[v] = fmaf(s[1], w1, acc[v]); acc[v] = fmaf(s[2], w2, acc[v]); acc[v] = fmaf(s[3], w3, acc[v]); }
        }
        const float bm = p.in[I_BMOD][(size_t)l * MODW + n];
#pragma unroll
        for (int v = 0; v < 11; ++v) MOD[((size_t)l * NMODV + vg * 11 + v) * MODW + n] = acc[v] + bm;
    }
    __syncthreads();
}

__device__ __forceinline__ void filt_item(const Params& p, int l, int kind  , int t, int lane) {
    const int L = kind ? CTXL : SEQ;
    hf* R = kind ? (hf*)(p.ws + WS_RFC) + (size_t)l * 256 * 512 : (hf*)(p.ws + WS_RF) + (size_t)l * 256 * 4096;
    const int rl = 2 * L;
    const float tl = (float)t / (float)(L - 1);
    const float wt = (6.283185307179586f / (float)L) * (float)t;
    float z = 0.f;
    if (lane == 0) z = tl;
    else if (lane <= 32) { const int bi = (lane - 1) & 15; const float band = 1e-4f + (15.f - 1e-4f) * ((float)bi / 15.f); const float a = band * wt; z = (lane <= 16) ? cosf(a) : -sinf(a); }
    const float* w1 = p.in[I_HW1] + (size_t)l * 33 * 64; const float* w2 = p.in[I_HW2] + (size_t)l * 64 * 64; const float* w3 = p.in[I_HW3] + (size_t)l * 64 * 512;
    const float fr = p.in[I_HFREQ][l * 64 + lane];
    float a1 = p.in[I_HB1][l * 64 + lane];
    for (int i = 0; i < 33; ++i) a1 = fmaf(__shfl(z, i), w1[i * 64 + lane], a1);
    a1 = sinf(fr * a1);
    float a2 = p.in[I_HB2][l * 64 + lane];
    for (int i = 0; i < 64; ++i) a2 = fmaf(__shfl(a1, i), w2[i * 64 + lane], a2);
    a2 = sinf(fr * a2);
    float h[8];
#pragma unroll
    for (int q = 0; q < 8; ++q) h[q] = p.in[I_HB3][l * 512 + q * 64 + lane];
    for (int i = 0; i < 64; ++i) { const float a = __shfl(a2, i);
#pragma unroll
        for (int q = 0; q < 8; ++q) h[q] = fmaf(a, w3[i * 512 + q * 64 + lane], h[q]); }
    const float d0 = -4.605170185988091f / 1.5f, d1 = -4.605170185988091f / 0.3f;
#pragma unroll
    for (int q = 0; q < 8; ++q) { const int o = q * 64 + lane, dir = o >> 8, c = o & 255;
        const float delta = fabsf(d0 + (d1 - d0) * ((float)c / 255.f));
        float val = h[q] * (expf(-tl * delta) + 0.05f);
        if (dir == 0) { if (t == 0) val += p.in[I_HSKIP][l * 256 + c]; R[(size_t)c * rl + (L - t)] = (hf)val; if (t == 0) R[(size_t)c * rl] = (hf)0.f; }
        else if (t >= 1) R[(size_t)c * rl + (L + t)] = (hf)val; }
}

__device__ __forceinline__ void convert_layer(const Frame& F, const Params& p, int l, unsigned char* wl) {
    LAS float* scr = (LAS float*)(F.lds + F.wave * 16384);
    const int gw = F.vcu * 8 + F.wave, NGW = F.G * 8, lane = F.lane;
    constexpr int IT_IN1 = 16 * 61, IT_ING = 16 * 96, IT_UQ = 4 * 24, IT_UKV = 2 * 32, IT_BRA = 8 * 32, IT_BRB = 4 * 32, IT_BRC = 4 * 32, IT_OUT = 16 * 32, IT_FC1 = 16 * 128, IT_FC2 = 64 * 32;
    constexpr int IT_LAYER = IT_IN1 + IT_ING + IT_UQ + IT_UKV + IT_BRA + IT_BRB + IT_BRC + IT_OUT + IT_FC1 + IT_FC2;
    for (int it = gw; it < IT_LAYER; it += NGW) {
        int r = it;
        if (r < IT_IN1) { tr_item(p.in[I_WIN] + (size_t)l * DM * D_IN, D_IN, (hf*)(wl + W_IN1), DM, 61, scr, r, lane); continue; } r -= IT_IN1;
        if (r < IT_ING) { tr_item(p.in[I_WIN] + (size_t)l * DM * D_IN + C_PG, D_IN, (hf*)(wl + W_ING), DM, 96, scr, r, lane); continue; } r -= IT_ING;
        if (r < IT_UQ) { tr_item(p.in[I_WUQ] + (size_t)l * 256 * 768, 768, (hf*)(wl + W_UP), KUP, 24, scr, r, lane, p.in[I_QNG] + l * 256); continue; } r -= IT_UQ;
        if (r < IT_UKV) { tr_item(p.in[I_WUKV] + (size_t)l * 128 * 1024, 1024, (hf*)(wl + W_UP) + (size_t)768 * KUP + 256, KUP, 32, scr, r, lane, p.in[I_KVNG] + l * 128); continue; } r -= IT_UKV;
        if (r < IT_BRA) { tr_item(p.in[I_WBRA] + (size_t)l * 512 * DM, DM, (hf*)(wl + W_BR), DM, 32, scr, r, lane); continue; } r -= IT_BRA;
        if (r < IT_BRB) { tr_item(p.in[I_WBRB] + (size_t)l * 256 * DM, DM, (hf*)(wl + W_BR) + 512, DM, 32, scr, r, lane); continue; } r -= IT_BRB;
        if (r < IT_BRC) { tr_item(p.in[I_WBRC] + (size_t)l * 256 * DM, DM, (hf*)(wl + W_BR) + 768, DM, 32, scr, r, lane); continue; } r -= IT_BRC;
        if (r < IT_OUT) { tr_item(p.in[I_WOUT] + (size_t)l * DM * DM, DM, (hf*)(wl + W_OUT), DM, 32, scr, r, lane); continue; } r -= IT_OUT;
        if (r < IT_FC1) { tr_item(p.in[I_FC1] + (size_t)l * DM * DFF, DFF, (hf*)(wl + W_FC1), DM, 128, scr, r, lane); continue; } r -= IT_FC1;
        tr_item(p.in[I_FC2] + (size_t)l * DFF * DM, DM, (hf*)(wl + W_FC2), DFF, 32, scr, r, lane);
    }
    const int gt = gw * 64 + lane, NGT = NGW * 64;
    u32x4* z1 = (u32x4*)((hf*)(wl + W_IN1) + (size_t)C_PG * DM);
    for (int i = gt; i < 96 * DM / 8; i += NGT) z1[i] = (u32x4){0u, 0u, 0u, 0u};
    hf* up = (hf*)(wl + W_UP);
    for (int i = gt; i < 768 * 16; i += NGT) { const int n = i / 16, k8 = i % 16; *(u32x4*)(up + (size_t)n * KUP + 256 + k8 * 8) = (u32x4){0u, 0u, 0u, 0u}; }
    for (int i = gt; i < 1024 * 32; i += NGT) { const int n = 768 + i / 32, k8 = i % 32; *(u32x4*)(up + (size_t)n * KUP + k8 * 8) = (u32x4){0u, 0u, 0u, 0u}; }
}

__device__ __forceinline__ void prologue_a(const Frame& F, const Params& p) {
    mod_phase(F, p);
    convert_layer(F, p, 0, p.ws + WS_WT);
    const int gw = F.vcu * 8 + F.wave, NGW = F.G * 8, lane = F.lane;
    for (int it = gw; it < DEPTH * (SEQ + CTXL); it += NGW) { const int l = it / (SEQ + CTXL), r = it % (SEQ + CTXL); if (r < SEQ) filt_item(p, l, 0, r, lane); else filt_item(p, l, 1, r - SEQ, lane); }
    {
        float* rope = (float*)(p.ws + WS_ROPE);
        const int gt = gw * 64 + lane, NGT = NGW * 64;
        for (int i = gt; i < SEQ * 16; i += NGT) { const int t = i >> 4, j = i & 15; const float pos = (j < 8) ? (float)(t / GRIDW) : (float)(t % GRIDW);
            const float inv = powf(10000.f, -(float)(j & 7) / 8.f); const float a = pos * inv; rope[t * 32 + j] = cosf(a); rope[t * 32 + 16 + j] = sinf(a); }
        if (gt < DEPTH) { const int l = gt; float s1 = 0.f, s2 = 0.f;
            for (int i = 0; i < 32; ++i) { s1 += p.in[I_LQ1][l * 32 + i] * p.in[I_LK1][l * 32 + i]; s2 += p.in[I_LQ2][l * 32 + i] * p.in[I_LK2][l * 32 + i]; }
            const float li = 0.8f - 0.6f * expf(-0.3f * (float)l);
            float* lam = (float*)(p.ws + WS_LAM); lam[2 * l] = expf(s1) - expf(s2) + li; lam[2 * l + 1] = 1.f - li; }
    }
}
__device__ __forceinline__ void prologue_b(const Frame& F, const Params& p) {
    const float* MOD = (const float*)(p.ws + WS_MOD); float* BIAS = (float*)(p.ws + WS_BIAS);
    {
        LAS float* sv = (LAS float*)F.lds;
        constexpr int NCB = DEPTH * NBIAS / 512;
        for (int item = F.vcu; item < NCB * 3; item += F.G) {
            const int cb = item / 3, vg = item % 3;
            const int gcol = cb * 512 + F.tid, l = gcol / NBIAS, n = gcol % NBIAS, n0 = (cb * 512) % NBIAS;
            const int soff = (n0 >= B_FC1) ? 3 * DM : 0;
            __syncthreads();
            for (int i = F.tid; i < 11 * 1024; i += 512) { const int v = vg * 11 + i / 1024, k = i % 1024; sv[i] = MOD[((size_t)l * NMODV + v) * MODW + soff + k]; }
            __syncthreads();
            const float* w; size_t ldw; bool valid = true;
            if (n < B_G) { w = p.in[I_WIN] + (size_t)l * DM * D_IN + n; ldw = D_IN; valid = n < C_PG; }
            else if (n < B_FC1) { w = p.in[I_WIN] + (size_t)l * DM * D_IN + C_PG + (n - B_G); ldw = D_IN; }
            else { w = p.in[I_FC1] + (size_t)l * DM * DFF + (n - B_FC1); ldw = DFF; }
            float acc[11];
#pragma unroll
            for (int v = 0; v < 11; ++v) acc[v] = 0.f;
            if (valid)
#pragma unroll 4
            for (int k = 0; k < DM; k += 4) {
                const float w0 = w[(size_t)k * ldw], w1 = w[(size_t)(k + 1) * ldw], w2 = w[(size_t)(k + 2) * ldw], w3 = w[(size_t)(k + 3) * ldw];
#pragma unroll
                for (int v = 0; v < 11; ++v) { const f32x4 sx = *(const LAS f32x4*)(sv + v * 1024 + k);
                    acc[v] = fmaf(sx[0], w0, acc[v]); acc[v] = fmaf(sx[1], w1, acc[v]); acc[v] = fmaf(sx[2], w2, acc[v]); acc[v] = fmaf(sx[3], w3, acc[v]); }
            }
#pragma unroll
            for (int v = 0; v < 11; ++v) BIAS[((size_t)l * NMODV + vg * 11 + v) * NBIAS + n] = acc[v];
        }
        __syncthreads();
    }
    const int gw = F.vcu * 8 + F.wave, NGW = F.G * 8, lane = F.lane;
    {
        float* GS = (float*)(p.ws + WS_GS);
        const int gt = gw * 64 + lane, NGT = NGW * 64;
        for (int i = gt; i < DEPTH * 2 * NMODV * DM; i += NGT) { const int c = i % DM, v = (i / DM) % NMODV, wh = (i / (DM * NMODV)) % 2, l = i / (DM * NMODV * 2);
            const float g = wh ? p.in[I_NFG][l * DM + c] : p.in[I_NMG][l * DM + c];
            GS[i] = g * (1.f + MOD[((size_t)l * NMODV + v) * MODW + (wh ? 4 * DM : DM) + c]); }
    }
    {
        hf* XS = (hf*)p.out; hf* X16 = (hf*)(p.ws + WS_X16); float* ss = (float*)(p.ws + WS_SS) + (size_t)SS_1 * MTOT;
        f32x4 g[4];
#pragma unroll
        for (int j = 0; j < 4; ++j) g[j] = *(const f32x4*)(p.in[I_NMG] + 4 * lane + 256 * j);
        for (int row = gw; row < MTOT; row += NGW) {
            const bool lat = row < NLAT; const float* xr = lat ? p.in[I_X] + (size_t)row * DM : p.in[I_CTX] + (size_t)(row - NLAT) * DM;
            const int v = lat ? (row >> 11) : NB; const float* mv = MOD + (size_t)v * MODW + DM;
            float sq = 0.f; hf* hr = XS + (size_t)row * DM; hf* xh = X16 + (size_t)row * DM;
#pragma unroll
            for (int j = 0; j < 4; ++j) { const f32x4 x = *(const f32x4*)(xr + 4 * lane + 256 * j); const f32x4 sc = *(const f32x4*)(mv + 4 * lane + 256 * j);
                sq += (x[0] * x[0] + x[1] * x[1]) + (x[2] * x[2] + x[3] * x[3]);
                const f32x4 o = x * (g[j] * (sc + 1.f)); u32x2 w; w.x = pkh(o[0], o[1]); w.y = pkh(o[2], o[3]); *(u32x2*)(hr + 4 * lane + 256 * j) = w;
                u32x2 w2; w2.x = pkh(x[0], x[1]); w2.y = pkh(x[2], x[3]); *(u32x2*)(xh + 4 * lane + 256 * j) = w2; }
            sq = wave_sum(sq);
            if (lane == 0) ss[row] = sq;
        }
    }
}

__device__ __forceinline__ void norm_phase(const Frame& F, const float* xs_lat, const float* xs_ctx, int nrows, const float* gain, const float* modl, int sh_off, int sc_off, hf* H) {
    const int gw = F.vcu * 8 + F.wave, NGW = F.G * 8, lane = F.lane;
    f32x4 g[4];
#pragma unroll
    for (int j = 0; j < 4; ++j) g[j] = *(const f32x4*)(gain + 4 * lane + 256 * j);
    for (int row = gw; row < nrows; row += NGW) {
        const bool lat = row < NLAT; const float* xr = lat ? xs_lat + (size_t)row * DM : xs_ctx + (size_t)(row - NLAT) * DM;
        const int v = lat ? (row >> 11) : NB; const float* mv = modl + (size_t)v * MODW;
        f32x4 x[4]; float ss = 0.f;
#pragma unroll
        for (int j = 0; j < 4; ++j) { x[j] = *(const f32x4*)(xr + 4 * lane + 256 * j); ss += (x[j][0] * x[j][0] + x[j][1] * x[j][1]) + (x[j][2] * x[j][2] + x[j][3] * x[j][3]); }
        const float rstd = rsqrtf(wave_sum(ss) * (1.f / DM) + EPS);
        hf* hr = H + (size_t)row * DM;
#pragma unroll
        for (int j = 0; j < 4; ++j) { const f32x4 sh = *(const f32x4*)(mv + sh_off + 4 * lane + 256 * j), sc = *(const f32x4*)(mv + sc_off + 4 * lane + 256 * j);
            const f32x4 y = (x[j] * rstd) * g[j]; const f32x4 o = y * (sc + 1.f) + sh;
            u32x2 w; w.x = pkh(o[0], o[1]); w.y = pkh(o[2], o[3]); *(u32x2*)(hr + 4 * lane + 256 * j) = w; }
    }
}
__device__ __forceinline__ void final_norm_phase(const Frame& F, const hf* X16, float* out, const float* gain, const float* ss) {
    const int gw = F.vcu * 8 + F.wave, NGW = F.G * 8, lane = F.lane;
    f32x4 g[4];
#pragma unroll
    for (int j = 0; j < 4; ++j) g[j] = *(const f32x4*)(gain + 4 * lane + 256 * j);
    for (int row = gw; row < NLAT; row += NGW) {
        const hf* xr = X16 + (size_t)row * DM; float* orow = out + (size_t)row * DM; const float rstd = rsqrtf(ss[row] * (1.f / DM) + EPS);
#pragma unroll
        for (int j = 0; j < 4; ++j) { const hf4 xh = *(const hf4*)(xr + 4 * lane + 256 * j); const f32x4 x = {(float)xh[0], (float)xh[1], (float)xh[2], (float)xh[3]};
            *(f32x4*)(orow + 4 * lane + 256 * j) = (x * rstd) * g[j]; }
    }
}

__device__ __forceinline__ void prep_rope(const Frame& F, const Params& p) {
    const int gw = F.vcu * 8 + F.wave, NGW = F.G * 8, lane = F.lane;
    hf* KR = (hf*)(p.ws + A_KR); hf* DK = (hf*)(p.ws + A_DK); const float* rope = (const float*)(p.ws + WS_ROPE);
    const int hh = lane >> 3, i0 = 2 * (lane & 7);
    for (int row0 = gw * 4; row0 < NLAT; row0 += NGW * 4) {
        hf2 a[4], b[4]; f32x2 c[4], sn[4]; float y1[4], y2[4], cc[4], ss[4];
#pragma unroll
        for (int q = 0; q < 4; ++q) { const int row = row0 + q, t = row & (SEQ - 1); const hf* dk = DK + (size_t)row * 256 + hh * 32 + i0;
            a[q] = *(const hf2*)dk; b[q] = *(const hf2*)(dk + 16); c[q] = *(const f32x2*)(rope + t * 32 + i0); sn[q] = *(const f32x2*)(rope + t * 32 + 16 + i0);
            if (lane < 16) { const hf* kr = KR + (size_t)row * 32 + lane; y1[q] = (float)kr[0]; y2[q] = (float)kr[16]; cc[q] = rope[t * 32 + lane]; ss[q] = rope[t * 32 + 16 + lane]; } }
#pragma unroll
        for (int q = 0; q < 4; ++q) { const int row = row0 + q; hf* dk = DK + (size_t)row * 256 + hh * 32 + i0;
            const float x1[2] = {(float)a[q][0], (float)a[q][1]}, x2[2] = {(float)b[q][0], (float)b[q][1]};
            *(unsigned*)dk = pkh(x1[0] * c[q][0] - x2[0] * sn[q][0], x1[1] * c[q][1] - x2[1] * sn[q][1]);
            *(unsigned*)(dk + 16) = pkh(x2[0] * c[q][0] + x1[0] * sn[q][0], x2[1] * c[q][1] + x1[1] * sn[q][1]);
            if (lane < 16) { hf* kr = KR + (size_t)row * 32 + lane; kr[0] = (hf)(y1[q] * cc[q] - y2[q] * ss[q]); kr[16] = (hf)(y2[q] * cc[q] + y1[q] * ss[q]); } }
    }
}
__device__ __forceinline__ void prep_hyena(const Frame& F, const Params& p, int l, bool with_ctx) {
    constexpr int INP = 784;
    constexpr int OUTP = 33;
    constexpr int OFF_OU = 66 * INP, OFF_OX = OFF_OU + 128 * OUTP * 4;
    const hf* PHY = (const hf*)(p.ws + A_PHY);
    LAS unsigned char* lds = F.lds; const int tid = F.tid;
    const float* cw = p.in[I_HCW] + (size_t)l * 3 * 768; const float* cb = p.in[I_HCB] + (size_t)l * 768;
    constexpr int U_LAT = NB * (SEQ / 64) * 2, U_CTX = NB * (CTXL / 64) * 2;
    const int nunit = U_LAT + (with_ctx ? U_CTX : 0);
    for (int un = F.vcu; un < nunit; un += F.G) {
        const bool ctx = un >= U_LAT; int r = ctx ? un - U_LAT : un; const int L = ctx ? CTXL : SEQ, ntile = L / 64;
        const int ch = r & 1; r >>= 1; const int tt = r % ntile, b = r / ntile;
        const int t0 = tt * 64; const size_t rowbase = ctx ? (size_t)NLAT + (size_t)b * CTXL : (size_t)b * SEQ;
        hf* dU = ctx ? (hf*)(p.ws + A_UTC) : (hf*)(p.ws + A_UT); hf* dX = ctx ? (hf*)(p.ws + A_X0TC) : (hf*)(p.ws + A_X0T);
        __syncthreads();
        {
            u32x4 tmp[7];
#pragma unroll
            for (int k = 0; k < 7; ++k) { const int i = tid + 512 * k, rr = i / 48, q = i % 48, seg = q >> 4, c16 = q & 15; const int t = t0 - 1 + rr;
                tmp[k] = (u32x4){0u, 0u, 0u, 0u};
                if (i < 66 * 48 && t >= 0 && t < L) tmp[k] = *(const u32x4*)(PHY + (rowbase + t) * 768 + seg * 256 + ch * 128 + c16 * 8); }
#pragma unroll
            for (int k = 0; k < 7; ++k) { const int i = tid + 512 * k, rr = i / 48, q = i % 48, seg = q >> 4, c16 = q & 15;
                if (i < 66 * 48) *(LAS u32x4*)(lds + rr * INP + seg * 256 + c16 * 16) = tmp[k]; }
        }
        __syncthreads();
        {
            const int c = tid & 127, tg = tid >> 7, cg = ch * 128 + c;
            const float a0 = cw[cg], a1 = cw[768 + cg], a2 = cw[1536 + cg], ab = cb[cg];
            const float b0 = cw[256 + cg], b1 = cw[768 + 256 + cg], b2 = cw[1536 + 256 + cg], bb = cb[256 + cg];
            const float v0 = cw[512 + cg], v1 = cw[768 + 512 + cg], v2 = cw[1536 + 512 + cg], vb = cb[512 + cg];
            const LAS hf* in = (const LAS hf*)(lds + (16 * tg) * INP) + c;
            float p0 = (float)in[0], p1 = (float)in[128], p2 = (float)in[256];
            float c0 = (float)in[INP / 2], c1 = (float)in[INP / 2 + 128], c2 = (float)in[INP / 2 + 256];
            LAS hf* ou = (LAS hf*)(lds + OFF_OU) + c * (OUTP * 2) + 16 * tg; LAS hf* ox = (LAS hf*)(lds + OFF_OX) + c * (OUTP * 2) + 16 * tg;
#pragma unroll
            for (int j = 0; j < 16; ++j) { const LAS hf* nx = in + (j + 2) * (INP / 2);
                const float n0 = (float)nx[0], n1 = (float)nx[128], n2 = (float)nx[256];
                const float x0 = a0 * p0 + a1 * c0 + a2 * n0 + ab, x1 = b0 * p1 + b1 * c1 + b2 * n1 + bb, vv = v0 * p2 + v1 * c2 + v2 * n2 + vb;
                ou[j] = (hf)(vv * x1); ox[j] = (hf)x0;
                p0 = c0; p1 = c1; p2 = c2; c0 = n0; c1 = n1; c2 = n2; }
        }
        __syncthreads();
        {
            const int c = tid >> 2, q = tid & 3; const size_t go = ((size_t)(ch * 128 + c) * NB + b) * L + t0 + 16 * q;
            const LAS unsigned* su = (const LAS unsigned*)(lds + OFF_OU) + c * OUTP + 8 * q; const LAS unsigned* sx = (const LAS unsigned*)(lds + OFF_OX) + c * OUTP + 8 * q;
            u32x4 w0 = {su[0], su[1], su[2], su[3]}, w1 = {su[4], su[5], su[6], su[7]};
            *(u32x4*)(dU + go) = w0; *(u32x4*)(dU + go + 8) = w1;
            u32x4 y0 = {sx[0], sx[1], sx[2], sx[3]}, y1 = {sx[4], sx[5], sx[6], sx[7]};
            *(u32x4*)(dX + go) = y0; *(u32x4*)(dX + go + 8) = y1;
        }
    }
    __syncthreads();
}

namespace att {
#ifndef PROF_SEL
#define PROF_SEL -1
#endif
#define ATT_MARK(b) do { if (PROF_SEL >= 0 && F.tid == 0) { volatile LAS unsigned* _pf = (volatile LAS unsigned*)(F.lds + LDS_BYTES - 512); const unsigned _t = (unsigned)__builtin_amdgcn_s_memrealtime(); _pf[(b)] += _t - _pf[32]; _pf[32] = _t; } } while (0)
__device__ __forceinline__ int crow(int r, int hi) { return (r & 3) + 8 * (r >> 2) + 4 * hi; }
#define SBAR() __builtin_amdgcn_sched_barrier(0)
constexpr float THR2 = 8.f * 1.4426950408889634f;
constexpr int KS_MLA = 208, KS_DF = 80;
constexpr int VS = 192, VB = 64 * VS;
constexpr int OFF_V = 32768;
template <int OFF> __device__ __forceinline__ s16x4 tr_read(int vb) {
    s16x4 r; asm volatile("ds_read_b64_tr_b16 %0, %1 offset:%2" : "=&v"(r) : "v"(vb), "i"(OFF) : "memory"); return r;
}
__device__ __forceinline__ int kpos(int key) { return (key & ~0xC) | ((key & 4) << 1) | ((key & 8) >> 1); }

template <int ND0, int KS>
__device__ __forceinline__ void qkt(f32x16& p0, f32x16& p1, const LAS unsigned char* Ks, const hf8* qr, int r32, int hi) {
    p0 = f32x16{}; p1 = f32x16{};
#pragma unroll
    for (int d0 = 0; d0 < ND0; ++d0) { const int cb = (d0 * 16 + hi * 8) * 2;
        const hf8 b0 = *(const LAS hf8*)(Ks + r32 * KS + cb), b1 = *(const LAS hf8*)(Ks + (32 + r32) * KS + cb);
        p0 = __builtin_amdgcn_mfma_f32_32x32x16_f16(b0, qr[d0], p0, 0, 0, 0); p1 = __builtin_amdgcn_mfma_f32_32x32x16_f16(b1, qr[d0], p1, 0, 0, 0); }
}
__device__ __forceinline__ float max3f(float a, float b, float c) { float r; asm("v_max3_f32 %0, %1, %2, %3" : "=v"(r) : "v"(a), "v"(b), "v"(c)); return r; }
__device__ __forceinline__ float max2f(float a, float b) { float r; asm("v_max_f32_e32 %0, %1, %2" : "=v"(r) : "v"(a), "v"(b)); return r; }
__device__ __forceinline__ float max16(const f32x16& p) { float r, t;
    asm("v_max3_f32 %0, %2, %3, %4\n\tv_max3_f32 %1, %10, %11, %12\n\tv_max3_f32 %0, %0, %5, %6\n\tv_max3_f32 %1, %1, %13, %14\n\tv_max3_f32 %0, %0, %7, %8\n\tv_max3_f32 %1, %1, %15, %16\n\tv_max3_f32 %0, %0, %9, %17\n\tv_max_f32_e32 %0, %0, %1"
        : "=&v"(r), "=&v"(t) : "v"(p[0]), "v"(p[1]), "v"(p[2]), "v"(p[3]), "v"(p[4]), "v"(p[5]), "v"(p[6]), "v"(p[7]), "v"(p[8]), "v"(p[9]), "v"(p[10]), "v"(p[11]), "v"(p[12]), "v"(p[13]), "v"(p[14]), "v"(p[15]));
    return r; }
__device__ __forceinline__ hf8 pack8(const f32x16& p, int b) { u32x4 w = {pkh(p[b], p[b + 1]), pkh(p[b + 2], p[b + 3]), pkh(p[b + 4], p[b + 5]), pkh(p[b + 6], p[b + 7])}; return __builtin_bit_cast(hf8, w); }
__device__ __forceinline__ void sm_max(const f32x16& p0, const f32x16& p1, float& m, float& l, f32x16& o0, f32x16& o1, const bool first) {
    float pmax = max2f(max16(p0), max16(p1));
    { auto rr = __builtin_amdgcn_permlane32_swap(__float_as_uint(pmax), __float_as_uint(pmax), false, false);
      pmax = max2f(__uint_as_float(rr[0]), __uint_as_float(rr[1])); }
    if (first || __any(pmax - m > THR2)) {
        const float mn = first ? pmax : max2f(m, pmax);
        if (!first) { const float alpha = __builtin_amdgcn_exp2f(m - mn); l *= alpha;
#pragma unroll
            for (int r = 0; r < 16; ++r) { o0[r] *= alpha; o1[r] *= alpha; } }
        m = mn;
    }
}
__device__ __forceinline__ void sm_exp(f32x16& p0, f32x16& p1, const float m, float& l, hf8& pf0, hf8& pf1, hf8& pf2, hf8& pf3) {
#pragma unroll
    for (int r = 0; r < 16; ++r) { p0[r] -= m; p1[r] -= m; }
#pragma unroll
    for (int r = 0; r < 16; ++r) { p0[r] = __builtin_amdgcn_exp2f(p0[r]); p1[r] = __builtin_amdgcn_exp2f(p1[r]); }
    float ps0 = p0[0] + p1[0], ps1 = p0[1] + p1[1], ps2 = p0[2] + p1[2], ps3 = p0[3] + p1[3];
#pragma unroll
    for (int r = 4; r < 16; r += 4) { ps0 += p0[r] + p1[r]; ps1 += p0[r + 1] + p1[r + 1]; ps2 += p0[r + 2] + p1[r + 2]; ps3 += p0[r + 3] + p1[r + 3]; }
    l += (ps0 + ps1) + (ps2 + ps3);
    pf0 = pack8(p0, 0); pf1 = pack8(p0, 8); pf2 = pack8(p1, 0); pf3 = pack8(p1, 8);
}
__device__ __forceinline__ void pv(const hf8 pf0, const hf8 pf1, const hf8 pf2, const hf8 pf3, f32x16& o0, f32x16& o1, const LAS unsigned char* Vt, int r32, int hi) {
    const int lg = (int)(threadIdx.x & 15), vq = lg >> 2, vp4 = lg & 3;
    const int vbase = (int)(unsigned)(uintptr_t)Vt + (4 * hi + vq) * VS + (16 * ((int)(threadIdx.x >> 4) & 1) + 4 * vp4) * 2;
#define PVRD(ks, L0, H0, L1, H1) s16x4 L0 = tr_read<(16 * (ks)) * VS>(vbase), H0 = tr_read<(16 * (ks) + 8) * VS>(vbase), L1 = tr_read<(16 * (ks)) * VS + 64>(vbase), H1 = tr_read<(16 * (ks) + 8) * VS + 64>(vbase)
#define PVMM(N, L0, H0, L1, H1, pf) do { asm volatile("s_waitcnt lgkmcnt(" #N ")" : "+v"(L0), "+v"(H0), "+v"(L1), "+v"(H1) :: "memory"); \
        const hf8 a0 = __builtin_bit_cast(hf8, (short __attribute__((ext_vector_type(8)))){L0[0], L0[1], L0[2], L0[3], H0[0], H0[1], H0[2], H0[3]}); \
        const hf8 a1 = __builtin_bit_cast(hf8, (short __attribute__((ext_vector_type(8)))){L1[0], L1[1], L1[2], L1[3], H1[0], H1[1], H1[2], H1[3]}); \
        o0 = __builtin_amdgcn_mfma_f32_32x32x16_f16(a0, pf, o0, 0, 0, 0); o1 = __builtin_amdgcn_mfma_f32_32x32x16_f16(a1, pf, o1, 0, 0, 0); } while (0)
    PVRD(0, a0l, a0h, a1l, a1h); PVRD(1, b0l, b0h, b1l, b1h);
    PVMM(4, a0l, a0h, a1l, a1h, pf0);
    PVRD(2, c0l, c0h, c1l, c1h);
    PVMM(4, b0l, b0h, b1l, b1h, pf1);
    PVRD(3, d0l, d0h, d1l, d1h);
    PVMM(4, c0l, c0h, c1l, c1h, pf2);
    PVMM(0, d0l, d0h, d1l, d1h, pf3);
#undef PVRD
#undef PVMM
#define PVK(ks, pf)
#undef PVK
}

template <bool MLA>
__device__ __forceinline__ void attn_pass(const Frame& F, const Params& p, int hq, int hv, int qrow0, int qpos0, int klat0, int nlat, int kctx0, f32x16& o0, f32x16& o1, float& inv) {
    constexpr int DK = MLA ? 96 : 32, ND0 = DK / 16, KS = MLA ? KS_MLA : KS_DF, KB = 64 * KS;
    constexpr float SCALE = MLA ? MLA_SCALE : DF_SCALE, C = SCALE * 1.4426950408889634f;
    const int tid = F.tid, wid = F.wave, lane = F.lane, r32 = lane & 31, hi = lane >> 5;
    const hf* QKV = (const hf*)(p.ws + A_QKV); const hf* KRb = (const hf*)(p.ws + A_KR);
    const hf* DQ = (const hf*)(p.ws + A_DQ); const hf* DKb = (const hf*)(p.ws + A_DK); const hf* DVb = (const hf*)(p.ws + A_DV);
    const float* rope = (const float*)(p.ws + WS_ROPE);
    LAS unsigned char* lds = F.lds;
    hf8 qr[ND0];
    {
        const int qrow = qrow0 + wid * 32 + r32;
        const hf* qp = MLA ? QKV + (size_t)qrow * NUP + hq * 96 + hi * 8 : DQ + (size_t)qrow * 256 + hq * 32 + hi * 8;
        hf8 raw[ND0];
#pragma unroll
        for (int d0 = 0; d0 < ND0; ++d0) raw[d0] = *(const hf8*)(qp + d0 * 16);
        f32x4 c0 = {1.f, 1.f, 1.f, 1.f}, c1 = c0, s0 = {0.f, 0.f, 0.f, 0.f}, s1 = s0;
        if (qpos0 >= 0) { const int t = qpos0 + wid * 32 + r32;
            c0 = *(const f32x4*)(rope + t * 32 + hi * 8); c1 = *(const f32x4*)(rope + t * 32 + hi * 8 + 4);
            s0 = *(const f32x4*)(rope + t * 32 + 16 + hi * 8); s1 = *(const f32x4*)(rope + t * 32 + 16 + hi * 8 + 4); }
#pragma unroll
        for (int d0 = 0; d0 < ND0 - 2; ++d0) {
#pragma unroll
            for (int j = 0; j < 8; ++j) qr[d0][j] = (hf)((float)raw[d0][j] * C); }
#pragma unroll
        for (int j = 0; j < 8; ++j) { const float cc = j < 4 ? c0[j & 3] : c1[j & 3], sn = j < 4 ? s0[j & 3] : s1[j & 3]; const float a = (float)raw[ND0 - 2][j], b = (float)raw[ND0 - 1][j];
            qr[ND0 - 2][j] = (hf)((a * cc - b * sn) * C); qr[ND0 - 1][j] = (hf)((b * cc + a * sn) * C); }
    }
    const int k1r = MLA ? (tid >> 3) : ((tid & 255) >> 2), k1c = MLA ? (tid & 7) * 8 : (tid & 3) * 8;
    const int k2r = (tid & 255) >> 2, k2c = (tid & 3) * 8;
    const int vr_ = tid >> 3, vc_ = (tid & 7) * 8;
    const bool klo = tid < 256;
    struct Stg { u32x4 v, k1, k2; };
    Stg sA, sB; sA.v = sA.k1 = sA.k2 = sB.v = sB.k1 = sB.k2 = (u32x4){0u, 0u, 0u, 0u};
    const int ntile = nlat + 4;
#define KROW0(j) (((j) < nlat) ? klat0 + (j) * 64 : kctx0 + ((j) - nlat) * 64)
#define A_LOADK(S, j) do { const int kr0 = KROW0(j); \
        if (MLA) { S.k1 = *(const u32x4*)(QKV + (size_t)(kr0 + k1r) * NUP + 768 + hq * 128 + k1c); S.k2 = *(const u32x4*)(KRb + (size_t)(kr0 + k2r) * 32 + k2c); } \
        else S.k1 = *(const u32x4*)(DKb + (size_t)(kr0 + k1r) * 256 + hq * 32 + k1c); } while (0)
#define A_LOADV(S, j) do { const int kr0 = KROW0(j); \
        if (MLA) S.v = *(const u32x4*)(QKV + (size_t)(kr0 + vr_) * NUP + 768 + hv * 128 + 64 + vc_); else S.v = *(const u32x4*)(DVb + (size_t)(kr0 + vr_) * 256 + hv * 64 + vc_); } while (0)
#define A_WRITEK(S, b) do { *(LAS u32x4*)(lds + (b) * KB + k1r * KS + k1c * 2) = S.k1; if (MLA) *(LAS u32x4*)(lds + (b) * KB + k2r * KS + 128 + k2c * 2) = S.k2; } while (0)
#define A_WRITEV(S, b) do { *(LAS u32x4*)(lds + OFF_V + (b) * VB + vr_ * VS + vc_ * 2) = S.v; } while (0)
    float m_reg = 0.f, l_reg = 0.f;
    o0 = f32x16{}; o1 = f32x16{};
    f32x16 pA0, pA1, pB0, pB1;
    __syncthreads();
    const int nt1 = ntile - 1;
#define TCL(j) (((j) < nt1) ? (j) : nt1)
    A_LOADK(sA, 0); A_LOADV(sA, 0); A_LOADK(sB, 1);
    A_WRITEK(sA, 0); A_WRITEV(sA, 0); A_WRITEK(sB, 1);
    A_LOADK(sA, TCL(2));
    A_LOADV(sA, 1);
    __syncthreads();
    qkt<ND0, KS>(pA0, pA1, lds, qr, r32, hi);
    hf8 f0, f1, f2, f3;
    if (wid >= 4) __syncthreads();
    for (int j = 0; j < ntile; j += 2) {
        A_LOADK(sB, TCL(j + 3)); A_LOADV(sB, TCL(j + 2));
        sm_max(pA0, pA1, m_reg, l_reg, o0, o1, j == 0);
        sm_exp(pA0, pA1, m_reg, l_reg, f0, f1, f2, f3);
        __syncthreads();
        qkt<ND0, KS>(pB0, pB1, lds + KB, qr, r32, hi);
        pv(f0, f1, f2, f3, o0, o1, lds + OFF_V, r32, hi);
        A_WRITEK(sA, 0); A_WRITEV(sA, 1);
        __syncthreads();
        A_LOADK(sA, TCL(j + 4)); A_LOADV(sA, TCL(j + 3));
        sm_max(pB0, pB1, m_reg, l_reg, o0, o1, false);
        sm_exp(pB0, pB1, m_reg, l_reg, f0, f1, f2, f3);
        __syncthreads();
        qkt<ND0, KS>(pA0, pA1, lds, qr, r32, hi);
        pv(f0, f1, f2, f3, o0, o1, lds + OFF_V + VB, r32, hi);
        A_WRITEK(sB, 1); A_WRITEV(sB, 0);
        __syncthreads();
    }
    if (wid < 4) __syncthreads();
#undef TCL
#undef KROW0
#undef A_LOADK
#undef A_LOADV
#undef A_WRITEK
#undef A_WRITEV
    const float lt = l_reg + __shfl_xor(l_reg, 32); inv = __builtin_amdgcn_rcpf(lt);
}
template <bool MLA>
__device__ __forceinline__ void attn_unit(const Frame& F, const Params& p, int l, int h, int qrow0, int qpos0, int klat0, int nlat, int kctx0) {
    const int wid = F.wave, lane = F.lane, r32 = lane & 31, hi = lane >> 5;
    hf* Y = (hf*)(p.ws + A_Y);
    const size_t yrow = (size_t)(qrow0 + wid * 32 + r32) * DM;
    if constexpr (MLA) {
        f32x16 o0, o1; float inv;
        attn_pass<true>(F, p, h, h, qrow0, qpos0, klat0, nlat, kctx0, o0, o1, inv);
#pragma unroll
        for (int g = 0; g < 4; ++g) { u32x2 w; w.x = pkh(o0[4 * g] * inv, o0[4 * g + 1] * inv); w.y = pkh(o0[4 * g + 2] * inv, o0[4 * g + 3] * inv); *(u32x2*)(Y + yrow + h * 64 + 8 * g + 4 * hi) = w; }
#pragma unroll
        for (int g = 0; g < 4; ++g) { u32x2 w; w.x = pkh(o1[4 * g] * inv, o1[4 * g + 1] * inv); w.y = pkh(o1[4 * g + 2] * inv, o1[4 * g + 3] * inv); *(u32x2*)(Y + yrow + h * 64 + 32 + 8 * g + 4 * hi) = w; }
    } else {
        const float lam = ((const float*)(p.ws + WS_LAM))[2 * l], oml = ((const float*)(p.ws + WS_LAM))[2 * l + 1];
        f32x16 a0, a1;
        LAS float* park = (LAS float*)(F.lds + 65536 + wid * 8192) + lane;
        { f32x16 o0, o1; float inv; attn_pass<false>(F, p, 2 * h, h, qrow0, qpos0, klat0, nlat, kctx0, o0, o1, inv);
#pragma unroll
          for (int r = 0; r < 16; ++r) { park[r * 64] = o0[r] * inv; park[(16 + r) * 64] = o1[r] * inv; } }
        { f32x16 o0, o1; float inv; attn_pass<false>(F, p, 2 * h + 1, h, qrow0, qpos0, klat0, nlat, kctx0, o0, o1, inv);
#pragma unroll
          for (int r = 0; r < 16; ++r) { a0[r] = park[r * 64] - o0[r] * (lam * inv); a1[r] = park[(16 + r) * 64] - o1[r] * (lam * inv); } }
        float ss = 0.f;
#pragma unroll
        for (int r = 0; r < 16; ++r) ss += a0[r] * a0[r] + a1[r] * a1[r];
        ss += __shfl_xor(ss, 32);
        const float rs = rsqrtf(ss * (1.f / 64.f) + EPS) * oml;
#pragma unroll
        for (int g = 0; g < 4; ++g) { const f32x4 gg = *(const f32x4*)(p.in[I_SUBG] + l * 64 + 8 * g + 4 * hi);
            u32x2 w; w.x = pkh(a0[4 * g] * rs * gg[0], a0[4 * g + 1] * rs * gg[1]); w.y = pkh(a0[4 * g + 2] * rs * gg[2], a0[4 * g + 3] * rs * gg[3]); *(u32x2*)(Y + yrow + 768 + h * 64 + 8 * g + 4 * hi) = w; }
#pragma unroll
        for (int g = 0; g < 4; ++g) { const f32x4 gg = *(const f32x4*)(p.in[I_SUBG] + l * 64 + 32 + 8 * g + 4 * hi);
            u32x2 w; w.x = pkh(a1[4 * g] * rs * gg[0], a1[4 * g + 1] * rs * gg[1]); w.y = pkh(a1[4 * g + 2] * rs * gg[2], a1[4 * g + 3] * rs * gg[3]); *(u32x2*)(Y + yrow + 768 + h * 64 + 32 + 8 * g + 4 * hi) = w; }
    }
}
}

#define HY_MARK(b) do { if (PROF_SEL >= 0 && F.tid == 0) { volatile LAS unsigned* _pf = (volatile LAS unsigned*)(F.lds + LDS_BYTES - 512); const unsigned _t = (unsigned)__builtin_amdgcn_s_memrealtime(); _pf[(b)] += _t - _pf[32]; _pf[32] = _t; } } while (0)
template <int L>
__device__ __forceinline__ void hyena_unit(const Frame& F, const hf* Rrow  , const hf* U  , const hf* X0  , hf* Ycol  ) {
    constexpr int NM = L / 256, RL = 2 * L, SH = (L > 1024) ? 1024 : L, NH = L / SH, US = SH * 2 + 16;
    constexpr int OFF_U = 8 * RL * 2;
    constexpr int XP = L * 2 + 16;
    static_assert(OFF_U + 32 * US <= LDS_MISC && 32 * XP <= LDS_MISC, "hyena LDS");
    const int tid = F.tid, w = F.wave, lane = F.lane, i32 = lane & 31, hi = lane >> 5;
    LAS unsigned char* lds = F.lds;
    __syncthreads();
    for (int i = tid; i < RL / 8; i += 512) *(LAS u32x4*)(lds + i * 16) = *(const u32x4*)(Rrow + i * 8);
    __syncthreads();
    {
        const LAS unsigned* src = (const LAS unsigned*)lds;
#pragma unroll 1
        for (int idx = tid; idx < 7 * (RL / 8); idx += 512) { const int cw = 1 + idx / (RL / 8), c4 = (idx % (RL / 8)) * 4;
            const int k0 = c4 - ((cw + 1) >> 1); unsigned d[5];
#pragma unroll
            for (int e = 0; e < 5; ++e) { const int k = k0 + e; d[e] = (k >= 0 && k < RL / 2) ? src[k] : 0u; }
            u32x4 o;
            if (cw & 1) { o.x = (d[0] >> 16) | (d[1] << 16); o.y = (d[1] >> 16) | (d[2] << 16); o.z = (d[2] >> 16) | (d[3] << 16); o.w = (d[3] >> 16) | (d[4] << 16); }
            else { o.x = d[0]; o.y = d[1]; o.z = d[2]; o.w = d[3]; }
            *(LAS u32x4*)(lds + cw * (RL * 2) + c4 * 4) = o; }
    }
    HY_MARK(22);
    f32x16 acc[NM];
#pragma unroll
    for (int m = 0; m < NM; ++m) acc[m] = f32x16{};
    const LAS unsigned char* cpy = lds + w * (RL * 2);
    for (int half = 0; half < NH; ++half) {
        __syncthreads();
        {
            constexpr int NPC = 32 * (SH / 8) / 512, NB4 = NPC > 4 ? 4 : NPC;
            int tq = tid; asm volatile("" : "+v"(tq));
#pragma unroll
            for (int k0 = 0; k0 < NPC; k0 += NB4) { u32x4 tmp[NB4];
#pragma unroll
                for (int k = 0; k < NB4; ++k) { const int idx = tq + 512 * (k0 + k), b = idx / (SH / 8), pc = idx % (SH / 8); tmp[k] = *(const u32x4*)(U + (size_t)b * L + half * SH + pc * 8); }
#pragma unroll
                for (int k = 0; k < NB4; ++k) { const int idx = tq + 512 * (k0 + k), b = idx / (SH / 8), pc = idx % (SH / 8); *(LAS u32x4*)(lds + OFF_U + b * US + pc * 16) = tmp[k]; }
                asm volatile("" ::: "memory"); }
        }
        __syncthreads();
#pragma unroll 2
        for (int jl = 0; jl < SH / 16; ++jl) {
            const int j = half * (SH / 16) + jl;
            const hf8 bf = *(const LAS hf8*)(lds + OFF_U + i32 * US + (jl * 16 + hi * 8) * 2);
            const int x0 = L + 16 * j + 8 * hi - 8 * i32;
#pragma unroll
            for (int m = 0; m < NM; ++m) { const hf8 af = *(const LAS hf8*)(cpy + (x0 - 256 * m) * 2);
                acc[m] = __builtin_amdgcn_mfma_f32_32x32x16_f16(af, bf, acc[m], 0, 0, 0); }
        }
    }
    __syncthreads();
    HY_MARK(23);
    {
        constexpr int NPC = 32 * (L / 8) / 512, NB8 = NPC > 4 ? 4 : NPC;
        int tq = tid; asm volatile("" : "+v"(tq));
#pragma unroll
        for (int k0 = 0; k0 < NPC; k0 += NB8) { u32x4 tmp[NB8];
#pragma unroll
            for (int k = 0; k < NB8; ++k) { const int idx = tq + 512 * (k0 + k), b = idx / (L / 8), pc = idx % (L / 8); tmp[k] = *(const u32x4*)(X0 + (size_t)b * L + pc * 8); }
#pragma unroll
            for (int k = 0; k < NB8; ++k) { const int idx = tq + 512 * (k0 + k), b = idx / (L / 8), pc = idx % (L / 8); *(LAS u32x4*)(lds + b * XP + pc * 16) = tmp[k]; }
            asm volatile("" ::: "memory"); }
    }
    __syncthreads();
    HY_MARK(24);
    const LAS hf* x0p = (const LAS hf*)(lds + i32 * XP) + w + 32 * hi;
    hf* yp = Ycol + ((size_t)i32 * L + w + 32 * hi) * DM;
#pragma unroll
    for (int m = 0; m < NM; ++m) {
#pragma unroll
        for (int r = 0; r < 16; ++r) { const int tt = 256 * m + 8 * ((r & 3) + 8 * (r >> 2));
            const float x0v = (float)x0p[tt];
            yp[(size_t)tt * DM] = (hf)(x0v * acc[m][r]); }
        asm volatile("" ::: "memory");
    }
    HY_MARK(25);
}


#ifndef PH_MASK
#define PH_MASK 0x1FFFF
#endif
#define PHM(k) ((PH_MASK >> (k)) & 1)
#ifndef PROBE_REP
#define PROBE_REP 0
#endif
#define NREP(k) (((PROBE_REP >> (k)) & 1) ? 2 : 1)
constexpr int NPH_LAYER = 9, PH_L0 = 2, NPHASE = PH_L0 + DEPTH * NPH_LAYER + 1;
__global__ void __launch_bounds__(512, 2) fwd_kernel(Params p) {
    extern __shared__ __attribute__((aligned(16))) unsigned char lds_raw[];
    Frame F0; Frame& F = F0;
    F.lds = (LAS unsigned char*)lds_raw;
    F.tid = threadIdx.x; F.lane = F.tid & 63; F.wave = __builtin_amdgcn_readfirstlane(F.tid >> 6);
    F.G = gridDim.x; { const int bx = blockIdx.x; F.vcu = (F.G % 8 == 0) ? (bx % 8) * (F.G / 8) + bx / 8 : bx; }
    volatile LAS unsigned* misc = (volatile LAS unsigned*)(F.lds + LDS_MISC);
    if (F.tid < 16) misc[F.tid] = 0u;
    __syncthreads();
    const int lo = p.ph_lo, hi = p.ph_hi;
    XcdBarrier bar; bar.bar = (unsigned*)(p.ws + WS_BAR); bar.x = 0; bar.st = misc;
    if (hi - lo > 1) bar = xcd_barrier_post((unsigned*)(p.ws + WS_BAR), misc);
#define IN(k) (lo <= (k) && (k) < hi)
#define LAUNDER(Fl) Frame Fl = F0; asm volatile("" : "+v"(Fl.tid), "+v"(Fl.lane))
#ifndef PROF_SEL
#define PROF_SEL -1
#endif
#define PROF_K 8
    volatile LAS unsigned* prof = (volatile LAS unsigned*)(F.lds + LDS_BYTES - 512);
    if (PROF_SEL >= 0 && F.tid < 40) prof[F.tid] = 0u;
    if (PROF_SEL >= 0) __syncthreads();
    if (PROF_SEL >= 0 && F.tid == 0) prof[32] = (unsigned)__builtin_amdgcn_s_memrealtime();
#define PROF_MARK(b) do { if (PROF_SEL >= 0 && F.tid == 0) { const unsigned _t = (unsigned)__builtin_amdgcn_s_memrealtime(); prof[(b)] += _t - prof[32]; if ((b) >= 16) prof[30] += _t - prof[32]; prof[32] = _t; } } while (0)
#define SEAMT(k, b) do { PROF_MARK(b); if (IN(k) && IN((k) + 1)) xcd_barrier(bar); PROF_MARK(16 + (b)); } while (0)
#define SEAM(k) do { if (IN(k) && IN((k) + 1)) xcd_barrier(bar); } while (0)
    unsigned char* ws = p.ws;
    hf* X16 = (hf*)(ws + WS_X16);
    hf* XS1 = (hf*)p.out; hf* MM = (hf*)p.out; hf* Y = (hf*)(ws + A_B); hf* XS2 = (hf*)(ws + A_B);
    hf* QKV = (hf*)(ws + A_QKV); hf* QKVN = (hf*)(ws + A_QKVN);
    unsigned char* Gt = (unsigned char*)(ws + A_G); hf* HID = (hf*)(ws + A_HID);
    float* SS = (float*)(ws + WS_SS);

    if (PHM(11) && IN(0)) for (int rep = 0; rep < NREP(11); ++rep) { LAUNDER(Fl); prologue_a(Fl, p); }
    SEAMT(0, 9);
    if (PHM(11) && IN(1)) for (int rep = 0; rep < NREP(12); ++rep) { LAUNDER(Fl); prologue_b(Fl, p); }
    SEAMT(1, 9);

    for (int l = 0; l < DEPTH; ++l) {
        const int pb = PH_L0 + l * NPH_LAYER;
        const bool ctx_live = l < DEPTH - 1;
        const int Mrows = ctx_live ? MTOT : NLAT;
        const float* modl = (const float*)(ws + WS_MOD) + (size_t)l * NMODV * MODW;
        const float* biasl = (const float*)(ws + WS_BIAS) + (size_t)l * NMODV * NBIAS;
        const float* gsl = (const float*)(ws + WS_GS) + (size_t)l * 2 * NMODV * DM;
        const unsigned char* wl = ws + WS_WT + (size_t)(l & 1) * W_LAYER;
        float* ss1 = SS + (size_t)(SS_1 + l) * MTOT; float* ss2 = SS + (size_t)(SS_2 + l) * MTOT;

        if (PHM(1) && IN(pb + 0)) for (int rep = 0; rep < NREP(1); ++rep) { pg8::Gemm g{XS1, (const hf*)(wl + W_IN1), MTOT, NP1, DM, DM, DM}; pg8::StaticOrder S; S.init(MTOT, NP1, F.G, (int)blockIdx.x);
            pg8::EpiIn E{QKVN, (hf*)(ws + A_KR), (hf*)(ws + A_PHY), (hf*)(ws + A_DQ), (hf*)(ws + A_DK), (hf*)(ws + A_DV), ss1, biasl + B_IN, SS + (size_t)(SS_Q + l) * MTOT, SS + (size_t)(SS_KV + l) * MTOT};
            pg8::gemm_phase(F.lds, g, S, E); }
        SEAMT(pb + 0, 0);
        if (PHM(2) && IN(pb + 1)) { LAUNDER(Fl); prep_rope(Fl, p); prep_hyena(Fl, p, l, ctx_live);
            if (l + 1 < DEPTH) convert_layer(Fl, p, l + 1, ws + WS_WT + (size_t)((l + 1) & 1) * W_LAYER); }
        SEAMT(pb + 1, 1);
        if (PHM(3) && IN(pb + 2)) for (int rep = 0; rep < NREP(3); ++rep) { pg8::Gemm g{QKVN, (const hf*)(wl + W_UP), MTOT, NUP, KUP, KUP, KUP}; pg8::StaticOrder S; S.init(MTOT, NUP, F.G, (int)blockIdx.x);
            pg8::EpiUp E{QKV, SS + (size_t)(SS_Q + l) * MTOT, SS + (size_t)(SS_KV + l) * MTOT}; pg8::gemm_phase(F.lds, g, S, E); }
        SEAMT(pb + 2, 2);
        if (PHM(4) && IN(pb + 3)) for (int rep = 0; rep < NREP(4); ++rep) {
            LAUNDER(Fl);
            PROF_MARK(14);
            const int n_mla = 2048 + (ctx_live ? 256 : 0);
            if (PHM(13)) for (int rp = 0; rp < NREP(13); ++rp) for (int id = F.vcu; id < n_mla; id += F.G) {
                if (id < 2048) { const int qb = id & 7, h = (id >> 3) & 7, b = id >> 6; att::attn_unit<true>(Fl, p, l, h, b * SEQ + qb * 256, qb * 256, b * SEQ, 32, NLAT + b * CTXL); }
                else { const int i2 = id - 2048, h = i2 & 7, b = i2 >> 3; att::attn_unit<true>(Fl, p, l, h, NLAT + b * CTXL, -1, 0, 0, NLAT + b * CTXL); }
            }
            PROF_MARK(11);
            const int n_df = 1024 + (ctx_live ? 128 : 0);
            if (PHM(14)) for (int rp = 0; rp < NREP(14); ++rp) for (int id = F.vcu; id < n_df; id += F.G) {
                if (id < 1024) { const int qb = id & 7, h = (id >> 3) & 3, b = id >> 5; att::attn_unit<false>(Fl, p, l, h, b * SEQ + qb * 256, qb * 256, b * SEQ, 32, NLAT + b * CTXL); }
                else { const int i2 = id - 1024, h = i2 & 3, b = i2 >> 2; att::attn_unit<false>(Fl, p, l, h, NLAT + b * CTXL, -1, 0, 0, NLAT + b * CTXL); }
            }
            PROF_MARK(12);
            if (PHM(15)) for (int rp = 0; rp < NREP(15); ++rp) for (int c = F.vcu; c < 256; c += F.G)
                hyena_unit<SEQ>(Fl, (const hf*)(ws + WS_RF) + ((size_t)l * 256 + c) * 4096, (const hf*)(ws + A_UT) + (size_t)c * NLAT, (const hf*)(ws + A_X0T) + (size_t)c * NLAT, Y + 512 + c);
            if (PHM(16) && ctx_live) for (int rp = 0; rp < NREP(15); ++rp) for (int c = F.vcu; c < 256; c += F.G)
                hyena_unit<CTXL>(Fl, (const hf*)(ws + WS_RFC) + ((size_t)l * 256 + c) * 512, (const hf*)(ws + A_UTC) + (size_t)c * NCTX, (const hf*)(ws + A_X0TC) + (size_t)c * NCTX, Y + (size_t)NLAT * DM + 512 + c);
            __syncthreads();
            PROF_MARK(13);
        }
        SEAMT(pb + 3, 3);
        if (PHM(5) && IN(pb + 4)) for (int rep = 0; rep < NREP(5); ++rep) { pg8::Gemm g{XS1, (const hf*)(wl + W_ING), Mrows, NGATE, DM, DM, DM}; pg8::StaticOrder S; S.init(Mrows, NGATE, F.G, (int)blockIdx.x);
            pg8::EpiGate8 E{Gt, ss1, biasl + B_G}; pg8::gemm_phase(F.lds, g, S, E); }
        SEAMT(pb + 4, 4);
        if (PHM(6) && IN(pb + 5)) for (int rep = 0; rep < NREP(6); ++rep) { pg8::Gemm g{Y, (const hf*)(wl + W_BR), Mrows, DM, DM, DM, DM}; pg8::StaticOrder S; S.init(Mrows, DM, F.G, (int)blockIdx.x);
            pg8::EpiMerge E{MM, Gt}; pg8::gemm_phase(F.lds, g, S, E); }
        SEAMT(pb + 5, 5);
        if (PHM(7) && IN(pb + 6)) { pg8::Gemm g{MM, (const hf*)(wl + W_OUT), Mrows, DM, DM, DM, DM}; pg8::StaticOrder S; S.init(Mrows, DM, F.G, (int)blockIdx.x);
            pg8::EpiResidX<true, true> E{X16, modl + 2 * DM, XS2, gsl + (size_t)NMODV * DM, ss2}; pg8::gemm_phase(F.lds, g, S, E); }
        SEAMT(pb + 6, 6);
        if (PHM(9) && IN(pb + 7)) for (int rep = 0; rep < NREP(9); ++rep) { pg8::Gemm g{XS2, (const hf*)(wl + W_FC1), Mrows, DFF, DM, DM, DM}; pg8::StaticOrder S; S.init(Mrows, DFF, F.G, (int)blockIdx.x);
            pg8::EpiHalf<2, true> E{HID, DFF, ss2, biasl + B_FC1}; pg8::gemm_phase(F.lds, g, S, E); }
        SEAMT(pb + 7, 7);
        if (PHM(10) && IN(pb + 8)) { pg8::Gemm g{HID, (const hf*)(wl + W_FC2), Mrows, DM, DFF, DFF, DFF}; pg8::StaticOrder S; S.init(Mrows, DM, F.G, (int)blockIdx.x);
            if (ctx_live) { pg8::EpiResidX<true, true> E{X16, modl + 5 * DM, XS1, gsl + (size_t)2 * NMODV * DM, ss1 + MTOT}; pg8::gemm_phase(F.lds, g, S, E); }
            else { pg8::EpiResidX<false, true> E{X16, modl + 5 * DM, nullptr, nullptr, SS + (size_t)SS_F * MTOT}; pg8::gemm_phase(F.lds, g, S, E); } }
        SEAMT(pb + 8, 8);
    }
    if (PHM(12) && IN(NPHASE - 1)) { LAUNDER(Fl); final_norm_phase(Fl, X16, p.out, p.in[I_FNG], SS + (size_t)SS_F * MTOT); }
    PROF_MARK(10);
    if (PROF_SEL >= 0 && blockIdx.x == 0 && F.tid == 0) { const unsigned long long t0 = __builtin_amdgcn_s_memrealtime(); const unsigned long long d = (unsigned long long)PROF_K * prof[PROF_SEL];
        while (__builtin_amdgcn_s_memrealtime() - t0 < d) __builtin_amdgcn_s_sleep(8); }
#undef IN
#undef SEAM
}

extern "C" void kernel_launch(void* const* d_in, const int* in_sizes, int n_in, void* d_out, int out_size, void* d_ws, size_t ws_size, hipStream_t stream) {
    static int grid = 0;
    if (grid == 0) {
        if (n_in != 35 || in_sizes[0] != NLAT * DM || out_size != NLAT * DM || ws_size < WS_END) {
            fprintf(stderr, "kernel_launch: unexpected shapes: n_in %d in0 %d out %d ws %zu (need %zu); nothing launched\n", n_in, n_in > 0 ? in_sizes[0] : -1, out_size, ws_size, (size_t)WS_END); grid = -1; return; }
        int dev = 0, cus = 0, per_cu = 0;
        if (hipGetDevice(&dev) != hipSuccess || hipDeviceGetAttribute(&cus, hipDeviceAttributeMultiprocessorCount, dev) != hipSuccess) { fprintf(stderr, "kernel_launch: device query failed\n"); grid = -1; return; }
        if (hipFuncSetAttribute((const void*)fwd_kernel, hipFuncAttributeMaxDynamicSharedMemorySize, LDS_BYTES) != hipSuccess) { fprintf(stderr, "kernel_launch: hipFuncSetAttribute failed\n"); grid = -1; return; }
        if (hipOccupancyMaxActiveBlocksPerMultiprocessor(&per_cu, (const void*)fwd_kernel, 512, LDS_BYTES) != hipSuccess || per_cu < 1)
            fprintf(stderr, "kernel_launch: note: occupancy query reports %d workgroups per CU\n", per_cu);
        (void)hipGetLastError();
        grid = cus;
    }
    if (grid < 0) return;
    if (hipMemsetAsync((char*)d_ws + WS_BAR, 0, WS_ZERO_BYTES, stream) != hipSuccess) { fprintf(stderr, "kernel_launch: memset failed\n"); return; }
    Params P{};
    for (int i = 0; i < 35; ++i) P.in[i] = (const float*)d_in[i];
    P.out = (float*)d_out; P.ws = (unsigned char*)d_ws;
#if MK_FUSED
    P.ph_lo = 0; P.ph_hi = NPHASE;
    hipLaunchKernelGGL(fwd_kernel, dim3(grid), dim3(512), LDS_BYTES, stream, P);
#else
    for (int ph = 0; ph < NPHASE; ++ph) { P.ph_lo = ph; P.ph_hi = ph + 1; hipLaunchKernelGGL(fwd_kernel, dim3(grid), dim3(512), LDS_BYTES, stream, P); }
#endif
    const hipError_t le = hipPeekAtLastError();
    if (le != hipSuccess) fprintf(stderr, "kernel_launch: launch failed: %s\n", hipGetErrorName(le));
}
```

```cpp
#include <hip/hip_runtime.h>
#include <cstdio>
#include <cstdint>

#ifndef MK_FUSED
#define MK_FUSED 1
#endif

#define LAS __attribute__((address_space(3)))
#define GAS __attribute__((address_space(1)))
typedef _Float16 hf;
typedef _Float16 hf2 __attribute__((ext_vector_type(2)));
typedef _Float16 hf4 __attribute__((ext_vector_type(4)));
typedef _Float16 hf8 __attribute__((ext_vector_type(8)));
typedef short s16x4 __attribute__((ext_vector_type(4)));
typedef float f32x2 __attribute__((ext_vector_type(2)));
typedef float f32x4 __attribute__((ext_vector_type(4)));
typedef float f32x16 __attribute__((ext_vector_type(16)));
typedef unsigned u32x2 __attribute__((ext_vector_type(2)));
typedef unsigned u32x4 __attribute__((ext_vector_type(4)));

constexpr int DM = 1024, NB = 32, SEQ = 2048, DEPTH = 4, CTXL = 256, GRIDW = 64;
constexpr int NLAT = NB * SEQ;
constexpr int NCTX = NB * CTXL;
constexpr int MTOT = NLAT + NCTX;
constexpr int D_IN = 5024, NP1 = 2048  , NGATE = 3072, DFF = 4096;
constexpr int C_PQ = 0, C_PKV = 256, C_PKR = 384, C_HY = 416, C_DQ = 1184, C_DK = 1440, C_DV = 1696, C_PG = 1952;
constexpr int NUP = 1792, KUP = 384;
constexpr int NMODV = 33, MODW = 6 * DM;
constexpr float EPS = 1e-6f;
constexpr float MLA_SCALE = 0.10206207261596575f;
constexpr float DF_SCALE = 0.17677669529663687f;

constexpr size_t al256(size_t x) { return (x + 255) / 256 * 256; }
constexpr size_t WS_BAR = 0, WS_BAR_BYTES = 65536;
constexpr size_t WS_SS = WS_BAR + WS_BAR_BYTES;
constexpr int SS_1 = 0, SS_2 = DEPTH, SS_F = 2 * DEPTH, SS_Q = 2 * DEPTH + 1, SS_KV = 3 * DEPTH + 1, SS_N = 4 * DEPTH + 1;
constexpr size_t WS_ZERO_BYTES = WS_BAR_BYTES + al256((size_t)SS_N * MTOT * 4);
constexpr size_t WS_MOD = WS_BAR + WS_ZERO_BYTES;
constexpr size_t WS_GS = WS_MOD + al256((size_t)DEPTH * NMODV * MODW * 4);
constexpr int NBIAS = 9216, B_IN = 0, B_G = 2048, B_FC1 = 5120;
constexpr size_t WS_BIAS = WS_GS + (size_t)DEPTH * 2 * NMODV * DM * 4;
constexpr size_t WS_ROPE = WS_BIAS + (size_t)DEPTH * NMODV * NBIAS * 4;
constexpr size_t WS_LAM = WS_ROPE + (size_t)SEQ * 32 * 4;
constexpr size_t WS_RF = WS_LAM + 256;
constexpr size_t WS_RFC = WS_RF + (size_t)DEPTH * 256 * 4096 * 2;
constexpr size_t WS_X16 = WS_RFC + (size_t)DEPTH * 256 * 512 * 2;
constexpr size_t WS_WT = WS_X16 + (size_t)MTOT * DM * 2;
constexpr size_t W_IN1 = 0, W_ING = W_IN1 + (size_t)NP1 * DM * 2, W_UP = W_ING + (size_t)NGATE * DM * 2, W_BR = W_UP + (size_t)NUP * KUP * 2,
                 W_OUT = W_BR + (size_t)DM * DM * 2, W_FC1 = W_OUT + (size_t)DM * DM * 2, W_FC2 = W_FC1 + (size_t)DFF * DM * 2, W_LAYER = W_FC2 + (size_t)DM * DFF * 2;
constexpr size_t WS_ARENA = WS_WT + 2 * W_LAYER;
constexpr size_t SZ_ROW1024 = (size_t)MTOT * 1024 * 2;
constexpr size_t A_B = WS_ARENA;
constexpr size_t A_C = A_B + SZ_ROW1024;
constexpr size_t A_Y = A_B, A_XS2 = A_B, A_BIG = A_C;
constexpr size_t A_QKVN = A_BIG;
constexpr size_t A_PHY = A_QKVN + (size_t)MTOT * KUP * 2;
constexpr size_t A_KR = A_BIG + (size_t)MTOT * NGATE;
constexpr size_t A_DQ = A_KR + (size_t)MTOT * 32 * 2;
constexpr size_t A_DK = A_DQ + (size_t)MTOT * 256 * 2;
constexpr size_t A_DV = A_DK + (size_t)MTOT * 256 * 2;
constexpr size_t A_QKV = A_DV + (size_t)MTOT * 256 * 2;
constexpr size_t A_BIG_END = A_QKV + (size_t)MTOT * NUP * 2;
static_assert(A_PHY + (size_t)MTOT * 768 * 2 <= A_KR, "QKVN + PHY must fit under the gate bytes");
constexpr size_t O_UT = SZ_ROW1024, O_X0T = O_UT + (size_t)256 * NLAT * 2, O_UTC = O_X0T + (size_t)256 * NLAT * 2, O_X0TC = O_UTC + (size_t)256 * NCTX * 2, O_END = O_X0TC + (size_t)256 * NCTX * 2;
static_assert(O_END <= (size_t)NLAT * DM * 4, "d_out scratch overflow");
constexpr size_t A_G = A_BIG;
constexpr size_t A_HID = A_C;
constexpr size_t WS_END = (A_BIG_END > A_HID + (size_t)MTOT * DFF * 2) ? A_BIG_END : A_HID + (size_t)MTOT * DFF * 2;
static_assert(WS_END <= (size_t)1024 * 1024 * 1024, "workspace map exceeds 1 GiB");

constexpr int LDS_BYTES = 147456;
constexpr int LDS_MISC = LDS_BYTES - 64;

__device__ __forceinline__ unsigned pkh(float lo, float hi) { f32x2 v = {lo, hi}; hf2 h = __builtin_convertvector(v, hf2); return __builtin_bit_cast(unsigned, h); }
__device__ __forceinline__ float wave_sum(float v) {
#pragma unroll
    for (int o = 1; o < 64; o <<= 1) v += __shfl_xor(v, o);
    return v;
}
#define LDS_WAIT() asm volatile("s_waitcnt lgkmcnt(0)" ::: "memory")
#define VM_WAIT() asm volatile("s_waitcnt vmcnt(0)" ::: "memory")

#define XB_TMO      128
#define XB_XCNT(j)  (256  + 64 * (j))
#define XB_XSUB(j)  (1280 + 64 * (j))
#define XB_XGEN(j)  (2304 + 64 * (j))
#define XB_TOP      3328
#define XB_TOPGEN   3392
#define XCD_BAR_WORDS 3456
#define XB_SPIN_CAP (1u << 22)
__device__ __forceinline__ unsigned xb_ld(unsigned* p)              { return __hip_atomic_load(p, __ATOMIC_RELAXED, __HIP_MEMORY_SCOPE_AGENT); }
__device__ __forceinline__ unsigned xb_add(unsigned* p, unsigned v) { return __hip_atomic_fetch_add(p, v, __ATOMIC_RELAXED, __HIP_MEMORY_SCOPE_AGENT); }
__device__ __forceinline__ unsigned xb_xcc_id() { return (unsigned)__builtin_amdgcn_s_getreg((3 << 11) | 20) & 0xFu; }
#define XB_SPIN(cond, bar) do { unsigned _sp = 0; while (cond) { __builtin_amdgcn_s_sleep(1); \
    if ((++_sp & 255u) == 0u) { if (xb_ld(&(bar)[XB_TMO])) break; if (_sp > XB_SPIN_CAP) { atomicAdd(&(bar)[XB_TMO], 1u); break; } } } } while (0)
struct XcdBarrier { unsigned* bar; unsigned x; volatile LAS unsigned* st; };
__device__ __forceinline__ XcdBarrier xcd_barrier_post(unsigned* bar, volatile LAS unsigned* st) {
    XcdBarrier b; b.bar = bar; b.x = xb_xcc_id(); b.st = st;
    if (threadIdx.x == 0) (void)xb_add(&bar[XB_XCNT(b.x)], 1u);
    return b;
}
__device__ __forceinline__ void xcd_barrier_complete(unsigned* bar, unsigned x, unsigned& nloc, unsigned& nx) {
    const unsigned G = gridDim.x * gridDim.y * gridDim.z;
    unsigned sum, cnt, mine, sp = 0u;
    for (;;) {
        sum = 0u; cnt = 0u; mine = 0u;
#pragma unroll
        for (unsigned j = 0; j < 16; ++j) { const unsigned c = xb_ld(&bar[XB_XCNT(j)]); sum += c; cnt += (c > 0u) ? 1u : 0u; mine = (j == x) ? c : mine; }
        if (sum == G) break;
        __builtin_amdgcn_s_sleep(1);
        if ((++sp & 255u) == 0u) { if (xb_ld(&bar[XB_TMO])) break; if (sp > XB_SPIN_CAP) { atomicAdd(&bar[XB_TMO], 1u); break; } }
    }
    nloc = mine > 0u ? mine : 1u; nx = cnt > 0u ? cnt : 1u;
}
__device__ __forceinline__ void xcd_barrier(const XcdBarrier& b) {
    asm volatile("s_waitcnt vmcnt(0)" ::: "memory");
    __syncthreads();
    if (threadIdx.x == 0) {
        unsigned* bar = b.bar;
        __builtin_amdgcn_s_waitcnt(0);
        unsigned nloc = b.st[0], nx = b.st[1];
        if (nloc == 0u) { xcd_barrier_complete(bar, b.x, nloc, nx); b.st[0] = nloc; b.st[1] = nx; }
        const unsigned old = xb_add(&bar[XB_XSUB(b.x)], 1u);
        const unsigned gen = old / nloc;
        if (old + 1u == (gen + 1u) * nloc) {
            __builtin_amdgcn_fence(__ATOMIC_RELEASE, "agent");
            asm volatile("s_waitcnt vmcnt(0)" ::: "memory");
            const unsigned og = xb_add(&bar[XB_TOP], 1u);
            const unsigned tg = og / nx;
            if (og + 1u == (tg + 1u) * nx) xb_add(&bar[XB_TOPGEN], 1u);
            else XB_SPIN(xb_ld(&bar[XB_TOPGEN]) == tg, bar);
            __builtin_amdgcn_fence(__ATOMIC_ACQUIRE, "agent");
            xb_add(&bar[XB_XGEN(b.x)], 1u);
            asm volatile("s_waitcnt vmcnt(0)" ::: "memory");
        } else {
            XB_SPIN(xb_ld(&bar[XB_XGEN(b.x)]) == gen, bar);
            __builtin_amdgcn_fence(__ATOMIC_ACQUIRE, "agent");
            asm volatile("s_waitcnt vmcnt(0)" ::: "memory");
        }
    }
    __syncthreads();
}

namespace pg8 {
constexpr int BM = 256, BK = 64, HALF = 128, HTB = HALF * BK * 2, STAGE_BYTES = 8 * HTB, NXCD = 8, WGM = 8;
__host__ __device__ __forceinline__ int lds_byte(int r, int c) { const int st = (r >> 4) * 2 + (c >> 5), rr = r & 15, cc = c & 31, ob = rr * 64 + cc * 2; return st * 1024 + (ob ^ (((ob >> 9) & 1) << 5)); }
__host__ __device__ __forceinline__ void stage_rc(int b, int& R, int& C) { const int st = b / 1024, sb = b % 1024, swz = sb ^ (((sb >> 9) & 1) << 5); R = (st >> 1) * 16 + swz / 64; C = (st & 1) * 32 + (swz % 64) / 2; }
__host__ __device__ __forceinline__ int perm32(int rho) { const int n = rho >> 4, i = rho & 15; return 8 * (i >> 2) + 4 * n + (i & 3); }
struct Unit { int pm, pn; };
struct Gemm { const hf* A; const hf* Bt; int M, N, K, lda, ldb; };
struct StaticOrder {
    int nM, nN, nwg, G, c;
    __host__ __device__ void init(int M, int N, int G_, int c_) { nM = M / BM; nN = N / BM; nwg = nM * nN; G = G_; c = c_; }
    __host__ __device__ bool next(int i, Unit& u) const {
        const long L = (long)i * G + c; if (L >= nwg) return false;
        int wgid = (int)L; { const int q = nwg / NXCD, r = nwg % NXCD, xcd = wgid % NXCD, off = wgid / NXCD; wgid = (xcd < r ? xcd * (q + 1) : r * (q + 1) + (xcd - r) * q) + off; }
        const int nig = WGM * nN, gid = wgid / nig, fm = gid * WGM, gsz = (nM - fm) < WGM ? (nM - fm) : WGM;
        u.pm = fm + ((wgid % nig) % gsz); u.pn = (wgid % nig) / gsz; return true;
    }
    __device__ __forceinline__ void a_ready(const Unit&) const {}
    __device__ __forceinline__ void done(const Unit&) const {}
};

template <int ACT  , bool NORM> struct EpiHalf {
    static constexpr bool PERM = true, AFTER_DRAIN = false, PROBE2 = false, MIDK = false;
    hf* O; int ldc; const float* ss; const float* bias;
    __device__ __forceinline__ void operator()(const f32x4 (&acc)[2][2][4][2], const Unit& u, int wr, int wc, int fr, int fq) const {
        const int row0 = u.pm * BM + wr * 64 + fr, col0 = u.pn * BM + wc * 32 + 8 * fq;
        f32x4 bv[2][2];
        if (NORM) { const int R0 = u.pm * BM; const int v = (R0 < NLAT) ? (R0 >> 11) : NB; const float* bp = bias + (size_t)v * NBIAS + col0;
#pragma unroll
            for (int bj = 0; bj < 2; ++bj)
#pragma unroll
                for (int n = 0; n < 2; ++n) bv[bj][n] = *(const f32x4*)(bp + bj * HALF + 4 * n); }
#pragma unroll
        for (int ai = 0; ai < 2; ++ai)
#pragma unroll
            for (int m = 0; m < 4; ++m) { const int r = row0 + ai * HALF + m * 16; hf* rowp = O + (size_t)r * ldc + col0;
                float rs = 1.f; if (NORM) rs = rsqrtf(ss[r] * (1.f / DM) + EPS);
#pragma unroll
                for (int bj = 0; bj < 2; ++bj) { f32x4 v0 = acc[ai][bj][m][0], v1 = acc[ai][bj][m][1];
                    if (NORM) { v0 = v0 * rs + bv[bj][0]; v1 = v1 * rs + bv[bj][1]; }
                    if (ACT == 1) {
#pragma unroll
                        for (int e = 0; e < 4; ++e) { v0[e] = __builtin_amdgcn_rcpf(1.f + __builtin_amdgcn_exp2f(-1.4426950408889634f * v0[e])); v1[e] = __builtin_amdgcn_rcpf(1.f + __builtin_amdgcn_exp2f(-1.4426950408889634f * v1[e])); } }
                    if (ACT == 2) {
#pragma unroll
                        for (int e = 0; e < 4; ++e) { const float a = fmaxf(v0[e], 0.f), b = fmaxf(v1[e], 0.f); v0[e] = a * a; v1[e] = b * b; } }
                    u32x4 w; w.x = pkh(v0[0], v0[1]); w.y = pkh(v0[2], v0[3]); w.z = pkh(v1[0], v1[1]); w.w = pkh(v1[2], v1[3]);
                    *(u32x4*)(rowp + bj * HALF) = w; } }
    }
};
struct EpiGate8 {
    static constexpr bool PERM = true, AFTER_DRAIN = false, PROBE2 = false, MIDK = false;
    unsigned char* O; const float* ss; const float* bias;
    __device__ __forceinline__ void operator()(const f32x4 (&acc)[2][2][4][2], const Unit& u, int wr, int wc, int fr, int fq) const {
        const int R0 = u.pm * BM, row0 = R0 + wr * 64 + fr, col0 = u.pn * BM + wc * 32 + 8 * fq;
        const int v = (R0 < NLAT) ? (R0 >> 11) : NB; const float* bp = bias + (size_t)v * NBIAS + col0;
        f32x4 bv[2][2];
#pragma unroll
        for (int bj = 0; bj < 2; ++bj) { bv[bj][0] = *(const f32x4*)(bp + bj * HALF); bv[bj][1] = *(const f32x4*)(bp + bj * HALF + 4); }
#pragma unroll
        for (int ai = 0; ai < 2; ++ai)
#pragma unroll
            for (int m = 0; m < 4; ++m) { const int r = row0 + ai * HALF + m * 16; const float rs = rsqrtf(ss[r] * (1.f / DM) + EPS);
#pragma unroll
                for (int bj = 0; bj < 2; ++bj) { const f32x4 v0 = acc[ai][bj][m][0] * rs + bv[bj][0], v1 = acc[ai][bj][m][1] * rs + bv[bj][1];
                    unsigned q[8];
#pragma unroll
                    for (int e = 0; e < 4; ++e) { const float g0 = __builtin_amdgcn_rcpf(1.f + __builtin_amdgcn_exp2f(-1.4426950408889634f * v0[e])), g1 = __builtin_amdgcn_rcpf(1.f + __builtin_amdgcn_exp2f(-1.4426950408889634f * v1[e]));
                        q[e] = (unsigned)fmaxf(1.f, __builtin_rintf(255.f * g0)); q[4 + e] = (unsigned)fmaxf(1.f, __builtin_rintf(255.f * g1)); }
                    u32x2 w; w.x = q[0] | (q[1] << 8) | (q[2] << 16) | (q[3] << 24); w.y = q[4] | (q[5] << 8) | (q[6] << 16) | (q[7] << 24);
                    *(u32x2*)(O + (size_t)r * NGATE + col0 + bj * HALF) = w; } }
    }
};
struct EpiIn {
    static constexpr bool PERM = true, AFTER_DRAIN = false, PROBE2 = false, MIDK = false;
    hf* QKVNo; hf* KRo; hf* PHYo; hf* DQo; hf* DKo; hf* DVo; const float* ss; const float* bias; float* ssq; float* sskv;
    __device__ __forceinline__ void operator()(const f32x4 (&acc)[2][2][4][2], const Unit& u, int wr, int wc, int fr, int fq) const {
        const int R0 = u.pm * BM, row0 = R0 + wr * 64 + fr, col0 = u.pn * BM + wc * 32 + 8 * fq;
        const int v = (R0 < NLAT) ? (R0 >> 11) : NB; const float* bp = bias + (size_t)v * NBIAS + col0;
        f32x4 bv[2][2]; hf* dst[2]; int ld[2];
#pragma unroll
        for (int bj = 0; bj < 2; ++bj) { const int c8 = col0 + bj * HALF;
            bv[bj][0] = *(const f32x4*)(bp + bj * HALF); bv[bj][1] = *(const f32x4*)(bp + bj * HALF + 4);
            if (c8 < C_PKR) { dst[bj] = QKVNo + c8; ld[bj] = KUP; }
            else if (c8 < C_HY) { dst[bj] = KRo + (c8 - C_PKR); ld[bj] = 32; }
            else if (c8 < C_DQ) { dst[bj] = PHYo + (c8 - C_HY); ld[bj] = 768; }
            else if (c8 < C_DK) { dst[bj] = DQo + (c8 - C_DQ); ld[bj] = 256; }
            else if (c8 < C_DV) { dst[bj] = DKo + (c8 - C_DK); ld[bj] = 256; }
            else if (c8 < C_PG) { dst[bj] = DVo + (c8 - C_DV); ld[bj] = 256; }
            else { dst[bj] = nullptr; ld[bj] = 0; } }
        const int nstat = (u.pn == 0) ? 2 : (u.pn == 1 ? 1 : 0);
        float* sp = (u.pn == 0) ? ssq : sskv;
#pragma unroll
        for (int ai = 0; ai < 2; ++ai)
#pragma unroll
            for (int m = 0; m < 4; ++m) { const int r = row0 + ai * HALF + m * 16; const float rs = rsqrtf(ss[r] * (1.f / DM) + EPS); float sq = 0.f;
#pragma unroll
                for (int bj = 0; bj < 2; ++bj) { const f32x4 v0 = acc[ai][bj][m][0] * rs + bv[bj][0], v1 = acc[ai][bj][m][1] * rs + bv[bj][1];
                    if (bj < nstat) sq += (v0[0] * v0[0] + v0[1] * v0[1]) + (v0[2] * v0[2] + v0[3] * v0[3]) + (v1[0] * v1[0] + v1[1] * v1[1]) + (v1[2] * v1[2] + v1[3] * v1[3]);
                    if (dst[bj]) { u32x4 w; w.x = pkh(v0[0], v0[1]); w.y = pkh(v0[2], v0[3]); w.z = pkh(v1[0], v1[1]); w.w = pkh(v1[2], v1[3]); *(u32x4*)(dst[bj] + (size_t)r * ld[bj]) = w; } }
                if (nstat) { sq += __shfl_xor(sq, 16); sq += __shfl_xor(sq, 32);
                    if (fq == 0) (void)__hip_atomic_fetch_add(sp + r, sq, __ATOMIC_RELAXED, __HIP_MEMORY_SCOPE_AGENT); } }
    }
};
struct EpiUp {
    static constexpr bool PERM = true, AFTER_DRAIN = false, PROBE2 = false, MIDK = false;
    hf* O; const float* ssq; const float* sskv;
    __device__ __forceinline__ void operator()(const f32x4 (&acc)[2][2][4][2], const Unit& u, int wr, int wc, int fr, int fq) const {
        const int row0 = u.pm * BM + wr * 64 + fr, col0 = u.pn * BM + wc * 32 + 8 * fq;
        const bool isq = u.pn < 3; const float* sp = isq ? ssq : sskv; const float invn = isq ? (1.f / 256.f) : (1.f / 128.f);
#pragma unroll
        for (int ai = 0; ai < 2; ++ai)
#pragma unroll
            for (int m = 0; m < 4; ++m) { const int r = row0 + ai * HALF + m * 16; hf* rowp = O + (size_t)r * NUP + col0; const float rs = rsqrtf(sp[r] * invn + EPS);
#pragma unroll
                for (int bj = 0; bj < 2; ++bj) { const f32x4 v0 = acc[ai][bj][m][0] * rs, v1 = acc[ai][bj][m][1] * rs;
                    u32x4 w; w.x = pkh(v0[0], v0[1]); w.y = pkh(v0[2], v0[3]); w.z = pkh(v1[0], v1[1]); w.w = pkh(v1[2], v1[3]);
                    *(u32x4*)(rowp + bj * HALF) = w; } }
    }
};
template <bool FIRST> struct EpiGated {
    static constexpr bool PERM = true, AFTER_DRAIN = false, PROBE2 = false, MIDK = false;
    hf* MMo; const hf* G; int goff;
    __device__ __forceinline__ void operator()(const f32x4 (&acc)[2][2][4][2], const Unit& u, int wr, int wc, int fr, int fq) const {
        const int row0 = u.pm * BM + wr * 64 + fr, col0 = u.pn * BM + wc * 32 + 8 * fq;
#pragma unroll
        for (int ai = 0; ai < 2; ++ai)
#pragma unroll
            for (int m = 0; m < 4; ++m) { const size_t r = (size_t)(row0 + ai * HALF + m * 16);
#pragma unroll
                for (int bj = 0; bj < 2; ++bj) { const f32x4 v0 = acc[ai][bj][m][0], v1 = acc[ai][bj][m][1];
                    const hf8 g = *(const hf8*)(G + r * NGATE + goff + col0 + bj * HALF);
                    hf* mp = MMo + r * DM + col0 + bj * HALF;
                    float o[8];
#pragma unroll
                    for (int e = 0; e < 4; ++e) { o[e] = (float)g[e] * v0[e]; o[4 + e] = (float)g[4 + e] * v1[e]; }
                    if (!FIRST) { const hf8 p = *(const hf8*)mp;
#pragma unroll
                        for (int e = 0; e < 8; ++e) o[e] += (float)p[e]; }
                    u32x4 w; w.x = pkh(o[0], o[1]); w.y = pkh(o[2], o[3]); w.z = pkh(o[4], o[5]); w.w = pkh(o[6], o[7]);
                    *(u32x4*)mp = w; } }
    }
};
struct EpiMerge {
    static constexpr bool PERM = true, AFTER_DRAIN = false, PROBE2 = false, MIDK = true;
    static constexpr int MID1 = 8, MID2 = 12;
    hf* MMo; const unsigned char* G;
    __device__ __forceinline__ void mid(f32x4 (&acc)[2][2][4][2], const Unit& u, int which, int wr, int wc, int fr, int fq) const {
        asm volatile("" : "+v"(fr), "+v"(fq));
        const int row0 = u.pm * BM + wr * 64 + fr, col0 = u.pn * BM + wc * 32 + 8 * fq; const int gnum = which ? 1024 : 0, gden = which ? 2048 : 1024;
#pragma unroll
        for (int ai = 0; ai < 2; ++ai) {
            u32x2 gn[4][2], gd[4][2];
#pragma unroll
            for (int m = 0; m < 4; ++m) { const unsigned char* gr = G + (size_t)(row0 + ai * HALF + m * 16) * NGATE + col0;
#pragma unroll
                for (int bj = 0; bj < 2; ++bj) { gn[m][bj] = *(const u32x2*)(gr + gnum + bj * HALF); gd[m][bj] = *(const u32x2*)(gr + gden + bj * HALF); } }
#pragma unroll
            for (int m = 0; m < 4; ++m)
#pragma unroll
                for (int bj = 0; bj < 2; ++bj)
#pragma unroll
                    for (int e = 0; e < 4; ++e) {
                        acc[ai][bj][m][0][e] *= (float)((gn[m][bj].x >> (8 * e)) & 255u) * __builtin_amdgcn_rcpf((float)((gd[m][bj].x >> (8 * e)) & 255u));
                        acc[ai][bj][m][1][e] *= (float)((gn[m][bj].y >> (8 * e)) & 255u) * __builtin_amdgcn_rcpf((float)((gd[m][bj].y >> (8 * e)) & 255u)); }
            asm volatile("" ::: "memory");
        }
    }
    __device__ __forceinline__ void operator()(const f32x4 (&acc)[2][2][4][2], const Unit& u, int wr, int wc, int fr, int fq) const {
        const int row0 = u.pm * BM + wr * 64 + fr, col0 = u.pn * BM + wc * 32 + 8 * fq;
#pragma unroll
        for (int ai = 0; ai < 2; ++ai)
#pragma unroll
            for (int m = 0; m < 4; ++m) { const size_t r = (size_t)(row0 + ai * HALF + m * 16);
#pragma unroll
                for (int bj = 0; bj < 2; ++bj) { const f32x4 v0 = acc[ai][bj][m][0], v1 = acc[ai][bj][m][1];
                    const u32x2 g = *(const u32x2*)(G + r * NGATE + 2048 + col0 + bj * HALF);
                    float o[8];
#pragma unroll
                    for (int e = 0; e < 4; ++e) { o[e] = (float)((g.x >> (8 * e)) & 255u) * (1.f / 255.f) * v0[e]; o[4 + e] = (float)((g.y >> (8 * e)) & 255u) * (1.f / 255.f) * v1[e]; }
                    u32x4 w; w.x = pkh(o[0], o[1]); w.y = pkh(o[2], o[3]); w.z = pkh(o[4], o[5]); w.w = pkh(o[6], o[7]);
                    *(u32x4*)(MMo + r * DM + col0 + bj * HALF) = w; } }
    }
};
template <bool XS, bool STAT> struct EpiResidX {
    static constexpr bool PERM = true, AFTER_DRAIN = false, PROBE2 = false, MIDK = false;
    hf* x16; const float* gate;
    hf* xsout; const float* gs; float* ss;
    __device__ __forceinline__ void operator()(const f32x4 (&acc)[2][2][4][2], const Unit& u, int wr, int wc, int fr, int fq) const {
        const int R0 = u.pm * BM; const int v = (R0 < NLAT) ? (R0 >> 11) : NB;
        const int rglob = R0 + wr * 64 + fr, col0 = u.pn * BM + wc * 32 + 8 * fq;
        const float* gp = gate + (size_t)v * MODW + col0; const float* gsp = gs + (size_t)v * DM + col0;
        float sq[2][4];
#pragma unroll
        for (int ai = 0; ai < 2; ++ai)
#pragma unroll
            for (int m = 0; m < 4; ++m) sq[ai][m] = 0.f;
#pragma unroll
        for (int bj = 0; bj < 2; ++bj) {
            const f32x4 g0 = *(const f32x4*)(gp + bj * HALF), g1 = *(const f32x4*)(gp + bj * HALF + 4);
            f32x4 s0 = {1.f, 1.f, 1.f, 1.f}, s1 = s0; if (XS) { s0 = *(const f32x4*)(gsp + bj * HALF); s1 = *(const f32x4*)(gsp + bj * HALF + 4); }
#pragma unroll
            for (int ai = 0; ai < 2; ++ai)
#pragma unroll
                for (int m = 0; m < 4; ++m) { const int rr = ai * HALF + m * 16; const size_t off = (size_t)(rglob + rr) * DM + col0 + bj * HALF;
                    const hf8 xv = *(const hf8*)(x16 + off);
                    const f32x4 x0 = {(float)xv[0], (float)xv[1], (float)xv[2], (float)xv[3]}, x1 = {(float)xv[4], (float)xv[5], (float)xv[6], (float)xv[7]};
                    const f32x4 n0 = x0 + g0 * acc[ai][bj][m][0], n1 = x1 + g1 * acc[ai][bj][m][1];
                    { u32x4 w; w.x = pkh(n0[0], n0[1]); w.y = pkh(n0[2], n0[3]); w.z = pkh(n1[0], n1[1]); w.w = pkh(n1[2], n1[3]); *(u32x4*)(x16 + off) = w; }
                    if (STAT) sq[ai][m] += (n0[0] * n0[0] + n0[1] * n0[1]) + (n0[2] * n0[2] + n0[3] * n0[3]) + (n1[0] * n1[0] + n1[1] * n1[1]) + (n1[2] * n1[2] + n1[3] * n1[3]);
                    if (XS) { const f32x4 a = n0 * s0, b = n1 * s1; u32x4 w; w.x = pkh(a[0], a[1]); w.y = pkh(a[2], a[3]); w.z = pkh(b[0], b[1]); w.w = pkh(b[2], b[3]);
                        *(u32x4*)(xsout + off) = w; } }
        }
        if (STAT) {
#pragma unroll
            for (int ai = 0; ai < 2; ++ai)
#pragma unroll
                for (int m = 0; m < 4; ++m) { float t = sq[ai][m]; t += __shfl_xor(t, 16); t += __shfl_xor(t, 32);
                    if (fq == 0) (void)__hip_atomic_fetch_add(ss + rglob + ai * HALF + m * 16, t, __ATOMIC_RELAXED, __HIP_MEMORY_SCOPE_AGENT); }
        }
    }
};

template <class Epi, class Sched, bool ALIGN_EPI = true>
__device__ __forceinline__ void gemm_phase(LAS unsigned char* lds, const Gemm g, const Sched& S, const Epi& E) {
    int tid = threadIdx.x; asm volatile("" : "+v"(tid));
    const int wid = __builtin_amdgcn_readfirstlane(tid >> 6), lane = tid & 63, wr = wid >> 2, wc = wid & 3, fr = lane & 15, fq = lane >> 4;
    const int K = g.K, nt = K / BK;
    unsigned voffA[2], voffB[2];
#pragma unroll
    for (int i = 0; i < 2; ++i) { int R, C; stage_rc(tid * 16 + i * 8192, R, C); const int Rb = Epi::PERM ? ((R & ~31) + perm32(R & 31)) : R;
        voffA[i] = (unsigned)(R * g.lda + C) * 2u; voffB[i] = (unsigned)(Rb * g.ldb + C) * 2u; }
    const size_t kstep = (size_t)(BK * 2);
    const size_t hstepA = (size_t)HALF * g.lda * 2, hstepB = (size_t)HALF * g.ldb * 2;
    const size_t tstepA = 2 * hstepA, tstepB = 2 * hstepB;
    const unsigned ldsw = (unsigned)wid * 1024u;
    const int aoff = lds_byte(wr * 64 + fr, fq * 8), boff = lds_byte(wc * 32 + fr, fq * 8);
#define PG8_SA(b, h) (((b) * 2 + (h)) * HTB)
#define PG8_SB(b, h) ((4 + (b) * 2 + (h)) * HTB)
#define PG8_STAGE(bufoff, gbase, voff) do { _Pragma("unroll") for (int _i = 0; _i < 2; ++_i) \
        __builtin_amdgcn_global_load_lds((const unsigned*)((const char*)(gbase) + (voff)[_i]), (LAS unsigned*)(lds + (bufoff) + ldsw + _i * 8192), 16, 0, 0); } while (0)
#define PG8_LDA(dst, b, h) do { _Pragma("unroll") for (int m = 0; m < 4; ++m) _Pragma("unroll") for (int k = 0; k < 2; ++k) dst[m][k] = *(const LAS hf8*)(lds + PG8_SA(b, h) + aoff + m * 2048 + k * 1024); } while (0)
#define PG8_LDB(dst, b, h) do { _Pragma("unroll") for (int n = 0; n < 2; ++n) _Pragma("unroll") for (int k = 0; k < 2; ++k) dst[n][k] = *(const LAS hf8*)(lds + PG8_SB(b, h) + boff + n * 2048 + k * 1024); } while (0)
#define PG8_MMA(ai, bj, At, Bt) do { __builtin_amdgcn_s_setprio(1); _Pragma("unroll") for (int m = 0; m < 4; ++m) _Pragma("unroll") for (int n = 0; n < 2; ++n) _Pragma("unroll") for (int k = 0; k < 2; ++k) \
        acc[ai][bj][m][n] = __builtin_amdgcn_mfma_f32_16x16x32_f16(Bt[n][k], At[m][k], acc[ai][bj][m][n], 0, 0, 0); __builtin_amdgcn_s_setprio(0); } while (0)
#define PG8_WAIT_V(n) asm volatile("s_waitcnt vmcnt(" #n ")" ::: "memory")
#define PG8_WAIT_L(n) asm volatile("s_waitcnt lgkmcnt(" #n ")" ::: "memory")
#define PG8_BAR __builtin_amdgcn_s_barrier()
#define PG8_SCHED __builtin_amdgcn_sched_barrier(0)
    Unit cur, nxt; int ui = 0;
    if (!S.next(0, cur)) return;
    f32x4 acc[2][2][4][2];
#pragma unroll
    for (int a = 0; a < 2; ++a)
#pragma unroll
        for (int b = 0; b < 2; ++b)
#pragma unroll
            for (int m = 0; m < 4; ++m)
#pragma unroll
                for (int n = 0; n < 2; ++n) acc[a][b][m][n] = (f32x4){0.f, 0.f, 0.f, 0.f};
    hf8 At[4][2], B0[2][2], B1[2][2];
    const char* cA = (const char*)g.A + (size_t)cur.pm * tstepA; const char* cB = (const char*)g.Bt + (size_t)cur.pn * tstepB;
    S.a_ready(cur);
    PG8_STAGE(PG8_SB(0, 0), cB, voffB); PG8_STAGE(PG8_SB(0, 1), cB + hstepB, voffB); PG8_STAGE(PG8_SA(0, 0), cA, voffA); PG8_STAGE(PG8_SA(0, 1), cA + hstepA, voffA);
    if (wr == 1) PG8_BAR;
    PG8_WAIT_V(2); PG8_BAR;
    PG8_STAGE(PG8_SB(1, 0), cB + kstep, voffB); PG8_STAGE(PG8_SA(1, 0), cA + kstep, voffA); PG8_STAGE(PG8_SB(1, 1), cB + hstepB + kstep, voffB);
    PG8_WAIT_V(6); PG8_BAR;
    for (;;) {
        const bool has_next = S.next(ui + 1, nxt);
        const char* nA = has_next ? (const char*)g.A + (size_t)nxt.pm * tstepA : cA; const char* nB = has_next ? (const char*)g.Bt + (size_t)nxt.pn * tstepB : cB;
#pragma unroll 1
        for (int t = 0; t < nt; t += 2) {
            const bool last = (t == nt - 2);
            const char* a1 = cA + (size_t)(t + 1) * kstep;
            const char* a2 = last ? nA : cA + (size_t)(t + 2) * kstep; const char* b2 = last ? nB : cB + (size_t)(t + 2) * kstep;
            const char* a3 = a2 + kstep; const char* b3 = b2 + kstep;
            if (last && has_next) S.a_ready(nxt);
            if constexpr (Epi::MIDK) { if (t == Epi::MID1 || t == Epi::MID2) E.mid(acc, cur, t == Epi::MID1 ? 0 : 1, wr, wc, fr, fq); }
            PG8_LDB(B0, 0, 0); PG8_LDB(B1, 0, 1); PG8_SCHED; PG8_LDA(At, 0, 0); PG8_STAGE(PG8_SA(1, 1), a1 + hstepA, voffA);
            PG8_WAIT_V(8); PG8_WAIT_L(0); PG8_BAR; PG8_MMA(0, 0, At, B0); PG8_MMA(0, 1, At, B1); PG8_BAR; PG8_SCHED;
            PG8_LDA(At, 0, 1); PG8_STAGE(PG8_SB(0, 0), b2, voffB); PG8_STAGE(PG8_SB(0, 1), b2 + hstepB, voffB); PG8_STAGE(PG8_SA(0, 0), a2, voffA);
            PG8_WAIT_V(8); PG8_WAIT_L(0); PG8_BAR; PG8_MMA(1, 0, At, B0); PG8_MMA(1, 1, At, B1); PG8_BAR; PG8_SCHED;
            PG8_LDB(B0, 1, 0); PG8_LDB(B1, 1, 1); PG8_SCHED; PG8_LDA(At, 1, 0); PG8_STAGE(PG8_SA(0, 1), a2 + hstepA, voffA);
            PG8_WAIT_V(8); PG8_WAIT_L(0); PG8_BAR; PG8_MMA(0, 0, At, B0); PG8_MMA(0, 1, At, B1); PG8_BAR; PG8_SCHED;
            PG8_LDA(At, 1, 1); PG8_STAGE(PG8_SB(1, 0), b3, voffB); PG8_STAGE(PG8_SB(1, 1), b3 + hstepB, voffB); PG8_STAGE(PG8_SA(1, 0), a3, voffA);
            PG8_WAIT_V(8); PG8_WAIT_L(0); PG8_BAR; PG8_MMA(1, 0, At, B0); PG8_MMA(1, 1, At, B1); PG8_BAR; PG8_SCHED;
        }
        if constexpr (ALIGN_EPI) { if (wr == 0) PG8_BAR; }
        E(acc, cur, wr, wc, fr, fq); S.done(cur);
#ifdef PROBE_EPI2
        if (Epi::PROBE2) { asm volatile("" ::: "memory"); E(acc, cur, wr, wc, fr, fq); }
#endif
        if (!has_next) break;
#pragma unroll
        for (int a = 0; a < 2; ++a)
#pragma unroll
            for (int b = 0; b < 2; ++b)
#pragma unroll
                for (int m = 0; m < 4; ++m)
#pragma unroll
                    for (int n = 0; n < 2; ++n) acc[a][b][m][n] = (f32x4){0.f, 0.f, 0.f, 0.f};
        cur = nxt; cA = nA; cB = nB; ++ui;
        if constexpr (ALIGN_EPI) { if (wr == 1) PG8_BAR; }
    }
    PG8_WAIT_V(0);
    if constexpr (!ALIGN_EPI) { if (wr == 0) PG8_BAR; }
    PG8_BAR;
#undef PG8_SA
#undef PG8_SB
#undef PG8_STAGE
#undef PG8_LDA
#undef PG8_LDB
#undef PG8_MMA
#undef PG8_WAIT_V
#undef PG8_WAIT_L
#undef PG8_BAR
#undef PG8_SCHED
}
}

struct Params {
    const float* in[35];
    float* out;
    unsigned char* ws;
    int ph_lo, ph_hi;
};
enum { I_X = 0, I_C, I_CTX, I_CCTX, I_NMG, I_NFG, I_WMOD, I_BMOD, I_WIN, I_QNG, I_WUQ, I_KVNG, I_WUKV, I_HCW, I_HCB, I_HW1, I_HB1, I_HFREQ, I_HW2, I_HB2, I_HW3, I_HB3,
       I_HSKIP, I_LQ1, I_LK1, I_LQ2, I_LK2, I_SUBG, I_WBRA, I_WBRB, I_WBRC, I_WOUT, I_FC1, I_FC2, I_FNG };

struct Frame {
    LAS unsigned char* lds;
    int tid, lane, wave, vcu, G;
};

__device__ __forceinline__ void tr_item(const float* W, int ldw, hf* WT, int ldt, int nblk, LAS float* scr, int item, int lane, const float* kgain = nullptr) {
    const int kb = item / nblk, nb = item % nblk, k0 = 64 * kb, n0 = 32 * nb;
#pragma unroll 8
    for (int i = 0; i < 32; ++i) { const int kk = 2 * i + (lane >> 5); const float gk = kgain ? kgain[k0 + kk] : 1.f; scr[kk * 33 + (lane & 31)] = W[(size_t)(k0 + kk) * ldw + n0 + (lane & 31)] * gk; }
    LDS_WAIT(); asm volatile("" ::: "memory");
    const int c = lane & 7;
#pragma unroll
    for (int j = 0; j < 4; ++j) { const int n = (lane >> 3) + 8 * j; const LAS float* s = scr + (8 * c) * 33 + n;
        u32x4 o; o.x = pkh(s[0 * 33], s[1 * 33]); o.y = pkh(s[2 * 33], s[3 * 33]); o.z = pkh(s[4 * 33], s[5 * 33]); o.w = pkh(s[6 * 33], s[7 * 33]);
        *(u32x4*)(WT + (size_t)(n0 + n) * ldt + k0 + 8 * c) = o; }
    LDS_WAIT(); asm volatile("" ::: "memory");
}
__device__ __forceinline__ float silu_f(float x) { return x / (1.f + expf(-x)); }

__device__ __forceinline__ void mod_phase(const Frame& F, const Params& p) {
    float* MOD = (float*)(p.ws + WS_MOD);
    LAS float* sv = (LAS float*)F.lds;
    constexpr int NCB = DEPTH * MODW / 512;
    for (int item = F.vcu; item < NCB * 3; item += F.G) {
        const int cb = item / 3, vg = item % 3;
        __syncthreads();
        for (int i = F.tid; i < 11 * 1024; i += 512) { const int v = vg * 11 + i / 1024, k = i % 1024;
            const float c = (v < NB) ? p.in[I_C][v * DM + k] : p.in[I_CCTX][k]; sv[i] = silu_f(c); }
        __syncthreads();
        const int gcol = cb * 512 + F.tid, l = gcol / MODW, n = gcol % MODW;
        const float* w = p.in[I_WMOD] + (size_t)l * DM * MODW + n;
        float acc[11];
#pragma unroll
        for (int v = 0; v < 11; ++v) acc[v] = 0.f;
#pragma unroll 4
        for (int k = 0; k < DM; k += 4) {
            const float w0 = w[(size_t)k * MODW], w1 = w[(size_t)(k + 1) * MODW], w2 = w[(size_t)(k + 2) * MODW], w3 = w[(size_t)(k + 3) * MODW];
#pragma unroll
            for (int v = 0; v < 11; ++v) { const f32x4 s = *(const LAS f32x4*)(sv + v * 1024 + k);
                acc[v] = fmaf(s[0], w0, acc[v]); acc[v] = fmaf(s[1], w1, acc[v]); acc[v] = fmaf(s[2], w2, acc[v]); acc[v] = fmaf(s[3], w3, acc[v]); }
        }
        const float bm = p.in[I_BMOD][(size_t)l * MODW + n];
#pragma unroll
        for (int v = 0; v < 11; ++v) MOD[((size_t)l * NMODV + vg * 11 + v) * MODW + n] = acc[v] + bm;
    }
    __syncthreads();
}

__device__ __forceinline__ void filt_item(const Params& p, int l, int kind  , int t, int lane) {
    const int L = kind ? CTXL : SEQ;
    hf* R = kind ? (hf*)(p.ws + WS_RFC) + (size_t)l * 256 * 512 : (hf*)(p.ws + WS_RF) + (size_t)l * 256 * 4096;
    const int rl = 2 * L;
    const float tl = (float)t / (float)(L - 1);
    const float wt = (6.283185307179586f / (float)L) * (float)t;
    float z = 0.f;
    if (lane == 0) z = tl;
    else if (lane <= 32) { const int bi = (lane - 1) & 15; const float band = 1e-4f + (15.f - 1e-4f) * ((float)bi / 15.f); const float a = band * wt; z = (lane <= 16) ? cosf(a) : -sinf(a); }
    const float* w1 = p.in[I_HW1] + (size_t)l * 33 * 64; const float* w2 = p.in[I_HW2] + (size_t)l * 64 * 64; const float* w3 = p.in[I_HW3] + (size_t)l * 64 * 512;
    const float fr = p.in[I_HFREQ][l * 64 + lane];
    float a1 = p.in[I_HB1][l * 64 + lane];
    for (int i = 0; i < 33; ++i) a1 = fmaf(__shfl(z, i), w1[i * 64 + lane], a1);
    a1 = sinf(fr * a1);
    float a2 = p.in[I_HB2][l * 64 + lane];
    for (int i = 0; i < 64; ++i) a2 = fmaf(__shfl(a1, i), w2[i * 64 + lane], a2);
    a2 = sinf(fr * a2);
    float h[8];
#pragma unroll
    for (int q = 0; q < 8; ++q) h[q] = p.in[I_HB3][l * 512 + q * 64 + lane];
    for (int i = 0; i < 64; ++i) { const float a = __shfl(a2, i);
#pragma unroll
        for (int q = 0; q < 8; ++q) h[q] = fmaf(a, w3[i * 512 + q * 64 + lane], h[q]); }
    const float d0 = -4.605170185988091f / 1.5f, d1 = -4.605170185988091f / 0.3f;
#pragma unroll
    for (int q = 0; q < 8; ++q) { const int o = q * 64 + lane, dir = o >> 8, c = o & 255;
        const float delta = fabsf(d0 + (d1 - d0) * ((float)c / 255.f));
        float val = h[q] * (expf(-tl * delta) + 0.05f);
        if (dir == 0) { if (t == 0) val += p.in[I_HSKIP][l * 256 + c]; R[(size_t)c * rl + (L - t)] = (hf)val; if (t == 0) R[(size_t)c * rl] = (hf)0.f; }
        else if (t >= 1) R[(size_t)c * rl + (L + t)] = (hf)val; }
}

__device__ __forceinline__ void convert_layer(const Frame& F, const Params& p, int l, unsigned char* wl, int wg_rank, int wg_count) {
    LAS float* scr = (LAS float*)(F.lds + F.wave * 16384);
    const int gw = wg_rank * 8 + F.wave, NGW = wg_count * 8, lane = F.lane;
    constexpr int IT_IN1 = 16 * 61, IT_ING = 16 * 96, IT_UQ = 4 * 24, IT_UKV = 2 * 32, IT_BRA = 8 * 32, IT_BRB = 4 * 32, IT_BRC = 4 * 32, IT_OUT = 16 * 32, IT_FC1 = 16 * 128, IT_FC2 = 64 * 32;
    constexpr int IT_LAYER = IT_IN1 + IT_ING + IT_UQ + IT_UKV + IT_BRA + IT_BRB + IT_BRC + IT_OUT + IT_FC1 + IT_FC2;
    for (int it = gw; it < IT_LAYER; it += NGW) {
        int r = it;
        if (r < IT_IN1) { tr_item(p.in[I_WIN] + (size_t)l * DM * D_IN, D_IN, (hf*)(wl + W_IN1), DM, 61, scr, r, lane); continue; } r -= IT_IN1;
        if (r < IT_ING) { tr_item(p.in[I_WIN] + (size_t)l * DM * D_IN + C_PG, D_IN, (hf*)(wl + W_ING), DM, 96, scr, r, lane); continue; } r -= IT_ING;
        if (r < IT_UQ) { tr_item(p.in[I_WUQ] + (size_t)l * 256 * 768, 768, (hf*)(wl + W_UP), KUP, 24, scr, r, lane, p.in[I_QNG] + l * 256); continue; } r -= IT_UQ;
        if (r < IT_UKV) { tr_item(p.in[I_WUKV] + (size_t)l * 128 * 1024, 1024, (hf*)(wl + W_UP) + (size_t)768 * KUP + 256, KUP, 32, scr, r, lane, p.in[I_KVNG] + l * 128); continue; } r -= IT_UKV;
        if (r < IT_BRA) { tr_item(p.in[I_WBRA] + (size_t)l * 512 * DM, DM, (hf*)(wl + W_BR), DM, 32, scr, r, lane); continue; } r -= IT_BRA;
        if (r < IT_BRB) { tr_item(p.in[I_WBRB] + (size_t)l * 256 * DM, DM, (hf*)(wl + W_BR) + 512, DM, 32, scr, r, lane); continue; } r -= IT_BRB;
        if (r < IT_BRC) { tr_item(p.in[I_WBRC] + (size_t)l * 256 * DM, DM, (hf*)(wl + W_BR) + 768, DM, 32, scr, r, lane); continue; } r -= IT_BRC;
        if (r < IT_OUT) { tr_item(p.in[I_WOUT] + (size_t)l * DM * DM, DM, (hf*)(wl + W_OUT), DM, 32, scr, r, lane); continue; } r -= IT_OUT;
        if (r < IT_FC1) { tr_item(p.in[I_FC1] + (size_t)l * DM * DFF, DFF, (hf*)(wl + W_FC1), DM, 128, scr, r, lane); continue; } r -= IT_FC1;
        tr_item(p.in[I_FC2] + (size_t)l * DFF * DM, DM, (hf*)(wl + W_FC2), DFF, 32, scr, r, lane);
    }
    const int gt = gw * 64 + lane, NGT = NGW * 64;
    u32x4* z1 = (u32x4*)((hf*)(wl + W_IN1) + (size_t)C_PG * DM);
    for (int i = gt; i < 96 * DM / 8; i += NGT) z1[i] = (u32x4){0u, 0u, 0u, 0u};
    hf* up = (hf*)(wl + W_UP);
    for (int i = gt; i < 768 * 16; i += NGT) { const int n = i / 16, k8 = i % 16; *(u32x4*)(up + (size_t)n * KUP + 256 + k8 * 8) = (u32x4){0u, 0u, 0u, 0u}; }
    for (int i = gt; i < 1024 * 32; i += NGT) { const int n = 768 + i / 32, k8 = i % 32; *(u32x4*)(up + (size_t)n * KUP + k8 * 8) = (u32x4){0u, 0u, 0u, 0u}; }
}

__device__ __forceinline__ void prologue_a(const Frame& F, const Params& p) {
    mod_phase(F, p);
    convert_layer(F, p, 0, p.ws + WS_WT, F.vcu, F.G);
    const int gw = F.vcu * 8 + F.wave, NGW = F.G * 8, lane = F.lane;
    for (int it = gw; it < DEPTH * (SEQ + CTXL); it += NGW) { const int l = it / (SEQ + CTXL), r = it % (SEQ + CTXL); if (r < SEQ) filt_item(p, l, 0, r, lane); else filt_item(p, l, 1, r - SEQ, lane); }
    {
        float* rope = (float*)(p.ws + WS_ROPE);
        const int gt = gw * 64 + lane, NGT = NGW * 64;
        for (int i = gt; i < SEQ * 16; i += NGT) { const int t = i >> 4, j = i & 15; const float pos = (j < 8) ? (float)(t / GRIDW) : (float)(t % GRIDW);
            const float inv = powf(10000.f, -(float)(j & 7) / 8.f); const float a = pos * inv; rope[t * 32 + j] = cosf(a); rope[t * 32 + 16 + j] = sinf(a); }
        if (gt < DEPTH) { const int l = gt; float s1 = 0.f, s2 = 0.f;
            for (int i = 0; i < 32; ++i) { s1 += p.in[I_LQ1][l * 32 + i] * p.in[I_LK1][l * 32 + i]; s2 += p.in[I_LQ2][l * 32 + i] * p.in[I_LK2][l * 32 + i]; }
            const float li = 0.8f - 0.6f * expf(-0.3f * (float)l);
            float* lam = (float*)(p.ws + WS_LAM); lam[2 * l] = expf(s1) - expf(s2) + li; lam[2 * l + 1] = 1.f - li; }
    }
}
__device__ __forceinline__ void prologue_b(const Frame& F, const Params& p) {
    const float* MOD = (const float*)(p.ws + WS_MOD); float* BIAS = (float*)(p.ws + WS_BIAS);
    {
        LAS float* sv = (LAS float*)F.lds;
        constexpr int NCB = DEPTH * NBIAS / 512;
        for (int item = F.vcu; item < NCB * 3; item += F.G) {
            const int cb = item / 3, vg = item % 3;
            const int gcol = cb * 512 + F.tid, l = gcol / NBIAS, n = gcol % NBIAS, n0 = (cb * 512) % NBIAS;
            const int soff = (n0 >= B_FC1) ? 3 * DM : 0;
            __syncthreads();
            for (int i = F.tid; i < 11 * 1024; i += 512) { const int v = vg * 11 + i / 1024, k = i % 1024; sv[i] = MOD[((size_t)l * NMODV + v) * MODW + soff + k]; }
            __syncthreads();
            const float* w; size_t ldw; bool valid = true;
            if (n < B_G) { w = p.in[I_WIN] + (size_t)l * DM * D_IN + n; ldw = D_IN; valid = n < C_PG; }
            else if (n < B_FC1) { w = p.in[I_WIN] + (size_t)l * DM * D_IN + C_PG + (n - B_G); ldw = D_IN; }
            else { w = p.in[I_FC1] + (size_t)l * DM * DFF + (n - B_FC1); ldw = DFF; }
            float acc[11];
#pragma unroll
            for (int v = 0; v < 11; ++v) acc[v] = 0.f;
            if (valid)
#pragma unroll 4
            for (int k = 0; k < DM; k += 4) {
                const float w0 = w[(size_t)k * ldw], w1 = w[(size_t)(k + 1) * ldw], w2 = w[(size_t)(k + 2) * ldw], w3 = w[(size_t)(k + 3) * ldw];
#pragma unroll
                for (int v = 0; v < 11; ++v) { const f32x4 sx = *(const LAS f32x4*)(sv + v * 1024 + k);
                    acc[v] = fmaf(sx[0], w0, acc[v]); acc[v] = fmaf(sx[1], w1, acc[v]); acc[v] = fmaf(sx[2], w2, acc[v]); acc[v] = fmaf(sx[3], w3, acc[v]); }
            }
#pragma unroll
            for (int v = 0; v < 11; ++v) BIAS[((size_t)l * NMODV + vg * 11 + v) * NBIAS + n] = acc[v];
        }
        __syncthreads();
    }
    const int gw = F.vcu * 8 + F.wave, NGW = F.G * 8, lane = F.lane;
    {
        float* GS = (float*)(p.ws + WS_GS);
        const int gt = gw * 64 + lane, NGT = NGW * 64;
        for (int i = gt; i < DEPTH * 2 * NMODV * DM; i += NGT) { const int c = i % DM, v = (i / DM) % NMODV, wh = (i / (DM * NMODV)) % 2, l = i / (DM * NMODV * 2);
            const float g = wh ? p.in[I_NFG][l * DM + c] : p.in[I_NMG][l * DM + c];
            GS[i] = g * (1.f + MOD[((size_t)l * NMODV + v) * MODW + (wh ? 4 * DM : DM) + c]); }
    }
    {
        hf* XS = (hf*)p.out; hf* X16 = (hf*)(p.ws + WS_X16); float* ss = (float*)(p.ws + WS_SS) + (size_t)SS_1 * MTOT;
        f32x4 g[4];
#pragma unroll
        for (int j = 0; j < 4; ++j) g[j] = *(const f32x4*)(p.in[I_NMG] + 4 * lane + 256 * j);
        for (int row = gw; row < MTOT; row += NGW) {
            const bool lat = row < NLAT; const float* xr = lat ? p.in[I_X] + (size_t)row * DM : p.in[I_CTX] + (size_t)(row - NLAT) * DM;
            const int v = lat ? (row >> 11) : NB; const float* mv = MOD + (size_t)v * MODW + DM;
            float sq = 0.f; hf* hr = XS + (size_t)row * DM; hf* xh = X16 + (size_t)row * DM;
#pragma unroll
            for (int j = 0; j < 4; ++j) { const f32x4 x = *(const f32x4*)(xr + 4 * lane + 256 * j); const f32x4 sc = *(const f32x4*)(mv + 4 * lane + 256 * j);
                sq += (x[0] * x[0] + x[1] * x[1]) + (x[2] * x[2] + x[3] * x[3]);
                const f32x4 o = x * (g[j] * (sc + 1.f)); u32x2 w; w.x = pkh(o[0], o[1]); w.y = pkh(o[2], o[3]); *(u32x2*)(hr + 4 * lane + 256 * j) = w;
                u32x2 w2; w2.x = pkh(x[0], x[1]); w2.y = pkh(x[2], x[3]); *(u32x2*)(xh + 4 * lane + 256 * j) = w2; }
            sq = wave_sum(sq);
            if (lane == 0) ss[row] = sq;
        }
    }
}

__device__ __forceinline__ void norm_phase(const Frame& F, const float* xs_lat, const float* xs_ctx, int nrows, const float* gain, const float* modl, int sh_off, int sc_off, hf* H) {
    const int gw = F.vcu * 8 + F.wave, NGW = F.G * 8, lane = F.lane;
    f32x4 g[4];
#pragma unroll
    for (int j = 0; j < 4; ++j) g[j] = *(const f32x4*)(gain + 4 * lane + 256 * j);
    for (int row = gw; row < nrows; row += NGW) {
        const bool lat = row < NLAT; const float* xr = lat ? xs_lat + (size_t)row * DM : xs_ctx + (size_t)(row - NLAT) * DM;
        const int v = lat ? (row >> 11) : NB; const float* mv = modl + (size_t)v * MODW;
        f32x4 x[4]; float ss = 0.f;
#pragma unroll
        for (int j = 0; j < 4; ++j) { x[j] = *(const f32x4*)(xr + 4 * lane + 256 * j); ss += (x[j][0] * x[j][0] + x[j][1] * x[j][1]) + (x[j][2] * x[j][2] + x[j][3] * x[j][3]); }
        const float rstd = rsqrtf(wave_sum(ss) * (1.f / DM) + EPS);
        hf* hr = H + (size_t)row * DM;
#pragma unroll
        for (int j = 0; j < 4; ++j) { const f32x4 sh = *(const f32x4*)(mv + sh_off + 4 * lane + 256 * j), sc = *(const f32x4*)(mv + sc_off + 4 * lane + 256 * j);
            const f32x4 y = (x[j] * rstd) * g[j]; const f32x4 o = y * (sc + 1.f) + sh;
            u32x2 w; w.x = pkh(o[0], o[1]); w.y = pkh(o[2], o[3]); *(u32x2*)(hr + 4 * lane + 256 * j) = w; }
    }
}
__device__ __forceinline__ void final_norm_phase(const Frame& F, const hf* X16, float* out, const float* gain, const float* ss) {
    const int gw = F.vcu * 8 + F.wave, NGW = F.G * 8, lane = F.lane;
    f32x4 g[4];
#pragma unroll
    for (int j = 0; j < 4; ++j) g[j] = *(const f32x4*)(gain + 4 * lane + 256 * j);
    for (int row = gw; row < NLAT; row += NGW) {
        const hf* xr = X16 + (size_t)row * DM; float* orow = out + (size_t)row * DM; const float rstd = rsqrtf(ss[row] * (1.f / DM) + EPS);
#pragma unroll
        for (int j = 0; j < 4; ++j) { const hf4 xh = *(const hf4*)(xr + 4 * lane + 256 * j); const f32x4 x = {(float)xh[0], (float)xh[1], (float)xh[2], (float)xh[3]};
            *(f32x4*)(orow + 4 * lane + 256 * j) = (x * rstd) * g[j]; }
    }
}

__device__ __forceinline__ void prep_rope(const Frame& F, const Params& p) {
    const int gw = F.vcu * 8 + F.wave, NGW = F.G * 8, lane = F.lane;
    hf* KR = (hf*)(p.ws + A_KR); hf* DK = (hf*)(p.ws + A_DK); const float* rope = (const float*)(p.ws + WS_ROPE);
    const int hh = lane >> 3, i0 = 2 * (lane & 7);
    for (int row0 = gw * 4; row0 < NLAT; row0 += NGW * 4) {
        hf2 a[4], b[4]; f32x2 c[4], sn[4]; float y1[4], y2[4], cc[4], ss[4];
#pragma unroll
        for (int q = 0; q < 4; ++q) { const int row = row0 + q, t = row & (SEQ - 1); const hf* dk = DK + (size_t)row * 256 + hh * 32 + i0;
            a[q] = *(const hf2*)dk; b[q] = *(const hf2*)(dk + 16); c[q] = *(const f32x2*)(rope + t * 32 + i0); sn[q] = *(const f32x2*)(rope + t * 32 + 16 + i0);
            if (lane < 16) { const hf* kr = KR + (size_t)row * 32 + lane; y1[q] = (float)kr[0]; y2[q] = (float)kr[16]; cc[q] = rope[t * 32 + lane]; ss[q] = rope[t * 32 + 16 + lane]; } }
#pragma unroll
        for (int q = 0; q < 4; ++q) { const int row = row0 + q; hf* dk = DK + (size_t)row * 256 + hh * 32 + i0;
            const float x1[2] = {(float)a[q][0], (float)a[q][1]}, x2[2] = {(float)b[q][0], (float)b[q][1]};
            *(unsigned*)dk = pkh(x1[0] * c[q][0] - x2[0] * sn[q][0], x1[1] * c[q][1] - x2[1] * sn[q][1]);
            *(unsigned*)(dk + 16) = pkh(x2[0] * c[q][0] + x1[0] * sn[q][0], x2[1] * c[q][1] + x1[1] * sn[q][1]);
            if (lane < 16) { hf* kr = KR + (size_t)row * 32 + lane; kr[0] = (hf)(y1[q] * cc[q] - y2[q] * ss[q]); kr[16] = (hf)(y2[q] * cc[q] + y1[q] * ss[q]); } }
    }
}
__device__ __forceinline__ void prep_hyena(const Frame& F, const Params& p, int l, bool with_ctx) {
    constexpr int INP = 784;
    constexpr int OUTP = 33;
    constexpr int OFF_OU = 66 * INP, OFF_OX = OFF_OU + 128 * OUTP * 4;
    const hf* PHY = (const hf*)(p.ws + A_PHY);
    LAS unsigned char* lds = F.lds; const int tid = F.tid;
    const float* cw = p.in[I_HCW] + (size_t)l * 3 * 768; const float* cb = p.in[I_HCB] + (size_t)l * 768;
    constexpr int U_LAT = NB * (SEQ / 64) * 2, U_CTX = NB * (CTXL / 64) * 2;
    const int nunit = U_LAT + (with_ctx ? U_CTX : 0);
    for (int un = F.vcu; un < nunit; un += F.G) {
        const bool ctx = un >= U_LAT; int r = ctx ? un - U_LAT : un; const int L = ctx ? CTXL : SEQ, ntile = L / 64;
        const int ch = r & 1; r >>= 1; const int tt = r % ntile, b = r / ntile;
        const int t0 = tt * 64; const size_t rowbase = ctx ? (size_t)NLAT + (size_t)b * CTXL : (size_t)b * SEQ;
        hf* dU = (hf*)((unsigned char*)p.out + (ctx ? O_UTC : O_UT)); hf* dX = (hf*)((unsigned char*)p.out + (ctx ? O_X0TC : O_X0T));
        __syncthreads();
        {
            u32x4 tmp[7];
#pragma unroll
            for (int k = 0; k < 7; ++k) { const int i = tid + 512 * k, rr = i / 48, q = i % 48, seg = q >> 4, c16 = q & 15; const int t = t0 - 1 + rr;
                tmp[k] = (u32x4){0u, 0u, 0u, 0u};
                if (i < 66 * 48 && t >= 0 && t < L) tmp[k] = *(const u32x4*)(PHY + (rowbase + t) * 768 + seg * 256 + ch * 128 + c16 * 8); }
#pragma unroll
            for (int k = 0; k < 7; ++k) { const int i = tid + 512 * k, rr = i / 48, q = i % 48, seg = q >> 4, c16 = q & 15;
                if (i < 66 * 48) *(LAS u32x4*)(lds + rr * INP + seg * 256 + c16 * 16) = tmp[k]; }
        }
        __syncthreads();
        {
            const int c = tid & 127, tg = tid >> 7, cg = ch * 128 + c;
            const float a0 = cw[cg], a1 = cw[768 + cg], a2 = cw[1536 + cg], ab = cb[cg];
            const float b0 = cw[256 + cg], b1 = cw[768 + 256 + cg], b2 = cw[1536 + 256 + cg], bb = cb[256 + cg];
            const float v0 = cw[512 + cg], v1 = cw[768 + 512 + cg], v2 = cw[1536 + 512 + cg], vb = cb[512 + cg];
            const LAS hf* in = (const LAS hf*)(lds + (16 * tg) * INP) + c;
            float p0 = (float)in[0], p1 = (float)in[128], p2 = (float)in[256];
            float c0 = (float)in[INP / 2], c1 = (float)in[INP / 2 + 128], c2 = (float)in[INP / 2 + 256];
            LAS hf* ou = (LAS hf*)(lds + OFF_OU) + c * (OUTP * 2) + 16 * tg; LAS hf* ox = (LAS hf*)(lds + OFF_OX) + c * (OUTP * 2) + 16 * tg;
#pragma unroll
            for (int j = 0; j < 16; ++j) { const LAS hf* nx = in + (j + 2) * (INP / 2);
                const float n0 = (float)nx[0], n1 = (float)nx[128], n2 = (float)nx[256];
                const float x0 = a0 * p0 + a1 * c0 + a2 * n0 + ab, x1 = b0 * p1 + b1 * c1 + b2 * n1 + bb, vv = v0 * p2 + v1 * c2 + v2 * n2 + vb;
                ou[j] = (hf)(vv * x1); ox[j] = (hf)x0;
                p0 = c0; p1 = c1; p2 = c2; c0 = n0; c1 = n1; c2 = n2; }
        }
        __syncthreads();
        {
            const int c = tid >> 2, q = tid & 3; const size_t go = ((size_t)(ch * 128 + c) * NB + b) * L + t0 + 16 * q;
            const LAS unsigned* su = (const LAS unsigned*)(lds + OFF_OU) + c * OUTP + 8 * q; const LAS unsigned* sx = (const LAS unsigned*)(lds + OFF_OX) + c * OUTP + 8 * q;
            u32x4 w0 = {su[0], su[1], su[2], su[3]}, w1 = {su[4], su[5], su[6], su[7]};
            *(u32x4*)(dU + go) = w0; *(u32x4*)(dU + go + 8) = w1;
            u32x4 y0 = {sx[0], sx[1], sx[2], sx[3]}, y1 = {sx[4], sx[5], sx[6], sx[7]};
            *(u32x4*)(dX + go) = y0; *(u32x4*)(dX + go + 8) = y1;
        }
    }
    __syncthreads();
}

namespace att {
#ifndef PROF_SEL
#define PROF_SEL -1
#endif
#define ATT_MARK(b) do { if (PROF_SEL >= 0 && F.tid == 0) { volatile LAS unsigned* _pf = (volatile LAS unsigned*)(F.lds + LDS_BYTES - 512); const unsigned _t = (unsigned)__builtin_amdgcn_s_memrealtime(); _pf[(b)] += _t - _pf[32]; _pf[32] = _t; } } while (0)
__device__ __forceinline__ int crow(int r, int hi) { return (r & 3) + 8 * (r >> 2) + 4 * hi; }
#define SBAR() __builtin_amdgcn_sched_barrier(0)
constexpr float THR2 = 8.f * 1.4426950408889634f;
constexpr int KS_MLA = 208, KS_DF = 80;
constexpr int VS = 192, VB = 64 * VS;
constexpr int OFF_V = 32768;
template <int OFF> __device__ __forceinline__ s16x4 tr_read(int vb) {
    s16x4 r; asm volatile("ds_read_b64_tr_b16 %0, %1 offset:%2" : "=&v"(r) : "v"(vb), "i"(OFF) : "memory"); return r;
}
__device__ __forceinline__ int kpos(int key) { return (key & ~0xC) | ((key & 4) << 1) | ((key & 8) >> 1); }

template <int ND0, int KS>
__device__ __forceinline__ void qkt(f32x16& p0, f32x16& p1, const LAS unsigned char* Ks, const hf8* qr, int r32, int hi) {
    p0 = f32x16{}; p1 = f32x16{};
#pragma unroll
    for (int d0 = 0; d0 < ND0; ++d0) { const int cb = (d0 * 16 + hi * 8) * 2;
        const hf8 b0 = *(const LAS hf8*)(Ks + r32 * KS + cb), b1 = *(const LAS hf8*)(Ks + (32 + r32) * KS + cb);
        p0 = __builtin_amdgcn_mfma_f32_32x32x16_f16(b0, qr[d0], p0, 0, 0, 0); p1 = __builtin_amdgcn_mfma_f32_32x32x16_f16(b1, qr[d0], p1, 0, 0, 0); }
}
__device__ __forceinline__ float max3f(float a, float b, float c) { float r; asm("v_max3_f32 %0, %1, %2, %3" : "=v"(r) : "v"(a), "v"(b), "v"(c)); return r; }
__device__ __forceinline__ float max2f(float a, float b) { float r; asm("v_max_f32_e32 %0, %1, %2" : "=v"(r) : "v"(a), "v"(b)); return r; }
__device__ __forceinline__ float max16(const f32x16& p) { float r, t;
    asm("v_max3_f32 %0, %2, %3, %4\n\tv_max3_f32 %1, %10, %11, %12\n\tv_max3_f32 %0, %0, %5, %6\n\tv_max3_f32 %1, %1, %13, %14\n\tv_max3_f32 %0, %0, %7, %8\n\tv_max3_f32 %1, %1, %15, %16\n\tv_max3_f32 %0, %0, %9, %17\n\tv_max_f32_e32 %0, %0, %1"
        : "=&v"(r), "=&v"(t) : "v"(p[0]), "v"(p[1]), "v"(p[2]), "v"(p[3]), "v"(p[4]), "v"(p[5]), "v"(p[6]), "v"(p[7]), "v"(p[8]), "v"(p[9]), "v"(p[10]), "v"(p[11]), "v"(p[12]), "v"(p[13]), "v"(p[14]), "v"(p[15]));
    return r; }
__device__ __forceinline__ hf8 pack8(const f32x16& p, int b) { u32x4 w = {pkh(p[b], p[b + 1]), pkh(p[b + 2], p[b + 3]), pkh(p[b + 4], p[b + 5]), pkh(p[b + 6], p[b + 7])}; return __builtin_bit_cast(hf8, w); }
__device__ __forceinline__ void sm_max(const f32x16& p0, const f32x16& p1, float& m, float& l, f32x16& o0, f32x16& o1, const bool first) {
    float pmax = max2f(max16(p0), max16(p1));
    { auto rr = __builtin_amdgcn_permlane32_swap(__float_as_uint(pmax), __float_as_uint(pmax), false, false);
      pmax = max2f(__uint_as_float(rr[0]), __uint_as_float(rr[1])); }
    if (first || __any(pmax - m > THR2)) {
        const float mn = first ? pmax : max2f(m, pmax);
        if (!first) { const float alpha = __builtin_amdgcn_exp2f(m - mn); l *= alpha;
#pragma unroll
            for (int r = 0; r < 16; ++r) { o0[r] *= alpha; o1[r] *= alpha; } }
        m = mn;
    }
}
__device__ __forceinline__ void sm_exp(f32x16& p0, f32x16& p1, const float m, float& l, hf8& pf0, hf8& pf1, hf8& pf2, hf8& pf3) {
#pragma unroll
    for (int r = 0; r < 16; ++r) { p0[r] -= m; p1[r] -= m; }
#pragma unroll
    for (int r = 0; r < 16; ++r) { p0[r] = __builtin_amdgcn_exp2f(p0[r]); p1[r] = __builtin_amdgcn_exp2f(p1[r]); }
    float ps0 = p0[0] + p1[0], ps1 = p0[1] + p1[1], ps2 = p0[2] + p1[2], ps3 = p0[3] + p1[3];
#pragma unroll
    for (int r = 4; r < 16; r += 4) { ps0 += p0[r] + p1[r]; ps1 += p0[r + 1] + p1[r + 1]; ps2 += p0[r + 2] + p1[r + 2]; ps3 += p0[r + 3] + p1[r + 3]; }
    l += (ps0 + ps1) + (ps2 + ps3);
    pf0 = pack8(p0, 0); pf1 = pack8(p0, 8); pf2 = pack8(p1, 0); pf3 = pack8(p1, 8);
}
__device__ __forceinline__ void pv(const hf8 pf0, const hf8 pf1, const hf8 pf2, const hf8 pf3, f32x16& o0, f32x16& o1, const LAS unsigned char* Vt, int r32, int hi) {
    const int lg = (int)(threadIdx.x & 15), vq = lg >> 2, vp4 = lg & 3;
    const int vbase = (int)(unsigned)(uintptr_t)Vt + (4 * hi + vq) * VS + (16 * ((int)(threadIdx.x >> 4) & 1) + 4 * vp4) * 2;
#define PVRD(ks, L0, H0, L1, H1) s16x4 L0 = tr_read<(16 * (ks)) * VS>(vbase), H0 = tr_read<(16 * (ks) + 8) * VS>(vbase), L1 = tr_read<(16 * (ks)) * VS + 64>(vbase), H1 = tr_read<(16 * (ks) + 8) * VS + 64>(vbase)
#define PVMM(N, L0, H0, L1, H1, pf) do { asm volatile("s_waitcnt lgkmcnt(" #N ")" : "+v"(L0), "+v"(H0), "+v"(L1), "+v"(H1) :: "memory"); \
        const hf8 a0 = __builtin_bit_cast(hf8, (short __attribute__((ext_vector_type(8)))){L0[0], L0[1], L0[2], L0[3], H0[0], H0[1], H0[2], H0[3]}); \
        const hf8 a1 = __builtin_bit_cast(hf8, (short __attribute__((ext_vector_type(8)))){L1[0], L1[1], L1[2], L1[3], H1[0], H1[1], H1[2], H1[3]}); \
        o0 = __builtin_amdgcn_mfma_f32_32x32x16_f16(a0, pf, o0, 0, 0, 0); o1 = __builtin_amdgcn_mfma_f32_32x32x16_f16(a1, pf, o1, 0, 0, 0); } while (0)
    PVRD(0, a0l, a0h, a1l, a1h); PVRD(1, b0l, b0h, b1l, b1h);
    PVMM(4, a0l, a0h, a1l, a1h, pf0);
    PVRD(2, c0l, c0h, c1l, c1h);
    PVMM(4, b0l, b0h, b1l, b1h, pf1);
    PVRD(3, d0l, d0h, d1l, d1h);
    PVMM(4, c0l, c0h, c1l, c1h, pf2);
    PVMM(0, d0l, d0h, d1l, d1h, pf3);
#undef PVRD
#undef PVMM
#define PVK(ks, pf)
#undef PVK
}

template <bool MLA>
__device__ __forceinline__ void attn_pass(const Frame& F, const Params& p, int hq, int hv, int qrow0, int qpos0, int klat0, int nlat, int kctx0, f32x16& o0, f32x16& o1, float& inv) {
    constexpr int DK = MLA ? 96 : 32, ND0 = DK / 16, KS = MLA ? KS_MLA : KS_DF, KB = 64 * KS;
    constexpr float SCALE = MLA ? MLA_SCALE : DF_SCALE, C = SCALE * 1.4426950408889634f;
    const int tid = F.tid, wid = F.wave, lane = F.lane, r32 = lane & 31, hi = lane >> 5;
    const hf* QKV = (const hf*)(p.ws + A_QKV); const hf* KRb = (const hf*)(p.ws + A_KR);
    const hf* DQ = (const hf*)(p.ws + A_DQ); const hf* DKb = (const hf*)(p.ws + A_DK); const hf* DVb = (const hf*)(p.ws + A_DV);
    const float* rope = (const float*)(p.ws + WS_ROPE);
    LAS unsigned char* lds = F.lds;
    hf8 qr[ND0];
    {
        const int qrow = qrow0 + wid * 32 + r32;
        const hf* qp = MLA ? QKV + (size_t)qrow * NUP + hq * 96 + hi * 8 : DQ + (size_t)qrow * 256 + hq * 32 + hi * 8;
        hf8 raw[ND0];
#pragma unroll
        for (int d0 = 0; d0 < ND0; ++d0) raw[d0] = *(const hf8*)(qp + d0 * 16);
        f32x4 c0 = {1.f, 1.f, 1.f, 1.f}, c1 = c0, s0 = {0.f, 0.f, 0.f, 0.f}, s1 = s0;
        if (qpos0 >= 0) { const int t = qpos0 + wid * 32 + r32;
            c0 = *(const f32x4*)(rope + t * 32 + hi * 8); c1 = *(const f32x4*)(rope + t * 32 + hi * 8 + 4);
            s0 = *(const f32x4*)(rope + t * 32 + 16 + hi * 8); s1 = *(const f32x4*)(rope + t * 32 + 16 + hi * 8 + 4); }
#pragma unroll
        for (int d0 = 0; d0 < ND0 - 2; ++d0) {
#pragma unroll
            for (int j = 0; j < 8; ++j) qr[d0][j] = (hf)((float)raw[d0][j] * C); }
#pragma unroll
        for (int j = 0; j < 8; ++j) { const float cc = j < 4 ? c0[j & 3] : c1[j & 3], sn = j < 4 ? s0[j & 3] : s1[j & 3]; const float a = (float)raw[ND0 - 2][j], b = (float)raw[ND0 - 1][j];
            qr[ND0 - 2][j] = (hf)((a * cc - b * sn) * C); qr[ND0 - 1][j] = (hf)((b * cc + a * sn) * C); }
    }
    const int k1r = MLA ? (tid >> 3) : ((tid & 255) >> 2), k1c = MLA ? (tid & 7) * 8 : (tid & 3) * 8;
    const int k2r = (tid & 255) >> 2, k2c = (tid & 3) * 8;
    const int vr_ = tid >> 3, vc_ = (tid & 7) * 8;
    const bool klo = tid < 256;
    struct Stg { u32x4 v, k1, k2; };
    Stg sA, sB; sA.v = sA.k1 = sA.k2 = sB.v = sB.k1 = sB.k2 = (u32x4){0u, 0u, 0u, 0u};
    const int ntile = nlat + 4;
#define KROW0(j) (((j) < nlat) ? klat0 + (j) * 64 : kctx0 + ((j) - nlat) * 64)
#define A_LOADK(S, j) do { const int kr0 = KROW0(j); \
        if (MLA) { S.k1 = *(const u32x4*)(QKV + (size_t)(kr0 + k1r) * NUP + 768 + hq * 128 + k1c); S.k2 = *(const u32x4*)(KRb + (size_t)(kr0 + k2r) * 32 + k2c); } \
        else S.k1 = *(const u32x4*)(DKb + (size_t)(kr0 + k1r) * 256 + hq * 32 + k1c); } while (0)
#define A_LOADV(S, j) do { const int kr0 = KROW0(j); \
        if (MLA) S.v = *(const u32x4*)(QKV + (size_t)(kr0 + vr_) * NUP + 768 + hv * 128 + 64 + vc_); else S.v = *(const u32x4*)(DVb + (size_t)(kr0 + vr_) * 256 + hv * 64 + vc_); } while (0)
#define A_WRITEK(S, b) do { *(LAS u32x4*)(lds + (b) * KB + k1r * KS + k1c * 2) = S.k1; if (MLA) *(LAS u32x4*)(lds + (b) * KB + k2r * KS + 128 + k2c * 2) = S.k2; } while (0)
#define A_WRITEV(S, b) do { *(LAS u32x4*)(lds + OFF_V + (b) * VB + vr_ * VS + vc_ * 2) = S.v; } while (0)
    float m_reg = 0.f, l_reg = 0.f;
    o0 = f32x16{}; o1 = f32x16{};
    f32x16 pA0, pA1, pB0, pB1;
    __syncthreads();
    const int nt1 = ntile - 1;
#define TCL(j) (((j) < nt1) ? (j) : nt1)
    A_LOADK(sA, 0); A_LOADV(sA, 0); A_LOADK(sB, 1);
    A_WRITEK(sA, 0); A_WRITEV(sA, 0); A_WRITEK(sB, 1);
    A_LOADK(sA, TCL(2));
    A_LOADV(sA, 1);
    __syncthreads();
    qkt<ND0, KS>(pA0, pA1, lds, qr, r32, hi);
    hf8 f0, f1, f2, f3;
    if (wid >= 4) __syncthreads();
    for (int j = 0; j < ntile; j += 2) {
        A_LOADK(sB, TCL(j + 3)); A_LOADV(sB, TCL(j + 2));
        sm_max(pA0, pA1, m_reg, l_reg, o0, o1, j == 0);
        sm_exp(pA0, pA1, m_reg, l_reg, f0, f1, f2, f3);
        __syncthreads();
        qkt<ND0, KS>(pB0, pB1, lds + KB, qr, r32, hi);
        pv(f0, f1, f2, f3, o0, o1, lds + OFF_V, r32, hi);
        A_WRITEK(sA, 0); A_WRITEV(sA, 1);
        __syncthreads();
        A_LOADK(sA, TCL(j + 4)); A_LOADV(sA, TCL(j + 3));
        sm_max(pB0, pB1, m_reg, l_reg, o0, o1, false);
        sm_exp(pB0, pB1, m_reg, l_reg, f0, f1, f2, f3);
        __syncthreads();
        qkt<ND0, KS>(pA0, pA1, lds, qr, r32, hi);
        pv(f0, f1, f2, f3, o0, o1, lds + OFF_V + VB, r32, hi);
        A_WRITEK(sB, 1); A_WRITEV(sB, 0);
        __syncthreads();
    }
    if (wid < 4) __syncthreads();
#undef TCL
#undef KROW0
#undef A_LOADK
#undef A_LOADV
#undef A_WRITEK
#undef A_WRITEV
    const float lt = l_reg + __shfl_xor(l_reg, 32); inv = __builtin_amdgcn_rcpf(lt);
}
template <bool MLA>
__device__ __forceinline__ void attn_unit(const Frame& F, const Params& p, int l, int h, int qrow0, int qpos0, int klat0, int nlat, int kctx0) {
    const int wid = F.wave, lane = F.lane, r32 = lane & 31, hi = lane >> 5;
    hf* Y = (hf*)(p.ws + A_Y);
    const size_t yrow = (size_t)(qrow0 + wid * 32 + r32) * DM;
    if constexpr (MLA) {
        f32x16 o0, o1; float inv;
        attn_pass<true>(F, p, h, h, qrow0, qpos0, klat0, nlat, kctx0, o0, o1, inv);
#pragma unroll
        for (int g = 0; g < 4; ++g) { u32x2 w; w.x = pkh(o0[4 * g] * inv, o0[4 * g + 1] * inv); w.y = pkh(o0[4 * g + 2] * inv, o0[4 * g + 3] * inv); *(u32x2*)(Y + yrow + h * 64 + 8 * g + 4 * hi) = w; }
#pragma unroll
        for (int g = 0; g < 4; ++g) { u32x2 w; w.x = pkh(o1[4 * g] * inv, o1[4 * g + 1] * inv); w.y = pkh(o1[4 * g + 2] * inv, o1[4 * g + 3] * inv); *(u32x2*)(Y + yrow + h * 64 + 32 + 8 * g + 4 * hi) = w; }
    } else {
        const float lam = ((const float*)(p.ws + WS_LAM))[2 * l], oml = ((const float*)(p.ws + WS_LAM))[2 * l + 1];
        f32x16 a0, a1;
        LAS float* park = (LAS float*)(F.lds + 65536 + wid * 8192) + lane;
        { f32x16 o0, o1; float inv; attn_pass<false>(F, p, 2 * h, h, qrow0, qpos0, klat0, nlat, kctx0, o0, o1, inv);
#pragma unroll
          for (int r = 0; r < 16; ++r) { park[r * 64] = o0[r] * inv; park[(16 + r) * 64] = o1[r] * inv; } }
        { f32x16 o0, o1; float inv; attn_pass<false>(F, p, 2 * h + 1, h, qrow0, qpos0, klat0, nlat, kctx0, o0, o1, inv);
#pragma unroll
          for (int r = 0; r < 16; ++r) { a0[r] = park[r * 64] - o0[r] * (lam * inv); a1[r] = park[(16 + r) * 64] - o1[r] * (lam * inv); } }
        float ss = 0.f;
#pragma unroll
        for (int r = 0; r < 16; ++r) ss += a0[r] * a0[r] + a1[r] * a1[r];
        ss += __shfl_xor(ss, 32);
        const float rs = rsqrtf(ss * (1.f / 64.f) + EPS) * oml;
#pragma unroll
        for (int g = 0; g < 4; ++g) { const f32x4 gg = *(const f32x4*)(p.in[I_SUBG] + l * 64 + 8 * g + 4 * hi);
            u32x2 w; w.x = pkh(a0[4 * g] * rs * gg[0], a0[4 * g + 1] * rs * gg[1]); w.y = pkh(a0[4 * g + 2] * rs * gg[2], a0[4 * g + 3] * rs * gg[3]); *(u32x2*)(Y + yrow + 768 + h * 64 + 8 * g + 4 * hi) = w; }
#pragma unroll
        for (int g = 0; g < 4; ++g) { const f32x4 gg = *(const f32x4*)(p.in[I_SUBG] + l * 64 + 32 + 8 * g + 4 * hi);
            u32x2 w; w.x = pkh(a1[4 * g] * rs * gg[0], a1[4 * g + 1] * rs * gg[1]); w.y = pkh(a1[4 * g + 2] * rs * gg[2], a1[4 * g + 3] * rs * gg[3]); *(u32x2*)(Y + yrow + 768 + h * 64 + 32 + 8 * g + 4 * hi) = w; }
    }
}
}

#define HY_MARK(b) do { if (PROF_SEL >= 0 && F.tid == 0) { volatile LAS unsigned* _pf = (volatile LAS unsigned*)(F.lds + LDS_BYTES - 512); const unsigned _t = (unsigned)__builtin_amdgcn_s_memrealtime(); _pf[(b)] += _t - _pf[32]; _pf[32] = _t; } } while (0)
template <int L>
__device__ __forceinline__ void hyena_unit(const Frame& F, const hf* Rrow  , const hf* U  , const hf* X0  , hf* Ycol  ) {
    constexpr int NM = L / 256, RL = 2 * L, SH = (L > 1024) ? 1024 : L, NH = L / SH, US = SH * 2 + 16;
    constexpr int OFF_U = 8 * RL * 2;
    constexpr int XP = L * 2 + 16;
    static_assert(OFF_U + 32 * US <= LDS_MISC && 32 * XP <= LDS_MISC, "hyena LDS");
    const int tid = F.tid, w = F.wave, lane = F.lane, i32 = lane & 31, hi = lane >> 5;
    LAS unsigned char* lds = F.lds;
    __syncthreads();
    for (int i = tid; i < RL / 8; i += 512) *(LAS u32x4*)(lds + i * 16) = *(const u32x4*)(Rrow + i * 8);
    __syncthreads();
    {
        const LAS unsigned* src = (const LAS unsigned*)lds;
#pragma unroll 1
        for (int idx = tid; idx < 7 * (RL / 8); idx += 512) { const int cw = 1 + idx / (RL / 8), c4 = (idx % (RL / 8)) * 4;
            const int k0 = c4 - ((cw + 1) >> 1); unsigned d[5];
#pragma unroll
            for (int e = 0; e < 5; ++e) { const int k = k0 + e; d[e] = (k >= 0 && k < RL / 2) ? src[k] : 0u; }
            u32x4 o;
            if (cw & 1) { o.x = (d[0] >> 16) | (d[1] << 16); o.y = (d[1] >> 16) | (d[2] << 16); o.z = (d[2] >> 16) | (d[3] << 16); o.w = (d[3] >> 16) | (d[4] << 16); }
            else { o.x = d[0]; o.y = d[1]; o.z = d[2]; o.w = d[3]; }
            *(LAS u32x4*)(lds + cw * (RL * 2) + c4 * 4) = o; }
    }
    HY_MARK(22);
    f32x16 acc[NM];
#pragma unroll
    for (int m = 0; m < NM; ++m) acc[m] = f32x16{};
    const LAS unsigned char* cpy = lds + w * (RL * 2);
    for (int half = 0; half < NH; ++half) {
        __syncthreads();
        {
            constexpr int NPC = 32 * (SH / 8) / 512, NB4 = NPC > 4 ? 4 : NPC;
            int tq = tid; asm volatile("" : "+v"(tq));
#pragma unroll
            for (int k0 = 0; k0 < NPC; k0 += NB4) { u32x4 tmp[NB4];
#pragma unroll
                for (int k = 0; k < NB4; ++k) { const int idx = tq + 512 * (k0 + k), b = idx / (SH / 8), pc = idx % (SH / 8); tmp[k] = *(const u32x4*)(U + (size_t)b * L + half * SH + pc * 8); }
#pragma unroll
                for (int k = 0; k < NB4; ++k) { const int idx = tq + 512 * (k0 + k), b = idx / (SH / 8), pc = idx % (SH / 8); *(LAS u32x4*)(lds + OFF_U + b * US + pc * 16) = tmp[k]; }
                asm volatile("" ::: "memory"); }
        }
        __syncthreads();
#pragma unroll 2
        for (int jl = 0; jl < SH / 16; ++jl) {
            const int j = half * (SH / 16) + jl;
            const hf8 bf = *(const LAS hf8*)(lds + OFF_U + i32 * US + (jl * 16 + hi * 8) * 2);
            const int x0 = L + 16 * j + 8 * hi - 8 * i32;
#pragma unroll
            for (int m = 0; m < NM; ++m) { const hf8 af = *(const LAS hf8*)(cpy + (x0 - 256 * m) * 2);
                acc[m] = __builtin_amdgcn_mfma_f32_32x32x16_f16(af, bf, acc[m], 0, 0, 0); }
        }
    }
    __syncthreads();
    HY_MARK(23);
    {
        constexpr int NPC = 32 * (L / 8) / 512, NB8 = NPC > 4 ? 4 : NPC;
        int tq = tid; asm volatile("" : "+v"(tq));
#pragma unroll
        for (int k0 = 0; k0 < NPC; k0 += NB8) { u32x4 tmp[NB8];
#pragma unroll
            for (int k = 0; k < NB8; ++k) { const int idx = tq + 512 * (k0 + k), b = idx / (L / 8), pc = idx % (L / 8); tmp[k] = *(const u32x4*)(X0 + (size_t)b * L + pc * 8); }
#pragma unroll
            for (int k = 0; k < NB8; ++k) { const int idx = tq + 512 * (k0 + k), b = idx / (L / 8), pc = idx % (L / 8); *(LAS u32x4*)(lds + b * XP + pc * 16) = tmp[k]; }
            asm volatile("" ::: "memory"); }
    }
    __syncthreads();
    HY_MARK(24);
    const LAS hf* x0p = (const LAS hf*)(lds + i32 * XP) + w + 32 * hi;
    hf* yp = Ycol + ((size_t)i32 * L + w + 32 * hi) * DM;
#pragma unroll
    for (int m = 0; m < NM; ++m) {
#pragma unroll
        for (int r = 0; r < 16; ++r) { const int tt = 256 * m + 8 * ((r & 3) + 8 * (r >> 2));
            const float x0v = (float)x0p[tt];
            yp[(size_t)tt * DM] = (hf)(x0v * acc[m][r]); }
        asm volatile("" ::: "memory");
    }
    HY_MARK(25);
}


#ifndef PH_MASK
#define PH_MASK 0x1FFFF
#endif
#define PHM(k) ((PH_MASK >> (k)) & 1)
#ifndef PROBE_REP
#define PROBE_REP 0
#endif
#define NREP(k) (((PROBE_REP >> (k)) & 1) ? 2 : 1)
constexpr int NPH_LAYER = 7, PH_L0 = 2, NPHASE = PH_L0 + DEPTH * NPH_LAYER + 1;
__global__ void __launch_bounds__(512, 2) fwd_kernel(Params p) {
    extern __shared__ __attribute__((aligned(16))) unsigned char lds_raw[];
    Frame F0; Frame& F = F0;
    F.lds = (LAS unsigned char*)lds_raw;
    F.tid = threadIdx.x; F.lane = F.tid & 63; F.wave = __builtin_amdgcn_readfirstlane(F.tid >> 6);
    F.G = gridDim.x; { const int bx = blockIdx.x; F.vcu = (F.G % 8 == 0) ? (bx % 8) * (F.G / 8) + bx / 8 : bx; }
    volatile LAS unsigned* misc = (volatile LAS unsigned*)(F.lds + LDS_MISC);
    if (F.tid < 16) misc[F.tid] = 0u;
    __syncthreads();
    const int lo = p.ph_lo, hi = p.ph_hi;
    XcdBarrier bar; bar.bar = (unsigned*)(p.ws + WS_BAR); bar.x = 0; bar.st = misc;
    if (hi - lo > 1) bar = xcd_barrier_post((unsigned*)(p.ws + WS_BAR), misc);
#define IN(k) (lo <= (k) && (k) < hi)
#define LAUNDER(Fl) Frame Fl = F0; asm volatile("" : "+v"(Fl.tid), "+v"(Fl.lane))
#ifndef PROF_SEL
#define PROF_SEL -1
#endif
#define PROF_K 8
    volatile LAS unsigned* prof = (volatile LAS unsigned*)(F.lds + LDS_BYTES - 512);
    if (PROF_SEL >= 0 && F.tid < 40) prof[F.tid] = 0u;
    if (PROF_SEL >= 0) __syncthreads();
    if (PROF_SEL >= 0 && F.tid == 0) prof[32] = (unsigned)__builtin_amdgcn_s_memrealtime();
#define PROF_MARK(b) do { if (PROF_SEL >= 0 && F.tid == 0) { const unsigned _t = (unsigned)__builtin_amdgcn_s_memrealtime(); prof[(b)] += _t - prof[32]; if ((b) >= 16) prof[30] += _t - prof[32]; prof[32] = _t; } } while (0)
#define SEAMT(k, b) do { PROF_MARK(b); if (IN(k) && IN((k) + 1)) xcd_barrier(bar); PROF_MARK(16 + (b)); } while (0)
#define SEAM(k) do { if (IN(k) && IN((k) + 1)) xcd_barrier(bar); } while (0)
    unsigned char* ws = p.ws;
    hf* X16 = (hf*)(ws + WS_X16);
    hf* XS1 = (hf*)p.out; hf* MM = (hf*)p.out; hf* Y = (hf*)(ws + A_B); hf* XS2 = (hf*)(ws + A_B);
    hf* QKV = (hf*)(ws + A_QKV); hf* QKVN = (hf*)(ws + A_QKVN);
    unsigned char* Gt = (unsigned char*)(ws + A_G); hf* HID = (hf*)(ws + A_HID);
    float* SS = (float*)(ws + WS_SS);

    if (PHM(11) && IN(0)) for (int rep = 0; rep < NREP(11); ++rep) { LAUNDER(Fl); prologue_a(Fl, p); }
    SEAMT(0, 9);
    if (PHM(11) && IN(1)) for (int rep = 0; rep < NREP(12); ++rep) { LAUNDER(Fl); prologue_b(Fl, p); }
    SEAMT(1, 9);

    for (int l = 0; l < DEPTH; ++l) {
        const int pb = PH_L0 + l * NPH_LAYER;
        const bool ctx_live = l < DEPTH - 1;
        const int Mrows = ctx_live ? MTOT : NLAT;
        const float* modl = (const float*)(ws + WS_MOD) + (size_t)l * NMODV * MODW;
        const float* biasl = (const float*)(ws + WS_BIAS) + (size_t)l * NMODV * NBIAS;
        const float* gsl = (const float*)(ws + WS_GS) + (size_t)l * 2 * NMODV * DM;
        const unsigned char* wl = ws + WS_WT + (size_t)(l & 1) * W_LAYER;
        float* ss1 = SS + (size_t)(SS_1 + l) * MTOT; float* ss2 = SS + (size_t)(SS_2 + l) * MTOT;

        if (PHM(1) && IN(pb + 0)) { pg8::Gemm g{XS1, (const hf*)(wl + W_IN1), MTOT, NP1, DM, DM, DM}; pg8::StaticOrder S; S.init(MTOT, NP1, F.G, (int)blockIdx.x);
            pg8::EpiIn E{QKVN, (hf*)(ws + A_KR), (hf*)(ws + A_PHY), (hf*)(ws + A_DQ), (hf*)(ws + A_DK), (hf*)(ws + A_DV), ss1, biasl + B_IN, SS + (size_t)(SS_Q + l) * MTOT, SS + (size_t)(SS_KV + l) * MTOT};
            pg8::gemm_phase(F.lds, g, S, E); }
        SEAMT(pb + 0, 0);
        if (PHM(2) && IN(pb + 1)) {
            { LAUNDER(Fl); prep_rope(Fl, p); prep_hyena(Fl, p, l, ctx_live); }
            __syncthreads();
            PROF_MARK(1);
            { pg8::Gemm g{QKVN, (const hf*)(wl + W_UP), MTOT, NUP, KUP, KUP, KUP}; pg8::StaticOrder S; S.init(MTOT, NUP, F.G, (int)blockIdx.x);
              pg8::EpiUp E{QKV, SS + (size_t)(SS_Q + l) * MTOT, SS + (size_t)(SS_KV + l) * MTOT}; pg8::gemm_phase(F.lds, g, S, E); }
        }
        SEAMT(pb + 1, 2);
        if (PHM(4) && IN(pb + 2)) {
            {
            LAUNDER(Fl);
            PROF_MARK(14);
            const int n_mla = 2048 + (ctx_live ? 256 : 0);
            for (int id = F.vcu; id < n_mla; id += F.G) {
                if (id < 2048) { const int qb = id & 7, h = (id >> 3) & 7, b = id >> 6; att::attn_unit<true>(Fl, p, l, h, b * SEQ + qb * 256, qb * 256, b * SEQ, 32, NLAT + b * CTXL); }
                else { const int i2 = id - 2048, h = i2 & 7, b = i2 >> 3; att::attn_unit<true>(Fl, p, l, h, NLAT + b * CTXL, -1, 0, 0, NLAT + b * CTXL); }
            }
            PROF_MARK(11);
            const int n_df = 1024 + (ctx_live ? 128 : 0);
            for (int id = F.vcu; id < n_df; id += F.G) {
                if (id < 1024) { const int qb = id & 7, h = (id >> 3) & 3, b = id >> 5; att::attn_unit<false>(Fl, p, l, h, b * SEQ + qb * 256, qb * 256, b * SEQ, 32, NLAT + b * CTXL); }
                else { const int i2 = id - 1024, h = i2 & 3, b = i2 >> 2; att::attn_unit<false>(Fl, p, l, h, NLAT + b * CTXL, -1, 0, 0, NLAT + b * CTXL); }
            }
            PROF_MARK(12);
            const unsigned char* ob = (const unsigned char*)p.out;
            for (int c = F.vcu; c < 256; c += F.G)
                hyena_unit<SEQ>(Fl, (const hf*)(ws + WS_RF) + ((size_t)l * 256 + c) * 4096, (const hf*)(ob + O_UT) + (size_t)c * NLAT, (const hf*)(ob + O_X0T) + (size_t)c * NLAT, Y + 512 + c);
            if (ctx_live) for (int c = F.vcu; c < 256; c += F.G)
                hyena_unit<CTXL>(Fl, (const hf*)(ws + WS_RFC) + ((size_t)l * 256 + c) * 512, (const hf*)(ob + O_UTC) + (size_t)c * NCTX, (const hf*)(ob + O_X0TC) + (size_t)c * NCTX, Y + (size_t)NLAT * DM + 512 + c);
            __syncthreads();
            PROF_MARK(13);
            }
            { pg8::Gemm g{XS1, (const hf*)(wl + W_ING), Mrows, NGATE, DM, DM, DM}; pg8::StaticOrder S; S.init(Mrows, NGATE, F.G, (int)blockIdx.x);
              pg8::EpiGate8 E{Gt, ss1, biasl + B_G}; pg8::gemm_phase(F.lds, g, S, E); }
        }
        SEAMT(pb + 2, 4);
        if (PHM(6) && IN(pb + 3)) { pg8::Gemm g{Y, (const hf*)(wl + W_BR), Mrows, DM, DM, DM, DM}; pg8::StaticOrder S; S.init(Mrows, DM, F.G, (int)blockIdx.x);
            pg8::EpiMerge E{MM, Gt}; pg8::gemm_phase(F.lds, g, S, E); }
        SEAMT(pb + 3, 5);
        if (PHM(7) && IN(pb + 4)) { pg8::Gemm g{MM, (const hf*)(wl + W_OUT), Mrows, DM, DM, DM, DM}; pg8::StaticOrder S; S.init(Mrows, DM, F.G, (int)blockIdx.x);
            pg8::EpiResidX<true, true> E{X16, modl + 2 * DM, XS2, gsl + (size_t)NMODV * DM, ss2}; pg8::gemm_phase(F.lds, g, S, E); }
        SEAMT(pb + 4, 6);
        if (PHM(9) && IN(pb + 5)) { pg8::Gemm g{XS2, (const hf*)(wl + W_FC1), Mrows, DFF, DM, DM, DM}; pg8::StaticOrder S; S.init(Mrows, DFF, F.G, (int)blockIdx.x);
            pg8::EpiHalf<2, true> E{HID, DFF, ss2, biasl + B_FC1}; pg8::gemm_phase(F.lds, g, S, E); }
        SEAMT(pb + 5, 7);
        if (PHM(10) && IN(pb + 6)) { pg8::Gemm g{HID, (const hf*)(wl + W_FC2), Mrows, DM, DFF, DFF, DFF}; pg8::StaticOrder S; S.init(Mrows, DM, F.G, (int)blockIdx.x);
            if (ctx_live) { pg8::EpiResidX<true, true> E{X16, modl + 5 * DM, XS1, gsl + (size_t)2 * NMODV * DM, ss1 + MTOT}; pg8::gemm_phase(F.lds, g, S, E);
                const int nheavy = (MTOT / 256 * 4) % F.G;
                if (nheavy > 0 && (int)blockIdx.x >= nheavy) { __syncthreads(); LAUNDER(Fl); convert_layer(Fl, p, l + 1, ws + WS_WT + (size_t)((l + 1) & 1) * W_LAYER, (int)blockIdx.x - nheavy, F.G - nheavy); }
                else if (nheavy == 0) { __syncthreads(); LAUNDER(Fl); convert_layer(Fl, p, l + 1, ws + WS_WT + (size_t)((l + 1) & 1) * W_LAYER, Fl.vcu, F.G); } }
            else { pg8::EpiResidX<false, true> E{X16, modl + 5 * DM, nullptr, nullptr, SS + (size_t)SS_F * MTOT}; pg8::gemm_phase(F.lds, g, S, E); } }
        SEAMT(pb + 6, 8);
    }
    if (PHM(12) && IN(NPHASE - 1)) { LAUNDER(Fl); final_norm_phase(Fl, X16, p.out, p.in[I_FNG], SS + (size_t)SS_F * MTOT); }
    PROF_MARK(10);
    if (PROF_SEL >= 0 && blockIdx.x == 0 && F.tid == 0) { const unsigned long long t0 = __builtin_amdgcn_s_memrealtime(); const unsigned long long d = (unsigned long long)PROF_K * prof[PROF_SEL];
        while (__builtin_amdgcn_s_memrealtime() - t0 < d) __builtin_amdgcn_s_sleep(8); }
#undef IN
#undef SEAM
}

extern "C" void kernel_launch(void* const* d_in, const int* in_sizes, int n_in, void* d_out, int out_size, void* d_ws, size_t ws_size, hipStream_t stream) {
    static int grid = 0;
    if (grid == 0) {
        if (n_in != 35 || in_sizes[0] != NLAT * DM || out_size != NLAT * DM || ws_size < WS_END) {
            fprintf(stderr, "kernel_launch: unexpected shapes: n_in %d in0 %d out %d ws %zu (need %zu); nothing launched\n", n_in, n_in > 0 ? in_sizes[0] : -1, out_size, ws_size, (size_t)WS_END); grid = -1; return; }
        int dev = 0, cus = 0, per_cu = 0;
        if (hipGetDevice(&dev) != hipSuccess || hipDeviceGetAttribute(&cus, hipDeviceAttributeMultiprocessorCount, dev) != hipSuccess) { fprintf(stderr, "kernel_launch: device query failed\n"); grid = -1; return; }
        if (hipFuncSetAttribute((const void*)fwd_kernel, hipFuncAttributeMaxDynamicSharedMemorySize, LDS_BYTES) != hipSuccess) { fprintf(stderr, "kernel_launch: hipFuncSetAttribute failed\n"); grid = -1; return; }
        if (hipOccupancyMaxActiveBlocksPerMultiprocessor(&per_cu, (const void*)fwd_kernel, 512, LDS_BYTES) != hipSuccess || per_cu < 1)
            fprintf(stderr, "kernel_launch: note: occupancy query reports %d workgroups per CU\n", per_cu);
        (void)hipGetLastError();
        grid = cus;
    }
    if (grid < 0) return;
    if (hipMemsetAsync((char*)d_ws + WS_BAR, 0, WS_ZERO_BYTES, stream) != hipSuccess) { fprintf(stderr, "kernel_launch: memset failed\n"); return; }
    Params P{};
    for (int i = 0; i < 35; ++i) P.in[i] = (const float*)d_in[i];
    P.out = (float*)d_out; P.ws = (unsigned char*)d_ws;
#if MK_FUSED
    P.ph_lo = 0; P.ph_hi = NPHASE;
    hipLaunchKernelGGL(fwd_kernel, dim3(grid), dim3(512), LDS_BYTES, stream, P);
#else
    for (int ph = 0; ph < NPHASE; ++ph) { P.ph_lo = ph; P.ph_hi = ph + 1; hipLaunchKernelGGL(fwd_kernel, dim3(grid), dim3(512), LDS_BYTES, stream, P); }
#endif
    const hipError_t le = hipPeekAtLastError();
    if (le != hipSuccess) fprintf(stderr, "kernel_launch: launch failed: %s\n", hipGetErrorName(le));
}
```

```cpp
#include <hip/hip_runtime.h>
#include <cstdio>
#include <cstdint>

#ifndef MK_FUSED
#define MK_FUSED 1
#endif

#define LAS __attribute__((address_space(3)))
#define GAS __attribute__((address_space(1)))
typedef _Float16 hf;
typedef _Float16 hf2 __attribute__((ext_vector_type(2)));
typedef _Float16 hf4 __attribute__((ext_vector_type(4)));
typedef _Float16 hf8 __attribute__((ext_vector_type(8)));
typedef short s16x4 __attribute__((ext_vector_type(4)));
typedef float f32x2 __attribute__((ext_vector_type(2)));
typedef float f32x4 __attribute__((ext_vector_type(4)));
typedef float f32x16 __attribute__((ext_vector_type(16)));
typedef unsigned u32x2 __attribute__((ext_vector_type(2)));
typedef unsigned u32x4 __attribute__((ext_vector_type(4)));

constexpr int DM = 1024, NB = 32, SEQ = 2048, DEPTH = 4, CTXL = 256, GRIDW = 64;
constexpr int NLAT = NB * SEQ;
constexpr int NCTX = NB * CTXL;
constexpr int MTOT = NLAT + NCTX;
constexpr int D_IN = 5024, NP1 = 2048  , NGATE = 3072, DFF = 4096;
constexpr int C_PQ = 0, C_PKV = 256, C_PKR = 384, C_HY = 416, C_DQ = 1184, C_DK = 1440, C_DV = 1696, C_PG = 1952;
constexpr int NUP = 1792, KUP = 384;
constexpr int NMODV = 33, MODW = 6 * DM;
constexpr float EPS = 1e-6f;
constexpr float MLA_SCALE = 0.10206207261596575f;
constexpr float DF_SCALE = 0.17677669529663687f;

constexpr size_t al256(size_t x) { return (x + 255) / 256 * 256; }
constexpr size_t WS_BAR = 0, WS_BAR_BYTES = 65536;
constexpr size_t WS_SS = WS_BAR + WS_BAR_BYTES;
constexpr int SS_1 = 0, SS_2 = DEPTH, SS_F = 2 * DEPTH, SS_Q = 2 * DEPTH + 1, SS_KV = 3 * DEPTH + 1, SS_N = 4 * DEPTH + 1;
constexpr size_t WS_ZERO_BYTES = WS_BAR_BYTES + al256((size_t)SS_N * MTOT * 4);
constexpr size_t WS_MOD = WS_BAR + WS_ZERO_BYTES;
constexpr size_t WS_GS = WS_MOD + al256((size_t)DEPTH * NMODV * MODW * 4);
constexpr int NBIAS = 9216, B_IN = 0, B_G = 2048, B_FC1 = 5120;
constexpr size_t WS_BIAS = WS_GS + (size_t)DEPTH * 2 * NMODV * DM * 4;
constexpr size_t WS_ROPE = WS_BIAS + (size_t)DEPTH * NMODV * NBIAS * 4;
constexpr size_t WS_LAM = WS_ROPE + (size_t)SEQ * 32 * 4;
constexpr size_t WS_RF = WS_LAM + 256;
constexpr size_t WS_RFC = WS_RF + (size_t)DEPTH * 256 * 4096 * 2;
constexpr size_t WS_X16 = WS_RFC + (size_t)DEPTH * 256 * 512 * 2;
constexpr size_t WS_WT = WS_X16 + (size_t)MTOT * DM * 2;
constexpr size_t W_IN1 = 0, W_ING = W_IN1 + (size_t)NP1 * DM * 2, W_UP = W_ING + (size_t)NGATE * DM * 2, W_BR = W_UP + (size_t)NUP * KUP * 2,
                 W_OUT = W_BR + (size_t)DM * DM * 2, W_FC1 = W_OUT + (size_t)DM * DM * 2, W_FC2 = W_FC1 + (size_t)DFF * DM * 2, W_LAYER = W_FC2 + (size_t)DM * DFF * 2;
constexpr size_t WS_ARENA = WS_WT + 2 * W_LAYER;
constexpr size_t SZ_ROW1024 = (size_t)MTOT * 1024 * 2;
constexpr size_t A_B = WS_ARENA;
constexpr size_t A_C = A_B + SZ_ROW1024;
constexpr size_t A_Y = A_B, A_XS2 = A_B, A_BIG = A_C;
constexpr size_t A_QKVN = A_BIG;
constexpr size_t A_PHY = A_QKVN + (size_t)MTOT * KUP * 2;
constexpr size_t A_KR = A_BIG + (size_t)MTOT * NGATE;
constexpr size_t A_DQ = A_KR + (size_t)MTOT * 32 * 2;
constexpr size_t A_DK = A_DQ + (size_t)MTOT * 256 * 2;
constexpr size_t A_DV = A_DK + (size_t)MTOT * 256 * 2;
constexpr size_t A_QKV = A_DV + (size_t)MTOT * 256 * 2;
constexpr size_t A_BIG_END = A_QKV + (size_t)MTOT * NUP * 2;
static_assert(A_PHY + (size_t)MTOT * 768 * 2 <= A_KR, "QKVN + PHY must fit under the gate bytes");
constexpr size_t O_UT = SZ_ROW1024, O_X0T = O_UT + (size_t)256 * NLAT * 2, O_UTC = O_X0T + (size_t)256 * NLAT * 2, O_X0TC = O_UTC + (size_t)256 * NCTX * 2, O_END = O_X0TC + (size_t)256 * NCTX * 2;
static_assert(O_END <= (size_t)NLAT * DM * 4, "d_out scratch overflow");
constexpr size_t A_G = A_BIG;
constexpr size_t A_HID = A_C;
constexpr size_t WS_END = (A_BIG_END > A_HID + (size_t)MTOT * DFF * 2) ? A_BIG_END : A_HID + (size_t)MTOT * DFF * 2;
static_assert(WS_END <= (size_t)1024 * 1024 * 1024, "workspace map exceeds 1 GiB");

constexpr int LDS_BYTES = 147456;
constexpr int LDS_MISC = LDS_BYTES - 64;

__device__ __forceinline__ unsigned pkh(float lo, float hi) { f32x2 v = {lo, hi}; hf2 h = __builtin_convertvector(v, hf2); return __builtin_bit_cast(unsigned, h); }
__device__ __forceinline__ float wave_sum(float v) {
#pragma unroll
    for (int o = 1; o < 64; o <<= 1) v += __shfl_xor(v, o);
    return v;
}
#define LDS_WAIT() asm volatile("s_waitcnt lgkmcnt(0)" ::: "memory")
#define VM_WAIT() asm volatile("s_waitcnt vmcnt(0)" ::: "memory")

#define XB_TMO      128
#define XB_XCNT(j)  (256  + 64 * (j))
#define XB_XSUB(j)  (1280 + 64 * (j))
#define XB_XGEN(j)  (2304 + 64 * (j))
#define XB_TOP      3328
#define XB_TOPGEN   3392
#define XCD_BAR_WORDS 3456
#define XB_SPIN_CAP (1u << 22)
__device__ __forceinline__ unsigned xb_ld(unsigned* p)              { return __hip_atomic_load(p, __ATOMIC_RELAXED, __HIP_MEMORY_SCOPE_AGENT); }
__device__ __forceinline__ unsigned xb_add(unsigned* p, unsigned v) { return __hip_atomic_fetch_add(p, v, __ATOMIC_RELAXED, __HIP_MEMORY_SCOPE_AGENT); }
__device__ __forceinline__ unsigned xb_xcc_id() { return (unsigned)__builtin_amdgcn_s_getreg((3 << 11) | 20) & 0xFu; }
#define XB_SPIN(cond, bar) do { unsigned _sp = 0; while (cond) { __builtin_amdgcn_s_sleep(1); \
    if ((++_sp & 255u) == 0u) { if (xb_ld(&(bar)[XB_TMO])) break; if (_sp > XB_SPIN_CAP) { atomicAdd(&(bar)[XB_TMO], 1u); break; } } } } while (0)
struct XcdBarrier { unsigned* bar; unsigned x; volatile LAS unsigned* st; };
__device__ __forceinline__ XcdBarrier xcd_barrier_post(unsigned* bar, volatile LAS unsigned* st) {
    XcdBarrier b; b.bar = bar; b.x = xb_xcc_id(); b.st = st;
    if (threadIdx.x == 0) (void)xb_add(&bar[XB_XCNT(b.x)], 1u);
    return b;
}
__device__ __forceinline__ void xcd_barrier_complete(unsigned* bar, unsigned x, unsigned& nloc, unsigned& nx) {
    const unsigned G = gridDim.x * gridDim.y * gridDim.z;
    unsigned sum, cnt, mine, sp = 0u;
    for (;;) {
        sum = 0u; cnt = 0u; mine = 0u;
#pragma unroll
        for (unsigned j = 0; j < 16; ++j) { const unsigned c = xb_ld(&bar[XB_XCNT(j)]); sum += c; cnt += (c > 0u) ? 1u : 0u; mine = (j == x) ? c : mine; }
        if (sum == G) break;
        __builtin_amdgcn_s_sleep(1);
        if ((++sp & 255u) == 0u) { if (xb_ld(&bar[XB_TMO])) break; if (sp > XB_SPIN_CAP) { atomicAdd(&bar[XB_TMO], 1u); break; } }
    }
    nloc = mine > 0u ? mine : 1u; nx = cnt > 0u ? cnt : 1u;
}
__device__ __forceinline__ void xcd_barrier(const XcdBarrier& b) {
    asm volatile("s_waitcnt vmcnt(0)" ::: "memory");
    __syncthreads();
    if (threadIdx.x == 0) {
        unsigned* bar = b.bar;
        __builtin_amdgcn_s_waitcnt(0);
        unsigned nloc = b.st[0], nx = b.st[1];
        if (nloc == 0u) { xcd_barrier_complete(bar, b.x, nloc, nx); b.st[0] = nloc; b.st[1] = nx; }
        const unsigned old = xb_add(&bar[XB_XSUB(b.x)], 1u);
        const unsigned gen = old / nloc;
        if (old + 1u == (gen + 1u) * nloc) {
            __builtin_amdgcn_fence(__ATOMIC_RELEASE, "agent");
            asm volatile("s_waitcnt vmcnt(0)" ::: "memory");
            const unsigned og = xb_add(&bar[XB_TOP], 1u);
            const unsigned tg = og / nx;
            if (og + 1u == (tg + 1u) * nx) xb_add(&bar[XB_TOPGEN], 1u);
            else XB_SPIN(xb_ld(&bar[XB_TOPGEN]) == tg, bar);
            __builtin_amdgcn_fence(__ATOMIC_ACQUIRE, "agent");
            xb_add(&bar[XB_XGEN(b.x)], 1u);
            asm volatile("s_waitcnt vmcnt(0)" ::: "memory");
        } else {
            XB_SPIN(xb_ld(&bar[XB_XGEN(b.x)]) == gen, bar);
            __builtin_amdgcn_fence(__ATOMIC_ACQUIRE, "agent");
            asm volatile("s_waitcnt vmcnt(0)" ::: "memory");
        }
    }
    __syncthreads();
}

namespace pg8 {
constexpr int BM = 256, BK = 64, HALF = 128, HTB = HALF * BK * 2, STAGE_BYTES = 8 * HTB, NXCD = 8, WGM = 8;
__host__ __device__ __forceinline__ int lds_byte(int r, int c) { const int st = (r >> 4) * 2 + (c >> 5), rr = r & 15, cc = c & 31, ob = rr * 64 + cc * 2; return st * 1024 + (ob ^ (((ob >> 9) & 1) << 5)); }
__host__ __device__ __forceinline__ void stage_rc(int b, int& R, int& C) { const int st = b / 1024, sb = b % 1024, swz = sb ^ (((sb >> 9) & 1) << 5); R = (st >> 1) * 16 + swz / 64; C = (st & 1) * 32 + (swz % 64) / 2; }
__host__ __device__ __forceinline__ int perm32(int rho) { const int n = rho >> 4, i = rho & 15; return 8 * (i >> 2) + 4 * n + (i & 3); }
struct Unit { int pm, pn; };
struct Gemm { const hf* A; const hf* Bt; int M, N, K, lda, ldb; };
struct StaticOrder {
    int nM, nN, nwg, G, c;
    __host__ __device__ void init(int M, int N, int G_, int c_) { nM = M / BM; nN = N / BM; nwg = nM * nN; G = G_; c = c_; }
    __host__ __device__ bool next(int i, Unit& u) const {
        const long L = (long)i * G + c; if (L >= nwg) return false;
        int wgid = (int)L; { const int q = nwg / NXCD, r = nwg % NXCD, xcd = wgid % NXCD, off = wgid / NXCD; wgid = (xcd < r ? xcd * (q + 1) : r * (q + 1) + (xcd - r) * q) + off; }
        const int nig = WGM * nN, gid = wgid / nig, fm = gid * WGM, gsz = (nM - fm) < WGM ? (nM - fm) : WGM;
        u.pm = fm + ((wgid % nig) % gsz); u.pn = (wgid % nig) / gsz; return true;
    }
    __device__ __forceinline__ void a_ready(const Unit&) const {}
    __device__ __forceinline__ void done(const Unit&) const {}
};

template <int ACT  , bool NORM> struct EpiHalf {
    static constexpr bool PERM = true, AFTER_DRAIN = false, PROBE2 = false, MIDK = false;
    hf* O; int ldc; const float* ss; const float* bias;
    __device__ __forceinline__ void operator()(const f32x4 (&acc)[2][2][4][2], const Unit& u, int wr, int wc, int fr, int fq) const {
        const int row0 = u.pm * BM + wr * 64 + fr, col0 = u.pn * BM + wc * 32 + 8 * fq;
        f32x4 bv[2][2];
        if (NORM) { const int R0 = u.pm * BM; const int v = (R0 < NLAT) ? (R0 >> 11) : NB; const float* bp = bias + (size_t)v * NBIAS + col0;
#pragma unroll
            for (int bj = 0; bj < 2; ++bj)
#pragma unroll
                for (int n = 0; n < 2; ++n) bv[bj][n] = *(const f32x4*)(bp + bj * HALF + 4 * n); }
#pragma unroll
        for (int ai = 0; ai < 2; ++ai)
#pragma unroll
            for (int m = 0; m < 4; ++m) { const int r = row0 + ai * HALF + m * 16; hf* rowp = O + (size_t)r * ldc + col0;
                float rs = 1.f; if (NORM) rs = rsqrtf(ss[r] * (1.f / DM) + EPS);
#pragma unroll
                for (int bj = 0; bj < 2; ++bj) { f32x4 v0 = acc[ai][bj][m][0], v1 = acc[ai][bj][m][1];
                    if (NORM) { v0 = v0 * rs + bv[bj][0]; v1 = v1 * rs + bv[bj][1]; }
                    if (ACT == 1) {
#pragma unroll
                        for (int e = 0; e < 4; ++e) { v0[e] = __builtin_amdgcn_rcpf(1.f + __builtin_amdgcn_exp2f(-1.4426950408889634f * v0[e])); v1[e] = __builtin_amdgcn_rcpf(1.f + __builtin_amdgcn_exp2f(-1.4426950408889634f * v1[e])); } }
                    if (ACT == 2) {
#pragma unroll
                        for (int e = 0; e < 4; ++e) { const float a = fmaxf(v0[e], 0.f), b = fmaxf(v1[e], 0.f); v0[e] = a * a; v1[e] = b * b; } }
                    u32x4 w; w.x = pkh(v0[0], v0[1]); w.y = pkh(v0[2], v0[3]); w.z = pkh(v1[0], v1[1]); w.w = pkh(v1[2], v1[3]);
                    *(u32x4*)(rowp + bj * HALF) = w; } }
    }
};
struct EpiGate8 {
    static constexpr bool PERM = true, AFTER_DRAIN = false, PROBE2 = false, MIDK = false;
    unsigned char* O; const float* ss; const float* bias;
    __device__ __forceinline__ void operator()(const f32x4 (&acc)[2][2][4][2], const Unit& u, int wr, int wc, int fr, int fq) const {
        const int R0 = u.pm * BM, row0 = R0 + wr * 64 + fr, col0 = u.pn * BM + wc * 32 + 8 * fq;
        const int v = (R0 < NLAT) ? (R0 >> 11) : NB; const float* bp = bias + (size_t)v * NBIAS + col0;
        f32x4 bv[2][2];
#pragma unroll
        for (int bj = 0; bj < 2; ++bj) { bv[bj][0] = *(const f32x4*)(bp + bj * HALF); bv[bj][1] = *(const f32x4*)(bp + bj * HALF + 4); }
#pragma unroll
        for (int ai = 0; ai < 2; ++ai)
#pragma unroll
            for (int m = 0; m < 4; ++m) { const int r = row0 + ai * HALF + m * 16; const float rs = rsqrtf(ss[r] * (1.f / DM) + EPS);
#pragma unroll
                for (int bj = 0; bj < 2; ++bj) { const f32x4 v0 = acc[ai][bj][m][0] * rs + bv[bj][0], v1 = acc[ai][bj][m][1] * rs + bv[bj][1];
                    unsigned q[8];
#pragma unroll
                    for (int e = 0; e < 4; ++e) { const float g0 = __builtin_amdgcn_rcpf(1.f + __builtin_amdgcn_exp2f(-1.4426950408889634f * v0[e])), g1 = __builtin_amdgcn_rcpf(1.f + __builtin_amdgcn_exp2f(-1.4426950408889634f * v1[e]));
                        q[e] = (unsigned)fmaxf(1.f, __builtin_rintf(255.f * g0)); q[4 + e] = (unsigned)fmaxf(1.f, __builtin_rintf(255.f * g1)); }
                    u32x2 w; w.x = q[0] | (q[1] << 8) | (q[2] << 16) | (q[3] << 24); w.y = q[4] | (q[5] << 8) | (q[6] << 16) | (q[7] << 24);
                    *(u32x2*)(O + (size_t)r * NGATE + col0 + bj * HALF) = w; } }
    }
};
struct EpiIn {
    static constexpr bool PERM = true, AFTER_DRAIN = false, PROBE2 = false, MIDK = false;
    hf* QKVNo; hf* KRo; hf* PHYo; hf* DQo; hf* DKo; hf* DVo; const float* ss; const float* bias; float* ssq; float* sskv;
    __device__ __forceinline__ void operator()(const f32x4 (&acc)[2][2][4][2], const Unit& u, int wr, int wc, int fr, int fq) const {
        const int R0 = u.pm * BM, row0 = R0 + wr * 64 + fr, col0 = u.pn * BM + wc * 32 + 8 * fq;
        const int v = (R0 < NLAT) ? (R0 >> 11) : NB; const float* bp = bias + (size_t)v * NBIAS + col0;
        f32x4 bv[2][2]; hf* dst[2]; int ld[2];
#pragma unroll
        for (int bj = 0; bj < 2; ++bj) { const int c8 = col0 + bj * HALF;
            bv[bj][0] = *(const f32x4*)(bp + bj * HALF); bv[bj][1] = *(const f32x4*)(bp + bj * HALF + 4);
            if (c8 < C_PKR) { dst[bj] = QKVNo + c8; ld[bj] = KUP; }
            else if (c8 < C_HY) { dst[bj] = KRo + (c8 - C_PKR); ld[bj] = 32; }
            else if (c8 < C_DQ) { dst[bj] = PHYo + (c8 - C_HY); ld[bj] = 768; }
            else if (c8 < C_DK) { dst[bj] = DQo + (c8 - C_DQ); ld[bj] = 256; }
            else if (c8 < C_DV) { dst[bj] = DKo + (c8 - C_DK); ld[bj] = 256; }
            else if (c8 < C_PG) { dst[bj] = DVo + (c8 - C_DV); ld[bj] = 256; }
            else { dst[bj] = nullptr; ld[bj] = 0; } }
        const int nstat = (u.pn == 0) ? 2 : (u.pn == 1 ? 1 : 0);
        float* sp = (u.pn == 0) ? ssq : sskv;
#pragma unroll
        for (int ai = 0; ai < 2; ++ai)
#pragma unroll
            for (int m = 0; m < 4; ++m) { const int r = row0 + ai * HALF + m * 16; const float rs = rsqrtf(ss[r] * (1.f / DM) + EPS); float sq = 0.f;
#pragma unroll
                for (int bj = 0; bj < 2; ++bj) { const f32x4 v0 = acc[ai][bj][m][0] * rs + bv[bj][0], v1 = acc[ai][bj][m][1] * rs + bv[bj][1];
                    if (bj < nstat) sq += (v0[0] * v0[0] + v0[1] * v0[1]) + (v0[2] * v0[2] + v0[3] * v0[3]) + (v1[0] * v1[0] + v1[1] * v1[1]) + (v1[2] * v1[2] + v1[3] * v1[3]);
                    if (dst[bj]) { u32x4 w; w.x = pkh(v0[0], v0[1]); w.y = pkh(v0[2], v0[3]); w.z = pkh(v1[0], v1[1]); w.w = pkh(v1[2], v1[3]); *(u32x4*)(dst[bj] + (size_t)r * ld[bj]) = w; } }
                if (nstat) { sq += __shfl_xor(sq, 16); sq += __shfl_xor(sq, 32);
                    if (fq == 0) (void)__hip_atomic_fetch_add(sp + r, sq, __ATOMIC_RELAXED, __HIP_MEMORY_SCOPE_AGENT); } }
    }
};
struct EpiUp {
    static constexpr bool PERM = true, AFTER_DRAIN = false, PROBE2 = false, MIDK = false;
    hf* O; const float* ssq; const float* sskv;
    __device__ __forceinline__ void operator()(const f32x4 (&acc)[2][2][4][2], const Unit& u, int wr, int wc, int fr, int fq) const {
        const int row0 = u.pm * BM + wr * 64 + fr, col0 = u.pn * BM + wc * 32 + 8 * fq;
        const bool isq = u.pn < 3; const float* sp = isq ? ssq : sskv; const float invn = isq ? (1.f / 256.f) : (1.f / 128.f);
#pragma unroll
        for (int ai = 0; ai < 2; ++ai)
#pragma unroll
            for (int m = 0; m < 4; ++m) { const int r = row0 + ai * HALF + m * 16; hf* rowp = O + (size_t)r * NUP + col0; const float rs = rsqrtf(sp[r] * invn + EPS);
#pragma unroll
                for (int bj = 0; bj < 2; ++bj) { const f32x4 v0 = acc[ai][bj][m][0] * rs, v1 = acc[ai][bj][m][1] * rs;
                    u32x4 w; w.x = pkh(v0[0], v0[1]); w.y = pkh(v0[2], v0[3]); w.z = pkh(v1[0], v1[1]); w.w = pkh(v1[2], v1[3]);
                    *(u32x4*)(rowp + bj * HALF) = w; } }
    }
};
template <bool FIRST> struct EpiGated {
    static constexpr bool PERM = true, AFTER_DRAIN = false, PROBE2 = false, MIDK = false;
    hf* MMo; const hf* G; int goff;
    __device__ __forceinline__ void operator()(const f32x4 (&acc)[2][2][4][2], const Unit& u, int wr, int wc, int fr, int fq) const {
        const int row0 = u.pm * BM + wr * 64 + fr, col0 = u.pn * BM + wc * 32 + 8 * fq;
#pragma unroll
        for (int ai = 0; ai < 2; ++ai)
#pragma unroll
            for (int m = 0; m < 4; ++m) { const size_t r = (size_t)(row0 + ai * HALF + m * 16);
#pragma unroll
                for (int bj = 0; bj < 2; ++bj) { const f32x4 v0 = acc[ai][bj][m][0], v1 = acc[ai][bj][m][1];
                    const hf8 g = *(const hf8*)(G + r * NGATE + goff + col0 + bj * HALF);
                    hf* mp = MMo + r * DM + col0 + bj * HALF;
                    float o[8];
#pragma unroll
                    for (int e = 0; e < 4; ++e) { o[e] = (float)g[e] * v0[e]; o[4 + e] = (float)g[4 + e] * v1[e]; }
                    if (!FIRST) { const hf8 p = *(const hf8*)mp;
#pragma unroll
                        for (int e = 0; e < 8; ++e) o[e] += (float)p[e]; }
                    u32x4 w; w.x = pkh(o[0], o[1]); w.y = pkh(o[2], o[3]); w.z = pkh(o[4], o[5]); w.w = pkh(o[6], o[7]);
                    *(u32x4*)mp = w; } }
    }
};
struct EpiMerge {
    static constexpr bool PERM = true, AFTER_DRAIN = false, PROBE2 = false, MIDK = true;
    static constexpr int MID1 = 8, MID2 = 12;
    hf* MMo; const unsigned char* G;
    __device__ __forceinline__ void mid(f32x4 (&acc)[2][2][4][2], const Unit& u, int which, int wr, int wc, int fr, int fq) const {
        asm volatile("" : "+v"(fr), "+v"(fq));
        const int row0 = u.pm * BM + wr * 64 + fr, col0 = u.pn * BM + wc * 32 + 8 * fq; const int gnum = which ? 1024 : 0, gden = which ? 2048 : 1024;
#pragma unroll
        for (int ai = 0; ai < 2; ++ai) {
            u32x2 gn[4][2], gd[4][2];
#pragma unroll
            for (int m = 0; m < 4; ++m) { const unsigned char* gr = G + (size_t)(row0 + ai * HALF + m * 16) * NGATE + col0;
#pragma unroll
                for (int bj = 0; bj < 2; ++bj) { gn[m][bj] = *(const u32x2*)(gr + gnum + bj * HALF); gd[m][bj] = *(const u32x2*)(gr + gden + bj * HALF); } }
#pragma unroll
            for (int m = 0; m < 4; ++m)
#pragma unroll
                for (int bj = 0; bj < 2; ++bj)
#pragma unroll
                    for (int e = 0; e < 4; ++e) {
                        acc[ai][bj][m][0][e] *= (float)((gn[m][bj].x >> (8 * e)) & 255u) * __builtin_amdgcn_rcpf((float)((gd[m][bj].x >> (8 * e)) & 255u));
                        acc[ai][bj][m][1][e] *= (float)((gn[m][bj].y >> (8 * e)) & 255u) * __builtin_amdgcn_rcpf((float)((gd[m][bj].y >> (8 * e)) & 255u)); }
            asm volatile("" ::: "memory");
        }
    }
    __device__ __forceinline__ void operator()(const f32x4 (&acc)[2][2][4][2], const Unit& u, int wr, int wc, int fr, int fq) const {
        const int row0 = u.pm * BM + wr * 64 + fr, col0 = u.pn * BM + wc * 32 + 8 * fq;
#pragma unroll
        for (int ai = 0; ai < 2; ++ai)
#pragma unroll
            for (int m = 0; m < 4; ++m) { const size_t r = (size_t)(row0 + ai * HALF + m * 16);
#pragma unroll
                for (int bj = 0; bj < 2; ++bj) { const f32x4 v0 = acc[ai][bj][m][0], v1 = acc[ai][bj][m][1];
                    const u32x2 g = *(const u32x2*)(G + r * NGATE + 2048 + col0 + bj * HALF);
                    float o[8];
#pragma unroll
                    for (int e = 0; e < 4; ++e) { o[e] = (float)((g.x >> (8 * e)) & 255u) * (1.f / 255.f) * v0[e]; o[4 + e] = (float)((g.y >> (8 * e)) & 255u) * (1.f / 255.f) * v1[e]; }
                    u32x4 w; w.x = pkh(o[0], o[1]); w.y = pkh(o[2], o[3]); w.z = pkh(o[4], o[5]); w.w = pkh(o[6], o[7]);
                    *(u32x4*)(MMo + r * DM + col0 + bj * HALF) = w; } }
    }
};
template <bool XS, bool STAT> struct EpiResidX {
    static constexpr bool PERM = true, AFTER_DRAIN = false, PROBE2 = false, MIDK = false;
    hf* x16; const float* gate;
    hf* xsout; const float* gs; float* ss;
    __device__ __forceinline__ void operator()(const f32x4 (&acc)[2][2][4][2], const Unit& u, int wr, int wc, int fr, int fq) const {
        const int R0 = u.pm * BM; const int v = (R0 < NLAT) ? (R0 >> 11) : NB;
        const int rglob = R0 + wr * 64 + fr, col0 = u.pn * BM + wc * 32 + 8 * fq;
        const float* gp = gate + (size_t)v * MODW + col0; const float* gsp = gs + (size_t)v * DM + col0;
        float sq[2][4];
#pragma unroll
        for (int ai = 0; ai < 2; ++ai)
#pragma unroll
            for (int m = 0; m < 4; ++m) sq[ai][m] = 0.f;
#pragma unroll
        for (int bj = 0; bj < 2; ++bj) {
            const f32x4 g0 = *(const f32x4*)(gp + bj * HALF), g1 = *(const f32x4*)(gp + bj * HALF + 4);
            f32x4 s0 = {1.f, 1.f, 1.f, 1.f}, s1 = s0; if (XS) { s0 = *(const f32x4*)(gsp + bj * HALF); s1 = *(const f32x4*)(gsp + bj * HALF + 4); }
#pragma unroll
            for (int ai = 0; ai < 2; ++ai)
#pragma unroll
                for (int m = 0; m < 4; ++m) { const int rr = ai * HALF + m * 16; const size_t off = (size_t)(rglob + rr) * DM + col0 + bj * HALF;
                    const hf8 xv = *(const hf8*)(x16 + off);
                    const f32x4 x0 = {(float)xv[0], (float)xv[1], (float)xv[2], (float)xv[3]}, x1 = {(float)xv[4], (float)xv[5], (float)xv[6], (float)xv[7]};
                    const f32x4 n0 = x0 + g0 * acc[ai][bj][m][0], n1 = x1 + g1 * acc[ai][bj][m][1];
                    { u32x4 w; w.x = pkh(n0[0], n0[1]); w.y = pkh(n0[2], n0[3]); w.z = pkh(n1[0], n1[1]); w.w = pkh(n1[2], n1[3]); *(u32x4*)(x16 + off) = w; }
                    if (STAT) sq[ai][m] += (n0[0] * n0[0] + n0[1] * n0[1]) + (n0[2] * n0[2] + n0[3] * n0[3]) + (n1[0] * n1[0] + n1[1] * n1[1]) + (n1[2] * n1[2] + n1[3] * n1[3]);
                    if (XS) { const f32x4 a = n0 * s0, b = n1 * s1; u32x4 w; w.x = pkh(a[0], a[1]); w.y = pkh(a[2], a[3]); w.z = pkh(b[0], b[1]); w.w = pkh(b[2], b[3]);
                        *(u32x4*)(xsout + off) = w; } }
        }
        if (STAT) {
#pragma unroll
            for (int ai = 0; ai < 2; ++ai)
#pragma unroll
                for (int m = 0; m < 4; ++m) { float t = sq[ai][m]; t += __shfl_xor(t, 16); t += __shfl_xor(t, 32);
                    if (fq == 0) (void)__hip_atomic_fetch_add(ss + rglob + ai * HALF + m * 16, t, __ATOMIC_RELAXED, __HIP_MEMORY_SCOPE_AGENT); }
        }
    }
};

template <class Epi, class Sched, bool ALIGN_EPI = true>
__device__ __forceinline__ void gemm_phase(LAS unsigned char* lds, const Gemm g, const Sched& S, const Epi& E) {
    int tid = threadIdx.x; asm volatile("" : "+v"(tid));
    const int wid = __builtin_amdgcn_readfirstlane(tid >> 6), lane = tid & 63, wr = wid >> 2, wc = wid & 3, fr = lane & 15, fq = lane >> 4;
    const int K = g.K, nt = K / BK;
    unsigned voffA[2], voffB[2];
#pragma unroll
    for (int i = 0; i < 2; ++i) { int R, C; stage_rc(tid * 16 + i * 8192, R, C); const int Rb = Epi::PERM ? ((R & ~31) + perm32(R & 31)) : R;
        voffA[i] = (unsigned)(R * g.lda + C) * 2u; voffB[i] = (unsigned)(Rb * g.ldb + C) * 2u; }
    const size_t kstep = (size_t)(BK * 2);
    const size_t hstepA = (size_t)HALF * g.lda * 2, hstepB = (size_t)HALF * g.ldb * 2;
    const size_t tstepA = 2 * hstepA, tstepB = 2 * hstepB;
    const unsigned ldsw = (unsigned)wid * 1024u;
    const int aoff = lds_byte(wr * 64 + fr, fq * 8), boff = lds_byte(wc * 32 + fr, fq * 8);
#define PG8_SA(b, h) (((b) * 2 + (h)) * HTB)
#define PG8_SB(b, h) ((4 + (b) * 2 + (h)) * HTB)
#define PG8_STAGE(bufoff, gbase, voff) do { _Pragma("unroll") for (int _i = 0; _i < 2; ++_i) \
        __builtin_amdgcn_global_load_lds((const unsigned*)((const char*)(gbase) + (voff)[_i]), (LAS unsigned*)(lds + (bufoff) + ldsw + _i * 8192), 16, 0, 0); } while (0)
#define PG8_LDA(dst, b, h) do { _Pragma("unroll") for (int m = 0; m < 4; ++m) _Pragma("unroll") for (int k = 0; k < 2; ++k) dst[m][k] = *(const LAS hf8*)(lds + PG8_SA(b, h) + aoff + m * 2048 + k * 1024); } while (0)
#define PG8_LDB(dst, b, h) do { _Pragma("unroll") for (int n = 0; n < 2; ++n) _Pragma("unroll") for (int k = 0; k < 2; ++k) dst[n][k] = *(const LAS hf8*)(lds + PG8_SB(b, h) + boff + n * 2048 + k * 1024); } while (0)
#define PG8_MMA(ai, bj, At, Bt) do { __builtin_amdgcn_s_setprio(1); _Pragma("unroll") for (int m = 0; m < 4; ++m) _Pragma("unroll") for (int n = 0; n < 2; ++n) _Pragma("unroll") for (int k = 0; k < 2; ++k) \
        acc[ai][bj][m][n] = __builtin_amdgcn_mfma_f32_16x16x32_f16(Bt[n][k], At[m][k], acc[ai][bj][m][n], 0, 0, 0); __builtin_amdgcn_s_setprio(0); } while (0)
#define PG8_WAIT_V(n) asm volatile("s_waitcnt vmcnt(" #n ")" ::: "memory")
#define PG8_WAIT_L(n) asm volatile("s_waitcnt lgkmcnt(" #n ")" ::: "memory")
#define PG8_BAR __builtin_amdgcn_s_barrier()
#define PG8_SCHED __builtin_amdgcn_sched_barrier(0)
    Unit cur, nxt; int ui = 0;
    if (!S.next(0, cur)) return;
    f32x4 acc[2][2][4][2];
#pragma unroll
    for (int a = 0; a < 2; ++a)
#pragma unroll
        for (int b = 0; b < 2; ++b)
#pragma unroll
            for (int m = 0; m < 4; ++m)
#pragma unroll
                for (int n = 0; n < 2; ++n) acc[a][b][m][n] = (f32x4){0.f, 0.f, 0.f, 0.f};
    hf8 At[4][2], B0[2][2], B1[2][2];
    const char* cA = (const char*)g.A + (size_t)cur.pm * tstepA; const char* cB = (const char*)g.Bt + (size_t)cur.pn * tstepB;
    S.a_ready(cur);
    PG8_STAGE(PG8_SB(0, 0), cB, voffB); PG8_STAGE(PG8_SB(0, 1), cB + hstepB, voffB); PG8_STAGE(PG8_SA(0, 0), cA, voffA); PG8_STAGE(PG8_SA(0, 1), cA + hstepA, voffA);
    if (wr == 1) PG8_BAR;
    PG8_WAIT_V(2); PG8_BAR;
    PG8_STAGE(PG8_SB(1, 0), cB + kstep, voffB); PG8_STAGE(PG8_SA(1, 0), cA + kstep, voffA); PG8_STAGE(PG8_SB(1, 1), cB + hstepB + kstep, voffB);
    PG8_WAIT_V(6); PG8_BAR;
    for (;;) {
        const bool has_next = S.next(ui + 1, nxt);
        const char* nA = has_next ? (const char*)g.A + (size_t)nxt.pm * tstepA : cA; const char* nB = has_next ? (const char*)g.Bt + (size_t)nxt.pn * tstepB : cB;
#pragma unroll 1
        for (int t = 0; t < nt; t += 2) {
            const bool last = (t == nt - 2);
            const char* a1 = cA + (size_t)(t + 1) * kstep;
            const char* a2 = last ? nA : cA + (size_t)(t + 2) * kstep; const char* b2 = last ? nB : cB + (size_t)(t + 2) * kstep;
            const char* a3 = a2 + kstep; const char* b3 = b2 + kstep;
            if (last && has_next) S.a_ready(nxt);
            if constexpr (Epi::MIDK) { if (t == Epi::MID1 || t == Epi::MID2) E.mid(acc, cur, t == Epi::MID1 ? 0 : 1, wr, wc, fr, fq); }
            PG8_LDB(B0, 0, 0); PG8_LDB(B1, 0, 1); PG8_SCHED; PG8_LDA(At, 0, 0); PG8_STAGE(PG8_SA(1, 1), a1 + hstepA, voffA);
            PG8_WAIT_V(8); PG8_WAIT_L(0); PG8_BAR; PG8_MMA(0, 0, At, B0); PG8_MMA(0, 1, At, B1); PG8_BAR; PG8_SCHED;
            PG8_LDA(At, 0, 1); PG8_STAGE(PG8_SB(0, 0), b2, voffB); PG8_STAGE(PG8_SB(0, 1), b2 + hstepB, voffB); PG8_STAGE(PG8_SA(0, 0), a2, voffA);
            PG8_WAIT_V(8); PG8_WAIT_L(0); PG8_BAR; PG8_MMA(1, 0, At, B0); PG8_MMA(1, 1, At, B1); PG8_BAR; PG8_SCHED;
            PG8_LDB(B0, 1, 0); PG8_LDB(B1, 1, 1); PG8_SCHED; PG8_LDA(At, 1, 0); PG8_STAGE(PG8_SA(0, 1), a2 + hstepA, voffA);
            PG8_WAIT_V(8); PG8_WAIT_L(0); PG8_BAR; PG8_MMA(0, 0, At, B0); PG8_MMA(0, 1, At, B1); PG8_BAR; PG8_SCHED;
            PG8_LDA(At, 1, 1); PG8_STAGE(PG8_SB(1, 0), b3, voffB); PG8_STAGE(PG8_SB(1, 1), b3 + hstepB, voffB); PG8_STAGE(PG8_SA(1, 0), a3, voffA);
            PG8_WAIT_V(8); PG8_WAIT_L(0); PG8_BAR; PG8_MMA(1, 0, At, B0); PG8_MMA(1, 1, At, B1); PG8_BAR; PG8_SCHED;
        }
        if constexpr (ALIGN_EPI) { if (wr == 0) PG8_BAR; }
        E(acc, cur, wr, wc, fr, fq); S.done(cur);
#ifdef PROBE_EPI2
        if (Epi::PROBE2) { asm volatile("" ::: "memory"); E(acc, cur, wr, wc, fr, fq); }
#endif
        if (!has_next) break;
#pragma unroll
        for (int a = 0; a < 2; ++a)
#pragma unroll
            for (int b = 0; b < 2; ++b)
#pragma unroll
                for (int m = 0; m < 4; ++m)
#pragma unroll
                    for (int n = 0; n < 2; ++n) acc[a][b][m][n] = (f32x4){0.f, 0.f, 0.f, 0.f};
        cur = nxt; cA = nA; cB = nB; ++ui;
        if constexpr (ALIGN_EPI) { if (wr == 1) PG8_BAR; }
    }
    PG8_WAIT_V(0);
    if constexpr (!ALIGN_EPI) { if (wr == 0) PG8_BAR; }
    PG8_BAR;
#undef PG8_SA
#undef PG8_SB
#undef PG8_STAGE
#undef PG8_LDA
#undef PG8_LDB
#undef PG8_MMA
#undef PG8_WAIT_V
#undef PG8_WAIT_L
#undef PG8_BAR
#undef PG8_SCHED
}
}

struct Params {
    const float* in[35];
    float* out;
    unsigned char* ws;
    int ph_lo, ph_hi;
};
enum { I_X = 0, I_C, I_CTX, I_CCTX, I_NMG, I_NFG, I_WMOD, I_BMOD, I_WIN, I_QNG, I_WUQ, I_KVNG, I_WUKV, I_HCW, I_HCB, I_HW1, I_HB1, I_HFREQ, I_HW2, I_HB2, I_HW3, I_HB3,
       I_HSKIP, I_LQ1, I_LK1, I_LQ2, I_LK2, I_SUBG, I_WBRA, I_WBRB, I_WBRC, I_WOUT, I_FC1, I_FC2, I_FNG };

struct Frame {
    LAS unsigned char* lds;
    int tid, lane, wave, vcu, G;
};

__device__ __forceinline__ void tr_item(const float* W, int ldw, hf* WT, int ldt, int nblk, LAS float* scr, int item, int lane, const float* kgain = nullptr) {
    const int kb = item / nblk, nb = item % nblk, k0 = 64 * kb, n0 = 32 * nb;
#pragma unroll 8
    for (int i = 0; i < 32; ++i) { const int kk = 2 * i + (lane >> 5); const float gk = kgain ? kgain[k0 + kk] : 1.f; { float wv = W[(size_t)(k0 + kk) * ldw + n0 + (lane & 31)] * gk; unsigned ub = __float_as_uint(wv); ub += 0x7fffu + ((ub >> 16) & 1u); ub &= 0xffff0000u; scr[kk * 33 + (lane & 31)] = __uint_as_float(ub); } }
    LDS_WAIT(); asm volatile("" ::: "memory");
    const int c = lane & 7;
#pragma unroll
    for (int j = 0; j < 4; ++j) { const int n = (lane >> 3) + 8 * j; const LAS float* s = scr + (8 * c) * 33 + n;
        u32x4 o; o.x = pkh(s[0 * 33], s[1 * 33]); o.y = pkh(s[2 * 33], s[3 * 33]); o.z = pkh(s[4 * 33], s[5 * 33]); o.w = pkh(s[6 * 33], s[7 * 33]);
        *(u32x4*)(WT + (size_t)(n0 + n) * ldt + k0 + 8 * c) = o; }
    LDS_WAIT(); asm volatile("" ::: "memory");
}
__device__ __forceinline__ float silu_f(float x) { return x / (1.f + expf(-x)); }

__device__ __forceinline__ void mod_phase(const Frame& F, const Params& p) {
    float* MOD = (float*)(p.ws + WS_MOD);
    LAS float* sv = (LAS float*)F.lds;
    constexpr int NCB = DEPTH * MODW / 512;
    for (int item = F.vcu; item < NCB * 3; item += F.G) {
        const int cb = item / 3, vg = item % 3;
        __syncthreads();
        for (int i = F.tid; i < 11 * 1024; i += 512) { const int v = vg * 11 + i / 1024, k = i % 1024;
            const float c = (v < NB) ? p.in[I_C][v * DM + k] : p.in[I_CCTX][k]; sv[i] = silu_f(c); }
        __syncthreads();
        const int gcol = cb * 512 + F.tid, l = gcol / MODW, n = gcol % MODW;
        const float* w = p.in[I_WMOD] + (size_t)l * DM * MODW + n;
        float acc[11];
#pragma unroll
        for (int v = 0; v < 11; ++v) acc[v] = 0.f;
#pragma unroll 4
        for (int k = 0; k < DM; k += 4) {
            const float w0 = w[(size_t)k * MODW], w1 = w[(size_t)(k + 1) * MODW], w2 = w[(size_t)(k + 2) * MODW], w3 = w[(size_t)(k + 3) * MODW];
#pragma unroll
            for (int v = 0; v < 11; ++v) { const f32x4 s = *(const LAS f32x4*)(sv + v * 1024 + k);
                acc[v] = fmaf(s[0], w0, acc[v]); acc[v] = fmaf(s[1], w1, acc[v]); acc[v] = fmaf(s[2], w2, acc[v]); acc[v] = fmaf(s[3], w3, acc[v]); }
        }
        const float bm = p.in[I_BMOD][(size_t)l * MODW + n];
#pragma unroll
        for (int v = 0; v < 11; ++v) MOD[((size_t)l * NMODV + vg * 11 + v) * MODW + n] = acc[v] + bm;
    }
    __syncthreads();
}

__device__ __forceinline__ void filt_item(const Params& p, int l, int kind  , int t, int lane) {
    const int L = kind ? CTXL : SEQ;
    hf* R = kind ? (hf*)(p.ws + WS_RFC) + (size_t)l * 256 * 512 : (hf*)(p.ws + WS_RF) + (size_t)l * 256 * 4096;
    const int rl = 2 * L;
    const float tl = (float)t / (float)(L - 1);
    const float wt = (6.283185307179586f / (float)L) * (float)t;
    float z = 0.f;
    if (lane == 0) z = tl;
    else if (lane <= 32) { const int bi = (lane - 1) & 15; const float band = 1e-4f + (15.f - 1e-4f) * ((float)bi / 15.f); const float a = band * wt; z = (lane <= 16) ? cosf(a) : -sinf(a); }
    const float* w1 = p.in[I_HW1] + (size_t)l * 33 * 64; const float* w2 = p.in[I_HW2] + (size_t)l * 64 * 64; const float* w3 = p.in[I_HW3] + (size_t)l * 64 * 512;
    const float fr = p.in[I_HFREQ][l * 64 + lane];
    float a1 = p.in[I_HB1][l * 64 + lane];
    for (int i = 0; i < 33; ++i) a1 = fmaf(__shfl(z, i), w1[i * 64 + lane], a1);
    a1 = sinf(fr * a1);
    float a2 = p.in[I_HB2][l * 64 + lane];
    for (int i = 0; i < 64; ++i) a2 = fmaf(__shfl(a1, i), w2[i * 64 + lane], a2);
    a2 = sinf(fr * a2);
    float h[8];
#pragma unroll
    for (int q = 0; q < 8; ++q) h[q] = p.in[I_HB3][l * 512 + q * 64 + lane];
    for (int i = 0; i < 64; ++i) { const float a = __shfl(a2, i);
#pragma unroll
        for (int q = 0; q < 8; ++q) h[q] = fmaf(a, w3[i * 512 + q * 64 + lane], h[q]); }
    const float d0 = -4.605170185988091f / 1.5f, d1 = -4.605170185988091f / 0.3f;
#pragma unroll
    for (int q = 0; q < 8; ++q) { const int o = q * 64 + lane, dir = o >> 8, c = o & 255;
        const float delta = fabsf(d0 + (d1 - d0) * ((float)c / 255.f));
        float val = h[q] * (expf(-tl * delta) + 0.05f);
        if (dir == 0) { if (t == 0) val += p.in[I_HSKIP][l * 256 + c]; R[(size_t)c * rl + (L - t)] = (hf)val; if (t == 0) R[(size_t)c * rl] = (hf)0.f; }
        else if (t >= 1) R[(size_t)c * rl + (L + t)] = (hf)val; }
}

__device__ __forceinline__ void convert_layer(const Frame& F, const Params& p, int l, unsigned char* wl, int wg_rank, int wg_count) {
    LAS float* scr = (LAS float*)(F.lds + F.wave * 16384);
    const int gw = wg_rank * 8 + F.wave, NGW = wg_count * 8, lane = F.lane;
    constexpr int IT_IN1 = 16 * 61, IT_ING = 16 * 96, IT_UQ = 4 * 24, IT_UKV = 2 * 32, IT_BRA = 8 * 32, IT_BRB = 4 * 32, IT_BRC = 4 * 32, IT_OUT = 16 * 32, IT_FC1 = 16 * 128, IT_FC2 = 64 * 32;
    constexpr int IT_LAYER = IT_IN1 + IT_ING + IT_UQ + IT_UKV + IT_BRA + IT_BRB + IT_BRC + IT_OUT + IT_FC1 + IT_FC2;
    for (int it = gw; it < IT_LAYER; it += NGW) {
        int r = it;
        if (r < IT_IN1) { tr_item(p.in[I_WIN] + (size_t)l * DM * D_IN, D_IN, (hf*)(wl + W_IN1), DM, 61, scr, r, lane); continue; } r -= IT_IN1;
        if (r < IT_ING) { tr_item(p.in[I_WIN] + (size_t)l * DM * D_IN + C_PG, D_IN, (hf*)(wl + W_ING), DM, 96, scr, r, lane); continue; } r -= IT_ING;
        if (r < IT_UQ) { tr_item(p.in[I_WUQ] + (size_t)l * 256 * 768, 768, (hf*)(wl + W_UP), KUP, 24, scr, r, lane, p.in[I_QNG] + l * 256); continue; } r -= IT_UQ;
        if (r < IT_UKV) { tr_item(p.in[I_WUKV] + (size_t)l * 128 * 1024, 1024, (hf*)(wl + W_UP) + (size_t)768 * KUP + 256, KUP, 32, scr, r, lane, p.in[I_KVNG] + l * 128); continue; } r -= IT_UKV;
        if (r < IT_BRA) { tr_item(p.in[I_WBRA] + (size_t)l * 512 * DM, DM, (hf*)(wl + W_BR), DM, 32, scr, r, lane); continue; } r -= IT_BRA;
        if (r < IT_BRB) { tr_item(p.in[I_WBRB] + (size_t)l * 256 * DM, DM, (hf*)(wl + W_BR) + 512, DM, 32, scr, r, lane); continue; } r -= IT_BRB;
        if (r < IT_BRC) { tr_item(p.in[I_WBRC] + (size_t)l * 256 * DM, DM, (hf*)(wl + W_BR) + 768, DM, 32, scr, r, lane); continue; } r -= IT_BRC;
        if (r < IT_OUT) { tr_item(p.in[I_WOUT] + (size_t)l * DM * DM, DM, (hf*)(wl + W_OUT), DM, 32, scr, r, lane); continue; } r -= IT_OUT;
        if (r < IT_FC1) { tr_item(p.in[I_FC1] + (size_t)l * DM * DFF, DFF, (hf*)(wl + W_FC1), DM, 128, scr, r, lane); continue; } r -= IT_FC1;
        tr_item(p.in[I_FC2] + (size_t)l * DFF * DM, DM, (hf*)(wl + W_FC2), DFF, 32, scr, r, lane);
    }
    const int gt = gw * 64 + lane, NGT = NGW * 64;
    u32x4* z1 = (u32x4*)((hf*)(wl + W_IN1) + (size_t)C_PG * DM);
    for (int i = gt; i < 96 * DM / 8; i += NGT) z1[i] = (u32x4){0u, 0u, 0u, 0u};
    hf* up = (hf*)(wl + W_UP);
    for (int i = gt; i < 768 * 16; i += NGT) { const int n = i / 16, k8 = i % 16; *(u32x4*)(up + (size_t)n * KUP + 256 + k8 * 8) = (u32x4){0u, 0u, 0u, 0u}; }
    for (int i = gt; i < 1024 * 32; i += NGT) { const int n = 768 + i / 32, k8 = i % 32; *(u32x4*)(up + (size_t)n * KUP + k8 * 8) = (u32x4){0u, 0u, 0u, 0u}; }
}

__device__ __forceinline__ void prologue_a(const Frame& F, const Params& p) {
    mod_phase(F, p);
    convert_layer(F, p, 0, p.ws + WS_WT, F.vcu, F.G);
    const int gw = F.vcu * 8 + F.wave, NGW = F.G * 8, lane = F.lane;
    for (int it = gw; it < DEPTH * (SEQ + CTXL); it += NGW) { const int l = it / (SEQ + CTXL), r = it % (SEQ + CTXL); if (r < SEQ) filt_item(p, l, 0, r, lane); else filt_item(p, l, 1, r - SEQ, lane); }
    {
        float* rope = (float*)(p.ws + WS_ROPE);
        const int gt = gw * 64 + lane, NGT = NGW * 64;
        for (int i = gt; i < SEQ * 16; i += NGT) { const int t = i >> 4, j = i & 15; const float pos = (j < 8) ? (float)(t / GRIDW) : (float)(t % GRIDW);
            const float inv = powf(10000.f, -(float)(j & 7) / 8.f); const float a = pos * inv; rope[t * 32 + j] = cosf(a); rope[t * 32 + 16 + j] = sinf(a); }
        if (gt < DEPTH) { const int l = gt; float s1 = 0.f, s2 = 0.f;
            for (int i = 0; i < 32; ++i) { s1 += p.in[I_LQ1][l * 32 + i] * p.in[I_LK1][l * 32 + i]; s2 += p.in[I_LQ2][l * 32 + i] * p.in[I_LK2][l * 32 + i]; }
            const float li = 0.8f - 0.6f * expf(-0.3f * (float)l);
            float* lam = (float*)(p.ws + WS_LAM); lam[2 * l] = expf(s1) - expf(s2) + li; lam[2 * l + 1] = 1.f - li; }
    }
}
__device__ __forceinline__ void prologue_b(const Frame& F, const Params& p) {
    const float* MOD = (const float*)(p.ws + WS_MOD); float* BIAS = (float*)(p.ws + WS_BIAS);
    {
        LAS float* sv = (LAS float*)F.lds;
        constexpr int NCB = DEPTH * NBIAS / 512;
        for (int item = F.vcu; item < NCB * 3; item += F.G) {
            const int cb = item / 3, vg = item % 3;
            const int gcol = cb * 512 + F.tid, l = gcol / NBIAS, n = gcol % NBIAS, n0 = (cb * 512) % NBIAS;
            const int soff = (n0 >= B_FC1) ? 3 * DM : 0;
            __syncthreads();
            for (int i = F.tid; i < 11 * 1024; i += 512) { const int v = vg * 11 + i / 1024, k = i % 1024; sv[i] = MOD[((size_t)l * NMODV + v) * MODW + soff + k]; }
            __syncthreads();
            const float* w; size_t ldw; bool valid = true;
            if (n < B_G) { w = p.in[I_WIN] + (size_t)l * DM * D_IN + n; ldw = D_IN; valid = n < C_PG; }
            else if (n < B_FC1) { w = p.in[I_WIN] + (size_t)l * DM * D_IN + C_PG + (n - B_G); ldw = D_IN; }
            else { w = p.in[I_FC1] + (size_t)l * DM * DFF + (n - B_FC1); ldw = DFF; }
            float acc[11];
#pragma unroll
            for (int v = 0; v < 11; ++v) acc[v] = 0.f;
            if (valid)
#pragma unroll 4
            for (int k = 0; k < DM; k += 4) {
                const float w0 = w[(size_t)k * ldw], w1 = w[(size_t)(k + 1) * ldw], w2 = w[(size_t)(k + 2) * ldw], w3 = w[(size_t)(k + 3) * ldw];
#pragma unroll
                for (int v = 0; v < 11; ++v) { const f32x4 sx = *(const LAS f32x4*)(sv + v * 1024 + k);
                    acc[v] = fmaf(sx[0], w0, acc[v]); acc[v] = fmaf(sx[1], w1, acc[v]); acc[v] = fmaf(sx[2], w2, acc[v]); acc[v] = fmaf(sx[3], w3, acc[v]); }
            }
#pragma unroll
            for (int v = 0; v < 11; ++v) BIAS[((size_t)l * NMODV + vg * 11 + v) * NBIAS + n] = acc[v];
        }
        __syncthreads();
    }
    const int gw = F.vcu * 8 + F.wave, NGW = F.G * 8, lane = F.lane;
    {
        float* GS = (float*)(p.ws + WS_GS);
        const int gt = gw * 64 + lane, NGT = NGW * 64;
        for (int i = gt; i < DEPTH * 2 * NMODV * DM; i += NGT) { const int c = i % DM, v = (i / DM) % NMODV, wh = (i / (DM * NMODV)) % 2, l = i / (DM * NMODV * 2);
            const float g = wh ? p.in[I_NFG][l * DM + c] : p.in[I_NMG][l * DM + c];
            GS[i] = g * (1.f + MOD[((size_t)l * NMODV + v) * MODW + (wh ? 4 * DM : DM) + c]); }
    }
    {
        hf* XS = (hf*)p.out; hf* X16 = (hf*)(p.ws + WS_X16); float* ss = (float*)(p.ws + WS_SS) + (size_t)SS_1 * MTOT;
        f32x4 g[4];
#pragma unroll
        for (int j = 0; j < 4; ++j) g[j] = *(const f32x4*)(p.in[I_NMG] + 4 * lane + 256 * j);
        for (int row = gw; row < MTOT; row += NGW) {
            const bool lat = row < NLAT; const float* xr = lat ? p.in[I_X] + (size_t)row * DM : p.in[I_CTX] + (size_t)(row - NLAT) * DM;
            const int v = lat ? (row >> 11) : NB; const float* mv = MOD + (size_t)v * MODW + DM;
            float sq = 0.f; hf* hr = XS + (size_t)row * DM; hf* xh = X16 + (size_t)row * DM;
#pragma unroll
            for (int j = 0; j < 4; ++j) { const f32x4 x = *(const f32x4*)(xr + 4 * lane + 256 * j); const f32x4 sc = *(const f32x4*)(mv + 4 * lane + 256 * j);
                sq += (x[0] * x[0] + x[1] * x[1]) + (x[2] * x[2] + x[3] * x[3]);
                const f32x4 o = x * (g[j] * (sc + 1.f)); u32x2 w; w.x = pkh(o[0], o[1]); w.y = pkh(o[2], o[3]); *(u32x2*)(hr + 4 * lane + 256 * j) = w;
                u32x2 w2; w2.x = pkh(x[0], x[1]); w2.y = pkh(x[2], x[3]); *(u32x2*)(xh + 4 * lane + 256 * j) = w2; }
            sq = wave_sum(sq);
            if (lane == 0) ss[row] = sq;
        }
    }
}

__device__ __forceinline__ void norm_phase(const Frame& F, const float* xs_lat, const float* xs_ctx, int nrows, const float* gain, const float* modl, int sh_off, int sc_off, hf* H) {
    const int gw = F.vcu * 8 + F.wave, NGW = F.G * 8, lane = F.lane;
    f32x4 g[4];
#pragma unroll
    for (int j = 0; j < 4; ++j) g[j] = *(const f32x4*)(gain + 4 * lane + 256 * j);
    for (int row = gw; row < nrows; row += NGW) {
        const bool lat = row < NLAT; const float* xr = lat ? xs_lat + (size_t)row * DM : xs_ctx + (size_t)(row - NLAT) * DM;
        const int v = lat ? (row >> 11) : NB; const float* mv = modl + (size_t)v * MODW;
        f32x4 x[4]; float ss = 0.f;
#pragma unroll
        for (int j = 0; j < 4; ++j) { x[j] = *(const f32x4*)(xr + 4 * lane + 256 * j); ss += (x[j][0] * x[j][0] + x[j][1] * x[j][1]) + (x[j][2] * x[j][2] + x[j][3] * x[j][3]); }
        const float rstd = rsqrtf(wave_sum(ss) * (1.f / DM) + EPS);
        hf* hr = H + (size_t)row * DM;
#pragma unroll
        for (int j = 0; j < 4; ++j) { const f32x4 sh = *(const f32x4*)(mv + sh_off + 4 * lane + 256 * j), sc = *(const f32x4*)(mv + sc_off + 4 * lane + 256 * j);
            const f32x4 y = (x[j] * rstd) * g[j]; const f32x4 o = y * (sc + 1.f) + sh;
            u32x2 w; w.x = pkh(o[0], o[1]); w.y = pkh(o[2], o[3]); *(u32x2*)(hr + 4 * lane + 256 * j) = w; }
    }
}
__device__ __forceinline__ void final_norm_phase(const Frame& F, const hf* X16, float* out, const float* gain, const float* ss) {
    const int gw = F.vcu * 8 + F.wave, NGW = F.G * 8, lane = F.lane;
    f32x4 g[4];
#pragma unroll
    for (int j = 0; j < 4; ++j) g[j] = *(const f32x4*)(gain + 4 * lane + 256 * j);
    for (int row = gw; row < NLAT; row += NGW) {
        const hf* xr = X16 + (size_t)row * DM; float* orow = out + (size_t)row * DM; const float rstd = rsqrtf(ss[row] * (1.f / DM) + EPS);
#pragma unroll
        for (int j = 0; j < 4; ++j) { const hf4 xh = *(const hf4*)(xr + 4 * lane + 256 * j); const f32x4 x = {(float)xh[0], (float)xh[1], (float)xh[2], (float)xh[3]};
            *(f32x4*)(orow + 4 * lane + 256 * j) = (x * rstd) * g[j]; }
    }
}

__device__ __forceinline__ void prep_rope(const Frame& F, const Params& p) {
    const int gw = F.vcu * 8 + F.wave, NGW = F.G * 8, lane = F.lane;
    hf* KR = (hf*)(p.ws + A_KR); hf* DK = (hf*)(p.ws + A_DK); const float* rope = (const float*)(p.ws + WS_ROPE);
    const int hh = lane >> 3, i0 = 2 * (lane & 7);
    for (int row0 = gw * 4; row0 < NLAT; row0 += NGW * 4) {
        hf2 a[4], b[4]; f32x2 c[4], sn[4]; float y1[4], y2[4], cc[4], ss[4];
#pragma unroll
        for (int q = 0; q < 4; ++q) { const int row = row0 + q, t = row & (SEQ - 1); const hf* dk = DK + (size_t)row * 256 + hh * 32 + i0;
            a[q] = *(const hf2*)dk; b[q] = *(const hf2*)(dk + 16); c[q] = *(const f32x2*)(rope + t * 32 + i0); sn[q] = *(const f32x2*)(rope + t * 32 + 16 + i0);
            if (lane < 16) { const hf* kr = KR + (size_t)row * 32 + lane; y1[q] = (float)kr[0]; y2[q] = (float)kr[16]; cc[q] = rope[t * 32 + lane]; ss[q] = rope[t * 32 + 16 + lane]; } }
#pragma unroll
        for (int q = 0; q < 4; ++q) { const int row = row0 + q; hf* dk = DK + (size_t)row * 256 + hh * 32 + i0;
            const float x1[2] = {(float)a[q][0], (float)a[q][1]}, x2[2] = {(float)b[q][0], (float)b[q][1]};
            *(unsigned*)dk = pkh(x1[0] * c[q][0] - x2[0] * sn[q][0], x1[1] * c[q][1] - x2[1] * sn[q][1]);
            *(unsigned*)(dk + 16) = pkh(x2[0] * c[q][0] + x1[0] * sn[q][0], x2[1] * c[q][1] + x1[1] * sn[q][1]);
            if (lane < 16) { hf* kr = KR + (size_t)row * 32 + lane; kr[0] = (hf)(y1[q] * cc[q] - y2[q] * ss[q]); kr[16] = (hf)(y2[q] * cc[q] + y1[q] * ss[q]); } }
    }
}
__device__ __forceinline__ void prep_hyena(const Frame& F, const Params& p, int l, bool with_ctx) {
    constexpr int INP = 784;
    constexpr int OUTP = 33;
    constexpr int OFF_OU = 66 * INP, OFF_OX = OFF_OU + 128 * OUTP * 4;
    const hf* PHY = (const hf*)(p.ws + A_PHY);
    LAS unsigned char* lds = F.lds; const int tid = F.tid;
    const float* cw = p.in[I_HCW] + (size_t)l * 3 * 768; const float* cb = p.in[I_HCB] + (size_t)l * 768;
    constexpr int U_LAT = NB * (SEQ / 64) * 2, U_CTX = NB * (CTXL / 64) * 2;
    const int nunit = U_LAT + (with_ctx ? U_CTX : 0);
    for (int un = F.vcu; un < nunit; un += F.G) {
        const bool ctx = un >= U_LAT; int r = ctx ? un - U_LAT : un; const int L = ctx ? CTXL : SEQ, ntile = L / 64;
        const int ch = r & 1; r >>= 1; const int tt = r % ntile, b = r / ntile;
        const int t0 = tt * 64; const size_t rowbase = ctx ? (size_t)NLAT + (size_t)b * CTXL : (size_t)b * SEQ;
        hf* dU = (hf*)((unsigned char*)p.out + (ctx ? O_UTC : O_UT)); hf* dX = (hf*)((unsigned char*)p.out + (ctx ? O_X0TC : O_X0T));
        __syncthreads();
        {
            u32x4 tmp[7];
#pragma unroll
            for (int k = 0; k < 7; ++k) { const int i = tid + 512 * k, rr = i / 48, q = i % 48, seg = q >> 4, c16 = q & 15; const int t = t0 - 1 + rr;
                tmp[k] = (u32x4){0u, 0u, 0u, 0u};
                if (i < 66 * 48 && t >= 0 && t < L) tmp[k] = *(const u32x4*)(PHY + (rowbase + t) * 768 + seg * 256 + ch * 128 + c16 * 8); }
#pragma unroll
            for (int k = 0; k < 7; ++k) { const int i = tid + 512 * k, rr = i / 48, q = i % 48, seg = q >> 4, c16 = q & 15;
                if (i < 66 * 48) *(LAS u32x4*)(lds + rr * INP + seg * 256 + c16 * 16) = tmp[k]; }
        }
        __syncthreads();
        {
            const int c = tid & 127, tg = tid >> 7, cg = ch * 128 + c;
            const float a0 = cw[cg], a1 = cw[768 + cg], a2 = cw[1536 + cg], ab = cb[cg];
            const float b0 = cw[256 + cg], b1 = cw[768 + 256 + cg], b2 = cw[1536 + 256 + cg], bb = cb[256 + cg];
            const float v0 = cw[512 + cg], v1 = cw[768 + 512 + cg], v2 = cw[1536 + 512 + cg], vb = cb[512 + cg];
            const LAS hf* in = (const LAS hf*)(lds + (16 * tg) * INP) + c;
            float p0 = (float)in[0], p1 = (float)in[128], p2 = (float)in[256];
            float c0 = (float)in[INP / 2], c1 = (float)in[INP / 2 + 128], c2 = (float)in[INP / 2 + 256];
            LAS hf* ou = (LAS hf*)(lds + OFF_OU) + c * (OUTP * 2) + 16 * tg; LAS hf* ox = (LAS hf*)(lds + OFF_OX) + c * (OUTP * 2) + 16 * tg;
#pragma unroll
            for (int j = 0; j < 16; ++j) { const LAS hf* nx = in + (j + 2) * (INP / 2);
                const float n0 = (float)nx[0], n1 = (float)nx[128], n2 = (float)nx[256];
                const float x0 = a0 * p0 + a1 * c0 + a2 * n0 + ab, x1 = b0 * p1 + b1 * c1 + b2 * n1 + bb, vv = v0 * p2 + v1 * c2 + v2 * n2 + vb;
                ou[j] = (hf)(vv * x1); ox[j] = (hf)x0;
                p0 = c0; p1 = c1; p2 = c2; c0 = n0; c1 = n1; c2 = n2; }
        }
        __syncthreads();
        {
            const int c = tid >> 2, q = tid & 3; const size_t go = ((size_t)(ch * 128 + c) * NB + b) * L + t0 + 16 * q;
            const LAS unsigned* su = (const LAS unsigned*)(lds + OFF_OU) + c * OUTP + 8 * q; const LAS unsigned* sx = (const LAS unsigned*)(lds + OFF_OX) + c * OUTP + 8 * q;
            u32x4 w0 = {su[0], su[1], su[2], su[3]}, w1 = {su[4], su[5], su[6], su[7]};
            *(u32x4*)(dU + go) = w0; *(u32x4*)(dU + go + 8) = w1;
            u32x4 y0 = {sx[0], sx[1], sx[2], sx[3]}, y1 = {sx[4], sx[5], sx[6], sx[7]};
            *(u32x4*)(dX + go) = y0; *(u32x4*)(dX + go + 8) = y1;
        }
    }
    __syncthreads();
}

namespace att {
#ifndef PROF_SEL
#define PROF_SEL -1
#endif
#define ATT_MARK(b) do { if (PROF_SEL >= 0 && F.tid == 0) { volatile LAS unsigned* _pf = (volatile LAS unsigned*)(F.lds + LDS_BYTES - 512); const unsigned _t = (unsigned)__builtin_amdgcn_s_memrealtime(); _pf[(b)] += _t - _pf[32]; _pf[32] = _t; } } while (0)
__device__ __forceinline__ int crow(int r, int hi) { return (r & 3) + 8 * (r >> 2) + 4 * hi; }
#define SBAR() __builtin_amdgcn_sched_barrier(0)
constexpr float THR2 = 8.f * 1.4426950408889634f;
constexpr int KS_MLA = 208, KS_DF = 80;
constexpr int VS = 192, VB = 64 * VS;
constexpr int OFF_V = 32768;
template <int OFF> __device__ __forceinline__ s16x4 tr_read(int vb) {
    s16x4 r; asm volatile("ds_read_b64_tr_b16 %0, %1 offset:%2" : "=&v"(r) : "v"(vb), "i"(OFF) : "memory"); return r;
}
__device__ __forceinline__ int kpos(int key) { return (key & ~0xC) | ((key & 4) << 1) | ((key & 8) >> 1); }

template <int ND0, int KS>
__device__ __forceinline__ void qkt(f32x16& p0, f32x16& p1, const LAS unsigned char* Ks, const hf8* qr, int r32, int hi) {
    p0 = f32x16{}; p1 = f32x16{};
#pragma unroll
    for (int d0 = 0; d0 < ND0; ++d0) { const int cb = (d0 * 16 + hi * 8) * 2;
        const hf8 b0 = *(const LAS hf8*)(Ks + r32 * KS + cb), b1 = *(const LAS hf8*)(Ks + (32 + r32) * KS + cb);
        p0 = __builtin_amdgcn_mfma_f32_32x32x16_f16(b0, qr[d0], p0, 0, 0, 0); p1 = __builtin_amdgcn_mfma_f32_32x32x16_f16(b1, qr[d0], p1, 0, 0, 0); }
}
__device__ __forceinline__ float max3f(float a, float b, float c) { float r; asm("v_max3_f32 %0, %1, %2, %3" : "=v"(r) : "v"(a), "v"(b), "v"(c)); return r; }
__device__ __forceinline__ float max2f(float a, float b) { float r; asm("v_max_f32_e32 %0, %1, %2" : "=v"(r) : "v"(a), "v"(b)); return r; }
__device__ __forceinline__ float max16(const f32x16& p) { float r, t;
    asm("v_max3_f32 %0, %2, %3, %4\n\tv_max3_f32 %1, %10, %11, %12\n\tv_max3_f32 %0, %0, %5, %6\n\tv_max3_f32 %1, %1, %13, %14\n\tv_max3_f32 %0, %0, %7, %8\n\tv_max3_f32 %1, %1, %15, %16\n\tv_max3_f32 %0, %0, %9, %17\n\tv_max_f32_e32 %0, %0, %1"
        : "=&v"(r), "=&v"(t) : "v"(p[0]), "v"(p[1]), "v"(p[2]), "v"(p[3]), "v"(p[4]), "v"(p[5]), "v"(p[6]), "v"(p[7]), "v"(p[8]), "v"(p[9]), "v"(p[10]), "v"(p[11]), "v"(p[12]), "v"(p[13]), "v"(p[14]), "v"(p[15]));
    return r; }
__device__ __forceinline__ hf8 pack8(const f32x16& p, int b) { u32x4 w = {pkh(p[b], p[b + 1]), pkh(p[b + 2], p[b + 3]), pkh(p[b + 4], p[b + 5]), pkh(p[b + 6], p[b + 7])}; return __builtin_bit_cast(hf8, w); }
__device__ __forceinline__ void sm_max(const f32x16& p0, const f32x16& p1, float& m, float& l, f32x16& o0, f32x16& o1, const bool first) {
    float pmax = max2f(max16(p0), max16(p1));
    { auto rr = __builtin_amdgcn_permlane32_swap(__float_as_uint(pmax), __float_as_uint(pmax), false, false);
      pmax = max2f(__uint_as_float(rr[0]), __uint_as_float(rr[1])); }
    if (first || __any(pmax - m > THR2)) {
        const float mn = first ? pmax : max2f(m, pmax);
        if (!first) { const float alpha = __builtin_amdgcn_exp2f(m - mn); l *= alpha;
#pragma unroll
            for (int r = 0; r < 16; ++r) { o0[r] *= alpha; o1[r] *= alpha; } }
        m = mn;
    }
}
__device__ __forceinline__ void sm_exp(f32x16& p0, f32x16& p1, const float m, float& l, hf8& pf0, hf8& pf1, hf8& pf2, hf8& pf3) {
#pragma unroll
    for (int r = 0; r < 16; ++r) { p0[r] -= m; p1[r] -= m; }
#pragma unroll
    for (int r = 0; r < 16; ++r) { p0[r] = __builtin_amdgcn_exp2f(p0[r]); p1[r] = __builtin_amdgcn_exp2f(p1[r]); }
    float ps0 = p0[0] + p1[0], ps1 = p0[1] + p1[1], ps2 = p0[2] + p1[2], ps3 = p0[3] + p1[3];
#pragma unroll
    for (int r = 4; r < 16; r += 4) { ps0 += p0[r] + p1[r]; ps1 += p0[r + 1] + p1[r + 1]; ps2 += p0[r + 2] + p1[r + 2]; ps3 += p0[r + 3] + p1[r + 3]; }
    l += (ps0 + ps1) + (ps2 + ps3);
    pf0 = pack8(p0, 0); pf1 = pack8(p0, 8); pf2 = pack8(p1, 0); pf3 = pack8(p1, 8);
}
__device__ __forceinline__ void pv(const hf8 pf0, const hf8 pf1, const hf8 pf2, const hf8 pf3, f32x16& o0, f32x16& o1, const LAS unsigned char* Vt, int r32, int hi) {
    const int lg = (int)(threadIdx.x & 15), vq = lg >> 2, vp4 = lg & 3;
    const int vbase = (int)(unsigned)(uintptr_t)Vt + (4 * hi + vq) * VS + (16 * ((int)(threadIdx.x >> 4) & 1) + 4 * vp4) * 2;
#define PVRD(ks, L0, H0, L1, H1) s16x4 L0 = tr_read<(16 * (ks)) * VS>(vbase), H0 = tr_read<(16 * (ks) + 8) * VS>(vbase), L1 = tr_read<(16 * (ks)) * VS + 64>(vbase), H1 = tr_read<(16 * (ks) + 8) * VS + 64>(vbase)
#define PVMM(N, L0, H0, L1, H1, pf) do { asm volatile("s_waitcnt lgkmcnt(" #N ")" : "+v"(L0), "+v"(H0), "+v"(L1), "+v"(H1) :: "memory"); \
        const hf8 a0 = __builtin_bit_cast(hf8, (short __attribute__((ext_vector_type(8)))){L0[0], L0[1], L0[2], L0[3], H0[0], H0[1], H0[2], H0[3]}); \
        const hf8 a1 = __builtin_bit_cast(hf8, (short __attribute__((ext_vector_type(8)))){L1[0], L1[1], L1[2], L1[3], H1[0], H1[1], H1[2], H1[3]}); \
        o0 = __builtin_amdgcn_mfma_f32_32x32x16_f16(a0, pf, o0, 0, 0, 0); o1 = __builtin_amdgcn_mfma_f32_32x32x16_f16(a1, pf, o1, 0, 0, 0); } while (0)
    PVRD(0, a0l, a0h, a1l, a1h); PVRD(1, b0l, b0h, b1l, b1h);
    PVMM(4, a0l, a0h, a1l, a1h, pf0);
    PVRD(2, c0l, c0h, c1l, c1h);
    PVMM(4, b0l, b0h, b1l, b1h, pf1);
    PVRD(3, d0l, d0h, d1l, d1h);
    PVMM(4, c0l, c0h, c1l, c1h, pf2);
    PVMM(0, d0l, d0h, d1l, d1h, pf3);
#undef PVRD
#undef PVMM
#define PVK(ks, pf)
#undef PVK
}

template <bool MLA>
__device__ __forceinline__ void attn_pass(const Frame& F, const Params& p, int hq, int hv, int qrow0, int qpos0, int klat0, int nlat, int kctx0, f32x16& o0, f32x16& o1, float& inv) {
    constexpr int DK = MLA ? 96 : 32, ND0 = DK / 16, KS = MLA ? KS_MLA : KS_DF, KB = 64 * KS;
    constexpr float SCALE = MLA ? MLA_SCALE : DF_SCALE, C = SCALE * 1.4426950408889634f;
    const int tid = F.tid, wid = F.wave, lane = F.lane, r32 = lane & 31, hi = lane >> 5;
    const hf* QKV = (const hf*)(p.ws + A_QKV); const hf* KRb = (const hf*)(p.ws + A_KR);
    const hf* DQ = (const hf*)(p.ws + A_DQ); const hf* DKb = (const hf*)(p.ws + A_DK); const hf* DVb = (const hf*)(p.ws + A_DV);
    const float* rope = (const float*)(p.ws + WS_ROPE);
    LAS unsigned char* lds = F.lds;
    hf8 qr[ND0];
    {
        const int qrow = qrow0 + wid * 32 + r32;
        const hf* qp = MLA ? QKV + (size_t)qrow * NUP + hq * 96 + hi * 8 : DQ + (size_t)qrow * 256 + hq * 32 + hi * 8;
        hf8 raw[ND0];
#pragma unroll
        for (int d0 = 0; d0 < ND0; ++d0) raw[d0] = *(const hf8*)(qp + d0 * 16);
        f32x4 c0 = {1.f, 1.f, 1.f, 1.f}, c1 = c0, s0 = {0.f, 0.f, 0.f, 0.f}, s1 = s0;
        if (qpos0 >= 0) { const int t = qpos0 + wid * 32 + r32;
            c0 = *(const f32x4*)(rope + t * 32 + hi * 8); c1 = *(const f32x4*)(rope + t * 32 + hi * 8 + 4);
            s0 = *(const f32x4*)(rope + t * 32 + 16 + hi * 8); s1 = *(const f32x4*)(rope + t * 32 + 16 + hi * 8 + 4); }
#pragma unroll
        for (int d0 = 0; d0 < ND0 - 2; ++d0) {
#pragma unroll
            for (int j = 0; j < 8; ++j) qr[d0][j] = (hf)((float)raw[d0][j] * C); }
#pragma unroll
        for (int j = 0; j < 8; ++j) { const float cc = j < 4 ? c0[j & 3] : c1[j & 3], sn = j < 4 ? s0[j & 3] : s1[j & 3]; const float a = (float)raw[ND0 - 2][j], b = (float)raw[ND0 - 1][j];
            qr[ND0 - 2][j] = (hf)((a * cc - b * sn) * C); qr[ND0 - 1][j] = (hf)((b * cc + a * sn) * C); }
    }
    const int k1r = MLA ? (tid >> 3) : ((tid & 255) >> 2), k1c = MLA ? (tid & 7) * 8 : (tid & 3) * 8;
    const int k2r = (tid & 255) >> 2, k2c = (tid & 3) * 8;
    const int vr_ = tid >> 3, vc_ = (tid & 7) * 8;
    const bool klo = tid < 256;
    struct Stg { u32x4 v, k1, k2; };
    Stg sA, sB; sA.v = sA.k1 = sA.k2 = sB.v = sB.k1 = sB.k2 = (u32x4){0u, 0u, 0u, 0u};
    const int ntile = nlat + 4;
#define KROW0(j) (((j) < nlat) ? klat0 + (j) * 64 : kctx0 + ((j) - nlat) * 64)
#define A_LOADK(S, j) do { const int kr0 = KROW0(j); \
        if (MLA) { S.k1 = *(const u32x4*)(QKV + (size_t)(kr0 + k1r) * NUP + 768 + hq * 128 + k1c); S.k2 = *(const u32x4*)(KRb + (size_t)(kr0 + k2r) * 32 + k2c); } \
        else S.k1 = *(const u32x4*)(DKb + (size_t)(kr0 + k1r) * 256 + hq * 32 + k1c); } while (0)
#define A_LOADV(S, j) do { const int kr0 = KROW0(j); \
        if (MLA) S.v = *(const u32x4*)(QKV + (size_t)(kr0 + vr_) * NUP + 768 + hv * 128 + 64 + vc_); else S.v = *(const u32x4*)(DVb + (size_t)(kr0 + vr_) * 256 + hv * 64 + vc_); } while (0)
#define A_WRITEK(S, b) do { *(LAS u32x4*)(lds + (b) * KB + k1r * KS + k1c * 2) = S.k1; if (MLA) *(LAS u32x4*)(lds + (b) * KB + k2r * KS + 128 + k2c * 2) = S.k2; } while (0)
#define A_WRITEV(S, b) do { *(LAS u32x4*)(lds + OFF_V + (b) * VB + vr_ * VS + vc_ * 2) = S.v; } while (0)
    float m_reg = 0.f, l_reg = 0.f;
    o0 = f32x16{}; o1 = f32x16{};
    f32x16 pA0, pA1, pB0, pB1;
    __syncthreads();
    const int nt1 = ntile - 1;
#define TCL(j) (((j) < nt1) ? (j) : nt1)
    A_LOADK(sA, 0); A_LOADV(sA, 0); A_LOADK(sB, 1);
    A_WRITEK(sA, 0); A_WRITEV(sA, 0); A_WRITEK(sB, 1);
    A_LOADK(sA, TCL(2));
    A_LOADV(sA, 1);
    __syncthreads();
    qkt<ND0, KS>(pA0, pA1, lds, qr, r32, hi);
    hf8 f0, f1, f2, f3;
    if (wid >= 4) __syncthreads();
    for (int j = 0; j < ntile; j += 2) {
        A_LOADK(sB, TCL(j + 3)); A_LOADV(sB, TCL(j + 2));
        sm_max(pA0, pA1, m_reg, l_reg, o0, o1, j == 0);
        sm_exp(pA0, pA1, m_reg, l_reg, f0, f1, f2, f3);
        __syncthreads();
        qkt<ND0, KS>(pB0, pB1, lds + KB, qr, r32, hi);
        pv(f0, f1, f2, f3, o0, o1, lds + OFF_V, r32, hi);
        A_WRITEK(sA, 0); A_WRITEV(sA, 1);
        __syncthreads();
        A_LOADK(sA, TCL(j + 4)); A_LOADV(sA, TCL(j + 3));
        sm_max(pB0, pB1, m_reg, l_reg, o0, o1, false);
        sm_exp(pB0, pB1, m_reg, l_reg, f0, f1, f2, f3);
        __syncthreads();
        qkt<ND0, KS>(pA0, pA1, lds, qr, r32, hi);
        pv(f0, f1, f2, f3, o0, o1, lds + OFF_V + VB, r32, hi);
        A_WRITEK(sB, 1); A_WRITEV(sB, 0);
        __syncthreads();
    }
    if (wid < 4) __syncthreads();
#undef TCL
#undef KROW0
#undef A_LOADK
#undef A_LOADV
#undef A_WRITEK
#undef A_WRITEV
    const float lt = l_reg + __shfl_xor(l_reg, 32); inv = __builtin_amdgcn_rcpf(lt);
}
template <bool MLA>
__device__ __forceinline__ void attn_unit(const Frame& F, const Params& p, int l, int h, int qrow0, int qpos0, int klat0, int nlat, int kctx0) {
    const int wid = F.wave, lane = F.lane, r32 = lane & 31, hi = lane >> 5;
    hf* Y = (hf*)(p.ws + A_Y);
    const size_t yrow = (size_t)(qrow0 + wid * 32 + r32) * DM;
    if constexpr (MLA) {
        f32x16 o0, o1; float inv;
        attn_pass<true>(F, p, h, h, qrow0, qpos0, klat0, nlat, kctx0, o0, o1, inv);
#pragma unroll
        for (int g = 0; g < 4; ++g) { u32x2 w; w.x = pkh(o0[4 * g] * inv, o0[4 * g + 1] * inv); w.y = pkh(o0[4 * g + 2] * inv, o0[4 * g + 3] * inv); *(u32x2*)(Y + yrow + h * 64 + 8 * g + 4 * hi) = w; }
#pragma unroll
        for (int g = 0; g < 4; ++g) { u32x2 w; w.x = pkh(o1[4 * g] * inv, o1[4 * g + 1] * inv); w.y = pkh(o1[4 * g + 2] * inv, o1[4 * g + 3] * inv); *(u32x2*)(Y + yrow + h * 64 + 32 + 8 * g + 4 * hi) = w; }
    } else {
        const float lam = ((const float*)(p.ws + WS_LAM))[2 * l], oml = ((const float*)(p.ws + WS_LAM))[2 * l + 1];
        f32x16 a0, a1;
        LAS float* park = (LAS float*)(F.lds + 65536 + wid * 8192) + lane;
        { f32x16 o0, o1; float inv; attn_pass<false>(F, p, 2 * h, h, qrow0, qpos0, klat0, nlat, kctx0, o0, o1, inv);
#pragma unroll
          for (int r = 0; r < 16; ++r) { park[r * 64] = o0[r] * inv; park[(16 + r) * 64] = o1[r] * inv; } }
        { f32x16 o0, o1; float inv; attn_pass<false>(F, p, 2 * h + 1, h, qrow0, qpos0, klat0, nlat, kctx0, o0, o1, inv);
#pragma unroll
          for (int r = 0; r < 16; ++r) { a0[r] = park[r * 64] - o0[r] * (lam * inv); a1[r] = park[(16 + r) * 64] - o1[r] * (lam * inv); } }
        float ss = 0.f;
#pragma unroll
        for (int r = 0; r < 16; ++r) ss += a0[r] * a0[r] + a1[r] * a1[r];
        ss += __shfl_xor(ss, 32);
        const float rs = rsqrtf(ss * (1.f / 64.f) + EPS) * oml;
#pragma unroll
        for (int g = 0; g < 4; ++g) { const f32x4 gg = *(const f32x4*)(p.in[I_SUBG] + l * 64 + 8 * g + 4 * hi);
            u32x2 w; w.x = pkh(a0[4 * g] * rs * gg[0], a0[4 * g + 1] * rs * gg[1]); w.y = pkh(a0[4 * g + 2] * rs * gg[2], a0[4 * g + 3] * rs * gg[3]); *(u32x2*)(Y + yrow + 768 + h * 64 + 8 * g + 4 * hi) = w; }
#pragma unroll
        for (int g = 0; g < 4; ++g) { const f32x4 gg = *(const f32x4*)(p.in[I_SUBG] + l * 64 + 32 + 8 * g + 4 * hi);
            u32x2 w; w.x = pkh(a1[4 * g] * rs * gg[0], a1[4 * g + 1] * rs * gg[1]); w.y = pkh(a1[4 * g + 2] * rs * gg[2], a1[4 * g + 3] * rs * gg[3]); *(u32x2*)(Y + yrow + 768 + h * 64 + 32 + 8 * g + 4 * hi) = w; }
    }
}
}

#define HY_MARK(b) do { if (PROF_SEL >= 0 && F.tid == 0) { volatile LAS unsigned* _pf = (volatile LAS unsigned*)(F.lds + LDS_BYTES - 512); const unsigned _t = (unsigned)__builtin_amdgcn_s_memrealtime(); _pf[(b)] += _t - _pf[32]; _pf[32] = _t; } } while (0)
template <int L>
__device__ __forceinline__ void hyena_unit(const Frame& F, const hf* Rrow  , const hf* U  , const hf* X0  , hf* Ycol  ) {
    constexpr int NM = L / 256, RL = 2 * L, SH = (L > 1024) ? 1024 : L, NH = L / SH, US = SH * 2 + 16;
    constexpr int OFF_U = 8 * RL * 2;
    constexpr int XP = L * 2 + 16;
    static_assert(OFF_U + 32 * US <= LDS_MISC && 32 * XP <= LDS_MISC, "hyena LDS");
    const int tid = F.tid, w = F.wave, lane = F.lane, i32 = lane & 31, hi = lane >> 5;
    LAS unsigned char* lds = F.lds;
    __syncthreads();
    for (int i = tid; i < RL / 8; i += 512) *(LAS u32x4*)(lds + i * 16) = *(const u32x4*)(Rrow + i * 8);
    __syncthreads();
    {
        const LAS unsigned* src = (const LAS unsigned*)lds;
#pragma unroll 1
        for (int idx = tid; idx < 7 * (RL / 8); idx += 512) { const int cw = 1 + idx / (RL / 8), c4 = (idx % (RL / 8)) * 4;
            const int k0 = c4 - ((cw + 1) >> 1); unsigned d[5];
#pragma unroll
            for (int e = 0; e < 5; ++e) { const int k = k0 + e; d[e] = (k >= 0 && k < RL / 2) ? src[k] : 0u; }
            u32x4 o;
            if (cw & 1) { o.x = (d[0] >> 16) | (d[1] << 16); o.y = (d[1] >> 16) | (d[2] << 16); o.z = (d[2] >> 16) | (d[3] << 16); o.w = (d[3] >> 16) | (d[4] << 16); }
            else { o.x = d[0]; o.y = d[1]; o.z = d[2]; o.w = d[3]; }
            *(LAS u32x4*)(lds + cw * (RL * 2) + c4 * 4) = o; }
    }
    HY_MARK(22);
    f32x16 acc[NM];
#pragma unroll
    for (int m = 0; m < NM; ++m) acc[m] = f32x16{};
    const LAS unsigned char* cpy = lds + w * (RL * 2);
    for (int half = 0; half < NH; ++half) {
        __syncthreads();
        {
            constexpr int NPC = 32 * (SH / 8) / 512, NB4 = NPC > 4 ? 4 : NPC;
            int tq = tid; asm volatile("" : "+v"(tq));
#pragma unroll
            for (int k0 = 0; k0 < NPC; k0 += NB4) { u32x4 tmp[NB4];
#pragma unroll
                for (int k = 0; k < NB4; ++k) { const int idx = tq + 512 * (k0 + k), b = idx / (SH / 8), pc = idx % (SH / 8); tmp[k] = *(const u32x4*)(U + (size_t)b * L + half * SH + pc * 8); }
#pragma unroll
                for (int k = 0; k < NB4; ++k) { const int idx = tq + 512 * (k0 + k), b = idx / (SH / 8), pc = idx % (SH / 8); *(LAS u32x4*)(lds + OFF_U + b * US + pc * 16) = tmp[k]; }
                asm volatile("" ::: "memory"); }
        }
        __syncthreads();
#pragma unroll 2
        for (int jl = 0; jl < SH / 16; ++jl) {
            const int j = half * (SH / 16) + jl;
            const hf8 bf = *(const LAS hf8*)(lds + OFF_U + i32 * US + (jl * 16 + hi * 8) * 2);
            const int x0 = L + 16 * j + 8 * hi - 8 * i32;
#pragma unroll
            for (int m = 0; m < NM; ++m) { const hf8 af = *(const LAS hf8*)(cpy + (x0 - 256 * m) * 2);
                acc[m] = __builtin_amdgcn_mfma_f32_32x32x16_f16(af, bf, acc[m], 0, 0, 0); }
        }
    }
    __syncthreads();
    HY_MARK(23);
    {
        constexpr int NPC = 32 * (L / 8) / 512, NB8 = NPC > 4 ? 4 : NPC;
        int tq = tid; asm volatile("" : "+v"(tq));
#pragma unroll
        for (int k0 = 0; k0 < NPC; k0 += NB8) { u32x4 tmp[NB8];
#pragma unroll
            for (int k = 0; k < NB8; ++k) { const int idx = tq + 512 * (k0 + k), b = idx / (L / 8), pc = idx % (L / 8); tmp[k] = *(const u32x4*)(X0 + (size_t)b * L + pc * 8); }
#pragma unroll
            for (int k = 0; k < NB8; ++k) { const int idx = tq + 512 * (k0 + k), b = idx / (L / 8), pc = idx % (L / 8); *(LAS u32x4*)(lds + b * XP + pc * 16) = tmp[k]; }
            asm volatile("" ::: "memory"); }
    }
    __syncthreads();
    HY_MARK(24);
    const LAS hf* x0p = (const LAS hf*)(lds + i32 * XP) + w + 32 * hi;
    hf* yp = Ycol + ((size_t)i32 * L + w + 32 * hi) * DM;
#pragma unroll
    for (int m = 0; m < NM; ++m) {
#pragma unroll
        for (int r = 0; r < 16; ++r) { const int tt = 256 * m + 8 * ((r & 3) + 8 * (r >> 2));
            const float x0v = (float)x0p[tt];
            yp[(size_t)tt * DM] = (hf)(x0v * acc[m][r]); }
        asm volatile("" ::: "memory");
    }
    HY_MARK(25);
}


#ifndef PH_MASK
#define PH_MASK 0x1FFFF
#endif
#define PHM(k) ((PH_MASK >> (k)) & 1)
#ifndef PROBE_REP
#define PROBE_REP 0
#endif
#define NREP(k) (((PROBE_REP >> (k)) & 1) ? 2 : 1)
constexpr int NPH_LAYER = 7, PH_L0 = 2, NPHASE = PH_L0 + DEPTH * NPH_LAYER + 1;
__global__ void __launch_bounds__(512, 2) fwd_kernel(Params p) {
    extern __shared__ __attribute__((aligned(16))) unsigned char lds_raw[];
    Frame F0; Frame& F = F0;
    F.lds = (LAS unsigned char*)lds_raw;
    F.tid = threadIdx.x; F.lane = F.tid & 63; F.wave = __builtin_amdgcn_readfirstlane(F.tid >> 6);
    F.G = gridDim.x; { const int bx = blockIdx.x; F.vcu = (F.G % 8 == 0) ? (bx % 8) * (F.G / 8) + bx / 8 : bx; }
    volatile LAS unsigned* misc = (volatile LAS unsigned*)(F.lds + LDS_MISC);
    if (F.tid < 16) misc[F.tid] = 0u;
    __syncthreads();
    const int lo = p.ph_lo, hi = p.ph_hi;
    XcdBarrier bar; bar.bar = (unsigned*)(p.ws + WS_BAR); bar.x = 0; bar.st = misc;
    if (hi - lo > 1) bar = xcd_barrier_post((unsigned*)(p.ws + WS_BAR), misc);
#define IN(k) (lo <= (k) && (k) < hi)
#define LAUNDER(Fl) Frame Fl = F0; asm volatile("" : "+v"(Fl.tid), "+v"(Fl.lane))
#ifndef PROF_SEL
#define PROF_SEL -1
#endif
#define PROF_K 8
    volatile LAS unsigned* prof = (volatile LAS unsigned*)(F.lds + LDS_BYTES - 512);
    if (PROF_SEL >= 0 && F.tid < 40) prof[F.tid] = 0u;
    if (PROF_SEL >= 0) __syncthreads();
    if (PROF_SEL >= 0 && F.tid == 0) prof[32] = (unsigned)__builtin_amdgcn_s_memrealtime();
#define PROF_MARK(b) do { if (PROF_SEL >= 0 && F.tid == 0) { const unsigned _t = (unsigned)__builtin_amdgcn_s_memrealtime(); prof[(b)] += _t - prof[32]; if ((b) >= 16) prof[30] += _t - prof[32]; prof[32] = _t; } } while (0)
#define SEAMT(k, b) do { PROF_MARK(b); if (IN(k) && IN((k) + 1)) xcd_barrier(bar); PROF_MARK(16 + (b)); } while (0)
#define SEAM(k) do { if (IN(k) && IN((k) + 1)) xcd_barrier(bar); } while (0)
    unsigned char* ws = p.ws;
    hf* X16 = (hf*)(ws + WS_X16);
    hf* XS1 = (hf*)p.out; hf* MM = (hf*)p.out; hf* Y = (hf*)(ws + A_B); hf* XS2 = (hf*)(ws + A_B);
    hf* QKV = (hf*)(ws + A_QKV); hf* QKVN = (hf*)(ws + A_QKVN);
    unsigned char* Gt = (unsigned char*)(ws + A_G); hf* HID = (hf*)(ws + A_HID);
    float* SS = (float*)(ws + WS_SS);

    if (PHM(11) && IN(0)) for (int rep = 0; rep < NREP(11); ++rep) { LAUNDER(Fl); prologue_a(Fl, p); }
    SEAMT(0, 9);
    if (PHM(11) && IN(1)) for (int rep = 0; rep < NREP(12); ++rep) { LAUNDER(Fl); prologue_b(Fl, p); }
    SEAMT(1, 9);

    for (int l = 0; l < DEPTH; ++l) {
        const int pb = PH_L0 + l * NPH_LAYER;
        const bool ctx_live = l < DEPTH - 1;
        const int Mrows = ctx_live ? MTOT : NLAT;
        const float* modl = (const float*)(ws + WS_MOD) + (size_t)l * NMODV * MODW;
        const float* biasl = (const float*)(ws + WS_BIAS) + (size_t)l * NMODV * NBIAS;
        const float* gsl = (const float*)(ws + WS_GS) + (size_t)l * 2 * NMODV * DM;
        const unsigned char* wl = ws + WS_WT + (size_t)(l & 1) * W_LAYER;
        float* ss1 = SS + (size_t)(SS_1 + l) * MTOT; float* ss2 = SS + (size_t)(SS_2 + l) * MTOT;

        if (PHM(1) && IN(pb + 0)) { pg8::Gemm g{XS1, (const hf*)(wl + W_IN1), MTOT, NP1, DM, DM, DM}; pg8::StaticOrder S; S.init(MTOT, NP1, F.G, (int)blockIdx.x);
            pg8::EpiIn E{QKVN, (hf*)(ws + A_KR), (hf*)(ws + A_PHY), (hf*)(ws + A_DQ), (hf*)(ws + A_DK), (hf*)(ws + A_DV), ss1, biasl + B_IN, SS + (size_t)(SS_Q + l) * MTOT, SS + (size_t)(SS_KV + l) * MTOT};
            pg8::gemm_phase(F.lds, g, S, E); }
        SEAMT(pb + 0, 0);
        if (PHM(2) && IN(pb + 1)) {
            { LAUNDER(Fl); prep_rope(Fl, p); prep_hyena(Fl, p, l, ctx_live); }
            __syncthreads();
            PROF_MARK(1);
            { pg8::Gemm g{QKVN, (const hf*)(wl + W_UP), MTOT, NUP, KUP, KUP, KUP}; pg8::StaticOrder S; S.init(MTOT, NUP, F.G, (int)blockIdx.x);
              pg8::EpiUp E{QKV, SS + (size_t)(SS_Q + l) * MTOT, SS + (size_t)(SS_KV + l) * MTOT}; pg8::gemm_phase(F.lds, g, S, E); }
        }
        SEAMT(pb + 1, 2);
        if (PHM(4) && IN(pb + 2)) {
            {
            LAUNDER(Fl);
            PROF_MARK(14);
            const int n_mla = 2048 + (ctx_live ? 256 : 0);
            for (int id = F.vcu; id < n_mla; id += F.G) {
                if (id < 2048) { const int qb = id & 7, h = (id >> 3) & 7, b = id >> 6; att::attn_unit<true>(Fl, p, l, h, b * SEQ + qb * 256, qb * 256, b * SEQ, 32, NLAT + b * CTXL); }
                else { const int i2 = id - 2048, h = i2 & 7, b = i2 >> 3; att::attn_unit<true>(Fl, p, l, h, NLAT + b * CTXL, -1, 0, 0, NLAT + b * CTXL); }
            }
            PROF_MARK(11);
            const int n_df = 1024 + (ctx_live ? 128 : 0);
            for (int id = F.vcu; id < n_df; id += F.G) {
                if (id < 1024) { const int qb = id & 7, h = (id >> 3) & 3, b = id >> 5; att::attn_unit<false>(Fl, p, l, h, b * SEQ + qb * 256, qb * 256, b * SEQ, 32, NLAT + b * CTXL); }
                else { const int i2 = id - 1024, h = i2 & 3, b = i2 >> 2; att::attn_unit<false>(Fl, p, l, h, NLAT + b * CTXL, -1, 0, 0, NLAT + b * CTXL); }
            }
            PROF_MARK(12);
            const unsigned char* ob = (const unsigned char*)p.out;
            for (int c = F.vcu; c < 256; c += F.G)
                hyena_unit<SEQ>(Fl, (const hf*)(ws + WS_RF) + ((size_t)l * 256 + c) * 4096, (const hf*)(ob + O_UT) + (size_t)c * NLAT, (const hf*)(ob + O_X0T) + (size_t)c * NLAT, Y + 512 + c);
            if (ctx_live) for (int c = F.vcu; c < 256; c += F.G)
                hyena_unit<CTXL>(Fl, (const hf*)(ws + WS_RFC) + ((size_t)l * 256 + c) * 512, (const hf*)(ob + O_UTC) + (size_t)c * NCTX, (const hf*)(ob + O_X0TC) + (size_t)c * NCTX, Y + (size_t)NLAT * DM + 512 + c);
            __syncthreads();
            PROF_MARK(13);
            }
            { pg8::Gemm g{XS1, (const hf*)(wl + W_ING), Mrows, NGATE, DM, DM, DM}; pg8::StaticOrder S; S.init(Mrows, NGATE, F.G, (int)blockIdx.x);
              pg8::EpiGate8 E{Gt, ss1, biasl + B_G}; pg8::gemm_phase(F.lds, g, S, E); }
        }
        SEAMT(pb + 2, 4);
        if (PHM(6) && IN(pb + 3)) { pg8::Gemm g{Y, (const hf*)(wl + W_BR), Mrows, DM, DM, DM, DM}; pg8::StaticOrder S; S.init(Mrows, DM, F.G, (int)blockIdx.x);
            pg8::EpiMerge E{MM, Gt}; pg8::gemm_phase(F.lds, g, S, E); }
        SEAMT(pb + 3, 5);
        if (PHM(7) && IN(pb + 4)) { pg8::Gemm g{MM, (const hf*)(wl + W_OUT), Mrows, DM, DM, DM, DM}; pg8::StaticOrder S; S.init(Mrows, DM, F.G, (int)blockIdx.x);
            pg8::EpiResidX<true, true> E{X16, modl + 2 * DM, XS2, gsl + (size_t)NMODV * DM, ss2}; pg8::gemm_phase(F.lds, g, S, E); }
        SEAMT(pb + 4, 6);
        if (PHM(9) && IN(pb + 5)) { pg8::Gemm g{XS2, (const hf*)(wl + W_FC1), Mrows, DFF, DM, DM, DM}; pg8::StaticOrder S; S.init(Mrows, DFF, F.G, (int)blockIdx.x);
            pg8::EpiHalf<2, true> E{HID, DFF, ss2, biasl + B_FC1}; pg8::gemm_phase(F.lds, g, S, E); }
        SEAMT(pb + 5, 7);
        if (PHM(10) && IN(pb + 6)) { pg8::Gemm g{HID, (const hf*)(wl + W_FC2), Mrows, DM, DFF, DFF, DFF}; pg8::StaticOrder S; S.init(Mrows, DM, F.G, (int)blockIdx.x);
            if (ctx_live) { pg8::EpiResidX<true, true> E{X16, modl + 5 * DM, XS1, gsl + (size_t)2 * NMODV * DM, ss1 + MTOT}; pg8::gemm_phase(F.lds, g, S, E);
                const int nheavy = (MTOT / 256 * 4) % F.G;
                if (nheavy > 0 && (int)blockIdx.x >= nheavy) { __syncthreads(); LAUNDER(Fl); convert_layer(Fl, p, l + 1, ws + WS_WT + (size_t)((l + 1) & 1) * W_LAYER, (int)blockIdx.x - nheavy, F.G - nheavy); }
                else if (nheavy == 0) { __syncthreads(); LAUNDER(Fl); convert_layer(Fl, p, l + 1, ws + WS_WT + (size_t)((l + 1) & 1) * W_LAYER, Fl.vcu, F.G); } }
            else { pg8::EpiResidX<false, true> E{X16, modl + 5 * DM, nullptr, nullptr, SS + (size_t)SS_F * MTOT}; pg8::gemm_phase(F.lds, g, S, E); } }
        SEAMT(pb + 6, 8);
    }
    if (PHM(12) && IN(NPHASE - 1)) { LAUNDER(Fl); final_norm_phase(Fl, X16, p.out, p.in[I_FNG], SS + (size_t)SS_F * MTOT); }
    PROF_MARK(10);
    if (PROF_SEL >= 0 && blockIdx.x == 0 && F.tid == 0) { const unsigned long long t0 = __builtin_amdgcn_s_memrealtime(); const unsigned long long d = (unsigned long long)PROF_K * prof[PROF_SEL];
        while (__builtin_amdgcn_s_memrealtime() - t0 < d) __builtin_amdgcn_s_sleep(8); }
#undef IN
#undef SEAM
}

extern "C" void kernel_launch(void* const* d_in, const int* in_sizes, int n_in, void* d_out, int out_size, void* d_ws, size_t ws_size, hipStream_t stream) {
    static int grid = 0;
    if (grid == 0) {
        if (n_in != 35 || in_sizes[0] != NLAT * DM || out_size != NLAT * DM || ws_size < WS_END) {
            fprintf(stderr, "kernel_launch: unexpected shapes: n_in %d in0 %d out %d ws %zu (need %zu); nothing launched\n", n_in, n_in > 0 ? in_sizes[0] : -1, out_size, ws_size, (size_t)WS_END); grid = -1; return; }
        int dev = 0, cus = 0, per_cu = 0;
        if (hipGetDevice(&dev) != hipSuccess || hipDeviceGetAttribute(&cus, hipDeviceAttributeMultiprocessorCount, dev) != hipSuccess) { fprintf(stderr, "kernel_launch: device query failed\n"); grid = -1; return; }
        if (hipFuncSetAttribute((const void*)fwd_kernel, hipFuncAttributeMaxDynamicSharedMemorySize, LDS_BYTES) != hipSuccess) { fprintf(stderr, "kernel_launch: hipFuncSetAttribute failed\n"); grid = -1; return; }
        if (hipOccupancyMaxActiveBlocksPerMultiprocessor(&per_cu, (const void*)fwd_kernel, 512, LDS_BYTES) != hipSuccess || per_cu < 1)
            fprintf(stderr, "kernel_launch: note: occupancy query reports %d workgroups per CU\n", per_cu);
        (void)hipGetLastError();
        grid = cus;
    }
    if (grid < 0) return;
    if (hipMemsetAsync((char*)d_ws + WS_BAR, 0, WS_ZERO_BYTES, stream) != hipSuccess) { fprintf(stderr, "kernel_launch: memset failed\n"); return; }
    Params P{};
    for (int i = 0; i < 35; ++i) P.in[i] = (const float*)d_in[i];
    P.out = (float*)d_out; P.ws = (unsigned char*)d_ws;
#if MK_FUSED
    P.ph_lo = 0; P.ph_hi = NPHASE;
    hipLaunchKernelGGL(fwd_kernel, dim3(grid), dim3(512), LDS_BYTES, stream, P);
#else
    for (int ph = 0; ph < NPHASE; ++ph) { P.ph_lo = ph; P.ph_hi = ph + 1; hipLaunchKernelGGL(fwd_kernel, dim3(grid), dim3(512), LDS_BYTES, stream, P); }
#endif
    const hipError_t le = hipPeekAtLastError();
    if (le != hipSuccess) fprintf(stderr, "kernel_launch: launch failed: %s\n", hipGetErrorName(le));
}
```

```cpp
#include <hip/hip_runtime.h>
#include <cstdio>
#include <cstdint>

#ifndef MK_FUSED
#define MK_FUSED 1
#endif

#define LAS __attribute__((address_space(3)))
#define GAS __attribute__((address_space(1)))
typedef _Float16 hf;
typedef _Float16 hf2 __attribute__((ext_vector_type(2)));
typedef _Float16 hf4 __attribute__((ext_vector_type(4)));
typedef _Float16 hf8 __attribute__((ext_vector_type(8)));
typedef short s16x4 __attribute__((ext_vector_type(4)));
typedef float f32x2 __attribute__((ext_vector_type(2)));
typedef float f32x4 __attribute__((ext_vector_type(4)));
typedef float f32x16 __attribute__((ext_vector_type(16)));
typedef unsigned u32x2 __attribute__((ext_vector_type(2)));
typedef unsigned u32x4 __attribute__((ext_vector_type(4)));

constexpr int DM = 1024, NB = 32, SEQ = 2048, DEPTH = 4, CTXL = 256, GRIDW = 64;
constexpr int NLAT = NB * SEQ;
constexpr int NCTX = NB * CTXL;
constexpr int MTOT = NLAT + NCTX;
constexpr int D_IN = 5024, NP1 = 2048  , NGATE = 3072, DFF = 4096;
constexpr int C_PQ = 0, C_PKV = 256, C_PKR = 384, C_HY = 416, C_DQ = 1184, C_DK = 1440, C_DV = 1696, C_PG = 1952;
constexpr int NUP = 1792, KUP = 384;
constexpr int NMODV = 33, MODW = 6 * DM;
constexpr float EPS = 1e-6f;
constexpr float MLA_SCALE = 0.10206207261596575f;
constexpr float DF_SCALE = 0.17677669529663687f;

constexpr size_t al256(size_t x) { return (x + 255) / 256 * 256; }
constexpr size_t WS_BAR = 0, WS_BAR_BYTES = 65536;
constexpr size_t WS_SS = WS_BAR + WS_BAR_BYTES;
constexpr int SS_1 = 0, SS_2 = DEPTH, SS_F = 2 * DEPTH, SSP_N = 2 * DEPTH + 1;
constexpr size_t WS_SSQ = WS_SS + (size_t)SSP_N * MTOT * 4 * 4;
constexpr size_t WS_SSKV = WS_SSQ + (size_t)DEPTH * MTOT * 4;
constexpr size_t WS_ZERO_BYTES = WS_BAR_BYTES;
constexpr size_t WS_MOD = al256(WS_SSKV + (size_t)DEPTH * MTOT * 4);
constexpr size_t WS_GS = WS_MOD + al256((size_t)DEPTH * NMODV * MODW * 4);
constexpr int NBIAS = 9216, B_IN = 0, B_G = 2048, B_FC1 = 5120;
constexpr size_t WS_BIAS = WS_GS + (size_t)DEPTH * 2 * NMODV * DM * 4;
constexpr size_t WS_ROPE = WS_BIAS + (size_t)DEPTH * NMODV * NBIAS * 4;
constexpr size_t WS_LAM = WS_ROPE + (size_t)SEQ * 32 * 4;
constexpr size_t WS_RF = WS_LAM + 256;
constexpr size_t WS_RFC = WS_RF + (size_t)DEPTH * 256 * 4096 * 2;
constexpr size_t WS_X16 = WS_RFC + (size_t)DEPTH * 256 * 512 * 2;
constexpr size_t WS_WT = WS_X16 + (size_t)MTOT * DM * 2;
constexpr size_t W_IN1 = 0, W_ING = W_IN1 + (size_t)NP1 * DM * 2, W_UP = W_ING + (size_t)NGATE * DM * 2, W_BR = W_UP + (size_t)NUP * KUP * 2,
                 W_OUT = W_BR + (size_t)DM * DM * 2, W_FC1 = W_OUT + (size_t)DM * DM * 2, W_FC2 = W_FC1 + (size_t)DFF * DM * 2, W_LAYER = W_FC2 + (size_t)DM * DFF * 2;
constexpr size_t WS_ARENA = WS_WT + 2 * W_LAYER;
constexpr size_t SZ_ROW1024 = (size_t)MTOT * 1024 * 2;
constexpr size_t A_B = WS_ARENA;
constexpr size_t A_C = A_B + SZ_ROW1024;
constexpr size_t A_Y = A_B, A_XS2 = A_B, A_BIG = A_C;
constexpr size_t A_QKVN = A_BIG;
constexpr size_t A_PHY = A_QKVN + (size_t)MTOT * KUP * 2;
constexpr size_t A_KR = A_BIG + (size_t)MTOT * NGATE;
constexpr size_t A_DQ = A_KR + (size_t)MTOT * 32 * 2;
constexpr size_t A_DK = A_DQ + (size_t)MTOT * 256 * 2;
constexpr size_t A_DV = A_DK + (size_t)MTOT * 256 * 2;
constexpr size_t A_QKV = A_DV + (size_t)MTOT * 256 * 2;
constexpr size_t A_BIG_END = A_QKV + (size_t)MTOT * NUP * 2;
static_assert(A_PHY + (size_t)MTOT * 768 * 2 <= A_KR, "QKVN + PHY must fit under the gate bytes");
constexpr size_t O_UT = SZ_ROW1024, O_X0T = O_UT + (size_t)256 * NLAT * 2, O_UTC = O_X0T + (size_t)256 * NLAT * 2, O_X0TC = O_UTC + (size_t)256 * NCTX * 2, O_END = O_X0TC + (size_t)256 * NCTX * 2;
static_assert(O_END <= (size_t)NLAT * DM * 4, "d_out scratch overflow");
constexpr size_t A_G = A_BIG;
constexpr size_t A_HID = A_C;
constexpr size_t WS_END = (A_BIG_END > A_HID + (size_t)MTOT * DFF * 2) ? A_BIG_END : A_HID + (size_t)MTOT * DFF * 2;
static_assert(WS_END <= (size_t)1024 * 1024 * 1024, "workspace map exceeds 1 GiB");

constexpr int LDS_BYTES = 147456;
constexpr int LDS_MISC = LDS_BYTES - 64;
constexpr int LDS_EXCH = 131072;

__device__ __forceinline__ unsigned pkh(float lo, float hi) { f32x2 v = {lo, hi}; hf2 h = __builtin_convertvector(v, hf2); return __builtin_bit_cast(unsigned, h); }
__device__ __forceinline__ unsigned pkhb(float lo, float hi) { unsigned b; asm("v_cvt_pk_bf16_f32 %0, %1, %2" : "=v"(b) : "v"(lo), "v"(hi)); return pkh(__uint_as_float(b << 16), __uint_as_float(b & 0xffff0000u)); }
__device__ __forceinline__ float wave_sum(float v) {
#pragma unroll
    for (int o = 1; o < 64; o <<= 1) v += __shfl_xor(v, o);
    return v;
}
__device__ __forceinline__ float rstd4(const float* ssp, int r) { const f32x4 q = *(const f32x4*)(ssp + 4 * (size_t)r); return rsqrtf(((q[0] + q[1]) + (q[2] + q[3])) * (1.f / DM) + EPS); }
#define LDS_WAIT() asm volatile("s_waitcnt lgkmcnt(0)" ::: "memory")
#define VM_WAIT() asm volatile("s_waitcnt vmcnt(0)" ::: "memory")

#define XB_TMO      128
#define XB_XCNT(j)  (256  + 64 * (j))
#define XB_XSUB(j)  (1280 + 64 * (j))
#define XB_XGEN(j)  (2304 + 64 * (j))
#define XB_TOP      3328
#define XB_TOPGEN   3392
#define XCD_BAR_WORDS 3456
#define XB_SPIN_CAP (1u << 22)
__device__ __forceinline__ unsigned xb_ld(unsigned* p)              { return __hip_atomic_load(p, __ATOMIC_RELAXED, __HIP_MEMORY_SCOPE_AGENT); }
__device__ __forceinline__ unsigned xb_add(unsigned* p, unsigned v) { return __hip_atomic_fetch_add(p, v, __ATOMIC_RELAXED, __HIP_MEMORY_SCOPE_AGENT); }
__device__ __forceinline__ unsigned xb_xcc_id() { return (unsigned)__builtin_amdgcn_s_getreg((3 << 11) | 20) & 0xFu; }
#define XB_SPIN(cond, bar) do { unsigned _sp = 0; while (cond) { __builtin_amdgcn_s_sleep(1); \
    if ((++_sp & 255u) == 0u) { if (xb_ld(&(bar)[XB_TMO])) break; if (_sp > XB_SPIN_CAP) { atomicAdd(&(bar)[XB_TMO], 1u); break; } } } } while (0)
struct XcdBarrier { unsigned* bar; unsigned x; volatile LAS unsigned* st; };
__device__ __forceinline__ XcdBarrier xcd_barrier_post(unsigned* bar, volatile LAS unsigned* st) {
    XcdBarrier b; b.bar = bar; b.x = xb_xcc_id(); b.st = st;
    if (threadIdx.x == 0) (void)xb_add(&bar[XB_XCNT(b.x)], 1u);
    return b;
}
__device__ __forceinline__ void xcd_barrier_complete(unsigned* bar, unsigned x, unsigned& nloc, unsigned& nx) {
    const unsigned G = gridDim.x * gridDim.y * gridDim.z;
    unsigned sum, cnt, mine, sp = 0u;
    for (;;) {
        sum = 0u; cnt = 0u; mine = 0u;
#pragma unroll
        for (unsigned j = 0; j < 16; ++j) { const unsigned c = xb_ld(&bar[XB_XCNT(j)]); sum += c; cnt += (c > 0u) ? 1u : 0u; mine = (j == x) ? c : mine; }
        if (sum == G) break;
        __builtin_amdgcn_s_sleep(1);
        if ((++sp & 255u) == 0u) { if (xb_ld(&bar[XB_TMO])) break; if (sp > XB_SPIN_CAP) { atomicAdd(&bar[XB_TMO], 1u); break; } }
    }
    nloc = mine > 0u ? mine : 1u; nx = cnt > 0u ? cnt : 1u;
}
__device__ __forceinline__ void xcd_barrier(const XcdBarrier& b) {
    asm volatile("s_waitcnt vmcnt(0)" ::: "memory");
    __syncthreads();
    if (threadIdx.x == 0) {
        unsigned* bar = b.bar;
        __builtin_amdgcn_s_waitcnt(0);
        unsigned nloc = b.st[0], nx = b.st[1];
        if (nloc == 0u) { xcd_barrier_complete(bar, b.x, nloc, nx); b.st[0] = nloc; b.st[1] = nx; }
        const unsigned old = xb_add(&bar[XB_XSUB(b.x)], 1u);
        const unsigned gen = old / nloc;
        if (old + 1u == (gen + 1u) * nloc) {
            __builtin_amdgcn_fence(__ATOMIC_RELEASE, "agent");
            asm volatile("s_waitcnt vmcnt(0)" ::: "memory");
            const unsigned og = xb_add(&bar[XB_TOP], 1u);
            const unsigned tg = og / nx;
            if (og + 1u == (tg + 1u) * nx) xb_add(&bar[XB_TOPGEN], 1u);
            else XB_SPIN(xb_ld(&bar[XB_TOPGEN]) == tg, bar);
            __builtin_amdgcn_fence(__ATOMIC_ACQUIRE, "agent");
            xb_add(&bar[XB_XGEN(b.x)], 1u);
            asm volatile("s_waitcnt vmcnt(0)" ::: "memory");
        } else {
            XB_SPIN(xb_ld(&bar[XB_XGEN(b.x)]) == gen, bar);
            __builtin_amdgcn_fence(__ATOMIC_ACQUIRE, "agent");
            asm volatile("s_waitcnt vmcnt(0)" ::: "memory");
        }
    }
    __syncthreads();
}

namespace pg8 {
constexpr int BM = 256, BK = 64, HALF = 128, HTB = HALF * BK * 2, STAGE_BYTES = 8 * HTB, NXCD = 8, WGM = 8;
__host__ __device__ __forceinline__ int lds_byte(int r, int c) { const int st = (r >> 4) * 2 + (c >> 5), rr = r & 15, cc = c & 31, ob = rr * 64 + cc * 2; return st * 1024 + (ob ^ (((ob >> 9) & 1) << 5)); }
__host__ __device__ __forceinline__ void stage_rc(int b, int& R, int& C) { const int st = b / 1024, sb = b % 1024, swz = sb ^ (((sb >> 9) & 1) << 5); R = (st >> 1) * 16 + swz / 64; C = (st & 1) * 32 + (swz % 64) / 2; }
__host__ __device__ __forceinline__ int perm32(int rho) { const int n = rho >> 4, i = rho & 15; return 8 * (i >> 2) + 4 * n + (i & 3); }
struct Unit { int pm, pn; };
struct Gemm { const hf* A; const hf* Bt; int M, N, K, lda, ldb; };
struct StaticOrder {
    int nM, nN, nwg, G, c;
    __host__ __device__ void init(int M, int N, int G_, int c_) { nM = M / BM; nN = N / BM; nwg = nM * nN; G = G_; c = c_; }
    __host__ __device__ bool next(int i, Unit& u) const {
        const long L = (long)i * G + c; if (L >= nwg) return false;
        int wgid = (int)L; { const int q = nwg / NXCD, r = nwg % NXCD, xcd = wgid % NXCD, off = wgid / NXCD; wgid = (xcd < r ? xcd * (q + 1) : r * (q + 1) + (xcd - r) * q) + off; }
        const int nig = WGM * nN, gid = wgid / nig, fm = gid * WGM, gsz = (nM - fm) < WGM ? (nM - fm) : WGM;
        u.pm = fm + ((wgid % nig) % gsz); u.pn = (wgid % nig) / gsz; return true;
    }
    __device__ __forceinline__ void a_ready(const Unit&) const {}
    __device__ __forceinline__ void done(const Unit&) const {}
};

template <int ACT  , bool NORM> struct EpiHalf {
    static constexpr bool PERM = true, AFTER_DRAIN = false, PROBE2 = false, MIDK = false;
    hf* O; int ldc; const float* ss; const float* bias;
    __device__ __forceinline__ void operator()(const f32x4 (&acc)[2][2][4][2], const Unit& u, int wr, int wc, int fr, int fq) const {
        const int row0 = u.pm * BM + wr * 64 + fr, col0 = u.pn * BM + wc * 32 + 8 * fq;
        f32x4 bv[2][2];
        if (NORM) { const int R0 = u.pm * BM; const int v = (R0 < NLAT) ? (R0 >> 11) : NB; const float* bp = bias + (size_t)v * NBIAS + col0;
#pragma unroll
            for (int bj = 0; bj < 2; ++bj)
#pragma unroll
                for (int n = 0; n < 2; ++n) bv[bj][n] = *(const f32x4*)(bp + bj * HALF + 4 * n); }
#pragma unroll
        for (int ai = 0; ai < 2; ++ai)
#pragma unroll
            for (int m = 0; m < 4; ++m) { const int r = row0 + ai * HALF + m * 16; hf* rowp = O + (size_t)r * ldc + col0;
                float rs = 1.f; if (NORM) rs = rstd4(ss, r);
#pragma unroll
                for (int bj = 0; bj < 2; ++bj) { f32x4 v0 = acc[ai][bj][m][0], v1 = acc[ai][bj][m][1];
                    if (NORM) { v0 = v0 * rs + bv[bj][0]; v1 = v1 * rs + bv[bj][1]; }
                    if (ACT == 1) {
#pragma unroll
                        for (int e = 0; e < 4; ++e) { v0[e] = __builtin_amdgcn_rcpf(1.f + __builtin_amdgcn_exp2f(-1.4426950408889634f * v0[e])); v1[e] = __builtin_amdgcn_rcpf(1.f + __builtin_amdgcn_exp2f(-1.4426950408889634f * v1[e])); } }
                    if (ACT == 2) {
#pragma unroll
                        for (int e = 0; e < 4; ++e) { const float a = fmaxf(v0[e], 0.f), b = fmaxf(v1[e], 0.f); v0[e] = a * a; v1[e] = b * b; } }
                    u32x4 w; w.x = pkhb(v0[0], v0[1]); w.y = pkhb(v0[2], v0[3]); w.z = pkhb(v1[0], v1[1]); w.w = pkhb(v1[2], v1[3]);
                    *(u32x4*)(rowp + bj * HALF) = w; } }
    }
};
struct EpiGate8 {
    static constexpr bool PERM = true, AFTER_DRAIN = false, PROBE2 = false, MIDK = false;
    unsigned char* O; const float* ss; const float* bias;
    __device__ __forceinline__ void operator()(const f32x4 (&acc)[2][2][4][2], const Unit& u, int wr, int wc, int fr, int fq) const {
        const int R0 = u.pm * BM, row0 = R0 + wr * 64 + fr, col0 = u.pn * BM + wc * 32 + 8 * fq;
        const int v = (R0 < NLAT) ? (R0 >> 11) : NB; const float* bp = bias + (size_t)v * NBIAS + col0;
        f32x4 bv[2][2];
#pragma unroll
        for (int bj = 0; bj < 2; ++bj) { bv[bj][0] = *(const f32x4*)(bp + bj * HALF); bv[bj][1] = *(const f32x4*)(bp + bj * HALF + 4); }
#pragma unroll
        for (int ai = 0; ai < 2; ++ai)
#pragma unroll
            for (int m = 0; m < 4; ++m) { const int r = row0 + ai * HALF + m * 16; const float rs = rstd4(ss, r);
#pragma unroll
                for (int bj = 0; bj < 2; ++bj) { const f32x4 v0 = acc[ai][bj][m][0] * rs + bv[bj][0], v1 = acc[ai][bj][m][1] * rs + bv[bj][1];
                    unsigned q[8];
#pragma unroll
                    for (int e = 0; e < 4; ++e) { const float g0 = __builtin_amdgcn_rcpf(1.f + __builtin_amdgcn_exp2f(-1.4426950408889634f * v0[e])), g1 = __builtin_amdgcn_rcpf(1.f + __builtin_amdgcn_exp2f(-1.4426950408889634f * v1[e]));
                        q[e] = (unsigned)fmaxf(1.f, __builtin_rintf(255.f * g0)); q[4 + e] = (unsigned)fmaxf(1.f, __builtin_rintf(255.f * g1)); }
                    u32x2 w; w.x = q[0] | (q[1] << 8) | (q[2] << 16) | (q[3] << 24); w.y = q[4] | (q[5] << 8) | (q[6] << 16) | (q[7] << 24);
                    *(u32x2*)(O + (size_t)r * NGATE + col0 + bj * HALF) = w; } }
    }
};
struct EpiIn {
    static constexpr bool PERM = true, AFTER_DRAIN = false, PROBE2 = false, MIDK = false;
    hf* QKVNo; hf* KRo; hf* PHYo; hf* DQo; hf* DKo; hf* DVo; const float* ss; const float* bias; float* ssq; float* sskv; LAS unsigned char* lx;
    __device__ __forceinline__ void operator()(const f32x4 (&acc)[2][2][4][2], const Unit& u, int wr, int wc, int fr, int fq) const {
        const int R0 = u.pm * BM, row0 = R0 + wr * 64 + fr, col0 = u.pn * BM + wc * 32 + 8 * fq;
        const int v = (R0 < NLAT) ? (R0 >> 11) : NB; const float* bp = bias + (size_t)v * NBIAS + col0;
        f32x4 bv[2][2]; hf* dst[2]; int ld[2];
#pragma unroll
        for (int bj = 0; bj < 2; ++bj) { const int c8 = col0 + bj * HALF;
            bv[bj][0] = *(const f32x4*)(bp + bj * HALF); bv[bj][1] = *(const f32x4*)(bp + bj * HALF + 4);
            if (c8 < C_PKR) { dst[bj] = QKVNo + c8; ld[bj] = KUP; }
            else if (c8 < C_HY) { dst[bj] = KRo + (c8 - C_PKR); ld[bj] = 32; }
            else if (c8 < C_DQ) { dst[bj] = PHYo + (c8 - C_HY); ld[bj] = 768; }
            else if (c8 < C_DK) { dst[bj] = DQo + (c8 - C_DQ); ld[bj] = 256; }
            else if (c8 < C_DV) { dst[bj] = DKo + (c8 - C_DK); ld[bj] = 256; }
            else if (c8 < C_PG) { dst[bj] = DVo + (c8 - C_DV); ld[bj] = 256; }
            else { dst[bj] = nullptr; ld[bj] = 0; } }
        const int nstat = (u.pn == 0) ? 2 : (u.pn == 1 ? 1 : 0);
        float* sp = (u.pn == 0) ? ssq : sskv;
        float sqv[2][4];
#pragma unroll
        for (int ai = 0; ai < 2; ++ai)
#pragma unroll
            for (int m = 0; m < 4; ++m) { const int r = row0 + ai * HALF + m * 16; const float rs = rstd4(ss, r); float sq = 0.f;
#pragma unroll
                for (int bj = 0; bj < 2; ++bj) { const f32x4 v0 = acc[ai][bj][m][0] * rs + bv[bj][0], v1 = acc[ai][bj][m][1] * rs + bv[bj][1];
                    if (bj < nstat) sq += (v0[0] * v0[0] + v0[1] * v0[1]) + (v0[2] * v0[2] + v0[3] * v0[3]) + (v1[0] * v1[0] + v1[1] * v1[1]) + (v1[2] * v1[2] + v1[3] * v1[3]);
                    if (dst[bj]) { u32x4 w; w.x = pkhb(v0[0], v0[1]); w.y = pkhb(v0[2], v0[3]); w.z = pkhb(v1[0], v1[1]); w.w = pkhb(v1[2], v1[3]); *(u32x4*)(dst[bj] + (size_t)r * ld[bj]) = w; } }
                sq += __shfl_xor(sq, 16); sq += __shfl_xor(sq, 32); sqv[ai][m] = sq; }
        if (nstat) {
            LAS float* ex = (LAS float*)lx;
            if (fq == 0) {
#pragma unroll
                for (int ai = 0; ai < 2; ++ai)
#pragma unroll
                    for (int m = 0; m < 4; ++m) ex[((wr * 4 + wc) * 8 + ai * 4 + m) * 16 + fr] = sqv[ai][m]; }
            asm volatile("s_waitcnt lgkmcnt(0)" ::: "memory"); __builtin_amdgcn_s_barrier(); asm volatile("" ::: "memory");
            if (wc == 0 && fq == 0) {
#pragma unroll
                for (int ai = 0; ai < 2; ++ai)
#pragma unroll
                    for (int m = 0; m < 4; ++m) { const int e = (ai * 4 + m) * 16 + fr; const int wb = wr * 4 * 128;
                        sp[row0 + ai * HALF + m * 16] = (ex[wb + e] + ex[wb + 128 + e]) + (ex[wb + 256 + e] + ex[wb + 384 + e]); } }
        }
    }
};
struct EpiUp {
    static constexpr bool PERM = true, AFTER_DRAIN = false, PROBE2 = false, MIDK = false;
    hf* O; const float* ssq; const float* sskv;
    __device__ __forceinline__ void operator()(const f32x4 (&acc)[2][2][4][2], const Unit& u, int wr, int wc, int fr, int fq) const {
        const int row0 = u.pm * BM + wr * 64 + fr, col0 = u.pn * BM + wc * 32 + 8 * fq;
        const bool isq = u.pn < 3; const float* sp = isq ? ssq : sskv; const float invn = isq ? (1.f / 256.f) : (1.f / 128.f);
#pragma unroll
        for (int ai = 0; ai < 2; ++ai)
#pragma unroll
            for (int m = 0; m < 4; ++m) { const int r = row0 + ai * HALF + m * 16; hf* rowp = O + (size_t)r * NUP + col0; const float rs = rsqrtf(sp[r] * invn + EPS);
#pragma unroll
                for (int bj = 0; bj < 2; ++bj) { const f32x4 v0 = acc[ai][bj][m][0] * rs, v1 = acc[ai][bj][m][1] * rs;
                    u32x4 w; w.x = pkhb(v0[0], v0[1]); w.y = pkhb(v0[2], v0[3]); w.z = pkhb(v1[0], v1[1]); w.w = pkhb(v1[2], v1[3]);
                    *(u32x4*)(rowp + bj * HALF) = w; } }
    }
};
template <bool FIRST> struct EpiGated {
    static constexpr bool PERM = true, AFTER_DRAIN = false, PROBE2 = false, MIDK = false;
    hf* MMo; const hf* G; int goff;
    __device__ __forceinline__ void operator()(const f32x4 (&acc)[2][2][4][2], const Unit& u, int wr, int wc, int fr, int fq) const {
        const int row0 = u.pm * BM + wr * 64 + fr, col0 = u.pn * BM + wc * 32 + 8 * fq;
#pragma unroll
        for (int ai = 0; ai < 2; ++ai)
#pragma unroll
            for (int m = 0; m < 4; ++m) { const size_t r = (size_t)(row0 + ai * HALF + m * 16);
#pragma unroll
                for (int bj = 0; bj < 2; ++bj) { const f32x4 v0 = acc[ai][bj][m][0], v1 = acc[ai][bj][m][1];
                    const hf8 g = *(const hf8*)(G + r * NGATE + goff + col0 + bj * HALF);
                    hf* mp = MMo + r * DM + col0 + bj * HALF;
                    float o[8];
#pragma unroll
                    for (int e = 0; e < 4; ++e) { o[e] = (float)g[e] * v0[e]; o[4 + e] = (float)g[4 + e] * v1[e]; }
                    if (!FIRST) { const hf8 p = *(const hf8*)mp;
#pragma unroll
                        for (int e = 0; e < 8; ++e) o[e] += (float)p[e]; }
                    u32x4 w; w.x = pkh(o[0], o[1]); w.y = pkh(o[2], o[3]); w.z = pkh(o[4], o[5]); w.w = pkh(o[6], o[7]);
                    *(u32x4*)mp = w; } }
    }
};
struct EpiMerge {
    static constexpr bool PERM = true, AFTER_DRAIN = false, PROBE2 = false, MIDK = true;
    static constexpr int MID1 = 8, MID2 = 12;
    hf* MMo; const unsigned char* G;
    __device__ __forceinline__ void mid(f32x4 (&acc)[2][2][4][2], const Unit& u, int which, int wr, int wc, int fr, int fq) const {
        asm volatile("" : "+v"(fr), "+v"(fq));
        const int row0 = u.pm * BM + wr * 64 + fr, col0 = u.pn * BM + wc * 32 + 8 * fq; const int gnum = which ? 1024 : 0, gden = which ? 2048 : 1024;
#pragma unroll
        for (int ai = 0; ai < 2; ++ai) {
            u32x2 gn[4][2], gd[4][2];
#pragma unroll
            for (int m = 0; m < 4; ++m) { const unsigned char* gr = G + (size_t)(row0 + ai * HALF + m * 16) * NGATE + col0;
#pragma unroll
                for (int bj = 0; bj < 2; ++bj) { gn[m][bj] = *(const u32x2*)(gr + gnum + bj * HALF); gd[m][bj] = *(const u32x2*)(gr + gden + bj * HALF); } }
#pragma unroll
            for (int m = 0; m < 4; ++m)
#pragma unroll
                for (int bj = 0; bj < 2; ++bj)
#pragma unroll
                    for (int e = 0; e < 4; ++e) {
                        acc[ai][bj][m][0][e] *= (float)((gn[m][bj].x >> (8 * e)) & 255u) * __builtin_amdgcn_rcpf((float)((gd[m][bj].x >> (8 * e)) & 255u));
                        acc[ai][bj][m][1][e] *= (float)((gn[m][bj].y >> (8 * e)) & 255u) * __builtin_amdgcn_rcpf((float)((gd[m][bj].y >> (8 * e)) & 255u)); }
            asm volatile("" ::: "memory");
        }
    }
    __device__ __forceinline__ void operator()(const f32x4 (&acc)[2][2][4][2], const Unit& u, int wr, int wc, int fr, int fq) const {
        const int row0 = u.pm * BM + wr * 64 + fr, col0 = u.pn * BM + wc * 32 + 8 * fq;
#pragma unroll
        for (int ai = 0; ai < 2; ++ai)
#pragma unroll
            for (int m = 0; m < 4; ++m) { const size_t r = (size_t)(row0 + ai * HALF + m * 16);
#pragma unroll
                for (int bj = 0; bj < 2; ++bj) { const f32x4 v0 = acc[ai][bj][m][0], v1 = acc[ai][bj][m][1];
                    const u32x2 g = *(const u32x2*)(G + r * NGATE + 2048 + col0 + bj * HALF);
                    float o[8];
#pragma unroll
                    for (int e = 0; e < 4; ++e) { o[e] = (float)((g.x >> (8 * e)) & 255u) * (1.f / 255.f) * v0[e]; o[4 + e] = (float)((g.y >> (8 * e)) & 255u) * (1.f / 255.f) * v1[e]; }
                    u32x4 w; w.x = pkhb(o[0], o[1]); w.y = pkhb(o[2], o[3]); w.z = pkhb(o[4], o[5]); w.w = pkhb(o[6], o[7]);
                    *(u32x4*)(MMo + r * DM + col0 + bj * HALF) = w; } }
    }
};
template <bool XS, bool STAT> struct EpiResidX {
    static constexpr bool PERM = true, AFTER_DRAIN = false, PROBE2 = false, MIDK = false;
    hf* x16; const float* gate;
    hf* xsout; const float* gs; float* ss; LAS unsigned char* lx;
    __device__ __forceinline__ void operator()(const f32x4 (&acc)[2][2][4][2], const Unit& u, int wr, int wc, int fr, int fq) const {
        const int R0 = u.pm * BM; const int v = (R0 < NLAT) ? (R0 >> 11) : NB;
        const int rglob = R0 + wr * 64 + fr, col0 = u.pn * BM + wc * 32 + 8 * fq;
        const float* gp = gate + (size_t)v * MODW + col0; const float* gsp = gs + (size_t)v * DM + col0;
        float sq[2][4];
#pragma unroll
        for (int ai = 0; ai < 2; ++ai)
#pragma unroll
            for (int m = 0; m < 4; ++m) sq[ai][m] = 0.f;
#pragma unroll
        for (int bj = 0; bj < 2; ++bj) {
            const f32x4 g0 = *(const f32x4*)(gp + bj * HALF), g1 = *(const f32x4*)(gp + bj * HALF + 4);
            f32x4 s0 = {1.f, 1.f, 1.f, 1.f}, s1 = s0; if (XS) { s0 = *(const f32x4*)(gsp + bj * HALF); s1 = *(const f32x4*)(gsp + bj * HALF + 4); }
#pragma unroll
            for (int ai = 0; ai < 2; ++ai)
#pragma unroll
                for (int m = 0; m < 4; ++m) { const int rr = ai * HALF + m * 16; const size_t off = (size_t)(rglob + rr) * DM + col0 + bj * HALF;
                    const hf8 xv = *(const hf8*)(x16 + off);
                    const f32x4 x0 = {(float)xv[0], (float)xv[1], (float)xv[2], (float)xv[3]}, x1 = {(float)xv[4], (float)xv[5], (float)xv[6], (float)xv[7]};
                    const f32x4 n0 = x0 + g0 * acc[ai][bj][m][0], n1 = x1 + g1 * acc[ai][bj][m][1];
                    { u32x4 w; w.x = pkh(n0[0], n0[1]); w.y = pkh(n0[2], n0[3]); w.z = pkh(n1[0], n1[1]); w.w = pkh(n1[2], n1[3]); *(u32x4*)(x16 + off) = w; }
                    if (STAT) sq[ai][m] += (n0[0] * n0[0] + n0[1] * n0[1]) + (n0[2] * n0[2] + n0[3] * n0[3]) + (n1[0] * n1[0] + n1[1] * n1[1]) + (n1[2] * n1[2] + n1[3] * n1[3]);
                    if (XS) { const f32x4 a = n0 * s0, b = n1 * s1; u32x4 w; w.x = pkhb(a[0], a[1]); w.y = pkhb(a[2], a[3]); w.z = pkhb(b[0], b[1]); w.w = pkhb(b[2], b[3]);
                        *(u32x4*)(xsout + off) = w; } }
        }
        if (STAT) {
            LAS float* ex = (LAS float*)lx;
#pragma unroll
            for (int ai = 0; ai < 2; ++ai)
#pragma unroll
                for (int m = 0; m < 4; ++m) { float t = sq[ai][m]; t += __shfl_xor(t, 16); t += __shfl_xor(t, 32);
                    if (fq == 0) ex[((wr * 4 + wc) * 8 + ai * 4 + m) * 16 + fr] = t; }
            asm volatile("s_waitcnt lgkmcnt(0)" ::: "memory"); __builtin_amdgcn_s_barrier(); asm volatile("" ::: "memory");
            if (wc == 0 && fq == 0) {
#pragma unroll
                for (int ai = 0; ai < 2; ++ai)
#pragma unroll
                    for (int m = 0; m < 4; ++m) { const int e = (ai * 4 + m) * 16 + fr; const int wb = wr * 4 * 128;
                        ss[(size_t)(rglob + ai * HALF + m * 16) * 4 + u.pn] = (ex[wb + e] + ex[wb + 128 + e]) + (ex[wb + 256 + e] + ex[wb + 384 + e]); } }
        }
    }
};

template <class Epi, class Sched, bool ALIGN_EPI = true>
__device__ __forceinline__ void gemm_phase(LAS unsigned char* lds, const Gemm g, const Sched& S, const Epi& E) {
    int tid = threadIdx.x; asm volatile("" : "+v"(tid));
    const int wid = __builtin_amdgcn_readfirstlane(tid >> 6), lane = tid & 63, wr = wid >> 2, wc = wid & 3, fr = lane & 15, fq = lane >> 4;
    const int K = g.K, nt = K / BK;
    unsigned voffA[2], voffB[2];
#pragma unroll
    for (int i = 0; i < 2; ++i) { int R, C; stage_rc(tid * 16 + i * 8192, R, C); const int Rb = Epi::PERM ? ((R & ~31) + perm32(R & 31)) : R;
        voffA[i] = (unsigned)(R * g.lda + C) * 2u; voffB[i] = (unsigned)(Rb * g.ldb + C) * 2u; }
    const size_t kstep = (size_t)(BK * 2);
    const size_t hstepA = (size_t)HALF * g.lda * 2, hstepB = (size_t)HALF * g.ldb * 2;
    const size_t tstepA = 2 * hstepA, tstepB = 2 * hstepB;
    const unsigned ldsw = (unsigned)wid * 1024u;
    const int aoff = lds_byte(wr * 64 + fr, fq * 8), boff = lds_byte(wc * 32 + fr, fq * 8);
#define PG8_SA(b, h) (((b) * 2 + (h)) * HTB)
#define PG8_SB(b, h) ((4 + (b) * 2 + (h)) * HTB)
#define PG8_STAGE(bufoff, gbase, voff) do { _Pragma("unroll") for (int _i = 0; _i < 2; ++_i) \
        __builtin_amdgcn_global_load_lds((const unsigned*)((const char*)(gbase) + (voff)[_i]), (LAS unsigned*)(lds + (bufoff) + ldsw + _i * 8192), 16, 0, 0); } while (0)
#define PG8_LDA(dst, b, h) do { _Pragma("unroll") for (int m = 0; m < 4; ++m) _Pragma("unroll") for (int k = 0; k < 2; ++k) dst[m][k] = *(const LAS hf8*)(lds + PG8_SA(b, h) + aoff + m * 2048 + k * 1024); } while (0)
#define PG8_LDB(dst, b, h) do { _Pragma("unroll") for (int n = 0; n < 2; ++n) _Pragma("unroll") for (int k = 0; k < 2; ++k) dst[n][k] = *(const LAS hf8*)(lds + PG8_SB(b, h) + boff + n * 2048 + k * 1024); } while (0)
#define PG8_MMA(ai, bj, At, Bt) do { __builtin_amdgcn_s_setprio(1); _Pragma("unroll") for (int m = 0; m < 4; ++m) _Pragma("unroll") for (int n = 0; n < 2; ++n) _Pragma("unroll") for (int k = 0; k < 2; ++k) \
        acc[ai][bj][m][n] = __builtin_amdgcn_mfma_f32_16x16x32_f16(Bt[n][k], At[m][k], acc[ai][bj][m][n], 0, 0, 0); __builtin_amdgcn_s_setprio(0); } while (0)
#define PG8_WAIT_V(n) asm volatile("s_waitcnt vmcnt(" #n ")" ::: "memory")
#define PG8_WAIT_L(n) asm volatile("s_waitcnt lgkmcnt(" #n ")" ::: "memory")
#define PG8_BAR __builtin_amdgcn_s_barrier()
#define PG8_SCHED __builtin_amdgcn_sched_barrier(0)
    Unit cur, nxt; int ui = 0;
    if (!S.next(0, cur)) return;
    f32x4 acc[2][2][4][2];
#pragma unroll
    for (int a = 0; a < 2; ++a)
#pragma unroll
        for (int b = 0; b < 2; ++b)
#pragma unroll
            for (int m = 0; m < 4; ++m)
#pragma unroll
                for (int n = 0; n < 2; ++n) acc[a][b][m][n] = (f32x4){0.f, 0.f, 0.f, 0.f};
    hf8 At[4][2], B0[2][2], B1[2][2];
    const char* cA = (const char*)g.A + (size_t)cur.pm * tstepA; const char* cB = (const char*)g.Bt + (size_t)cur.pn * tstepB;
    S.a_ready(cur);
    PG8_STAGE(PG8_SB(0, 0), cB, voffB); PG8_STAGE(PG8_SB(0, 1), cB + hstepB, voffB); PG8_STAGE(PG8_SA(0, 0), cA, voffA); PG8_STAGE(PG8_SA(0, 1), cA + hstepA, voffA);
    if (wr == 1) PG8_BAR;
    PG8_WAIT_V(2); PG8_BAR;
    PG8_STAGE(PG8_SB(1, 0), cB + kstep, voffB); PG8_STAGE(PG8_SA(1, 0), cA + kstep, voffA); PG8_STAGE(PG8_SB(1, 1), cB + hstepB + kstep, voffB);
    PG8_WAIT_V(6); PG8_BAR;
    for (;;) {
        const bool has_next = S.next(ui + 1, nxt);
        const char* nA = has_next ? (const char*)g.A + (size_t)nxt.pm * tstepA : cA; const char* nB = has_next ? (const char*)g.Bt + (size_t)nxt.pn * tstepB : cB;
#pragma unroll 1
        for (int t = 0; t < nt; t += 2) {
            const bool last = (t == nt - 2);
            const char* a1 = cA + (size_t)(t + 1) * kstep;
            const char* a2 = last ? nA : cA + (size_t)(t + 2) * kstep; const char* b2 = last ? nB : cB + (size_t)(t + 2) * kstep;
            const char* a3 = a2 + kstep; const char* b3 = b2 + kstep;
            if (last && has_next) S.a_ready(nxt);
            if constexpr (Epi::MIDK) { if (t == Epi::MID1 || t == Epi::MID2) E.mid(acc, cur, t == Epi::MID1 ? 0 : 1, wr, wc, fr, fq); }
            PG8_LDB(B0, 0, 0); PG8_LDB(B1, 0, 1); PG8_SCHED; PG8_LDA(At, 0, 0); PG8_STAGE(PG8_SA(1, 1), a1 + hstepA, voffA);
            PG8_WAIT_V(8); PG8_WAIT_L(0); PG8_BAR; PG8_MMA(0, 0, At, B0); PG8_MMA(0, 1, At, B1); PG8_BAR; PG8_SCHED;
            PG8_LDA(At, 0, 1); PG8_STAGE(PG8_SB(0, 0), b2, voffB); PG8_STAGE(PG8_SB(0, 1), b2 + hstepB, voffB); PG8_STAGE(PG8_SA(0, 0), a2, voffA);
            PG8_WAIT_V(8); PG8_WAIT_L(0); PG8_BAR; PG8_MMA(1, 0, At, B0); PG8_MMA(1, 1, At, B1); PG8_BAR; PG8_SCHED;
            PG8_LDB(B0, 1, 0); PG8_LDB(B1, 1, 1); PG8_SCHED; PG8_LDA(At, 1, 0); PG8_STAGE(PG8_SA(0, 1), a2 + hstepA, voffA);
            PG8_WAIT_V(8); PG8_WAIT_L(0); PG8_BAR; PG8_MMA(0, 0, At, B0); PG8_MMA(0, 1, At, B1); PG8_BAR; PG8_SCHED;
            PG8_LDA(At, 1, 1); PG8_STAGE(PG8_SB(1, 0), b3, voffB); PG8_STAGE(PG8_SB(1, 1), b3 + hstepB, voffB); PG8_STAGE(PG8_SA(1, 0), a3, voffA);
            PG8_WAIT_V(8); PG8_WAIT_L(0); PG8_BAR; PG8_MMA(1, 0, At, B0); PG8_MMA(1, 1, At, B1); PG8_BAR; PG8_SCHED;
        }
        if constexpr (ALIGN_EPI) { if (wr == 0) PG8_BAR; }
        E(acc, cur, wr, wc, fr, fq); S.done(cur);
#ifdef PROBE_EPI2
        if (Epi::PROBE2) { asm volatile("" ::: "memory"); E(acc, cur, wr, wc, fr, fq); }
#endif
        if (!has_next) break;
#pragma unroll
        for (int a = 0; a < 2; ++a)
#pragma unroll
            for (int b = 0; b < 2; ++b)
#pragma unroll
                for (int m = 0; m < 4; ++m)
#pragma unroll
                    for (int n = 0; n < 2; ++n) acc[a][b][m][n] = (f32x4){0.f, 0.f, 0.f, 0.f};
        cur = nxt; cA = nA; cB = nB; ++ui;
        if constexpr (ALIGN_EPI) { if (wr == 1) PG8_BAR; }
    }
    PG8_WAIT_V(0);
    if constexpr (!ALIGN_EPI) { if (wr == 0) PG8_BAR; }
    PG8_BAR;
#undef PG8_SA
#undef PG8_SB
#undef PG8_STAGE
#undef PG8_LDA
#undef PG8_LDB
#undef PG8_MMA
#undef PG8_WAIT_V
#undef PG8_WAIT_L
#undef PG8_BAR
#undef PG8_SCHED
}
}

struct Params {
    const float* in[35];
    float* out;
    unsigned char* ws;
    int ph_lo, ph_hi;
};
enum { I_X = 0, I_C, I_CTX, I_CCTX, I_NMG, I_NFG, I_WMOD, I_BMOD, I_WIN, I_QNG, I_WUQ, I_KVNG, I_WUKV, I_HCW, I_HCB, I_HW1, I_HB1, I_HFREQ, I_HW2, I_HB2, I_HW3, I_HB3,
       I_HSKIP, I_LQ1, I_LK1, I_LQ2, I_LK2, I_SUBG, I_WBRA, I_WBRB, I_WBRC, I_WOUT, I_FC1, I_FC2, I_FNG };

struct Frame {
    LAS unsigned char* lds;
    int tid, lane, wave, vcu, G;
};

__device__ __forceinline__ void tr_item(const float* W, int ldw, hf* WT, int ldt, int nblk, LAS float* scr, int item, int lane, const float* kgain = nullptr) {
    const int kb = item / nblk, nb = item % nblk, k0 = 64 * kb, n0 = 32 * nb;
#pragma unroll 8
    for (int i = 0; i < 32; ++i) { const int kk = 2 * i + (lane >> 5); const float gk = kgain ? kgain[k0 + kk] : 1.f; { float wv = W[(size_t)(k0 + kk) * ldw + n0 + (lane & 31)] * gk; unsigned ub = __float_as_uint(wv); ub += 0x7fffu + ((ub >> 16) & 1u); ub &= 0xffff0000u; scr[kk * 33 + (lane & 31)] = __uint_as_float(ub); } }
    LDS_WAIT(); asm volatile("" ::: "memory");
    const int c = lane & 7;
#pragma unroll
    for (int j = 0; j < 4; ++j) { const int n = (lane >> 3) + 8 * j; const LAS float* s = scr + (8 * c) * 33 + n;
        u32x4 o; o.x = pkh(s[0 * 33], s[1 * 33]); o.y = pkh(s[2 * 33], s[3 * 33]); o.z = pkh(s[4 * 33], s[5 * 33]); o.w = pkh(s[6 * 33], s[7 * 33]);
        *(u32x4*)(WT + (size_t)(n0 + n) * ldt + k0 + 8 * c) = o; }
    LDS_WAIT(); asm volatile("" ::: "memory");
}
__device__ __forceinline__ float silu_f(float x) { return x / (1.f + expf(-x)); }

__device__ __forceinline__ void mod_phase(const Frame& F, const Params& p) {
    float* MOD = (float*)(p.ws + WS_MOD);
    LAS float* sv = (LAS float*)F.lds;
    constexpr int NCB = DEPTH * MODW / 512;
    for (int item = F.vcu; item < NCB * 3; item += F.G) {
        const int cb = item / 3, vg = item % 3;
        __syncthreads();
        for (int i = F.tid; i < 11 * 1024; i += 512) { const int v = vg * 11 + i / 1024, k = i % 1024;
            const float c = (v < NB) ? p.in[I_C][v * DM + k] : p.in[I_CCTX][k]; sv[i] = silu_f(c); }
        __syncthreads();
        const int gcol = cb * 512 + F.tid, l = gcol / MODW, n = gcol % MODW;
        const float* w = p.in[I_WMOD] + (size_t)l * DM * MODW + n;
        float acc[11];
#pragma unroll
        for (int v = 0; v < 11; ++v) acc[v] = 0.f;
#pragma unroll 4
        for (int k = 0; k < DM; k += 4) {
            const float w0 = w[(size_t)k * MODW], w1 = w[(size_t)(k + 1) * MODW], w2 = w[(size_t)(k + 2) * MODW], w3 = w[(size_t)(k + 3) * MODW];
#pragma unroll
            for (int v = 0; v < 11; ++v) { const f32x4 s = *(const LAS f32x4*)(sv + v * 1024 + k);
                acc[v] = fmaf(s[0], w0, acc[v]); acc[v] = fmaf(s[1], w1, acc[v]); acc[v] = fmaf(s[2], w2, acc[v]); acc[v] = fmaf(s[3], w3, acc[v]); }
        }
        const float bm = p.in[I_BMOD][(size_t)l * MODW + n];
#pragma unroll
        for (int v = 0; v < 11; ++v) MOD[((size_t)l * NMODV + vg * 11 + v) * MODW + n] = acc[v] + bm;
    }
    __syncthreads();
}

__device__ __forceinline__ void filt_item(const Params& p, int l, int kind  , int t, int lane) {
    const int L = kind ? CTXL : SEQ;
    hf* R = kind ? (hf*)(p.ws + WS_RFC) + (size_t)l * 256 * 512 : (hf*)(p.ws + WS_RF) + (size_t)l * 256 * 4096;
    const int rl = 2 * L;
    const float tl = (float)t / (float)(L - 1);
    const float wt = (6.283185307179586f / (float)L) * (float)t;
    float z = 0.f;
    if (lane == 0) z = tl;
    else if (lane <= 32) { const int bi = (lane - 1) & 15; const float band = 1e-4f + (15.f - 1e-4f) * ((float)bi / 15.f); const float a = band * wt; z = (lane <= 16) ? cosf(a) : -sinf(a); }
    const float* w1 = p.in[I_HW1] + (size_t)l * 33 * 64; const float* w2 = p.in[I_HW2] + (size_t)l * 64 * 64; const float* w3 = p.in[I_HW3] + (size_t)l * 64 * 512;
    const float fr = p.in[I_HFREQ][l * 64 + lane];
    float a1 = p.in[I_HB1][l * 64 + lane];
    for (int i = 0; i < 33; ++i) a1 = fmaf(__shfl(z, i), w1[i * 64 + lane], a1);
    a1 = sinf(fr * a1);
    float a2 = p.in[I_HB2][l * 64 + lane];
    for (int i = 0; i < 64; ++i) a2 = fmaf(__shfl(a1, i), w2[i * 64 + lane], a2);
    a2 = sinf(fr * a2);
    float h[8];
#pragma unroll
    for (int q = 0; q < 8; ++q) h[q] = p.in[I_HB3][l * 512 + q * 64 + lane];
    for (int i = 0; i < 64; ++i) { const float a = __shfl(a2, i);
#pragma unroll
        for (int q = 0; q < 8; ++q) h[q] = fmaf(a, w3[i * 512 + q * 64 + lane], h[q]); }
    const float d0 = -4.605170185988091f / 1.5f, d1 = -4.605170185988091f / 0.3f;
#pragma unroll
    for (int q = 0; q < 8; ++q) { const int o = q * 64 + lane, dir = o >> 8, c = o & 255;
        const float delta = fabsf(d0 + (d1 - d0) * ((float)c / 255.f));
        float val = h[q] * (expf(-tl * delta) + 0.05f);
        if (dir == 0) { if (t == 0) val += p.in[I_HSKIP][l * 256 + c]; R[(size_t)c * rl + (L - t)] = (hf)val; if (t == 0) R[(size_t)c * rl] = (hf)0.f; }
        else if (t >= 1) R[(size_t)c * rl + (L + t)] = (hf)val; }
}

__device__ __forceinline__ void convert_layer(const Frame& F, const Params& p, int l, unsigned char* wl, int wg_rank, int wg_count) {
    LAS float* scr = (LAS float*)(F.lds + F.wave * 16384);
    const int gw = wg_rank * 8 + F.wave, NGW = wg_count * 8, lane = F.lane;
    constexpr int IT_IN1 = 16 * 61, IT_ING = 16 * 96, IT_UQ = 4 * 24, IT_UKV = 2 * 32, IT_BRA = 8 * 32, IT_BRB = 4 * 32, IT_BRC = 4 * 32, IT_OUT = 16 * 32, IT_FC1 = 16 * 128, IT_FC2 = 64 * 32;
    constexpr int IT_LAYER = IT_IN1 + IT_ING + IT_UQ + IT_UKV + IT_BRA + IT_BRB + IT_BRC + IT_OUT + IT_FC1 + IT_FC2;
    for (int it = gw; it < IT_LAYER; it += NGW) {
        int r = it;
        if (r < IT_IN1) { tr_item(p.in[I_WIN] + (size_t)l * DM * D_IN, D_IN, (hf*)(wl + W_IN1), DM, 61, scr, r, lane); continue; } r -= IT_IN1;
        if (r < IT_ING) { tr_item(p.in[I_WIN] + (size_t)l * DM * D_IN + C_PG, D_IN, (hf*)(wl + W_ING), DM, 96, scr, r, lane); continue; } r -= IT_ING;
        if (r < IT_UQ) { tr_item(p.in[I_WUQ] + (size_t)l * 256 * 768, 768, (hf*)(wl + W_UP), KUP, 24, scr, r, lane, p.in[I_QNG] + l * 256); continue; } r -= IT_UQ;
        if (r < IT_UKV) { tr_item(p.in[I_WUKV] + (size_t)l * 128 * 1024, 1024, (hf*)(wl + W_UP) + (size_t)768 * KUP + 256, KUP, 32, scr, r, lane, p.in[I_KVNG] + l * 128); continue; } r -= IT_UKV;
        if (r < IT_BRA) { tr_item(p.in[I_WBRA] + (size_t)l * 512 * DM, DM, (hf*)(wl + W_BR), DM, 32, scr, r, lane); continue; } r -= IT_BRA;
        if (r < IT_BRB) { tr_item(p.in[I_WBRB] + (size_t)l * 256 * DM, DM, (hf*)(wl + W_BR) + 512, DM, 32, scr, r, lane); continue; } r -= IT_BRB;
        if (r < IT_BRC) { tr_item(p.in[I_WBRC] + (size_t)l * 256 * DM, DM, (hf*)(wl + W_BR) + 768, DM, 32, scr, r, lane); continue; } r -= IT_BRC;
        if (r < IT_OUT) { tr_item(p.in[I_WOUT] + (size_t)l * DM * DM, DM, (hf*)(wl + W_OUT), DM, 32, scr, r, lane); continue; } r -= IT_OUT;
        if (r < IT_FC1) { tr_item(p.in[I_FC1] + (size_t)l * DM * DFF, DFF, (hf*)(wl + W_FC1), DM, 128, scr, r, lane); continue; } r -= IT_FC1;
        tr_item(p.in[I_FC2] + (size_t)l * DFF * DM, DM, (hf*)(wl + W_FC2), DFF, 32, scr, r, lane);
    }
    const int gt = gw * 64 + lane, NGT = NGW * 64;
    u32x4* z1 = (u32x4*)((hf*)(wl + W_IN1) + (size_t)C_PG * DM);
    for (int i = gt; i < 96 * DM / 8; i += NGT) z1[i] = (u32x4){0u, 0u, 0u, 0u};
    hf* up = (hf*)(wl + W_UP);
    for (int i = gt; i < 768 * 16; i += NGT) { const int n = i / 16, k8 = i % 16; *(u32x4*)(up + (size_t)n * KUP + 256 + k8 * 8) = (u32x4){0u, 0u, 0u, 0u}; }
    for (int i = gt; i < 1024 * 32; i += NGT) { const int n = 768 + i / 32, k8 = i % 32; *(u32x4*)(up + (size_t)n * KUP + k8 * 8) = (u32x4){0u, 0u, 0u, 0u}; }
}

__device__ __forceinline__ void prologue_a(const Frame& F, const Params& p) {
    mod_phase(F, p);
    convert_layer(F, p, 0, p.ws + WS_WT, F.vcu, F.G);
    const int gw = F.vcu * 8 + F.wave, NGW = F.G * 8, lane = F.lane;
    for (int it = gw; it < DEPTH * (SEQ + CTXL); it += NGW) { const int l = it / (SEQ + CTXL), r = it % (SEQ + CTXL); if (r < SEQ) filt_item(p, l, 0, r, lane); else filt_item(p, l, 1, r - SEQ, lane); }
    {
        float* rope = (float*)(p.ws + WS_ROPE);
        const int gt = gw * 64 + lane, NGT = NGW * 64;
        for (int i = gt; i < SEQ * 16; i += NGT) { const int t = i >> 4, j = i & 15; const float pos = (j < 8) ? (float)(t / GRIDW) : (float)(t % GRIDW);
            const float inv = powf(10000.f, -(float)(j & 7) / 8.f); const float a = pos * inv; rope[t * 32 + j] = cosf(a); rope[t * 32 + 16 + j] = sinf(a); }
        if (gt < DEPTH) { const int l = gt; float s1 = 0.f, s2 = 0.f;
            for (int i = 0; i < 32; ++i) { s1 += p.in[I_LQ1][l * 32 + i] * p.in[I_LK1][l * 32 + i]; s2 += p.in[I_LQ2][l * 32 + i] * p.in[I_LK2][l * 32 + i]; }
            const float li = 0.8f - 0.6f * expf(-0.3f * (float)l);
            float* lam = (float*)(p.ws + WS_LAM); lam[2 * l] = expf(s1) - expf(s2) + li; lam[2 * l + 1] = 1.f - li; }
    }
}
__device__ __forceinline__ void prologue_b(const Frame& F, const Params& p) {
    const float* MOD = (const float*)(p.ws + WS_MOD); float* BIAS = (float*)(p.ws + WS_BIAS);
    {
        LAS float* sv = (LAS float*)F.lds;
        constexpr int NCB = DEPTH * NBIAS / 512;
        for (int item = F.vcu; item < NCB * 3; item += F.G) {
            const int cb = item / 3, vg = item % 3;
            const int gcol = cb * 512 + F.tid, l = gcol / NBIAS, n = gcol % NBIAS, n0 = (cb * 512) % NBIAS;
            const int soff = (n0 >= B_FC1) ? 3 * DM : 0;
            __syncthreads();
            for (int i = F.tid; i < 11 * 1024; i += 512) { const int v = vg * 11 + i / 1024, k = i % 1024; sv[i] = MOD[((size_t)l * NMODV + v) * MODW + soff + k]; }
            __syncthreads();
            const float* w; size_t ldw; bool valid = true;
            if (n < B_G) { w = p.in[I_WIN] + (size_t)l * DM * D_IN + n; ldw = D_IN; valid = n < C_PG; }
            else if (n < B_FC1) { w = p.in[I_WIN] + (size_t)l * DM * D_IN + C_PG + (n - B_G); ldw = D_IN; }
            else { w = p.in[I_FC1] + (size_t)l * DM * DFF + (n - B_FC1); ldw = DFF; }
            float acc[11];
#pragma unroll
            for (int v = 0; v < 11; ++v) acc[v] = 0.f;
            if (valid)
#pragma unroll 4
            for (int k = 0; k < DM; k += 4) {
                const float w0 = w[(size_t)k * ldw], w1 = w[(size_t)(k + 1) * ldw], w2 = w[(size_t)(k + 2) * ldw], w3 = w[(size_t)(k + 3) * ldw];
#pragma unroll
                for (int v = 0; v < 11; ++v) { const f32x4 sx = *(const LAS f32x4*)(sv + v * 1024 + k);
                    acc[v] = fmaf(sx[0], w0, acc[v]); acc[v] = fmaf(sx[1], w1, acc[v]); acc[v] = fmaf(sx[2], w2, acc[v]); acc[v] = fmaf(sx[3], w3, acc[v]); }
            }
#pragma unroll
            for (int v = 0; v < 11; ++v) BIAS[((size_t)l * NMODV + vg * 11 + v) * NBIAS + n] = acc[v];
        }
        __syncthreads();
    }
    const int gw = F.vcu * 8 + F.wave, NGW = F.G * 8, lane = F.lane;
    {
        float* GS = (float*)(p.ws + WS_GS);
        const int gt = gw * 64 + lane, NGT = NGW * 64;
        for (int i = gt; i < DEPTH * 2 * NMODV * DM; i += NGT) { const int c = i % DM, v = (i / DM) % NMODV, wh = (i / (DM * NMODV)) % 2, l = i / (DM * NMODV * 2);
            const float g = wh ? p.in[I_NFG][l * DM + c] : p.in[I_NMG][l * DM + c];
            GS[i] = g * (1.f + MOD[((size_t)l * NMODV + v) * MODW + (wh ? 4 * DM : DM) + c]); }
    }
    {
        hf* XS = (hf*)p.out; hf* X16 = (hf*)(p.ws + WS_X16); float* ss = (float*)(p.ws + WS_SS) + (size_t)SS_1 * MTOT * 4;
        f32x4 g[4];
#pragma unroll
        for (int j = 0; j < 4; ++j) g[j] = *(const f32x4*)(p.in[I_NMG] + 4 * lane + 256 * j);
        for (int row = gw; row < MTOT; row += NGW) {
            const bool lat = row < NLAT; const float* xr = lat ? p.in[I_X] + (size_t)row * DM : p.in[I_CTX] + (size_t)(row - NLAT) * DM;
            const int v = lat ? (row >> 11) : NB; const float* mv = MOD + (size_t)v * MODW + DM;
            float sq = 0.f; hf* hr = XS + (size_t)row * DM; hf* xh = X16 + (size_t)row * DM;
#pragma unroll
            for (int j = 0; j < 4; ++j) { const f32x4 x = *(const f32x4*)(xr + 4 * lane + 256 * j); const f32x4 sc = *(const f32x4*)(mv + 4 * lane + 256 * j);
                sq += (x[0] * x[0] + x[1] * x[1]) + (x[2] * x[2] + x[3] * x[3]);
                const f32x4 o = x * (g[j] * (sc + 1.f)); u32x2 w; w.x = pkhb(o[0], o[1]); w.y = pkhb(o[2], o[3]); *(u32x2*)(hr + 4 * lane + 256 * j) = w;
                u32x2 w2; w2.x = pkh(x[0], x[1]); w2.y = pkh(x[2], x[3]); *(u32x2*)(xh + 4 * lane + 256 * j) = w2; }
            sq = wave_sum(sq);
            if (lane == 0) *(f32x4*)(ss + 4 * (size_t)row) = (f32x4){sq, 0.f, 0.f, 0.f};
        }
    }
}

__device__ __forceinline__ void norm_phase(const Frame& F, const float* xs_lat, const float* xs_ctx, int nrows, const float* gain, const float* modl, int sh_off, int sc_off, hf* H) {
    const int gw = F.vcu * 8 + F.wave, NGW = F.G * 8, lane = F.lane;
    f32x4 g[4];
#pragma unroll
    for (int j = 0; j < 4; ++j) g[j] = *(const f32x4*)(gain + 4 * lane + 256 * j);
    for (int row = gw; row < nrows; row += NGW) {
        const bool lat = row < NLAT; const float* xr = lat ? xs_lat + (size_t)row * DM : xs_ctx + (size_t)(row - NLAT) * DM;
        const int v = lat ? (row >> 11) : NB; const float* mv = modl + (size_t)v * MODW;
        f32x4 x[4]; float ss = 0.f;
#pragma unroll
        for (int j = 0; j < 4; ++j) { x[j] = *(const f32x4*)(xr + 4 * lane + 256 * j); ss += (x[j][0] * x[j][0] + x[j][1] * x[j][1]) + (x[j][2] * x[j][2] + x[j][3] * x[j][3]); }
        const float rstd = rsqrtf(wave_sum(ss) * (1.f / DM) + EPS);
        hf* hr = H + (size_t)row * DM;
#pragma unroll
        for (int j = 0; j < 4; ++j) { const f32x4 sh = *(const f32x4*)(mv + sh_off + 4 * lane + 256 * j), sc = *(const f32x4*)(mv + sc_off + 4 * lane + 256 * j);
            const f32x4 y = (x[j] * rstd) * g[j]; const f32x4 o = y * (sc + 1.f) + sh;
            u32x2 w; w.x = pkh(o[0], o[1]); w.y = pkh(o[2], o[3]); *(u32x2*)(hr + 4 * lane + 256 * j) = w; }
    }
}
__device__ __forceinline__ void final_norm_phase(const Frame& F, const hf* X16, float* out, const float* gain, const float* ss) {
    const int gw = F.vcu * 8 + F.wave, NGW = F.G * 8, lane = F.lane;
    f32x4 g[4];
#pragma unroll
    for (int j = 0; j < 4; ++j) g[j] = *(const f32x4*)(gain + 4 * lane + 256 * j);
    for (int row = gw; row < NLAT; row += NGW) {
        const hf* xr = X16 + (size_t)row * DM; float* orow = out + (size_t)row * DM; const float rstd = rstd4(ss, row);
#pragma unroll
        for (int j = 0; j < 4; ++j) { const hf4 xh = *(const hf4*)(xr + 4 * lane + 256 * j); const f32x4 x = {(float)xh[0], (float)xh[1], (float)xh[2], (float)xh[3]};
            *(f32x4*)(orow + 4 * lane + 256 * j) = (x * rstd) * g[j]; }
    }
}

__device__ __forceinline__ void prep_rope(const Frame& F, const Params& p) {
    const int gw = F.vcu * 8 + F.wave, NGW = F.G * 8, lane = F.lane;
    hf* KR = (hf*)(p.ws + A_KR); hf* DK = (hf*)(p.ws + A_DK); const float* rope = (const float*)(p.ws + WS_ROPE);
    const int hh = lane >> 3, i0 = 2 * (lane & 7);
    for (int row0 = gw * 4; row0 < NLAT; row0 += NGW * 4) {
        hf2 a[4], b[4]; f32x2 c[4], sn[4]; float y1[4], y2[4], cc[4], ss[4];
#pragma unroll
        for (int q = 0; q < 4; ++q) { const int row = row0 + q, t = row & (SEQ - 1); const hf* dk = DK + (size_t)row * 256 + hh * 32 + i0;
            a[q] = *(const hf2*)dk; b[q] = *(const hf2*)(dk + 16); c[q] = *(const f32x2*)(rope + t * 32 + i0); sn[q] = *(const f32x2*)(rope + t * 32 + 16 + i0);
            if (lane < 16) { const hf* kr = KR + (size_t)row * 32 + lane; y1[q] = (float)kr[0]; y2[q] = (float)kr[16]; cc[q] = rope[t * 32 + lane]; ss[q] = rope[t * 32 + 16 + lane]; } }
#pragma unroll
        for (int q = 0; q < 4; ++q) { const int row = row0 + q; hf* dk = DK + (size_t)row * 256 + hh * 32 + i0;
            const float x1[2] = {(float)a[q][0], (float)a[q][1]}, x2[2] = {(float)b[q][0], (float)b[q][1]};
            *(unsigned*)dk = pkh(x1[0] * c[q][0] - x2[0] * sn[q][0], x1[1] * c[q][1] - x2[1] * sn[q][1]);
            *(unsigned*)(dk + 16) = pkh(x2[0] * c[q][0] + x1[0] * sn[q][0], x2[1] * c[q][1] + x1[1] * sn[q][1]);
            if (lane < 16) { hf* kr = KR + (size_t)row * 32 + lane; kr[0] = (hf)(y1[q] * cc[q] - y2[q] * ss[q]); kr[16] = (hf)(y2[q] * cc[q] + y1[q] * ss[q]); } }
    }
}
__device__ __forceinline__ void prep_hyena(const Frame& F, const Params& p, int l, bool with_ctx) {
    constexpr int INP = 784;
    constexpr int OUTP = 33;
    constexpr int OFF_OU = 66 * INP, OFF_OX = OFF_OU + 128 * OUTP * 4;
    const hf* PHY = (const hf*)(p.ws + A_PHY);
    LAS unsigned char* lds = F.lds; const int tid = F.tid;
    const float* cw = p.in[I_HCW] + (size_t)l * 3 * 768; const float* cb = p.in[I_HCB] + (size_t)l * 768;
    constexpr int U_LAT = NB * (SEQ / 64) * 2, U_CTX = NB * (CTXL / 64) * 2;
    const int nunit = U_LAT + (with_ctx ? U_CTX : 0);
    for (int un = F.vcu; un < nunit; un += F.G) {
        const bool ctx = un >= U_LAT; int r = ctx ? un - U_LAT : un; const int L = ctx ? CTXL : SEQ, ntile = L / 64;
        const int ch = r & 1; r >>= 1; const int tt = r % ntile, b = r / ntile;
        const int t0 = tt * 64; const size_t rowbase = ctx ? (size_t)NLAT + (size_t)b * CTXL : (size_t)b * SEQ;
        hf* dU = (hf*)((unsigned char*)p.out + (ctx ? O_UTC : O_UT)); hf* dX = (hf*)((unsigned char*)p.out + (ctx ? O_X0TC : O_X0T));
        __syncthreads();
        {
            u32x4 tmp[7];
#pragma unroll
            for (int k = 0; k < 7; ++k) { const int i = tid + 512 * k, rr = i / 48, q = i % 48, seg = q >> 4, c16 = q & 15; const int t = t0 - 1 + rr;
                tmp[k] = (u32x4){0u, 0u, 0u, 0u};
                if (i < 66 * 48 && t >= 0 && t < L) tmp[k] = *(const u32x4*)(PHY + (rowbase + t) * 768 + seg * 256 + ch * 128 + c16 * 8); }
#pragma unroll
            for (int k = 0; k < 7; ++k) { const int i = tid + 512 * k, rr = i / 48, q = i % 48, seg = q >> 4, c16 = q & 15;
                if (i < 66 * 48) *(LAS u32x4*)(lds + rr * INP + seg * 256 + c16 * 16) = tmp[k]; }
        }
        __syncthreads();
        {
            const int c = tid & 127, tg = tid >> 7, cg = ch * 128 + c;
            const float a0 = cw[cg], a1 = cw[768 + cg], a2 = cw[1536 + cg], ab = cb[cg];
            const float b0 = cw[256 + cg], b1 = cw[768 + 256 + cg], b2 = cw[1536 + 256 + cg], bb = cb[256 + cg];
            const float v0 = cw[512 + cg], v1 = cw[768 + 512 + cg], v2 = cw[1536 + 512 + cg], vb = cb[512 + cg];
            const LAS hf* in = (const LAS hf*)(lds + (16 * tg) * INP) + c;
            float p0 = (float)in[0], p1 = (float)in[128], p2 = (float)in[256];
            float c0 = (float)in[INP / 2], c1 = (float)in[INP / 2 + 128], c2 = (float)in[INP / 2 + 256];
            LAS hf* ou = (LAS hf*)(lds + OFF_OU) + c * (OUTP * 2) + 16 * tg; LAS hf* ox = (LAS hf*)(lds + OFF_OX) + c * (OUTP * 2) + 16 * tg;
#pragma unroll
            for (int j = 0; j < 16; ++j) { const LAS hf* nx = in + (j + 2) * (INP / 2);
                const float n0 = (float)nx[0], n1 = (float)nx[128], n2 = (float)nx[256];
                const float x0 = a0 * p0 + a1 * c0 + a2 * n0 + ab, x1 = b0 * p1 + b1 * c1 + b2 * n1 + bb, vv = v0 * p2 + v1 * c2 + v2 * n2 + vb;
                ou[j] = (hf)(vv * x1); ox[j] = (hf)x0;
                p0 = c0; p1 = c1; p2 = c2; c0 = n0; c1 = n1; c2 = n2; }
        }
        __syncthreads();
        {
            const int c = tid >> 2, q = tid & 3; const size_t go = ((size_t)(ch * 128 + c) * NB + b) * L + t0 + 16 * q;
            const LAS unsigned* su = (const LAS unsigned*)(lds + OFF_OU) + c * OUTP + 8 * q; const LAS unsigned* sx = (const LAS unsigned*)(lds + OFF_OX) + c * OUTP + 8 * q;
            u32x4 w0 = {su[0], su[1], su[2], su[3]}, w1 = {su[4], su[5], su[6], su[7]};
            *(u32x4*)(dU + go) = w0; *(u32x4*)(dU + go + 8) = w1;
            u32x4 y0 = {sx[0], sx[1], sx[2], sx[3]}, y1 = {sx[4], sx[5], sx[6], sx[7]};
            *(u32x4*)(dX + go) = y0; *(u32x4*)(dX + go + 8) = y1;
        }
    }
    __syncthreads();
}

namespace att {
#ifndef PROF_SEL
#define PROF_SEL -1
#endif
#define ATT_MARK(b) do { if (PROF_SEL >= 0 && F.tid == 0) { volatile LAS unsigned* _pf = (volatile LAS unsigned*)(F.lds + LDS_BYTES - 512); const unsigned _t = (unsigned)__builtin_amdgcn_s_memrealtime(); _pf[(b)] += _t - _pf[32]; _pf[32] = _t; } } while (0)
__device__ __forceinline__ int crow(int r, int hi) { return (r & 3) + 8 * (r >> 2) + 4 * hi; }
#define SBAR() __builtin_amdgcn_sched_barrier(0)
constexpr float THR2 = 8.f * 1.4426950408889634f;
constexpr int KS_MLA = 208, KS_DF = 80;
constexpr int VS = 192, VB = 64 * VS;
constexpr int OFF_V = 32768;
template <int OFF> __device__ __forceinline__ s16x4 tr_read(int vb) {
    s16x4 r; asm volatile("ds_read_b64_tr_b16 %0, %1 offset:%2" : "=&v"(r) : "v"(vb), "i"(OFF) : "memory"); return r;
}
__device__ __forceinline__ int kpos(int key) { return (key & ~0xC) | ((key & 4) << 1) | ((key & 8) >> 1); }

template <int ND0, int KS>
__device__ __forceinline__ void qkt(f32x16& p0, f32x16& p1, const LAS unsigned char* Ks, const hf8* qr, int r32, int hi) {
    p0 = f32x16{}; p1 = f32x16{};
#pragma unroll
    for (int d0 = 0; d0 < ND0; ++d0) { const int cb = (d0 * 16 + hi * 8) * 2;
        const hf8 b0 = *(const LAS hf8*)(Ks + r32 * KS + cb), b1 = *(const LAS hf8*)(Ks + (32 + r32) * KS + cb);
        p0 = __builtin_amdgcn_mfma_f32_32x32x16_f16(b0, qr[d0], p0, 0, 0, 0); p1 = __builtin_amdgcn_mfma_f32_32x32x16_f16(b1, qr[d0], p1, 0, 0, 0); }
}
__device__ __forceinline__ float max3f(float a, float b, float c) { float r; asm("v_max3_f32 %0, %1, %2, %3" : "=v"(r) : "v"(a), "v"(b), "v"(c)); return r; }
__device__ __forceinline__ float max2f(float a, float b) { float r; asm("v_max_f32_e32 %0, %1, %2" : "=v"(r) : "v"(a), "v"(b)); return r; }
__device__ __forceinline__ float max16(const f32x16& p) { float r, t;
    asm("v_max3_f32 %0, %2, %3, %4\n\tv_max3_f32 %1, %10, %11, %12\n\tv_max3_f32 %0, %0, %5, %6\n\tv_max3_f32 %1, %1, %13, %14\n\tv_max3_f32 %0, %0, %7, %8\n\tv_max3_f32 %1, %1, %15, %16\n\tv_max3_f32 %0, %0, %9, %17\n\tv_max_f32_e32 %0, %0, %1"
        : "=&v"(r), "=&v"(t) : "v"(p[0]), "v"(p[1]), "v"(p[2]), "v"(p[3]), "v"(p[4]), "v"(p[5]), "v"(p[6]), "v"(p[7]), "v"(p[8]), "v"(p[9]), "v"(p[10]), "v"(p[11]), "v"(p[12]), "v"(p[13]), "v"(p[14]), "v"(p[15]));
    return r; }
__device__ __forceinline__ hf8 pack8(const f32x16& p, int b) { u32x4 w = {pkh(p[b], p[b + 1]), pkh(p[b + 2], p[b + 3]), pkh(p[b + 4], p[b + 5]), pkh(p[b + 6], p[b + 7])}; return __builtin_bit_cast(hf8, w); }
__device__ __forceinline__ void sm_max(const f32x16& p0, const f32x16& p1, float& m, float& l, f32x16& o0, f32x16& o1, const bool first) {
    float pmax = max2f(max16(p0), max16(p1));
    { auto rr = __builtin_amdgcn_permlane32_swap(__float_as_uint(pmax), __float_as_uint(pmax), false, false);
      pmax = max2f(__uint_as_float(rr[0]), __uint_as_float(rr[1])); }
    if (first || __any(pmax - m > THR2)) {
        const float mn = first ? pmax : max2f(m, pmax);
        if (!first) { const float alpha = __builtin_amdgcn_exp2f(m - mn); l *= alpha;
#pragma unroll
            for (int r = 0; r < 16; ++r) { o0[r] *= alpha; o1[r] *= alpha; } }
        m = mn;
    }
}
__device__ __forceinline__ void sm_exp(f32x16& p0, f32x16& p1, const float m, float& l, hf8& pf0, hf8& pf1, hf8& pf2, hf8& pf3) {
#pragma unroll
    for (int r = 0; r < 16; ++r) { p0[r] -= m; p1[r] -= m; }
#pragma unroll
    for (int r = 0; r < 16; ++r) { p0[r] = __builtin_amdgcn_exp2f(p0[r]); p1[r] = __builtin_amdgcn_exp2f(p1[r]); }
    float ps0 = p0[0] + p1[0], ps1 = p0[1] + p1[1], ps2 = p0[2] + p1[2], ps3 = p0[3] + p1[3];
#pragma unroll
    for (int r = 4; r < 16; r += 4) { ps0 += p0[r] + p1[r]; ps1 += p0[r + 1] + p1[r + 1]; ps2 += p0[r + 2] + p1[r + 2]; ps3 += p0[r + 3] + p1[r + 3]; }
    l += (ps0 + ps1) + (ps2 + ps3);
    pf0 = pack8(p0, 0); pf1 = pack8(p0, 8); pf2 = pack8(p1, 0); pf3 = pack8(p1, 8);
}
__device__ __forceinline__ void pv(const hf8 pf0, const hf8 pf1, const hf8 pf2, const hf8 pf3, f32x16& o0, f32x16& o1, const LAS unsigned char* Vt, int r32, int hi) {
    const int lg = (int)(threadIdx.x & 15), vq = lg >> 2, vp4 = lg & 3;
    const int vbase = (int)(unsigned)(uintptr_t)Vt + (4 * hi + vq) * VS + (16 * ((int)(threadIdx.x >> 4) & 1) + 4 * vp4) * 2;
#define PVRD(ks, L0, H0, L1, H1) s16x4 L0 = tr_read<(16 * (ks)) * VS>(vbase), H0 = tr_read<(16 * (ks) + 8) * VS>(vbase), L1 = tr_read<(16 * (ks)) * VS + 64>(vbase), H1 = tr_read<(16 * (ks) + 8) * VS + 64>(vbase)
#define PVMM(N, L0, H0, L1, H1, pf) do { asm volatile("s_waitcnt lgkmcnt(" #N ")" : "+v"(L0), "+v"(H0), "+v"(L1), "+v"(H1) :: "memory"); \
        const hf8 a0 = __builtin_bit_cast(hf8, (short __attribute__((ext_vector_type(8)))){L0[0], L0[1], L0[2], L0[3], H0[0], H0[1], H0[2], H0[3]}); \
        const hf8 a1 = __builtin_bit_cast(hf8, (short __attribute__((ext_vector_type(8)))){L1[0], L1[1], L1[2], L1[3], H1[0], H1[1], H1[2], H1[3]}); \
        o0 = __builtin_amdgcn_mfma_f32_32x32x16_f16(a0, pf, o0, 0, 0, 0); o1 = __builtin_amdgcn_mfma_f32_32x32x16_f16(a1, pf, o1, 0, 0, 0); } while (0)
    PVRD(0, a0l, a0h, a1l, a1h); PVRD(1, b0l, b0h, b1l, b1h);
    PVMM(4, a0l, a0h, a1l, a1h, pf0);
    PVRD(2, c0l, c0h, c1l, c1h);
    PVMM(4, b0l, b0h, b1l, b1h, pf1);
    PVRD(3, d0l, d0h, d1l, d1h);
    PVMM(4, c0l, c0h, c1l, c1h, pf2);
    PVMM(0, d0l, d0h, d1l, d1h, pf3);
#undef PVRD
#undef PVMM
#define PVK(ks, pf)
#undef PVK
}

template <bool MLA>
__device__ __forceinline__ void attn_pass(const Frame& F, const Params& p, int hq, int hv, int qrow0, int qpos0, int klat0, int nlat, int kctx0, f32x16& o0, f32x16& o1, float& inv) {
    constexpr int DK = MLA ? 96 : 32, ND0 = DK / 16, KS = MLA ? KS_MLA : KS_DF, KB = 64 * KS;
    constexpr float SCALE = MLA ? MLA_SCALE : DF_SCALE, C = SCALE * 1.4426950408889634f;
    const int tid = F.tid, wid = F.wave, lane = F.lane, r32 = lane & 31, hi = lane >> 5;
    const hf* QKV = (const hf*)(p.ws + A_QKV); const hf* KRb = (const hf*)(p.ws + A_KR);
    const hf* DQ = (const hf*)(p.ws + A_DQ); const hf* DKb = (const hf*)(p.ws + A_DK); const hf* DVb = (const hf*)(p.ws + A_DV);
    const float* rope = (const float*)(p.ws + WS_ROPE);
    LAS unsigned char* lds = F.lds;
    hf8 qr[ND0];
    {
        const int qrow = qrow0 + wid * 32 + r32;
        const hf* qp = MLA ? QKV + (size_t)qrow * NUP + hq * 96 + hi * 8 : DQ + (size_t)qrow * 256 + hq * 32 + hi * 8;
        hf8 raw[ND0];
#pragma unroll
        for (int d0 = 0; d0 < ND0; ++d0) raw[d0] = *(const hf8*)(qp + d0 * 16);
        f32x4 c0 = {1.f, 1.f, 1.f, 1.f}, c1 = c0, s0 = {0.f, 0.f, 0.f, 0.f}, s1 = s0;
        if (qpos0 >= 0) { const int t = qpos0 + wid * 32 + r32;
            c0 = *(const f32x4*)(rope + t * 32 + hi * 8); c1 = *(const f32x4*)(rope + t * 32 + hi * 8 + 4);
            s0 = *(const f32x4*)(rope + t * 32 + 16 + hi * 8); s1 = *(const f32x4*)(rope + t * 32 + 16 + hi * 8 + 4); }
#pragma unroll
        for (int d0 = 0; d0 < ND0 - 2; ++d0) {
#pragma unroll
            for (int j = 0; j < 8; ++j) qr[d0][j] = (hf)((float)raw[d0][j] * C); }
#pragma unroll
        for (int j = 0; j < 8; ++j) { const float cc = j < 4 ? c0[j & 3] : c1[j & 3], sn = j < 4 ? s0[j & 3] : s1[j & 3]; const float a = (float)raw[ND0 - 2][j], b = (float)raw[ND0 - 1][j];
            qr[ND0 - 2][j] = (hf)((a * cc - b * sn) * C); qr[ND0 - 1][j] = (hf)((b * cc + a * sn) * C); }
    }
    const int k1r = MLA ? (tid >> 3) : ((tid & 255) >> 2), k1c = MLA ? (tid & 7) * 8 : (tid & 3) * 8;
    const int k2r = (tid & 255) >> 2, k2c = (tid & 3) * 8;
    const int vr_ = tid >> 3, vc_ = (tid & 7) * 8;
    const bool klo = tid < 256;
    struct Stg { u32x4 v, k1, k2; };
    Stg sA, sB; sA.v = sA.k1 = sA.k2 = sB.v = sB.k1 = sB.k2 = (u32x4){0u, 0u, 0u, 0u};
    const int ntile = nlat + 4;
#define KROW0(j) (((j) < nlat) ? klat0 + (j) * 64 : kctx0 + ((j) - nlat) * 64)
#define A_LOADK(S, j) do { const int kr0 = KROW0(j); \
        if (MLA) { S.k1 = *(const u32x4*)(QKV + (size_t)(kr0 + k1r) * NUP + 768 + hq * 128 + k1c); S.k2 = *(const u32x4*)(KRb + (size_t)(kr0 + k2r) * 32 + k2c); } \
        else S.k1 = *(const u32x4*)(DKb + (size_t)(kr0 + k1r) * 256 + hq * 32 + k1c); } while (0)
#define A_LOADV(S, j) do { const int kr0 = KROW0(j); \
        if (MLA) S.v = *(const u32x4*)(QKV + (size_t)(kr0 + vr_) * NUP + 768 + hv * 128 + 64 + vc_); else S.v = *(const u32x4*)(DVb + (size_t)(kr0 + vr_) * 256 + hv * 64 + vc_); } while (0)
#define A_WRITEK(S, b) do { *(LAS u32x4*)(lds + (b) * KB + k1r * KS + k1c * 2) = S.k1; if (MLA) *(LAS u32x4*)(lds + (b) * KB + k2r * KS + 128 + k2c * 2) = S.k2; } while (0)
#define A_WRITEV(S, b) do { *(LAS u32x4*)(lds + OFF_V + (b) * VB + vr_ * VS + vc_ * 2) = S.v; } while (0)
    float m_reg = 0.f, l_reg = 0.f;
    o0 = f32x16{}; o1 = f32x16{};
    f32x16 pA0, pA1, pB0, pB1;
    __syncthreads();
    const int nt1 = ntile - 1;
#define TCL(j) (((j) < nt1) ? (j) : nt1)
    A_LOADK(sA, 0); A_LOADV(sA, 0); A_LOADK(sB, 1);
    A_WRITEK(sA, 0); A_WRITEV(sA, 0); A_WRITEK(sB, 1);
    A_LOADK(sA, TCL(2));
    A_LOADV(sA, 1);
    __syncthreads();
    qkt<ND0, KS>(pA0, pA1, lds, qr, r32, hi);
    hf8 f0, f1, f2, f3;
    if (wid >= 4) __syncthreads();
    for (int j = 0; j < ntile; j += 2) {
        A_LOADK(sB, TCL(j + 3)); A_LOADV(sB, TCL(j + 2));
        sm_max(pA0, pA1, m_reg, l_reg, o0, o1, j == 0);
        sm_exp(pA0, pA1, m_reg, l_reg, f0, f1, f2, f3);
        __syncthreads();
        qkt<ND0, KS>(pB0, pB1, lds + KB, qr, r32, hi);
        pv(f0, f1, f2, f3, o0, o1, lds + OFF_V, r32, hi);
        A_WRITEK(sA, 0); A_WRITEV(sA, 1);
        __syncthreads();
        A_LOADK(sA, TCL(j + 4)); A_LOADV(sA, TCL(j + 3));
        sm_max(pB0, pB1, m_reg, l_reg, o0, o1, false);
        sm_exp(pB0, pB1, m_reg, l_reg, f0, f1, f2, f3);
        __syncthreads();
        qkt<ND0, KS>(pA0, pA1, lds, qr, r32, hi);
        pv(f0, f1, f2, f3, o0, o1, lds + OFF_V + VB, r32, hi);
        A_WRITEK(sB, 1); A_WRITEV(sB, 0);
        __syncthreads();
    }
    if (wid < 4) __syncthreads();
#undef TCL
#undef KROW0
#undef A_LOADK
#undef A_LOADV
#undef A_WRITEK
#undef A_WRITEV
    const float lt = l_reg + __shfl_xor(l_reg, 32); inv = __builtin_amdgcn_rcpf(lt);
}
template <bool MLA>
__device__ __forceinline__ void attn_unit(const Frame& F, const Params& p, int l, int h, int qrow0, int qpos0, int klat0, int nlat, int kctx0) {
    const int wid = F.wave, lane = F.lane, r32 = lane & 31, hi = lane >> 5;
    hf* Y = (hf*)(p.ws + A_Y);
    const size_t yrow = (size_t)(qrow0 + wid * 32 + r32) * DM;
    if constexpr (MLA) {
        f32x16 o0, o1; float inv;
        attn_pass<true>(F, p, h, h, qrow0, qpos0, klat0, nlat, kctx0, o0, o1, inv);
#pragma unroll
        for (int g = 0; g < 4; ++g) { u32x2 w; w.x = pkhb(o0[4 * g] * inv, o0[4 * g + 1] * inv); w.y = pkhb(o0[4 * g + 2] * inv, o0[4 * g + 3] * inv); *(u32x2*)(Y + yrow + h * 64 + 8 * g + 4 * hi) = w; }
#pragma unroll
        for (int g = 0; g < 4; ++g) { u32x2 w; w.x = pkhb(o1[4 * g] * inv, o1[4 * g + 1] * inv); w.y = pkhb(o1[4 * g + 2] * inv, o1[4 * g + 3] * inv); *(u32x2*)(Y + yrow + h * 64 + 32 + 8 * g + 4 * hi) = w; }
    } else {
        const float lam = ((const float*)(p.ws + WS_LAM))[2 * l], oml = ((const float*)(p.ws + WS_LAM))[2 * l + 1];
        f32x16 a0, a1;
        LAS float* park = (LAS float*)(F.lds + 65536 + wid * 8192) + lane;
        { f32x16 o0, o1; float inv; attn_pass<false>(F, p, 2 * h, h, qrow0, qpos0, klat0, nlat, kctx0, o0, o1, inv);
#pragma unroll
          for (int r = 0; r < 16; ++r) { park[r * 64] = o0[r] * inv; park[(16 + r) * 64] = o1[r] * inv; } }
        { f32x16 o0, o1; float inv; attn_pass<false>(F, p, 2 * h + 1, h, qrow0, qpos0, klat0, nlat, kctx0, o0, o1, inv);
#pragma unroll
          for (int r = 0; r < 16; ++r) { a0[r] = park[r * 64] - o0[r] * (lam * inv); a1[r] = park[(16 + r) * 64] - o1[r] * (lam * inv); } }
        float ss = 0.f;
#pragma unroll
        for (int r = 0; r < 16; ++r) ss += a0[r] * a0[r] + a1[r] * a1[r];
        ss += __shfl_xor(ss, 32);
        const float rs = rsqrtf(ss * (1.f / 64.f) + EPS) * oml;
#pragma unroll
        for (int g = 0; g < 4; ++g) { const f32x4 gg = *(const f32x4*)(p.in[I_SUBG] + l * 64 + 8 * g + 4 * hi);
            u32x2 w; w.x = pkhb(a0[4 * g] * rs * gg[0], a0[4 * g + 1] * rs * gg[1]); w.y = pkhb(a0[4 * g + 2] * rs * gg[2], a0[4 * g + 3] * rs * gg[3]); *(u32x2*)(Y + yrow + 768 + h * 64 + 8 * g + 4 * hi) = w; }
#pragma unroll
        for (int g = 0; g < 4; ++g) { const f32x4 gg = *(const f32x4*)(p.in[I_SUBG] + l * 64 + 32 + 8 * g + 4 * hi);
            u32x2 w; w.x = pkhb(a1[4 * g] * rs * gg[0], a1[4 * g + 1] * rs * gg[1]); w.y = pkhb(a1[4 * g + 2] * rs * gg[2], a1[4 * g + 3] * rs * gg[3]); *(u32x2*)(Y + yrow + 768 + h * 64 + 32 + 8 * g + 4 * hi) = w; }
    }
}
}

#define HY_MARK(b) do { if (PROF_SEL >= 0 && F.tid == 0) { volatile LAS unsigned* _pf = (volatile LAS unsigned*)(F.lds + LDS_BYTES - 512); const unsigned _t = (unsigned)__builtin_amdgcn_s_memrealtime(); _pf[(b)] += _t - _pf[32]; _pf[32] = _t; } } while (0)
template <int L>
__device__ __forceinline__ void hyena_unit(const Frame& F, const hf* Rrow  , const hf* U  , const hf* X0  , hf* Ycol  ) {
    constexpr int NM = L / 256, RL = 2 * L, SH = (L > 1024) ? 1024 : L, NH = L / SH, US = SH * 2 + 16;
    constexpr int OFF_U = 8 * RL * 2;
    constexpr int XP = L * 2 + 16;
    static_assert(OFF_U + 32 * US <= LDS_MISC && 32 * XP <= LDS_MISC, "hyena LDS");
    const int tid = F.tid, w = F.wave, lane = F.lane, i32 = lane & 31, hi = lane >> 5;
    LAS unsigned char* lds = F.lds;
    __syncthreads();
    for (int i = tid; i < RL / 8; i += 512) *(LAS u32x4*)(lds + i * 16) = *(const u32x4*)(Rrow + i * 8);
    __syncthreads();
    {
        const LAS unsigned* src = (const LAS unsigned*)lds;
#pragma unroll 1
        for (int idx = tid; idx < 7 * (RL / 8); idx += 512) { const int cw = 1 + idx / (RL / 8), c4 = (idx % (RL / 8)) * 4;
            const int k0 = c4 - ((cw + 1) >> 1); unsigned d[5];
#pragma unroll
            for (int e = 0; e < 5; ++e) { const int k = k0 + e; d[e] = (k >= 0 && k < RL / 2) ? src[k] : 0u; }
            u32x4 o;
            if (cw & 1) { o.x = (d[0] >> 16) | (d[1] << 16); o.y = (d[1] >> 16) | (d[2] << 16); o.z = (d[2] >> 16) | (d[3] << 16); o.w = (d[3] >> 16) | (d[4] << 16); }
            else { o.x = d[0]; o.y = d[1]; o.z = d[2]; o.w = d[3]; }
            *(LAS u32x4*)(lds + cw * (RL * 2) + c4 * 4) = o; }
    }
    HY_MARK(22);
    f32x16 acc[NM];
#pragma unroll
    for (int m = 0; m < NM; ++m) acc[m] = f32x16{};
    const LAS unsigned char* cpy = lds + w * (RL * 2);
    for (int half = 0; half < NH; ++half) {
        __syncthreads();
        {
            constexpr int NPC = 32 * (SH / 8) / 512, NB4 = NPC > 4 ? 4 : NPC;
            int tq = tid; asm volatile("" : "+v"(tq));
#pragma unroll
            for (int k0 = 0; k0 < NPC; k0 += NB4) { u32x4 tmp[NB4];
#pragma unroll
                for (int k = 0; k < NB4; ++k) { const int idx = tq + 512 * (k0 + k), b = idx / (SH / 8), pc = idx % (SH / 8); tmp[k] = *(const u32x4*)(U + (size_t)b * L + half * SH + pc * 8); }
#pragma unroll
                for (int k = 0; k < NB4; ++k) { const int idx = tq + 512 * (k0 + k), b = idx / (SH / 8), pc = idx % (SH / 8); *(LAS u32x4*)(lds + OFF_U + b * US + pc * 16) = tmp[k]; }
                asm volatile("" ::: "memory"); }
        }
        __syncthreads();
#pragma unroll 2
        for (int jl = 0; jl < SH / 16; ++jl) {
            const int j = half * (SH / 16) + jl;
            const hf8 bf = *(const LAS hf8*)(lds + OFF_U + i32 * US + (jl * 16 + hi * 8) * 2);
            const int x0 = L + 16 * j + 8 * hi - 8 * i32;
#pragma unroll
            for (int m = 0; m < NM; ++m) { const hf8 af = *(const LAS hf8*)(cpy + (x0 - 256 * m) * 2);
                acc[m] = __builtin_amdgcn_mfma_f32_32x32x16_f16(af, bf, acc[m], 0, 0, 0); }
        }
    }
    __syncthreads();
    HY_MARK(23);
    {
        constexpr int NPC = 32 * (L / 8) / 512, NB8 = NPC > 4 ? 4 : NPC;
        int tq = tid; asm volatile("" : "+v"(tq));
#pragma unroll
        for (int k0 = 0; k0 < NPC; k0 += NB8) { u32x4 tmp[NB8];
#pragma unroll
            for (int k = 0; k < NB8; ++k) { const int idx = tq + 512 * (k0 + k), b = idx / (L / 8), pc = idx % (L / 8); tmp[k] = *(const u32x4*)(X0 + (size_t)b * L + pc * 8); }
#pragma unroll
            for (int k = 0; k < NB8; ++k) { const int idx = tq + 512 * (k0 + k), b = idx / (L / 8), pc = idx % (L / 8); *(LAS u32x4*)(lds + b * XP + pc * 16) = tmp[k]; }
            asm volatile("" ::: "memory"); }
    }
    __syncthreads();
    HY_MARK(24);
    const LAS hf* x0p = (const LAS hf*)(lds + i32 * XP) + w + 32 * hi;
    hf* yp = Ycol + ((size_t)i32 * L + w + 32 * hi) * DM;
#pragma unroll
    for (int m = 0; m < NM; ++m) {
#pragma unroll
        for (int r = 0; r < 16; ++r) { const int tt = 256 * m + 8 * ((r & 3) + 8 * (r >> 2));
            const float x0v = (float)x0p[tt];
            { const float yv = x0v * acc[m][r]; unsigned ub = __float_as_uint(yv); ub += 0x7fffu + ((ub >> 16) & 1u); yp[(size_t)tt * DM] = (hf)__uint_as_float(ub & 0xffff0000u); } }
        asm volatile("" ::: "memory");
    }
    HY_MARK(25);
}

#ifndef PH_MASK
#define PH_MASK 0x1FFFF
#endif
#define PHM(k) ((PH_MASK >> (k)) & 1)
#ifndef PROBE_REP
#define PROBE_REP 0
#endif
#define NREP(k) (((PROBE_REP >> (k)) & 1) ? 2 : 1)
constexpr int NPH_LAYER = 7, PH_L0 = 2, NPHASE = PH_L0 + DEPTH * NPH_LAYER + 1;
__global__ void __launch_bounds__(512, 2) fwd_kernel(Params p) {
    extern __shared__ __attribute__((aligned(16))) unsigned char lds_raw[];
    Frame F0; Frame& F = F0;
    F.lds = (LAS unsigned char*)lds_raw;
    F.tid = threadIdx.x; F.lane = F.tid & 63; F.wave = __builtin_amdgcn_readfirstlane(F.tid >> 6);
    F.G = gridDim.x; { const int bx = blockIdx.x; F.vcu = (F.G % 8 == 0) ? (bx % 8) * (F.G / 8) + bx / 8 : bx; }
    volatile LAS unsigned* misc = (volatile LAS unsigned*)(F.lds + LDS_MISC);
    if (F.tid < 16) misc[F.tid] = 0u;
    __syncthreads();
    const int lo = p.ph_lo, hi = p.ph_hi;
    XcdBarrier bar; bar.bar = (unsigned*)(p.ws + WS_BAR); bar.x = 0; bar.st = misc;
    if (hi - lo > 1) bar = xcd_barrier_post((unsigned*)(p.ws + WS_BAR), misc);
#define IN(k) (lo <= (k) && (k) < hi)
#define LAUNDER(Fl) Frame Fl = F0; asm volatile("" : "+v"(Fl.tid), "+v"(Fl.lane))
#ifndef PROF_SEL
#define PROF_SEL -1
#endif
#define PROF_K 8
    volatile LAS unsigned* prof = (volatile LAS unsigned*)(F.lds + LDS_BYTES - 512);
    if (PROF_SEL >= 0 && F.tid < 40) prof[F.tid] = 0u;
    if (PROF_SEL >= 0) __syncthreads();
    if (PROF_SEL >= 0 && F.tid == 0) prof[32] = (unsigned)__builtin_amdgcn_s_memrealtime();
#define PROF_MARK(b) do { if (PROF_SEL >= 0 && F.tid == 0) { const unsigned _t = (unsigned)__builtin_amdgcn_s_memrealtime(); prof[(b)] += _t - prof[32]; if ((b) >= 16) prof[30] += _t - prof[32]; prof[32] = _t; } } while (0)
#define SEAMT(k, b) do { PROF_MARK(b); if (IN(k) && IN((k) + 1)) xcd_barrier(bar); PROF_MARK(16 + (b)); } while (0)
#define SEAM(k) do { if (IN(k) && IN((k) + 1)) xcd_barrier(bar); } while (0)
    unsigned char* ws = p.ws;
    hf* X16 = (hf*)(ws + WS_X16);
    hf* XS1 = (hf*)p.out; hf* MM = (hf*)p.out; hf* Y = (hf*)(ws + A_B); hf* XS2 = (hf*)(ws + A_B);
    hf* QKV = (hf*)(ws + A_QKV); hf* QKVN = (hf*)(ws + A_QKVN);
    unsigned char* Gt = (unsigned char*)(ws + A_G); hf* HID = (hf*)(ws + A_HID);
    float* SS = (float*)(ws + WS_SS);

    if (PHM(11) && IN(0)) for (int rep = 0; rep < NREP(11); ++rep) { LAUNDER(Fl); prologue_a(Fl, p); }
    SEAMT(0, 9);
    if (PHM(11) && IN(1)) for (int rep = 0; rep < NREP(12); ++rep) { LAUNDER(Fl); prologue_b(Fl, p); }
    SEAMT(1, 9);

    for (int l = 0; l < DEPTH; ++l) {
        const int pb = PH_L0 + l * NPH_LAYER;
        const bool ctx_live = l < DEPTH - 1;
        const int Mrows = ctx_live ? MTOT : NLAT;
        const float* modl = (const float*)(ws + WS_MOD) + (size_t)l * NMODV * MODW;
        const float* biasl = (const float*)(ws + WS_BIAS) + (size_t)l * NMODV * NBIAS;
        const float* gsl = (const float*)(ws + WS_GS) + (size_t)l * 2 * NMODV * DM;
        const unsigned char* wl = ws + WS_WT + (size_t)(l & 1) * W_LAYER;
        float* ss1 = SS + (size_t)(SS_1 + l) * MTOT * 4; float* ss2 = SS + (size_t)(SS_2 + l) * MTOT * 4;
        float* ssq = (float*)(ws + WS_SSQ) + (size_t)l * MTOT; float* sskv = (float*)(ws + WS_SSKV) + (size_t)l * MTOT;
        LAS unsigned char* lx = F.lds + LDS_EXCH;

        if (PHM(1) && IN(pb + 0)) { pg8::Gemm g{XS1, (const hf*)(wl + W_IN1), MTOT, NP1, DM, DM, DM}; pg8::StaticOrder S; S.init(MTOT, NP1, F.G, (int)blockIdx.x);
            pg8::EpiIn E{QKVN, (hf*)(ws + A_KR), (hf*)(ws + A_PHY), (hf*)(ws + A_DQ), (hf*)(ws + A_DK), (hf*)(ws + A_DV), ss1, biasl + B_IN, ssq, sskv, lx};
            pg8::gemm_phase(F.lds, g, S, E); }
        SEAMT(pb + 0, 0);
        if (PHM(2) && IN(pb + 1)) {
            { LAUNDER(Fl); prep_rope(Fl, p); prep_hyena(Fl, p, l, ctx_live); }
            __syncthreads();
            PROF_MARK(1);
            { pg8::Gemm g{QKVN, (const hf*)(wl + W_UP), MTOT, NUP, KUP, KUP, KUP}; pg8::StaticOrder S; S.init(MTOT, NUP, F.G, (int)blockIdx.x);
              pg8::EpiUp E{QKV, ssq, sskv}; pg8::gemm_phase(F.lds, g, S, E); }
        }
        SEAMT(pb + 1, 2);
        if (PHM(4) && IN(pb + 2)) {
            {
            LAUNDER(Fl);
            PROF_MARK(14);
            const int n_mla = 2048 + (ctx_live ? 256 : 0);
            for (int id = F.vcu; id < n_mla; id += F.G) {
                if (id < 2048) { const int qb = id & 7, h = (id >> 3) & 7, b = id >> 6; att::attn_unit<true>(Fl, p, l, h, b * SEQ + qb * 256, qb * 256, b * SEQ, 32, NLAT + b * CTXL); }
                else { const int i2 = id - 2048, h = i2 & 7, b = i2 >> 3; att::attn_unit<true>(Fl, p, l, h, NLAT + b * CTXL, -1, 0, 0, NLAT + b * CTXL); }
            }
            PROF_MARK(11);
            const int n_df = 1024 + (ctx_live ? 128 : 0);
            for (int id = F.vcu; id < n_df; id += F.G) {
                if (id < 1024) { const int qb = id & 7, h = (id >> 3) & 3, b = id >> 5; att::attn_unit<false>(Fl, p, l, h, b * SEQ + qb * 256, qb * 256, b * SEQ, 32, NLAT + b * CTXL); }
                else { const int i2 = id - 1024, h = i2 & 3, b = i2 >> 2; att::attn_unit<false>(Fl, p, l, h, NLAT + b * CTXL, -1, 0, 0, NLAT + b * CTXL); }
            }
            PROF_MARK(12);
            const unsigned char* ob = (const unsigned char*)p.out;
            for (int c = F.vcu; c < 256; c += F.G)
                hyena_unit<SEQ>(Fl, (const hf*)(ws + WS_RF) + ((size_t)l * 256 + c) * 4096, (const hf*)(ob + O_UT) + (size_t)c * NLAT, (const hf*)(ob + O_X0T) + (size_t)c * NLAT, Y + 512 + c);
            if (ctx_live) for (int c = F.vcu; c < 256; c += F.G)
                hyena_unit<CTXL>(Fl, (const hf*)(ws + WS_RFC) + ((size_t)l * 256 + c) * 512, (const hf*)(ob + O_UTC) + (size_t)c * NCTX, (const hf*)(ob + O_X0TC) + (size_t)c * NCTX, Y + (size_t)NLAT * DM + 512 + c);
            __syncthreads();
            PROF_MARK(13);
            }
            { pg8::Gemm g{XS1, (const hf*)(wl + W_ING), Mrows, NGATE, DM, DM, DM}; pg8::StaticOrder S; S.init(Mrows, NGATE, F.G, (int)blockIdx.x);
              pg8::EpiGate8 E{Gt, ss1, biasl + B_G}; pg8::gemm_phase(F.lds, g, S, E); }
        }
        SEAMT(pb + 2, 4);
        if (PHM(6) && IN(pb + 3)) { pg8::Gemm g{Y, (const hf*)(wl + W_BR), Mrows, DM, DM, DM, DM}; pg8::StaticOrder S; S.init(Mrows, DM, F.G, (int)blockIdx.x);
            pg8::EpiMerge E{MM, Gt}; pg8::gemm_phase(F.lds, g, S, E); }
        SEAMT(pb + 3, 5);
        if (PHM(7) && IN(pb + 4)) { pg8::Gemm g{MM, (const hf*)(wl + W_OUT), Mrows, DM, DM, DM, DM}; pg8::StaticOrder S; S.init(Mrows, DM, F.G, (int)blockIdx.x);
            pg8::EpiResidX<true, true> E{X16, modl + 2 * DM, XS2, gsl + (size_t)NMODV * DM, ss2, lx}; pg8::gemm_phase(F.lds, g, S, E); }
        SEAMT(pb + 4, 6);
        if (PHM(9) && IN(pb + 5)) { pg8::Gemm g{XS2, (const hf*)(wl + W_FC1), Mrows, DFF, DM, DM, DM}; pg8::StaticOrder S; S.init(Mrows, DFF, F.G, (int)blockIdx.x);
            pg8::EpiHalf<2, true> E{HID, DFF, ss2, biasl + B_FC1}; pg8::gemm_phase(F.lds, g, S, E); }
        SEAMT(pb + 5, 7);
        if (PHM(10) && IN(pb + 6)) { pg8::Gemm g{HID, (const hf*)(wl + W_FC2), Mrows, DM, DFF, DFF, DFF}; pg8::StaticOrder S; S.init(Mrows, DM, F.G, (int)blockIdx.x);
            if (ctx_live) { pg8::EpiResidX<true, true> E{X16, modl + 5 * DM, XS1, gsl + (size_t)2 * NMODV * DM, ss1 + (size_t)MTOT * 4, lx}; pg8::gemm_phase(F.lds, g, S, E);
                const int nheavy = (MTOT / 256 * 4) % F.G;
                if (nheavy > 0 && (int)blockIdx.x >= nheavy) { __syncthreads(); LAUNDER(Fl); convert_layer(Fl, p, l + 1, ws + WS_WT + (size_t)((l + 1) & 1) * W_LAYER, (int)blockIdx.x - nheavy, F.G - nheavy); }
                else if (nheavy == 0) { __syncthreads(); LAUNDER(Fl); convert_layer(Fl, p, l + 1, ws + WS_WT + (size_t)((l + 1) & 1) * W_LAYER, Fl.vcu, F.G); } }
            else { pg8::EpiResidX<false, true> E{X16, modl + 5 * DM, nullptr, nullptr, SS + (size_t)SS_F * MTOT * 4, lx}; pg8::gemm_phase(F.lds, g, S, E); } }
        SEAMT(pb + 6, 8);
    }
    if (PHM(12) && IN(NPHASE - 1)) { LAUNDER(Fl); final_norm_phase(Fl, X16, p.out, p.in[I_FNG], SS + (size_t)SS_F * MTOT * 4); }
    PROF_MARK(10);
    if (PROF_SEL >= 0 && blockIdx.x == 0 && F.tid == 0) { const unsigned long long t0 = __builtin_amdgcn_s_memrealtime(); const unsigned long long d = (unsigned long long)PROF_K * prof[PROF_SEL];
        while (__builtin_amdgcn_s_memrealtime() - t0 < d) __builtin_amdgcn_s_sleep(8); }
#undef IN
#undef SEAM
}

extern "C" void kernel_launch(void* const* d_in, const int* in_sizes, int n_in, void* d_out, int out_size, void* d_ws, size_t ws_size, hipStream_t stream) {
    static int grid = 0;
    if (grid == 0) {
        if (n_in != 35 || in_sizes[0] != NLAT * DM || out_size != NLAT * DM || ws_size < WS_END) {
            fprintf(stderr, "kernel_launch: unexpected shapes: n_in %d in0 %d out %d ws %zu (need %zu); nothing launched\n", n_in, n_in > 0 ? in_sizes[0] : -1, out_size, ws_size, (size_t)WS_END); grid = -1; return; }
        int dev = 0, cus = 0, per_cu = 0;
        if (hipGetDevice(&dev) != hipSuccess || hipDeviceGetAttribute(&cus, hipDeviceAttributeMultiprocessorCount, dev) != hipSuccess) { fprintf(stderr, "kernel_launch: device query failed\n"); grid = -1; return; }
        if (hipFuncSetAttribute((const void*)fwd_kernel, hipFuncAttributeMaxDynamicSharedMemorySize, LDS_BYTES) != hipSuccess) { fprintf(stderr, "kernel_launch: hipFuncSetAttribute failed\n"); grid = -1; return; }
        if (hipOccupancyMaxActiveBlocksPerMultiprocessor(&per_cu, (const void*)fwd_kernel, 512, LDS_BYTES) != hipSuccess || per_cu < 1)
            fprintf(stderr, "kernel_launch: note: occupancy query reports %d workgroups per CU\n", per_cu);
        (void)hipGetLastError();
        grid = cus;
    }
    if (grid < 0) return;
    if (hipMemsetAsync((char*)d_ws + WS_BAR, 0, WS_ZERO_BYTES, stream) != hipSuccess) { fprintf(stderr, "kernel_launch: memset failed\n"); return; }
    Params P{};
    for (int i = 0; i < 35; ++i) P.in[i] = (const float*)d_in[i];
    P.out = (float*)d_out; P.ws = (unsigned char*)d_ws;
#if MK_FUSED
    P.ph_lo = 0; P.ph_hi = NPHASE;
    hipLaunchKernelGGL(fwd_kernel, dim3(grid), dim3(512), LDS_BYTES, stream, P);
#else
    for (int ph = 0; ph < NPHASE; ++ph) { P.ph_lo = ph; P.ph_hi = ph + 1; hipLaunchKernelGGL(fwd_kernel, dim3(grid), dim3(512), LDS_BYTES, stream, P); }
#endif
    const hipError_t le = hipPeekAtLastError();
    if (le != hipSuccess) fprintf(stderr, "kernel_launch: launch failed: %s\n", hipGetErrorName(le));
}
```

```cpp
#include <hip/hip_runtime.h>
#include <cstdio>
#include <cstdint>

#ifndef MK_FUSED
#define MK_FUSED 1
#endif

#define LAS __attribute__((address_space(3)))
#define GAS __attribute__((address_space(1)))
typedef _Float16 hf;
typedef _Float16 hf2 __attribute__((ext_vector_type(2)));
typedef _Float16 hf4 __attribute__((ext_vector_type(4)));
typedef _Float16 hf8 __attribute__((ext_vector_type(8)));
typedef short s16x4 __attribute__((ext_vector_type(4)));
typedef float f32x2 __attribute__((ext_vector_type(2)));
typedef float f32x4 __attribute__((ext_vector_type(4)));
typedef float f32x16 __attribute__((ext_vector_type(16)));
typedef unsigned u32x2 __attribute__((ext_vector_type(2)));
typedef unsigned u32x4 __attribute__((ext_vector_type(4)));

constexpr int DM = 1024, NB = 32, SEQ = 2048, DEPTH = 4, CTXL = 256, GRIDW = 64;
constexpr int NLAT = NB * SEQ;
constexpr int NCTX = NB * CTXL;
constexpr int MTOT = NLAT + NCTX;
constexpr int D_IN = 5024, NP1 = 2048  , NGATE = 3072, DFF = 4096;
constexpr int C_PQ = 0, C_PKV = 256, C_PKR = 384, C_HY = 416, C_DQ = 1184, C_DK = 1440, C_DV = 1696, C_PG = 1952;
constexpr int NUP = 1792, KUP = 384;
constexpr int NMODV = 33, MODW = 6 * DM;
constexpr float EPS = 1e-6f;
constexpr float MLA_SCALE = 0.10206207261596575f;
constexpr float DF_SCALE = 0.17677669529663687f;

constexpr size_t al256(size_t x) { return (x + 255) / 256 * 256; }
constexpr size_t WS_BAR = 0, WS_BAR_BYTES = 65536;
constexpr size_t WS_SS = WS_BAR + WS_BAR_BYTES;
constexpr int SS_1 = 0, SS_2 = DEPTH, SS_F = 2 * DEPTH, SSP_N = 2 * DEPTH + 1;
constexpr size_t WS_SSQ = WS_SS + (size_t)SSP_N * MTOT * 4 * 4;
constexpr size_t WS_SSKV = WS_SSQ + (size_t)DEPTH * MTOT * 4;
constexpr size_t WS_ZERO_BYTES = WS_BAR_BYTES;
constexpr size_t WS_MOD = al256(WS_SSKV + (size_t)DEPTH * MTOT * 4);
constexpr size_t WS_GS = WS_MOD + al256((size_t)DEPTH * NMODV * MODW * 4);
constexpr int NBIAS = 9216, B_IN = 0, B_G = 2048, B_FC1 = 5120;
constexpr size_t WS_BIAS = WS_GS + (size_t)DEPTH * 2 * NMODV * DM * 4;
constexpr size_t WS_ROPE = WS_BIAS + (size_t)DEPTH * NMODV * NBIAS * 4;
constexpr size_t WS_LAM = WS_ROPE + (size_t)SEQ * 32 * 4;
constexpr size_t WS_RF = WS_LAM + 256;
constexpr size_t WS_RFC = WS_RF + (size_t)DEPTH * 256 * 4096 * 2;
constexpr size_t WS_X16 = WS_RFC + (size_t)DEPTH * 256 * 512 * 2;
constexpr size_t WS_WT = WS_X16 + (size_t)MTOT * DM * 2;
constexpr size_t W_IN1 = 0, W_ING = W_IN1 + (size_t)NP1 * DM * 2, W_UP = W_ING + (size_t)NGATE * DM * 2, W_BR = W_UP + (size_t)NUP * KUP * 2,
                 W_OUT = W_BR + (size_t)DM * DM * 2, W_FC1 = W_OUT + (size_t)DM * DM * 2, W_FC2 = W_FC1 + (size_t)DFF * DM * 2, W_LAYER = W_FC2 + (size_t)DM * DFF * 2;
constexpr size_t WS_ARENA = WS_WT + 2 * W_LAYER;
constexpr size_t SZ_ROW1024 = (size_t)MTOT * 1024 * 2;
constexpr size_t A_B = WS_ARENA;
constexpr size_t A_C = A_B + SZ_ROW1024;
constexpr size_t A_Y = A_B, A_XS2 = A_B, A_BIG = A_C;
constexpr size_t A_QKVN = A_BIG;
constexpr size_t A_PHY = A_QKVN + (size_t)MTOT * KUP * 2;
constexpr size_t A_KR = A_BIG + (size_t)MTOT * NGATE;
constexpr size_t A_DQ = A_KR + (size_t)MTOT * 32 * 2;
constexpr size_t A_DK = A_DQ + (size_t)MTOT * 256 * 2;
constexpr size_t A_DV = A_DK + (size_t)MTOT * 256 * 2;
constexpr size_t A_QKV = A_DV + (size_t)MTOT * 256 * 2;
constexpr size_t A_BIG_END = A_QKV + (size_t)MTOT * NUP * 2;
static_assert(A_PHY + (size_t)MTOT * 768 * 2 <= A_KR, "QKVN + PHY must fit under the gate bytes");
constexpr size_t O_UT = SZ_ROW1024, O_X0T = O_UT + (size_t)256 * NLAT * 2, O_UTC = O_X0T + (size_t)256 * NLAT * 2, O_X0TC = O_UTC + (size_t)256 * NCTX * 2, O_END = O_X0TC + (size_t)256 * NCTX * 2;
static_assert(O_END <= (size_t)NLAT * DM * 4, "d_out scratch overflow");
constexpr size_t A_G = A_BIG;
constexpr size_t A_HID = A_C;
constexpr size_t WS_END = (A_BIG_END > A_HID + (size_t)MTOT * DFF * 2) ? A_BIG_END : A_HID + (size_t)MTOT * DFF * 2;
static_assert(WS_END <= (size_t)1024 * 1024 * 1024, "workspace map exceeds 1 GiB");

constexpr int LDS_BYTES = 147456;
constexpr int LDS_MISC = LDS_BYTES - 64;
constexpr int LDS_EXCH = 131072;

__device__ __forceinline__ unsigned pkh(float lo, float hi) { f32x2 v = {lo, hi}; hf2 h = __builtin_convertvector(v, hf2); return __builtin_bit_cast(unsigned, h); }
__device__ __forceinline__ unsigned pkhb(float lo, float hi) { unsigned b; asm("v_cvt_pk_bf16_f32 %0, %1, %2" : "=v"(b) : "v"(lo), "v"(hi)); return pkh(__uint_as_float(b << 16), __uint_as_float(b & 0xffff0000u)); }
__device__ __forceinline__ float wave_sum(float v) {
#pragma unroll
    for (int o = 1; o < 64; o <<= 1) v += __shfl_xor(v, o);
    return v;
}
__device__ __forceinline__ float rstd4(const float* ssp, int r) { const f32x4 q = *(const f32x4*)(ssp + 4 * (size_t)r); return rsqrtf(((q[0] + q[1]) + (q[2] + q[3])) * (1.f / DM) + EPS); }
#define LDS_WAIT() asm volatile("s_waitcnt lgkmcnt(0)" ::: "memory")
#define VM_WAIT() asm volatile("s_waitcnt vmcnt(0)" ::: "memory")

#define XB_TMO      128
#define XB_XCNT(j)  (256  + 64 * (j))
#define XB_XSUB(j)  (1280 + 64 * (j))
#define XB_XGEN(j)  (2304 + 64 * (j))
#define XB_TOP      3328
#define XB_TOPGEN   3392
#define XCD_BAR_WORDS 3456
#define XB_SPIN_CAP (1u << 22)
__device__ __forceinline__ unsigned xb_ld(unsigned* p)              { return __hip_atomic_load(p, __ATOMIC_RELAXED, __HIP_MEMORY_SCOPE_AGENT); }
__device__ __forceinline__ unsigned xb_add(unsigned* p, unsigned v) { return __hip_atomic_fetch_add(p, v, __ATOMIC_RELAXED, __HIP_MEMORY_SCOPE_AGENT); }
__device__ __forceinline__ unsigned xb_xcc_id() { return (unsigned)__builtin_amdgcn_s_getreg((3 << 11) | 20) & 0xFu; }
#define XB_SPIN(cond, bar) do { unsigned _sp = 0; while (cond) { __builtin_amdgcn_s_sleep(1); \
    if ((++_sp & 255u) == 0u) { if (xb_ld(&(bar)[XB_TMO])) break; if (_sp > XB_SPIN_CAP) { atomicAdd(&(bar)[XB_TMO], 1u); break; } } } } while (0)
struct XcdBarrier { unsigned* bar; unsigned x; volatile LAS unsigned* st; };
__device__ __forceinline__ XcdBarrier xcd_barrier_post(unsigned* bar, volatile LAS unsigned* st) {
    XcdBarrier b; b.bar = bar; b.x = xb_xcc_id(); b.st = st;
    if (threadIdx.x == 0) (void)xb_add(&bar[XB_XCNT(b.x)], 1u);
    return b;
}
__device__ __forceinline__ void xcd_barrier_complete(unsigned* bar, unsigned x, unsigned& nloc, unsigned& nx) {
    const unsigned G = gridDim.x * gridDim.y * gridDim.z;
    unsigned sum, cnt, mine, sp = 0u;
    for (;;) {
        sum = 0u; cnt = 0u; mine = 0u;
#pragma unroll
        for (unsigned j = 0; j < 16; ++j) { const unsigned c = xb_ld(&bar[XB_XCNT(j)]); sum += c; cnt += (c > 0u) ? 1u : 0u; mine = (j == x) ? c : mine; }
        if (sum == G) break;
        __builtin_amdgcn_s_sleep(1);
        if ((++sp & 255u) == 0u) { if (xb_ld(&bar[XB_TMO])) break; if (sp > XB_SPIN_CAP) { atomicAdd(&bar[XB_TMO], 1u); break; } }
    }
    nloc = mine > 0u ? mine : 1u; nx = cnt > 0u ? cnt : 1u;
}
__device__ __forceinline__ void xcd_barrier(const XcdBarrier& b) {
    asm volatile("s_waitcnt vmcnt(0)" ::: "memory");
    __syncthreads();
    if (threadIdx.x == 0) {
        unsigned* bar = b.bar;
        __builtin_amdgcn_s_waitcnt(0);
        unsigned nloc = b.st[0], nx = b.st[1];
        if (nloc == 0u) { xcd_barrier_complete(bar, b.x, nloc, nx); b.st[0] = nloc; b.st[1] = nx; }
        const unsigned old = xb_add(&bar[XB_XSUB(b.x)], 1u);
        const unsigned gen = old / nloc;
        if (old + 1u == (gen + 1u) * nloc) {
            __builtin_amdgcn_fence(__ATOMIC_RELEASE, "agent");
            asm volatile("s_waitcnt vmcnt(0)" ::: "memory");
            const unsigned og = xb_add(&bar[XB_TOP], 1u);
            const unsigned tg = og / nx;
            if (og + 1u == (tg + 1u) * nx) xb_add(&bar[XB_TOPGEN], 1u);
            else XB_SPIN(xb_ld(&bar[XB_TOPGEN]) == tg, bar);
            __builtin_amdgcn_fence(__ATOMIC_ACQUIRE, "agent");
            xb_add(&bar[XB_XGEN(b.x)], 1u);
            asm volatile("s_waitcnt vmcnt(0)" ::: "memory");
        } else {
            XB_SPIN(xb_ld(&bar[XB_XGEN(b.x)]) == gen, bar);
            __builtin_amdgcn_fence(__ATOMIC_ACQUIRE, "agent");
            asm volatile("s_waitcnt vmcnt(0)" ::: "memory");
        }
    }
    __syncthreads();
}

namespace pg8 {
constexpr int BM = 256, BK = 64, HALF = 128, HTB = HALF * BK * 2, STAGE_BYTES = 8 * HTB, NXCD = 8, WGM = 8;
__host__ __device__ __forceinline__ int lds_byte(int r, int c) { const int st = (r >> 4) * 2 + (c >> 5), rr = r & 15, cc = c & 31, ob = rr * 64 + cc * 2; return st * 1024 + (ob ^ (((ob >> 9) & 1) << 5)); }
__host__ __device__ __forceinline__ void stage_rc(int b, int& R, int& C) { const int st = b / 1024, sb = b % 1024, swz = sb ^ (((sb >> 9) & 1) << 5); R = (st >> 1) * 16 + swz / 64; C = (st & 1) * 32 + (swz % 64) / 2; }
__host__ __device__ __forceinline__ int perm32(int rho) { const int n = rho >> 4, i = rho & 15; return 8 * (i >> 2) + 4 * n + (i & 3); }
struct Unit { int pm, pn; };
struct Gemm { const hf* A; const hf* Bt; int M, N, K, lda, ldb; };
struct StaticOrder {
    int nM, nN, nwg, G, c;
    __host__ __device__ void init(int M, int N, int G_, int c_) { nM = M / BM; nN = N / BM; nwg = nM * nN; G = G_; c = c_; }
    __host__ __device__ bool next(int i, Unit& u) const {
        const long L = (long)i * G + c; if (L >= nwg) return false;
        int wgid = (int)L; { const int q = nwg / NXCD, r = nwg % NXCD, xcd = wgid % NXCD, off = wgid / NXCD; wgid = (xcd < r ? xcd * (q + 1) : r * (q + 1) + (xcd - r) * q) + off; }
        const int nig = WGM * nN, gid = wgid / nig, fm = gid * WGM, gsz = (nM - fm) < WGM ? (nM - fm) : WGM;
        u.pm = fm + ((wgid % nig) % gsz); u.pn = (wgid % nig) / gsz; return true;
    }
    __device__ __forceinline__ void a_ready(const Unit&) const {}
    __device__ __forceinline__ void done(const Unit&) const {}
};

template <int ACT  , bool NORM> struct EpiHalf {
    static constexpr bool PERM = true, AFTER_DRAIN = false, PROBE2 = false, MIDK = false;
    hf* O; int ldc; const float* ss; const float* bias;
    __device__ __forceinline__ void operator()(const f32x4 (&acc)[2][2][4][2], const Unit& u, int wr, int wc, int fr, int fq) const {
        const int row0 = u.pm * BM + wr * 64 + fr, col0 = u.pn * BM + wc * 32 + 8 * fq;
        f32x4 bv[2][2];
        if (NORM) { const int R0 = u.pm * BM; const int v = (R0 < NLAT) ? (R0 >> 11) : NB; const float* bp = bias + (size_t)v * NBIAS + col0;
#pragma unroll
            for (int bj = 0; bj < 2; ++bj)
#pragma unroll
                for (int n = 0; n < 2; ++n) bv[bj][n] = *(const f32x4*)(bp + bj * HALF + 4 * n); }
#pragma unroll
        for (int ai = 0; ai < 2; ++ai)
#pragma unroll
            for (int m = 0; m < 4; ++m) { const int r = row0 + ai * HALF + m * 16; hf* rowp = O + (size_t)r * ldc + col0;
                float rs = 1.f; if (NORM) rs = rstd4(ss, r);
#pragma unroll
                for (int bj = 0; bj < 2; ++bj) { f32x4 v0 = acc[ai][bj][m][0], v1 = acc[ai][bj][m][1];
                    if (NORM) { v0 = v0 * rs + bv[bj][0]; v1 = v1 * rs + bv[bj][1]; }
                    if (ACT == 1) {
#pragma unroll
                        for (int e = 0; e < 4; ++e) { v0[e] = __builtin_amdgcn_rcpf(1.f + __builtin_amdgcn_exp2f(-1.4426950408889634f * v0[e])); v1[e] = __builtin_amdgcn_rcpf(1.f + __builtin_amdgcn_exp2f(-1.4426950408889634f * v1[e])); } }
                    if (ACT == 2) {
#pragma unroll
                        for (int e = 0; e < 4; ++e) { const float a = fmaxf(v0[e], 0.f), b = fmaxf(v1[e], 0.f); v0[e] = a * a; v1[e] = b * b; } }
                    u32x4 w; w.x = pkhb(v0[0], v0[1]); w.y = pkhb(v0[2], v0[3]); w.z = pkhb(v1[0], v1[1]); w.w = pkhb(v1[2], v1[3]);
                    *(u32x4*)(rowp + bj * HALF) = w; } }
    }
};
struct EpiGate8 {
    static constexpr bool PERM = true, AFTER_DRAIN = false, PROBE2 = false, MIDK = false;
    unsigned char* O; const float* ss; const float* bias;
    __device__ __forceinline__ void operator()(const f32x4 (&acc)[2][2][4][2], const Unit& u, int wr, int wc, int fr, int fq) const {
        const int R0 = u.pm * BM, row0 = R0 + wr * 64 + fr, col0 = u.pn * BM + wc * 32 + 8 * fq;
        const int v = (R0 < NLAT) ? (R0 >> 11) : NB; const float* bp = bias + (size_t)v * NBIAS + col0;
        f32x4 bv[2][2];
#pragma unroll
        for (int bj = 0; bj < 2; ++bj) { bv[bj][0] = *(const f32x4*)(bp + bj * HALF); bv[bj][1] = *(const f32x4*)(bp + bj * HALF + 4); }
#pragma unroll
        for (int ai = 0; ai < 2; ++ai)
#pragma unroll
            for (int m = 0; m < 4; ++m) { const int r = row0 + ai * HALF + m * 16; const float rs = rstd4(ss, r);
#pragma unroll
                for (int bj = 0; bj < 2; ++bj) { const f32x4 v0 = acc[ai][bj][m][0] * rs + bv[bj][0], v1 = acc[ai][bj][m][1] * rs + bv[bj][1];
                    unsigned q[8];
#pragma unroll
                    for (int e = 0; e < 4; ++e) { const float g0 = __builtin_amdgcn_rcpf(1.f + __builtin_amdgcn_exp2f(-1.4426950408889634f * v0[e])), g1 = __builtin_amdgcn_rcpf(1.f + __builtin_amdgcn_exp2f(-1.4426950408889634f * v1[e]));
                        q[e] = (unsigned)fmaxf(1.f, __builtin_rintf(255.f * g0)); q[4 + e] = (unsigned)fmaxf(1.f, __builtin_rintf(255.f * g1)); }
                    u32x2 w; w.x = q[0] | (q[1] << 8) | (q[2] << 16) | (q[3] << 24); w.y = q[4] | (q[5] << 8) | (q[6] << 16) | (q[7] << 24);
                    *(u32x2*)(O + (size_t)r * NGATE + col0 + bj * HALF) = w; } }
    }
};
struct EpiIn {
    static constexpr bool PERM = true, AFTER_DRAIN = false, PROBE2 = false, MIDK = false;
    hf* QKVNo; hf* KRo; hf* PHYo; hf* DQo; hf* DKo; hf* DVo; const float* ss; const float* bias; float* ssq; float* sskv; LAS unsigned char* lx;
    __device__ __forceinline__ void operator()(const f32x4 (&acc)[2][2][4][2], const Unit& u, int wr, int wc, int fr, int fq) const {
        const int R0 = u.pm * BM, row0 = R0 + wr * 64 + fr, col0 = u.pn * BM + wc * 32 + 8 * fq;
        const int v = (R0 < NLAT) ? (R0 >> 11) : NB; const float* bp = bias + (size_t)v * NBIAS + col0;
        f32x4 bv[2][2]; hf* dst[2]; int ld[2];
#pragma unroll
        for (int bj = 0; bj < 2; ++bj) { const int c8 = col0 + bj * HALF;
            bv[bj][0] = *(const f32x4*)(bp + bj * HALF); bv[bj][1] = *(const f32x4*)(bp + bj * HALF + 4);
            if (c8 < C_PKR) { dst[bj] = QKVNo + c8; ld[bj] = KUP; }
            else if (c8 < C_HY) { dst[bj] = KRo + (c8 - C_PKR); ld[bj] = 32; }
            else if (c8 < C_DQ) { dst[bj] = PHYo + (c8 - C_HY); ld[bj] = 768; }
            else if (c8 < C_DK) { dst[bj] = DQo + (c8 - C_DQ); ld[bj] = 256; }
            else if (c8 < C_DV) { dst[bj] = DKo + (c8 - C_DK); ld[bj] = 256; }
            else if (c8 < C_PG) { dst[bj] = DVo + (c8 - C_DV); ld[bj] = 256; }
            else { dst[bj] = nullptr; ld[bj] = 0; } }
        const int nstat = (u.pn == 0) ? 2 : (u.pn == 1 ? 1 : 0);
        float* sp = (u.pn == 0) ? ssq : sskv;
        float sqv[2][4];
#pragma unroll
        for (int ai = 0; ai < 2; ++ai)
#pragma unroll
            for (int m = 0; m < 4; ++m) { const int r = row0 + ai * HALF + m * 16; const float rs = rstd4(ss, r); float sq = 0.f;
#pragma unroll
                for (int bj = 0; bj < 2; ++bj) { const f32x4 v0 = acc[ai][bj][m][0] * rs + bv[bj][0], v1 = acc[ai][bj][m][1] * rs + bv[bj][1];
                    if (bj < nstat) sq += (v0[0] * v0[0] + v0[1] * v0[1]) + (v0[2] * v0[2] + v0[3] * v0[3]) + (v1[0] * v1[0] + v1[1] * v1[1]) + (v1[2] * v1[2] + v1[3] * v1[3]);
                    if (dst[bj]) { u32x4 w; w.x = pkhb(v0[0], v0[1]); w.y = pkhb(v0[2], v0[3]); w.z = pkhb(v1[0], v1[1]); w.w = pkhb(v1[2], v1[3]); *(u32x4*)(dst[bj] + (size_t)r * ld[bj]) = w; } }
                sq += __shfl_xor(sq, 16); sq += __shfl_xor(sq, 32); sqv[ai][m] = sq; }
        if (nstat) {
            LAS float* ex = (LAS float*)lx;
            if (fq == 0) {
#pragma unroll
                for (int ai = 0; ai < 2; ++ai)
#pragma unroll
                    for (int m = 0; m < 4; ++m) ex[((wr * 4 + wc) * 8 + ai * 4 + m) * 16 + fr] = sqv[ai][m]; }
            asm volatile("s_waitcnt lgkmcnt(0)" ::: "memory"); __builtin_amdgcn_s_barrier(); asm volatile("" ::: "memory");
            if (wc == 0 && fq == 0) {
#pragma unroll
                for (int ai = 0; ai < 2; ++ai)
#pragma unroll
                    for (int m = 0; m < 4; ++m) { const int e = (ai * 4 + m) * 16 + fr; const int wb = wr * 4 * 128;
                        sp[row0 + ai * HALF + m * 16] = (ex[wb + e] + ex[wb + 128 + e]) + (ex[wb + 256 + e] + ex[wb + 384 + e]); } }
        }
    }
};
struct EpiUp {
    static constexpr bool PERM = true, AFTER_DRAIN = false, PROBE2 = false, MIDK = false;
    hf* O; const float* ssq; const float* sskv;
    __device__ __forceinline__ void operator()(const f32x4 (&acc)[2][2][4][2], const Unit& u, int wr, int wc, int fr, int fq) const {
        const int row0 = u.pm * BM + wr * 64 + fr, col0 = u.pn * BM + wc * 32 + 8 * fq;
        const bool isq = u.pn < 3; const float* sp = isq ? ssq : sskv; const float invn = isq ? (1.f / 256.f) : (1.f / 128.f);
#pragma unroll
        for (int ai = 0; ai < 2; ++ai)
#pragma unroll
            for (int m = 0; m < 4; ++m) { const int r = row0 + ai * HALF + m * 16; hf* rowp = O + (size_t)r * NUP + col0; const float rs = rsqrtf(sp[r] * invn + EPS);
#pragma unroll
                for (int bj = 0; bj < 2; ++bj) { const f32x4 v0 = acc[ai][bj][m][0] * rs, v1 = acc[ai][bj][m][1] * rs;
                    u32x4 w; w.x = pkhb(v0[0], v0[1]); w.y = pkhb(v0[2], v0[3]); w.z = pkhb(v1[0], v1[1]); w.w = pkhb(v1[2], v1[3]);
                    *(u32x4*)(rowp + bj * HALF) = w; } }
    }
};
template <bool FIRST> struct EpiGated {
    static constexpr bool PERM = true, AFTER_DRAIN = false, PROBE2 = false, MIDK = false;
    hf* MMo; const hf* G; int goff;
    __device__ __forceinline__ void operator()(const f32x4 (&acc)[2][2][4][2], const Unit& u, int wr, int wc, int fr, int fq) const {
        const int row0 = u.pm * BM + wr * 64 + fr, col0 = u.pn * BM + wc * 32 + 8 * fq;
#pragma unroll
        for (int ai = 0; ai < 2; ++ai)
#pragma unroll
            for (int m = 0; m < 4; ++m) { const size_t r = (size_t)(row0 + ai * HALF + m * 16);
#pragma unroll
                for (int bj = 0; bj < 2; ++bj) { const f32x4 v0 = acc[ai][bj][m][0], v1 = acc[ai][bj][m][1];
                    const hf8 g = *(const hf8*)(G + r * NGATE + goff + col0 + bj * HALF);
                    hf* mp = MMo + r * DM + col0 + bj * HALF;
                    float o[8];
#pragma unroll
                    for (int e = 0; e < 4; ++e) { o[e] = (float)g[e] * v0[e]; o[4 + e] = (float)g[4 + e] * v1[e]; }
                    if (!FIRST) { const hf8 p = *(const hf8*)mp;
#pragma unroll
                        for (int e = 0; e < 8; ++e) o[e] += (float)p[e]; }
                    u32x4 w; w.x = pkh(o[0], o[1]); w.y = pkh(o[2], o[3]); w.z = pkh(o[4], o[5]); w.w = pkh(o[6], o[7]);
                    *(u32x4*)mp = w; } }
    }
};
struct EpiMerge {
    static constexpr bool PERM = true, AFTER_DRAIN = false, PROBE2 = false, MIDK = true;
    static constexpr int MID1 = 8, MID2 = 12;
    hf* MMo; const unsigned char* G;
    __device__ __forceinline__ void mid(f32x4 (&acc)[2][2][4][2], const Unit& u, int which, int wr, int wc, int fr, int fq) const {
        asm volatile("" : "+v"(fr), "+v"(fq));
        const int row0 = u.pm * BM + wr * 64 + fr, col0 = u.pn * BM + wc * 32 + 8 * fq; const int gnum = which ? 1024 : 0, gden = which ? 2048 : 1024;
#pragma unroll
        for (int ai = 0; ai < 2; ++ai) {
            u32x2 gn[4][2], gd[4][2];
#pragma unroll
            for (int m = 0; m < 4; ++m) { const unsigned char* gr = G + (size_t)(row0 + ai * HALF + m * 16) * NGATE + col0;
#pragma unroll
                for (int bj = 0; bj < 2; ++bj) { gn[m][bj] = *(const u32x2*)(gr + gnum + bj * HALF); gd[m][bj] = *(const u32x2*)(gr + gden + bj * HALF); } }
#pragma unroll
            for (int m = 0; m < 4; ++m)
#pragma unroll
                for (int bj = 0; bj < 2; ++bj)
#pragma unroll
                    for (int e = 0; e < 4; ++e) {
                        acc[ai][bj][m][0][e] *= (float)((gn[m][bj].x >> (8 * e)) & 255u) * __builtin_amdgcn_rcpf((float)((gd[m][bj].x >> (8 * e)) & 255u));
                        acc[ai][bj][m][1][e] *= (float)((gn[m][bj].y >> (8 * e)) & 255u) * __builtin_amdgcn_rcpf((float)((gd[m][bj].y >> (8 * e)) & 255u)); }
            asm volatile("" ::: "memory");
        }
    }
    __device__ __forceinline__ void operator()(const f32x4 (&acc)[2][2][4][2], const Unit& u, int wr, int wc, int fr, int fq) const {
        const int row0 = u.pm * BM + wr * 64 + fr, col0 = u.pn * BM + wc * 32 + 8 * fq;
#pragma unroll
        for (int ai = 0; ai < 2; ++ai)
#pragma unroll
            for (int m = 0; m < 4; ++m) { const size_t r = (size_t)(row0 + ai * HALF + m * 16);
#pragma unroll
                for (int bj = 0; bj < 2; ++bj) { const f32x4 v0 = acc[ai][bj][m][0], v1 = acc[ai][bj][m][1];
                    const u32x2 g = *(const u32x2*)(G + r * NGATE + 2048 + col0 + bj * HALF);
                    float o[8];
#pragma unroll
                    for (int e = 0; e < 4; ++e) { o[e] = (float)((g.x >> (8 * e)) & 255u) * (1.f / 255.f) * v0[e]; o[4 + e] = (float)((g.y >> (8 * e)) & 255u) * (1.f / 255.f) * v1[e]; }
                    u32x4 w; w.x = pkhb(o[0], o[1]); w.y = pkhb(o[2], o[3]); w.z = pkhb(o[4], o[5]); w.w = pkhb(o[6], o[7]);
                    *(u32x4*)(MMo + r * DM + col0 + bj * HALF) = w; } }
    }
};
template <bool XS, bool STAT> struct EpiResidX {
    static constexpr bool PERM = true, AFTER_DRAIN = false, PROBE2 = false, MIDK = false;
    hf* x16; const float* gate;
    hf* xsout; const float* gs; float* ss; LAS unsigned char* lx;
    __device__ __forceinline__ void operator()(const f32x4 (&acc)[2][2][4][2], const Unit& u, int wr, int wc, int fr, int fq) const {
        const int R0 = u.pm * BM; const int v = (R0 < NLAT) ? (R0 >> 11) : NB;
        const int rglob = R0 + wr * 64 + fr, col0 = u.pn * BM + wc * 32 + 8 * fq;
        const float* gp = gate + (size_t)v * MODW + col0; const float* gsp = gs + (size_t)v * DM + col0;
        float sq[2][4];
#pragma unroll
        for (int ai = 0; ai < 2; ++ai)
#pragma unroll
            for (int m = 0; m < 4; ++m) sq[ai][m] = 0.f;
#pragma unroll
        for (int bj = 0; bj < 2; ++bj) {
            const f32x4 g0 = *(const f32x4*)(gp + bj * HALF), g1 = *(const f32x4*)(gp + bj * HALF + 4);
            f32x4 s0 = {1.f, 1.f, 1.f, 1.f}, s1 = s0; if (XS) { s0 = *(const f32x4*)(gsp + bj * HALF); s1 = *(const f32x4*)(gsp + bj * HALF + 4); }
#pragma unroll
            for (int ai = 0; ai < 2; ++ai)
#pragma unroll
                for (int m = 0; m < 4; ++m) { const int rr = ai * HALF + m * 16; const size_t off = (size_t)(rglob + rr) * DM + col0 + bj * HALF;
                    const hf8 xv = *(const hf8*)(x16 + off);
                    const f32x4 x0 = {(float)xv[0], (float)xv[1], (float)xv[2], (float)xv[3]}, x1 = {(float)xv[4], (float)xv[5], (float)xv[6], (float)xv[7]};
                    const f32x4 n0 = x0 + g0 * acc[ai][bj][m][0], n1 = x1 + g1 * acc[ai][bj][m][1];
                    { u32x4 w; w.x = pkh(n0[0], n0[1]); w.y = pkh(n0[2], n0[3]); w.z = pkh(n1[0], n1[1]); w.w = pkh(n1[2], n1[3]); *(u32x4*)(x16 + off) = w; }
                    if (STAT) sq[ai][m] += (n0[0] * n0[0] + n0[1] * n0[1]) + (n0[2] * n0[2] + n0[3] * n0[3]) + (n1[0] * n1[0] + n1[1] * n1[1]) + (n1[2] * n1[2] + n1[3] * n1[3]);
                    if (XS) { const f32x4 a = n0 * s0, b = n1 * s1; u32x4 w; w.x = pkhb(a[0], a[1]); w.y = pkhb(a[2], a[3]); w.z = pkhb(b[0], b[1]); w.w = pkhb(b[2], b[3]);
                        *(u32x4*)(xsout + off) = w; } }
        }
        if (STAT) {
            LAS float* ex = (LAS float*)lx;
#pragma unroll
            for (int ai = 0; ai < 2; ++ai)
#pragma unroll
                for (int m = 0; m < 4; ++m) { float t = sq[ai][m]; t += __shfl_xor(t, 16); t += __shfl_xor(t, 32);
                    if (fq == 0) ex[((wr * 4 + wc) * 8 + ai * 4 + m) * 16 + fr] = t; }
            asm volatile("s_waitcnt lgkmcnt(0)" ::: "memory"); __builtin_amdgcn_s_barrier(); asm volatile("" ::: "memory");
            if (wc == 0 && fq == 0) {
#pragma unroll
                for (int ai = 0; ai < 2; ++ai)
#pragma unroll
                    for (int m = 0; m < 4; ++m) { const int e = (ai * 4 + m) * 16 + fr; const int wb = wr * 4 * 128;
                        ss[(size_t)(rglob + ai * HALF + m * 16) * 4 + u.pn] = (ex[wb + e] + ex[wb + 128 + e]) + (ex[wb + 256 + e] + ex[wb + 384 + e]); } }
        }
    }
};

template <class Epi, class Sched, bool ALIGN_EPI = true>
__device__ __forceinline__ void gemm_phase(LAS unsigned char* lds, const Gemm g, const Sched& S, const Epi& E) {
    int tid = threadIdx.x; asm volatile("" : "+v"(tid));
    const int wid = __builtin_amdgcn_readfirstlane(tid >> 6), lane = tid & 63, wr = wid >> 2, wc = wid & 3, fr = lane & 15, fq = lane >> 4;
    const int K = g.K, nt = K / BK;
    unsigned voffA[2], voffB[2];
#pragma unroll
    for (int i = 0; i < 2; ++i) { int R, C; stage_rc(tid * 16 + i * 8192, R, C); const int Rb = Epi::PERM ? ((R & ~31) + perm32(R & 31)) : R;
        voffA[i] = (unsigned)(R * g.lda + C) * 2u; voffB[i] = (unsigned)(Rb * g.ldb + C) * 2u; }
    const size_t kstep = (size_t)(BK * 2);
    const size_t hstepA = (size_t)HALF * g.lda * 2, hstepB = (size_t)HALF * g.ldb * 2;
    const size_t tstepA = 2 * hstepA, tstepB = 2 * hstepB;
    const unsigned ldsw = (unsigned)wid * 1024u;
    const int aoff = lds_byte(wr * 64 + fr, fq * 8), boff = lds_byte(wc * 32 + fr, fq * 8);
#define PG8_SA(b, h) (((b) * 2 + (h)) * HTB)
#define PG8_SB(b, h) ((4 + (b) * 2 + (h)) * HTB)
#define PG8_STAGE(bufoff, gbase, voff) do { _Pragma("unroll") for (int _i = 0; _i < 2; ++_i) \
        __builtin_amdgcn_global_load_lds((const unsigned*)((const char*)(gbase) + (voff)[_i]), (LAS unsigned*)(lds + (bufoff) + ldsw + _i * 8192), 16, 0, 0); } while (0)
#define PG8_LDA(dst, b, h) do { _Pragma("unroll") for (int m = 0; m < 4; ++m) _Pragma("unroll") for (int k = 0; k < 2; ++k) dst[m][k] = *(const LAS hf8*)(lds + PG8_SA(b, h) + aoff + m * 2048 + k * 1024); } while (0)
#define PG8_LDB(dst, b, h) do { _Pragma("unroll") for (int n = 0; n < 2; ++n) _Pragma("unroll") for (int k = 0; k < 2; ++k) dst[n][k] = *(const LAS hf8*)(lds + PG8_SB(b, h) + boff + n * 2048 + k * 1024); } while (0)
#define PG8_MMA(ai, bj, At, Bt) do { __builtin_amdgcn_s_setprio(1); _Pragma("unroll") for (int m = 0; m < 4; ++m) _Pragma("unroll") for (int n = 0; n < 2; ++n) _Pragma("unroll") for (int k = 0; k < 2; ++k) \
        acc[ai][bj][m][n] = __builtin_amdgcn_mfma_f32_16x16x32_f16(Bt[n][k], At[m][k], acc[ai][bj][m][n], 0, 0, 0); __builtin_amdgcn_s_setprio(0); } while (0)
#define PG8_WAIT_V(n) asm volatile("s_waitcnt vmcnt(" #n ")" ::: "memory")
#define PG8_WAIT_L(n) asm volatile("s_waitcnt lgkmcnt(" #n ")" ::: "memory")
#define PG8_BAR __builtin_amdgcn_s_barrier()
#define PG8_SCHED __builtin_amdgcn_sched_barrier(0)
    Unit cur, nxt; int ui = 0;
    if (!S.next(0, cur)) return;
    f32x4 acc[2][2][4][2];
#pragma unroll
    for (int a = 0; a < 2; ++a)
#pragma unroll
        for (int b = 0; b < 2; ++b)
#pragma unroll
            for (int m = 0; m < 4; ++m)
#pragma unroll
                for (int n = 0; n < 2; ++n) acc[a][b][m][n] = (f32x4){0.f, 0.f, 0.f, 0.f};
    hf8 At[4][2], B0[2][2], B1[2][2];
    const char* cA = (const char*)g.A + (size_t)cur.pm * tstepA; const char* cB = (const char*)g.Bt + (size_t)cur.pn * tstepB;
    S.a_ready(cur);
    PG8_STAGE(PG8_SB(0, 0), cB, voffB); PG8_STAGE(PG8_SB(0, 1), cB + hstepB, voffB); PG8_STAGE(PG8_SA(0, 0), cA, voffA); PG8_STAGE(PG8_SA(0, 1), cA + hstepA, voffA);
    if (wr == 1) PG8_BAR;
    PG8_WAIT_V(2); PG8_BAR;
    PG8_STAGE(PG8_SB(1, 0), cB + kstep, voffB); PG8_STAGE(PG8_SA(1, 0), cA + kstep, voffA); PG8_STAGE(PG8_SB(1, 1), cB + hstepB + kstep, voffB);
    PG8_WAIT_V(6); PG8_BAR;
    for (;;) {
        const bool has_next = S.next(ui + 1, nxt);
        const char* nA = has_next ? (const char*)g.A + (size_t)nxt.pm * tstepA : cA; const char* nB = has_next ? (const char*)g.Bt + (size_t)nxt.pn * tstepB : cB;
#pragma unroll 1
        for (int t = 0; t < nt; t += 2) {
            const bool last = (t == nt - 2);
            const char* a1 = cA + (size_t)(t + 1) * kstep;
            const char* a2 = last ? nA : cA + (size_t)(t + 2) * kstep; const char* b2 = last ? nB : cB + (size_t)(t + 2) * kstep;
            const char* a3 = a2 + kstep; const char* b3 = b2 + kstep;
            if (last && has_next) S.a_ready(nxt);
            if constexpr (Epi::MIDK) { if (t == Epi::MID1 || t == Epi::MID2) E.mid(acc, cur, t == Epi::MID1 ? 0 : 1, wr, wc, fr, fq); }
            PG8_LDB(B0, 0, 0); PG8_LDB(B1, 0, 1); PG8_SCHED; PG8_LDA(At, 0, 0); PG8_STAGE(PG8_SA(1, 1), a1 + hstepA, voffA);
            PG8_WAIT_V(8); PG8_WAIT_L(0); PG8_BAR; PG8_MMA(0, 0, At, B0); PG8_MMA(0, 1, At, B1); PG8_BAR; PG8_SCHED;
            PG8_LDA(At, 0, 1); PG8_STAGE(PG8_SB(0, 0), b2, voffB); PG8_STAGE(PG8_SB(0, 1), b2 + hstepB, voffB); PG8_STAGE(PG8_SA(0, 0), a2, voffA);
            PG8_WAIT_V(8); PG8_WAIT_L(0); PG8_BAR; PG8_MMA(1, 0, At, B0); PG8_MMA(1, 1, At, B1); PG8_BAR; PG8_SCHED;
            PG8_LDB(B0, 1, 0); PG8_LDB(B1, 1, 1); PG8_SCHED; PG8_LDA(At, 1, 0); PG8_STAGE(PG8_SA(0, 1), a2 + hstepA, voffA);
            PG8_WAIT_V(8); PG8_WAIT_L(0); PG8_BAR; PG8_MMA(0, 0, At, B0); PG8_MMA(0, 1, At, B1); PG8_BAR; PG8_SCHED;
            PG8_LDA(At, 1, 1); PG8_STAGE(PG8_SB(1, 0), b3, voffB); PG8_STAGE(PG8_SB(1, 1), b3 + hstepB, voffB); PG8_STAGE(PG8_SA(1, 0), a3, voffA);
            PG8_WAIT_V(8); PG8_WAIT_L(0); PG8_BAR; PG8_MMA(1, 0, At, B0); PG8_MMA(1, 1, At, B1); PG8_BAR; PG8_SCHED;
        }
        if constexpr (ALIGN_EPI) { if (wr == 0) PG8_BAR; }
        E(acc, cur, wr, wc, fr, fq); S.done(cur);
#ifdef PROBE_EPI2
        if (Epi::PROBE2) { asm volatile("" ::: "memory"); E(acc, cur, wr, wc, fr, fq); }
#endif
        if (!has_next) break;
#pragma unroll
        for (int a = 0; a < 2; ++a)
#pragma unroll
            for (int b = 0; b < 2; ++b)
#pragma unroll
                for (int m = 0; m < 4; ++m)
#pragma unroll
                    for (int n = 0; n < 2; ++n) acc[a][b][m][n] = (f32x4){0.f, 0.f, 0.f, 0.f};
        cur = nxt; cA = nA; cB = nB; ++ui;
        if constexpr (ALIGN_EPI) { if (wr == 1) PG8_BAR; }
    }
    PG8_WAIT_V(0);
    if constexpr (!ALIGN_EPI) { if (wr == 0) PG8_BAR; }
    PG8_BAR;
#undef PG8_SA
#undef PG8_SB
#undef PG8_STAGE
#undef PG8_LDA
#undef PG8_LDB
#undef PG8_MMA
#undef PG8_WAIT_V
#undef PG8_WAIT_L
#undef PG8_BAR
#undef PG8_SCHED
}
}

struct Params {
    const float* in[35];
    float* out;
    unsigned char* ws;
    int ph_lo, ph_hi;
};
enum { I_X = 0, I_C, I_CTX, I_CCTX, I_NMG, I_NFG, I_WMOD, I_BMOD, I_WIN, I_QNG, I_WUQ, I_KVNG, I_WUKV, I_HCW, I_HCB, I_HW1, I_HB1, I_HFREQ, I_HW2, I_HB2, I_HW3, I_HB3,
       I_HSKIP, I_LQ1, I_LK1, I_LQ2, I_LK2, I_SUBG, I_WBRA, I_WBRB, I_WBRC, I_WOUT, I_FC1, I_FC2, I_FNG };

struct Frame {
    LAS unsigned char* lds;
    int tid, lane, wave, vcu, G;
};

__device__ __forceinline__ void tr_item(const float* W, int ldw, hf* WT, int ldt, int nblk, LAS float* scr, int item, int lane, const float* kgain = nullptr) {
    const int kb = item / nblk, nb = item % nblk, k0 = 64 * kb, n0 = 32 * nb;
#pragma unroll 8
    for (int i = 0; i < 32; ++i) { const int kk = 2 * i + (lane >> 5); const float gk = kgain ? kgain[k0 + kk] : 1.f; { float wv = W[(size_t)(k0 + kk) * ldw + n0 + (lane & 31)] * gk; unsigned ub = __float_as_uint(wv); ub += 0x7fffu + ((ub >> 16) & 1u); ub &= 0xffff0000u; scr[kk * 33 + (lane & 31)] = __uint_as_float(ub); } }
    LDS_WAIT(); asm volatile("" ::: "memory");
    const int c = lane & 7;
#pragma unroll
    for (int j = 0; j < 4; ++j) { const int n = (lane >> 3) + 8 * j; const LAS float* s = scr + (8 * c) * 33 + n;
        u32x4 o; o.x = pkh(s[0 * 33], s[1 * 33]); o.y = pkh(s[2 * 33], s[3 * 33]); o.z = pkh(s[4 * 33], s[5 * 33]); o.w = pkh(s[6 * 33], s[7 * 33]);
        *(u32x4*)(WT + (size_t)(n0 + n) * ldt + k0 + 8 * c) = o; }
    LDS_WAIT(); asm volatile("" ::: "memory");
}
__device__ __forceinline__ float silu_f(float x) { return x / (1.f + expf(-x)); }

__device__ __forceinline__ void mod_phase(const Frame& F, const Params& p) {
    float* MOD = (float*)(p.ws + WS_MOD);
    LAS float* sv = (LAS float*)F.lds;
    constexpr int NCB = DEPTH * MODW / 512;
    for (int item = F.vcu; item < NCB * 3; item += F.G) {
        const int cb = item / 3, vg = item % 3;
        __syncthreads();
        for (int i = F.tid; i < 11 * 1024; i += 512) { const int v = vg * 11 + i / 1024, k = i % 1024;
            const float c = (v < NB) ? p.in[I_C][v * DM + k] : p.in[I_CCTX][k]; sv[i] = silu_f(c); }
        __syncthreads();
        const int gcol = cb * 512 + F.tid, l = gcol / MODW, n = gcol % MODW;
        const float* w = p.in[I_WMOD] + (size_t)l * DM * MODW + n;
        float acc[11];
#pragma unroll
        for (int v = 0; v < 11; ++v) acc[v] = 0.f;
#pragma unroll 4
        for (int k = 0; k < DM; k += 4) {
            const float w0 = w[(size_t)k * MODW], w1 = w[(size_t)(k + 1) * MODW], w2 = w[(size_t)(k + 2) * MODW], w3 = w[(size_t)(k + 3) * MODW];
#pragma unroll
            for (int v = 0; v < 11; ++v) { const f32x4 s = *(const LAS f32x4*)(sv + v * 1024 + k);
                acc[v] = fmaf(s[0], w0, acc[v]); acc[v] = fmaf(s[1], w1, acc[v]); acc[v] = fmaf(s[2], w2, acc[v]); acc[v] = fmaf(s[3], w3, acc[v]); }
        }
        const float bm = p.in[I_BMOD][(size_t)l * MODW + n];
#pragma unroll
        for (int v = 0; v < 11; ++v) MOD[((size_t)l * NMODV + vg * 11 + v) * MODW + n] = acc[v] + bm;
    }
    __syncthreads();
}

__device__ __forceinline__ void filt_item(const Params& p, int l, int kind  , int t, int lane) {
    const int L = kind ? CTXL : SEQ;
    hf* R = kind ? (hf*)(p.ws + WS_RFC) + (size_t)l * 256 * 512 : (hf*)(p.ws + WS_RF) + (size_t)l * 256 * 4096;
    const int rl = 2 * L;
    const float tl = (float)t / (float)(L - 1);
    const float wt = (6.283185307179586f / (float)L) * (float)t;
    float z = 0.f;
    if (lane == 0) z = tl;
    else if (lane <= 32) { const int bi = (lane - 1) & 15; const float band = 1e-4f + (15.f - 1e-4f) * ((float)bi / 15.f); const float a = band * wt; z = (lane <= 16) ? cosf(a) : -sinf(a); }
    const float* w1 = p.in[I_HW1] + (size_t)l * 33 * 64; const float* w2 = p.in[I_HW2] + (size_t)l * 64 * 64; const float* w3 = p.in[I_HW3] + (size_t)l * 64 * 512;
    const float fr = p.in[I_HFREQ][l * 64 + lane];
    float a1 = p.in[I_HB1][l * 64 + lane];
    for (int i = 0; i < 33; ++i) a1 = fmaf(__shfl(z, i), w1[i * 64 + lane], a1);
    a1 = sinf(fr * a1);
    float a2 = p.in[I_HB2][l * 64 + lane];
    for (int i = 0; i < 64; ++i) a2 = fmaf(__shfl(a1, i), w2[i * 64 + lane], a2);
    a2 = sinf(fr * a2);
    float h[8];
#pragma unroll
    for (int q = 0; q < 8; ++q) h[q] = p.in[I_HB3][l * 512 + q * 64 + lane];
    for (int i = 0; i < 64; ++i) { const float a = __shfl(a2, i);
#pragma unroll
        for (int q = 0; q < 8; ++q) h[q] = fmaf(a, w3[i * 512 + q * 64 + lane], h[q]); }
    const float d0 = -4.605170185988091f / 1.5f, d1 = -4.605170185988091f / 0.3f;
#pragma unroll
    for (int q = 0; q < 8; ++q) { const int o = q * 64 + lane, dir = o >> 8, c = o & 255;
        const float delta = fabsf(d0 + (d1 - d0) * ((float)c / 255.f));
        float val = h[q] * (expf(-tl * delta) + 0.05f);
        if (dir == 0) { if (t == 0) val += p.in[I_HSKIP][l * 256 + c]; R[(size_t)c * rl + (L - t)] = (hf)val; if (t == 0) R[(size_t)c * rl] = (hf)0.f; }
        else if (t >= 1) R[(size_t)c * rl + (L + t)] = (hf)val; }
}

__device__ __forceinline__ void convert_layer(const Frame& F, const Params& p, int l, unsigned char* wl, int wg_rank, int wg_count) {
    LAS float* scr = (LAS float*)(F.lds + F.wave * 16384);
    const int gw = wg_rank * 8 + F.wave, NGW = wg_count * 8, lane = F.lane;
    constexpr int IT_IN1 = 16 * 61, IT_ING = 16 * 96, IT_UQ = 4 * 24, IT_UKV = 2 * 32, IT_BRA = 8 * 32, IT_BRB = 4 * 32, IT_BRC = 4 * 32, IT_OUT = 16 * 32, IT_FC1 = 16 * 128, IT_FC2 = 64 * 32;
    constexpr int IT_LAYER = IT_IN1 + IT_ING + IT_UQ + IT_UKV + IT_BRA + IT_BRB + IT_BRC + IT_OUT + IT_FC1 + IT_FC2;
    for (int it = gw; it < IT_LAYER; it += NGW) {
        int r = it;
        if (r < IT_IN1) { tr_item(p.in[I_WIN] + (size_t)l * DM * D_IN, D_IN, (hf*)(wl + W_IN1), DM, 61, scr, r, lane); continue; } r -= IT_IN1;
        if (r < IT_ING) { tr_item(p.in[I_WIN] + (size_t)l * DM * D_IN + C_PG, D_IN, (hf*)(wl + W_ING), DM, 96, scr, r, lane); continue; } r -= IT_ING;
        if (r < IT_UQ) { tr_item(p.in[I_WUQ] + (size_t)l * 256 * 768, 768, (hf*)(wl + W_UP), KUP, 24, scr, r, lane, p.in[I_QNG] + l * 256); continue; } r -= IT_UQ;
        if (r < IT_UKV) { tr_item(p.in[I_WUKV] + (size_t)l * 128 * 1024, 1024, (hf*)(wl + W_UP) + (size_t)768 * KUP + 256, KUP, 32, scr, r, lane, p.in[I_KVNG] + l * 128); continue; } r -= IT_UKV;
        if (r < IT_BRA) { tr_item(p.in[I_WBRA] + (size_t)l * 512 * DM, DM, (hf*)(wl + W_BR), DM, 32, scr, r, lane); continue; } r -= IT_BRA;
        if (r < IT_BRB) { tr_item(p.in[I_WBRB] + (size_t)l * 256 * DM, DM, (hf*)(wl + W_BR) + 512, DM, 32, scr, r, lane); continue; } r -= IT_BRB;
        if (r < IT_BRC) { tr_item(p.in[I_WBRC] + (size_t)l * 256 * DM, DM, (hf*)(wl + W_BR) + 768, DM, 32, scr, r, lane); continue; } r -= IT_BRC;
        if (r < IT_OUT) { tr_item(p.in[I_WOUT] + (size_t)l * DM * DM, DM, (hf*)(wl + W_OUT), DM, 32, scr, r, lane); continue; } r -= IT_OUT;
        if (r < IT_FC1) { tr_item(p.in[I_FC1] + (size_t)l * DM * DFF, DFF, (hf*)(wl + W_FC1), DM, 128, scr, r, lane); continue; } r -= IT_FC1;
        tr_item(p.in[I_FC2] + (size_t)l * DFF * DM, DM, (hf*)(wl + W_FC2), DFF, 32, scr, r, lane);
    }
    const int gt = gw * 64 + lane, NGT = NGW * 64;
    u32x4* z1 = (u32x4*)((hf*)(wl + W_IN1) + (size_t)C_PG * DM);
    for (int i = gt; i < 96 * DM / 8; i += NGT) z1[i] = (u32x4){0u, 0u, 0u, 0u};
    hf* up = (hf*)(wl + W_UP);
    for (int i = gt; i < 768 * 16; i += NGT) { const int n = i / 16, k8 = i % 16; *(u32x4*)(up + (size_t)n * KUP + 256 + k8 * 8) = (u32x4){0u, 0u, 0u, 0u}; }
    for (int i = gt; i < 1024 * 32; i += NGT) { const int n = 768 + i / 32, k8 = i % 32; *(u32x4*)(up + (size_t)n * KUP + k8 * 8) = (u32x4){0u, 0u, 0u, 0u}; }
}

__device__ __forceinline__ void prologue_a(const Frame& F, const Params& p) {
    mod_phase(F, p);
    convert_layer(F, p, 0, p.ws + WS_WT, F.vcu, F.G);
    const int gw = F.vcu * 8 + F.wave, NGW = F.G * 8, lane = F.lane;
    for (int it = gw; it < DEPTH * (SEQ + CTXL); it += NGW) { const int l = it / (SEQ + CTXL), r = it % (SEQ + CTXL); if (r < SEQ) filt_item(p, l, 0, r, lane); else filt_item(p, l, 1, r - SEQ, lane); }
    {
        float* rope = (float*)(p.ws + WS_ROPE);
        const int gt = gw * 64 + lane, NGT = NGW * 64;
        for (int i = gt; i < SEQ * 16; i += NGT) { const int t = i >> 4, j = i & 15; const float pos = (j < 8) ? (float)(t / GRIDW) : (float)(t % GRIDW);
            const float inv = powf(10000.f, -(float)(j & 7) / 8.f); const float a = pos * inv; rope[t * 32 + j] = cosf(a); rope[t * 32 + 16 + j] = sinf(a); }
        if (gt < DEPTH) { const int l = gt; float s1 = 0.f, s2 = 0.f;
            for (int i = 0; i < 32; ++i) { s1 += p.in[I_LQ1][l * 32 + i] * p.in[I_LK1][l * 32 + i]; s2 += p.in[I_LQ2][l * 32 + i] * p.in[I_LK2][l * 32 + i]; }
            const float li = 0.8f - 0.6f * expf(-0.3f * (float)l);
            float* lam = (float*)(p.ws + WS_LAM); lam[2 * l] = expf(s1) - expf(s2) + li; lam[2 * l + 1] = 1.f - li; }
    }
}
__device__ __forceinline__ void prologue_b(const Frame& F, const Params& p) {
    const float* MOD = (const float*)(p.ws + WS_MOD); float* BIAS = (float*)(p.ws + WS_BIAS);
    {
        LAS float* sv = (LAS float*)F.lds;
        constexpr int NCB = DEPTH * NBIAS / 512;
        for (int item = F.vcu; item < NCB * 3; item += F.G) {
            const int cb = item / 3, vg = item % 3;
            const int gcol = cb * 512 + F.tid, l = gcol / NBIAS, n = gcol % NBIAS, n0 = (cb * 512) % NBIAS;
            const int soff = (n0 >= B_FC1) ? 3 * DM : 0;
            __syncthreads();
            for (int i = F.tid; i < 11 * 1024; i += 512) { const int v = vg * 11 + i / 1024, k = i % 1024; sv[i] = MOD[((size_t)l * NMODV + v) * MODW + soff + k]; }
            __syncthreads();
            const float* w; size_t ldw; bool valid = true;
            if (n < B_G) { w = p.in[I_WIN] + (size_t)l * DM * D_IN + n; ldw = D_IN; valid = n < C_PG; }
            else if (n < B_FC1) { w = p.in[I_WIN] + (size_t)l * DM * D_IN + C_PG + (n - B_G); ldw = D_IN; }
            else { w = p.in[I_FC1] + (size_t)l * DM * DFF + (n - B_FC1); ldw = DFF; }
            float acc[11];
#pragma unroll
            for (int v = 0; v < 11; ++v) acc[v] = 0.f;
            if (valid)
#pragma unroll 4
            for (int k = 0; k < DM; k += 4) {
                const float w0 = w[(size_t)k * ldw], w1 = w[(size_t)(k + 1) * ldw], w2 = w[(size_t)(k + 2) * ldw], w3 = w[(size_t)(k + 3) * ldw];
#pragma unroll
                for (int v = 0; v < 11; ++v) { const f32x4 sx = *(const LAS f32x4*)(sv + v * 1024 + k);
                    acc[v] = fmaf(sx[0], w0, acc[v]); acc[v] = fmaf(sx[1], w1, acc[v]); acc[v] = fmaf(sx[2], w2, acc[v]); acc[v] = fmaf(sx[3], w3, acc[v]); }
            }
#pragma unroll
            for (int v = 0; v < 11; ++v) BIAS[((size_t)l * NMODV + vg * 11 + v) * NBIAS + n] = acc[v];
        }
        __syncthreads();
    }
    const int gw = F.vcu * 8 + F.wave, NGW = F.G * 8, lane = F.lane;
    {
        float* GS = (float*)(p.ws + WS_GS);
        const int gt = gw * 64 + lane, NGT = NGW * 64;
        for (int i = gt; i < DEPTH * 2 * NMODV * DM; i += NGT) { const int c = i % DM, v = (i / DM) % NMODV, wh = (i / (DM * NMODV)) % 2, l = i / (DM * NMODV * 2);
            const float g = wh ? p.in[I_NFG][l * DM + c] : p.in[I_NMG][l * DM + c];
            GS[i] = g * (1.f + MOD[((size_t)l * NMODV + v) * MODW + (wh ? 4 * DM : DM) + c]); }
    }
    {
        hf* XS = (hf*)p.out; hf* X16 = (hf*)(p.ws + WS_X16); float* ss = (float*)(p.ws + WS_SS) + (size_t)SS_1 * MTOT * 4;
        f32x4 g[4];
#pragma unroll
        for (int j = 0; j < 4; ++j) g[j] = *(const f32x4*)(p.in[I_NMG] + 4 * lane + 256 * j);
        for (int row = gw; row < MTOT; row += NGW) {
            const bool lat = row < NLAT; const float* xr = lat ? p.in[I_X] + (size_t)row * DM : p.in[I_CTX] + (size_t)(row - NLAT) * DM;
            const int v = lat ? (row >> 11) : NB; const float* mv = MOD + (size_t)v * MODW + DM;
            float sq = 0.f; hf* hr = XS + (size_t)row * DM; hf* xh = X16 + (size_t)row * DM;
#pragma unroll
            for (int j = 0; j < 4; ++j) { const f32x4 x = *(const f32x4*)(xr + 4 * lane + 256 * j); const f32x4 sc = *(const f32x4*)(mv + 4 * lane + 256 * j);
                sq += (x[0] * x[0] + x[1] * x[1]) + (x[2] * x[2] + x[3] * x[3]);
                const f32x4 o = x * (g[j] * (sc + 1.f)); u32x2 w; w.x = pkhb(o[0], o[1]); w.y = pkhb(o[2], o[3]); *(u32x2*)(hr + 4 * lane + 256 * j) = w;
                u32x2 w2; w2.x = pkh(x[0], x[1]); w2.y = pkh(x[2], x[3]); *(u32x2*)(xh + 4 * lane + 256 * j) = w2; }
            sq = wave_sum(sq);
            if (lane == 0) *(f32x4*)(ss + 4 * (size_t)row) = (f32x4){sq, 0.f, 0.f, 0.f};
        }
    }
}

__device__ __forceinline__ void norm_phase(const Frame& F, const float* xs_lat, const float* xs_ctx, int nrows, const float* gain, const float* modl, int sh_off, int sc_off, hf* H) {
    const int gw = F.vcu * 8 + F.wave, NGW = F.G * 8, lane = F.lane;
    f32x4 g[4];
#pragma unroll
    for (int j = 0; j < 4; ++j) g[j] = *(const f32x4*)(gain + 4 * lane + 256 * j);
    for (int row = gw; row < nrows; row += NGW) {
        const bool lat = row < NLAT; const float* xr = lat ? xs_lat + (size_t)row * DM : xs_ctx + (size_t)(row - NLAT) * DM;
        const int v = lat ? (row >> 11) : NB; const float* mv = modl + (size_t)v * MODW;
        f32x4 x[4]; float ss = 0.f;
#pragma unroll
        for (int j = 0; j < 4; ++j) { x[j] = *(const f32x4*)(xr + 4 * lane + 256 * j); ss += (x[j][0] * x[j][0] + x[j][1] * x[j][1]) + (x[j][2] * x[j][2] + x[j][3] * x[j][3]); }
        const float rstd = rsqrtf(wave_sum(ss) * (1.f / DM) + EPS);
        hf* hr = H + (size_t)row * DM;
#pragma unroll
        for (int j = 0; j < 4; ++j) { const f32x4 sh = *(const f32x4*)(mv + sh_off + 4 * lane + 256 * j), sc = *(const f32x4*)(mv + sc_off + 4 * lane + 256 * j);
            const f32x4 y = (x[j] * rstd) * g[j]; const f32x4 o = y * (sc + 1.f) + sh;
            u32x2 w; w.x = pkh(o[0], o[1]); w.y = pkh(o[2], o[3]); *(u32x2*)(hr + 4 * lane + 256 * j) = w; }
    }
}
__device__ __forceinline__ void final_norm_phase(const Frame& F, const hf* X16, float* out, const float* gain, const float* ss) {
    const int gw = F.vcu * 8 + F.wave, NGW = F.G * 8, lane = F.lane;
    f32x4 g[4];
#pragma unroll
    for (int j = 0; j < 4; ++j) g[j] = *(const f32x4*)(gain + 4 * lane + 256 * j);
    for (int row = gw; row < NLAT; row += NGW) {
        const hf* xr = X16 + (size_t)row * DM; float* orow = out + (size_t)row * DM; const float rstd = rstd4(ss, row);
#pragma unroll
        for (int j = 0; j < 4; ++j) { const hf4 xh = *(const hf4*)(xr + 4 * lane + 256 * j); const f32x4 x = {(float)xh[0], (float)xh[1], (float)xh[2], (float)xh[3]};
            *(f32x4*)(orow + 4 * lane + 256 * j) = (x * rstd) * g[j]; }
    }
}

__device__ __forceinline__ void prep_rope(const Frame& F, const Params& p) {
    const int gw = F.vcu * 8 + F.wave, NGW = F.G * 8, lane = F.lane;
    hf* KR = (hf*)(p.ws + A_KR); hf* DK = (hf*)(p.ws + A_DK); const float* rope = (const float*)(p.ws + WS_ROPE);
    const int hh = lane >> 3, i0 = 2 * (lane & 7);
    for (int row0 = gw * 4; row0 < NLAT; row0 += NGW * 4) {
        hf2 a[4], b[4]; f32x2 c[4], sn[4]; float y1[4], y2[4], cc[4], ss[4];
#pragma unroll
        for (int q = 0; q < 4; ++q) { const int row = row0 + q, t = row & (SEQ - 1); const hf* dk = DK + (size_t)row * 256 + hh * 32 + i0;
            a[q] = *(const hf2*)dk; b[q] = *(const hf2*)(dk + 16); c[q] = *(const f32x2*)(rope + t * 32 + i0); sn[q] = *(const f32x2*)(rope + t * 32 + 16 + i0);
            if (lane < 16) { const hf* kr = KR + (size_t)row * 32 + lane; y1[q] = (float)kr[0]; y2[q] = (float)kr[16]; cc[q] = rope[t * 32 + lane]; ss[q] = rope[t * 32 + 16 + lane]; } }
#pragma unroll
        for (int q = 0; q < 4; ++q) { const int row = row0 + q; hf* dk = DK + (size_t)row * 256 + hh * 32 + i0;
            const float x1[2] = {(float)a[q][0], (float)a[q][1]}, x2[2] = {(float)b[q][0], (float)b[q][1]};
            *(unsigned*)dk = pkh(x1[0] * c[q][0] - x2[0] * sn[q][0], x1[1] * c[q][1] - x2[1] * sn[q][1]);
            *(unsigned*)(dk + 16) = pkh(x2[0] * c[q][0] + x1[0] * sn[q][0], x2[1] * c[q][1] + x1[1] * sn[q][1]);
            if (lane < 16) { hf* kr = KR + (size_t)row * 32 + lane; kr[0] = (hf)(y1[q] * cc[q] - y2[q] * ss[q]); kr[16] = (hf)(y2[q] * cc[q] + y1[q] * ss[q]); } }
    }
}
__device__ __forceinline__ void prep_hyena(const Frame& F, const Params& p, int l, bool with_ctx) {
    constexpr int INP = 784;
    constexpr int OUTP = 33;
    constexpr int OFF_OU = 66 * INP, OFF_OX = OFF_OU + 128 * OUTP * 4;
    const hf* PHY = (const hf*)(p.ws + A_PHY);
    LAS unsigned char* lds = F.lds; const int tid = F.tid;
    const float* cw = p.in[I_HCW] + (size_t)l * 3 * 768; const float* cb = p.in[I_HCB] + (size_t)l * 768;
    constexpr int U_LAT = NB * (SEQ / 64) * 2, U_CTX = NB * (CTXL / 64) * 2;
    const int nunit = U_LAT + (with_ctx ? U_CTX : 0);
    for (int un = F.vcu; un < nunit; un += F.G) {
        const bool ctx = un >= U_LAT; int r = ctx ? un - U_LAT : un; const int L = ctx ? CTXL : SEQ, ntile = L / 64;
        const int ch = r & 1; r >>= 1; const int tt = r % ntile, b = r / ntile;
        const int t0 = tt * 64; const size_t rowbase = ctx ? (size_t)NLAT + (size_t)b * CTXL : (size_t)b * SEQ;
        hf* dU = (hf*)((unsigned char*)p.out + (ctx ? O_UTC : O_UT)); hf* dX = (hf*)((unsigned char*)p.out + (ctx ? O_X0TC : O_X0T));
        __syncthreads();
        {
            u32x4 tmp[7];
#pragma unroll
            for (int k = 0; k < 7; ++k) { const int i = tid + 512 * k, rr = i / 48, q = i % 48, seg = q >> 4, c16 = q & 15; const int t = t0 - 1 + rr;
                tmp[k] = (u32x4){0u, 0u, 0u, 0u};
                if (i < 66 * 48 && t >= 0 && t < L) tmp[k] = *(const u32x4*)(PHY + (rowbase + t) * 768 + seg * 256 + ch * 128 + c16 * 8); }
#pragma unroll
            for (int k = 0; k < 7; ++k) { const int i = tid + 512 * k, rr = i / 48, q = i % 48, seg = q >> 4, c16 = q & 15;
                if (i < 66 * 48) *(LAS u32x4*)(lds + rr * INP + seg * 256 + c16 * 16) = tmp[k]; }
        }
        __syncthreads();
        {
            const int c = tid & 127, tg = tid >> 7, cg = ch * 128 + c;
            const float a0 = cw[cg], a1 = cw[768 + cg], a2 = cw[1536 + cg], ab = cb[cg];
            const float b0 = cw[256 + cg], b1 = cw[768 + 256 + cg], b2 = cw[1536 + 256 + cg], bb = cb[256 + cg];
            const float v0 = cw[512 + cg], v1 = cw[768 + 512 + cg], v2 = cw[1536 + 512 + cg], vb = cb[512 + cg];
            const LAS hf* in = (const LAS hf*)(lds + (16 * tg) * INP) + c;
            float p0 = (float)in[0], p1 = (float)in[128], p2 = (float)in[256];
            float c0 = (float)in[INP / 2], c1 = (float)in[INP / 2 + 128], c2 = (float)in[INP / 2 + 256];
            LAS hf* ou = (LAS hf*)(lds + OFF_OU) + c * (OUTP * 2) + 16 * tg; LAS hf* ox = (LAS hf*)(lds + OFF_OX) + c * (OUTP * 2) + 16 * tg;
#pragma unroll
            for (int j = 0; j < 16; ++j) { const LAS hf* nx = in + (j + 2) * (INP / 2);
                const float n0 = (float)nx[0], n1 = (float)nx[128], n2 = (float)nx[256];
                const float x0 = a0 * p0 + a1 * c0 + a2 * n0 + ab, x1 = b0 * p1 + b1 * c1 + b2 * n1 + bb, vv = v0 * p2 + v1 * c2 + v2 * n2 + vb;
                ou[j] = (hf)(vv * x1); ox[j] = (hf)x0;
                p0 = c0; p1 = c1; p2 = c2; c0 = n0; c1 = n1; c2 = n2; }
        }
        __syncthreads();
        {
            const int c = tid >> 2, q = tid & 3; const size_t go = ((size_t)(ch * 128 + c) * NB + b) * L + t0 + 16 * q;
            const LAS unsigned* su = (const LAS unsigned*)(lds + OFF_OU) + c * OUTP + 8 * q; const LAS unsigned* sx = (const LAS unsigned*)(lds + OFF_OX) + c * OUTP + 8 * q;
            u32x4 w0 = {su[0], su[1], su[2], su[3]}, w1 = {su[4], su[5], su[6], su[7]};
            *(u32x4*)(dU + go) = w0; *(u32x4*)(dU + go + 8) = w1;
            u32x4 y0 = {sx[0], sx[1], sx[2], sx[3]}, y1 = {sx[4], sx[5], sx[6], sx[7]};
            *(u32x4*)(dX + go) = y0; *(u32x4*)(dX + go + 8) = y1;
        }
    }
    __syncthreads();
}

namespace att {
#ifndef PROF_SEL
#define PROF_SEL -1
#endif
#define ATT_MARK(b) do { if (PROF_SEL >= 0 && F.tid == 0) { volatile LAS unsigned* _pf = (volatile LAS unsigned*)(F.lds + LDS_BYTES - 512); const unsigned _t = (unsigned)__builtin_amdgcn_s_memrealtime(); _pf[(b)] += _t - _pf[32]; _pf[32] = _t; } } while (0)
__device__ __forceinline__ int crow(int r, int hi) { return (r & 3) + 8 * (r >> 2) + 4 * hi; }
#define SBAR() __builtin_amdgcn_sched_barrier(0)
constexpr float THR2 = 8.f * 1.4426950408889634f;
constexpr int KS_MLA = 208, KS_DF = 80;
constexpr int VS = 192, VB = 64 * VS;
constexpr int OFF_V = 32768;
template <int OFF> __device__ __forceinline__ s16x4 tr_read(int vb) {
    s16x4 r; asm volatile("ds_read_b64_tr_b16 %0, %1 offset:%2" : "=&v"(r) : "v"(vb), "i"(OFF) : "memory"); return r;
}
__device__ __forceinline__ int kpos(int key) { return (key & ~0xC) | ((key & 4) << 1) | ((key & 8) >> 1); }

template <int ND0, int KS>
__device__ __forceinline__ void qkt(f32x16& p0, f32x16& p1, const LAS unsigned char* Ks, const hf8* qr, int r32, int hi, const f32x16& negm) {
#pragma unroll
    for (int d0 = 0; d0 < ND0; ++d0) { const int cb = (d0 * 16 + hi * 8) * 2;
        const hf8 b0 = *(const LAS hf8*)(Ks + r32 * KS + cb), b1 = *(const LAS hf8*)(Ks + (32 + r32) * KS + cb);
        if (d0 == 0) { p0 = __builtin_amdgcn_mfma_f32_32x32x16_f16(b0, qr[0], negm, 0, 0, 0); p1 = __builtin_amdgcn_mfma_f32_32x32x16_f16(b1, qr[0], negm, 0, 0, 0); }
        else { p0 = __builtin_amdgcn_mfma_f32_32x32x16_f16(b0, qr[d0], p0, 0, 0, 0); p1 = __builtin_amdgcn_mfma_f32_32x32x16_f16(b1, qr[d0], p1, 0, 0, 0); } }
}
__device__ __forceinline__ float max3f(float a, float b, float c) { float r; asm("v_max3_f32 %0, %1, %2, %3" : "=v"(r) : "v"(a), "v"(b), "v"(c)); return r; }
__device__ __forceinline__ float max2f(float a, float b) { float r; asm("v_max_f32_e32 %0, %1, %2" : "=v"(r) : "v"(a), "v"(b)); return r; }
__device__ __forceinline__ float max16(const f32x16& p) { float r, t;
    asm("v_max3_f32 %0, %2, %3, %4\n\tv_max3_f32 %1, %10, %11, %12\n\tv_max3_f32 %0, %0, %5, %6\n\tv_max3_f32 %1, %1, %13, %14\n\tv_max3_f32 %0, %0, %7, %8\n\tv_max3_f32 %1, %1, %15, %16\n\tv_max3_f32 %0, %0, %9, %17\n\tv_max_f32_e32 %0, %0, %1"
        : "=&v"(r), "=&v"(t) : "v"(p[0]), "v"(p[1]), "v"(p[2]), "v"(p[3]), "v"(p[4]), "v"(p[5]), "v"(p[6]), "v"(p[7]), "v"(p[8]), "v"(p[9]), "v"(p[10]), "v"(p[11]), "v"(p[12]), "v"(p[13]), "v"(p[14]), "v"(p[15]));
    return r; }
__device__ __forceinline__ hf8 pack8(const f32x16& p, int b) { u32x4 w = {pkh(p[b], p[b + 1]), pkh(p[b + 2], p[b + 3]), pkh(p[b + 4], p[b + 5]), pkh(p[b + 6], p[b + 7])}; return __builtin_bit_cast(hf8, w); }
__device__ __forceinline__ void sm_max(f32x16& p0, f32x16& p1, float& m, float& l, f32x16& o0, f32x16& o1, f32x16& negm, const bool first) {
    float pmax = max2f(max16(p0), max16(p1));
    { auto rr = __builtin_amdgcn_permlane32_swap(__float_as_uint(pmax), __float_as_uint(pmax), false, false);
      pmax = max2f(__uint_as_float(rr[0]), __uint_as_float(rr[1])); }
    if (first || __any(pmax > THR2)) {
        const float delta = first ? pmax : fmaxf(pmax, 0.f);
        if (!first) { const float alpha = __builtin_amdgcn_exp2f(-delta); l *= alpha;
#pragma unroll
            for (int r = 0; r < 16; ++r) { o0[r] *= alpha; o1[r] *= alpha; } }
#pragma unroll
        for (int r = 0; r < 16; ++r) { p0[r] -= delta; p1[r] -= delta; }
        m += delta;
#pragma unroll
        for (int r = 0; r < 16; ++r) negm[r] = -m;
        asm volatile("" : "+v"(negm));
    }
}
__device__ __forceinline__ void sm_exp(f32x16& p0, f32x16& p1, const float m, float& l, hf8& pf0, hf8& pf1, hf8& pf2, hf8& pf3) {
#pragma unroll
    for (int r = 0; r < 16; ++r) { p0[r] = __builtin_amdgcn_exp2f(p0[r]); p1[r] = __builtin_amdgcn_exp2f(p1[r]); }
    float ps0 = p0[0] + p1[0], ps1 = p0[1] + p1[1], ps2 = p0[2] + p1[2], ps3 = p0[3] + p1[3];
#pragma unroll
    for (int r = 4; r < 16; r += 4) { ps0 += p0[r] + p1[r]; ps1 += p0[r + 1] + p1[r + 1]; ps2 += p0[r + 2] + p1[r + 2]; ps3 += p0[r + 3] + p1[r + 3]; }
    l += (ps0 + ps1) + (ps2 + ps3);
    pf0 = pack8(p0, 0); pf1 = pack8(p0, 8); pf2 = pack8(p1, 0); pf3 = pack8(p1, 8);
}
__device__ __forceinline__ void pv(const hf8 pf0, const hf8 pf1, const hf8 pf2, const hf8 pf3, f32x16& o0, f32x16& o1, const LAS unsigned char* Vt, int r32, int hi) {
    const int lg = (int)(threadIdx.x & 15), vq = lg >> 2, vp4 = lg & 3;
    const int vbase = (int)(unsigned)(uintptr_t)Vt + (4 * hi + vq) * VS + (16 * ((int)(threadIdx.x >> 4) & 1) + 4 * vp4) * 2;
#define PVRD(ks, L0, H0, L1, H1) s16x4 L0 = tr_read<(16 * (ks)) * VS>(vbase), H0 = tr_read<(16 * (ks) + 8) * VS>(vbase), L1 = tr_read<(16 * (ks)) * VS + 64>(vbase), H1 = tr_read<(16 * (ks) + 8) * VS + 64>(vbase)
#define PVMM(N, L0, H0, L1, H1, pf) do { asm volatile("s_waitcnt lgkmcnt(" #N ")" : "+v"(L0), "+v"(H0), "+v"(L1), "+v"(H1) :: "memory"); \
        const hf8 a0 = __builtin_bit_cast(hf8, (short __attribute__((ext_vector_type(8)))){L0[0], L0[1], L0[2], L0[3], H0[0], H0[1], H0[2], H0[3]}); \
        const hf8 a1 = __builtin_bit_cast(hf8, (short __attribute__((ext_vector_type(8)))){L1[0], L1[1], L1[2], L1[3], H1[0], H1[1], H1[2], H1[3]}); \
        o0 = __builtin_amdgcn_mfma_f32_32x32x16_f16(a0, pf, o0, 0, 0, 0); o1 = __builtin_amdgcn_mfma_f32_32x32x16_f16(a1, pf, o1, 0, 0, 0); } while (0)
    PVRD(0, a0l, a0h, a1l, a1h); PVRD(1, b0l, b0h, b1l, b1h);
    PVMM(4, a0l, a0h, a1l, a1h, pf0);
    PVRD(2, c0l, c0h, c1l, c1h);
    PVMM(4, b0l, b0h, b1l, b1h, pf1);
    PVRD(3, d0l, d0h, d1l, d1h);
    PVMM(4, c0l, c0h, c1l, c1h, pf2);
    PVMM(0, d0l, d0h, d1l, d1h, pf3);
#undef PVRD
#undef PVMM
#define PVK(ks, pf)
#undef PVK
}

template <bool MLA>
__device__ __forceinline__ void attn_pass(const Frame& F, const Params& p, int hq, int hv, int qrow0, int qpos0, int klat0, int nlat, int kctx0, f32x16& o0, f32x16& o1, float& inv) {
    constexpr int DK = MLA ? 96 : 32, ND0 = DK / 16, KS = MLA ? KS_MLA : KS_DF, KB = 64 * KS;
    constexpr float SCALE = MLA ? MLA_SCALE : DF_SCALE, C = SCALE * 1.4426950408889634f;
    const int tid = F.tid, wid = F.wave, lane = F.lane, r32 = lane & 31, hi = lane >> 5;
    const hf* QKV = (const hf*)(p.ws + A_QKV); const hf* KRb = (const hf*)(p.ws + A_KR);
    const hf* DQ = (const hf*)(p.ws + A_DQ); const hf* DKb = (const hf*)(p.ws + A_DK); const hf* DVb = (const hf*)(p.ws + A_DV);
    const float* rope = (const float*)(p.ws + WS_ROPE);
    LAS unsigned char* lds = F.lds;
    hf8 qr[ND0];
    {
        const int qrow = qrow0 + wid * 32 + r32;
        const hf* qp = MLA ? QKV + (size_t)qrow * NUP + hq * 96 + hi * 8 : DQ + (size_t)qrow * 256 + hq * 32 + hi * 8;
        hf8 raw[ND0];
#pragma unroll
        for (int d0 = 0; d0 < ND0; ++d0) raw[d0] = *(const hf8*)(qp + d0 * 16);
        f32x4 c0 = {1.f, 1.f, 1.f, 1.f}, c1 = c0, s0 = {0.f, 0.f, 0.f, 0.f}, s1 = s0;
        if (qpos0 >= 0) { const int t = qpos0 + wid * 32 + r32;
            c0 = *(const f32x4*)(rope + t * 32 + hi * 8); c1 = *(const f32x4*)(rope + t * 32 + hi * 8 + 4);
            s0 = *(const f32x4*)(rope + t * 32 + 16 + hi * 8); s1 = *(const f32x4*)(rope + t * 32 + 16 + hi * 8 + 4); }
#pragma unroll
        for (int d0 = 0; d0 < ND0 - 2; ++d0) {
#pragma unroll
            for (int j = 0; j < 8; ++j) qr[d0][j] = (hf)((float)raw[d0][j] * C); }
#pragma unroll
        for (int j = 0; j < 8; ++j) { const float cc = j < 4 ? c0[j & 3] : c1[j & 3], sn = j < 4 ? s0[j & 3] : s1[j & 3]; const float a = (float)raw[ND0 - 2][j], b = (float)raw[ND0 - 1][j];
            qr[ND0 - 2][j] = (hf)((a * cc - b * sn) * C); qr[ND0 - 1][j] = (hf)((b * cc + a * sn) * C); }
    }
    const int k1r = MLA ? (tid >> 3) : ((tid & 255) >> 2), k1c = MLA ? (tid & 7) * 8 : (tid & 3) * 8;
    const int k2r = (tid & 255) >> 2, k2c = (tid & 3) * 8;
    const int vr_ = tid >> 3, vc_ = (tid & 7) * 8;
    const bool klo = tid < 256;
    struct Stg { u32x4 v, k1, k2; };
    Stg sA, sB; sA.v = sA.k1 = sA.k2 = sB.v = sB.k1 = sB.k2 = (u32x4){0u, 0u, 0u, 0u};
    const int ntile = nlat + 4;
#define KROW0(j) (((j) < nlat) ? klat0 + (j) * 64 : kctx0 + ((j) - nlat) * 64)
#define A_LOADK(S, j) do { const int kr0 = KROW0(j); \
        if (MLA) { S.k1 = *(const u32x4*)(QKV + (size_t)(kr0 + k1r) * NUP + 768 + hq * 128 + k1c); S.k2 = *(const u32x4*)(KRb + (size_t)(kr0 + k2r) * 32 + k2c); } \
        else S.k1 = *(const u32x4*)(DKb + (size_t)(kr0 + k1r) * 256 + hq * 32 + k1c); } while (0)
#define A_LOADV(S, j) do { const int kr0 = KROW0(j); \
        if (MLA) S.v = *(const u32x4*)(QKV + (size_t)(kr0 + vr_) * NUP + 768 + hv * 128 + 64 + vc_); else S.v = *(const u32x4*)(DVb + (size_t)(kr0 + vr_) * 256 + hv * 64 + vc_); } while (0)
#define A_WRITEK(S, b) do { *(LAS u32x4*)(lds + (b) * KB + k1r * KS + k1c * 2) = S.k1; if (MLA) *(LAS u32x4*)(lds + (b) * KB + k2r * KS + 128 + k2c * 2) = S.k2; } while (0)
#define A_WRITEV(S, b) do { *(LAS u32x4*)(lds + OFF_V + (b) * VB + vr_ * VS + vc_ * 2) = S.v; } while (0)
    float m_reg = 0.f, l_reg = 0.f;
    f32x16 negm = f32x16{}; asm volatile("" : "+v"(negm));
    o0 = f32x16{}; o1 = f32x16{};
    f32x16 pA0, pA1, pB0, pB1;
    __syncthreads();
    const int nt1 = ntile - 1;
#define TCL(j) (((j) < nt1) ? (j) : nt1)
    A_LOADK(sA, 0); A_LOADV(sA, 0); A_LOADK(sB, 1);
    A_WRITEK(sA, 0); A_WRITEV(sA, 0); A_WRITEK(sB, 1);
    A_LOADK(sA, TCL(2));
    A_LOADV(sA, 1);
    __syncthreads();
    qkt<ND0, KS>(pA0, pA1, lds, qr, r32, hi, negm);
    hf8 f0, f1, f2, f3;
    if (wid >= 4) __syncthreads();
    for (int j = 0; j < ntile; j += 2) {
        A_LOADK(sB, TCL(j + 3)); A_LOADV(sB, TCL(j + 2));
        sm_max(pA0, pA1, m_reg, l_reg, o0, o1, negm, j == 0);
        sm_exp(pA0, pA1, m_reg, l_reg, f0, f1, f2, f3);
        __syncthreads();
        qkt<ND0, KS>(pB0, pB1, lds + KB, qr, r32, hi, negm);
        pv(f0, f1, f2, f3, o0, o1, lds + OFF_V, r32, hi);
        A_WRITEK(sA, 0); A_WRITEV(sA, 1);
        __syncthreads();
        A_LOADK(sA, TCL(j + 4)); A_LOADV(sA, TCL(j + 3));
        sm_max(pB0, pB1, m_reg, l_reg, o0, o1, negm, false);
        sm_exp(pB0, pB1, m_reg, l_reg, f0, f1, f2, f3);
        __syncthreads();
        qkt<ND0, KS>(pA0, pA1, lds, qr, r32, hi, negm);
        pv(f0, f1, f2, f3, o0, o1, lds + OFF_V + VB, r32, hi);
        A_WRITEK(sB, 1); A_WRITEV(sB, 0);
        __syncthreads();
    }
    if (wid < 4) __syncthreads();
#undef TCL
#undef KROW0
#undef A_LOADK
#undef A_LOADV
#undef A_WRITEK
#undef A_WRITEV
    const float lt = l_reg + __shfl_xor(l_reg, 32); inv = __builtin_amdgcn_rcpf(lt);
}
template <bool MLA>
__device__ __forceinline__ void attn_unit(const Frame& F, const Params& p, int l, int h, int qrow0, int qpos0, int klat0, int nlat, int kctx0) {
    const int wid = F.wave, lane = F.lane, r32 = lane & 31, hi = lane >> 5;
    hf* Y = (hf*)(p.ws + A_Y);
    const size_t yrow = (size_t)(qrow0 + wid * 32 + r32) * DM;
    if constexpr (MLA) {
        f32x16 o0, o1; float inv;
        attn_pass<true>(F, p, h, h, qrow0, qpos0, klat0, nlat, kctx0, o0, o1, inv);
#pragma unroll
        for (int g = 0; g < 4; ++g) { u32x2 w; w.x = pkhb(o0[4 * g] * inv, o0[4 * g + 1] * inv); w.y = pkhb(o0[4 * g + 2] * inv, o0[4 * g + 3] * inv); *(u32x2*)(Y + yrow + h * 64 + 8 * g + 4 * hi) = w; }
#pragma unroll
        for (int g = 0; g < 4; ++g) { u32x2 w; w.x = pkhb(o1[4 * g] * inv, o1[4 * g + 1] * inv); w.y = pkhb(o1[4 * g + 2] * inv, o1[4 * g + 3] * inv); *(u32x2*)(Y + yrow + h * 64 + 32 + 8 * g + 4 * hi) = w; }
    } else {
        const float lam = ((const float*)(p.ws + WS_LAM))[2 * l], oml = ((const float*)(p.ws + WS_LAM))[2 * l + 1];
        f32x16 a0, a1;
        LAS float* park = (LAS float*)(F.lds + 65536 + wid * 8192) + lane;
        { f32x16 o0, o1; float inv; attn_pass<false>(F, p, 2 * h, h, qrow0, qpos0, klat0, nlat, kctx0, o0, o1, inv);
#pragma unroll
          for (int r = 0; r < 16; ++r) { park[r * 64] = o0[r] * inv; park[(16 + r) * 64] = o1[r] * inv; } }
        { f32x16 o0, o1; float inv; attn_pass<false>(F, p, 2 * h + 1, h, qrow0, qpos0, klat0, nlat, kctx0, o0, o1, inv);
#pragma unroll
          for (int r = 0; r < 16; ++r) { a0[r] = park[r * 64] - o0[r] * (lam * inv); a1[r] = park[(16 + r) * 64] - o1[r] * (lam * inv); } }
        float ss = 0.f;
#pragma unroll
        for (int r = 0; r < 16; ++r) ss += a0[r] * a0[r] + a1[r] * a1[r];
        ss += __shfl_xor(ss, 32);
        const float rs = rsqrtf(ss * (1.f / 64.f) + EPS) * oml;
#pragma unroll
        for (int g = 0; g < 4; ++g) { const f32x4 gg = *(const f32x4*)(p.in[I_SUBG] + l * 64 + 8 * g + 4 * hi);
            u32x2 w; w.x = pkhb(a0[4 * g] * rs * gg[0], a0[4 * g + 1] * rs * gg[1]); w.y = pkhb(a0[4 * g + 2] * rs * gg[2], a0[4 * g + 3] * rs * gg[3]); *(u32x2*)(Y + yrow + 768 + h * 64 + 8 * g + 4 * hi) = w; }
#pragma unroll
        for (int g = 0; g < 4; ++g) { const f32x4 gg = *(const f32x4*)(p.in[I_SUBG] + l * 64 + 32 + 8 * g + 4 * hi);
            u32x2 w; w.x = pkhb(a1[4 * g] * rs * gg[0], a1[4 * g + 1] * rs * gg[1]); w.y = pkhb(a1[4 * g + 2] * rs * gg[2], a1[4 * g + 3] * rs * gg[3]); *(u32x2*)(Y + yrow + 768 + h * 64 + 32 + 8 * g + 4 * hi) = w; }
    }
}
}

#define HY_MARK(b) do { if (PROF_SEL >= 0 && F.tid == 0) { volatile LAS unsigned* _pf = (volatile LAS unsigned*)(F.lds + LDS_BYTES - 512); const unsigned _t = (unsigned)__builtin_amdgcn_s_memrealtime(); _pf[(b)] += _t - _pf[32]; _pf[32] = _t; } } while (0)
template <int L>
__device__ __forceinline__ void hyena_unit(const Frame& F, const hf* Rrow  , const hf* U  , const hf* X0  , hf* Ycol  ) {
    constexpr int NM = L / 256, RL = 2 * L, SH = (L > 1024) ? 1024 : L, NH = L / SH, US = SH * 2 + 16;
    constexpr int OFF_U = 8 * RL * 2;
    constexpr int XP = L * 2 + 16;
    static_assert(OFF_U + 32 * US <= LDS_MISC && 32 * XP <= LDS_MISC, "hyena LDS");
    const int tid = F.tid, w = F.wave, lane = F.lane, i32 = lane & 31, hi = lane >> 5;
    LAS unsigned char* lds = F.lds;
    __syncthreads();
    for (int i = tid; i < RL / 8; i += 512) *(LAS u32x4*)(lds + i * 16) = *(const u32x4*)(Rrow + i * 8);
    __syncthreads();
    {
        const LAS unsigned* src = (const LAS unsigned*)lds;
#pragma unroll 1
        for (int idx = tid; idx < 7 * (RL / 8); idx += 512) { const int cw = 1 + idx / (RL / 8), c4 = (idx % (RL / 8)) * 4;
            const int k0 = c4 - ((cw + 1) >> 1); unsigned d[5];
#pragma unroll
            for (int e = 0; e < 5; ++e) { const int k = k0 + e; d[e] = (k >= 0 && k < RL / 2) ? src[k] : 0u; }
            u32x4 o;
            if (cw & 1) { o.x = (d[0] >> 16) | (d[1] << 16); o.y = (d[1] >> 16) | (d[2] << 16); o.z = (d[2] >> 16) | (d[3] << 16); o.w = (d[3] >> 16) | (d[4] << 16); }
            else { o.x = d[0]; o.y = d[1]; o.z = d[2]; o.w = d[3]; }
            *(LAS u32x4*)(lds + cw * (RL * 2) + c4 * 4) = o; }
    }
    HY_MARK(22);
    f32x16 acc[NM];
#pragma unroll
    for (int m = 0; m < NM; ++m) acc[m] = f32x16{};
    const LAS unsigned char* cpy = lds + w * (RL * 2);
    for (int half = 0; half < NH; ++half) {
        __syncthreads();
        {
            constexpr int NPC = 32 * (SH / 8) / 512, NB4 = NPC > 4 ? 4 : NPC;
            int tq = tid; asm volatile("" : "+v"(tq));
#pragma unroll
            for (int k0 = 0; k0 < NPC; k0 += NB4) { u32x4 tmp[NB4];
#pragma unroll
                for (int k = 0; k < NB4; ++k) { const int idx = tq + 512 * (k0 + k), b = idx / (SH / 8), pc = idx % (SH / 8); tmp[k] = *(const u32x4*)(U + (size_t)b * L + half * SH + pc * 8); }
#pragma unroll
                for (int k = 0; k < NB4; ++k) { const int idx = tq + 512 * (k0 + k), b = idx / (SH / 8), pc = idx % (SH / 8); *(LAS u32x4*)(lds + OFF_U + b * US + pc * 16) = tmp[k]; }
                asm volatile("" ::: "memory"); }
        }
        __syncthreads();
#pragma unroll 2
        for (int jl = 0; jl < SH / 16; ++jl) {
            const int j = half * (SH / 16) + jl;
            const hf8 bf = *(const LAS hf8*)(lds + OFF_U + i32 * US + (jl * 16 + hi * 8) * 2);
            const int x0 = L + 16 * j + 8 * hi - 8 * i32;
#pragma unroll
            for (int m = 0; m < NM; ++m) { const hf8 af = *(const LAS hf8*)(cpy + (x0 - 256 * m) * 2);
                acc[m] = __builtin_amdgcn_mfma_f32_32x32x16_f16(af, bf, acc[m], 0, 0, 0); }
        }
    }
    __syncthreads();
    HY_MARK(23);
    {
        constexpr int NPC = 32 * (L / 8) / 512, NB8 = NPC > 4 ? 4 : NPC;
        int tq = tid; asm volatile("" : "+v"(tq));
#pragma unroll
        for (int k0 = 0; k0 < NPC; k0 += NB8) { u32x4 tmp[NB8];
#pragma unroll
            for (int k = 0; k < NB8; ++k) { const int idx = tq + 512 * (k0 + k), b = idx / (L / 8), pc = idx % (L / 8); tmp[k] = *(const u32x4*)(X0 + (size_t)b * L + pc * 8); }
#pragma unroll
            for (int k = 0; k < NB8; ++k) { const int idx = tq + 512 * (k0 + k), b = idx / (L / 8), pc = idx % (L / 8); *(LAS u32x4*)(lds + b * XP + pc * 16) = tmp[k]; }
            asm volatile("" ::: "memory"); }
    }
    __syncthreads();
    HY_MARK(24);
    const LAS hf* x0p = (const LAS hf*)(lds + i32 * XP) + w + 32 * hi;
    hf* yp = Ycol + ((size_t)i32 * L + w + 32 * hi) * DM;
#pragma unroll
    for (int m = 0; m < NM; ++m) {
#pragma unroll
        for (int r = 0; r < 16; ++r) { const int tt = 256 * m + 8 * ((r & 3) + 8 * (r >> 2));
            const float x0v = (float)x0p[tt];
            { const float yv = x0v * acc[m][r]; unsigned ub = __float_as_uint(yv); ub += 0x7fffu + ((ub >> 16) & 1u); yp[(size_t)tt * DM] = (hf)__uint_as_float(ub & 0xffff0000u); } }
        asm volatile("" ::: "memory");
    }
    HY_MARK(25);
}

#ifndef PH_MASK
#define PH_MASK 0x1FFFF
#endif
#define PHM(k) ((PH_MASK >> (k)) & 1)
#ifndef PROBE_REP
#define PROBE_REP 0
#endif
#define NREP(k) (((PROBE_REP >> (k)) & 1) ? 2 : 1)
constexpr int NPH_LAYER = 7, PH_L0 = 2, NPHASE = PH_L0 + DEPTH * NPH_LAYER + 1;
__global__ void __launch_bounds__(512, 2) fwd_kernel(Params p) {
    extern __shared__ __attribute__((aligned(16))) unsigned char lds_raw[];
    Frame F0; Frame& F = F0;
    F.lds = (LAS unsigned char*)lds_raw;
    F.tid = threadIdx.x; F.lane = F.tid & 63; F.wave = __builtin_amdgcn_readfirstlane(F.tid >> 6);
    F.G = gridDim.x; { const int bx = blockIdx.x; F.vcu = (F.G % 8 == 0) ? (bx % 8) * (F.G / 8) + bx / 8 : bx; }
    volatile LAS unsigned* misc = (volatile LAS unsigned*)(F.lds + LDS_MISC);
    if (F.tid < 16) misc[F.tid] = 0u;
    __syncthreads();
    const int lo = p.ph_lo, hi = p.ph_hi;
    XcdBarrier bar; bar.bar = (unsigned*)(p.ws + WS_BAR); bar.x = 0; bar.st = misc;
    if (hi - lo > 1) bar = xcd_barrier_post((unsigned*)(p.ws + WS_BAR), misc);
#define IN(k) (lo <= (k) && (k) < hi)
#define LAUNDER(Fl) Frame Fl = F0; asm volatile("" : "+v"(Fl.tid), "+v"(Fl.lane))
#ifndef PROF_SEL
#define PROF_SEL -1
#endif
#define PROF_K 8
    volatile LAS unsigned* prof = (volatile LAS unsigned*)(F.lds + LDS_BYTES - 512);
    if (PROF_SEL >= 0 && F.tid < 40) prof[F.tid] = 0u;
    if (PROF_SEL >= 0) __syncthreads();
    if (PROF_SEL >= 0 && F.tid == 0) prof[32] = (unsigned)__builtin_amdgcn_s_memrealtime();
#define PROF_MARK(b) do { if (PROF_SEL >= 0 && F.tid == 0) { const unsigned _t = (unsigned)__builtin_amdgcn_s_memrealtime(); prof[(b)] += _t - prof[32]; if ((b) >= 16) prof[30] += _t - prof[32]; prof[32] = _t; } } while (0)
#define SEAMT(k, b) do { PROF_MARK(b); if (IN(k) && IN((k) + 1)) xcd_barrier(bar); PROF_MARK(16 + (b)); } while (0)
#define SEAM(k) do { if (IN(k) && IN((k) + 1)) xcd_barrier(bar); } while (0)
    unsigned char* ws = p.ws;
    hf* X16 = (hf*)(ws + WS_X16);
    hf* XS1 = (hf*)p.out; hf* MM = (hf*)p.out; hf* Y = (hf*)(ws + A_B); hf* XS2 = (hf*)(ws + A_B);
    hf* QKV = (hf*)(ws + A_QKV); hf* QKVN = (hf*)(ws + A_QKVN);
    unsigned char* Gt = (unsigned char*)(ws + A_G); hf* HID = (hf*)(ws + A_HID);
    float* SS = (float*)(ws + WS_SS);

    if (PHM(11) && IN(0)) for (int rep = 0; rep < NREP(11); ++rep) { LAUNDER(Fl); prologue_a(Fl, p); }
    SEAMT(0, 9);
    if (PHM(11) && IN(1)) for (int rep = 0; rep < NREP(12); ++rep) { LAUNDER(Fl); prologue_b(Fl, p); }
    SEAMT(1, 9);

    for (int l = 0; l < DEPTH; ++l) {
        const int pb = PH_L0 + l * NPH_LAYER;
        const bool ctx_live = l < DEPTH - 1;
        const int Mrows = ctx_live ? MTOT : NLAT;
        const float* modl = (const float*)(ws + WS_MOD) + (size_t)l * NMODV * MODW;
        const float* biasl = (const float*)(ws + WS_BIAS) + (size_t)l * NMODV * NBIAS;
        const float* gsl = (const float*)(ws + WS_GS) + (size_t)l * 2 * NMODV * DM;
        const unsigned char* wl = ws + WS_WT + (size_t)(l & 1) * W_LAYER;
        float* ss1 = SS + (size_t)(SS_1 + l) * MTOT * 4; float* ss2 = SS + (size_t)(SS_2 + l) * MTOT * 4;
        float* ssq = (float*)(ws + WS_SSQ) + (size_t)l * MTOT; float* sskv = (float*)(ws + WS_SSKV) + (size_t)l * MTOT;
        LAS unsigned char* lx = F.lds + LDS_EXCH;

        if (PHM(1) && IN(pb + 0)) { pg8::Gemm g{XS1, (const hf*)(wl + W_IN1), MTOT, NP1, DM, DM, DM}; pg8::StaticOrder S; S.init(MTOT, NP1, F.G, (int)blockIdx.x);
            pg8::EpiIn E{QKVN, (hf*)(ws + A_KR), (hf*)(ws + A_PHY), (hf*)(ws + A_DQ), (hf*)(ws + A_DK), (hf*)(ws + A_DV), ss1, biasl + B_IN, ssq, sskv, lx};
            pg8::gemm_phase(F.lds, g, S, E); }
        SEAMT(pb + 0, 0);
        if (PHM(2) && IN(pb + 1)) {
            { LAUNDER(Fl); prep_rope(Fl, p); prep_hyena(Fl, p, l, ctx_live); }
            __syncthreads();
            PROF_MARK(1);
            { pg8::Gemm g{QKVN, (const hf*)(wl + W_UP), MTOT, NUP, KUP, KUP, KUP}; pg8::StaticOrder S; S.init(MTOT, NUP, F.G, (int)blockIdx.x);
              pg8::EpiUp E{QKV, ssq, sskv}; pg8::gemm_phase(F.lds, g, S, E); }
        }
        SEAMT(pb + 1, 2);
        if (PHM(4) && IN(pb + 2)) {
            {
            LAUNDER(Fl);
            PROF_MARK(14);
            const int n_mla = 2048 + (ctx_live ? 256 : 0);
            for (int id = F.vcu; id < n_mla; id += F.G) {
                if (id < 2048) { const int qb = id & 7, h = (id >> 3) & 7, b = id >> 6; att::attn_unit<true>(Fl, p, l, h, b * SEQ + qb * 256, qb * 256, b * SEQ, 32, NLAT + b * CTXL); }
                else { const int i2 = id - 2048, h = i2 & 7, b = i2 >> 3; att::attn_unit<true>(Fl, p, l, h, NLAT + b * CTXL, -1, 0, 0, NLAT + b * CTXL); }
            }
            PROF_MARK(11);
            const int n_df = 1024 + (ctx_live ? 128 : 0);
            for (int id = F.vcu; id < n_df; id += F.G) {
                if (id < 1024) { const int qb = id & 7, h = (id >> 3) & 3, b = id >> 5; att::attn_unit<false>(Fl, p, l, h, b * SEQ + qb * 256, qb * 256, b * SEQ, 32, NLAT + b * CTXL); }
                else { const int i2 = id - 1024, h = i2 & 3, b = i2 >> 2; att::attn_unit<false>(Fl, p, l, h, NLAT + b * CTXL, -1, 0, 0, NLAT + b * CTXL); }
            }
            PROF_MARK(12);
            const unsigned char* ob = (const unsigned char*)p.out;
            for (int c = F.vcu; c < 256; c += F.G)
                hyena_unit<SEQ>(Fl, (const hf*)(ws + WS_RF) + ((size_t)l * 256 + c) * 4096, (const hf*)(ob + O_UT) + (size_t)c * NLAT, (const hf*)(ob + O_X0T) + (size_t)c * NLAT, Y + 512 + c);
            if (ctx_live) for (int c = F.vcu; c < 256; c += F.G)
                hyena_unit<CTXL>(Fl, (const hf*)(ws + WS_RFC) + ((size_t)l * 256 + c) * 512, (const hf*)(ob + O_UTC) + (size_t)c * NCTX, (const hf*)(ob + O_X0TC) + (size_t)c * NCTX, Y + (size_t)NLAT * DM + 512 + c);
            __syncthreads();
            PROF_MARK(13);
            }
            { pg8::Gemm g{XS1, (const hf*)(wl + W_ING), Mrows, NGATE, DM, DM, DM}; pg8::StaticOrder S; S.init(Mrows, NGATE, F.G, (int)blockIdx.x);
              pg8::EpiGate8 E{Gt, ss1, biasl + B_G}; pg8::gemm_phase(F.lds, g, S, E); }
        }
        SEAMT(pb + 2, 4);
        if (PHM(6) && IN(pb + 3)) { pg8::Gemm g{Y, (const hf*)(wl + W_BR), Mrows, DM, DM, DM, DM}; pg8::StaticOrder S; S.init(Mrows, DM, F.G, (int)blockIdx.x);
            pg8::EpiMerge E{MM, Gt}; pg8::gemm_phase(F.lds, g, S, E); }
        SEAMT(pb + 3, 5);
        if (PHM(7) && IN(pb + 4)) { pg8::Gemm g{MM, (const hf*)(wl + W_OUT), Mrows, DM, DM, DM, DM}; pg8::StaticOrder S; S.init(Mrows, DM, F.G, (int)blockIdx.x);
            pg8::EpiResidX<true, true> E{X16, modl + 2 * DM, XS2, gsl + (size_t)NMODV * DM, ss2, lx}; pg8::gemm_phase(F.lds, g, S, E); }
        SEAMT(pb + 4, 6);
        if (PHM(9) && IN(pb + 5)) { pg8::Gemm g{XS2, (const hf*)(wl + W_FC1), Mrows, DFF, DM, DM, DM}; pg8::StaticOrder S; S.init(Mrows, DFF, F.G, (int)blockIdx.x);
            pg8::EpiHalf<2, true> E{HID, DFF, ss2, biasl + B_FC1}; pg8::gemm_phase(F.lds, g, S, E); }
        SEAMT(pb + 5, 7);
        if (PHM(10) && IN(pb + 6)) { pg8::Gemm g{HID, (const hf*)(wl + W_FC2), Mrows, DM, DFF, DFF, DFF}; pg8::StaticOrder S; S.init(Mrows, DM, F.G, (int)blockIdx.x);
            if (ctx_live) { pg8::EpiResidX<true, true> E{X16, modl + 5 * DM, XS1, gsl + (size_t)2 * NMODV * DM, ss1 + (size_t)MTOT * 4, lx}; pg8::gemm_phase(F.lds, g, S, E);
                const int nheavy = (MTOT / 256 * 4) % F.G;
                if (nheavy > 0 && (int)blockIdx.x >= nheavy) { __syncthreads(); LAUNDER(Fl); convert_layer(Fl, p, l + 1, ws + WS_WT + (size_t)((l + 1) & 1) * W_LAYER, (int)blockIdx.x - nheavy, F.G - nheavy); }
                else if (nheavy == 0) { __syncthreads(); LAUNDER(Fl); convert_layer(Fl, p, l + 1, ws + WS_WT + (size_t)((l + 1) & 1) * W_LAYER, Fl.vcu, F.G); } }
            else { pg8::EpiResidX<false, true> E{X16, modl + 5 * DM, nullptr, nullptr, SS + (size_t)SS_F * MTOT * 4, lx}; pg8::gemm_phase(F.lds, g, S, E); } }
        SEAMT(pb + 6, 8);
    }
    if (PHM(12) && IN(NPHASE - 1)) { LAUNDER(Fl); final_norm_phase(Fl, X16, p.out, p.in[I_FNG], SS + (size_t)SS_F * MTOT * 4); }
    PROF_MARK(10);
    if (PROF_SEL >= 0 && blockIdx.x == 0 && F.tid == 0) { const unsigned long long t0 = __builtin_amdgcn_s_memrealtime(); const unsigned long long d = (unsigned long long)PROF_K * prof[PROF_SEL];
        while (__builtin_amdgcn_s_memrealtime() - t0 < d) __builtin_amdgcn_s_sleep(8); }
#undef IN
#undef SEAM
}

extern "C" void kernel_launch(void* const* d_in, const int* in_sizes, int n_in, void* d_out, int out_size, void* d_ws, size_t ws_size, hipStream_t stream) {
    static int grid = 0;
    if (grid == 0) {
        if (n_in != 35 || in_sizes[0] != NLAT * DM || out_size != NLAT * DM || ws_size < WS_END) {
            fprintf(stderr, "kernel_launch: unexpected shapes: n_in %d in0 %d out %d ws %zu (need %zu); nothing launched\n", n_in, n_in > 0 ? in_sizes[0] : -1, out_size, ws_size, (size_t)WS_END); grid = -1; return; }
        int dev = 0, cus = 0, per_cu = 0;
        if (hipGetDevice(&dev) != hipSuccess || hipDeviceGetAttribute(&cus, hipDeviceAttributeMultiprocessorCount, dev) != hipSuccess) { fprintf(stderr, "kernel_launch: device query failed\n"); grid = -1; return; }
        if (hipFuncSetAttribute((const void*)fwd_kernel, hipFuncAttributeMaxDynamicSharedMemorySize, LDS_BYTES) != hipSuccess) { fprintf(stderr, "kernel_launch: hipFuncSetAttribute failed\n"); grid = -1; return; }
        if (hipOccupancyMaxActiveBlocksPerMultiprocessor(&per_cu, (const void*)fwd_kernel, 512, LDS_BYTES) != hipSuccess || per_cu < 1)
            fprintf(stderr, "kernel_launch: note: occupancy query reports %d workgroups per CU\n", per_cu);
        (void)hipGetLastError();
        grid = cus;
    }
    if (grid < 0) return;
    if (hipMemsetAsync((char*)d_ws + WS_BAR, 0, WS_ZERO_BYTES, stream) != hipSuccess) { fprintf(stderr, "kernel_launch: memset failed\n"); return; }
    Params P{};
    for (int i = 0; i < 35; ++i) P.in[i] = (const float*)d_in[i];
    P.out = (float*)d_out; P.ws = (unsigned char*)d_ws;
#if MK_FUSED
    P.ph_lo = 0; P.ph_hi = NPHASE;
    hipLaunchKernelGGL(fwd_kernel, dim3(grid), dim3(512), LDS_BYTES, stream, P);
#else
    for (int ph = 0; ph < NPHASE; ++ph) { P.ph_lo = ph; P.ph_hi = ph + 1; hipLaunchKernelGGL(fwd_kernel, dim3(grid), dim3(512), LDS_BYTES, stream, P); }
#endif
    const hipError_t le = hipPeekAtLastError();
    if (le != hipSuccess) fprintf(stderr, "kernel_launch: launch failed: %s\n", hipGetErrorName(le));
}
```

```cpp
#include <hip/hip_runtime.h>
#include <cstdio>
#include <cstdint>

#ifndef MK_FUSED
#define MK_FUSED 1
#endif

#define LAS __attribute__((address_space(3)))
#define GAS __attribute__((address_space(1)))
typedef _Float16 hf;
typedef _Float16 hf2 __attribute__((ext_vector_type(2)));
typedef _Float16 hf4 __attribute__((ext_vector_type(4)));
typedef _Float16 hf8 __attribute__((ext_vector_type(8)));
typedef short s16x4 __attribute__((ext_vector_type(4)));
typedef float f32x2 __attribute__((ext_vector_type(2)));
typedef float f32x4 __attribute__((ext_vector_type(4)));
typedef float f32x16 __attribute__((ext_vector_type(16)));
typedef unsigned u32x2 __attribute__((ext_vector_type(2)));
typedef unsigned u32x4 __attribute__((ext_vector_type(4)));

constexpr int DM = 1024, NB = 32, SEQ = 2048, DEPTH = 4, CTXL = 256, GRIDW = 64;
constexpr int NLAT = NB * SEQ;
constexpr int NCTX = NB * CTXL;
constexpr int MTOT = NLAT + NCTX;
constexpr int D_IN = 5024, NP1 = 2048  , NGATE = 3072, DFF = 4096;
constexpr int C_PQ = 0, C_PKV = 256, C_PKR = 384, C_HY = 416, C_DQ = 1184, C_DK = 1440, C_DV = 1696, C_PG = 1952;
constexpr int NUP = 1792, KUP = 384;
constexpr int NMODV = 33, MODW = 6 * DM;
constexpr float EPS = 1e-6f;
constexpr float MLA_SCALE = 0.10206207261596575f;
constexpr float DF_SCALE = 0.17677669529663687f;

constexpr size_t al256(size_t x) { return (x + 255) / 256 * 256; }
constexpr size_t WS_BAR = 0, WS_BAR_BYTES = 65536;
constexpr size_t WS_SS = WS_BAR + WS_BAR_BYTES;
constexpr int SS_1 = 0, SS_2 = DEPTH, SS_F = 2 * DEPTH, SSP_N = 2 * DEPTH + 1;
constexpr size_t WS_SSQ = WS_SS + (size_t)SSP_N * MTOT * 4 * 4;
constexpr size_t WS_SSKV = WS_SSQ + (size_t)DEPTH * MTOT * 4;
constexpr size_t WS_ZERO_BYTES = WS_BAR_BYTES;
constexpr size_t WS_MOD = al256(WS_SSKV + (size_t)DEPTH * MTOT * 4);
constexpr size_t WS_GS = WS_MOD + al256((size_t)DEPTH * NMODV * MODW * 4);
constexpr int NBIAS = 9216, B_IN = 0, B_G = 2048, B_FC1 = 5120;
constexpr size_t WS_BIAS = WS_GS + (size_t)DEPTH * 2 * NMODV * DM * 4;
constexpr size_t WS_ROPE = WS_BIAS + (size_t)DEPTH * NMODV * NBIAS * 4;
constexpr size_t WS_LAM = WS_ROPE + (size_t)SEQ * 32 * 4;
constexpr size_t WS_RF = WS_LAM + 256;
constexpr size_t WS_RFC = WS_RF + (size_t)DEPTH * 256 * 4096 * 2;
constexpr size_t WS_X16 = WS_RFC + (size_t)DEPTH * 256 * 512 * 2;
constexpr size_t WS_WT = WS_X16 + (size_t)MTOT * DM * 2;
constexpr size_t W_IN1 = 0, W_ING = W_IN1 + (size_t)NP1 * DM * 2, W_UP = W_ING + (size_t)NGATE * DM * 2, W_BR = W_UP + (size_t)NUP * KUP * 2,
                 W_OUT = W_BR + (size_t)DM * DM * 2, W_FC1 = W_OUT + (size_t)DM * DM * 2, W_FC2 = W_FC1 + (size_t)DFF * DM * 2, W_LAYER = W_FC2 + (size_t)DM * DFF * 2;
constexpr size_t WS_ARENA = WS_WT + 2 * W_LAYER;
constexpr size_t SZ_ROW1024 = (size_t)MTOT * 1024 * 2;
constexpr size_t A_B = WS_ARENA;
constexpr size_t A_C = A_B + SZ_ROW1024;
constexpr size_t A_Y = A_B, A_XS2 = A_B, A_BIG = A_C;
constexpr size_t A_QKVN = A_BIG;
constexpr size_t A_PHY = A_QKVN + (size_t)MTOT * KUP * 2;
constexpr size_t A_KR = A_BIG + (size_t)MTOT * NGATE;
constexpr size_t A_DQ = A_KR + (size_t)MTOT * 32 * 2;
constexpr size_t A_DK = A_DQ + (size_t)MTOT * 256 * 2;
constexpr size_t A_DV = A_DK + (size_t)MTOT * 256 * 2;
constexpr size_t A_QKV = A_DV + (size_t)MTOT * 256 * 2;
constexpr size_t A_BIG_END = A_QKV + (size_t)MTOT * NUP * 2;
static_assert(A_PHY + (size_t)MTOT * 768 * 2 <= A_KR, "QKVN + PHY must fit under the gate bytes");
constexpr size_t O_UT = SZ_ROW1024, O_X0T = O_UT + (size_t)256 * NLAT * 2, O_UTC = O_X0T + (size_t)256 * NLAT * 2, O_X0TC = O_UTC + (size_t)256 * NCTX * 2, O_END = O_X0TC + (size_t)256 * NCTX * 2;
static_assert(O_END <= (size_t)NLAT * DM * 4, "d_out scratch overflow");
constexpr size_t A_G = A_BIG;
constexpr size_t A_HID = A_C;
constexpr size_t WS_END = (A_BIG_END > A_HID + (size_t)MTOT * DFF * 2) ? A_BIG_END : A_HID + (size_t)MTOT * DFF * 2;
static_assert(WS_END <= (size_t)1024 * 1024 * 1024, "workspace map exceeds 1 GiB");

constexpr int LDS_BYTES = 147456;
constexpr int LDS_MISC = LDS_BYTES - 64;
constexpr int LDS_EXCH = 131072;

__device__ __forceinline__ unsigned pkh(float lo, float hi) { f32x2 v = {lo, hi}; hf2 h = __builtin_convertvector(v, hf2); return __builtin_bit_cast(unsigned, h); }
__device__ __forceinline__ unsigned rb8(unsigned h) { return (h + 0x00040004u) & 0xfff8fff8u; }
__device__ __forceinline__ unsigned pkhb(float lo, float hi) { return rb8(pkh(lo, hi)); }
__device__ __forceinline__ float wave_sum(float v) {
#pragma unroll
    for (int o = 1; o < 64; o <<= 1) v += __shfl_xor(v, o);
    return v;
}
__device__ __forceinline__ float rstd4(const float* ssp, int r) { const f32x4 q = *(const f32x4*)(ssp + 4 * (size_t)r); return rsqrtf(((q[0] + q[1]) + (q[2] + q[3])) * (1.f / DM) + EPS); }
#define LDS_WAIT() asm volatile("s_waitcnt lgkmcnt(0)" ::: "memory")
#define VM_WAIT() asm volatile("s_waitcnt vmcnt(0)" ::: "memory")

#define XB_TMO      128
#define XB_XCNT(j)  (256  + 64 * (j))
#define XB_XSUB(j)  (1280 + 64 * (j))
#define XB_XGEN(j)  (2304 + 64 * (j))
#define XB_TOP      3328
#define XB_TOPGEN   3392
#define XCD_BAR_WORDS 3456
#define XB_SPIN_CAP (1u << 22)
__device__ __forceinline__ unsigned xb_ld(unsigned* p)              { return __hip_atomic_load(p, __ATOMIC_RELAXED, __HIP_MEMORY_SCOPE_AGENT); }
__device__ __forceinline__ unsigned xb_add(unsigned* p, unsigned v) { return __hip_atomic_fetch_add(p, v, __ATOMIC_RELAXED, __HIP_MEMORY_SCOPE_AGENT); }
__device__ __forceinline__ unsigned xb_xcc_id() { return (unsigned)__builtin_amdgcn_s_getreg((3 << 11) | 20) & 0xFu; }
#define XB_SPIN(cond, bar) do { unsigned _sp = 0; while (cond) { __builtin_amdgcn_s_sleep(1); \
    if ((++_sp & 255u) == 0u) { if (xb_ld(&(bar)[XB_TMO])) break; if (_sp > XB_SPIN_CAP) { atomicAdd(&(bar)[XB_TMO], 1u); break; } } } } while (0)
struct XcdBarrier { unsigned* bar; unsigned x; volatile LAS unsigned* st; };
__device__ __forceinline__ XcdBarrier xcd_barrier_post(unsigned* bar, volatile LAS unsigned* st) {
    XcdBarrier b; b.bar = bar; b.x = xb_xcc_id(); b.st = st;
    if (threadIdx.x == 0) (void)xb_add(&bar[XB_XCNT(b.x)], 1u);
    return b;
}
__device__ __forceinline__ void xcd_barrier_complete(unsigned* bar, unsigned x, unsigned& nloc, unsigned& nx) {
    const unsigned G = gridDim.x * gridDim.y * gridDim.z;
    unsigned sum, cnt, mine, sp = 0u;
    for (;;) {
        sum = 0u; cnt = 0u; mine = 0u;
#pragma unroll
        for (unsigned j = 0; j < 16; ++j) { const unsigned c = xb_ld(&bar[XB_XCNT(j)]); sum += c; cnt += (c > 0u) ? 1u : 0u; mine = (j == x) ? c : mine; }
        if (sum == G) break;
        __builtin_amdgcn_s_sleep(1);
        if ((++sp & 255u) == 0u) { if (xb_ld(&bar[XB_TMO])) break; if (sp > XB_SPIN_CAP) { atomicAdd(&bar[XB_TMO], 1u); break; } }
    }
    nloc = mine > 0u ? mine : 1u; nx = cnt > 0u ? cnt : 1u;
}
__device__ __forceinline__ void xcd_barrier(const XcdBarrier& b) {
    asm volatile("s_waitcnt vmcnt(0)" ::: "memory");
    __syncthreads();
    if (threadIdx.x == 0) {
        unsigned* bar = b.bar;
        __builtin_amdgcn_s_waitcnt(0);
        unsigned nloc = b.st[0], nx = b.st[1];
        if (nloc == 0u) { xcd_barrier_complete(bar, b.x, nloc, nx); b.st[0] = nloc; b.st[1] = nx; }
        const unsigned old = xb_add(&bar[XB_XSUB(b.x)], 1u);
        const unsigned gen = old / nloc;
        if (old + 1u == (gen + 1u) * nloc) {
            __builtin_amdgcn_fence(__ATOMIC_RELEASE, "agent");
            asm volatile("s_waitcnt vmcnt(0)" ::: "memory");
            const unsigned og = xb_add(&bar[XB_TOP], 1u);
            const unsigned tg = og / nx;
            if (og + 1u == (tg + 1u) * nx) xb_add(&bar[XB_TOPGEN], 1u);
            else XB_SPIN(xb_ld(&bar[XB_TOPGEN]) == tg, bar);
            __builtin_amdgcn_fence(__ATOMIC_ACQUIRE, "agent");
            xb_add(&bar[XB_XGEN(b.x)], 1u);
            asm volatile("s_waitcnt vmcnt(0)" ::: "memory");
        } else {
            XB_SPIN(xb_ld(&bar[XB_XGEN(b.x)]) == gen, bar);
            __builtin_amdgcn_fence(__ATOMIC_ACQUIRE, "agent");
            asm volatile("s_waitcnt vmcnt(0)" ::: "memory");
        }
    }
    __syncthreads();
}

namespace pg8 {
constexpr int BM = 256, BK = 64, HALF = 128, HTB = HALF * BK * 2, STAGE_BYTES = 8 * HTB, NXCD = 8, WGM = 8;
__host__ __device__ __forceinline__ int lds_byte(int r, int c) { const int st = (r >> 4) * 2 + (c >> 5), rr = r & 15, cc = c & 31, ob = rr * 64 + cc * 2; return st * 1024 + (ob ^ (((ob >> 9) & 1) << 5)); }
__host__ __device__ __forceinline__ void stage_rc(int b, int& R, int& C) { const int st = b / 1024, sb = b % 1024, swz = sb ^ (((sb >> 9) & 1) << 5); R = (st >> 1) * 16 + swz / 64; C = (st & 1) * 32 + (swz % 64) / 2; }
__host__ __device__ __forceinline__ int perm32(int rho) { const int n = rho >> 4, i = rho & 15; return 8 * (i >> 2) + 4 * n + (i & 3); }
struct Unit { int pm, pn; };
struct Gemm { const hf* A; const hf* Bt; int M, N, K, lda, ldb; };
struct StaticOrder {
    int nM, nN, nwg, G, c;
    __host__ __device__ void init(int M, int N, int G_, int c_) { nM = M / BM; nN = N / BM; nwg = nM * nN; G = G_; c = c_; }
    __host__ __device__ bool next(int i, Unit& u) const {
        const long L = (long)i * G + c; if (L >= nwg) return false;
        int wgid = (int)L; { const int q = nwg / NXCD, r = nwg % NXCD, xcd = wgid % NXCD, off = wgid / NXCD; wgid = (xcd < r ? xcd * (q + 1) : r * (q + 1) + (xcd - r) * q) + off; }
        const int nig = WGM * nN, gid = wgid / nig, fm = gid * WGM, gsz = (nM - fm) < WGM ? (nM - fm) : WGM;
        u.pm = fm + ((wgid % nig) % gsz); u.pn = (wgid % nig) / gsz; return true;
    }
    __device__ __forceinline__ void a_ready(const Unit&) const {}
    __device__ __forceinline__ void done(const Unit&) const {}
};

template <int ACT  , bool NORM> struct EpiHalf {
    static constexpr bool PERM = true, AFTER_DRAIN = false, PROBE2 = false, MIDK = false;
    hf* O; int ldc; const float* ss; const float* bias;
    __device__ __forceinline__ void operator()(const f32x4 (&acc)[2][2][4][2], const Unit& u, int wr, int wc, int fr, int fq) const {
        const int row0 = u.pm * BM + wr * 64 + fr, col0 = u.pn * BM + wc * 32 + 8 * fq;
        f32x4 bv[2][2];
        if (NORM) { const int R0 = u.pm * BM; const int v = (R0 < NLAT) ? (R0 >> 11) : NB; const float* bp = bias + (size_t)v * NBIAS + col0;
#pragma unroll
            for (int bj = 0; bj < 2; ++bj)
#pragma unroll
                for (int n = 0; n < 2; ++n) bv[bj][n] = *(const f32x4*)(bp + bj * HALF + 4 * n); }
#pragma unroll
        for (int ai = 0; ai < 2; ++ai)
#pragma unroll
            for (int m = 0; m < 4; ++m) { const int r = row0 + ai * HALF + m * 16; hf* rowp = O + (size_t)r * ldc + col0;
                float rs = 1.f; if (NORM) rs = rstd4(ss, r);
#pragma unroll
                for (int bj = 0; bj < 2; ++bj) { f32x4 v0 = acc[ai][bj][m][0], v1 = acc[ai][bj][m][1];
                    if (NORM) { v0 = v0 * rs + bv[bj][0]; v1 = v1 * rs + bv[bj][1]; }
                    if (ACT == 1) {
#pragma unroll
                        for (int e = 0; e < 4; ++e) { v0[e] = __builtin_amdgcn_rcpf(1.f + __builtin_amdgcn_exp2f(-1.4426950408889634f * v0[e])); v1[e] = __builtin_amdgcn_rcpf(1.f + __builtin_amdgcn_exp2f(-1.4426950408889634f * v1[e])); } }
                    u32x4 w;
                    if (ACT == 2) {
                        const unsigned h[4] = {pkh(v0[0], v0[1]), pkh(v0[2], v0[3]), pkh(v1[0], v1[1]), pkh(v1[2], v1[3])}; unsigned o[4];
#pragma unroll
                        for (int e = 0; e < 4; ++e) { hf2 a = __builtin_bit_cast(hf2, h[e]); a = __builtin_elementwise_max(a, (hf2){(hf)0.f, (hf)0.f}); a = a * a; o[e] = rb8(__builtin_bit_cast(unsigned, a)); }
                        w.x = o[0]; w.y = o[1]; w.z = o[2]; w.w = o[3];
                    } else { w.x = pkhb(v0[0], v0[1]); w.y = pkhb(v0[2], v0[3]); w.z = pkhb(v1[0], v1[1]); w.w = pkhb(v1[2], v1[3]); }
                    *(u32x4*)(rowp + bj * HALF) = w; } }
    }
};
struct EpiGate8 {
    static constexpr bool PERM = true, AFTER_DRAIN = false, PROBE2 = false, MIDK = false;
    unsigned char* O; const float* ss; const float* bias;
    __device__ __forceinline__ void operator()(const f32x4 (&acc)[2][2][4][2], const Unit& u, int wr, int wc, int fr, int fq) const {
        const int R0 = u.pm * BM, row0 = R0 + wr * 64 + fr, col0 = u.pn * BM + wc * 32 + 8 * fq;
        const int v = (R0 < NLAT) ? (R0 >> 11) : NB; const float* bp = bias + (size_t)v * NBIAS + col0;
        f32x4 bv[2][2];
#pragma unroll
        for (int bj = 0; bj < 2; ++bj) { bv[bj][0] = *(const f32x4*)(bp + bj * HALF); bv[bj][1] = *(const f32x4*)(bp + bj * HALF + 4); }
#pragma unroll
        for (int ai = 0; ai < 2; ++ai)
#pragma unroll
            for (int m = 0; m < 4; ++m) { const int r = row0 + ai * HALF + m * 16; const float rs = rstd4(ss, r);
#pragma unroll
                for (int bj = 0; bj < 2; ++bj) { const f32x4 v0 = acc[ai][bj][m][0] * rs + bv[bj][0], v1 = acc[ai][bj][m][1] * rs + bv[bj][1];
                    unsigned q[8];
#pragma unroll
                    for (int e = 0; e < 4; ++e) { const float g0 = __builtin_amdgcn_rcpf(1.f + __builtin_amdgcn_exp2f(-1.4426950408889634f * v0[e])), g1 = __builtin_amdgcn_rcpf(1.f + __builtin_amdgcn_exp2f(-1.4426950408889634f * v1[e]));
                        q[e] = (unsigned)fmaxf(1.f, __builtin_rintf(255.f * g0)); q[4 + e] = (unsigned)fmaxf(1.f, __builtin_rintf(255.f * g1)); }
                    u32x2 w; w.x = q[0] | (q[1] << 8) | (q[2] << 16) | (q[3] << 24); w.y = q[4] | (q[5] << 8) | (q[6] << 16) | (q[7] << 24);
                    *(u32x2*)(O + (size_t)r * NGATE + col0 + bj * HALF) = w; } }
    }
};
struct EpiIn {
    static constexpr bool PERM = true, AFTER_DRAIN = false, PROBE2 = false, MIDK = false;
    hf* QKVNo; hf* KRo; hf* PHYo; hf* DQo; hf* DKo; hf* DVo; const float* ss; const float* bias; float* ssq; float* sskv; LAS unsigned char* lx;
    __device__ __forceinline__ void operator()(const f32x4 (&acc)[2][2][4][2], const Unit& u, int wr, int wc, int fr, int fq) const {
        const int R0 = u.pm * BM, row0 = R0 + wr * 64 + fr, col0 = u.pn * BM + wc * 32 + 8 * fq;
        const int v = (R0 < NLAT) ? (R0 >> 11) : NB; const float* bp = bias + (size_t)v * NBIAS + col0;
        f32x4 bv[2][2]; hf* dst[2]; int ld[2];
#pragma unroll
        for (int bj = 0; bj < 2; ++bj) { const int c8 = col0 + bj * HALF;
            bv[bj][0] = *(const f32x4*)(bp + bj * HALF); bv[bj][1] = *(const f32x4*)(bp + bj * HALF + 4);
            if (c8 < C_PKR) { dst[bj] = QKVNo + c8; ld[bj] = KUP; }
            else if (c8 < C_HY) { dst[bj] = KRo + (c8 - C_PKR); ld[bj] = 32; }
            else if (c8 < C_DQ) { dst[bj] = PHYo + (c8 - C_HY); ld[bj] = 768; }
            else if (c8 < C_DK) { dst[bj] = DQo + (c8 - C_DQ); ld[bj] = 256; }
            else if (c8 < C_DV) { dst[bj] = DKo + (c8 - C_DK); ld[bj] = 256; }
            else if (c8 < C_PG) { dst[bj] = DVo + (c8 - C_DV); ld[bj] = 256; }
            else { dst[bj] = nullptr; ld[bj] = 0; } }
        const int nstat = (u.pn == 0) ? 2 : (u.pn == 1 ? 1 : 0);
        float* sp = (u.pn == 0) ? ssq : sskv;
        float sqv[2][4];
#pragma unroll
        for (int ai = 0; ai < 2; ++ai)
#pragma unroll
            for (int m = 0; m < 4; ++m) { const int r = row0 + ai * HALF + m * 16; const float rs = rstd4(ss, r); float sq = 0.f;
#pragma unroll
                for (int bj = 0; bj < 2; ++bj) { const f32x4 v0 = acc[ai][bj][m][0] * rs + bv[bj][0], v1 = acc[ai][bj][m][1] * rs + bv[bj][1];
                    if (bj < nstat) sq += (v0[0] * v0[0] + v0[1] * v0[1]) + (v0[2] * v0[2] + v0[3] * v0[3]) + (v1[0] * v1[0] + v1[1] * v1[1]) + (v1[2] * v1[2] + v1[3] * v1[3]);
                    if (dst[bj]) { u32x4 w; w.x = pkhb(v0[0], v0[1]); w.y = pkhb(v0[2], v0[3]); w.z = pkhb(v1[0], v1[1]); w.w = pkhb(v1[2], v1[3]); *(u32x4*)(dst[bj] + (size_t)r * ld[bj]) = w; } }
                sq += __shfl_xor(sq, 16); sq += __shfl_xor(sq, 32); sqv[ai][m] = sq; }
        if (nstat) {
            LAS float* ex = (LAS float*)lx;
            if (fq == 0) {
#pragma unroll
                for (int ai = 0; ai < 2; ++ai)
#pragma unroll
                    for (int m = 0; m < 4; ++m) ex[((wr * 4 + wc) * 8 + ai * 4 + m) * 16 + fr] = sqv[ai][m]; }
            asm volatile("s_waitcnt lgkmcnt(0)" ::: "memory"); __builtin_amdgcn_s_barrier(); asm volatile("" ::: "memory");
            if (wc == 0 && fq == 0) {
#pragma unroll
                for (int ai = 0; ai < 2; ++ai)
#pragma unroll
                    for (int m = 0; m < 4; ++m) { const int e = (ai * 4 + m) * 16 + fr; const int wb = wr * 4 * 128;
                        sp[row0 + ai * HALF + m * 16] = (ex[wb + e] + ex[wb + 128 + e]) + (ex[wb + 256 + e] + ex[wb + 384 + e]); } }
        }
    }
};
struct EpiUp {
    static constexpr bool PERM = true, AFTER_DRAIN = false, PROBE2 = false, MIDK = false;
    hf* O; const float* ssq; const float* sskv;
    __device__ __forceinline__ void operator()(const f32x4 (&acc)[2][2][4][2], const Unit& u, int wr, int wc, int fr, int fq) const {
        const int row0 = u.pm * BM + wr * 64 + fr, col0 = u.pn * BM + wc * 32 + 8 * fq;
        const bool isq = u.pn < 3; const float* sp = isq ? ssq : sskv; const float invn = isq ? (1.f / 256.f) : (1.f / 128.f);
#pragma unroll
        for (int ai = 0; ai < 2; ++ai)
#pragma unroll
            for (int m = 0; m < 4; ++m) { const int r = row0 + ai * HALF + m * 16; hf* rowp = O + (size_t)r * NUP + col0; const float rs = rsqrtf(sp[r] * invn + EPS);
#pragma unroll
                for (int bj = 0; bj < 2; ++bj) { const f32x4 v0 = acc[ai][bj][m][0] * rs, v1 = acc[ai][bj][m][1] * rs;
                    u32x4 w; w.x = pkhb(v0[0], v0[1]); w.y = pkhb(v0[2], v0[3]); w.z = pkhb(v1[0], v1[1]); w.w = pkhb(v1[2], v1[3]);
                    *(u32x4*)(rowp + bj * HALF) = w; } }
    }
};
template <bool FIRST> struct EpiGated {
    static constexpr bool PERM = true, AFTER_DRAIN = false, PROBE2 = false, MIDK = false;
    hf* MMo; const hf* G; int goff;
    __device__ __forceinline__ void operator()(const f32x4 (&acc)[2][2][4][2], const Unit& u, int wr, int wc, int fr, int fq) const {
        const int row0 = u.pm * BM + wr * 64 + fr, col0 = u.pn * BM + wc * 32 + 8 * fq;
#pragma unroll
        for (int ai = 0; ai < 2; ++ai)
#pragma unroll
            for (int m = 0; m < 4; ++m) { const size_t r = (size_t)(row0 + ai * HALF + m * 16);
#pragma unroll
                for (int bj = 0; bj < 2; ++bj) { const f32x4 v0 = acc[ai][bj][m][0], v1 = acc[ai][bj][m][1];
                    const hf8 g = *(const hf8*)(G + r * NGATE + goff + col0 + bj * HALF);
                    hf* mp = MMo + r * DM + col0 + bj * HALF;
                    float o[8];
#pragma unroll
                    for (int e = 0; e < 4; ++e) { o[e] = (float)g[e] * v0[e]; o[4 + e] = (float)g[4 + e] * v1[e]; }
                    if (!FIRST) { const hf8 p = *(const hf8*)mp;
#pragma unroll
                        for (int e = 0; e < 8; ++e) o[e] += (float)p[e]; }
                    u32x4 w; w.x = pkh(o[0], o[1]); w.y = pkh(o[2], o[3]); w.z = pkh(o[4], o[5]); w.w = pkh(o[6], o[7]);
                    *(u32x4*)mp = w; } }
    }
};
struct EpiMerge {
    static constexpr bool PERM = true, AFTER_DRAIN = false, PROBE2 = false, MIDK = true;
    static constexpr int MID1 = 8, MID2 = 12;
    hf* MMo; const unsigned char* G;
    __device__ __forceinline__ void mid(f32x4 (&acc)[2][2][4][2], const Unit& u, int which, int wr, int wc, int fr, int fq) const {
        asm volatile("" : "+v"(fr), "+v"(fq));
        const int row0 = u.pm * BM + wr * 64 + fr, col0 = u.pn * BM + wc * 32 + 8 * fq; const int gnum = which ? 1024 : 0, gden = which ? 2048 : 1024;
#pragma unroll
        for (int ai = 0; ai < 2; ++ai) {
            u32x2 gn[4][2], gd[4][2];
#pragma unroll
            for (int m = 0; m < 4; ++m) { const unsigned char* gr = G + (size_t)(row0 + ai * HALF + m * 16) * NGATE + col0;
#pragma unroll
                for (int bj = 0; bj < 2; ++bj) { gn[m][bj] = *(const u32x2*)(gr + gnum + bj * HALF); gd[m][bj] = *(const u32x2*)(gr + gden + bj * HALF); } }
#pragma unroll
            for (int m = 0; m < 4; ++m)
#pragma unroll
                for (int bj = 0; bj < 2; ++bj)
#pragma unroll
                    for (int e = 0; e < 4; ++e) {
                        acc[ai][bj][m][0][e] *= (float)((gn[m][bj].x >> (8 * e)) & 255u) * __builtin_amdgcn_rcpf((float)((gd[m][bj].x >> (8 * e)) & 255u));
                        acc[ai][bj][m][1][e] *= (float)((gn[m][bj].y >> (8 * e)) & 255u) * __builtin_amdgcn_rcpf((float)((gd[m][bj].y >> (8 * e)) & 255u)); }
            asm volatile("" ::: "memory");
        }
    }
    __device__ __forceinline__ void operator()(const f32x4 (&acc)[2][2][4][2], const Unit& u, int wr, int wc, int fr, int fq) const {
        const int row0 = u.pm * BM + wr * 64 + fr, col0 = u.pn * BM + wc * 32 + 8 * fq;
#pragma unroll
        for (int ai = 0; ai < 2; ++ai)
#pragma unroll
            for (int m = 0; m < 4; ++m) { const size_t r = (size_t)(row0 + ai * HALF + m * 16);
#pragma unroll
                for (int bj = 0; bj < 2; ++bj) { const f32x4 v0 = acc[ai][bj][m][0], v1 = acc[ai][bj][m][1];
                    const u32x2 g = *(const u32x2*)(G + r * NGATE + 2048 + col0 + bj * HALF);
                    float o[8];
#pragma unroll
                    for (int e = 0; e < 4; ++e) { o[e] = (float)((g.x >> (8 * e)) & 255u) * (1.f / 255.f) * v0[e]; o[4 + e] = (float)((g.y >> (8 * e)) & 255u) * (1.f / 255.f) * v1[e]; }
                    u32x4 w; w.x = pkhb(o[0], o[1]); w.y = pkhb(o[2], o[3]); w.z = pkhb(o[4], o[5]); w.w = pkhb(o[6], o[7]);
                    *(u32x4*)(MMo + r * DM + col0 + bj * HALF) = w; } }
    }
};
template <bool XS, bool STAT> struct EpiResidX {
    static constexpr bool PERM = true, AFTER_DRAIN = false, PROBE2 = false, MIDK = false;
    hf* x16; const float* gate;
    hf* xsout; const float* gs; float* ss; LAS unsigned char* lx;
    __device__ __forceinline__ void operator()(const f32x4 (&acc)[2][2][4][2], const Unit& u, int wr, int wc, int fr, int fq) const {
        const int R0 = u.pm * BM; const int v = (R0 < NLAT) ? (R0 >> 11) : NB;
        const int rglob = R0 + wr * 64 + fr, col0 = u.pn * BM + wc * 32 + 8 * fq;
        const float* gp = gate + (size_t)v * MODW + col0; const float* gsp = gs + (size_t)v * DM + col0;
        float sq[2][4];
#pragma unroll
        for (int ai = 0; ai < 2; ++ai)
#pragma unroll
            for (int m = 0; m < 4; ++m) sq[ai][m] = 0.f;
#pragma unroll
        for (int bj = 0; bj < 2; ++bj) {
            const f32x4 g0 = *(const f32x4*)(gp + bj * HALF), g1 = *(const f32x4*)(gp + bj * HALF + 4);
            f32x4 s0 = {1.f, 1.f, 1.f, 1.f}, s1 = s0; if (XS) { s0 = *(const f32x4*)(gsp + bj * HALF); s1 = *(const f32x4*)(gsp + bj * HALF + 4); }
#pragma unroll
            for (int ai = 0; ai < 2; ++ai)
#pragma unroll
                for (int m = 0; m < 4; ++m) { const int rr = ai * HALF + m * 16; const size_t off = (size_t)(rglob + rr) * DM + col0 + bj * HALF;
                    const hf8 xv = *(const hf8*)(x16 + off);
                    const f32x4 x0 = {(float)xv[0], (float)xv[1], (float)xv[2], (float)xv[3]}, x1 = {(float)xv[4], (float)xv[5], (float)xv[6], (float)xv[7]};
                    const f32x4 n0 = x0 + g0 * acc[ai][bj][m][0], n1 = x1 + g1 * acc[ai][bj][m][1];
                    { u32x4 w; w.x = pkh(n0[0], n0[1]); w.y = pkh(n0[2], n0[3]); w.z = pkh(n1[0], n1[1]); w.w = pkh(n1[2], n1[3]); *(u32x4*)(x16 + off) = w; }
                    if (STAT) sq[ai][m] += (n0[0] * n0[0] + n0[1] * n0[1]) + (n0[2] * n0[2] + n0[3] * n0[3]) + (n1[0] * n1[0] + n1[1] * n1[1]) + (n1[2] * n1[2] + n1[3] * n1[3]);
                    if (XS) { const f32x4 a = n0 * s0, b = n1 * s1; u32x4 w; w.x = pkhb(a[0], a[1]); w.y = pkhb(a[2], a[3]); w.z = pkhb(b[0], b[1]); w.w = pkhb(b[2], b[3]);
                        *(u32x4*)(xsout + off) = w; } }
        }
        if (STAT) {
            LAS float* ex = (LAS float*)lx;
#pragma unroll
            for (int ai = 0; ai < 2; ++ai)
#pragma unroll
                for (int m = 0; m < 4; ++m) { float t = sq[ai][m]; t += __shfl_xor(t, 16); t += __shfl_xor(t, 32);
                    if (fq == 0) ex[((wr * 4 + wc) * 8 + ai * 4 + m) * 16 + fr] = t; }
            asm volatile("s_waitcnt lgkmcnt(0)" ::: "memory"); __builtin_amdgcn_s_barrier(); asm volatile("" ::: "memory");
            if (wc == 0 && fq == 0) {
#pragma unroll
                for (int ai = 0; ai < 2; ++ai)
#pragma unroll
                    for (int m = 0; m < 4; ++m) { const int e = (ai * 4 + m) * 16 + fr; const int wb = wr * 4 * 128;
                        ss[(size_t)(rglob + ai * HALF + m * 16) * 4 + u.pn] = (ex[wb + e] + ex[wb + 128 + e]) + (ex[wb + 256 + e] + ex[wb + 384 + e]); } }
        }
    }
};

template <class Epi, class Sched, bool ALIGN_EPI = true>
__device__ __forceinline__ void gemm_phase(LAS unsigned char* lds, const Gemm g, const Sched& S, const Epi& E) {
    int tid = threadIdx.x; asm volatile("" : "+v"(tid));
    const int wid = __builtin_amdgcn_readfirstlane(tid >> 6), lane = tid & 63, wr = wid >> 2, wc = wid & 3, fr = lane & 15, fq = lane >> 4;
    const int K = g.K, nt = K / BK;
    unsigned voffA[2], voffB[2];
#pragma unroll
    for (int i = 0; i < 2; ++i) { int R, C; stage_rc(tid * 16 + i * 8192, R, C); const int Rb = Epi::PERM ? ((R & ~31) + perm32(R & 31)) : R;
        voffA[i] = (unsigned)(R * g.lda + C) * 2u; voffB[i] = (unsigned)(Rb * g.ldb + C) * 2u; }
    const size_t kstep = (size_t)(BK * 2);
    const size_t hstepA = (size_t)HALF * g.lda * 2, hstepB = (size_t)HALF * g.ldb * 2;
    const size_t tstepA = 2 * hstepA, tstepB = 2 * hstepB;
    const unsigned ldsw = (unsigned)wid * 1024u;
    const int aoff = lds_byte(wr * 64 + fr, fq * 8), boff = lds_byte(wc * 32 + fr, fq * 8);
#define PG8_SA(b, h) (((b) * 2 + (h)) * HTB)
#define PG8_SB(b, h) ((4 + (b) * 2 + (h)) * HTB)
#define PG8_STAGE(bufoff, gbase, voff) do { _Pragma("unroll") for (int _i = 0; _i < 2; ++_i) \
        __builtin_amdgcn_global_load_lds((const unsigned*)((const char*)(gbase) + (voff)[_i]), (LAS unsigned*)(lds + (bufoff) + ldsw + _i * 8192), 16, 0, 0); } while (0)
#define PG8_LDA(dst, b, h) do { _Pragma("unroll") for (int m = 0; m < 4; ++m) _Pragma("unroll") for (int k = 0; k < 2; ++k) dst[m][k] = *(const LAS hf8*)(lds + PG8_SA(b, h) + aoff + m * 2048 + k * 1024); } while (0)
#define PG8_LDB(dst, b, h) do { _Pragma("unroll") for (int n = 0; n < 2; ++n) _Pragma("unroll") for (int k = 0; k < 2; ++k) dst[n][k] = *(const LAS hf8*)(lds + PG8_SB(b, h) + boff + n * 2048 + k * 1024); } while (0)
#define PG8_MMA(ai, bj, At, Bt) do { __builtin_amdgcn_s_setprio(1); _Pragma("unroll") for (int m = 0; m < 4; ++m) _Pragma("unroll") for (int n = 0; n < 2; ++n) _Pragma("unroll") for (int k = 0; k < 2; ++k) \
        acc[ai][bj][m][n] = __builtin_amdgcn_mfma_f32_16x16x32_f16(Bt[n][k], At[m][k], acc[ai][bj][m][n], 0, 0, 0); __builtin_amdgcn_s_setprio(0); } while (0)
#define PG8_WAIT_V(n) asm volatile("s_waitcnt vmcnt(" #n ")" ::: "memory")
#define PG8_WAIT_L(n) asm volatile("s_waitcnt lgkmcnt(" #n ")" ::: "memory")
#define PG8_BAR __builtin_amdgcn_s_barrier()
#define PG8_SCHED __builtin_amdgcn_sched_barrier(0)
    Unit cur, nxt; int ui = 0;
    if (!S.next(0, cur)) return;
    f32x4 acc[2][2][4][2];
#pragma unroll
    for (int a = 0; a < 2; ++a)
#pragma unroll
        for (int b = 0; b < 2; ++b)
#pragma unroll
            for (int m = 0; m < 4; ++m)
#pragma unroll
                for (int n = 0; n < 2; ++n) acc[a][b][m][n] = (f32x4){0.f, 0.f, 0.f, 0.f};
    hf8 At[4][2], B0[2][2], B1[2][2];
    const char* cA = (const char*)g.A + (size_t)cur.pm * tstepA; const char* cB = (const char*)g.Bt + (size_t)cur.pn * tstepB;
    S.a_ready(cur);
    PG8_STAGE(PG8_SB(0, 0), cB, voffB); PG8_STAGE(PG8_SB(0, 1), cB + hstepB, voffB); PG8_STAGE(PG8_SA(0, 0), cA, voffA); PG8_STAGE(PG8_SA(0, 1), cA + hstepA, voffA);
    if (wr == 1) PG8_BAR;
    PG8_WAIT_V(2); PG8_BAR;
    PG8_STAGE(PG8_SB(1, 0), cB + kstep, voffB); PG8_STAGE(PG8_SA(1, 0), cA + kstep, voffA); PG8_STAGE(PG8_SB(1, 1), cB + hstepB + kstep, voffB);
    PG8_WAIT_V(6); PG8_BAR;
    for (;;) {
        const bool has_next = S.next(ui + 1, nxt);
        const char* nA = has_next ? (const char*)g.A + (size_t)nxt.pm * tstepA : cA; const char* nB = has_next ? (const char*)g.Bt + (size_t)nxt.pn * tstepB : cB;
#pragma unroll 1
        for (int t = 0; t < nt; t += 2) {
            const bool last = (t == nt - 2);
            const char* a1 = cA + (size_t)(t + 1) * kstep;
            const char* a2 = last ? nA : cA + (size_t)(t + 2) * kstep; const char* b2 = last ? nB : cB + (size_t)(t + 2) * kstep;
            const char* a3 = a2 + kstep; const char* b3 = b2 + kstep;
            if (last && has_next) S.a_ready(nxt);
            if constexpr (Epi::MIDK) { if (t == Epi::MID1 || t == Epi::MID2) E.mid(acc, cur, t == Epi::MID1 ? 0 : 1, wr, wc, fr, fq); }
            PG8_LDB(B0, 0, 0); PG8_LDB(B1, 0, 1); PG8_SCHED; PG8_LDA(At, 0, 0); PG8_STAGE(PG8_SA(1, 1), a1 + hstepA, voffA);
            PG8_WAIT_V(8); PG8_WAIT_L(0); PG8_BAR; PG8_MMA(0, 0, At, B0); PG8_MMA(0, 1, At, B1); PG8_BAR; PG8_SCHED;
            PG8_LDA(At, 0, 1); PG8_STAGE(PG8_SB(0, 0), b2, voffB); PG8_STAGE(PG8_SB(0, 1), b2 + hstepB, voffB); PG8_STAGE(PG8_SA(0, 0), a2, voffA);
            PG8_WAIT_V(8); PG8_WAIT_L(0); PG8_BAR; PG8_MMA(1, 0, At, B0); PG8_MMA(1, 1, At, B1); PG8_BAR; PG8_SCHED;
            PG8_LDB(B0, 1, 0); PG8_LDB(B1, 1, 1); PG8_SCHED; PG8_LDA(At, 1, 0); PG8_STAGE(PG8_SA(0, 1), a2 + hstepA, voffA);
            PG8_WAIT_V(8); PG8_WAIT_L(0); PG8_BAR; PG8_MMA(0, 0, At, B0); PG8_MMA(0, 1, At, B1); PG8_BAR; PG8_SCHED;
            PG8_LDA(At, 1, 1); PG8_STAGE(PG8_SB(1, 0), b3, voffB); PG8_STAGE(PG8_SB(1, 1), b3 + hstepB, voffB); PG8_STAGE(PG8_SA(1, 0), a3, voffA);
            PG8_WAIT_V(8); PG8_WAIT_L(0); PG8_BAR; PG8_MMA(1, 0, At, B0); PG8_MMA(1, 1, At, B1); PG8_BAR; PG8_SCHED;
        }
        if constexpr (ALIGN_EPI) { if (wr == 0) PG8_BAR; }
        E(acc, cur, wr, wc, fr, fq); S.done(cur);
#ifdef PROBE_EPI2
        if (Epi::PROBE2) { asm volatile("" ::: "memory"); E(acc, cur, wr, wc, fr, fq); }
#endif
        if (!has_next) break;
#pragma unroll
        for (int a = 0; a < 2; ++a)
#pragma unroll
            for (int b = 0; b < 2; ++b)
#pragma unroll
                for (int m = 0; m < 4; ++m)
#pragma unroll
                    for (int n = 0; n < 2; ++n) acc[a][b][m][n] = (f32x4){0.f, 0.f, 0.f, 0.f};
        cur = nxt; cA = nA; cB = nB; ++ui;
        if constexpr (ALIGN_EPI) { if (wr == 1) PG8_BAR; }
    }
    PG8_WAIT_V(0);
    if constexpr (!ALIGN_EPI) { if (wr == 0) PG8_BAR; }
    PG8_BAR;
#undef PG8_SA
#undef PG8_SB
#undef PG8_STAGE
#undef PG8_LDA
#undef PG8_LDB
#undef PG8_MMA
#undef PG8_WAIT_V
#undef PG8_WAIT_L
#undef PG8_BAR
#undef PG8_SCHED
}
}

struct Params {
    const float* in[35];
    float* out;
    unsigned char* ws;
    int ph_lo, ph_hi;
};
enum { I_X = 0, I_C, I_CTX, I_CCTX, I_NMG, I_NFG, I_WMOD, I_BMOD, I_WIN, I_QNG, I_WUQ, I_KVNG, I_WUKV, I_HCW, I_HCB, I_HW1, I_HB1, I_HFREQ, I_HW2, I_HB2, I_HW3, I_HB3,
       I_HSKIP, I_LQ1, I_LK1, I_LQ2, I_LK2, I_SUBG, I_WBRA, I_WBRB, I_WBRC, I_WOUT, I_FC1, I_FC2, I_FNG };

struct Frame {
    LAS unsigned char* lds;
    int tid, lane, wave, vcu, G;
};

__device__ __forceinline__ void tr_item(const float* W, int ldw, hf* WT, int ldt, int nblk, LAS float* scr, int item, int lane, const float* kgain = nullptr) {
    const int kb = item / nblk, nb = item % nblk, k0 = 64 * kb, n0 = 32 * nb;
#pragma unroll 8
    for (int i = 0; i < 32; ++i) { const int kk = 2 * i + (lane >> 5); const float gk = kgain ? kgain[k0 + kk] : 1.f; { float wv = W[(size_t)(k0 + kk) * ldw + n0 + (lane & 31)] * gk; unsigned ub = __float_as_uint(wv); ub += 0x7fffu + ((ub >> 16) & 1u); ub &= 0xffff0000u; scr[kk * 33 + (lane & 31)] = __uint_as_float(ub); } }
    LDS_WAIT(); asm volatile("" ::: "memory");
    const int c = lane & 7;
#pragma unroll
    for (int j = 0; j < 4; ++j) { const int n = (lane >> 3) + 8 * j; const LAS float* s = scr + (8 * c) * 33 + n;
        u32x4 o; o.x = pkh(s[0 * 33], s[1 * 33]); o.y = pkh(s[2 * 33], s[3 * 33]); o.z = pkh(s[4 * 33], s[5 * 33]); o.w = pkh(s[6 * 33], s[7 * 33]);
        *(u32x4*)(WT + (size_t)(n0 + n) * ldt + k0 + 8 * c) = o; }
    LDS_WAIT(); asm volatile("" ::: "memory");
}
__device__ __forceinline__ float silu_f(float x) { return x / (1.f + expf(-x)); }

__device__ __forceinline__ void mod_phase(const Frame& F, const Params& p) {
    float* MOD = (float*)(p.ws + WS_MOD);
    LAS float* sv = (LAS float*)F.lds;
    constexpr int NCB = DEPTH * MODW / 512;
    for (int item = F.vcu; item < NCB * 3; item += F.G) {
        const int cb = item / 3, vg = item % 3;
        __syncthreads();
        for (int i = F.tid; i < 11 * 1024; i += 512) { const int v = vg * 11 + i / 1024, k = i % 1024;
            const float c = (v < NB) ? p.in[I_C][v * DM + k] : p.in[I_CCTX][k]; sv[i] = silu_f(c); }
        __syncthreads();
        const int gcol = cb * 512 + F.tid, l = gcol / MODW, n = gcol % MODW;
        const float* w = p.in[I_WMOD] + (size_t)l * DM * MODW + n;
        float acc[11];
#pragma unroll
        for (int v = 0; v < 11; ++v) acc[v] = 0.f;
#pragma unroll 4
        for (int k = 0; k < DM; k += 4) {
            const float w0 = w[(size_t)k * MODW], w1 = w[(size_t)(k + 1) * MODW], w2 = w[(size_t)(k + 2) * MODW], w3 = w[(size_t)(k + 3) * MODW];
#pragma unroll
            for (int v = 0; v < 11; ++v) { const f32x4 s = *(const LAS f32x4*)(sv + v * 1024 + k);
                acc[v] = fmaf(s[0], w0, acc[v]); acc[v] = fmaf(s[1], w1, acc[v]); acc[v] = fmaf(s[2], w2, acc[v]); acc[v] = fmaf(s[3], w3, acc[v]); }
        }
        const float bm = p.in[I_BMOD][(size_t)l * MODW + n];
#pragma unroll
        for (int v = 0; v < 11; ++v) MOD[((size_t)l * NMODV + vg * 11 + v) * MODW + n] = acc[v] + bm;
    }
    __syncthreads();
}

__device__ __forceinline__ void filt_item(const Params& p, int l, int kind  , int t, int lane) {
    const int L = kind ? CTXL : SEQ;
    hf* R = kind ? (hf*)(p.ws + WS_RFC) + (size_t)l * 256 * 512 : (hf*)(p.ws + WS_RF) + (size_t)l * 256 * 4096;
    const int rl = 2 * L;
    const float tl = (float)t / (float)(L - 1);
    const float wt = (6.283185307179586f / (float)L) * (float)t;
    float z = 0.f;
    if (lane == 0) z = tl;
    else if (lane <= 32) { const int bi = (lane - 1) & 15; const float band = 1e-4f + (15.f - 1e-4f) * ((float)bi / 15.f); const float a = band * wt; z = (lane <= 16) ? cosf(a) : -sinf(a); }
    const float* w1 = p.in[I_HW1] + (size_t)l * 33 * 64; const float* w2 = p.in[I_HW2] + (size_t)l * 64 * 64; const float* w3 = p.in[I_HW3] + (size_t)l * 64 * 512;
    const float fr = p.in[I_HFREQ][l * 64 + lane];
    float a1 = p.in[I_HB1][l * 64 + lane];
    for (int i = 0; i < 33; ++i) a1 = fmaf(__shfl(z, i), w1[i * 64 + lane], a1);
    a1 = sinf(fr * a1);
    float a2 = p.in[I_HB2][l * 64 + lane];
    for (int i = 0; i < 64; ++i) a2 = fmaf(__shfl(a1, i), w2[i * 64 + lane], a2);
    a2 = sinf(fr * a2);
    float h[8];
#pragma unroll
    for (int q = 0; q < 8; ++q) h[q] = p.in[I_HB3][l * 512 + q * 64 + lane];
    for (int i = 0; i < 64; ++i) { const float a = __shfl(a2, i);
#pragma unroll
        for (int q = 0; q < 8; ++q) h[q] = fmaf(a, w3[i * 512 + q * 64 + lane], h[q]); }
    const float d0 = -4.605170185988091f / 1.5f, d1 = -4.605170185988091f / 0.3f;
#pragma unroll
    for (int q = 0; q < 8; ++q) { const int o = q * 64 + lane, dir = o >> 8, c = o & 255;
        const float delta = fabsf(d0 + (d1 - d0) * ((float)c / 255.f));
        float val = h[q] * (expf(-tl * delta) + 0.05f);
        if (dir == 0) { if (t == 0) val += p.in[I_HSKIP][l * 256 + c]; R[(size_t)c * rl + (L - t)] = (hf)val; if (t == 0) R[(size_t)c * rl] = (hf)0.f; }
        else if (t >= 1) R[(size_t)c * rl + (L + t)] = (hf)val; }
}

__device__ __forceinline__ void convert_layer(const Frame& F, const Params& p, int l, unsigned char* wl, int wg_rank, int wg_count) {
    LAS float* scr = (LAS float*)(F.lds + F.wave * 16384);
    const int gw = wg_rank * 8 + F.wave, NGW = wg_count * 8, lane = F.lane;
    constexpr int IT_IN1 = 16 * 61, IT_ING = 16 * 96, IT_UQ = 4 * 24, IT_UKV = 2 * 32, IT_BRA = 8 * 32, IT_BRB = 4 * 32, IT_BRC = 4 * 32, IT_OUT = 16 * 32, IT_FC1 = 16 * 128, IT_FC2 = 64 * 32;
    constexpr int IT_LAYER = IT_IN1 + IT_ING + IT_UQ + IT_UKV + IT_BRA + IT_BRB + IT_BRC + IT_OUT + IT_FC1 + IT_FC2;
    for (int it = gw; it < IT_LAYER; it += NGW) {
        int r = it;
        if (r < IT_IN1) { tr_item(p.in[I_WIN] + (size_t)l * DM * D_IN, D_IN, (hf*)(wl + W_IN1), DM, 61, scr, r, lane); continue; } r -= IT_IN1;
        if (r < IT_ING) { tr_item(p.in[I_WIN] + (size_t)l * DM * D_IN + C_PG, D_IN, (hf*)(wl + W_ING), DM, 96, scr, r, lane); continue; } r -= IT_ING;
        if (r < IT_UQ) { tr_item(p.in[I_WUQ] + (size_t)l * 256 * 768, 768, (hf*)(wl + W_UP), KUP, 24, scr, r, lane, p.in[I_QNG] + l * 256); continue; } r -= IT_UQ;
        if (r < IT_UKV) { tr_item(p.in[I_WUKV] + (size_t)l * 128 * 1024, 1024, (hf*)(wl + W_UP) + (size_t)768 * KUP + 256, KUP, 32, scr, r, lane, p.in[I_KVNG] + l * 128); continue; } r -= IT_UKV;
        if (r < IT_BRA) { tr_item(p.in[I_WBRA] + (size_t)l * 512 * DM, DM, (hf*)(wl + W_BR), DM, 32, scr, r, lane); continue; } r -= IT_BRA;
        if (r < IT_BRB) { tr_item(p.in[I_WBRB] + (size_t)l * 256 * DM, DM, (hf*)(wl + W_BR) + 512, DM, 32, scr, r, lane); continue; } r -= IT_BRB;
        if (r < IT_BRC) { tr_item(p.in[I_WBRC] + (size_t)l * 256 * DM, DM, (hf*)(wl + W_BR) + 768, DM, 32, scr, r, lane); continue; } r -= IT_BRC;
        if (r < IT_OUT) { tr_item(p.in[I_WOUT] + (size_t)l * DM * DM, DM, (hf*)(wl + W_OUT), DM, 32, scr, r, lane); continue; } r -= IT_OUT;
        if (r < IT_FC1) { tr_item(p.in[I_FC1] + (size_t)l * DM * DFF, DFF, (hf*)(wl + W_FC1), DM, 128, scr, r, lane); continue; } r -= IT_FC1;
        tr_item(p.in[I_FC2] + (size_t)l * DFF * DM, DM, (hf*)(wl + W_FC2), DFF, 32, scr, r, lane);
    }
    const int gt = gw * 64 + lane, NGT = NGW * 64;
    u32x4* z1 = (u32x4*)((hf*)(wl + W_IN1) + (size_t)C_PG * DM);
    for (int i = gt; i < 96 * DM / 8; i += NGT) z1[i] = (u32x4){0u, 0u, 0u, 0u};
    hf* up = (hf*)(wl + W_UP);
    for (int i = gt; i < 768 * 16; i += NGT) { const int n = i / 16, k8 = i % 16; *(u32x4*)(up + (size_t)n * KUP + 256 + k8 * 8) = (u32x4){0u, 0u, 0u, 0u}; }
    for (int i = gt; i < 1024 * 32; i += NGT) { const int n = 768 + i / 32, k8 = i % 32; *(u32x4*)(up + (size_t)n * KUP + k8 * 8) = (u32x4){0u, 0u, 0u, 0u}; }
}

__device__ __forceinline__ void prologue_a(const Frame& F, const Params& p) {
    mod_phase(F, p);
    convert_layer(F, p, 0, p.ws + WS_WT, F.vcu, F.G);
    const int gw = F.vcu * 8 + F.wave, NGW = F.G * 8, lane = F.lane;
    for (int it = gw; it < DEPTH * (SEQ + CTXL); it += NGW) { const int l = it / (SEQ + CTXL), r = it % (SEQ + CTXL); if (r < SEQ) filt_item(p, l, 0, r, lane); else filt_item(p, l, 1, r - SEQ, lane); }
    {
        float* rope = (float*)(p.ws + WS_ROPE);
        const int gt = gw * 64 + lane, NGT = NGW * 64;
        for (int i = gt; i < SEQ * 16; i += NGT) { const int t = i >> 4, j = i & 15; const float pos = (j < 8) ? (float)(t / GRIDW) : (float)(t % GRIDW);
            const float inv = powf(10000.f, -(float)(j & 7) / 8.f); const float a = pos * inv; rope[t * 32 + j] = cosf(a); rope[t * 32 + 16 + j] = sinf(a); }
        if (gt < DEPTH) { const int l = gt; float s1 = 0.f, s2 = 0.f;
            for (int i = 0; i < 32; ++i) { s1 += p.in[I_LQ1][l * 32 + i] * p.in[I_LK1][l * 32 + i]; s2 += p.in[I_LQ2][l * 32 + i] * p.in[I_LK2][l * 32 + i]; }
            const float li = 0.8f - 0.6f * expf(-0.3f * (float)l);
            float* lam = (float*)(p.ws + WS_LAM); lam[2 * l] = expf(s1) - expf(s2) + li; lam[2 * l + 1] = 1.f - li; }
    }
}
__device__ __forceinline__ void prologue_b(const Frame& F, const Params& p) {
    const float* MOD = (const float*)(p.ws + WS_MOD); float* BIAS = (float*)(p.ws + WS_BIAS);
    {
        LAS float* sv = (LAS float*)F.lds;
        constexpr int NCB = DEPTH * NBIAS / 512;
        for (int item = F.vcu; item < NCB * 3; item += F.G) {
            const int cb = item / 3, vg = item % 3;
            const int gcol = cb * 512 + F.tid, l = gcol / NBIAS, n = gcol % NBIAS, n0 = (cb * 512) % NBIAS;
            const int soff = (n0 >= B_FC1) ? 3 * DM : 0;
            __syncthreads();
            for (int i = F.tid; i < 11 * 1024; i += 512) { const int v = vg * 11 + i / 1024, k = i % 1024; sv[i] = MOD[((size_t)l * NMODV + v) * MODW + soff + k]; }
            __syncthreads();
            const float* w; size_t ldw; bool valid = true;
            if (n < B_G) { w = p.in[I_WIN] + (size_t)l * DM * D_IN + n; ldw = D_IN; valid = n < C_PG; }
            else if (n < B_FC1) { w = p.in[I_WIN] + (size_t)l * DM * D_IN + C_PG + (n - B_G); ldw = D_IN; }
            else { w = p.in[I_FC1] + (size_t)l * DM * DFF + (n - B_FC1); ldw = DFF; }
            float acc[11];
#pragma unroll
            for (int v = 0; v < 11; ++v) acc[v] = 0.f;
            if (valid)
#pragma unroll 4
            for (int k = 0; k < DM; k += 4) {
                const float w0 = w[(size_t)k * ldw], w1 = w[(size_t)(k + 1) * ldw], w2 = w[(size_t)(k + 2) * ldw], w3 = w[(size_t)(k + 3) * ldw];
#pragma unroll
                for (int v = 0; v < 11; ++v) { const f32x4 sx = *(const LAS f32x4*)(sv + v * 1024 + k);
                    acc[v] = fmaf(sx[0], w0, acc[v]); acc[v] = fmaf(sx[1], w1, acc[v]); acc[v] = fmaf(sx[2], w2, acc[v]); acc[v] = fmaf(sx[3], w3, acc[v]); }
            }
#pragma unroll
            for (int v = 0; v < 11; ++v) BIAS[((size_t)l * NMODV + vg * 11 + v) * NBIAS + n] = acc[v];
        }
        __syncthreads();
    }
    const int gw = F.vcu * 8 + F.wave, NGW = F.G * 8, lane = F.lane;
    {
        float* GS = (float*)(p.ws + WS_GS);
        const int gt = gw * 64 + lane, NGT = NGW * 64;
        for (int i = gt; i < DEPTH * 2 * NMODV * DM; i += NGT) { const int c = i % DM, v = (i / DM) % NMODV, wh = (i / (DM * NMODV)) % 2, l = i / (DM * NMODV * 2);
            const float g = wh ? p.in[I_NFG][l * DM + c] : p.in[I_NMG][l * DM + c];
            GS[i] = g * (1.f + MOD[((size_t)l * NMODV + v) * MODW + (wh ? 4 * DM : DM) + c]); }
    }
    {
        hf* XS = (hf*)p.out; hf* X16 = (hf*)(p.ws + WS_X16); float* ss = (float*)(p.ws + WS_SS) + (size_t)SS_1 * MTOT * 4;
        f32x4 g[4];
#pragma unroll
        for (int j = 0; j < 4; ++j) g[j] = *(const f32x4*)(p.in[I_NMG] + 4 * lane + 256 * j);
        for (int row = gw; row < MTOT; row += NGW) {
            const bool lat = row < NLAT; const float* xr = lat ? p.in[I_X] + (size_t)row * DM : p.in[I_CTX] + (size_t)(row - NLAT) * DM;
            const int v = lat ? (row >> 11) : NB; const float* mv = MOD + (size_t)v * MODW + DM;
            float sq = 0.f; hf* hr = XS + (size_t)row * DM; hf* xh = X16 + (size_t)row * DM;
#pragma unroll
            for (int j = 0; j < 4; ++j) { const f32x4 x = *(const f32x4*)(xr + 4 * lane + 256 * j); const f32x4 sc = *(const f32x4*)(mv + 4 * lane + 256 * j);
                sq += (x[0] * x[0] + x[1] * x[1]) + (x[2] * x[2] + x[3] * x[3]);
                const f32x4 o = x * (g[j] * (sc + 1.f)); u32x2 w; w.x = pkhb(o[0], o[1]); w.y = pkhb(o[2], o[3]); *(u32x2*)(hr + 4 * lane + 256 * j) = w;
                u32x2 w2; w2.x = pkh(x[0], x[1]); w2.y = pkh(x[2], x[3]); *(u32x2*)(xh + 4 * lane + 256 * j) = w2; }
            sq = wave_sum(sq);
            if (lane == 0) *(f32x4*)(ss + 4 * (size_t)row) = (f32x4){sq, 0.f, 0.f, 0.f};
        }
    }
}

__device__ __forceinline__ void norm_phase(const Frame& F, const float* xs_lat, const float* xs_ctx, int nrows, const float* gain, const float* modl, int sh_off, int sc_off, hf* H) {
    const int gw = F.vcu * 8 + F.wave, NGW = F.G * 8, lane = F.lane;
    f32x4 g[4];
#pragma unroll
    for (int j = 0; j < 4; ++j) g[j] = *(const f32x4*)(gain + 4 * lane + 256 * j);
    for (int row = gw; row < nrows; row += NGW) {
        const bool lat = row < NLAT; const float* xr = lat ? xs_lat + (size_t)row * DM : xs_ctx + (size_t)(row - NLAT) * DM;
        const int v = lat ? (row >> 11) : NB; const float* mv = modl + (size_t)v * MODW;
        f32x4 x[4]; float ss = 0.f;
#pragma unroll
        for (int j = 0; j < 4; ++j) { x[j] = *(const f32x4*)(xr + 4 * lane + 256 * j); ss += (x[j][0] * x[j][0] + x[j][1] * x[j][1]) + (x[j][2] * x[j][2] + x[j][3] * x[j][3]); }
        const float rstd = rsqrtf(wave_sum(ss) * (1.f / DM) + EPS);
        hf* hr = H + (size_t)row * DM;
#pragma unroll
        for (int j = 0; j < 4; ++j) { const f32x4 sh = *(const f32x4*)(mv + sh_off + 4 * lane + 256 * j), sc = *(const f32x4*)(mv + sc_off + 4 * lane + 256 * j);
            const f32x4 y = (x[j] * rstd) * g[j]; const f32x4 o = y * (sc + 1.f) + sh;
            u32x2 w; w.x = pkh(o[0], o[1]); w.y = pkh(o[2], o[3]); *(u32x2*)(hr + 4 * lane + 256 * j) = w; }
    }
}
__device__ __forceinline__ void final_norm_phase(const Frame& F, const hf* X16, float* out, const float* gain, const float* ss) {
    const int gw = F.vcu * 8 + F.wave, NGW = F.G * 8, lane = F.lane;
    f32x4 g[4];
#pragma unroll
    for (int j = 0; j < 4; ++j) g[j] = *(const f32x4*)(gain + 4 * lane + 256 * j);
    for (int row = gw; row < NLAT; row += NGW) {
        const hf* xr = X16 + (size_t)row * DM; float* orow = out + (size_t)row * DM; const float rstd = rstd4(ss, row);
#pragma unroll
        for (int j = 0; j < 4; ++j) { const hf4 xh = *(const hf4*)(xr + 4 * lane + 256 * j); const f32x4 x = {(float)xh[0], (float)xh[1], (float)xh[2], (float)xh[3]};
            *(f32x4*)(orow + 4 * lane + 256 * j) = (x * rstd) * g[j]; }
    }
}

__device__ __forceinline__ void prep_rope(const Frame& F, const Params& p) {
    const int gw = F.vcu * 8 + F.wave, NGW = F.G * 8, lane = F.lane;
    hf* KR = (hf*)(p.ws + A_KR); hf* DK = (hf*)(p.ws + A_DK); const float* rope = (const float*)(p.ws + WS_ROPE);
    const int hh = lane >> 3, i0 = 2 * (lane & 7);
    for (int row0 = gw * 4; row0 < NLAT; row0 += NGW * 4) {
        hf2 a[4], b[4]; f32x2 c[4], sn[4]; float y1[4], y2[4], cc[4], ss[4];
#pragma unroll
        for (int q = 0; q < 4; ++q) { const int row = row0 + q, t = row & (SEQ - 1); const hf* dk = DK + (size_t)row * 256 + hh * 32 + i0;
            a[q] = *(const hf2*)dk; b[q] = *(const hf2*)(dk + 16); c[q] = *(const f32x2*)(rope + t * 32 + i0); sn[q] = *(const f32x2*)(rope + t * 32 + 16 + i0);
            if (lane < 16) { const hf* kr = KR + (size_t)row * 32 + lane; y1[q] = (float)kr[0]; y2[q] = (float)kr[16]; cc[q] = rope[t * 32 + lane]; ss[q] = rope[t * 32 + 16 + lane]; } }
#pragma unroll
        for (int q = 0; q < 4; ++q) { const int row = row0 + q; hf* dk = DK + (size_t)row * 256 + hh * 32 + i0;
            const float x1[2] = {(float)a[q][0], (float)a[q][1]}, x2[2] = {(float)b[q][0], (float)b[q][1]};
            *(unsigned*)dk = pkh(x1[0] * c[q][0] - x2[0] * sn[q][0], x1[1] * c[q][1] - x2[1] * sn[q][1]);
            *(unsigned*)(dk + 16) = pkh(x2[0] * c[q][0] + x1[0] * sn[q][0], x2[1] * c[q][1] + x1[1] * sn[q][1]);
            if (lane < 16) { hf* kr = KR + (size_t)row * 32 + lane; kr[0] = (hf)(y1[q] * cc[q] - y2[q] * ss[q]); kr[16] = (hf)(y2[q] * cc[q] + y1[q] * ss[q]); } }
    }
}
__device__ __forceinline__ void prep_hyena(const Frame& F, const Params& p, int l, bool with_ctx) {
    constexpr int INP = 784;
    constexpr int OUTP = 33;
    constexpr int OFF_OU = 66 * INP, OFF_OX = OFF_OU + 128 * OUTP * 4;
    const hf* PHY = (const hf*)(p.ws + A_PHY);
    LAS unsigned char* lds = F.lds; const int tid = F.tid;
    const float* cw = p.in[I_HCW] + (size_t)l * 3 * 768; const float* cb = p.in[I_HCB] + (size_t)l * 768;
    constexpr int U_LAT = NB * (SEQ / 64) * 2, U_CTX = NB * (CTXL / 64) * 2;
    const int nunit = U_LAT + (with_ctx ? U_CTX : 0);
    for (int un = F.vcu; un < nunit; un += F.G) {
        const bool ctx = un >= U_LAT; int r = ctx ? un - U_LAT : un; const int L = ctx ? CTXL : SEQ, ntile = L / 64;
        const int ch = r & 1; r >>= 1; const int tt = r % ntile, b = r / ntile;
        const int t0 = tt * 64; const size_t rowbase = ctx ? (size_t)NLAT + (size_t)b * CTXL : (size_t)b * SEQ;
        hf* dU = (hf*)((unsigned char*)p.out + (ctx ? O_UTC : O_UT)); hf* dX = (hf*)((unsigned char*)p.out + (ctx ? O_X0TC : O_X0T));
        __syncthreads();
        {
            u32x4 tmp[7];
#pragma unroll
            for (int k = 0; k < 7; ++k) { const int i = tid + 512 * k, rr = i / 48, q = i % 48, seg = q >> 4, c16 = q & 15; const int t = t0 - 1 + rr;
                tmp[k] = (u32x4){0u, 0u, 0u, 0u};
                if (i < 66 * 48 && t >= 0 && t < L) tmp[k] = *(const u32x4*)(PHY + (rowbase + t) * 768 + seg * 256 + ch * 128 + c16 * 8); }
#pragma unroll
            for (int k = 0; k < 7; ++k) { const int i = tid + 512 * k, rr = i / 48, q = i % 48, seg = q >> 4, c16 = q & 15;
                if (i < 66 * 48) *(LAS u32x4*)(lds + rr * INP + seg * 256 + c16 * 16) = tmp[k]; }
        }
        __syncthreads();
        {
            const int c = tid & 127, tg = tid >> 7, cg = ch * 128 + c;
            const float a0 = cw[cg], a1 = cw[768 + cg], a2 = cw[1536 + cg], ab = cb[cg];
            const float b0 = cw[256 + cg], b1 = cw[768 + 256 + cg], b2 = cw[1536 + 256 + cg], bb = cb[256 + cg];
            const float v0 = cw[512 + cg], v1 = cw[768 + 512 + cg], v2 = cw[1536 + 512 + cg], vb = cb[512 + cg];
            const LAS hf* in = (const LAS hf*)(lds + (16 * tg) * INP) + c;
            float p0 = (float)in[0], p1 = (float)in[128], p2 = (float)in[256];
            float c0 = (float)in[INP / 2], c1 = (float)in[INP / 2 + 128], c2 = (float)in[INP / 2 + 256];
            LAS hf* ou = (LAS hf*)(lds + OFF_OU) + c * (OUTP * 2) + 16 * tg; LAS hf* ox = (LAS hf*)(lds + OFF_OX) + c * (OUTP * 2) + 16 * tg;
#pragma unroll
            for (int j = 0; j < 16; ++j) { const LAS hf* nx = in + (j + 2) * (INP / 2);
                const float n0 = (float)nx[0], n1 = (float)nx[128], n2 = (float)nx[256];
                const float x0 = a0 * p0 + a1 * c0 + a2 * n0 + ab, x1 = b0 * p1 + b1 * c1 + b2 * n1 + bb, vv = v0 * p2 + v1 * c2 + v2 * n2 + vb;
                ou[j] = (hf)(vv * x1); ox[j] = (hf)x0;
                p0 = c0; p1 = c1; p2 = c2; c0 = n0; c1 = n1; c2 = n2; }
        }
        __syncthreads();
        {
            const int c = tid >> 2, q = tid & 3; const size_t go = ((size_t)(ch * 128 + c) * NB + b) * L + t0 + 16 * q;
            const LAS unsigned* su = (const LAS unsigned*)(lds + OFF_OU) + c * OUTP + 8 * q; const LAS unsigned* sx = (const LAS unsigned*)(lds + OFF_OX) + c * OUTP + 8 * q;
            u32x4 w0 = {su[0], su[1], su[2], su[3]}, w1 = {su[4], su[5], su[6], su[7]};
            *(u32x4*)(dU + go) = w0; *(u32x4*)(dU + go + 8) = w1;
            u32x4 y0 = {sx[0], sx[1], sx[2], sx[3]}, y1 = {sx[4], sx[5], sx[6], sx[7]};
            *(u32x4*)(dX + go) = y0; *(u32x4*)(dX + go + 8) = y1;
        }
    }
    __syncthreads();
}

namespace att {
#ifndef PROF_SEL
#define PROF_SEL -1
#endif
#define ATT_MARK(b) do { if (PROF_SEL >= 0 && F.tid == 0) { volatile LAS unsigned* _pf = (volatile LAS unsigned*)(F.lds + LDS_BYTES - 512); const unsigned _t = (unsigned)__builtin_amdgcn_s_memrealtime(); _pf[(b)] += _t - _pf[32]; _pf[32] = _t; } } while (0)
__device__ __forceinline__ int crow(int r, int hi) { return (r & 3) + 8 * (r >> 2) + 4 * hi; }
#define SBAR() __builtin_amdgcn_sched_barrier(0)
constexpr float THR2 = 8.f * 1.4426950408889634f;
constexpr int KS_MLA = 208, KS_DF = 80;
constexpr int VS = 192, VB = 64 * VS;
constexpr int OFF_V = 32768;
template <int OFF> __device__ __forceinline__ s16x4 tr_read(int vb) {
    s16x4 r; asm volatile("ds_read_b64_tr_b16 %0, %1 offset:%2" : "=&v"(r) : "v"(vb), "i"(OFF) : "memory"); return r;
}
__device__ __forceinline__ int kpos(int key) { return (key & ~0xC) | ((key & 4) << 1) | ((key & 8) >> 1); }

template <int ND0, int KS>
__device__ __forceinline__ void qkt(f32x16& p0, f32x16& p1, const LAS unsigned char* Ks, const hf8* qr, int r32, int hi, const f32x16& negm) {
#pragma unroll
    for (int d0 = 0; d0 < ND0; ++d0) { const int cb = (d0 * 16 + hi * 8) * 2;
        const hf8 b0 = *(const LAS hf8*)(Ks + r32 * KS + cb), b1 = *(const LAS hf8*)(Ks + (32 + r32) * KS + cb);
        if (d0 == 0) { p0 = __builtin_amdgcn_mfma_f32_32x32x16_f16(b0, qr[0], negm, 0, 0, 0); p1 = __builtin_amdgcn_mfma_f32_32x32x16_f16(b1, qr[0], negm, 0, 0, 0); }
        else { p0 = __builtin_amdgcn_mfma_f32_32x32x16_f16(b0, qr[d0], p0, 0, 0, 0); p1 = __builtin_amdgcn_mfma_f32_32x32x16_f16(b1, qr[d0], p1, 0, 0, 0); } }
}
__device__ __forceinline__ float max3f(float a, float b, float c) { float r; asm("v_max3_f32 %0, %1, %2, %3" : "=v"(r) : "v"(a), "v"(b), "v"(c)); return r; }
__device__ __forceinline__ float max2f(float a, float b) { float r; asm("v_max_f32_e32 %0, %1, %2" : "=v"(r) : "v"(a), "v"(b)); return r; }
__device__ __forceinline__ float max16(const f32x16& p) { float r, t;
    asm("v_max3_f32 %0, %2, %3, %4\n\tv_max3_f32 %1, %10, %11, %12\n\tv_max3_f32 %0, %0, %5, %6\n\tv_max3_f32 %1, %1, %13, %14\n\tv_max3_f32 %0, %0, %7, %8\n\tv_max3_f32 %1, %1, %15, %16\n\tv_max3_f32 %0, %0, %9, %17\n\tv_max_f32_e32 %0, %0, %1"
        : "=&v"(r), "=&v"(t) : "v"(p[0]), "v"(p[1]), "v"(p[2]), "v"(p[3]), "v"(p[4]), "v"(p[5]), "v"(p[6]), "v"(p[7]), "v"(p[8]), "v"(p[9]), "v"(p[10]), "v"(p[11]), "v"(p[12]), "v"(p[13]), "v"(p[14]), "v"(p[15]));
    return r; }
__device__ __forceinline__ hf8 pack8(const f32x16& p, int b) { u32x4 w = {pkh(p[b], p[b + 1]), pkh(p[b + 2], p[b + 3]), pkh(p[b + 4], p[b + 5]), pkh(p[b + 6], p[b + 7])}; return __builtin_bit_cast(hf8, w); }
__device__ __forceinline__ void sm_max(f32x16& p0, f32x16& p1, float& m, float& l, f32x16& o0, f32x16& o1, f32x16& negm, const bool first) {
    float pmax = max2f(max16(p0), max16(p1));
    { auto rr = __builtin_amdgcn_permlane32_swap(__float_as_uint(pmax), __float_as_uint(pmax), false, false);
      pmax = max2f(__uint_as_float(rr[0]), __uint_as_float(rr[1])); }
    if (first || __any(pmax > THR2)) {
        const float delta = first ? pmax : fmaxf(pmax, 0.f);
        if (!first) { const float alpha = __builtin_amdgcn_exp2f(-delta); l *= alpha;
#pragma unroll
            for (int r = 0; r < 16; ++r) { o0[r] *= alpha; o1[r] *= alpha; } }
#pragma unroll
        for (int r = 0; r < 16; ++r) { p0[r] -= delta; p1[r] -= delta; }
        m += delta;
#pragma unroll
        for (int r = 0; r < 16; ++r) negm[r] = -m;
        asm volatile("" : "+v"(negm));
    }
}
__device__ __forceinline__ void sm_exp(f32x16& p0, f32x16& p1, const float m, float& l, hf8& pf0, hf8& pf1, hf8& pf2, hf8& pf3) {
#pragma unroll
    for (int r = 0; r < 16; ++r) { p0[r] = __builtin_amdgcn_exp2f(p0[r]); p1[r] = __builtin_amdgcn_exp2f(p1[r]); }
    float ps0 = p0[0] + p1[0], ps1 = p0[1] + p1[1], ps2 = p0[2] + p1[2], ps3 = p0[3] + p1[3];
#pragma unroll
    for (int r = 4; r < 16; r += 4) { ps0 += p0[r] + p1[r]; ps1 += p0[r + 1] + p1[r + 1]; ps2 += p0[r + 2] + p1[r + 2]; ps3 += p0[r + 3] + p1[r + 3]; }
    l += (ps0 + ps1) + (ps2 + ps3);
    pf0 = pack8(p0, 0); pf1 = pack8(p0, 8); pf2 = pack8(p1, 0); pf3 = pack8(p1, 8);
}
__device__ __forceinline__ void pv(const hf8 pf0, const hf8 pf1, const hf8 pf2, const hf8 pf3, f32x16& o0, f32x16& o1, const LAS unsigned char* Vt, int r32, int hi) {
    const int lg = (int)(threadIdx.x & 15), vq = lg >> 2, vp4 = lg & 3;
    const int vbase = (int)(unsigned)(uintptr_t)Vt + (4 * hi + vq) * VS + (16 * ((int)(threadIdx.x >> 4) & 1) + 4 * vp4) * 2;
#define PVRD(ks, L0, H0, L1, H1) s16x4 L0 = tr_read<(16 * (ks)) * VS>(vbase), H0 = tr_read<(16 * (ks) + 8) * VS>(vbase), L1 = tr_read<(16 * (ks)) * VS + 64>(vbase), H1 = tr_read<(16 * (ks) + 8) * VS + 64>(vbase)
#define PVMM(N, L0, H0, L1, H1, pf) do { asm volatile("s_waitcnt lgkmcnt(" #N ")" : "+v"(L0), "+v"(H0), "+v"(L1), "+v"(H1) :: "memory"); \
        const hf8 a0 = __builtin_bit_cast(hf8, (short __attribute__((ext_vector_type(8)))){L0[0], L0[1], L0[2], L0[3], H0[0], H0[1], H0[2], H0[3]}); \
        const hf8 a1 = __builtin_bit_cast(hf8, (short __attribute__((ext_vector_type(8)))){L1[0], L1[1], L1[2], L1[3], H1[0], H1[1], H1[2], H1[3]}); \
        o0 = __builtin_amdgcn_mfma_f32_32x32x16_f16(a0, pf, o0, 0, 0, 0); o1 = __builtin_amdgcn_mfma_f32_32x32x16_f16(a1, pf, o1, 0, 0, 0); } while (0)
    PVRD(0, a0l, a0h, a1l, a1h); PVRD(1, b0l, b0h, b1l, b1h);
    PVMM(4, a0l, a0h, a1l, a1h, pf0);
    PVRD(2, c0l, c0h, c1l, c1h);
    PVMM(4, b0l, b0h, b1l, b1h, pf1);
    PVRD(3, d0l, d0h, d1l, d1h);
    PVMM(4, c0l, c0h, c1l, c1h, pf2);
    PVMM(0, d0l, d0h, d1l, d1h, pf3);
#undef PVRD
#undef PVMM
#define PVK(ks, pf)
#undef PVK
}

template <bool MLA>
__device__ __forceinline__ void attn_pass(const Frame& F, const Params& p, int hq, int hv, int qrow0, int qpos0, int klat0, int nlat, int kctx0, f32x16& o0, f32x16& o1, float& inv) {
    constexpr int DK = MLA ? 96 : 32, ND0 = DK / 16, KS = MLA ? KS_MLA : KS_DF, KB = 64 * KS;
    constexpr float SCALE = MLA ? MLA_SCALE : DF_SCALE, C = SCALE * 1.4426950408889634f;
    const int tid = F.tid, wid = F.wave, lane = F.lane, r32 = lane & 31, hi = lane >> 5;
    const hf* QKV = (const hf*)(p.ws + A_QKV); const hf* KRb = (const hf*)(p.ws + A_KR);
    const hf* DQ = (const hf*)(p.ws + A_DQ); const hf* DKb = (const hf*)(p.ws + A_DK); const hf* DVb = (const hf*)(p.ws + A_DV);
    const float* rope = (const float*)(p.ws + WS_ROPE);
    LAS unsigned char* lds = F.lds;
    hf8 qr[ND0];
    {
        const int qrow = qrow0 + wid * 32 + r32;
        const hf* qp = MLA ? QKV + (size_t)qrow * NUP + hq * 96 + hi * 8 : DQ + (size_t)qrow * 256 + hq * 32 + hi * 8;
        hf8 raw[ND0];
#pragma unroll
        for (int d0 = 0; d0 < ND0; ++d0) raw[d0] = *(const hf8*)(qp + d0 * 16);
        f32x4 c0 = {1.f, 1.f, 1.f, 1.f}, c1 = c0, s0 = {0.f, 0.f, 0.f, 0.f}, s1 = s0;
        if (qpos0 >= 0) { const int t = qpos0 + wid * 32 + r32;
            c0 = *(const f32x4*)(rope + t * 32 + hi * 8); c1 = *(const f32x4*)(rope + t * 32 + hi * 8 + 4);
            s0 = *(const f32x4*)(rope + t * 32 + 16 + hi * 8); s1 = *(const f32x4*)(rope + t * 32 + 16 + hi * 8 + 4); }
#pragma unroll
        for (int d0 = 0; d0 < ND0 - 2; ++d0) {
#pragma unroll
            for (int j = 0; j < 8; ++j) qr[d0][j] = (hf)((float)raw[d0][j] * C); }
#pragma unroll
        for (int j = 0; j < 8; ++j) { const float cc = j < 4 ? c0[j & 3] : c1[j & 3], sn = j < 4 ? s0[j & 3] : s1[j & 3]; const float a = (float)raw[ND0 - 2][j], b = (float)raw[ND0 - 1][j];
            qr[ND0 - 2][j] = (hf)((a * cc - b * sn) * C); qr[ND0 - 1][j] = (hf)((b * cc + a * sn) * C); }
    }
    const int k1r = MLA ? (tid >> 3) : ((tid & 255) >> 2), k1c = MLA ? (tid & 7) * 8 : (tid & 3) * 8;
    const int k2r = (tid & 255) >> 2, k2c = (tid & 3) * 8;
    const int vr_ = tid >> 3, vc_ = (tid & 7) * 8;
    const bool klo = tid < 256;
    struct Stg { u32x4 v, k1, k2; };
    Stg sA, sB; sA.v = sA.k1 = sA.k2 = sB.v = sB.k1 = sB.k2 = (u32x4){0u, 0u, 0u, 0u};
    const int ntile = nlat + 4;
#define KROW0(j) (((j) < nlat) ? klat0 + (j) * 64 : kctx0 + ((j) - nlat) * 64)
#define A_LOADK(S, j) do { const int kr0 = KROW0(j); \
        if (MLA) { S.k1 = *(const u32x4*)(QKV + (size_t)(kr0 + k1r) * NUP + 768 + hq * 128 + k1c); S.k2 = *(const u32x4*)(KRb + (size_t)(kr0 + k2r) * 32 + k2c); } \
        else S.k1 = *(const u32x4*)(DKb + (size_t)(kr0 + k1r) * 256 + hq * 32 + k1c); } while (0)
#define A_LOADV(S, j) do { const int kr0 = KROW0(j); \
        if (MLA) S.v = *(const u32x4*)(QKV + (size_t)(kr0 + vr_) * NUP + 768 + hv * 128 + 64 + vc_); else S.v = *(const u32x4*)(DVb + (size_t)(kr0 + vr_) * 256 + hv * 64 + vc_); } while (0)
#define A_WRITEK(S, b) do { *(LAS u32x4*)(lds + (b) * KB + k1r * KS + k1c * 2) = S.k1; if (MLA) *(LAS u32x4*)(lds + (b) * KB + k2r * KS + 128 + k2c * 2) = S.k2; } while (0)
#define A_WRITEV(S, b) do { *(LAS u32x4*)(lds + OFF_V + (b) * VB + vr_ * VS + vc_ * 2) = S.v; } while (0)
    float m_reg = 0.f, l_reg = 0.f;
    f32x16 negm = f32x16{}; asm volatile("" : "+v"(negm));
    o0 = f32x16{}; o1 = f32x16{};
    f32x16 pA0, pA1, pB0, pB1;
    __syncthreads();
    const int nt1 = ntile - 1;
#define TCL(j) (((j) < nt1) ? (j) : nt1)
    A_LOADK(sA, 0); A_LOADV(sA, 0); A_LOADK(sB, 1);
    A_WRITEK(sA, 0); A_WRITEV(sA, 0); A_WRITEK(sB, 1);
    A_LOADK(sA, TCL(2));
    A_LOADV(sA, 1);
    __syncthreads();
    qkt<ND0, KS>(pA0, pA1, lds, qr, r32, hi, negm);
    hf8 f0, f1, f2, f3;
    if (wid >= 4) __syncthreads();
    for (int j = 0; j < ntile; j += 2) {
        A_LOADK(sB, TCL(j + 3)); A_LOADV(sB, TCL(j + 2));
        sm_max(pA0, pA1, m_reg, l_reg, o0, o1, negm, j == 0);
        sm_exp(pA0, pA1, m_reg, l_reg, f0, f1, f2, f3);
        __syncthreads();
        qkt<ND0, KS>(pB0, pB1, lds + KB, qr, r32, hi, negm);
        pv(f0, f1, f2, f3, o0, o1, lds + OFF_V, r32, hi);
        A_WRITEK(sA, 0); A_WRITEV(sA, 1);
        __syncthreads();
        A_LOADK(sA, TCL(j + 4)); A_LOADV(sA, TCL(j + 3));
        sm_max(pB0, pB1, m_reg, l_reg, o0, o1, negm, false);
        sm_exp(pB0, pB1, m_reg, l_reg, f0, f1, f2, f3);
        __syncthreads();
        qkt<ND0, KS>(pA0, pA1, lds, qr, r32, hi, negm);
        pv(f0, f1, f2, f3, o0, o1, lds + OFF_V + VB, r32, hi);
        A_WRITEK(sB, 1); A_WRITEV(sB, 0);
        __syncthreads();
    }
    if (wid < 4) __syncthreads();
#undef TCL
#undef KROW0
#undef A_LOADK
#undef A_LOADV
#undef A_WRITEK
#undef A_WRITEV
    const float lt = l_reg + __shfl_xor(l_reg, 32); inv = __builtin_amdgcn_rcpf(lt);
}
template <bool MLA>
__device__ __forceinline__ void attn_unit(const Frame& F, const Params& p, int l, int h, int qrow0, int qpos0, int klat0, int nlat, int kctx0) {
    const int wid = F.wave, lane = F.lane, r32 = lane & 31, hi = lane >> 5;
    hf* Y = (hf*)(p.ws + A_Y);
    const size_t yrow = (size_t)(qrow0 + wid * 32 + r32) * DM;
    if constexpr (MLA) {
        f32x16 o0, o1; float inv;
        attn_pass<true>(F, p, h, h, qrow0, qpos0, klat0, nlat, kctx0, o0, o1, inv);
#pragma unroll
        for (int g = 0; g < 4; ++g) { u32x2 w; w.x = pkhb(o0[4 * g] * inv, o0[4 * g + 1] * inv); w.y = pkhb(o0[4 * g + 2] * inv, o0[4 * g + 3] * inv); *(u32x2*)(Y + yrow + h * 64 + 8 * g + 4 * hi) = w; }
#pragma unroll
        for (int g = 0; g < 4; ++g) { u32x2 w; w.x = pkhb(o1[4 * g] * inv, o1[4 * g + 1] * inv); w.y = pkhb(o1[4 * g + 2] * inv, o1[4 * g + 3] * inv); *(u32x2*)(Y + yrow + h * 64 + 32 + 8 * g + 4 * hi) = w; }
    } else {
        const float lam = ((const float*)(p.ws + WS_LAM))[2 * l], oml = ((const float*)(p.ws + WS_LAM))[2 * l + 1];
        f32x16 a0, a1;
        LAS float* park = (LAS float*)(F.lds + 65536 + wid * 8192) + lane;
        { f32x16 o0, o1; float inv; attn_pass<false>(F, p, 2 * h, h, qrow0, qpos0, klat0, nlat, kctx0, o0, o1, inv);
#pragma unroll
          for (int r = 0; r < 16; ++r) { park[r * 64] = o0[r] * inv; park[(16 + r) * 64] = o1[r] * inv; } }
        { f32x16 o0, o1; float inv; attn_pass<false>(F, p, 2 * h + 1, h, qrow0, qpos0, klat0, nlat, kctx0, o0, o1, inv);
#pragma unroll
          for (int r = 0; r < 16; ++r) { a0[r] = park[r * 64] - o0[r] * (lam * inv); a1[r] = park[(16 + r) * 64] - o1[r] * (lam * inv); } }
        float ss = 0.f;
#pragma unroll
        for (int r = 0; r < 16; ++r) ss += a0[r] * a0[r] + a1[r] * a1[r];
        ss += __shfl_xor(ss, 32);
        const float rs = rsqrtf(ss * (1.f / 64.f) + EPS) * oml;
#pragma unroll
        for (int g = 0; g < 4; ++g) { const f32x4 gg = *(const f32x4*)(p.in[I_SUBG] + l * 64 + 8 * g + 4 * hi);
            u32x2 w; w.x = pkhb(a0[4 * g] * rs * gg[0], a0[4 * g + 1] * rs * gg[1]); w.y = pkhb(a0[4 * g + 2] * rs * gg[2], a0[4 * g + 3] * rs * gg[3]); *(u32x2*)(Y + yrow + 768 + h * 64 + 8 * g + 4 * hi) = w; }
#pragma unroll
        for (int g = 0; g < 4; ++g) { const f32x4 gg = *(const f32x4*)(p.in[I_SUBG] + l * 64 + 32 + 8 * g + 4 * hi);
            u32x2 w; w.x = pkhb(a1[4 * g] * rs * gg[0], a1[4 * g + 1] * rs * gg[1]); w.y = pkhb(a1[4 * g + 2] * rs * gg[2], a1[4 * g + 3] * rs * gg[3]); *(u32x2*)(Y + yrow + 768 + h * 64 + 32 + 8 * g + 4 * hi) = w; }
    }
}
}

#define HY_MARK(b) do { if (PROF_SEL >= 0 && F.tid == 0) { volatile LAS unsigned* _pf = (volatile LAS unsigned*)(F.lds + LDS_BYTES - 512); const unsigned _t = (unsigned)__builtin_amdgcn_s_memrealtime(); _pf[(b)] += _t - _pf[32]; _pf[32] = _t; } } while (0)
template <int L>
__device__ __forceinline__ void hyena_unit(const Frame& F, const hf* Rrow  , const hf* U  , const hf* X0  , hf* Ycol  ) {
    constexpr int NM = L / 256, RL = 2 * L, SH = (L > 1024) ? 1024 : L, NH = L / SH, US = SH * 2 + 16;
    constexpr int OFF_U = 8 * RL * 2;
    constexpr int XP = L * 2 + 16;
    static_assert(OFF_U + 32 * US <= LDS_MISC && 32 * XP <= LDS_MISC, "hyena LDS");
    const int tid = F.tid, w = F.wave, lane = F.lane, i32 = lane & 31, hi = lane >> 5;
    LAS unsigned char* lds = F.lds;
    __syncthreads();
    for (int i = tid; i < RL / 8; i += 512) *(LAS u32x4*)(lds + i * 16) = *(const u32x4*)(Rrow + i * 8);
    __syncthreads();
    {
        const LAS unsigned* src = (const LAS unsigned*)lds;
#pragma unroll 1
        for (int idx = tid; idx < 7 * (RL / 8); idx += 512) { const int cw = 1 + idx / (RL / 8), c4 = (idx % (RL / 8)) * 4;
            const int k0 = c4 - ((cw + 1) >> 1); unsigned d[5];
#pragma unroll
            for (int e = 0; e < 5; ++e) { const int k = k0 + e; d[e] = (k >= 0 && k < RL / 2) ? src[k] : 0u; }
            u32x4 o;
            if (cw & 1) { o.x = (d[0] >> 16) | (d[1] << 16); o.y = (d[1] >> 16) | (d[2] << 16); o.z = (d[2] >> 16) | (d[3] << 16); o.w = (d[3] >> 16) | (d[4] << 16); }
            else { o.x = d[0]; o.y = d[1]; o.z = d[2]; o.w = d[3]; }
            *(LAS u32x4*)(lds + cw * (RL * 2) + c4 * 4) = o; }
    }
    HY_MARK(22);
    f32x16 acc[NM];
#pragma unroll
    for (int m = 0; m < NM; ++m) acc[m] = f32x16{};
    const LAS unsigned char* cpy = lds + w * (RL * 2);
    for (int half = 0; half < NH; ++half) {
        __syncthreads();
        {
            constexpr int NPC = 32 * (SH / 8) / 512, NB4 = NPC > 4 ? 4 : NPC;
            int tq = tid; asm volatile("" : "+v"(tq));
#pragma unroll
            for (int k0 = 0; k0 < NPC; k0 += NB4) { u32x4 tmp[NB4];
#pragma unroll
                for (int k = 0; k < NB4; ++k) { const int idx = tq + 512 * (k0 + k), b = idx / (SH / 8), pc = idx % (SH / 8); tmp[k] = *(const u32x4*)(U + (size_t)b * L + half * SH + pc * 8); }
#pragma unroll
                for (int k = 0; k < NB4; ++k) { const int idx = tq + 512 * (k0 + k), b = idx / (SH / 8), pc = idx % (SH / 8); *(LAS u32x4*)(lds + OFF_U + b * US + pc * 16) = tmp[k]; }
                asm volatile("" ::: "memory"); }
        }
        __syncthreads();
#pragma unroll 2
        for (int jl = 0; jl < SH / 16; ++jl) {
            const int j = half * (SH / 16) + jl;
            const hf8 bf = *(const LAS hf8*)(lds + OFF_U + i32 * US + (jl * 16 + hi * 8) * 2);
            const int x0 = L + 16 * j + 8 * hi - 8 * i32;
#pragma unroll
            for (int m = 0; m < NM; ++m) { const hf8 af = *(const LAS hf8*)(cpy + (x0 - 256 * m) * 2);
                acc[m] = __builtin_amdgcn_mfma_f32_32x32x16_f16(af, bf, acc[m], 0, 0, 0); }
        }
    }
    __syncthreads();
    HY_MARK(23);
    {
        constexpr int NPC = 32 * (L / 8) / 512, NB8 = NPC > 4 ? 4 : NPC;
        int tq = tid; asm volatile("" : "+v"(tq));
#pragma unroll
        for (int k0 = 0; k0 < NPC; k0 += NB8) { u32x4 tmp[NB8];
#pragma unroll
            for (int k = 0; k < NB8; ++k) { const int idx = tq + 512 * (k0 + k), b = idx / (L / 8), pc = idx % (L / 8); tmp[k] = *(const u32x4*)(X0 + (size_t)b * L + pc * 8); }
#pragma unroll
            for (int k = 0; k < NB8; ++k) { const int idx = tq + 512 * (k0 + k), b = idx / (L / 8), pc = idx % (L / 8); *(LAS u32x4*)(lds + b * XP + pc * 16) = tmp[k]; }
            asm volatile("" ::: "memory"); }
    }
    __syncthreads();
    HY_MARK(24);
    const LAS hf* x0p = (const LAS hf*)(lds + i32 * XP) + w + 32 * hi;
    hf* yp = Ycol + ((size_t)i32 * L + w + 32 * hi) * DM;
#pragma unroll
    for (int m = 0; m < NM; ++m) {
#pragma unroll
        for (int r = 0; r < 16; ++r) { const int tt = 256 * m + 8 * ((r & 3) + 8 * (r >> 2));
            const float x0v = (float)x0p[tt];
            { const float yv = x0v * acc[m][r]; unsigned ub = __float_as_uint(yv); ub += 0x7fffu + ((ub >> 16) & 1u); yp[(size_t)tt * DM] = (hf)__uint_as_float(ub & 0xffff0000u); } }
        asm volatile("" ::: "memory");
    }
    HY_MARK(25);
}

#ifndef PH_MASK
#define PH_MASK 0x1FFFF
#endif
#define PHM(k) ((PH_MASK >> (k)) & 1)
#ifndef PROBE_REP
#define PROBE_REP 0
#endif
#define NREP(k) (((PROBE_REP >> (k)) & 1) ? 2 : 1)
constexpr int NPH_LAYER = 7, PH_L0 = 2, NPHASE = PH_L0 + DEPTH * NPH_LAYER + 1;
__global__ void __launch_bounds__(512, 2) fwd_kernel(Params p) {
    extern __shared__ __attribute__((aligned(16))) unsigned char lds_raw[];
    Frame F0; Frame& F = F0;
    F.lds = (LAS unsigned char*)lds_raw;
    F.tid = threadIdx.x; F.lane = F.tid & 63; F.wave = __builtin_amdgcn_readfirstlane(F.tid >> 6);
    F.G = gridDim.x; { const int bx = blockIdx.x; F.vcu = (F.G % 8 == 0) ? (bx % 8) * (F.G / 8) + bx / 8 : bx; }
    volatile LAS unsigned* misc = (volatile LAS unsigned*)(F.lds + LDS_MISC);
    if (F.tid < 16) misc[F.tid] = 0u;
    __syncthreads();
    const int lo = p.ph_lo, hi = p.ph_hi;
    XcdBarrier bar; bar.bar = (unsigned*)(p.ws + WS_BAR); bar.x = 0; bar.st = misc;
    if (hi - lo > 1) bar = xcd_barrier_post((unsigned*)(p.ws + WS_BAR), misc);
#define IN(k) (lo <= (k) && (k) < hi)
#define LAUNDER(Fl) Frame Fl = F0; asm volatile("" : "+v"(Fl.tid), "+v"(Fl.lane))
#ifndef PROF_SEL
#define PROF_SEL -1
#endif
#define PROF_K 8
    volatile LAS unsigned* prof = (volatile LAS unsigned*)(F.lds + LDS_BYTES - 512);
    if (PROF_SEL >= 0 && F.tid < 40) prof[F.tid] = 0u;
    if (PROF_SEL >= 0) __syncthreads();
    if (PROF_SEL >= 0 && F.tid == 0) prof[32] = (unsigned)__builtin_amdgcn_s_memrealtime();
#define PROF_MARK(b) do { if (PROF_SEL >= 0 && F.tid == 0) { const unsigned _t = (unsigned)__builtin_amdgcn_s_memrealtime(); prof[(b)] += _t - prof[32]; if ((b) >= 16) prof[30] += _t - prof[32]; prof[32] = _t; } } while (0)
#define SEAMT(k, b) do { PROF_MARK(b); if (IN(k) && IN((k) + 1)) xcd_barrier(bar); PROF_MARK(16 + (b)); } while (0)
#define SEAM(k) do { if (IN(k) && IN((k) + 1)) xcd_barrier(bar); } while (0)
    unsigned char* ws = p.ws;
    hf* X16 = (hf*)(ws + WS_X16);
    hf* XS1 = (hf*)p.out; hf* MM = (hf*)p.out; hf* Y = (hf*)(ws + A_B); hf* XS2 = (hf*)(ws + A_B);
    hf* QKV = (hf*)(ws + A_QKV); hf* QKVN = (hf*)(ws + A_QKVN);
    unsigned char* Gt = (unsigned char*)(ws + A_G); hf* HID = (hf*)(ws + A_HID);
    float* SS = (float*)(ws + WS_SS);

    if (PHM(11) && IN(0)) for (int rep = 0; rep < NREP(11); ++rep) { LAUNDER(Fl); prologue_a(Fl, p); }
    SEAMT(0, 9);
    if (PHM(11) && IN(1)) for (int rep = 0; rep < NREP(12); ++rep) { LAUNDER(Fl); prologue_b(Fl, p); }
    SEAMT(1, 9);

    for (int l = 0; l < DEPTH; ++l) {
        const int pb = PH_L0 + l * NPH_LAYER;
        const bool ctx_live = l < DEPTH - 1;
        const int Mrows = ctx_live ? MTOT : NLAT;
        const float* modl = (const float*)(ws + WS_MOD) + (size_t)l * NMODV * MODW;
        const float* biasl = (const float*)(ws + WS_BIAS) + (size_t)l * NMODV * NBIAS;
        const float* gsl = (const float*)(ws + WS_GS) + (size_t)l * 2 * NMODV * DM;
        const unsigned char* wl = ws + WS_WT + (size_t)(l & 1) * W_LAYER;
        float* ss1 = SS + (size_t)(SS_1 + l) * MTOT * 4; float* ss2 = SS + (size_t)(SS_2 + l) * MTOT * 4;
        float* ssq = (float*)(ws + WS_SSQ) + (size_t)l * MTOT; float* sskv = (float*)(ws + WS_SSKV) + (size_t)l * MTOT;
        LAS unsigned char* lx = F.lds + LDS_EXCH;

        if (PHM(1) && IN(pb + 0)) { pg8::Gemm g{XS1, (const hf*)(wl + W_IN1), MTOT, NP1, DM, DM, DM}; pg8::StaticOrder S; S.init(MTOT, NP1, F.G, (int)blockIdx.x);
            pg8::EpiIn E{QKVN, (hf*)(ws + A_KR), (hf*)(ws + A_PHY), (hf*)(ws + A_DQ), (hf*)(ws + A_DK), (hf*)(ws + A_DV), ss1, biasl + B_IN, ssq, sskv, lx};
            pg8::gemm_phase(F.lds, g, S, E); }
        SEAMT(pb + 0, 0);
        if (PHM(2) && IN(pb + 1)) {
            { LAUNDER(Fl); prep_rope(Fl, p); prep_hyena(Fl, p, l, ctx_live); }
            __syncthreads();
            PROF_MARK(1);
            { pg8::Gemm g{QKVN, (const hf*)(wl + W_UP), MTOT, NUP, KUP, KUP, KUP}; pg8::StaticOrder S; S.init(MTOT, NUP, F.G, (int)blockIdx.x);
              pg8::EpiUp E{QKV, ssq, sskv}; pg8::gemm_phase(F.lds, g, S, E); }
        }
        SEAMT(pb + 1, 2);
        if (PHM(4) && IN(pb + 2)) {
            {
            LAUNDER(Fl);
            PROF_MARK(14);
            const int n_mla = 2048 + (ctx_live ? 256 : 0);
            for (int id = F.vcu; id < n_mla; id += F.G) {
                if (id < 2048) { const int qb = id & 7, h = (id >> 3) & 7, b = id >> 6; att::attn_unit<true>(Fl, p, l, h, b * SEQ + qb * 256, qb * 256, b * SEQ, 32, NLAT + b * CTXL); }
                else { const int i2 = id - 2048, h = i2 & 7, b = i2 >> 3; att::attn_unit<true>(Fl, p, l, h, NLAT + b * CTXL, -1, 0, 0, NLAT + b * CTXL); }
            }
            PROF_MARK(11);
            const int n_df = 1024 + (ctx_live ? 128 : 0);
            for (int id = F.vcu; id < n_df; id += F.G) {
                if (id < 1024) { const int qb = id & 7, h = (id >> 3) & 3, b = id >> 5; att::attn_unit<false>(Fl, p, l, h, b * SEQ + qb * 256, qb * 256, b * SEQ, 32, NLAT + b * CTXL); }
                else { const int i2 = id - 1024, h = i2 & 3, b = i2 >> 2; att::attn_unit<false>(Fl, p, l, h, NLAT + b * CTXL, -1, 0, 0, NLAT + b * CTXL); }
            }
            PROF_MARK(12);
            const unsigned char* ob = (const unsigned char*)p.out;
            for (int c = F.vcu; c < 256; c += F.G)
                hyena_unit<SEQ>(Fl, (const hf*)(ws + WS_RF) + ((size_t)l * 256 + c) * 4096, (const hf*)(ob + O_UT) + (size_t)c * NLAT, (const hf*)(ob + O_X0T) + (size_t)c * NLAT, Y + 512 + c);
            if (ctx_live) for (int c = F.vcu; c < 256; c += F.G)
                hyena_unit<CTXL>(Fl, (const hf*)(ws + WS_RFC) + ((size_t)l * 256 + c) * 512, (const hf*)(ob + O_UTC) + (size_t)c * NCTX, (const hf*)(ob + O_X0TC) + (size_t)c * NCTX, Y + (size_t)NLAT * DM + 512 + c);
            __syncthreads();
            PROF_MARK(13);
            }
            { pg8::Gemm g{XS1, (const hf*)(wl + W_ING), Mrows, NGATE, DM, DM, DM}; pg8::StaticOrder S; S.init(Mrows, NGATE, F.G, (int)blockIdx.x);
              pg8::EpiGate8 E{Gt, ss1, biasl + B_G}; pg8::gemm_phase(F.lds, g, S, E); }
        }
        SEAMT(pb + 2, 4);
        if (PHM(6) && IN(pb + 3)) { pg8::Gemm g{Y, (const hf*)(wl + W_BR), Mrows, DM, DM, DM, DM}; pg8::StaticOrder S; S.init(Mrows, DM, F.G, (int)blockIdx.x);
            pg8::EpiMerge E{MM, Gt}; pg8::gemm_phase(F.lds, g, S, E); }
        SEAMT(pb + 3, 5);
        if (PHM(7) && IN(pb + 4)) { pg8::Gemm g{MM, (const hf*)(wl + W_OUT), Mrows, DM, DM, DM, DM}; pg8::StaticOrder S; S.init(Mrows, DM, F.G, (int)blockIdx.x);
            pg8::EpiResidX<true, true> E{X16, modl + 2 * DM, XS2, gsl + (size_t)NMODV * DM, ss2, lx}; pg8::gemm_phase(F.lds, g, S, E); }
        SEAMT(pb + 4, 6);
        if (PHM(9) && IN(pb + 5)) { pg8::Gemm g{XS2, (const hf*)(wl + W_FC1), Mrows, DFF, DM, DM, DM}; pg8::StaticOrder S; S.init(Mrows, DFF, F.G, (int)blockIdx.x);
            pg8::EpiHalf<2, true> E{HID, DFF, ss2, biasl + B_FC1}; pg8::gemm_phase(F.lds, g, S, E); }
        SEAMT(pb + 5, 7);
        if (PHM(10) && IN(pb + 6)) { pg8::Gemm g{HID, (const hf*)(wl + W_FC2), Mrows, DM, DFF, DFF, DFF}; pg8::StaticOrder S; S.init(Mrows, DM, F.G, (int)blockIdx.x);
            if (ctx_live) { pg8::EpiResidX<true, true> E{X16, modl + 5 * DM, XS1, gsl + (size_t)2 * NMODV * DM, ss1 + (size_t)MTOT * 4, lx}; pg8::gemm_phase(F.lds, g, S, E);
                const int nheavy = (MTOT / 256 * 4) % F.G;
                if (nheavy > 0 && (int)blockIdx.x >= nheavy) { __syncthreads(); LAUNDER(Fl); convert_layer(Fl, p, l + 1, ws + WS_WT + (size_t)((l + 1) & 1) * W_LAYER, (int)blockIdx.x - nheavy, F.G - nheavy); }
                else if (nheavy == 0) { __syncthreads(); LAUNDER(Fl); convert_layer(Fl, p, l + 1, ws + WS_WT + (size_t)((l + 1) & 1) * W_LAYER, Fl.vcu, F.G); } }
            else { pg8::EpiResidX<false, true> E{X16, modl + 5 * DM, nullptr, nullptr, SS + (size_t)SS_F * MTOT * 4, lx}; pg8::gemm_phase(F.lds, g, S, E); } }
        SEAMT(pb + 6, 8);
    }
    if (PHM(12) && IN(NPHASE - 1)) { LAUNDER(Fl); final_norm_phase(Fl, X16, p.out, p.in[I_FNG], SS + (size_t)SS_F * MTOT * 4); }
    PROF_MARK(10);
    if (PROF_SEL >= 0 && blockIdx.x == 0 && F.tid == 0) { const unsigned long long t0 = __builtin_amdgcn_s_memrealtime(); const unsigned long long d = (unsigned long long)PROF_K * prof[PROF_SEL];
        while (__builtin_amdgcn_s_memrealtime() - t0 < d) __builtin_amdgcn_s_sleep(8); }
#undef IN
#undef SEAM
}

extern "C" void kernel_launch(void* const* d_in, const int* in_sizes, int n_in, void* d_out, int out_size, void* d_ws, size_t ws_size, hipStream_t stream) {
    static int grid = 0;
    if (grid == 0) {
        if (n_in != 35 || in_sizes[0] != NLAT * DM || out_size != NLAT * DM || ws_size < WS_END) {
            fprintf(stderr, "kernel_launch: unexpected shapes: n_in %d in0 %d out %d ws %zu (need %zu); nothing launched\n", n_in, n_in > 0 ? in_sizes[0] : -1, out_size, ws_size, (size_t)WS_END); grid = -1; return; }
        int dev = 0, cus = 0, per_cu = 0;
        if (hipGetDevice(&dev) != hipSuccess || hipDeviceGetAttribute(&cus, hipDeviceAttributeMultiprocessorCount, dev) != hipSuccess) { fprintf(stderr, "kernel_launch: device query failed\n"); grid = -1; return; }
        if (hipFuncSetAttribute((const void*)fwd_kernel, hipFuncAttributeMaxDynamicSharedMemorySize, LDS_BYTES) != hipSuccess) { fprintf(stderr, "kernel_launch: hipFuncSetAttribute failed\n"); grid = -1; return; }
        if (hipOccupancyMaxActiveBlocksPerMultiprocessor(&per_cu, (const void*)fwd_kernel, 512, LDS_BYTES) != hipSuccess || per_cu < 1)
            fprintf(stderr, "kernel_launch: note: occupancy query reports %d workgroups per CU\n", per_cu);
        (void)hipGetLastError();
        grid = cus;
    }
    if (grid < 0) return;
    if (hipMemsetAsync((char*)d_ws + WS_BAR, 0, WS_ZERO_BYTES, stream) != hipSuccess) { fprintf(stderr, "kernel_launch: memset failed\n"); return; }
    Params P{};
    for (int i = 0; i < 35; ++i) P.in[i] = (const float*)d_in[i];
    P.out = (float*)d_out; P.ws = (unsigned char*)d_ws;
#if MK_FUSED
    P.ph_lo = 0; P.ph_hi = NPHASE;
    hipLaunchKernelGGL(fwd_kernel, dim3(grid), dim3(512), LDS_BYTES, stream, P);
#else
    for (int ph = 0; ph < NPHASE; ++ph) { P.ph_lo = ph; P.ph_hi = ph + 1; hipLaunchKernelGGL(fwd_kernel, dim3(grid), dim3(512), LDS_BYTES, stream, P); }
#endif
    const hipError_t le = hipPeekAtLastError();
    if (le != hipSuccess) fprintf(stderr, "kernel_launch: launch failed: %s\n", hipGetErrorName(le));
}
```

```cpp
#include <hip/hip_runtime.h>
#include <cstdio>
#include <cstdint>

#ifndef MK_FUSED
#define MK_FUSED 1
#endif

#define LAS __attribute__((address_space(3)))
#define GAS __attribute__((address_space(1)))
typedef _Float16 hf;
typedef _Float16 hf2 __attribute__((ext_vector_type(2)));
typedef _Float16 hf4 __attribute__((ext_vector_type(4)));
typedef _Float16 hf8 __attribute__((ext_vector_type(8)));
typedef short s16x4 __attribute__((ext_vector_type(4)));
typedef float f32x2 __attribute__((ext_vector_type(2)));
typedef float f32x4 __attribute__((ext_vector_type(4)));
typedef float f32x16 __attribute__((ext_vector_type(16)));
typedef unsigned u32x2 __attribute__((ext_vector_type(2)));
typedef unsigned u32x4 __attribute__((ext_vector_type(4)));

constexpr int DM = 1024, NB = 32, SEQ = 2048, DEPTH = 4, CTXL = 256, GRIDW = 64;
constexpr int NLAT = NB * SEQ;
constexpr int NCTX = NB * CTXL;
constexpr int MTOT = NLAT + NCTX;
constexpr int D_IN = 5024, NP1 = 2048  , NGATE = 3072, DFF = 4096;
constexpr int C_PQ = 0, C_PKV = 256, C_PKR = 384, C_HY = 416, C_DQ = 1184, C_DK = 1440, C_DV = 1696, C_PG = 1952;
constexpr int NUP = 1792, KUP = 384;
constexpr int NMODV = 33, MODW = 6 * DM;
constexpr float EPS = 1e-6f;
constexpr float MLA_SCALE = 0.10206207261596575f;
constexpr float DF_SCALE = 0.17677669529663687f;

constexpr size_t al256(size_t x) { return (x + 255) / 256 * 256; }
constexpr size_t WS_BAR = 0, WS_BAR_BYTES = 65536;
constexpr size_t WS_SS = WS_BAR + WS_BAR_BYTES;
constexpr int SS_1 = 0, SS_2 = DEPTH, SS_F = 2 * DEPTH, SSP_N = 2 * DEPTH + 1;
constexpr size_t WS_SSQ = WS_SS + (size_t)SSP_N * MTOT * 4 * 4;
constexpr size_t WS_SSKV = WS_SSQ + (size_t)DEPTH * MTOT * 4;
constexpr size_t WS_ZERO_BYTES = WS_BAR_BYTES;
constexpr size_t WS_MOD = al256(WS_SSKV + (size_t)DEPTH * MTOT * 4);
constexpr size_t WS_GS = WS_MOD + al256((size_t)DEPTH * NMODV * MODW * 4);
constexpr int NBIAS = 9216, B_IN = 0, B_G = 2048, B_FC1 = 5120;
constexpr size_t WS_BIAS = WS_GS + (size_t)DEPTH * 2 * NMODV * DM * 4;
constexpr size_t WS_ROPE = WS_BIAS + (size_t)DEPTH * NMODV * NBIAS * 4;
constexpr size_t WS_LAM = WS_ROPE + (size_t)SEQ * 32 * 4;
constexpr size_t WS_RF = WS_LAM + 256;
constexpr size_t WS_RFC = WS_RF + (size_t)DEPTH * 256 * 4096 * 2;
constexpr size_t WS_X16 = WS_RFC + (size_t)DEPTH * 256 * 512 * 2;
constexpr size_t WS_WT = WS_X16 + (size_t)MTOT * DM * 2;
constexpr size_t W_IN1 = 0, W_ING = W_IN1 + (size_t)NP1 * DM * 2, W_UP = W_ING + (size_t)NGATE * DM * 2, W_BR = W_UP + (size_t)NUP * KUP * 2,
                 W_OUT = W_BR + (size_t)DM * DM * 2, W_FC1 = W_OUT + (size_t)DM * DM * 2, W_FC2 = W_FC1 + (size_t)DFF * DM * 2, W_LAYER = W_FC2 + (size_t)DM * DFF * 2;
constexpr size_t WS_ARENA = WS_WT + 2 * W_LAYER;
constexpr size_t SZ_ROW1024 = (size_t)MTOT * 1024 * 2;
constexpr size_t A_B = WS_ARENA;
constexpr size_t A_C = A_B + SZ_ROW1024;
constexpr size_t A_Y = A_B, A_XS2 = A_B, A_BIG = A_C;
constexpr size_t A_QKVN = A_BIG;
constexpr size_t A_PHY = A_QKVN + (size_t)MTOT * KUP * 2;
constexpr size_t A_KR = A_BIG + (size_t)MTOT * NGATE;
constexpr size_t A_DQ = A_KR + (size_t)MTOT * 32 * 2;
constexpr size_t A_DK = A_DQ + (size_t)MTOT * 256 * 2;
constexpr size_t A_DV = A_DK + (size_t)MTOT * 256 * 2;
constexpr size_t A_QKV = A_DV + (size_t)MTOT * 256 * 2;
constexpr size_t A_BIG_END = A_QKV + (size_t)MTOT * NUP * 2;
static_assert(A_PHY + (size_t)MTOT * 768 * 2 <= A_KR, "QKVN + PHY must fit under the gate bytes");
constexpr size_t O_UT = SZ_ROW1024, O_X0T = O_UT + (size_t)256 * NLAT * 2, O_UTC = O_X0T + (size_t)256 * NLAT * 2, O_X0TC = O_UTC + (size_t)256 * NCTX * 2, O_END = O_X0TC + (size_t)256 * NCTX * 2;
static_assert(O_END <= (size_t)NLAT * DM * 4, "d_out scratch overflow");
constexpr size_t A_G = A_BIG;
constexpr size_t A_HID = A_C;
constexpr size_t WS_END = (A_BIG_END > A_HID + (size_t)MTOT * DFF * 2) ? A_BIG_END : A_HID + (size_t)MTOT * DFF * 2;
static_assert(WS_END <= (size_t)1024 * 1024 * 1024, "workspace map exceeds 1 GiB");

constexpr int LDS_BYTES = 147456;
constexpr int LDS_MISC = LDS_BYTES - 64;
constexpr int LDS_EXCH = 131072;

__device__ __forceinline__ unsigned pkh(float lo, float hi) { f32x2 v = {lo, hi}; hf2 h = __builtin_convertvector(v, hf2); return __builtin_bit_cast(unsigned, h); }
__device__ __forceinline__ unsigned rb8(unsigned h) { return (h + 0x00040004u) & 0xfff8fff8u; }
__device__ __forceinline__ unsigned pkhb(float lo, float hi) { return rb8(pkh(lo, hi)); }
__device__ __forceinline__ float wave_sum(float v) {
#pragma unroll
    for (int o = 1; o < 64; o <<= 1) v += __shfl_xor(v, o);
    return v;
}
__device__ __forceinline__ float rstd4(const float* ssp, int r) { const f32x4 q = *(const f32x4*)(ssp + 4 * (size_t)r); return rsqrtf(((q[0] + q[1]) + (q[2] + q[3])) * (1.f / DM) + EPS); }
__device__ __forceinline__ void rstd8(const float* ssp, int row0, float (&rs)[2][4]) {
    f32x4 q[2][4];
#pragma unroll
    for (int ai = 0; ai < 2; ++ai)
#pragma unroll
        for (int m = 0; m < 4; ++m) q[ai][m] = *(const f32x4*)(ssp + 4 * (size_t)(row0 + ai * 128 + m * 16));
#pragma unroll
    for (int ai = 0; ai < 2; ++ai)
#pragma unroll
        for (int m = 0; m < 4; ++m) rs[ai][m] = rsqrtf(((q[ai][m][0] + q[ai][m][1]) + (q[ai][m][2] + q[ai][m][3])) * (1.f / DM) + EPS);
}
#define LDS_WAIT() asm volatile("s_waitcnt lgkmcnt(0)" ::: "memory")
#define VM_WAIT() asm volatile("s_waitcnt vmcnt(0)" ::: "memory")

#define XB_TMO      128
#define XB_XCNT(j)  (256  + 64 * (j))
#define XB_XSUB(j)  (1280 + 64 * (j))
#define XB_XGEN(j)  (2304 + 64 * (j))
#define XB_TOP      3328
#define XB_TOPGEN   3392
#define XCD_BAR_WORDS 3456
#define XB_SPIN_CAP (1u << 22)
__device__ __forceinline__ unsigned xb_ld(unsigned* p)              { return __hip_atomic_load(p, __ATOMIC_RELAXED, __HIP_MEMORY_SCOPE_AGENT); }
__device__ __forceinline__ unsigned xb_add(unsigned* p, unsigned v) { return __hip_atomic_fetch_add(p, v, __ATOMIC_RELAXED, __HIP_MEMORY_SCOPE_AGENT); }
__device__ __forceinline__ unsigned xb_xcc_id() { return (unsigned)__builtin_amdgcn_s_getreg((3 << 11) | 20) & 0xFu; }
#define XB_SPIN(cond, bar) do { unsigned _sp = 0; while (cond) { __builtin_amdgcn_s_sleep(1); \
    if ((++_sp & 255u) == 0u) { if (xb_ld(&(bar)[XB_TMO])) break; if (_sp > XB_SPIN_CAP) { atomicAdd(&(bar)[XB_TMO], 1u); break; } } } } while (0)
struct XcdBarrier { unsigned* bar; unsigned x; volatile LAS unsigned* st; };
__device__ __forceinline__ XcdBarrier xcd_barrier_post(unsigned* bar, volatile LAS unsigned* st) {
    XcdBarrier b; b.bar = bar; b.x = xb_xcc_id(); b.st = st;
    if (threadIdx.x == 0) (void)xb_add(&bar[XB_XCNT(b.x)], 1u);
    return b;
}
__device__ __forceinline__ void xcd_barrier_complete(unsigned* bar, unsigned x, unsigned& nloc, unsigned& nx) {
    const unsigned G = gridDim.x * gridDim.y * gridDim.z;
    unsigned sum, cnt, mine, sp = 0u;
    for (;;) {
        sum = 0u; cnt = 0u; mine = 0u;
#pragma unroll
        for (unsigned j = 0; j < 16; ++j) { const unsigned c = xb_ld(&bar[XB_XCNT(j)]); sum += c; cnt += (c > 0u) ? 1u : 0u; mine = (j == x) ? c : mine; }
        if (sum == G) break;
        __builtin_amdgcn_s_sleep(1);
        if ((++sp & 255u) == 0u) { if (xb_ld(&bar[XB_TMO])) break; if (sp > XB_SPIN_CAP) { atomicAdd(&bar[XB_TMO], 1u); break; } }
    }
    nloc = mine > 0u ? mine : 1u; nx = cnt > 0u ? cnt : 1u;
}
__device__ __forceinline__ void xcd_barrier(const XcdBarrier& b) {
    asm volatile("s_waitcnt vmcnt(0)" ::: "memory");
    __syncthreads();
    if (threadIdx.x == 0) {
        unsigned* bar = b.bar;
        __builtin_amdgcn_s_waitcnt(0);
        unsigned nloc = b.st[0], nx = b.st[1];
        if (nloc == 0u) { xcd_barrier_complete(bar, b.x, nloc, nx); b.st[0] = nloc; b.st[1] = nx; }
        const unsigned old = xb_add(&bar[XB_XSUB(b.x)], 1u);
        const unsigned gen = old / nloc;
        if (old + 1u == (gen + 1u) * nloc) {
            __builtin_amdgcn_fence(__ATOMIC_RELEASE, "agent");
            asm volatile("s_waitcnt vmcnt(0)" ::: "memory");
            const unsigned og = xb_add(&bar[XB_TOP], 1u);
            const unsigned tg = og / nx;
            if (og + 1u == (tg + 1u) * nx) xb_add(&bar[XB_TOPGEN], 1u);
            else XB_SPIN(xb_ld(&bar[XB_TOPGEN]) == tg, bar);
            __builtin_amdgcn_fence(__ATOMIC_ACQUIRE, "agent");
            xb_add(&bar[XB_XGEN(b.x)], 1u);
            asm volatile("s_waitcnt vmcnt(0)" ::: "memory");
        } else {
            XB_SPIN(xb_ld(&bar[XB_XGEN(b.x)]) == gen, bar);
            __builtin_amdgcn_fence(__ATOMIC_ACQUIRE, "agent");
            asm volatile("s_waitcnt vmcnt(0)" ::: "memory");
        }
    }
    __syncthreads();
}

namespace pg8 {
constexpr int BM = 256, BK = 64, HALF = 128, HTB = HALF * BK * 2, STAGE_BYTES = 8 * HTB, NXCD = 8, WGM = 8;
__host__ __device__ __forceinline__ int lds_byte(int r, int c) { const int st = (r >> 4) * 2 + (c >> 5), rr = r & 15, cc = c & 31, ob = rr * 64 + cc * 2; return st * 1024 + (ob ^ (((ob >> 9) & 1) << 5)); }
__host__ __device__ __forceinline__ void stage_rc(int b, int& R, int& C) { const int st = b / 1024, sb = b % 1024, swz = sb ^ (((sb >> 9) & 1) << 5); R = (st >> 1) * 16 + swz / 64; C = (st & 1) * 32 + (swz % 64) / 2; }
__host__ __device__ __forceinline__ int perm32(int rho) { const int n = rho >> 4, i = rho & 15; return 8 * (i >> 2) + 4 * n + (i & 3); }
struct Unit { int pm, pn; };
struct Gemm { const hf* A; const hf* Bt; int M, N, K, lda, ldb; };
struct StaticOrder {
    int nM, nN, nwg, G, c;
    __host__ __device__ void init(int M, int N, int G_, int c_) { nM = M / BM; nN = N / BM; nwg = nM * nN; G = G_; c = c_; }
    __host__ __device__ bool next(int i, Unit& u) const {
        const long L = (long)i * G + c; if (L >= nwg) return false;
        int wgid = (int)L; { const int q = nwg / NXCD, r = nwg % NXCD, xcd = wgid % NXCD, off = wgid / NXCD; wgid = (xcd < r ? xcd * (q + 1) : r * (q + 1) + (xcd - r) * q) + off; }
        const int nig = WGM * nN, gid = wgid / nig, fm = gid * WGM, gsz = (nM - fm) < WGM ? (nM - fm) : WGM;
        u.pm = fm + ((wgid % nig) % gsz); u.pn = (wgid % nig) / gsz; return true;
    }
    __device__ __forceinline__ void a_ready(const Unit&) const {}
    __device__ __forceinline__ void done(const Unit&) const {}
};

template <int ACT  , bool NORM> struct EpiHalf {
    static constexpr bool PERM = true, AFTER_DRAIN = false, PROBE2 = false, MIDK = false;
    hf* O; int ldc; const float* ss; const float* bias;
    __device__ __forceinline__ void operator()(const f32x4 (&acc)[2][2][4][2], const Unit& u, int wr, int wc, int fr, int fq) const {
        const int row0 = u.pm * BM + wr * 64 + fr, col0 = u.pn * BM + wc * 32 + 8 * fq;
        f32x4 bv[2][2];
        if (NORM) { const int R0 = u.pm * BM; const int v = (R0 < NLAT) ? (R0 >> 11) : NB; const float* bp = bias + (size_t)v * NBIAS + col0;
#pragma unroll
            for (int bj = 0; bj < 2; ++bj)
#pragma unroll
                for (int n = 0; n < 2; ++n) bv[bj][n] = *(const f32x4*)(bp + bj * HALF + 4 * n); }
        float rsv[2][4]; if (NORM) rstd8(ss, row0, rsv);
#pragma unroll
        for (int ai = 0; ai < 2; ++ai)
#pragma unroll
            for (int m = 0; m < 4; ++m) { const int r = row0 + ai * HALF + m * 16; hf* rowp = O + (size_t)r * ldc + col0;
                float rs = 1.f; if (NORM) rs = rsv[ai][m];
#pragma unroll
                for (int bj = 0; bj < 2; ++bj) { f32x4 v0 = acc[ai][bj][m][0], v1 = acc[ai][bj][m][1];
                    if (NORM) { v0 = v0 * rs + bv[bj][0]; v1 = v1 * rs + bv[bj][1]; }
                    if (ACT == 1) {
#pragma unroll
                        for (int e = 0; e < 4; ++e) { v0[e] = __builtin_amdgcn_rcpf(1.f + __builtin_amdgcn_exp2f(-1.4426950408889634f * v0[e])); v1[e] = __builtin_amdgcn_rcpf(1.f + __builtin_amdgcn_exp2f(-1.4426950408889634f * v1[e])); } }
                    u32x4 w;
                    if (ACT == 2) {
                        const unsigned h[4] = {pkh(v0[0], v0[1]), pkh(v0[2], v0[3]), pkh(v1[0], v1[1]), pkh(v1[2], v1[3])}; unsigned o[4];
#pragma unroll
                        for (int e = 0; e < 4; ++e) { hf2 a = __builtin_bit_cast(hf2, h[e]); a = __builtin_elementwise_max(a, (hf2){(hf)0.f, (hf)0.f}); a = a * a; o[e] = rb8(__builtin_bit_cast(unsigned, a)); }
                        w.x = o[0]; w.y = o[1]; w.z = o[2]; w.w = o[3];
                    } else { w.x = pkhb(v0[0], v0[1]); w.y = pkhb(v0[2], v0[3]); w.z = pkhb(v1[0], v1[1]); w.w = pkhb(v1[2], v1[3]); }
                    *(u32x4*)(rowp + bj * HALF) = w; } }
    }
};
struct EpiGate8 {
    static constexpr bool PERM = true, AFTER_DRAIN = false, PROBE2 = false, MIDK = false;
    unsigned char* O; const float* ss; const float* bias;
    __device__ __forceinline__ void operator()(const f32x4 (&acc)[2][2][4][2], const Unit& u, int wr, int wc, int fr, int fq) const {
        const int R0 = u.pm * BM, row0 = R0 + wr * 64 + fr, col0 = u.pn * BM + wc * 32 + 8 * fq;
        const int v = (R0 < NLAT) ? (R0 >> 11) : NB; const float* bp = bias + (size_t)v * NBIAS + col0;
        f32x4 bv[2][2];
#pragma unroll
        for (int bj = 0; bj < 2; ++bj) { bv[bj][0] = *(const f32x4*)(bp + bj * HALF); bv[bj][1] = *(const f32x4*)(bp + bj * HALF + 4); }
        float rsv[2][4]; rstd8(ss, row0, rsv);
#pragma unroll
        for (int ai = 0; ai < 2; ++ai)
#pragma unroll
            for (int m = 0; m < 4; ++m) { const int r = row0 + ai * HALF + m * 16; const float rs = rsv[ai][m];
#pragma unroll
                for (int bj = 0; bj < 2; ++bj) { const f32x4 v0 = acc[ai][bj][m][0] * rs + bv[bj][0], v1 = acc[ai][bj][m][1] * rs + bv[bj][1];
                    unsigned q[8];
#pragma unroll
                    for (int e = 0; e < 4; ++e) { const float g0 = __builtin_amdgcn_rcpf(1.f + __builtin_amdgcn_exp2f(-1.4426950408889634f * v0[e])), g1 = __builtin_amdgcn_rcpf(1.f + __builtin_amdgcn_exp2f(-1.4426950408889634f * v1[e]));
                        q[e] = (unsigned)fmaxf(1.f, __builtin_rintf(255.f * g0)); q[4 + e] = (unsigned)fmaxf(1.f, __builtin_rintf(255.f * g1)); }
                    u32x2 w; w.x = q[0] | (q[1] << 8) | (q[2] << 16) | (q[3] << 24); w.y = q[4] | (q[5] << 8) | (q[6] << 16) | (q[7] << 24);
                    *(u32x2*)(O + (size_t)r * NGATE + col0 + bj * HALF) = w; } }
    }
};
struct EpiIn {
    static constexpr bool PERM = true, AFTER_DRAIN = false, PROBE2 = false, MIDK = false;
    hf* QKVNo; hf* KRo; hf* PHYo; hf* DQo; hf* DKo; hf* DVo; const float* ss; const float* bias; float* ssq; float* sskv; LAS unsigned char* lx;
    __device__ __forceinline__ void operator()(const f32x4 (&acc)[2][2][4][2], const Unit& u, int wr, int wc, int fr, int fq) const {
        const int R0 = u.pm * BM, row0 = R0 + wr * 64 + fr, col0 = u.pn * BM + wc * 32 + 8 * fq;
        const int v = (R0 < NLAT) ? (R0 >> 11) : NB; const float* bp = bias + (size_t)v * NBIAS + col0;
        f32x4 bv[2][2]; hf* dst[2]; int ld[2];
#pragma unroll
        for (int bj = 0; bj < 2; ++bj) { const int c8 = col0 + bj * HALF;
            bv[bj][0] = *(const f32x4*)(bp + bj * HALF); bv[bj][1] = *(const f32x4*)(bp + bj * HALF + 4);
            if (c8 < C_PKR) { dst[bj] = QKVNo + c8; ld[bj] = KUP; }
            else if (c8 < C_HY) { dst[bj] = KRo + (c8 - C_PKR); ld[bj] = 32; }
            else if (c8 < C_DQ) { dst[bj] = PHYo + (c8 - C_HY); ld[bj] = 768; }
            else if (c8 < C_DK) { dst[bj] = DQo + (c8 - C_DQ); ld[bj] = 256; }
            else if (c8 < C_DV) { dst[bj] = DKo + (c8 - C_DK); ld[bj] = 256; }
            else if (c8 < C_PG) { dst[bj] = DVo + (c8 - C_DV); ld[bj] = 256; }
            else { dst[bj] = nullptr; ld[bj] = 0; } }
        const int nstat = (u.pn == 0) ? 2 : (u.pn == 1 ? 1 : 0);
        float* sp = (u.pn == 0) ? ssq : sskv;
        float sqv[2][4];
        float rsv[2][4]; rstd8(ss, row0, rsv);
#pragma unroll
        for (int ai = 0; ai < 2; ++ai)
#pragma unroll
            for (int m = 0; m < 4; ++m) { const int r = row0 + ai * HALF + m * 16; const float rs = rsv[ai][m]; float sq = 0.f;
#pragma unroll
                for (int bj = 0; bj < 2; ++bj) { const f32x4 v0 = acc[ai][bj][m][0] * rs + bv[bj][0], v1 = acc[ai][bj][m][1] * rs + bv[bj][1];
                    if (bj < nstat) sq += (v0[0] * v0[0] + v0[1] * v0[1]) + (v0[2] * v0[2] + v0[3] * v0[3]) + (v1[0] * v1[0] + v1[1] * v1[1]) + (v1[2] * v1[2] + v1[3] * v1[3]);
                    if (dst[bj]) { u32x4 w; w.x = pkhb(v0[0], v0[1]); w.y = pkhb(v0[2], v0[3]); w.z = pkhb(v1[0], v1[1]); w.w = pkhb(v1[2], v1[3]); *(u32x4*)(dst[bj] + (size_t)r * ld[bj]) = w; } }
                sq += __shfl_xor(sq, 16); sq += __shfl_xor(sq, 32); sqv[ai][m] = sq; }
        if (nstat) {
            LAS float* ex = (LAS float*)lx;
            if (fq == 0) {
#pragma unroll
                for (int ai = 0; ai < 2; ++ai)
#pragma unroll
                    for (int m = 0; m < 4; ++m) ex[((wr * 4 + wc) * 8 + ai * 4 + m) * 16 + fr] = sqv[ai][m]; }
            asm volatile("s_waitcnt lgkmcnt(0)" ::: "memory"); __builtin_amdgcn_s_barrier(); asm volatile("" ::: "memory");
            if (wc == 0 && fq == 0) {
#pragma unroll
                for (int ai = 0; ai < 2; ++ai)
#pragma unroll
                    for (int m = 0; m < 4; ++m) { const int e = (ai * 4 + m) * 16 + fr; const int wb = wr * 4 * 128;
                        sp[row0 + ai * HALF + m * 16] = (ex[wb + e] + ex[wb + 128 + e]) + (ex[wb + 256 + e] + ex[wb + 384 + e]); } }
        }
    }
};
struct EpiUp {
    static constexpr bool PERM = true, AFTER_DRAIN = false, PROBE2 = false, MIDK = false;
    hf* O; const float* ssq; const float* sskv;
    __device__ __forceinline__ void operator()(const f32x4 (&acc)[2][2][4][2], const Unit& u, int wr, int wc, int fr, int fq) const {
        const int row0 = u.pm * BM + wr * 64 + fr, col0 = u.pn * BM + wc * 32 + 8 * fq;
        const bool isq = u.pn < 3; const float* sp = isq ? ssq : sskv; const float invn = isq ? (1.f / 256.f) : (1.f / 128.f);
        float rsv[2][4];
#pragma unroll
        for (int ai = 0; ai < 2; ++ai)
#pragma unroll
            for (int m = 0; m < 4; ++m) rsv[ai][m] = sp[row0 + ai * HALF + m * 16];
#pragma unroll
        for (int ai = 0; ai < 2; ++ai)
#pragma unroll
            for (int m = 0; m < 4; ++m) { const int r = row0 + ai * HALF + m * 16; hf* rowp = O + (size_t)r * NUP + col0; const float rs = rsqrtf(rsv[ai][m] * invn + EPS);
#pragma unroll
                for (int bj = 0; bj < 2; ++bj) { const f32x4 v0 = acc[ai][bj][m][0] * rs, v1 = acc[ai][bj][m][1] * rs;
                    u32x4 w; w.x = pkhb(v0[0], v0[1]); w.y = pkhb(v0[2], v0[3]); w.z = pkhb(v1[0], v1[1]); w.w = pkhb(v1[2], v1[3]);
                    *(u32x4*)(rowp + bj * HALF) = w; } }
    }
};
template <bool FIRST> struct EpiGated {
    static constexpr bool PERM = true, AFTER_DRAIN = false, PROBE2 = false, MIDK = false;
    hf* MMo; const hf* G; int goff;
    __device__ __forceinline__ void operator()(const f32x4 (&acc)[2][2][4][2], const Unit& u, int wr, int wc, int fr, int fq) const {
        const int row0 = u.pm * BM + wr * 64 + fr, col0 = u.pn * BM + wc * 32 + 8 * fq;
#pragma unroll
        for (int ai = 0; ai < 2; ++ai)
#pragma unroll
            for (int m = 0; m < 4; ++m) { const size_t r = (size_t)(row0 + ai * HALF + m * 16);
#pragma unroll
                for (int bj = 0; bj < 2; ++bj) { const f32x4 v0 = acc[ai][bj][m][0], v1 = acc[ai][bj][m][1];
                    const hf8 g = *(const hf8*)(G + r * NGATE + goff + col0 + bj * HALF);
                    hf* mp = MMo + r * DM + col0 + bj * HALF;
                    float o[8];
#pragma unroll
                    for (int e = 0; e < 4; ++e) { o[e] = (float)g[e] * v0[e]; o[4 + e] = (float)g[4 + e] * v1[e]; }
                    if (!FIRST) { const hf8 p = *(const hf8*)mp;
#pragma unroll
                        for (int e = 0; e < 8; ++e) o[e] += (float)p[e]; }
                    u32x4 w; w.x = pkh(o[0], o[1]); w.y = pkh(o[2], o[3]); w.z = pkh(o[4], o[5]); w.w = pkh(o[6], o[7]);
                    *(u32x4*)mp = w; } }
    }
};
struct EpiMerge {
    static constexpr bool PERM = true, AFTER_DRAIN = false, PROBE2 = false, MIDK = true;
    static constexpr int MID1 = 8, MID2 = 12;
    hf* MMo; const unsigned char* G;
    __device__ __forceinline__ void mid(f32x4 (&acc)[2][2][4][2], const Unit& u, int which, int wr, int wc, int fr, int fq) const {
        asm volatile("" : "+v"(fr), "+v"(fq));
        const int row0 = u.pm * BM + wr * 64 + fr, col0 = u.pn * BM + wc * 32 + 8 * fq; const int gnum = which ? 1024 : 0, gden = which ? 2048 : 1024;
#pragma unroll
        for (int ai = 0; ai < 2; ++ai) {
            u32x2 gn[4][2], gd[4][2];
#pragma unroll
            for (int m = 0; m < 4; ++m) { const unsigned char* gr = G + (size_t)(row0 + ai * HALF + m * 16) * NGATE + col0;
#pragma unroll
                for (int bj = 0; bj < 2; ++bj) { gn[m][bj] = *(const u32x2*)(gr + gnum + bj * HALF); gd[m][bj] = *(const u32x2*)(gr + gden + bj * HALF); } }
#pragma unroll
            for (int m = 0; m < 4; ++m)
#pragma unroll
                for (int bj = 0; bj < 2; ++bj)
#pragma unroll
                    for (int e = 0; e < 4; ++e) {
                        acc[ai][bj][m][0][e] *= (float)((gn[m][bj].x >> (8 * e)) & 255u) * __builtin_amdgcn_rcpf((float)((gd[m][bj].x >> (8 * e)) & 255u));
                        acc[ai][bj][m][1][e] *= (float)((gn[m][bj].y >> (8 * e)) & 255u) * __builtin_amdgcn_rcpf((float)((gd[m][bj].y >> (8 * e)) & 255u)); }
            asm volatile("" ::: "memory");
        }
    }
    __device__ __forceinline__ void operator()(const f32x4 (&acc)[2][2][4][2], const Unit& u, int wr, int wc, int fr, int fq) const {
        const int row0 = u.pm * BM + wr * 64 + fr, col0 = u.pn * BM + wc * 32 + 8 * fq;
#pragma unroll
        for (int ai = 0; ai < 2; ++ai) {
            u32x2 gq[4][2];
#pragma unroll
            for (int m = 0; m < 4; ++m)
#pragma unroll
                for (int bj = 0; bj < 2; ++bj) gq[m][bj] = *(const u32x2*)(G + (size_t)(row0 + ai * HALF + m * 16) * NGATE + 2048 + col0 + bj * HALF);
#pragma unroll
            for (int m = 0; m < 4; ++m) { const size_t r = (size_t)(row0 + ai * HALF + m * 16);
#pragma unroll
                for (int bj = 0; bj < 2; ++bj) { const f32x4 v0 = acc[ai][bj][m][0], v1 = acc[ai][bj][m][1];
                    const u32x2 g = gq[m][bj];
                    float o[8];
#pragma unroll
                    for (int e = 0; e < 4; ++e) { o[e] = (float)((g.x >> (8 * e)) & 255u) * (1.f / 255.f) * v0[e]; o[4 + e] = (float)((g.y >> (8 * e)) & 255u) * (1.f / 255.f) * v1[e]; }
                    u32x4 w; w.x = pkhb(o[0], o[1]); w.y = pkhb(o[2], o[3]); w.z = pkhb(o[4], o[5]); w.w = pkhb(o[6], o[7]);
                    *(u32x4*)(MMo + r * DM + col0 + bj * HALF) = w; } } }
    }
};
template <bool XS, bool STAT> struct EpiResidX {
    static constexpr bool PERM = true, AFTER_DRAIN = false, PROBE2 = false, MIDK = false;
    hf* x16; const float* gate;
    hf* xsout; const float* gs; float* ss; LAS unsigned char* lx;
    __device__ __forceinline__ void operator()(const f32x4 (&acc)[2][2][4][2], const Unit& u, int wr, int wc, int fr, int fq) const {
        const int R0 = u.pm * BM; const int v = (R0 < NLAT) ? (R0 >> 11) : NB;
        const int rglob = R0 + wr * 64 + fr, col0 = u.pn * BM + wc * 32 + 8 * fq;
        const float* gp = gate + (size_t)v * MODW + col0; const float* gsp = gs + (size_t)v * DM + col0;
        float sq[2][4];
#pragma unroll
        for (int ai = 0; ai < 2; ++ai)
#pragma unroll
            for (int m = 0; m < 4; ++m) sq[ai][m] = 0.f;
#pragma unroll
        for (int bj = 0; bj < 2; ++bj) {
            const f32x4 g0 = *(const f32x4*)(gp + bj * HALF), g1 = *(const f32x4*)(gp + bj * HALF + 4);
            f32x4 s0 = {1.f, 1.f, 1.f, 1.f}, s1 = s0; if (XS) { s0 = *(const f32x4*)(gsp + bj * HALF); s1 = *(const f32x4*)(gsp + bj * HALF + 4); }
#pragma unroll
            for (int ai = 0; ai < 2; ++ai)
#pragma unroll
                for (int m = 0; m < 4; ++m) { const int rr = ai * HALF + m * 16; const size_t off = (size_t)(rglob + rr) * DM + col0 + bj * HALF;
                    const hf8 xv = *(const hf8*)(x16 + off);
                    const f32x4 x0 = {(float)xv[0], (float)xv[1], (float)xv[2], (float)xv[3]}, x1 = {(float)xv[4], (float)xv[5], (float)xv[6], (float)xv[7]};
                    const f32x4 n0 = x0 + g0 * acc[ai][bj][m][0], n1 = x1 + g1 * acc[ai][bj][m][1];
                    { u32x4 w; w.x = pkh(n0[0], n0[1]); w.y = pkh(n0[2], n0[3]); w.z = pkh(n1[0], n1[1]); w.w = pkh(n1[2], n1[3]); *(u32x4*)(x16 + off) = w; }
                    if (STAT) sq[ai][m] += (n0[0] * n0[0] + n0[1] * n0[1]) + (n0[2] * n0[2] + n0[3] * n0[3]) + (n1[0] * n1[0] + n1[1] * n1[1]) + (n1[2] * n1[2] + n1[3] * n1[3]);
                    if (XS) { const f32x4 a = n0 * s0, b = n1 * s1; u32x4 w; w.x = pkhb(a[0], a[1]); w.y = pkhb(a[2], a[3]); w.z = pkhb(b[0], b[1]); w.w = pkhb(b[2], b[3]);
                        *(u32x4*)(xsout + off) = w; } }
        }
        if (STAT) {
            LAS float* ex = (LAS float*)lx;
#pragma unroll
            for (int ai = 0; ai < 2; ++ai)
#pragma unroll
                for (int m = 0; m < 4; ++m) { float t = sq[ai][m]; t += __shfl_xor(t, 16); t += __shfl_xor(t, 32);
                    if (fq == 0) ex[((wr * 4 + wc) * 8 + ai * 4 + m) * 16 + fr] = t; }
            asm volatile("s_waitcnt lgkmcnt(0)" ::: "memory"); __builtin_amdgcn_s_barrier(); asm volatile("" ::: "memory");
            if (wc == 0 && fq == 0) {
#pragma unroll
                for (int ai = 0; ai < 2; ++ai)
#pragma unroll
                    for (int m = 0; m < 4; ++m) { const int e = (ai * 4 + m) * 16 + fr; const int wb = wr * 4 * 128;
                        ss[(size_t)(rglob + ai * HALF + m * 16) * 4 + u.pn] = (ex[wb + e] + ex[wb + 128 + e]) + (ex[wb + 256 + e] + ex[wb + 384 + e]); } }
        }
    }
};

template <class Epi, class Sched, bool ALIGN_EPI = true>
__device__ __forceinline__ void gemm_phase(LAS unsigned char* lds, const Gemm g, const Sched& S, const Epi& E) {
    int tid = threadIdx.x; asm volatile("" : "+v"(tid));
    const int wid = __builtin_amdgcn_readfirstlane(tid >> 6), lane = tid & 63, wr = wid >> 2, wc = wid & 3, fr = lane & 15, fq = lane >> 4;
    const int K = g.K, nt = K / BK;
    unsigned voffA[2], voffB[2];
#pragma unroll
    for (int i = 0; i < 2; ++i) { int R, C; stage_rc(tid * 16 + i * 8192, R, C); const int Rb = Epi::PERM ? ((R & ~31) + perm32(R & 31)) : R;
        voffA[i] = (unsigned)(R * g.lda + C) * 2u; voffB[i] = (unsigned)(Rb * g.ldb + C) * 2u; }
    const size_t kstep = (size_t)(BK * 2);
    const size_t hstepA = (size_t)HALF * g.lda * 2, hstepB = (size_t)HALF * g.ldb * 2;
    const size_t tstepA = 2 * hstepA, tstepB = 2 * hstepB;
    const unsigned ldsw = (unsigned)wid * 1024u;
    const int aoff = lds_byte(wr * 64 + fr, fq * 8), boff = lds_byte(wc * 32 + fr, fq * 8);
#define PG8_SA(b, h) (((b) * 2 + (h)) * HTB)
#define PG8_SB(b, h) ((4 + (b) * 2 + (h)) * HTB)
#define PG8_STAGE(bufoff, gbase, voff) do { _Pragma("unroll") for (int _i = 0; _i < 2; ++_i) \
        __builtin_amdgcn_global_load_lds((const unsigned*)((const char*)(gbase) + (voff)[_i]), (LAS unsigned*)(lds + (bufoff) + ldsw + _i * 8192), 16, 0, 0); } while (0)
#define PG8_LDA(dst, b, h) do { _Pragma("unroll") for (int m = 0; m < 4; ++m) _Pragma("unroll") for (int k = 0; k < 2; ++k) dst[m][k] = *(const LAS hf8*)(lds + PG8_SA(b, h) + aoff + m * 2048 + k * 1024); } while (0)
#define PG8_LDB(dst, b, h) do { _Pragma("unroll") for (int n = 0; n < 2; ++n) _Pragma("unroll") for (int k = 0; k < 2; ++k) dst[n][k] = *(const LAS hf8*)(lds + PG8_SB(b, h) + boff + n * 2048 + k * 1024); } while (0)
#define PG8_MMA(ai, bj, At, Bt) do { __builtin_amdgcn_s_setprio(1); _Pragma("unroll") for (int m = 0; m < 4; ++m) _Pragma("unroll") for (int n = 0; n < 2; ++n) _Pragma("unroll") for (int k = 0; k < 2; ++k) \
        acc[ai][bj][m][n] = __builtin_amdgcn_mfma_f32_16x16x32_f16(Bt[n][k], At[m][k], acc[ai][bj][m][n], 0, 0, 0); __builtin_amdgcn_s_setprio(0); } while (0)
#define PG8_WAIT_V(n) asm volatile("s_waitcnt vmcnt(" #n ")" ::: "memory")
#define PG8_WAIT_L(n) asm volatile("s_waitcnt lgkmcnt(" #n ")" ::: "memory")
#define PG8_BAR __builtin_amdgcn_s_barrier()
#define PG8_SCHED __builtin_amdgcn_sched_barrier(0)
    Unit cur, nxt; int ui = 0;
    if (!S.next(0, cur)) return;
    f32x4 acc[2][2][4][2];
#pragma unroll
    for (int a = 0; a < 2; ++a)
#pragma unroll
        for (int b = 0; b < 2; ++b)
#pragma unroll
            for (int m = 0; m < 4; ++m)
#pragma unroll
                for (int n = 0; n < 2; ++n) acc[a][b][m][n] = (f32x4){0.f, 0.f, 0.f, 0.f};
    hf8 At[4][2], B0[2][2], B1[2][2];
    const char* cA = (const char*)g.A + (size_t)cur.pm * tstepA; const char* cB = (const char*)g.Bt + (size_t)cur.pn * tstepB;
    S.a_ready(cur);
    PG8_STAGE(PG8_SB(0, 0), cB, voffB); PG8_STAGE(PG8_SB(0, 1), cB + hstepB, voffB); PG8_STAGE(PG8_SA(0, 0), cA, voffA); PG8_STAGE(PG8_SA(0, 1), cA + hstepA, voffA);
    if (wr == 1) PG8_BAR;
    PG8_WAIT_V(2); PG8_BAR;
    PG8_STAGE(PG8_SB(1, 0), cB + kstep, voffB); PG8_STAGE(PG8_SA(1, 0), cA + kstep, voffA); PG8_STAGE(PG8_SB(1, 1), cB + hstepB + kstep, voffB);
    PG8_WAIT_V(6); PG8_BAR;
    for (;;) {
        const bool has_next = S.next(ui + 1, nxt);
        const char* nA = has_next ? (const char*)g.A + (size_t)nxt.pm * tstepA : cA; const char* nB = has_next ? (const char*)g.Bt + (size_t)nxt.pn * tstepB : cB;
#pragma unroll 1
        for (int t = 0; t < nt; t += 2) {
            const bool last = (t == nt - 2);
            const char* a1 = cA + (size_t)(t + 1) * kstep;
            const char* a2 = last ? nA : cA + (size_t)(t + 2) * kstep; const char* b2 = last ? nB : cB + (size_t)(t + 2) * kstep;
            const char* a3 = a2 + kstep; const char* b3 = b2 + kstep;
            if (last && has_next) S.a_ready(nxt);
            if constexpr (Epi::MIDK) { if (t == Epi::MID1 || t == Epi::MID2) E.mid(acc, cur, t == Epi::MID1 ? 0 : 1, wr, wc, fr, fq); }
            PG8_LDB(B0, 0, 0); PG8_LDB(B1, 0, 1); PG8_SCHED; PG8_LDA(At, 0, 0); PG8_STAGE(PG8_SA(1, 1), a1 + hstepA, voffA);
            PG8_WAIT_V(8); PG8_WAIT_L(0); PG8_BAR; PG8_MMA(0, 0, At, B0); PG8_MMA(0, 1, At, B1); PG8_BAR; PG8_SCHED;
            PG8_LDA(At, 0, 1); PG8_STAGE(PG8_SB(0, 0), b2, voffB); PG8_STAGE(PG8_SB(0, 1), b2 + hstepB, voffB); PG8_STAGE(PG8_SA(0, 0), a2, voffA);
            PG8_WAIT_V(8); PG8_WAIT_L(0); PG8_BAR; PG8_MMA(1, 0, At, B0); PG8_MMA(1, 1, At, B1); PG8_BAR; PG8_SCHED;
            PG8_LDB(B0, 1, 0); PG8_LDB(B1, 1, 1); PG8_SCHED; PG8_LDA(At, 1, 0); PG8_STAGE(PG8_SA(0, 1), a2 + hstepA, voffA);
            PG8_WAIT_V(8); PG8_WAIT_L(0); PG8_BAR; PG8_MMA(0, 0, At, B0); PG8_MMA(0, 1, At, B1); PG8_BAR; PG8_SCHED;
            PG8_LDA(At, 1, 1); PG8_STAGE(PG8_SB(1, 0), b3, voffB); PG8_STAGE(PG8_SB(1, 1), b3 + hstepB, voffB); PG8_STAGE(PG8_SA(1, 0), a3, voffA);
            PG8_WAIT_V(8); PG8_WAIT_L(0); PG8_BAR; PG8_MMA(1, 0, At, B0); PG8_MMA(1, 1, At, B1); PG8_BAR; PG8_SCHED;
        }
        if constexpr (ALIGN_EPI) { if (wr == 0) PG8_BAR; }
        E(acc, cur, wr, wc, fr, fq); S.done(cur);
#ifdef PROBE_EPI2
        if (Epi::PROBE2) { asm volatile("" ::: "memory"); E(acc, cur, wr, wc, fr, fq); }
#endif
        if (!has_next) break;
#pragma unroll
        for (int a = 0; a < 2; ++a)
#pragma unroll
            for (int b = 0; b < 2; ++b)
#pragma unroll
                for (int m = 0; m < 4; ++m)
#pragma unroll
                    for (int n = 0; n < 2; ++n) acc[a][b][m][n] = (f32x4){0.f, 0.f, 0.f, 0.f};
        cur = nxt; cA = nA; cB = nB; ++ui;
        if constexpr (ALIGN_EPI) { if (wr == 1) PG8_BAR; }
    }
    PG8_WAIT_V(0);
    if constexpr (!ALIGN_EPI) { if (wr == 0) PG8_BAR; }
    PG8_BAR;
#undef PG8_SA
#undef PG8_SB
#undef PG8_STAGE
#undef PG8_LDA
#undef PG8_LDB
#undef PG8_MMA
#undef PG8_WAIT_V
#undef PG8_WAIT_L
#undef PG8_BAR
#undef PG8_SCHED
}
}

struct Params {
    const float* in[35];
    float* out;
    unsigned char* ws;
    int ph_lo, ph_hi;
};
enum { I_X = 0, I_C, I_CTX, I_CCTX, I_NMG, I_NFG, I_WMOD, I_BMOD, I_WIN, I_QNG, I_WUQ, I_KVNG, I_WUKV, I_HCW, I_HCB, I_HW1, I_HB1, I_HFREQ, I_HW2, I_HB2, I_HW3, I_HB3,
       I_HSKIP, I_LQ1, I_LK1, I_LQ2, I_LK2, I_SUBG, I_WBRA, I_WBRB, I_WBRC, I_WOUT, I_FC1, I_FC2, I_FNG };

struct Frame {
    LAS unsigned char* lds;
    int tid, lane, wave, vcu, G;
};

__device__ __forceinline__ void tr_item(const float* W, int ldw, hf* WT, int ldt, int nblk, LAS float* scr, int item, int lane, const float* kgain = nullptr) {
    const int kb = item / nblk, nb = item % nblk, k0 = 64 * kb, n0 = 32 * nb;
#pragma unroll 8
    for (int i = 0; i < 32; ++i) { const int kk = 2 * i + (lane >> 5); const float gk = kgain ? kgain[k0 + kk] : 1.f; { float wv = W[(size_t)(k0 + kk) * ldw + n0 + (lane & 31)] * gk; unsigned ub = __float_as_uint(wv); ub += 0x7fffu + ((ub >> 16) & 1u); ub &= 0xffff0000u; scr[kk * 33 + (lane & 31)] = __uint_as_float(ub); } }
    LDS_WAIT(); asm volatile("" ::: "memory");
    const int c = lane & 7;
#pragma unroll
    for (int j = 0; j < 4; ++j) { const int n = (lane >> 3) + 8 * j; const LAS float* s = scr + (8 * c) * 33 + n;
        u32x4 o; o.x = pkh(s[0 * 33], s[1 * 33]); o.y = pkh(s[2 * 33], s[3 * 33]); o.z = pkh(s[4 * 33], s[5 * 33]); o.w = pkh(s[6 * 33], s[7 * 33]);
        *(u32x4*)(WT + (size_t)(n0 + n) * ldt + k0 + 8 * c) = o; }
    LDS_WAIT(); asm volatile("" ::: "memory");
}
__device__ __forceinline__ float silu_f(float x) { return x / (1.f + expf(-x)); }

__device__ __forceinline__ void mod_phase(const Frame& F, const Params& p) {
    float* MOD = (float*)(p.ws + WS_MOD);
    LAS float* sv = (LAS float*)F.lds;
    constexpr int NCB = DEPTH * MODW / 512;
    for (int item = F.vcu; item < NCB * 3; item += F.G) {
        const int cb = item / 3, vg = item % 3;
        __syncthreads();
        for (int i = F.tid; i < 11 * 1024; i += 512) { const int v = vg * 11 + i / 1024, k = i % 1024;
            const float c = (v < NB) ? p.in[I_C][v * DM + k] : p.in[I_CCTX][k]; sv[i] = silu_f(c); }
        __syncthreads();
        const int gcol = cb * 512 + F.tid, l = gcol / MODW, n = gcol % MODW;
        const float* w = p.in[I_WMOD] + (size_t)l * DM * MODW + n;
        float acc[11];
#pragma unroll
        for (int v = 0; v < 11; ++v) acc[v] = 0.f;
#pragma unroll 4
        for (int k = 0; k < DM; k += 4) {
            const float w0 = w[(size_t)k * MODW], w1 = w[(size_t)(k + 1) * MODW], w2 = w[(size_t)(k + 2) * MODW], w3 = w[(size_t)(k + 3) * MODW];
#pragma unroll
            for (int v = 0; v < 11; ++v) { const f32x4 s = *(const LAS f32x4*)(sv + v * 1024 + k);
                acc[v] = fmaf(s[0], w0, acc[v]); acc[v] = fmaf(s[1], w1, acc[v]); acc[v] = fmaf(s[2], w2, acc[v]); acc[v] = fmaf(s[3], w3, acc[v]); }
        }
        const float bm = p.in[I_BMOD][(size_t)l * MODW + n];
#pragma unroll
        for (int v = 0; v < 11; ++v) MOD[((size_t)l * NMODV + vg * 11 + v) * MODW + n] = acc[v] + bm;
    }
    __syncthreads();
}

__device__ __forceinline__ void filt_item(const Params& p, int l, int kind  , int t, int lane) {
    const int L = kind ? CTXL : SEQ;
    hf* R = kind ? (hf*)(p.ws + WS_RFC) + (size_t)l * 256 * 512 : (hf*)(p.ws + WS_RF) + (size_t)l * 256 * 4096;
    const int rl = 2 * L;
    const float tl = (float)t / (float)(L - 1);
    const float wt = (6.283185307179586f / (float)L) * (float)t;
    float z = 0.f;
    if (lane == 0) z = tl;
    else if (lane <= 32) { const int bi = (lane - 1) & 15; const float band = 1e-4f + (15.f - 1e-4f) * ((float)bi / 15.f); const float a = band * wt; z = (lane <= 16) ? cosf(a) : -sinf(a); }
    const float* w1 = p.in[I_HW1] + (size_t)l * 33 * 64; const float* w2 = p.in[I_HW2] + (size_t)l * 64 * 64; const float* w3 = p.in[I_HW3] + (size_t)l * 64 * 512;
    const float fr = p.in[I_HFREQ][l * 64 + lane];
    float a1 = p.in[I_HB1][l * 64 + lane];
    for (int i = 0; i < 33; ++i) a1 = fmaf(__shfl(z, i), w1[i * 64 + lane], a1);
    a1 = sinf(fr * a1);
    float a2 = p.in[I_HB2][l * 64 + lane];
    for (int i = 0; i < 64; ++i) a2 = fmaf(__shfl(a1, i), w2[i * 64 + lane], a2);
    a2 = sinf(fr * a2);
    float h[8];
#pragma unroll
    for (int q = 0; q < 8; ++q) h[q] = p.in[I_HB3][l * 512 + q * 64 + lane];
    for (int i = 0; i < 64; ++i) { const float a = __shfl(a2, i);
#pragma unroll
        for (int q = 0; q < 8; ++q) h[q] = fmaf(a, w3[i * 512 + q * 64 + lane], h[q]); }
    const float d0 = -4.605170185988091f / 1.5f, d1 = -4.605170185988091f / 0.3f;
#pragma unroll
    for (int q = 0; q < 8; ++q) { const int o = q * 64 + lane, dir = o >> 8, c = o & 255;
        const float delta = fabsf(d0 + (d1 - d0) * ((float)c / 255.f));
        float val = h[q] * (expf(-tl * delta) + 0.05f);
        if (dir == 0) { if (t == 0) val += p.in[I_HSKIP][l * 256 + c]; R[(size_t)c * rl + (L - t)] = (hf)val; if (t == 0) R[(size_t)c * rl] = (hf)0.f; }
        else if (t >= 1) R[(size_t)c * rl + (L + t)] = (hf)val; }
}

__device__ __forceinline__ void convert_layer(const Frame& F, const Params& p, int l, unsigned char* wl, int wg_rank, int wg_count) {
    LAS float* scr = (LAS float*)(F.lds + F.wave * 16384);
    const int gw = wg_rank * 8 + F.wave, NGW = wg_count * 8, lane = F.lane;
    constexpr int IT_IN1 = 16 * 61, IT_ING = 16 * 96, IT_UQ = 4 * 24, IT_UKV = 2 * 32, IT_BRA = 8 * 32, IT_BRB = 4 * 32, IT_BRC = 4 * 32, IT_OUT = 16 * 32, IT_FC1 = 16 * 128, IT_FC2 = 64 * 32;
    constexpr int IT_LAYER = IT_IN1 + IT_ING + IT_UQ + IT_UKV + IT_BRA + IT_BRB + IT_BRC + IT_OUT + IT_FC1 + IT_FC2;
    for (int it = gw; it < IT_LAYER; it += NGW) {
        int r = it;
        if (r < IT_IN1) { tr_item(p.in[I_WIN] + (size_t)l * DM * D_IN, D_IN, (hf*)(wl + W_IN1), DM, 61, scr, r, lane); continue; } r -= IT_IN1;
        if (r < IT_ING) { tr_item(p.in[I_WIN] + (size_t)l * DM * D_IN + C_PG, D_IN, (hf*)(wl + W_ING), DM, 96, scr, r, lane); continue; } r -= IT_ING;
        if (r < IT_UQ) { tr_item(p.in[I_WUQ] + (size_t)l * 256 * 768, 768, (hf*)(wl + W_UP), KUP, 24, scr, r, lane, p.in[I_QNG] + l * 256); continue; } r -= IT_UQ;
        if (r < IT_UKV) { tr_item(p.in[I_WUKV] + (size_t)l * 128 * 1024, 1024, (hf*)(wl + W_UP) + (size_t)768 * KUP + 256, KUP, 32, scr, r, lane, p.in[I_KVNG] + l * 128); continue; } r -= IT_UKV;
        if (r < IT_BRA) { tr_item(p.in[I_WBRA] + (size_t)l * 512 * DM, DM, (hf*)(wl + W_BR), DM, 32, scr, r, lane); continue; } r -= IT_BRA;
        if (r < IT_BRB) { tr_item(p.in[I_WBRB] + (size_t)l * 256 * DM, DM, (hf*)(wl + W_BR) + 512, DM, 32, scr, r, lane); continue; } r -= IT_BRB;
        if (r < IT_BRC) { tr_item(p.in[I_WBRC] + (size_t)l * 256 * DM, DM, (hf*)(wl + W_BR) + 768, DM, 32, scr, r, lane); continue; } r -= IT_BRC;
        if (r < IT_OUT) { tr_item(p.in[I_WOUT] + (size_t)l * DM * DM, DM, (hf*)(wl + W_OUT), DM, 32, scr, r, lane); continue; } r -= IT_OUT;
        if (r < IT_FC1) { tr_item(p.in[I_FC1] + (size_t)l * DM * DFF, DFF, (hf*)(wl + W_FC1), DM, 128, scr, r, lane); continue; } r -= IT_FC1;
        tr_item(p.in[I_FC2] + (size_t)l * DFF * DM, DM, (hf*)(wl + W_FC2), DFF, 32, scr, r, lane);
    }
    const int gt = gw * 64 + lane, NGT = NGW * 64;
    u32x4* z1 = (u32x4*)((hf*)(wl + W_IN1) + (size_t)C_PG * DM);
    for (int i = gt; i < 96 * DM / 8; i += NGT) z1[i] = (u32x4){0u, 0u, 0u, 0u};
    hf* up = (hf*)(wl + W_UP);
    for (int i = gt; i < 768 * 16; i += NGT) { const int n = i / 16, k8 = i % 16; *(u32x4*)(up + (size_t)n * KUP + 256 + k8 * 8) = (u32x4){0u, 0u, 0u, 0u}; }
    for (int i = gt; i < 1024 * 32; i += NGT) { const int n = 768 + i / 32, k8 = i % 32; *(u32x4*)(up + (size_t)n * KUP + k8 * 8) = (u32x4){0u, 0u, 0u, 0u}; }
}

__device__ __forceinline__ void prologue_a(const Frame& F, const Params& p) {
    mod_phase(F, p);
    convert_layer(F, p, 0, p.ws + WS_WT, F.vcu, F.G);
    const int gw = F.vcu * 8 + F.wave, NGW = F.G * 8, lane = F.lane;
    for (int it = gw; it < DEPTH * (SEQ + CTXL); it += NGW) { const int l = it / (SEQ + CTXL), r = it % (SEQ + CTXL); if (r < SEQ) filt_item(p, l, 0, r, lane); else filt_item(p, l, 1, r - SEQ, lane); }
    {
        float* rope = (float*)(p.ws + WS_ROPE);
        const int gt = gw * 64 + lane, NGT = NGW * 64;
        for (int i = gt; i < SEQ * 16; i += NGT) { const int t = i >> 4, j = i & 15; const float pos = (j < 8) ? (float)(t / GRIDW) : (float)(t % GRIDW);
            const float inv = powf(10000.f, -(float)(j & 7) / 8.f); const float a = pos * inv; rope[t * 32 + j] = cosf(a); rope[t * 32 + 16 + j] = sinf(a); }
        if (gt < DEPTH) { const int l = gt; float s1 = 0.f, s2 = 0.f;
            for (int i = 0; i < 32; ++i) { s1 += p.in[I_LQ1][l * 32 + i] * p.in[I_LK1][l * 32 + i]; s2 += p.in[I_LQ2][l * 32 + i] * p.in[I_LK2][l * 32 + i]; }
            const float li = 0.8f - 0.6f * expf(-0.3f * (float)l);
            float* lam = (float*)(p.ws + WS_LAM); lam[2 * l] = expf(s1) - expf(s2) + li; lam[2 * l + 1] = 1.f - li; }
    }
}
__device__ __forceinline__ void prologue_b(const Frame& F, const Params& p) {
    const float* MOD = (const float*)(p.ws + WS_MOD); float* BIAS = (float*)(p.ws + WS_BIAS);
    {
        LAS float* sv = (LAS float*)F.lds;
        constexpr int NCB = DEPTH * NBIAS / 512;
        for (int item = F.vcu; item < NCB * 3; item += F.G) {
            const int cb = item / 3, vg = item % 3;
            const int gcol = cb * 512 + F.tid, l = gcol / NBIAS, n = gcol % NBIAS, n0 = (cb * 512) % NBIAS;
            const int soff = (n0 >= B_FC1) ? 3 * DM : 0;
            __syncthreads();
            for (int i = F.tid; i < 11 * 1024; i += 512) { const int v = vg * 11 + i / 1024, k = i % 1024; sv[i] = MOD[((size_t)l * NMODV + v) * MODW + soff + k]; }
            __syncthreads();
            const float* w; size_t ldw; bool valid = true;
            if (n < B_G) { w = p.in[I_WIN] + (size_t)l * DM * D_IN + n; ldw = D_IN; valid = n < C_PG; }
            else if (n < B_FC1) { w = p.in[I_WIN] + (size_t)l * DM * D_IN + C_PG + (n - B_G); ldw = D_IN; }
            else { w = p.in[I_FC1] + (size_t)l * DM * DFF + (n - B_FC1); ldw = DFF; }
            float acc[11];
#pragma unroll
            for (int v = 0; v < 11; ++v) acc[v] = 0.f;
            if (valid)
#pragma unroll 4
            for (int k = 0; k < DM; k += 4) {
                const float w0 = w[(size_t)k * ldw], w1 = w[(size_t)(k + 1) * ldw], w2 = w[(size_t)(k + 2) * ldw], w3 = w[(size_t)(k + 3) * ldw];
#pragma unroll
                for (int v = 0; v < 11; ++v) { const f32x4 sx = *(const LAS f32x4*)(sv + v * 1024 + k);
                    acc[v] = fmaf(sx[0], w0, acc[v]); acc[v] = fmaf(sx[1], w1, acc[v]); acc[v] = fmaf(sx[2], w2, acc[v]); acc[v] = fmaf(sx[3], w3, acc[v]); }
            }
#pragma unroll
            for (int v = 0; v < 11; ++v) BIAS[((size_t)l * NMODV + vg * 11 + v) * NBIAS + n] = acc[v];
        }
        __syncthreads();
    }
    const int gw = F.vcu * 8 + F.wave, NGW = F.G * 8, lane = F.lane;
    {
        float* GS = (float*)(p.ws + WS_GS);
        const int gt = gw * 64 + lane, NGT = NGW * 64;
        for (int i = gt; i < DEPTH * 2 * NMODV * DM; i += NGT) { const int c = i % DM, v = (i / DM) % NMODV, wh = (i / (DM * NMODV)) % 2, l = i / (DM * NMODV * 2);
            const float g = wh ? p.in[I_NFG][l * DM + c] : p.in[I_NMG][l * DM + c];
            GS[i] = g * (1.f + MOD[((size_t)l * NMODV + v) * MODW + (wh ? 4 * DM : DM) + c]); }
    }
    {
        hf* XS = (hf*)p.out; hf* X16 = (hf*)(p.ws + WS_X16); float* ss = (float*)(p.ws + WS_SS) + (size_t)SS_1 * MTOT * 4;
        f32x4 g[4];
#pragma unroll
        for (int j = 0; j < 4; ++j) g[j] = *(const f32x4*)(p.in[I_NMG] + 4 * lane + 256 * j);
        for (int row = gw; row < MTOT; row += NGW) {
            const bool lat = row < NLAT; const float* xr = lat ? p.in[I_X] + (size_t)row * DM : p.in[I_CTX] + (size_t)(row - NLAT) * DM;
            const int v = lat ? (row >> 11) : NB; const float* mv = MOD + (size_t)v * MODW + DM;
            float sq = 0.f; hf* hr = XS + (size_t)row * DM; hf* xh = X16 + (size_t)row * DM;
#pragma unroll
            for (int j = 0; j < 4; ++j) { const f32x4 x = *(const f32x4*)(xr + 4 * lane + 256 * j); const f32x4 sc = *(const f32x4*)(mv + 4 * lane + 256 * j);
                sq += (x[0] * x[0] + x[1] * x[1]) + (x[2] * x[2] + x[3] * x[3]);
                const f32x4 o = x * (g[j] * (sc + 1.f)); u32x2 w; w.x = pkhb(o[0], o[1]); w.y = pkhb(o[2], o[3]); *(u32x2*)(hr + 4 * lane + 256 * j) = w;
                u32x2 w2; w2.x = pkh(x[0], x[1]); w2.y = pkh(x[2], x[3]); *(u32x2*)(xh + 4 * lane + 256 * j) = w2; }
            sq = wave_sum(sq);
            if (lane == 0) *(f32x4*)(ss + 4 * (size_t)row) = (f32x4){sq, 0.f, 0.f, 0.f};
        }
    }
}

__device__ __forceinline__ void norm_phase(const Frame& F, const float* xs_lat, const float* xs_ctx, int nrows, const float* gain, const float* modl, int sh_off, int sc_off, hf* H) {
    const int gw = F.vcu * 8 + F.wave, NGW = F.G * 8, lane = F.lane;
    f32x4 g[4];
#pragma unroll
    for (int j = 0; j < 4; ++j) g[j] = *(const f32x4*)(gain + 4 * lane + 256 * j);
    for (int row = gw; row < nrows; row += NGW) {
        const bool lat = row < NLAT; const float* xr = lat ? xs_lat + (size_t)row * DM : xs_ctx + (size_t)(row - NLAT) * DM;
        const int v = lat ? (row >> 11) : NB; const float* mv = modl + (size_t)v * MODW;
        f32x4 x[4]; float ss = 0.f;
#pragma unroll
        for (int j = 0; j < 4; ++j) { x[j] = *(const f32x4*)(xr + 4 * lane + 256 * j); ss += (x[j][0] * x[j][0] + x[j][1] * x[j][1]) + (x[j][2] * x[j][2] + x[j][3] * x[j][3]); }
        const float rstd = rsqrtf(wave_sum(ss) * (1.f / DM) + EPS);
        hf* hr = H + (size_t)row * DM;
#pragma unroll
        for (int j = 0; j < 4; ++j) { const f32x4 sh = *(const f32x4*)(mv + sh_off + 4 * lane + 256 * j), sc = *(const f32x4*)(mv + sc_off + 4 * lane + 256 * j);
            const f32x4 y = (x[j] * rstd) * g[j]; const f32x4 o = y * (sc + 1.f) + sh;
            u32x2 w; w.x = pkh(o[0], o[1]); w.y = pkh(o[2], o[3]); *(u32x2*)(hr + 4 * lane + 256 * j) = w; }
    }
}
__device__ __forceinline__ void final_norm_phase(const Frame& F, const hf* X16, float* out, const float* gain, const float* ss) {
    const int gw = F.vcu * 8 + F.wave, NGW = F.G * 8, lane = F.lane;
    f32x4 g[4];
#pragma unroll
    for (int j = 0; j < 4; ++j) g[j] = *(const f32x4*)(gain + 4 * lane + 256 * j);
    for (int row = gw; row < NLAT; row += NGW) {
        const hf* xr = X16 + (size_t)row * DM; float* orow = out + (size_t)row * DM; const float rstd = rstd4(ss, row);
#pragma unroll
        for (int j = 0; j < 4; ++j) { const hf4 xh = *(const hf4*)(xr + 4 * lane + 256 * j); const f32x4 x = {(float)xh[0], (float)xh[1], (float)xh[2], (float)xh[3]};
            *(f32x4*)(orow + 4 * lane + 256 * j) = (x * rstd) * g[j]; }
    }
}

__device__ __forceinline__ void prep_rope(const Frame& F, const Params& p) {
    const int gw = F.vcu * 8 + F.wave, NGW = F.G * 8, lane = F.lane;
    hf* KR = (hf*)(p.ws + A_KR); hf* DK = (hf*)(p.ws + A_DK); const float* rope = (const float*)(p.ws + WS_ROPE);
    const int hh = lane >> 3, i0 = 2 * (lane & 7);
    for (int row0 = gw * 4; row0 < NLAT; row0 += NGW * 4) {
        hf2 a[4], b[4]; f32x2 c[4], sn[4]; float y1[4], y2[4], cc[4], ss[4];
#pragma unroll
        for (int q = 0; q < 4; ++q) { const int row = row0 + q, t = row & (SEQ - 1); const hf* dk = DK + (size_t)row * 256 + hh * 32 + i0;
            a[q] = *(const hf2*)dk; b[q] = *(const hf2*)(dk + 16); c[q] = *(const f32x2*)(rope + t * 32 + i0); sn[q] = *(const f32x2*)(rope + t * 32 + 16 + i0);
            if (lane < 16) { const hf* kr = KR + (size_t)row * 32 + lane; y1[q] = (float)kr[0]; y2[q] = (float)kr[16]; cc[q] = rope[t * 32 + lane]; ss[q] = rope[t * 32 + 16 + lane]; } }
#pragma unroll
        for (int q = 0; q < 4; ++q) { const int row = row0 + q; hf* dk = DK + (size_t)row * 256 + hh * 32 + i0;
            const float x1[2] = {(float)a[q][0], (float)a[q][1]}, x2[2] = {(float)b[q][0], (float)b[q][1]};
            *(unsigned*)dk = pkh(x1[0] * c[q][0] - x2[0] * sn[q][0], x1[1] * c[q][1] - x2[1] * sn[q][1]);
            *(unsigned*)(dk + 16) = pkh(x2[0] * c[q][0] + x1[0] * sn[q][0], x2[1] * c[q][1] + x1[1] * sn[q][1]);
            if (lane < 16) { hf* kr = KR + (size_t)row * 32 + lane; kr[0] = (hf)(y1[q] * cc[q] - y2[q] * ss[q]); kr[16] = (hf)(y2[q] * cc[q] + y1[q] * ss[q]); } }
    }
}
__device__ __forceinline__ void prep_hyena(const Frame& F, const Params& p, int l, bool with_ctx) {
    constexpr int INP = 784;
    constexpr int OUTP = 33;
    constexpr int OFF_OU = 66 * INP, OFF_OX = OFF_OU + 128 * OUTP * 4;
    const hf* PHY = (const hf*)(p.ws + A_PHY);
    LAS unsigned char* lds = F.lds; const int tid = F.tid;
    const float* cw = p.in[I_HCW] + (size_t)l * 3 * 768; const float* cb = p.in[I_HCB] + (size_t)l * 768;
    constexpr int U_LAT = NB * (SEQ / 64) * 2, U_CTX = NB * (CTXL / 64) * 2;
    const int nunit = U_LAT + (with_ctx ? U_CTX : 0);
    for (int un = F.vcu; un < nunit; un += F.G) {
        const bool ctx = un >= U_LAT; int r = ctx ? un - U_LAT : un; const int L = ctx ? CTXL : SEQ, ntile = L / 64;
        const int ch = r & 1; r >>= 1; const int tt = r % ntile, b = r / ntile;
        const int t0 = tt * 64; const size_t rowbase = ctx ? (size_t)NLAT + (size_t)b * CTXL : (size_t)b * SEQ;
        hf* dU = (hf*)((unsigned char*)p.out + (ctx ? O_UTC : O_UT)); hf* dX = (hf*)((unsigned char*)p.out + (ctx ? O_X0TC : O_X0T));
        __syncthreads();
        {
            u32x4 tmp[7];
#pragma unroll
            for (int k = 0; k < 7; ++k) { const int i = tid + 512 * k, rr = i / 48, q = i % 48, seg = q >> 4, c16 = q & 15; const int t = t0 - 1 + rr;
                tmp[k] = (u32x4){0u, 0u, 0u, 0u};
                if (i < 66 * 48 && t >= 0 && t < L) tmp[k] = *(const u32x4*)(PHY + (rowbase + t) * 768 + seg * 256 + ch * 128 + c16 * 8); }
#pragma unroll
            for (int k = 0; k < 7; ++k) { const int i = tid + 512 * k, rr = i / 48, q = i % 48, seg = q >> 4, c16 = q & 15;
                if (i < 66 * 48) *(LAS u32x4*)(lds + rr * INP + seg * 256 + c16 * 16) = tmp[k]; }
        }
        __syncthreads();
        {
            const int c = tid & 127, tg = tid >> 7, cg = ch * 128 + c;
            const float a0 = cw[cg], a1 = cw[768 + cg], a2 = cw[1536 + cg], ab = cb[cg];
            const float b0 = cw[256 + cg], b1 = cw[768 + 256 + cg], b2 = cw[1536 + 256 + cg], bb = cb[256 + cg];
            const float v0 = cw[512 + cg], v1 = cw[768 + 512 + cg], v2 = cw[1536 + 512 + cg], vb = cb[512 + cg];
            const LAS hf* in = (const LAS hf*)(lds + (16 * tg) * INP) + c;
            float p0 = (float)in[0], p1 = (float)in[128], p2 = (float)in[256];
            float c0 = (float)in[INP / 2], c1 = (float)in[INP / 2 + 128], c2 = (float)in[INP / 2 + 256];
            LAS hf* ou = (LAS hf*)(lds + OFF_OU) + c * (OUTP * 2) + 16 * tg; LAS hf* ox = (LAS hf*)(lds + OFF_OX) + c * (OUTP * 2) + 16 * tg;
#pragma unroll
            for (int j = 0; j < 16; ++j) { const LAS hf* nx = in + (j + 2) * (INP / 2);
                const float n0 = (float)nx[0], n1 = (float)nx[128], n2 = (float)nx[256];
                const float x0 = a0 * p0 + a1 * c0 + a2 * n0 + ab, x1 = b0 * p1 + b1 * c1 + b2 * n1 + bb, vv = v0 * p2 + v1 * c2 + v2 * n2 + vb;
                ou[j] = (hf)(vv * x1); ox[j] = (hf)x0;
                p0 = c0; p1 = c1; p2 = c2; c0 = n0; c1 = n1; c2 = n2; }
        }
        __syncthreads();
        {
            const int c = tid >> 2, q = tid & 3; const size_t go = ((size_t)(ch * 128 + c) * NB + b) * L + t0 + 16 * q;
            const LAS unsigned* su = (const LAS unsigned*)(lds + OFF_OU) + c * OUTP + 8 * q; const LAS unsigned* sx = (const LAS unsigned*)(lds + OFF_OX) + c * OUTP + 8 * q;
            u32x4 w0 = {su[0], su[1], su[2], su[3]}, w1 = {su[4], su[5], su[6], su[7]};
            *(u32x4*)(dU + go) = w0; *(u32x4*)(dU + go + 8) = w1;
            u32x4 y0 = {sx[0], sx[1], sx[2], sx[3]}, y1 = {sx[4], sx[5], sx[6], sx[7]};
            *(u32x4*)(dX + go) = y0; *(u32x4*)(dX + go + 8) = y1;
        }
    }
    __syncthreads();
}

namespace att {
#ifndef PROF_SEL
#define PROF_SEL -1
#endif
#define ATT_MARK(b) do { if (PROF_SEL >= 0 && F.tid == 0) { volatile LAS unsigned* _pf = (volatile LAS unsigned*)(F.lds + LDS_BYTES - 512); const unsigned _t = (unsigned)__builtin_amdgcn_s_memrealtime(); _pf[(b)] += _t - _pf[32]; _pf[32] = _t; } } while (0)
__device__ __forceinline__ int crow(int r, int hi) { return (r & 3) + 8 * (r >> 2) + 4 * hi; }
#define SBAR() __builtin_amdgcn_sched_barrier(0)
constexpr float THR2 = 8.f * 1.4426950408889634f;
constexpr int KS_MLA = 208, KS_DF = 80;
constexpr int VS = 192, VB = 64 * VS;
constexpr int OFF_V = 32768;
template <int OFF> __device__ __forceinline__ s16x4 tr_read(int vb) {
    s16x4 r; asm volatile("ds_read_b64_tr_b16 %0, %1 offset:%2" : "=&v"(r) : "v"(vb), "i"(OFF) : "memory"); return r;
}
__device__ __forceinline__ int kpos(int key) { return (key & ~0xC) | ((key & 4) << 1) | ((key & 8) >> 1); }

template <int ND0, int KS>
__device__ __forceinline__ void qkt(f32x16& p0, f32x16& p1, const LAS unsigned char* Ks, const hf8* qr, int r32, int hi, const f32x16& negm) {
#pragma unroll
    for (int d0 = 0; d0 < ND0; ++d0) { const int cb = (d0 * 16 + hi * 8) * 2;
        const hf8 b0 = *(const LAS hf8*)(Ks + r32 * KS + cb), b1 = *(const LAS hf8*)(Ks + (32 + r32) * KS + cb);
        if (d0 == 0) { p0 = __builtin_amdgcn_mfma_f32_32x32x16_f16(b0, qr[0], negm, 0, 0, 0); p1 = __builtin_amdgcn_mfma_f32_32x32x16_f16(b1, qr[0], negm, 0, 0, 0); }
        else { p0 = __builtin_amdgcn_mfma_f32_32x32x16_f16(b0, qr[d0], p0, 0, 0, 0); p1 = __builtin_amdgcn_mfma_f32_32x32x16_f16(b1, qr[d0], p1, 0, 0, 0); } }
}
__device__ __forceinline__ float max3f(float a, float b, float c) { float r; asm("v_max3_f32 %0, %1, %2, %3" : "=v"(r) : "v"(a), "v"(b), "v"(c)); return r; }
__device__ __forceinline__ float max2f(float a, float b) { float r; asm("v_max_f32_e32 %0, %1, %2" : "=v"(r) : "v"(a), "v"(b)); return r; }
__device__ __forceinline__ float max16(const f32x16& p) { float r, t;
    asm("v_max3_f32 %0, %2, %3, %4\n\tv_max3_f32 %1, %10, %11, %12\n\tv_max3_f32 %0, %0, %5, %6\n\tv_max3_f32 %1, %1, %13, %14\n\tv_max3_f32 %0, %0, %7, %8\n\tv_max3_f32 %1, %1, %15, %16\n\tv_max3_f32 %0, %0, %9, %17\n\tv_max_f32_e32 %0, %0, %1"
        : "=&v"(r), "=&v"(t) : "v"(p[0]), "v"(p[1]), "v"(p[2]), "v"(p[3]), "v"(p[4]), "v"(p[5]), "v"(p[6]), "v"(p[7]), "v"(p[8]), "v"(p[9]), "v"(p[10]), "v"(p[11]), "v"(p[12]), "v"(p[13]), "v"(p[14]), "v"(p[15]));
    return r; }
__device__ __forceinline__ hf8 pack8(const f32x16& p, int b) { u32x4 w = {pkh(p[b], p[b + 1]), pkh(p[b + 2], p[b + 3]), pkh(p[b + 4], p[b + 5]), pkh(p[b + 6], p[b + 7])}; return __builtin_bit_cast(hf8, w); }
__device__ __forceinline__ void sm_max(f32x16& p0, f32x16& p1, float& m, float& l, f32x16& o0, f32x16& o1, f32x16& negm, const bool first) {
    float pmax = max2f(max16(p0), max16(p1));
    { auto rr = __builtin_amdgcn_permlane32_swap(__float_as_uint(pmax), __float_as_uint(pmax), false, false);
      pmax = max2f(__uint_as_float(rr[0]), __uint_as_float(rr[1])); }
    if (first || __any(pmax > THR2)) {
        const float delta = first ? pmax : fmaxf(pmax, 0.f);
        if (!first) { const float alpha = __builtin_amdgcn_exp2f(-delta); l *= alpha;
#pragma unroll
            for (int r = 0; r < 16; ++r) { o0[r] *= alpha; o1[r] *= alpha; } }
#pragma unroll
        for (int r = 0; r < 16; ++r) { p0[r] -= delta; p1[r] -= delta; }
        m += delta;
#pragma unroll
        for (int r = 0; r < 16; ++r) negm[r] = -m;
        asm volatile("" : "+v"(negm));
    }
}
__device__ __forceinline__ void sm_exp(f32x16& p0, f32x16& p1, const float m, float& l, hf8& pf0, hf8& pf1, hf8& pf2, hf8& pf3) {
#pragma unroll
    for (int r = 0; r < 16; ++r) { p0[r] = __builtin_amdgcn_exp2f(p0[r]); p1[r] = __builtin_amdgcn_exp2f(p1[r]); }
    float ps0 = p0[0] + p1[0], ps1 = p0[1] + p1[1], ps2 = p0[2] + p1[2], ps3 = p0[3] + p1[3];
#pragma unroll
    for (int r = 4; r < 16; r += 4) { ps0 += p0[r] + p1[r]; ps1 += p0[r + 1] + p1[r + 1]; ps2 += p0[r + 2] + p1[r + 2]; ps3 += p0[r + 3] + p1[r + 3]; }
    l += (ps0 + ps1) + (ps2 + ps3);
    pf0 = pack8(p0, 0); pf1 = pack8(p0, 8); pf2 = pack8(p1, 0); pf3 = pack8(p1, 8);
}
__device__ __forceinline__ void pv(const hf8 pf0, const hf8 pf1, const hf8 pf2, const hf8 pf3, f32x16& o0, f32x16& o1, const LAS unsigned char* Vt, int r32, int hi) {
    const int lg = (int)(threadIdx.x & 15), vq = lg >> 2, vp4 = lg & 3;
    const int vbase = (int)(unsigned)(uintptr_t)Vt + (4 * hi + vq) * VS + (16 * ((int)(threadIdx.x >> 4) & 1) + 4 * vp4) * 2;
#define PVRD(ks, L0, H0, L1, H1) s16x4 L0 = tr_read<(16 * (ks)) * VS>(vbase), H0 = tr_read<(16 * (ks) + 8) * VS>(vbase), L1 = tr_read<(16 * (ks)) * VS + 64>(vbase), H1 = tr_read<(16 * (ks) + 8) * VS + 64>(vbase)
#define PVMM(N, L0, H0, L1, H1, pf) do { asm volatile("s_waitcnt lgkmcnt(" #N ")" : "+v"(L0), "+v"(H0), "+v"(L1), "+v"(H1) :: "memory"); \
        const hf8 a0 = __builtin_bit_cast(hf8, (short __attribute__((ext_vector_type(8)))){L0[0], L0[1], L0[2], L0[3], H0[0], H0[1], H0[2], H0[3]}); \
        const hf8 a1 = __builtin_bit_cast(hf8, (short __attribute__((ext_vector_type(8)))){L1[0], L1[1], L1[2], L1[3], H1[0], H1[1], H1[2], H1[3]}); \
        o0 = __builtin_amdgcn_mfma_f32_32x32x16_f16(a0, pf, o0, 0, 0, 0); o1 = __builtin_amdgcn_mfma_f32_32x32x16_f16(a1, pf, o1, 0, 0, 0); } while (0)
    PVRD(0, a0l, a0h, a1l, a1h); PVRD(1, b0l, b0h, b1l, b1h);
    PVMM(4, a0l, a0h, a1l, a1h, pf0);
    PVRD(2, c0l, c0h, c1l, c1h);
    PVMM(4, b0l, b0h, b1l, b1h, pf1);
    PVRD(3, d0l, d0h, d1l, d1h);
    PVMM(4, c0l, c0h, c1l, c1h, pf2);
    PVMM(0, d0l, d0h, d1l, d1h, pf3);
#undef PVRD
#undef PVMM
#define PVK(ks, pf)
#undef PVK
}

template <bool MLA>
__device__ __forceinline__ void attn_pass(const Frame& F, const Params& p, int hq, int hv, int qrow0, int qpos0, int klat0, int nlat, int kctx0, f32x16& o0, f32x16& o1, float& inv) {
    constexpr int DK = MLA ? 96 : 32, ND0 = DK / 16, KS = MLA ? KS_MLA : KS_DF, KB = 64 * KS;
    constexpr float SCALE = MLA ? MLA_SCALE : DF_SCALE, C = SCALE * 1.4426950408889634f;
    const int tid = F.tid, wid = F.wave, lane = F.lane, r32 = lane & 31, hi = lane >> 5;
    const hf* QKV = (const hf*)(p.ws + A_QKV); const hf* KRb = (const hf*)(p.ws + A_KR);
    const hf* DQ = (const hf*)(p.ws + A_DQ); const hf* DKb = (const hf*)(p.ws + A_DK); const hf* DVb = (const hf*)(p.ws + A_DV);
    const float* rope = (const float*)(p.ws + WS_ROPE);
    LAS unsigned char* lds = F.lds;
    hf8 qr[ND0];
    {
        const int qrow = qrow0 + wid * 32 + r32;
        const hf* qp = MLA ? QKV + (size_t)qrow * NUP + hq * 96 + hi * 8 : DQ + (size_t)qrow * 256 + hq * 32 + hi * 8;
        hf8 raw[ND0];
#pragma unroll
        for (int d0 = 0; d0 < ND0; ++d0) raw[d0] = *(const hf8*)(qp + d0 * 16);
        f32x4 c0 = {1.f, 1.f, 1.f, 1.f}, c1 = c0, s0 = {0.f, 0.f, 0.f, 0.f}, s1 = s0;
        if (qpos0 >= 0) { const int t = qpos0 + wid * 32 + r32;
            c0 = *(const f32x4*)(rope + t * 32 + hi * 8); c1 = *(const f32x4*)(rope + t * 32 + hi * 8 + 4);
            s0 = *(const f32x4*)(rope + t * 32 + 16 + hi * 8); s1 = *(const f32x4*)(rope + t * 32 + 16 + hi * 8 + 4); }
#pragma unroll
        for (int d0 = 0; d0 < ND0 - 2; ++d0) {
#pragma unroll
            for (int j = 0; j < 8; ++j) qr[d0][j] = (hf)((float)raw[d0][j] * C); }
#pragma unroll
        for (int j = 0; j < 8; ++j) { const float cc = j < 4 ? c0[j & 3] : c1[j & 3], sn = j < 4 ? s0[j & 3] : s1[j & 3]; const float a = (float)raw[ND0 - 2][j], b = (float)raw[ND0 - 1][j];
            qr[ND0 - 2][j] = (hf)((a * cc - b * sn) * C); qr[ND0 - 1][j] = (hf)((b * cc + a * sn) * C); }
    }
    const int k1r = MLA ? (tid >> 3) : ((tid & 255) >> 2), k1c = MLA ? (tid & 7) * 8 : (tid & 3) * 8;
    const int k2r = (tid & 255) >> 2, k2c = (tid & 3) * 8;
    const int vr_ = tid >> 3, vc_ = (tid & 7) * 8;
    const bool klo = tid < 256;
    struct Stg { u32x4 v, k1, k2; };
    Stg sA, sB; sA.v = sA.k1 = sA.k2 = sB.v = sB.k1 = sB.k2 = (u32x4){0u, 0u, 0u, 0u};
    const int ntile = nlat + 4;
#define KROW0(j) (((j) < nlat) ? klat0 + (j) * 64 : kctx0 + ((j) - nlat) * 64)
#define A_LOADK(S, j) do { const int kr0 = KROW0(j); \
        if (MLA) { S.k1 = *(const u32x4*)(QKV + (size_t)(kr0 + k1r) * NUP + 768 + hq * 128 + k1c); S.k2 = *(const u32x4*)(KRb + (size_t)(kr0 + k2r) * 32 + k2c); } \
        else S.k1 = *(const u32x4*)(DKb + (size_t)(kr0 + k1r) * 256 + hq * 32 + k1c); } while (0)
#define A_LOADV(S, j) do { const int kr0 = KROW0(j); \
        if (MLA) S.v = *(const u32x4*)(QKV + (size_t)(kr0 + vr_) * NUP + 768 + hv * 128 + 64 + vc_); else S.v = *(const u32x4*)(DVb + (size_t)(kr0 + vr_) * 256 + hv * 64 + vc_); } while (0)
#define A_WRITEK(S, b) do { *(LAS u32x4*)(lds + (b) * KB + k1r * KS + k1c * 2) = S.k1; if (MLA) *(LAS u32x4*)(lds + (b) * KB + k2r * KS + 128 + k2c * 2) = S.k2; } while (0)
#define A_WRITEV(S, b) do { *(LAS u32x4*)(lds + OFF_V + (b) * VB + vr_ * VS + vc_ * 2) = S.v; } while (0)
    float m_reg = 0.f, l_reg = 0.f;
    f32x16 negm = f32x16{}; asm volatile("" : "+v"(negm));
    o0 = f32x16{}; o1 = f32x16{};
    f32x16 pA0, pA1, pB0, pB1;
    __syncthreads();
    const int nt1 = ntile - 1;
#define TCL(j) (((j) < nt1) ? (j) : nt1)
    A_LOADK(sA, 0); A_LOADV(sA, 0); A_LOADK(sB, 1);
    A_WRITEK(sA, 0); A_WRITEV(sA, 0); A_WRITEK(sB, 1);
    A_LOADK(sA, TCL(2));
    A_LOADV(sA, 1);
    __syncthreads();
    qkt<ND0, KS>(pA0, pA1, lds, qr, r32, hi, negm);
    hf8 f0, f1, f2, f3;
    if (wid >= 4) __syncthreads();
    for (int j = 0; j < ntile; j += 2) {
        A_LOADK(sB, TCL(j + 3)); A_LOADV(sB, TCL(j + 2));
        sm_max(pA0, pA1, m_reg, l_reg, o0, o1, negm, j == 0);
        sm_exp(pA0, pA1, m_reg, l_reg, f0, f1, f2, f3);
        __syncthreads();
        qkt<ND0, KS>(pB0, pB1, lds + KB, qr, r32, hi, negm);
        pv(f0, f1, f2, f3, o0, o1, lds + OFF_V, r32, hi);
        A_WRITEK(sA, 0); A_WRITEV(sA, 1);
        __syncthreads();
        A_LOADK(sA, TCL(j + 4)); A_LOADV(sA, TCL(j + 3));
        sm_max(pB0, pB1, m_reg, l_reg, o0, o1, negm, false);
        sm_exp(pB0, pB1, m_reg, l_reg, f0, f1, f2, f3);
        __syncthreads();
        qkt<ND0, KS>(pA0, pA1, lds, qr, r32, hi, negm);
        pv(f0, f1, f2, f3, o0, o1, lds + OFF_V + VB, r32, hi);
        A_WRITEK(sB, 1); A_WRITEV(sB, 0);
        __syncthreads();
    }
    if (wid < 4) __syncthreads();
#undef TCL
#undef KROW0
#undef A_LOADK
#undef A_LOADV
#undef A_WRITEK
#undef A_WRITEV
    const float lt = l_reg + __shfl_xor(l_reg, 32); inv = __builtin_amdgcn_rcpf(lt);
}
template <bool MLA>
__device__ __forceinline__ void attn_unit(const Frame& F, const Params& p, int l, int h, int qrow0, int qpos0, int klat0, int nlat, int kctx0) {
    const int wid = F.wave, lane = F.lane, r32 = lane & 31, hi = lane >> 5;
    hf* Y = (hf*)(p.ws + A_Y);
    const size_t yrow = (size_t)(qrow0 + wid * 32 + r32) * DM;
    if constexpr (MLA) {
        f32x16 o0, o1; float inv;
        attn_pass<true>(F, p, h, h, qrow0, qpos0, klat0, nlat, kctx0, o0, o1, inv);
#pragma unroll
        for (int g = 0; g < 4; ++g) { u32x2 w; w.x = pkhb(o0[4 * g] * inv, o0[4 * g + 1] * inv); w.y = pkhb(o0[4 * g + 2] * inv, o0[4 * g + 3] * inv); *(u32x2*)(Y + yrow + h * 64 + 8 * g + 4 * hi) = w; }
#pragma unroll
        for (int g = 0; g < 4; ++g) { u32x2 w; w.x = pkhb(o1[4 * g] * inv, o1[4 * g + 1] * inv); w.y = pkhb(o1[4 * g + 2] * inv, o1[4 * g + 3] * inv); *(u32x2*)(Y + yrow + h * 64 + 32 + 8 * g + 4 * hi) = w; }
    } else {
        const float lam = ((const float*)(p.ws + WS_LAM))[2 * l], oml = ((const float*)(p.ws + WS_LAM))[2 * l + 1];
        f32x16 a0, a1;
        LAS float* park = (LAS float*)(F.lds + 65536 + wid * 8192) + lane;
        { f32x16 o0, o1; float inv; attn_pass<false>(F, p, 2 * h, h, qrow0, qpos0, klat0, nlat, kctx0, o0, o1, inv);
#pragma unroll
          for (int r = 0; r < 16; ++r) { park[r * 64] = o0[r] * inv; park[(16 + r) * 64] = o1[r] * inv; } }
        { f32x16 o0, o1; float inv; attn_pass<false>(F, p, 2 * h + 1, h, qrow0, qpos0, klat0, nlat, kctx0, o0, o1, inv);
#pragma unroll
          for (int r = 0; r < 16; ++r) { a0[r] = park[r * 64] - o0[r] * (lam * inv); a1[r] = park[(16 + r) * 64] - o1[r] * (lam * inv); } }
        float ss = 0.f;
#pragma unroll
        for (int r = 0; r < 16; ++r) ss += a0[r] * a0[r] + a1[r] * a1[r];
        ss += __shfl_xor(ss, 32);
        const float rs = rsqrtf(ss * (1.f / 64.f) + EPS) * oml;
#pragma unroll
        for (int g = 0; g < 4; ++g) { const f32x4 gg = *(const f32x4*)(p.in[I_SUBG] + l * 64 + 8 * g + 4 * hi);
            u32x2 w; w.x = pkhb(a0[4 * g] * rs * gg[0], a0[4 * g + 1] * rs * gg[1]); w.y = pkhb(a0[4 * g + 2] * rs * gg[2], a0[4 * g + 3] * rs * gg[3]); *(u32x2*)(Y + yrow + 768 + h * 64 + 8 * g + 4 * hi) = w; }
#pragma unroll
        for (int g = 0; g < 4; ++g) { const f32x4 gg = *(const f32x4*)(p.in[I_SUBG] + l * 64 + 32 + 8 * g + 4 * hi);
            u32x2 w; w.x = pkhb(a1[4 * g] * rs * gg[0], a1[4 * g + 1] * rs * gg[1]); w.y = pkhb(a1[4 * g + 2] * rs * gg[2], a1[4 * g + 3] * rs * gg[3]); *(u32x2*)(Y + yrow + 768 + h * 64 + 32 + 8 * g + 4 * hi) = w; }
    }
}
}

#define HY_MARK(b) do { if (PROF_SEL >= 0 && F.tid == 0) { volatile LAS unsigned* _pf = (volatile LAS unsigned*)(F.lds + LDS_BYTES - 512); const unsigned _t = (unsigned)__builtin_amdgcn_s_memrealtime(); _pf[(b)] += _t - _pf[32]; _pf[32] = _t; } } while (0)
template <int L>
__device__ __forceinline__ void hyena_unit(const Frame& F, const hf* Rrow  , const hf* U  , const hf* X0  , hf* Ycol  ) {
    constexpr int NM = L / 256, RL = 2 * L, SH = (L > 1024) ? 1024 : L, NH = L / SH, US = SH * 2 + 16;
    constexpr int OFF_U = 8 * RL * 2;
    constexpr int XP = L * 2 + 16;
    static_assert(OFF_U + 32 * US <= LDS_MISC && 32 * XP <= LDS_MISC, "hyena LDS");
    const int tid = F.tid, w = F.wave, lane = F.lane, i32 = lane & 31, hi = lane >> 5;
    LAS unsigned char* lds = F.lds;
    __syncthreads();
    for (int i = tid; i < RL / 8; i += 512) *(LAS u32x4*)(lds + i * 16) = *(const u32x4*)(Rrow + i * 8);
    __syncthreads();
    {
        const LAS unsigned* src = (const LAS unsigned*)lds;
#pragma unroll 1
        for (int idx = tid; idx < 7 * (RL / 8); idx += 512) { const int cw = 1 + idx / (RL / 8), c4 = (idx % (RL / 8)) * 4;
            const int k0 = c4 - ((cw + 1) >> 1); unsigned d[5];
#pragma unroll
            for (int e = 0; e < 5; ++e) { const int k = k0 + e; d[e] = (k >= 0 && k < RL / 2) ? src[k] : 0u; }
            u32x4 o;
            if (cw & 1) { o.x = (d[0] >> 16) | (d[1] << 16); o.y = (d[1] >> 16) | (d[2] << 16); o.z = (d[2] >> 16) | (d[3] << 16); o.w = (d[3] >> 16) | (d[4] << 16); }
            else { o.x = d[0]; o.y = d[1]; o.z = d[2]; o.w = d[3]; }
            *(LAS u32x4*)(lds + cw * (RL * 2) + c4 * 4) = o; }
    }
    HY_MARK(22);
    f32x16 acc[NM];
#pragma unroll
    for (int m = 0; m < NM; ++m) acc[m] = f32x16{};
    const LAS unsigned char* cpy = lds + w * (RL * 2);
    for (int half = 0; half < NH; ++half) {
        __syncthreads();
        {
            constexpr int NPC = 32 * (SH / 8) / 512, NB4 = NPC > 4 ? 4 : NPC;
            int tq = tid; asm volatile("" : "+v"(tq));
#pragma unroll
            for (int k0 = 0; k0 < NPC; k0 += NB4) { u32x4 tmp[NB4];
#pragma unroll
                for (int k = 0; k < NB4; ++k) { const int idx = tq + 512 * (k0 + k), b = idx / (SH / 8), pc = idx % (SH / 8); tmp[k] = *(const u32x4*)(U + (size_t)b * L + half * SH + pc * 8); }
#pragma unroll
                for (int k = 0; k < NB4; ++k) { const int idx = tq + 512 * (k0 + k), b = idx / (SH / 8), pc = idx % (SH / 8); *(LAS u32x4*)(lds + OFF_U + b * US + pc * 16) = tmp[k]; }
                asm volatile("" ::: "memory"); }
        }
        __syncthreads();
#pragma unroll 2
        for (int jl = 0; jl < SH / 16; ++jl) {
            const int j = half * (SH / 16) + jl;
            const hf8 bf = *(const LAS hf8*)(lds + OFF_U + i32 * US + (jl * 16 + hi * 8) * 2);
            const int x0 = L + 16 * j + 8 * hi - 8 * i32;
#pragma unroll
            for (int m = 0; m < NM; ++m) { const hf8 af = *(const LAS hf8*)(cpy + (x0 - 256 * m) * 2);
                acc[m] = __builtin_amdgcn_mfma_f32_32x32x16_f16(af, bf, acc[m], 0, 0, 0); }
        }
    }
    __syncthreads();
    HY_MARK(23);
    {
        constexpr int NPC = 32 * (L / 8) / 512, NB8 = NPC > 4 ? 4 : NPC;
        int tq = tid; asm volatile("" : "+v"(tq));
#pragma unroll
        for (int k0 = 0; k0 < NPC; k0 += NB8) { u32x4 tmp[NB8];
#pragma unroll
            for (int k = 0; k < NB8; ++k) { const int idx = tq + 512 * (k0 + k), b = idx / (L / 8), pc = idx % (L / 8); tmp[k] = *(const u32x4*)(X0 + (size_t)b * L + pc * 8); }
#pragma unroll
            for (int k = 0; k < NB8; ++k) { const int idx = tq + 512 * (k0 + k), b = idx / (L / 8), pc = idx % (L / 8); *(LAS u32x4*)(lds + b * XP + pc * 16) = tmp[k]; }
            asm volatile("" ::: "memory"); }
    }
    __syncthreads();
    HY_MARK(24);
    const LAS hf* x0p = (const LAS hf*)(lds + i32 * XP) + w + 32 * hi;
    hf* yp = Ycol + ((size_t)i32 * L + w + 32 * hi) * DM;
#pragma unroll
    for (int m = 0; m < NM; ++m) {
#pragma unroll
        for (int r = 0; r < 16; ++r) { const int tt = 256 * m + 8 * ((r & 3) + 8 * (r >> 2));
            const float x0v = (float)x0p[tt];
            { const float yv = x0v * acc[m][r]; unsigned ub = __float_as_uint(yv); ub += 0x7fffu + ((ub >> 16) & 1u); yp[(size_t)tt * DM] = (hf)__uint_as_float(ub & 0xffff0000u); } }
        asm volatile("" ::: "memory");
    }
    HY_MARK(25);
}

#ifndef PH_MASK
#define PH_MASK 0x1FFFF
#endif
#define PHM(k) ((PH_MASK >> (k)) & 1)
#ifndef PROBE_REP
#define PROBE_REP 0
#endif
#define NREP(k) (((PROBE_REP >> (k)) & 1) ? 2 : 1)
constexpr int NPH_LAYER = 7, PH_L0 = 2, NPHASE = PH_L0 + DEPTH * NPH_LAYER + 1;
__global__ void __launch_bounds__(512, 2) fwd_kernel(Params p) {
    extern __shared__ __attribute__((aligned(16))) unsigned char lds_raw[];
    Frame F0; Frame& F = F0;
    F.lds = (LAS unsigned char*)lds_raw;
    F.tid = threadIdx.x; F.lane = F.tid & 63; F.wave = __builtin_amdgcn_readfirstlane(F.tid >> 6);
    F.G = gridDim.x; { const int bx = blockIdx.x; F.vcu = (F.G % 8 == 0) ? (bx % 8) * (F.G / 8) + bx / 8 : bx; }
    volatile LAS unsigned* misc = (volatile LAS unsigned*)(F.lds + LDS_MISC);
    if (F.tid < 16) misc[F.tid] = 0u;
    __syncthreads();
    const int lo = p.ph_lo, hi = p.ph_hi;
    XcdBarrier bar; bar.bar = (unsigned*)(p.ws + WS_BAR); bar.x = 0; bar.st = misc;
    if (hi - lo > 1) bar = xcd_barrier_post((unsigned*)(p.ws + WS_BAR), misc);
#define IN(k) (lo <= (k) && (k) < hi)
#define LAUNDER(Fl) Frame Fl = F0; asm volatile("" : "+v"(Fl.tid), "+v"(Fl.lane))
#ifndef PROF_SEL
#define PROF_SEL -1
#endif
#define PROF_K 8
    volatile LAS unsigned* prof = (volatile LAS unsigned*)(F.lds + LDS_BYTES - 512);
    if (PROF_SEL >= 0 && F.tid < 40) prof[F.tid] = 0u;
    if (PROF_SEL >= 0) __syncthreads();
    if (PROF_SEL >= 0 && F.tid == 0) prof[32] = (unsigned)__builtin_amdgcn_s_memrealtime();
#define PROF_MARK(b) do { if (PROF_SEL >= 0 && F.tid == 0) { const unsigned _t = (unsigned)__builtin_amdgcn_s_memrealtime(); prof[(b)] += _t - prof[32]; if ((b) >= 16) prof[30] += _t - prof[32]; prof[32] = _t; } } while (0)
#define SEAMT(k, b) do { PROF_MARK(b); if (IN(k) && IN((k) + 1)) xcd_barrier(bar); PROF_MARK(16 + (b)); } while (0)
#define SEAM(k) do { if (IN(k) && IN((k) + 1)) xcd_barrier(bar); } while (0)
    unsigned char* ws = p.ws;
    hf* X16 = (hf*)(ws + WS_X16);
    hf* XS1 = (hf*)p.out; hf* MM = (hf*)p.out; hf* Y = (hf*)(ws + A_B); hf* XS2 = (hf*)(ws + A_B);
    hf* QKV = (hf*)(ws + A_QKV); hf* QKVN = (hf*)(ws + A_QKVN);
    unsigned char* Gt = (unsigned char*)(ws + A_G); hf* HID = (hf*)(ws + A_HID);
    float* SS = (float*)(ws + WS_SS);

    if (PHM(11) && IN(0)) for (int rep = 0; rep < NREP(11); ++rep) { LAUNDER(Fl); prologue_a(Fl, p); }
    SEAMT(0, 9);
    if (PHM(11) && IN(1)) for (int rep = 0; rep < NREP(12); ++rep) { LAUNDER(Fl); prologue_b(Fl, p); }
    SEAMT(1, 9);

    for (int l = 0; l < DEPTH; ++l) {
        const int pb = PH_L0 + l * NPH_LAYER;
        const bool ctx_live = l < DEPTH - 1;
        const int Mrows = ctx_live ? MTOT : NLAT;
        const float* modl = (const float*)(ws + WS_MOD) + (size_t)l * NMODV * MODW;
        const float* biasl = (const float*)(ws + WS_BIAS) + (size_t)l * NMODV * NBIAS;
        const float* gsl = (const float*)(ws + WS_GS) + (size_t)l * 2 * NMODV * DM;
        const unsigned char* wl = ws + WS_WT + (size_t)(l & 1) * W_LAYER;
        float* ss1 = SS + (size_t)(SS_1 + l) * MTOT * 4; float* ss2 = SS + (size_t)(SS_2 + l) * MTOT * 4;
        float* ssq = (float*)(ws + WS_SSQ) + (size_t)l * MTOT; float* sskv = (float*)(ws + WS_SSKV) + (size_t)l * MTOT;
        LAS unsigned char* lx = F.lds + LDS_EXCH;

        if (PHM(1) && IN(pb + 0)) { pg8::Gemm g{XS1, (const hf*)(wl + W_IN1), MTOT, NP1, DM, DM, DM}; pg8::StaticOrder S; S.init(MTOT, NP1, F.G, (int)blockIdx.x);
            pg8::EpiIn E{QKVN, (hf*)(ws + A_KR), (hf*)(ws + A_PHY), (hf*)(ws + A_DQ), (hf*)(ws + A_DK), (hf*)(ws + A_DV), ss1, biasl + B_IN, ssq, sskv, lx};
            pg8::gemm_phase(F.lds, g, S, E); }
        SEAMT(pb + 0, 0);
        if (PHM(2) && IN(pb + 1)) {
            { LAUNDER(Fl); prep_rope(Fl, p); prep_hyena(Fl, p, l, ctx_live); }
            __syncthreads();
            PROF_MARK(1);
            { pg8::Gemm g{QKVN, (const hf*)(wl + W_UP), MTOT, NUP, KUP, KUP, KUP}; pg8::StaticOrder S; S.init(MTOT, NUP, F.G, (int)blockIdx.x);
              pg8::EpiUp E{QKV, ssq, sskv}; pg8::gemm_phase(F.lds, g, S, E); }
        }
        SEAMT(pb + 1, 2);
        if (PHM(4) && IN(pb + 2)) {
            {
            LAUNDER(Fl);
            PROF_MARK(14);
            const int n_mla = 2048 + (ctx_live ? 256 : 0);
            for (int id = F.vcu; id < n_mla; id += F.G) {
                if (id < 2048) { const int qb = id & 7, h = (id >> 3) & 7, b = id >> 6; att::attn_unit<true>(Fl, p, l, h, b * SEQ + qb * 256, qb * 256, b * SEQ, 32, NLAT + b * CTXL); }
                else { const int i2 = id - 2048, h = i2 & 7, b = i2 >> 3; att::attn_unit<true>(Fl, p, l, h, NLAT + b * CTXL, -1, 0, 0, NLAT + b * CTXL); }
            }
            PROF_MARK(11);
            const int n_df = 1024 + (ctx_live ? 128 : 0);
            for (int id = F.vcu; id < n_df; id += F.G) {
                if (id < 1024) { const int qb = id & 7, h = (id >> 3) & 3, b = id >> 5; att::attn_unit<false>(Fl, p, l, h, b * SEQ + qb * 256, qb * 256, b * SEQ, 32, NLAT + b * CTXL); }
                else { const int i2 = id - 1024, h = i2 & 3, b = i2 >> 2; att::attn_unit<false>(Fl, p, l, h, NLAT + b * CTXL, -1, 0, 0, NLAT + b * CTXL); }
            }
            PROF_MARK(12);
            const unsigned char* ob = (const unsigned char*)p.out;
            for (int c = F.vcu; c < 256; c += F.G)
                hyena_unit<SEQ>(Fl, (const hf*)(ws + WS_RF) + ((size_t)l * 256 + c) * 4096, (const hf*)(ob + O_UT) + (size_t)c * NLAT, (const hf*)(ob + O_X0T) + (size_t)c * NLAT, Y + 512 + c);
            if (ctx_live) for (int c = F.vcu; c < 256; c += F.G)
                hyena_unit<CTXL>(Fl, (const hf*)(ws + WS_RFC) + ((size_t)l * 256 + c) * 512, (const hf*)(ob + O_UTC) + (size_t)c * NCTX, (const hf*)(ob + O_X0TC) + (size_t)c * NCTX, Y + (size_t)NLAT * DM + 512 + c);
            __syncthreads();
            PROF_MARK(13);
            }
            { pg8::Gemm g{XS1, (const hf*)(wl + W_ING), Mrows, NGATE, DM, DM, DM}; pg8::StaticOrder S; S.init(Mrows, NGATE, F.G, (int)blockIdx.x);
              pg8::EpiGate8 E{Gt, ss1, biasl + B_G}; pg8::gemm_phase(F.lds, g, S, E); }
        }
        SEAMT(pb + 2, 4);
        if (PHM(6) && IN(pb + 3)) { pg8::Gemm g{Y, (const hf*)(wl + W_BR), Mrows, DM, DM, DM, DM}; pg8::StaticOrder S; S.init(Mrows, DM, F.G, (int)blockIdx.x);
            pg8::EpiMerge E{MM, Gt}; pg8::gemm_phase(F.lds, g, S, E); }
        SEAMT(pb + 3, 5);
        if (PHM(7) && IN(pb + 4)) { pg8::Gemm g{MM, (const hf*)(wl + W_OUT), Mrows, DM, DM, DM, DM}; pg8::StaticOrder S; S.init(Mrows, DM, F.G, (int)blockIdx.x);
            pg8::EpiResidX<true, true> E{X16, modl + 2 * DM, XS2, gsl + (size_t)NMODV * DM, ss2, lx}; pg8::gemm_phase(F.lds, g, S, E); }
        SEAMT(pb + 4, 6);
        if (PHM(9) && IN(pb + 5)) { pg8::Gemm g{XS2, (const hf*)(wl + W_FC1), Mrows, DFF, DM, DM, DM}; pg8::StaticOrder S; S.init(Mrows, DFF, F.G, (int)blockIdx.x);
            pg8::EpiHalf<2, true> E{HID, DFF, ss2, biasl + B_FC1}; pg8::gemm_phase(F.lds, g, S, E); }
        SEAMT(pb + 5, 7);
        if (PHM(10) && IN(pb + 6)) { pg8::Gemm g{HID, (const hf*)(wl + W_FC2), Mrows, DM, DFF, DFF, DFF}; pg8::StaticOrder S; S.init(Mrows, DM, F.G, (int)blockIdx.x);
            if (ctx_live) { pg8::EpiResidX<true, true> E{X16, modl + 5 * DM, XS1, gsl + (size_t)2 * NMODV * DM, ss1 + (size_t)MTOT * 4, lx}; pg8::gemm_phase(F.lds, g, S, E);
                const int nheavy = (MTOT / 256 * 4) % F.G;
                if (nheavy > 0 && (int)blockIdx.x >= nheavy) { __syncthreads(); LAUNDER(Fl); convert_layer(Fl, p, l + 1, ws + WS_WT + (size_t)((l + 1) & 1) * W_LAYER, (int)blockIdx.x - nheavy, F.G - nheavy); }
                else if (nheavy == 0) { __syncthreads(); LAUNDER(Fl); convert_layer(Fl, p, l + 1, ws + WS_WT + (size_t)((l + 1) & 1) * W_LAYER, Fl.vcu, F.G); } }
            else { pg8::EpiResidX<false, true> E{X16, modl + 5 * DM, nullptr, nullptr, SS + (size_t)SS_F * MTOT * 4, lx}; pg8::gemm_phase(F.lds, g, S, E); } }
        SEAMT(pb + 6, 8);
    }
    if (PHM(12) && IN(NPHASE - 1)) { LAUNDER(Fl); final_norm_phase(Fl, X16, p.out, p.in[I_FNG], SS + (size_t)SS_F * MTOT * 4); }
    PROF_MARK(10);
    if (PROF_SEL >= 0 && blockIdx.x == 0 && F.tid == 0) { const unsigned long long t0 = __builtin_amdgcn_s_memrealtime(); const unsigned long long d = (unsigned long long)PROF_K * prof[PROF_SEL];
        while (__builtin_amdgcn_s_memrealtime() - t0 < d) __builtin_amdgcn_s_sleep(8); }
#undef IN
#undef SEAM
}

extern "C" void kernel_launch(void* const* d_in, const int* in_sizes, int n_in, void* d_out, int out_size, void* d_ws, size_t ws_size, hipStream_t stream) {
    static int grid = 0;
    if (grid == 0) {
        if (n_in != 35 || in_sizes[0] != NLAT * DM || out_size != NLAT * DM || ws_size < WS_END) {
            fprintf(stderr, "kernel_launch: unexpected shapes: n_in %d in0 %d out %d ws %zu (need %zu); nothing launched\n", n_in, n_in > 0 ? in_sizes[0] : -1, out_size, ws_size, (size_t)WS_END); grid = -1; return; }
        int dev = 0, cus = 0, per_cu = 0;
        if (hipGetDevice(&dev) != hipSuccess || hipDeviceGetAttribute(&cus, hipDeviceAttributeMultiprocessorCount, dev) != hipSuccess) { fprintf(stderr, "kernel_launch: device query failed\n"); grid = -1; return; }
        if (hipFuncSetAttribute((const void*)fwd_kernel, hipFuncAttributeMaxDynamicSharedMemorySize, LDS_BYTES) != hipSuccess) { fprintf(stderr, "kernel_launch: hipFuncSetAttribute failed\n"); grid = -1; return; }
        if (hipOccupancyMaxActiveBlocksPerMultiprocessor(&per_cu, (const void*)fwd_kernel, 512, LDS_BYTES) != hipSuccess || per_cu < 1)
            fprintf(stderr, "kernel_launch: note: occupancy query reports %d workgroups per CU\n", per_cu);
        (void)hipGetLastError();
        grid = cus;
    }
    if (grid < 0) return;
    if (hipMemsetAsync((char*)d_ws + WS_BAR, 0, WS_ZERO_BYTES, stream) != hipSuccess) { fprintf(stderr, "kernel_launch: memset failed\n"); return; }
    Params P{};
    for (int i = 0; i < 35; ++i) P.in[i] = (const float*)d_in[i];
    P.out = (float*)d_out; P.ws = (unsigned char*)d_ws;
#if MK_FUSED
    P.ph_lo = 0; P.ph_hi = NPHASE;
    hipLaunchKernelGGL(fwd_kernel, dim3(grid), dim3(512), LDS_BYTES, stream, P);
#else
    for (int ph = 0; ph < NPHASE; ++ph) { P.ph_lo = ph; P.ph_hi = ph + 1; hipLaunchKernelGGL(fwd_kernel, dim3(grid), dim3(512), LDS_BYTES, stream, P); }
#endif
    const hipError_t le = hipPeekAtLastError();
    if (le != hipSuccess) fprintf(stderr, "kernel_launch: launch failed: %s\n", hipGetErrorName(le));
}
```

```cpp
#include <hip/hip_runtime.h>
#include <cstdio>
#include <cstdint>

#ifndef MK_FUSED
#define MK_FUSED 1
#endif

#define LAS __attribute__((address_space(3)))
#define GAS __attribute__((address_space(1)))
typedef _Float16 hf;
typedef _Float16 hf2 __attribute__((ext_vector_type(2)));
typedef _Float16 hf4 __attribute__((ext_vector_type(4)));
typedef _Float16 hf8 __attribute__((ext_vector_type(8)));
typedef short s16x4 __attribute__((ext_vector_type(4)));
typedef float f32x2 __attribute__((ext_vector_type(2)));
typedef float f32x4 __attribute__((ext_vector_type(4)));
typedef float f32x16 __attribute__((ext_vector_type(16)));
typedef unsigned u32x2 __attribute__((ext_vector_type(2)));
typedef unsigned u32x4 __attribute__((ext_vector_type(4)));

constexpr int DM = 1024, NB = 32, SEQ = 2048, DEPTH = 4, CTXL = 256, GRIDW = 64;
constexpr int NLAT = NB * SEQ;
constexpr int NCTX = NB * CTXL;
constexpr int MTOT = NLAT + NCTX;
constexpr int D_IN = 5024, NP1 = 2048  , NGATE = 3072, DFF = 4096;
constexpr int C_PQ = 0, C_PKV = 256, C_PKR = 384, C_HY = 416, C_DQ = 1184, C_DK = 1440, C_DV = 1696, C_PG = 1952;
constexpr int NUP = 1792, KUP = 384;
constexpr int NMODV = 33, MODW = 6 * DM;
constexpr float EPS = 1e-6f;
constexpr float MLA_SCALE = 0.10206207261596575f;
constexpr float DF_SCALE = 0.17677669529663687f;

constexpr size_t al256(size_t x) { return (x + 255) / 256 * 256; }
constexpr size_t WS_BAR = 0, WS_BAR_BYTES = 65536;
constexpr size_t WS_SS = WS_BAR + WS_BAR_BYTES;
constexpr int SS_1 = 0, SS_2 = DEPTH, SS_F = 2 * DEPTH, SSP_N = 2 * DEPTH + 1;
constexpr size_t WS_SSQ = WS_SS + (size_t)SSP_N * MTOT * 4 * 4;
constexpr size_t WS_SSKV = WS_SSQ + (size_t)DEPTH * MTOT * 4;
constexpr size_t WS_ZERO_BYTES = WS_BAR_BYTES;
constexpr size_t WS_MOD = al256(WS_SSKV + (size_t)DEPTH * MTOT * 4);
constexpr size_t WS_GS = WS_MOD + al256((size_t)DEPTH * NMODV * MODW * 4);
constexpr int NBIAS = 9216, B_IN = 0, B_G = 2048, B_FC1 = 5120;
constexpr size_t WS_BIAS = WS_GS + (size_t)DEPTH * 2 * NMODV * DM * 4;
constexpr size_t WS_ROPE = WS_BIAS + (size_t)DEPTH * NMODV * NBIAS * 4;
constexpr size_t WS_LAM = WS_ROPE + (size_t)SEQ * 32 * 4;
constexpr size_t WS_RF = WS_LAM + 256;
constexpr size_t WS_RFC = WS_RF + (size_t)DEPTH * 256 * 4096 * 2;
constexpr size_t WS_X16 = WS_RFC + (size_t)DEPTH * 256 * 512 * 2;
constexpr size_t WS_WT = WS_X16 + (size_t)MTOT * DM * 2;
constexpr size_t W_IN1 = 0, W_ING = W_IN1 + (size_t)NP1 * DM * 2, W_UP = W_ING + (size_t)NGATE * DM * 2, W_BR = W_UP + (size_t)NUP * KUP * 2,
                 W_OUT = W_BR + (size_t)DM * DM * 2, W_FC1 = W_OUT + (size_t)DM * DM * 2, W_FC2 = W_FC1 + (size_t)DFF * DM * 2, W_LAYER = W_FC2 + (size_t)DM * DFF * 2;
constexpr size_t WS_ARENA = WS_WT + 2 * W_LAYER;
constexpr size_t SZ_ROW1024 = (size_t)MTOT * 1024 * 2;
constexpr size_t A_B = WS_ARENA;
constexpr size_t A_C = A_B + SZ_ROW1024;
constexpr size_t A_Y = A_B, A_XS2 = A_B, A_BIG = A_C;
constexpr size_t A_QKVN = A_BIG;
constexpr size_t A_PHY = A_QKVN + (size_t)MTOT * KUP * 2;
constexpr size_t A_KR = A_BIG + (size_t)MTOT * NGATE;
constexpr size_t A_DQ = A_KR + (size_t)MTOT * 32 * 2;
constexpr size_t A_DK = A_DQ + (size_t)MTOT * 256 * 2;
constexpr size_t A_DV = A_DK + (size_t)MTOT * 256 * 2;
constexpr size_t A_QKV = A_DV + (size_t)MTOT * 256 * 2;
constexpr size_t A_BIG_END = A_QKV + (size_t)MTOT * NUP * 2;
static_assert(A_PHY + (size_t)MTOT * 768 * 2 <= A_KR, "QKVN + PHY must fit under the gate bytes");
constexpr size_t O_UT = SZ_ROW1024, O_X0T = O_UT + (size_t)256 * NLAT * 2, O_UTC = O_X0T + (size_t)256 * NLAT * 2, O_X0TC = O_UTC + (size_t)256 * NCTX * 2, O_END = O_X0TC + (size_t)256 * NCTX * 2;
static_assert(O_END <= (size_t)NLAT * DM * 4, "d_out scratch overflow");
constexpr size_t A_G = A_BIG;
constexpr size_t A_HID = A_C;
constexpr size_t WS_END = (A_BIG_END > A_HID + (size_t)MTOT * DFF * 2) ? A_BIG_END : A_HID + (size_t)MTOT * DFF * 2;
static_assert(WS_END <= (size_t)1024 * 1024 * 1024, "workspace map exceeds 1 GiB");

constexpr int LDS_BYTES = 147456;
constexpr int LDS_MISC = LDS_BYTES - 64;
constexpr int LDS_PRE = 135168;
constexpr int LDS_EXCH = 131072;

__device__ __forceinline__ unsigned pkh(float lo, float hi) { f32x2 v = {lo, hi}; hf2 h = __builtin_convertvector(v, hf2); return __builtin_bit_cast(unsigned, h); }
__device__ __forceinline__ unsigned rb8(unsigned h) { return (h + 0x00040004u) & 0xfff8fff8u; }
__device__ __forceinline__ unsigned pkhb(float lo, float hi) { return rb8(pkh(lo, hi)); }
__device__ __forceinline__ float wave_sum(float v) {
#pragma unroll
    for (int o = 1; o < 64; o <<= 1) v += __shfl_xor(v, o);
    return v;
}
__device__ __forceinline__ float rstd4(const float* ssp, int r) { const f32x4 q = *(const f32x4*)(ssp + 4 * (size_t)r); return rsqrtf(((q[0] + q[1]) + (q[2] + q[3])) * (1.f / DM) + EPS); }
__device__ __forceinline__ void rstd8(const float* ssp, int row0, float (&rs)[2][4]) {
    f32x4 q[2][4];
#pragma unroll
    for (int ai = 0; ai < 2; ++ai)
#pragma unroll
        for (int m = 0; m < 4; ++m) q[ai][m] = *(const f32x4*)(ssp + 4 * (size_t)(row0 + ai * 128 + m * 16));
#pragma unroll
    for (int ai = 0; ai < 2; ++ai)
#pragma unroll
        for (int m = 0; m < 4; ++m) rs[ai][m] = rsqrtf(((q[ai][m][0] + q[ai][m][1]) + (q[ai][m][2] + q[ai][m][3])) * (1.f / DM) + EPS);
}
__device__ __forceinline__ void rstd8_lds(const LAS unsigned char* pl, int lr0, float (&rs)[2][4]) {
    f32x4 q[2][4];
#pragma unroll
    for (int ai = 0; ai < 2; ++ai)
#pragma unroll
        for (int m = 0; m < 4; ++m) q[ai][m] = *(const LAS f32x4*)(pl + 16 * (lr0 + ai * 128 + m * 16));
#pragma unroll
    for (int ai = 0; ai < 2; ++ai)
#pragma unroll
        for (int m = 0; m < 4; ++m) rs[ai][m] = rsqrtf(((q[ai][m][0] + q[ai][m][1]) + (q[ai][m][2] + q[ai][m][3])) * (1.f / DM) + EPS);
}
__device__ __forceinline__ void dma16(const void* g, LAS unsigned char* l) { __builtin_amdgcn_global_load_lds((const unsigned*)g, (LAS unsigned*)l, 16, 0, 0); }
__device__ __forceinline__ void pre_norm(LAS unsigned char* pl, const float* ss, const float* biasrow, int R0, int wid, int lane) {
    if (wid < 4) dma16(ss + 4 * (size_t)(R0 + wid * 64 + lane), pl + wid * 1024);
    else if (wid == 4) dma16(biasrow + lane * 4, pl + 4096);
}
#define LDS_WAIT() asm volatile("s_waitcnt lgkmcnt(0)" ::: "memory")
#define VM_WAIT() asm volatile("s_waitcnt vmcnt(0)" ::: "memory")

#define XB_TMO      128
#define XB_XCNT(j)  (256  + 64 * (j))
#define XB_XSUB(j)  (1280 + 64 * (j))
#define XB_XGEN(j)  (2304 + 64 * (j))
#define XB_TOP      3328
#define XB_TOPGEN   3392
#define XCD_BAR_WORDS 3456
#define XB_SPIN_CAP (1u << 22)
__device__ __forceinline__ unsigned xb_ld(unsigned* p)              { return __hip_atomic_load(p, __ATOMIC_RELAXED, __HIP_MEMORY_SCOPE_AGENT); }
__device__ __forceinline__ unsigned xb_add(unsigned* p, unsigned v) { return __hip_atomic_fetch_add(p, v, __ATOMIC_RELAXED, __HIP_MEMORY_SCOPE_AGENT); }
__device__ __forceinline__ unsigned xb_xcc_id() { return (unsigned)__builtin_amdgcn_s_getreg((3 << 11) | 20) & 0xFu; }
#define XB_SPIN(cond, bar) do { unsigned _sp = 0; while (cond) { __builtin_amdgcn_s_sleep(1); \
    if ((++_sp & 255u) == 0u) { if (xb_ld(&(bar)[XB_TMO])) break; if (_sp > XB_SPIN_CAP) { atomicAdd(&(bar)[XB_TMO], 1u); break; } } } } while (0)
struct XcdBarrier { unsigned* bar; unsigned x; volatile LAS unsigned* st; };
__device__ __forceinline__ XcdBarrier xcd_barrier_post(unsigned* bar, volatile LAS unsigned* st) {
    XcdBarrier b; b.bar = bar; b.x = xb_xcc_id(); b.st = st;
    if (threadIdx.x == 0) (void)xb_add(&bar[XB_XCNT(b.x)], 1u);
    return b;
}
__device__ __forceinline__ void xcd_barrier_complete(unsigned* bar, unsigned x, unsigned& nloc, unsigned& nx) {
    const unsigned G = gridDim.x * gridDim.y * gridDim.z;
    unsigned sum, cnt, mine, sp = 0u;
    for (;;) {
        sum = 0u; cnt = 0u; mine = 0u;
#pragma unroll
        for (unsigned j = 0; j < 16; ++j) { const unsigned c = xb_ld(&bar[XB_XCNT(j)]); sum += c; cnt += (c > 0u) ? 1u : 0u; mine = (j == x) ? c : mine; }
        if (sum == G) break;
        __builtin_amdgcn_s_sleep(1);
        if ((++sp & 255u) == 0u) { if (xb_ld(&bar[XB_TMO])) break; if (sp > XB_SPIN_CAP) { atomicAdd(&bar[XB_TMO], 1u); break; } }
    }
    nloc = mine > 0u ? mine : 1u; nx = cnt > 0u ? cnt : 1u;
}
__device__ __forceinline__ void xcd_barrier(const XcdBarrier& b) {
    asm volatile("s_waitcnt vmcnt(0)" ::: "memory");
    __syncthreads();
    if (threadIdx.x == 0) {
        unsigned* bar = b.bar;
        __builtin_amdgcn_s_waitcnt(0);
        unsigned nloc = b.st[0], nx = b.st[1];
        if (nloc == 0u) { xcd_barrier_complete(bar, b.x, nloc, nx); b.st[0] = nloc; b.st[1] = nx; }
        const unsigned old = xb_add(&bar[XB_XSUB(b.x)], 1u);
        const unsigned gen = old / nloc;
        if (old + 1u == (gen + 1u) * nloc) {
            __builtin_amdgcn_fence(__ATOMIC_RELEASE, "agent");
            asm volatile("s_waitcnt vmcnt(0)" ::: "memory");
            const unsigned og = xb_add(&bar[XB_TOP], 1u);
            const unsigned tg = og / nx;
            if (og + 1u == (tg + 1u) * nx) xb_add(&bar[XB_TOPGEN], 1u);
            else XB_SPIN(xb_ld(&bar[XB_TOPGEN]) == tg, bar);
            __builtin_amdgcn_fence(__ATOMIC_ACQUIRE, "agent");
            xb_add(&bar[XB_XGEN(b.x)], 1u);
            asm volatile("s_waitcnt vmcnt(0)" ::: "memory");
        } else {
            XB_SPIN(xb_ld(&bar[XB_XGEN(b.x)]) == gen, bar);
            __builtin_amdgcn_fence(__ATOMIC_ACQUIRE, "agent");
            asm volatile("s_waitcnt vmcnt(0)" ::: "memory");
        }
    }
    __syncthreads();
}

namespace pg8 {
constexpr int BM = 256, BK = 64, HALF = 128, HTB = HALF * BK * 2, STAGE_BYTES = 8 * HTB, NXCD = 8, WGM = 8;
__host__ __device__ __forceinline__ int lds_byte(int r, int c) { const int st = (r >> 4) * 2 + (c >> 5), rr = r & 15, cc = c & 31, ob = rr * 64 + cc * 2; return st * 1024 + (ob ^ (((ob >> 9) & 1) << 5)); }
__host__ __device__ __forceinline__ void stage_rc(int b, int& R, int& C) { const int st = b / 1024, sb = b % 1024, swz = sb ^ (((sb >> 9) & 1) << 5); R = (st >> 1) * 16 + swz / 64; C = (st & 1) * 32 + (swz % 64) / 2; }
__host__ __device__ __forceinline__ int perm32(int rho) { const int n = rho >> 4, i = rho & 15; return 8 * (i >> 2) + 4 * n + (i & 3); }
struct Unit { int pm, pn; };
struct Gemm { const hf* A; const hf* Bt; int M, N, K, lda, ldb; };
struct StaticOrder {
    int nM, nN, nwg, G, c;
    __host__ __device__ void init(int M, int N, int G_, int c_) { nM = M / BM; nN = N / BM; nwg = nM * nN; G = G_; c = c_; }
    __host__ __device__ bool next(int i, Unit& u) const {
        const long L = (long)i * G + c; if (L >= nwg) return false;
        int wgid = (int)L; { const int q = nwg / NXCD, r = nwg % NXCD, xcd = wgid % NXCD, off = wgid / NXCD; wgid = (xcd < r ? xcd * (q + 1) : r * (q + 1) + (xcd - r) * q) + off; }
        const int nig = WGM * nN, gid = wgid / nig, fm = gid * WGM, gsz = (nM - fm) < WGM ? (nM - fm) : WGM;
        u.pm = fm + ((wgid % nig) % gsz); u.pn = (wgid % nig) / gsz; return true;
    }
    __device__ __forceinline__ void a_ready(const Unit&) const {}
    __device__ __forceinline__ void done(const Unit&) const {}
};

template <int ACT  , bool NORM> struct EpiHalf {
    static constexpr bool PERM = true, AFTER_DRAIN = false, PROBE2 = false, MIDK = false, PRE = NORM;
    hf* O; int ldc; const float* ss; const float* bias; LAS unsigned char* pl;
    __device__ __forceinline__ void prefetch(const Unit& u, int wid, int lane) const { const int R0 = u.pm * BM; const int v = (R0 < NLAT) ? (R0 >> 11) : NB; pre_norm(pl, ss, bias + (size_t)v * NBIAS + u.pn * BM, R0, wid, lane); }
    __device__ __forceinline__ void operator()(const f32x4 (&acc)[2][2][4][2], const Unit& u, int wr, int wc, int fr, int fq) const {
        const int row0 = u.pm * BM + wr * 64 + fr, col0 = u.pn * BM + wc * 32 + 8 * fq;
        f32x4 bv[2][2];
        const int lc0 = wc * 32 + 8 * fq;
        if (NORM) {
#pragma unroll
            for (int bj = 0; bj < 2; ++bj)
#pragma unroll
                for (int n = 0; n < 2; ++n) bv[bj][n] = *(const LAS f32x4*)(pl + 4096 + 4 * (lc0 + bj * HALF + 4 * n)); }
        float rsv[2][4]; if (NORM) rstd8_lds(pl, wr * 64 + fr, rsv);
#pragma unroll
        for (int ai = 0; ai < 2; ++ai)
#pragma unroll
            for (int m = 0; m < 4; ++m) { const int r = row0 + ai * HALF + m * 16; hf* rowp = O + (size_t)r * ldc + col0;
                float rs = 1.f; if (NORM) rs = rsv[ai][m];
#pragma unroll
                for (int bj = 0; bj < 2; ++bj) { f32x4 v0 = acc[ai][bj][m][0], v1 = acc[ai][bj][m][1];
                    if (NORM) { v0 = v0 * rs + bv[bj][0]; v1 = v1 * rs + bv[bj][1]; }
                    if (ACT == 1) {
#pragma unroll
                        for (int e = 0; e < 4; ++e) { v0[e] = __builtin_amdgcn_rcpf(1.f + __builtin_amdgcn_exp2f(-1.4426950408889634f * v0[e])); v1[e] = __builtin_amdgcn_rcpf(1.f + __builtin_amdgcn_exp2f(-1.4426950408889634f * v1[e])); } }
                    u32x4 w;
                    if (ACT == 2) {
                        const unsigned h[4] = {pkh(v0[0], v0[1]), pkh(v0[2], v0[3]), pkh(v1[0], v1[1]), pkh(v1[2], v1[3])}; unsigned o[4];
#pragma unroll
                        for (int e = 0; e < 4; ++e) { hf2 a = __builtin_bit_cast(hf2, h[e]); a = __builtin_elementwise_max(a, (hf2){(hf)0.f, (hf)0.f}); a = a * a; o[e] = rb8(__builtin_bit_cast(unsigned, a)); }
                        w.x = o[0]; w.y = o[1]; w.z = o[2]; w.w = o[3];
                    } else { w.x = pkhb(v0[0], v0[1]); w.y = pkhb(v0[2], v0[3]); w.z = pkhb(v1[0], v1[1]); w.w = pkhb(v1[2], v1[3]); }
                    *(u32x4*)(rowp + bj * HALF) = w; } }
    }
};
struct EpiGate8 {
    static constexpr bool PERM = true, AFTER_DRAIN = false, PROBE2 = false, MIDK = false, PRE = true;
    unsigned char* O; const float* ss; const float* bias; LAS unsigned char* pl;
    __device__ __forceinline__ void prefetch(const Unit& u, int wid, int lane) const { const int R0 = u.pm * BM; const int v = (R0 < NLAT) ? (R0 >> 11) : NB; pre_norm(pl, ss, bias + (size_t)v * NBIAS + u.pn * BM, R0, wid, lane); }
    __device__ __forceinline__ void operator()(const f32x4 (&acc)[2][2][4][2], const Unit& u, int wr, int wc, int fr, int fq) const {
        const int R0 = u.pm * BM, row0 = R0 + wr * 64 + fr, col0 = u.pn * BM + wc * 32 + 8 * fq;
        const int lc0 = wc * 32 + 8 * fq;
        f32x4 bv[2][2];
#pragma unroll
        for (int bj = 0; bj < 2; ++bj) { bv[bj][0] = *(const LAS f32x4*)(pl + 4096 + 4 * (lc0 + bj * HALF)); bv[bj][1] = *(const LAS f32x4*)(pl + 4096 + 4 * (lc0 + bj * HALF + 4)); }
        float rsv[2][4]; rstd8_lds(pl, wr * 64 + fr, rsv);
#pragma unroll
        for (int ai = 0; ai < 2; ++ai)
#pragma unroll
            for (int m = 0; m < 4; ++m) { const int r = row0 + ai * HALF + m * 16; const float rs = rsv[ai][m];
#pragma unroll
                for (int bj = 0; bj < 2; ++bj) { const f32x4 v0 = acc[ai][bj][m][0] * rs + bv[bj][0], v1 = acc[ai][bj][m][1] * rs + bv[bj][1];
                    unsigned q[8];
#pragma unroll
                    for (int e = 0; e < 4; ++e) { const float g0 = __builtin_amdgcn_rcpf(1.f + __builtin_amdgcn_exp2f(-1.4426950408889634f * v0[e])), g1 = __builtin_amdgcn_rcpf(1.f + __builtin_amdgcn_exp2f(-1.4426950408889634f * v1[e]));
                        q[e] = (unsigned)fmaxf(1.f, __builtin_rintf(255.f * g0)); q[4 + e] = (unsigned)fmaxf(1.f, __builtin_rintf(255.f * g1)); }
                    u32x2 w; w.x = q[0] | (q[1] << 8) | (q[2] << 16) | (q[3] << 24); w.y = q[4] | (q[5] << 8) | (q[6] << 16) | (q[7] << 24);
                    *(u32x2*)(O + (size_t)r * NGATE + col0 + bj * HALF) = w; } }
    }
};
struct EpiIn {
    static constexpr bool PERM = true, AFTER_DRAIN = false, PROBE2 = false, MIDK = false, PRE = true;
    hf* QKVNo; hf* KRo; hf* PHYo; hf* DQo; hf* DKo; hf* DVo; const float* ss; const float* bias; float* ssq; float* sskv; LAS unsigned char* lx; LAS unsigned char* pl;
    __device__ __forceinline__ void prefetch(const Unit& u, int wid, int lane) const { const int R0 = u.pm * BM; const int v = (R0 < NLAT) ? (R0 >> 11) : NB; pre_norm(pl, ss, bias + (size_t)v * NBIAS + u.pn * BM, R0, wid, lane); }
    __device__ __forceinline__ void operator()(const f32x4 (&acc)[2][2][4][2], const Unit& u, int wr, int wc, int fr, int fq) const {
        const int R0 = u.pm * BM, row0 = R0 + wr * 64 + fr, col0 = u.pn * BM + wc * 32 + 8 * fq;
        const int lc0 = wc * 32 + 8 * fq;
        f32x4 bv[2][2]; hf* dst[2]; int ld[2];
#pragma unroll
        for (int bj = 0; bj < 2; ++bj) { const int c8 = col0 + bj * HALF;
            bv[bj][0] = *(const LAS f32x4*)(pl + 4096 + 4 * (lc0 + bj * HALF)); bv[bj][1] = *(const LAS f32x4*)(pl + 4096 + 4 * (lc0 + bj * HALF + 4));
            if (c8 < C_PKR) { dst[bj] = QKVNo + c8; ld[bj] = KUP; }
            else if (c8 < C_HY) { dst[bj] = KRo + (c8 - C_PKR); ld[bj] = 32; }
            else if (c8 < C_DQ) { dst[bj] = PHYo + (c8 - C_HY); ld[bj] = 768; }
            else if (c8 < C_DK) { dst[bj] = DQo + (c8 - C_DQ); ld[bj] = 256; }
            else if (c8 < C_DV) { dst[bj] = DKo + (c8 - C_DK); ld[bj] = 256; }
            else if (c8 < C_PG) { dst[bj] = DVo + (c8 - C_DV); ld[bj] = 256; }
            else { dst[bj] = nullptr; ld[bj] = 0; } }
        const int nstat = (u.pn == 0) ? 2 : (u.pn == 1 ? 1 : 0);
        float* sp = (u.pn == 0) ? ssq : sskv;
        float sqv[2][4];
        float rsv[2][4]; rstd8_lds(pl, wr * 64 + fr, rsv);
#pragma unroll
        for (int ai = 0; ai < 2; ++ai)
#pragma unroll
            for (int m = 0; m < 4; ++m) { const int r = row0 + ai * HALF + m * 16; const float rs = rsv[ai][m]; float sq = 0.f;
#pragma unroll
                for (int bj = 0; bj < 2; ++bj) { const f32x4 v0 = acc[ai][bj][m][0] * rs + bv[bj][0], v1 = acc[ai][bj][m][1] * rs + bv[bj][1];
                    if (bj < nstat) sq += (v0[0] * v0[0] + v0[1] * v0[1]) + (v0[2] * v0[2] + v0[3] * v0[3]) + (v1[0] * v1[0] + v1[1] * v1[1]) + (v1[2] * v1[2] + v1[3] * v1[3]);
                    if (dst[bj]) { u32x4 w; w.x = pkhb(v0[0], v0[1]); w.y = pkhb(v0[2], v0[3]); w.z = pkhb(v1[0], v1[1]); w.w = pkhb(v1[2], v1[3]); *(u32x4*)(dst[bj] + (size_t)r * ld[bj]) = w; } }
                sq += __shfl_xor(sq, 16); sq += __shfl_xor(sq, 32); sqv[ai][m] = sq; }
        if (nstat) {
            LAS float* ex = (LAS float*)lx;
            if (fq == 0) {
#pragma unroll
                for (int ai = 0; ai < 2; ++ai)
#pragma unroll
                    for (int m = 0; m < 4; ++m) ex[((wr * 4 + wc) * 8 + ai * 4 + m) * 16 + fr] = sqv[ai][m]; }
            asm volatile("s_waitcnt lgkmcnt(0)" ::: "memory"); __builtin_amdgcn_s_barrier(); asm volatile("" ::: "memory");
            if (wc == 0 && fq == 0) {
#pragma unroll
                for (int ai = 0; ai < 2; ++ai)
#pragma unroll
                    for (int m = 0; m < 4; ++m) { const int e = (ai * 4 + m) * 16 + fr; const int wb = wr * 4 * 128;
                        sp[row0 + ai * HALF + m * 16] = (ex[wb + e] + ex[wb + 128 + e]) + (ex[wb + 256 + e] + ex[wb + 384 + e]); } }
        }
    }
};
struct EpiUp {
    static constexpr bool PERM = true, AFTER_DRAIN = false, PROBE2 = false, MIDK = false, PRE = true;
    hf* O; const float* ssq; const float* sskv; LAS unsigned char* pl;
    __device__ __forceinline__ void prefetch(const Unit& u, int wid, int lane) const { if (wid == 0) dma16((u.pn < 3 ? ssq : sskv) + u.pm * BM + 4 * lane, pl); }
    __device__ __forceinline__ void operator()(const f32x4 (&acc)[2][2][4][2], const Unit& u, int wr, int wc, int fr, int fq) const {
        const int row0 = u.pm * BM + wr * 64 + fr, col0 = u.pn * BM + wc * 32 + 8 * fq;
        const bool isq = u.pn < 3; const float* sp = isq ? ssq : sskv; const float invn = isq ? (1.f / 256.f) : (1.f / 128.f);
        float rsv[2][4];
#pragma unroll
        for (int ai = 0; ai < 2; ++ai)
#pragma unroll
            for (int m = 0; m < 4; ++m) rsv[ai][m] = *(const LAS float*)(pl + 4 * (wr * 64 + fr + ai * HALF + m * 16));
#pragma unroll
        for (int ai = 0; ai < 2; ++ai)
#pragma unroll
            for (int m = 0; m < 4; ++m) { const int r = row0 + ai * HALF + m * 16; hf* rowp = O + (size_t)r * NUP + col0; const float rs = rsqrtf(rsv[ai][m] * invn + EPS);
#pragma unroll
                for (int bj = 0; bj < 2; ++bj) { const f32x4 v0 = acc[ai][bj][m][0] * rs, v1 = acc[ai][bj][m][1] * rs;
                    u32x4 w; w.x = pkhb(v0[0], v0[1]); w.y = pkhb(v0[2], v0[3]); w.z = pkhb(v1[0], v1[1]); w.w = pkhb(v1[2], v1[3]);
                    *(u32x4*)(rowp + bj * HALF) = w; } }
    }
};
template <bool FIRST> struct EpiGated {
    static constexpr bool PERM = true, AFTER_DRAIN = false, PROBE2 = false, MIDK = false, PRE = false;
    hf* MMo; const hf* G; int goff;
    __device__ __forceinline__ void operator()(const f32x4 (&acc)[2][2][4][2], const Unit& u, int wr, int wc, int fr, int fq) const {
        const int row0 = u.pm * BM + wr * 64 + fr, col0 = u.pn * BM + wc * 32 + 8 * fq;
#pragma unroll
        for (int ai = 0; ai < 2; ++ai)
#pragma unroll
            for (int m = 0; m < 4; ++m) { const size_t r = (size_t)(row0 + ai * HALF + m * 16);
#pragma unroll
                for (int bj = 0; bj < 2; ++bj) { const f32x4 v0 = acc[ai][bj][m][0], v1 = acc[ai][bj][m][1];
                    const hf8 g = *(const hf8*)(G + r * NGATE + goff + col0 + bj * HALF);
                    hf* mp = MMo + r * DM + col0 + bj * HALF;
                    float o[8];
#pragma unroll
                    for (int e = 0; e < 4; ++e) { o[e] = (float)g[e] * v0[e]; o[4 + e] = (float)g[4 + e] * v1[e]; }
                    if (!FIRST) { const hf8 p = *(const hf8*)mp;
#pragma unroll
                        for (int e = 0; e < 8; ++e) o[e] += (float)p[e]; }
                    u32x4 w; w.x = pkh(o[0], o[1]); w.y = pkh(o[2], o[3]); w.z = pkh(o[4], o[5]); w.w = pkh(o[6], o[7]);
                    *(u32x4*)mp = w; } }
    }
};
struct EpiMerge {
    static constexpr bool PERM = true, AFTER_DRAIN = false, PROBE2 = false, MIDK = true, PRE = false;
    static constexpr int MID1 = 8, MID2 = 12;
    hf* MMo; const unsigned char* G;
    __device__ __forceinline__ void mid(f32x4 (&acc)[2][2][4][2], const Unit& u, int which, int wr, int wc, int fr, int fq) const {
        asm volatile("" : "+v"(fr), "+v"(fq));
        const int row0 = u.pm * BM + wr * 64 + fr, col0 = u.pn * BM + wc * 32 + 8 * fq; const int gnum = which ? 1024 : 0, gden = which ? 2048 : 1024;
#pragma unroll
        for (int ai = 0; ai < 2; ++ai) {
            u32x2 gn[4][2], gd[4][2];
#pragma unroll
            for (int m = 0; m < 4; ++m) { const unsigned char* gr = G + (size_t)(row0 + ai * HALF + m * 16) * NGATE + col0;
#pragma unroll
                for (int bj = 0; bj < 2; ++bj) { gn[m][bj] = *(const u32x2*)(gr + gnum + bj * HALF); gd[m][bj] = *(const u32x2*)(gr + gden + bj * HALF); } }
#pragma unroll
            for (int m = 0; m < 4; ++m)
#pragma unroll
                for (int bj = 0; bj < 2; ++bj)
#pragma unroll
                    for (int e = 0; e < 4; ++e) {
                        acc[ai][bj][m][0][e] *= (float)((gn[m][bj].x >> (8 * e)) & 255u) * __builtin_amdgcn_rcpf((float)((gd[m][bj].x >> (8 * e)) & 255u));
                        acc[ai][bj][m][1][e] *= (float)((gn[m][bj].y >> (8 * e)) & 255u) * __builtin_amdgcn_rcpf((float)((gd[m][bj].y >> (8 * e)) & 255u)); }
            asm volatile("" ::: "memory");
        }
    }
    __device__ __forceinline__ void operator()(const f32x4 (&acc)[2][2][4][2], const Unit& u, int wr, int wc, int fr, int fq) const {
        const int row0 = u.pm * BM + wr * 64 + fr, col0 = u.pn * BM + wc * 32 + 8 * fq;
#pragma unroll
        for (int ai = 0; ai < 2; ++ai) {
            u32x2 gq[4][2];
#pragma unroll
            for (int m = 0; m < 4; ++m)
#pragma unroll
                for (int bj = 0; bj < 2; ++bj) gq[m][bj] = *(const u32x2*)(G + (size_t)(row0 + ai * HALF + m * 16) * NGATE + 2048 + col0 + bj * HALF);
#pragma unroll
            for (int m = 0; m < 4; ++m) { const size_t r = (size_t)(row0 + ai * HALF + m * 16);
#pragma unroll
                for (int bj = 0; bj < 2; ++bj) { const f32x4 v0 = acc[ai][bj][m][0], v1 = acc[ai][bj][m][1];
                    const u32x2 g = gq[m][bj];
                    float o[8];
#pragma unroll
                    for (int e = 0; e < 4; ++e) { o[e] = (float)((g.x >> (8 * e)) & 255u) * (1.f / 255.f) * v0[e]; o[4 + e] = (float)((g.y >> (8 * e)) & 255u) * (1.f / 255.f) * v1[e]; }
                    u32x4 w; w.x = pkhb(o[0], o[1]); w.y = pkhb(o[2], o[3]); w.z = pkhb(o[4], o[5]); w.w = pkhb(o[6], o[7]);
                    *(u32x4*)(MMo + r * DM + col0 + bj * HALF) = w; } } }
    }
};
template <bool XS, bool STAT> struct EpiResidX {
    static constexpr bool PERM = true, AFTER_DRAIN = false, PROBE2 = false, MIDK = false, PRE = false;
    hf* x16; const float* gate;
    hf* xsout; const float* gs; float* ss; LAS unsigned char* lx;
    __device__ __forceinline__ void operator()(const f32x4 (&acc)[2][2][4][2], const Unit& u, int wr, int wc, int fr, int fq) const {
        const int R0 = u.pm * BM; const int v = (R0 < NLAT) ? (R0 >> 11) : NB;
        const int rglob = R0 + wr * 64 + fr, col0 = u.pn * BM + wc * 32 + 8 * fq;
        const float* gp = gate + (size_t)v * MODW + col0; const float* gsp = gs + (size_t)v * DM + col0;
        float sq[2][4];
#pragma unroll
        for (int ai = 0; ai < 2; ++ai)
#pragma unroll
            for (int m = 0; m < 4; ++m) sq[ai][m] = 0.f;
#pragma unroll
        for (int bj = 0; bj < 2; ++bj) {
            const f32x4 g0 = *(const f32x4*)(gp + bj * HALF), g1 = *(const f32x4*)(gp + bj * HALF + 4);
            const hf2 gh[4] = {__builtin_bit_cast(hf2, pkh(g0[0], g0[1])), __builtin_bit_cast(hf2, pkh(g0[2], g0[3])), __builtin_bit_cast(hf2, pkh(g1[0], g1[1])), __builtin_bit_cast(hf2, pkh(g1[2], g1[3]))};
            hf2 sh[4] = {gh[0], gh[0], gh[0], gh[0]};
            if (XS) { const f32x4 s0 = *(const f32x4*)(gsp + bj * HALF), s1 = *(const f32x4*)(gsp + bj * HALF + 4);
                sh[0] = __builtin_bit_cast(hf2, pkh(s0[0], s0[1])); sh[1] = __builtin_bit_cast(hf2, pkh(s0[2], s0[3])); sh[2] = __builtin_bit_cast(hf2, pkh(s1[0], s1[1])); sh[3] = __builtin_bit_cast(hf2, pkh(s1[2], s1[3])); }
#pragma unroll
            for (int ai = 0; ai < 2; ++ai) {
                hf8 xq[4];
#pragma unroll
                for (int m = 0; m < 4; ++m) xq[m] = *(const hf8*)(x16 + (size_t)(rglob + ai * HALF + m * 16) * DM + col0 + bj * HALF);
#pragma unroll
                for (int m = 0; m < 4; ++m) { const int rr = ai * HALF + m * 16; const size_t off = (size_t)(rglob + rr) * DM + col0 + bj * HALF;
                    const hf8 xv = xq[m];
                    const f32x4 a0 = acc[ai][bj][m][0], a1 = acc[ai][bj][m][1];
                    const hf2 ah[4] = {__builtin_bit_cast(hf2, pkh(a0[0], a0[1])), __builtin_bit_cast(hf2, pkh(a0[2], a0[3])), __builtin_bit_cast(hf2, pkh(a1[0], a1[1])), __builtin_bit_cast(hf2, pkh(a1[2], a1[3]))};
                    u32x4 wn, wx;
#pragma unroll
                    for (int e = 0; e < 4; ++e) { const hf2 n = __builtin_elementwise_fma(gh[e], ah[e], (hf2){xv[2 * e], xv[2 * e + 1]});
                        wn[e] = __builtin_bit_cast(unsigned, n);
                        if (STAT) sq[ai][m] = __builtin_amdgcn_fdot2(n, n, sq[ai][m], false);
                        if (XS) wx[e] = rb8(__builtin_bit_cast(unsigned, n * sh[e])); }
                    *(u32x4*)(x16 + off) = wn;
                    if (XS) *(u32x4*)(xsout + off) = wx; } }
        }
        if (STAT) {
            LAS float* ex = (LAS float*)lx;
#pragma unroll
            for (int ai = 0; ai < 2; ++ai)
#pragma unroll
                for (int m = 0; m < 4; ++m) { float t = sq[ai][m]; t += __shfl_xor(t, 16); t += __shfl_xor(t, 32);
                    if (fq == 0) ex[((wr * 4 + wc) * 8 + ai * 4 + m) * 16 + fr] = t; }
            asm volatile("s_waitcnt lgkmcnt(0)" ::: "memory"); __builtin_amdgcn_s_barrier(); asm volatile("" ::: "memory");
            if (wc == 0 && fq == 0) {
#pragma unroll
                for (int ai = 0; ai < 2; ++ai)
#pragma unroll
                    for (int m = 0; m < 4; ++m) { const int e = (ai * 4 + m) * 16 + fr; const int wb = wr * 4 * 128;
                        ss[(size_t)(rglob + ai * HALF + m * 16) * 4 + u.pn] = (ex[wb + e] + ex[wb + 128 + e]) + (ex[wb + 256 + e] + ex[wb + 384 + e]); } }
        }
    }
};

template <class Epi, class Sched, bool ALIGN_EPI = true>
__device__ __forceinline__ void gemm_phase(LAS unsigned char* lds, const Gemm g, const Sched& S, const Epi& E) {
    int tid = threadIdx.x; asm volatile("" : "+v"(tid));
    const int wid = __builtin_amdgcn_readfirstlane(tid >> 6), lane = tid & 63, wr = wid >> 2, wc = wid & 3, fr = lane & 15, fq = lane >> 4;
    const int K = g.K, nt = K / BK;
    unsigned voffA[2], voffB[2];
#pragma unroll
    for (int i = 0; i < 2; ++i) { int R, C; stage_rc(tid * 16 + i * 8192, R, C); const int Rb = Epi::PERM ? ((R & ~31) + perm32(R & 31)) : R;
        voffA[i] = (unsigned)(R * g.lda + C) * 2u; voffB[i] = (unsigned)(Rb * g.ldb + C) * 2u; }
    const size_t kstep = (size_t)(BK * 2);
    const size_t hstepA = (size_t)HALF * g.lda * 2, hstepB = (size_t)HALF * g.ldb * 2;
    const size_t tstepA = 2 * hstepA, tstepB = 2 * hstepB;
    const unsigned ldsw = (unsigned)wid * 1024u;
    const int aoff = lds_byte(wr * 64 + fr, fq * 8), boff = lds_byte(wc * 32 + fr, fq * 8);
#define PG8_SA(b, h) (((b) * 2 + (h)) * HTB)
#define PG8_SB(b, h) ((4 + (b) * 2 + (h)) * HTB)
#define PG8_STAGE(bufoff, gbase, voff) do { _Pragma("unroll") for (int _i = 0; _i < 2; ++_i) \
        __builtin_amdgcn_global_load_lds((const unsigned*)((const char*)(gbase) + (voff)[_i]), (LAS unsigned*)(lds + (bufoff) + ldsw + _i * 8192), 16, 0, 0); } while (0)
#define PG8_LDA(dst, b, h) do { _Pragma("unroll") for (int m = 0; m < 4; ++m) _Pragma("unroll") for (int k = 0; k < 2; ++k) dst[m][k] = *(const LAS hf8*)(lds + PG8_SA(b, h) + aoff + m * 2048 + k * 1024); } while (0)
#define PG8_LDB(dst, b, h) do { _Pragma("unroll") for (int n = 0; n < 2; ++n) _Pragma("unroll") for (int k = 0; k < 2; ++k) dst[n][k] = *(const LAS hf8*)(lds + PG8_SB(b, h) + boff + n * 2048 + k * 1024); } while (0)
#define PG8_MMA(ai, bj, At, Bt) do { __builtin_amdgcn_s_setprio(1); _Pragma("unroll") for (int m = 0; m < 4; ++m) _Pragma("unroll") for (int n = 0; n < 2; ++n) _Pragma("unroll") for (int k = 0; k < 2; ++k) \
        acc[ai][bj][m][n] = __builtin_amdgcn_mfma_f32_16x16x32_f16(Bt[n][k], At[m][k], acc[ai][bj][m][n], 0, 0, 0); __builtin_amdgcn_s_setprio(0); } while (0)
#define PG8_WAIT_V(n) asm volatile("s_waitcnt vmcnt(" #n ")" ::: "memory")
#define PG8_WAIT_L(n) asm volatile("s_waitcnt lgkmcnt(" #n ")" ::: "memory")
#define PG8_BAR __builtin_amdgcn_s_barrier()
#define PG8_SCHED __builtin_amdgcn_sched_barrier(0)
    Unit cur, nxt; int ui = 0;
    if (!S.next(0, cur)) return;
    f32x4 acc[2][2][4][2];
#pragma unroll
    for (int a = 0; a < 2; ++a)
#pragma unroll
        for (int b = 0; b < 2; ++b)
#pragma unroll
            for (int m = 0; m < 4; ++m)
#pragma unroll
                for (int n = 0; n < 2; ++n) acc[a][b][m][n] = (f32x4){0.f, 0.f, 0.f, 0.f};
    hf8 At[4][2], B0[2][2], B1[2][2];
    const char* cA = (const char*)g.A + (size_t)cur.pm * tstepA; const char* cB = (const char*)g.Bt + (size_t)cur.pn * tstepB;
    S.a_ready(cur);
    PG8_STAGE(PG8_SB(0, 0), cB, voffB); PG8_STAGE(PG8_SB(0, 1), cB + hstepB, voffB); PG8_STAGE(PG8_SA(0, 0), cA, voffA); PG8_STAGE(PG8_SA(0, 1), cA + hstepA, voffA);
    if (wr == 1) PG8_BAR;
    PG8_WAIT_V(2); PG8_BAR;
    PG8_STAGE(PG8_SB(1, 0), cB + kstep, voffB); PG8_STAGE(PG8_SA(1, 0), cA + kstep, voffA); PG8_STAGE(PG8_SB(1, 1), cB + hstepB + kstep, voffB);
    PG8_WAIT_V(6); PG8_BAR;
    for (;;) {
        const bool has_next = S.next(ui + 1, nxt);
        const char* nA = has_next ? (const char*)g.A + (size_t)nxt.pm * tstepA : cA; const char* nB = has_next ? (const char*)g.Bt + (size_t)nxt.pn * tstepB : cB;
#pragma unroll 1
        for (int t = 0; t < nt; t += 2) {
            const bool last = (t == nt - 2);
            const char* a1 = cA + (size_t)(t + 1) * kstep;
            const char* a2 = last ? nA : cA + (size_t)(t + 2) * kstep; const char* b2 = last ? nB : cB + (size_t)(t + 2) * kstep;
            const char* a3 = a2 + kstep; const char* b3 = b2 + kstep;
            if (last && has_next) S.a_ready(nxt);
            if constexpr (Epi::MIDK) { if (t == Epi::MID1 || t == Epi::MID2) E.mid(acc, cur, t == Epi::MID1 ? 0 : 1, wr, wc, fr, fq); }
            if constexpr (Epi::PRE) { if (last) E.prefetch(cur, wid, lane); }
            PG8_LDB(B0, 0, 0); PG8_LDB(B1, 0, 1); PG8_SCHED; PG8_LDA(At, 0, 0); PG8_STAGE(PG8_SA(1, 1), a1 + hstepA, voffA);
            PG8_WAIT_V(8); PG8_WAIT_L(0); PG8_BAR; PG8_MMA(0, 0, At, B0); PG8_MMA(0, 1, At, B1); PG8_BAR; PG8_SCHED;
            PG8_LDA(At, 0, 1); PG8_STAGE(PG8_SB(0, 0), b2, voffB); PG8_STAGE(PG8_SB(0, 1), b2 + hstepB, voffB); PG8_STAGE(PG8_SA(0, 0), a2, voffA);
            PG8_WAIT_V(8); PG8_WAIT_L(0); PG8_BAR; PG8_MMA(1, 0, At, B0); PG8_MMA(1, 1, At, B1); PG8_BAR; PG8_SCHED;
            PG8_LDB(B0, 1, 0); PG8_LDB(B1, 1, 1); PG8_SCHED; PG8_LDA(At, 1, 0); PG8_STAGE(PG8_SA(0, 1), a2 + hstepA, voffA);
            PG8_WAIT_V(8); PG8_WAIT_L(0); PG8_BAR; PG8_MMA(0, 0, At, B0); PG8_MMA(0, 1, At, B1); PG8_BAR; PG8_SCHED;
            PG8_LDA(At, 1, 1); PG8_STAGE(PG8_SB(1, 0), b3, voffB); PG8_STAGE(PG8_SB(1, 1), b3 + hstepB, voffB); PG8_STAGE(PG8_SA(1, 0), a3, voffA);
            PG8_WAIT_V(8); PG8_WAIT_L(0); PG8_BAR; PG8_MMA(1, 0, At, B0); PG8_MMA(1, 1, At, B1); PG8_BAR; PG8_SCHED;
        }
        if constexpr (ALIGN_EPI) { if (wr == 0) PG8_BAR; }
        E(acc, cur, wr, wc, fr, fq); S.done(cur);
#ifdef PROBE_EPI2
        if (Epi::PROBE2) { asm volatile("" ::: "memory"); E(acc, cur, wr, wc, fr, fq); }
#endif
        if (!has_next) break;
#pragma unroll
        for (int a = 0; a < 2; ++a)
#pragma unroll
            for (int b = 0; b < 2; ++b)
#pragma unroll
                for (int m = 0; m < 4; ++m)
#pragma unroll
                    for (int n = 0; n < 2; ++n) acc[a][b][m][n] = (f32x4){0.f, 0.f, 0.f, 0.f};
        cur = nxt; cA = nA; cB = nB; ++ui;
        if constexpr (ALIGN_EPI) { if (wr == 1) PG8_BAR; }
    }
    PG8_WAIT_V(0);
    if constexpr (!ALIGN_EPI) { if (wr == 0) PG8_BAR; }
    PG8_BAR;
#undef PG8_SA
#undef PG8_SB
#undef PG8_STAGE
#undef PG8_LDA
#undef PG8_LDB
#undef PG8_MMA
#undef PG8_WAIT_V
#undef PG8_WAIT_L
#undef PG8_BAR
#undef PG8_SCHED
}
}

struct Params {
    const float* in[35];
    float* out;
    unsigned char* ws;
    int ph_lo, ph_hi;
};
enum { I_X = 0, I_C, I_CTX, I_CCTX, I_NMG, I_NFG, I_WMOD, I_BMOD, I_WIN, I_QNG, I_WUQ, I_KVNG, I_WUKV, I_HCW, I_HCB, I_HW1, I_HB1, I_HFREQ, I_HW2, I_HB2, I_HW3, I_HB3,
       I_HSKIP, I_LQ1, I_LK1, I_LQ2, I_LK2, I_SUBG, I_WBRA, I_WBRB, I_WBRC, I_WOUT, I_FC1, I_FC2, I_FNG };

struct Frame {
    LAS unsigned char* lds;
    int tid, lane, wave, vcu, G;
};

__device__ __forceinline__ void tr_item(const float* W, int ldw, hf* WT, int ldt, int nblk, LAS float* scr, int item, int lane, const float* kgain = nullptr) {
    const int kb = item / nblk, nb = item % nblk, k0 = 64 * kb, n0 = 32 * nb;
#pragma unroll 8
    for (int i = 0; i < 32; ++i) { const int kk = 2 * i + (lane >> 5); const float gk = kgain ? kgain[k0 + kk] : 1.f; { float wv = W[(size_t)(k0 + kk) * ldw + n0 + (lane & 31)] * gk; unsigned ub = __float_as_uint(wv); ub += 0x7fffu + ((ub >> 16) & 1u); ub &= 0xffff0000u; scr[kk * 33 + (lane & 31)] = __uint_as_float(ub); } }
    LDS_WAIT(); asm volatile("" ::: "memory");
    const int c = lane & 7;
#pragma unroll
    for (int j = 0; j < 4; ++j) { const int n = (lane >> 3) + 8 * j; const LAS float* s = scr + (8 * c) * 33 + n;
        u32x4 o; o.x = pkh(s[0 * 33], s[1 * 33]); o.y = pkh(s[2 * 33], s[3 * 33]); o.z = pkh(s[4 * 33], s[5 * 33]); o.w = pkh(s[6 * 33], s[7 * 33]);
        *(u32x4*)(WT + (size_t)(n0 + n) * ldt + k0 + 8 * c) = o; }
    LDS_WAIT(); asm volatile("" ::: "memory");
}
__device__ __forceinline__ float silu_f(float x) { return x / (1.f + expf(-x)); }

__device__ __forceinline__ void mod_phase(const Frame& F, const Params& p) {
    float* MOD = (float*)(p.ws + WS_MOD);
    LAS float* sv = (LAS float*)F.lds;
    constexpr int NCB = DEPTH * MODW / 512;
    for (int item = F.vcu; item < NCB * 3; item += F.G) {
        const int cb = item / 3, vg = item % 3;
        __syncthreads();
        for (int i = F.tid; i < 11 * 1024; i += 512) { const int v = vg * 11 + i / 1024, k = i % 1024;
            const float c = (v < NB) ? p.in[I_C][v * DM + k] : p.in[I_CCTX][k]; sv[i] = silu_f(c); }
        __syncthreads();
        const int gcol = cb * 512 + F.tid, l = gcol / MODW, n = gcol % MODW;
        const float* w = p.in[I_WMOD] + (size_t)l * DM * MODW + n;
        float acc[11];
#pragma unroll
        for (int v = 0; v < 11; ++v) acc[v] = 0.f;
#pragma unroll 4
        for (int k = 0; k < DM; k += 4) {
            const float w0 = w[(size_t)k * MODW], w1 = w[(size_t)(k + 1) * MODW], w2 = w[(size_t)(k + 2) * MODW], w3 = w[(size_t)(k + 3) * MODW];
#pragma unroll
            for (int v = 0; v < 11; ++v) { const f32x4 s = *(const LAS f32x4*)(sv + v * 1024 + k);
                acc[v] = fmaf(s[0], w0, acc[v]); acc[v] = fmaf(s[1], w1, acc[v]); acc[v] = fmaf(s[2], w2, acc[v]); acc[v] = fmaf(s[3], w3, acc[v]); }
        }
        const float bm = p.in[I_BMOD][(size_t)l * MODW + n];
#pragma unroll
        for (int v = 0; v < 11; ++v) MOD[((size_t)l * NMODV + vg * 11 + v) * MODW + n] = acc[v] + bm;
    }
    __syncthreads();
}

__device__ __forceinline__ void filt_item(const Params& p, int l, int kind  , int t, int lane) {
    const int L = kind ? CTXL : SEQ;
    hf* R = kind ? (hf*)(p.ws + WS_RFC) + (size_t)l * 256 * 512 : (hf*)(p.ws + WS_RF) + (size_t)l * 256 * 4096;
    const int rl = 2 * L;
    const float tl = (float)t / (float)(L - 1);
    const float wt = (6.283185307179586f / (float)L) * (float)t;
    float z = 0.f;
    if (lane == 0) z = tl;
    else if (lane <= 32) { const int bi = (lane - 1) & 15; const float band = 1e-4f + (15.f - 1e-4f) * ((float)bi / 15.f); const float a = band * wt; z = (lane <= 16) ? cosf(a) : -sinf(a); }
    const float* w1 = p.in[I_HW1] + (size_t)l * 33 * 64; const float* w2 = p.in[I_HW2] + (size_t)l * 64 * 64; const float* w3 = p.in[I_HW3] + (size_t)l * 64 * 512;
    const float fr = p.in[I_HFREQ][l * 64 + lane];
    float a1 = p.in[I_HB1][l * 64 + lane];
    for (int i = 0; i < 33; ++i) a1 = fmaf(__shfl(z, i), w1[i * 64 + lane], a1);
    a1 = sinf(fr * a1);
    float a2 = p.in[I_HB2][l * 64 + lane];
    for (int i = 0; i < 64; ++i) a2 = fmaf(__shfl(a1, i), w2[i * 64 + lane], a2);
    a2 = sinf(fr * a2);
    float h[8];
#pragma unroll
    for (int q = 0; q < 8; ++q) h[q] = p.in[I_HB3][l * 512 + q * 64 + lane];
    for (int i = 0; i < 64; ++i) { const float a = __shfl(a2, i);
#pragma unroll
        for (int q = 0; q < 8; ++q) h[q] = fmaf(a, w3[i * 512 + q * 64 + lane], h[q]); }
    const float d0 = -4.605170185988091f / 1.5f, d1 = -4.605170185988091f / 0.3f;
#pragma unroll
    for (int q = 0; q < 8; ++q) { const int o = q * 64 + lane, dir = o >> 8, c = o & 255;
        const float delta = fabsf(d0 + (d1 - d0) * ((float)c / 255.f));
        float val = h[q] * (expf(-tl * delta) + 0.05f);
        if (dir == 0) { if (t == 0) val += p.in[I_HSKIP][l * 256 + c]; R[(size_t)c * rl + (L - t)] = (hf)val; if (t == 0) R[(size_t)c * rl] = (hf)0.f; }
        else if (t >= 1) R[(size_t)c * rl + (L + t)] = (hf)val; }
}

__device__ __forceinline__ void convert_layer(const Frame& F, const Params& p, int l, unsigned char* wl, int wg_rank, int wg_count) {
    LAS float* scr = (LAS float*)(F.lds + F.wave * 16384);
    const int gw = wg_rank * 8 + F.wave, NGW = wg_count * 8, lane = F.lane;
    constexpr int IT_IN1 = 16 * 61, IT_ING = 16 * 96, IT_UQ = 4 * 24, IT_UKV = 2 * 32, IT_BRA = 8 * 32, IT_BRB = 4 * 32, IT_BRC = 4 * 32, IT_OUT = 16 * 32, IT_FC1 = 16 * 128, IT_FC2 = 64 * 32;
    constexpr int IT_LAYER = IT_IN1 + IT_ING + IT_UQ + IT_UKV + IT_BRA + IT_BRB + IT_BRC + IT_OUT + IT_FC1 + IT_FC2;
    for (int it = gw; it < IT_LAYER; it += NGW) {
        int r = it;
        if (r < IT_IN1) { tr_item(p.in[I_WIN] + (size_t)l * DM * D_IN, D_IN, (hf*)(wl + W_IN1), DM, 61, scr, r, lane); continue; } r -= IT_IN1;
        if (r < IT_ING) { tr_item(p.in[I_WIN] + (size_t)l * DM * D_IN + C_PG, D_IN, (hf*)(wl + W_ING), DM, 96, scr, r, lane); continue; } r -= IT_ING;
        if (r < IT_UQ) { tr_item(p.in[I_WUQ] + (size_t)l * 256 * 768, 768, (hf*)(wl + W_UP), KUP, 24, scr, r, lane, p.in[I_QNG] + l * 256); continue; } r -= IT_UQ;
        if (r < IT_UKV) { tr_item(p.in[I_WUKV] + (size_t)l * 128 * 1024, 1024, (hf*)(wl + W_UP) + (size_t)768 * KUP + 256, KUP, 32, scr, r, lane, p.in[I_KVNG] + l * 128); continue; } r -= IT_UKV;
        if (r < IT_BRA) { tr_item(p.in[I_WBRA] + (size_t)l * 512 * DM, DM, (hf*)(wl + W_BR), DM, 32, scr, r, lane); continue; } r -= IT_BRA;
        if (r < IT_BRB) { tr_item(p.in[I_WBRB] + (size_t)l * 256 * DM, DM, (hf*)(wl + W_BR) + 512, DM, 32, scr, r, lane); continue; } r -= IT_BRB;
        if (r < IT_BRC) { tr_item(p.in[I_WBRC] + (size_t)l * 256 * DM, DM, (hf*)(wl + W_BR) + 768, DM, 32, scr, r, lane); continue; } r -= IT_BRC;
        if (r < IT_OUT) { tr_item(p.in[I_WOUT] + (size_t)l * DM * DM, DM, (hf*)(wl + W_OUT), DM, 32, scr, r, lane); continue; } r -= IT_OUT;
        if (r < IT_FC1) { tr_item(p.in[I_FC1] + (size_t)l * DM * DFF, DFF, (hf*)(wl + W_FC1), DM, 128, scr, r, lane); continue; } r -= IT_FC1;
        tr_item(p.in[I_FC2] + (size_t)l * DFF * DM, DM, (hf*)(wl + W_FC2), DFF, 32, scr, r, lane);
    }
    const int gt = gw * 64 + lane, NGT = NGW * 64;
    u32x4* z1 = (u32x4*)((hf*)(wl + W_IN1) + (size_t)C_PG * DM);
    for (int i = gt; i < 96 * DM / 8; i += NGT) z1[i] = (u32x4){0u, 0u, 0u, 0u};
    hf* up = (hf*)(wl + W_UP);
    for (int i = gt; i < 768 * 16; i += NGT) { const int n = i / 16, k8 = i % 16; *(u32x4*)(up + (size_t)n * KUP + 256 + k8 * 8) = (u32x4){0u, 0u, 0u, 0u}; }
    for (int i = gt; i < 1024 * 32; i += NGT) { const int n = 768 + i / 32, k8 = i % 32; *(u32x4*)(up + (size_t)n * KUP + k8 * 8) = (u32x4){0u, 0u, 0u, 0u}; }
}

__device__ __forceinline__ void prologue_a(const Frame& F, const Params& p) {
    mod_phase(F, p);
    convert_layer(F, p, 0, p.ws + WS_WT, F.vcu, F.G);
    const int gw = F.vcu * 8 + F.wave, NGW = F.G * 8, lane = F.lane;
    for (int it = gw; it < DEPTH * (SEQ + CTXL); it += NGW) { const int l = it / (SEQ + CTXL), r = it % (SEQ + CTXL); if (r < SEQ) filt_item(p, l, 0, r, lane); else filt_item(p, l, 1, r - SEQ, lane); }
    {
        float* rope = (float*)(p.ws + WS_ROPE);
        const int gt = gw * 64 + lane, NGT = NGW * 64;
        for (int i = gt; i < SEQ * 16; i += NGT) { const int t = i >> 4, j = i & 15; const float pos = (j < 8) ? (float)(t / GRIDW) : (float)(t % GRIDW);
            const float inv = powf(10000.f, -(float)(j & 7) / 8.f); const float a = pos * inv; rope[t * 32 + j] = cosf(a); rope[t * 32 + 16 + j] = sinf(a); }
        if (gt < DEPTH) { const int l = gt; float s1 = 0.f, s2 = 0.f;
            for (int i = 0; i < 32; ++i) { s1 += p.in[I_LQ1][l * 32 + i] * p.in[I_LK1][l * 32 + i]; s2 += p.in[I_LQ2][l * 32 + i] * p.in[I_LK2][l * 32 + i]; }
            const float li = 0.8f - 0.6f * expf(-0.3f * (float)l);
            float* lam = (float*)(p.ws + WS_LAM); lam[2 * l] = expf(s1) - expf(s2) + li; lam[2 * l + 1] = 1.f - li; }
    }
}
__device__ __forceinline__ void prologue_b(const Frame& F, const Params& p) {
    const float* MOD = (const float*)(p.ws + WS_MOD); float* BIAS = (float*)(p.ws + WS_BIAS);
    {
        LAS float* sv = (LAS float*)F.lds;
        constexpr int NCB = DEPTH * NBIAS / 512;
        for (int item = F.vcu; item < NCB * 3; item += F.G) {
            const int cb = item / 3, vg = item % 3;
            const int gcol = cb * 512 + F.tid, l = gcol / NBIAS, n = gcol % NBIAS, n0 = (cb * 512) % NBIAS;
            const int soff = (n0 >= B_FC1) ? 3 * DM : 0;
            __syncthreads();
            for (int i = F.tid; i < 11 * 1024; i += 512) { const int v = vg * 11 + i / 1024, k = i % 1024; sv[i] = MOD[((size_t)l * NMODV + v) * MODW + soff + k]; }
            __syncthreads();
            const float* w; size_t ldw; bool valid = true;
            if (n < B_G) { w = p.in[I_WIN] + (size_t)l * DM * D_IN + n; ldw = D_IN; valid = n < C_PG; }
            else if (n < B_FC1) { w = p.in[I_WIN] + (size_t)l * DM * D_IN + C_PG + (n - B_G); ldw = D_IN; }
            else { w = p.in[I_FC1] + (size_t)l * DM * DFF + (n - B_FC1); ldw = DFF; }
            float acc[11];
#pragma unroll
            for (int v = 0; v < 11; ++v) acc[v] = 0.f;
            if (valid)
#pragma unroll 4
            for (int k = 0; k < DM; k += 4) {
                const float w0 = w[(size_t)k * ldw], w1 = w[(size_t)(k + 1) * ldw], w2 = w[(size_t)(k + 2) * ldw], w3 = w[(size_t)(k + 3) * ldw];
#pragma unroll
                for (int v = 0; v < 11; ++v) { const f32x4 sx = *(const LAS f32x4*)(sv + v * 1024 + k);
                    acc[v] = fmaf(sx[0], w0, acc[v]); acc[v] = fmaf(sx[1], w1, acc[v]); acc[v] = fmaf(sx[2], w2, acc[v]); acc[v] = fmaf(sx[3], w3, acc[v]); }
            }
#pragma unroll
            for (int v = 0; v < 11; ++v) BIAS[((size_t)l * NMODV + vg * 11 + v) * NBIAS + n] = acc[v];
        }
        __syncthreads();
    }
    const int gw = F.vcu * 8 + F.wave, NGW = F.G * 8, lane = F.lane;
    {
        float* GS = (float*)(p.ws + WS_GS);
        const int gt = gw * 64 + lane, NGT = NGW * 64;
        for (int i = gt; i < DEPTH * 2 * NMODV * DM; i += NGT) { const int c = i % DM, v = (i / DM) % NMODV, wh = (i / (DM * NMODV)) % 2, l = i / (DM * NMODV * 2);
            const float g = wh ? p.in[I_NFG][l * DM + c] : p.in[I_NMG][l * DM + c];
            GS[i] = g * (1.f + MOD[((size_t)l * NMODV + v) * MODW + (wh ? 4 * DM : DM) + c]); }
    }
    {
        hf* XS = (hf*)p.out; hf* X16 = (hf*)(p.ws + WS_X16); float* ss = (float*)(p.ws + WS_SS) + (size_t)SS_1 * MTOT * 4;
        f32x4 g[4];
#pragma unroll
        for (int j = 0; j < 4; ++j) g[j] = *(const f32x4*)(p.in[I_NMG] + 4 * lane + 256 * j);
        for (int row = gw; row < MTOT; row += NGW) {
            const bool lat = row < NLAT; const float* xr = lat ? p.in[I_X] + (size_t)row * DM : p.in[I_CTX] + (size_t)(row - NLAT) * DM;
            const int v = lat ? (row >> 11) : NB; const float* mv = MOD + (size_t)v * MODW + DM;
            float sq = 0.f; hf* hr = XS + (size_t)row * DM; hf* xh = X16 + (size_t)row * DM;
#pragma unroll
            for (int j = 0; j < 4; ++j) { const f32x4 x = *(const f32x4*)(xr + 4 * lane + 256 * j); const f32x4 sc = *(const f32x4*)(mv + 4 * lane + 256 * j);
                sq += (x[0] * x[0] + x[1] * x[1]) + (x[2] * x[2] + x[3] * x[3]);
                const f32x4 o = x * (g[j] * (sc + 1.f)); u32x2 w; w.x = pkhb(o[0], o[1]); w.y = pkhb(o[2], o[3]); *(u32x2*)(hr + 4 * lane + 256 * j) = w;
                u32x2 w2; w2.x = pkh(x[0], x[1]); w2.y = pkh(x[2], x[3]); *(u32x2*)(xh + 4 * lane + 256 * j) = w2; }
            sq = wave_sum(sq);
            if (lane == 0) *(f32x4*)(ss + 4 * (size_t)row) = (f32x4){sq, 0.f, 0.f, 0.f};
        }
    }
}

__device__ __forceinline__ void norm_phase(const Frame& F, const float* xs_lat, const float* xs_ctx, int nrows, const float* gain, const float* modl, int sh_off, int sc_off, hf* H) {
    const int gw = F.vcu * 8 + F.wave, NGW = F.G * 8, lane = F.lane;
    f32x4 g[4];
#pragma unroll
    for (int j = 0; j < 4; ++j) g[j] = *(const f32x4*)(gain + 4 * lane + 256 * j);
    for (int row = gw; row < nrows; row += NGW) {
        const bool lat = row < NLAT; const float* xr = lat ? xs_lat + (size_t)row * DM : xs_ctx + (size_t)(row - NLAT) * DM;
        const int v = lat ? (row >> 11) : NB; const float* mv = modl + (size_t)v * MODW;
        f32x4 x[4]; float ss = 0.f;
#pragma unroll
        for (int j = 0; j < 4; ++j) { x[j] = *(const f32x4*)(xr + 4 * lane + 256 * j); ss += (x[j][0] * x[j][0] + x[j][1] * x[j][1]) + (x[j][2] * x[j][2] + x[j][3] * x[j][3]); }
        const float rstd = rsqrtf(wave_sum(ss) * (1.f / DM) + EPS);
        hf* hr = H + (size_t)row * DM;
#pragma unroll
        for (int j = 0; j < 4; ++j) { const f32x4 sh = *(const f32x4*)(mv + sh_off + 4 * lane + 256 * j), sc = *(const f32x4*)(mv + sc_off + 4 * lane + 256 * j);
            const f32x4 y = (x[j] * rstd) * g[j]; const f32x4 o = y * (sc + 1.f) + sh;
            u32x2 w; w.x = pkh(o[0], o[1]); w.y = pkh(o[2], o[3]); *(u32x2*)(hr + 4 * lane + 256 * j) = w; }
    }
}
__device__ __forceinline__ void final_norm_phase(const Frame& F, const hf* X16, float* out, const float* gain, const float* ss) {
    const int gw = F.vcu * 8 + F.wave, NGW = F.G * 8, lane = F.lane;
    f32x4 g[4];
#pragma unroll
    for (int j = 0; j < 4; ++j) g[j] = *(const f32x4*)(gain + 4 * lane + 256 * j);
    for (int row = gw; row < NLAT; row += NGW) {
        const hf* xr = X16 + (size_t)row * DM; float* orow = out + (size_t)row * DM; const float rstd = rstd4(ss, row);
#pragma unroll
        for (int j = 0; j < 4; ++j) { const hf4 xh = *(const hf4*)(xr + 4 * lane + 256 * j); const f32x4 x = {(float)xh[0], (float)xh[1], (float)xh[2], (float)xh[3]};
            *(f32x4*)(orow + 4 * lane + 256 * j) = (x * rstd) * g[j]; }
    }
}

__device__ __forceinline__ void prep_rope(const Frame& F, const Params& p) {
    const int gw = F.vcu * 8 + F.wave, NGW = F.G * 8, lane = F.lane;
    hf* KR = (hf*)(p.ws + A_KR); hf* DK = (hf*)(p.ws + A_DK); const float* rope = (const float*)(p.ws + WS_ROPE);
    const int hh = lane >> 3, i0 = 2 * (lane & 7);
    for (int row0 = gw * 4; row0 < NLAT; row0 += NGW * 4) {
        hf2 a[4], b[4]; f32x2 c[4], sn[4]; float y1[4], y2[4], cc[4], ss[4];
#pragma unroll
        for (int q = 0; q < 4; ++q) { const int row = row0 + q, t = row & (SEQ - 1); const hf* dk = DK + (size_t)row * 256 + hh * 32 + i0;
            a[q] = *(const hf2*)dk; b[q] = *(const hf2*)(dk + 16); c[q] = *(const f32x2*)(rope + t * 32 + i0); sn[q] = *(const f32x2*)(rope + t * 32 + 16 + i0);
            if (lane < 16) { const hf* kr = KR + (size_t)row * 32 + lane; y1[q] = (float)kr[0]; y2[q] = (float)kr[16]; cc[q] = rope[t * 32 + lane]; ss[q] = rope[t * 32 + 16 + lane]; } }
#pragma unroll
        for (int q = 0; q < 4; ++q) { const int row = row0 + q; hf* dk = DK + (size_t)row * 256 + hh * 32 + i0;
            const float x1[2] = {(float)a[q][0], (float)a[q][1]}, x2[2] = {(float)b[q][0], (float)b[q][1]};
            *(unsigned*)dk = pkh(x1[0] * c[q][0] - x2[0] * sn[q][0], x1[1] * c[q][1] - x2[1] * sn[q][1]);
            *(unsigned*)(dk + 16) = pkh(x2[0] * c[q][0] + x1[0] * sn[q][0], x2[1] * c[q][1] + x1[1] * sn[q][1]);
            if (lane < 16) { hf* kr = KR + (size_t)row * 32 + lane; kr[0] = (hf)(y1[q] * cc[q] - y2[q] * ss[q]); kr[16] = (hf)(y2[q] * cc[q] + y1[q] * ss[q]); } }
    }
}
__device__ __forceinline__ void prep_hyena(const Frame& F, const Params& p, int l, bool with_ctx) {
    constexpr int INP = 784;
    constexpr int OUTP = 33;
    constexpr int OFF_OU = 66 * INP, OFF_OX = OFF_OU + 128 * OUTP * 4;
    const hf* PHY = (const hf*)(p.ws + A_PHY);
    LAS unsigned char* lds = F.lds; const int tid = F.tid;
    const float* cw = p.in[I_HCW] + (size_t)l * 3 * 768; const float* cb = p.in[I_HCB] + (size_t)l * 768;
    constexpr int U_LAT = NB * (SEQ / 64) * 2, U_CTX = NB * (CTXL / 64) * 2;
    const int nunit = U_LAT + (with_ctx ? U_CTX : 0);
    for (int un = F.vcu; un < nunit; un += F.G) {
        const bool ctx = un >= U_LAT; int r = ctx ? un - U_LAT : un; const int L = ctx ? CTXL : SEQ, ntile = L / 64;
        const int ch = r & 1; r >>= 1; const int tt = r % ntile, b = r / ntile;
        const int t0 = tt * 64; const size_t rowbase = ctx ? (size_t)NLAT + (size_t)b * CTXL : (size_t)b * SEQ;
        hf* dU = (hf*)((unsigned char*)p.out + (ctx ? O_UTC : O_UT)); hf* dX = (hf*)((unsigned char*)p.out + (ctx ? O_X0TC : O_X0T));
        __syncthreads();
        {
            u32x4 tmp[7];
#pragma unroll
            for (int k = 0; k < 7; ++k) { const int i = tid + 512 * k, rr = i / 48, q = i % 48, seg = q >> 4, c16 = q & 15; const int t = t0 - 1 + rr;
                tmp[k] = (u32x4){0u, 0u, 0u, 0u};
                if (i < 66 * 48 && t >= 0 && t < L) tmp[k] = *(const u32x4*)(PHY + (rowbase + t) * 768 + seg * 256 + ch * 128 + c16 * 8); }
#pragma unroll
            for (int k = 0; k < 7; ++k) { const int i = tid + 512 * k, rr = i / 48, q = i % 48, seg = q >> 4, c16 = q & 15;
                if (i < 66 * 48) *(LAS u32x4*)(lds + rr * INP + seg * 256 + c16 * 16) = tmp[k]; }
        }
        __syncthreads();
        {
            const int c = tid & 127, tg = tid >> 7, cg = ch * 128 + c;
            const float a0 = cw[cg], a1 = cw[768 + cg], a2 = cw[1536 + cg], ab = cb[cg];
            const float b0 = cw[256 + cg], b1 = cw[768 + 256 + cg], b2 = cw[1536 + 256 + cg], bb = cb[256 + cg];
            const float v0 = cw[512 + cg], v1 = cw[768 + 512 + cg], v2 = cw[1536 + 512 + cg], vb = cb[512 + cg];
            const LAS hf* in = (const LAS hf*)(lds + (16 * tg) * INP) + c;
            float p0 = (float)in[0], p1 = (float)in[128], p2 = (float)in[256];
            float c0 = (float)in[INP / 2], c1 = (float)in[INP / 2 + 128], c2 = (float)in[INP / 2 + 256];
            LAS hf* ou = (LAS hf*)(lds + OFF_OU) + c * (OUTP * 2) + 16 * tg; LAS hf* ox = (LAS hf*)(lds + OFF_OX) + c * (OUTP * 2) + 16 * tg;
#pragma unroll
            for (int j = 0; j < 16; ++j) { const LAS hf* nx = in + (j + 2) * (INP / 2);
                const float n0 = (float)nx[0], n1 = (float)nx[128], n2 = (float)nx[256];
                const float x0 = a0 * p0 + a1 * c0 + a2 * n0 + ab, x1 = b0 * p1 + b1 * c1 + b2 * n1 + bb, vv = v0 * p2 + v1 * c2 + v2 * n2 + vb;
                ou[j] = (hf)(vv * x1); ox[j] = (hf)x0;
                p0 = c0; p1 = c1; p2 = c2; c0 = n0; c1 = n1; c2 = n2; }
        }
        __syncthreads();
        {
            const int c = tid >> 2, q = tid & 3; const size_t go = ((size_t)(ch * 128 + c) * NB + b) * L + t0 + 16 * q;
            const LAS unsigned* su = (const LAS unsigned*)(lds + OFF_OU) + c * OUTP + 8 * q; const LAS unsigned* sx = (const LAS unsigned*)(lds + OFF_OX) + c * OUTP + 8 * q;
            u32x4 w0 = {su[0], su[1], su[2], su[3]}, w1 = {su[4], su[5], su[6], su[7]};
            *(u32x4*)(dU + go) = w0; *(u32x4*)(dU + go + 8) = w1;
            u32x4 y0 = {sx[0], sx[1], sx[2], sx[3]}, y1 = {sx[4], sx[5], sx[6], sx[7]};
            *(u32x4*)(dX + go) = y0; *(u32x4*)(dX + go + 8) = y1;
        }
    }
    __syncthreads();
}

namespace att {
#ifndef PROF_SEL
#define PROF_SEL -1
#endif
#define ATT_MARK(b) do { if (PROF_SEL >= 0 && F.tid == 0) { volatile LAS unsigned* _pf = (volatile LAS unsigned*)(F.lds + LDS_BYTES - 512); const unsigned _t = (unsigned)__builtin_amdgcn_s_memrealtime(); _pf[(b)] += _t - _pf[32]; _pf[32] = _t; } } while (0)
__device__ __forceinline__ int crow(int r, int hi) { return (r & 3) + 8 * (r >> 2) + 4 * hi; }
#define SBAR() __builtin_amdgcn_sched_barrier(0)
constexpr float THR2 = 8.f * 1.4426950408889634f;
constexpr int KS_MLA = 208, KS_DF = 80;
constexpr int VS = 192, VB = 64 * VS;
constexpr int OFF_V = 32768;
template <int OFF> __device__ __forceinline__ s16x4 tr_read(int vb) {
    s16x4 r; asm volatile("ds_read_b64_tr_b16 %0, %1 offset:%2" : "=&v"(r) : "v"(vb), "i"(OFF) : "memory"); return r;
}
__device__ __forceinline__ int kpos(int key) { return (key & ~0xC) | ((key & 4) << 1) | ((key & 8) >> 1); }

template <int ND0, int KS>
__device__ __forceinline__ void qkt(f32x16& p0, f32x16& p1, const LAS unsigned char* Ks, const hf8* qr, int r32, int hi, const f32x16& negm) {
#pragma unroll
    for (int d0 = 0; d0 < ND0; ++d0) { const int cb = (d0 * 16 + hi * 8) * 2;
        const hf8 b0 = *(const LAS hf8*)(Ks + r32 * KS + cb), b1 = *(const LAS hf8*)(Ks + (32 + r32) * KS + cb);
        if (d0 == 0) { p0 = __builtin_amdgcn_mfma_f32_32x32x16_f16(b0, qr[0], negm, 0, 0, 0); p1 = __builtin_amdgcn_mfma_f32_32x32x16_f16(b1, qr[0], negm, 0, 0, 0); }
        else { p0 = __builtin_amdgcn_mfma_f32_32x32x16_f16(b0, qr[d0], p0, 0, 0, 0); p1 = __builtin_amdgcn_mfma_f32_32x32x16_f16(b1, qr[d0], p1, 0, 0, 0); } }
}
__device__ __forceinline__ float max3f(float a, float b, float c) { float r; asm("v_max3_f32 %0, %1, %2, %3" : "=v"(r) : "v"(a), "v"(b), "v"(c)); return r; }
__device__ __forceinline__ float max2f(float a, float b) { float r; asm("v_max_f32_e32 %0, %1, %2" : "=v"(r) : "v"(a), "v"(b)); return r; }
__device__ __forceinline__ float max16(const f32x16& p) { float r, t;
    asm("v_max3_f32 %0, %2, %3, %4\n\tv_max3_f32 %1, %10, %11, %12\n\tv_max3_f32 %0, %0, %5, %6\n\tv_max3_f32 %1, %1, %13, %14\n\tv_max3_f32 %0, %0, %7, %8\n\tv_max3_f32 %1, %1, %15, %16\n\tv_max3_f32 %0, %0, %9, %17\n\tv_max_f32_e32 %0, %0, %1"
        : "=&v"(r), "=&v"(t) : "v"(p[0]), "v"(p[1]), "v"(p[2]), "v"(p[3]), "v"(p[4]), "v"(p[5]), "v"(p[6]), "v"(p[7]), "v"(p[8]), "v"(p[9]), "v"(p[10]), "v"(p[11]), "v"(p[12]), "v"(p[13]), "v"(p[14]), "v"(p[15]));
    return r; }
__device__ __forceinline__ hf8 pack8(const f32x16& p, int b) { u32x4 w = {pkh(p[b], p[b + 1]), pkh(p[b + 2], p[b + 3]), pkh(p[b + 4], p[b + 5]), pkh(p[b + 6], p[b + 7])}; return __builtin_bit_cast(hf8, w); }
__device__ __forceinline__ void sm_max(f32x16& p0, f32x16& p1, float& m, float& l, f32x16& o0, f32x16& o1, f32x16& negm, const bool first) {
    float pmax = max2f(max16(p0), max16(p1));
    { auto rr = __builtin_amdgcn_permlane32_swap(__float_as_uint(pmax), __float_as_uint(pmax), false, false);
      pmax = max2f(__uint_as_float(rr[0]), __uint_as_float(rr[1])); }
    if (first || __any(pmax > THR2)) {
        const float delta = first ? pmax : fmaxf(pmax, 0.f);
        if (!first) { const float alpha = __builtin_amdgcn_exp2f(-delta); l *= alpha;
#pragma unroll
            for (int r = 0; r < 16; ++r) { o0[r] *= alpha; o1[r] *= alpha; } }
#pragma unroll
        for (int r = 0; r < 16; ++r) { p0[r] -= delta; p1[r] -= delta; }
        m += delta;
#pragma unroll
        for (int r = 0; r < 16; ++r) negm[r] = -m;
        asm volatile("" : "+v"(negm));
    }
}
__device__ __forceinline__ void sm_exp(f32x16& p0, f32x16& p1, const float m, float& l, hf8& pf0, hf8& pf1, hf8& pf2, hf8& pf3) {
#pragma unroll
    for (int r = 0; r < 16; ++r) { p0[r] = __builtin_amdgcn_exp2f(p0[r]); p1[r] = __builtin_amdgcn_exp2f(p1[r]); }
    float ps0 = p0[0] + p1[0], ps1 = p0[1] + p1[1], ps2 = p0[2] + p1[2], ps3 = p0[3] + p1[3];
#pragma unroll
    for (int r = 4; r < 16; r += 4) { ps0 += p0[r] + p1[r]; ps1 += p0[r + 1] + p1[r + 1]; ps2 += p0[r + 2] + p1[r + 2]; ps3 += p0[r + 3] + p1[r + 3]; }
    l += (ps0 + ps1) + (ps2 + ps3);
    pf0 = pack8(p0, 0); pf1 = pack8(p0, 8); pf2 = pack8(p1, 0); pf3 = pack8(p1, 8);
}
__device__ __forceinline__ void pv(const hf8 pf0, const hf8 pf1, const hf8 pf2, const hf8 pf3, f32x16& o0, f32x16& o1, const LAS unsigned char* Vt, int r32, int hi) {
    const int lg = (int)(threadIdx.x & 15), vq = lg >> 2, vp4 = lg & 3;
    const int vbase = (int)(unsigned)(uintptr_t)Vt + (4 * hi + vq) * VS + (16 * ((int)(threadIdx.x >> 4) & 1) + 4 * vp4) * 2;
#define PVRD(ks, L0, H0, L1, H1) s16x4 L0 = tr_read<(16 * (ks)) * VS>(vbase), H0 = tr_read<(16 * (ks) + 8) * VS>(vbase), L1 = tr_read<(16 * (ks)) * VS + 64>(vbase), H1 = tr_read<(16 * (ks) + 8) * VS + 64>(vbase)
#define PVMM(N, L0, H0, L1, H1, pf) do { asm volatile("s_waitcnt lgkmcnt(" #N ")" : "+v"(L0), "+v"(H0), "+v"(L1), "+v"(H1) :: "memory"); \
        const hf8 a0 = __builtin_bit_cast(hf8, (short __attribute__((ext_vector_type(8)))){L0[0], L0[1], L0[2], L0[3], H0[0], H0[1], H0[2], H0[3]}); \
        const hf8 a1 = __builtin_bit_cast(hf8, (short __attribute__((ext_vector_type(8)))){L1[0], L1[1], L1[2], L1[3], H1[0], H1[1], H1[2], H1[3]}); \
        o0 = __builtin_amdgcn_mfma_f32_32x32x16_f16(a0, pf, o0, 0, 0, 0); o1 = __builtin_amdgcn_mfma_f32_32x32x16_f16(a1, pf, o1, 0, 0, 0); } while (0)
    PVRD(0, a0l, a0h, a1l, a1h); PVRD(1, b0l, b0h, b1l, b1h);
    PVMM(4, a0l, a0h, a1l, a1h, pf0);
    PVRD(2, c0l, c0h, c1l, c1h);
    PVMM(4, b0l, b0h, b1l, b1h, pf1);
    PVRD(3, d0l, d0h, d1l, d1h);
    PVMM(4, c0l, c0h, c1l, c1h, pf2);
    PVMM(0, d0l, d0h, d1l, d1h, pf3);
#undef PVRD
#undef PVMM
#define PVK(ks, pf)
#undef PVK
}

template <bool MLA>
__device__ __forceinline__ void attn_pass(const Frame& F, const Params& p, int hq, int hv, int qrow0, int qpos0, int klat0, int nlat, int kctx0, f32x16& o0, f32x16& o1, float& inv) {
    constexpr int DK = MLA ? 96 : 32, ND0 = DK / 16, KS = MLA ? KS_MLA : KS_DF, KB = 64 * KS;
    constexpr float SCALE = MLA ? MLA_SCALE : DF_SCALE, C = SCALE * 1.4426950408889634f;
    const int tid = F.tid, wid = F.wave, lane = F.lane, r32 = lane & 31, hi = lane >> 5;
    const hf* QKV = (const hf*)(p.ws + A_QKV); const hf* KRb = (const hf*)(p.ws + A_KR);
    const hf* DQ = (const hf*)(p.ws + A_DQ); const hf* DKb = (const hf*)(p.ws + A_DK); const hf* DVb = (const hf*)(p.ws + A_DV);
    const float* rope = (const float*)(p.ws + WS_ROPE);
    LAS unsigned char* lds = F.lds;
    hf8 qr[ND0];
    {
        const int qrow = qrow0 + wid * 32 + r32;
        const hf* qp = MLA ? QKV + (size_t)qrow * NUP + hq * 96 + hi * 8 : DQ + (size_t)qrow * 256 + hq * 32 + hi * 8;
        hf8 raw[ND0];
#pragma unroll
        for (int d0 = 0; d0 < ND0; ++d0) raw[d0] = *(const hf8*)(qp + d0 * 16);
        f32x4 c0 = {1.f, 1.f, 1.f, 1.f}, c1 = c0, s0 = {0.f, 0.f, 0.f, 0.f}, s1 = s0;
        if (qpos0 >= 0) { const int t = qpos0 + wid * 32 + r32;
            c0 = *(const f32x4*)(rope + t * 32 + hi * 8); c1 = *(const f32x4*)(rope + t * 32 + hi * 8 + 4);
            s0 = *(const f32x4*)(rope + t * 32 + 16 + hi * 8); s1 = *(const f32x4*)(rope + t * 32 + 16 + hi * 8 + 4); }
#pragma unroll
        for (int d0 = 0; d0 < ND0 - 2; ++d0) {
#pragma unroll
            for (int j = 0; j < 8; ++j) qr[d0][j] = (hf)((float)raw[d0][j] * C); }
#pragma unroll
        for (int j = 0; j < 8; ++j) { const float cc = j < 4 ? c0[j & 3] : c1[j & 3], sn = j < 4 ? s0[j & 3] : s1[j & 3]; const float a = (float)raw[ND0 - 2][j], b = (float)raw[ND0 - 1][j];
            qr[ND0 - 2][j] = (hf)((a * cc - b * sn) * C); qr[ND0 - 1][j] = (hf)((b * cc + a * sn) * C); }
    }
    const int k1r = MLA ? (tid >> 3) : ((tid & 255) >> 2), k1c = MLA ? (tid & 7) * 8 : (tid & 3) * 8;
    const int k2r = (tid & 255) >> 2, k2c = (tid & 3) * 8;
    const int vr_ = tid >> 3, vc_ = (tid & 7) * 8;
    const bool klo = tid < 256;
    struct Stg { u32x4 v, k1, k2; };
    Stg sA, sB; sA.v = sA.k1 = sA.k2 = sB.v = sB.k1 = sB.k2 = (u32x4){0u, 0u, 0u, 0u};
    const int ntile = nlat + 4;
#define KROW0(j) (((j) < nlat) ? klat0 + (j) * 64 : kctx0 + ((j) - nlat) * 64)
#define A_LOADK(S, j) do { const int kr0 = KROW0(j); \
        if (MLA) { S.k1 = *(const u32x4*)(QKV + (size_t)(kr0 + k1r) * NUP + 768 + hq * 128 + k1c); S.k2 = *(const u32x4*)(KRb + (size_t)(kr0 + k2r) * 32 + k2c); } \
        else S.k1 = *(const u32x4*)(DKb + (size_t)(kr0 + k1r) * 256 + hq * 32 + k1c); } while (0)
#define A_LOADV(S, j) do { const int kr0 = KROW0(j); \
        if (MLA) S.v = *(const u32x4*)(QKV + (size_t)(kr0 + vr_) * NUP + 768 + hv * 128 + 64 + vc_); else S.v = *(const u32x4*)(DVb + (size_t)(kr0 + vr_) * 256 + hv * 64 + vc_); } while (0)
#define A_WRITEK(S, b) do { *(LAS u32x4*)(lds + (b) * KB + k1r * KS + k1c * 2) = S.k1; if (MLA) *(LAS u32x4*)(lds + (b) * KB + k2r * KS + 128 + k2c * 2) = S.k2; } while (0)
#define A_WRITEV(S, b) do { *(LAS u32x4*)(lds + OFF_V + (b) * VB + vr_ * VS + vc_ * 2) = S.v; } while (0)
    float m_reg = 0.f, l_reg = 0.f;
    f32x16 negm = f32x16{}; asm volatile("" : "+v"(negm));
    o0 = f32x16{}; o1 = f32x16{};
    f32x16 pA0, pA1, pB0, pB1;
    __syncthreads();
    const int nt1 = ntile - 1;
#define TCL(j) (((j) < nt1) ? (j) : nt1)
    A_LOADK(sA, 0); A_LOADV(sA, 0); A_LOADK(sB, 1);
    A_WRITEK(sA, 0); A_WRITEV(sA, 0); A_WRITEK(sB, 1);
    A_LOADK(sA, TCL(2));
    A_LOADV(sA, 1);
    __syncthreads();
    qkt<ND0, KS>(pA0, pA1, lds, qr, r32, hi, negm);
    hf8 f0, f1, f2, f3;
    if (wid >= 4) __syncthreads();
    for (int j = 0; j < ntile; j += 2) {
        A_LOADK(sB, TCL(j + 3)); A_LOADV(sB, TCL(j + 2));
        sm_max(pA0, pA1, m_reg, l_reg, o0, o1, negm, j == 0);
        sm_exp(pA0, pA1, m_reg, l_reg, f0, f1, f2, f3);
        __syncthreads();
        qkt<ND0, KS>(pB0, pB1, lds + KB, qr, r32, hi, negm);
        pv(f0, f1, f2, f3, o0, o1, lds + OFF_V, r32, hi);
        A_WRITEK(sA, 0); A_WRITEV(sA, 1);
        __syncthreads();
        A_LOADK(sA, TCL(j + 4)); A_LOADV(sA, TCL(j + 3));
        sm_max(pB0, pB1, m_reg, l_reg, o0, o1, negm, false);
        sm_exp(pB0, pB1, m_reg, l_reg, f0, f1, f2, f3);
        __syncthreads();
        qkt<ND0, KS>(pA0, pA1, lds, qr, r32, hi, negm);
        pv(f0, f1, f2, f3, o0, o1, lds + OFF_V + VB, r32, hi);
        A_WRITEK(sB, 1); A_WRITEV(sB, 0);
        __syncthreads();
    }
    if (wid < 4) __syncthreads();
#undef TCL
#undef KROW0
#undef A_LOADK
#undef A_LOADV
#undef A_WRITEK
#undef A_WRITEV
    const float lt = l_reg + __shfl_xor(l_reg, 32); inv = __builtin_amdgcn_rcpf(lt);
}
template <bool MLA>
__device__ __forceinline__ void attn_unit(const Frame& F, const Params& p, int l, int h, int qrow0, int qpos0, int klat0, int nlat, int kctx0) {
    const int wid = F.wave, lane = F.lane, r32 = lane & 31, hi = lane >> 5;
    hf* Y = (hf*)(p.ws + A_Y);
    const size_t yrow = (size_t)(qrow0 + wid * 32 + r32) * DM;
    if constexpr (MLA) {
        f32x16 o0, o1; float inv;
        attn_pass<true>(F, p, h, h, qrow0, qpos0, klat0, nlat, kctx0, o0, o1, inv);
#pragma unroll
        for (int g = 0; g < 4; ++g) { u32x2 w; w.x = pkhb(o0[4 * g] * inv, o0[4 * g + 1] * inv); w.y = pkhb(o0[4 * g + 2] * inv, o0[4 * g + 3] * inv); *(u32x2*)(Y + yrow + h * 64 + 8 * g + 4 * hi) = w; }
#pragma unroll
        for (int g = 0; g < 4; ++g) { u32x2 w; w.x = pkhb(o1[4 * g] * inv, o1[4 * g + 1] * inv); w.y = pkhb(o1[4 * g + 2] * inv, o1[4 * g + 3] * inv); *(u32x2*)(Y + yrow + h * 64 + 32 + 8 * g + 4 * hi) = w; }
    } else {
        const float lam = ((const float*)(p.ws + WS_LAM))[2 * l], oml = ((const float*)(p.ws + WS_LAM))[2 * l + 1];
        f32x16 a0, a1;
        LAS float* park = (LAS float*)(F.lds + 65536 + wid * 8192) + lane;
        { f32x16 o0, o1; float inv; attn_pass<false>(F, p, 2 * h, h, qrow0, qpos0, klat0, nlat, kctx0, o0, o1, inv);
#pragma unroll
          for (int r = 0; r < 16; ++r) { park[r * 64] = o0[r] * inv; park[(16 + r) * 64] = o1[r] * inv; } }
        { f32x16 o0, o1; float inv; attn_pass<false>(F, p, 2 * h + 1, h, qrow0, qpos0, klat0, nlat, kctx0, o0, o1, inv);
#pragma unroll
          for (int r = 0; r < 16; ++r) { a0[r] = park[r * 64] - o0[r] * (lam * inv); a1[r] = park[(16 + r) * 64] - o1[r] * (lam * inv); } }
        float ss = 0.f;
#pragma unroll
        for (int r = 0; r < 16; ++r) ss += a0[r] * a0[r] + a1[r] * a1[r];
        ss += __shfl_xor(ss, 32);
        const float rs = rsqrtf(ss * (1.f / 64.f) + EPS) * oml;
#pragma unroll
        for (int g = 0; g < 4; ++g) { const f32x4 gg = *(const f32x4*)(p.in[I_SUBG] + l * 64 + 8 * g + 4 * hi);
            u32x2 w; w.x = pkhb(a0[4 * g] * rs * gg[0], a0[4 * g + 1] * rs * gg[1]); w.y = pkhb(a0[4 * g + 2] * rs * gg[2], a0[4 * g + 3] * rs * gg[3]); *(u32x2*)(Y + yrow + 768 + h * 64 + 8 * g + 4 * hi) = w; }
#pragma unroll
        for (int g = 0; g < 4; ++g) { const f32x4 gg = *(const f32x4*)(p.in[I_SUBG] + l * 64 + 32 + 8 * g + 4 * hi);
            u32x2 w; w.x = pkhb(a1[4 * g] * rs * gg[0], a1[4 * g + 1] * rs * gg[1]); w.y = pkhb(a1[4 * g + 2] * rs * gg[2], a1[4 * g + 3] * rs * gg[3]); *(u32x2*)(Y + yrow + 768 + h * 64 + 32 + 8 * g + 4 * hi) = w; }
    }
}
}

#define HY_MARK(b) do { if (PROF_SEL >= 0 && F.tid == 0) { volatile LAS unsigned* _pf = (volatile LAS unsigned*)(F.lds + LDS_BYTES - 512); const unsigned _t = (unsigned)__builtin_amdgcn_s_memrealtime(); _pf[(b)] += _t - _pf[32]; _pf[32] = _t; } } while (0)
template <int L>
__device__ __forceinline__ void hyena_unit(const Frame& F, const hf* Rrow  , const hf* U  , const hf* X0  , hf* Ycol  ) {
    constexpr int NM = L / 256, RL = 2 * L, SH = (L > 1024) ? 1024 : L, NH = L / SH, US = SH * 2 + 16;
    constexpr int OFF_U = 8 * RL * 2;
    constexpr int XP = L * 2 + 16;
    static_assert(OFF_U + 32 * US <= LDS_MISC && 32 * XP <= LDS_MISC, "hyena LDS");
    const int tid = F.tid, w = F.wave, lane = F.lane, i32 = lane & 31, hi = lane >> 5;
    LAS unsigned char* lds = F.lds;
    __syncthreads();
    for (int i = tid; i < RL / 8; i += 512) *(LAS u32x4*)(lds + i * 16) = *(const u32x4*)(Rrow + i * 8);
    __syncthreads();
    {
        const LAS unsigned* src = (const LAS unsigned*)lds;
#pragma unroll 1
        for (int idx = tid; idx < 7 * (RL / 8); idx += 512) { const int cw = 1 + idx / (RL / 8), c4 = (idx % (RL / 8)) * 4;
            const int k0 = c4 - ((cw + 1) >> 1); unsigned d[5];
#pragma unroll
            for (int e = 0; e < 5; ++e) { const int k = k0 + e; d[e] = (k >= 0 && k < RL / 2) ? src[k] : 0u; }
            u32x4 o;
            if (cw & 1) { o.x = (d[0] >> 16) | (d[1] << 16); o.y = (d[1] >> 16) | (d[2] << 16); o.z = (d[2] >> 16) | (d[3] << 16); o.w = (d[3] >> 16) | (d[4] << 16); }
            else { o.x = d[0]; o.y = d[1]; o.z = d[2]; o.w = d[3]; }
            *(LAS u32x4*)(lds + cw * (RL * 2) + c4 * 4) = o; }
    }
    HY_MARK(22);
    f32x16 acc[NM];
#pragma unroll
    for (int m = 0; m < NM; ++m) acc[m] = f32x16{};
    const LAS unsigned char* cpy = lds + w * (RL * 2);
    for (int half = 0; half < NH; ++half) {
        __syncthreads();
        {
            constexpr int NPC = 32 * (SH / 8) / 512, NB4 = NPC > 4 ? 4 : NPC;
            int tq = tid; asm volatile("" : "+v"(tq));
#pragma unroll
            for (int k0 = 0; k0 < NPC; k0 += NB4) { u32x4 tmp[NB4];
#pragma unroll
                for (int k = 0; k < NB4; ++k) { const int idx = tq + 512 * (k0 + k), b = idx / (SH / 8), pc = idx % (SH / 8); tmp[k] = *(const u32x4*)(U + (size_t)b * L + half * SH + pc * 8); }
#pragma unroll
                for (int k = 0; k < NB4; ++k) { const int idx = tq + 512 * (k0 + k), b = idx / (SH / 8), pc = idx % (SH / 8); *(LAS u32x4*)(lds + OFF_U + b * US + pc * 16) = tmp[k]; }
                asm volatile("" ::: "memory"); }
        }
        __syncthreads();
#pragma unroll 2
        for (int jl = 0; jl < SH / 16; ++jl) {
            const int j = half * (SH / 16) + jl;
            const hf8 bf = *(const LAS hf8*)(lds + OFF_U + i32 * US + (jl * 16 + hi * 8) * 2);
            const int x0 = L + 16 * j + 8 * hi - 8 * i32;
#pragma unroll
            for (int m = 0; m < NM; ++m) { const hf8 af = *(const LAS hf8*)(cpy + (x0 - 256 * m) * 2);
                acc[m] = __builtin_amdgcn_mfma_f32_32x32x16_f16(af, bf, acc[m], 0, 0, 0); }
        }
    }
    __syncthreads();
    HY_MARK(23);
    {
        constexpr int NPC = 32 * (L / 8) / 512, NB8 = NPC > 4 ? 4 : NPC;
        int tq = tid; asm volatile("" : "+v"(tq));
#pragma unroll
        for (int k0 = 0; k0 < NPC; k0 += NB8) { u32x4 tmp[NB8];
#pragma unroll
            for (int k = 0; k < NB8; ++k) { const int idx = tq + 512 * (k0 + k), b = idx / (L / 8), pc = idx % (L / 8); tmp[k] = *(const u32x4*)(X0 + (size_t)b * L + pc * 8); }
#pragma unroll
            for (int k = 0; k < NB8; ++k) { const int idx = tq + 512 * (k0 + k), b = idx / (L / 8), pc = idx % (L / 8); *(LAS u32x4*)(lds + b * XP + pc * 16) = tmp[k]; }
            asm volatile("" ::: "memory"); }
    }
    __syncthreads();
    HY_MARK(24);
    const LAS hf* x0p = (const LAS hf*)(lds + i32 * XP) + w + 32 * hi;
    hf* yp = Ycol + ((size_t)i32 * L + w + 32 * hi) * DM;
#pragma unroll
    for (int m = 0; m < NM; ++m) {
#pragma unroll
        for (int r = 0; r < 16; ++r) { const int tt = 256 * m + 8 * ((r & 3) + 8 * (r >> 2));
            const float x0v = (float)x0p[tt];
            { const float yv = x0v * acc[m][r]; unsigned ub = __float_as_uint(yv); ub += 0x7fffu + ((ub >> 16) & 1u); yp[(size_t)tt * DM] = (hf)__uint_as_float(ub & 0xffff0000u); } }
        asm volatile("" ::: "memory");
    }
    HY_MARK(25);
}

#ifndef PH_MASK
#define PH_MASK 0x1FFFF
#endif
#define PHM(k) ((PH_MASK >> (k)) & 1)
#ifndef PROBE_REP
#define PROBE_REP 0
#endif
#define NREP(k) (((PROBE_REP >> (k)) & 1) ? 2 : 1)
constexpr int NPH_LAYER = 7, PH_L0 = 2, NPHASE = PH_L0 + DEPTH * NPH_LAYER + 1;
__global__ void __launch_bounds__(512, 2) fwd_kernel(Params p) {
    extern __shared__ __attribute__((aligned(16))) unsigned char lds_raw[];
    Frame F0; Frame& F = F0;
    F.lds = (LAS unsigned char*)lds_raw;
    F.tid = threadIdx.x; F.lane = F.tid & 63; F.wave = __builtin_amdgcn_readfirstlane(F.tid >> 6);
    F.G = gridDim.x; { const int bx = blockIdx.x; F.vcu = (F.G % 8 == 0) ? (bx % 8) * (F.G / 8) + bx / 8 : bx; }
    volatile LAS unsigned* misc = (volatile LAS unsigned*)(F.lds + LDS_MISC);
    if (F.tid < 16) misc[F.tid] = 0u;
    __syncthreads();
    const int lo = p.ph_lo, hi = p.ph_hi;
    XcdBarrier bar; bar.bar = (unsigned*)(p.ws + WS_BAR); bar.x = 0; bar.st = misc;
    if (hi - lo > 1) bar = xcd_barrier_post((unsigned*)(p.ws + WS_BAR), misc);
#define IN(k) (lo <= (k) && (k) < hi)
#define LAUNDER(Fl) Frame Fl = F0; asm volatile("" : "+v"(Fl.tid), "+v"(Fl.lane))
#ifndef PROF_SEL
#define PROF_SEL -1
#endif
#define PROF_K 8
    volatile LAS unsigned* prof = (volatile LAS unsigned*)(F.lds + LDS_BYTES - 512);
    if (PROF_SEL >= 0 && F.tid < 40) prof[F.tid] = 0u;
    if (PROF_SEL >= 0) __syncthreads();
    if (PROF_SEL >= 0 && F.tid == 0) prof[32] = (unsigned)__builtin_amdgcn_s_memrealtime();
#define PROF_MARK(b) do { if (PROF_SEL >= 0 && F.tid == 0) { const unsigned _t = (unsigned)__builtin_amdgcn_s_memrealtime(); prof[(b)] += _t - prof[32]; if ((b) >= 16) prof[30] += _t - prof[32]; prof[32] = _t; } } while (0)
#define SEAMT(k, b) do { PROF_MARK(b); if (IN(k) && IN((k) + 1)) xcd_barrier(bar); PROF_MARK(16 + (b)); } while (0)
#define SEAM(k) do { if (IN(k) && IN((k) + 1)) xcd_barrier(bar); } while (0)
    unsigned char* ws = p.ws;
    hf* X16 = (hf*)(ws + WS_X16);
    hf* XS1 = (hf*)p.out; hf* MM = (hf*)p.out; hf* Y = (hf*)(ws + A_B); hf* XS2 = (hf*)(ws + A_B);
    hf* QKV = (hf*)(ws + A_QKV); hf* QKVN = (hf*)(ws + A_QKVN);
    unsigned char* Gt = (unsigned char*)(ws + A_G); hf* HID = (hf*)(ws + A_HID);
    float* SS = (float*)(ws + WS_SS);

    if (PHM(11) && IN(0)) for (int rep = 0; rep < NREP(11); ++rep) { LAUNDER(Fl); prologue_a(Fl, p); }
    SEAMT(0, 9);
    if (PHM(11) && IN(1)) for (int rep = 0; rep < NREP(12); ++rep) { LAUNDER(Fl); prologue_b(Fl, p); }
    SEAMT(1, 9);

    for (int l = 0; l < DEPTH; ++l) {
        const int pb = PH_L0 + l * NPH_LAYER;
        const bool ctx_live = l < DEPTH - 1;
        const int Mrows = ctx_live ? MTOT : NLAT;
        const float* modl = (const float*)(ws + WS_MOD) + (size_t)l * NMODV * MODW;
        const float* biasl = (const float*)(ws + WS_BIAS) + (size_t)l * NMODV * NBIAS;
        const float* gsl = (const float*)(ws + WS_GS) + (size_t)l * 2 * NMODV * DM;
        const unsigned char* wl = ws + WS_WT + (size_t)(l & 1) * W_LAYER;
        float* ss1 = SS + (size_t)(SS_1 + l) * MTOT * 4; float* ss2 = SS + (size_t)(SS_2 + l) * MTOT * 4;
        float* ssq = (float*)(ws + WS_SSQ) + (size_t)l * MTOT; float* sskv = (float*)(ws + WS_SSKV) + (size_t)l * MTOT;
        LAS unsigned char* lx = F.lds + LDS_EXCH;

        if (PHM(1) && IN(pb + 0)) { pg8::Gemm g{XS1, (const hf*)(wl + W_IN1), MTOT, NP1, DM, DM, DM}; pg8::StaticOrder S; S.init(MTOT, NP1, F.G, (int)blockIdx.x);
            pg8::EpiIn E{QKVN, (hf*)(ws + A_KR), (hf*)(ws + A_PHY), (hf*)(ws + A_DQ), (hf*)(ws + A_DK), (hf*)(ws + A_DV), ss1, biasl + B_IN, ssq, sskv, lx, F.lds + LDS_PRE};
            pg8::gemm_phase(F.lds, g, S, E); }
        SEAMT(pb + 0, 0);
        if (PHM(2) && IN(pb + 1)) {
            { LAUNDER(Fl); prep_rope(Fl, p); prep_hyena(Fl, p, l, ctx_live); }
            __syncthreads();
            PROF_MARK(1);
            { pg8::Gemm g{QKVN, (const hf*)(wl + W_UP), MTOT, NUP, KUP, KUP, KUP}; pg8::StaticOrder S; S.init(MTOT, NUP, F.G, (int)blockIdx.x);
              pg8::EpiUp E{QKV, ssq, sskv, F.lds + LDS_PRE}; pg8::gemm_phase(F.lds, g, S, E); }
        }
        SEAMT(pb + 1, 2);
        if (PHM(4) && IN(pb + 2)) {
            {
            LAUNDER(Fl);
            PROF_MARK(14);
            const int n_mla = 2048 + (ctx_live ? 256 : 0);
            for (int id = F.vcu; id < n_mla; id += F.G) {
                if (id < 2048) { const int qb = id & 7, h = (id >> 3) & 7, b = id >> 6; att::attn_unit<true>(Fl, p, l, h, b * SEQ + qb * 256, qb * 256, b * SEQ, 32, NLAT + b * CTXL); }
                else { const int i2 = id - 2048, h = i2 & 7, b = i2 >> 3; att::attn_unit<true>(Fl, p, l, h, NLAT + b * CTXL, -1, 0, 0, NLAT + b * CTXL); }
            }
            PROF_MARK(11);
            const int n_df = 1024 + (ctx_live ? 128 : 0);
            for (int id = F.vcu; id < n_df; id += F.G) {
                if (id < 1024) { const int qb = id & 7, h = (id >> 3) & 3, b = id >> 5; att::attn_unit<false>(Fl, p, l, h, b * SEQ + qb * 256, qb * 256, b * SEQ, 32, NLAT + b * CTXL); }
                else { const int i2 = id - 1024, h = i2 & 3, b = i2 >> 2; att::attn_unit<false>(Fl, p, l, h, NLAT + b * CTXL, -1, 0, 0, NLAT + b * CTXL); }
            }
            PROF_MARK(12);
            const unsigned char* ob = (const unsigned char*)p.out;
            for (int c = F.vcu; c < 256; c += F.G)
                hyena_unit<SEQ>(Fl, (const hf*)(ws + WS_RF) + ((size_t)l * 256 + c) * 4096, (const hf*)(ob + O_UT) + (size_t)c * NLAT, (const hf*)(ob + O_X0T) + (size_t)c * NLAT, Y + 512 + c);
            if (ctx_live) for (int c = F.vcu; c < 256; c += F.G)
                hyena_unit<CTXL>(Fl, (const hf*)(ws + WS_RFC) + ((size_t)l * 256 + c) * 512, (const hf*)(ob + O_UTC) + (size_t)c * NCTX, (const hf*)(ob + O_X0TC) + (size_t)c * NCTX, Y + (size_t)NLAT * DM + 512 + c);
            __syncthreads();
            PROF_MARK(13);
            }
            { pg8::Gemm g{XS1, (const hf*)(wl + W_ING), Mrows, NGATE, DM, DM, DM}; pg8::StaticOrder S; S.init(Mrows, NGATE, F.G, (int)blockIdx.x);
              pg8::EpiGate8 E{Gt, ss1, biasl + B_G, F.lds + LDS_PRE}; pg8::gemm_phase(F.lds, g, S, E); }
        }
        SEAMT(pb + 2, 4);
        if (PHM(6) && IN(pb + 3)) { pg8::Gemm g{Y, (const hf*)(wl + W_BR), Mrows, DM, DM, DM, DM}; pg8::StaticOrder S; S.init(Mrows, DM, F.G, (int)blockIdx.x);
            pg8::EpiMerge E{MM, Gt}; pg8::gemm_phase(F.lds, g, S, E); }
        SEAMT(pb + 3, 5);
        if (PHM(7) && IN(pb + 4)) { pg8::Gemm g{MM, (const hf*)(wl + W_OUT), Mrows, DM, DM, DM, DM}; pg8::StaticOrder S; S.init(Mrows, DM, F.G, (int)blockIdx.x);
            pg8::EpiResidX<true, true> E{X16, modl + 2 * DM, XS2, gsl + (size_t)NMODV * DM, ss2, lx}; pg8::gemm_phase(F.lds, g, S, E); }
        SEAMT(pb + 4, 6);
        if (PHM(9) && IN(pb + 5)) { pg8::Gemm g{XS2, (const hf*)(wl + W_FC1), Mrows, DFF, DM, DM, DM}; pg8::StaticOrder S; S.init(Mrows, DFF, F.G, (int)blockIdx.x);
            pg8::EpiHalf<2, true> E{HID, DFF, ss2, biasl + B_FC1, F.lds + LDS_PRE}; pg8::gemm_phase(F.lds, g, S, E); }
        SEAMT(pb + 5, 7);
        if (PHM(10) && IN(pb + 6)) { pg8::Gemm g{HID, (const hf*)(wl + W_FC2), Mrows, DM, DFF, DFF, DFF}; pg8::StaticOrder S; S.init(Mrows, DM, F.G, (int)blockIdx.x);
            if (ctx_live) { pg8::EpiResidX<true, true> E{X16, modl + 5 * DM, XS1, gsl + (size_t)2 * NMODV * DM, ss1 + (size_t)MTOT * 4, lx}; pg8::gemm_phase(F.lds, g, S, E);
                const int nheavy = (MTOT / 256 * 4) % F.G;
                if (nheavy > 0 && (int)blockIdx.x >= nheavy) { __syncthreads(); LAUNDER(Fl); convert_layer(Fl, p, l + 1, ws + WS_WT + (size_t)((l + 1) & 1) * W_LAYER, (int)blockIdx.x - nheavy, F.G - nheavy); }
                else if (nheavy == 0) { __syncthreads(); LAUNDER(Fl); convert_layer(Fl, p, l + 1, ws + WS_WT + (size_t)((l + 1) & 1) * W_LAYER, Fl.vcu, F.G); } }
            else { pg8::EpiResidX<false, true> E{X16, modl + 5 * DM, nullptr, nullptr, SS + (size_t)SS_F * MTOT * 4, lx}; pg8::gemm_phase(F.lds, g, S, E); } }
        SEAMT(pb + 6, 8);
    }
    if (PHM(12) && IN(NPHASE - 1)) { LAUNDER(Fl); final_norm_phase(Fl, X16, p.out, p.in[I_FNG], SS + (size_t)SS_F * MTOT * 4); }
    PROF_MARK(10);
    if (PROF_SEL >= 0 && blockIdx.x == 0 && F.tid == 0) { const unsigned long long t0 = __builtin_amdgcn_s_memrealtime(); const unsigned long long d = (unsigned long long)PROF_K * prof[PROF_SEL];
        while (__builtin_amdgcn_s_memrealtime() - t0 < d) __builtin_amdgcn_s_sleep(8); }
#undef IN
#undef SEAM
}

extern "C" void kernel_launch(void* const* d_in, const int* in_sizes, int n_in, void* d_out, int out_size, void* d_ws, size_t ws_size, hipStream_t stream) {
    static int grid = 0;
    if (grid == 0) {
        if (n_in != 35 || in_sizes[0] != NLAT * DM || out_size != NLAT * DM || ws_size < WS_END) {
            fprintf(stderr, "kernel_launch: unexpected shapes: n_in %d in0 %d out %d ws %zu (need %zu); nothing launched\n", n_in, n_in > 0 ? in_sizes[0] : -1, out_size, ws_size, (size_t)WS_END); grid = -1; return; }
        int dev = 0, cus = 0, per_cu = 0;
        if (hipGetDevice(&dev) != hipSuccess || hipDeviceGetAttribute(&cus, hipDeviceAttributeMultiprocessorCount, dev) != hipSuccess) { fprintf(stderr, "kernel_launch: device query failed\n"); grid = -1; return; }
        if (hipFuncSetAttribute((const void*)fwd_kernel, hipFuncAttributeMaxDynamicSharedMemorySize, LDS_BYTES) != hipSuccess) { fprintf(stderr, "kernel_launch: hipFuncSetAttribute failed\n"); grid = -1; return; }
        if (hipOccupancyMaxActiveBlocksPerMultiprocessor(&per_cu, (const void*)fwd_kernel, 512, LDS_BYTES) != hipSuccess || per_cu < 1)
            fprintf(stderr, "kernel_launch: note: occupancy query reports %d workgroups per CU\n", per_cu);
        (void)hipGetLastError();
        grid = cus;
    }
    if (grid < 0) return;
    if (hipMemsetAsync((char*)d_ws + WS_BAR, 0, WS_ZERO_BYTES, stream) != hipSuccess) { fprintf(stderr, "kernel_launch: memset failed\n"); return; }
    Params P{};
    for (int i = 0; i < 35; ++i) P.in[i] = (const float*)d_in[i];
    P.out = (float*)d_out; P.ws = (unsigned char*)d_ws;
#if MK_FUSED
    P.ph_lo = 0; P.ph_hi = NPHASE;
    hipLaunchKernelGGL(fwd_kernel, dim3(grid), dim3(512), LDS_BYTES, stream, P);
#else
    for (int ph = 0; ph < NPHASE; ++ph) { P.ph_lo = ph; P.ph_hi = ph + 1; hipLaunchKernelGGL(fwd_kernel, dim3(grid), dim3(512), LDS_BYTES, stream, P); }
#endif
    const hipError_t le = hipPeekAtLastError();
    if (le != hipSuccess) fprintf(stderr, "kernel_launch: launch failed: %s\n", hipGetErrorName(le));
}
```

```cpp
#include <hip/hip_runtime.h>
#include <cstdio>
#include <cstdint>

#ifndef MK_FUSED
#define MK_FUSED 1
#endif

#define LAS __attribute__((address_space(3)))
#define GAS __attribute__((address_space(1)))
typedef _Float16 hf;
typedef _Float16 hf2 __attribute__((ext_vector_type(2)));
typedef _Float16 hf4 __attribute__((ext_vector_type(4)));
typedef _Float16 hf8 __attribute__((ext_vector_type(8)));
typedef short s16x4 __attribute__((ext_vector_type(4)));
typedef float f32x2 __attribute__((ext_vector_type(2)));
typedef float f32x4 __attribute__((ext_vector_type(4)));
typedef float f32x16 __attribute__((ext_vector_type(16)));
typedef unsigned u32x2 __attribute__((ext_vector_type(2)));
typedef unsigned u32x4 __attribute__((ext_vector_type(4)));

constexpr int DM = 1024, NB = 32, SEQ = 2048, DEPTH = 4, CTXL = 256, GRIDW = 64;
constexpr int NLAT = NB * SEQ;
constexpr int NCTX = NB * CTXL;
constexpr int MTOT = NLAT + NCTX;
constexpr int D_IN = 5024, NP1 = 2048  , NGATE = 3072, DFF = 4096;
constexpr int C_PQ = 0, C_PKV = 256, C_PKR = 384, C_HY = 416, C_DQ = 1184, C_DK = 1440, C_DV = 1696, C_PG = 1952;
constexpr int NUP = 1792, KUP = 384;
constexpr int NMODV = 33, MODW = 6 * DM;
constexpr float EPS = 1e-6f;
constexpr float MLA_SCALE = 0.10206207261596575f;
constexpr float DF_SCALE = 0.17677669529663687f;

constexpr size_t al256(size_t x) { return (x + 255) / 256 * 256; }
constexpr size_t WS_BAR = 0, WS_BAR_BYTES = 65536;
constexpr size_t WS_SS = WS_BAR + WS_BAR_BYTES;
constexpr int SS_1 = 0, SS_2 = DEPTH, SS_F = 2 * DEPTH, SSP_N = 2 * DEPTH + 1;
constexpr size_t WS_SSQ = WS_SS + (size_t)SSP_N * MTOT * 4 * 4;
constexpr size_t WS_SSKV = WS_SSQ + (size_t)DEPTH * MTOT * 4;
constexpr size_t WS_ZERO_BYTES = WS_BAR_BYTES;
constexpr size_t WS_MOD = al256(WS_SSKV + (size_t)DEPTH * MTOT * 4);
constexpr size_t WS_GS = WS_MOD + al256((size_t)DEPTH * NMODV * MODW * 4);
constexpr int NBIAS = 9216, B_IN = 0, B_G = 2048, B_FC1 = 5120;
constexpr size_t WS_BIAS = WS_GS + (size_t)DEPTH * 2 * NMODV * DM * 4;
constexpr size_t WS_ROPE = WS_BIAS + (size_t)DEPTH * NMODV * NBIAS * 4;
constexpr size_t WS_LAM = WS_ROPE + (size_t)SEQ * 32 * 4;
constexpr size_t WS_RF = WS_LAM + 256;
constexpr size_t WS_RFC = WS_RF + (size_t)DEPTH * 256 * 4096 * 2;
constexpr size_t WS_X16 = WS_RFC + (size_t)DEPTH * 256 * 512 * 2;
constexpr size_t WS_WT = WS_X16 + (size_t)MTOT * DM * 2;
constexpr size_t W_IN1 = 0, W_ING = W_IN1 + (size_t)NP1 * DM * 2, W_UP = W_ING + (size_t)NGATE * DM * 2, W_BR = W_UP + (size_t)NUP * KUP * 2,
                 W_OUT = W_BR + (size_t)DM * DM * 2, W_FC1 = W_OUT + (size_t)DM * DM * 2, W_FC2 = W_FC1 + (size_t)DFF * DM * 2, W_LAYER = W_FC2 + (size_t)DM * DFF * 2;
constexpr size_t WS_ARENA = WS_WT + 2 * W_LAYER;
constexpr size_t SZ_ROW1024 = (size_t)MTOT * 1024 * 2;
constexpr size_t A_B = WS_ARENA;
constexpr size_t A_C = A_B + SZ_ROW1024;
constexpr size_t A_Y = A_B, A_XS2 = A_B, A_BIG = A_C;
constexpr size_t A_QKVN = A_BIG;
constexpr size_t A_PHY = A_QKVN + (size_t)MTOT * KUP * 2;
constexpr size_t A_KR = A_BIG + (size_t)MTOT * NGATE;
constexpr size_t A_DQ = A_KR + (size_t)MTOT * 32 * 2;
constexpr size_t A_DK = A_DQ + (size_t)MTOT * 256 * 2;
constexpr size_t A_DV = A_DK + (size_t)MTOT * 256 * 2;
constexpr size_t A_QKV = A_DV + (size_t)MTOT * 256 * 2;
constexpr size_t A_BIG_END = A_QKV + (size_t)MTOT * NUP * 2;
static_assert(A_PHY + (size_t)MTOT * 768 * 2 <= A_KR, "QKVN + PHY must fit under the gate bytes");
constexpr size_t O_UT = SZ_ROW1024, O_X0T = O_UT + (size_t)256 * NLAT * 2, O_UTC = O_X0T + (size_t)256 * NLAT * 2, O_X0TC = O_UTC + (size_t)256 * NCTX * 2, O_END = O_X0TC + (size_t)256 * NCTX * 2;
static_assert(O_END <= (size_t)NLAT * DM * 4, "d_out scratch overflow");
constexpr size_t A_G = A_BIG;
constexpr size_t A_HID = A_C;
constexpr size_t WS_END = (A_BIG_END > A_HID + (size_t)MTOT * DFF * 2) ? A_BIG_END : A_HID + (size_t)MTOT * DFF * 2;
static_assert(WS_END <= (size_t)1024 * 1024 * 1024, "workspace map exceeds 1 GiB");

constexpr int LDS_BYTES = 147456;
constexpr int LDS_MISC = LDS_BYTES - 64;
constexpr int LDS_PRE = 135168;
constexpr int LDS_EXCH = 131072;

__device__ __forceinline__ unsigned pkh(float lo, float hi) { f32x2 v = {lo, hi}; hf2 h = __builtin_convertvector(v, hf2); return __builtin_bit_cast(unsigned, h); }
__device__ __forceinline__ unsigned rb8(unsigned h) { return (h + 0x00040004u) & 0xfff8fff8u; }
__device__ __forceinline__ unsigned pkhb(float lo, float hi) { return rb8(pkh(lo, hi)); }
__device__ __forceinline__ float wave_sum(float v) {
#pragma unroll
    for (int o = 1; o < 64; o <<= 1) v += __shfl_xor(v, o);
    return v;
}
__device__ __forceinline__ float rstd4(const float* ssp, int r) { const f32x4 q = *(const f32x4*)(ssp + 4 * (size_t)r); return rsqrtf(((q[0] + q[1]) + (q[2] + q[3])) * (1.f / DM) + EPS); }
__device__ __forceinline__ void rstd8(const float* ssp, int row0, float (&rs)[2][4]) {
    f32x4 q[2][4];
#pragma unroll
    for (int ai = 0; ai < 2; ++ai)
#pragma unroll
        for (int m = 0; m < 4; ++m) q[ai][m] = *(const f32x4*)(ssp + 4 * (size_t)(row0 + ai * 128 + m * 16));
#pragma unroll
    for (int ai = 0; ai < 2; ++ai)
#pragma unroll
        for (int m = 0; m < 4; ++m) rs[ai][m] = rsqrtf(((q[ai][m][0] + q[ai][m][1]) + (q[ai][m][2] + q[ai][m][3])) * (1.f / DM) + EPS);
}
__device__ __forceinline__ void rstd8_lds(const LAS unsigned char* pl, int lr0, float (&rs)[2][4]) {
    f32x4 q[2][4];
#pragma unroll
    for (int ai = 0; ai < 2; ++ai)
#pragma unroll
        for (int m = 0; m < 4; ++m) q[ai][m] = *(const LAS f32x4*)(pl + 16 * (lr0 + ai * 128 + m * 16));
#pragma unroll
    for (int ai = 0; ai < 2; ++ai)
#pragma unroll
        for (int m = 0; m < 4; ++m) rs[ai][m] = rsqrtf(((q[ai][m][0] + q[ai][m][1]) + (q[ai][m][2] + q[ai][m][3])) * (1.f / DM) + EPS);
}
__device__ __forceinline__ void dma16(const void* g, LAS unsigned char* l) { __builtin_amdgcn_global_load_lds((const unsigned*)g, (LAS unsigned*)l, 16, 0, 0); }
__device__ __forceinline__ void pre_norm(LAS unsigned char* pl, const float* ss, const float* biasrow, int R0, int wid, int lane) {
    if (wid < 4) dma16(ss + 4 * (size_t)(R0 + wid * 64 + lane), pl + wid * 1024);
    else if (wid == 4) dma16(biasrow + lane * 4, pl + 4096);
}
#define LDS_WAIT() asm volatile("s_waitcnt lgkmcnt(0)" ::: "memory")
#define VM_WAIT() asm volatile("s_waitcnt vmcnt(0)" ::: "memory")

#define XB_TMO      128
#define XB_XCNT(j)  (256  + 64 * (j))
#define XB_XSUB(j)  (1280 + 64 * (j))
#define XB_XGEN(j)  (2304 + 64 * (j))
#define XB_TOP      3328
#define XB_TOPGEN   3392
#define XCD_BAR_WORDS 3456
#define XB_SPIN_CAP (1u << 22)
__device__ __forceinline__ unsigned xb_ld(unsigned* p)              { return __hip_atomic_load(p, __ATOMIC_RELAXED, __HIP_MEMORY_SCOPE_AGENT); }
__device__ __forceinline__ unsigned xb_add(unsigned* p, unsigned v) { return __hip_atomic_fetch_add(p, v, __ATOMIC_RELAXED, __HIP_MEMORY_SCOPE_AGENT); }
__device__ __forceinline__ unsigned xb_xcc_id() { return (unsigned)__builtin_amdgcn_s_getreg((3 << 11) | 20) & 0xFu; }
#define XB_SPIN(cond, bar) do { unsigned _sp = 0; while (cond) { __builtin_amdgcn_s_sleep(1); \
    if ((++_sp & 255u) == 0u) { if (xb_ld(&(bar)[XB_TMO])) break; if (_sp > XB_SPIN_CAP) { atomicAdd(&(bar)[XB_TMO], 1u); break; } } } } while (0)
struct XcdBarrier { unsigned* bar; unsigned x; volatile LAS unsigned* st; };
__device__ __forceinline__ XcdBarrier xcd_barrier_post(unsigned* bar, volatile LAS unsigned* st) {
    XcdBarrier b; b.bar = bar; b.x = xb_xcc_id(); b.st = st;
    if (threadIdx.x == 0) (void)xb_add(&bar[XB_XCNT(b.x)], 1u);
    return b;
}
__device__ __forceinline__ void xcd_barrier_complete(unsigned* bar, unsigned x, unsigned& nloc, unsigned& nx) {
    const unsigned G = gridDim.x * gridDim.y * gridDim.z;
    unsigned sum, cnt, mine, sp = 0u;
    for (;;) {
        sum = 0u; cnt = 0u; mine = 0u;
#pragma unroll
        for (unsigned j = 0; j < 16; ++j) { const unsigned c = xb_ld(&bar[XB_XCNT(j)]); sum += c; cnt += (c > 0u) ? 1u : 0u; mine = (j == x) ? c : mine; }
        if (sum == G) break;
        __builtin_amdgcn_s_sleep(1);
        if ((++sp & 255u) == 0u) { if (xb_ld(&bar[XB_TMO])) break; if (sp > XB_SPIN_CAP) { atomicAdd(&bar[XB_TMO], 1u); break; } }
    }
    nloc = mine > 0u ? mine : 1u; nx = cnt > 0u ? cnt : 1u;
}
__device__ __forceinline__ void xcd_barrier(const XcdBarrier& b) {
    asm volatile("s_waitcnt vmcnt(0)" ::: "memory");
    __syncthreads();
    if (threadIdx.x == 0) {
        unsigned* bar = b.bar;
        __builtin_amdgcn_s_waitcnt(0);
        unsigned nloc = b.st[0], nx = b.st[1];
        if (nloc == 0u) { xcd_barrier_complete(bar, b.x, nloc, nx); b.st[0] = nloc; b.st[1] = nx; }
        const unsigned old = xb_add(&bar[XB_XSUB(b.x)], 1u);
        const unsigned gen = old / nloc;
        if (old + 1u == (gen + 1u) * nloc) {
            __builtin_amdgcn_fence(__ATOMIC_RELEASE, "agent");
            asm volatile("s_waitcnt vmcnt(0)" ::: "memory");
            const unsigned og = xb_add(&bar[XB_TOP], 1u);
            const unsigned tg = og / nx;
            if (og + 1u == (tg + 1u) * nx) xb_add(&bar[XB_TOPGEN], 1u);
            else XB_SPIN(xb_ld(&bar[XB_TOPGEN]) == tg, bar);
            __builtin_amdgcn_fence(__ATOMIC_ACQUIRE, "agent");
            xb_add(&bar[XB_XGEN(b.x)], 1u);
            asm volatile("s_waitcnt vmcnt(0)" ::: "memory");
        } else {
            XB_SPIN(xb_ld(&bar[XB_XGEN(b.x)]) == gen, bar);
            __builtin_amdgcn_fence(__ATOMIC_ACQUIRE, "agent");
            asm volatile("s_waitcnt vmcnt(0)" ::: "memory");
        }
    }
    __syncthreads();
}

namespace pg8 {
constexpr int BM = 256, BK = 64, HALF = 128, HTB = HALF * BK * 2, STAGE_BYTES = 8 * HTB, NXCD = 8, WGM = 8;
__host__ __device__ __forceinline__ int lds_byte(int r, int c) { const int st = (r >> 4) * 2 + (c >> 5), rr = r & 15, cc = c & 31, ob = rr * 64 + cc * 2; return st * 1024 + (ob ^ (((ob >> 9) & 1) << 5)); }
__host__ __device__ __forceinline__ void stage_rc(int b, int& R, int& C) { const int st = b / 1024, sb = b % 1024, swz = sb ^ (((sb >> 9) & 1) << 5); R = (st >> 1) * 16 + swz / 64; C = (st & 1) * 32 + (swz % 64) / 2; }
__host__ __device__ __forceinline__ int perm32(int rho) { const int n = rho >> 4, i = rho & 15; return 8 * (i >> 2) + 4 * n + (i & 3); }
struct Unit { int pm, pn; };
struct Gemm { const hf* A; const hf* Bt; int M, N, K, lda, ldb; };
struct StaticOrder {
    int nM, nN, nwg, G, c;
    __host__ __device__ void init(int M, int N, int G_, int c_) { nM = M / BM; nN = N / BM; nwg = nM * nN; G = G_; c = c_; }
    __host__ __device__ bool next(int i, Unit& u) const {
        const long L = (long)i * G + c; if (L >= nwg) return false;
        int wgid = (int)L; { const int q = nwg / NXCD, r = nwg % NXCD, xcd = wgid % NXCD, off = wgid / NXCD; wgid = (xcd < r ? xcd * (q + 1) : r * (q + 1) + (xcd - r) * q) + off; }
        const int nig = WGM * nN, gid = wgid / nig, fm = gid * WGM, gsz = (nM - fm) < WGM ? (nM - fm) : WGM;
        u.pm = fm + ((wgid % nig) % gsz); u.pn = (wgid % nig) / gsz; return true;
    }
    __device__ __forceinline__ void a_ready(const Unit&) const {}
    __device__ __forceinline__ void done(const Unit&) const {}
};

template <int ACT  , bool NORM> struct EpiHalf {
    static constexpr bool PERM = true, AFTER_DRAIN = false, PROBE2 = false, MIDK = false, PRE = NORM;
    hf* O; int ldc; const float* ss; const float* bias; LAS unsigned char* pl;
    __device__ __forceinline__ void prefetch(const Unit& u, int wid, int lane) const { const int R0 = u.pm * BM; const int v = (R0 < NLAT) ? (R0 >> 11) : NB; pre_norm(pl, ss, bias + (size_t)v * NBIAS + u.pn * BM, R0, wid, lane); }
    __device__ __forceinline__ void operator()(const f32x4 (&acc)[2][2][4][2], const Unit& u, int wr, int wc, int fr, int fq) const {
        const int row0 = u.pm * BM + wr * 64 + fr, col0 = u.pn * BM + wc * 32 + 8 * fq;
        f32x4 bv[2][2];
        const int lc0 = wc * 32 + 8 * fq;
        if (NORM) {
#pragma unroll
            for (int bj = 0; bj < 2; ++bj)
#pragma unroll
                for (int n = 0; n < 2; ++n) bv[bj][n] = *(const LAS f32x4*)(pl + 4096 + 4 * (lc0 + bj * HALF + 4 * n)); }
        float rsv[2][4]; if (NORM) rstd8_lds(pl, wr * 64 + fr, rsv);
#pragma unroll
        for (int ai = 0; ai < 2; ++ai)
#pragma unroll
            for (int m = 0; m < 4; ++m) { const int r = row0 + ai * HALF + m * 16; hf* rowp = O + (size_t)r * ldc + col0;
                float rs = 1.f; if (NORM) rs = rsv[ai][m];
#pragma unroll
                for (int bj = 0; bj < 2; ++bj) { f32x4 v0 = acc[ai][bj][m][0], v1 = acc[ai][bj][m][1];
                    if (NORM) { v0 = v0 * rs + bv[bj][0]; v1 = v1 * rs + bv[bj][1]; }
                    if (ACT == 1) {
#pragma unroll
                        for (int e = 0; e < 4; ++e) { v0[e] = __builtin_amdgcn_rcpf(1.f + __builtin_amdgcn_exp2f(-1.4426950408889634f * v0[e])); v1[e] = __builtin_amdgcn_rcpf(1.f + __builtin_amdgcn_exp2f(-1.4426950408889634f * v1[e])); } }
                    u32x4 w;
                    if (ACT == 2) {
                        const unsigned h[4] = {pkh(v0[0], v0[1]), pkh(v0[2], v0[3]), pkh(v1[0], v1[1]), pkh(v1[2], v1[3])}; unsigned o[4];
#pragma unroll
                        for (int e = 0; e < 4; ++e) { hf2 a = __builtin_bit_cast(hf2, h[e]); a = __builtin_elementwise_max(a, (hf2){(hf)0.f, (hf)0.f}); a = a * a; o[e] = rb8(__builtin_bit_cast(unsigned, a)); }
                        w.x = o[0]; w.y = o[1]; w.z = o[2]; w.w = o[3];
                    } else { w.x = pkhb(v0[0], v0[1]); w.y = pkhb(v0[2], v0[3]); w.z = pkhb(v1[0], v1[1]); w.w = pkhb(v1[2], v1[3]); }
                    *(u32x4*)(rowp + bj * HALF) = w; } }
    }
};
struct EpiGate8 {
    static constexpr bool PERM = true, AFTER_DRAIN = false, PROBE2 = false, MIDK = false, PRE = true;
    unsigned char* O; const float* ss; const float* bias; LAS unsigned char* pl;
    __device__ __forceinline__ void prefetch(const Unit& u, int wid, int lane) const { const int R0 = u.pm * BM; const int v = (R0 < NLAT) ? (R0 >> 11) : NB; pre_norm(pl, ss, bias + (size_t)v * NBIAS + u.pn * BM, R0, wid, lane); }
    __device__ __forceinline__ void operator()(const f32x4 (&acc)[2][2][4][2], const Unit& u, int wr, int wc, int fr, int fq) const {
        const int R0 = u.pm * BM, row0 = R0 + wr * 64 + fr, col0 = u.pn * BM + wc * 32 + 8 * fq;
        const int lc0 = wc * 32 + 8 * fq;
        f32x4 bv[2][2];
#pragma unroll
        for (int bj = 0; bj < 2; ++bj) { bv[bj][0] = *(const LAS f32x4*)(pl + 4096 + 4 * (lc0 + bj * HALF)); bv[bj][1] = *(const LAS f32x4*)(pl + 4096 + 4 * (lc0 + bj * HALF + 4)); }
        float rsv[2][4]; rstd8_lds(pl, wr * 64 + fr, rsv);
#pragma unroll
        for (int ai = 0; ai < 2; ++ai)
#pragma unroll
            for (int m = 0; m < 4; ++m) { const int r = row0 + ai * HALF + m * 16; const float rs = rsv[ai][m];
#pragma unroll
                for (int bj = 0; bj < 2; ++bj) { const f32x4 v0 = acc[ai][bj][m][0] * rs + bv[bj][0], v1 = acc[ai][bj][m][1] * rs + bv[bj][1];
                    unsigned q[8];
#pragma unroll
                    for (int e = 0; e < 4; ++e) { const float g0 = __builtin_amdgcn_rcpf(1.f + __builtin_amdgcn_exp2f(-1.4426950408889634f * v0[e])), g1 = __builtin_amdgcn_rcpf(1.f + __builtin_amdgcn_exp2f(-1.4426950408889634f * v1[e]));
                        q[e] = (unsigned)fmaxf(1.f, __builtin_rintf(255.f * g0)); q[4 + e] = (unsigned)fmaxf(1.f, __builtin_rintf(255.f * g1)); }
                    u32x2 w; w.x = q[0] | (q[1] << 8) | (q[2] << 16) | (q[3] << 24); w.y = q[4] | (q[5] << 8) | (q[6] << 16) | (q[7] << 24);
                    *(u32x2*)(O + (size_t)r * NGATE + col0 + bj * HALF) = w; } }
    }
};
struct EpiIn {
    static constexpr bool PERM = true, AFTER_DRAIN = false, PROBE2 = false, MIDK = false, PRE = true;
    hf* QKVNo; hf* KRo; hf* PHYo; hf* DQo; hf* DKo; hf* DVo; const float* ss; const float* bias; float* ssq; float* sskv; LAS unsigned char* lx; LAS unsigned char* pl;
    __device__ __forceinline__ void prefetch(const Unit& u, int wid, int lane) const { const int R0 = u.pm * BM; const int v = (R0 < NLAT) ? (R0 >> 11) : NB; pre_norm(pl, ss, bias + (size_t)v * NBIAS + u.pn * BM, R0, wid, lane); }
    __device__ __forceinline__ void operator()(const f32x4 (&acc)[2][2][4][2], const Unit& u, int wr, int wc, int fr, int fq) const {
        const int R0 = u.pm * BM, row0 = R0 + wr * 64 + fr, col0 = u.pn * BM + wc * 32 + 8 * fq;
        const int lc0 = wc * 32 + 8 * fq;
        f32x4 bv[2][2]; hf* dst[2]; int ld[2];
#pragma unroll
        for (int bj = 0; bj < 2; ++bj) { const int c8 = col0 + bj * HALF;
            bv[bj][0] = *(const LAS f32x4*)(pl + 4096 + 4 * (lc0 + bj * HALF)); bv[bj][1] = *(const LAS f32x4*)(pl + 4096 + 4 * (lc0 + bj * HALF + 4));
            if (c8 < C_PKR) { dst[bj] = QKVNo + c8; ld[bj] = KUP; }
            else if (c8 < C_HY) { dst[bj] = KRo + (c8 - C_PKR); ld[bj] = 32; }
            else if (c8 < C_DQ) { dst[bj] = PHYo + (c8 - C_HY); ld[bj] = 768; }
            else if (c8 < C_DK) { dst[bj] = DQo + (c8 - C_DQ); ld[bj] = 256; }
            else if (c8 < C_DV) { dst[bj] = DKo + (c8 - C_DK); ld[bj] = 256; }
            else if (c8 < C_PG) { dst[bj] = DVo + (c8 - C_DV); ld[bj] = 256; }
            else { dst[bj] = nullptr; ld[bj] = 0; } }
        const int nstat = (u.pn == 0) ? 2 : (u.pn == 1 ? 1 : 0);
        float* sp = (u.pn == 0) ? ssq : sskv;
        float sqv[2][4];
        float rsv[2][4]; rstd8_lds(pl, wr * 64 + fr, rsv);
#pragma unroll
        for (int ai = 0; ai < 2; ++ai)
#pragma unroll
            for (int m = 0; m < 4; ++m) { const int r = row0 + ai * HALF + m * 16; const float rs = rsv[ai][m]; float sq = 0.f;
#pragma unroll
                for (int bj = 0; bj < 2; ++bj) { const f32x4 v0 = acc[ai][bj][m][0] * rs + bv[bj][0], v1 = acc[ai][bj][m][1] * rs + bv[bj][1];
                    if (bj < nstat) sq += (v0[0] * v0[0] + v0[1] * v0[1]) + (v0[2] * v0[2] + v0[3] * v0[3]) + (v1[0] * v1[0] + v1[1] * v1[1]) + (v1[2] * v1[2] + v1[3] * v1[3]);
                    if (dst[bj]) { u32x4 w; w.x = pkhb(v0[0], v0[1]); w.y = pkhb(v0[2], v0[3]); w.z = pkhb(v1[0], v1[1]); w.w = pkhb(v1[2], v1[3]); *(u32x4*)(dst[bj] + (size_t)r * ld[bj]) = w; } }
                sq += __shfl_xor(sq, 16); sq += __shfl_xor(sq, 32); sqv[ai][m] = sq; }
        if (nstat) {
            LAS float* ex = (LAS float*)lx;
            if (fq == 0) {
#pragma unroll
                for (int ai = 0; ai < 2; ++ai)
#pragma unroll
                    for (int m = 0; m < 4; ++m) ex[((wr * 4 + wc) * 8 + ai * 4 + m) * 16 + fr] = sqv[ai][m]; }
            asm volatile("s_waitcnt lgkmcnt(0)" ::: "memory"); __builtin_amdgcn_s_barrier(); asm volatile("" ::: "memory");
            if (wc == 0 && fq == 0) {
#pragma unroll
                for (int ai = 0; ai < 2; ++ai)
#pragma unroll
                    for (int m = 0; m < 4; ++m) { const int e = (ai * 4 + m) * 16 + fr; const int wb = wr * 4 * 128;
                        sp[row0 + ai * HALF + m * 16] = (ex[wb + e] + ex[wb + 128 + e]) + (ex[wb + 256 + e] + ex[wb + 384 + e]); } }
        }
    }
};
struct EpiUp {
    static constexpr bool PERM = true, AFTER_DRAIN = false, PROBE2 = false, MIDK = false, PRE = true;
    hf* O; const float* ssq; const float* sskv; LAS unsigned char* pl;
    __device__ __forceinline__ void prefetch(const Unit& u, int wid, int lane) const { if (wid == 0) dma16((u.pn < 3 ? ssq : sskv) + u.pm * BM + 4 * lane, pl); }
    __device__ __forceinline__ void operator()(const f32x4 (&acc)[2][2][4][2], const Unit& u, int wr, int wc, int fr, int fq) const {
        const int row0 = u.pm * BM + wr * 64 + fr, col0 = u.pn * BM + wc * 32 + 8 * fq;
        const bool isq = u.pn < 3; const float* sp = isq ? ssq : sskv; const float invn = isq ? (1.f / 256.f) : (1.f / 128.f);
        float rsv[2][4];
#pragma unroll
        for (int ai = 0; ai < 2; ++ai)
#pragma unroll
            for (int m = 0; m < 4; ++m) rsv[ai][m] = *(const LAS float*)(pl + 4 * (wr * 64 + fr + ai * HALF + m * 16));
#pragma unroll
        for (int ai = 0; ai < 2; ++ai)
#pragma unroll
            for (int m = 0; m < 4; ++m) { const int r = row0 + ai * HALF + m * 16; hf* rowp = O + (size_t)r * NUP + col0; const float rs = rsqrtf(rsv[ai][m] * invn + EPS);
#pragma unroll
                for (int bj = 0; bj < 2; ++bj) { const f32x4 v0 = acc[ai][bj][m][0] * rs, v1 = acc[ai][bj][m][1] * rs;
                    u32x4 w; w.x = pkhb(v0[0], v0[1]); w.y = pkhb(v0[2], v0[3]); w.z = pkhb(v1[0], v1[1]); w.w = pkhb(v1[2], v1[3]);
                    *(u32x4*)(rowp + bj * HALF) = w; } }
    }
};
template <bool FIRST> struct EpiGated {
    static constexpr bool PERM = true, AFTER_DRAIN = false, PROBE2 = false, MIDK = false, PRE = false;
    hf* MMo; const hf* G; int goff;
    __device__ __forceinline__ void operator()(const f32x4 (&acc)[2][2][4][2], const Unit& u, int wr, int wc, int fr, int fq) const {
        const int row0 = u.pm * BM + wr * 64 + fr, col0 = u.pn * BM + wc * 32 + 8 * fq;
#pragma unroll
        for (int ai = 0; ai < 2; ++ai)
#pragma unroll
            for (int m = 0; m < 4; ++m) { const size_t r = (size_t)(row0 + ai * HALF + m * 16);
#pragma unroll
                for (int bj = 0; bj < 2; ++bj) { const f32x4 v0 = acc[ai][bj][m][0], v1 = acc[ai][bj][m][1];
                    const hf8 g = *(const hf8*)(G + r * NGATE + goff + col0 + bj * HALF);
                    hf* mp = MMo + r * DM + col0 + bj * HALF;
                    float o[8];
#pragma unroll
                    for (int e = 0; e < 4; ++e) { o[e] = (float)g[e] * v0[e]; o[4 + e] = (float)g[4 + e] * v1[e]; }
                    if (!FIRST) { const hf8 p = *(const hf8*)mp;
#pragma unroll
                        for (int e = 0; e < 8; ++e) o[e] += (float)p[e]; }
                    u32x4 w; w.x = pkh(o[0], o[1]); w.y = pkh(o[2], o[3]); w.z = pkh(o[4], o[5]); w.w = pkh(o[6], o[7]);
                    *(u32x4*)mp = w; } }
    }
};
struct EpiMerge {
    static constexpr bool PERM = true, AFTER_DRAIN = false, PROBE2 = false, MIDK = true, PRE = false;
    static constexpr int MID1 = 8, MID2 = 12;
    hf* MMo; const unsigned char* G;
    __device__ __forceinline__ void mid(f32x4 (&acc)[2][2][4][2], const Unit& u, int which, int wr, int wc, int fr, int fq) const {
        asm volatile("" : "+v"(fr), "+v"(fq));
        const int row0 = u.pm * BM + wr * 64 + fr, col0 = u.pn * BM + wc * 32 + 8 * fq; const int gnum = which ? 1024 : 0, gden = which ? 2048 : 1024;
#pragma unroll
        for (int ai = 0; ai < 2; ++ai) {
            u32x2 gn[4][2], gd[4][2];
#pragma unroll
            for (int m = 0; m < 4; ++m) { const unsigned char* gr = G + (size_t)(row0 + ai * HALF + m * 16) * NGATE + col0;
#pragma unroll
                for (int bj = 0; bj < 2; ++bj) { gn[m][bj] = *(const u32x2*)(gr + gnum + bj * HALF); gd[m][bj] = *(const u32x2*)(gr + gden + bj * HALF); } }
#pragma unroll
            for (int m = 0; m < 4; ++m)
#pragma unroll
                for (int bj = 0; bj < 2; ++bj)
#pragma unroll
                    for (int e = 0; e < 4; ++e) {
                        acc[ai][bj][m][0][e] *= (float)((gn[m][bj].x >> (8 * e)) & 255u) * __builtin_amdgcn_rcpf((float)((gd[m][bj].x >> (8 * e)) & 255u));
                        acc[ai][bj][m][1][e] *= (float)((gn[m][bj].y >> (8 * e)) & 255u) * __builtin_amdgcn_rcpf((float)((gd[m][bj].y >> (8 * e)) & 255u)); }
            asm volatile("" ::: "memory");
        }
    }
    __device__ __forceinline__ void operator()(const f32x4 (&acc)[2][2][4][2], const Unit& u, int wr, int wc, int fr, int fq) const {
        const int row0 = u.pm * BM + wr * 64 + fr, col0 = u.pn * BM + wc * 32 + 8 * fq;
#pragma unroll
        for (int ai = 0; ai < 2; ++ai) {
            u32x2 gq[4][2];
#pragma unroll
            for (int m = 0; m < 4; ++m)
#pragma unroll
                for (int bj = 0; bj < 2; ++bj) gq[m][bj] = *(const u32x2*)(G + (size_t)(row0 + ai * HALF + m * 16) * NGATE + 2048 + col0 + bj * HALF);
#pragma unroll
            for (int m = 0; m < 4; ++m) { const size_t r = (size_t)(row0 + ai * HALF + m * 16);
#pragma unroll
                for (int bj = 0; bj < 2; ++bj) { const f32x4 v0 = acc[ai][bj][m][0], v1 = acc[ai][bj][m][1];
                    const u32x2 g = gq[m][bj];
                    float o[8];
#pragma unroll
                    for (int e = 0; e < 4; ++e) { o[e] = (float)((g.x >> (8 * e)) & 255u) * (1.f / 255.f) * v0[e]; o[4 + e] = (float)((g.y >> (8 * e)) & 255u) * (1.f / 255.f) * v1[e]; }
                    u32x4 w; w.x = pkhb(o[0], o[1]); w.y = pkhb(o[2], o[3]); w.z = pkhb(o[4], o[5]); w.w = pkhb(o[6], o[7]);
                    *(u32x4*)(MMo + r * DM + col0 + bj * HALF) = w; } } }
    }
};
template <bool XS, bool STAT> struct EpiResidX {
    static constexpr bool PERM = true, AFTER_DRAIN = false, PROBE2 = false, MIDK = false, PRE = false;
    hf* x16; const float* gate;
    hf* xsout; const float* gs; float* ss; LAS unsigned char* lx;
    __device__ __forceinline__ void operator()(const f32x4 (&acc)[2][2][4][2], const Unit& u, int wr, int wc, int fr, int fq) const {
        const int R0 = u.pm * BM; const int v = (R0 < NLAT) ? (R0 >> 11) : NB;
        const int rglob = R0 + wr * 64 + fr, col0 = u.pn * BM + wc * 32 + 8 * fq;
        const float* gp = gate + (size_t)v * MODW + col0; const float* gsp = gs + (size_t)v * DM + col0;
        float sq[2][4];
#pragma unroll
        for (int ai = 0; ai < 2; ++ai)
#pragma unroll
            for (int m = 0; m < 4; ++m) sq[ai][m] = 0.f;
        u32x4 ah[2][2][4];
#pragma unroll
        for (int bj = 0; bj < 2; ++bj)
#pragma unroll
            for (int ai = 0; ai < 2; ++ai)
#pragma unroll
                for (int m = 0; m < 4; ++m) { const f32x4 a0 = acc[ai][bj][m][0], a1 = acc[ai][bj][m][1];
                    u32x4 t; t.x = pkh(a0[0], a0[1]); t.y = pkh(a0[2], a0[3]); t.z = pkh(a1[0], a1[1]); t.w = pkh(a1[2], a1[3]); asm volatile("" : "+v"(t)); ah[bj][ai][m] = t; }
        asm volatile("" ::: "memory");
        hf8 xq[2][2][4];
#pragma unroll
        for (int bj = 0; bj < 2; ++bj)
#pragma unroll
            for (int ai = 0; ai < 2; ++ai)
#pragma unroll
                for (int m = 0; m < 4; ++m) xq[bj][ai][m] = *(const hf8*)(x16 + (size_t)(rglob + ai * HALF + m * 16) * DM + col0 + bj * HALF);
        f32x4 gv[2][2], sv[2][2];
#pragma unroll
        for (int bj = 0; bj < 2; ++bj) { gv[bj][0] = *(const f32x4*)(gp + bj * HALF); gv[bj][1] = *(const f32x4*)(gp + bj * HALF + 4);
            if (XS) { sv[bj][0] = *(const f32x4*)(gsp + bj * HALF); sv[bj][1] = *(const f32x4*)(gsp + bj * HALF + 4); } }
#pragma unroll
        for (int bj = 0; bj < 2; ++bj) {
            const f32x4 g0 = gv[bj][0], g1 = gv[bj][1];
            const hf2 gh[4] = {__builtin_bit_cast(hf2, pkh(g0[0], g0[1])), __builtin_bit_cast(hf2, pkh(g0[2], g0[3])), __builtin_bit_cast(hf2, pkh(g1[0], g1[1])), __builtin_bit_cast(hf2, pkh(g1[2], g1[3]))};
            hf2 sh[4] = {gh[0], gh[0], gh[0], gh[0]};
            if (XS) { const f32x4 s0 = sv[bj][0], s1 = sv[bj][1];
                sh[0] = __builtin_bit_cast(hf2, pkh(s0[0], s0[1])); sh[1] = __builtin_bit_cast(hf2, pkh(s0[2], s0[3])); sh[2] = __builtin_bit_cast(hf2, pkh(s1[0], s1[1])); sh[3] = __builtin_bit_cast(hf2, pkh(s1[2], s1[3])); }
#pragma unroll
            for (int ai = 0; ai < 2; ++ai)
#pragma unroll
                for (int m = 0; m < 4; ++m) { const int rr = ai * HALF + m * 16; const size_t off = (size_t)(rglob + rr) * DM + col0 + bj * HALF;
                    const hf8 xv = xq[bj][ai][m]; const u32x4 av = ah[bj][ai][m];
                    const unsigned aw[4] = {av.x, av.y, av.z, av.w};
                    u32x4 wn, wx;
#pragma unroll
                    for (int e = 0; e < 4; ++e) { const hf2 n = __builtin_elementwise_fma(gh[e], __builtin_bit_cast(hf2, aw[e]), (hf2){xv[2 * e], xv[2 * e + 1]});
                        wn[e] = __builtin_bit_cast(unsigned, n);
                        if (STAT) sq[ai][m] = __builtin_amdgcn_fdot2(n, n, sq[ai][m], false);
                        if (XS) wx[e] = rb8(__builtin_bit_cast(unsigned, n * sh[e])); }
                    *(u32x4*)(x16 + off) = wn;
                    if (XS) *(u32x4*)(xsout + off) = wx; }
        }
        if (STAT) {
            LAS float* ex = (LAS float*)lx;
#pragma unroll
            for (int ai = 0; ai < 2; ++ai)
#pragma unroll
                for (int m = 0; m < 4; ++m) { float t = sq[ai][m]; t += __shfl_xor(t, 16); t += __shfl_xor(t, 32);
                    if (fq == 0) ex[((wr * 4 + wc) * 8 + ai * 4 + m) * 16 + fr] = t; }
            asm volatile("s_waitcnt lgkmcnt(0)" ::: "memory"); __builtin_amdgcn_s_barrier(); asm volatile("" ::: "memory");
            if (wc == 0 && fq == 0) {
#pragma unroll
                for (int ai = 0; ai < 2; ++ai)
#pragma unroll
                    for (int m = 0; m < 4; ++m) { const int e = (ai * 4 + m) * 16 + fr; const int wb = wr * 4 * 128;
                        ss[(size_t)(rglob + ai * HALF + m * 16) * 4 + u.pn] = (ex[wb + e] + ex[wb + 128 + e]) + (ex[wb + 256 + e] + ex[wb + 384 + e]); } }
        }
    }
};

template <class Epi, class Sched, bool ALIGN_EPI = true>
__device__ __forceinline__ void gemm_phase(LAS unsigned char* lds, const Gemm g, const Sched& S, const Epi& E) {
    int tid = threadIdx.x; asm volatile("" : "+v"(tid));
    const int wid = __builtin_amdgcn_readfirstlane(tid >> 6), lane = tid & 63, wr = wid >> 2, wc = wid & 3, fr = lane & 15, fq = lane >> 4;
    const int K = g.K, nt = K / BK;
    unsigned voffA[2], voffB[2];
#pragma unroll
    for (int i = 0; i < 2; ++i) { int R, C; stage_rc(tid * 16 + i * 8192, R, C); const int Rb = Epi::PERM ? ((R & ~31) + perm32(R & 31)) : R;
        voffA[i] = (unsigned)(R * g.lda + C) * 2u; voffB[i] = (unsigned)(Rb * g.ldb + C) * 2u; }
    const size_t kstep = (size_t)(BK * 2);
    const size_t hstepA = (size_t)HALF * g.lda * 2, hstepB = (size_t)HALF * g.ldb * 2;
    const size_t tstepA = 2 * hstepA, tstepB = 2 * hstepB;
    const unsigned ldsw = (unsigned)wid * 1024u;
    const int aoff = lds_byte(wr * 64 + fr, fq * 8), boff = lds_byte(wc * 32 + fr, fq * 8);
#define PG8_SA(b, h) (((b) * 2 + (h)) * HTB)
#define PG8_SB(b, h) ((4 + (b) * 2 + (h)) * HTB)
#define PG8_STAGE(bufoff, gbase, voff) do { _Pragma("unroll") for (int _i = 0; _i < 2; ++_i) \
        __builtin_amdgcn_global_load_lds((const unsigned*)((const char*)(gbase) + (voff)[_i]), (LAS unsigned*)(lds + (bufoff) + ldsw + _i * 8192), 16, 0, 0); } while (0)
#define PG8_LDA(dst, b, h) do { _Pragma("unroll") for (int m = 0; m < 4; ++m) _Pragma("unroll") for (int k = 0; k < 2; ++k) dst[m][k] = *(const LAS hf8*)(lds + PG8_SA(b, h) + aoff + m * 2048 + k * 1024); } while (0)
#define PG8_LDB(dst, b, h) do { _Pragma("unroll") for (int n = 0; n < 2; ++n) _Pragma("unroll") for (int k = 0; k < 2; ++k) dst[n][k] = *(const LAS hf8*)(lds + PG8_SB(b, h) + boff + n * 2048 + k * 1024); } while (0)
#define PG8_MMA(ai, bj, At, Bt) do { __builtin_amdgcn_s_setprio(1); _Pragma("unroll") for (int m = 0; m < 4; ++m) _Pragma("unroll") for (int n = 0; n < 2; ++n) _Pragma("unroll") for (int k = 0; k < 2; ++k) \
        acc[ai][bj][m][n] = __builtin_amdgcn_mfma_f32_16x16x32_f16(Bt[n][k], At[m][k], acc[ai][bj][m][n], 0, 0, 0); __builtin_amdgcn_s_setprio(0); } while (0)
#define PG8_WAIT_V(n) asm volatile("s_waitcnt vmcnt(" #n ")" ::: "memory")
#define PG8_WAIT_L(n) asm volatile("s_waitcnt lgkmcnt(" #n ")" ::: "memory")
#define PG8_BAR __builtin_amdgcn_s_barrier()
#define PG8_SCHED __builtin_amdgcn_sched_barrier(0)
    Unit cur, nxt; int ui = 0;
    if (!S.next(0, cur)) return;
    f32x4 acc[2][2][4][2];
#pragma unroll
    for (int a = 0; a < 2; ++a)
#pragma unroll
        for (int b = 0; b < 2; ++b)
#pragma unroll
            for (int m = 0; m < 4; ++m)
#pragma unroll
                for (int n = 0; n < 2; ++n) acc[a][b][m][n] = (f32x4){0.f, 0.f, 0.f, 0.f};
    hf8 At[4][2], B0[2][2], B1[2][2];
    const char* cA = (const char*)g.A + (size_t)cur.pm * tstepA; const char* cB = (const char*)g.Bt + (size_t)cur.pn * tstepB;
    S.a_ready(cur);
    PG8_STAGE(PG8_SB(0, 0), cB, voffB); PG8_STAGE(PG8_SB(0, 1), cB + hstepB, voffB); PG8_STAGE(PG8_SA(0, 0), cA, voffA); PG8_STAGE(PG8_SA(0, 1), cA + hstepA, voffA);
    if (wr == 1) PG8_BAR;
    PG8_WAIT_V(2); PG8_BAR;
    PG8_STAGE(PG8_SB(1, 0), cB + kstep, voffB); PG8_STAGE(PG8_SA(1, 0), cA + kstep, voffA); PG8_STAGE(PG8_SB(1, 1), cB + hstepB + kstep, voffB);
    PG8_WAIT_V(6); PG8_BAR;
    for (;;) {
        const bool has_next = S.next(ui + 1, nxt);
        const char* nA = has_next ? (const char*)g.A + (size_t)nxt.pm * tstepA : cA; const char* nB = has_next ? (const char*)g.Bt + (size_t)nxt.pn * tstepB : cB;
#pragma unroll 1
        for (int t = 0; t < nt; t += 2) {
            const bool last = (t == nt - 2);
            const char* a1 = cA + (size_t)(t + 1) * kstep;
            const char* a2 = last ? nA : cA + (size_t)(t + 2) * kstep; const char* b2 = last ? nB : cB + (size_t)(t + 2) * kstep;
            const char* a3 = a2 + kstep; const char* b3 = b2 + kstep;
            if (last && has_next) S.a_ready(nxt);
            if constexpr (Epi::MIDK) { if (t == Epi::MID1 || t == Epi::MID2) E.mid(acc, cur, t == Epi::MID1 ? 0 : 1, wr, wc, fr, fq); }
            if constexpr (Epi::PRE) { if (last) E.prefetch(cur, wid, lane); }
            PG8_LDB(B0, 0, 0); PG8_LDB(B1, 0, 1); PG8_SCHED; PG8_LDA(At, 0, 0); PG8_STAGE(PG8_SA(1, 1), a1 + hstepA, voffA);
            PG8_WAIT_V(8); PG8_WAIT_L(0); PG8_BAR; PG8_MMA(0, 0, At, B0); PG8_MMA(0, 1, At, B1); PG8_BAR; PG8_SCHED;
            PG8_LDA(At, 0, 1); PG8_STAGE(PG8_SB(0, 0), b2, voffB); PG8_STAGE(PG8_SB(0, 1), b2 + hstepB, voffB); PG8_STAGE(PG8_SA(0, 0), a2, voffA);
            PG8_WAIT_V(8); PG8_WAIT_L(0); PG8_BAR; PG8_MMA(1, 0, At, B0); PG8_MMA(1, 1, At, B1); PG8_BAR; PG8_SCHED;
            PG8_LDB(B0, 1, 0); PG8_LDB(B1, 1, 1); PG8_SCHED; PG8_LDA(At, 1, 0); PG8_STAGE(PG8_SA(0, 1), a2 + hstepA, voffA);
            PG8_WAIT_V(8); PG8_WAIT_L(0); PG8_BAR; PG8_MMA(0, 0, At, B0); PG8_MMA(0, 1, At, B1); PG8_BAR; PG8_SCHED;
            PG8_LDA(At, 1, 1); PG8_STAGE(PG8_SB(1, 0), b3, voffB); PG8_STAGE(PG8_SB(1, 1), b3 + hstepB, voffB); PG8_STAGE(PG8_SA(1, 0), a3, voffA);
            PG8_WAIT_V(8); PG8_WAIT_L(0); PG8_BAR; PG8_MMA(1, 0, At, B0); PG8_MMA(1, 1, At, B1); PG8_BAR; PG8_SCHED;
        }
        if constexpr (ALIGN_EPI) { if (wr == 0) PG8_BAR; }
        E(acc, cur, wr, wc, fr, fq); S.done(cur);
#ifdef PROBE_EPI2
        if (Epi::PROBE2) { asm volatile("" ::: "memory"); E(acc, cur, wr, wc, fr, fq); }
#endif
        if (!has_next) break;
#pragma unroll
        for (int a = 0; a < 2; ++a)
#pragma unroll
            for (int b = 0; b < 2; ++b)
#pragma unroll
                for (int m = 0; m < 4; ++m)
#pragma unroll
                    for (int n = 0; n < 2; ++n) acc[a][b][m][n] = (f32x4){0.f, 0.f, 0.f, 0.f};
        cur = nxt; cA = nA; cB = nB; ++ui;
        if constexpr (ALIGN_EPI) { if (wr == 1) PG8_BAR; }
    }
    PG8_WAIT_V(0);
    if constexpr (!ALIGN_EPI) { if (wr == 0) PG8_BAR; }
    PG8_BAR;
#undef PG8_SA
#undef PG8_SB
#undef PG8_STAGE
#undef PG8_LDA
#undef PG8_LDB
#undef PG8_MMA
#undef PG8_WAIT_V
#undef PG8_WAIT_L
#undef PG8_BAR
#undef PG8_SCHED
}
}

struct Params {
    const float* in[35];
    float* out;
    unsigned char* ws;
    int ph_lo, ph_hi;
};
enum { I_X = 0, I_C, I_CTX, I_CCTX, I_NMG, I_NFG, I_WMOD, I_BMOD, I_WIN, I_QNG, I_WUQ, I_KVNG, I_WUKV, I_HCW, I_HCB, I_HW1, I_HB1, I_HFREQ, I_HW2, I_HB2, I_HW3, I_HB3,
       I_HSKIP, I_LQ1, I_LK1, I_LQ2, I_LK2, I_SUBG, I_WBRA, I_WBRB, I_WBRC, I_WOUT, I_FC1, I_FC2, I_FNG };

struct Frame {
    LAS unsigned char* lds;
    int tid, lane, wave, vcu, G;
};

__device__ __forceinline__ void tr_item(const float* W, int ldw, hf* WT, int ldt, int nblk, LAS float* scr, int item, int lane, const float* kgain = nullptr) {
    const int kb = item / nblk, nb = item % nblk, k0 = 64 * kb, n0 = 32 * nb;
#pragma unroll 8
    for (int i = 0; i < 32; ++i) { const int kk = 2 * i + (lane >> 5); const float gk = kgain ? kgain[k0 + kk] : 1.f; { float wv = W[(size_t)(k0 + kk) * ldw + n0 + (lane & 31)] * gk; unsigned ub = __float_as_uint(wv); ub += 0x7fffu + ((ub >> 16) & 1u); ub &= 0xffff0000u; scr[kk * 33 + (lane & 31)] = __uint_as_float(ub); } }
    LDS_WAIT(); asm volatile("" ::: "memory");
    const int c = lane & 7;
#pragma unroll
    for (int j = 0; j < 4; ++j) { const int n = (lane >> 3) + 8 * j; const LAS float* s = scr + (8 * c) * 33 + n;
        u32x4 o; o.x = pkh(s[0 * 33], s[1 * 33]); o.y = pkh(s[2 * 33], s[3 * 33]); o.z = pkh(s[4 * 33], s[5 * 33]); o.w = pkh(s[6 * 33], s[7 * 33]);
        *(u32x4*)(WT + (size_t)(n0 + n) * ldt + k0 + 8 * c) = o; }
    LDS_WAIT(); asm volatile("" ::: "memory");
}
__device__ __forceinline__ float silu_f(float x) { return x / (1.f + expf(-x)); }

__device__ __forceinline__ void mod_phase(const Frame& F, const Params& p) {
    float* MOD = (float*)(p.ws + WS_MOD);
    LAS float* sv = (LAS float*)F.lds;
    constexpr int NCB = DEPTH * MODW / 512;
    for (int item = F.vcu; item < NCB * 3; item += F.G) {
        const int cb = item / 3, vg = item % 3;
        __syncthreads();
        for (int i = F.tid; i < 11 * 1024; i += 512) { const int v = vg * 11 + i / 1024, k = i % 1024;
            const float c = (v < NB) ? p.in[I_C][v * DM + k] : p.in[I_CCTX][k]; sv[i] = silu_f(c); }
        __syncthreads();
        const int gcol = cb * 512 + F.tid, l = gcol / MODW, n = gcol % MODW;
        const float* w = p.in[I_WMOD] + (size_t)l * DM * MODW + n;
        float acc[11];
#pragma unroll
        for (int v = 0; v < 11; ++v) acc[v] = 0.f;
#pragma unroll 4
        for (int k = 0; k < DM; k += 4) {
            const float w0 = w[(size_t)k * MODW], w1 = w[(size_t)(k + 1) * MODW], w2 = w[(size_t)(k + 2) * MODW], w3 = w[(size_t)(k + 3) * MODW];
#pragma unroll
            for (int v = 0; v < 11; ++v) { const f32x4 s = *(const LAS f32x4*)(sv + v * 1024 + k);
                acc[v] = fmaf(s[0], w0, acc[v]); acc[v] = fmaf(s[1], w1, acc[v]); acc[v] = fmaf(s[2], w2, acc[v]); acc[v] = fmaf(s[3], w3, acc[v]); }
        }
        const float bm = p.in[I_BMOD][(size_t)l * MODW + n];
#pragma unroll
        for (int v = 0; v < 11; ++v) MOD[((size_t)l * NMODV + vg * 11 + v) * MODW + n] = acc[v] + bm;
    }
    __syncthreads();
}

__device__ __forceinline__ void filt_item(const Params& p, int l, int kind  , int t, int lane) {
    const int L = kind ? CTXL : SEQ;
    hf* R = kind ? (hf*)(p.ws + WS_RFC) + (size_t)l * 256 * 512 : (hf*)(p.ws + WS_RF) + (size_t)l * 256 * 4096;
    const int rl = 2 * L;
    const float tl = (float)t / (float)(L - 1);
    const float wt = (6.283185307179586f / (float)L) * (float)t;
    float z = 0.f;
    if (lane == 0) z = tl;
    else if (lane <= 32) { const int bi = (lane - 1) & 15; const float band = 1e-4f + (15.f - 1e-4f) * ((float)bi / 15.f); const float a = band * wt; z = (lane <= 16) ? cosf(a) : -sinf(a); }
    const float* w1 = p.in[I_HW1] + (size_t)l * 33 * 64; const float* w2 = p.in[I_HW2] + (size_t)l * 64 * 64; const float* w3 = p.in[I_HW3] + (size_t)l * 64 * 512;
    const float fr = p.in[I_HFREQ][l * 64 + lane];
    float a1 = p.in[I_HB1][l * 64 + lane];
    for (int i = 0; i < 33; ++i) a1 = fmaf(__shfl(z, i), w1[i * 64 + lane], a1);
    a1 = sinf(fr * a1);
    float a2 = p.in[I_HB2][l * 64 + lane];
    for (int i = 0; i < 64; ++i) a2 = fmaf(__shfl(a1, i), w2[i * 64 + lane], a2);
    a2 = sinf(fr * a2);
    float h[8];
#pragma unroll
    for (int q = 0; q < 8; ++q) h[q] = p.in[I_HB3][l * 512 + q * 64 + lane];
    for (int i = 0; i < 64; ++i) { const float a = __shfl(a2, i);
#pragma unroll
        for (int q = 0; q < 8; ++q) h[q] = fmaf(a, w3[i * 512 + q * 64 + lane], h[q]); }
    const float d0 = -4.605170185988091f / 1.5f, d1 = -4.605170185988091f / 0.3f;
#pragma unroll
    for (int q = 0; q < 8; ++q) { const int o = q * 64 + lane, dir = o >> 8, c = o & 255;
        const float delta = fabsf(d0 + (d1 - d0) * ((float)c / 255.f));
        float val = h[q] * (expf(-tl * delta) + 0.05f);
        if (dir == 0) { if (t == 0) val += p.in[I_HSKIP][l * 256 + c]; R[(size_t)c * rl + (L - t)] = (hf)val; if (t == 0) R[(size_t)c * rl] = (hf)0.f; }
        else if (t >= 1) R[(size_t)c * rl + (L + t)] = (hf)val; }
}

__device__ __forceinline__ void convert_layer(const Frame& F, const Params& p, int l, unsigned char* wl, int wg_rank, int wg_count) {
    LAS float* scr = (LAS float*)(F.lds + F.wave * 16384);
    const int gw = wg_rank * 8 + F.wave, NGW = wg_count * 8, lane = F.lane;
    constexpr int IT_IN1 = 16 * 61, IT_ING = 16 * 96, IT_UQ = 4 * 24, IT_UKV = 2 * 32, IT_BRA = 8 * 32, IT_BRB = 4 * 32, IT_BRC = 4 * 32, IT_OUT = 16 * 32, IT_FC1 = 16 * 128, IT_FC2 = 64 * 32;
    constexpr int IT_LAYER = IT_IN1 + IT_ING + IT_UQ + IT_UKV + IT_BRA + IT_BRB + IT_BRC + IT_OUT + IT_FC1 + IT_FC2;
    for (int it = gw; it < IT_LAYER; it += NGW) {
        int r = it;
        if (r < IT_IN1) { tr_item(p.in[I_WIN] + (size_t)l * DM * D_IN, D_IN, (hf*)(wl + W_IN1), DM, 61, scr, r, lane); continue; } r -= IT_IN1;
        if (r < IT_ING) { tr_item(p.in[I_WIN] + (size_t)l * DM * D_IN + C_PG, D_IN, (hf*)(wl + W_ING), DM, 96, scr, r, lane); continue; } r -= IT_ING;
        if (r < IT_UQ) { tr_item(p.in[I_WUQ] + (size_t)l * 256 * 768, 768, (hf*)(wl + W_UP), KUP, 24, scr, r, lane, p.in[I_QNG] + l * 256); continue; } r -= IT_UQ;
        if (r < IT_UKV) { tr_item(p.in[I_WUKV] + (size_t)l * 128 * 1024, 1024, (hf*)(wl + W_UP) + (size_t)768 * KUP + 256, KUP, 32, scr, r, lane, p.in[I_KVNG] + l * 128); continue; } r -= IT_UKV;
        if (r < IT_BRA) { tr_item(p.in[I_WBRA] + (size_t)l * 512 * DM, DM, (hf*)(wl + W_BR), DM, 32, scr, r, lane); continue; } r -= IT_BRA;
        if (r < IT_BRB) { tr_item(p.in[I_WBRB] + (size_t)l * 256 * DM, DM, (hf*)(wl + W_BR) + 512, DM, 32, scr, r, lane); continue; } r -= IT_BRB;
        if (r < IT_BRC) { tr_item(p.in[I_WBRC] + (size_t)l * 256 * DM, DM, (hf*)(wl + W_BR) + 768, DM, 32, scr, r, lane); continue; } r -= IT_BRC;
        if (r < IT_OUT) { tr_item(p.in[I_WOUT] + (size_t)l * DM * DM, DM, (hf*)(wl + W_OUT), DM, 32, scr, r, lane); continue; } r -= IT_OUT;
        if (r < IT_FC1) { tr_item(p.in[I_FC1] + (size_t)l * DM * DFF, DFF, (hf*)(wl + W_FC1), DM, 128, scr, r, lane); continue; } r -= IT_FC1;
        tr_item(p.in[I_FC2] + (size_t)l * DFF * DM, DM, (hf*)(wl + W_FC2), DFF, 32, scr, r, lane);
    }
    const int gt = gw * 64 + lane, NGT = NGW * 64;
    u32x4* z1 = (u32x4*)((hf*)(wl + W_IN1) + (size_t)C_PG * DM);
    for (int i = gt; i < 96 * DM / 8; i += NGT) z1[i] = (u32x4){0u, 0u, 0u, 0u};
    hf* up = (hf*)(wl + W_UP);
    for (int i = gt; i < 768 * 16; i += NGT) { const int n = i / 16, k8 = i % 16; *(u32x4*)(up + (size_t)n * KUP + 256 + k8 * 8) = (u32x4){0u, 0u, 0u, 0u}; }
    for (int i = gt; i < 1024 * 32; i += NGT) { const int n = 768 + i / 32, k8 = i % 32; *(u32x4*)(up + (size_t)n * KUP + k8 * 8) = (u32x4){0u, 0u, 0u, 0u}; }
}

__device__ __forceinline__ void prologue_a(const Frame& F, const Params& p) {
    mod_phase(F, p);
    convert_layer(F, p, 0, p.ws + WS_WT, F.vcu, F.G);
    const int gw = F.vcu * 8 + F.wave, NGW = F.G * 8, lane = F.lane;
    for (int it = gw; it < DEPTH * (SEQ + CTXL); it += NGW) { const int l = it / (SEQ + CTXL), r = it % (SEQ + CTXL); if (r < SEQ) filt_item(p, l, 0, r, lane); else filt_item(p, l, 1, r - SEQ, lane); }
    {
        float* rope = (float*)(p.ws + WS_ROPE);
        const int gt = gw * 64 + lane, NGT = NGW * 64;
        for (int i = gt; i < SEQ * 16; i += NGT) { const int t = i >> 4, j = i & 15; const float pos = (j < 8) ? (float)(t / GRIDW) : (float)(t % GRIDW);
            const float inv = powf(10000.f, -(float)(j & 7) / 8.f); const float a = pos * inv; rope[t * 32 + j] = cosf(a); rope[t * 32 + 16 + j] = sinf(a); }
        if (gt < DEPTH) { const int l = gt; float s1 = 0.f, s2 = 0.f;
            for (int i = 0; i < 32; ++i) { s1 += p.in[I_LQ1][l * 32 + i] * p.in[I_LK1][l * 32 + i]; s2 += p.in[I_LQ2][l * 32 + i] * p.in[I_LK2][l * 32 + i]; }
            const float li = 0.8f - 0.6f * expf(-0.3f * (float)l);
            float* lam = (float*)(p.ws + WS_LAM); lam[2 * l] = expf(s1) - expf(s2) + li; lam[2 * l + 1] = 1.f - li; }
    }
}
__device__ __forceinline__ void prologue_b(const Frame& F, const Params& p) {
    const float* MOD = (const float*)(p.ws + WS_MOD); float* BIAS = (float*)(p.ws + WS_BIAS);
    {
        LAS float* sv = (LAS float*)F.lds;
        constexpr int NCB = DEPTH * NBIAS / 512;
        for (int item = F.vcu; item < NCB * 3; item += F.G) {
            const int cb = item / 3, vg = item % 3;
            const int gcol = cb * 512 + F.tid, l = gcol / NBIAS, n = gcol % NBIAS, n0 = (cb * 512) % NBIAS;
            const int soff = (n0 >= B_FC1) ? 3 * DM : 0;
            __syncthreads();
            for (int i = F.tid; i < 11 * 1024; i += 512) { const int v = vg * 11 + i / 1024, k = i % 1024; sv[i] = MOD[((size_t)l * NMODV + v) * MODW + soff + k]; }
            __syncthreads();
            const float* w; size_t ldw; bool valid = true;
            if (n < B_G) { w = p.in[I_WIN] + (size_t)l * DM * D_IN + n; ldw = D_IN; valid = n < C_PG; }
            else if (n < B_FC1) { w = p.in[I_WIN] + (size_t)l * DM * D_IN + C_PG + (n - B_G); ldw = D_IN; }
            else { w = p.in[I_FC1] + (size_t)l * DM * DFF + (n - B_FC1); ldw = DFF; }
            float acc[11];
#pragma unroll
            for (int v = 0; v < 11; ++v) acc[v] = 0.f;
            if (valid)
#pragma unroll 4
            for (int k = 0; k < DM; k += 4) {
                const float w0 = w[(size_t)k * ldw], w1 = w[(size_t)(k + 1) * ldw], w2 = w[(size_t)(k + 2) * ldw], w3 = w[(size_t)(k + 3) * ldw];
#pragma unroll
                for (int v = 0; v < 11; ++v) { const f32x4 sx = *(const LAS f32x4*)(sv + v * 1024 + k);
                    acc[v] = fmaf(sx[0], w0, acc[v]); acc[v] = fmaf(sx[1], w1, acc[v]); acc[v] = fmaf(sx[2], w2, acc[v]); acc[v] = fmaf(sx[3], w3, acc[v]); }
            }
#pragma unroll
            for (int v = 0; v < 11; ++v) BIAS[((size_t)l * NMODV + vg * 11 + v) * NBIAS + n] = acc[v];
        }
        __syncthreads();
    }
    const int gw = F.vcu * 8 + F.wave, NGW = F.G * 8, lane = F.lane;
    {
        float* GS = (float*)(p.ws + WS_GS);
        const int gt = gw * 64 + lane, NGT = NGW * 64;
        for (int i = gt; i < DEPTH * 2 * NMODV * DM; i += NGT) { const int c = i % DM, v = (i / DM) % NMODV, wh = (i / (DM * NMODV)) % 2, l = i / (DM * NMODV * 2);
            const float g = wh ? p.in[I_NFG][l * DM + c] : p.in[I_NMG][l * DM + c];
            GS[i] = g * (1.f + MOD[((size_t)l * NMODV + v) * MODW + (wh ? 4 * DM : DM) + c]); }
    }
    {
        hf* XS = (hf*)p.out; hf* X16 = (hf*)(p.ws + WS_X16); float* ss = (float*)(p.ws + WS_SS) + (size_t)SS_1 * MTOT * 4;
        f32x4 g[4];
#pragma unroll
        for (int j = 0; j < 4; ++j) g[j] = *(const f32x4*)(p.in[I_NMG] + 4 * lane + 256 * j);
        for (int row = gw; row < MTOT; row += NGW) {
            const bool lat = row < NLAT; const float* xr = lat ? p.in[I_X] + (size_t)row * DM : p.in[I_CTX] + (size_t)(row - NLAT) * DM;
            const int v = lat ? (row >> 11) : NB; const float* mv = MOD + (size_t)v * MODW + DM;
            float sq = 0.f; hf* hr = XS + (size_t)row * DM; hf* xh = X16 + (size_t)row * DM;
#pragma unroll
            for (int j = 0; j < 4; ++j) { const f32x4 x = *(const f32x4*)(xr + 4 * lane + 256 * j); const f32x4 sc = *(const f32x4*)(mv + 4 * lane + 256 * j);
                sq += (x[0] * x[0] + x[1] * x[1]) + (x[2] * x[2] + x[3] * x[3]);
                const f32x4 o = x * (g[j] * (sc + 1.f)); u32x2 w; w.x = pkhb(o[0], o[1]); w.y = pkhb(o[2], o[3]); *(u32x2*)(hr + 4 * lane + 256 * j) = w;
                u32x2 w2; w2.x = pkh(x[0], x[1]); w2.y = pkh(x[2], x[3]); *(u32x2*)(xh + 4 * lane + 256 * j) = w2; }
            sq = wave_sum(sq);
            if (lane == 0) *(f32x4*)(ss + 4 * (size_t)row) = (f32x4){sq, 0.f, 0.f, 0.f};
        }
    }
}

__device__ __forceinline__ void norm_phase(const Frame& F, const float* xs_lat, const float* xs_ctx, int nrows, const float* gain, const float* modl, int sh_off, int sc_off, hf* H) {
    const int gw = F.vcu * 8 + F.wave, NGW = F.G * 8, lane = F.lane;
    f32x4 g[4];
#pragma unroll
    for (int j = 0; j < 4; ++j) g[j] = *(const f32x4*)(gain + 4 * lane + 256 * j);
    for (int row = gw; row < nrows; row += NGW) {
        const bool lat = row < NLAT; const float* xr = lat ? xs_lat + (size_t)row * DM : xs_ctx + (size_t)(row - NLAT) * DM;
        const int v = lat ? (row >> 11) : NB; const float* mv = modl + (size_t)v * MODW;
        f32x4 x[4]; float ss = 0.f;
#pragma unroll
        for (int j = 0; j < 4; ++j) { x[j] = *(const f32x4*)(xr + 4 * lane + 256 * j); ss += (x[j][0] * x[j][0] + x[j][1] * x[j][1]) + (x[j][2] * x[j][2] + x[j][3] * x[j][3]); }
        const float rstd = rsqrtf(wave_sum(ss) * (1.f / DM) + EPS);
        hf* hr = H + (size_t)row * DM;
#pragma unroll
        for (int j = 0; j < 4; ++j) { const f32x4 sh = *(const f32x4*)(mv + sh_off + 4 * lane + 256 * j), sc = *(const f32x4*)(mv + sc_off + 4 * lane + 256 * j);
            const f32x4 y = (x[j] * rstd) * g[j]; const f32x4 o = y * (sc + 1.f) + sh;
            u32x2 w; w.x = pkh(o[0], o[1]); w.y = pkh(o[2], o[3]); *(u32x2*)(hr + 4 * lane + 256 * j) = w; }
    }
}
__device__ __forceinline__ void final_norm_phase(const Frame& F, const hf* X16, float* out, const float* gain, const float* ss) {
    const int gw = F.vcu * 8 + F.wave, NGW = F.G * 8, lane = F.lane;
    f32x4 g[4];
#pragma unroll
    for (int j = 0; j < 4; ++j) g[j] = *(const f32x4*)(gain + 4 * lane + 256 * j);
    for (int row = gw; row < NLAT; row += NGW) {
        const hf* xr = X16 + (size_t)row * DM; float* orow = out + (size_t)row * DM; const float rstd = rstd4(ss, row);
#pragma unroll
        for (int j = 0; j < 4; ++j) { const hf4 xh = *(const hf4*)(xr + 4 * lane + 256 * j); const f32x4 x = {(float)xh[0], (float)xh[1], (float)xh[2], (float)xh[3]};
            *(f32x4*)(orow + 4 * lane + 256 * j) = (x * rstd) * g[j]; }
    }
}

__device__ __forceinline__ void prep_rope(const Frame& F, const Params& p) {
    const int gw = F.vcu * 8 + F.wave, NGW = F.G * 8, lane = F.lane;
    hf* KR = (hf*)(p.ws + A_KR); hf* DK = (hf*)(p.ws + A_DK); const float* rope = (const float*)(p.ws + WS_ROPE);
    const int hh = lane >> 3, i0 = 2 * (lane & 7);
    for (int row0 = gw * 4; row0 < NLAT; row0 += NGW * 4) {
        hf2 a[4], b[4]; f32x2 c[4], sn[4]; float y1[4], y2[4], cc[4], ss[4];
#pragma unroll
        for (int q = 0; q < 4; ++q) { const int row = row0 + q, t = row & (SEQ - 1); const hf* dk = DK + (size_t)row * 256 + hh * 32 + i0;
            a[q] = *(const hf2*)dk; b[q] = *(const hf2*)(dk + 16); c[q] = *(const f32x2*)(rope + t * 32 + i0); sn[q] = *(const f32x2*)(rope + t * 32 + 16 + i0);
            if (lane < 16) { const hf* kr = KR + (size_t)row * 32 + lane; y1[q] = (float)kr[0]; y2[q] = (float)kr[16]; cc[q] = rope[t * 32 + lane]; ss[q] = rope[t * 32 + 16 + lane]; } }
#pragma unroll
        for (int q = 0; q < 4; ++q) { const int row = row0 + q; hf* dk = DK + (size_t)row * 256 + hh * 32 + i0;
            const float x1[2] = {(float)a[q][0], (float)a[q][1]}, x2[2] = {(float)b[q][0], (float)b[q][1]};
            *(unsigned*)dk = pkh(x1[0] * c[q][0] - x2[0] * sn[q][0], x1[1] * c[q][1] - x2[1] * sn[q][1]);
            *(unsigned*)(dk + 16) = pkh(x2[0] * c[q][0] + x1[0] * sn[q][0], x2[1] * c[q][1] + x1[1] * sn[q][1]);
            if (lane < 16) { hf* kr = KR + (size_t)row * 32 + lane; kr[0] = (hf)(y1[q] * cc[q] - y2[q] * ss[q]); kr[16] = (hf)(y2[q] * cc[q] + y1[q] * ss[q]); } }
    }
}
__device__ __forceinline__ void prep_hyena(const Frame& F, const Params& p, int l, bool with_ctx) {
    constexpr int INP = 784;
    constexpr int OUTP = 33;
    constexpr int OFF_OU = 66 * INP, OFF_OX = OFF_OU + 128 * OUTP * 4;
    const hf* PHY = (const hf*)(p.ws + A_PHY);
    LAS unsigned char* lds = F.lds; const int tid = F.tid;
    const float* cw = p.in[I_HCW] + (size_t)l * 3 * 768; const float* cb = p.in[I_HCB] + (size_t)l * 768;
    constexpr int U_LAT = NB * (SEQ / 64) * 2, U_CTX = NB * (CTXL / 64) * 2;
    const int nunit = U_LAT + (with_ctx ? U_CTX : 0);
    for (int un = F.vcu; un < nunit; un += F.G) {
        const bool ctx = un >= U_LAT; int r = ctx ? un - U_LAT : un; const int L = ctx ? CTXL : SEQ, ntile = L / 64;
        const int ch = r & 1; r >>= 1; const int tt = r % ntile, b = r / ntile;
        const int t0 = tt * 64; const size_t rowbase = ctx ? (size_t)NLAT + (size_t)b * CTXL : (size_t)b * SEQ;
        hf* dU = (hf*)((unsigned char*)p.out + (ctx ? O_UTC : O_UT)); hf* dX = (hf*)((unsigned char*)p.out + (ctx ? O_X0TC : O_X0T));
        __syncthreads();
        {
            u32x4 tmp[7];
#pragma unroll
            for (int k = 0; k < 7; ++k) { const int i = tid + 512 * k, rr = i / 48, q = i % 48, seg = q >> 4, c16 = q & 15; const int t = t0 - 1 + rr;
                tmp[k] = (u32x4){0u, 0u, 0u, 0u};
                if (i < 66 * 48 && t >= 0 && t < L) tmp[k] = *(const u32x4*)(PHY + (rowbase + t) * 768 + seg * 256 + ch * 128 + c16 * 8); }
#pragma unroll
            for (int k = 0; k < 7; ++k) { const int i = tid + 512 * k, rr = i / 48, q = i % 48, seg = q >> 4, c16 = q & 15;
                if (i < 66 * 48) *(LAS u32x4*)(lds + rr * INP + seg * 256 + c16 * 16) = tmp[k]; }
        }
        __syncthreads();
        {
            const int c = tid & 127, tg = tid >> 7, cg = ch * 128 + c;
            const float a0 = cw[cg], a1 = cw[768 + cg], a2 = cw[1536 + cg], ab = cb[cg];
            const float b0 = cw[256 + cg], b1 = cw[768 + 256 + cg], b2 = cw[1536 + 256 + cg], bb = cb[256 + cg];
            const float v0 = cw[512 + cg], v1 = cw[768 + 512 + cg], v2 = cw[1536 + 512 + cg], vb = cb[512 + cg];
            const LAS hf* in = (const LAS hf*)(lds + (16 * tg) * INP) + c;
            float p0 = (float)in[0], p1 = (float)in[128], p2 = (float)in[256];
            float c0 = (float)in[INP / 2], c1 = (float)in[INP / 2 + 128], c2 = (float)in[INP / 2 + 256];
            LAS hf* ou = (LAS hf*)(lds + OFF_OU) + c * (OUTP * 2) + 16 * tg; LAS hf* ox = (LAS hf*)(lds + OFF_OX) + c * (OUTP * 2) + 16 * tg;
#pragma unroll
            for (int j = 0; j < 16; ++j) { const LAS hf* nx = in + (j + 2) * (INP / 2);
                const float n0 = (float)nx[0], n1 = (float)nx[128], n2 = (float)nx[256];
                const float x0 = a0 * p0 + a1 * c0 + a2 * n0 + ab, x1 = b0 * p1 + b1 * c1 + b2 * n1 + bb, vv = v0 * p2 + v1 * c2 + v2 * n2 + vb;
                ou[j] = (hf)(vv * x1); ox[j] = (hf)x0;
                p0 = c0; p1 = c1; p2 = c2; c0 = n0; c1 = n1; c2 = n2; }
        }
        __syncthreads();
        {
            const int c = tid >> 2, q = tid & 3; const size_t go = ((size_t)(ch * 128 + c) * NB + b) * L + t0 + 16 * q;
            const LAS unsigned* su = (const LAS unsigned*)(lds + OFF_OU) + c * OUTP + 8 * q; const LAS unsigned* sx = (const LAS unsigned*)(lds + OFF_OX) + c * OUTP + 8 * q;
            u32x4 w0 = {su[0], su[1], su[2], su[3]}, w1 = {su[4], su[5], su[6], su[7]};
            *(u32x4*)(dU + go) = w0; *(u32x4*)(dU + go + 8) = w1;
            u32x4 y0 = {sx[0], sx[1], sx[2], sx[3]}, y1 = {sx[4], sx[5], sx[6], sx[7]};
            *(u32x4*)(dX + go) = y0; *(u32x4*)(dX + go + 8) = y1;
        }
    }
    __syncthreads();
}

namespace att {
#ifndef PROF_SEL
#define PROF_SEL -1
#endif
#define ATT_MARK(b) do { if (PROF_SEL >= 0 && F.tid == 0) { volatile LAS unsigned* _pf = (volatile LAS unsigned*)(F.lds + LDS_BYTES - 512); const unsigned _t = (unsigned)__builtin_amdgcn_s_memrealtime(); _pf[(b)] += _t - _pf[32]; _pf[32] = _t; } } while (0)
__device__ __forceinline__ int crow(int r, int hi) { return (r & 3) + 8 * (r >> 2) + 4 * hi; }
#define SBAR() __builtin_amdgcn_sched_barrier(0)
constexpr float THR2 = 8.f * 1.4426950408889634f;
constexpr int KS_MLA = 208, KS_DF = 80;
constexpr int VS = 192, VB = 64 * VS;
constexpr int OFF_V = 32768;
template <int OFF> __device__ __forceinline__ s16x4 tr_read(int vb) {
    s16x4 r; asm volatile("ds_read_b64_tr_b16 %0, %1 offset:%2" : "=&v"(r) : "v"(vb), "i"(OFF) : "memory"); return r;
}
__device__ __forceinline__ int kpos(int key) { return (key & ~0xC) | ((key & 4) << 1) | ((key & 8) >> 1); }

template <int ND0, int KS>
__device__ __forceinline__ void qkt(f32x16& p0, f32x16& p1, const LAS unsigned char* Ks, const hf8* qr, int r32, int hi, const f32x16& negm) {
#pragma unroll
    for (int d0 = 0; d0 < ND0; ++d0) { const int cb = (d0 * 16 + hi * 8) * 2;
        const hf8 b0 = *(const LAS hf8*)(Ks + r32 * KS + cb), b1 = *(const LAS hf8*)(Ks + (32 + r32) * KS + cb);
        if (d0 == 0) { p0 = __builtin_amdgcn_mfma_f32_32x32x16_f16(b0, qr[0], negm, 0, 0, 0); p1 = __builtin_amdgcn_mfma_f32_32x32x16_f16(b1, qr[0], negm, 0, 0, 0); }
        else { p0 = __builtin_amdgcn_mfma_f32_32x32x16_f16(b0, qr[d0], p0, 0, 0, 0); p1 = __builtin_amdgcn_mfma_f32_32x32x16_f16(b1, qr[d0], p1, 0, 0, 0); } }
}
__device__ __forceinline__ float max3f(float a, float b, float c) { float r; asm("v_max3_f32 %0, %1, %2, %3" : "=v"(r) : "v"(a), "v"(b), "v"(c)); return r; }
__device__ __forceinline__ float max2f(float a, float b) { float r; asm("v_max_f32_e32 %0, %1, %2" : "=v"(r) : "v"(a), "v"(b)); return r; }
__device__ __forceinline__ float max16(const f32x16& p) { float r, t;
    asm("v_max3_f32 %0, %2, %3, %4\n\tv_max3_f32 %1, %10, %11, %12\n\tv_max3_f32 %0, %0, %5, %6\n\tv_max3_f32 %1, %1, %13, %14\n\tv_max3_f32 %0, %0, %7, %8\n\tv_max3_f32 %1, %1, %15, %16\n\tv_max3_f32 %0, %0, %9, %17\n\tv_max_f32_e32 %0, %0, %1"
        : "=&v"(r), "=&v"(t) : "v"(p[0]), "v"(p[1]), "v"(p[2]), "v"(p[3]), "v"(p[4]), "v"(p[5]), "v"(p[6]), "v"(p[7]), "v"(p[8]), "v"(p[9]), "v"(p[10]), "v"(p[11]), "v"(p[12]), "v"(p[13]), "v"(p[14]), "v"(p[15]));
    return r; }
__device__ __forceinline__ hf8 pack8(const f32x16& p, int b) { u32x4 w = {pkh(p[b], p[b + 1]), pkh(p[b + 2], p[b + 3]), pkh(p[b + 4], p[b + 5]), pkh(p[b + 6], p[b + 7])}; return __builtin_bit_cast(hf8, w); }
__device__ __forceinline__ void sm_max(f32x16& p0, f32x16& p1, float& m, float& l, f32x16& o0, f32x16& o1, f32x16& negm, const bool first) {
    float pmax = max2f(max16(p0), max16(p1));
    { auto rr = __builtin_amdgcn_permlane32_swap(__float_as_uint(pmax), __float_as_uint(pmax), false, false);
      pmax = max2f(__uint_as_float(rr[0]), __uint_as_float(rr[1])); }
    if (first || __any(pmax > THR2)) {
        const float delta = first ? pmax : fmaxf(pmax, 0.f);
        if (!first) { const float alpha = __builtin_amdgcn_exp2f(-delta); l *= alpha;
#pragma unroll
            for (int r = 0; r < 16; ++r) { o0[r] *= alpha; o1[r] *= alpha; } }
#pragma unroll
        for (int r = 0; r < 16; ++r) { p0[r] -= delta; p1[r] -= delta; }
        m += delta;
#pragma unroll
        for (int r = 0; r < 16; ++r) negm[r] = -m;
        asm volatile("" : "+v"(negm));
    }
}
__device__ __forceinline__ void sm_exp(f32x16& p0, f32x16& p1, const float m, float& l, hf8& pf0, hf8& pf1, hf8& pf2, hf8& pf3) {
#pragma unroll
    for (int r = 0; r < 16; ++r) { p0[r] = __builtin_amdgcn_exp2f(p0[r]); p1[r] = __builtin_amdgcn_exp2f(p1[r]); }
    float ps0 = p0[0] + p1[0], ps1 = p0[1] + p1[1], ps2 = p0[2] + p1[2], ps3 = p0[3] + p1[3];
#pragma unroll
    for (int r = 4; r < 16; r += 4) { ps0 += p0[r] + p1[r]; ps1 += p0[r + 1] + p1[r + 1]; ps2 += p0[r + 2] + p1[r + 2]; ps3 += p0[r + 3] + p1[r + 3]; }
    l += (ps0 + ps1) + (ps2 + ps3);
    pf0 = pack8(p0, 0); pf1 = pack8(p0, 8); pf2 = pack8(p1, 0); pf3 = pack8(p1, 8);
}
__device__ __forceinline__ void pv(const hf8 pf0, const hf8 pf1, const hf8 pf2, const hf8 pf3, f32x16& o0, f32x16& o1, const LAS unsigned char* Vt, int r32, int hi) {
    const int lg = (int)(threadIdx.x & 15), vq = lg >> 2, vp4 = lg & 3;
    const int vbase = (int)(unsigned)(uintptr_t)Vt + (4 * hi + vq) * VS + (16 * ((int)(threadIdx.x >> 4) & 1) + 4 * vp4) * 2;
#define PVRD(ks, L0, H0, L1, H1) s16x4 L0 = tr_read<(16 * (ks)) * VS>(vbase), H0 = tr_read<(16 * (ks) + 8) * VS>(vbase), L1 = tr_read<(16 * (ks)) * VS + 64>(vbase), H1 = tr_read<(16 * (ks) + 8) * VS + 64>(vbase)
#define PVMM(N, L0, H0, L1, H1, pf) do { asm volatile("s_waitcnt lgkmcnt(" #N ")" : "+v"(L0), "+v"(H0), "+v"(L1), "+v"(H1) :: "memory"); \
        const hf8 a0 = __builtin_bit_cast(hf8, (short __attribute__((ext_vector_type(8)))){L0[0], L0[1], L0[2], L0[3], H0[0], H0[1], H0[2], H0[3]}); \
        const hf8 a1 = __builtin_bit_cast(hf8, (short __attribute__((ext_vector_type(8)))){L1[0], L1[1], L1[2], L1[3], H1[0], H1[1], H1[2], H1[3]}); \
        o0 = __builtin_amdgcn_mfma_f32_32x32x16_f16(a0, pf, o0, 0, 0, 0); o1 = __builtin_amdgcn_mfma_f32_32x32x16_f16(a1, pf, o1, 0, 0, 0); } while (0)
    PVRD(0, a0l, a0h, a1l, a1h); PVRD(1, b0l, b0h, b1l, b1h);
    PVMM(4, a0l, a0h, a1l, a1h, pf0);
    PVRD(2, c0l, c0h, c1l, c1h);
    PVMM(4, b0l, b0h, b1l, b1h, pf1);
    PVRD(3, d0l, d0h, d1l, d1h);
    PVMM(4, c0l, c0h, c1l, c1h, pf2);
    PVMM(0, d0l, d0h, d1l, d1h, pf3);
#undef PVRD
#undef PVMM
#define PVK(ks, pf)
#undef PVK
}

template <bool MLA>
__device__ __forceinline__ void attn_pass(const Frame& F, const Params& p, int hq, int hv, int qrow0, int qpos0, int klat0, int nlat, int kctx0, f32x16& o0, f32x16& o1, float& inv) {
    constexpr int DK = MLA ? 96 : 32, ND0 = DK / 16, KS = MLA ? KS_MLA : KS_DF, KB = 64 * KS;
    constexpr float SCALE = MLA ? MLA_SCALE : DF_SCALE, C = SCALE * 1.4426950408889634f;
    const int tid = F.tid, wid = F.wave, lane = F.lane, r32 = lane & 31, hi = lane >> 5;
    const hf* QKV = (const hf*)(p.ws + A_QKV); const hf* KRb = (const hf*)(p.ws + A_KR);
    const hf* DQ = (const hf*)(p.ws + A_DQ); const hf* DKb = (const hf*)(p.ws + A_DK); const hf* DVb = (const hf*)(p.ws + A_DV);
    const float* rope = (const float*)(p.ws + WS_ROPE);
    LAS unsigned char* lds = F.lds;
    hf8 qr[ND0];
    {
        const int qrow = qrow0 + wid * 32 + r32;
        const hf* qp = MLA ? QKV + (size_t)qrow * NUP + hq * 96 + hi * 8 : DQ + (size_t)qrow * 256 + hq * 32 + hi * 8;
        hf8 raw[ND0];
#pragma unroll
        for (int d0 = 0; d0 < ND0; ++d0) raw[d0] = *(const hf8*)(qp + d0 * 16);
        f32x4 c0 = {1.f, 1.f, 1.f, 1.f}, c1 = c0, s0 = {0.f, 0.f, 0.f, 0.f}, s1 = s0;
        if (qpos0 >= 0) { const int t = qpos0 + wid * 32 + r32;
            c0 = *(const f32x4*)(rope + t * 32 + hi * 8); c1 = *(const f32x4*)(rope + t * 32 + hi * 8 + 4);
            s0 = *(const f32x4*)(rope + t * 32 + 16 + hi * 8); s1 = *(const f32x4*)(rope + t * 32 + 16 + hi * 8 + 4); }
#pragma unroll
        for (int d0 = 0; d0 < ND0 - 2; ++d0) {
#pragma unroll
            for (int j = 0; j < 8; ++j) qr[d0][j] = (hf)((float)raw[d0][j] * C); }
#pragma unroll
        for (int j = 0; j < 8; ++j) { const float cc = j < 4 ? c0[j & 3] : c1[j & 3], sn = j < 4 ? s0[j & 3] : s1[j & 3]; const float a = (float)raw[ND0 - 2][j], b = (float)raw[ND0 - 1][j];
            qr[ND0 - 2][j] = (hf)((a * cc - b * sn) * C); qr[ND0 - 1][j] = (hf)((b * cc + a * sn) * C); }
    }
    const int k1r = MLA ? (tid >> 3) : ((tid & 255) >> 2), k1c = MLA ? (tid & 7) * 8 : (tid & 3) * 8;
    const int k2r = (tid & 255) >> 2, k2c = (tid & 3) * 8;
    const int vr_ = tid >> 3, vc_ = (tid & 7) * 8;
    const bool klo = tid < 256;
    struct Stg { u32x4 v, k1, k2; };
    Stg sA, sB; sA.v = sA.k1 = sA.k2 = sB.v = sB.k1 = sB.k2 = (u32x4){0u, 0u, 0u, 0u};
    const int ntile = nlat + 4;
#define KROW0(j) (((j) < nlat) ? klat0 + (j) * 64 : kctx0 + ((j) - nlat) * 64)
#define A_LOADK(S, j) do { const int kr0 = KROW0(j); \
        if (MLA) { S.k1 = *(const u32x4*)(QKV + (size_t)(kr0 + k1r) * NUP + 768 + hq * 128 + k1c); S.k2 = *(const u32x4*)(KRb + (size_t)(kr0 + k2r) * 32 + k2c); } \
        else S.k1 = *(const u32x4*)(DKb + (size_t)(kr0 + k1r) * 256 + hq * 32 + k1c); } while (0)
#define A_LOADV(S, j) do { const int kr0 = KROW0(j); \
        if (MLA) S.v = *(const u32x4*)(QKV + (size_t)(kr0 + vr_) * NUP + 768 + hv * 128 + 64 + vc_); else S.v = *(const u32x4*)(DVb + (size_t)(kr0 + vr_) * 256 + hv * 64 + vc_); } while (0)
#define A_WRITEK(S, b) do { *(LAS u32x4*)(lds + (b) * KB + k1r * KS + k1c * 2) = S.k1; if (MLA) *(LAS u32x4*)(lds + (b) * KB + k2r * KS + 128 + k2c * 2) = S.k2; } while (0)
#define A_WRITEV(S, b) do { *(LAS u32x4*)(lds + OFF_V + (b) * VB + vr_ * VS + vc_ * 2) = S.v; } while (0)
    float m_reg = 0.f, l_reg = 0.f;
    f32x16 negm = f32x16{}; asm volatile("" : "+v"(negm));
    o0 = f32x16{}; o1 = f32x16{};
    f32x16 pA0, pA1, pB0, pB1;
    __syncthreads();
    const int nt1 = ntile - 1;
#define TCL(j) (((j) < nt1) ? (j) : nt1)
    A_LOADK(sA, 0); A_LOADV(sA, 0); A_LOADK(sB, 1);
    A_WRITEK(sA, 0); A_WRITEV(sA, 0); A_WRITEK(sB, 1);
    A_LOADK(sA, TCL(2));
    A_LOADV(sA, 1);
    __syncthreads();
    qkt<ND0, KS>(pA0, pA1, lds, qr, r32, hi, negm);
    hf8 f0, f1, f2, f3;
    if (wid >= 4) __syncthreads();
    for (int j = 0; j < ntile; j += 2) {
        A_LOADK(sB, TCL(j + 3)); A_LOADV(sB, TCL(j + 2));
        sm_max(pA0, pA1, m_reg, l_reg, o0, o1, negm, j == 0);
        sm_exp(pA0, pA1, m_reg, l_reg, f0, f1, f2, f3);
        __syncthreads();
        qkt<ND0, KS>(pB0, pB1, lds + KB, qr, r32, hi, negm);
        pv(f0, f1, f2, f3, o0, o1, lds + OFF_V, r32, hi);
        A_WRITEK(sA, 0); A_WRITEV(sA, 1);
        __syncthreads();
        A_LOADK(sA, TCL(j + 4)); A_LOADV(sA, TCL(j + 3));
        sm_max(pB0, pB1, m_reg, l_reg, o0, o1, negm, false);
        sm_exp(pB0, pB1, m_reg, l_reg, f0, f1, f2, f3);
        __syncthreads();
        qkt<ND0, KS>(pA0, pA1, lds, qr, r32, hi, negm);
        pv(f0, f1, f2, f3, o0, o1, lds + OFF_V + VB, r32, hi);
        A_WRITEK(sB, 1); A_WRITEV(sB, 0);
        __syncthreads();
    }
    if (wid < 4) __syncthreads();
#undef TCL
#undef KROW0
#undef A_LOADK
#undef A_LOADV
#undef A_WRITEK
#undef A_WRITEV
    const float lt = l_reg + __shfl_xor(l_reg, 32); inv = __builtin_amdgcn_rcpf(lt);
}
template <bool MLA>
__device__ __forceinline__ void attn_unit(const Frame& F, const Params& p, int l, int h, int qrow0, int qpos0, int klat0, int nlat, int kctx0) {
    const int wid = F.wave, lane = F.lane, r32 = lane & 31, hi = lane >> 5;
    hf* Y = (hf*)(p.ws + A_Y);
    const size_t yrow = (size_t)(qrow0 + wid * 32 + r32) * DM;
    if constexpr (MLA) {
        f32x16 o0, o1; float inv;
        attn_pass<true>(F, p, h, h, qrow0, qpos0, klat0, nlat, kctx0, o0, o1, inv);
#pragma unroll
        for (int g = 0; g < 4; ++g) { u32x2 w; w.x = pkhb(o0[4 * g] * inv, o0[4 * g + 1] * inv); w.y = pkhb(o0[4 * g + 2] * inv, o0[4 * g + 3] * inv); *(u32x2*)(Y + yrow + h * 64 + 8 * g + 4 * hi) = w; }
#pragma unroll
        for (int g = 0; g < 4; ++g) { u32x2 w; w.x = pkhb(o1[4 * g] * inv, o1[4 * g + 1] * inv); w.y = pkhb(o1[4 * g + 2] * inv, o1[4 * g + 3] * inv); *(u32x2*)(Y + yrow + h * 64 + 32 + 8 * g + 4 * hi) = w; }
    } else {
        const float lam = ((const float*)(p.ws + WS_LAM))[2 * l], oml = ((const float*)(p.ws + WS_LAM))[2 * l + 1];
        f32x16 a0, a1;
        LAS float* park = (LAS float*)(F.lds + 65536 + wid * 8192) + lane;
        { f32x16 o0, o1; float inv; attn_pass<false>(F, p, 2 * h, h, qrow0, qpos0, klat0, nlat, kctx0, o0, o1, inv);
#pragma unroll
          for (int r = 0; r < 16; ++r) { park[r * 64] = o0[r] * inv; park[(16 + r) * 64] = o1[r] * inv; } }
        { f32x16 o0, o1; float inv; attn_pass<false>(F, p, 2 * h + 1, h, qrow0, qpos0, klat0, nlat, kctx0, o0, o1, inv);
#pragma unroll
          for (int r = 0; r < 16; ++r) { a0[r] = park[r * 64] - o0[r] * (lam * inv); a1[r] = park[(16 + r) * 64] - o1[r] * (lam * inv); } }
        float ss = 0.f;
#pragma unroll
        for (int r = 0; r < 16; ++r) ss += a0[r] * a0[r] + a1[r] * a1[r];
        ss += __shfl_xor(ss, 32);
        const float rs = rsqrtf(ss * (1.f / 64.f) + EPS) * oml;
#pragma unroll
        for (int g = 0; g < 4; ++g) { const f32x4 gg = *(const f32x4*)(p.in[I_SUBG] + l * 64 + 8 * g + 4 * hi);
            u32x2 w; w.x = pkhb(a0[4 * g] * rs * gg[0], a0[4 * g + 1] * rs * gg[1]); w.y = pkhb(a0[4 * g + 2] * rs * gg[2], a0[4 * g + 3] * rs * gg[3]); *(u32x2*)(Y + yrow + 768 + h * 64 + 8 * g + 4 * hi) = w; }
#pragma unroll
        for (int g = 0; g < 4; ++g) { const f32x4 gg = *(const f32x4*)(p.in[I_SUBG] + l * 64 + 32 + 8 * g + 4 * hi);
            u32x2 w; w.x = pkhb(a1[4 * g] * rs * gg[0], a1[4 * g + 1] * rs * gg[1]); w.y = pkhb(a1[4 * g + 2] * rs * gg[2], a1[4 * g + 3] * rs * gg[3]); *(u32x2*)(Y + yrow + 768 + h * 64 + 32 + 8 * g + 4 * hi) = w; }
    }
}
}

#define HY_MARK(b) do { if (PROF_SEL >= 0 && F.tid == 0) { volatile LAS unsigned* _pf = (volatile LAS unsigned*)(F.lds + LDS_BYTES - 512); const unsigned _t = (unsigned)__builtin_amdgcn_s_memrealtime(); _pf[(b)] += _t - _pf[32]; _pf[32] = _t; } } while (0)
template <int L>
__device__ __forceinline__ void hyena_unit(const Frame& F, const hf* Rrow  , const hf* U  , const hf* X0  , hf* Ycol  ) {
    constexpr int NM = L / 256, RL = 2 * L, SH = (L > 1024) ? 1024 : L, NH = L / SH, US = SH * 2 + 16;
    constexpr int OFF_U = 8 * RL * 2;
    constexpr int XP = L * 2 + 16;
    static_assert(OFF_U + 32 * US <= LDS_MISC && 32 * XP <= LDS_MISC, "hyena LDS");
    const int tid = F.tid, w = F.wave, lane = F.lane, i32 = lane & 31, hi = lane >> 5;
    LAS unsigned char* lds = F.lds;
    __syncthreads();
    for (int i = tid; i < RL / 8; i += 512) *(LAS u32x4*)(lds + i * 16) = *(const u32x4*)(Rrow + i * 8);
    __syncthreads();
    {
        const LAS unsigned* src = (const LAS unsigned*)lds;
#pragma unroll 1
        for (int idx = tid; idx < 7 * (RL / 8); idx += 512) { const int cw = 1 + idx / (RL / 8), c4 = (idx % (RL / 8)) * 4;
            const int k0 = c4 - ((cw + 1) >> 1); unsigned d[5];
#pragma unroll
            for (int e = 0; e < 5; ++e) { const int k = k0 + e; d[e] = (k >= 0 && k < RL / 2) ? src[k] : 0u; }
            u32x4 o;
            if (cw & 1) { o.x = (d[0] >> 16) | (d[1] << 16); o.y = (d[1] >> 16) | (d[2] << 16); o.z = (d[2] >> 16) | (d[3] << 16); o.w = (d[3] >> 16) | (d[4] << 16); }
            else { o.x = d[0]; o.y = d[1]; o.z = d[2]; o.w = d[3]; }
            *(LAS u32x4*)(lds + cw * (RL * 2) + c4 * 4) = o; }
    }
    HY_MARK(22);
    f32x16 acc[NM];
#pragma unroll
    for (int m = 0; m < NM; ++m) acc[m] = f32x16{};
    const LAS unsigned char* cpy = lds + w * (RL * 2);
    for (int half = 0; half < NH; ++half) {
        __syncthreads();
        {
            constexpr int NPC = 32 * (SH / 8) / 512, NB4 = NPC > 4 ? 4 : NPC;
            int tq = tid; asm volatile("" : "+v"(tq));
#pragma unroll
            for (int k0 = 0; k0 < NPC; k0 += NB4) { u32x4 tmp[NB4];
#pragma unroll
                for (int k = 0; k < NB4; ++k) { const int idx = tq + 512 * (k0 + k), b = idx / (SH / 8), pc = idx % (SH / 8); tmp[k] = *(const u32x4*)(U + (size_t)b * L + half * SH + pc * 8); }
#pragma unroll
                for (int k = 0; k < NB4; ++k) { const int idx = tq + 512 * (k0 + k), b = idx / (SH / 8), pc = idx % (SH / 8); *(LAS u32x4*)(lds + OFF_U + b * US + pc * 16) = tmp[k]; }
                asm volatile("" ::: "memory"); }
        }
        __syncthreads();
#pragma unroll 2
        for (int jl = 0; jl < SH / 16; ++jl) {
            const int j = half * (SH / 16) + jl;
            const hf8 bf = *(const LAS hf8*)(lds + OFF_U + i32 * US + (jl * 16 + hi * 8) * 2);
            const int x0 = L + 16 * j + 8 * hi - 8 * i32;
#pragma unroll
            for (int m = 0; m < NM; ++m) { const hf8 af = *(const LAS hf8*)(cpy + (x0 - 256 * m) * 2);
                acc[m] = __builtin_amdgcn_mfma_f32_32x32x16_f16(af, bf, acc[m], 0, 0, 0); }
        }
    }
    __syncthreads();
    HY_MARK(23);
    {
        constexpr int NPC = 32 * (L / 8) / 512, NB8 = NPC > 4 ? 4 : NPC;
        int tq = tid; asm volatile("" : "+v"(tq));
#pragma unroll
        for (int k0 = 0; k0 < NPC; k0 += NB8) { u32x4 tmp[NB8];
#pragma unroll
            for (int k = 0; k < NB8; ++k) { const int idx = tq + 512 * (k0 + k), b = idx / (L / 8), pc = idx % (L / 8); tmp[k] = *(const u32x4*)(X0 + (size_t)b * L + pc * 8); }
#pragma unroll
            for (int k = 0; k < NB8; ++k) { const int idx = tq + 512 * (k0 + k), b = idx / (L / 8), pc = idx % (L / 8); *(LAS u32x4*)(lds + b * XP + pc * 16) = tmp[k]; }
            asm volatile("" ::: "memory"); }
    }
    __syncthreads();
    HY_MARK(24);
    const LAS hf* x0p = (const LAS hf*)(lds + i32 * XP) + w + 32 * hi;
    hf* yp = Ycol + ((size_t)i32 * L + w + 32 * hi) * DM;
#pragma unroll
    for (int m = 0; m < NM; ++m) {
#pragma unroll
        for (int r = 0; r < 16; ++r) { const int tt = 256 * m + 8 * ((r & 3) + 8 * (r >> 2));
            const float x0v = (float)x0p[tt];
            { const float yv = x0v * acc[m][r]; unsigned ub = __float_as_uint(yv); ub += 0x7fffu + ((ub >> 16) & 1u); yp[(size_t)tt * DM] = (hf)__uint_as_float(ub & 0xffff0000u); } }
        asm volatile("" ::: "memory");
    }
    HY_MARK(25);
}

#ifndef PH_MASK
#define PH_MASK 0x1FFFF
#endif
#define PHM(k) ((PH_MASK >> (k)) & 1)
#ifndef PROBE_REP
#define PROBE_REP 0
#endif
#define NREP(k) (((PROBE_REP >> (k)) & 1) ? 2 : 1)
constexpr int NPH_LAYER = 7, PH_L0 = 2, NPHASE = PH_L0 + DEPTH * NPH_LAYER + 1;
__global__ void __launch_bounds__(512, 2) fwd_kernel(Params p) {
    extern __shared__ __attribute__((aligned(16))) unsigned char lds_raw[];
    Frame F0; Frame& F = F0;
    F.lds = (LAS unsigned char*)lds_raw;
    F.tid = threadIdx.x; F.lane = F.tid & 63; F.wave = __builtin_amdgcn_readfirstlane(F.tid >> 6);
    F.G = gridDim.x; { const int bx = blockIdx.x; F.vcu = (F.G % 8 == 0) ? (bx % 8) * (F.G / 8) + bx / 8 : bx; }
    volatile LAS unsigned* misc = (volatile LAS unsigned*)(F.lds + LDS_MISC);
    if (F.tid < 16) misc[F.tid] = 0u;
    __syncthreads();
    const int lo = p.ph_lo, hi = p.ph_hi;
    XcdBarrier bar; bar.bar = (unsigned*)(p.ws + WS_BAR); bar.x = 0; bar.st = misc;
    if (hi - lo > 1) bar = xcd_barrier_post((unsigned*)(p.ws + WS_BAR), misc);
#define IN(k) (lo <= (k) && (k) < hi)
#define LAUNDER(Fl) Frame Fl = F0; asm volatile("" : "+v"(Fl.tid), "+v"(Fl.lane))
#ifndef PROF_SEL
#define PROF_SEL -1
#endif
#define PROF_K 8
    volatile LAS unsigned* prof = (volatile LAS unsigned*)(F.lds + LDS_BYTES - 512);
    if (PROF_SEL >= 0 && F.tid < 40) prof[F.tid] = 0u;
    if (PROF_SEL >= 0) __syncthreads();
    if (PROF_SEL >= 0 && F.tid == 0) prof[32] = (unsigned)__builtin_amdgcn_s_memrealtime();
#define PROF_MARK(b) do { if (PROF_SEL >= 0 && F.tid == 0) { const unsigned _t = (unsigned)__builtin_amdgcn_s_memrealtime(); prof[(b)] += _t - prof[32]; if ((b) >= 16) prof[30] += _t - prof[32]; prof[32] = _t; } } while (0)
#define SEAMT(k, b) do { PROF_MARK(b); if (IN(k) && IN((k) + 1)) xcd_barrier(bar); PROF_MARK(16 + (b)); } while (0)
#define SEAM(k) do { if (IN(k) && IN((k) + 1)) xcd_barrier(bar); } while (0)
    unsigned char* ws = p.ws;
    hf* X16 = (hf*)(ws + WS_X16);
    hf* XS1 = (hf*)p.out; hf* MM = (hf*)p.out; hf* Y = (hf*)(ws + A_B); hf* XS2 = (hf*)(ws + A_B);
    hf* QKV = (hf*)(ws + A_QKV); hf* QKVN = (hf*)(ws + A_QKVN);
    unsigned char* Gt = (unsigned char*)(ws + A_G); hf* HID = (hf*)(ws + A_HID);
    float* SS = (float*)(ws + WS_SS);

    if (PHM(11) && IN(0)) for (int rep = 0; rep < NREP(11); ++rep) { LAUNDER(Fl); prologue_a(Fl, p); }
    SEAMT(0, 9);
    if (PHM(11) && IN(1)) for (int rep = 0; rep < NREP(12); ++rep) { LAUNDER(Fl); prologue_b(Fl, p); }
    SEAMT(1, 9);

    for (int l = 0; l < DEPTH; ++l) {
        const int pb = PH_L0 + l * NPH_LAYER;
        const bool ctx_live = l < DEPTH - 1;
        const int Mrows = ctx_live ? MTOT : NLAT;
        const float* modl = (const float*)(ws + WS_MOD) + (size_t)l * NMODV * MODW;
        const float* biasl = (const float*)(ws + WS_BIAS) + (size_t)l * NMODV * NBIAS;
        const float* gsl = (const float*)(ws + WS_GS) + (size_t)l * 2 * NMODV * DM;
        const unsigned char* wl = ws + WS_WT + (size_t)(l & 1) * W_LAYER;
        float* ss1 = SS + (size_t)(SS_1 + l) * MTOT * 4; float* ss2 = SS + (size_t)(SS_2 + l) * MTOT * 4;
        float* ssq = (float*)(ws + WS_SSQ) + (size_t)l * MTOT; float* sskv = (float*)(ws + WS_SSKV) + (size_t)l * MTOT;
        LAS unsigned char* lx = F.lds + LDS_EXCH;

        if (PHM(1) && IN(pb + 0)) { pg8::Gemm g{XS1, (const hf*)(wl + W_IN1), MTOT, NP1, DM, DM, DM}; pg8::StaticOrder S; S.init(MTOT, NP1, F.G, (int)blockIdx.x);
            pg8::EpiIn E{QKVN, (hf*)(ws + A_KR), (hf*)(ws + A_PHY), (hf*)(ws + A_DQ), (hf*)(ws + A_DK), (hf*)(ws + A_DV), ss1, biasl + B_IN, ssq, sskv, lx, F.lds + LDS_PRE};
            pg8::gemm_phase(F.lds, g, S, E); }
        SEAMT(pb + 0, 0);
        if (PHM(2) && IN(pb + 1)) {
            { LAUNDER(Fl); prep_rope(Fl, p); prep_hyena(Fl, p, l, ctx_live); }
            __syncthreads();
            PROF_MARK(1);
            { pg8::Gemm g{QKVN, (const hf*)(wl + W_UP), MTOT, NUP, KUP, KUP, KUP}; pg8::StaticOrder S; S.init(MTOT, NUP, F.G, (int)blockIdx.x);
              pg8::EpiUp E{QKV, ssq, sskv, F.lds + LDS_PRE}; pg8::gemm_phase(F.lds, g, S, E); }
        }
        SEAMT(pb + 1, 2);
        if (PHM(4) && IN(pb + 2)) {
            {
            LAUNDER(Fl);
            PROF_MARK(14);
            const int n_mla = 2048 + (ctx_live ? 256 : 0);
            for (int id = F.vcu; id < n_mla; id += F.G) {
                if (id < 2048) { const int qb = id & 7, h = (id >> 3) & 7, b = id >> 6; att::attn_unit<true>(Fl, p, l, h, b * SEQ + qb * 256, qb * 256, b * SEQ, 32, NLAT + b * CTXL); }
                else { const int i2 = id - 2048, h = i2 & 7, b = i2 >> 3; att::attn_unit<true>(Fl, p, l, h, NLAT + b * CTXL, -1, 0, 0, NLAT + b * CTXL); }
            }
            PROF_MARK(11);
            const int n_df = 1024 + (ctx_live ? 128 : 0);
            for (int id = F.vcu; id < n_df; id += F.G) {
                if (id < 1024) { const int qb = id & 7, h = (id >> 3) & 3, b = id >> 5; att::attn_unit<false>(Fl, p, l, h, b * SEQ + qb * 256, qb * 256, b * SEQ, 32, NLAT + b * CTXL); }
                else { const int i2 = id - 1024, h = i2 & 3, b = i2 >> 2; att::attn_unit<false>(Fl, p, l, h, NLAT + b * CTXL, -1, 0, 0, NLAT + b * CTXL); }
            }
            PROF_MARK(12);
            const unsigned char* ob = (const unsigned char*)p.out;
            for (int c = F.vcu; c < 256; c += F.G)
                hyena_unit<SEQ>(Fl, (const hf*)(ws + WS_RF) + ((size_t)l * 256 + c) * 4096, (const hf*)(ob + O_UT) + (size_t)c * NLAT, (const hf*)(ob + O_X0T) + (size_t)c * NLAT, Y + 512 + c);
            if (ctx_live) for (int c = F.vcu; c < 256; c += F.G)
                hyena_unit<CTXL>(Fl, (const hf*)(ws + WS_RFC) + ((size_t)l * 256 + c) * 512, (const hf*)(ob + O_UTC) + (size_t)c * NCTX, (const hf*)(ob + O_X0TC) + (size_t)c * NCTX, Y + (size_t)NLAT * DM + 512 + c);
            __syncthreads();
            PROF_MARK(13);
            }
            { pg8::Gemm g{XS1, (const hf*)(wl + W_ING), Mrows, NGATE, DM, DM, DM}; pg8::StaticOrder S; S.init(Mrows, NGATE, F.G, (int)blockIdx.x);
              pg8::EpiGate8 E{Gt, ss1, biasl + B_G, F.lds + LDS_PRE}; pg8::gemm_phase(F.lds, g, S, E); }
        }
        SEAMT(pb + 2, 4);
        if (PHM(6) && IN(pb + 3)) { pg8::Gemm g{Y, (const hf*)(wl + W_BR), Mrows, DM, DM, DM, DM}; pg8::StaticOrder S; S.init(Mrows, DM, F.G, (int)blockIdx.x);
            pg8::EpiMerge E{MM, Gt}; pg8::gemm_phase(F.lds, g, S, E); }
        SEAMT(pb + 3, 5);
        if (PHM(7) && IN(pb + 4)) { pg8::Gemm g{MM, (const hf*)(wl + W_OUT), Mrows, DM, DM, DM, DM}; pg8::StaticOrder S; S.init(Mrows, DM, F.G, (int)blockIdx.x);
            pg8::EpiResidX<true, true> E{X16, modl + 2 * DM, XS2, gsl + (size_t)NMODV * DM, ss2, lx}; pg8::gemm_phase(F.lds, g, S, E); }
        SEAMT(pb + 4, 6);
        if (PHM(9) && IN(pb + 5)) { pg8::Gemm g{XS2, (const hf*)(wl + W_FC1), Mrows, DFF, DM, DM, DM}; pg8::StaticOrder S; S.init(Mrows, DFF, F.G, (int)blockIdx.x);
            pg8::EpiHalf<2, true> E{HID, DFF, ss2, biasl + B_FC1, F.lds + LDS_PRE}; pg8::gemm_phase(F.lds, g, S, E); }
        SEAMT(pb + 5, 7);
        if (PHM(10) && IN(pb + 6)) { pg8::Gemm g{HID, (const hf*)(wl + W_FC2), Mrows, DM, DFF, DFF, DFF}; pg8::StaticOrder S; S.init(Mrows, DM, F.G, (int)blockIdx.x);
            if (ctx_live) { pg8::EpiResidX<true, true> E{X16, modl + 5 * DM, XS1, gsl + (size_t)2 * NMODV * DM, ss1 + (size_t)MTOT * 4, lx}; pg8::gemm_phase(F.lds, g, S, E);
                const int nheavy = (MTOT / 256 * 4) % F.G;
                if (nheavy > 0 && (int)blockIdx.x >= nheavy) { __syncthreads(); LAUNDER(Fl); convert_layer(Fl, p, l + 1, ws + WS_WT + (size_t)((l + 1) & 1) * W_LAYER, (int)blockIdx.x - nheavy, F.G - nheavy); }
                else if (nheavy == 0) { __syncthreads(); LAUNDER(Fl); convert_layer(Fl, p, l + 1, ws + WS_WT + (size_t)((l + 1) & 1) * W_LAYER, Fl.vcu, F.G); } }
            else { pg8::EpiResidX<false, true> E{X16, modl + 5 * DM, nullptr, nullptr, SS + (size_t)SS_F * MTOT * 4, lx}; pg8::gemm_phase(F.lds, g, S, E); } }
        SEAMT(pb + 6, 8);
    }
    if (PHM(12) && IN(NPHASE - 1)) { LAUNDER(Fl); final_norm_phase(Fl, X16, p.out, p.in[I_FNG], SS + (size_t)SS_F * MTOT * 4); }
    PROF_MARK(10);
    if (PROF_SEL >= 0 && blockIdx.x == 0 && F.tid == 0) { const unsigned long long t0 = __builtin_amdgcn_s_memrealtime(); const unsigned long long d = (unsigned long long)PROF_K * prof[PROF_SEL];
        while (__builtin_amdgcn_s_memrealtime() - t0 < d) __builtin_amdgcn_s_sleep(8); }
#undef IN
#undef SEAM
}

extern "C" void kernel_launch(void* const* d_in, const int* in_sizes, int n_in, void* d_out, int out_size, void* d_ws, size_t ws_size, hipStream_t stream) {
    static int grid = 0;
    if (grid == 0) {
        if (n_in != 35 || in_sizes[0] != NLAT * DM || out_size != NLAT * DM || ws_size < WS_END) {
            fprintf(stderr, "kernel_launch: unexpected shapes: n_in %d in0 %d out %d ws %zu (need %zu); nothing launched\n", n_in, n_in > 0 ? in_sizes[0] : -1, out_size, ws_size, (size_t)WS_END); grid = -1; return; }
        int dev = 0, cus = 0, per_cu = 0;
        if (hipGetDevice(&dev) != hipSuccess || hipDeviceGetAttribute(&cus, hipDeviceAttributeMultiprocessorCount, dev) != hipSuccess) { fprintf(stderr, "kernel_launch: device query failed\n"); grid = -1; return; }
        if (hipFuncSetAttribute((const void*)fwd_kernel, hipFuncAttributeMaxDynamicSharedMemorySize, LDS_BYTES) != hipSuccess) { fprintf(stderr, "kernel_launch: hipFuncSetAttribute failed\n"); grid = -1; return; }
        if (hipOccupancyMaxActiveBlocksPerMultiprocessor(&per_cu, (const void*)fwd_kernel, 512, LDS_BYTES) != hipSuccess || per_cu < 1)
            fprintf(stderr, "kernel_launch: note: occupancy query reports %d workgroups per CU\n", per_cu);
        (void)hipGetLastError();
        grid = cus;
    }
    if (grid < 0) return;
    if (hipMemsetAsync((char*)d_ws + WS_BAR, 0, WS_ZERO_BYTES, stream) != hipSuccess) { fprintf(stderr, "kernel_launch: memset failed\n"); return; }
    Params P{};
    for (int i = 0; i < 35; ++i) P.in[i] = (const float*)d_in[i];
    P.out = (float*)d_out; P.ws = (unsigned char*)d_ws;
#if MK_FUSED
    P.ph_lo = 0; P.ph_hi = NPHASE;
    hipLaunchKernelGGL(fwd_kernel, dim3(grid), dim3(512), LDS_BYTES, stream, P);
#else
    for (int ph = 0; ph < NPHASE; ++ph) { P.ph_lo = ph; P.ph_hi = ph + 1; hipLaunchKernelGGL(fwd_kernel, dim3(grid), dim3(512), LDS_BYTES, stream, P); }
#endif
    const hipError_t le = hipPeekAtLastError();
    if (le != hipSuccess) fprintf(stderr, "kernel_launch: launch failed: %s\n", hipGetErrorName(le));
}
```

```cpp
#include <hip/hip_runtime.h>
#include <cstdio>
#include <cstdint>

#ifndef MK_FUSED
#define MK_FUSED 1
#endif

#define LAS __attribute__((address_space(3)))
#define GAS __attribute__((address_space(1)))
typedef _Float16 hf;
typedef _Float16 hf2 __attribute__((ext_vector_type(2)));
typedef _Float16 hf4 __attribute__((ext_vector_type(4)));
typedef _Float16 hf8 __attribute__((ext_vector_type(8)));
typedef short s16x4 __attribute__((ext_vector_type(4)));
typedef float f32x2 __attribute__((ext_vector_type(2)));
typedef float f32x4 __attribute__((ext_vector_type(4)));
typedef float f32x16 __attribute__((ext_vector_type(16)));
typedef unsigned u32x2 __attribute__((ext_vector_type(2)));
typedef unsigned u32x4 __attribute__((ext_vector_type(4)));

constexpr int DM = 1024, NB = 32, SEQ = 2048, DEPTH = 4, CTXL = 256, GRIDW = 64;
constexpr int NLAT = NB * SEQ;
constexpr int NCTX = NB * CTXL;
constexpr int MTOT = NLAT + NCTX;
constexpr int D_IN = 5024, NP1 = 2048  , NGATE = 3072, DFF = 4096;
constexpr int C_PQ = 0, C_PKV = 256, C_PKR = 384, C_HY = 416, C_DQ = 1184, C_DK = 1440, C_DV = 1696, C_PG = 1952;
constexpr int NUP = 1792, KUP = 384;
constexpr int NMODV = 33, MODW = 6 * DM;
constexpr float EPS = 1e-6f;
constexpr float MLA_SCALE = 0.10206207261596575f;
constexpr float DF_SCALE = 0.17677669529663687f;

constexpr size_t al256(size_t x) { return (x + 255) / 256 * 256; }
constexpr size_t WS_BAR = 0, WS_BAR_BYTES = 65536;
constexpr size_t WS_SS = WS_BAR + WS_BAR_BYTES;
constexpr int SS_1 = 0, SS_2 = DEPTH, SS_F = 2 * DEPTH, SSP_N = 2 * DEPTH + 1;
constexpr size_t WS_SSQ = WS_SS + (size_t)SSP_N * MTOT * 4 * 4;
constexpr size_t WS_SSKV = WS_SSQ + (size_t)DEPTH * MTOT * 4;
constexpr size_t WS_ZERO_BYTES = WS_BAR_BYTES;
constexpr size_t WS_MOD = al256(WS_SSKV + (size_t)DEPTH * MTOT * 4);
constexpr size_t WS_GS = WS_MOD + al256((size_t)DEPTH * NMODV * MODW * 4);
constexpr int NBIAS = 9216, B_IN = 0, B_G = 2048, B_FC1 = 5120;
constexpr size_t WS_BIAS = WS_GS + (size_t)DEPTH * 2 * NMODV * DM * 4;
constexpr size_t WS_ROPE = WS_BIAS + (size_t)DEPTH * NMODV * NBIAS * 4;
constexpr size_t WS_LAM = WS_ROPE + (size_t)SEQ * 32 * 4;
constexpr size_t WS_RF = WS_LAM + 256;
constexpr size_t WS_RFC = WS_RF + (size_t)DEPTH * 256 * 4096 * 2;
constexpr size_t WS_X16 = WS_RFC + (size_t)DEPTH * 256 * 512 * 2;
constexpr size_t WS_WT = WS_X16 + (size_t)MTOT * DM * 2;
constexpr size_t W_IN1 = 0, W_ING = W_IN1 + (size_t)NP1 * DM * 2, W_UP = W_ING + (size_t)NGATE * DM * 2, W_BR = W_UP + (size_t)NUP * KUP * 2,
                 W_OUT = W_BR + (size_t)DM * DM * 2, W_FC1 = W_OUT + (size_t)DM * DM * 2, W_FC2 = W_FC1 + (size_t)DFF * DM * 2, W_LAYER = W_FC2 + (size_t)DM * DFF * 2;
constexpr size_t WS_ARENA = WS_WT + 2 * W_LAYER;
constexpr size_t SZ_ROW1024 = (size_t)MTOT * 1024 * 2;
constexpr size_t A_B = WS_ARENA;
constexpr size_t A_C = A_B + SZ_ROW1024;
constexpr size_t A_Y = A_B, A_XS2 = A_B, A_BIG = A_C;
constexpr size_t A_QKVN = A_BIG;
constexpr size_t A_PHY = A_QKVN + (size_t)MTOT * KUP * 2;
constexpr size_t A_KR = A_BIG + (size_t)MTOT * NGATE;
constexpr size_t A_DQ = A_KR + (size_t)MTOT * 32 * 2;
constexpr size_t A_DK = A_DQ + (size_t)MTOT * 256 * 2;
constexpr size_t A_DV = A_DK + (size_t)MTOT * 256 * 2;
constexpr size_t A_QKV = A_DV + (size_t)MTOT * 256 * 2;
constexpr size_t A_BIG_END = A_QKV + (size_t)MTOT * NUP * 2;
static_assert(A_PHY + (size_t)MTOT * 768 * 2 <= A_KR, "QKVN + PHY must fit under the gate bytes");
constexpr size_t O_UT = SZ_ROW1024, O_X0T = O_UT + (size_t)256 * NLAT * 2, O_UTC = O_X0T + (size_t)256 * NLAT * 2, O_X0TC = O_UTC + (size_t)256 * NCTX * 2, O_END = O_X0TC + (size_t)256 * NCTX * 2;
static_assert(O_END <= (size_t)NLAT * DM * 4, "d_out scratch overflow");
constexpr size_t A_G = A_BIG;
constexpr size_t A_HID = A_C;
constexpr size_t WS_END = (A_BIG_END > A_HID + (size_t)MTOT * DFF * 2) ? A_BIG_END : A_HID + (size_t)MTOT * DFF * 2;
static_assert(WS_END <= (size_t)1024 * 1024 * 1024, "workspace map exceeds 1 GiB");

constexpr int LDS_BYTES = 147456;
constexpr int LDS_MISC = LDS_BYTES - 64;
constexpr int LDS_PRE = 135168;
constexpr int LDS_EXCH = 131072;

__device__ __forceinline__ unsigned pkh(float lo, float hi) { f32x2 v = {lo, hi}; hf2 h = __builtin_convertvector(v, hf2); return __builtin_bit_cast(unsigned, h); }
__device__ __forceinline__ unsigned rb8(unsigned h) { return (h + 0x00080008u) & 0xfff0fff0u; }
__device__ __forceinline__ unsigned pkhb(float lo, float hi) { return rb8(pkh(lo, hi)); }
__device__ __forceinline__ float wave_sum(float v) {
#pragma unroll
    for (int o = 1; o < 64; o <<= 1) v += __shfl_xor(v, o);
    return v;
}
__device__ __forceinline__ float rstd4(const float* ssp, int r) { const f32x4 q = *(const f32x4*)(ssp + 4 * (size_t)r); return rsqrtf(((q[0] + q[1]) + (q[2] + q[3])) * (1.f / DM) + EPS); }
__device__ __forceinline__ void rstd8(const float* ssp, int row0, float (&rs)[2][4]) {
    f32x4 q[2][4];
#pragma unroll
    for (int ai = 0; ai < 2; ++ai)
#pragma unroll
        for (int m = 0; m < 4; ++m) q[ai][m] = *(const f32x4*)(ssp + 4 * (size_t)(row0 + ai * 128 + m * 16));
#pragma unroll
    for (int ai = 0; ai < 2; ++ai)
#pragma unroll
        for (int m = 0; m < 4; ++m) rs[ai][m] = rsqrtf(((q[ai][m][0] + q[ai][m][1]) + (q[ai][m][2] + q[ai][m][3])) * (1.f / DM) + EPS);
}
__device__ __forceinline__ void rstd8_lds(const LAS unsigned char* pl, int lr0, float (&rs)[2][4]) {
    f32x4 q[2][4];
#pragma unroll
    for (int ai = 0; ai < 2; ++ai)
#pragma unroll
        for (int m = 0; m < 4; ++m) q[ai][m] = *(const LAS f32x4*)(pl + 16 * (lr0 + ai * 128 + m * 16));
#pragma unroll
    for (int ai = 0; ai < 2; ++ai)
#pragma unroll
        for (int m = 0; m < 4; ++m) rs[ai][m] = rsqrtf(((q[ai][m][0] + q[ai][m][1]) + (q[ai][m][2] + q[ai][m][3])) * (1.f / DM) + EPS);
}
__device__ __forceinline__ void dma16(const void* g, LAS unsigned char* l) { __builtin_amdgcn_global_load_lds((const unsigned*)g, (LAS unsigned*)l, 16, 0, 0); }
__device__ __forceinline__ void pre_norm(LAS unsigned char* pl, const float* ss, const float* biasrow, int R0, int wid, int lane) {
    if (wid < 4) dma16(ss + 4 * (size_t)(R0 + wid * 64 + lane), pl + wid * 1024);
    else if (wid == 4) dma16(biasrow + lane * 4, pl + 4096);
}
#define LDS_WAIT() asm volatile("s_waitcnt lgkmcnt(0)" ::: "memory")
#define VM_WAIT() asm volatile("s_waitcnt vmcnt(0)" ::: "memory")

#define XB_TMO      128
#define XB_XCNT(j)  (256  + 64 * (j))
#define XB_XSUB(j)  (1280 + 64 * (j))
#define XB_XGEN(j)  (2304 + 64 * (j))
#define XB_TOP      3328
#define XB_TOPGEN   3392
#define XCD_BAR_WORDS 3456
#define XB_SPIN_CAP (1u << 22)
__device__ __forceinline__ unsigned xb_ld(unsigned* p)              { return __hip_atomic_load(p, __ATOMIC_RELAXED, __HIP_MEMORY_SCOPE_AGENT); }
__device__ __forceinline__ unsigned xb_add(unsigned* p, unsigned v) { return __hip_atomic_fetch_add(p, v, __ATOMIC_RELAXED, __HIP_MEMORY_SCOPE_AGENT); }
__device__ __forceinline__ unsigned xb_xcc_id() { return (unsigned)__builtin_amdgcn_s_getreg((3 << 11) | 20) & 0xFu; }
#define XB_SPIN(cond, bar) do { unsigned _sp = 0; while (cond) { __builtin_amdgcn_s_sleep(1); \
    if ((++_sp & 255u) == 0u) { if (xb_ld(&(bar)[XB_TMO])) break; if (_sp > XB_SPIN_CAP) { atomicAdd(&(bar)[XB_TMO], 1u); break; } } } } while (0)
struct XcdBarrier { unsigned* bar; unsigned x; volatile LAS unsigned* st; };
__device__ __forceinline__ XcdBarrier xcd_barrier_post(unsigned* bar, volatile LAS unsigned* st) {
    XcdBarrier b; b.bar = bar; b.x = xb_xcc_id(); b.st = st;
    if (threadIdx.x == 0) (void)xb_add(&bar[XB_XCNT(b.x)], 1u);
    return b;
}
__device__ __forceinline__ void xcd_barrier_complete(unsigned* bar, unsigned x, unsigned& nloc, unsigned& nx) {
    const unsigned G = gridDim.x * gridDim.y * gridDim.z;
    unsigned sum, cnt, mine, sp = 0u;
    for (;;) {
        sum = 0u; cnt = 0u; mine = 0u;
#pragma unroll
        for (unsigned j = 0; j < 16; ++j) { const unsigned c = xb_ld(&bar[XB_XCNT(j)]); sum += c; cnt += (c > 0u) ? 1u : 0u; mine = (j == x) ? c : mine; }
        if (sum == G) break;
        __builtin_amdgcn_s_sleep(1);
        if ((++sp & 255u) == 0u) { if (xb_ld(&bar[XB_TMO])) break; if (sp > XB_SPIN_CAP) { atomicAdd(&bar[XB_TMO], 1u); break; } }
    }
    nloc = mine > 0u ? mine : 1u; nx = cnt > 0u ? cnt : 1u;
}
__device__ __forceinline__ void xcd_barrier(const XcdBarrier& b) {
    asm volatile("s_waitcnt vmcnt(0)" ::: "memory");
    __syncthreads();
    if (threadIdx.x == 0) {
        unsigned* bar = b.bar;
        __builtin_amdgcn_s_waitcnt(0);
        unsigned nloc = b.st[0], nx = b.st[1];
        if (nloc == 0u) { xcd_barrier_complete(bar, b.x, nloc, nx); b.st[0] = nloc; b.st[1] = nx; }
        const unsigned old = xb_add(&bar[XB_XSUB(b.x)], 1u);
        const unsigned gen = old / nloc;
        if (old + 1u == (gen + 1u) * nloc) {
            __builtin_amdgcn_fence(__ATOMIC_RELEASE, "agent");
            asm volatile("s_waitcnt vmcnt(0)" ::: "memory");
            const unsigned og = xb_add(&bar[XB_TOP], 1u);
            const unsigned tg = og / nx;
            if (og + 1u == (tg + 1u) * nx) xb_add(&bar[XB_TOPGEN], 1u);
            else XB_SPIN(xb_ld(&bar[XB_TOPGEN]) == tg, bar);
            __builtin_amdgcn_fence(__ATOMIC_ACQUIRE, "agent");
            xb_add(&bar[XB_XGEN(b.x)], 1u);
            asm volatile("s_waitcnt vmcnt(0)" ::: "memory");
        } else {
            XB_SPIN(xb_ld(&bar[XB_XGEN(b.x)]) == gen, bar);
            __builtin_amdgcn_fence(__ATOMIC_ACQUIRE, "agent");
            asm volatile("s_waitcnt vmcnt(0)" ::: "memory");
        }
    }
    __syncthreads();
}

namespace pg8 {
constexpr int BM = 256, BK = 64, HALF = 128, HTB = HALF * BK * 2, STAGE_BYTES = 8 * HTB, NXCD = 8, WGM = 8;
__host__ __device__ __forceinline__ int lds_byte(int r, int c) { const int st = (r >> 4) * 2 + (c >> 5), rr = r & 15, cc = c & 31, ob = rr * 64 + cc * 2; return st * 1024 + (ob ^ (((ob >> 9) & 1) << 5)); }
__host__ __device__ __forceinline__ void stage_rc(int b, int& R, int& C) { const int st = b / 1024, sb = b % 1024, swz = sb ^ (((sb >> 9) & 1) << 5); R = (st >> 1) * 16 + swz / 64; C = (st & 1) * 32 + (swz % 64) / 2; }
__host__ __device__ __forceinline__ int perm32(int rho) { const int n = rho >> 4, i = rho & 15; return 8 * (i >> 2) + 4 * n + (i & 3); }
struct Unit { int pm, pn; };
struct Gemm { const hf* A; const hf* Bt; int M, N, K, lda, ldb; };
struct StaticOrder {
    int nM, nN, nwg, G, c;
    __host__ __device__ void init(int M, int N, int G_, int c_) { nM = M / BM; nN = N / BM; nwg = nM * nN; G = G_; c = c_; }
    __host__ __device__ bool next(int i, Unit& u) const {
        const long L = (long)i * G + c; if (L >= nwg) return false;
        int wgid = (int)L; { const int q = nwg / NXCD, r = nwg % NXCD, xcd = wgid % NXCD, off = wgid / NXCD; wgid = (xcd < r ? xcd * (q + 1) : r * (q + 1) + (xcd - r) * q) + off; }
        const int nig = WGM * nN, gid = wgid / nig, fm = gid * WGM, gsz = (nM - fm) < WGM ? (nM - fm) : WGM;
        u.pm = fm + ((wgid % nig) % gsz); u.pn = (wgid % nig) / gsz; return true;
    }
    __device__ __forceinline__ void a_ready(const Unit&) const {}
    __device__ __forceinline__ void done(const Unit&) const {}
};

template <int ACT  , bool NORM> struct EpiHalf {
    static constexpr bool PERM = true, AFTER_DRAIN = false, PROBE2 = false, MIDK = false, PRE = NORM;
    static constexpr bool KSPLIT = false;
    hf* O; int ldc; const float* ss; const float* bias; LAS unsigned char* pl;
    __device__ __forceinline__ void prefetch(const Unit& u, int wid, int lane) const { const int R0 = u.pm * BM; const int v = (R0 < NLAT) ? (R0 >> 11) : NB; pre_norm(pl, ss, bias + (size_t)v * NBIAS + u.pn * BM, R0, wid, lane); }
    __device__ __forceinline__ void operator()(const f32x4 (&acc)[2][2][4][2], const Unit& u, int wr, int wc, int fr, int fq) const {
        const int row0 = u.pm * BM + wr * 64 + fr, col0 = u.pn * BM + wc * 32 + 8 * fq;
        f32x4 bv[2][2];
        const int lc0 = wc * 32 + 8 * fq;
        if (NORM) {
#pragma unroll
            for (int bj = 0; bj < 2; ++bj)
#pragma unroll
                for (int n = 0; n < 2; ++n) bv[bj][n] = *(const LAS f32x4*)(pl + 4096 + 4 * (lc0 + bj * HALF + 4 * n)); }
        float rsv[2][4]; if (NORM) rstd8_lds(pl, wr * 64 + fr, rsv);
#pragma unroll
        for (int ai = 0; ai < 2; ++ai)
#pragma unroll
            for (int m = 0; m < 4; ++m) { const int r = row0 + ai * HALF + m * 16; hf* rowp = O + (size_t)r * ldc + col0;
                float rs = 1.f; if (NORM) rs = rsv[ai][m];
#pragma unroll
                for (int bj = 0; bj < 2; ++bj) { f32x4 v0 = acc[ai][bj][m][0], v1 = acc[ai][bj][m][1];
                    if (NORM) { v0 = v0 * rs + bv[bj][0]; v1 = v1 * rs + bv[bj][1]; }
                    if (ACT == 1) {
#pragma unroll
                        for (int e = 0; e < 4; ++e) { v0[e] = __builtin_amdgcn_rcpf(1.f + __builtin_amdgcn_exp2f(-1.4426950408889634f * v0[e])); v1[e] = __builtin_amdgcn_rcpf(1.f + __builtin_amdgcn_exp2f(-1.4426950408889634f * v1[e])); } }
                    u32x4 w;
                    if (ACT == 2) {
                        const unsigned h[4] = {pkh(v0[0], v0[1]), pkh(v0[2], v0[3]), pkh(v1[0], v1[1]), pkh(v1[2], v1[3])}; unsigned o[4];
#pragma unroll
                        for (int e = 0; e < 4; ++e) { hf2 a = __builtin_bit_cast(hf2, h[e]); a = __builtin_elementwise_max(a, (hf2){(hf)0.f, (hf)0.f}); a = a * a; o[e] = rb8(__builtin_bit_cast(unsigned, a)); }
                        w.x = o[0]; w.y = o[1]; w.z = o[2]; w.w = o[3];
                    } else { w.x = pkhb(v0[0], v0[1]); w.y = pkhb(v0[2], v0[3]); w.z = pkhb(v1[0], v1[1]); w.w = pkhb(v1[2], v1[3]); }
                    *(u32x4*)(rowp + bj * HALF) = w; } }
    }
};
struct EpiGate8 {
    static constexpr bool PERM = true, AFTER_DRAIN = false, PROBE2 = false, MIDK = false, PRE = true;
    static constexpr bool KSPLIT = false;
    unsigned char* O; const float* ss; const float* bias; LAS unsigned char* pl;
    __device__ __forceinline__ void prefetch(const Unit& u, int wid, int lane) const { const int R0 = u.pm * BM; const int v = (R0 < NLAT) ? (R0 >> 11) : NB; pre_norm(pl, ss, bias + (size_t)v * NBIAS + u.pn * BM, R0, wid, lane); }
    __device__ __forceinline__ void operator()(const f32x4 (&acc)[2][2][4][2], const Unit& u, int wr, int wc, int fr, int fq) const {
        const int R0 = u.pm * BM, row0 = R0 + wr * 64 + fr, col0 = u.pn * BM + wc * 32 + 8 * fq;
        const int lc0 = wc * 32 + 8 * fq;
        f32x4 bv[2][2];
#pragma unroll
        for (int bj = 0; bj < 2; ++bj) { bv[bj][0] = *(const LAS f32x4*)(pl + 4096 + 4 * (lc0 + bj * HALF)); bv[bj][1] = *(const LAS f32x4*)(pl + 4096 + 4 * (lc0 + bj * HALF + 4)); }
        float rsv[2][4]; rstd8_lds(pl, wr * 64 + fr, rsv);
#pragma unroll
        for (int ai = 0; ai < 2; ++ai)
#pragma unroll
            for (int m = 0; m < 4; ++m) { const int r = row0 + ai * HALF + m * 16; const float rs = rsv[ai][m];
#pragma unroll
                for (int bj = 0; bj < 2; ++bj) { const f32x4 v0 = acc[ai][bj][m][0] * rs + bv[bj][0], v1 = acc[ai][bj][m][1] * rs + bv[bj][1];
                    unsigned q[8];
#pragma unroll
                    for (int e = 0; e < 4; ++e) { const float g0 = __builtin_amdgcn_rcpf(1.f + __builtin_amdgcn_exp2f(-1.4426950408889634f * v0[e])), g1 = __builtin_amdgcn_rcpf(1.f + __builtin_amdgcn_exp2f(-1.4426950408889634f * v1[e]));
                        q[e] = (unsigned)fmaxf(1.f, __builtin_rintf(255.f * g0)); q[4 + e] = (unsigned)fmaxf(1.f, __builtin_rintf(255.f * g1)); }
                    u32x2 w; w.x = q[0] | (q[1] << 8) | (q[2] << 16) | (q[3] << 24); w.y = q[4] | (q[5] << 8) | (q[6] << 16) | (q[7] << 24);
                    *(u32x2*)(O + (size_t)r * NGATE + col0 + bj * HALF) = w; } }
    }
};
struct EpiIn {
    static constexpr bool PERM = true, AFTER_DRAIN = false, PROBE2 = false, MIDK = false, PRE = true;
    static constexpr bool KSPLIT = false;
    hf* QKVNo; hf* KRo; hf* PHYo; hf* DQo; hf* DKo; hf* DVo; const float* ss; const float* bias; float* ssq; float* sskv; LAS unsigned char* lx; LAS unsigned char* pl;
    __device__ __forceinline__ void prefetch(const Unit& u, int wid, int lane) const { const int R0 = u.pm * BM; const int v = (R0 < NLAT) ? (R0 >> 11) : NB; pre_norm(pl, ss, bias + (size_t)v * NBIAS + u.pn * BM, R0, wid, lane); }
    __device__ __forceinline__ void operator()(const f32x4 (&acc)[2][2][4][2], const Unit& u, int wr, int wc, int fr, int fq) const {
        const int R0 = u.pm * BM, row0 = R0 + wr * 64 + fr, col0 = u.pn * BM + wc * 32 + 8 * fq;
        const int lc0 = wc * 32 + 8 * fq;
        f32x4 bv[2][2]; hf* dst[2]; int ld[2];
#pragma unroll
        for (int bj = 0; bj < 2; ++bj) { const int c8 = col0 + bj * HALF;
            bv[bj][0] = *(const LAS f32x4*)(pl + 4096 + 4 * (lc0 + bj * HALF)); bv[bj][1] = *(const LAS f32x4*)(pl + 4096 + 4 * (lc0 + bj * HALF + 4));
            if (c8 < C_PKR) { dst[bj] = QKVNo + c8; ld[bj] = KUP; }
            else if (c8 < C_HY) { dst[bj] = KRo + (c8 - C_PKR); ld[bj] = 32; }
            else if (c8 < C_DQ) { dst[bj] = PHYo + (c8 - C_HY); ld[bj] = 768; }
            else if (c8 < C_DK) { dst[bj] = DQo + (c8 - C_DQ); ld[bj] = 256; }
            else if (c8 < C_DV) { dst[bj] = DKo + (c8 - C_DK); ld[bj] = 256; }
            else if (c8 < C_PG) { dst[bj] = DVo + (c8 - C_DV); ld[bj] = 256; }
            else { dst[bj] = nullptr; ld[bj] = 0; } }
        const int nstat = (u.pn == 0) ? 2 : (u.pn == 1 ? 1 : 0);
        float* sp = (u.pn == 0) ? ssq : sskv;
        float sqv[2][4];
        float rsv[2][4]; rstd8_lds(pl, wr * 64 + fr, rsv);
#pragma unroll
        for (int ai = 0; ai < 2; ++ai)
#pragma unroll
            for (int m = 0; m < 4; ++m) { const int r = row0 + ai * HALF + m * 16; const float rs = rsv[ai][m]; float sq = 0.f;
#pragma unroll
                for (int bj = 0; bj < 2; ++bj) { const f32x4 v0 = acc[ai][bj][m][0] * rs + bv[bj][0], v1 = acc[ai][bj][m][1] * rs + bv[bj][1];
                    if (bj < nstat) sq += (v0[0] * v0[0] + v0[1] * v0[1]) + (v0[2] * v0[2] + v0[3] * v0[3]) + (v1[0] * v1[0] + v1[1] * v1[1]) + (v1[2] * v1[2] + v1[3] * v1[3]);
                    if (dst[bj]) { u32x4 w; w.x = pkhb(v0[0], v0[1]); w.y = pkhb(v0[2], v0[3]); w.z = pkhb(v1[0], v1[1]); w.w = pkhb(v1[2], v1[3]); *(u32x4*)(dst[bj] + (size_t)r * ld[bj]) = w; } }
                sq += __shfl_xor(sq, 16); sq += __shfl_xor(sq, 32); sqv[ai][m] = sq; }
        if (nstat) {
            LAS float* ex = (LAS float*)lx;
            if (fq == 0) {
#pragma unroll
                for (int ai = 0; ai < 2; ++ai)
#pragma unroll
                    for (int m = 0; m < 4; ++m) ex[((wr * 4 + wc) * 8 + ai * 4 + m) * 16 + fr] = sqv[ai][m]; }
            asm volatile("s_waitcnt lgkmcnt(0)" ::: "memory"); __builtin_amdgcn_s_barrier(); asm volatile("" ::: "memory");
            if (wc == 0 && fq == 0) {
#pragma unroll
                for (int ai = 0; ai < 2; ++ai)
#pragma unroll
                    for (int m = 0; m < 4; ++m) { const int e = (ai * 4 + m) * 16 + fr; const int wb = wr * 4 * 128;
                        sp[row0 + ai * HALF + m * 16] = (ex[wb + e] + ex[wb + 128 + e]) + (ex[wb + 256 + e] + ex[wb + 384 + e]); } }
        }
    }
};
struct EpiUp {
    static constexpr bool PERM = true, AFTER_DRAIN = false, PROBE2 = false, MIDK = false, PRE = true;
    static constexpr bool KSPLIT = true;
    __device__ __forceinline__ int koff(const Unit& u) const { return u.pn < 3 ? 0 : 256 * 2; }
    __device__ __forceinline__ int ktiles(const Unit& u) const { return u.pn < 3 ? 4 : 2; }
    hf* O; const float* ssq; const float* sskv; LAS unsigned char* pl;
    __device__ __forceinline__ void prefetch(const Unit& u, int wid, int lane) const { if (wid == 0) dma16((u.pn < 3 ? ssq : sskv) + u.pm * BM + 4 * lane, pl); }
    __device__ __forceinline__ void operator()(const f32x4 (&acc)[2][2][4][2], const Unit& u, int wr, int wc, int fr, int fq) const {
        const int row0 = u.pm * BM + wr * 64 + fr, col0 = u.pn * BM + wc * 32 + 8 * fq;
        const bool isq = u.pn < 3; const float* sp = isq ? ssq : sskv; const float invn = isq ? (1.f / 256.f) : (1.f / 128.f);
        float rsv[2][4];
#pragma unroll
        for (int ai = 0; ai < 2; ++ai)
#pragma unroll
            for (int m = 0; m < 4; ++m) rsv[ai][m] = *(const LAS float*)(pl + 4 * (wr * 64 + fr + ai * HALF + m * 16));
#pragma unroll
        for (int ai = 0; ai < 2; ++ai)
#pragma unroll
            for (int m = 0; m < 4; ++m) { const int r = row0 + ai * HALF + m * 16; hf* rowp = O + (size_t)r * NUP + col0; const float rs = rsqrtf(rsv[ai][m] * invn + EPS);
#pragma unroll
                for (int bj = 0; bj < 2; ++bj) { const f32x4 v0 = acc[ai][bj][m][0] * rs, v1 = acc[ai][bj][m][1] * rs;
                    u32x4 w; w.x = pkhb(v0[0], v0[1]); w.y = pkhb(v0[2], v0[3]); w.z = pkhb(v1[0], v1[1]); w.w = pkhb(v1[2], v1[3]);
                    *(u32x4*)(rowp + bj * HALF) = w; } }
    }
};
template <bool FIRST> struct EpiGated {
    static constexpr bool PERM = true, AFTER_DRAIN = false, PROBE2 = false, MIDK = false, PRE = false;
    static constexpr bool KSPLIT = false;
    hf* MMo; const hf* G; int goff;
    __device__ __forceinline__ void operator()(const f32x4 (&acc)[2][2][4][2], const Unit& u, int wr, int wc, int fr, int fq) const {
        const int row0 = u.pm * BM + wr * 64 + fr, col0 = u.pn * BM + wc * 32 + 8 * fq;
#pragma unroll
        for (int ai = 0; ai < 2; ++ai)
#pragma unroll
            for (int m = 0; m < 4; ++m) { const size_t r = (size_t)(row0 + ai * HALF + m * 16);
#pragma unroll
                for (int bj = 0; bj < 2; ++bj) { const f32x4 v0 = acc[ai][bj][m][0], v1 = acc[ai][bj][m][1];
                    const hf8 g = *(const hf8*)(G + r * NGATE + goff + col0 + bj * HALF);
                    hf* mp = MMo + r * DM + col0 + bj * HALF;
                    float o[8];
#pragma unroll
                    for (int e = 0; e < 4; ++e) { o[e] = (float)g[e] * v0[e]; o[4 + e] = (float)g[4 + e] * v1[e]; }
                    if (!FIRST) { const hf8 p = *(const hf8*)mp;
#pragma unroll
                        for (int e = 0; e < 8; ++e) o[e] += (float)p[e]; }
                    u32x4 w; w.x = pkh(o[0], o[1]); w.y = pkh(o[2], o[3]); w.z = pkh(o[4], o[5]); w.w = pkh(o[6], o[7]);
                    *(u32x4*)mp = w; } }
    }
};
struct EpiMerge {
    static constexpr bool PERM = true, AFTER_DRAIN = false, PROBE2 = false, MIDK = true, PRE = false;
    static constexpr bool KSPLIT = false;
    static constexpr int MID1 = 8, MID2 = 12;
    hf* MMo; const unsigned char* G;
    __device__ __forceinline__ void mid(f32x4 (&acc)[2][2][4][2], const Unit& u, int which, int wr, int wc, int fr, int fq) const {
        asm volatile("" : "+v"(fr), "+v"(fq));
        const int row0 = u.pm * BM + wr * 64 + fr, col0 = u.pn * BM + wc * 32 + 8 * fq; const int gnum = which ? 1024 : 0, gden = which ? 2048 : 1024;
        u32x2 gn[2][4][2], gd[2][4][2];
#pragma unroll
        for (int ai = 0; ai < 2; ++ai)
#pragma unroll
            for (int m = 0; m < 4; ++m) { const unsigned char* gr = G + (size_t)(row0 + ai * HALF + m * 16) * NGATE + col0;
#pragma unroll
                for (int bj = 0; bj < 2; ++bj) { gn[ai][m][bj] = *(const u32x2*)(gr + gnum + bj * HALF); gd[ai][m][bj] = *(const u32x2*)(gr + gden + bj * HALF); } }
#pragma unroll
        for (int ai = 0; ai < 2; ++ai) {
#pragma unroll
            for (int m = 0; m < 4; ++m)
#pragma unroll
                for (int bj = 0; bj < 2; ++bj)
#pragma unroll
                    for (int e = 0; e < 4; ++e) {
                        acc[ai][bj][m][0][e] *= (float)((gn[ai][m][bj].x >> (8 * e)) & 255u) * __builtin_amdgcn_rcpf((float)((gd[ai][m][bj].x >> (8 * e)) & 255u));
                        acc[ai][bj][m][1][e] *= (float)((gn[ai][m][bj].y >> (8 * e)) & 255u) * __builtin_amdgcn_rcpf((float)((gd[ai][m][bj].y >> (8 * e)) & 255u)); }
        }
        asm volatile("" ::: "memory");
    }
    __device__ __forceinline__ void operator()(const f32x4 (&acc)[2][2][4][2], const Unit& u, int wr, int wc, int fr, int fq) const {
        const int row0 = u.pm * BM + wr * 64 + fr, col0 = u.pn * BM + wc * 32 + 8 * fq;
        u32x2 gq[2][4][2];
#pragma unroll
        for (int ai = 0; ai < 2; ++ai)
#pragma unroll
            for (int m = 0; m < 4; ++m)
#pragma unroll
                for (int bj = 0; bj < 2; ++bj) gq[ai][m][bj] = *(const u32x2*)(G + (size_t)(row0 + ai * HALF + m * 16) * NGATE + 2048 + col0 + bj * HALF);
#pragma unroll
        for (int ai = 0; ai < 2; ++ai) {
#pragma unroll
            for (int m = 0; m < 4; ++m) { const size_t r = (size_t)(row0 + ai * HALF + m * 16);
#pragma unroll
                for (int bj = 0; bj < 2; ++bj) { const f32x4 v0 = acc[ai][bj][m][0], v1 = acc[ai][bj][m][1];
                    const u32x2 g = gq[ai][m][bj];
                    float o[8];
#pragma unroll
                    for (int e = 0; e < 4; ++e) { o[e] = (float)((g.x >> (8 * e)) & 255u) * (1.f / 255.f) * v0[e]; o[4 + e] = (float)((g.y >> (8 * e)) & 255u) * (1.f / 255.f) * v1[e]; }
                    u32x4 w; w.x = pkhb(o[0], o[1]); w.y = pkhb(o[2], o[3]); w.z = pkhb(o[4], o[5]); w.w = pkhb(o[6], o[7]);
                    *(u32x4*)(MMo + r * DM + col0 + bj * HALF) = w; } } }
    }
};
template <bool XS, bool STAT> struct EpiResidX {
    static constexpr bool PERM = true, AFTER_DRAIN = false, PROBE2 = false, MIDK = false, PRE = false;
    static constexpr bool KSPLIT = false;
    hf* x16; const float* gate;
    hf* xsout; const float* gs; float* ss; LAS unsigned char* lx;
    __device__ __forceinline__ void operator()(const f32x4 (&acc)[2][2][4][2], const Unit& u, int wr, int wc, int fr, int fq) const {
        const int R0 = u.pm * BM; const int v = (R0 < NLAT) ? (R0 >> 11) : NB;
        const int rglob = R0 + wr * 64 + fr, col0 = u.pn * BM + wc * 32 + 8 * fq;
        const float* gp = gate + (size_t)v * MODW + col0; const float* gsp = gs + (size_t)v * DM + col0;
        float sq[2][4];
#pragma unroll
        for (int ai = 0; ai < 2; ++ai)
#pragma unroll
            for (int m = 0; m < 4; ++m) sq[ai][m] = 0.f;
        u32x4 ah[2][2][4];
#pragma unroll
        for (int bj = 0; bj < 2; ++bj)
#pragma unroll
            for (int ai = 0; ai < 2; ++ai)
#pragma unroll
                for (int m = 0; m < 4; ++m) { const f32x4 a0 = acc[ai][bj][m][0], a1 = acc[ai][bj][m][1];
                    u32x4 t; t.x = pkh(a0[0], a0[1]); t.y = pkh(a0[2], a0[3]); t.z = pkh(a1[0], a1[1]); t.w = pkh(a1[2], a1[3]); asm volatile("" : "+v"(t)); ah[bj][ai][m] = t; }
        asm volatile("" ::: "memory");
        hf8 xq[2][2][4];
#pragma unroll
        for (int bj = 0; bj < 2; ++bj)
#pragma unroll
            for (int ai = 0; ai < 2; ++ai)
#pragma unroll
                for (int m = 0; m < 4; ++m) xq[bj][ai][m] = *(const hf8*)(x16 + (size_t)(rglob + ai * HALF + m * 16) * DM + col0 + bj * HALF);
        f32x4 gv[2][2], sv[2][2];
#pragma unroll
        for (int bj = 0; bj < 2; ++bj) { gv[bj][0] = *(const f32x4*)(gp + bj * HALF); gv[bj][1] = *(const f32x4*)(gp + bj * HALF + 4);
            if (XS) { sv[bj][0] = *(const f32x4*)(gsp + bj * HALF); sv[bj][1] = *(const f32x4*)(gsp + bj * HALF + 4); } }
#pragma unroll
        for (int bj = 0; bj < 2; ++bj) {
            const f32x4 g0 = gv[bj][0], g1 = gv[bj][1];
            const hf2 gh[4] = {__builtin_bit_cast(hf2, pkh(g0[0], g0[1])), __builtin_bit_cast(hf2, pkh(g0[2], g0[3])), __builtin_bit_cast(hf2, pkh(g1[0], g1[1])), __builtin_bit_cast(hf2, pkh(g1[2], g1[3]))};
            hf2 sh[4] = {gh[0], gh[0], gh[0], gh[0]};
            if (XS) { const f32x4 s0 = sv[bj][0], s1 = sv[bj][1];
                sh[0] = __builtin_bit_cast(hf2, pkh(s0[0], s0[1])); sh[1] = __builtin_bit_cast(hf2, pkh(s0[2], s0[3])); sh[2] = __builtin_bit_cast(hf2, pkh(s1[0], s1[1])); sh[3] = __builtin_bit_cast(hf2, pkh(s1[2], s1[3])); }
#pragma unroll
            for (int ai = 0; ai < 2; ++ai)
#pragma unroll
                for (int m = 0; m < 4; ++m) { const int rr = ai * HALF + m * 16; const size_t off = (size_t)(rglob + rr) * DM + col0 + bj * HALF;
                    const hf8 xv = xq[bj][ai][m]; const u32x4 av = ah[bj][ai][m];
                    const unsigned aw[4] = {av.x, av.y, av.z, av.w};
                    u32x4 wn, wx;
#pragma unroll
                    for (int e = 0; e < 4; ++e) { const hf2 n = __builtin_elementwise_fma(gh[e], __builtin_bit_cast(hf2, aw[e]), (hf2){xv[2 * e], xv[2 * e + 1]});
                        wn[e] = __builtin_bit_cast(unsigned, n);
                        if (STAT) sq[ai][m] = __builtin_amdgcn_fdot2(n, n, sq[ai][m], false);
                        if (XS) wx[e] = rb8(__builtin_bit_cast(unsigned, n * sh[e])); }
                    *(u32x4*)(x16 + off) = wn;
                    if (XS) *(u32x4*)(xsout + off) = wx; }
        }
        if (STAT) {
            LAS float* ex = (LAS float*)lx;
#pragma unroll
            for (int ai = 0; ai < 2; ++ai)
#pragma unroll
                for (int m = 0; m < 4; ++m) { float t = sq[ai][m]; t += __shfl_xor(t, 16); t += __shfl_xor(t, 32);
                    if (fq == 0) ex[((wr * 4 + wc) * 8 + ai * 4 + m) * 16 + fr] = t; }
            asm volatile("s_waitcnt lgkmcnt(0)" ::: "memory"); __builtin_amdgcn_s_barrier(); asm volatile("" ::: "memory");
            if (wc == 0 && fq == 0) {
#pragma unroll
                for (int ai = 0; ai < 2; ++ai)
#pragma unroll
                    for (int m = 0; m < 4; ++m) { const int e = (ai * 4 + m) * 16 + fr; const int wb = wr * 4 * 128;
                        ss[(size_t)(rglob + ai * HALF + m * 16) * 4 + u.pn] = (ex[wb + e] + ex[wb + 128 + e]) + (ex[wb + 256 + e] + ex[wb + 384 + e]); } }
        }
    }
};

template <class Epi, class Sched, bool ALIGN_EPI = true>
__device__ __forceinline__ void gemm_phase(LAS unsigned char* lds, const Gemm g, const Sched& S, const Epi& E) {
    int tid = threadIdx.x; asm volatile("" : "+v"(tid));
    const int wid = __builtin_amdgcn_readfirstlane(tid >> 6), lane = tid & 63, wr = wid >> 2, wc = wid & 3, fr = lane & 15, fq = lane >> 4;
    const int K = g.K, nt = K / BK;
    auto PG8_KOFF = [&](const Unit& u) -> size_t { if constexpr (Epi::KSPLIT) return (size_t)E.koff(u); else return (size_t)0; };
    auto PG8_NT = [&](const Unit& u) -> int { if constexpr (Epi::KSPLIT) return E.ktiles(u); else return nt; };
    unsigned voffA[2], voffB[2];
#pragma unroll
    for (int i = 0; i < 2; ++i) { int R, C; stage_rc(tid * 16 + i * 8192, R, C); const int Rb = Epi::PERM ? ((R & ~31) + perm32(R & 31)) : R;
        voffA[i] = (unsigned)(R * g.lda + C) * 2u; voffB[i] = (unsigned)(Rb * g.ldb + C) * 2u; }
    const size_t kstep = (size_t)(BK * 2);
    const size_t hstepA = (size_t)HALF * g.lda * 2, hstepB = (size_t)HALF * g.ldb * 2;
    const size_t tstepA = 2 * hstepA, tstepB = 2 * hstepB;
    const unsigned ldsw = (unsigned)wid * 1024u;
    const int aoff = lds_byte(wr * 64 + fr, fq * 8), boff = lds_byte(wc * 32 + fr, fq * 8);
#define PG8_SA(b, h) (((b) * 2 + (h)) * HTB)
#define PG8_SB(b, h) ((4 + (b) * 2 + (h)) * HTB)
#define PG8_STAGE(bufoff, gbase, voff) do { _Pragma("unroll") for (int _i = 0; _i < 2; ++_i) \
        __builtin_amdgcn_global_load_lds((const unsigned*)((const char*)(gbase) + (voff)[_i]), (LAS unsigned*)(lds + (bufoff) + ldsw + _i * 8192), 16, 0, 0); } while (0)
#define PG8_LDA(dst, b, h) do { _Pragma("unroll") for (int m = 0; m < 4; ++m) _Pragma("unroll") for (int k = 0; k < 2; ++k) dst[m][k] = *(const LAS hf8*)(lds + PG8_SA(b, h) + aoff + m * 2048 + k * 1024); } while (0)
#define PG8_LDB(dst, b, h) do { _Pragma("unroll") for (int n = 0; n < 2; ++n) _Pragma("unroll") for (int k = 0; k < 2; ++k) dst[n][k] = *(const LAS hf8*)(lds + PG8_SB(b, h) + boff + n * 2048 + k * 1024); } while (0)
#define PG8_MMA(ai, bj, At, Bt) do { __builtin_amdgcn_s_setprio(1); _Pragma("unroll") for (int m = 0; m < 4; ++m) _Pragma("unroll") for (int n = 0; n < 2; ++n) _Pragma("unroll") for (int k = 0; k < 2; ++k) \
        acc[ai][bj][m][n] = __builtin_amdgcn_mfma_f32_16x16x32_f16(Bt[n][k], At[m][k], acc[ai][bj][m][n], 0, 0, 0); __builtin_amdgcn_s_setprio(0); } while (0)
#define PG8_WAIT_V(n) asm volatile("s_waitcnt vmcnt(" #n ")" ::: "memory")
#define PG8_WAIT_L(n) asm volatile("s_waitcnt lgkmcnt(" #n ")" ::: "memory")
#define PG8_BAR __builtin_amdgcn_s_barrier()
#define PG8_SCHED __builtin_amdgcn_sched_barrier(0)
    Unit cur, nxt; int ui = 0;
    if (!S.next(0, cur)) return;
    f32x4 acc[2][2][4][2];
#pragma unroll
    for (int a = 0; a < 2; ++a)
#pragma unroll
        for (int b = 0; b < 2; ++b)
#pragma unroll
            for (int m = 0; m < 4; ++m)
#pragma unroll
                for (int n = 0; n < 2; ++n) acc[a][b][m][n] = (f32x4){0.f, 0.f, 0.f, 0.f};
    hf8 At[4][2], B0[2][2], B1[2][2];
    const char* cA = (const char*)g.A + (size_t)cur.pm * tstepA + PG8_KOFF(cur); const char* cB = (const char*)g.Bt + (size_t)cur.pn * tstepB + PG8_KOFF(cur);
    int ntc = PG8_NT(cur);
    S.a_ready(cur);
    PG8_STAGE(PG8_SB(0, 0), cB, voffB); PG8_STAGE(PG8_SB(0, 1), cB + hstepB, voffB); PG8_STAGE(PG8_SA(0, 0), cA, voffA); PG8_STAGE(PG8_SA(0, 1), cA + hstepA, voffA);
    if (wr == 1) PG8_BAR;
    PG8_WAIT_V(2); PG8_BAR;
    PG8_STAGE(PG8_SB(1, 0), cB + kstep, voffB); PG8_STAGE(PG8_SA(1, 0), cA + kstep, voffA); PG8_STAGE(PG8_SB(1, 1), cB + hstepB + kstep, voffB);
    PG8_WAIT_V(6); PG8_BAR;
    for (;;) {
        const bool has_next = S.next(ui + 1, nxt);
        const char* nA = has_next ? (const char*)g.A + (size_t)nxt.pm * tstepA + PG8_KOFF(nxt) : cA; const char* nB = has_next ? (const char*)g.Bt + (size_t)nxt.pn * tstepB + PG8_KOFF(nxt) : cB;
#pragma unroll 1
        for (int t = 0; t < ntc; t += 2) {
            const bool last = (t == ntc - 2);
            const char* a1 = cA + (size_t)(t + 1) * kstep;
            const char* a2 = last ? nA : cA + (size_t)(t + 2) * kstep; const char* b2 = last ? nB : cB + (size_t)(t + 2) * kstep;
            const char* a3 = a2 + kstep; const char* b3 = b2 + kstep;
            if (last && has_next) S.a_ready(nxt);
            if constexpr (Epi::MIDK) { if (t == Epi::MID1 || t == Epi::MID2) {
                if (wr == 0) PG8_BAR;
                E.mid(acc, cur, t == Epi::MID1 ? 0 : 1, wr, wc, fr, fq);
                if (wr == 1) PG8_BAR; } }
            if constexpr (Epi::PRE) { if (last) E.prefetch(cur, wid, lane); }
            PG8_LDB(B0, 0, 0); PG8_LDB(B1, 0, 1); PG8_SCHED; PG8_LDA(At, 0, 0); PG8_STAGE(PG8_SA(1, 1), a1 + hstepA, voffA);
            PG8_WAIT_V(8); PG8_WAIT_L(0); PG8_BAR; PG8_MMA(0, 0, At, B0); PG8_MMA(0, 1, At, B1); PG8_BAR; PG8_SCHED;
            PG8_LDA(At, 0, 1); PG8_STAGE(PG8_SB(0, 0), b2, voffB); PG8_STAGE(PG8_SB(0, 1), b2 + hstepB, voffB); PG8_STAGE(PG8_SA(0, 0), a2, voffA);
            PG8_WAIT_V(8); PG8_WAIT_L(0); PG8_BAR; PG8_MMA(1, 0, At, B0); PG8_MMA(1, 1, At, B1); PG8_BAR; PG8_SCHED;
            PG8_LDB(B0, 1, 0); PG8_LDB(B1, 1, 1); PG8_SCHED; PG8_LDA(At, 1, 0); PG8_STAGE(PG8_SA(0, 1), a2 + hstepA, voffA);
            PG8_WAIT_V(8); PG8_WAIT_L(0); PG8_BAR; PG8_MMA(0, 0, At, B0); PG8_MMA(0, 1, At, B1); PG8_BAR; PG8_SCHED;
            PG8_LDA(At, 1, 1); PG8_STAGE(PG8_SB(1, 0), b3, voffB); PG8_STAGE(PG8_SB(1, 1), b3 + hstepB, voffB); PG8_STAGE(PG8_SA(1, 0), a3, voffA);
            PG8_WAIT_V(8); PG8_WAIT_L(0); PG8_BAR; PG8_MMA(1, 0, At, B0); PG8_MMA(1, 1, At, B1); PG8_BAR; PG8_SCHED;
        }
        if constexpr (ALIGN_EPI) { if (wr == 0) PG8_BAR; }
        E(acc, cur, wr, wc, fr, fq); S.done(cur);
#ifdef PROBE_EPI2
        if (Epi::PROBE2) { asm volatile("" ::: "memory"); E(acc, cur, wr, wc, fr, fq); }
#endif
        if (!has_next) break;
#pragma unroll
        for (int a = 0; a < 2; ++a)
#pragma unroll
            for (int b = 0; b < 2; ++b)
#pragma unroll
                for (int m = 0; m < 4; ++m)
#pragma unroll
                    for (int n = 0; n < 2; ++n) acc[a][b][m][n] = (f32x4){0.f, 0.f, 0.f, 0.f};
        cur = nxt; cA = nA; cB = nB; ++ui; ntc = PG8_NT(cur);
        if constexpr (ALIGN_EPI) { if (wr == 1) PG8_BAR; }
    }
    PG8_WAIT_V(0);
    if constexpr (!ALIGN_EPI) { if (wr == 0) PG8_BAR; }
    PG8_BAR;
#undef PG8_SA
#undef PG8_SB
#undef PG8_STAGE
#undef PG8_LDA
#undef PG8_LDB
#undef PG8_MMA
#undef PG8_WAIT_V
#undef PG8_WAIT_L
#undef PG8_BAR
#undef PG8_SCHED
}
}

struct Params {
    const float* in[35];
    float* out;
    unsigned char* ws;
    int ph_lo, ph_hi;
};
enum { I_X = 0, I_C, I_CTX, I_CCTX, I_NMG, I_NFG, I_WMOD, I_BMOD, I_WIN, I_QNG, I_WUQ, I_KVNG, I_WUKV, I_HCW, I_HCB, I_HW1, I_HB1, I_HFREQ, I_HW2, I_HB2, I_HW3, I_HB3,
       I_HSKIP, I_LQ1, I_LK1, I_LQ2, I_LK2, I_SUBG, I_WBRA, I_WBRB, I_WBRC, I_WOUT, I_FC1, I_FC2, I_FNG };

struct Frame {
    LAS unsigned char* lds;
    int tid, lane, wave, vcu, G;
};

__device__ __forceinline__ void tr_item(const float* W, int ldw, hf* WT, int ldt, int nblk, LAS float* scr, int item, int lane, const float* kgain = nullptr) {
    const int kb = item / nblk, nb = item % nblk, k0 = 64 * kb, n0 = 32 * nb;
#pragma unroll 8
    for (int i = 0; i < 32; ++i) { const int kk = 2 * i + (lane >> 5); const float gk = kgain ? kgain[k0 + kk] : 1.f; { float wv = W[(size_t)(k0 + kk) * ldw + n0 + (lane & 31)] * gk; unsigned ub = __float_as_uint(wv); ub += 0xffffu + ((ub >> 17) & 1u); ub &= 0xfffe0000u; scr[kk * 33 + (lane & 31)] = __uint_as_float(ub); } }
    LDS_WAIT(); asm volatile("" ::: "memory");
    const int c = lane & 7;
#pragma unroll
    for (int j = 0; j < 4; ++j) { const int n = (lane >> 3) + 8 * j; const LAS float* s = scr + (8 * c) * 33 + n;
        u32x4 o; o.x = pkh(s[0 * 33], s[1 * 33]); o.y = pkh(s[2 * 33], s[3 * 33]); o.z = pkh(s[4 * 33], s[5 * 33]); o.w = pkh(s[6 * 33], s[7 * 33]);
        *(u32x4*)(WT + (size_t)(n0 + n) * ldt + k0 + 8 * c) = o; }
    LDS_WAIT(); asm volatile("" ::: "memory");
}
__device__ __forceinline__ float silu_f(float x) { return x / (1.f + expf(-x)); }

constexpr int SP33 = 1032;
__device__ __forceinline__ void gemv33_wave(const LAS hf* S16, const float* Wn, size_t ldw, int lane, f32x16& acc, float& a32) {
    const int r32 = lane & 31, hi = lane >> 5;
    acc = f32x16{}; float s32 = 0.f;
    const LAS hf* sa = S16 + r32 * SP33 + 8 * hi; const LAS hf* sc = S16 + 32 * SP33 + 8 * hi;
    const float* wp = Wn + (size_t)(8 * hi) * ldw;
#pragma unroll 1
    for (int k0 = 0; k0 < DM; k0 += 64) {
        float wv[4][8];
#pragma unroll
        for (int q = 0; q < 4; ++q)
#pragma unroll
            for (int j = 0; j < 8; ++j) wv[q][j] = wp[(size_t)(k0 + 16 * q + j) * ldw];
#pragma unroll
        for (int q = 0; q < 4; ++q) {
            u32x4 bw; bw.x = pkh(wv[q][0], wv[q][1]); bw.y = pkh(wv[q][2], wv[q][3]); bw.z = pkh(wv[q][4], wv[q][5]); bw.w = pkh(wv[q][6], wv[q][7]);
            const hf8 af = *(const LAS hf8*)(sa + k0 + 16 * q), cf = *(const LAS hf8*)(sc + k0 + 16 * q);
            acc = __builtin_amdgcn_mfma_f32_32x32x16_f16(af, __builtin_bit_cast(hf8, bw), acc, 0, 0, 0);
#pragma unroll
            for (int j = 0; j < 8; ++j) s32 = fmaf((float)cf[j], wv[q][j], s32); }
    }
    a32 = s32 + __shfl_xor(s32, 32);
}
__device__ __forceinline__ void mod_phase(const Frame& F, const Params& p) {
    float* MOD = (float*)(p.ws + WS_MOD);
    LAS hf* S16 = (LAS hf*)F.lds;
    const int lane = F.lane, r32 = lane & 31, hi = lane >> 5;
    __syncthreads();
    for (int i = F.tid; i < NMODV * DM; i += 512) { const int v = i / DM, k = i % DM;
        const float c = (v < NB) ? p.in[I_C][v * DM + k] : p.in[I_CCTX][k]; S16[v * SP33 + k] = (hf)silu_f(c); }
    __syncthreads();
    constexpr int NWI = DEPTH * MODW / 32;
    for (int wi = F.wave * F.G + F.vcu; wi < NWI; wi += 8 * F.G) {
        const int gcol = wi * 32, l = gcol / MODW, n = gcol % MODW + r32;
        f32x16 acc; float a32;
        gemv33_wave(S16, p.in[I_WMOD] + (size_t)l * DM * MODW + n, MODW, lane, acc, a32);
        const float bm = p.in[I_BMOD][(size_t)l * MODW + n];
        float* o = MOD + (size_t)l * NMODV * MODW + n;
#pragma unroll
        for (int r = 0; r < 16; ++r) o[(size_t)((r & 3) + 8 * (r >> 2) + 4 * hi) * MODW] = acc[r] + bm;
        if (hi == 0) o[(size_t)NB * MODW] = a32 + bm;
    }
    __syncthreads();
}

__device__ __forceinline__ void filt_item(const Params& p, int l, int kind  , int t, int lane) {
    const int L = kind ? CTXL : SEQ;
    hf* R = kind ? (hf*)(p.ws + WS_RFC) + (size_t)l * 256 * 512 : (hf*)(p.ws + WS_RF) + (size_t)l * 256 * 4096;
    const int rl = 2 * L;
    const float tl = (float)t / (float)(L - 1);
    const float wt = (6.283185307179586f / (float)L) * (float)t;
    float z = 0.f;
    if (lane == 0) z = tl;
    else if (lane <= 32) { const int bi = (lane - 1) & 15; const float band = 1e-4f + (15.f - 1e-4f) * ((float)bi / 15.f); const float a = band * wt; z = (lane <= 16) ? cosf(a) : -sinf(a); }
    const float* w1 = p.in[I_HW1] + (size_t)l * 33 * 64; const float* w2 = p.in[I_HW2] + (size_t)l * 64 * 64; const float* w3 = p.in[I_HW3] + (size_t)l * 64 * 512;
    const float fr = p.in[I_HFREQ][l * 64 + lane];
    float a1 = p.in[I_HB1][l * 64 + lane];
#pragma unroll
    for (int i = 0; i < 33; ++i) a1 = fmaf(__shfl(z, i), w1[i * 64 + lane], a1);
    a1 = sinf(fr * a1);
    float a2 = p.in[I_HB2][l * 64 + lane];
#pragma unroll 16
    for (int i = 0; i < 64; ++i) a2 = fmaf(__shfl(a1, i), w2[i * 64 + lane], a2);
    a2 = sinf(fr * a2);
    float h[8];
#pragma unroll
    for (int q = 0; q < 8; ++q) h[q] = p.in[I_HB3][l * 512 + q * 64 + lane];
#pragma unroll 8
    for (int i = 0; i < 64; ++i) { const float a = __shfl(a2, i);
#pragma unroll
        for (int q = 0; q < 8; ++q) h[q] = fmaf(a, w3[i * 512 + q * 64 + lane], h[q]); }
    const float d0 = -4.605170185988091f / 1.5f, d1 = -4.605170185988091f / 0.3f;
#pragma unroll
    for (int q = 0; q < 8; ++q) { const int o = q * 64 + lane, dir = o >> 8, c = o & 255;
        const float delta = fabsf(d0 + (d1 - d0) * ((float)c / 255.f));
        float val = h[q] * (expf(-tl * delta) + 0.05f);
        if (dir == 0) { if (t == 0) val += p.in[I_HSKIP][l * 256 + c]; R[(size_t)c * rl + (L - t)] = (hf)val; if (t == 0) R[(size_t)c * rl] = (hf)0.f; }
        else if (t >= 1) R[(size_t)c * rl + (L + t)] = (hf)val; }
}

__device__ __forceinline__ void convert_layer(const Frame& F, const Params& p, int l, unsigned char* wl, int wg_rank, int wg_count) {
    LAS float* scr = (LAS float*)(F.lds + F.wave * 16384);
    const int gw = wg_rank * 8 + F.wave, NGW = wg_count * 8, lane = F.lane;
    constexpr int IT_IN1 = 16 * 61, IT_ING = 16 * 96, IT_UQ = 4 * 24, IT_UKV = 2 * 32, IT_BRA = 8 * 32, IT_BRB = 4 * 32, IT_BRC = 4 * 32, IT_OUT = 16 * 32, IT_FC1 = 16 * 128, IT_FC2 = 64 * 32;
    constexpr int IT_LAYER = IT_IN1 + IT_ING + IT_UQ + IT_UKV + IT_BRA + IT_BRB + IT_BRC + IT_OUT + IT_FC1 + IT_FC2;
    for (int it = gw; it < IT_LAYER; it += NGW) {
        int r = it;
        if (r < IT_IN1) { tr_item(p.in[I_WIN] + (size_t)l * DM * D_IN, D_IN, (hf*)(wl + W_IN1), DM, 61, scr, r, lane); continue; } r -= IT_IN1;
        if (r < IT_ING) { tr_item(p.in[I_WIN] + (size_t)l * DM * D_IN + C_PG, D_IN, (hf*)(wl + W_ING), DM, 96, scr, r, lane); continue; } r -= IT_ING;
        if (r < IT_UQ) { tr_item(p.in[I_WUQ] + (size_t)l * 256 * 768, 768, (hf*)(wl + W_UP), KUP, 24, scr, r, lane, p.in[I_QNG] + l * 256); continue; } r -= IT_UQ;
        if (r < IT_UKV) { tr_item(p.in[I_WUKV] + (size_t)l * 128 * 1024, 1024, (hf*)(wl + W_UP) + (size_t)768 * KUP + 256, KUP, 32, scr, r, lane, p.in[I_KVNG] + l * 128); continue; } r -= IT_UKV;
        if (r < IT_BRA) { tr_item(p.in[I_WBRA] + (size_t)l * 512 * DM, DM, (hf*)(wl + W_BR), DM, 32, scr, r, lane); continue; } r -= IT_BRA;
        if (r < IT_BRB) { tr_item(p.in[I_WBRB] + (size_t)l * 256 * DM, DM, (hf*)(wl + W_BR) + 512, DM, 32, scr, r, lane); continue; } r -= IT_BRB;
        if (r < IT_BRC) { tr_item(p.in[I_WBRC] + (size_t)l * 256 * DM, DM, (hf*)(wl + W_BR) + 768, DM, 32, scr, r, lane); continue; } r -= IT_BRC;
        if (r < IT_OUT) { tr_item(p.in[I_WOUT] + (size_t)l * DM * DM, DM, (hf*)(wl + W_OUT), DM, 32, scr, r, lane); continue; } r -= IT_OUT;
        if (r < IT_FC1) { tr_item(p.in[I_FC1] + (size_t)l * DM * DFF, DFF, (hf*)(wl + W_FC1), DM, 128, scr, r, lane); continue; } r -= IT_FC1;
        tr_item(p.in[I_FC2] + (size_t)l * DFF * DM, DM, (hf*)(wl + W_FC2), DFF, 32, scr, r, lane);
    }
    const int gt = gw * 64 + lane, NGT = NGW * 64;
    u32x4* z1 = (u32x4*)((hf*)(wl + W_IN1) + (size_t)C_PG * DM);
    for (int i = gt; i < 96 * DM / 8; i += NGT) z1[i] = (u32x4){0u, 0u, 0u, 0u};
    hf* up = (hf*)(wl + W_UP);
    for (int i = gt; i < 768 * 16; i += NGT) { const int n = i / 16, k8 = i % 16; *(u32x4*)(up + (size_t)n * KUP + 256 + k8 * 8) = (u32x4){0u, 0u, 0u, 0u}; }
    for (int i = gt; i < 1024 * 32; i += NGT) { const int n = 768 + i / 32, k8 = i % 32; *(u32x4*)(up + (size_t)n * KUP + k8 * 8) = (u32x4){0u, 0u, 0u, 0u}; }
}

__device__ __forceinline__ void prologue_a(const Frame& F, const Params& p) {
    mod_phase(F, p);
    convert_layer(F, p, 0, p.ws + WS_WT, F.vcu, F.G);
    const int gw = F.vcu * 8 + F.wave, NGW = F.G * 8, lane = F.lane;
    for (int it = gw; it < DEPTH * (SEQ + CTXL); it += NGW) { const int l = it / (SEQ + CTXL), r = it % (SEQ + CTXL); if (r < SEQ) filt_item(p, l, 0, r, lane); else filt_item(p, l, 1, r - SEQ, lane); }
    {
        float* rope = (float*)(p.ws + WS_ROPE);
        const int gt = gw * 64 + lane, NGT = NGW * 64;
        for (int i = gt; i < SEQ * 16; i += NGT) { const int t = i >> 4, j = i & 15; const float pos = (j < 8) ? (float)(t / GRIDW) : (float)(t % GRIDW);
            const float inv = powf(10000.f, -(float)(j & 7) / 8.f); const float a = pos * inv; rope[t * 32 + j] = cosf(a); rope[t * 32 + 16 + j] = sinf(a); }
        if (gt < DEPTH) { const int l = gt; float s1 = 0.f, s2 = 0.f;
            for (int i = 0; i < 32; ++i) { s1 += p.in[I_LQ1][l * 32 + i] * p.in[I_LK1][l * 32 + i]; s2 += p.in[I_LQ2][l * 32 + i] * p.in[I_LK2][l * 32 + i]; }
            const float li = 0.8f - 0.6f * expf(-0.3f * (float)l);
            float* lam = (float*)(p.ws + WS_LAM); lam[2 * l] = expf(s1) - expf(s2) + li; lam[2 * l + 1] = 1.f - li; }
    }
}
__device__ __forceinline__ void prologue_b(const Frame& F, const Params& p) {
    const float* MOD = (const float*)(p.ws + WS_MOD); float* BIAS = (float*)(p.ws + WS_BIAS);
    {
        LAS hf* S16 = (LAS hf*)F.lds;
        const int lane = F.lane, r32 = lane & 31, hi = lane >> 5;
        const int grp = F.vcu % 8, rank = F.vcu / 8, nrank = (F.G - grp + 7) / 8;
        const int l = grp >> 1, typ = grp & 1, soff = typ ? 3 * DM : 0, nb0 = typ ? B_FC1 : 0, nwi = (typ ? (NBIAS - B_FC1) : B_FC1) / 32;
        __syncthreads();
        for (int i = F.tid; i < NMODV * DM; i += 512) { const int v = i / DM, k = i % DM; S16[v * SP33 + k] = (hf)MOD[((size_t)l * NMODV + v) * MODW + soff + k]; }
        __syncthreads();
        for (int wi = rank + nrank * F.wave; wi < nwi; wi += nrank * 8) {
            const int n0 = nb0 + wi * 32, n = n0 + r32;
            const float* w; size_t ldw; bool valid = true;
            if (n0 < B_G) { w = p.in[I_WIN] + (size_t)l * DM * D_IN + n; ldw = D_IN; valid = n0 < C_PG; }
            else if (n0 < B_FC1) { w = p.in[I_WIN] + (size_t)l * DM * D_IN + C_PG + (n - B_G); ldw = D_IN; }
            else { w = p.in[I_FC1] + (size_t)l * DM * DFF + (n - B_FC1); ldw = DFF; }
            f32x16 acc = f32x16{}; float a32 = 0.f;
            if (valid) gemv33_wave(S16, w, ldw, lane, acc, a32);
            float* o = BIAS + (size_t)l * NMODV * NBIAS + n;
#pragma unroll
            for (int r = 0; r < 16; ++r) o[(size_t)((r & 3) + 8 * (r >> 2) + 4 * hi) * NBIAS] = acc[r];
            if (hi == 0) o[(size_t)NB * NBIAS] = a32;
        }
        __syncthreads();
    }
    const int gw = F.vcu * 8 + F.wave, NGW = F.G * 8, lane = F.lane;
    {
        float* GS = (float*)(p.ws + WS_GS);
        const int gt = gw * 64 + lane, NGT = NGW * 64;
        for (int i = gt; i < DEPTH * 2 * NMODV * DM; i += NGT) { const int c = i % DM, v = (i / DM) % NMODV, wh = (i / (DM * NMODV)) % 2, l = i / (DM * NMODV * 2);
            const float g = wh ? p.in[I_NFG][l * DM + c] : p.in[I_NMG][l * DM + c];
            GS[i] = g * (1.f + MOD[((size_t)l * NMODV + v) * MODW + (wh ? 4 * DM : DM) + c]); }
    }
    {
        hf* XS = (hf*)p.out; hf* X16 = (hf*)(p.ws + WS_X16); float* ss = (float*)(p.ws + WS_SS) + (size_t)SS_1 * MTOT * 4;
        f32x4 g[4];
#pragma unroll
        for (int j = 0; j < 4; ++j) g[j] = *(const f32x4*)(p.in[I_NMG] + 4 * lane + 256 * j);
        for (int row0 = gw; row0 < MTOT; row0 += 2 * NGW) {
            const int row1 = (row0 + NGW < MTOT) ? row0 + NGW : row0;
            f32x4 xa[2][4], sa[2][4];
#pragma unroll
            for (int h = 0; h < 2; ++h) { const int row = h ? row1 : row0; const bool lat = row < NLAT;
                const float* xr = lat ? p.in[I_X] + (size_t)row * DM : p.in[I_CTX] + (size_t)(row - NLAT) * DM;
                const int v = lat ? (row >> 11) : NB; const float* mv = MOD + (size_t)v * MODW + DM;
#pragma unroll
                for (int j = 0; j < 4; ++j) { xa[h][j] = *(const f32x4*)(xr + 4 * lane + 256 * j); sa[h][j] = *(const f32x4*)(mv + 4 * lane + 256 * j); } }
#pragma unroll
            for (int h = 0; h < 2; ++h) { const int row = h ? row1 : row0;
                float sq = 0.f; hf* hr = XS + (size_t)row * DM; hf* xh = X16 + (size_t)row * DM;
#pragma unroll
                for (int j = 0; j < 4; ++j) { const f32x4 x = xa[h][j]; const f32x4 sc = sa[h][j];
                    sq += (x[0] * x[0] + x[1] * x[1]) + (x[2] * x[2] + x[3] * x[3]);
                    const f32x4 o = x * (g[j] * (sc + 1.f)); u32x2 w; w.x = pkhb(o[0], o[1]); w.y = pkhb(o[2], o[3]); *(u32x2*)(hr + 4 * lane + 256 * j) = w;
                    u32x2 w2; w2.x = pkh(x[0], x[1]); w2.y = pkh(x[2], x[3]); *(u32x2*)(xh + 4 * lane + 256 * j) = w2; }
                sq = wave_sum(sq);
                if (lane == 0) *(f32x4*)(ss + 4 * (size_t)row) = (f32x4){sq, 0.f, 0.f, 0.f}; }
        }
    }
}

__device__ __forceinline__ void norm_phase(const Frame& F, const float* xs_lat, const float* xs_ctx, int nrows, const float* gain, const float* modl, int sh_off, int sc_off, hf* H) {
    const int gw = F.vcu * 8 + F.wave, NGW = F.G * 8, lane = F.lane;
    f32x4 g[4];
#pragma unroll
    for (int j = 0; j < 4; ++j) g[j] = *(const f32x4*)(gain + 4 * lane + 256 * j);
    for (int row = gw; row < nrows; row += NGW) {
        const bool lat = row < NLAT; const float* xr = lat ? xs_lat + (size_t)row * DM : xs_ctx + (size_t)(row - NLAT) * DM;
        const int v = lat ? (row >> 11) : NB; const float* mv = modl + (size_t)v * MODW;
        f32x4 x[4]; float ss = 0.f;
#pragma unroll
        for (int j = 0; j < 4; ++j) { x[j] = *(const f32x4*)(xr + 4 * lane + 256 * j); ss += (x[j][0] * x[j][0] + x[j][1] * x[j][1]) + (x[j][2] * x[j][2] + x[j][3] * x[j][3]); }
        const float rstd = rsqrtf(wave_sum(ss) * (1.f / DM) + EPS);
        hf* hr = H + (size_t)row * DM;
#pragma unroll
        for (int j = 0; j < 4; ++j) { const f32x4 sh = *(const f32x4*)(mv + sh_off + 4 * lane + 256 * j), sc = *(const f32x4*)(mv + sc_off + 4 * lane + 256 * j);
            const f32x4 y = (x[j] * rstd) * g[j]; const f32x4 o = y * (sc + 1.f) + sh;
            u32x2 w; w.x = pkh(o[0], o[1]); w.y = pkh(o[2], o[3]); *(u32x2*)(hr + 4 * lane + 256 * j) = w; }
    }
}
__device__ __forceinline__ void final_norm_phase(const Frame& F, const hf* X16, float* out, const float* gain, const float* ss) {
    const int gw = F.vcu * 8 + F.wave, NGW = F.G * 8, lane = F.lane;
    f32x4 g[4];
#pragma unroll
    for (int j = 0; j < 4; ++j) g[j] = *(const f32x4*)(gain + 4 * lane + 256 * j);
    for (int row0 = gw; row0 < NLAT; row0 += 2 * NGW) {
        const int row1 = (row0 + NGW < NLAT) ? row0 + NGW : row0;
        hf4 xa[2][4]; float rs[2];
#pragma unroll
        for (int h = 0; h < 2; ++h) { const int row = h ? row1 : row0; const hf* xr = X16 + (size_t)row * DM; rs[h] = rstd4(ss, row);
#pragma unroll
            for (int j = 0; j < 4; ++j) xa[h][j] = *(const hf4*)(xr + 4 * lane + 256 * j); }
#pragma unroll
        for (int h = 0; h < 2; ++h) { const int row = h ? row1 : row0; float* orow = out + (size_t)row * DM;
#pragma unroll
            for (int j = 0; j < 4; ++j) { const hf4 xh = xa[h][j]; const f32x4 x = {(float)xh[0], (float)xh[1], (float)xh[2], (float)xh[3]};
                *(f32x4*)(orow + 4 * lane + 256 * j) = (x * rs[h]) * g[j]; } }
    }
}
__device__ __forceinline__ void prep_rope(const Frame& F, const Params& p) {
    const int gw = F.vcu * 8 + F.wave, NGW = F.G * 8, lane = F.lane;
    hf* KR = (hf*)(p.ws + A_KR); hf* DK = (hf*)(p.ws + A_DK); const float* rope = (const float*)(p.ws + WS_ROPE);
    auto rot8 = [&](const hf8 xa, const hf8 xb, const f32x4 c0, const f32x4 c1, const f32x4 s0, const f32x4 s1, u32x4& oa, u32x4& ob) {
        float ra[8], rb[8];
#pragma unroll
        for (int j = 0; j < 8; ++j) { const float cc = j < 4 ? c0[j & 3] : c1[j & 3], sn = j < 4 ? s0[j & 3] : s1[j & 3]; const float x1 = (float)xa[j], x2 = (float)xb[j];
            ra[j] = x1 * cc - x2 * sn; rb[j] = x2 * cc + x1 * sn; }
        oa.x = pkh(ra[0], ra[1]); oa.y = pkh(ra[2], ra[3]); oa.z = pkh(ra[4], ra[5]); oa.w = pkh(ra[6], ra[7]);
        ob.x = pkh(rb[0], rb[1]); ob.y = pkh(rb[2], rb[3]); ob.z = pkh(rb[4], rb[5]); ob.w = pkh(rb[6], rb[7]); };
    const int i0 = (lane & 1) * 8;
    {
        const int rsub = lane >> 4, hh = (lane >> 1) & 7;
        for (int row0 = gw * 8; row0 < NLAT; row0 += NGW * 8) {
            hf8 xa[2], xb[2]; f32x4 c0[2], c1[2], s0[2], s1[2];
#pragma unroll
            for (int g = 0; g < 2; ++g) { const int row = row0 + 4 * g + rsub, t = row & (SEQ - 1); const hf* dk = DK + (size_t)row * 256 + hh * 32 + i0; const float* rt = rope + t * 32 + i0;
                xa[g] = *(const hf8*)dk; xb[g] = *(const hf8*)(dk + 16); c0[g] = *(const f32x4*)rt; c1[g] = *(const f32x4*)(rt + 4); s0[g] = *(const f32x4*)(rt + 16); s1[g] = *(const f32x4*)(rt + 20); }
#pragma unroll
            for (int g = 0; g < 2; ++g) { const int row = row0 + 4 * g + rsub; hf* dk = DK + (size_t)row * 256 + hh * 32 + i0; u32x4 oa, ob;
                rot8(xa[g], xb[g], c0[g], c1[g], s0[g], s1[g], oa, ob); *(u32x4*)dk = oa; *(u32x4*)(dk + 16) = ob; }
        }
    }
    {
        for (int row0 = gw * 32; row0 < NLAT; row0 += NGW * 32) { const int row = row0 + (lane >> 1), t = row & (SEQ - 1); hf* kr = KR + (size_t)row * 32 + i0; const float* rt = rope + t * 32 + i0;
            const hf8 xa = *(const hf8*)kr, xb = *(const hf8*)(kr + 16); const f32x4 c0 = *(const f32x4*)rt, c1 = *(const f32x4*)(rt + 4), s0 = *(const f32x4*)(rt + 16), s1 = *(const f32x4*)(rt + 20);
            u32x4 oa, ob; rot8(xa, xb, c0, c1, s0, s1, oa, ob); *(u32x4*)kr = oa; *(u32x4*)(kr + 16) = ob; }
    }
}
__device__ __forceinline__ void prep_hyena(const Frame& F, const Params& p, int l, bool with_ctx) {
    constexpr int INP = 784;
    constexpr int OUTP = 33;
    constexpr int OFF_OU = 66 * INP, OFF_OX = OFF_OU + 128 * OUTP * 4;
    const hf* PHY = (const hf*)(p.ws + A_PHY);
    LAS unsigned char* lds = F.lds; const int tid = F.tid;
    const float* cw = p.in[I_HCW] + (size_t)l * 3 * 768; const float* cb = p.in[I_HCB] + (size_t)l * 768;
    constexpr int U_LAT = NB * (SEQ / 64) * 2, U_CTX = NB * (CTXL / 64) * 2;
    const int nunit = U_LAT + (with_ctx ? U_CTX : 0);
    for (int un = F.vcu; un < nunit; un += F.G) {
        const bool ctx = un >= U_LAT; int r = ctx ? un - U_LAT : un; const int L = ctx ? CTXL : SEQ, ntile = L / 64;
        const int ch = r & 1; r >>= 1; const int tt = r % ntile, b = r / ntile;
        const int t0 = tt * 64; const size_t rowbase = ctx ? (size_t)NLAT + (size_t)b * CTXL : (size_t)b * SEQ;
        hf* dU = (hf*)((unsigned char*)p.out + (ctx ? O_UTC : O_UT)); hf* dX = (hf*)((unsigned char*)p.out + (ctx ? O_X0TC : O_X0T));
        __syncthreads();
        {
            u32x4 tmp[7];
#pragma unroll
            for (int k = 0; k < 7; ++k) { const int i = tid + 512 * k, rr = i / 48, q = i % 48, seg = q >> 4, c16 = q & 15; const int t = t0 - 1 + rr;
                tmp[k] = (u32x4){0u, 0u, 0u, 0u};
                if (i < 66 * 48 && t >= 0 && t < L) tmp[k] = *(const u32x4*)(PHY + (rowbase + t) * 768 + seg * 256 + ch * 128 + c16 * 8); }
#pragma unroll
            for (int k = 0; k < 7; ++k) { const int i = tid + 512 * k, rr = i / 48, q = i % 48, seg = q >> 4, c16 = q & 15;
                if (i < 66 * 48) *(LAS u32x4*)(lds + rr * INP + seg * 256 + c16 * 16) = tmp[k]; }
        }
        __syncthreads();
        {
            const int c = tid & 127, tg = tid >> 7, cg = ch * 128 + c;
            const float a0 = cw[cg], a1 = cw[768 + cg], a2 = cw[1536 + cg], ab = cb[cg];
            const float b0 = cw[256 + cg], b1 = cw[768 + 256 + cg], b2 = cw[1536 + 256 + cg], bb = cb[256 + cg];
            const float v0 = cw[512 + cg], v1 = cw[768 + 512 + cg], v2 = cw[1536 + 512 + cg], vb = cb[512 + cg];
            const LAS hf* in = (const LAS hf*)(lds + (16 * tg) * INP) + c;
            float p0 = (float)in[0], p1 = (float)in[128], p2 = (float)in[256];
            float c0 = (float)in[INP / 2], c1 = (float)in[INP / 2 + 128], c2 = (float)in[INP / 2 + 256];
            LAS hf* ou = (LAS hf*)(lds + OFF_OU) + c * (OUTP * 2) + 16 * tg; LAS hf* ox = (LAS hf*)(lds + OFF_OX) + c * (OUTP * 2) + 16 * tg;
#pragma unroll
            for (int j = 0; j < 16; ++j) { const LAS hf* nx = in + (j + 2) * (INP / 2);
                const float n0 = (float)nx[0], n1 = (float)nx[128], n2 = (float)nx[256];
                const float x0 = a0 * p0 + a1 * c0 + a2 * n0 + ab, x1 = b0 * p1 + b1 * c1 + b2 * n1 + bb, vv = v0 * p2 + v1 * c2 + v2 * n2 + vb;
                ou[j] = (hf)(vv * x1); ox[j] = (hf)x0;
                p0 = c0; p1 = c1; p2 = c2; c0 = n0; c1 = n1; c2 = n2; }
        }
        __syncthreads();
        {
            const int c = tid >> 2, q = tid & 3; const size_t go = ((size_t)(ch * 128 + c) * NB + b) * L + t0 + 16 * q;
            const LAS unsigned* su = (const LAS unsigned*)(lds + OFF_OU) + c * OUTP + 8 * q; const LAS unsigned* sx = (const LAS unsigned*)(lds + OFF_OX) + c * OUTP + 8 * q;
            u32x4 w0 = {su[0], su[1], su[2], su[3]}, w1 = {su[4], su[5], su[6], su[7]};
            *(u32x4*)(dU + go) = w0; *(u32x4*)(dU + go + 8) = w1;
            u32x4 y0 = {sx[0], sx[1], sx[2], sx[3]}, y1 = {sx[4], sx[5], sx[6], sx[7]};
            *(u32x4*)(dX + go) = y0; *(u32x4*)(dX + go + 8) = y1;
        }
    }
    __syncthreads();
}

namespace att {
#ifndef PROF_SEL
#define PROF_SEL -1
#endif
#define ATT_MARK(b) do { if (PROF_SEL >= 0 && F.tid == 0) { volatile LAS unsigned* _pf = (volatile LAS unsigned*)(F.lds + LDS_BYTES - 512); const unsigned _t = (unsigned)__builtin_amdgcn_s_memrealtime(); _pf[(b)] += _t - _pf[32]; _pf[32] = _t; } } while (0)
__device__ __forceinline__ int crow(int r, int hi) { return (r & 3) + 8 * (r >> 2) + 4 * hi; }
#define SBAR() __builtin_amdgcn_sched_barrier(0)
constexpr float THR2 = 8.f * 1.4426950408889634f;
constexpr int KS_MLA = 208, KS_DF = 80;
constexpr int VS = 192, VB = 64 * VS;
constexpr int OFF_V = 32768;
template <int OFF> __device__ __forceinline__ s16x4 tr_read(int vb) {
    s16x4 r; asm volatile("ds_read_b64_tr_b16 %0, %1 offset:%2" : "=&v"(r) : "v"(vb), "i"(OFF) : "memory"); return r;
}
__device__ __forceinline__ int kpos(int key) { return (key & ~0xC) | ((key & 4) << 1) | ((key & 8) >> 1); }

template <int ND0, int KS>
__device__ __forceinline__ void qkt(f32x16& p0, f32x16& p1, const LAS unsigned char* Ks, const hf8* qr, int r32, int hi, const f32x16& negm) {
#pragma unroll
    for (int d0 = 0; d0 < ND0; ++d0) { const int cb = (d0 * 16 + hi * 8) * 2;
        const hf8 b0 = *(const LAS hf8*)(Ks + r32 * KS + cb), b1 = *(const LAS hf8*)(Ks + (32 + r32) * KS + cb);
        if (d0 == 0) { p0 = __builtin_amdgcn_mfma_f32_32x32x16_f16(b0, qr[0], negm, 0, 0, 0); p1 = __builtin_amdgcn_mfma_f32_32x32x16_f16(b1, qr[0], negm, 0, 0, 0); }
        else { p0 = __builtin_amdgcn_mfma_f32_32x32x16_f16(b0, qr[d0], p0, 0, 0, 0); p1 = __builtin_amdgcn_mfma_f32_32x32x16_f16(b1, qr[d0], p1, 0, 0, 0); } }
}
__device__ __forceinline__ float max3f(float a, float b, float c) { float r; asm("v_max3_f32 %0, %1, %2, %3" : "=v"(r) : "v"(a), "v"(b), "v"(c)); return r; }
__device__ __forceinline__ float max2f(float a, float b) { float r; asm("v_max_f32_e32 %0, %1, %2" : "=v"(r) : "v"(a), "v"(b)); return r; }
__device__ __forceinline__ float max16(const f32x16& p) { float r, t;
    asm("v_max3_f32 %0, %2, %3, %4\n\tv_max3_f32 %1, %10, %11, %12\n\tv_max3_f32 %0, %0, %5, %6\n\tv_max3_f32 %1, %1, %13, %14\n\tv_max3_f32 %0, %0, %7, %8\n\tv_max3_f32 %1, %1, %15, %16\n\tv_max3_f32 %0, %0, %9, %17\n\tv_max_f32_e32 %0, %0, %1"
        : "=&v"(r), "=&v"(t) : "v"(p[0]), "v"(p[1]), "v"(p[2]), "v"(p[3]), "v"(p[4]), "v"(p[5]), "v"(p[6]), "v"(p[7]), "v"(p[8]), "v"(p[9]), "v"(p[10]), "v"(p[11]), "v"(p[12]), "v"(p[13]), "v"(p[14]), "v"(p[15]));
    return r; }
__device__ __forceinline__ hf8 pack8(const f32x16& p, int b) { u32x4 w = {pkh(p[b], p[b + 1]), pkh(p[b + 2], p[b + 3]), pkh(p[b + 4], p[b + 5]), pkh(p[b + 6], p[b + 7])}; return __builtin_bit_cast(hf8, w); }
__device__ __forceinline__ void sm_max(f32x16& p0, f32x16& p1, float& m, float& l, f32x16& o0, f32x16& o1, f32x16& negm, const bool first) {
    float pmax = max2f(max16(p0), max16(p1));
    { auto rr = __builtin_amdgcn_permlane32_swap(__float_as_uint(pmax), __float_as_uint(pmax), false, false);
      pmax = max2f(__uint_as_float(rr[0]), __uint_as_float(rr[1])); }
    if (first || __any(pmax > THR2)) {
        const float delta = first ? pmax : fmaxf(pmax, 0.f);
        if (!first) { const float alpha = __builtin_amdgcn_exp2f(-delta); l *= alpha;
#pragma unroll
            for (int r = 0; r < 16; ++r) { o0[r] *= alpha; o1[r] *= alpha; } }
#pragma unroll
        for (int r = 0; r < 16; ++r) { p0[r] -= delta; p1[r] -= delta; }
        m += delta;
#pragma unroll
        for (int r = 0; r < 16; ++r) negm[r] = -m;
        asm volatile("" : "+v"(negm));
    }
}
__device__ __forceinline__ void sm_exp(f32x16& p0, f32x16& p1, const float m, float& l, hf8& pf0, hf8& pf1, hf8& pf2, hf8& pf3) {
#pragma unroll
    for (int r = 0; r < 16; ++r) { p0[r] = __builtin_amdgcn_exp2f(p0[r]); p1[r] = __builtin_amdgcn_exp2f(p1[r]); }
    float ps0 = p0[0] + p1[0], ps1 = p0[1] + p1[1], ps2 = p0[2] + p1[2], ps3 = p0[3] + p1[3];
#pragma unroll
    for (int r = 4; r < 16; r += 4) { ps0 += p0[r] + p1[r]; ps1 += p0[r + 1] + p1[r + 1]; ps2 += p0[r + 2] + p1[r + 2]; ps3 += p0[r + 3] + p1[r + 3]; }
    l += (ps0 + ps1) + (ps2 + ps3);
    pf0 = pack8(p0, 0); pf1 = pack8(p0, 8); pf2 = pack8(p1, 0); pf3 = pack8(p1, 8);
}
__device__ __forceinline__ void pv(const hf8 pf0, const hf8 pf1, const hf8 pf2, const hf8 pf3, f32x16& o0, f32x16& o1, const LAS unsigned char* Vt, int r32, int hi) {
    const int lg = r32 & 15, vq = lg >> 2, vp4 = lg & 3;
    const int vbase = (int)(unsigned)(uintptr_t)Vt + (4 * hi + vq) * VS + (16 * ((r32 >> 4) & 1) + 4 * vp4) * 2;
#define PVRD(ks, L0, H0, L1, H1) s16x4 L0 = tr_read<(16 * (ks)) * VS>(vbase), H0 = tr_read<(16 * (ks) + 8) * VS>(vbase), L1 = tr_read<(16 * (ks)) * VS + 64>(vbase), H1 = tr_read<(16 * (ks) + 8) * VS + 64>(vbase)
#define PVMM(N, L0, H0, L1, H1, pf) do { asm volatile("s_waitcnt lgkmcnt(" #N ")" : "+v"(L0), "+v"(H0), "+v"(L1), "+v"(H1) :: "memory"); \
        const hf8 a0 = __builtin_bit_cast(hf8, (short __attribute__((ext_vector_type(8)))){L0[0], L0[1], L0[2], L0[3], H0[0], H0[1], H0[2], H0[3]}); \
        const hf8 a1 = __builtin_bit_cast(hf8, (short __attribute__((ext_vector_type(8)))){L1[0], L1[1], L1[2], L1[3], H1[0], H1[1], H1[2], H1[3]}); \
        o0 = __builtin_amdgcn_mfma_f32_32x32x16_f16(a0, pf, o0, 0, 0, 0); o1 = __builtin_amdgcn_mfma_f32_32x32x16_f16(a1, pf, o1, 0, 0, 0); } while (0)
    PVRD(0, a0l, a0h, a1l, a1h); PVRD(1, b0l, b0h, b1l, b1h);
    PVMM(4, a0l, a0h, a1l, a1h, pf0);
    PVRD(2, c0l, c0h, c1l, c1h);
    PVMM(4, b0l, b0h, b1l, b1h, pf1);
    PVRD(3, d0l, d0h, d1l, d1h);
    PVMM(4, c0l, c0h, c1l, c1h, pf2);
    PVMM(0, d0l, d0h, d1l, d1h, pf3);
#undef PVRD
#undef PVMM
#define PVK(ks, pf)
#undef PVK
}

template <bool MLA>
__device__ __forceinline__ void attn_pass(const Frame& F, const Params& p, int hq, int hv, int qrow0, int qpos0, int klat0, int nlat, int kctx0, f32x16& o0, f32x16& o1, float& inv) {
    constexpr int DK = MLA ? 96 : 32, ND0 = DK / 16, KS = MLA ? KS_MLA : KS_DF, KB = 64 * KS;
    constexpr float SCALE = MLA ? MLA_SCALE : DF_SCALE, C = SCALE * 1.4426950408889634f;
    const int tid = F.tid, wid = F.wave, lane = F.lane, r32 = lane & 31, hi = lane >> 5;
    const hf* QKV = (const hf*)(p.ws + A_QKV); const hf* KRb = (const hf*)(p.ws + A_KR);
    const hf* DQ = (const hf*)(p.ws + A_DQ); const hf* DKb = (const hf*)(p.ws + A_DK); const hf* DVb = (const hf*)(p.ws + A_DV);
    const float* rope = (const float*)(p.ws + WS_ROPE);
    LAS unsigned char* lds = F.lds;
    hf8 qr[ND0];
    {
        const int qrow = qrow0 + wid * 32 + r32;
        const hf* qp = MLA ? QKV + (size_t)qrow * NUP + hq * 96 + hi * 8 : DQ + (size_t)qrow * 256 + hq * 32 + hi * 8;
        hf8 raw[ND0];
#pragma unroll
        for (int d0 = 0; d0 < ND0; ++d0) raw[d0] = *(const hf8*)(qp + d0 * 16);
        f32x4 c0 = {1.f, 1.f, 1.f, 1.f}, c1 = c0, s0 = {0.f, 0.f, 0.f, 0.f}, s1 = s0;
        if (qpos0 >= 0) { const int t = qpos0 + wid * 32 + r32;
            c0 = *(const f32x4*)(rope + t * 32 + hi * 8); c1 = *(const f32x4*)(rope + t * 32 + hi * 8 + 4);
            s0 = *(const f32x4*)(rope + t * 32 + 16 + hi * 8); s1 = *(const f32x4*)(rope + t * 32 + 16 + hi * 8 + 4); }
#pragma unroll
        for (int d0 = 0; d0 < ND0 - 2; ++d0) {
#pragma unroll
            for (int j = 0; j < 8; ++j) qr[d0][j] = (hf)((float)raw[d0][j] * C); }
#pragma unroll
        for (int j = 0; j < 8; ++j) { const float cc = j < 4 ? c0[j & 3] : c1[j & 3], sn = j < 4 ? s0[j & 3] : s1[j & 3]; const float a = (float)raw[ND0 - 2][j], b = (float)raw[ND0 - 1][j];
            qr[ND0 - 2][j] = (hf)((a * cc - b * sn) * C); qr[ND0 - 1][j] = (hf)((b * cc + a * sn) * C); }
    }
    const int k1r = MLA ? (tid >> 3) : ((tid & 255) >> 2), k1c = MLA ? (tid & 7) * 8 : (tid & 3) * 8;
    const int k2r = (tid & 255) >> 2, k2c = (tid & 3) * 8;
    const int vr_ = tid >> 3, vc_ = (tid & 7) * 8;
    const bool klo = tid < 256;
    struct Stg { u32x4 v, k1, k2; };
    Stg sA, sB; sA.v = sA.k1 = sA.k2 = sB.v = sB.k1 = sB.k2 = (u32x4){0u, 0u, 0u, 0u};
    const int ntile = nlat + 4;
#define KROW0(j) (((j) < nlat) ? klat0 + (j) * 64 : kctx0 + ((j) - nlat) * 64)
#define A_LOADK(S, j) do { const int kr0 = KROW0(j); \
        if (MLA) { S.k1 = *(const u32x4*)(QKV + (size_t)(kr0 + k1r) * NUP + 768 + hq * 128 + k1c); S.k2 = *(const u32x4*)(KRb + (size_t)(kr0 + k2r) * 32 + k2c); } \
        else S.k1 = *(const u32x4*)(DKb + (size_t)(kr0 + k1r) * 256 + hq * 32 + k1c); } while (0)
#define A_LOADV(S, j) do { const int kr0 = KROW0(j); \
        if (MLA) S.v = *(const u32x4*)(QKV + (size_t)(kr0 + vr_) * NUP + 768 + hv * 128 + 64 + vc_); else S.v = *(const u32x4*)(DVb + (size_t)(kr0 + vr_) * 256 + hv * 64 + vc_); } while (0)
#define A_WRITEK(S, b) do { *(LAS u32x4*)(lds + (b) * KB + k1r * KS + k1c * 2) = S.k1; if (MLA) *(LAS u32x4*)(lds + (b) * KB + k2r * KS + 128 + k2c * 2) = S.k2; } while (0)
#define A_WRITEV(S, b) do { *(LAS u32x4*)(lds + OFF_V + (b) * VB + vr_ * VS + vc_ * 2) = S.v; } while (0)
    float m_reg = 0.f, l_reg = 0.f;
    f32x16 negm = f32x16{}; asm volatile("" : "+v"(negm));
    o0 = f32x16{}; o1 = f32x16{};
    f32x16 pA0, pA1, pB0, pB1;
    __syncthreads();
    const int nt1 = ntile - 1;
#define TCL(j) (((j) < nt1) ? (j) : nt1)
    A_LOADK(sA, 0); A_LOADV(sA, 0); A_LOADK(sB, 1);
    A_WRITEK(sA, 0); A_WRITEV(sA, 0); A_WRITEK(sB, 1);
    A_LOADK(sA, TCL(2));
    A_LOADV(sA, 1);
    __syncthreads();
    qkt<ND0, KS>(pA0, pA1, lds, qr, r32, hi, negm);
    hf8 f0, f1, f2, f3;
    if (wid >= 4) __syncthreads();
    for (int j = 0; j < ntile; j += 2) {
        A_LOADK(sB, TCL(j + 3)); A_LOADV(sB, TCL(j + 2));
        sm_max(pA0, pA1, m_reg, l_reg, o0, o1, negm, j == 0);
        sm_exp(pA0, pA1, m_reg, l_reg, f0, f1, f2, f3);
        __syncthreads();
        if (MLA) __builtin_amdgcn_s_setprio(1);
        qkt<ND0, KS>(pB0, pB1, lds + KB, qr, r32, hi, negm);
        if (!MLA) __builtin_amdgcn_s_setprio(1);
        pv(f0, f1, f2, f3, o0, o1, lds + OFF_V, r32, hi);
        __builtin_amdgcn_s_setprio(0);
        A_WRITEK(sA, 0); A_WRITEV(sA, 1);
        __syncthreads();
        A_LOADK(sA, TCL(j + 4)); A_LOADV(sA, TCL(j + 3));
        sm_max(pB0, pB1, m_reg, l_reg, o0, o1, negm, false);
        sm_exp(pB0, pB1, m_reg, l_reg, f0, f1, f2, f3);
        __syncthreads();
        if (MLA) __builtin_amdgcn_s_setprio(1);
        qkt<ND0, KS>(pA0, pA1, lds, qr, r32, hi, negm);
        if (!MLA) __builtin_amdgcn_s_setprio(1);
        pv(f0, f1, f2, f3, o0, o1, lds + OFF_V + VB, r32, hi);
        __builtin_amdgcn_s_setprio(0);
        A_WRITEK(sB, 1); A_WRITEV(sB, 0);
        __syncthreads();
    }
    if (wid < 4) __syncthreads();
#undef TCL
#undef KROW0
#undef A_LOADK
#undef A_LOADV
#undef A_WRITEK
#undef A_WRITEV
    const float lt = l_reg + __shfl_xor(l_reg, 32); inv = __builtin_amdgcn_rcpf(lt);
}
template <bool MLA>
__device__ __forceinline__ void attn_unit(const Frame& F, const Params& p, int l, int h, int qrow0, int qpos0, int klat0, int nlat, int kctx0) {
    const int wid = F.wave, lane = F.lane, r32 = lane & 31, hi = lane >> 5;
    hf* Y = (hf*)(p.ws + A_Y);
    const size_t yrow = (size_t)(qrow0 + wid * 32 + r32) * DM;
    if constexpr (MLA) {
        f32x16 o0, o1; float inv;
        attn_pass<true>(F, p, h, h, qrow0, qpos0, klat0, nlat, kctx0, o0, o1, inv);
#pragma unroll
        for (int blk = 0; blk < 2; ++blk) { const f32x16& o = blk ? o1 : o0;
#pragma unroll
            for (int g = 0; g < 4; g += 2) {
                u32x2 a, b; a.x = pkhb(o[4 * g] * inv, o[4 * g + 1] * inv); a.y = pkhb(o[4 * g + 2] * inv, o[4 * g + 3] * inv);
                b.x = pkhb(o[4 * g + 4] * inv, o[4 * g + 5] * inv); b.y = pkhb(o[4 * g + 6] * inv, o[4 * g + 7] * inv);
                { auto r = __builtin_amdgcn_permlane32_swap(a.x, b.x, false, false); a.x = r[0]; b.x = r[1]; }
                { auto r = __builtin_amdgcn_permlane32_swap(a.y, b.y, false, false); a.y = r[0]; b.y = r[1]; }
                u32x4 w = {a.x, a.y, b.x, b.y};
                *(u32x4*)(Y + yrow + h * 64 + 32 * blk + 8 * g + 8 * hi) = w; } }
    } else {
        const float lam = ((const float*)(p.ws + WS_LAM))[2 * l], oml = ((const float*)(p.ws + WS_LAM))[2 * l + 1];
        f32x16 a0, a1;
        LAS float* park = (LAS float*)(F.lds + 65536 + wid * 8192) + lane;
        { f32x16 o0, o1; float inv; attn_pass<false>(F, p, 2 * h, h, qrow0, qpos0, klat0, nlat, kctx0, o0, o1, inv);
#pragma unroll
          for (int r = 0; r < 16; ++r) { park[r * 64] = o0[r] * inv; park[(16 + r) * 64] = o1[r] * inv; } }
        { f32x16 o0, o1; float inv; attn_pass<false>(F, p, 2 * h + 1, h, qrow0, qpos0, klat0, nlat, kctx0, o0, o1, inv);
#pragma unroll
          for (int r = 0; r < 16; ++r) { a0[r] = park[r * 64] - o0[r] * (lam * inv); a1[r] = park[(16 + r) * 64] - o1[r] * (lam * inv); } }
        float ss = 0.f;
#pragma unroll
        for (int r = 0; r < 16; ++r) ss += a0[r] * a0[r] + a1[r] * a1[r];
        ss += __shfl_xor(ss, 32);
        const float rs = rsqrtf(ss * (1.f / 64.f) + EPS) * oml;
#pragma unroll
        for (int g = 0; g < 4; ++g) { const f32x4 gg = *(const f32x4*)(p.in[I_SUBG] + l * 64 + 8 * g + 4 * hi);
            u32x2 w; w.x = pkhb(a0[4 * g] * rs * gg[0], a0[4 * g + 1] * rs * gg[1]); w.y = pkhb(a0[4 * g + 2] * rs * gg[2], a0[4 * g + 3] * rs * gg[3]); *(u32x2*)(Y + yrow + 768 + h * 64 + 8 * g + 4 * hi) = w; }
#pragma unroll
        for (int g = 0; g < 4; ++g) { const f32x4 gg = *(const f32x4*)(p.in[I_SUBG] + l * 64 + 32 + 8 * g + 4 * hi);
            u32x2 w; w.x = pkhb(a1[4 * g] * rs * gg[0], a1[4 * g + 1] * rs * gg[1]); w.y = pkhb(a1[4 * g + 2] * rs * gg[2], a1[4 * g + 3] * rs * gg[3]); *(u32x2*)(Y + yrow + 768 + h * 64 + 32 + 8 * g + 4 * hi) = w; }
    }
}
}

#define HY_MARK(b) do { if (PROF_SEL >= 0 && F.tid == 0) { volatile LAS unsigned* _pf = (volatile LAS unsigned*)(F.lds + LDS_BYTES - 512); const unsigned _t = (unsigned)__builtin_amdgcn_s_memrealtime(); _pf[(b)] += _t - _pf[32]; _pf[32] = _t; } } while (0)
template <int L>
__device__ __forceinline__ void hyena_unit(const Frame& F, const hf* Rrow  , const hf* U  , const hf* X0  , hf* Ycol  ) {
    constexpr int NM = L / 256, RL = 2 * L, SH = (L > 1024) ? 1024 : L, NH = L / SH, US = SH * 2 + 16;
    constexpr int OFF_U = 8 * RL * 2;
    constexpr int XP = L * 2 + 16;
    static_assert(OFF_U + 32 * US <= LDS_MISC && 32 * XP <= LDS_MISC, "hyena LDS");
    const int tid = F.tid, w = F.wave, lane = F.lane, i32 = lane & 31, hi = lane >> 5;
    LAS unsigned char* lds = F.lds;
    __syncthreads();
    for (int i = tid; i < RL / 8; i += 512) *(LAS u32x4*)(lds + i * 16) = *(const u32x4*)(Rrow + i * 8);
    __syncthreads();
    {
        const LAS unsigned* src = (const LAS unsigned*)lds;
#pragma unroll 1
        for (int idx = tid; idx < 7 * (RL / 8); idx += 512) { const int cw = 1 + idx / (RL / 8), c4 = (idx % (RL / 8)) * 4;
            const int k0 = c4 - ((cw + 1) >> 1); unsigned d[5];
#pragma unroll
            for (int e = 0; e < 5; ++e) { const int k = k0 + e; d[e] = (k >= 0 && k < RL / 2) ? src[k] : 0u; }
            u32x4 o;
            if (cw & 1) { o.x = (d[0] >> 16) | (d[1] << 16); o.y = (d[1] >> 16) | (d[2] << 16); o.z = (d[2] >> 16) | (d[3] << 16); o.w = (d[3] >> 16) | (d[4] << 16); }
            else { o.x = d[0]; o.y = d[1]; o.z = d[2]; o.w = d[3]; }
            *(LAS u32x4*)(lds + cw * (RL * 2) + c4 * 4) = o; }
    }
    HY_MARK(22);
    f32x16 acc[NM];
#pragma unroll
    for (int m = 0; m < NM; ++m) acc[m] = f32x16{};
    const LAS unsigned char* cpy = lds + w * (RL * 2);
    for (int half = 0; half < NH; ++half) {
        __syncthreads();
        {
            constexpr int NPC = 32 * (SH / 8) / 512, NB4 = NPC > 4 ? 4 : NPC;
            int tq = tid; asm volatile("" : "+v"(tq));
#pragma unroll
            for (int k0 = 0; k0 < NPC; k0 += NB4) { u32x4 tmp[NB4];
#pragma unroll
                for (int k = 0; k < NB4; ++k) { const int idx = tq + 512 * (k0 + k), b = idx / (SH / 8), pc = idx % (SH / 8); tmp[k] = *(const u32x4*)(U + (size_t)b * L + half * SH + pc * 8); }
#pragma unroll
                for (int k = 0; k < NB4; ++k) { const int idx = tq + 512 * (k0 + k), b = idx / (SH / 8), pc = idx % (SH / 8); *(LAS u32x4*)(lds + OFF_U + b * US + pc * 16) = tmp[k]; }
                asm volatile("" ::: "memory"); }
        }
        __syncthreads();
#pragma unroll 2
        for (int jl = 0; jl < SH / 16; ++jl) {
            const int j = half * (SH / 16) + jl;
            const hf8 bf = *(const LAS hf8*)(lds + OFF_U + i32 * US + (jl * 16 + hi * 8) * 2);
            const int x0 = L + 16 * j + 8 * hi - 8 * i32;
#pragma unroll
            for (int m = 0; m < NM; ++m) { const hf8 af = *(const LAS hf8*)(cpy + (x0 - 256 * m) * 2);
                acc[m] = __builtin_amdgcn_mfma_f32_32x32x16_f16(af, bf, acc[m], 0, 0, 0); }
        }
    }
    __syncthreads();
    HY_MARK(23);
    {
        constexpr int NPC = 32 * (L / 8) / 512, NB8 = NPC > 4 ? 4 : NPC;
        int tq = tid; asm volatile("" : "+v"(tq));
#pragma unroll
        for (int k0 = 0; k0 < NPC; k0 += NB8) { u32x4 tmp[NB8];
#pragma unroll
            for (int k = 0; k < NB8; ++k) { const int idx = tq + 512 * (k0 + k), b = idx / (L / 8), pc = idx % (L / 8); tmp[k] = *(const u32x4*)(X0 + (size_t)b * L + pc * 8); }
#pragma unroll
            for (int k = 0; k < NB8; ++k) { const int idx = tq + 512 * (k0 + k), b = idx / (L / 8), pc = idx % (L / 8); *(LAS u32x4*)(lds + b * XP + pc * 16) = tmp[k]; }
            asm volatile("" ::: "memory"); }
    }
    __syncthreads();
    HY_MARK(24);
    const LAS hf* x0p = (const LAS hf*)(lds + i32 * XP) + w + 32 * hi;
    hf* yp = Ycol + ((size_t)i32 * L + w + 32 * hi) * DM;
#pragma unroll
    for (int m = 0; m < NM; ++m) {
#pragma unroll
        for (int r = 0; r < 16; ++r) { const int tt = 256 * m + 8 * ((r & 3) + 8 * (r >> 2));
            const float x0v = (float)x0p[tt];
            { const float yv = x0v * acc[m][r]; unsigned ub = __float_as_uint(yv); ub += 0xffffu + ((ub >> 17) & 1u); yp[(size_t)tt * DM] = (hf)__uint_as_float(ub & 0xfffe0000u); } }
        asm volatile("" ::: "memory");
    }
    HY_MARK(25);
}

#ifndef PH_MASK
#define PH_MASK 0x1FFFF
#endif
#define PHM(k) ((PH_MASK >> (k)) & 1)
#ifndef PROBE_REP
#define PROBE_REP 0
#endif
#define NREP(k) (((PROBE_REP >> (k)) & 1) ? 2 : 1)
constexpr int NPH_LAYER = 7, PH_L0 = 2, NPHASE = PH_L0 + DEPTH * NPH_LAYER + 1;
__global__ void __launch_bounds__(512, 2) fwd_kernel(Params p) {
    extern __shared__ __attribute__((aligned(16))) unsigned char lds_raw[];
    Frame F0; Frame& F = F0;
    F.lds = (LAS unsigned char*)lds_raw;
    F.tid = threadIdx.x; F.lane = F.tid & 63; F.wave = __builtin_amdgcn_readfirstlane(F.tid >> 6);
    F.G = gridDim.x; { const int bx = blockIdx.x; F.vcu = (F.G % 8 == 0) ? (bx % 8) * (F.G / 8) + bx / 8 : bx; }
    volatile LAS unsigned* misc = (volatile LAS unsigned*)(F.lds + LDS_MISC);
    if (F.tid < 16) misc[F.tid] = 0u;
    __syncthreads();
    const int lo = p.ph_lo, hi = p.ph_hi;
    XcdBarrier bar; bar.bar = (unsigned*)(p.ws + WS_BAR); bar.x = 0; bar.st = misc;
    if (hi - lo > 1) bar = xcd_barrier_post((unsigned*)(p.ws + WS_BAR), misc);
#define IN(k) (lo <= (k) && (k) < hi)
#define LAUNDER(Fl) Frame Fl = F0; asm volatile("" : "+v"(Fl.tid)); Fl.lane = Fl.tid & 63
#ifndef PROF_SEL
#define PROF_SEL -1
#endif
#define PROF_K 8
    volatile LAS unsigned* prof = (volatile LAS unsigned*)(F.lds + LDS_BYTES - 512);
    if (PROF_SEL >= 0 && F.tid < 40) prof[F.tid] = 0u;
    if (PROF_SEL >= 0) __syncthreads();
    if (PROF_SEL >= 0 && F.tid == 0) prof[32] = (unsigned)__builtin_amdgcn_s_memrealtime();
#define PROF_MARK(b) do { if (PROF_SEL >= 0 && F.tid == 0) { const unsigned _t = (unsigned)__builtin_amdgcn_s_memrealtime(); prof[(b)] += _t - prof[32]; if ((b) >= 16) prof[30] += _t - prof[32]; prof[32] = _t; } } while (0)
#define SEAMT(k, b) do { PROF_MARK(b); if (IN(k) && IN((k) + 1)) xcd_barrier(bar); PROF_MARK(16 + (b)); } while (0)
#define SEAM(k) do { if (IN(k) && IN((k) + 1)) xcd_barrier(bar); } while (0)
    unsigned char* ws = p.ws;
    hf* X16 = (hf*)(ws + WS_X16);
    hf* XS1 = (hf*)p.out; hf* MM = (hf*)p.out; hf* Y = (hf*)(ws + A_B); hf* XS2 = (hf*)(ws + A_B);
    hf* QKV = (hf*)(ws + A_QKV); hf* QKVN = (hf*)(ws + A_QKVN);
    unsigned char* Gt = (unsigned char*)(ws + A_G); hf* HID = (hf*)(ws + A_HID);
    float* SS = (float*)(ws + WS_SS);

    if (PHM(11) && IN(0)) for (int rep = 0; rep < NREP(11); ++rep) { LAUNDER(Fl); prologue_a(Fl, p); }
    SEAMT(0, 9);
    if (PHM(11) && IN(1)) for (int rep = 0; rep < NREP(12); ++rep) { LAUNDER(Fl); prologue_b(Fl, p); }
    SEAMT(1, 9);

    for (int l = 0; l < DEPTH; ++l) {
        const int pb = PH_L0 + l * NPH_LAYER;
        const bool ctx_live = l < DEPTH - 1;
        const int Mrows = ctx_live ? MTOT : NLAT;
        const float* modl = (const float*)(ws + WS_MOD) + (size_t)l * NMODV * MODW;
        const float* biasl = (const float*)(ws + WS_BIAS) + (size_t)l * NMODV * NBIAS;
        const float* gsl = (const float*)(ws + WS_GS) + (size_t)l * 2 * NMODV * DM;
        const unsigned char* wl = ws + WS_WT + (size_t)(l & 1) * W_LAYER;
        float* ss1 = SS + (size_t)(SS_1 + l) * MTOT * 4; float* ss2 = SS + (size_t)(SS_2 + l) * MTOT * 4;
        float* ssq = (float*)(ws + WS_SSQ) + (size_t)l * MTOT; float* sskv = (float*)(ws + WS_SSKV) + (size_t)l * MTOT;
        LAS unsigned char* lx = F.lds + LDS_EXCH;

        if (PHM(1) && IN(pb + 0)) { pg8::Gemm g{XS1, (const hf*)(wl + W_IN1), MTOT, NP1, DM, DM, DM}; pg8::StaticOrder S; S.init(MTOT, NP1, F.G, (int)blockIdx.x);
            pg8::EpiIn E{QKVN, (hf*)(ws + A_KR), (hf*)(ws + A_PHY), (hf*)(ws + A_DQ), (hf*)(ws + A_DK), (hf*)(ws + A_DV), ss1, biasl + B_IN, ssq, sskv, lx, F.lds + LDS_PRE};
            pg8::gemm_phase(F.lds, g, S, E); }
        SEAMT(pb + 0, 0);
        if (PHM(2) && IN(pb + 1)) {
            { LAUNDER(Fl); prep_rope(Fl, p); prep_hyena(Fl, p, l, ctx_live); }
            __syncthreads();
            PROF_MARK(1);
            { pg8::Gemm g{QKVN, (const hf*)(wl + W_UP), MTOT, NUP, KUP, KUP, KUP}; pg8::StaticOrder S; S.init(MTOT, NUP, F.G, (int)blockIdx.x);
              pg8::EpiUp E{QKV, ssq, sskv, F.lds + LDS_PRE}; pg8::gemm_phase(F.lds, g, S, E); }
        }
        SEAMT(pb + 1, 2);
        if (PHM(4) && IN(pb + 2)) {
            {
            LAUNDER(Fl);
            PROF_MARK(14);
            const int n_mla = 2048 + (ctx_live ? 256 : 0);
            for (int id = F.vcu; id < n_mla; id += F.G) {
                if (id < 2048) { const int qb = id & 7, h = (id >> 3) & 7, b = id >> 6; att::attn_unit<true>(Fl, p, l, h, b * SEQ + qb * 256, qb * 256, b * SEQ, 32, NLAT + b * CTXL); }
                else { const int i2 = id - 2048, h = i2 & 7, b = i2 >> 3; att::attn_unit<true>(Fl, p, l, h, NLAT + b * CTXL, -1, 0, 0, NLAT + b * CTXL); }
            }
            PROF_MARK(11);
            const int n_df = 1024 + (ctx_live ? 128 : 0);
            for (int id = F.vcu; id < n_df; id += F.G) {
                if (id < 1024) { const int qb = id & 7, h = (id >> 3) & 3, b = id >> 5; att::attn_unit<false>(Fl, p, l, h, b * SEQ + qb * 256, qb * 256, b * SEQ, 32, NLAT + b * CTXL); }
                else { const int i2 = id - 1024, h = i2 & 3, b = i2 >> 2; att::attn_unit<false>(Fl, p, l, h, NLAT + b * CTXL, -1, 0, 0, NLAT + b * CTXL); }
            }
            PROF_MARK(12);
            const unsigned char* ob = (const unsigned char*)p.out;
            for (int c = F.vcu; c < 256; c += F.G)
                hyena_unit<SEQ>(Fl, (const hf*)(ws + WS_RF) + ((size_t)l * 256 + c) * 4096, (const hf*)(ob + O_UT) + (size_t)c * NLAT, (const hf*)(ob + O_X0T) + (size_t)c * NLAT, Y + 512 + c);
            if (ctx_live) for (int c = F.vcu; c < 256; c += F.G)
                hyena_unit<CTXL>(Fl, (const hf*)(ws + WS_RFC) + ((size_t)l * 256 + c) * 512, (const hf*)(ob + O_UTC) + (size_t)c * NCTX, (const hf*)(ob + O_X0TC) + (size_t)c * NCTX, Y + (size_t)NLAT * DM + 512 + c);
            __syncthreads();
            PROF_MARK(13);
            }
            { pg8::Gemm g{XS1, (const hf*)(wl + W_ING), Mrows, NGATE, DM, DM, DM}; pg8::StaticOrder S; S.init(Mrows, NGATE, F.G, (int)blockIdx.x);
              pg8::EpiGate8 E{Gt, ss1, biasl + B_G, F.lds + LDS_PRE}; pg8::gemm_phase(F.lds, g, S, E); }
        }
        SEAMT(pb + 2, 4);
        if (PHM(6) && IN(pb + 3)) { pg8::Gemm g{Y, (const hf*)(wl + W_BR), Mrows, DM, DM, DM, DM}; pg8::StaticOrder S; S.init(Mrows, DM, F.G, (int)blockIdx.x);
            pg8::EpiMerge E{MM, Gt}; pg8::gemm_phase(F.lds, g, S, E); }
        SEAMT(pb + 3, 5);
        if (PHM(7) && IN(pb + 4)) { pg8::Gemm g{MM, (const hf*)(wl + W_OUT), Mrows, DM, DM, DM, DM}; pg8::StaticOrder S; S.init(Mrows, DM, F.G, (int)blockIdx.x);
            pg8::EpiResidX<true, true> E{X16, modl + 2 * DM, XS2, gsl + (size_t)NMODV * DM, ss2, lx}; pg8::gemm_phase(F.lds, g, S, E); }
        SEAMT(pb + 4, 6);
        if (PHM(9) && IN(pb + 5)) { pg8::Gemm g{XS2, (const hf*)(wl + W_FC1), Mrows, DFF, DM, DM, DM}; pg8::StaticOrder S; S.init(Mrows, DFF, F.G, (int)blockIdx.x);
            pg8::EpiHalf<2, true> E{HID, DFF, ss2, biasl + B_FC1, F.lds + LDS_PRE}; pg8::gemm_phase(F.lds, g, S, E); }
        SEAMT(pb + 5, 7);
        if (PHM(10) && IN(pb + 6)) { pg8::Gemm g{HID, (const hf*)(wl + W_FC2), Mrows, DM, DFF, DFF, DFF}; pg8::StaticOrder S; S.init(Mrows, DM, F.G, (int)blockIdx.x);
            if (ctx_live) { pg8::EpiResidX<true, true> E{X16, modl + 5 * DM, XS1, gsl + (size_t)2 * NMODV * DM, ss1 + (size_t)MTOT * 4, lx}; pg8::gemm_phase(F.lds, g, S, E);
                const int nheavy = (MTOT / 256 * 4) % F.G;
                if (nheavy > 0 && (int)blockIdx.x >= nheavy) { __syncthreads(); LAUNDER(Fl); convert_layer(Fl, p, l + 1, ws + WS_WT + (size_t)((l + 1) & 1) * W_LAYER, (int)blockIdx.x - nheavy, F.G - nheavy); }
                else if (nheavy == 0) { __syncthreads(); LAUNDER(Fl); convert_layer(Fl, p, l + 1, ws + WS_WT + (size_t)((l + 1) & 1) * W_LAYER, Fl.vcu, F.G); } }
            else { pg8::EpiResidX<false, true> E{X16, modl + 5 * DM, nullptr, nullptr, SS + (size_t)SS_F * MTOT * 4, lx}; pg8::gemm_phase(F.lds, g, S, E); } }
        SEAMT(pb + 6, 8);
    }
    if (PHM(12) && IN(NPHASE - 1)) { LAUNDER(Fl); final_norm_phase(Fl, X16, p.out, p.in[I_FNG], SS + (size_t)SS_F * MTOT * 4); }
    PROF_MARK(10);
    if (PROF_SEL >= 0 && blockIdx.x == 0 && F.tid == 0) { const unsigned long long t0 = __builtin_amdgcn_s_memrealtime(); const unsigned long long d = (unsigned long long)PROF_K * prof[PROF_SEL];
        while (__builtin_amdgcn_s_memrealtime() - t0 < d) __builtin_amdgcn_s_sleep(8); }
#undef IN
#undef SEAM
}

extern "C" void kernel_launch(void* const* d_in, const int* in_sizes, int n_in, void* d_out, int out_size, void* d_ws, size_t ws_size, hipStream_t stream) {
    static int grid = 0;
    if (grid == 0) {
        if (n_in != 35 || in_sizes[0] != NLAT * DM || out_size != NLAT * DM || ws_size < WS_END) {
            fprintf(stderr, "kernel_launch: unexpected shapes: n_in %d in0 %d out %d ws %zu (need %zu); nothing launched\n", n_in, n_in > 0 ? in_sizes[0] : -1, out_size, ws_size, (size_t)WS_END); grid = -1; return; }
        int dev = 0, cus = 0, per_cu = 0;
        if (hipGetDevice(&dev) != hipSuccess || hipDeviceGetAttribute(&cus, hipDeviceAttributeMultiprocessorCount, dev) != hipSuccess) { fprintf(stderr, "kernel_launch: device query failed\n"); grid = -1; return; }
        if (hipFuncSetAttribute((const void*)fwd_kernel, hipFuncAttributeMaxDynamicSharedMemorySize, LDS_BYTES) != hipSuccess) { fprintf(stderr, "kernel_launch: hipFuncSetAttribute failed\n"); grid = -1; return; }
        if (hipOccupancyMaxActiveBlocksPerMultiprocessor(&per_cu, (const void*)fwd_kernel, 512, LDS_BYTES) != hipSuccess || per_cu < 1)
            fprintf(stderr, "kernel_launch: note: occupancy query reports %d workgroups per CU\n", per_cu);
        (void)hipGetLastError();
        grid = cus;
    }
    if (grid < 0) return;
    if (hipMemsetAsync((char*)d_ws + WS_BAR, 0, WS_ZERO_BYTES, stream) != hipSuccess) { fprintf(stderr, "kernel_launch: memset failed\n"); return; }
    Params P{};
    for (int i = 0; i < 35; ++i) P.in[i] = (const float*)d_in[i];
    P.out = (float*)d_out; P.ws = (unsigned char*)d_ws;
#if MK_FUSED
    P.ph_lo = 0; P.ph_hi = NPHASE;
    hipLaunchKernelGGL(fwd_kernel, dim3(grid), dim3(512), LDS_BYTES, stream, P);
#else
    for (int ph = 0; ph < NPHASE; ++ph) { P.ph_lo = ph; P.ph_hi = ph + 1; hipLaunchKernelGGL(fwd_kernel, dim3(grid), dim3(512), LDS_BYTES, stream, P); }
#endif
    const hipError_t le = hipPeekAtLastError();
    if (le != hipSuccess) fprintf(stderr, "kernel_launch: launch failed: %s\n", hipGetErrorName(le));
}
```
